# Optimizing an MI355X kernel written in HIP

```python
import jax, jax.numpy as jnp
from jax import lax
import numpy as np

D_MODEL = 2048
BATCH = 4
SEQ = 4096
DEPTH = 1

MIX_WIDTH = D_MODEL
GLA_HEADS = 4
GLA_DV = MIX_WIDTH // 2 // GLA_HEADS
GLA_DK = GLA_DV // 2
GLA_RANK = 16
GLA_TAU = 16.0
GLA_CHUNK = 64
ATT_HEADS = 16
ATT_HD = (MIX_WIDTH - GLA_HEADS * GLA_DV) // ATT_HEADS
DILATED_PATTERNS = ((128, 1), (512, 4), (2048, 16))
PEER_NKEYS = 128
PEER_EXPERTS = PEER_NKEYS * PEER_NKEYS
PEER_HEADS = 8
PEER_TOPK = 16
PEER_DQ = 256
PEER_TOKEN_BLOCK = 64
EPS = 1e-6
NEG = -1e30

GLA_QK = GLA_HEADS * GLA_DK
GLA_V = GLA_HEADS * GLA_DV
ATT_W = ATT_HEADS * ATT_HD
IN_SPLITS = (GLA_QK, GLA_QK, GLA_V, GLA_V, GLA_RANK, GLA_RANK, ATT_W, ATT_W, ATT_W)
IN_WIDTH = sum(IN_SPLITS)

kernel_name = "hymba_gla_dilated_peer_encoder"


def rms_norm(x, g):
    xf = x.astype(jnp.float32)
    y = xf * lax.rsqrt(jnp.mean(xf * xf, axis=-1, keepdims=True) + EPS)
    return (y * g.astype(jnp.float32)).astype(x.dtype)


def alibi_slopes(n):
    return (2.0 ** (-8.0 * np.arange(1, n + 1) / n)).astype(np.float32)


def gla_chunked(q, k, v, log_a):
    B, H, S, dk = q.shape
    dv = v.shape[-1]
    C = GLA_CHUNK
    N = S // C
    q = q.reshape(B, H, N, C, dk)
    k = k.reshape(B, H, N, C, dk)
    v = v.reshape(B, H, N, C, dv)
    b = jnp.cumsum(log_a.reshape(B, H, N, C, dk), axis=3)
    b_last = b[:, :, :, -1:, :]
    q_d = q * jnp.exp(b)
    k_d = k * jnp.exp(-b)
    causal = jnp.tril(jnp.ones((C, C), dtype=bool))
    att = jnp.where(causal, jnp.einsum('bhncd,bhnsd->bhncs', q_d, k_d), 0.0)
    o_intra = jnp.einsum('bhncs,bhnse->bhnce', att, v)
    kv = jnp.einsum('bhncd,bhnce->bhnde', k * jnp.exp(b_last - b), v)
    decay = jnp.exp(b_last[:, :, :, 0, :])

    def step(state, inp):
        dec, kv_n = inp
        return dec[..., None] * state + kv_n, state

    init = jnp.zeros((B, H, dk, dv), q.dtype)
    _, prev = lax.scan(step, init, (jnp.moveaxis(decay, 2, 0), jnp.moveaxis(kv, 2, 0)))
    prev = jnp.moveaxis(prev, 0, 2)
    o_inter = jnp.einsum('bhncd,bhnde->bhnce', q_d, prev)
    return (o_intra + o_inter).reshape(B, H, S, dv)


def dilated_band(q, k, v, slopes, dilation, radius):
    B, H, S, hd = q.shape
    L = S // dilation
    blk = radius
    nb = -(-L // blk)
    Lp = nb * blk

    def to_sub(t):
        return t.reshape(B, H, L, dilation, hd).transpose(0, 1, 3, 2, 4)

    qs = jnp.pad(to_sub(q), ((0, 0),) * 3 + ((0, Lp - L), (0, 0))).reshape(B, H, dilation, nb, blk, hd)
    pad_kv = ((0, 0),) * 3 + ((blk, Lp - L + blk), (0, 0))

    def windows(t):
        t = jnp.pad(to_sub(t), pad_kv).reshape(B, H, dilation, nb + 2, blk, hd)
        return jnp.concatenate([t[:, :, :, :-2], t[:, :, :, 1:-1], t[:, :, :, 2:]], axis=4)

    kw, vw = windows(k), windows(v)
    q_pos = jnp.arange(nb)[:, None] * blk + jnp.arange(blk)[None, :]
    k_pos = jnp.arange(nb)[:, None] * blk - blk + jnp.arange(3 * blk)[None, :]
    off = k_pos[:, None, :] - q_pos[:, :, None]
    valid = (jnp.abs(off) <= radius) & (k_pos[:, None, :] >= 0) & (k_pos[:, None, :] < L)
    dist = (jnp.abs(off) * dilation).astype(jnp.float32)
    s = jnp.einsum('bhrnqd,bhrnkd->bhrnqk', qs, kw)
    s = s - slopes[None, :, None, None, None, None] * dist
    s = jnp.where(valid, s, NEG)
    m = jnp.max(s, axis=-1)
    p = jnp.exp(s - m[..., None])
    l = jnp.sum(p, axis=-1)
    num = jnp.einsum('bhrnqk,bhrnkd->bhrnqd', p, vw)

    def from_sub(t):
        t = t.reshape((B, H, dilation, Lp) + t.shape[5:])[:, :, :, :L]
        t = jnp.moveaxis(t, 2, 3)
        return t.reshape((B, H, S) + t.shape[4:])

    return from_sub(num), from_sub(m), from_sub(l)


def hybrid_mixer(h, w_in, gate_up_f, gate_bias_f, gate_up_b, gate_bias_b, gla_norm_g, att_norm_g, w_out):
    B, S, _ = h.shape
    f32 = jnp.float32
    proj = jnp.einsum('bsd,de->bse', h, w_in)
    offsets = [int(o) for o in np.cumsum(IN_SPLITS)[:-1]]
    gq, gk, gv, gr, gdf, gdb, aq, ak, av = jnp.split(proj, offsets, axis=-1)

    def heads(t, n):
        return t.reshape(B, S, n, -1).transpose(0, 2, 1, 3).astype(f32)

    q = heads(gq, GLA_HEADS) * (GLA_DK ** -0.5)
    k = heads(gk, GLA_HEADS)
    v = heads(gv, GLA_HEADS)

    def log_gate(down, up, bias):
        z = (jnp.einsum('bsr,rk->bsk', down, up) + bias).astype(f32)
        return heads(jax.nn.log_sigmoid(z) / GLA_TAU, GLA_HEADS)

    la_f = log_gate(gdf, gate_up_f, gate_bias_f)
    la_b = log_gate(gdb, gate_up_b, gate_bias_b)
    flip = lambda t: jnp.flip(t, axis=2)
    o_f = gla_chunked(q, k, v, la_f)
    o_b = flip(gla_chunked(flip(q), flip(k), flip(v), flip(la_b)))
    o = rms_norm(o_f + o_b, gla_norm_g)
    o = o.transpose(0, 2, 1, 3).reshape(B, S, GLA_V)
    gla_out = o * jax.nn.silu(gr.astype(f32))

    q = heads(aq, ATT_HEADS) * (ATT_HD ** -0.5)
    k = heads(ak, ATT_HEADS)
    v = heads(av, ATT_HEADS)
    slopes = jnp.asarray(alibi_slopes(ATT_HEADS))
    nums, maxs, dens = [], [], []
    for window, dilation in DILATED_PATTERNS:
        n_, m_, l_ = dilated_band(q, k, v, slopes, dilation, window // (2 * dilation))
        nums.append(n_); maxs.append(m_); dens.append(l_)
    nums, maxs, dens = jnp.stack(nums), jnp.stack(maxs), jnp.stack(dens)
    w = jnp.exp(maxs - jnp.max(maxs, axis=0, keepdims=True))
    att = jnp.sum(w[..., None] * nums, axis=0) / jnp.sum(w * dens, axis=0)[..., None]
    att = att.transpose(0, 2, 1, 3).reshape(B, S, ATT_W)
    att = rms_norm(att, att_norm_g)

    y = jnp.concatenate([gla_out, att], axis=-1).astype(h.dtype)
    return jnp.einsum('bse,ed->bsd', y, w_out)


def peer_ffn(h, w_q, sub_keys, expert_u, expert_v):
    B, S, D = h.shape
    T = B * S
    f32 = jnp.float32
    x = h.reshape(T, D)
    q = jnp.einsum('td,de->te', x, w_q).reshape(T, PEER_HEADS, 2, PEER_DQ // 2).astype(f32)
    s = jnp.einsum('thcd,hckd->thck', q, sub_keys.astype(f32))
    sc, si = lax.top_k(s, PEER_TOPK)
    cand = (sc[:, :, 0, :, None] + sc[:, :, 1, None, :]).reshape(T, PEER_HEADS, PEER_TOPK * PEER_TOPK)
    top_sc, top_ci = lax.top_k(cand, PEER_TOPK)
    i1 = jnp.take_along_axis(si[:, :, 0], top_ci // PEER_TOPK, axis=-1)
    i2 = jnp.take_along_axis(si[:, :, 1], top_ci % PEER_TOPK, axis=-1)
    experts = i1 * PEER_NKEYS + i2
    gates = jax.nn.softmax(top_sc, axis=-1)
    TB = PEER_TOKEN_BLOCK
    nblk = T // TB

    def block(args):
        xb, eb, gb = args
        a = jax.nn.gelu(jnp.einsum('td,thkd->thk', xb, expert_u[eb]).astype(f32), approximate=False)
        wgt = (gb * a).astype(xb.dtype)
        return jnp.einsum('thk,thkd->td', wgt, expert_v[eb])

    out = lax.map(block, (x.reshape(nblk, TB, D),
                          experts.reshape(nblk, TB, PEER_HEADS, PEER_TOPK),
                          gates.reshape(nblk, TB, PEER_HEADS, PEER_TOPK)))
    return out.reshape(B, S, D).astype(h.dtype)


def setup_inputs(seed: int = 0) -> dict:
    key = jax.random.key(seed)
    ks = jax.random.split(key, 20)
    nrm = lambda k, shape, scale: jax.random.normal(k, shape, jnp.float32) * scale
    L = DEPTH
    return {
        "x": nrm(ks[0], (BATCH, SEQ, D_MODEL), 1.0),
        "norm1_g": 1.0 + nrm(ks[1], (L, D_MODEL), 0.02),
        "w_in": nrm(ks[2], (L, D_MODEL, IN_WIDTH), D_MODEL ** -0.5),
        "gla_gate_up_f": nrm(ks[3], (L, GLA_RANK, GLA_QK), GLA_RANK ** -0.5),
        "gla_gate_bias_f": nrm(ks[4], (L, GLA_QK), 0.1),
        "gla_gate_up_b": nrm(ks[5], (L, GLA_RANK, GLA_QK), GLA_RANK ** -0.5),
        "gla_gate_bias_b": nrm(ks[6], (L, GLA_QK), 0.1),
        "gla_norm_g": 1.0 + nrm(ks[7], (L, GLA_DV), 0.02),
        "att_norm_g": 1.0 + nrm(ks[8], (L, ATT_W), 0.02),
        "w_out": nrm(ks[9], (L, MIX_WIDTH, D_MODEL), MIX_WIDTH ** -0.5),
        "norm2_g": 1.0 + nrm(ks[10], (L, D_MODEL), 0.02),
        "peer_w_q": nrm(ks[11], (L, D_MODEL, PEER_HEADS * PEER_DQ), D_MODEL ** -0.5),
        "peer_sub_keys": nrm(ks[12], (L, PEER_HEADS, 2, PEER_NKEYS, PEER_DQ // 2), (PEER_DQ // 2) ** -0.5),
        "peer_u": nrm(ks[13], (L, PEER_EXPERTS, D_MODEL), D_MODEL ** -0.5),
        "peer_v": nrm(ks[14], (L, PEER_EXPERTS, D_MODEL), 0.5),
        "final_norm_g": 1.0 + nrm(ks[15], (D_MODEL,), 0.02),
    }


def reference(x, norm1_g, w_in, gla_gate_up_f, gla_gate_bias_f, gla_gate_up_b, gla_gate_bias_b,
              gla_norm_g, att_norm_g, w_out, norm2_g, peer_w_q, peer_sub_keys, peer_u, peer_v,
              final_norm_g):
    for l in range(DEPTH):
        h = x + hybrid_mixer(rms_norm(x, norm1_g[l]), w_in[l], gla_gate_up_f[l], gla_gate_bias_f[l],
                             gla_gate_up_b[l], gla_gate_bias_b[l], gla_norm_g[l], att_norm_g[l], w_out[l])
        x = h + peer_ffn(rms_norm(h, norm2_g[l]), peer_w_q[l], peer_sub_keys[l], peer_u[l], peer_v[l])
    return rms_norm(x, final_norm_g)
```

```cpp
#include <hip/hip_runtime.h>
#include <cstdio>
#include <cstdint>
#include <cmath>
namespace pg8 {
#define PG8_LAS __attribute__((address_space(3)))
typedef unsigned short bf16_t;
typedef short bf16x8 __attribute__((ext_vector_type(8)));
typedef float f32x4 __attribute__((ext_vector_type(4)));
typedef unsigned u32x4 __attribute__((ext_vector_type(4)));
constexpr int BM = 256, BK = 64, HALF = 128, HTB = HALF * BK * 2  , STAGE_BYTES = 8 * HTB, NXCD = 8, WGM = 8;

__host__ __device__ __forceinline__ int lds_byte(int r, int c) { const int st = (r >> 4) * 2 + (c >> 5), rr = r & 15, cc = c & 31, ob = rr * 64 + cc * 2; return st * 1024 + (ob ^ (((ob >> 9) & 1) << 5)); }
__host__ __device__ __forceinline__ void stage_rc(int b, int& R, int& C) { const int st = b / 1024, sb = b % 1024, swz = sb ^ (((sb >> 9) & 1) << 5); R = (st >> 1) * 16 + swz / 64; C = (st & 1) * 32 + (swz % 64) / 2; }
__host__ __device__ __forceinline__ int perm32(int rho) { const int n = rho >> 4, i = rho & 15; return 8 * (i >> 2) + 4 * n + (i & 3); }

struct Unit { int pm, pn; };
struct Gemm { const bf16_t* A; const bf16_t* Bt; int M, N, K; };

struct StaticOrder {
    int nM, nN, nwg, G, c;
    __host__ __device__ void init(int M, int N, int G_, int c_) { nM = M / BM; nN = N / BM; nwg = nM * nN; G = G_; c = c_; }
    __host__ __device__ bool next(int i, Unit& u) const {
        const long L = (long)i * G + c; if (L >= nwg) return false;
        int wgid = (int)L; { const int q = nwg / NXCD, r = nwg % NXCD, xcd = wgid % NXCD, off = wgid / NXCD; wgid = (xcd < r ? xcd * (q + 1) : r * (q + 1) + (xcd - r) * q) + off; }
        const int nig = WGM * nN, gid = wgid / nig, fm = gid * WGM, gsz = (nM - fm) < WGM ? (nM - fm) : WGM;
        u.pm = fm + ((wgid % nig) % gsz); u.pn = (wgid % nig) / gsz; return true;
    }
    __device__ __forceinline__ void a_ready(const Unit&) const {}
    __device__ __forceinline__ void done(const Unit&) const {}
};

__device__ __forceinline__ unsigned cvt_pk_bf16(float lo, float hi) { unsigned r; asm volatile("v_cvt_pk_bf16_f32 %0, %1, %2" : "=v"(r) : "v"(lo), "v"(hi)); return r; }
typedef float f32x2 __attribute__((ext_vector_type(2)));
__device__ __forceinline__ f32x2 gelu_pk(f32x2 v) {
    const f32x2 av = __builtin_elementwise_abs(v), d = av * 0.2316418882f + 1.0f;
    f32x2 t; t.x = __builtin_amdgcn_rcpf(d.x); t.y = __builtin_amdgcn_rcpf(d.y);
    f32x2 q = t * 0.5307027145f + (-0.7265760135f); q = q * t + 0.7107068705f; q = q * t + (-0.142248368f); q = q * t + 0.127414796f; q = q * t;
    const f32x2 s = (v * v) * (-0.72134752044f);
    f32x2 e; e.x = __builtin_amdgcn_exp2f(s.x); e.y = __builtin_amdgcn_exp2f(s.y);
    const f32x2 m = v * (q * e), r = v - m;
    f32x2 o; o.x = v.x < 0.f ? m.x : r.x; o.y = v.y < 0.f ? m.y : r.y; return o;
}

template <int ACT  > struct EpiBf16 {
    static constexpr bool PERM = true, AFTER_DRAIN = false; static_assert(ACT == 0 || ACT == 1, "EpiBf16: ACT is 0 (none) or 1 (gelu_pk)");
    bf16_t* O; int ldc; const float* bias; int split_cols; size_t split_stride; float scale0;
    __device__ __forceinline__ void operator()(const f32x4 (&acc)[2][2][4][2], const Unit& u, int wr, int wc, int fr, int fq) const {
        const int row0 = u.pm * BM + wr * 64 + fr; int colt = u.pn * BM; bf16_t* base = O;
        float sc = 1.f; if (split_cols) { const int t = colt / split_cols; base += (size_t)t * split_stride; colt -= t * split_cols; if (t == 0) sc = scale0; }
        const int col0 = colt + wc * 32 + 8 * fq, bcol0 = u.pn * BM + wc * 32 + 8 * fq;
        f32x4 bv[2][2];
#pragma unroll
        for (int bj = 0; bj < 2; ++bj)
#pragma unroll
            for (int n = 0; n < 2; ++n) bv[bj][n] = bias ? *(const f32x4*)(bias + bcol0 + bj * HALF + 4 * n) : (f32x4){0.f, 0.f, 0.f, 0.f};
#pragma unroll
        for (int ai = 0; ai < 2; ++ai)
#pragma unroll
            for (int m = 0; m < 4; ++m) { bf16_t* rowp = base + (size_t)(row0 + ai * HALF + m * 16) * ldc + col0;
#pragma unroll
                for (int bj = 0; bj < 2; ++bj) { f32x4 v0 = acc[ai][bj][m][0] + bv[bj][0], v1 = acc[ai][bj][m][1] + bv[bj][1];
                    if (ACT == 1) { f32x2 a = gelu_pk((f32x2){v0[0], v0[1]}), b = gelu_pk((f32x2){v0[2], v0[3]}), c = gelu_pk((f32x2){v1[0], v1[1]}), d = gelu_pk((f32x2){v1[2], v1[3]});
                        v0 = (f32x4){a.x, a.y, b.x, b.y}; v1 = (f32x4){c.x, c.y, d.x, d.y}; }
                    v0 = v0 * sc; v1 = v1 * sc; u32x4 w; w.x = cvt_pk_bf16(v0[0], v0[1]); w.y = cvt_pk_bf16(v0[2], v0[3]); w.z = cvt_pk_bf16(v1[0], v1[1]); w.w = cvt_pk_bf16(v1[2], v1[3]);
                    *(u32x4*)(rowp + bj * HALF) = w; } }
    }
};
template <class Epi, class Sched, bool ALIGN_EPI = false, bool SP2 = false>
__device__ __forceinline__ void gemm_phase(PG8_LAS unsigned char* lds, const Gemm g, const Sched& S, const Epi& E) {
    const int tid = threadIdx.x, wid = __builtin_amdgcn_readfirstlane(tid >> 6), lane = tid & 63, wr = wid >> 2, wc = wid & 3, fr = lane & 15, fq = lane >> 4;
    const int K = g.K, nt = K / BK;
    unsigned voffA[2], voffB[2];
#pragma unroll
    for (int i = 0; i < 2; ++i) { int R, C; stage_rc(tid * 16 + i * 8192, R, C); const int Rb = Epi::PERM ? ((R & ~31) + perm32(R & 31)) : R;
        voffA[i] = (unsigned)(R * K + C) * 2u; voffB[i] = (unsigned)(Rb * K + C) * 2u; }
    const size_t kstep = (size_t)(BK * 2);
    const size_t hstep = (size_t)HALF * K * 2;
    const size_t tstep = 2 * hstep;
    const unsigned ldsw = (unsigned)wid * 1024u;
    const int aoff = lds_byte(wr * 64 + fr, fq * 8), boff = lds_byte(wc * 32 + fr, fq * 8);
#define PG8_SA(b, h) (((b) * 2 + (h)) * HTB)
#define PG8_SB(b, h) ((4 + (b) * 2 + (h)) * HTB)
#define PG8_STAGE(bufoff, gbase, voff) do { _Pragma("unroll") for (int _i = 0; _i < 2; ++_i) \
        __builtin_amdgcn_global_load_lds((const unsigned*)((const char*)(gbase) + (voff)[_i]), (PG8_LAS unsigned*)(lds + (bufoff) + ldsw + _i * 8192), 16, 0, 0); } while (0)
#define PG8_LDA(dst, b, h) do { _Pragma("unroll") for (int m = 0; m < 4; ++m) _Pragma("unroll") for (int k = 0; k < 2; ++k) dst[m][k] = *(const PG8_LAS bf16x8*)(lds + PG8_SA(b, h) + aoff + m * 2048 + k * 1024); } while (0)
#define PG8_LDB(dst, b, h) do { _Pragma("unroll") for (int n = 0; n < 2; ++n) _Pragma("unroll") for (int k = 0; k < 2; ++k) dst[n][k] = *(const PG8_LAS bf16x8*)(lds + PG8_SB(b, h) + boff + n * 2048 + k * 1024); } while (0)
#define PG8_MMA(ai, bj, At, Bt) do { __builtin_amdgcn_s_setprio(1); _Pragma("unroll") for (int m = 0; m < 4; ++m) _Pragma("unroll") for (int n = 0; n < 2; ++n) _Pragma("unroll") for (int k = 0; k < 2; ++k) \
        acc[ai][bj][m][n] = __builtin_amdgcn_mfma_f32_16x16x32_bf16(Bt[n][k], At[m][k], acc[ai][bj][m][n], 0, 0, 0); __builtin_amdgcn_s_setprio(0); } while (0)
#define PG8_WAIT_V(n) asm volatile("s_waitcnt vmcnt(" #n ")" ::: "memory")
#define PG8_WAIT_L(n) asm volatile("s_waitcnt lgkmcnt(" #n ")" ::: "memory")
#define PG8_BAR __builtin_amdgcn_s_barrier()
#define PG8_SCHED __builtin_amdgcn_sched_barrier(0)
    Unit cur, nxt; int ui = 0;
    if (!S.next(0, cur)) return;
    f32x4 acc[2][2][4][2];
#pragma unroll
    for (int a = 0; a < 2; ++a)
#pragma unroll
        for (int b = 0; b < 2; ++b)
#pragma unroll
            for (int m = 0; m < 4; ++m)
#pragma unroll
                for (int n = 0; n < 2; ++n) acc[a][b][m][n] = (f32x4){0.f, 0.f, 0.f, 0.f};
    bf16x8 At[4][2], B0[2][2], B1[2][2];
    const char* cA = (const char*)g.A + (size_t)cur.pm * tstep; const char* cB = (const char*)g.Bt + (size_t)cur.pn * tstep;
    S.a_ready(cur);
    if constexpr (SP2) {
        PG8_STAGE(PG8_SB(0, 0), cB, voffB); PG8_STAGE(PG8_SB(0, 1), cB + hstep, voffB); PG8_STAGE(PG8_SA(0, 0), cA, voffA); PG8_STAGE(PG8_SA(0, 1), cA + hstep, voffA);
        if (wr == 1) PG8_BAR;
        PG8_WAIT_V(2); PG8_BAR;
        PG8_STAGE(PG8_SB(1, 0), cB + kstep, voffB); PG8_STAGE(PG8_SA(1, 0), cA + kstep, voffA); PG8_STAGE(PG8_SB(1, 1), cB + hstep + kstep, voffB);
        PG8_WAIT_V(6); PG8_BAR;
    } else {
        PG8_STAGE(PG8_SB(0, 0), cB, voffB); PG8_STAGE(PG8_SA(0, 0), cA, voffA); PG8_STAGE(PG8_SB(0, 1), cB + hstep, voffB); PG8_STAGE(PG8_SA(0, 1), cA + hstep, voffA);
        if (wr == 1) PG8_BAR;
        PG8_WAIT_V(4); PG8_BAR;
        PG8_STAGE(PG8_SB(1, 0), cB + kstep, voffB); PG8_STAGE(PG8_SA(1, 0), cA + kstep, voffA); PG8_STAGE(PG8_SB(1, 1), cB + hstep + kstep, voffB);
        PG8_WAIT_V(6); PG8_BAR;
    }
    for (;;) {
        const bool has_next = S.next(ui + 1, nxt);
        const char* nA = has_next ? (const char*)g.A + (size_t)nxt.pm * tstep : cA; const char* nB = has_next ? (const char*)g.Bt + (size_t)nxt.pn * tstep : cB;
        for (int t = 0; t < nt; t += 2) {
            const bool last = (t == nt - 2);
            const char* a1 = cA + (size_t)(t + 1) * kstep;
            const char* a2 = last ? nA : cA + (size_t)(t + 2) * kstep; const char* b2 = last ? nB : cB + (size_t)(t + 2) * kstep;
            const char* a3 = a2 + kstep; const char* b3 = b2 + kstep;
            if (last && has_next) S.a_ready(nxt);
            if constexpr (SP2) {
            PG8_LDB(B0, 0, 0); PG8_LDB(B1, 0, 1); PG8_SCHED; PG8_LDA(At, 0, 0); PG8_STAGE(PG8_SA(1, 1), a1 + hstep, voffA);
            PG8_WAIT_V(8); PG8_WAIT_L(0); PG8_BAR; PG8_MMA(0, 0, At, B0); PG8_MMA(0, 1, At, B1); PG8_BAR; PG8_SCHED;
            PG8_LDA(At, 0, 1); PG8_STAGE(PG8_SB(0, 0), b2, voffB); PG8_STAGE(PG8_SB(0, 1), b2 + hstep, voffB); PG8_STAGE(PG8_SA(0, 0), a2, voffA);
            PG8_WAIT_V(8); PG8_WAIT_L(0); PG8_BAR; PG8_MMA(1, 0, At, B0); PG8_MMA(1, 1, At, B1); PG8_BAR; PG8_SCHED;
            PG8_LDB(B0, 1, 0); PG8_LDB(B1, 1, 1); PG8_SCHED; PG8_LDA(At, 1, 0); PG8_STAGE(PG8_SA(0, 1), a2 + hstep, voffA);
            PG8_WAIT_V(8); PG8_WAIT_L(0); PG8_BAR; PG8_MMA(0, 0, At, B0); PG8_MMA(0, 1, At, B1); PG8_BAR; PG8_SCHED;
            PG8_LDA(At, 1, 1); PG8_STAGE(PG8_SB(1, 0), b3, voffB); PG8_STAGE(PG8_SB(1, 1), b3 + hstep, voffB); PG8_STAGE(PG8_SA(1, 0), a3, voffA);
            PG8_WAIT_V(8); PG8_WAIT_L(0); PG8_BAR; PG8_MMA(1, 0, At, B0); PG8_MMA(1, 1, At, B1); PG8_BAR; PG8_SCHED;
            } else {
            PG8_LDB(B0, 0, 0); PG8_SCHED; PG8_LDA(At, 0, 0); PG8_STAGE(PG8_SA(1, 1), a1 + hstep, voffA);
            PG8_WAIT_L(8); PG8_BAR; PG8_WAIT_L(0); PG8_MMA(0, 0, At, B0); PG8_BAR; PG8_SCHED;
            PG8_LDB(B1, 0, 1); PG8_STAGE(PG8_SB(0, 0), b2, voffB);
            PG8_BAR; PG8_WAIT_L(0); PG8_MMA(0, 1, At, B1); PG8_BAR;
            PG8_LDA(At, 0, 1); PG8_STAGE(PG8_SA(0, 0), a2, voffA);
            PG8_BAR; PG8_WAIT_L(0); PG8_MMA(1, 0, At, B0); PG8_BAR; PG8_SCHED;
            PG8_STAGE(PG8_SB(0, 1), b2 + hstep, voffB);
            PG8_WAIT_V(6); PG8_BAR; PG8_MMA(1, 1, At, B1); PG8_BAR;
            PG8_LDB(B0, 1, 0); PG8_SCHED; PG8_LDA(At, 1, 0); PG8_STAGE(PG8_SA(0, 1), a2 + hstep, voffA);
            PG8_WAIT_L(8); PG8_BAR; PG8_WAIT_L(0); PG8_MMA(0, 0, At, B0); PG8_BAR; PG8_SCHED;
            PG8_LDB(B1, 1, 1); PG8_STAGE(PG8_SB(1, 0), b3, voffB);
            PG8_BAR; PG8_WAIT_L(0); PG8_MMA(0, 1, At, B1); PG8_BAR;
            PG8_LDA(At, 1, 1); PG8_STAGE(PG8_SA(1, 0), a3, voffA);
            PG8_BAR; PG8_WAIT_L(0); PG8_MMA(1, 0, At, B0); PG8_BAR; PG8_SCHED;
            PG8_STAGE(PG8_SB(1, 1), b3 + hstep, voffB);
            PG8_WAIT_V(6); PG8_BAR; PG8_MMA(1, 1, At, B1); PG8_BAR;
            }
        }
        if constexpr (ALIGN_EPI) { if (wr == 0) PG8_BAR; }
        if constexpr (!Epi::AFTER_DRAIN) { E(acc, cur, wr, wc, fr, fq); S.done(cur); }
        if (!has_next) break;
#pragma unroll
        for (int a = 0; a < 2; ++a)
#pragma unroll
            for (int b = 0; b < 2; ++b)
#pragma unroll
                for (int m = 0; m < 4; ++m)
#pragma unroll
                    for (int n = 0; n < 2; ++n) acc[a][b][m][n] = (f32x4){0.f, 0.f, 0.f, 0.f};
        cur = nxt; cA = nA; cB = nB; ++ui;
        if constexpr (ALIGN_EPI) { if (wr == 1) PG8_BAR; }
    }
    PG8_WAIT_V(0);
    if constexpr (!ALIGN_EPI) { if (wr == 0) PG8_BAR; }
    PG8_BAR;
    if constexpr (Epi::AFTER_DRAIN) { E.fused(acc, cur, wr, wc, fr, fq, lds, wid, lane); S.done(cur); }
#undef PG8_SA
#undef PG8_SB
#undef PG8_STAGE
#undef PG8_LDA
#undef PG8_LDB
#undef PG8_MMA
#undef PG8_WAIT_V
#undef PG8_WAIT_L
#undef PG8_BAR
#undef PG8_SCHED
}
}

#ifndef PG8_SP2
#define PG8_SP2 true
#endif
#ifndef PG8_ALIGN
#define PG8_ALIGN true
#endif
#define GAS __attribute__((address_space(1)))
#define LAS __attribute__((address_space(3)))
typedef unsigned short bf16;
typedef unsigned v4u __attribute__((ext_vector_type(4)));
typedef float f32x4 __attribute__((ext_vector_type(4)));
typedef short bf16x8 __attribute__((ext_vector_type(8)));
typedef GAS unsigned gu32;
typedef GAS unsigned long long gu64;
#define RLX_AGENT __ATOMIC_RELAXED, __HIP_MEMORY_SCOPE_AGENT
#define LDS_WAIT() asm volatile("s_waitcnt lgkmcnt(0)" ::: "memory")
#define VM_WAIT() asm volatile("s_waitcnt vmcnt(0)" ::: "memory")
__device__ __forceinline__ unsigned long long rt() { return __builtin_amdgcn_s_memrealtime(); }
__device__ __forceinline__ unsigned f2bf(float f) { unsigned u = __builtin_bit_cast(unsigned, f); return (u + 0x7fffu + ((u >> 16) & 1u)) >> 16; }
__device__ __forceinline__ unsigned pk2(float lo, float hi) { return f2bf(lo) | (f2bf(hi) << 16); }

#define XB_TMO      128
#define XB_XCNT(j)  (256  + 64 * (j))
#define XB_XSUB(j)  (1280 + 64 * (j))
#define XB_XGEN(j)  (2304 + 64 * (j))
#define XB_TOP      3328
#define XB_TOPGEN   3392
#define XCD_BAR_WORDS 3456
#define XB_SPIN_CAP (1u << 18)

__device__ __forceinline__ unsigned xb_ld(unsigned* p)              { return __hip_atomic_load(p, __ATOMIC_RELAXED, __HIP_MEMORY_SCOPE_AGENT); }
__device__ __forceinline__ unsigned xb_add(unsigned* p, unsigned v) { return __hip_atomic_fetch_add(p, v, __ATOMIC_RELAXED, __HIP_MEMORY_SCOPE_AGENT); }
__device__ __forceinline__ unsigned xb_xcc_id() { return (unsigned)__builtin_amdgcn_s_getreg((3 << 11) | 20) & 0xFu; }
#define XB_SPIN(cond, bar) do { unsigned _sp = 0; while (cond) { __builtin_amdgcn_s_sleep(1); \
    if ((++_sp & 255u) == 0u) { if (xb_ld(&(bar)[XB_TMO])) break; if (_sp > XB_SPIN_CAP) { atomicAdd(&(bar)[XB_TMO], 1u); break; } } } } while (0)

struct XcdBarrier {
    unsigned* bar; unsigned x;
    volatile LAS unsigned* st;
};

__device__ __forceinline__ XcdBarrier xcd_barrier_post(unsigned* bar, volatile LAS unsigned* st) {
    XcdBarrier b; b.bar = bar; b.x = xb_xcc_id(); b.st = st;
    if (threadIdx.x == 0) (void)xb_add(&bar[XB_XCNT(b.x)], 1u);
    return b;
}
__device__ __forceinline__ void xcd_barrier_complete(unsigned* bar, unsigned x, unsigned& nloc, unsigned& nx) {
    const unsigned G = gridDim.x * gridDim.y * gridDim.z;
    unsigned sum, cnt, mine, sp = 0u;
    for (;;) {
        sum = 0u; cnt = 0u; mine = 0u;
#pragma unroll
        for (unsigned j = 0; j < 16; ++j) { const unsigned c = xb_ld(&bar[XB_XCNT(j)]); sum += c; cnt += (c > 0u) ? 1u : 0u; mine = (j == x) ? c : mine; }
        if (sum == G) break;
        __builtin_amdgcn_s_sleep(1);
        if ((++sp & 255u) == 0u) { if (xb_ld(&bar[XB_TMO])) break; if (sp > XB_SPIN_CAP) { atomicAdd(&bar[XB_TMO], 1u); break; } }
    }
    nloc = mine > 0u ? mine : 1u; nx = cnt > 0u ? cnt : 1u;
}

__device__ __forceinline__ void xcd_barrier(const XcdBarrier& b) {
    asm volatile("s_waitcnt vmcnt(0)" ::: "memory");
    __syncthreads();
    if (threadIdx.x == 0) {
        unsigned* bar = b.bar;
        __builtin_amdgcn_s_waitcnt(0);
        unsigned nloc = b.st[0], nx = b.st[1];
        if (nloc == 0u) { xcd_barrier_complete(bar, b.x, nloc, nx); b.st[0] = nloc; b.st[1] = nx; }
        const unsigned old = xb_add(&bar[XB_XSUB(b.x)], 1u);
        const unsigned gen = old / nloc;
        if (old + 1u == (gen + 1u) * nloc) {
            __builtin_amdgcn_fence(__ATOMIC_RELEASE, "agent");
            asm volatile("s_waitcnt vmcnt(0)" ::: "memory");
            const unsigned og = xb_add(&bar[XB_TOP], 1u);
            const unsigned tg = og / nx;
            if (og + 1u == (tg + 1u) * nx) xb_add(&bar[XB_TOPGEN], 1u);
            else XB_SPIN(xb_ld(&bar[XB_TOPGEN]) == tg, bar);
            __builtin_amdgcn_fence(__ATOMIC_ACQUIRE, "agent");
            xb_add(&bar[XB_XGEN(b.x)], 1u);
            asm volatile("s_waitcnt vmcnt(0)" ::: "memory");
        } else {
            XB_SPIN(xb_ld(&bar[XB_XGEN(b.x)]) == gen, bar);
            __builtin_amdgcn_fence(__ATOMIC_ACQUIRE, "agent");
            asm volatile("s_waitcnt vmcnt(0)" ::: "memory");
        }
    }
    __syncthreads();
}


constexpr int NWAVES = 8;
constexpr int DM = 2048, BATCH = 4, SEQ = 4096, M = BATCH * SEQ;
constexpr int NIN = 6176, NINP = 6400;
constexpr int O_GQ = 0, O_GK = 512, O_GV = 1024, O_GR = 2048, O_GDF = 3072, O_GDB = 3088, O_AQ = 3104, O_AK = 4128, O_AV = 5152;
constexpr float EPS = 1e-6f;
constexpr int PEER_K = 128;

constexpr size_t MiB = 1u << 20;
constexpr size_t WS_CTL = 0, CTL_ZERO_BYTES = 1 * MiB;
constexpr size_t WS_WIN = 1 * MiB;
constexpr size_t WS_WOUT = 26 * MiB;
constexpr size_t WS_WQ = 34 * MiB;
constexpr size_t WS_SSQ = 42 * MiB;
constexpr size_t WS_EIDX = 44 * MiB;
constexpr size_t WS_GATE = 52 * MiB;
constexpr size_t WS_XN = 64 * MiB;
constexpr size_t WS_PROJ = 128 * MiB;
constexpr size_t WS_HB = 256 * MiB;
constexpr size_t WS_OF = 328 * MiB;
constexpr size_t WS_OB = 392 * MiB;
constexpr size_t WS_ATT = 456 * MiB;
constexpr size_t WS_END = 488 * MiB;
constexpr int CW_TMO = 0, CW_CODE = 1, CW_BAR = 4096;

constexpr int RING_OFF = 0, RING_BYTES = 131072;
constexpr int LDSCTL_OFF = RING_BYTES, MISC_OFF = LDSCTL_OFF + 320;
constexpr int LDS_BYTES = 147456;

__device__ __forceinline__ float bf2f(unsigned short h) { return __builtin_bit_cast(float, (unsigned)h << 16); }
__device__ __forceinline__ float bflo(unsigned w) { return __builtin_bit_cast(float, w << 16); }
__device__ __forceinline__ float bfhi(unsigned w) { return __builtin_bit_cast(float, w & 0xffff0000u); }
__device__ __forceinline__ float wave_sum(float v) {
#pragma unroll
    for (int o = 1; o < 64; o <<= 1) v += __shfl_xor(v, o);
    return v;
}
__device__ __forceinline__ float wave_max(float v) {
#pragma unroll
    for (int o = 1; o < 64; o <<= 1) v = fmaxf(v, __shfl_xor(v, o));
    return v;
}

namespace pg8 {
struct EpiRes {
    static constexpr bool PERM = false, AFTER_DRAIN = false;
    const float* x; float* H; bf16_t* HB; float* ssq; int ldc;
    __device__ __forceinline__ void operator()(const f32x4 (&acc)[2][2][4][2], const Unit& u, int wr, int wc, int fr, int fq) const {
        const int col0 = u.pn * BM + wc * 32 + 4 * fq;
#pragma unroll
        for (int ai = 0; ai < 2; ++ai)
#pragma unroll
            for (int m = 0; m < 4; ++m) {
                const int r = u.pm * BM + ai * HALF + wr * 64 + m * 16 + fr; const size_t off = (size_t)r * ldc + col0; float s = 0.f;
#pragma unroll
                for (int bj = 0; bj < 2; ++bj)
#pragma unroll
                    for (int n = 0; n < 2; ++n) {
                        const f32x4 xv = *(const f32x4*)(x + off + bj * HALF + n * 16);
                        const f32x4 hv = xv + acc[ai][bj][m][n];
                        *(f32x4*)(H + off + bj * HALF + n * 16) = hv;
                        s += (hv[0] * hv[0] + hv[1] * hv[1]) + (hv[2] * hv[2] + hv[3] * hv[3]);
                        unsigned long long w = (unsigned long long)cvt_pk_bf16(hv[0], hv[1]) | ((unsigned long long)cvt_pk_bf16(hv[2], hv[3]) << 32);
                        *(unsigned long long*)(HB + off + bj * HALF + n * 16) = w;
                    }
                s += __shfl_xor(s, 16); s += __shfl_xor(s, 32);
                if (fq == 0) ssq[(size_t)r * 32 + u.pn * 4 + wc] = s;
            }
    }
};
struct EpiRowScale {
    static constexpr bool PERM = true, AFTER_DRAIN = false;
    bf16_t* O; int ldc; const float* ssq; float inv_n, eps;
    __device__ __forceinline__ void operator()(const f32x4 (&acc)[2][2][4][2], const Unit& u, int wr, int wc, int fr, int fq) const {
        const int col0 = u.pn * BM + wc * 32 + 8 * fq;
#pragma unroll
        for (int ai = 0; ai < 2; ++ai)
#pragma unroll
            for (int m = 0; m < 4; ++m) {
                const int r = u.pm * BM + ai * HALF + wr * 64 + m * 16 + fr;
                const f32x4* sp = (const f32x4*)(ssq + (size_t)r * 32); float s = 0.f;
#pragma unroll
                for (int i = 0; i < 8; ++i) { const f32x4 t = sp[i]; s += (t[0] + t[1]) + (t[2] + t[3]); }
                const float sc = 1.0f / sqrtf(s * inv_n + eps);
                bf16_t* rowp = O + (size_t)r * ldc + col0;
#pragma unroll
                for (int bj = 0; bj < 2; ++bj) { const f32x4 v0 = acc[ai][bj][m][0] * sc, v1 = acc[ai][bj][m][1] * sc;
                    u32x4 w; w.x = cvt_pk_bf16(v0[0], v0[1]); w.y = cvt_pk_bf16(v0[2], v0[3]); w.z = cvt_pk_bf16(v1[0], v1[1]); w.w = cvt_pk_bf16(v1[2], v1[3]);
                    *(u32x4*)(rowp + bj * HALF) = w; }
            }
    }
};
}

struct Frame {
    LAS unsigned char* lds;
    volatile LAS unsigned* MISC;
    gu32* ctl;
    int tid, lane, wave;
    int vcu, G;
};

__device__ __forceinline__ void p0_transpose_item(const float* W, int K, int ldw, const float* gk, bf16* WT, LAS float* scr, int item, int lane) {
    const int nblk = ldw / 32, kb = item / nblk, nb = item % nblk, k0 = 64 * kb, n0 = 32 * nb;
#pragma unroll 8
    for (int i = 0; i < 32; ++i) { const int kk = 2 * i + (lane >> 5); float w = W[(size_t)(k0 + kk) * ldw + n0 + (lane & 31)]; if (gk) w *= gk[k0 + kk]; scr[kk * 33 + (lane & 31)] = w; }
    LDS_WAIT(); asm volatile("" ::: "memory");
    const int c = lane & 7;
#pragma unroll
    for (int j = 0; j < 4; ++j) { const int n = (lane >> 3) + 8 * j; const LAS float* s = scr + (8 * c) * 33 + n;
        v4u o; o.x = pk2(s[0 * 33], s[1 * 33]); o.y = pk2(s[2 * 33], s[3 * 33]); o.z = pk2(s[4 * 33], s[5 * 33]); o.w = pk2(s[6 * 33], s[7 * 33]);
        *(GAS v4u*)(WT + (size_t)(n0 + n) * K + k0 + 8 * c) = o; }
    LDS_WAIT(); asm volatile("" ::: "memory");
}
__device__ __forceinline__ void rms_row_to_bf16(int lane, const float* xrow, const float* g, bf16* orow) {
    const GAS f32x4* xr = (const GAS f32x4*)xrow + lane; const GAS f32x4* gr = (const GAS f32x4*)g + lane;
    f32x4 v[8]; float s = 0.f;
#pragma unroll
    for (int j = 0; j < 8; ++j) { v[j] = xr[64 * j]; s += (v[j].x * v[j].x + v[j].y * v[j].y) + (v[j].z * v[j].z + v[j].w * v[j].w); }
    const float rstd = 1.f / sqrtf(wave_sum(s) * (1.f / DM) + EPS);
    GAS unsigned long long* o8 = (GAS unsigned long long*)orow + lane;
#pragma unroll
    for (int j = 0; j < 8; ++j) { const f32x4 gg = gr[64 * j];
        o8[64 * j] = (unsigned long long)pk2(v[j].x * rstd * gg.x, v[j].y * rstd * gg.y) | ((unsigned long long)pk2(v[j].z * rstd * gg.z, v[j].w * rstd * gg.w) << 32); }
}

struct Args {
    const float* in[16]; float* out; unsigned char* ws; int ph_lo, ph_hi, li, pad;
};

__device__ __forceinline__ void p0_prologue(Frame& F, const Args& a) {
    unsigned char* ws = a.ws;
    LAS float* scr = (LAS float*)(F.lds + RING_OFF + F.wave * 16384);
    const int gw = F.vcu * NWAVES + F.wave, NGW = F.G * NWAVES;
    bf16* Win_t = (bf16*)(ws + WS_WIN); bf16* Wout_t = (bf16*)(ws + WS_WOUT); bf16* Wq_t = (bf16*)(ws + WS_WQ); bf16* XN = (bf16*)(ws + WS_XN);
    constexpr int I_IN = (DM / 64) * (NIN / 32), I_SQ = (DM / 64) * (DM / 32);
    constexpr int NITEMS = I_IN + 2 * I_SQ;
    for (int it = gw; it < NITEMS; it += NGW) {
        int r = it;
        if (r < I_IN) { p0_transpose_item(a.in[2], DM, NIN, nullptr, Win_t, scr, r, F.lane); continue; } r -= I_IN;
        if (r < I_SQ) { p0_transpose_item(a.in[9], DM, DM, nullptr, Wout_t, scr, r, F.lane); continue; } r -= I_SQ;
        p0_transpose_item(a.in[11], DM, DM, a.in[10], Wq_t, scr, r, F.lane);
    }
    { GAS v4u* z = (GAS v4u*)(Win_t + (size_t)NIN * DM); const int n16 = (NINP - NIN) * DM * 2 / 16;
      for (int i = (gw * 64 + F.lane); i < n16; i += NGW * 64) z[i] = (v4u){0u, 0u, 0u, 0u}; }
    for (int m = gw; m < M; m += NGW) rms_row_to_bf16(F.lane, a.in[0] + (size_t)m * DM, a.in[1], XN + (size_t)m * DM);
}

__device__ __forceinline__ void p3_finalize(Frame& F, const Args& a) {
    unsigned char* ws = a.ws;
    const int gw = F.vcu * NWAVES + F.wave, NGW = F.G * NWAVES, lane = F.lane;
    const float* OFp = (const float*)(ws + WS_OF); const float* OBp = (const float*)(ws + WS_OB);
    const bf16* ATT = (const bf16*)(ws + WS_ATT); const bf16* PROJ = (const bf16*)(ws + WS_PROJ); bf16* Y = (bf16*)(ws + WS_XN);
    const float* gla_g = a.in[7]; const float* att_g = a.in[8];
    const f32x4 gg = *(const f32x4*)(gla_g + 4 * lane);
    for (int m = gw; m < M; m += NGW) {
#pragma unroll
        for (int hh = 0; hh < 4; ++hh) {
            const f32x4 of = *(const f32x4*)(OFp + (size_t)m * 1024 + hh * 256 + 4 * lane);
            const f32x4 ob = *(const f32x4*)(OBp + (size_t)m * 1024 + hh * 256 + 4 * lane);
            const f32x4 o = of + ob;
            const float ss = wave_sum((o.x * o.x + o.y * o.y) + (o.z * o.z + o.w * o.w));
            const float rstd = 1.f / sqrtf(ss * (1.f / 256.f) + EPS);
            const unsigned long long gr = *(const unsigned long long*)(PROJ + (size_t)m * NINP + O_GR + hh * 256 + 4 * lane);
            const float r0 = bflo((unsigned)gr), r1 = bfhi((unsigned)gr), r2 = bflo((unsigned)(gr >> 32)), r3 = bfhi((unsigned)(gr >> 32));
            const float y0 = o.x * rstd * gg.x * (r0 / (1.f + __expf(-r0))), y1 = o.y * rstd * gg.y * (r1 / (1.f + __expf(-r1)));
            const float y2 = o.z * rstd * gg.z * (r2 / (1.f + __expf(-r2))), y3 = o.w * rstd * gg.w * (r3 / (1.f + __expf(-r3)));
            *(unsigned long long*)(Y + (size_t)m * DM + hh * 256 + 4 * lane) = (unsigned long long)pk2(y0, y1) | ((unsigned long long)pk2(y2, y3) << 32);
        }
        float av[16]; float ss = 0.f;
#pragma unroll
        for (int p = 0; p < 2; ++p) { const v4u w = *(const v4u*)(ATT + (size_t)m * 1024 + p * 512 + 8 * lane);
            av[p * 8 + 0] = bflo(w.x); av[p * 8 + 1] = bfhi(w.x); av[p * 8 + 2] = bflo(w.y); av[p * 8 + 3] = bfhi(w.y);
            av[p * 8 + 4] = bflo(w.z); av[p * 8 + 5] = bfhi(w.z); av[p * 8 + 6] = bflo(w.w); av[p * 8 + 7] = bfhi(w.w); }
#pragma unroll
        for (int i = 0; i < 16; ++i) ss += av[i] * av[i];
        const float rstd = 1.f / sqrtf(wave_sum(ss) * (1.f / 1024.f) + EPS);
#pragma unroll
        for (int p = 0; p < 2; ++p) { const f32x4 g0 = *(const f32x4*)(att_g + p * 512 + 8 * lane), g1 = *(const f32x4*)(att_g + p * 512 + 8 * lane + 4);
            v4u w; w.x = pk2(av[p * 8 + 0] * rstd * g0.x, av[p * 8 + 1] * rstd * g0.y); w.y = pk2(av[p * 8 + 2] * rstd * g0.z, av[p * 8 + 3] * rstd * g0.w);
            w.z = pk2(av[p * 8 + 4] * rstd * g1.x, av[p * 8 + 5] * rstd * g1.y); w.w = pk2(av[p * 8 + 6] * rstd * g1.z, av[p * 8 + 7] * rstd * g1.w);
            *(v4u*)(Y + (size_t)m * DM + 1024 + p * 512 + 8 * lane) = w; }
    }
}

__global__ void __launch_bounds__(NWAVES * 64, 2) mk_fwd(Args args) {
    extern __shared__ __attribute__((aligned(16))) unsigned char lds[];
    Frame F;
    F.lds = (LAS unsigned char*)lds;
    F.MISC = (volatile LAS unsigned*)(F.lds + MISC_OFF);
    F.tid = threadIdx.x; F.lane = F.tid & 63; F.wave = __builtin_amdgcn_readfirstlane(F.tid >> 6);
    F.G = gridDim.x; { const int bx = blockIdx.x; F.vcu = (F.G % 8 == 0) ? (bx % 8) * (F.G / 8) + bx / 8 : bx; }
    unsigned char* ws = args.ws;
    F.ctl = (gu32*)(ws + WS_CTL);
    for (int u = F.tid; u < (LDS_BYTES - LDSCTL_OFF) / 4; u += NWAVES * 64) ((LAS unsigned*)(F.lds + LDSCTL_OFF))[u] = 0u;
    __syncthreads();
    XcdBarrier bar = xcd_barrier_post((unsigned*)(F.ctl + CW_BAR) + args.li * XCD_BAR_WORDS, F.MISC + 8);
    const int lo = args.ph_lo, hi = args.ph_hi;
#define IN(k) (lo <= (k) && (k) < hi)
#define BOTH(k) (IN(k) && IN((k) + 1))
#define GRID_BAR() xcd_barrier(bar)

    if (IN(0)) { p0_prologue(F, args); if (BOTH(0)) GRID_BAR(); }

    if (IN(1)) {
        pg8::Gemm g{(const bf16*)(ws + WS_XN), (const bf16*)(ws + WS_WIN), M, NINP, DM}; pg8::StaticOrder S; S.init(M, NINP, F.G, (int)blockIdx.x);
        pg8::EpiBf16<0> E{(bf16*)(ws + WS_PROJ), NINP, nullptr, 0, 0, 1.f};
        pg8::gemm_phase<pg8::EpiBf16<0>, pg8::StaticOrder, PG8_ALIGN, PG8_SP2>(F.lds + RING_OFF, g, S, E);
        if (BOTH(1)) GRID_BAR();
    }
    if (IN(2)) { if (BOTH(2)) GRID_BAR(); }
    if (IN(3)) { p3_finalize(F, args); if (BOTH(3)) GRID_BAR(); }
    if (IN(4)) {
        pg8::Gemm g{(const bf16*)(ws + WS_XN), (const bf16*)(ws + WS_WOUT), M, DM, DM}; pg8::StaticOrder S; S.init(M, DM, F.G, (int)blockIdx.x);
        pg8::EpiRes E{args.in[0], args.out, (bf16*)(ws + WS_HB), (float*)(ws + WS_SSQ), DM};
        pg8::gemm_phase<pg8::EpiRes, pg8::StaticOrder, PG8_ALIGN, PG8_SP2>(F.lds + RING_OFF, g, S, E);
        if (BOTH(4)) GRID_BAR();
    }
    if (IN(5)) {
        pg8::Gemm g{(const bf16*)(ws + WS_HB), (const bf16*)(ws + WS_WQ), M, DM, DM}; pg8::StaticOrder S; S.init(M, DM, F.G, (int)blockIdx.x);
        pg8::EpiRowScale E{(bf16*)(ws + WS_XN), DM, (const float*)(ws + WS_SSQ), 1.f / DM, EPS};
        pg8::gemm_phase<pg8::EpiRowScale, pg8::StaticOrder, PG8_ALIGN, PG8_SP2>(F.lds + RING_OFF, g, S, E);
        if (BOTH(5)) GRID_BAR();
    }
#undef IN
#undef BOTH
}

__global__ void __launch_bounds__(256) naive_gla(const bf16* PROJ, const float* up_f, const float* bias_f, const float* up_b, const float* bias_b, float* OFp, float* OBp) {
    const int tid = threadIdx.x, e = tid & 15, dg = tid >> 4, d0 = dg * 8;
    const int e0 = blockIdx.x * 16, h = blockIdx.y & 3, b = blockIdx.y >> 2, dir = blockIdx.z;
    const float* up = dir ? up_b : up_f; const float* bias = dir ? bias_b : bias_f; float* Out = dir ? OBp : OFp;
    __shared__ float qs[16][128], ks[16][128], as_[16][128], gds[16][16], vs[16][16], psum[16][4][16];
    float S[8];
#pragma unroll
    for (int j = 0; j < 8; ++j) S[j] = 0.f;
    for (int t0 = 0; t0 < SEQ; t0 += 16) {
        for (int idx = tid; idx < 16 * 128; idx += 256) { const int i = idx >> 7, d = idx & 127; const int t = dir ? (SEQ - 1 - (t0 + i)) : (t0 + i); const size_t row = (size_t)b * SEQ + t;
            qs[i][d] = bf2f(PROJ[row * NINP + O_GQ + h * 128 + d]) * 0.08838834764831845f; ks[i][d] = bf2f(PROJ[row * NINP + O_GK + h * 128 + d]); }
        { const int i = tid >> 4, r = tid & 15; const int t = dir ? (SEQ - 1 - (t0 + i)) : (t0 + i); const size_t row = (size_t)b * SEQ + t;
          gds[i][r] = bf2f(PROJ[row * NINP + O_GDF + dir * 16 + r]); vs[i][r] = bf2f(PROJ[row * NINP + O_GV + h * 256 + e0 + r]); }
        __syncthreads();
        for (int idx = tid; idx < 16 * 128; idx += 256) { const int i = idx >> 7, d = idx & 127; float z = bias[h * 128 + d];
#pragma unroll
            for (int r = 0; r < 16; ++r) z += gds[i][r] * up[r * 512 + h * 128 + d];
            const float ls = fminf(z, 0.f) - log1pf(expf(-fabsf(z))); as_[i][d] = expf(ls * (1.f / 16.f)); }
        __syncthreads();
        for (int i = 0; i < 16; ++i) { const float v = vs[i][e]; float p = 0.f;
#pragma unroll
            for (int j = 0; j < 8; ++j) { S[j] = as_[i][d0 + j] * S[j] + ks[i][d0 + j] * v; p += qs[i][d0 + j] * S[j]; }
            p += __shfl_xor(p, 16); p += __shfl_xor(p, 32);
            if ((tid & 63) < 16) psum[i][tid >> 6][e] = p; }
        __syncthreads();
        { const int i = tid >> 4, ee = tid & 15; const int t = dir ? (SEQ - 1 - (t0 + i)) : (t0 + i); const size_t row = (size_t)b * SEQ + t;
          Out[row * 1024 + h * 256 + e0 + ee] = (psum[i][0][ee] + psum[i][1][ee]) + (psum[i][2][ee] + psum[i][3][ee]); }
    }
}

__global__ void __launch_bounds__(256) naive_attn(const bf16* PROJ, bf16* ATT) {
    const int gid = blockIdx.x * 256 + threadIdx.x; const int h = gid & 15, row = gid >> 4, b = row >> 12, t = row & (SEQ - 1);
    float q[64], o[64];
    const bf16* qp = PROJ + (size_t)row * NINP + O_AQ + h * 64;
#pragma unroll
    for (int i = 0; i < 64; ++i) { q[i] = bf2f(qp[i]) * 0.125f; o[i] = 0.f; }
    const float slope = exp2f(-0.5f * (float)(h + 1));
    float m = -1e30f, l = 0.f;
    for (int p = 0; p < 3; ++p) { const int dil = (p == 0) ? 1 : (p == 1 ? 4 : 16);
        for (int j = -64; j <= 64; ++j) { const int tk = t + j * dil; if (tk < 0 || tk >= SEQ) continue;
            const bf16* kp = PROJ + ((size_t)b * SEQ + tk) * NINP + O_AK + h * 64; const bf16* vp = kp + (O_AV - O_AK);
            float s = 0.f;
#pragma unroll
            for (int i = 0; i < 64; ++i) s += q[i] * bf2f(kp[i]);
            s -= slope * (float)((j < 0 ? -j : j) * dil);
            const float mn = fmaxf(m, s), sc = __expf(m - mn), pe = __expf(s - mn); l = l * sc + pe; m = mn;
#pragma unroll
            for (int i = 0; i < 64; ++i) o[i] = o[i] * sc + pe * bf2f(vp[i]); } }
    const float il = 1.f / l; bf16* op = ATT + (size_t)row * 1024 + h * 64;
#pragma unroll
    for (int i = 0; i < 64; ++i) op[i] = (bf16)f2bf(o[i] * il);
}

__device__ __forceinline__ void wave_argmax(float& v, int& idx) {
#pragma unroll
    for (int o = 1; o < 64; o <<= 1) { const float ov = __shfl_xor(v, o); const int oi = __shfl_xor(idx, o); if (ov > v || (ov == v && oi < idx)) { v = ov; idx = oi; } }
}
__global__ void __launch_bounds__(256) naive_topk(const bf16* QP, const float* subk, int* EIDX, float* GATE) {
    __shared__ float qsh[4][256];
    const int tid = threadIdx.x, lane = tid & 63, wv = tid >> 6; const int gwv = blockIdx.x * 4 + wv; const int h = gwv & 7, row = gwv >> 3;
    const bf16* qp = QP + (size_t)row * DM + h * 256;
#pragma unroll
    for (int i = 0; i < 4; ++i) qsh[wv][lane + 64 * i] = bf2f(qp[lane + 64 * i]);
    __syncthreads();
    float tv[2]; int ti[2];
#pragma unroll
    for (int c = 0; c < 2; ++c) {
        const float* k0 = subk + (((size_t)h * 2 + c) * 128 + lane) * 128; const float* k1 = k0 + 64 * 128;
        float a = 0.f, bsc = 0.f;
        for (int d = 0; d < 128; d += 4) { const f32x4 x0 = *(const f32x4*)(k0 + d), x1 = *(const f32x4*)(k1 + d); const float q0 = qsh[wv][c * 128 + d], q1 = qsh[wv][c * 128 + d + 1], q2 = qsh[wv][c * 128 + d + 2], q3 = qsh[wv][c * 128 + d + 3];
            a += q0 * x0.x + q1 * x0.y + q2 * x0.z + q3 * x0.w; bsc += q0 * x1.x + q1 * x1.y + q2 * x1.z + q3 * x1.w; }
        float keepv = -3e38f; int keepi = 0;
        for (int r = 0; r < 16; ++r) { float v; int idx; if (a >= bsc) { v = a; idx = lane; } else { v = bsc; idx = lane + 64; }
            wave_argmax(v, idx);
            if (idx == lane) a = -3e38f; if (idx == lane + 64) bsc = -3e38f;
            if (lane == r) { keepv = v; keepi = idx; } }
        tv[c] = keepv; ti[c] = keepi;
    }
    float cv[4];
#pragma unroll
    for (int u = 0; u < 4; ++u) { const int id = lane * 4 + u; cv[u] = __shfl(tv[0], id >> 4) + __shfl(tv[1], id & 15); }
    float topv = -3e38f; int topid = 0;
    for (int r = 0; r < 16; ++r) { float v = cv[0]; int idx = lane * 4;
#pragma unroll
        for (int u = 1; u < 4; ++u) if (cv[u] > v) { v = cv[u]; idx = lane * 4 + u; }
        wave_argmax(v, idx);
        if ((idx >> 2) == lane) {
#pragma unroll
            for (int u = 0; u < 4; ++u) if ((idx & 3) == u) cv[u] = -3e38f; }
        if (lane == r) { topv = v; topid = idx; } }
    const int i1 = __shfl(ti[0], topid >> 4), i2 = __shfl(ti[1], topid & 15);
    const float vm = (lane < 16) ? topv : -3e38f; const float mx = wave_max(vm);
    const float ex = (lane < 16) ? __expf(topv - mx) : 0.f; const float sm = wave_sum(ex);
    if (lane < 16) { EIDX[(size_t)row * 128 + h * 16 + lane] = i1 * 128 + i2; GATE[(size_t)row * 128 + h * 16 + lane] = ex / sm; }
}

__global__ void __launch_bounds__(256) naive_peer(float* H  , const float* g2, const float* U, const float* V, const int* EIDX, const float* GATE, const float* gf) {
    const int tid = threadIdx.x, lane = tid & 63; const int row = blockIdx.x * 4 + (tid >> 6);
    float* hrow = H + (size_t)row * DM;
    f32x4 hv[8], xn[8], acc[8]; float ss = 0.f;
#pragma unroll
    for (int j = 0; j < 8; ++j) { hv[j] = *(const f32x4*)(hrow + 256 * j + 4 * lane); ss += (hv[j].x * hv[j].x + hv[j].y * hv[j].y) + (hv[j].z * hv[j].z + hv[j].w * hv[j].w); acc[j] = (f32x4){0.f, 0.f, 0.f, 0.f}; }
    const float rstd = 1.f / sqrtf(wave_sum(ss) * (1.f / DM) + EPS);
#pragma unroll
    for (int j = 0; j < 8; ++j) { const f32x4 g = *(const f32x4*)(g2 + 256 * j + 4 * lane); xn[j] = hv[j] * rstd * g; }
    for (int p = 0; p < PEER_K; ++p) { const int e = EIDX[(size_t)row * 128 + p]; const float gt = GATE[(size_t)row * 128 + p];
        const float* ur = U + (size_t)e * DM; const float* vr = V + (size_t)e * DM; float d = 0.f;
#pragma unroll
        for (int j = 0; j < 8; ++j) { const f32x4 u = *(const f32x4*)(ur + 256 * j + 4 * lane); d += (xn[j].x * u.x + xn[j].y * u.y) + (xn[j].z * u.z + xn[j].w * u.w); }
        d = wave_sum(d);
        const float w = gt * 0.5f * d * (1.f + erff(d * 0.70710678118654752f));
#pragma unroll
        for (int j = 0; j < 8; ++j) { const f32x4 v = *(const f32x4*)(vr + 256 * j + 4 * lane); acc[j] += v * w; } }
    float s2 = 0.f;
#pragma unroll
    for (int j = 0; j < 8; ++j) { acc[j] += hv[j]; s2 += (acc[j].x * acc[j].x + acc[j].y * acc[j].y) + (acc[j].z * acc[j].z + acc[j].w * acc[j].w); }
    const float rf = 1.f / sqrtf(wave_sum(s2) * (1.f / DM) + EPS);
#pragma unroll
    for (int j = 0; j < 8; ++j) { const f32x4 g = *(const f32x4*)(gf + 256 * j + 4 * lane); *(f32x4*)(hrow + 256 * j + 4 * lane) = acc[j] * rf * g; }
}

extern "C" void kernel_launch(void* const* d_in, const int* in_sizes, int n_in, void* d_out, int out_size, void* d_ws, size_t ws_size, hipStream_t stream) {
    static int grid = 0;
    if (grid == 0) {
        if (n_in != 16 || in_sizes[0] != M * DM || out_size != M * DM || ws_size < WS_END) { fprintf(stderr, "kernel_launch: unexpected shapes: n_in %d in0 %d out %d ws %zu\n", n_in, n_in > 0 ? in_sizes[0] : -1, out_size, ws_size); grid = -1; return; }
        int dev = 0, cus = 0;
        if (hipGetDevice(&dev) != hipSuccess || hipDeviceGetAttribute(&cus, hipDeviceAttributeMultiprocessorCount, dev) != hipSuccess) { grid = -1; return; }
        if (hipFuncSetAttribute((const void*)mk_fwd, hipFuncAttributeMaxDynamicSharedMemorySize, LDS_BYTES) != hipSuccess) { fprintf(stderr, "kernel_launch: hipFuncSetAttribute failed\n"); grid = -1; return; }
        (void)hipGetLastError();
        grid = cus;
    }
    if (grid < 0) return;
    (void)hipMemsetAsync((char*)d_ws + WS_CTL, 0, CTL_ZERO_BYTES, stream);
    Args a{};
    for (int i = 0; i < 16; ++i) a.in[i] = (const float*)d_in[i];
    a.out = (float*)d_out; a.ws = (unsigned char*)d_ws;
    unsigned char* ws = (unsigned char*)d_ws;
    auto launch = [&](int lo, int hi, int li) { a.ph_lo = lo; a.ph_hi = hi; a.li = li; hipLaunchKernelGGL(mk_fwd, dim3(grid), dim3(NWAVES * 64), LDS_BYTES, stream, a); };
    launch(0, 2, 0);
    naive_gla<<<dim3(16, 16, 2), 256, 0, stream>>>((const bf16*)(ws + WS_PROJ), a.in[3], a.in[4], a.in[5], a.in[6], (float*)(ws + WS_OF), (float*)(ws + WS_OB));
    naive_attn<<<dim3(M * 16 / 256), 256, 0, stream>>>((const bf16*)(ws + WS_PROJ), (bf16*)(ws + WS_ATT));
    launch(3, 6, 1);
    naive_topk<<<dim3(M * 8 / 4), 256, 0, stream>>>((const bf16*)(ws + WS_XN), a.in[12], (int*)(ws + WS_EIDX), (float*)(ws + WS_GATE));
    naive_peer<<<dim3(M / 4), 256, 0, stream>>>((float*)d_out, a.in[10], a.in[13], a.in[14], (const int*)(ws + WS_EIDX), (const float*)(ws + WS_GATE), a.in[15]);
}
```

```cpp
#include <hip/hip_runtime.h>
#include <cstdio>
#include <cstdint>
#include <cmath>
namespace pg8 {
#define PG8_LAS __attribute__((address_space(3)))
typedef unsigned short bf16_t;
typedef short bf16x8 __attribute__((ext_vector_type(8)));
typedef float f32x4 __attribute__((ext_vector_type(4)));
typedef unsigned u32x4 __attribute__((ext_vector_type(4)));
constexpr int BM = 256, BK = 64, HALF = 128, HTB = HALF * BK * 2  , STAGE_BYTES = 8 * HTB, NXCD = 8, WGM = 8;

__host__ __device__ __forceinline__ int lds_byte(int r, int c) { const int st = (r >> 4) * 2 + (c >> 5), rr = r & 15, cc = c & 31, ob = rr * 64 + cc * 2; return st * 1024 + (ob ^ (((ob >> 9) & 1) << 5)); }
__host__ __device__ __forceinline__ void stage_rc(int b, int& R, int& C) { const int st = b / 1024, sb = b % 1024, swz = sb ^ (((sb >> 9) & 1) << 5); R = (st >> 1) * 16 + swz / 64; C = (st & 1) * 32 + (swz % 64) / 2; }
__host__ __device__ __forceinline__ int perm32(int rho) { const int n = rho >> 4, i = rho & 15; return 8 * (i >> 2) + 4 * n + (i & 3); }

struct Unit { int pm, pn; };
struct Gemm { const bf16_t* A; const bf16_t* Bt; int M, N, K; };

struct StaticOrder {
    int nM, nN, nwg, G, c;
    __host__ __device__ void init(int M, int N, int G_, int c_) { nM = M / BM; nN = N / BM; nwg = nM * nN; G = G_; c = c_; }
    __host__ __device__ bool next(int i, Unit& u) const {
        const long L = (long)i * G + c; if (L >= nwg) return false;
        int wgid = (int)L; { const int q = nwg / NXCD, r = nwg % NXCD, xcd = wgid % NXCD, off = wgid / NXCD; wgid = (xcd < r ? xcd * (q + 1) : r * (q + 1) + (xcd - r) * q) + off; }
        const int nig = WGM * nN, gid = wgid / nig, fm = gid * WGM, gsz = (nM - fm) < WGM ? (nM - fm) : WGM;
        u.pm = fm + ((wgid % nig) % gsz); u.pn = (wgid % nig) / gsz; return true;
    }
    __device__ __forceinline__ void a_ready(const Unit&) const {}
    __device__ __forceinline__ void done(const Unit&) const {}
};

__device__ __forceinline__ unsigned cvt_pk_bf16(float lo, float hi) { unsigned r; asm volatile("v_cvt_pk_bf16_f32 %0, %1, %2" : "=v"(r) : "v"(lo), "v"(hi)); return r; }
typedef float f32x2 __attribute__((ext_vector_type(2)));
__device__ __forceinline__ f32x2 gelu_pk(f32x2 v) {
    const f32x2 av = __builtin_elementwise_abs(v), d = av * 0.2316418882f + 1.0f;
    f32x2 t; t.x = __builtin_amdgcn_rcpf(d.x); t.y = __builtin_amdgcn_rcpf(d.y);
    f32x2 q = t * 0.5307027145f + (-0.7265760135f); q = q * t + 0.7107068705f; q = q * t + (-0.142248368f); q = q * t + 0.127414796f; q = q * t;
    const f32x2 s = (v * v) * (-0.72134752044f);
    f32x2 e; e.x = __builtin_amdgcn_exp2f(s.x); e.y = __builtin_amdgcn_exp2f(s.y);
    const f32x2 m = v * (q * e), r = v - m;
    f32x2 o; o.x = v.x < 0.f ? m.x : r.x; o.y = v.y < 0.f ? m.y : r.y; return o;
}

template <int ACT  > struct EpiBf16 {
    static constexpr bool PERM = true, AFTER_DRAIN = false; static_assert(ACT == 0 || ACT == 1, "EpiBf16: ACT is 0 (none) or 1 (gelu_pk)");
    bf16_t* O; int ldc; const float* bias; int split_cols; size_t split_stride; float scale0;
    __device__ __forceinline__ void operator()(const f32x4 (&acc)[2][2][4][2], const Unit& u, int wr, int wc, int fr, int fq) const {
        const int row0 = u.pm * BM + wr * 64 + fr; int colt = u.pn * BM; bf16_t* base = O;
        float sc = 1.f; if (split_cols) { const int t = colt / split_cols; base += (size_t)t * split_stride; colt -= t * split_cols; if (t == 0) sc = scale0; }
        const int col0 = colt + wc * 32 + 8 * fq, bcol0 = u.pn * BM + wc * 32 + 8 * fq;
        f32x4 bv[2][2];
#pragma unroll
        for (int bj = 0; bj < 2; ++bj)
#pragma unroll
            for (int n = 0; n < 2; ++n) bv[bj][n] = bias ? *(const f32x4*)(bias + bcol0 + bj * HALF + 4 * n) : (f32x4){0.f, 0.f, 0.f, 0.f};
#pragma unroll
        for (int ai = 0; ai < 2; ++ai)
#pragma unroll
            for (int m = 0; m < 4; ++m) { bf16_t* rowp = base + (size_t)(row0 + ai * HALF + m * 16) * ldc + col0;
#pragma unroll
                for (int bj = 0; bj < 2; ++bj) { f32x4 v0 = acc[ai][bj][m][0] + bv[bj][0], v1 = acc[ai][bj][m][1] + bv[bj][1];
                    if (ACT == 1) { f32x2 a = gelu_pk((f32x2){v0[0], v0[1]}), b = gelu_pk((f32x2){v0[2], v0[3]}), c = gelu_pk((f32x2){v1[0], v1[1]}), d = gelu_pk((f32x2){v1[2], v1[3]});
                        v0 = (f32x4){a.x, a.y, b.x, b.y}; v1 = (f32x4){c.x, c.y, d.x, d.y}; }
                    v0 = v0 * sc; v1 = v1 * sc; u32x4 w; w.x = cvt_pk_bf16(v0[0], v0[1]); w.y = cvt_pk_bf16(v0[2], v0[3]); w.z = cvt_pk_bf16(v1[0], v1[1]); w.w = cvt_pk_bf16(v1[2], v1[3]);
                    *(u32x4*)(rowp + bj * HALF) = w; } }
    }
};
template <class Epi, class Sched, bool ALIGN_EPI = false, bool SP2 = false>
__device__ __forceinline__ void gemm_phase(PG8_LAS unsigned char* lds, const Gemm g, const Sched& S, const Epi& E) {
    const int tid = threadIdx.x, wid = __builtin_amdgcn_readfirstlane(tid >> 6), lane = tid & 63, wr = wid >> 2, wc = wid & 3, fr = lane & 15, fq = lane >> 4;
    const int K = g.K, nt = K / BK;
    unsigned voffA[2], voffB[2];
#pragma unroll
    for (int i = 0; i < 2; ++i) { int R, C; stage_rc(tid * 16 + i * 8192, R, C); const int Rb = Epi::PERM ? ((R & ~31) + perm32(R & 31)) : R;
        voffA[i] = (unsigned)(R * K + C) * 2u; voffB[i] = (unsigned)(Rb * K + C) * 2u; }
    const size_t kstep = (size_t)(BK * 2);
    const size_t hstep = (size_t)HALF * K * 2;
    const size_t tstep = 2 * hstep;
    const unsigned ldsw = (unsigned)wid * 1024u;
    const int aoff = lds_byte(wr * 64 + fr, fq * 8), boff = lds_byte(wc * 32 + fr, fq * 8);
#define PG8_SA(b, h) (((b) * 2 + (h)) * HTB)
#define PG8_SB(b, h) ((4 + (b) * 2 + (h)) * HTB)
#define PG8_STAGE(bufoff, gbase, voff) do { _Pragma("unroll") for (int _i = 0; _i < 2; ++_i) \
        __builtin_amdgcn_global_load_lds((const unsigned*)((const char*)(gbase) + (voff)[_i]), (PG8_LAS unsigned*)(lds + (bufoff) + ldsw + _i * 8192), 16, 0, 0); } while (0)
#define PG8_LDA(dst, b, h) do { _Pragma("unroll") for (int m = 0; m < 4; ++m) _Pragma("unroll") for (int k = 0; k < 2; ++k) dst[m][k] = *(const PG8_LAS bf16x8*)(lds + PG8_SA(b, h) + aoff + m * 2048 + k * 1024); } while (0)
#define PG8_LDB(dst, b, h) do { _Pragma("unroll") for (int n = 0; n < 2; ++n) _Pragma("unroll") for (int k = 0; k < 2; ++k) dst[n][k] = *(const PG8_LAS bf16x8*)(lds + PG8_SB(b, h) + boff + n * 2048 + k * 1024); } while (0)
#define PG8_MMA(ai, bj, At, Bt) do { __builtin_amdgcn_s_setprio(1); _Pragma("unroll") for (int m = 0; m < 4; ++m) _Pragma("unroll") for (int n = 0; n < 2; ++n) _Pragma("unroll") for (int k = 0; k < 2; ++k) \
        acc[ai][bj][m][n] = __builtin_amdgcn_mfma_f32_16x16x32_bf16(Bt[n][k], At[m][k], acc[ai][bj][m][n], 0, 0, 0); __builtin_amdgcn_s_setprio(0); } while (0)
#define PG8_WAIT_V(n) asm volatile("s_waitcnt vmcnt(" #n ")" ::: "memory")
#define PG8_WAIT_L(n) asm volatile("s_waitcnt lgkmcnt(" #n ")" ::: "memory")
#define PG8_BAR __builtin_amdgcn_s_barrier()
#define PG8_SCHED __builtin_amdgcn_sched_barrier(0)
    Unit cur, nxt; int ui = 0;
    if (!S.next(0, cur)) return;
    f32x4 acc[2][2][4][2];
#pragma unroll
    for (int a = 0; a < 2; ++a)
#pragma unroll
        for (int b = 0; b < 2; ++b)
#pragma unroll
            for (int m = 0; m < 4; ++m)
#pragma unroll
                for (int n = 0; n < 2; ++n) acc[a][b][m][n] = (f32x4){0.f, 0.f, 0.f, 0.f};
    bf16x8 At[4][2], B0[2][2], B1[2][2];
    const char* cA = (const char*)g.A + (size_t)cur.pm * tstep; const char* cB = (const char*)g.Bt + (size_t)cur.pn * tstep;
    S.a_ready(cur);
    if constexpr (SP2) {
        PG8_STAGE(PG8_SB(0, 0), cB, voffB); PG8_STAGE(PG8_SB(0, 1), cB + hstep, voffB); PG8_STAGE(PG8_SA(0, 0), cA, voffA); PG8_STAGE(PG8_SA(0, 1), cA + hstep, voffA);
        if (wr == 1) PG8_BAR;
        PG8_WAIT_V(2); PG8_BAR;
        PG8_STAGE(PG8_SB(1, 0), cB + kstep, voffB); PG8_STAGE(PG8_SA(1, 0), cA + kstep, voffA); PG8_STAGE(PG8_SB(1, 1), cB + hstep + kstep, voffB);
        PG8_WAIT_V(6); PG8_BAR;
    } else {
        PG8_STAGE(PG8_SB(0, 0), cB, voffB); PG8_STAGE(PG8_SA(0, 0), cA, voffA); PG8_STAGE(PG8_SB(0, 1), cB + hstep, voffB); PG8_STAGE(PG8_SA(0, 1), cA + hstep, voffA);
        if (wr == 1) PG8_BAR;
        PG8_WAIT_V(4); PG8_BAR;
        PG8_STAGE(PG8_SB(1, 0), cB + kstep, voffB); PG8_STAGE(PG8_SA(1, 0), cA + kstep, voffA); PG8_STAGE(PG8_SB(1, 1), cB + hstep + kstep, voffB);
        PG8_WAIT_V(6); PG8_BAR;
    }
    for (;;) {
        const bool has_next = S.next(ui + 1, nxt);
        const char* nA = has_next ? (const char*)g.A + (size_t)nxt.pm * tstep : cA; const char* nB = has_next ? (const char*)g.Bt + (size_t)nxt.pn * tstep : cB;
        for (int t = 0; t < nt; t += 2) {
            const bool last = (t == nt - 2);
            const char* a1 = cA + (size_t)(t + 1) * kstep;
            const char* a2 = last ? nA : cA + (size_t)(t + 2) * kstep; const char* b2 = last ? nB : cB + (size_t)(t + 2) * kstep;
            const char* a3 = a2 + kstep; const char* b3 = b2 + kstep;
            if (last && has_next) S.a_ready(nxt);
            if constexpr (SP2) {
            PG8_LDB(B0, 0, 0); PG8_LDB(B1, 0, 1); PG8_SCHED; PG8_LDA(At, 0, 0); PG8_STAGE(PG8_SA(1, 1), a1 + hstep, voffA);
            PG8_WAIT_V(8); PG8_WAIT_L(0); PG8_BAR; PG8_MMA(0, 0, At, B0); PG8_MMA(0, 1, At, B1); PG8_BAR; PG8_SCHED;
            PG8_LDA(At, 0, 1); PG8_STAGE(PG8_SB(0, 0), b2, voffB); PG8_STAGE(PG8_SB(0, 1), b2 + hstep, voffB); PG8_STAGE(PG8_SA(0, 0), a2, voffA);
            PG8_WAIT_V(8); PG8_WAIT_L(0); PG8_BAR; PG8_MMA(1, 0, At, B0); PG8_MMA(1, 1, At, B1); PG8_BAR; PG8_SCHED;
            PG8_LDB(B0, 1, 0); PG8_LDB(B1, 1, 1); PG8_SCHED; PG8_LDA(At, 1, 0); PG8_STAGE(PG8_SA(0, 1), a2 + hstep, voffA);
            PG8_WAIT_V(8); PG8_WAIT_L(0); PG8_BAR; PG8_MMA(0, 0, At, B0); PG8_MMA(0, 1, At, B1); PG8_BAR; PG8_SCHED;
            PG8_LDA(At, 1, 1); PG8_STAGE(PG8_SB(1, 0), b3, voffB); PG8_STAGE(PG8_SB(1, 1), b3 + hstep, voffB); PG8_STAGE(PG8_SA(1, 0), a3, voffA);
            PG8_WAIT_V(8); PG8_WAIT_L(0); PG8_BAR; PG8_MMA(1, 0, At, B0); PG8_MMA(1, 1, At, B1); PG8_BAR; PG8_SCHED;
            } else {
            PG8_LDB(B0, 0, 0); PG8_SCHED; PG8_LDA(At, 0, 0); PG8_STAGE(PG8_SA(1, 1), a1 + hstep, voffA);
            PG8_WAIT_L(8); PG8_BAR; PG8_WAIT_L(0); PG8_MMA(0, 0, At, B0); PG8_BAR; PG8_SCHED;
            PG8_LDB(B1, 0, 1); PG8_STAGE(PG8_SB(0, 0), b2, voffB);
            PG8_BAR; PG8_WAIT_L(0); PG8_MMA(0, 1, At, B1); PG8_BAR;
            PG8_LDA(At, 0, 1); PG8_STAGE(PG8_SA(0, 0), a2, voffA);
            PG8_BAR; PG8_WAIT_L(0); PG8_MMA(1, 0, At, B0); PG8_BAR; PG8_SCHED;
            PG8_STAGE(PG8_SB(0, 1), b2 + hstep, voffB);
            PG8_WAIT_V(6); PG8_BAR; PG8_MMA(1, 1, At, B1); PG8_BAR;
            PG8_LDB(B0, 1, 0); PG8_SCHED; PG8_LDA(At, 1, 0); PG8_STAGE(PG8_SA(0, 1), a2 + hstep, voffA);
            PG8_WAIT_L(8); PG8_BAR; PG8_WAIT_L(0); PG8_MMA(0, 0, At, B0); PG8_BAR; PG8_SCHED;
            PG8_LDB(B1, 1, 1); PG8_STAGE(PG8_SB(1, 0), b3, voffB);
            PG8_BAR; PG8_WAIT_L(0); PG8_MMA(0, 1, At, B1); PG8_BAR;
            PG8_LDA(At, 1, 1); PG8_STAGE(PG8_SA(1, 0), a3, voffA);
            PG8_BAR; PG8_WAIT_L(0); PG8_MMA(1, 0, At, B0); PG8_BAR; PG8_SCHED;
            PG8_STAGE(PG8_SB(1, 1), b3 + hstep, voffB);
            PG8_WAIT_V(6); PG8_BAR; PG8_MMA(1, 1, At, B1); PG8_BAR;
            }
        }
        if constexpr (ALIGN_EPI) { if (wr == 0) PG8_BAR; }
        if constexpr (!Epi::AFTER_DRAIN) { E(acc, cur, wr, wc, fr, fq); S.done(cur); }
        if (!has_next) break;
#pragma unroll
        for (int a = 0; a < 2; ++a)
#pragma unroll
            for (int b = 0; b < 2; ++b)
#pragma unroll
                for (int m = 0; m < 4; ++m)
#pragma unroll
                    for (int n = 0; n < 2; ++n) acc[a][b][m][n] = (f32x4){0.f, 0.f, 0.f, 0.f};
        cur = nxt; cA = nA; cB = nB; ++ui;
        if constexpr (ALIGN_EPI) { if (wr == 1) PG8_BAR; }
    }
    PG8_WAIT_V(0);
    if constexpr (!ALIGN_EPI) { if (wr == 0) PG8_BAR; }
    PG8_BAR;
    if constexpr (Epi::AFTER_DRAIN) { E.fused(acc, cur, wr, wc, fr, fq, lds, wid, lane); S.done(cur); }
#undef PG8_SA
#undef PG8_SB
#undef PG8_STAGE
#undef PG8_LDA
#undef PG8_LDB
#undef PG8_MMA
#undef PG8_WAIT_V
#undef PG8_WAIT_L
#undef PG8_BAR
#undef PG8_SCHED
}
}

#ifndef PG8_SP2
#define PG8_SP2 true
#endif
#ifndef PG8_ALIGN
#define PG8_ALIGN true
#endif
#define GAS __attribute__((address_space(1)))
#define LAS __attribute__((address_space(3)))
typedef unsigned short bf16;
typedef unsigned v4u __attribute__((ext_vector_type(4)));
typedef float f32x4 __attribute__((ext_vector_type(4)));
typedef short bf16x8 __attribute__((ext_vector_type(8)));
typedef GAS unsigned gu32;
typedef GAS unsigned long long gu64;
#define RLX_AGENT __ATOMIC_RELAXED, __HIP_MEMORY_SCOPE_AGENT
#define LDS_WAIT() asm volatile("s_waitcnt lgkmcnt(0)" ::: "memory")
#define VM_WAIT() asm volatile("s_waitcnt vmcnt(0)" ::: "memory")
__device__ __forceinline__ unsigned long long rt() { return __builtin_amdgcn_s_memrealtime(); }
__device__ __forceinline__ unsigned f2bf(float f) { unsigned u = __builtin_bit_cast(unsigned, f); return (u + 0x7fffu + ((u >> 16) & 1u)) >> 16; }
__device__ __forceinline__ unsigned pk2(float lo, float hi) { return f2bf(lo) | (f2bf(hi) << 16); }

#define XB_TMO      128
#define XB_XCNT(j)  (256  + 64 * (j))
#define XB_XSUB(j)  (1280 + 64 * (j))
#define XB_XGEN(j)  (2304 + 64 * (j))
#define XB_TOP      3328
#define XB_TOPGEN   3392
#define XCD_BAR_WORDS 3456
#define XB_SPIN_CAP (1u << 18)

__device__ __forceinline__ unsigned xb_ld(unsigned* p)              { return __hip_atomic_load(p, __ATOMIC_RELAXED, __HIP_MEMORY_SCOPE_AGENT); }
__device__ __forceinline__ unsigned xb_add(unsigned* p, unsigned v) { return __hip_atomic_fetch_add(p, v, __ATOMIC_RELAXED, __HIP_MEMORY_SCOPE_AGENT); }
__device__ __forceinline__ unsigned xb_xcc_id() { return (unsigned)__builtin_amdgcn_s_getreg((3 << 11) | 20) & 0xFu; }
#define XB_SPIN(cond, bar) do { unsigned _sp = 0; while (cond) { __builtin_amdgcn_s_sleep(1); \
    if ((++_sp & 255u) == 0u) { if (xb_ld(&(bar)[XB_TMO])) break; if (_sp > XB_SPIN_CAP) { atomicAdd(&(bar)[XB_TMO], 1u); break; } } } } while (0)

struct XcdBarrier {
    unsigned* bar; unsigned x;
    volatile LAS unsigned* st;
};

__device__ __forceinline__ XcdBarrier xcd_barrier_post(unsigned* bar, volatile LAS unsigned* st) {
    XcdBarrier b; b.bar = bar; b.x = xb_xcc_id(); b.st = st;
    if (threadIdx.x == 0) (void)xb_add(&bar[XB_XCNT(b.x)], 1u);
    return b;
}
__device__ __forceinline__ void xcd_barrier_complete(unsigned* bar, unsigned x, unsigned& nloc, unsigned& nx) {
    const unsigned G = gridDim.x * gridDim.y * gridDim.z;
    unsigned sum, cnt, mine, sp = 0u;
    for (;;) {
        sum = 0u; cnt = 0u; mine = 0u;
#pragma unroll
        for (unsigned j = 0; j < 16; ++j) { const unsigned c = xb_ld(&bar[XB_XCNT(j)]); sum += c; cnt += (c > 0u) ? 1u : 0u; mine = (j == x) ? c : mine; }
        if (sum == G) break;
        __builtin_amdgcn_s_sleep(1);
        if ((++sp & 255u) == 0u) { if (xb_ld(&bar[XB_TMO])) break; if (sp > XB_SPIN_CAP) { atomicAdd(&bar[XB_TMO], 1u); break; } }
    }
    nloc = mine > 0u ? mine : 1u; nx = cnt > 0u ? cnt : 1u;
}

__device__ __forceinline__ void xcd_barrier(const XcdBarrier& b) {
    asm volatile("s_waitcnt vmcnt(0)" ::: "memory");
    __syncthreads();
    if (threadIdx.x == 0) {
        unsigned* bar = b.bar;
        __builtin_amdgcn_s_waitcnt(0);
        unsigned nloc = b.st[0], nx = b.st[1];
        if (nloc == 0u) { xcd_barrier_complete(bar, b.x, nloc, nx); b.st[0] = nloc; b.st[1] = nx; }
        const unsigned old = xb_add(&bar[XB_XSUB(b.x)], 1u);
        const unsigned gen = old / nloc;
        if (old + 1u == (gen + 1u) * nloc) {
            __builtin_amdgcn_fence(__ATOMIC_RELEASE, "agent");
            asm volatile("s_waitcnt vmcnt(0)" ::: "memory");
            const unsigned og = xb_add(&bar[XB_TOP], 1u);
            const unsigned tg = og / nx;
            if (og + 1u == (tg + 1u) * nx) xb_add(&bar[XB_TOPGEN], 1u);
            else XB_SPIN(xb_ld(&bar[XB_TOPGEN]) == tg, bar);
            __builtin_amdgcn_fence(__ATOMIC_ACQUIRE, "agent");
            xb_add(&bar[XB_XGEN(b.x)], 1u);
            asm volatile("s_waitcnt vmcnt(0)" ::: "memory");
        } else {
            XB_SPIN(xb_ld(&bar[XB_XGEN(b.x)]) == gen, bar);
            __builtin_amdgcn_fence(__ATOMIC_ACQUIRE, "agent");
            asm volatile("s_waitcnt vmcnt(0)" ::: "memory");
        }
    }
    __syncthreads();
}


constexpr int NWAVES = 8;
constexpr int DM = 2048, BATCH = 4, SEQ = 4096, M = BATCH * SEQ;
constexpr int NIN = 6176, NINP = 6400;
constexpr int O_GQ = 0, O_GK = 512, O_GV = 1024, O_GR = 2048, O_GDF = 3072, O_GDB = 3088, O_AQ = 3104, O_AK = 4128, O_AV = 5152;
constexpr float EPS = 1e-6f;
constexpr int PEER_K = 128;

constexpr size_t MiB = 1u << 20;
constexpr size_t WS_CTL = 0, CTL_ZERO_BYTES = 1 * MiB;
constexpr size_t WS_WIN = 1 * MiB;
constexpr size_t WS_WOUT = 26 * MiB;
constexpr size_t WS_WQ = 34 * MiB;
constexpr size_t WS_SSQ = 42 * MiB;
constexpr size_t WS_EIDX = 44 * MiB;
constexpr size_t WS_GATE = 52 * MiB;
constexpr size_t WS_XN = 64 * MiB;
constexpr size_t WS_PROJ = 128 * MiB;
constexpr size_t WS_HB = 256 * MiB;
constexpr size_t WS_OF = 328 * MiB;
constexpr size_t WS_OB = 392 * MiB;
constexpr size_t WS_ATT = 456 * MiB;
constexpr size_t WS_END = 488 * MiB;
constexpr int CW_TMO = 0, CW_CODE = 1, CW_BAR = 4096;

constexpr int RING_OFF = 0, RING_BYTES = 131072;
constexpr int LDSCTL_OFF = RING_BYTES, MISC_OFF = LDSCTL_OFF + 320;
constexpr int LDS_BYTES = 147456;

__device__ __forceinline__ float bf2f(unsigned short h) { return __builtin_bit_cast(float, (unsigned)h << 16); }
__device__ __forceinline__ float bflo(unsigned w) { return __builtin_bit_cast(float, w << 16); }
__device__ __forceinline__ float bfhi(unsigned w) { return __builtin_bit_cast(float, w & 0xffff0000u); }
__device__ __forceinline__ float wave_sum(float v) {
#pragma unroll
    for (int o = 1; o < 64; o <<= 1) v += __shfl_xor(v, o);
    return v;
}
__device__ __forceinline__ float wave_max(float v) {
#pragma unroll
    for (int o = 1; o < 64; o <<= 1) v = fmaxf(v, __shfl_xor(v, o));
    return v;
}

namespace pg8 {
struct EpiRes {
    static constexpr bool PERM = false, AFTER_DRAIN = false;
    const float* x; float* H; bf16_t* HB; float* ssq; int ldc;
    __device__ __forceinline__ void operator()(const f32x4 (&acc)[2][2][4][2], const Unit& u, int wr, int wc, int fr, int fq) const {
        const int col0 = u.pn * BM + wc * 32 + 4 * fq;
#pragma unroll
        for (int ai = 0; ai < 2; ++ai)
#pragma unroll
            for (int m = 0; m < 4; ++m) {
                const int r = u.pm * BM + ai * HALF + wr * 64 + m * 16 + fr; const size_t off = (size_t)r * ldc + col0; float s = 0.f;
#pragma unroll
                for (int bj = 0; bj < 2; ++bj)
#pragma unroll
                    for (int n = 0; n < 2; ++n) {
                        const f32x4 xv = *(const f32x4*)(x + off + bj * HALF + n * 16);
                        const f32x4 hv = xv + acc[ai][bj][m][n];
                        *(f32x4*)(H + off + bj * HALF + n * 16) = hv;
                        s += (hv[0] * hv[0] + hv[1] * hv[1]) + (hv[2] * hv[2] + hv[3] * hv[3]);
                        unsigned long long w = (unsigned long long)cvt_pk_bf16(hv[0], hv[1]) | ((unsigned long long)cvt_pk_bf16(hv[2], hv[3]) << 32);
                        *(unsigned long long*)(HB + off + bj * HALF + n * 16) = w;
                    }
                s += __shfl_xor(s, 16); s += __shfl_xor(s, 32);
                if (fq == 0) ssq[(size_t)r * 32 + u.pn * 4 + wc] = s;
            }
    }
};
struct EpiRowScale {
    static constexpr bool PERM = true, AFTER_DRAIN = false;
    bf16_t* O; int ldc; const float* ssq; float inv_n, eps;
    __device__ __forceinline__ void operator()(const f32x4 (&acc)[2][2][4][2], const Unit& u, int wr, int wc, int fr, int fq) const {
        const int col0 = u.pn * BM + wc * 32 + 8 * fq;
#pragma unroll
        for (int ai = 0; ai < 2; ++ai)
#pragma unroll
            for (int m = 0; m < 4; ++m) {
                const int r = u.pm * BM + ai * HALF + wr * 64 + m * 16 + fr;
                const f32x4* sp = (const f32x4*)(ssq + (size_t)r * 32); float s = 0.f;
#pragma unroll
                for (int i = 0; i < 8; ++i) { const f32x4 t = sp[i]; s += (t[0] + t[1]) + (t[2] + t[3]); }
                const float sc = 1.0f / sqrtf(s * inv_n + eps);
                bf16_t* rowp = O + (size_t)r * ldc + col0;
#pragma unroll
                for (int bj = 0; bj < 2; ++bj) { const f32x4 v0 = acc[ai][bj][m][0] * sc, v1 = acc[ai][bj][m][1] * sc;
                    u32x4 w; w.x = cvt_pk_bf16(v0[0], v0[1]); w.y = cvt_pk_bf16(v0[2], v0[3]); w.z = cvt_pk_bf16(v1[0], v1[1]); w.w = cvt_pk_bf16(v1[2], v1[3]);
                    *(u32x4*)(rowp + bj * HALF) = w; }
            }
    }
};
}

struct Frame {
    LAS unsigned char* lds;
    volatile LAS unsigned* MISC;
    gu32* ctl;
    int tid, lane, wave;
    int vcu, G;
};

__device__ __forceinline__ void p0_transpose_item(const float* W, int K, int ldw, const float* gk, bf16* WT, LAS float* scr, int item, int lane) {
    const int nblk = ldw / 32, kb = item / nblk, nb = item % nblk, k0 = 64 * kb, n0 = 32 * nb;
#pragma unroll 8
    for (int i = 0; i < 32; ++i) { const int kk = 2 * i + (lane >> 5); float w = W[(size_t)(k0 + kk) * ldw + n0 + (lane & 31)]; if (gk) w *= gk[k0 + kk]; scr[kk * 33 + (lane & 31)] = w; }
    LDS_WAIT(); asm volatile("" ::: "memory");
    const int c = lane & 7;
#pragma unroll
    for (int j = 0; j < 4; ++j) { const int n = (lane >> 3) + 8 * j; const LAS float* s = scr + (8 * c) * 33 + n;
        v4u o; o.x = pk2(s[0 * 33], s[1 * 33]); o.y = pk2(s[2 * 33], s[3 * 33]); o.z = pk2(s[4 * 33], s[5 * 33]); o.w = pk2(s[6 * 33], s[7 * 33]);
        *(GAS v4u*)(WT + (size_t)(n0 + n) * K + k0 + 8 * c) = o; }
    LDS_WAIT(); asm volatile("" ::: "memory");
}
__device__ __forceinline__ void rms_row_to_bf16(int lane, const float* xrow, const float* g, bf16* orow) {
    const GAS f32x4* xr = (const GAS f32x4*)xrow + lane; const GAS f32x4* gr = (const GAS f32x4*)g + lane;
    f32x4 v[8]; float s = 0.f;
#pragma unroll
    for (int j = 0; j < 8; ++j) { v[j] = xr[64 * j]; s += (v[j].x * v[j].x + v[j].y * v[j].y) + (v[j].z * v[j].z + v[j].w * v[j].w); }
    const float rstd = 1.f / sqrtf(wave_sum(s) * (1.f / DM) + EPS);
    GAS unsigned long long* o8 = (GAS unsigned long long*)orow + lane;
#pragma unroll
    for (int j = 0; j < 8; ++j) { const f32x4 gg = gr[64 * j];
        o8[64 * j] = (unsigned long long)pk2(v[j].x * rstd * gg.x, v[j].y * rstd * gg.y) | ((unsigned long long)pk2(v[j].z * rstd * gg.z, v[j].w * rstd * gg.w) << 32); }
}

struct Args {
    const float* in[16]; float* out; unsigned char* ws; int ph_lo, ph_hi, li, pad;
};

__device__ __forceinline__ void p0_prologue(Frame& F, const Args& a) {
    unsigned char* ws = a.ws;
    LAS float* scr = (LAS float*)(F.lds + RING_OFF + F.wave * 16384);
    const int gw = F.vcu * NWAVES + F.wave, NGW = F.G * NWAVES;
    bf16* Win_t = (bf16*)(ws + WS_WIN); bf16* Wout_t = (bf16*)(ws + WS_WOUT); bf16* Wq_t = (bf16*)(ws + WS_WQ); bf16* XN = (bf16*)(ws + WS_XN);
    constexpr int I_IN = (DM / 64) * (NIN / 32), I_SQ = (DM / 64) * (DM / 32);
    constexpr int NITEMS = I_IN + 2 * I_SQ;
    for (int it = gw; it < NITEMS; it += NGW) {
        int r = it;
        if (r < I_IN) { p0_transpose_item(a.in[2], DM, NIN, nullptr, Win_t, scr, r, F.lane); continue; } r -= I_IN;
        if (r < I_SQ) { p0_transpose_item(a.in[9], DM, DM, nullptr, Wout_t, scr, r, F.lane); continue; } r -= I_SQ;
        p0_transpose_item(a.in[11], DM, DM, a.in[10], Wq_t, scr, r, F.lane);
    }
    { GAS v4u* z = (GAS v4u*)(Win_t + (size_t)NIN * DM); const int n16 = (NINP - NIN) * DM * 2 / 16;
      for (int i = (gw * 64 + F.lane); i < n16; i += NGW * 64) z[i] = (v4u){0u, 0u, 0u, 0u}; }
    for (int m = gw; m < M; m += NGW) rms_row_to_bf16(F.lane, a.in[0] + (size_t)m * DM, a.in[1], XN + (size_t)m * DM);
}

__device__ __forceinline__ void p3_finalize(Frame& F, const Args& a) {
    unsigned char* ws = a.ws;
    const int gw = F.vcu * NWAVES + F.wave, NGW = F.G * NWAVES, lane = F.lane;
    const float* OFp = (const float*)(ws + WS_OF); const float* OBp = (const float*)(ws + WS_OB);
    const bf16* ATT = (const bf16*)(ws + WS_ATT); const bf16* PROJ = (const bf16*)(ws + WS_PROJ); bf16* Y = (bf16*)(ws + WS_XN);
    const float* gla_g = a.in[7]; const float* att_g = a.in[8];
    const f32x4 gg = *(const f32x4*)(gla_g + 4 * lane);
    for (int m = gw; m < M; m += NGW) {
#pragma unroll
        for (int hh = 0; hh < 4; ++hh) {
            const f32x4 of = *(const f32x4*)(OFp + (size_t)m * 1024 + hh * 256 + 4 * lane);
            const f32x4 ob = *(const f32x4*)(OBp + (size_t)m * 1024 + hh * 256 + 4 * lane);
            const f32x4 o = of + ob;
            const float ss = wave_sum((o.x * o.x + o.y * o.y) + (o.z * o.z + o.w * o.w));
            const float rstd = 1.f / sqrtf(ss * (1.f / 256.f) + EPS);
            const unsigned long long gr = *(const unsigned long long*)(PROJ + (size_t)m * NINP + O_GR + hh * 256 + 4 * lane);
            const float r0 = bflo((unsigned)gr), r1 = bfhi((unsigned)gr), r2 = bflo((unsigned)(gr >> 32)), r3 = bfhi((unsigned)(gr >> 32));
            const float y0 = o.x * rstd * gg.x * (r0 / (1.f + __expf(-r0))), y1 = o.y * rstd * gg.y * (r1 / (1.f + __expf(-r1)));
            const float y2 = o.z * rstd * gg.z * (r2 / (1.f + __expf(-r2))), y3 = o.w * rstd * gg.w * (r3 / (1.f + __expf(-r3)));
            *(unsigned long long*)(Y + (size_t)m * DM + hh * 256 + 4 * lane) = (unsigned long long)pk2(y0, y1) | ((unsigned long long)pk2(y2, y3) << 32);
        }
        float av[16]; float ss = 0.f;
#pragma unroll
        for (int p = 0; p < 2; ++p) { const v4u w = *(const v4u*)(ATT + (size_t)m * 1024 + p * 512 + 8 * lane);
            av[p * 8 + 0] = bflo(w.x); av[p * 8 + 1] = bfhi(w.x); av[p * 8 + 2] = bflo(w.y); av[p * 8 + 3] = bfhi(w.y);
            av[p * 8 + 4] = bflo(w.z); av[p * 8 + 5] = bfhi(w.z); av[p * 8 + 6] = bflo(w.w); av[p * 8 + 7] = bfhi(w.w); }
#pragma unroll
        for (int i = 0; i < 16; ++i) ss += av[i] * av[i];
        const float rstd = 1.f / sqrtf(wave_sum(ss) * (1.f / 1024.f) + EPS);
#pragma unroll
        for (int p = 0; p < 2; ++p) { const f32x4 g0 = *(const f32x4*)(att_g + p * 512 + 8 * lane), g1 = *(const f32x4*)(att_g + p * 512 + 8 * lane + 4);
            v4u w; w.x = pk2(av[p * 8 + 0] * rstd * g0.x, av[p * 8 + 1] * rstd * g0.y); w.y = pk2(av[p * 8 + 2] * rstd * g0.z, av[p * 8 + 3] * rstd * g0.w);
            w.z = pk2(av[p * 8 + 4] * rstd * g1.x, av[p * 8 + 5] * rstd * g1.y); w.w = pk2(av[p * 8 + 6] * rstd * g1.z, av[p * 8 + 7] * rstd * g1.w);
            *(v4u*)(Y + (size_t)m * DM + 1024 + p * 512 + 8 * lane) = w; }
    }
}


__device__ __forceinline__ void naive_gla_phase(Frame& F, const Args& a) {
    unsigned char* ws = a.ws; const bf16* PROJ = (const bf16*)(ws + WS_PROJ);
    const int half = F.tid >> 8, tid = F.tid & 255, e = tid & 15, dg = tid >> 4, d0 = dg * 8;
    LAS float* sm = (LAS float*)(F.lds + RING_OFF + half * 32768);
    LAS float* qs = sm; LAS float* ks = sm + 2048; LAS float* as_ = sm + 4096; LAS float* gds = sm + 6144; LAS float* vs = sm + 6400; LAS float* psum = sm + 6656;
    for (int ui = F.vcu; ui < 256; ui += F.G) {
        const int unit = ui * 2 + half;
        const int e0 = (unit & 15) * 16, h = (unit >> 4) & 3, b = (unit >> 6) & 3, dir = unit >> 8;
        const float* up = dir ? a.in[5] : a.in[3]; const float* bias = dir ? a.in[6] : a.in[4]; float* Out = (float*)(ws + (dir ? WS_OB : WS_OF));
        float S[8];
#pragma unroll
        for (int j = 0; j < 8; ++j) S[j] = 0.f;
        for (int t0 = 0; t0 < SEQ; t0 += 16) {
            for (int idx = tid; idx < 16 * 128; idx += 256) { const int i = idx >> 7, d = idx & 127; const int t = dir ? (SEQ - 1 - (t0 + i)) : (t0 + i); const size_t row = (size_t)b * SEQ + t;
                qs[i * 128 + d] = bf2f(PROJ[row * NINP + O_GQ + h * 128 + d]) * 0.08838834764831845f; ks[i * 128 + d] = bf2f(PROJ[row * NINP + O_GK + h * 128 + d]); }
            { const int i = tid >> 4, r = tid & 15; const int t = dir ? (SEQ - 1 - (t0 + i)) : (t0 + i); const size_t row = (size_t)b * SEQ + t;
              gds[i * 16 + r] = bf2f(PROJ[row * NINP + O_GDF + dir * 16 + r]); vs[i * 16 + r] = bf2f(PROJ[row * NINP + O_GV + h * 256 + e0 + r]); }
            __syncthreads();
            for (int idx = tid; idx < 16 * 128; idx += 256) { const int i = idx >> 7, d = idx & 127; float z = bias[h * 128 + d];
#pragma unroll
                for (int r = 0; r < 16; ++r) z += gds[i * 16 + r] * up[r * 512 + h * 128 + d];
                const float ls = fminf(z, 0.f) - log1pf(expf(-fabsf(z))); as_[i * 128 + d] = expf(ls * (1.f / 16.f)); }
            __syncthreads();
            for (int i = 0; i < 16; ++i) { const float v = vs[i * 16 + e]; float p = 0.f;
#pragma unroll
                for (int j = 0; j < 8; ++j) { S[j] = as_[i * 128 + d0 + j] * S[j] + ks[i * 128 + d0 + j] * v; p += qs[i * 128 + d0 + j] * S[j]; }
                p += __shfl_xor(p, 16); p += __shfl_xor(p, 32);
                if ((tid & 63) < 16) psum[(i * 4 + (tid >> 6)) * 16 + e] = p; }
            __syncthreads();
            { const int i = tid >> 4, ee = tid & 15; const int t = dir ? (SEQ - 1 - (t0 + i)) : (t0 + i); const size_t row = (size_t)b * SEQ + t;
              Out[row * 1024 + h * 256 + e0 + ee] = (psum[(i * 4 + 0) * 16 + ee] + psum[(i * 4 + 1) * 16 + ee]) + (psum[(i * 4 + 2) * 16 + ee] + psum[(i * 4 + 3) * 16 + ee]); }
        }
        __syncthreads();
    }
}

__device__ __forceinline__ void naive_attn_phase(Frame& F, const Args& a) {
    unsigned char* ws = a.ws; const bf16* PROJ = (const bf16*)(ws + WS_PROJ); bf16* ATT = (bf16*)(ws + WS_ATT);
    for (int gid2 = F.vcu * 512 + F.tid; gid2 < M * 32; gid2 += F.G * 512) {
        const int hf = gid2 & 1, gid = gid2 >> 1;
        const int h = gid & 15, row = gid >> 4, b = row >> 12, t = row & (SEQ - 1);
        float q[32], o[32];
        const bf16* qp = PROJ + (size_t)row * NINP + O_AQ + h * 64 + hf * 32;
#pragma unroll
        for (int i = 0; i < 32; ++i) { q[i] = bf2f(qp[i]) * 0.125f; o[i] = 0.f; }
        const float slope = exp2f(-0.5f * (float)(h + 1));
        float m = -1e30f, l = 0.f;
        for (int p = 0; p < 3; ++p) { const int dil = (p == 0) ? 1 : (p == 1 ? 4 : 16);
            for (int j = -64; j <= 64; ++j) { const int tk = t + j * dil; if (tk < 0 || tk >= SEQ) continue;
                const bf16* kp = PROJ + ((size_t)b * SEQ + tk) * NINP + O_AK + h * 64 + hf * 32; const bf16* vp = kp + (O_AV - O_AK);
                float s = 0.f;
#pragma unroll
                for (int i = 0; i < 32; ++i) s += q[i] * bf2f(kp[i]);
                s += __shfl_xor(s, 1);
                s -= slope * (float)((j < 0 ? -j : j) * dil);
                const float mn = fmaxf(m, s), sc = __expf(m - mn), pe = __expf(s - mn); l = l * sc + pe; m = mn;
#pragma unroll
                for (int i = 0; i < 32; ++i) o[i] = o[i] * sc + pe * bf2f(vp[i]); } }
        const float il = 1.f / l; bf16* op = ATT + (size_t)row * 1024 + h * 64 + hf * 32;
#pragma unroll
        for (int i = 0; i < 32; ++i) op[i] = (bf16)f2bf(o[i] * il);
    }
}

__device__ __forceinline__ void wave_argmax(float& v, int& idx) {
#pragma unroll
    for (int o = 1; o < 64; o <<= 1) { const float ov = __shfl_xor(v, o); const int oi = __shfl_xor(idx, o); if (ov > v || (ov == v && oi < idx)) { v = ov; idx = oi; } }
}
__device__ __forceinline__ void naive_topk_phase(Frame& F, const Args& a) {
    unsigned char* ws = a.ws; const bf16* QP = (const bf16*)(ws + WS_XN); const float* subk = a.in[12]; int* EIDX = (int*)(ws + WS_EIDX); float* GATE = (float*)(ws + WS_GATE);
    LAS float* qsh = (LAS float*)(F.lds + RING_OFF + F.wave * 1024);
    const int lane = F.lane;
    for (int gwv = F.vcu * NWAVES + F.wave; gwv < M * 8; gwv += F.G * NWAVES) {
        const int h = gwv & 7, row = gwv >> 3;
        const bf16* qp = QP + (size_t)row * DM + h * 256;
#pragma unroll
        for (int i = 0; i < 4; ++i) qsh[lane + 64 * i] = bf2f(qp[lane + 64 * i]);
        LDS_WAIT(); asm volatile("" ::: "memory");
        float tv[2]; int ti[2];
#pragma unroll
        for (int c = 0; c < 2; ++c) {
            const float* k0 = subk + (((size_t)h * 2 + c) * 128 + lane) * 128; const float* k1 = k0 + 64 * 128;
            float av = 0.f, bsc = 0.f;
#pragma unroll 4
            for (int d = 0; d < 128; d += 4) { const f32x4 x0 = *(const f32x4*)(k0 + d), x1 = *(const f32x4*)(k1 + d); const float q0 = qsh[c * 128 + d], q1 = qsh[c * 128 + d + 1], q2 = qsh[c * 128 + d + 2], q3 = qsh[c * 128 + d + 3];
                av += q0 * x0.x + q1 * x0.y + q2 * x0.z + q3 * x0.w; bsc += q0 * x1.x + q1 * x1.y + q2 * x1.z + q3 * x1.w; }
            float keepv = -3e38f; int keepi = 0;
            for (int r = 0; r < 16; ++r) { float v; int idx; if (av >= bsc) { v = av; idx = lane; } else { v = bsc; idx = lane + 64; }
                wave_argmax(v, idx);
                if (idx == lane) av = -3e38f; if (idx == lane + 64) bsc = -3e38f;
                if (lane == r) { keepv = v; keepi = idx; } }
            tv[c] = keepv; ti[c] = keepi;
        }
        float cv[4];
#pragma unroll
        for (int u = 0; u < 4; ++u) { const int id = lane * 4 + u; cv[u] = __shfl(tv[0], id >> 4) + __shfl(tv[1], id & 15); }
        float topv = -3e38f; int topid = 0;
        for (int r = 0; r < 16; ++r) { float v = cv[0]; int idx = lane * 4;
#pragma unroll
            for (int u = 1; u < 4; ++u) if (cv[u] > v) { v = cv[u]; idx = lane * 4 + u; }
            wave_argmax(v, idx);
            if ((idx >> 2) == lane) {
#pragma unroll
                for (int u = 0; u < 4; ++u) if ((idx & 3) == u) cv[u] = -3e38f; }
            if (lane == r) { topv = v; topid = idx; } }
        const int i1 = __shfl(ti[0], topid >> 4), i2 = __shfl(ti[1], topid & 15);
        const float vm = (lane < 16) ? topv : -3e38f; const float mx = wave_max(vm);
        const float ex = (lane < 16) ? __expf(topv - mx) : 0.f; const float sm = wave_sum(ex);
        if (lane < 16) { EIDX[(size_t)row * 128 + h * 16 + lane] = i1 * 128 + i2; GATE[(size_t)row * 128 + h * 16 + lane] = ex / sm; }
        LDS_WAIT(); asm volatile("" ::: "memory");
    }
}

__device__ __forceinline__ void naive_peer_phase(Frame& F, const Args& a) {
    unsigned char* ws = a.ws; float* H = a.out; const float* g2 = a.in[10]; const float* U = a.in[13]; const float* V = a.in[14]; const float* gf = a.in[15];
    const int* EIDX = (const int*)(ws + WS_EIDX); const float* GATE = (const float*)(ws + WS_GATE);
    const int lane = F.lane;
    for (int row = F.vcu * NWAVES + F.wave; row < M; row += F.G * NWAVES) {
        float* hrow = H + (size_t)row * DM;
        f32x4 hv[8], xn[8], acc[8]; float ss = 0.f;
#pragma unroll
        for (int j = 0; j < 8; ++j) { hv[j] = *(const f32x4*)(hrow + 256 * j + 4 * lane); ss += (hv[j].x * hv[j].x + hv[j].y * hv[j].y) + (hv[j].z * hv[j].z + hv[j].w * hv[j].w); acc[j] = (f32x4){0.f, 0.f, 0.f, 0.f}; }
        const float rstd = 1.f / sqrtf(wave_sum(ss) * (1.f / DM) + EPS);
#pragma unroll
        for (int j = 0; j < 8; ++j) { const f32x4 g = *(const f32x4*)(g2 + 256 * j + 4 * lane); xn[j] = hv[j] * rstd * g; }
        for (int p = 0; p < PEER_K; ++p) { const int e = EIDX[(size_t)row * 128 + p]; const float gt = GATE[(size_t)row * 128 + p];
            const float* ur = U + (size_t)e * DM; const float* vr = V + (size_t)e * DM; float d = 0.f;
#pragma unroll
            for (int j = 0; j < 8; ++j) { const f32x4 u = *(const f32x4*)(ur + 256 * j + 4 * lane); d += (xn[j].x * u.x + xn[j].y * u.y) + (xn[j].z * u.z + xn[j].w * u.w); }
            d = wave_sum(d);
            const float w = gt * 0.5f * d * (1.f + erff(d * 0.70710678118654752f));
#pragma unroll
            for (int j = 0; j < 8; ++j) { const f32x4 v = *(const f32x4*)(vr + 256 * j + 4 * lane); acc[j] += v * w; } }
        float s2 = 0.f;
#pragma unroll
        for (int j = 0; j < 8; ++j) { acc[j] += hv[j]; s2 += (acc[j].x * acc[j].x + acc[j].y * acc[j].y) + (acc[j].z * acc[j].z + acc[j].w * acc[j].w); }
        const float rf = 1.f / sqrtf(wave_sum(s2) * (1.f / DM) + EPS);
#pragma unroll
        for (int j = 0; j < 8; ++j) { const f32x4 g = *(const f32x4*)(gf + 256 * j + 4 * lane); *(f32x4*)(hrow + 256 * j + 4 * lane) = acc[j] * rf * g; }
    }
}
__global__ void __launch_bounds__(NWAVES * 64, 2) mk_fwd(Args args) {
    extern __shared__ __attribute__((aligned(16))) unsigned char lds[];
    Frame F;
    F.lds = (LAS unsigned char*)lds;
    F.MISC = (volatile LAS unsigned*)(F.lds + MISC_OFF);
    F.tid = threadIdx.x; F.lane = F.tid & 63; F.wave = __builtin_amdgcn_readfirstlane(F.tid >> 6);
    F.G = gridDim.x; { const int bx = blockIdx.x; F.vcu = (F.G % 8 == 0) ? (bx % 8) * (F.G / 8) + bx / 8 : bx; }
    unsigned char* ws = args.ws;
    F.ctl = (gu32*)(ws + WS_CTL);
    for (int u = F.tid; u < (LDS_BYTES - LDSCTL_OFF) / 4; u += NWAVES * 64) ((LAS unsigned*)(F.lds + LDSCTL_OFF))[u] = 0u;
    __syncthreads();
    XcdBarrier bar = xcd_barrier_post((unsigned*)(F.ctl + CW_BAR) + args.li * XCD_BAR_WORDS, F.MISC + 8);
    const int lo = args.ph_lo, hi = args.ph_hi;
#define IN(k) (lo <= (k) && (k) < hi)
#define BOTH(k) (IN(k) && IN((k) + 1))
#define GRID_BAR() xcd_barrier(bar)

    if (IN(0)) { p0_prologue(F, args); if (BOTH(0)) GRID_BAR(); }

    if (IN(1)) {
        pg8::Gemm g{(const bf16*)(ws + WS_XN), (const bf16*)(ws + WS_WIN), M, NINP, DM}; pg8::StaticOrder S; S.init(M, NINP, F.G, (int)blockIdx.x);
        pg8::EpiBf16<0> E{(bf16*)(ws + WS_PROJ), NINP, nullptr, 0, 0, 1.f};
        pg8::gemm_phase<pg8::EpiBf16<0>, pg8::StaticOrder, PG8_ALIGN, PG8_SP2>(F.lds + RING_OFF, g, S, E);
        if (BOTH(1)) GRID_BAR();
    }
    if (IN(2)) { naive_gla_phase(F, args); naive_attn_phase(F, args); if (BOTH(2)) GRID_BAR(); }
    if (IN(3)) { p3_finalize(F, args); if (BOTH(3)) GRID_BAR(); }
    if (IN(4)) {
        pg8::Gemm g{(const bf16*)(ws + WS_XN), (const bf16*)(ws + WS_WOUT), M, DM, DM}; pg8::StaticOrder S; S.init(M, DM, F.G, (int)blockIdx.x);
        pg8::EpiRes E{args.in[0], args.out, (bf16*)(ws + WS_HB), (float*)(ws + WS_SSQ), DM};
        pg8::gemm_phase<pg8::EpiRes, pg8::StaticOrder, PG8_ALIGN, PG8_SP2>(F.lds + RING_OFF, g, S, E);
        if (BOTH(4)) GRID_BAR();
    }
    if (IN(5)) {
        pg8::Gemm g{(const bf16*)(ws + WS_HB), (const bf16*)(ws + WS_WQ), M, DM, DM}; pg8::StaticOrder S; S.init(M, DM, F.G, (int)blockIdx.x);
        pg8::EpiRowScale E{(bf16*)(ws + WS_XN), DM, (const float*)(ws + WS_SSQ), 1.f / DM, EPS};
        pg8::gemm_phase<pg8::EpiRowScale, pg8::StaticOrder, PG8_ALIGN, PG8_SP2>(F.lds + RING_OFF, g, S, E);
        if (BOTH(5)) GRID_BAR();
    }
    if (IN(6)) { naive_topk_phase(F, args); if (BOTH(6)) GRID_BAR(); }
    if (IN(7)) { naive_peer_phase(F, args); }
#undef IN
#undef BOTH
}


extern "C" void kernel_launch(void* const* d_in, const int* in_sizes, int n_in, void* d_out, int out_size, void* d_ws, size_t ws_size, hipStream_t stream) {
    static int grid = 0;
    if (grid == 0) {
        if (n_in != 16 || in_sizes[0] != M * DM || out_size != M * DM || ws_size < WS_END) { fprintf(stderr, "kernel_launch: unexpected shapes: n_in %d in0 %d out %d ws %zu\n", n_in, n_in > 0 ? in_sizes[0] : -1, out_size, ws_size); grid = -1; return; }
        int dev = 0, cus = 0;
        if (hipGetDevice(&dev) != hipSuccess || hipDeviceGetAttribute(&cus, hipDeviceAttributeMultiprocessorCount, dev) != hipSuccess) { grid = -1; return; }
        if (hipFuncSetAttribute((const void*)mk_fwd, hipFuncAttributeMaxDynamicSharedMemorySize, LDS_BYTES) != hipSuccess) { fprintf(stderr, "kernel_launch: hipFuncSetAttribute failed\n"); grid = -1; return; }
        (void)hipGetLastError();
        grid = cus;
    }
    if (grid < 0) return;
    (void)hipMemsetAsync((char*)d_ws + WS_CTL, 0, CTL_ZERO_BYTES, stream);
    Args a{};
    for (int i = 0; i < 16; ++i) a.in[i] = (const float*)d_in[i];
    a.out = (float*)d_out; a.ws = (unsigned char*)d_ws;
    a.ph_lo = 0; a.ph_hi = 8; a.li = 0;
    hipLaunchKernelGGL(mk_fwd, dim3(grid), dim3(NWAVES * 64), LDS_BYTES, stream, a);
}
```

```cpp
#define REP_PHASE -1

#include <hip/hip_runtime.h>
#include <cstdio>
#include <cstdint>
#include <cmath>
#ifndef REP_PHASE
#define REP_PHASE -1
#endif
#define NREP(k) ((REP_PHASE == (k)) ? 2 : 1)
namespace pg8 {
#define PG8_LAS __attribute__((address_space(3)))
typedef unsigned short bf16_t;
typedef short bf16x8 __attribute__((ext_vector_type(8)));
typedef float f32x4 __attribute__((ext_vector_type(4)));
typedef unsigned u32x4 __attribute__((ext_vector_type(4)));
constexpr int BM = 256, BK = 64, HALF = 128, HTB = HALF * BK * 2  , STAGE_BYTES = 8 * HTB, NXCD = 8, WGM = 8;

__host__ __device__ __forceinline__ int lds_byte(int r, int c) { const int st = (r >> 4) * 2 + (c >> 5), rr = r & 15, cc = c & 31, ob = rr * 64 + cc * 2; return st * 1024 + (ob ^ (((ob >> 9) & 1) << 5)); }
__host__ __device__ __forceinline__ void stage_rc(int b, int& R, int& C) { const int st = b / 1024, sb = b % 1024, swz = sb ^ (((sb >> 9) & 1) << 5); R = (st >> 1) * 16 + swz / 64; C = (st & 1) * 32 + (swz % 64) / 2; }
__host__ __device__ __forceinline__ int perm32(int rho) { const int n = rho >> 4, i = rho & 15; return 8 * (i >> 2) + 4 * n + (i & 3); }

struct Unit { int pm, pn; };
struct Gemm { const bf16_t* A; const bf16_t* Bt; int M, N, K; };

struct StaticOrder {
    int nM, nN, nwg, G, c;
    __host__ __device__ void init(int M, int N, int G_, int c_) { nM = M / BM; nN = N / BM; nwg = nM * nN; G = G_; c = c_; }
    __host__ __device__ bool next(int i, Unit& u) const {
        const long L = (long)i * G + c; if (L >= nwg) return false;
        int wgid = (int)L; { const int q = nwg / NXCD, r = nwg % NXCD, xcd = wgid % NXCD, off = wgid / NXCD; wgid = (xcd < r ? xcd * (q + 1) : r * (q + 1) + (xcd - r) * q) + off; }
        const int nig = WGM * nN, gid = wgid / nig, fm = gid * WGM, gsz = (nM - fm) < WGM ? (nM - fm) : WGM;
        u.pm = fm + ((wgid % nig) % gsz); u.pn = (wgid % nig) / gsz; return true;
    }
    __device__ __forceinline__ void a_ready(const Unit&) const {}
    __device__ __forceinline__ void done(const Unit&) const {}
};

__device__ __forceinline__ unsigned cvt_pk_bf16(float lo, float hi) { unsigned r; asm volatile("v_cvt_pk_bf16_f32 %0, %1, %2" : "=v"(r) : "v"(lo), "v"(hi)); return r; }
typedef float f32x2 __attribute__((ext_vector_type(2)));
__device__ __forceinline__ f32x2 gelu_pk(f32x2 v) {
    const f32x2 av = __builtin_elementwise_abs(v), d = av * 0.2316418882f + 1.0f;
    f32x2 t; t.x = __builtin_amdgcn_rcpf(d.x); t.y = __builtin_amdgcn_rcpf(d.y);
    f32x2 q = t * 0.5307027145f + (-0.7265760135f); q = q * t + 0.7107068705f; q = q * t + (-0.142248368f); q = q * t + 0.127414796f; q = q * t;
    const f32x2 s = (v * v) * (-0.72134752044f);
    f32x2 e; e.x = __builtin_amdgcn_exp2f(s.x); e.y = __builtin_amdgcn_exp2f(s.y);
    const f32x2 m = v * (q * e), r = v - m;
    f32x2 o; o.x = v.x < 0.f ? m.x : r.x; o.y = v.y < 0.f ? m.y : r.y; return o;
}

template <int ACT  > struct EpiBf16 {
    static constexpr bool PERM = true, AFTER_DRAIN = false; static_assert(ACT == 0 || ACT == 1, "EpiBf16: ACT is 0 (none) or 1 (gelu_pk)");
    bf16_t* O; int ldc; const float* bias; int split_cols; size_t split_stride; float scale0;
    __device__ __forceinline__ void operator()(const f32x4 (&acc)[2][2][4][2], const Unit& u, int wr, int wc, int fr, int fq) const {
        const int row0 = u.pm * BM + wr * 64 + fr; int colt = u.pn * BM; bf16_t* base = O;
        float sc = 1.f; if (split_cols) { const int t = colt / split_cols; base += (size_t)t * split_stride; colt -= t * split_cols; if (t == 0) sc = scale0; }
        const int col0 = colt + wc * 32 + 8 * fq, bcol0 = u.pn * BM + wc * 32 + 8 * fq;
        f32x4 bv[2][2];
#pragma unroll
        for (int bj = 0; bj < 2; ++bj)
#pragma unroll
            for (int n = 0; n < 2; ++n) bv[bj][n] = bias ? *(const f32x4*)(bias + bcol0 + bj * HALF + 4 * n) : (f32x4){0.f, 0.f, 0.f, 0.f};
#pragma unroll
        for (int ai = 0; ai < 2; ++ai)
#pragma unroll
            for (int m = 0; m < 4; ++m) { bf16_t* rowp = base + (size_t)(row0 + ai * HALF + m * 16) * ldc + col0;
#pragma unroll
                for (int bj = 0; bj < 2; ++bj) { f32x4 v0 = acc[ai][bj][m][0] + bv[bj][0], v1 = acc[ai][bj][m][1] + bv[bj][1];
                    if (ACT == 1) { f32x2 a = gelu_pk((f32x2){v0[0], v0[1]}), b = gelu_pk((f32x2){v0[2], v0[3]}), c = gelu_pk((f32x2){v1[0], v1[1]}), d = gelu_pk((f32x2){v1[2], v1[3]});
                        v0 = (f32x4){a.x, a.y, b.x, b.y}; v1 = (f32x4){c.x, c.y, d.x, d.y}; }
                    v0 = v0 * sc; v1 = v1 * sc; u32x4 w; w.x = cvt_pk_bf16(v0[0], v0[1]); w.y = cvt_pk_bf16(v0[2], v0[3]); w.z = cvt_pk_bf16(v1[0], v1[1]); w.w = cvt_pk_bf16(v1[2], v1[3]);
                    *(u32x4*)(rowp + bj * HALF) = w; } }
    }
};
template <class Epi, class Sched, bool ALIGN_EPI = false, bool SP2 = false>
__device__ __forceinline__ void gemm_phase(PG8_LAS unsigned char* lds, const Gemm g, const Sched& S, const Epi& E) {
    const int tid = threadIdx.x, wid = __builtin_amdgcn_readfirstlane(tid >> 6), lane = tid & 63, wr = wid >> 2, wc = wid & 3, fr = lane & 15, fq = lane >> 4;
    const int K = g.K, nt = K / BK;
    unsigned voffA[2], voffB[2];
#pragma unroll
    for (int i = 0; i < 2; ++i) { int R, C; stage_rc(tid * 16 + i * 8192, R, C); const int Rb = Epi::PERM ? ((R & ~31) + perm32(R & 31)) : R;
        voffA[i] = (unsigned)(R * K + C) * 2u; voffB[i] = (unsigned)(Rb * K + C) * 2u; }
    const size_t kstep = (size_t)(BK * 2);
    const size_t hstep = (size_t)HALF * K * 2;
    const size_t tstep = 2 * hstep;
    const unsigned ldsw = (unsigned)wid * 1024u;
    const int aoff = lds_byte(wr * 64 + fr, fq * 8), boff = lds_byte(wc * 32 + fr, fq * 8);
#define PG8_SA(b, h) (((b) * 2 + (h)) * HTB)
#define PG8_SB(b, h) ((4 + (b) * 2 + (h)) * HTB)
#define PG8_STAGE(bufoff, gbase, voff) do { _Pragma("unroll") for (int _i = 0; _i < 2; ++_i) \
        __builtin_amdgcn_global_load_lds((const unsigned*)((const char*)(gbase) + (voff)[_i]), (PG8_LAS unsigned*)(lds + (bufoff) + ldsw + _i * 8192), 16, 0, 0); } while (0)
#define PG8_LDA(dst, b, h) do { _Pragma("unroll") for (int m = 0; m < 4; ++m) _Pragma("unroll") for (int k = 0; k < 2; ++k) dst[m][k] = *(const PG8_LAS bf16x8*)(lds + PG8_SA(b, h) + aoff + m * 2048 + k * 1024); } while (0)
#define PG8_LDB(dst, b, h) do { _Pragma("unroll") for (int n = 0; n < 2; ++n) _Pragma("unroll") for (int k = 0; k < 2; ++k) dst[n][k] = *(const PG8_LAS bf16x8*)(lds + PG8_SB(b, h) + boff + n * 2048 + k * 1024); } while (0)
#define PG8_MMA(ai, bj, At, Bt) do { __builtin_amdgcn_s_setprio(1); _Pragma("unroll") for (int m = 0; m < 4; ++m) _Pragma("unroll") for (int n = 0; n < 2; ++n) _Pragma("unroll") for (int k = 0; k < 2; ++k) \
        acc[ai][bj][m][n] = __builtin_amdgcn_mfma_f32_16x16x32_bf16(Bt[n][k], At[m][k], acc[ai][bj][m][n], 0, 0, 0); __builtin_amdgcn_s_setprio(0); } while (0)
#define PG8_WAIT_V(n) asm volatile("s_waitcnt vmcnt(" #n ")" ::: "memory")
#define PG8_WAIT_L(n) asm volatile("s_waitcnt lgkmcnt(" #n ")" ::: "memory")
#define PG8_BAR __builtin_amdgcn_s_barrier()
#define PG8_SCHED __builtin_amdgcn_sched_barrier(0)
    Unit cur, nxt; int ui = 0;
    if (!S.next(0, cur)) return;
    f32x4 acc[2][2][4][2];
#pragma unroll
    for (int a = 0; a < 2; ++a)
#pragma unroll
        for (int b = 0; b < 2; ++b)
#pragma unroll
            for (int m = 0; m < 4; ++m)
#pragma unroll
                for (int n = 0; n < 2; ++n) acc[a][b][m][n] = (f32x4){0.f, 0.f, 0.f, 0.f};
    bf16x8 At[4][2], B0[2][2], B1[2][2];
    const char* cA = (const char*)g.A + (size_t)cur.pm * tstep; const char* cB = (const char*)g.Bt + (size_t)cur.pn * tstep;
    S.a_ready(cur);
    if constexpr (SP2) {
        PG8_STAGE(PG8_SB(0, 0), cB, voffB); PG8_STAGE(PG8_SB(0, 1), cB + hstep, voffB); PG8_STAGE(PG8_SA(0, 0), cA, voffA); PG8_STAGE(PG8_SA(0, 1), cA + hstep, voffA);
        if (wr == 1) PG8_BAR;
        PG8_WAIT_V(2); PG8_BAR;
        PG8_STAGE(PG8_SB(1, 0), cB + kstep, voffB); PG8_STAGE(PG8_SA(1, 0), cA + kstep, voffA); PG8_STAGE(PG8_SB(1, 1), cB + hstep + kstep, voffB);
        PG8_WAIT_V(6); PG8_BAR;
    } else {
        PG8_STAGE(PG8_SB(0, 0), cB, voffB); PG8_STAGE(PG8_SA(0, 0), cA, voffA); PG8_STAGE(PG8_SB(0, 1), cB + hstep, voffB); PG8_STAGE(PG8_SA(0, 1), cA + hstep, voffA);
        if (wr == 1) PG8_BAR;
        PG8_WAIT_V(4); PG8_BAR;
        PG8_STAGE(PG8_SB(1, 0), cB + kstep, voffB); PG8_STAGE(PG8_SA(1, 0), cA + kstep, voffA); PG8_STAGE(PG8_SB(1, 1), cB + hstep + kstep, voffB);
        PG8_WAIT_V(6); PG8_BAR;
    }
    for (;;) {
        const bool has_next = S.next(ui + 1, nxt);
        const char* nA = has_next ? (const char*)g.A + (size_t)nxt.pm * tstep : cA; const char* nB = has_next ? (const char*)g.Bt + (size_t)nxt.pn * tstep : cB;
        for (int t = 0; t < nt; t += 2) {
            const bool last = (t == nt - 2);
            const char* a1 = cA + (size_t)(t + 1) * kstep;
            const char* a2 = last ? nA : cA + (size_t)(t + 2) * kstep; const char* b2 = last ? nB : cB + (size_t)(t + 2) * kstep;
            const char* a3 = a2 + kstep; const char* b3 = b2 + kstep;
            if (last && has_next) S.a_ready(nxt);
            if constexpr (SP2) {
            PG8_LDB(B0, 0, 0); PG8_LDB(B1, 0, 1); PG8_SCHED; PG8_LDA(At, 0, 0); PG8_STAGE(PG8_SA(1, 1), a1 + hstep, voffA);
            PG8_WAIT_V(8); PG8_WAIT_L(0); PG8_BAR; PG8_MMA(0, 0, At, B0); PG8_MMA(0, 1, At, B1); PG8_BAR; PG8_SCHED;
            PG8_LDA(At, 0, 1); PG8_STAGE(PG8_SB(0, 0), b2, voffB); PG8_STAGE(PG8_SB(0, 1), b2 + hstep, voffB); PG8_STAGE(PG8_SA(0, 0), a2, voffA);
            PG8_WAIT_V(8); PG8_WAIT_L(0); PG8_BAR; PG8_MMA(1, 0, At, B0); PG8_MMA(1, 1, At, B1); PG8_BAR; PG8_SCHED;
            PG8_LDB(B0, 1, 0); PG8_LDB(B1, 1, 1); PG8_SCHED; PG8_LDA(At, 1, 0); PG8_STAGE(PG8_SA(0, 1), a2 + hstep, voffA);
            PG8_WAIT_V(8); PG8_WAIT_L(0); PG8_BAR; PG8_MMA(0, 0, At, B0); PG8_MMA(0, 1, At, B1); PG8_BAR; PG8_SCHED;
            PG8_LDA(At, 1, 1); PG8_STAGE(PG8_SB(1, 0), b3, voffB); PG8_STAGE(PG8_SB(1, 1), b3 + hstep, voffB); PG8_STAGE(PG8_SA(1, 0), a3, voffA);
            PG8_WAIT_V(8); PG8_WAIT_L(0); PG8_BAR; PG8_MMA(1, 0, At, B0); PG8_MMA(1, 1, At, B1); PG8_BAR; PG8_SCHED;
            } else {
            PG8_LDB(B0, 0, 0); PG8_SCHED; PG8_LDA(At, 0, 0); PG8_STAGE(PG8_SA(1, 1), a1 + hstep, voffA);
            PG8_WAIT_L(8); PG8_BAR; PG8_WAIT_L(0); PG8_MMA(0, 0, At, B0); PG8_BAR; PG8_SCHED;
            PG8_LDB(B1, 0, 1); PG8_STAGE(PG8_SB(0, 0), b2, voffB);
            PG8_BAR; PG8_WAIT_L(0); PG8_MMA(0, 1, At, B1); PG8_BAR;
            PG8_LDA(At, 0, 1); PG8_STAGE(PG8_SA(0, 0), a2, voffA);
            PG8_BAR; PG8_WAIT_L(0); PG8_MMA(1, 0, At, B0); PG8_BAR; PG8_SCHED;
            PG8_STAGE(PG8_SB(0, 1), b2 + hstep, voffB);
            PG8_WAIT_V(6); PG8_BAR; PG8_MMA(1, 1, At, B1); PG8_BAR;
            PG8_LDB(B0, 1, 0); PG8_SCHED; PG8_LDA(At, 1, 0); PG8_STAGE(PG8_SA(0, 1), a2 + hstep, voffA);
            PG8_WAIT_L(8); PG8_BAR; PG8_WAIT_L(0); PG8_MMA(0, 0, At, B0); PG8_BAR; PG8_SCHED;
            PG8_LDB(B1, 1, 1); PG8_STAGE(PG8_SB(1, 0), b3, voffB);
            PG8_BAR; PG8_WAIT_L(0); PG8_MMA(0, 1, At, B1); PG8_BAR;
            PG8_LDA(At, 1, 1); PG8_STAGE(PG8_SA(1, 0), a3, voffA);
            PG8_BAR; PG8_WAIT_L(0); PG8_MMA(1, 0, At, B0); PG8_BAR; PG8_SCHED;
            PG8_STAGE(PG8_SB(1, 1), b3 + hstep, voffB);
            PG8_WAIT_V(6); PG8_BAR; PG8_MMA(1, 1, At, B1); PG8_BAR;
            }
        }
        if constexpr (ALIGN_EPI) { if (wr == 0) PG8_BAR; }
        if constexpr (!Epi::AFTER_DRAIN) { E(acc, cur, wr, wc, fr, fq); S.done(cur); }
        if (!has_next) break;
#pragma unroll
        for (int a = 0; a < 2; ++a)
#pragma unroll
            for (int b = 0; b < 2; ++b)
#pragma unroll
                for (int m = 0; m < 4; ++m)
#pragma unroll
                    for (int n = 0; n < 2; ++n) acc[a][b][m][n] = (f32x4){0.f, 0.f, 0.f, 0.f};
        cur = nxt; cA = nA; cB = nB; ++ui;
        if constexpr (ALIGN_EPI) { if (wr == 1) PG8_BAR; }
    }
    PG8_WAIT_V(0);
    if constexpr (!ALIGN_EPI) { if (wr == 0) PG8_BAR; }
    PG8_BAR;
    if constexpr (Epi::AFTER_DRAIN) { E.fused(acc, cur, wr, wc, fr, fq, lds, wid, lane); S.done(cur); }
#undef PG8_SA
#undef PG8_SB
#undef PG8_STAGE
#undef PG8_LDA
#undef PG8_LDB
#undef PG8_MMA
#undef PG8_WAIT_V
#undef PG8_WAIT_L
#undef PG8_BAR
#undef PG8_SCHED
}
}

#ifndef PG8_SP2
#define PG8_SP2 true
#endif
#ifndef PG8_ALIGN
#define PG8_ALIGN true
#endif
#define GAS __attribute__((address_space(1)))
#define LAS __attribute__((address_space(3)))
typedef unsigned short bf16;
typedef unsigned v4u __attribute__((ext_vector_type(4)));
typedef float f32x4 __attribute__((ext_vector_type(4)));
typedef short bf16x8 __attribute__((ext_vector_type(8)));
typedef GAS unsigned gu32;
typedef GAS unsigned long long gu64;
#define RLX_AGENT __ATOMIC_RELAXED, __HIP_MEMORY_SCOPE_AGENT
#define LDS_WAIT() asm volatile("s_waitcnt lgkmcnt(0)" ::: "memory")
#define VM_WAIT() asm volatile("s_waitcnt vmcnt(0)" ::: "memory")
__device__ __forceinline__ unsigned long long rt() { return __builtin_amdgcn_s_memrealtime(); }
__device__ __forceinline__ unsigned f2bf(float f) { unsigned u = __builtin_bit_cast(unsigned, f); return (u + 0x7fffu + ((u >> 16) & 1u)) >> 16; }
__device__ __forceinline__ unsigned pk2(float lo, float hi) { return f2bf(lo) | (f2bf(hi) << 16); }

#define XB_TMO      128
#define XB_XCNT(j)  (256  + 64 * (j))
#define XB_XSUB(j)  (1280 + 64 * (j))
#define XB_XGEN(j)  (2304 + 64 * (j))
#define XB_TOP      3328
#define XB_TOPGEN   3392
#define XCD_BAR_WORDS 3456
#define XB_SPIN_CAP (1u << 18)

__device__ __forceinline__ unsigned xb_ld(unsigned* p)              { return __hip_atomic_load(p, __ATOMIC_RELAXED, __HIP_MEMORY_SCOPE_AGENT); }
__device__ __forceinline__ unsigned xb_add(unsigned* p, unsigned v) { return __hip_atomic_fetch_add(p, v, __ATOMIC_RELAXED, __HIP_MEMORY_SCOPE_AGENT); }
__device__ __forceinline__ unsigned xb_xcc_id() { return (unsigned)__builtin_amdgcn_s_getreg((3 << 11) | 20) & 0xFu; }
#define XB_SPIN(cond, bar) do { unsigned _sp = 0; while (cond) { __builtin_amdgcn_s_sleep(1); \
    if ((++_sp & 255u) == 0u) { if (xb_ld(&(bar)[XB_TMO])) break; if (_sp > XB_SPIN_CAP) { atomicAdd(&(bar)[XB_TMO], 1u); break; } } } } while (0)

struct XcdBarrier {
    unsigned* bar; unsigned x;
    volatile LAS unsigned* st;
};

__device__ __forceinline__ XcdBarrier xcd_barrier_post(unsigned* bar, volatile LAS unsigned* st) {
    XcdBarrier b; b.bar = bar; b.x = xb_xcc_id(); b.st = st;
    if (threadIdx.x == 0) (void)xb_add(&bar[XB_XCNT(b.x)], 1u);
    return b;
}
__device__ __forceinline__ void xcd_barrier_complete(unsigned* bar, unsigned x, unsigned& nloc, unsigned& nx) {
    const unsigned G = gridDim.x * gridDim.y * gridDim.z;
    unsigned sum, cnt, mine, sp = 0u;
    for (;;) {
        sum = 0u; cnt = 0u; mine = 0u;
#pragma unroll
        for (unsigned j = 0; j < 16; ++j) { const unsigned c = xb_ld(&bar[XB_XCNT(j)]); sum += c; cnt += (c > 0u) ? 1u : 0u; mine = (j == x) ? c : mine; }
        if (sum == G) break;
        __builtin_amdgcn_s_sleep(1);
        if ((++sp & 255u) == 0u) { if (xb_ld(&bar[XB_TMO])) break; if (sp > XB_SPIN_CAP) { atomicAdd(&bar[XB_TMO], 1u); break; } }
    }
    nloc = mine > 0u ? mine : 1u; nx = cnt > 0u ? cnt : 1u;
}

__device__ __forceinline__ void xcd_barrier(const XcdBarrier& b) {
    asm volatile("s_waitcnt vmcnt(0)" ::: "memory");
    __syncthreads();
    if (threadIdx.x == 0) {
        unsigned* bar = b.bar;
        __builtin_amdgcn_s_waitcnt(0);
        unsigned nloc = b.st[0], nx = b.st[1];
        if (nloc == 0u) { xcd_barrier_complete(bar, b.x, nloc, nx); b.st[0] = nloc; b.st[1] = nx; }
        const unsigned old = xb_add(&bar[XB_XSUB(b.x)], 1u);
        const unsigned gen = old / nloc;
        if (old + 1u == (gen + 1u) * nloc) {
            __builtin_amdgcn_fence(__ATOMIC_RELEASE, "agent");
            asm volatile("s_waitcnt vmcnt(0)" ::: "memory");
            const unsigned og = xb_add(&bar[XB_TOP], 1u);
            const unsigned tg = og / nx;
            if (og + 1u == (tg + 1u) * nx) xb_add(&bar[XB_TOPGEN], 1u);
            else XB_SPIN(xb_ld(&bar[XB_TOPGEN]) == tg, bar);
            __builtin_amdgcn_fence(__ATOMIC_ACQUIRE, "agent");
            xb_add(&bar[XB_XGEN(b.x)], 1u);
            asm volatile("s_waitcnt vmcnt(0)" ::: "memory");
        } else {
            XB_SPIN(xb_ld(&bar[XB_XGEN(b.x)]) == gen, bar);
            __builtin_amdgcn_fence(__ATOMIC_ACQUIRE, "agent");
            asm volatile("s_waitcnt vmcnt(0)" ::: "memory");
        }
    }
    __syncthreads();
}


constexpr int NWAVES = 8;
constexpr int DM = 2048, BATCH = 4, SEQ = 4096, M = BATCH * SEQ;
constexpr int NIN = 6176, NINP = 6400;
constexpr int O_GQ = 0, O_GK = 512, O_GV = 1024, O_GR = 2048, O_GDF = 3072, O_GDB = 3088, O_AQ = 3104, O_AK = 4128, O_AV = 5152;
constexpr float EPS = 1e-6f;
constexpr int PEER_K = 128;

constexpr size_t MiB = 1u << 20;
constexpr size_t WS_CTL = 0, CTL_ZERO_BYTES = 1 * MiB;
constexpr size_t WS_WIN = 1 * MiB;
constexpr size_t WS_WOUT = 26 * MiB;
constexpr size_t WS_WQ = 34 * MiB;
constexpr size_t WS_SSQ = 42 * MiB;
constexpr size_t WS_EIDX = 44 * MiB;
constexpr size_t WS_GATE = 52 * MiB;
constexpr size_t WS_SKB = 60 * MiB;
constexpr size_t WS_XN = 64 * MiB;
constexpr size_t WS_PROJ = 128 * MiB;
constexpr size_t WS_HB = 256 * MiB;
constexpr size_t WS_OF = 328 * MiB;
constexpr size_t WS_OB = 360 * MiB;
constexpr size_t WS_ATT = 392 * MiB;
constexpr size_t WS_ATTP = 392 * MiB;
constexpr size_t WS_ATTML = 488 * MiB;
constexpr size_t WS_GT_QD = 64 * MiB;
constexpr size_t WS_GT_KE = 96 * MiB;
constexpr size_t OUT_GT_AM = 0;
constexpr size_t OUT_GT_DEC = 16 * MiB;
constexpr size_t OUT_GT_VT = 32 * MiB;
constexpr int CW_ATTQ = 64;
constexpr size_t WS_END = 494 * MiB;
constexpr size_t WS_U8 = 128 * MiB;
constexpr size_t WS_V8 = 160 * MiB;
constexpr size_t WS_SU = 192 * MiB;
constexpr size_t WS_SV = 193 * MiB;
constexpr int PEER_E = 16384, PEER_EC = 512, PEER_NCH = PEER_E / PEER_EC;
constexpr int CW_TMO = 0, CW_CODE = 1, CW_BAR = 4096;

constexpr int RING_OFF = 0, RING_BYTES = 131072;
constexpr int LDS_BYTES = 163840;
constexpr int LDSCTL_OFF = LDS_BYTES - 1024, MISC_OFF = LDSCTL_OFF + 320;

typedef float f32x2 __attribute__((ext_vector_type(2)));
__device__ __forceinline__ float bf2f(unsigned short h) { return __builtin_bit_cast(float, (unsigned)h << 16); }
__device__ __forceinline__ float bflo(unsigned w) { return __builtin_bit_cast(float, w << 16); }
__device__ __forceinline__ float bfhi(unsigned w) { return __builtin_bit_cast(float, w & 0xffff0000u); }
__device__ __forceinline__ float wave_sum(float v) {
#pragma unroll
    for (int o = 1; o < 64; o <<= 1) v += __shfl_xor(v, o);
    return v;
}
__device__ __forceinline__ float wave_max(float v) {
#pragma unroll
    for (int o = 1; o < 64; o <<= 1) v = fmaxf(v, __shfl_xor(v, o));
    return v;
}

template <class T> __device__ __forceinline__ T* opaque(T* p) { asm volatile("" : "+s"(p)); return p; }
__device__ __forceinline__ int opaque_v(int x) { asm volatile("" : "+v"(x)); return x; }
template <class T> __device__ __forceinline__ T ldu(const void* ubase, unsigned voff) { return *(const T*)((const char*)ubase + voff); }
template <class T> __device__ __forceinline__ void stu(void* ubase, unsigned voff, T v) { *(T*)((char*)ubase + voff) = v; }
namespace pg8 {
struct EpiRes {
    static constexpr bool PERM = false, AFTER_DRAIN = false;
    const float* x; float* H; bf16_t* HB; float* ssq; int ldc;
    __device__ __forceinline__ void operator()(const f32x4 (&acc)[2][2][4][2], const Unit& u, int wr, int wc, int fr, int fq) const {
        const int col0 = u.pn * BM + wc * 32 + 4 * fq;
#pragma unroll
        for (int ai = 0; ai < 2; ++ai)
#pragma unroll
            for (int m = 0; m < 4; ++m) {
                const int r = u.pm * BM + ai * HALF + wr * 64 + m * 16 + fr; const size_t off = (size_t)r * ldc + col0; float s = 0.f;
#pragma unroll
                for (int bj = 0; bj < 2; ++bj)
#pragma unroll
                    for (int n = 0; n < 2; ++n) {
                        const f32x4 xv = *(const f32x4*)(x + off + bj * HALF + n * 16);
                        const f32x4 hv = xv + acc[ai][bj][m][n];
                        *(f32x4*)(H + off + bj * HALF + n * 16) = hv;
                        s += (hv[0] * hv[0] + hv[1] * hv[1]) + (hv[2] * hv[2] + hv[3] * hv[3]);
                        unsigned long long w = (unsigned long long)cvt_pk_bf16(hv[0], hv[1]) | ((unsigned long long)cvt_pk_bf16(hv[2], hv[3]) << 32);
                        *(unsigned long long*)(HB + off + bj * HALF + n * 16) = w;
                    }
                s += __shfl_xor(s, 16); s += __shfl_xor(s, 32);
                if (fq == 0) ssq[(size_t)r * 32 + u.pn * 4 + wc] = s;
            }
    }
};
struct EpiRowScale {
    static constexpr bool PERM = true, AFTER_DRAIN = false;
    bf16_t* O; int ldc; const float* ssq; float inv_n, eps;
    __device__ __forceinline__ void operator()(const f32x4 (&acc)[2][2][4][2], const Unit& u, int wr, int wc, int fr, int fq) const {
        const int col0 = u.pn * BM + wc * 32 + 8 * fq;
#pragma unroll
        for (int ai = 0; ai < 2; ++ai)
#pragma unroll
            for (int m = 0; m < 4; ++m) {
                const int r = u.pm * BM + ai * HALF + wr * 64 + m * 16 + fr;
                const f32x4* sp = (const f32x4*)(ssq + (size_t)r * 32); float s = 0.f;
#pragma unroll
                for (int i = 0; i < 8; ++i) { const f32x4 t = sp[i]; s += (t[0] + t[1]) + (t[2] + t[3]); }
                const float sc = 1.0f / sqrtf(s * inv_n + eps);
                bf16_t* rowp = O + (size_t)r * ldc + col0;
#pragma unroll
                for (int bj = 0; bj < 2; ++bj) { const f32x4 v0 = acc[ai][bj][m][0] * sc, v1 = acc[ai][bj][m][1] * sc;
                    u32x4 w; w.x = cvt_pk_bf16(v0[0], v0[1]); w.y = cvt_pk_bf16(v0[2], v0[3]); w.z = cvt_pk_bf16(v1[0], v1[1]); w.w = cvt_pk_bf16(v1[2], v1[3]);
                    *(u32x4*)(rowp + bj * HALF) = w; }
            }
    }
};
}

struct Frame {
    LAS unsigned char* lds;
    volatile LAS unsigned* MISC;
    gu32* ctl;
    int tid, lane, wave;
    int vcu, G;
};

__device__ __forceinline__ void p0_transpose_item(const float* W, int K, int ldw, const float* gk, bf16* WT, LAS float* scr, int item, int lane) {
    const int nblk = ldw / 32, kb = item / nblk, nb = item % nblk, k0 = 64 * kb, n0 = 32 * nb;
#pragma unroll 8
    for (int i = 0; i < 32; ++i) { const int kk = 2 * i + (lane >> 5); float w = W[(size_t)(k0 + kk) * ldw + n0 + (lane & 31)]; if (gk) w *= gk[k0 + kk]; scr[kk * 33 + (lane & 31)] = w; }
    LDS_WAIT(); asm volatile("" ::: "memory");
    const int c = lane & 7;
#pragma unroll
    for (int j = 0; j < 4; ++j) { const int n = (lane >> 3) + 8 * j; const LAS float* s = scr + (8 * c) * 33 + n;
        v4u o; o.x = pk2(s[0 * 33], s[1 * 33]); o.y = pk2(s[2 * 33], s[3 * 33]); o.z = pk2(s[4 * 33], s[5 * 33]); o.w = pk2(s[6 * 33], s[7 * 33]);
        *(GAS v4u*)(WT + (size_t)(n0 + n) * K + k0 + 8 * c) = o; }
    LDS_WAIT(); asm volatile("" ::: "memory");
}
__device__ __forceinline__ void rms_row_to_bf16(int lane, const float* xrow, const float* g, bf16* orow) {
    const GAS f32x4* xr = (const GAS f32x4*)xrow + lane; const GAS f32x4* gr = (const GAS f32x4*)g + lane;
    f32x4 v[8]; float s = 0.f;
#pragma unroll
    for (int j = 0; j < 8; ++j) { v[j] = xr[64 * j]; s += (v[j].x * v[j].x + v[j].y * v[j].y) + (v[j].z * v[j].z + v[j].w * v[j].w); }
    const float rstd = 1.f / sqrtf(wave_sum(s) * (1.f / DM) + EPS);
    GAS unsigned long long* o8 = (GAS unsigned long long*)orow + lane;
#pragma unroll
    for (int j = 0; j < 8; ++j) { const f32x4 gg = gr[64 * j];
        o8[64 * j] = (unsigned long long)pk2(v[j].x * rstd * gg.x, v[j].y * rstd * gg.y) | ((unsigned long long)pk2(v[j].z * rstd * gg.z, v[j].w * rstd * gg.w) << 32); }
}

struct Args {
    const float* in[16]; float* out; unsigned char* ws; int ph_lo, ph_hi, li, pad;
};

__device__ __forceinline__ void p0_prologue(Frame& F, const Args& a) {
    unsigned char* ws = a.ws;
    LAS float* scr = (LAS float*)(F.lds + RING_OFF + F.wave * 16384);
    const int gw = F.vcu * NWAVES + F.wave, NGW = F.G * NWAVES;
    bf16* Win_t = (bf16*)(ws + WS_WIN); bf16* Wout_t = (bf16*)(ws + WS_WOUT); bf16* Wq_t = (bf16*)(ws + WS_WQ); bf16* XN = (bf16*)(ws + WS_XN);
    constexpr int I_IN = (DM / 64) * (NIN / 32), I_SQ = (DM / 64) * (DM / 32);
    constexpr int NITEMS = I_IN + 2 * I_SQ;
    for (int it = gw; it < NITEMS; it += NGW) {
        int r = it;
        if (r < I_IN) { p0_transpose_item(a.in[2], DM, NIN, nullptr, Win_t, scr, r, F.lane); continue; } r -= I_IN;
        if (r < I_SQ) { p0_transpose_item(a.in[9], DM, DM, nullptr, Wout_t, scr, r, F.lane); continue; } r -= I_SQ;
        p0_transpose_item(a.in[11], DM, DM, a.in[10], Wq_t, scr, r, F.lane);
    }
    { GAS v4u* z = (GAS v4u*)(Win_t + (size_t)NIN * DM); const int n16 = (NINP - NIN) * DM * 2 / 16;
      for (int i = (gw * 64 + F.lane); i < n16; i += NGW * 64) z[i] = (v4u){0u, 0u, 0u, 0u}; }
    { const f32x4* sk = (const f32x4*)a.in[12]; unsigned long long* skb = (unsigned long long*)(ws + WS_SKB);
      for (int i = gw * 64 + F.lane; i < 8 * 2 * 128 * 128 / 4; i += NGW * 64) { const f32x4 v = sk[i]; skb[i] = (unsigned long long)pk2(v.x, v.y) | ((unsigned long long)pk2(v.z, v.w) << 32); } }
    for (int m = gw; m < M; m += NGW) rms_row_to_bf16(F.lane, a.in[0] + (size_t)m * DM, a.in[1], XN + (size_t)m * DM);
}

__device__ __forceinline__ void p3_finalize(Frame& F, const Args& a) {
    unsigned char* ws = a.ws;
    const int gw = F.vcu * NWAVES + F.wave, NGW = F.G * NWAVES, lane = F.lane;
    const bf16* OFp = (const bf16*)(ws + WS_OF); const bf16* OBp = (const bf16*)(ws + WS_OB);
    const bf16* PROJ = (const bf16*)(ws + WS_PROJ); bf16* Y = (bf16*)(ws + WS_XN);
    const float* gla_g = a.in[7]; const float* att_g = a.in[8];
    const f32x4 gg = *(const f32x4*)(gla_g + 4 * lane);
    for (int m = gw; m < M; m += NGW) {
#pragma unroll
        for (int hh = 0; hh < 4; ++hh) {
            const unsigned long long wf = *(const unsigned long long*)(OFp + (size_t)m * 1024 + hh * 256 + 4 * lane);
            const unsigned long long wb = *(const unsigned long long*)(OBp + (size_t)m * 1024 + hh * 256 + 4 * lane);
            const f32x4 o = (f32x4){bflo((unsigned)wf) + bflo((unsigned)wb), bfhi((unsigned)wf) + bfhi((unsigned)wb), bflo((unsigned)(wf >> 32)) + bflo((unsigned)(wb >> 32)), bfhi((unsigned)(wf >> 32)) + bfhi((unsigned)(wb >> 32))};
            const float ss = wave_sum((o.x * o.x + o.y * o.y) + (o.z * o.z + o.w * o.w));
            const float rstd = 1.f / sqrtf(ss * (1.f / 256.f) + EPS);
            const unsigned long long gr = *(const unsigned long long*)(PROJ + (size_t)m * NINP + O_GR + hh * 256 + 4 * lane);
            const float r0 = bflo((unsigned)gr), r1 = bfhi((unsigned)gr), r2 = bflo((unsigned)(gr >> 32)), r3 = bfhi((unsigned)(gr >> 32));
            const float y0 = o.x * rstd * gg.x * (r0 / (1.f + __expf(-r0))), y1 = o.y * rstd * gg.y * (r1 / (1.f + __expf(-r1)));
            const float y2 = o.z * rstd * gg.z * (r2 / (1.f + __expf(-r2))), y3 = o.w * rstd * gg.w * (r3 / (1.f + __expf(-r3)));
            *(unsigned long long*)(Y + (size_t)m * DM + hh * 256 + 4 * lane) = (unsigned long long)pk2(y0, y1) | ((unsigned long long)pk2(y2, y3) << 32);
        }
        float av[16]; float ss = 0.f;
#pragma unroll
        for (int p = 0; p < 2; ++p) { const int col = p * 512 + 8 * lane, hd = col >> 6; float mm[3], ll[3]; v4u ow[3];
#pragma unroll
            for (int pt = 0; pt < 3; ++pt) { const size_t rec = ((size_t)pt * M + m) * 16 + hd; const f32x2 ml2 = *(const f32x2*)((const float*)(ws + WS_ATTML) + rec * 2); mm[pt] = ml2.x; ll[pt] = ml2.y;
                ow[pt] = *(const v4u*)((const bf16*)(ws + WS_ATTP) + rec * 64 + (col & 63)); }
            const float mt = fmaxf(fmaxf(mm[0], mm[1]), mm[2]); const float w0 = __expf(mm[0] - mt), w1 = __expf(mm[1] - mt), w2 = __expf(mm[2] - mt);
            const float inv = 1.f / (w0 * ll[0] + w1 * ll[1] + w2 * ll[2]);
            av[p * 8 + 0] = (w0 * bflo(ow[0].x) + w1 * bflo(ow[1].x) + w2 * bflo(ow[2].x)) * inv; av[p * 8 + 1] = (w0 * bfhi(ow[0].x) + w1 * bfhi(ow[1].x) + w2 * bfhi(ow[2].x)) * inv;
            av[p * 8 + 2] = (w0 * bflo(ow[0].y) + w1 * bflo(ow[1].y) + w2 * bflo(ow[2].y)) * inv; av[p * 8 + 3] = (w0 * bfhi(ow[0].y) + w1 * bfhi(ow[1].y) + w2 * bfhi(ow[2].y)) * inv;
            av[p * 8 + 4] = (w0 * bflo(ow[0].z) + w1 * bflo(ow[1].z) + w2 * bflo(ow[2].z)) * inv; av[p * 8 + 5] = (w0 * bfhi(ow[0].z) + w1 * bfhi(ow[1].z) + w2 * bfhi(ow[2].z)) * inv;
            av[p * 8 + 6] = (w0 * bflo(ow[0].w) + w1 * bflo(ow[1].w) + w2 * bflo(ow[2].w)) * inv; av[p * 8 + 7] = (w0 * bfhi(ow[0].w) + w1 * bfhi(ow[1].w) + w2 * bfhi(ow[2].w)) * inv; }
#pragma unroll
        for (int i = 0; i < 16; ++i) ss += av[i] * av[i];
        const float rstd = 1.f / sqrtf(wave_sum(ss) * (1.f / 1024.f) + EPS);
#pragma unroll
        for (int p = 0; p < 2; ++p) { const f32x4 g0 = *(const f32x4*)(att_g + p * 512 + 8 * lane), g1 = *(const f32x4*)(att_g + p * 512 + 8 * lane + 4);
            v4u w; w.x = pk2(av[p * 8 + 0] * rstd * g0.x, av[p * 8 + 1] * rstd * g0.y); w.y = pk2(av[p * 8 + 2] * rstd * g0.z, av[p * 8 + 3] * rstd * g0.w);
            w.z = pk2(av[p * 8 + 4] * rstd * g1.x, av[p * 8 + 5] * rstd * g1.y); w.w = pk2(av[p * 8 + 6] * rstd * g1.z, av[p * 8 + 7] * rstd * g1.w);
            *(v4u*)(Y + (size_t)m * DM + 1024 + p * 512 + 8 * lane) = w; }
    }
}


__device__ __forceinline__ void naive_gla_phase(Frame& F, const Args& a) {
    unsigned char* ws = a.ws; const bf16* PROJ = (const bf16*)(ws + WS_PROJ);
    const int half = F.tid >> 8, tid = F.tid & 255, e = tid & 15, dg = tid >> 4, d0 = dg * 8;
    LAS float* sm = (LAS float*)(F.lds + RING_OFF + half * 32768);
    LAS float* qs = sm; LAS float* ks = sm + 2048; LAS float* as_ = sm + 4096; LAS float* gds = sm + 6144; LAS float* vs = sm + 6400; LAS float* psum = sm + 6656;
    for (int ui = F.vcu; ui < 256; ui += F.G) {
        const int unit = ui * 2 + half;
        const int e0 = (unit & 15) * 16, h = (unit >> 4) & 3, b = (unit >> 6) & 3, dir = unit >> 8;
        const float* up = dir ? a.in[5] : a.in[3]; const float* bias = dir ? a.in[6] : a.in[4]; float* Out = (float*)(ws + (dir ? WS_OB : WS_OF));
        float S[8];
#pragma unroll
        for (int j = 0; j < 8; ++j) S[j] = 0.f;
        for (int t0 = 0; t0 < SEQ; t0 += 16) {
            for (int idx = tid; idx < 16 * 128; idx += 256) { const int i = idx >> 7, d = idx & 127; const int t = dir ? (SEQ - 1 - (t0 + i)) : (t0 + i); const size_t row = (size_t)b * SEQ + t;
                qs[i * 128 + d] = bf2f(PROJ[row * NINP + O_GQ + h * 128 + d]) * 0.08838834764831845f; ks[i * 128 + d] = bf2f(PROJ[row * NINP + O_GK + h * 128 + d]); }
            { const int i = tid >> 4, r = tid & 15; const int t = dir ? (SEQ - 1 - (t0 + i)) : (t0 + i); const size_t row = (size_t)b * SEQ + t;
              gds[i * 16 + r] = bf2f(PROJ[row * NINP + O_GDF + dir * 16 + r]); vs[i * 16 + r] = bf2f(PROJ[row * NINP + O_GV + h * 256 + e0 + r]); }
            __syncthreads();
            for (int idx = tid; idx < 16 * 128; idx += 256) { const int i = idx >> 7, d = idx & 127; float z = bias[h * 128 + d];
#pragma unroll
                for (int r = 0; r < 16; ++r) z += gds[i * 16 + r] * up[r * 512 + h * 128 + d];
                const float ls = fminf(z, 0.f) - log1pf(expf(-fabsf(z))); as_[i * 128 + d] = expf(ls * (1.f / 16.f)); }
            __syncthreads();
            for (int i = 0; i < 16; ++i) { const float v = vs[i * 16 + e]; float p = 0.f;
#pragma unroll
                for (int j = 0; j < 8; ++j) { S[j] = as_[i * 128 + d0 + j] * S[j] + ks[i * 128 + d0 + j] * v; p += qs[i * 128 + d0 + j] * S[j]; }
                p += __shfl_xor(p, 16); p += __shfl_xor(p, 32);
                if ((tid & 63) < 16) psum[(i * 4 + (tid >> 6)) * 16 + e] = p; }
            __syncthreads();
            { const int i = tid >> 4, ee = tid & 15; const int t = dir ? (SEQ - 1 - (t0 + i)) : (t0 + i); const size_t row = (size_t)b * SEQ + t;
              Out[row * 1024 + h * 256 + e0 + ee] = (psum[(i * 4 + 0) * 16 + ee] + psum[(i * 4 + 1) * 16 + ee]) + (psum[(i * 4 + 2) * 16 + ee] + psum[(i * 4 + 3) * 16 + ee]); }
        }
        __syncthreads();
    }
}

__device__ __forceinline__ void naive_attn_phase(Frame& F, const Args& a) {
    unsigned char* ws = a.ws; const bf16* PROJ = (const bf16*)(ws + WS_PROJ); bf16* ATT = (bf16*)(ws + WS_ATT);
    for (int gid2 = F.vcu * 512 + F.tid; gid2 < M * 32; gid2 += F.G * 512) {
        const int hf = gid2 & 1, gid = gid2 >> 1;
        const int h = gid & 15, row = gid >> 4, b = row >> 12, t = row & (SEQ - 1);
        float q[32], o[32];
        const bf16* qp = PROJ + (size_t)row * NINP + O_AQ + h * 64 + hf * 32;
#pragma unroll
        for (int i = 0; i < 32; ++i) { q[i] = bf2f(qp[i]) * 0.125f; o[i] = 0.f; }
        const float slope = exp2f(-0.5f * (float)(h + 1));
        float m = -1e30f, l = 0.f;
        for (int p = 0; p < 3; ++p) { const int dil = (p == 0) ? 1 : (p == 1 ? 4 : 16);
            for (int j = -64; j <= 64; ++j) { const int tk = t + j * dil; if (tk < 0 || tk >= SEQ) continue;
                const bf16* kp = PROJ + ((size_t)b * SEQ + tk) * NINP + O_AK + h * 64 + hf * 32; const bf16* vp = kp + (O_AV - O_AK);
                float s = 0.f;
#pragma unroll
                for (int i = 0; i < 32; ++i) s += q[i] * bf2f(kp[i]);
                s += __shfl_xor(s, 1);
                s -= slope * (float)((j < 0 ? -j : j) * dil);
                const float mn = fmaxf(m, s), sc = __expf(m - mn), pe = __expf(s - mn); l = l * sc + pe; m = mn;
#pragma unroll
                for (int i = 0; i < 32; ++i) o[i] = o[i] * sc + pe * bf2f(vp[i]); } }
        const float il = 1.f / l; bf16* op = ATT + (size_t)row * 1024 + h * 64 + hf * 32;
#pragma unroll
        for (int i = 0; i < 32; ++i) op[i] = (bf16)f2bf(o[i] * il);
    }
}

__device__ __forceinline__ void wave_argmax(float& v, int& idx) {
#pragma unroll
    for (int o = 1; o < 64; o <<= 1) { const float ov = __shfl_xor(v, o); const int oi = __shfl_xor(idx, o); if (ov > v || (ov == v && oi < idx)) { v = ov; idx = oi; } }
}
__device__ __forceinline__ void naive_topk_phase(Frame& F, const Args& a) {
    unsigned char* ws = a.ws; const bf16* QP = (const bf16*)(ws + WS_XN); const float* subk = a.in[12]; int* EIDX = (int*)(ws + WS_EIDX); float* GATE = (float*)(ws + WS_GATE);
    LAS float* qsh = (LAS float*)(F.lds + RING_OFF + F.wave * 4096);
    LAS int* sid = (LAS int*)(qsh + 256);
    LAS float* sgt = (LAS float*)(qsh + 384);
    const int lane = F.lane;
    for (int row = F.vcu * NWAVES + F.wave; row < M; row += F.G * NWAVES) {
        for (int h = 0; h < 8; ++h) {
            const bf16* qp = QP + (size_t)row * DM + h * 256;
#pragma unroll
            for (int i = 0; i < 4; ++i) qsh[lane + 64 * i] = bf2f(qp[lane + 64 * i]);
            LDS_WAIT(); asm volatile("" ::: "memory");
            float tv[2]; int ti[2];
#pragma unroll
            for (int c = 0; c < 2; ++c) {
                const float* k0 = subk + (((size_t)h * 2 + c) * 128 + lane) * 128; const float* k1 = k0 + 64 * 128;
                float av = 0.f, bsc = 0.f;
#pragma unroll 4
                for (int d = 0; d < 128; d += 4) { const f32x4 x0 = *(const f32x4*)(k0 + d), x1 = *(const f32x4*)(k1 + d); const float q0 = qsh[c * 128 + d], q1 = qsh[c * 128 + d + 1], q2 = qsh[c * 128 + d + 2], q3 = qsh[c * 128 + d + 3];
                    av += q0 * x0.x + q1 * x0.y + q2 * x0.z + q3 * x0.w; bsc += q0 * x1.x + q1 * x1.y + q2 * x1.z + q3 * x1.w; }
                float keepv = -3e38f; int keepi = 0;
                for (int r = 0; r < 16; ++r) { float v; int idx; if (av >= bsc) { v = av; idx = lane; } else { v = bsc; idx = lane + 64; }
                    wave_argmax(v, idx);
                    if (idx == lane) av = -3e38f; if (idx == lane + 64) bsc = -3e38f;
                    if (lane == r) { keepv = v; keepi = idx; } }
                tv[c] = keepv; ti[c] = keepi;
            }
            float cv[4];
#pragma unroll
            for (int u = 0; u < 4; ++u) { const int id = lane * 4 + u; cv[u] = __shfl(tv[0], id >> 4) + __shfl(tv[1], id & 15); }
            float topv = -3e38f; int topid = 0;
            for (int r = 0; r < 16; ++r) { float v = cv[0]; int idx = lane * 4;
#pragma unroll
                for (int u = 1; u < 4; ++u) if (cv[u] > v) { v = cv[u]; idx = lane * 4 + u; }
                wave_argmax(v, idx);
                if ((idx >> 2) == lane) {
#pragma unroll
                    for (int u = 0; u < 4; ++u) if ((idx & 3) == u) cv[u] = -3e38f; }
                if (lane == r) { topv = v; topid = idx; } }
            const int i1 = __shfl(ti[0], topid >> 4), i2 = __shfl(ti[1], topid & 15);
            const float vm = (lane < 16) ? topv : -3e38f; const float mx = wave_max(vm);
            const float ex = (lane < 16) ? __expf(topv - mx) : 0.f; const float sm = wave_sum(ex);
            if (lane < 16) { sid[h * 16 + lane] = i1 * 128 + i2; sgt[h * 16 + lane] = ex / sm; }
            LDS_WAIT(); asm volatile("" ::: "memory");
        }
        const int m0 = sid[lane], m1 = sid[lane + 64]; const float g0 = sgt[lane], g1 = sgt[lane + 64];
        int r0 = 0, r1 = 0;
        for (int j = 0; j < 128; ++j) { const int o = sid[j]; r0 += (o < m0 || (o == m0 && j < lane)) ? 1 : 0; r1 += (o < m1 || (o == m1 && j < lane + 64)) ? 1 : 0; }
        EIDX[(size_t)row * 128 + r0] = m0; GATE[(size_t)row * 128 + r0] = g0;
        EIDX[(size_t)row * 128 + r1] = m1; GATE[(size_t)row * 128 + r1] = g1;
        LDS_WAIT(); asm volatile("" ::: "memory");
    }
}

typedef float f32x16 __attribute__((ext_vector_type(16)));
__device__ __forceinline__ void ce_desc(float& a, float& b) { const float hi = fmaxf(a, b), lo = fminf(a, b); a = hi; b = lo; }
__device__ __forceinline__ void sort16_desc(float* v) {
#pragma unroll
    for (int k = 2; k <= 16; k <<= 1)
#pragma unroll
        for (int j = k >> 1; j > 0; j >>= 1)
#pragma unroll
            for (int i = 0; i < 16; ++i) { const int l = i ^ j; if (l > i) { if ((i & k) == 0 || k == 16) ce_desc(v[i], v[l]); else ce_desc(v[l], v[i]); } }
}
__device__ __forceinline__ void merge16_desc(float* v) {
#pragma unroll
    for (int j = 8; j > 0; j >>= 1)
#pragma unroll
        for (int i = 0; i < 16; ++i) { const int l = i ^ j; if (l > i) ce_desc(v[i], v[l]); }
}
__device__ __forceinline__ void top16_of_two(float* a, const float* b) {
#pragma unroll
    for (int i = 0; i < 16; ++i) a[i] = fmaxf(a[i], b[15 - i]);
    merge16_desc(a);
}
__device__ __forceinline__ void top16_of_64(float* v) {
    sort16_desc(v); sort16_desc(v + 16); sort16_desc(v + 32); sort16_desc(v + 48);
    top16_of_two(v, v + 16); top16_of_two(v + 32, v + 48); top16_of_two(v, v + 32);
}
__device__ __forceinline__ void topk_phase(Frame& F, const Args& a) {
    unsigned char* ws = a.ws; const bf16* QP = (const bf16*)(ws + WS_XN); const bf16* SKB = (const bf16*)(ws + WS_SKB); int* EIDX = (int*)(ws + WS_EIDX); float* GATE = (float*)(ws + WS_GATE);
    const int lane = F.lane, h = F.wave, r32 = lane & 31, hh = lane >> 5;
    LAS int* tok_id = (LAS int*)(F.lds);
    LAS float* tok_gt = (LAS float*)(F.lds + 32768);
    LAS int* ktab = (LAS int*)(F.lds + 65536 + F.wave * 8192);
    for (int unit = F.vcu; unit < M / 64; unit += F.G) {
        const int tok0 = unit * 64;
#pragma unroll 1
        for (int tt = 0; tt < 2; ++tt) {
            const size_t row = (size_t)(tok0 + tt * 32 + r32);
            float L[2][16];
#pragma unroll
            for (int c = 0; c < 2; ++c) {
                f32x16 acc[4];
#pragma unroll
                for (int kt = 0; kt < 4; ++kt) acc[kt] = (f32x16){0.f, 0.f, 0.f, 0.f, 0.f, 0.f, 0.f, 0.f, 0.f, 0.f, 0.f, 0.f, 0.f, 0.f, 0.f, 0.f};
                const bf16* qb = QP + row * DM + h * 256 + c * 128 + 8 * hh;
                const bf16* kb = SKB + ((size_t)(h * 2 + c) * 128 + r32) * 128 + 8 * hh;
#if !defined(TOPK_DBG)
#pragma unroll 2
                for (int st = 0; st < 8; ++st) {
                    const bf16x8 bq = *(const bf16x8*)(qb + 16 * st);
#pragma unroll
                    for (int kt = 0; kt < 4; ++kt) { const bf16x8 ak = *(const bf16x8*)(kb + (size_t)kt * 32 * 128 + 16 * st);
                        acc[kt] = __builtin_amdgcn_mfma_f32_32x32x16_bf16(ak, bq, acc[kt], 0, 0, 0); }
                }
#else
                (void)qb; (void)kb;
#pragma unroll
                for (int kt = 0; kt < 4; ++kt)
#pragma unroll
                    for (int r = 0; r < 16; ++r) { const int key = 32 * kt + (r & 3) + 8 * (r >> 2) + 4 * hh; float d = 0.f;
                        const bf16* qq = QP + row * DM + h * 256 + c * 128; const float* kk = a.in[12] + ((size_t)(h * 2 + c) * 128 + key) * 128;
                        for (int dd = 0; dd < 128; ++dd) d += bf2f(qq[dd]) * kk[dd];
                        acc[kt][r] = d; }
#endif
                float v[64];
#pragma unroll
                for (int kt = 0; kt < 4; ++kt)
#pragma unroll
                    for (int r = 0; r < 16; ++r) { const int key = 32 * kt + (r & 3) + 8 * (r >> 2);
                        const float sc = acc[kt][r];
                        v[kt * 16 + r] = __builtin_bit_cast(float, (__builtin_bit_cast(unsigned, sc) & ~127u) | (unsigned)(key + 4 * hh)); }
                top16_of_64(v);
                float p[16];
#pragma unroll
                for (int i = 0; i < 16; ++i) p[i] = __shfl_xor(v[i], 32);
                top16_of_two(v, p);
#pragma unroll
                for (int i = 0; i < 16; ++i) { L[c][i] = v[i]; ktab[(c * 16 + i) * 64 + lane] = (int)(__builtin_bit_cast(unsigned, v[i]) & 127u); }
            }
            float cnd[64];
            { int n = 0;
#pragma unroll
              for (int i = 0; i < 16; ++i)
#pragma unroll
                  for (int j = 0; j < 16; ++j) if ((i + 1) * (j + 1) <= 16) { cnd[n] = __builtin_bit_cast(float, (__builtin_bit_cast(unsigned, L[0][i] + L[1][j]) & ~255u) | (unsigned)((i << 4) | j)); ++n; }
#pragma unroll
              for (int q = 50; q < 64; ++q) cnd[q] = -3.0e38f; }
            top16_of_64(cnd);
            float mx = __builtin_bit_cast(float, __builtin_bit_cast(unsigned, cnd[0]) & ~255u), sum = 0.f; float ex[16];
#pragma unroll
            for (int i = 0; i < 16; ++i) { ex[i] = __expf(__builtin_bit_cast(float, __builtin_bit_cast(unsigned, cnd[i]) & ~255u) - mx); sum += ex[i]; }
            const float inv = 1.f / sum;
            LDS_WAIT(); asm volatile("" ::: "memory");
            if (hh == 0) {
#pragma unroll
                for (int i = 0; i < 16; ++i) { const unsigned bits = __builtin_bit_cast(unsigned, cnd[i]); const int ia = (bits >> 4) & 15, jb = bits & 15;
                    const int e = ktab[ia * 64 + lane] * 128 + ktab[(16 + jb) * 64 + lane];
                    tok_id[(tt * 32 + r32) * 128 + h * 16 + i] = e; tok_gt[(tt * 32 + r32) * 128 + h * 16 + i] = ex[i] * inv; }
            }
            LDS_WAIT(); asm volatile("" ::: "memory");
        }
        __syncthreads();
        for (int t8 = 0; t8 < 8; ++t8) { const int tk = F.wave * 8 + t8; const LAS int* ids = tok_id + tk * 128; const LAS float* gts = tok_gt + tk * 128;
            const int m0 = ids[lane], m1 = ids[lane + 64]; const float g0 = gts[lane], g1 = gts[lane + 64];
            int r0 = 0, r1 = 0;
#pragma unroll 8
            for (int j = 0; j < 128; ++j) { const int o = ids[j]; r0 += (o < m0 || (o == m0 && j < lane)) ? 1 : 0; r1 += (o < m1 || (o == m1 && j < lane + 64)) ? 1 : 0; }
            const size_t ob = (size_t)(tok0 + tk) * 128;
            EIDX[ob + r0] = m0; GATE[ob + r0] = g0; EIDX[ob + r1] = m1; GATE[ob + r1] = g1; }
        __syncthreads();
    }
}


__device__ __forceinline__ void gla_prep_phase(Frame& F, const Args& a) {
    unsigned char* ws = a.ws; const bf16* PROJ;
    const int w = F.wave;
    LAS unsigned char* L = F.lds;
    LAS unsigned char* Qraw = L; LAS unsigned char* Kraw = L + 16384; LAS unsigned char* Vraw = L + 32768; LAS float* GDf = (LAS float*)(L + 65536); LAS float* GSUM = (LAS float*)(L + 73728);
    LAS unsigned char* IMGQ = L + 77824; LAS unsigned char* IMGK = L + 95232; LAS unsigned char* IMGE = L + 112640; LAS unsigned char* AMI = L + 32768;
    for (int it = F.vcu; it < 1024; it += F.G) {
        const int b = it >> 8, h = (it >> 6) & 3, n = it & 63; const size_t row0 = (size_t)b * SEQ + n * 64;
        ws = opaque(ws); PROJ = (const bf16*)(ws + WS_PROJ);
        int tid = opaque_v(F.tid), lane = tid & 63, r32 = lane & 31, hh = lane >> 5;
#pragma unroll
        for (int i = 0; i < 2; ++i) { const int idx = tid + 512 * i, r = idx >> 4, c = idx & 15;
            *(LAS v4u*)(Qraw + r * 256 + c * 16) = *(const v4u*)(PROJ + (row0 + r) * NINP + O_GQ + h * 128 + c * 8);
            *(LAS v4u*)(Kraw + r * 256 + c * 16) = *(const v4u*)(PROJ + (row0 + r) * NINP + O_GK + h * 128 + c * 8); }
#pragma unroll
        for (int i = 0; i < 4; ++i) { const int idx = tid + 512 * i, r = idx >> 5, c = idx & 31;
            *(LAS v4u*)(Vraw + r * 512 + c * 16) = *(const v4u*)(PROJ + (row0 + r) * NINP + O_GV + h * 256 + c * 8); }
        if (tid < 256) { const int r = tid >> 2, c = tid & 3; const v4u g = *(const v4u*)(PROJ + (row0 + r) * NINP + O_GDF + c * 8); LAS float* dst = GDf + r * 32 + c * 8;
            dst[0] = bflo(g.x); dst[1] = bfhi(g.x); dst[2] = bflo(g.y); dst[3] = bfhi(g.y); dst[4] = bflo(g.z); dst[5] = bfhi(g.z); dst[6] = bflo(g.w); dst[7] = bfhi(g.w); }
        __syncthreads();
#pragma unroll
        for (int ks = 0; ks < 4; ++ks) { unsigned pk[4];
#pragma unroll
            for (int p = 0; p < 4; ++p) { const int s0 = 16 * ks + 8 * hh + 2 * p; const unsigned lo = *(const LAS unsigned short*)(Vraw + s0 * 512 + (32 * w + r32) * 2), hi = *(const LAS unsigned short*)(Vraw + (s0 + 1) * 512 + (32 * w + r32) * 2); pk[p] = lo | (hi << 16); }
            *(v4u*)((unsigned char*)a.out + OUT_GT_VT + (size_t)it * 32768 + (w * 4 + ks) * 1024 + lane * 16) = (v4u){pk[0], pk[1], pk[2], pk[3]}; }
        for (int dir = 0; dir < 2; ++dir) {
            const size_t idir = (size_t)(((b * 4 + h) * 2 + dir) * 64 + n); ws = opaque(ws); tid = opaque_v(tid); lane = tid & 63; r32 = lane & 31; hh = lane >> 5;
            {
                const int d = tid & 127, tq = tid >> 7; const float* upp = (dir ? a.in[5] : a.in[3]) + h * 128 + d; const float bias = (dir ? a.in[6] : a.in[4])[h * 128 + d];
                float up[16];
#pragma unroll
                for (int r = 0; r < 16; ++r) up[r] = upp[r * 512];
                float c[16];
#pragma unroll
                for (int i = 0; i < 16; ++i) { const LAS float* g = GDf + (16 * tq + i) * 32 + dir * 16; float z = bias;
#pragma unroll
                    for (int r = 0; r < 16; ++r) z += g[r] * up[r];
                    c[i] = (fminf(z, 0.f) - __logf(1.f + __expf(-fabsf(z)))) * (1.f / 16.f); }
                if (dir == 0) {
#pragma unroll
                    for (int i = 1; i < 16; ++i) c[i] += c[i - 1];
                } else {
#pragma unroll
                    for (int i = 14; i >= 0; --i) c[i] += c[i + 1];
                }
                GSUM[(dir * 4 + tq) * 128 + d] = dir == 0 ? c[15] : c[0];
                __syncthreads();
                const float t0 = GSUM[(dir * 4 + 0) * 128 + d], t1 = GSUM[(dir * 4 + 1) * 128 + d], t2 = GSUM[(dir * 4 + 2) * 128 + d], t3 = GSUM[(dir * 4 + 3) * 128 + d];
                const float Bt = (t0 + t1) + (t2 + t3);
                float off;
                if (dir == 0) off = (tq > 0 ? t0 : 0.f) + (tq > 1 ? t1 : 0.f) + (tq > 2 ? t2 : 0.f);
                else off = (tq < 1 ? t1 : 0.f) + (tq < 2 ? t2 : 0.f) + (tq < 3 ? t3 : 0.f);
                unsigned kep[8];
#pragma unroll
                for (int i = 0; i < 16; i += 2) { float ke2[2];
#pragma unroll
                    for (int q = 0; q < 2; ++q) { const int t = 16 * tq + i + q; const float bi = c[i + q] + off;
                        const float qv = bf2f(*(const LAS unsigned short*)(Qraw + t * 256 + d * 2)), kv = bf2f(*(const LAS unsigned short*)(Kraw + t * 256 + d * 2));
                        *(LAS unsigned short*)(IMGQ + t * 272 + d * 2) = (unsigned short)f2bf(qv * 0.08838834764831845f * __expf(bi));
                        *(LAS unsigned short*)(IMGK + t * 272 + d * 2) = (unsigned short)f2bf(kv * __expf(-bi));
                        ke2[q] = kv * __expf(Bt - bi); }
                    kep[i >> 1] = pk2(ke2[0], ke2[1]); }
                *(LAS v4u*)(IMGE + d * 144 + (16 * tq) * 2) = (v4u){kep[0], kep[1], kep[2], kep[3]};
                *(LAS v4u*)(IMGE + d * 144 + (16 * tq + 8) * 2) = (v4u){kep[4], kep[5], kep[6], kep[7]};
                if (tq == 0) ((float*)((unsigned char*)a.out + OUT_GT_DEC))[idir * 128 + d] = __expf(Bt);
            }
            __syncthreads();
            if (w < 4) {
                const int si = w >> 1, ti = w & 1; f32x16 acc = (f32x16){0.f, 0.f, 0.f, 0.f, 0.f, 0.f, 0.f, 0.f, 0.f, 0.f, 0.f, 0.f, 0.f, 0.f, 0.f, 0.f};
#pragma unroll
                for (int ks = 0; ks < 8; ++ks) { const bf16x8 ak = *(const LAS bf16x8*)(IMGK + (32 * si + r32) * 272 + (16 * ks + 8 * hh) * 2), bq = *(const LAS bf16x8*)(IMGQ + (32 * ti + r32) * 272 + (16 * ks + 8 * hh) * 2);
                    acc = __builtin_amdgcn_mfma_f32_32x32x16_bf16(ak, bq, acc, 0, 0, 0); }
                const int t = 32 * ti + r32;
#pragma unroll
                for (int qd = 0; qd < 4; ++qd) { float v4[4];
#pragma unroll
                    for (int i = 0; i < 4; ++i) { const int sidx = 32 * si + 8 * qd + 4 * hh + i; const float x = acc[4 * qd + i]; const bool keep = dir == 0 ? (sidx <= t) : (sidx >= t); v4[i] = keep ? x : 0.f; }
                    *(LAS unsigned long long*)(AMI + t * 144 + (32 * si + 8 * qd + 4 * hh) * 2) = (unsigned long long)pk2(v4[0], v4[1]) | ((unsigned long long)pk2(v4[2], v4[3]) << 32); }
            } else {
                const int w4 = w - 4;
#pragma unroll
                for (int q = 0; q < 4; ++q) { const int bq = w4 * 4 + q, tt = bq >> 3, ks = bq & 7, j = ks >> 1, u = ks & 1; const int t = 32 * tt + r32;
                    const unsigned long long p0 = *(const LAS unsigned long long*)(IMGQ + t * 272 + (32 * j + 16 * u + 4 * hh) * 2), p1 = *(const LAS unsigned long long*)(IMGQ + t * 272 + (32 * j + 16 * u + 8 + 4 * hh) * 2);
                    *(v4u*)(ws + WS_GT_QD + idir * 16384 + bq * 1024 + lane * 16) = (v4u){(unsigned)p0, (unsigned)(p0 >> 32), (unsigned)p1, (unsigned)(p1 >> 32)}; }
#pragma unroll
                for (int q = 0; q < 4; ++q) { const int bk = w4 * 4 + q, j = bk >> 2, ks = bk & 3; const int d = 32 * j + r32;
                    *(v4u*)(ws + WS_GT_KE + idir * 16384 + bk * 1024 + lane * 16) = *(const LAS v4u*)(IMGE + d * 144 + (16 * ks + 8 * hh) * 2); }
            }
            __syncthreads();
            { const int tt = w >> 2, ks = w & 3; const int t = 32 * tt + r32;
              *(v4u*)((unsigned char*)a.out + OUT_GT_AM + idir * 8192 + w * 1024 + lane * 16) = *(const LAS v4u*)(AMI + t * 144 + (16 * ks + 8 * hh) * 2); }
            __syncthreads();
        }
    }
}

__device__ __forceinline__ void gla_seq_phase(Frame& F, const Args& a) {
    unsigned char* ws = a.ws;
    const int w = F.wave;
    LAS unsigned char* QDl = F.lds; LAS unsigned char* KEl = F.lds + 16384; LAS unsigned char* AMl = F.lds + 32768; LAS float* DECl = (LAS float*)(F.lds + 40960);
    for (int unit = F.vcu; unit < 32; unit += F.G) {
        const int dir = unit & 1, bh = unit >> 1, b = bh >> 2, h = bh & 3;
        bf16* Out;
        f32x16 S[4];
#pragma unroll
        for (int j = 0; j < 4; ++j) S[j] = (f32x16){0.f, 0.f, 0.f, 0.f, 0.f, 0.f, 0.f, 0.f, 0.f, 0.f, 0.f, 0.f, 0.f, 0.f, 0.f, 0.f};
        for (int ns = 0; ns < 64; ++ns) {
            const int n = dir ? 63 - ns : ns; const size_t idir = (size_t)((bh * 2 + dir) * 64 + n), iv = (size_t)(bh * 64 + n); ws = opaque(ws); Out = (bf16*)(ws + (dir ? WS_OB : WS_OF));
            const int tid = opaque_v(F.tid), lane = tid & 63, r32 = lane & 31, hh = lane >> 5;
            { const v4u* gq = (const v4u*)(ws + WS_GT_QD + idir * 16384); const v4u* gk = (const v4u*)(ws + WS_GT_KE + idir * 16384); const v4u* ga = (const v4u*)((unsigned char*)a.out + OUT_GT_AM + idir * 8192);
              const v4u x0 = gq[tid], x1 = gq[tid + 512], x2 = gk[tid], x3 = gk[tid + 512], x4 = ga[tid];
              ((LAS v4u*)QDl)[tid] = x0; ((LAS v4u*)QDl)[tid + 512] = x1; ((LAS v4u*)KEl)[tid] = x2; ((LAS v4u*)KEl)[tid + 512] = x3; ((LAS v4u*)AMl)[tid] = x4;
              if (tid < 32) ((LAS v4u*)DECl)[tid] = ((const v4u*)((unsigned char*)a.out + OUT_GT_DEC + idir * 512))[tid]; }
            bf16x8 vf[4];
#pragma unroll
            for (int ks = 0; ks < 4; ++ks) vf[ks] = *(const bf16x8*)((unsigned char*)a.out + OUT_GT_VT + iv * 32768 + (w * 4 + ks) * 1024 + lane * 16);
            __syncthreads();
            f32x16 o[2];
#pragma unroll
            for (int tt = 0; tt < 2; ++tt) o[tt] = (f32x16){0.f, 0.f, 0.f, 0.f, 0.f, 0.f, 0.f, 0.f, 0.f, 0.f, 0.f, 0.f, 0.f, 0.f, 0.f, 0.f};
#pragma unroll
            for (int ks8 = 0; ks8 < 8; ++ks8) { const int j = ks8 >> 1, u = ks8 & 1; v4u sb;
                sb.x = pg8::cvt_pk_bf16(S[j][8 * u + 0], S[j][8 * u + 1]); sb.y = pg8::cvt_pk_bf16(S[j][8 * u + 2], S[j][8 * u + 3]); sb.z = pg8::cvt_pk_bf16(S[j][8 * u + 4], S[j][8 * u + 5]); sb.w = pg8::cvt_pk_bf16(S[j][8 * u + 6], S[j][8 * u + 7]);
                const bf16x8 bs = __builtin_bit_cast(bf16x8, sb);
#pragma unroll
                for (int tt = 0; tt < 2; ++tt) { const bf16x8 aq = *(const LAS bf16x8*)(QDl + (tt * 8 + ks8) * 1024 + lane * 16); o[tt] = __builtin_amdgcn_mfma_f32_32x32x16_bf16(aq, bs, o[tt], 0, 0, 0); } }
#pragma unroll
            for (int ks = 0; ks < 4; ++ks)
#pragma unroll
                for (int tt = 0; tt < 2; ++tt) { const bf16x8 am = *(const LAS bf16x8*)(AMl + (tt * 4 + ks) * 1024 + lane * 16); o[tt] = __builtin_amdgcn_mfma_f32_32x32x16_bf16(am, vf[ks], o[tt], 0, 0, 0); }
#pragma unroll
            for (int tt = 0; tt < 2; ++tt)
#pragma unroll
                for (int r = 0; r < 16; ++r) { const int t = 32 * tt + (r & 3) + 8 * (r >> 2) + 4 * hh; const float x = o[tt][r];
                    Out[((size_t)b * SEQ + 64 * n + t) * 1024 + h * 256 + 32 * w + r32] = (bf16)f2bf(x); }
#pragma unroll
            for (int j = 0; j < 4; ++j) {
#pragma unroll
                for (int q = 0; q < 4; ++q) { const f32x4 dv = *(const LAS f32x4*)(DECl + 32 * j + 8 * q + 4 * hh); S[j][4 * q + 0] *= dv.x; S[j][4 * q + 1] *= dv.y; S[j][4 * q + 2] *= dv.z; S[j][4 * q + 3] *= dv.w; }
#pragma unroll
                for (int ks = 0; ks < 4; ++ks) { const bf16x8 ak = *(const LAS bf16x8*)(KEl + (j * 4 + ks) * 1024 + lane * 16); S[j] = __builtin_amdgcn_mfma_f32_32x32x16_bf16(ak, vf[ks], S[j], 0, 0, 0); } }
            __syncthreads();
        }
    }
}


typedef short v4i16_t __attribute__((ext_vector_type(4)));
__device__ __forceinline__ void attn_phase(Frame& F, const Args& a, int qslot) {
    unsigned char* ws = a.ws; const bf16* PROJ = (const bf16*)(ws + WS_PROJ);
    const int w = F.wave;
    LAS unsigned char* Kl = F.lds; LAS unsigned char* Vl = F.lds + 39168; volatile LAS int* uword = (volatile LAS int*)(F.lds + 78336);
    constexpr int NUNITS = 64 * 3 * 32;
    for (;;) {
        const int tid = opaque_v(F.tid), lane = tid & 63, q16 = lane & 15, g = lane >> 4;
        if (tid == 0) uword[0] = (int)__hip_atomic_fetch_add((unsigned*)(F.ctl + CW_ATTQ + 64 * qslot), 1u, __ATOMIC_RELAXED, __HIP_MEMORY_SCOPE_AGENT);
        __syncthreads();
        const int u = __builtin_amdgcn_readfirstlane(uword[0]);
        if (u >= NUNITS) break;
        const int bh = u / 96, rem = u - bh * 96, p = rem >> 5, idx = rem & 31; const int lgd = 2 * p, d = 1 << lgd;
        const int r = idx >> (5 - lgd), J = idx & ((32 >> lgd) - 1), Lc = SEQ >> lgd; const int b = bh >> 4, h = bh & 15;
        const int m0 = 128 * J - 64;
        ws = opaque(ws); PROJ = (const bf16*)(ws + WS_PROJ);
#pragma unroll
        for (int i = 0; i < 4; ++i) { const int kr = (tid >> 3) + 64 * i, ch = tid & 7; const int mp = m0 + kr; v4u kx = (v4u){0u, 0u, 0u, 0u}, vx = kx;
            if (mp >= 0 && mp < Lc) { const bf16* src = PROJ + ((size_t)b * SEQ + r + d * mp) * NINP + O_AK + h * 64 + ch * 8; kx = *(const v4u*)src; vx = *(const v4u*)(src + (O_AV - O_AK)); }
            *(LAS v4u*)(Kl + kr * 144 + ch * 16) = kx; *(LAS v4u*)(Vl + kr * 144 + ch * 16) = vx; }
        if (tid < 128) { const int kr = 256 + (tid >> 3), ch = tid & 7; *(LAS v4u*)(Kl + kr * 144 + ch * 16) = (v4u){0u, 0u, 0u, 0u}; *(LAS v4u*)(Vl + kr * 144 + ch * 16) = (v4u){0u, 0u, 0u, 0u}; }
        const int tokq = r + d * (128 * J + 16 * w + q16);
        bf16x8 qf[2];
#pragma unroll
        for (int sft = 0; sft < 2; ++sft) { const v4u qw = *(const v4u*)(PROJ + ((size_t)b * SEQ + tokq) * NINP + O_AQ + h * 64 + 32 * sft + 8 * g);
            v4u qs; qs.x = pk2(bflo(qw.x) * 0.125f, bfhi(qw.x) * 0.125f); qs.y = pk2(bflo(qw.y) * 0.125f, bfhi(qw.y) * 0.125f); qs.z = pk2(bflo(qw.z) * 0.125f, bfhi(qw.z) * 0.125f); qs.w = pk2(bflo(qw.w) * 0.125f, bfhi(qw.w) * 0.125f);
            qf[sft] = __builtin_bit_cast(bf16x8, qs); }
        __syncthreads();
        const float slope = exp2f(-0.5f * (float)(h + 1)) * (float)d;
        float sv[5][2][4]; float mx = -1e30f;
#pragma unroll
        for (int kb = 0; kb < 5; ++kb)
#pragma unroll
            for (int uu = 0; uu < 2; ++uu) { f32x4 acc = (f32x4){0.f, 0.f, 0.f, 0.f};
                const int krow = 16 * w + 32 * kb + 8 * (q16 >> 2) + 4 * uu + (q16 & 3);
#pragma unroll
                for (int sft = 0; sft < 2; ++sft) { const bf16x8 ak = *(const LAS bf16x8*)(Kl + krow * 144 + (32 * sft + 8 * g) * 2); acc = __builtin_amdgcn_mfma_f32_16x16x32_bf16(ak, qf[sft], acc, 0, 0, 0); }
#pragma unroll
                for (int rho = 0; rho < 4; ++rho) { const int jo = 32 * kb + 8 * g + 4 * uu + rho - 64 - q16; const int mp = m0 + 16 * w + 32 * kb + 8 * g + 4 * uu + rho; const int aj = jo < 0 ? -jo : jo;
                    const bool ok = (aj <= 64) && (mp >= 0) && (mp < Lc); const float x = acc[rho];
                    const float sc = ok ? (x - slope * (float)aj) : -1e30f; sv[kb][uu][rho] = sc; mx = fmaxf(mx, sc); } }
        mx = fmaxf(mx, __shfl_xor(mx, 16)); mx = fmaxf(mx, __shfl_xor(mx, 32));
        float lsum = 0.f; bf16x8 pf[5];
#pragma unroll
        for (int kb = 0; kb < 5; ++kb) { float e[8];
#pragma unroll
            for (int uu = 0; uu < 2; ++uu)
#pragma unroll
                for (int rho = 0; rho < 4; ++rho) { const float pe = __expf(sv[kb][uu][rho] - mx); e[uu * 4 + rho] = pe; lsum += pe; }
            v4u pw; pw.x = pk2(e[0], e[1]); pw.y = pk2(e[2], e[3]); pw.z = pk2(e[4], e[5]); pw.w = pk2(e[6], e[7]); pf[kb] = __builtin_bit_cast(bf16x8, pw); }
        lsum += __shfl_xor(lsum, 16); lsum += __shfl_xor(lsum, 32);
        f32x4 oT[4];
#pragma unroll
        for (int nn = 0; nn < 4; ++nn) oT[nn] = (f32x4){0.f, 0.f, 0.f, 0.f};
#pragma unroll
        for (int kb = 0; kb < 5; ++kb)
#pragma unroll
            for (int nn = 0; nn < 4; ++nn) { const LAS unsigned char* va = Vl + (16 * w + 32 * kb + 8 * g + (q16 >> 2)) * 144 + (16 * nn + 4 * (q16 & 3)) * 2;
                const v4i16_t lo = __builtin_amdgcn_ds_read_tr16_b64_v4i16((LAS v4i16_t*)va), hi = __builtin_amdgcn_ds_read_tr16_b64_v4i16((LAS v4i16_t*)(va + 4 * 144));
                const bf16x8 vf = (bf16x8){lo[0], lo[1], lo[2], lo[3], hi[0], hi[1], hi[2], hi[3]};
                oT[nn] = __builtin_amdgcn_mfma_f32_16x16x32_bf16(vf, pf[kb], oT[nn], 0, 0, 0); }
        { const size_t rec = ((size_t)p * M + (size_t)b * SEQ + tokq) * 16 + h; bf16* op = (bf16*)(ws + WS_ATTP) + rec * 64 + 4 * g;
#pragma unroll
          for (int nn = 0; nn < 4; ++nn) *(unsigned long long*)(op + 16 * nn) = (unsigned long long)pk2(oT[nn][0], oT[nn][1]) | ((unsigned long long)pk2(oT[nn][2], oT[nn][3]) << 32);
          if (g == 0) { float* ml = (float*)(ws + WS_ATTML) + rec * 2; ml[0] = mx; ml[1] = lsum; } }
    }
}

typedef __bf16 bf16x2_t __attribute__((ext_vector_type(2)));
typedef int i32x4 __attribute__((ext_vector_type(4)));
__device__ __forceinline__ void peer_convert_tables(Frame& F, const Args& a) {
    unsigned char* ws = a.ws; const int lane = F.lane;
    for (int r = F.vcu * NWAVES + F.wave; r < 2 * PEER_E; r += F.G * NWAVES) {
        const int e = r & (PEER_E - 1); const bool isv = r >= PEER_E;
        const float* src = (isv ? a.in[14] : a.in[13]) + (size_t)e * DM;
        unsigned char* dst = ws + (isv ? WS_V8 : WS_U8) + (size_t)e * DM; float* sc = (float*)(ws + (isv ? WS_SV : WS_SU));
        f32x4 v[8]; float am = 0.f;
#pragma unroll
        for (int j = 0; j < 8; ++j) { v[j] = *(const f32x4*)(src + 256 * j + 4 * lane); am = fmaxf(am, fmaxf(fmaxf(fabsf(v[j].x), fabsf(v[j].y)), fmaxf(fabsf(v[j].z), fabsf(v[j].w)))); }
        am = wave_max(am); am = fmaxf(am, 1e-30f);
        const float inv = 440.f / am;
        int d[8];
#pragma unroll
        for (int j = 0; j < 8; ++j) { int p = __builtin_amdgcn_cvt_pk_fp8_f32(v[j].x * inv, v[j].y * inv, 0, false); d[j] = __builtin_amdgcn_cvt_pk_fp8_f32(v[j].z * inv, v[j].w * inv, p, true); }
        *(i32x4*)(dst + 16 * lane) = (i32x4){d[0], d[1], d[2], d[3]};
        *(i32x4*)(dst + 1024 + 16 * lane) = (i32x4){d[4], d[5], d[6], d[7]};
        if (lane == 0) sc[e] = am * (1.f / 440.f);
    }
}

#define PEER_NB 8
#define PEER_NBV 8
__device__ __forceinline__ void peer_phase(Frame& F, const Args& a) {
    unsigned char* ws = a.ws; float* H = a.out; const float* g2 = a.in[10]; const float* gf = a.in[15];
    const unsigned char* U8 = ws + WS_U8; const unsigned char* V8 = ws + WS_V8; const float* SU = (const float*)(ws + WS_SU); const float* SV = (const float*)(ws + WS_SV);
    const int* EIDX = (const int*)(ws + WS_EIDX); const float* GATE = (const float*)(ws + WS_GATE);
    const int lane = F.lane; const unsigned l16 = (unsigned)lane * 16u, l4 = (unsigned)lane * 4u;
    LAS unsigned* xq = (LAS unsigned*)(F.lds + F.wave * 18432);
    LAS float* wv = (LAS float*)(F.lds + F.wave * 18432 + 16384);
    const int tok_per_wg = M / F.G;
    for (int base2 = 0; base2 < tok_per_wg * NREP(7); base2 += NWAVES * 4) {
        const int base = base2 % tok_per_wg; const bool dry = (base2 + tok_per_wg < tok_per_wg * NREP(7));
        const int row0 = __builtin_amdgcn_readfirstlane(F.vcu * tok_per_wg + base + F.wave * 4);
        if (base + F.wave * 4 >= tok_per_wg) break;
        int eid[4][2]; float gt[4][2];
#pragma unroll
        for (int i = 0; i < 4; ++i) {
            const float* hrow = opaque(H) + (size_t)(row0 + i) * DM; f32x4 hv[8]; float ss = 0.f;
#pragma unroll
            for (int j = 0; j < 8; ++j) { hv[j] = ldu<f32x4>(hrow + 256 * j, l16); ss += (hv[j].x * hv[j].x + hv[j].y * hv[j].y) + (hv[j].z * hv[j].z + hv[j].w * hv[j].w); }
            const float rstd = 1.f / sqrtf(wave_sum(ss) * (1.f / DM) + EPS);
#pragma unroll
            for (int j = 0; j < 8; ++j) { const f32x4 g = ldu<f32x4>(opaque(g2) + 256 * j, l16); xq[(i * 16 + 2 * j) * 64 + lane] = pk2(hv[j].x * rstd * g.x, hv[j].y * rstd * g.y); xq[(i * 16 + 2 * j + 1) * 64 + lane] = pk2(hv[j].z * rstd * g.z, hv[j].w * rstd * g.w); }
            eid[i][0] = ldu<int>(opaque(EIDX) + (size_t)(row0 + i) * 128, l4); eid[i][1] = ldu<int>(opaque(EIDX) + (size_t)(row0 + i) * 128 + 64, l4);
            gt[i][0] = ldu<float>(opaque(GATE) + (size_t)(row0 + i) * 128, l4); gt[i][1] = ldu<float>(opaque(GATE) + (size_t)(row0 + i) * 128 + 64, l4);
            asm volatile("" ::: "memory");
        }
        LDS_WAIT(); asm volatile("" ::: "memory");
        int pos[4] = {0, 0, 0, 0};
        for (int c = 0; c < PEER_NCH; ++c) {
            const int cend = (c + 1) * PEER_EC;
            int nl[4];
#pragma unroll
            for (int i = 0; i < 4; ++i) nl[i] = __builtin_popcountll(__ballot(eid[i][0] < cend)) + __builtin_popcountll(__ballot(eid[i][1] < cend));
            for (int i = 0; i < 4; ++i) {
                const int nlt = i == 0 ? nl[0] : i == 1 ? nl[1] : i == 2 ? nl[2] : nl[3];
                int p = i == 0 ? pos[0] : i == 1 ? pos[1] : i == 2 ? pos[2] : pos[3];
                if (p >= nlt) continue;
                const int e0v = i == 0 ? eid[0][0] : i == 1 ? eid[1][0] : i == 2 ? eid[2][0] : eid[3][0];
                const int e1v = i == 0 ? eid[0][1] : i == 1 ? eid[1][1] : i == 2 ? eid[2][1] : eid[3][1];
                unsigned xp[16];
#pragma unroll
                for (int k = 0; k < 16; ++k) xp[k] = xq[(i * 16 + k) * 64 + lane];
                while (p < nlt) {
                    const int nb = (nlt - p) < PEER_NB ? (nlt - p) : PEER_NB;
                    i32x4 r[PEER_NB][2];
#pragma unroll
                    for (int k = 0; k < PEER_NB; ++k) if (k < nb) { const int pp = p + k; const int lo = __builtin_amdgcn_readlane(e0v, pp & 63), hi = __builtin_amdgcn_readlane(e1v, pp & 63); const int e = pp < 64 ? lo : hi;
                        const unsigned char* rp = opaque(U8) + (size_t)e * DM; r[k][0] = ldu<i32x4>(rp, l16); r[k][1] = ldu<i32x4>(rp + 1024, l16); }
#pragma unroll
                    for (int k = 0; k < PEER_NB; ++k) if (k < nb) { float d = 0.f;
#pragma unroll
                        for (int j = 0; j < 8; ++j) { const int dw = r[k][j >> 2][j & 3];
                            d = __builtin_amdgcn_fdot2_f32_bf16(__builtin_amdgcn_cvt_scalef32_pk_bf16_fp8(dw, 1.0f, false), __builtin_bit_cast(bf16x2_t, xp[2 * j]), d, false);
                            d = __builtin_amdgcn_fdot2_f32_bf16(__builtin_amdgcn_cvt_scalef32_pk_bf16_fp8(dw, 1.0f, true), __builtin_bit_cast(bf16x2_t, xp[2 * j + 1]), d, false); }
                        d = wave_sum(d);
                        if (lane == 0) wv[i * 128 + p + k] = d; }
                    p += nb;
                }
            }
#pragma unroll
            for (int i = 0; i < 4; ++i) pos[i] = nl[i];
        }
        LDS_WAIT(); asm volatile("" ::: "memory");
#pragma unroll
        for (int i = 0; i < 4; ++i)
#pragma unroll
            for (int q = 0; q < 2; ++q) { const int e = eid[i][q]; const float d = wv[i * 128 + q * 64 + lane] * ldu<float>(SU, (unsigned)e * 4u);
                const float w = gt[i][q] * 0.5f * d * (1.f + erff(d * 0.70710678118654752f)) * ldu<float>(SV, (unsigned)e * 4u); wv[i * 128 + q * 64 + lane] = w; }
        LDS_WAIT(); asm volatile("" ::: "memory");
        float ssq[4] = {0.f, 0.f, 0.f, 0.f};
#pragma unroll 1
        for (int hp = 0; hp < 2; ++hp) {
            f32x4 acc[4][4];
#pragma unroll
            for (int i = 0; i < 4; ++i)
#pragma unroll
                for (int j = 0; j < 4; ++j) acc[i][j] = (f32x4){0.f, 0.f, 0.f, 0.f};
#pragma unroll
            for (int i = 0; i < 4; ++i) pos[i] = 0;
            for (int c = 0; c < PEER_NCH; ++c) {
                const int cend = (c + 1) * PEER_EC;
#pragma unroll
                for (int i = 0; i < 4; ++i) {
                    const int nlt = __builtin_popcountll(__ballot(eid[i][0] < cend)) + __builtin_popcountll(__ballot(eid[i][1] < cend));
                    int p = pos[i];
                    while (p < nlt) {
                        const int nb = (nlt - p) < PEER_NBV ? (nlt - p) : PEER_NBV;
                        i32x4 r[PEER_NBV];
#pragma unroll
                        for (int k = 0; k < PEER_NBV; ++k) if (k < nb) { const int pp = p + k; const int lo = __builtin_amdgcn_readlane(eid[i][0], pp & 63), hi = __builtin_amdgcn_readlane(eid[i][1], pp & 63); const int e = pp < 64 ? lo : hi;
                            r[k] = ldu<i32x4>(opaque(V8) + (size_t)e * DM + hp * 1024, l16); }
#pragma unroll
                        for (int k = 0; k < PEER_NBV; ++k) if (k < nb) { const float w = wv[i * 128 + p + k];
#pragma unroll
                            for (int j = 0; j < 4; ++j) { const int dw = r[k][j]; const f32x2 lo = __builtin_amdgcn_cvt_pk_f32_fp8(dw, false), hi = __builtin_amdgcn_cvt_pk_f32_fp8(dw, true);
                                acc[i][j].x += w * lo.x; acc[i][j].y += w * lo.y; acc[i][j].z += w * hi.x; acc[i][j].w += w * hi.y; } }
                        p += nb;
                    }
                    pos[i] = nlt;
                }
            }
#pragma unroll
            for (int i = 0; i < 4; ++i) {
                float* hrow = opaque(H) + (size_t)(row0 + i) * DM + hp * 1024;
#pragma unroll
                for (int j = 0; j < 4; ++j) { acc[i][j] += ldu<f32x4>(hrow + 256 * j, l16); ssq[i] += (acc[i][j].x * acc[i][j].x + acc[i][j].y * acc[i][j].y) + (acc[i][j].z * acc[i][j].z + acc[i][j].w * acc[i][j].w);
                    stu<f32x4>((dry ? (float*)(ws + WS_OF) + (size_t)(row0 + i) * DM / 2 + hp * 1024 : hrow) + 256 * j, l16, acc[i][j]); }
            }
        }
#pragma unroll
        for (int i = 0; i < 4; ++i) {
            float* hrow = (dry ? (float*)(opaque(ws) + WS_OF) + (size_t)(row0 + i) * DM / 2 : opaque(H) + (size_t)(row0 + i) * DM);
            const float rf = 1.f / sqrtf(wave_sum(ssq[i]) * (1.f / DM) + EPS);
#pragma unroll
            for (int j = 0; j < 8; ++j) { const f32x4 g = ldu<f32x4>(opaque(gf) + 256 * j, l16); const f32x4 y = ldu<f32x4>(hrow + 256 * j, l16); stu<f32x4>(hrow + 256 * j, l16, y * rf * g); }
        }
        LDS_WAIT(); asm volatile("" ::: "memory");
    }
}

__global__ void __launch_bounds__(NWAVES * 64, 2) mk_fwd(Args args) {
    extern __shared__ __attribute__((aligned(16))) unsigned char lds[];
    Frame F;
    F.lds = (LAS unsigned char*)lds;
    F.MISC = (volatile LAS unsigned*)(F.lds + MISC_OFF);
    F.tid = threadIdx.x; F.lane = F.tid & 63; F.wave = __builtin_amdgcn_readfirstlane(F.tid >> 6);
    F.G = gridDim.x; { const int bx = blockIdx.x; F.vcu = (F.G % 8 == 0) ? (bx % 8) * (F.G / 8) + bx / 8 : bx; }
    unsigned char* ws = args.ws;
    F.ctl = (gu32*)(ws + WS_CTL);
    for (int u = F.tid; u < (LDS_BYTES - LDSCTL_OFF) / 4; u += NWAVES * 64) ((LAS unsigned*)(F.lds + LDSCTL_OFF))[u] = 0u;
    __syncthreads();
    XcdBarrier bar = xcd_barrier_post((unsigned*)(F.ctl + CW_BAR) + args.li * XCD_BAR_WORDS, F.MISC + 8);
    const int lo = args.ph_lo, hi = args.ph_hi;
#define IN(k) (lo <= (k) && (k) < hi)
#define BOTH(k) (IN(k) && IN((k) + 1))
#define GRID_BAR() xcd_barrier(bar)

    if (IN(0)) { for (int rep = 0; rep < NREP(0); ++rep) p0_prologue(F, args); if (BOTH(0)) GRID_BAR(); }

    if (IN(1)) {
        pg8::Gemm g{(const bf16*)(ws + WS_XN), (const bf16*)(ws + WS_WIN), M, NINP, DM}; pg8::StaticOrder S; S.init(M, NINP, F.G, (int)blockIdx.x);
        pg8::EpiBf16<0> E{(bf16*)(ws + WS_PROJ), NINP, nullptr, 0, 0, 1.f};
        pg8::gemm_phase<pg8::EpiBf16<0>, pg8::StaticOrder, PG8_ALIGN, PG8_SP2>(F.lds + RING_OFF, g, S, E);
        if (BOTH(1)) GRID_BAR();
    }
    if (IN(2)) {
        for (int rep = 0; rep < NREP(21); ++rep) gla_prep_phase(F, args);
        GRID_BAR();
        for (int rep = 0; rep < NREP(2); ++rep) gla_seq_phase(F, args);
        for (int rep = 0; rep < NREP(20); ++rep) attn_phase(F, args, rep);
        if (BOTH(2)) GRID_BAR(); }
    if (IN(3)) { for (int rep = 0; rep < NREP(3); ++rep) p3_finalize(F, args); if (BOTH(3)) GRID_BAR(); }
    if (IN(4)) {
        for (int rep = 0; rep < NREP(40); ++rep) peer_convert_tables(F, args);
        pg8::Gemm g{(const bf16*)(ws + WS_XN), (const bf16*)(ws + WS_WOUT), M, DM, DM}; pg8::StaticOrder S; S.init(M, DM, F.G, (int)blockIdx.x);
        pg8::EpiRes E{args.in[0], args.out, (bf16*)(ws + WS_HB), (float*)(ws + WS_SSQ), DM};
        pg8::gemm_phase<pg8::EpiRes, pg8::StaticOrder, PG8_ALIGN, PG8_SP2>(F.lds + RING_OFF, g, S, E);
        if (BOTH(4)) GRID_BAR();
    }
    if (IN(5)) {
        pg8::Gemm g{(const bf16*)(ws + WS_HB), (const bf16*)(ws + WS_WQ), M, DM, DM}; pg8::StaticOrder S; S.init(M, DM, F.G, (int)blockIdx.x);
        pg8::EpiRowScale E{(bf16*)(ws + WS_XN), DM, (const float*)(ws + WS_SSQ), 1.f / DM, EPS};
        pg8::gemm_phase<pg8::EpiRowScale, pg8::StaticOrder, PG8_ALIGN, PG8_SP2>(F.lds + RING_OFF, g, S, E);
        if (BOTH(5)) GRID_BAR();
    }
    if (IN(6)) { for (int rep = 0; rep < NREP(6); ++rep) topk_phase(F, args); if (BOTH(6)) GRID_BAR(); }
    if (IN(7)) { peer_phase(F, args); }
#undef IN
#undef BOTH
}


extern "C" void kernel_launch(void* const* d_in, const int* in_sizes, int n_in, void* d_out, int out_size, void* d_ws, size_t ws_size, hipStream_t stream) {
    static int grid = 0;
    if (grid == 0) {
        if (n_in != 16 || in_sizes[0] != M * DM || out_size != M * DM || ws_size < WS_END) { fprintf(stderr, "kernel_launch: unexpected shapes: n_in %d in0 %d out %d ws %zu\n", n_in, n_in > 0 ? in_sizes[0] : -1, out_size, ws_size); grid = -1; return; }
        int dev = 0, cus = 0;
        if (hipGetDevice(&dev) != hipSuccess || hipDeviceGetAttribute(&cus, hipDeviceAttributeMultiprocessorCount, dev) != hipSuccess) { grid = -1; return; }
        if (hipFuncSetAttribute((const void*)mk_fwd, hipFuncAttributeMaxDynamicSharedMemorySize, LDS_BYTES) != hipSuccess) { fprintf(stderr, "kernel_launch: hipFuncSetAttribute failed\n"); grid = -1; return; }
        (void)hipGetLastError();
        grid = cus;
    }
    if (grid < 0) return;
    (void)hipMemsetAsync((char*)d_ws + WS_CTL, 0, CTL_ZERO_BYTES, stream);
    Args a{};
    for (int i = 0; i < 16; ++i) a.in[i] = (const float*)d_in[i];
    a.out = (float*)d_out; a.ws = (unsigned char*)d_ws;
    a.ph_lo = 0; a.ph_hi = 8; a.li = 0;
    hipLaunchKernelGGL(mk_fwd, dim3(grid), dim3(NWAVES * 64), LDS_BYTES, stream, a);
}
```

```cpp
#define REP_PHASE -1

#include <hip/hip_runtime.h>
#include <cstdio>
#include <cstdint>
#include <cmath>
#ifndef REP_PHASE
#define REP_PHASE -1
#endif
#define NREP(k) ((REP_PHASE == (k)) ? 2 : 1)
namespace pg8 {
#define PG8_LAS __attribute__((address_space(3)))
typedef unsigned short bf16_t;
typedef short bf16x8 __attribute__((ext_vector_type(8)));
typedef float f32x4 __attribute__((ext_vector_type(4)));
typedef unsigned u32x4 __attribute__((ext_vector_type(4)));
constexpr int BM = 256, BK = 64, HALF = 128, HTB = HALF * BK * 2  , STAGE_BYTES = 8 * HTB, NXCD = 8, WGM = 8;

__host__ __device__ __forceinline__ int lds_byte(int r, int c) { const int st = (r >> 4) * 2 + (c >> 5), rr = r & 15, cc = c & 31, ob = rr * 64 + cc * 2; return st * 1024 + (ob ^ (((ob >> 9) & 1) << 5)); }
__host__ __device__ __forceinline__ void stage_rc(int b, int& R, int& C) { const int st = b / 1024, sb = b % 1024, swz = sb ^ (((sb >> 9) & 1) << 5); R = (st >> 1) * 16 + swz / 64; C = (st & 1) * 32 + (swz % 64) / 2; }
__host__ __device__ __forceinline__ int perm32(int rho) { const int n = rho >> 4, i = rho & 15; return 8 * (i >> 2) + 4 * n + (i & 3); }

struct Unit { int pm, pn; };
struct Gemm { const bf16_t* A; const bf16_t* Bt; int M, N, K; };

struct StaticOrder {
    int nM, nN, nwg, G, c;
    __host__ __device__ void init(int M, int N, int G_, int c_) { nM = M / BM; nN = N / BM; nwg = nM * nN; G = G_; c = c_; }
    __host__ __device__ bool next(int i, Unit& u) const {
        const long L = (long)i * G + c; if (L >= nwg) return false;
        int wgid = (int)L; { const int q = nwg / NXCD, r = nwg % NXCD, xcd = wgid % NXCD, off = wgid / NXCD; wgid = (xcd < r ? xcd * (q + 1) : r * (q + 1) + (xcd - r) * q) + off; }
        const int nig = WGM * nN, gid = wgid / nig, fm = gid * WGM, gsz = (nM - fm) < WGM ? (nM - fm) : WGM;
        u.pm = fm + ((wgid % nig) % gsz); u.pn = (wgid % nig) / gsz; return true;
    }
    __device__ __forceinline__ void a_ready(const Unit&) const {}
    __device__ __forceinline__ void done(const Unit&) const {}
};

__device__ __forceinline__ unsigned cvt_pk_bf16(float lo, float hi) { unsigned r; asm volatile("v_cvt_pk_bf16_f32 %0, %1, %2" : "=v"(r) : "v"(lo), "v"(hi)); return r; }
typedef float f32x2 __attribute__((ext_vector_type(2)));
__device__ __forceinline__ f32x2 gelu_pk(f32x2 v) {
    const f32x2 av = __builtin_elementwise_abs(v), d = av * 0.2316418882f + 1.0f;
    f32x2 t; t.x = __builtin_amdgcn_rcpf(d.x); t.y = __builtin_amdgcn_rcpf(d.y);
    f32x2 q = t * 0.5307027145f + (-0.7265760135f); q = q * t + 0.7107068705f; q = q * t + (-0.142248368f); q = q * t + 0.127414796f; q = q * t;
    const f32x2 s = (v * v) * (-0.72134752044f);
    f32x2 e; e.x = __builtin_amdgcn_exp2f(s.x); e.y = __builtin_amdgcn_exp2f(s.y);
    const f32x2 m = v * (q * e), r = v - m;
    f32x2 o; o.x = v.x < 0.f ? m.x : r.x; o.y = v.y < 0.f ? m.y : r.y; return o;
}

template <int ACT  > struct EpiBf16 {
    static constexpr bool PERM = true, AFTER_DRAIN = false; static_assert(ACT == 0 || ACT == 1, "EpiBf16: ACT is 0 (none) or 1 (gelu_pk)");
    bf16_t* O; int ldc; const float* bias; int split_cols; size_t split_stride; float scale0;
    __device__ __forceinline__ void operator()(const f32x4 (&acc)[2][2][4][2], const Unit& u, int wr, int wc, int fr, int fq) const {
        const int row0 = u.pm * BM + wr * 64 + fr; int colt = u.pn * BM; bf16_t* base = O;
        float sc = 1.f; if (split_cols) { const int t = colt / split_cols; base += (size_t)t * split_stride; colt -= t * split_cols; if (t == 0) sc = scale0; }
        const int col0 = colt + wc * 32 + 8 * fq, bcol0 = u.pn * BM + wc * 32 + 8 * fq;
        f32x4 bv[2][2];
#pragma unroll
        for (int bj = 0; bj < 2; ++bj)
#pragma unroll
            for (int n = 0; n < 2; ++n) bv[bj][n] = bias ? *(const f32x4*)(bias + bcol0 + bj * HALF + 4 * n) : (f32x4){0.f, 0.f, 0.f, 0.f};
#pragma unroll
        for (int ai = 0; ai < 2; ++ai)
#pragma unroll
            for (int m = 0; m < 4; ++m) { bf16_t* rowp = base + (size_t)(row0 + ai * HALF + m * 16) * ldc + col0;
#pragma unroll
                for (int bj = 0; bj < 2; ++bj) { f32x4 v0 = acc[ai][bj][m][0] + bv[bj][0], v1 = acc[ai][bj][m][1] + bv[bj][1];
                    if (ACT == 1) { f32x2 a = gelu_pk((f32x2){v0[0], v0[1]}), b = gelu_pk((f32x2){v0[2], v0[3]}), c = gelu_pk((f32x2){v1[0], v1[1]}), d = gelu_pk((f32x2){v1[2], v1[3]});
                        v0 = (f32x4){a.x, a.y, b.x, b.y}; v1 = (f32x4){c.x, c.y, d.x, d.y}; }
                    v0 = v0 * sc; v1 = v1 * sc; u32x4 w; w.x = cvt_pk_bf16(v0[0], v0[1]); w.y = cvt_pk_bf16(v0[2], v0[3]); w.z = cvt_pk_bf16(v1[0], v1[1]); w.w = cvt_pk_bf16(v1[2], v1[3]);
                    *(u32x4*)(rowp + bj * HALF) = w; } }
    }
};
template <class Epi, class Sched, bool ALIGN_EPI = false, bool SP2 = false>
__device__ __forceinline__ void gemm_phase(PG8_LAS unsigned char* lds, const Gemm g, const Sched& S, const Epi& E) {
    const int tid = threadIdx.x, wid = __builtin_amdgcn_readfirstlane(tid >> 6), lane = tid & 63, wr = wid >> 2, wc = wid & 3, fr = lane & 15, fq = lane >> 4;
    const int K = g.K, nt = K / BK;
    unsigned voffA[2], voffB[2];
#pragma unroll
    for (int i = 0; i < 2; ++i) { int R, C; stage_rc(tid * 16 + i * 8192, R, C); const int Rb = Epi::PERM ? ((R & ~31) + perm32(R & 31)) : R;
        voffA[i] = (unsigned)(R * K + C) * 2u; voffB[i] = (unsigned)(Rb * K + C) * 2u; }
    const size_t kstep = (size_t)(BK * 2);
    const size_t hstep = (size_t)HALF * K * 2;
    const size_t tstep = 2 * hstep;
    const unsigned ldsw = (unsigned)wid * 1024u;
    const int aoff = lds_byte(wr * 64 + fr, fq * 8), boff = lds_byte(wc * 32 + fr, fq * 8);
#define PG8_SA(b, h) (((b) * 2 + (h)) * HTB)
#define PG8_SB(b, h) ((4 + (b) * 2 + (h)) * HTB)
#define PG8_STAGE(bufoff, gbase, voff) do { _Pragma("unroll") for (int _i = 0; _i < 2; ++_i) \
        __builtin_amdgcn_global_load_lds((const unsigned*)((const char*)(gbase) + (voff)[_i]), (PG8_LAS unsigned*)(lds + (bufoff) + ldsw + _i * 8192), 16, 0, 0); } while (0)
#define PG8_LDA(dst, b, h) do { _Pragma("unroll") for (int m = 0; m < 4; ++m) _Pragma("unroll") for (int k = 0; k < 2; ++k) dst[m][k] = *(const PG8_LAS bf16x8*)(lds + PG8_SA(b, h) + aoff + m * 2048 + k * 1024); } while (0)
#define PG8_LDB(dst, b, h) do { _Pragma("unroll") for (int n = 0; n < 2; ++n) _Pragma("unroll") for (int k = 0; k < 2; ++k) dst[n][k] = *(const PG8_LAS bf16x8*)(lds + PG8_SB(b, h) + boff + n * 2048 + k * 1024); } while (0)
#define PG8_MMA(ai, bj, At, Bt) do { __builtin_amdgcn_s_setprio(1); _Pragma("unroll") for (int m = 0; m < 4; ++m) _Pragma("unroll") for (int n = 0; n < 2; ++n) _Pragma("unroll") for (int k = 0; k < 2; ++k) \
        acc[ai][bj][m][n] = __builtin_amdgcn_mfma_f32_16x16x32_bf16(Bt[n][k], At[m][k], acc[ai][bj][m][n], 0, 0, 0); __builtin_amdgcn_s_setprio(0); } while (0)
#define PG8_WAIT_V(n) asm volatile("s_waitcnt vmcnt(" #n ")" ::: "memory")
#define PG8_WAIT_L(n) asm volatile("s_waitcnt lgkmcnt(" #n ")" ::: "memory")
#define PG8_BAR __builtin_amdgcn_s_barrier()
#define PG8_SCHED __builtin_amdgcn_sched_barrier(0)
    Unit cur, nxt; int ui = 0;
    if (!S.next(0, cur)) return;
    f32x4 acc[2][2][4][2];
#pragma unroll
    for (int a = 0; a < 2; ++a)
#pragma unroll
        for (int b = 0; b < 2; ++b)
#pragma unroll
            for (int m = 0; m < 4; ++m)
#pragma unroll
                for (int n = 0; n < 2; ++n) acc[a][b][m][n] = (f32x4){0.f, 0.f, 0.f, 0.f};
    bf16x8 At[4][2], B0[2][2], B1[2][2];
    const char* cA = (const char*)g.A + (size_t)cur.pm * tstep; const char* cB = (const char*)g.Bt + (size_t)cur.pn * tstep;
    S.a_ready(cur);
    if constexpr (SP2) {
        PG8_STAGE(PG8_SB(0, 0), cB, voffB); PG8_STAGE(PG8_SB(0, 1), cB + hstep, voffB); PG8_STAGE(PG8_SA(0, 0), cA, voffA); PG8_STAGE(PG8_SA(0, 1), cA + hstep, voffA);
        if (wr == 1) PG8_BAR;
        PG8_WAIT_V(2); PG8_BAR;
        PG8_STAGE(PG8_SB(1, 0), cB + kstep, voffB); PG8_STAGE(PG8_SA(1, 0), cA + kstep, voffA); PG8_STAGE(PG8_SB(1, 1), cB + hstep + kstep, voffB);
        PG8_WAIT_V(6); PG8_BAR;
    } else {
        PG8_STAGE(PG8_SB(0, 0), cB, voffB); PG8_STAGE(PG8_SA(0, 0), cA, voffA); PG8_STAGE(PG8_SB(0, 1), cB + hstep, voffB); PG8_STAGE(PG8_SA(0, 1), cA + hstep, voffA);
        if (wr == 1) PG8_BAR;
        PG8_WAIT_V(4); PG8_BAR;
        PG8_STAGE(PG8_SB(1, 0), cB + kstep, voffB); PG8_STAGE(PG8_SA(1, 0), cA + kstep, voffA); PG8_STAGE(PG8_SB(1, 1), cB + hstep + kstep, voffB);
        PG8_WAIT_V(6); PG8_BAR;
    }
    for (;;) {
        const bool has_next = S.next(ui + 1, nxt);
        const char* nA = has_next ? (const char*)g.A + (size_t)nxt.pm * tstep : cA; const char* nB = has_next ? (const char*)g.Bt + (size_t)nxt.pn * tstep : cB;
        for (int t = 0; t < nt; t += 2) {
            const bool last = (t == nt - 2);
            const char* a1 = cA + (size_t)(t + 1) * kstep;
            const char* a2 = last ? nA : cA + (size_t)(t + 2) * kstep; const char* b2 = last ? nB : cB + (size_t)(t + 2) * kstep;
            const char* a3 = a2 + kstep; const char* b3 = b2 + kstep;
            if (last && has_next) S.a_ready(nxt);
            if constexpr (SP2) {
            PG8_LDB(B0, 0, 0); PG8_LDB(B1, 0, 1); PG8_SCHED; PG8_LDA(At, 0, 0); PG8_STAGE(PG8_SA(1, 1), a1 + hstep, voffA);
            PG8_WAIT_V(8); PG8_WAIT_L(0); PG8_BAR; PG8_MMA(0, 0, At, B0); PG8_MMA(0, 1, At, B1); PG8_BAR; PG8_SCHED;
            PG8_LDA(At, 0, 1); PG8_STAGE(PG8_SB(0, 0), b2, voffB); PG8_STAGE(PG8_SB(0, 1), b2 + hstep, voffB); PG8_STAGE(PG8_SA(0, 0), a2, voffA);
            PG8_WAIT_V(8); PG8_WAIT_L(0); PG8_BAR; PG8_MMA(1, 0, At, B0); PG8_MMA(1, 1, At, B1); PG8_BAR; PG8_SCHED;
            PG8_LDB(B0, 1, 0); PG8_LDB(B1, 1, 1); PG8_SCHED; PG8_LDA(At, 1, 0); PG8_STAGE(PG8_SA(0, 1), a2 + hstep, voffA);
            PG8_WAIT_V(8); PG8_WAIT_L(0); PG8_BAR; PG8_MMA(0, 0, At, B0); PG8_MMA(0, 1, At, B1); PG8_BAR; PG8_SCHED;
            PG8_LDA(At, 1, 1); PG8_STAGE(PG8_SB(1, 0), b3, voffB); PG8_STAGE(PG8_SB(1, 1), b3 + hstep, voffB); PG8_STAGE(PG8_SA(1, 0), a3, voffA);
            PG8_WAIT_V(8); PG8_WAIT_L(0); PG8_BAR; PG8_MMA(1, 0, At, B0); PG8_MMA(1, 1, At, B1); PG8_BAR; PG8_SCHED;
            } else {
            PG8_LDB(B0, 0, 0); PG8_SCHED; PG8_LDA(At, 0, 0); PG8_STAGE(PG8_SA(1, 1), a1 + hstep, voffA);
            PG8_WAIT_L(8); PG8_BAR; PG8_WAIT_L(0); PG8_MMA(0, 0, At, B0); PG8_BAR; PG8_SCHED;
            PG8_LDB(B1, 0, 1); PG8_STAGE(PG8_SB(0, 0), b2, voffB);
            PG8_BAR; PG8_WAIT_L(0); PG8_MMA(0, 1, At, B1); PG8_BAR;
            PG8_LDA(At, 0, 1); PG8_STAGE(PG8_SA(0, 0), a2, voffA);
            PG8_BAR; PG8_WAIT_L(0); PG8_MMA(1, 0, At, B0); PG8_BAR; PG8_SCHED;
            PG8_STAGE(PG8_SB(0, 1), b2 + hstep, voffB);
            PG8_WAIT_V(6); PG8_BAR; PG8_MMA(1, 1, At, B1); PG8_BAR;
            PG8_LDB(B0, 1, 0); PG8_SCHED; PG8_LDA(At, 1, 0); PG8_STAGE(PG8_SA(0, 1), a2 + hstep, voffA);
            PG8_WAIT_L(8); PG8_BAR; PG8_WAIT_L(0); PG8_MMA(0, 0, At, B0); PG8_BAR; PG8_SCHED;
            PG8_LDB(B1, 1, 1); PG8_STAGE(PG8_SB(1, 0), b3, voffB);
            PG8_BAR; PG8_WAIT_L(0); PG8_MMA(0, 1, At, B1); PG8_BAR;
            PG8_LDA(At, 1, 1); PG8_STAGE(PG8_SA(1, 0), a3, voffA);
            PG8_BAR; PG8_WAIT_L(0); PG8_MMA(1, 0, At, B0); PG8_BAR; PG8_SCHED;
            PG8_STAGE(PG8_SB(1, 1), b3 + hstep, voffB);
            PG8_WAIT_V(6); PG8_BAR; PG8_MMA(1, 1, At, B1); PG8_BAR;
            }
        }
        if constexpr (ALIGN_EPI) { if (wr == 0) PG8_BAR; }
        if constexpr (!Epi::AFTER_DRAIN) { E(acc, cur, wr, wc, fr, fq); S.done(cur); }
        if (!has_next) break;
#pragma unroll
        for (int a = 0; a < 2; ++a)
#pragma unroll
            for (int b = 0; b < 2; ++b)
#pragma unroll
                for (int m = 0; m < 4; ++m)
#pragma unroll
                    for (int n = 0; n < 2; ++n) acc[a][b][m][n] = (f32x4){0.f, 0.f, 0.f, 0.f};
        cur = nxt; cA = nA; cB = nB; ++ui;
        if constexpr (ALIGN_EPI) { if (wr == 1) PG8_BAR; }
    }
    PG8_WAIT_V(0);
    if constexpr (!ALIGN_EPI) { if (wr == 0) PG8_BAR; }
    PG8_BAR;
    if constexpr (Epi::AFTER_DRAIN) { E.fused(acc, cur, wr, wc, fr, fq, lds, wid, lane); S.done(cur); }
#undef PG8_SA
#undef PG8_SB
#undef PG8_STAGE
#undef PG8_LDA
#undef PG8_LDB
#undef PG8_MMA
#undef PG8_WAIT_V
#undef PG8_WAIT_L
#undef PG8_BAR
#undef PG8_SCHED
}
}

#ifndef PG8_SP2
#define PG8_SP2 true
#endif
#ifndef PG8_ALIGN
#define PG8_ALIGN true
#endif
#define GAS __attribute__((address_space(1)))
#define LAS __attribute__((address_space(3)))
typedef unsigned short bf16;
typedef unsigned v4u __attribute__((ext_vector_type(4)));
typedef float f32x4 __attribute__((ext_vector_type(4)));
typedef short bf16x8 __attribute__((ext_vector_type(8)));
typedef GAS unsigned gu32;
typedef GAS unsigned long long gu64;
#define RLX_AGENT __ATOMIC_RELAXED, __HIP_MEMORY_SCOPE_AGENT
#define LDS_WAIT() asm volatile("s_waitcnt lgkmcnt(0)" ::: "memory")
#define VM_WAIT() asm volatile("s_waitcnt vmcnt(0)" ::: "memory")
__device__ __forceinline__ unsigned long long rt() { return __builtin_amdgcn_s_memrealtime(); }
__device__ __forceinline__ unsigned f2bf(float f) { unsigned u = __builtin_bit_cast(unsigned, f); return (u + 0x7fffu + ((u >> 16) & 1u)) >> 16; }
__device__ __forceinline__ unsigned pk2(float lo, float hi) { return f2bf(lo) | (f2bf(hi) << 16); }

#define XB_TMO      128
#define XB_XCNT(j)  (256  + 64 * (j))
#define XB_XSUB(j)  (1280 + 64 * (j))
#define XB_XGEN(j)  (2304 + 64 * (j))
#define XB_TOP      3328
#define XB_TOPGEN   3392
#define XCD_BAR_WORDS 3456
#define XB_SPIN_CAP (1u << 18)

__device__ __forceinline__ unsigned xb_ld(unsigned* p)              { return __hip_atomic_load(p, __ATOMIC_RELAXED, __HIP_MEMORY_SCOPE_AGENT); }
__device__ __forceinline__ unsigned xb_add(unsigned* p, unsigned v) { return __hip_atomic_fetch_add(p, v, __ATOMIC_RELAXED, __HIP_MEMORY_SCOPE_AGENT); }
__device__ __forceinline__ unsigned xb_xcc_id() { return (unsigned)__builtin_amdgcn_s_getreg((3 << 11) | 20) & 0xFu; }
#define XB_SPIN(cond, bar) do { unsigned _sp = 0; while (cond) { __builtin_amdgcn_s_sleep(1); \
    if ((++_sp & 255u) == 0u) { if (xb_ld(&(bar)[XB_TMO])) break; if (_sp > XB_SPIN_CAP) { atomicAdd(&(bar)[XB_TMO], 1u); break; } } } } while (0)

struct XcdBarrier {
    unsigned* bar; unsigned x;
    volatile LAS unsigned* st;
};

__device__ __forceinline__ XcdBarrier xcd_barrier_post(unsigned* bar, volatile LAS unsigned* st) {
    XcdBarrier b; b.bar = bar; b.x = xb_xcc_id(); b.st = st;
    if (threadIdx.x == 0) (void)xb_add(&bar[XB_XCNT(b.x)], 1u);
    return b;
}
__device__ __forceinline__ void xcd_barrier_complete(unsigned* bar, unsigned x, unsigned& nloc, unsigned& nx) {
    const unsigned G = gridDim.x * gridDim.y * gridDim.z;
    unsigned sum, cnt, mine, sp = 0u;
    for (;;) {
        sum = 0u; cnt = 0u; mine = 0u;
#pragma unroll
        for (unsigned j = 0; j < 16; ++j) { const unsigned c = xb_ld(&bar[XB_XCNT(j)]); sum += c; cnt += (c > 0u) ? 1u : 0u; mine = (j == x) ? c : mine; }
        if (sum == G) break;
        __builtin_amdgcn_s_sleep(1);
        if ((++sp & 255u) == 0u) { if (xb_ld(&bar[XB_TMO])) break; if (sp > XB_SPIN_CAP) { atomicAdd(&bar[XB_TMO], 1u); break; } }
    }
    nloc = mine > 0u ? mine : 1u; nx = cnt > 0u ? cnt : 1u;
}

__device__ __forceinline__ void xcd_barrier(const XcdBarrier& b) {
    asm volatile("s_waitcnt vmcnt(0)" ::: "memory");
    __syncthreads();
    if (threadIdx.x == 0) {
        unsigned* bar = b.bar;
        __builtin_amdgcn_s_waitcnt(0);
        unsigned nloc = b.st[0], nx = b.st[1];
        if (nloc == 0u) { xcd_barrier_complete(bar, b.x, nloc, nx); b.st[0] = nloc; b.st[1] = nx; }
        const unsigned old = xb_add(&bar[XB_XSUB(b.x)], 1u);
        const unsigned gen = old / nloc;
        if (old + 1u == (gen + 1u) * nloc) {
            __builtin_amdgcn_fence(__ATOMIC_RELEASE, "agent");
            asm volatile("s_waitcnt vmcnt(0)" ::: "memory");
            const unsigned og = xb_add(&bar[XB_TOP], 1u);
            const unsigned tg = og / nx;
            if (og + 1u == (tg + 1u) * nx) xb_add(&bar[XB_TOPGEN], 1u);
            else XB_SPIN(xb_ld(&bar[XB_TOPGEN]) == tg, bar);
            __builtin_amdgcn_fence(__ATOMIC_ACQUIRE, "agent");
            xb_add(&bar[XB_XGEN(b.x)], 1u);
            asm volatile("s_waitcnt vmcnt(0)" ::: "memory");
        } else {
            XB_SPIN(xb_ld(&bar[XB_XGEN(b.x)]) == gen, bar);
            __builtin_amdgcn_fence(__ATOMIC_ACQUIRE, "agent");
            asm volatile("s_waitcnt vmcnt(0)" ::: "memory");
        }
    }
    __syncthreads();
}


constexpr int NWAVES = 8;
constexpr int DM = 2048, BATCH = 4, SEQ = 4096, M = BATCH * SEQ;
constexpr int NIN = 6176, NINP = 6400;
constexpr int O_GQ = 0, O_GK = 512, O_GV = 1024, O_GR = 2048, O_GDF = 3072, O_GDB = 3088, O_AQ = 3104, O_AK = 4128, O_AV = 5152;
constexpr float EPS = 1e-6f;
constexpr int PEER_K = 128;

constexpr size_t MiB = 1u << 20;
constexpr size_t WS_CTL = 0, CTL_ZERO_BYTES = 1 * MiB;
constexpr size_t WS_WIN = 1 * MiB;
constexpr size_t WS_WOUT = 26 * MiB;
constexpr size_t WS_WQ = 34 * MiB;
constexpr size_t WS_SSQ = 42 * MiB;
constexpr size_t WS_EIDX = 44 * MiB;
constexpr size_t WS_GATE = 52 * MiB;
constexpr size_t WS_SKB = 60 * MiB;
constexpr size_t WS_XN = 64 * MiB;
constexpr size_t WS_PROJ = 128 * MiB;
constexpr size_t WS_HB = 256 * MiB;
constexpr size_t WS_OF = 328 * MiB;
constexpr size_t WS_OB = 360 * MiB;
constexpr size_t WS_ATT = 392 * MiB;
constexpr size_t WS_ATTP = 392 * MiB;
constexpr size_t WS_ATTML = 488 * MiB;
constexpr size_t WS_GT_QD = 64 * MiB;
constexpr size_t WS_GT_KE = 96 * MiB;
constexpr size_t OUT_GT_AM = 0;
constexpr size_t OUT_GT_DEC = 16 * MiB;
constexpr size_t OUT_GT_VT = 32 * MiB;
constexpr int CW_ATTQ = 64;
constexpr size_t WS_END = 494 * MiB;
constexpr size_t WS_U8 = 128 * MiB;
constexpr size_t WS_V8 = 160 * MiB;
constexpr size_t WS_SU = 192 * MiB;
constexpr size_t WS_SV = 193 * MiB;
constexpr size_t WS_PW = 194 * MiB;
constexpr size_t WS_SSQ2 = 203 * MiB;
constexpr size_t WS_PD = 64 * MiB;
constexpr int PEER_E = 16384;
constexpr int CW_TMO = 0, CW_CODE = 1, CW_BAR = 4096;

constexpr int RING_OFF = 0, RING_BYTES = 131072;
constexpr int LDS_BYTES = 163840;
constexpr int LDSCTL_OFF = LDS_BYTES - 1024, MISC_OFF = LDSCTL_OFF + 320;

typedef float f32x2 __attribute__((ext_vector_type(2)));
__device__ __forceinline__ float bf2f(unsigned short h) { return __builtin_bit_cast(float, (unsigned)h << 16); }
__device__ __forceinline__ float bflo(unsigned w) { return __builtin_bit_cast(float, w << 16); }
__device__ __forceinline__ float bfhi(unsigned w) { return __builtin_bit_cast(float, w & 0xffff0000u); }
__device__ __forceinline__ float wave_sum(float v) {
#pragma unroll
    for (int o = 1; o < 64; o <<= 1) v += __shfl_xor(v, o);
    return v;
}
__device__ __forceinline__ float wave_max(float v) {
#pragma unroll
    for (int o = 1; o < 64; o <<= 1) v = fmaxf(v, __shfl_xor(v, o));
    return v;
}

template <class T> __device__ __forceinline__ T* opaque(T* p) { asm volatile("" : "+s"(p)); return p; }
__device__ __forceinline__ int opaque_v(int x) { asm volatile("" : "+v"(x)); return x; }
template <class T> __device__ __forceinline__ T ldu(const void* ubase, unsigned voff) { return *(const T*)((const char*)ubase + voff); }
template <class T> __device__ __forceinline__ void stu(void* ubase, unsigned voff, T v) { *(T*)((char*)ubase + voff) = v; }
namespace pg8 {
struct EpiRes {
    static constexpr bool PERM = false, AFTER_DRAIN = false;
    const float* x; float* H; bf16_t* HB; float* ssq; int ldc;
    __device__ __forceinline__ void operator()(const f32x4 (&acc)[2][2][4][2], const Unit& u, int wr, int wc, int fr, int fq) const {
        const int col0 = u.pn * BM + wc * 32 + 4 * fq;
#pragma unroll
        for (int ai = 0; ai < 2; ++ai)
#pragma unroll
            for (int m = 0; m < 4; ++m) {
                const int r = u.pm * BM + ai * HALF + wr * 64 + m * 16 + fr; const size_t off = (size_t)r * ldc + col0; float s = 0.f;
#pragma unroll
                for (int bj = 0; bj < 2; ++bj)
#pragma unroll
                    for (int n = 0; n < 2; ++n) {
                        const f32x4 xv = *(const f32x4*)(x + off + bj * HALF + n * 16);
                        const f32x4 hv = xv + acc[ai][bj][m][n];
                        *(f32x4*)(H + off + bj * HALF + n * 16) = hv;
                        s += (hv[0] * hv[0] + hv[1] * hv[1]) + (hv[2] * hv[2] + hv[3] * hv[3]);
                        unsigned long long w = (unsigned long long)cvt_pk_bf16(hv[0], hv[1]) | ((unsigned long long)cvt_pk_bf16(hv[2], hv[3]) << 32);
                        *(unsigned long long*)(HB + off + bj * HALF + n * 16) = w;
                    }
                s += __shfl_xor(s, 16); s += __shfl_xor(s, 32);
                if (fq == 0) ssq[(size_t)r * 32 + u.pn * 4 + wc] = s;
            }
    }
};
struct EpiRowScale {
    static constexpr bool PERM = true, AFTER_DRAIN = false;
    bf16_t* O; int ldc; const float* ssq; float inv_n, eps;
    __device__ __forceinline__ void operator()(const f32x4 (&acc)[2][2][4][2], const Unit& u, int wr, int wc, int fr, int fq) const {
        const int col0 = u.pn * BM + wc * 32 + 8 * fq;
#pragma unroll
        for (int ai = 0; ai < 2; ++ai)
#pragma unroll
            for (int m = 0; m < 4; ++m) {
                const int r = u.pm * BM + ai * HALF + wr * 64 + m * 16 + fr;
                const f32x4* sp = (const f32x4*)(ssq + (size_t)r * 32); float s = 0.f;
#pragma unroll
                for (int i = 0; i < 8; ++i) { const f32x4 t = sp[i]; s += (t[0] + t[1]) + (t[2] + t[3]); }
                const float sc = 1.0f / sqrtf(s * inv_n + eps);
                bf16_t* rowp = O + (size_t)r * ldc + col0;
#pragma unroll
                for (int bj = 0; bj < 2; ++bj) { const f32x4 v0 = acc[ai][bj][m][0] * sc, v1 = acc[ai][bj][m][1] * sc;
                    u32x4 w; w.x = cvt_pk_bf16(v0[0], v0[1]); w.y = cvt_pk_bf16(v0[2], v0[3]); w.z = cvt_pk_bf16(v1[0], v1[1]); w.w = cvt_pk_bf16(v1[2], v1[3]);
                    *(u32x4*)(rowp + bj * HALF) = w; }
            }
    }
};
}

struct Frame {
    LAS unsigned char* lds;
    volatile LAS unsigned* MISC;
    gu32* ctl;
    int tid, lane, wave;
    int vcu, G;
};

__device__ __forceinline__ void p0_transpose_item(const float* W, int K, int ldw, const float* gk, bf16* WT, LAS float* scr, int item, int lane) {
    const int nblk = ldw / 32, kb = item / nblk, nb = item % nblk, k0 = 64 * kb, n0 = 32 * nb;
#pragma unroll 8
    for (int i = 0; i < 32; ++i) { const int kk = 2 * i + (lane >> 5); float w = W[(size_t)(k0 + kk) * ldw + n0 + (lane & 31)]; if (gk) w *= gk[k0 + kk]; scr[kk * 33 + (lane & 31)] = w; }
    LDS_WAIT(); asm volatile("" ::: "memory");
    const int c = lane & 7;
#pragma unroll
    for (int j = 0; j < 4; ++j) { const int n = (lane >> 3) + 8 * j; const LAS float* s = scr + (8 * c) * 33 + n;
        v4u o; o.x = pk2(s[0 * 33], s[1 * 33]); o.y = pk2(s[2 * 33], s[3 * 33]); o.z = pk2(s[4 * 33], s[5 * 33]); o.w = pk2(s[6 * 33], s[7 * 33]);
        *(GAS v4u*)(WT + (size_t)(n0 + n) * K + k0 + 8 * c) = o; }
    LDS_WAIT(); asm volatile("" ::: "memory");
}
__device__ __forceinline__ void rms_row_to_bf16(int lane, const float* xrow, const float* g, bf16* orow) {
    const GAS f32x4* xr = (const GAS f32x4*)xrow + lane; const GAS f32x4* gr = (const GAS f32x4*)g + lane;
    f32x4 v[8]; float s = 0.f;
#pragma unroll
    for (int j = 0; j < 8; ++j) { v[j] = xr[64 * j]; s += (v[j].x * v[j].x + v[j].y * v[j].y) + (v[j].z * v[j].z + v[j].w * v[j].w); }
    const float rstd = 1.f / sqrtf(wave_sum(s) * (1.f / DM) + EPS);
    GAS unsigned long long* o8 = (GAS unsigned long long*)orow + lane;
#pragma unroll
    for (int j = 0; j < 8; ++j) { const f32x4 gg = gr[64 * j];
        o8[64 * j] = (unsigned long long)pk2(v[j].x * rstd * gg.x, v[j].y * rstd * gg.y) | ((unsigned long long)pk2(v[j].z * rstd * gg.z, v[j].w * rstd * gg.w) << 32); }
}

struct Args {
    const float* in[16]; float* out; unsigned char* ws; int ph_lo, ph_hi, li, pad;
};

__device__ __forceinline__ void p0_prologue(Frame& F, const Args& a) {
    unsigned char* ws = a.ws;
    LAS float* scr = (LAS float*)(F.lds + RING_OFF + F.wave * 16384);
    const int gw = F.vcu * NWAVES + F.wave, NGW = F.G * NWAVES;
    bf16* Win_t = (bf16*)(ws + WS_WIN); bf16* Wout_t = (bf16*)(ws + WS_WOUT); bf16* Wq_t = (bf16*)(ws + WS_WQ); bf16* XN = (bf16*)(ws + WS_XN);
    constexpr int I_IN = (DM / 64) * (NIN / 32), I_SQ = (DM / 64) * (DM / 32);
    constexpr int NITEMS = I_IN + 2 * I_SQ;
    for (int it = gw; it < NITEMS; it += NGW) {
        int r = it;
        if (r < I_IN) { p0_transpose_item(a.in[2], DM, NIN, nullptr, Win_t, scr, r, F.lane); continue; } r -= I_IN;
        if (r < I_SQ) { p0_transpose_item(a.in[9], DM, DM, nullptr, Wout_t, scr, r, F.lane); continue; } r -= I_SQ;
        p0_transpose_item(a.in[11], DM, DM, a.in[10], Wq_t, scr, r, F.lane);
    }
    { GAS v4u* z = (GAS v4u*)(Win_t + (size_t)NIN * DM); const int n16 = (NINP - NIN) * DM * 2 / 16;
      for (int i = (gw * 64 + F.lane); i < n16; i += NGW * 64) z[i] = (v4u){0u, 0u, 0u, 0u}; }
    { const f32x4* sk = (const f32x4*)a.in[12]; unsigned long long* skb = (unsigned long long*)(ws + WS_SKB);
      for (int i = gw * 64 + F.lane; i < 8 * 2 * 128 * 128 / 4; i += NGW * 64) { const f32x4 v = sk[i]; skb[i] = (unsigned long long)pk2(v.x, v.y) | ((unsigned long long)pk2(v.z, v.w) << 32); } }
    for (int m = gw; m < M; m += NGW) rms_row_to_bf16(F.lane, a.in[0] + (size_t)m * DM, a.in[1], XN + (size_t)m * DM);
}

__device__ __forceinline__ void p3_finalize(Frame& F, const Args& a) {
    unsigned char* ws = a.ws;
    const int gw = F.vcu * NWAVES + F.wave, NGW = F.G * NWAVES, lane = F.lane;
    const bf16* OFp = (const bf16*)(ws + WS_OF); const bf16* OBp = (const bf16*)(ws + WS_OB);
    const bf16* PROJ = (const bf16*)(ws + WS_PROJ); bf16* Y = (bf16*)(ws + WS_XN);
    const float* gla_g = a.in[7]; const float* att_g = a.in[8];
    const f32x4 gg = *(const f32x4*)(gla_g + 4 * lane);
    for (int m = gw; m < M; m += NGW) {
#pragma unroll
        for (int hh = 0; hh < 4; ++hh) {
            const unsigned long long wf = *(const unsigned long long*)(OFp + (size_t)m * 1024 + hh * 256 + 4 * lane);
            const unsigned long long wb = *(const unsigned long long*)(OBp + (size_t)m * 1024 + hh * 256 + 4 * lane);
            const f32x4 o = (f32x4){bflo((unsigned)wf) + bflo((unsigned)wb), bfhi((unsigned)wf) + bfhi((unsigned)wb), bflo((unsigned)(wf >> 32)) + bflo((unsigned)(wb >> 32)), bfhi((unsigned)(wf >> 32)) + bfhi((unsigned)(wb >> 32))};
            const float ss = wave_sum((o.x * o.x + o.y * o.y) + (o.z * o.z + o.w * o.w));
            const float rstd = 1.f / sqrtf(ss * (1.f / 256.f) + EPS);
            const unsigned long long gr = *(const unsigned long long*)(PROJ + (size_t)m * NINP + O_GR + hh * 256 + 4 * lane);
            const float r0 = bflo((unsigned)gr), r1 = bfhi((unsigned)gr), r2 = bflo((unsigned)(gr >> 32)), r3 = bfhi((unsigned)(gr >> 32));
            const float y0 = o.x * rstd * gg.x * (r0 / (1.f + __expf(-r0))), y1 = o.y * rstd * gg.y * (r1 / (1.f + __expf(-r1)));
            const float y2 = o.z * rstd * gg.z * (r2 / (1.f + __expf(-r2))), y3 = o.w * rstd * gg.w * (r3 / (1.f + __expf(-r3)));
            *(unsigned long long*)(Y + (size_t)m * DM + hh * 256 + 4 * lane) = (unsigned long long)pk2(y0, y1) | ((unsigned long long)pk2(y2, y3) << 32);
        }
        float av[16]; float ss = 0.f;
#pragma unroll
        for (int p = 0; p < 2; ++p) { const int col = p * 512 + 8 * lane, hd = col >> 6; float mm[3], ll[3]; v4u ow[3];
#pragma unroll
            for (int pt = 0; pt < 3; ++pt) { const size_t rec = ((size_t)pt * M + m) * 16 + hd; const f32x2 ml2 = *(const f32x2*)((const float*)(ws + WS_ATTML) + rec * 2); mm[pt] = ml2.x; ll[pt] = ml2.y;
                ow[pt] = *(const v4u*)((const bf16*)(ws + WS_ATTP) + rec * 64 + (col & 63)); }
            const float mt = fmaxf(fmaxf(mm[0], mm[1]), mm[2]); const float w0 = __expf(mm[0] - mt), w1 = __expf(mm[1] - mt), w2 = __expf(mm[2] - mt);
            const float inv = 1.f / (w0 * ll[0] + w1 * ll[1] + w2 * ll[2]);
            av[p * 8 + 0] = (w0 * bflo(ow[0].x) + w1 * bflo(ow[1].x) + w2 * bflo(ow[2].x)) * inv; av[p * 8 + 1] = (w0 * bfhi(ow[0].x) + w1 * bfhi(ow[1].x) + w2 * bfhi(ow[2].x)) * inv;
            av[p * 8 + 2] = (w0 * bflo(ow[0].y) + w1 * bflo(ow[1].y) + w2 * bflo(ow[2].y)) * inv; av[p * 8 + 3] = (w0 * bfhi(ow[0].y) + w1 * bfhi(ow[1].y) + w2 * bfhi(ow[2].y)) * inv;
            av[p * 8 + 4] = (w0 * bflo(ow[0].z) + w1 * bflo(ow[1].z) + w2 * bflo(ow[2].z)) * inv; av[p * 8 + 5] = (w0 * bfhi(ow[0].z) + w1 * bfhi(ow[1].z) + w2 * bfhi(ow[2].z)) * inv;
            av[p * 8 + 6] = (w0 * bflo(ow[0].w) + w1 * bflo(ow[1].w) + w2 * bflo(ow[2].w)) * inv; av[p * 8 + 7] = (w0 * bfhi(ow[0].w) + w1 * bfhi(ow[1].w) + w2 * bfhi(ow[2].w)) * inv; }
#pragma unroll
        for (int i = 0; i < 16; ++i) ss += av[i] * av[i];
        const float rstd = 1.f / sqrtf(wave_sum(ss) * (1.f / 1024.f) + EPS);
#pragma unroll
        for (int p = 0; p < 2; ++p) { const f32x4 g0 = *(const f32x4*)(att_g + p * 512 + 8 * lane), g1 = *(const f32x4*)(att_g + p * 512 + 8 * lane + 4);
            v4u w; w.x = pk2(av[p * 8 + 0] * rstd * g0.x, av[p * 8 + 1] * rstd * g0.y); w.y = pk2(av[p * 8 + 2] * rstd * g0.z, av[p * 8 + 3] * rstd * g0.w);
            w.z = pk2(av[p * 8 + 4] * rstd * g1.x, av[p * 8 + 5] * rstd * g1.y); w.w = pk2(av[p * 8 + 6] * rstd * g1.z, av[p * 8 + 7] * rstd * g1.w);
            *(v4u*)(Y + (size_t)m * DM + 1024 + p * 512 + 8 * lane) = w; }
    }
}


__device__ __forceinline__ void naive_gla_phase(Frame& F, const Args& a) {
    unsigned char* ws = a.ws; const bf16* PROJ = (const bf16*)(ws + WS_PROJ);
    const int half = F.tid >> 8, tid = F.tid & 255, e = tid & 15, dg = tid >> 4, d0 = dg * 8;
    LAS float* sm = (LAS float*)(F.lds + RING_OFF + half * 32768);
    LAS float* qs = sm; LAS float* ks = sm + 2048; LAS float* as_ = sm + 4096; LAS float* gds = sm + 6144; LAS float* vs = sm + 6400; LAS float* psum = sm + 6656;
    for (int ui = F.vcu; ui < 256; ui += F.G) {
        const int unit = ui * 2 + half;
        const int e0 = (unit & 15) * 16, h = (unit >> 4) & 3, b = (unit >> 6) & 3, dir = unit >> 8;
        const float* up = dir ? a.in[5] : a.in[3]; const float* bias = dir ? a.in[6] : a.in[4]; float* Out = (float*)(ws + (dir ? WS_OB : WS_OF));
        float S[8];
#pragma unroll
        for (int j = 0; j < 8; ++j) S[j] = 0.f;
        for (int t0 = 0; t0 < SEQ; t0 += 16) {
            for (int idx = tid; idx < 16 * 128; idx += 256) { const int i = idx >> 7, d = idx & 127; const int t = dir ? (SEQ - 1 - (t0 + i)) : (t0 + i); const size_t row = (size_t)b * SEQ + t;
                qs[i * 128 + d] = bf2f(PROJ[row * NINP + O_GQ + h * 128 + d]) * 0.08838834764831845f; ks[i * 128 + d] = bf2f(PROJ[row * NINP + O_GK + h * 128 + d]); }
            { const int i = tid >> 4, r = tid & 15; const int t = dir ? (SEQ - 1 - (t0 + i)) : (t0 + i); const size_t row = (size_t)b * SEQ + t;
              gds[i * 16 + r] = bf2f(PROJ[row * NINP + O_GDF + dir * 16 + r]); vs[i * 16 + r] = bf2f(PROJ[row * NINP + O_GV + h * 256 + e0 + r]); }
            __syncthreads();
            for (int idx = tid; idx < 16 * 128; idx += 256) { const int i = idx >> 7, d = idx & 127; float z = bias[h * 128 + d];
#pragma unroll
                for (int r = 0; r < 16; ++r) z += gds[i * 16 + r] * up[r * 512 + h * 128 + d];
                const float ls = fminf(z, 0.f) - log1pf(expf(-fabsf(z))); as_[i * 128 + d] = expf(ls * (1.f / 16.f)); }
            __syncthreads();
            for (int i = 0; i < 16; ++i) { const float v = vs[i * 16 + e]; float p = 0.f;
#pragma unroll
                for (int j = 0; j < 8; ++j) { S[j] = as_[i * 128 + d0 + j] * S[j] + ks[i * 128 + d0 + j] * v; p += qs[i * 128 + d0 + j] * S[j]; }
                p += __shfl_xor(p, 16); p += __shfl_xor(p, 32);
                if ((tid & 63) < 16) psum[(i * 4 + (tid >> 6)) * 16 + e] = p; }
            __syncthreads();
            { const int i = tid >> 4, ee = tid & 15; const int t = dir ? (SEQ - 1 - (t0 + i)) : (t0 + i); const size_t row = (size_t)b * SEQ + t;
              Out[row * 1024 + h * 256 + e0 + ee] = (psum[(i * 4 + 0) * 16 + ee] + psum[(i * 4 + 1) * 16 + ee]) + (psum[(i * 4 + 2) * 16 + ee] + psum[(i * 4 + 3) * 16 + ee]); }
        }
        __syncthreads();
    }
}

__device__ __forceinline__ void naive_attn_phase(Frame& F, const Args& a) {
    unsigned char* ws = a.ws; const bf16* PROJ = (const bf16*)(ws + WS_PROJ); bf16* ATT = (bf16*)(ws + WS_ATT);
    for (int gid2 = F.vcu * 512 + F.tid; gid2 < M * 32; gid2 += F.G * 512) {
        const int hf = gid2 & 1, gid = gid2 >> 1;
        const int h = gid & 15, row = gid >> 4, b = row >> 12, t = row & (SEQ - 1);
        float q[32], o[32];
        const bf16* qp = PROJ + (size_t)row * NINP + O_AQ + h * 64 + hf * 32;
#pragma unroll
        for (int i = 0; i < 32; ++i) { q[i] = bf2f(qp[i]) * 0.125f; o[i] = 0.f; }
        const float slope = exp2f(-0.5f * (float)(h + 1));
        float m = -1e30f, l = 0.f;
        for (int p = 0; p < 3; ++p) { const int dil = (p == 0) ? 1 : (p == 1 ? 4 : 16);
            for (int j = -64; j <= 64; ++j) { const int tk = t + j * dil; if (tk < 0 || tk >= SEQ) continue;
                const bf16* kp = PROJ + ((size_t)b * SEQ + tk) * NINP + O_AK + h * 64 + hf * 32; const bf16* vp = kp + (O_AV - O_AK);
                float s = 0.f;
#pragma unroll
                for (int i = 0; i < 32; ++i) s += q[i] * bf2f(kp[i]);
                s += __shfl_xor(s, 1);
                s -= slope * (float)((j < 0 ? -j : j) * dil);
                const float mn = fmaxf(m, s), sc = __expf(m - mn), pe = __expf(s - mn); l = l * sc + pe; m = mn;
#pragma unroll
                for (int i = 0; i < 32; ++i) o[i] = o[i] * sc + pe * bf2f(vp[i]); } }
        const float il = 1.f / l; bf16* op = ATT + (size_t)row * 1024 + h * 64 + hf * 32;
#pragma unroll
        for (int i = 0; i < 32; ++i) op[i] = (bf16)f2bf(o[i] * il);
    }
}

__device__ __forceinline__ void wave_argmax(float& v, int& idx) {
#pragma unroll
    for (int o = 1; o < 64; o <<= 1) { const float ov = __shfl_xor(v, o); const int oi = __shfl_xor(idx, o); if (ov > v || (ov == v && oi < idx)) { v = ov; idx = oi; } }
}
__device__ __forceinline__ void naive_topk_phase(Frame& F, const Args& a) {
    unsigned char* ws = a.ws; const bf16* QP = (const bf16*)(ws + WS_XN); const float* subk = a.in[12]; int* EIDX = (int*)(ws + WS_EIDX); float* GATE = (float*)(ws + WS_GATE);
    LAS float* qsh = (LAS float*)(F.lds + RING_OFF + F.wave * 4096);
    LAS int* sid = (LAS int*)(qsh + 256);
    LAS float* sgt = (LAS float*)(qsh + 384);
    const int lane = F.lane;
    for (int row = F.vcu * NWAVES + F.wave; row < M; row += F.G * NWAVES) {
        for (int h = 0; h < 8; ++h) {
            const bf16* qp = QP + (size_t)row * DM + h * 256;
#pragma unroll
            for (int i = 0; i < 4; ++i) qsh[lane + 64 * i] = bf2f(qp[lane + 64 * i]);
            LDS_WAIT(); asm volatile("" ::: "memory");
            float tv[2]; int ti[2];
#pragma unroll
            for (int c = 0; c < 2; ++c) {
                const float* k0 = subk + (((size_t)h * 2 + c) * 128 + lane) * 128; const float* k1 = k0 + 64 * 128;
                float av = 0.f, bsc = 0.f;
#pragma unroll 4
                for (int d = 0; d < 128; d += 4) { const f32x4 x0 = *(const f32x4*)(k0 + d), x1 = *(const f32x4*)(k1 + d); const float q0 = qsh[c * 128 + d], q1 = qsh[c * 128 + d + 1], q2 = qsh[c * 128 + d + 2], q3 = qsh[c * 128 + d + 3];
                    av += q0 * x0.x + q1 * x0.y + q2 * x0.z + q3 * x0.w; bsc += q0 * x1.x + q1 * x1.y + q2 * x1.z + q3 * x1.w; }
                float keepv = -3e38f; int keepi = 0;
                for (int r = 0; r < 16; ++r) { float v; int idx; if (av >= bsc) { v = av; idx = lane; } else { v = bsc; idx = lane + 64; }
                    wave_argmax(v, idx);
                    if (idx == lane) av = -3e38f; if (idx == lane + 64) bsc = -3e38f;
                    if (lane == r) { keepv = v; keepi = idx; } }
                tv[c] = keepv; ti[c] = keepi;
            }
            float cv[4];
#pragma unroll
            for (int u = 0; u < 4; ++u) { const int id = lane * 4 + u; cv[u] = __shfl(tv[0], id >> 4) + __shfl(tv[1], id & 15); }
            float topv = -3e38f; int topid = 0;
            for (int r = 0; r < 16; ++r) { float v = cv[0]; int idx = lane * 4;
#pragma unroll
                for (int u = 1; u < 4; ++u) if (cv[u] > v) { v = cv[u]; idx = lane * 4 + u; }
                wave_argmax(v, idx);
                if ((idx >> 2) == lane) {
#pragma unroll
                    for (int u = 0; u < 4; ++u) if ((idx & 3) == u) cv[u] = -3e38f; }
                if (lane == r) { topv = v; topid = idx; } }
            const int i1 = __shfl(ti[0], topid >> 4), i2 = __shfl(ti[1], topid & 15);
            const float vm = (lane < 16) ? topv : -3e38f; const float mx = wave_max(vm);
            const float ex = (lane < 16) ? __expf(topv - mx) : 0.f; const float sm = wave_sum(ex);
            if (lane < 16) { sid[h * 16 + lane] = i1 * 128 + i2; sgt[h * 16 + lane] = ex / sm; }
            LDS_WAIT(); asm volatile("" ::: "memory");
        }
        const int m0 = sid[lane], m1 = sid[lane + 64]; const float g0 = sgt[lane], g1 = sgt[lane + 64];
        int r0 = 0, r1 = 0;
        for (int j = 0; j < 128; ++j) { const int o = sid[j]; r0 += (o < m0 || (o == m0 && j < lane)) ? 1 : 0; r1 += (o < m1 || (o == m1 && j < lane + 64)) ? 1 : 0; }
        EIDX[(size_t)row * 128 + r0] = m0; GATE[(size_t)row * 128 + r0] = g0;
        EIDX[(size_t)row * 128 + r1] = m1; GATE[(size_t)row * 128 + r1] = g1;
        LDS_WAIT(); asm volatile("" ::: "memory");
    }
}

typedef float f32x16 __attribute__((ext_vector_type(16)));
__device__ __forceinline__ void ce_desc(float& a, float& b) { const float hi = fmaxf(a, b), lo = fminf(a, b); a = hi; b = lo; }
__device__ __forceinline__ void sort16_desc(float* v) {
#pragma unroll
    for (int k = 2; k <= 16; k <<= 1)
#pragma unroll
        for (int j = k >> 1; j > 0; j >>= 1)
#pragma unroll
            for (int i = 0; i < 16; ++i) { const int l = i ^ j; if (l > i) { if ((i & k) == 0 || k == 16) ce_desc(v[i], v[l]); else ce_desc(v[l], v[i]); } }
}
__device__ __forceinline__ void merge16_desc(float* v) {
#pragma unroll
    for (int j = 8; j > 0; j >>= 1)
#pragma unroll
        for (int i = 0; i < 16; ++i) { const int l = i ^ j; if (l > i) ce_desc(v[i], v[l]); }
}
__device__ __forceinline__ void top16_of_two(float* a, const float* b) {
#pragma unroll
    for (int i = 0; i < 16; ++i) a[i] = fmaxf(a[i], b[15 - i]);
    merge16_desc(a);
}
__device__ __forceinline__ void top16_of_64(float* v) {
    sort16_desc(v); sort16_desc(v + 16); sort16_desc(v + 32); sort16_desc(v + 48);
    top16_of_two(v, v + 16); top16_of_two(v + 32, v + 48); top16_of_two(v, v + 32);
}
__device__ __forceinline__ void topk_phase(Frame& F, const Args& a) {
    unsigned char* ws = a.ws; const bf16* QP = (const bf16*)(ws + WS_XN); const bf16* SKB = (const bf16*)(ws + WS_SKB); int* EIDX = (int*)(ws + WS_EIDX); float* GATE = (float*)(ws + WS_GATE);
    const int lane = F.lane, h = F.wave, r32 = lane & 31, hh = lane >> 5;
    LAS int* tok_id = (LAS int*)(F.lds);
    LAS float* tok_gt = (LAS float*)(F.lds + 32768);
    LAS int* ktab = (LAS int*)(F.lds + 65536 + F.wave * 8192);
    for (int unit = F.vcu; unit < M / 64; unit += F.G) {
        const int tok0 = unit * 64;
#pragma unroll 1
        for (int tt = 0; tt < 2; ++tt) {
            const size_t row = (size_t)(tok0 + tt * 32 + r32);
            float L[2][16];
#pragma unroll
            for (int c = 0; c < 2; ++c) {
                f32x16 acc[4];
#pragma unroll
                for (int kt = 0; kt < 4; ++kt) acc[kt] = (f32x16){0.f, 0.f, 0.f, 0.f, 0.f, 0.f, 0.f, 0.f, 0.f, 0.f, 0.f, 0.f, 0.f, 0.f, 0.f, 0.f};
                const bf16* qb = QP + row * DM + h * 256 + c * 128 + 8 * hh;
                const bf16* kb = SKB + ((size_t)(h * 2 + c) * 128 + r32) * 128 + 8 * hh;
#if !defined(TOPK_DBG)
#pragma unroll 2
                for (int st = 0; st < 8; ++st) {
                    const bf16x8 bq = *(const bf16x8*)(qb + 16 * st);
#pragma unroll
                    for (int kt = 0; kt < 4; ++kt) { const bf16x8 ak = *(const bf16x8*)(kb + (size_t)kt * 32 * 128 + 16 * st);
                        acc[kt] = __builtin_amdgcn_mfma_f32_32x32x16_bf16(ak, bq, acc[kt], 0, 0, 0); }
                }
#else
                (void)qb; (void)kb;
#pragma unroll
                for (int kt = 0; kt < 4; ++kt)
#pragma unroll
                    for (int r = 0; r < 16; ++r) { const int key = 32 * kt + (r & 3) + 8 * (r >> 2) + 4 * hh; float d = 0.f;
                        const bf16* qq = QP + row * DM + h * 256 + c * 128; const float* kk = a.in[12] + ((size_t)(h * 2 + c) * 128 + key) * 128;
                        for (int dd = 0; dd < 128; ++dd) d += bf2f(qq[dd]) * kk[dd];
                        acc[kt][r] = d; }
#endif
                float v[64];
#pragma unroll
                for (int kt = 0; kt < 4; ++kt)
#pragma unroll
                    for (int r = 0; r < 16; ++r) { const int key = 32 * kt + (r & 3) + 8 * (r >> 2);
                        const float sc = acc[kt][r];
                        v[kt * 16 + r] = __builtin_bit_cast(float, (__builtin_bit_cast(unsigned, sc) & ~127u) | (unsigned)(key + 4 * hh)); }
                top16_of_64(v);
                float p[16];
#pragma unroll
                for (int i = 0; i < 16; ++i) p[i] = __shfl_xor(v[i], 32);
                top16_of_two(v, p);
#pragma unroll
                for (int i = 0; i < 16; ++i) { L[c][i] = v[i]; ktab[(c * 16 + i) * 64 + lane] = (int)(__builtin_bit_cast(unsigned, v[i]) & 127u); }
            }
            float cnd[64];
            { int n = 0;
#pragma unroll
              for (int i = 0; i < 16; ++i)
#pragma unroll
                  for (int j = 0; j < 16; ++j) if ((i + 1) * (j + 1) <= 16) { cnd[n] = __builtin_bit_cast(float, (__builtin_bit_cast(unsigned, L[0][i] + L[1][j]) & ~255u) | (unsigned)((i << 4) | j)); ++n; }
#pragma unroll
              for (int q = 50; q < 64; ++q) cnd[q] = -3.0e38f; }
            top16_of_64(cnd);
            float mx = __builtin_bit_cast(float, __builtin_bit_cast(unsigned, cnd[0]) & ~255u), sum = 0.f; float ex[16];
#pragma unroll
            for (int i = 0; i < 16; ++i) { ex[i] = __expf(__builtin_bit_cast(float, __builtin_bit_cast(unsigned, cnd[i]) & ~255u) - mx); sum += ex[i]; }
            const float inv = 1.f / sum;
            LDS_WAIT(); asm volatile("" ::: "memory");
            if (hh == 0) {
#pragma unroll
                for (int i = 0; i < 16; ++i) { const unsigned bits = __builtin_bit_cast(unsigned, cnd[i]); const int ia = (bits >> 4) & 15, jb = bits & 15;
                    const int e = ktab[ia * 64 + lane] * 128 + ktab[(16 + jb) * 64 + lane];
                    tok_id[(tt * 32 + r32) * 128 + h * 16 + i] = e; tok_gt[(tt * 32 + r32) * 128 + h * 16 + i] = ex[i] * inv; }
            }
            LDS_WAIT(); asm volatile("" ::: "memory");
        }
        __syncthreads();
        for (int t8 = 0; t8 < 8; ++t8) { const int tk = F.wave * 8 + t8; const size_t ob = (size_t)(tok0 + tk) * 128;
            EIDX[ob + lane] = tok_id[tk * 128 + lane]; EIDX[ob + 64 + lane] = tok_id[tk * 128 + 64 + lane]; GATE[ob + lane] = tok_gt[tk * 128 + lane]; GATE[ob + 64 + lane] = tok_gt[tk * 128 + 64 + lane]; }
        __syncthreads();
    }
}


__device__ __forceinline__ void gla_prep_phase(Frame& F, const Args& a) {
    unsigned char* ws = a.ws; const bf16* PROJ;
    const int w = F.wave;
    LAS unsigned char* L = F.lds;
    LAS unsigned char* Qraw = L; LAS unsigned char* Kraw = L + 16384; LAS unsigned char* Vraw = L + 32768; LAS float* GDf = (LAS float*)(L + 65536); LAS float* GSUM = (LAS float*)(L + 73728);
    LAS unsigned char* IMGQ = L + 77824; LAS unsigned char* IMGK = L + 95232; LAS unsigned char* IMGE = L + 112640; LAS unsigned char* AMI = L + 32768;
    for (int it = F.vcu; it < 1024; it += F.G) {
        const int b = it >> 8, h = (it >> 6) & 3, n = it & 63; const size_t row0 = (size_t)b * SEQ + n * 64;
        ws = opaque(ws); PROJ = (const bf16*)(ws + WS_PROJ);
        int tid = opaque_v(F.tid), lane = tid & 63, r32 = lane & 31, hh = lane >> 5;
#pragma unroll
        for (int i = 0; i < 2; ++i) { const int idx = tid + 512 * i, r = idx >> 4, c = idx & 15;
            *(LAS v4u*)(Qraw + r * 256 + c * 16) = *(const v4u*)(PROJ + (row0 + r) * NINP + O_GQ + h * 128 + c * 8);
            *(LAS v4u*)(Kraw + r * 256 + c * 16) = *(const v4u*)(PROJ + (row0 + r) * NINP + O_GK + h * 128 + c * 8); }
#pragma unroll
        for (int i = 0; i < 4; ++i) { const int idx = tid + 512 * i, r = idx >> 5, c = idx & 31;
            *(LAS v4u*)(Vraw + r * 512 + c * 16) = *(const v4u*)(PROJ + (row0 + r) * NINP + O_GV + h * 256 + c * 8); }
        if (tid < 256) { const int r = tid >> 2, c = tid & 3; const v4u g = *(const v4u*)(PROJ + (row0 + r) * NINP + O_GDF + c * 8); LAS float* dst = GDf + r * 32 + c * 8;
            dst[0] = bflo(g.x); dst[1] = bfhi(g.x); dst[2] = bflo(g.y); dst[3] = bfhi(g.y); dst[4] = bflo(g.z); dst[5] = bfhi(g.z); dst[6] = bflo(g.w); dst[7] = bfhi(g.w); }
        __syncthreads();
#pragma unroll
        for (int ks = 0; ks < 4; ++ks) { unsigned pk[4];
#pragma unroll
            for (int p = 0; p < 4; ++p) { const int s0 = 16 * ks + 8 * hh + 2 * p; const unsigned lo = *(const LAS unsigned short*)(Vraw + s0 * 512 + (32 * w + r32) * 2), hi = *(const LAS unsigned short*)(Vraw + (s0 + 1) * 512 + (32 * w + r32) * 2); pk[p] = lo | (hi << 16); }
            *(v4u*)((unsigned char*)a.out + OUT_GT_VT + (size_t)it * 32768 + (w * 4 + ks) * 1024 + lane * 16) = (v4u){pk[0], pk[1], pk[2], pk[3]}; }
        for (int dir = 0; dir < 2; ++dir) {
            const size_t idir = (size_t)(((b * 4 + h) * 2 + dir) * 64 + n); ws = opaque(ws); tid = opaque_v(tid); lane = tid & 63; r32 = lane & 31; hh = lane >> 5;
            {
                const int d = tid & 127, tq = tid >> 7; const float* upp = (dir ? a.in[5] : a.in[3]) + h * 128 + d; const float bias = (dir ? a.in[6] : a.in[4])[h * 128 + d];
                float up[16];
#pragma unroll
                for (int r = 0; r < 16; ++r) up[r] = upp[r * 512];
                float c[16];
#pragma unroll
                for (int i = 0; i < 16; ++i) { const LAS float* g = GDf + (16 * tq + i) * 32 + dir * 16; float z = bias;
#pragma unroll
                    for (int r = 0; r < 16; ++r) z += g[r] * up[r];
                    c[i] = (fminf(z, 0.f) - __logf(1.f + __expf(-fabsf(z)))) * (1.f / 16.f); }
                if (dir == 0) {
#pragma unroll
                    for (int i = 1; i < 16; ++i) c[i] += c[i - 1];
                } else {
#pragma unroll
                    for (int i = 14; i >= 0; --i) c[i] += c[i + 1];
                }
                GSUM[(dir * 4 + tq) * 128 + d] = dir == 0 ? c[15] : c[0];
                __syncthreads();
                const float t0 = GSUM[(dir * 4 + 0) * 128 + d], t1 = GSUM[(dir * 4 + 1) * 128 + d], t2 = GSUM[(dir * 4 + 2) * 128 + d], t3 = GSUM[(dir * 4 + 3) * 128 + d];
                const float Bt = (t0 + t1) + (t2 + t3);
                float off;
                if (dir == 0) off = (tq > 0 ? t0 : 0.f) + (tq > 1 ? t1 : 0.f) + (tq > 2 ? t2 : 0.f);
                else off = (tq < 1 ? t1 : 0.f) + (tq < 2 ? t2 : 0.f) + (tq < 3 ? t3 : 0.f);
                unsigned kep[8];
#pragma unroll
                for (int i = 0; i < 16; i += 2) { float ke2[2];
#pragma unroll
                    for (int q = 0; q < 2; ++q) { const int t = 16 * tq + i + q; const float bi = c[i + q] + off;
                        const float qv = bf2f(*(const LAS unsigned short*)(Qraw + t * 256 + d * 2)), kv = bf2f(*(const LAS unsigned short*)(Kraw + t * 256 + d * 2));
                        *(LAS unsigned short*)(IMGQ + t * 272 + d * 2) = (unsigned short)f2bf(qv * 0.08838834764831845f * __expf(bi));
                        *(LAS unsigned short*)(IMGK + t * 272 + d * 2) = (unsigned short)f2bf(kv * __expf(-bi));
                        ke2[q] = kv * __expf(Bt - bi); }
                    kep[i >> 1] = pk2(ke2[0], ke2[1]); }
                *(LAS v4u*)(IMGE + d * 144 + (16 * tq) * 2) = (v4u){kep[0], kep[1], kep[2], kep[3]};
                *(LAS v4u*)(IMGE + d * 144 + (16 * tq + 8) * 2) = (v4u){kep[4], kep[5], kep[6], kep[7]};
                if (tq == 0) ((float*)((unsigned char*)a.out + OUT_GT_DEC))[idir * 128 + d] = __expf(Bt);
            }
            __syncthreads();
            if (w < 4) {
                const int si = w >> 1, ti = w & 1; f32x16 acc = (f32x16){0.f, 0.f, 0.f, 0.f, 0.f, 0.f, 0.f, 0.f, 0.f, 0.f, 0.f, 0.f, 0.f, 0.f, 0.f, 0.f};
#pragma unroll
                for (int ks = 0; ks < 8; ++ks) { const bf16x8 ak = *(const LAS bf16x8*)(IMGK + (32 * si + r32) * 272 + (16 * ks + 8 * hh) * 2), bq = *(const LAS bf16x8*)(IMGQ + (32 * ti + r32) * 272 + (16 * ks + 8 * hh) * 2);
                    acc = __builtin_amdgcn_mfma_f32_32x32x16_bf16(ak, bq, acc, 0, 0, 0); }
                const int t = 32 * ti + r32;
#pragma unroll
                for (int qd = 0; qd < 4; ++qd) { float v4[4];
#pragma unroll
                    for (int i = 0; i < 4; ++i) { const int sidx = 32 * si + 8 * qd + 4 * hh + i; const float x = acc[4 * qd + i]; const bool keep = dir == 0 ? (sidx <= t) : (sidx >= t); v4[i] = keep ? x : 0.f; }
                    *(LAS unsigned long long*)(AMI + t * 144 + (32 * si + 8 * qd + 4 * hh) * 2) = (unsigned long long)pk2(v4[0], v4[1]) | ((unsigned long long)pk2(v4[2], v4[3]) << 32); }
            } else {
                const int w4 = w - 4;
#pragma unroll
                for (int q = 0; q < 4; ++q) { const int bq = w4 * 4 + q, tt = bq >> 3, ks = bq & 7, j = ks >> 1, u = ks & 1; const int t = 32 * tt + r32;
                    const unsigned long long p0 = *(const LAS unsigned long long*)(IMGQ + t * 272 + (32 * j + 16 * u + 4 * hh) * 2), p1 = *(const LAS unsigned long long*)(IMGQ + t * 272 + (32 * j + 16 * u + 8 + 4 * hh) * 2);
                    *(v4u*)(ws + WS_GT_QD + idir * 16384 + bq * 1024 + lane * 16) = (v4u){(unsigned)p0, (unsigned)(p0 >> 32), (unsigned)p1, (unsigned)(p1 >> 32)}; }
#pragma unroll
                for (int q = 0; q < 4; ++q) { const int bk = w4 * 4 + q, j = bk >> 2, ks = bk & 3; const int d = 32 * j + r32;
                    *(v4u*)(ws + WS_GT_KE + idir * 16384 + bk * 1024 + lane * 16) = *(const LAS v4u*)(IMGE + d * 144 + (16 * ks + 8 * hh) * 2); }
            }
            __syncthreads();
            { const int tt = w >> 2, ks = w & 3; const int t = 32 * tt + r32;
              *(v4u*)((unsigned char*)a.out + OUT_GT_AM + idir * 8192 + w * 1024 + lane * 16) = *(const LAS v4u*)(AMI + t * 144 + (16 * ks + 8 * hh) * 2); }
            __syncthreads();
        }
    }
}

__device__ __forceinline__ void gla_seq_phase(Frame& F, const Args& a) {
    unsigned char* ws = a.ws;
    const int w = F.wave;
    LAS unsigned char* QDl = F.lds; LAS unsigned char* KEl = F.lds + 16384; LAS unsigned char* AMl = F.lds + 32768; LAS float* DECl = (LAS float*)(F.lds + 40960);
    for (int unit = F.vcu; unit < 32; unit += F.G) {
        const int dir = unit & 1, bh = unit >> 1, b = bh >> 2, h = bh & 3;
        bf16* Out;
        f32x16 S[4];
#pragma unroll
        for (int j = 0; j < 4; ++j) S[j] = (f32x16){0.f, 0.f, 0.f, 0.f, 0.f, 0.f, 0.f, 0.f, 0.f, 0.f, 0.f, 0.f, 0.f, 0.f, 0.f, 0.f};
        for (int ns = 0; ns < 64; ++ns) {
            const int n = dir ? 63 - ns : ns; const size_t idir = (size_t)((bh * 2 + dir) * 64 + n), iv = (size_t)(bh * 64 + n); ws = opaque(ws); Out = (bf16*)(ws + (dir ? WS_OB : WS_OF));
            const int tid = opaque_v(F.tid), lane = tid & 63, r32 = lane & 31, hh = lane >> 5;
            { const v4u* gq = (const v4u*)(ws + WS_GT_QD + idir * 16384); const v4u* gk = (const v4u*)(ws + WS_GT_KE + idir * 16384); const v4u* ga = (const v4u*)((unsigned char*)a.out + OUT_GT_AM + idir * 8192);
              const v4u x0 = gq[tid], x1 = gq[tid + 512], x2 = gk[tid], x3 = gk[tid + 512], x4 = ga[tid];
              ((LAS v4u*)QDl)[tid] = x0; ((LAS v4u*)QDl)[tid + 512] = x1; ((LAS v4u*)KEl)[tid] = x2; ((LAS v4u*)KEl)[tid + 512] = x3; ((LAS v4u*)AMl)[tid] = x4;
              if (tid < 32) ((LAS v4u*)DECl)[tid] = ((const v4u*)((unsigned char*)a.out + OUT_GT_DEC + idir * 512))[tid]; }
            bf16x8 vf[4];
#pragma unroll
            for (int ks = 0; ks < 4; ++ks) vf[ks] = *(const bf16x8*)((unsigned char*)a.out + OUT_GT_VT + iv * 32768 + (w * 4 + ks) * 1024 + lane * 16);
            __syncthreads();
            f32x16 o[2];
#pragma unroll
            for (int tt = 0; tt < 2; ++tt) o[tt] = (f32x16){0.f, 0.f, 0.f, 0.f, 0.f, 0.f, 0.f, 0.f, 0.f, 0.f, 0.f, 0.f, 0.f, 0.f, 0.f, 0.f};
#pragma unroll
            for (int ks8 = 0; ks8 < 8; ++ks8) { const int j = ks8 >> 1, u = ks8 & 1; v4u sb;
                sb.x = pg8::cvt_pk_bf16(S[j][8 * u + 0], S[j][8 * u + 1]); sb.y = pg8::cvt_pk_bf16(S[j][8 * u + 2], S[j][8 * u + 3]); sb.z = pg8::cvt_pk_bf16(S[j][8 * u + 4], S[j][8 * u + 5]); sb.w = pg8::cvt_pk_bf16(S[j][8 * u + 6], S[j][8 * u + 7]);
                const bf16x8 bs = __builtin_bit_cast(bf16x8, sb);
#pragma unroll
                for (int tt = 0; tt < 2; ++tt) { const bf16x8 aq = *(const LAS bf16x8*)(QDl + (tt * 8 + ks8) * 1024 + lane * 16); o[tt] = __builtin_amdgcn_mfma_f32_32x32x16_bf16(aq, bs, o[tt], 0, 0, 0); } }
#pragma unroll
            for (int ks = 0; ks < 4; ++ks)
#pragma unroll
                for (int tt = 0; tt < 2; ++tt) { const bf16x8 am = *(const LAS bf16x8*)(AMl + (tt * 4 + ks) * 1024 + lane * 16); o[tt] = __builtin_amdgcn_mfma_f32_32x32x16_bf16(am, vf[ks], o[tt], 0, 0, 0); }
#pragma unroll
            for (int tt = 0; tt < 2; ++tt)
#pragma unroll
                for (int r = 0; r < 16; ++r) { const int t = 32 * tt + (r & 3) + 8 * (r >> 2) + 4 * hh; const float x = o[tt][r];
                    Out[((size_t)b * SEQ + 64 * n + t) * 1024 + h * 256 + 32 * w + r32] = (bf16)f2bf(x); }
#pragma unroll
            for (int j = 0; j < 4; ++j) {
#pragma unroll
                for (int q = 0; q < 4; ++q) { const f32x4 dv = *(const LAS f32x4*)(DECl + 32 * j + 8 * q + 4 * hh); S[j][4 * q + 0] *= dv.x; S[j][4 * q + 1] *= dv.y; S[j][4 * q + 2] *= dv.z; S[j][4 * q + 3] *= dv.w; }
#pragma unroll
                for (int ks = 0; ks < 4; ++ks) { const bf16x8 ak = *(const LAS bf16x8*)(KEl + (j * 4 + ks) * 1024 + lane * 16); S[j] = __builtin_amdgcn_mfma_f32_32x32x16_bf16(ak, vf[ks], S[j], 0, 0, 0); } }
            __syncthreads();
        }
    }
}


typedef short v4i16_t __attribute__((ext_vector_type(4)));
__device__ __forceinline__ void attn_phase(Frame& F, const Args& a, int qslot) {
    unsigned char* ws = a.ws; const bf16* PROJ = (const bf16*)(ws + WS_PROJ);
    const int w = F.wave;
    LAS unsigned char* Kl = F.lds; LAS unsigned char* Vl = F.lds + 39168; volatile LAS int* uword = (volatile LAS int*)(F.lds + 78336);
    constexpr int NUNITS = 64 * 3 * 32;
    for (;;) {
        const int tid = opaque_v(F.tid), lane = tid & 63, q16 = lane & 15, g = lane >> 4;
        if (tid == 0) uword[0] = (int)__hip_atomic_fetch_add((unsigned*)(F.ctl + CW_ATTQ + 64 * qslot), 1u, __ATOMIC_RELAXED, __HIP_MEMORY_SCOPE_AGENT);
        __syncthreads();
        const int u = __builtin_amdgcn_readfirstlane(uword[0]);
        if (u >= NUNITS) break;
        const int bh = u / 96, rem = u - bh * 96, p = rem >> 5, idx = rem & 31; const int lgd = 2 * p, d = 1 << lgd;
        const int r = idx >> (5 - lgd), J = idx & ((32 >> lgd) - 1), Lc = SEQ >> lgd; const int b = bh >> 4, h = bh & 15;
        const int m0 = 128 * J - 64;
        ws = opaque(ws); PROJ = (const bf16*)(ws + WS_PROJ);
#pragma unroll
        for (int i = 0; i < 4; ++i) { const int kr = (tid >> 3) + 64 * i, ch = tid & 7; const int mp = m0 + kr; v4u kx = (v4u){0u, 0u, 0u, 0u}, vx = kx;
            if (mp >= 0 && mp < Lc) { const bf16* src = PROJ + ((size_t)b * SEQ + r + d * mp) * NINP + O_AK + h * 64 + ch * 8; kx = *(const v4u*)src; vx = *(const v4u*)(src + (O_AV - O_AK)); }
            *(LAS v4u*)(Kl + kr * 144 + ch * 16) = kx; *(LAS v4u*)(Vl + kr * 144 + ch * 16) = vx; }
        if (tid < 128) { const int kr = 256 + (tid >> 3), ch = tid & 7; *(LAS v4u*)(Kl + kr * 144 + ch * 16) = (v4u){0u, 0u, 0u, 0u}; *(LAS v4u*)(Vl + kr * 144 + ch * 16) = (v4u){0u, 0u, 0u, 0u}; }
        const int tokq = r + d * (128 * J + 16 * w + q16);
        bf16x8 qf[2];
#pragma unroll
        for (int sft = 0; sft < 2; ++sft) { const v4u qw = *(const v4u*)(PROJ + ((size_t)b * SEQ + tokq) * NINP + O_AQ + h * 64 + 32 * sft + 8 * g);
            v4u qs; qs.x = pk2(bflo(qw.x) * 0.125f, bfhi(qw.x) * 0.125f); qs.y = pk2(bflo(qw.y) * 0.125f, bfhi(qw.y) * 0.125f); qs.z = pk2(bflo(qw.z) * 0.125f, bfhi(qw.z) * 0.125f); qs.w = pk2(bflo(qw.w) * 0.125f, bfhi(qw.w) * 0.125f);
            qf[sft] = __builtin_bit_cast(bf16x8, qs); }
        __syncthreads();
        const float slope = exp2f(-0.5f * (float)(h + 1)) * (float)d;
        float sv[5][2][4]; float mx = -1e30f;
#pragma unroll
        for (int kb = 0; kb < 5; ++kb)
#pragma unroll
            for (int uu = 0; uu < 2; ++uu) { f32x4 acc = (f32x4){0.f, 0.f, 0.f, 0.f};
                const int krow = 16 * w + 32 * kb + 8 * (q16 >> 2) + 4 * uu + (q16 & 3);
#pragma unroll
                for (int sft = 0; sft < 2; ++sft) { const bf16x8 ak = *(const LAS bf16x8*)(Kl + krow * 144 + (32 * sft + 8 * g) * 2); acc = __builtin_amdgcn_mfma_f32_16x16x32_bf16(ak, qf[sft], acc, 0, 0, 0); }
#pragma unroll
                for (int rho = 0; rho < 4; ++rho) { const int jo = 32 * kb + 8 * g + 4 * uu + rho - 64 - q16; const int mp = m0 + 16 * w + 32 * kb + 8 * g + 4 * uu + rho; const int aj = jo < 0 ? -jo : jo;
                    const bool ok = (aj <= 64) && (mp >= 0) && (mp < Lc); const float x = acc[rho];
                    const float sc = ok ? (x - slope * (float)aj) : -1e30f; sv[kb][uu][rho] = sc; mx = fmaxf(mx, sc); } }
        mx = fmaxf(mx, __shfl_xor(mx, 16)); mx = fmaxf(mx, __shfl_xor(mx, 32));
        float lsum = 0.f; bf16x8 pf[5];
#pragma unroll
        for (int kb = 0; kb < 5; ++kb) { float e[8];
#pragma unroll
            for (int uu = 0; uu < 2; ++uu)
#pragma unroll
                for (int rho = 0; rho < 4; ++rho) { const float pe = __expf(sv[kb][uu][rho] - mx); e[uu * 4 + rho] = pe; lsum += pe; }
            v4u pw; pw.x = pk2(e[0], e[1]); pw.y = pk2(e[2], e[3]); pw.z = pk2(e[4], e[5]); pw.w = pk2(e[6], e[7]); pf[kb] = __builtin_bit_cast(bf16x8, pw); }
        lsum += __shfl_xor(lsum, 16); lsum += __shfl_xor(lsum, 32);
        f32x4 oT[4];
#pragma unroll
        for (int nn = 0; nn < 4; ++nn) oT[nn] = (f32x4){0.f, 0.f, 0.f, 0.f};
#pragma unroll
        for (int kb = 0; kb < 5; ++kb)
#pragma unroll
            for (int nn = 0; nn < 4; ++nn) { const LAS unsigned char* va = Vl + (16 * w + 32 * kb + 8 * g + (q16 >> 2)) * 144 + (16 * nn + 4 * (q16 & 3)) * 2;
                const v4i16_t lo = __builtin_amdgcn_ds_read_tr16_b64_v4i16((LAS v4i16_t*)va), hi = __builtin_amdgcn_ds_read_tr16_b64_v4i16((LAS v4i16_t*)(va + 4 * 144));
                const bf16x8 vf = (bf16x8){lo[0], lo[1], lo[2], lo[3], hi[0], hi[1], hi[2], hi[3]};
                oT[nn] = __builtin_amdgcn_mfma_f32_16x16x32_bf16(vf, pf[kb], oT[nn], 0, 0, 0); }
        { const size_t rec = ((size_t)p * M + (size_t)b * SEQ + tokq) * 16 + h; bf16* op = (bf16*)(ws + WS_ATTP) + rec * 64 + 4 * g;
#pragma unroll
          for (int nn = 0; nn < 4; ++nn) *(unsigned long long*)(op + 16 * nn) = (unsigned long long)pk2(oT[nn][0], oT[nn][1]) | ((unsigned long long)pk2(oT[nn][2], oT[nn][3]) << 32);
          if (g == 0) { float* ml = (float*)(ws + WS_ATTML) + rec * 2; ml[0] = mx; ml[1] = lsum; } }
    }
}

typedef __bf16 bf16x2_t __attribute__((ext_vector_type(2)));
typedef int i32x4 __attribute__((ext_vector_type(4)));
__device__ __forceinline__ void peer_convert_tables(Frame& F, const Args& a) {
    unsigned char* ws = a.ws; const int lane = F.lane;
    for (int r = F.vcu * NWAVES + F.wave; r < 2 * PEER_E; r += F.G * NWAVES) {
        const int e = r & (PEER_E - 1); const bool isv = r >= PEER_E;
        const float* src = (isv ? a.in[14] : a.in[13]) + (size_t)e * DM;
        unsigned char* dst = ws + (isv ? WS_V8 : WS_U8) + (size_t)e * DM; float* sc = (float*)(ws + (isv ? WS_SV : WS_SU));
        f32x4 v[8]; float am = 0.f;
#pragma unroll
        for (int j = 0; j < 8; ++j) { v[j] = *(const f32x4*)(src + 256 * j + 4 * lane); am = fmaxf(am, fmaxf(fmaxf(fabsf(v[j].x), fabsf(v[j].y)), fmaxf(fabsf(v[j].z), fabsf(v[j].w)))); }
        am = wave_max(am); am = fmaxf(am, 1e-30f);
        const float inv = 440.f / am;
#pragma unroll
        for (int j = 0; j < 8; ++j) { int p = __builtin_amdgcn_cvt_pk_fp8_f32(v[j].x * inv, v[j].y * inv, 0, false); p = __builtin_amdgcn_cvt_pk_fp8_f32(v[j].z * inv, v[j].w * inv, p, true);
            *(int*)(dst + 256 * j + 4 * lane) = p; }
        if (lane == 0) sc[e] = am * (1.f / 440.f);
    }
}

__device__ __forceinline__ float dpp_row_sum(float x) {
#define PEER_DPP(ctrl) x += __builtin_bit_cast(float, __builtin_amdgcn_update_dpp(0, __builtin_bit_cast(int, x), ctrl, 0xF, 0xF, false))
    PEER_DPP(0xB1); PEER_DPP(0x4E); PEER_DPP(0x141); PEER_DPP(0x140);
#undef PEER_DPP
    return x;
}
template <bool VPH, int PBS> __device__ __forceinline__ void peer_uv_phase(Frame& F, const Args& a) {
    unsigned char* ws = a.ws; float* H = a.out; const float* g2 = a.in[10];
    const int sl = blockIdx.x & 7, rk = blockIdx.x >> 3, nrk = F.G >> 3, tpw = M / nrk / NWAVES, nq = tpw / 4;
    const unsigned char* TAB; const int* EIDX; const float* SSQ; const float* PW; float* PD; float* SSQ2;
    LAS int* idt = (LAS int*)(F.lds + F.wave * 8192);
    LAS float* wt = (LAS float*)(F.lds + F.wave * 8192 + 4096);
    const int t0 = (rk * NWAVES + F.wave) * tpw;
#define PEER_STAGE(QI) do { const size_t tb_ = (size_t)(t0 + 4 * (QI) + a4) * 128; const int bf_ = ((QI) & 1) * 512; _Pragma("unroll") for (int k = 0; k < 8; ++k) { \
        idt[bf_ + (16 * k + q) * 4 + a4] = EIDX[tb_ + 16 * k + q]; if (VPH) wt[bf_ + (16 * k + q) * 4 + a4] = PW[tb_ + 16 * k + q]; } } while (0)
#define PEER_ISSUE(R, QI, WB) do { const int bf_ = ((QI) & 1) * 512 + (WB) * (4 * PBS) + a4; _Pragma("unroll") for (int j = 0; j < PBS; ++j) { const int e_ = idt[bf_ + 4 * j]; R[j] = ldu<i32x4>(TAB, (unsigned)e_ * 2048u + (unsigned)(16 * q)); } } while (0)
    unsigned xq[8]; float acc[16];
#define PEER_QUAD_BEGIN(QI) do { const size_t t_ = (size_t)(t0 + 4 * (QI) + a4); \
        if (!VPH) { f32x4 hq[4]; _Pragma("unroll") for (int k = 0; k < 4; ++k) hq[k] = *(const f32x4*)(H + t_ * DM + 256 * sl + 16 * q + 4 * k);  const float pss_ = dpp_row_sum(SSQ[t_ * 32 + q] + SSQ[t_ * 32 + 16 + q]); const float rstd_ = 1.f / sqrtf(pss_ * (1.f / DM) + EPS); f32x4 gv[4]; \
            _Pragma("unroll") for (int k = 0; k < 4; ++k) gv[k] = *(const f32x4*)(g2 + 256 * sl + 16 * q + 4 * k); \
            _Pragma("unroll") for (int k = 0; k < 4; ++k) { xq[2 * k] = pk2(hq[k].x * rstd_ * gv[k].x, hq[k].y * rstd_ * gv[k].y); xq[2 * k + 1] = pk2(hq[k].z * rstd_ * gv[k].z, hq[k].w * rstd_ * gv[k].w); } } \
        else { _Pragma("unroll") for (int k = 0; k < 16; ++k) acc[k] = 0.f; } } while (0)
#define PEER_COMPUTE(R, QI, WB) do { if (!VPH) { float pdb_ = 0.f; _Pragma("unroll") for (int j = 0; j < PBS; ++j) { float d_ = 0.f; _Pragma("unroll") for (int k = 0; k < 4; ++k) { const int dw_ = R[j][k]; \
                d_ = __builtin_amdgcn_fdot2_f32_bf16(__builtin_amdgcn_cvt_scalef32_pk_bf16_fp8(dw_, 1.0f, false), __builtin_bit_cast(bf16x2_t, xq[2 * k]), d_, false); \
                d_ = __builtin_amdgcn_fdot2_f32_bf16(__builtin_amdgcn_cvt_scalef32_pk_bf16_fp8(dw_, 1.0f, true), __builtin_bit_cast(bf16x2_t, xq[2 * k + 1]), d_, false); } \
                d_ = dpp_row_sum(d_); pdb_ = (q == j) ? d_ : pdb_; } \
            if (q < PBS) PD[((size_t)(t0 + 4 * (QI) + a4) * 8 + sl) * 128 + PBS * (WB) + q] = pdb_; } \
        else { const int bf_ = ((QI) & 1) * 512 + (WB) * (4 * PBS) + a4; _Pragma("unroll") for (int j = 0; j < PBS; ++j) { const float w_ = wt[bf_ + 4 * j]; int r0_ = R[j][0], r1_ = R[j][1], r2_ = R[j][2], r3_ = R[j][3]; asm volatile("" : "+v"(r0_), "+v"(r1_), "+v"(r2_), "+v"(r3_));     \
                _Pragma("unroll") for (int k = 0; k < 4; ++k) { const int dw_ = k == 0 ? r0_ : k == 1 ? r1_ : k == 2 ? r2_ : r3_; \
                const f32x2 lo_ = __builtin_amdgcn_cvt_pk_f32_fp8(dw_, false), hi_ = __builtin_amdgcn_cvt_pk_f32_fp8(dw_, true); \
                acc[4 * k + 0] += w_ * lo_.x; acc[4 * k + 1] += w_ * lo_.y; acc[4 * k + 2] += w_ * hi_.x; acc[4 * k + 3] += w_ * hi_.y; } } } } while (0)
#define PEER_QUAD_END(QI) do { if (VPH) { const size_t t_ = (size_t)(t0 + 4 * (QI) + a4); float ss_ = 0.f; f32x4 hq[4]; _Pragma("unroll") for (int k = 0; k < 4; ++k) hq[k] = *(const f32x4*)(H + t_ * DM + 256 * sl + 16 * q + 4 * k); \
            _Pragma("unroll") for (int k = 0; k < 4; ++k) { \
            const f32x4 y_ = hq[k] + (f32x4){acc[4 * k], acc[4 * k + 1], acc[4 * k + 2], acc[4 * k + 3]}; *(f32x4*)(H + t_ * DM + 256 * sl + 16 * q + 4 * k) = y_; ss_ += (y_.x * y_.x + y_.y * y_.y) + (y_.z * y_.z + y_.w * y_.w); } \
            ss_ = dpp_row_sum(ss_); if (q == 0) SSQ2[t_ * 8 + sl] = ss_; } } while (0)
#pragma unroll 1
    for (int qi = 0; qi < nq; ++qi) {
        i32x4 rA[PBS], rB[PBS];
        const int lane = opaque_v(F.lane), a4 = lane >> 4, q = lane & 15; ws = opaque(ws); H = opaque(H);
        TAB = ws + (VPH ? WS_V8 : WS_U8) + 256 * sl; EIDX = (const int*)(ws + WS_EIDX); SSQ = (const float*)(ws + WS_SSQ); PW = (const float*)(ws + WS_PW); PD = (float*)(ws + WS_PD); SSQ2 = (float*)(ws + WS_SSQ2);
        PEER_STAGE(qi); LDS_WAIT(); asm volatile("" ::: "memory");
        PEER_ISSUE(rA, qi, 0);
        PEER_ISSUE(rB, qi, 1);
        PEER_QUAD_BEGIN(qi);
#pragma unroll
        for (int wb = 0; wb < 128 / PBS; wb += 2) {
            PEER_COMPUTE(rA, qi, wb); if (wb + 2 < 128 / PBS) { PEER_ISSUE(rA, qi, wb + 2); }
            PEER_COMPUTE(rB, qi, wb + 1); if (wb + 3 < 128 / PBS) { PEER_ISSUE(rB, qi, wb + 3); }
        }
        PEER_QUAD_END(qi);
    }
#undef PEER_STAGE
#undef PEER_ISSUE
#undef PEER_QUAD_BEGIN
#undef PEER_COMPUTE
#undef PEER_QUAD_END
}
__device__ __forceinline__ void peer_w_phase(Frame& F, const Args& a) {
    unsigned char* ws = a.ws; const float* PD = (const float*)(ws + WS_PD); const int* EIDX = (const int*)(ws + WS_EIDX); const float* GATE = (const float*)(ws + WS_GATE);
    const float* SU = (const float*)(ws + WS_SU); const float* SV = (const float*)(ws + WS_SV); float* PW = (float*)(ws + WS_PW);
    for (int i = F.vcu * 512 + F.tid; i < M * 128; i += F.G * 512) { const int t = i >> 7, p = i & 127; float d = 0.f;
#pragma unroll
        for (int sl = 0; sl < 8; ++sl) d += PD[((size_t)t * 8 + sl) * 128 + p];
        const int e = EIDX[i]; d *= SU[e];
        PW[i] = GATE[i] * 0.5f * d * (1.f + erff(d * 0.70710678118654752f)) * SV[e]; }
}
__device__ __forceinline__ void peer_n_phase(Frame& F, const Args& a) {
    unsigned char* ws = a.ws; float* H = a.out; const float* gf = a.in[15]; const float* SSQ2 = (const float*)(ws + WS_SSQ2); const int lane = F.lane;
    for (int m = F.vcu * NWAVES + F.wave; m < M; m += F.G * NWAVES) {
        const f32x4 s0 = *(const f32x4*)(SSQ2 + (size_t)m * 8), s1 = *(const f32x4*)(SSQ2 + (size_t)m * 8 + 4);
        const float rf = 1.f / sqrtf((((s0.x + s0.y) + (s0.z + s0.w)) + ((s1.x + s1.y) + (s1.z + s1.w))) * (1.f / DM) + EPS);
        float* row = H + (size_t)m * DM;
#pragma unroll
        for (int j = 0; j < 8; ++j) { const f32x4 g = *(const f32x4*)(gf + 256 * j + 4 * lane); const f32x4 y = *(const f32x4*)(row + 256 * j + 4 * lane); *(f32x4*)(row + 256 * j + 4 * lane) = y * rf * g; }
    }
}

__global__ void __launch_bounds__(NWAVES * 64, 2) mk_fwd(Args args) {
    extern __shared__ __attribute__((aligned(16))) unsigned char lds[];
    Frame F;
    F.lds = (LAS unsigned char*)lds;
    F.MISC = (volatile LAS unsigned*)(F.lds + MISC_OFF);
    F.tid = threadIdx.x; F.lane = F.tid & 63; F.wave = __builtin_amdgcn_readfirstlane(F.tid >> 6);
    F.G = gridDim.x; { const int bx = blockIdx.x; F.vcu = (F.G % 8 == 0) ? (bx % 8) * (F.G / 8) + bx / 8 : bx; }
    unsigned char* ws = args.ws;
    F.ctl = (gu32*)(ws + WS_CTL);
    for (int u = F.tid; u < (LDS_BYTES - LDSCTL_OFF) / 4; u += NWAVES * 64) ((LAS unsigned*)(F.lds + LDSCTL_OFF))[u] = 0u;
    __syncthreads();
    XcdBarrier bar = xcd_barrier_post((unsigned*)(F.ctl + CW_BAR) + args.li * XCD_BAR_WORDS, F.MISC + 8);
    const int lo = args.ph_lo, hi = args.ph_hi;
#define IN(k) (lo <= (k) && (k) < hi)
#define BOTH(k) (IN(k) && IN((k) + 1))
#define GRID_BAR() xcd_barrier(bar)

    if (IN(0)) { for (int rep = 0; rep < NREP(0); ++rep) p0_prologue(F, args); if (BOTH(0)) GRID_BAR(); }

    if (IN(1)) {
        pg8::Gemm g{(const bf16*)(ws + WS_XN), (const bf16*)(ws + WS_WIN), M, NINP, DM}; pg8::StaticOrder S; S.init(M, NINP, F.G, (int)blockIdx.x);
        pg8::EpiBf16<0> E{(bf16*)(ws + WS_PROJ), NINP, nullptr, 0, 0, 1.f};
        for (int rep = 0; rep < NREP(1); ++rep) pg8::gemm_phase<pg8::EpiBf16<0>, pg8::StaticOrder, PG8_ALIGN, PG8_SP2>(F.lds + RING_OFF, g, S, E);
        if (BOTH(1)) GRID_BAR();
    }
    if (IN(2)) {
        for (int rep = 0; rep < NREP(21); ++rep) gla_prep_phase(F, args);
        GRID_BAR();
        for (int rep = 0; rep < NREP(2); ++rep) gla_seq_phase(F, args);
        for (int rep = 0; rep < NREP(20); ++rep) attn_phase(F, args, rep);
        if (BOTH(2)) GRID_BAR(); }
    if (IN(3)) { for (int rep = 0; rep < NREP(3); ++rep) p3_finalize(F, args); if (BOTH(3)) GRID_BAR(); }
    if (IN(4)) {
        for (int rep = 0; rep < NREP(40); ++rep) peer_convert_tables(F, args);
        pg8::Gemm g{(const bf16*)(ws + WS_XN), (const bf16*)(ws + WS_WOUT), M, DM, DM}; pg8::StaticOrder S; S.init(M, DM, F.G, (int)blockIdx.x);
        pg8::EpiRes E{args.in[0], args.out, (bf16*)(ws + WS_HB), (float*)(ws + WS_SSQ), DM};
        for (int rep = 0; rep < NREP(4); ++rep) pg8::gemm_phase<pg8::EpiRes, pg8::StaticOrder, PG8_ALIGN, PG8_SP2>(F.lds + RING_OFF, g, S, E);
        if (BOTH(4)) GRID_BAR();
    }
    if (IN(5)) {
        pg8::Gemm g{(const bf16*)(ws + WS_HB), (const bf16*)(ws + WS_WQ), M, DM, DM}; pg8::StaticOrder S; S.init(M, DM, F.G, (int)blockIdx.x);
        pg8::EpiRowScale E{(bf16*)(ws + WS_XN), DM, (const float*)(ws + WS_SSQ), 1.f / DM, EPS};
        for (int rep = 0; rep < NREP(5); ++rep) pg8::gemm_phase<pg8::EpiRowScale, pg8::StaticOrder, PG8_ALIGN, PG8_SP2>(F.lds + RING_OFF, g, S, E);
        if (BOTH(5)) GRID_BAR();
    }
    if (IN(6)) { for (int rep = 0; rep < NREP(6); ++rep) topk_phase(F, args); if (BOTH(6)) GRID_BAR(); }
    if (IN(7)) {
        for (int rep = 0; rep < NREP(7); ++rep) peer_uv_phase<false, 16>(F, args);
        GRID_BAR();
        peer_w_phase(F, args);
        GRID_BAR();
        if (REP_PHASE != 8) peer_uv_phase<true, 16>(F, args);
        GRID_BAR();
        peer_n_phase(F, args);
    }
#undef IN
#undef BOTH
}


extern "C" void kernel_launch(void* const* d_in, const int* in_sizes, int n_in, void* d_out, int out_size, void* d_ws, size_t ws_size, hipStream_t stream) {
    static int grid = 0;
    if (grid == 0) {
        if (n_in != 16 || in_sizes[0] != M * DM || out_size != M * DM || ws_size < WS_END) { fprintf(stderr, "kernel_launch: unexpected shapes: n_in %d in0 %d out %d ws %zu\n", n_in, n_in > 0 ? in_sizes[0] : -1, out_size, ws_size); grid = -1; return; }
        int dev = 0, cus = 0;
        if (hipGetDevice(&dev) != hipSuccess || hipDeviceGetAttribute(&cus, hipDeviceAttributeMultiprocessorCount, dev) != hipSuccess) { grid = -1; return; }
        if (hipFuncSetAttribute((const void*)mk_fwd, hipFuncAttributeMaxDynamicSharedMemorySize, LDS_BYTES) != hipSuccess) { fprintf(stderr, "kernel_launch: hipFuncSetAttribute failed\n"); grid = -1; return; }
        (void)hipGetLastError();
        grid = cus;
    }
    if (grid < 0) return;
    (void)hipMemsetAsync((char*)d_ws + WS_CTL, 0, CTL_ZERO_BYTES, stream);
    Args a{};
    for (int i = 0; i < 16; ++i) a.in[i] = (const float*)d_in[i];
    a.out = (float*)d_out; a.ws = (unsigned char*)d_ws;
    a.ph_lo = 0; a.ph_hi = 8; a.li = 0;
    hipLaunchKernelGGL(mk_fwd, dim3(grid), dim3(NWAVES * 64), LDS_BYTES, stream, a);
}
```

```cpp
#define REP_PHASE -1

#include <hip/hip_runtime.h>
#include <cstdio>
#include <cstdint>
#include <cmath>
#ifndef REP_PHASE
#define REP_PHASE -1
#endif
#define NREP(k) ((REP_PHASE == (k)) ? 2 : 1)
namespace pg8 {
#define PG8_LAS __attribute__((address_space(3)))
typedef unsigned short bf16_t;
typedef short bf16x8 __attribute__((ext_vector_type(8)));
typedef float f32x4 __attribute__((ext_vector_type(4)));
typedef unsigned u32x4 __attribute__((ext_vector_type(4)));
constexpr int BM = 256, BK = 64, HALF = 128, HTB = HALF * BK * 2  , STAGE_BYTES = 8 * HTB, NXCD = 8, WGM = 8;

__host__ __device__ __forceinline__ int lds_byte(int r, int c) { const int st = (r >> 4) * 2 + (c >> 5), rr = r & 15, cc = c & 31, ob = rr * 64 + cc * 2; return st * 1024 + (ob ^ (((ob >> 9) & 1) << 5)); }
__host__ __device__ __forceinline__ void stage_rc(int b, int& R, int& C) { const int st = b / 1024, sb = b % 1024, swz = sb ^ (((sb >> 9) & 1) << 5); R = (st >> 1) * 16 + swz / 64; C = (st & 1) * 32 + (swz % 64) / 2; }
__host__ __device__ __forceinline__ int perm32(int rho) { const int n = rho >> 4, i = rho & 15; return 8 * (i >> 2) + 4 * n + (i & 3); }

struct Unit { int pm, pn; };
struct Gemm { const bf16_t* A; const bf16_t* Bt; int M, N, K; };

struct StaticOrder {
    int nM, nN, nwg, G, c;
    __host__ __device__ void init(int M, int N, int G_, int c_) { nM = M / BM; nN = N / BM; nwg = nM * nN; G = G_; c = c_; }
    __host__ __device__ bool next(int i, Unit& u) const {
        const long L = (long)i * G + c; if (L >= nwg) return false;
        int wgid = (int)L; { const int q = nwg / NXCD, r = nwg % NXCD, xcd = wgid % NXCD, off = wgid / NXCD; wgid = (xcd < r ? xcd * (q + 1) : r * (q + 1) + (xcd - r) * q) + off; }
        const int nig = WGM * nN, gid = wgid / nig, fm = gid * WGM, gsz = (nM - fm) < WGM ? (nM - fm) : WGM;
        u.pm = fm + ((wgid % nig) % gsz); u.pn = (wgid % nig) / gsz; return true;
    }
    __device__ __forceinline__ void a_ready(const Unit&) const {}
    __device__ __forceinline__ void done(const Unit&) const {}
};

__device__ __forceinline__ unsigned cvt_pk_bf16(float lo, float hi) { unsigned r; asm volatile("v_cvt_pk_bf16_f32 %0, %1, %2" : "=v"(r) : "v"(lo), "v"(hi)); return r; }
typedef float f32x2 __attribute__((ext_vector_type(2)));
__device__ __forceinline__ f32x2 gelu_pk(f32x2 v) {
    const f32x2 av = __builtin_elementwise_abs(v), d = av * 0.2316418882f + 1.0f;
    f32x2 t; t.x = __builtin_amdgcn_rcpf(d.x); t.y = __builtin_amdgcn_rcpf(d.y);
    f32x2 q = t * 0.5307027145f + (-0.7265760135f); q = q * t + 0.7107068705f; q = q * t + (-0.142248368f); q = q * t + 0.127414796f; q = q * t;
    const f32x2 s = (v * v) * (-0.72134752044f);
    f32x2 e; e.x = __builtin_amdgcn_exp2f(s.x); e.y = __builtin_amdgcn_exp2f(s.y);
    const f32x2 m = v * (q * e), r = v - m;
    f32x2 o; o.x = v.x < 0.f ? m.x : r.x; o.y = v.y < 0.f ? m.y : r.y; return o;
}

template <int ACT  > struct EpiBf16 {
    static constexpr bool PERM = true, AFTER_DRAIN = false; static_assert(ACT == 0 || ACT == 1, "EpiBf16: ACT is 0 (none) or 1 (gelu_pk)");
    bf16_t* O; int ldc; const float* bias; int split_cols; size_t split_stride; float scale0;
    __device__ __forceinline__ void operator()(const f32x4 (&acc)[2][2][4][2], const Unit& u, int wr, int wc, int fr, int fq) const {
        const int row0 = u.pm * BM + wr * 64 + fr; int colt = u.pn * BM; bf16_t* base = O;
        float sc = 1.f; if (split_cols) { const int t = colt / split_cols; base += (size_t)t * split_stride; colt -= t * split_cols; if (t == 0) sc = scale0; }
        const int col0 = colt + wc * 32 + 8 * fq, bcol0 = u.pn * BM + wc * 32 + 8 * fq;
        f32x4 bv[2][2];
#pragma unroll
        for (int bj = 0; bj < 2; ++bj)
#pragma unroll
            for (int n = 0; n < 2; ++n) bv[bj][n] = bias ? *(const f32x4*)(bias + bcol0 + bj * HALF + 4 * n) : (f32x4){0.f, 0.f, 0.f, 0.f};
#pragma unroll
        for (int ai = 0; ai < 2; ++ai)
#pragma unroll
            for (int m = 0; m < 4; ++m) { bf16_t* rowp = base + (size_t)(row0 + ai * HALF + m * 16) * ldc + col0;
#pragma unroll
                for (int bj = 0; bj < 2; ++bj) { f32x4 v0 = acc[ai][bj][m][0] + bv[bj][0], v1 = acc[ai][bj][m][1] + bv[bj][1];
                    if (ACT == 1) { f32x2 a = gelu_pk((f32x2){v0[0], v0[1]}), b = gelu_pk((f32x2){v0[2], v0[3]}), c = gelu_pk((f32x2){v1[0], v1[1]}), d = gelu_pk((f32x2){v1[2], v1[3]});
                        v0 = (f32x4){a.x, a.y, b.x, b.y}; v1 = (f32x4){c.x, c.y, d.x, d.y}; }
                    v0 = v0 * sc; v1 = v1 * sc; u32x4 w; w.x = cvt_pk_bf16(v0[0], v0[1]); w.y = cvt_pk_bf16(v0[2], v0[3]); w.z = cvt_pk_bf16(v1[0], v1[1]); w.w = cvt_pk_bf16(v1[2], v1[3]);
                    *(u32x4*)(rowp + bj * HALF) = w; } }
    }
};
template <class Epi, class Sched, bool ALIGN_EPI = false, bool SP2 = false>
__device__ __forceinline__ void gemm_phase(PG8_LAS unsigned char* lds, const Gemm g, const Sched& S, const Epi& E) {
    const int tid = threadIdx.x, wid = __builtin_amdgcn_readfirstlane(tid >> 6), lane = tid & 63, wr = wid >> 2, wc = wid & 3, fr = lane & 15, fq = lane >> 4;
    const int K = g.K, nt = K / BK;
    unsigned voffA[2], voffB[2];
#pragma unroll
    for (int i = 0; i < 2; ++i) { int R, C; stage_rc(tid * 16 + i * 8192, R, C); const int Rb = Epi::PERM ? ((R & ~31) + perm32(R & 31)) : R;
        voffA[i] = (unsigned)(R * K + C) * 2u; voffB[i] = (unsigned)(Rb * K + C) * 2u; }
    const size_t kstep = (size_t)(BK * 2);
    const size_t hstep = (size_t)HALF * K * 2;
    const size_t tstep = 2 * hstep;
    const unsigned ldsw = (unsigned)wid * 1024u;
    const int aoff = lds_byte(wr * 64 + fr, fq * 8), boff = lds_byte(wc * 32 + fr, fq * 8);
#define PG8_SA(b, h) (((b) * 2 + (h)) * HTB)
#define PG8_SB(b, h) ((4 + (b) * 2 + (h)) * HTB)
#define PG8_STAGE(bufoff, gbase, voff) do { _Pragma("unroll") for (int _i = 0; _i < 2; ++_i) \
        __builtin_amdgcn_global_load_lds((const unsigned*)((const char*)(gbase) + (voff)[_i]), (PG8_LAS unsigned*)(lds + (bufoff) + ldsw + _i * 8192), 16, 0, 0); } while (0)
#define PG8_LDA(dst, b, h) do { _Pragma("unroll") for (int m = 0; m < 4; ++m) _Pragma("unroll") for (int k = 0; k < 2; ++k) dst[m][k] = *(const PG8_LAS bf16x8*)(lds + PG8_SA(b, h) + aoff + m * 2048 + k * 1024); } while (0)
#define PG8_LDB(dst, b, h) do { _Pragma("unroll") for (int n = 0; n < 2; ++n) _Pragma("unroll") for (int k = 0; k < 2; ++k) dst[n][k] = *(const PG8_LAS bf16x8*)(lds + PG8_SB(b, h) + boff + n * 2048 + k * 1024); } while (0)
#define PG8_MMA(ai, bj, At, Bt) do { __builtin_amdgcn_s_setprio(1); _Pragma("unroll") for (int m = 0; m < 4; ++m) _Pragma("unroll") for (int n = 0; n < 2; ++n) _Pragma("unroll") for (int k = 0; k < 2; ++k) \
        acc[ai][bj][m][n] = __builtin_amdgcn_mfma_f32_16x16x32_bf16(Bt[n][k], At[m][k], acc[ai][bj][m][n], 0, 0, 0); __builtin_amdgcn_s_setprio(0); } while (0)
#define PG8_WAIT_V(n) asm volatile("s_waitcnt vmcnt(" #n ")" ::: "memory")
#define PG8_WAIT_L(n) asm volatile("s_waitcnt lgkmcnt(" #n ")" ::: "memory")
#define PG8_BAR __builtin_amdgcn_s_barrier()
#define PG8_SCHED __builtin_amdgcn_sched_barrier(0)
    Unit cur, nxt; int ui = 0;
    if (!S.next(0, cur)) return;
    f32x4 acc[2][2][4][2];
#pragma unroll
    for (int a = 0; a < 2; ++a)
#pragma unroll
        for (int b = 0; b < 2; ++b)
#pragma unroll
            for (int m = 0; m < 4; ++m)
#pragma unroll
                for (int n = 0; n < 2; ++n) acc[a][b][m][n] = (f32x4){0.f, 0.f, 0.f, 0.f};
    bf16x8 At[4][2], B0[2][2], B1[2][2];
    const char* cA = (const char*)g.A + (size_t)cur.pm * tstep; const char* cB = (const char*)g.Bt + (size_t)cur.pn * tstep;
    S.a_ready(cur);
    if constexpr (SP2) {
        PG8_STAGE(PG8_SB(0, 0), cB, voffB); PG8_STAGE(PG8_SB(0, 1), cB + hstep, voffB); PG8_STAGE(PG8_SA(0, 0), cA, voffA); PG8_STAGE(PG8_SA(0, 1), cA + hstep, voffA);
        if (wr == 1) PG8_BAR;
        PG8_WAIT_V(2); PG8_BAR;
        PG8_STAGE(PG8_SB(1, 0), cB + kstep, voffB); PG8_STAGE(PG8_SA(1, 0), cA + kstep, voffA); PG8_STAGE(PG8_SB(1, 1), cB + hstep + kstep, voffB);
        PG8_WAIT_V(6); PG8_BAR;
    } else {
        PG8_STAGE(PG8_SB(0, 0), cB, voffB); PG8_STAGE(PG8_SA(0, 0), cA, voffA); PG8_STAGE(PG8_SB(0, 1), cB + hstep, voffB); PG8_STAGE(PG8_SA(0, 1), cA + hstep, voffA);
        if (wr == 1) PG8_BAR;
        PG8_WAIT_V(4); PG8_BAR;
        PG8_STAGE(PG8_SB(1, 0), cB + kstep, voffB); PG8_STAGE(PG8_SA(1, 0), cA + kstep, voffA); PG8_STAGE(PG8_SB(1, 1), cB + hstep + kstep, voffB);
        PG8_WAIT_V(6); PG8_BAR;
    }
    for (;;) {
        const bool has_next = S.next(ui + 1, nxt);
        const char* nA = has_next ? (const char*)g.A + (size_t)nxt.pm * tstep : cA; const char* nB = has_next ? (const char*)g.Bt + (size_t)nxt.pn * tstep : cB;
        for (int t = 0; t < nt; t += 2) {
            const bool last = (t == nt - 2);
            const char* a1 = cA + (size_t)(t + 1) * kstep;
            const char* a2 = last ? nA : cA + (size_t)(t + 2) * kstep; const char* b2 = last ? nB : cB + (size_t)(t + 2) * kstep;
            const char* a3 = a2 + kstep; const char* b3 = b2 + kstep;
            if (last && has_next) S.a_ready(nxt);
            if constexpr (SP2) {
            PG8_LDB(B0, 0, 0); PG8_LDB(B1, 0, 1); PG8_SCHED; PG8_LDA(At, 0, 0); PG8_STAGE(PG8_SA(1, 1), a1 + hstep, voffA);
            PG8_WAIT_V(8); PG8_WAIT_L(0); PG8_BAR; PG8_MMA(0, 0, At, B0); PG8_MMA(0, 1, At, B1); PG8_BAR; PG8_SCHED;
            PG8_LDA(At, 0, 1); PG8_STAGE(PG8_SB(0, 0), b2, voffB); PG8_STAGE(PG8_SB(0, 1), b2 + hstep, voffB); PG8_STAGE(PG8_SA(0, 0), a2, voffA);
            PG8_WAIT_V(8); PG8_WAIT_L(0); PG8_BAR; PG8_MMA(1, 0, At, B0); PG8_MMA(1, 1, At, B1); PG8_BAR; PG8_SCHED;
            PG8_LDB(B0, 1, 0); PG8_LDB(B1, 1, 1); PG8_SCHED; PG8_LDA(At, 1, 0); PG8_STAGE(PG8_SA(0, 1), a2 + hstep, voffA);
            PG8_WAIT_V(8); PG8_WAIT_L(0); PG8_BAR; PG8_MMA(0, 0, At, B0); PG8_MMA(0, 1, At, B1); PG8_BAR; PG8_SCHED;
            PG8_LDA(At, 1, 1); PG8_STAGE(PG8_SB(1, 0), b3, voffB); PG8_STAGE(PG8_SB(1, 1), b3 + hstep, voffB); PG8_STAGE(PG8_SA(1, 0), a3, voffA);
            PG8_WAIT_V(8); PG8_WAIT_L(0); PG8_BAR; PG8_MMA(1, 0, At, B0); PG8_MMA(1, 1, At, B1); PG8_BAR; PG8_SCHED;
            } else {
            PG8_LDB(B0, 0, 0); PG8_SCHED; PG8_LDA(At, 0, 0); PG8_STAGE(PG8_SA(1, 1), a1 + hstep, voffA);
            PG8_WAIT_L(8); PG8_BAR; PG8_WAIT_L(0); PG8_MMA(0, 0, At, B0); PG8_BAR; PG8_SCHED;
            PG8_LDB(B1, 0, 1); PG8_STAGE(PG8_SB(0, 0), b2, voffB);
            PG8_BAR; PG8_WAIT_L(0); PG8_MMA(0, 1, At, B1); PG8_BAR;
            PG8_LDA(At, 0, 1); PG8_STAGE(PG8_SA(0, 0), a2, voffA);
            PG8_BAR; PG8_WAIT_L(0); PG8_MMA(1, 0, At, B0); PG8_BAR; PG8_SCHED;
            PG8_STAGE(PG8_SB(0, 1), b2 + hstep, voffB);
            PG8_WAIT_V(6); PG8_BAR; PG8_MMA(1, 1, At, B1); PG8_BAR;
            PG8_LDB(B0, 1, 0); PG8_SCHED; PG8_LDA(At, 1, 0); PG8_STAGE(PG8_SA(0, 1), a2 + hstep, voffA);
            PG8_WAIT_L(8); PG8_BAR; PG8_WAIT_L(0); PG8_MMA(0, 0, At, B0); PG8_BAR; PG8_SCHED;
            PG8_LDB(B1, 1, 1); PG8_STAGE(PG8_SB(1, 0), b3, voffB);
            PG8_BAR; PG8_WAIT_L(0); PG8_MMA(0, 1, At, B1); PG8_BAR;
            PG8_LDA(At, 1, 1); PG8_STAGE(PG8_SA(1, 0), a3, voffA);
            PG8_BAR; PG8_WAIT_L(0); PG8_MMA(1, 0, At, B0); PG8_BAR; PG8_SCHED;
            PG8_STAGE(PG8_SB(1, 1), b3 + hstep, voffB);
            PG8_WAIT_V(6); PG8_BAR; PG8_MMA(1, 1, At, B1); PG8_BAR;
            }
        }
        if constexpr (ALIGN_EPI) { if (wr == 0) PG8_BAR; }
        if constexpr (!Epi::AFTER_DRAIN) { E(acc, cur, wr, wc, fr, fq); S.done(cur); }
        if (!has_next) break;
#pragma unroll
        for (int a = 0; a < 2; ++a)
#pragma unroll
            for (int b = 0; b < 2; ++b)
#pragma unroll
                for (int m = 0; m < 4; ++m)
#pragma unroll
                    for (int n = 0; n < 2; ++n) acc[a][b][m][n] = (f32x4){0.f, 0.f, 0.f, 0.f};
        cur = nxt; cA = nA; cB = nB; ++ui;
        if constexpr (ALIGN_EPI) { if (wr == 1) PG8_BAR; }
    }
    PG8_WAIT_V(0);
    if constexpr (!ALIGN_EPI) { if (wr == 0) PG8_BAR; }
    PG8_BAR;
    if constexpr (Epi::AFTER_DRAIN) { E.fused(acc, cur, wr, wc, fr, fq, lds, wid, lane); S.done(cur); }
#undef PG8_SA
#undef PG8_SB
#undef PG8_STAGE
#undef PG8_LDA
#undef PG8_LDB
#undef PG8_MMA
#undef PG8_WAIT_V
#undef PG8_WAIT_L
#undef PG8_BAR
#undef PG8_SCHED
}
}

#ifndef PG8_SP2
#define PG8_SP2 true
#endif
#ifndef PG8_ALIGN
#define PG8_ALIGN true
#endif
#define GAS __attribute__((address_space(1)))
#define LAS __attribute__((address_space(3)))
typedef unsigned short bf16;
typedef unsigned v4u __attribute__((ext_vector_type(4)));
typedef float f32x4 __attribute__((ext_vector_type(4)));
typedef short bf16x8 __attribute__((ext_vector_type(8)));
typedef GAS unsigned gu32;
typedef GAS unsigned long long gu64;
#define RLX_AGENT __ATOMIC_RELAXED, __HIP_MEMORY_SCOPE_AGENT
#define LDS_WAIT() asm volatile("s_waitcnt lgkmcnt(0)" ::: "memory")
#define VM_WAIT() asm volatile("s_waitcnt vmcnt(0)" ::: "memory")
__device__ __forceinline__ unsigned long long rt() { return __builtin_amdgcn_s_memrealtime(); }
__device__ __forceinline__ unsigned f2bf(float f) { unsigned u = __builtin_bit_cast(unsigned, f); return (u + 0x7fffu + ((u >> 16) & 1u)) >> 16; }
typedef float pk2_f32x2 __attribute__((ext_vector_type(2))); typedef __bf16 pk2_bf16x2 __attribute__((ext_vector_type(2)));
__device__ __forceinline__ unsigned pk2(float lo, float hi) { pk2_f32x2 v = {lo, hi}; pk2_bf16x2 b = __builtin_convertvector(v, pk2_bf16x2); return __builtin_bit_cast(unsigned, b); }

#define XB_TMO      128
#define XB_XCNT(j)  (256  + 64 * (j))
#define XB_XSUB(j)  (1280 + 64 * (j))
#define XB_XGEN(j)  (2304 + 64 * (j))
#define XB_TOP      3328
#define XB_TOPGEN   3392
#define XCD_BAR_WORDS 3456
#define XB_SPIN_CAP (1u << 18)

__device__ __forceinline__ unsigned xb_ld(unsigned* p)              { return __hip_atomic_load(p, __ATOMIC_RELAXED, __HIP_MEMORY_SCOPE_AGENT); }
__device__ __forceinline__ unsigned xb_add(unsigned* p, unsigned v) { return __hip_atomic_fetch_add(p, v, __ATOMIC_RELAXED, __HIP_MEMORY_SCOPE_AGENT); }
__device__ __forceinline__ unsigned xb_xcc_id() { return (unsigned)__builtin_amdgcn_s_getreg((3 << 11) | 20) & 0xFu; }
#define XB_SPIN(cond, bar) do { unsigned _sp = 0; while (cond) { __builtin_amdgcn_s_sleep(1); \
    if ((++_sp & 255u) == 0u) { if (xb_ld(&(bar)[XB_TMO])) break; if (_sp > XB_SPIN_CAP) { atomicAdd(&(bar)[XB_TMO], 1u); break; } } } } while (0)

struct XcdBarrier {
    unsigned* bar; unsigned x;
    volatile LAS unsigned* st;
};

__device__ __forceinline__ XcdBarrier xcd_barrier_post(unsigned* bar, volatile LAS unsigned* st) {
    XcdBarrier b; b.bar = bar; b.x = xb_xcc_id(); b.st = st;
    if (threadIdx.x == 0) (void)xb_add(&bar[XB_XCNT(b.x)], 1u);
    return b;
}
__device__ __forceinline__ void xcd_barrier_complete(unsigned* bar, unsigned x, unsigned& nloc, unsigned& nx) {
    const unsigned G = gridDim.x * gridDim.y * gridDim.z;
    unsigned sum, cnt, mine, sp = 0u;
    for (;;) {
        sum = 0u; cnt = 0u; mine = 0u;
#pragma unroll
        for (unsigned j = 0; j < 16; ++j) { const unsigned c = xb_ld(&bar[XB_XCNT(j)]); sum += c; cnt += (c > 0u) ? 1u : 0u; mine = (j == x) ? c : mine; }
        if (sum == G) break;
        __builtin_amdgcn_s_sleep(1);
        if ((++sp & 255u) == 0u) { if (xb_ld(&bar[XB_TMO])) break; if (sp > XB_SPIN_CAP) { atomicAdd(&bar[XB_TMO], 1u); break; } }
    }
    nloc = mine > 0u ? mine : 1u; nx = cnt > 0u ? cnt : 1u;
}

__device__ __forceinline__ void xcd_barrier(const XcdBarrier& b) {
    asm volatile("s_waitcnt vmcnt(0)" ::: "memory");
    __syncthreads();
    if (threadIdx.x == 0) {
        unsigned* bar = b.bar;
        __builtin_amdgcn_s_waitcnt(0);
        unsigned nloc = b.st[0], nx = b.st[1];
        if (nloc == 0u) { xcd_barrier_complete(bar, b.x, nloc, nx); b.st[0] = nloc; b.st[1] = nx; }
        const unsigned old = xb_add(&bar[XB_XSUB(b.x)], 1u);
        const unsigned gen = old / nloc;
        if (old + 1u == (gen + 1u) * nloc) {
            __builtin_amdgcn_fence(__ATOMIC_RELEASE, "agent");
            asm volatile("s_waitcnt vmcnt(0)" ::: "memory");
            const unsigned og = xb_add(&bar[XB_TOP], 1u);
            const unsigned tg = og / nx;
            if (og + 1u == (tg + 1u) * nx) xb_add(&bar[XB_TOPGEN], 1u);
            else XB_SPIN(xb_ld(&bar[XB_TOPGEN]) == tg, bar);
            __builtin_amdgcn_fence(__ATOMIC_ACQUIRE, "agent");
            xb_add(&bar[XB_XGEN(b.x)], 1u);
            asm volatile("s_waitcnt vmcnt(0)" ::: "memory");
        } else {
            XB_SPIN(xb_ld(&bar[XB_XGEN(b.x)]) == gen, bar);
            __builtin_amdgcn_fence(__ATOMIC_ACQUIRE, "agent");
            asm volatile("s_waitcnt vmcnt(0)" ::: "memory");
        }
    }
    __syncthreads();
}


constexpr int NWAVES = 8;
constexpr int DM = 2048, BATCH = 4, SEQ = 4096, M = BATCH * SEQ;
constexpr int NIN = 6176, NINP = 6400;
constexpr int O_GQ = 0, O_GK = 512, O_GV = 1024, O_GR = 2048, O_GDF = 3072, O_GDB = 3088, O_AQ = 3104, O_AK = 4128, O_AV = 5152;
constexpr float EPS = 1e-6f;
constexpr int PEER_K = 128;

constexpr size_t MiB = 1u << 20;
constexpr size_t WS_CTL = 0, CTL_ZERO_BYTES = 1 * MiB;
constexpr size_t WS_WIN = 1 * MiB;
constexpr size_t WS_WOUT = 26 * MiB;
constexpr size_t WS_WQ = 34 * MiB;
constexpr size_t WS_SSQ = 42 * MiB;
constexpr size_t WS_EIDX = 44 * MiB;
constexpr size_t WS_GATE = 52 * MiB;
constexpr size_t WS_SKB = 60 * MiB;
constexpr size_t WS_XN = 64 * MiB;
constexpr size_t WS_PROJ = 128 * MiB;
constexpr size_t WS_HB = 256 * MiB;
constexpr size_t WS_OF = 328 * MiB;
constexpr size_t WS_OB = 360 * MiB;
constexpr size_t WS_ATT = 392 * MiB;
constexpr size_t WS_ATTP = 392 * MiB;
constexpr size_t WS_ATTML = 488 * MiB;
constexpr size_t WS_GT_QD = 64 * MiB;
constexpr size_t WS_GT_KE = 96 * MiB;
constexpr size_t OUT_GT_AM = 0;
constexpr size_t OUT_GT_DEC = 16 * MiB;
constexpr size_t OUT_GT_VT = 32 * MiB;
constexpr int CW_ATTQ = 64;
constexpr size_t WS_END = 494 * MiB;
constexpr size_t WS_H = 128 * MiB;
constexpr size_t OUT_U8 = 64 * MiB;
constexpr size_t OUT_V8 = 96 * MiB;
constexpr size_t WS_SU = 61 * MiB;
constexpr size_t WS_SV = 61 * MiB + 65536;
constexpr int CW_CONVQ = 256;
constexpr size_t WS_PW = 256 * MiB;
constexpr size_t WS_SSQ2 = 264 * MiB;
constexpr size_t WS_PD = 64 * MiB;
constexpr int PEER_E = 16384;
constexpr int CW_TMO = 0, CW_CODE = 1, CW_BAR = 4096;

constexpr int RING_OFF = 0, RING_BYTES = 131072;
constexpr int LDS_BYTES = 163840;
constexpr int LDSCTL_OFF = LDS_BYTES - 1024, MISC_OFF = LDSCTL_OFF + 320;

typedef float f32x2 __attribute__((ext_vector_type(2)));
__device__ __forceinline__ float bf2f(unsigned short h) { return __builtin_bit_cast(float, (unsigned)h << 16); }
__device__ __forceinline__ float bflo(unsigned w) { return __builtin_bit_cast(float, w << 16); }
__device__ __forceinline__ float bfhi(unsigned w) { return __builtin_bit_cast(float, w & 0xffff0000u); }
__device__ __forceinline__ float wave_sum(float v) {
#pragma unroll
    for (int o = 1; o < 64; o <<= 1) v += __shfl_xor(v, o);
    return v;
}
__device__ __forceinline__ float wave_max(float v) {
#pragma unroll
    for (int o = 1; o < 64; o <<= 1) v = fmaxf(v, __shfl_xor(v, o));
    return v;
}

template <class T> __device__ __forceinline__ T* opaque(T* p) { asm volatile("" : "+s"(p)); return p; }
__device__ __forceinline__ int opaque_v(int x) { asm volatile("" : "+v"(x)); return x; }
template <class T> __device__ __forceinline__ T ldu(const void* ubase, unsigned voff) { return *(const T*)((const char*)ubase + voff); }
template <class T> __device__ __forceinline__ void stu(void* ubase, unsigned voff, T v) { *(T*)((char*)ubase + voff) = v; }
namespace pg8 {
struct EpiRes {
    static constexpr bool PERM = false, AFTER_DRAIN = false;
    const float* x; float* H; bf16_t* HB; float* ssq; int ldc;
    __device__ __forceinline__ void operator()(const f32x4 (&acc)[2][2][4][2], const Unit& u, int wr, int wc, int fr, int fq) const {
        const int col0 = u.pn * BM + wc * 32 + 4 * fq;
#pragma unroll
        for (int ai = 0; ai < 2; ++ai)
#pragma unroll
            for (int m = 0; m < 4; ++m) {
                const int r = u.pm * BM + ai * HALF + wr * 64 + m * 16 + fr; const size_t off = (size_t)r * ldc + col0; float s = 0.f;
#pragma unroll
                for (int bj = 0; bj < 2; ++bj)
#pragma unroll
                    for (int n = 0; n < 2; ++n) {
                        const f32x4 xv = *(const f32x4*)(x + off + bj * HALF + n * 16);
                        const f32x4 hv = xv + acc[ai][bj][m][n];
                        *(f32x4*)(H + off + bj * HALF + n * 16) = hv;
                        s += (hv[0] * hv[0] + hv[1] * hv[1]) + (hv[2] * hv[2] + hv[3] * hv[3]);
                        unsigned long long w = (unsigned long long)cvt_pk_bf16(hv[0], hv[1]) | ((unsigned long long)cvt_pk_bf16(hv[2], hv[3]) << 32);
                        *(unsigned long long*)(HB + off + bj * HALF + n * 16) = w;
                    }
                s += __shfl_xor(s, 16); s += __shfl_xor(s, 32);
                if (fq == 0) ssq[(size_t)r * 32 + u.pn * 4 + wc] = s;
            }
    }
};
struct EpiRowScale {
    static constexpr bool PERM = true, AFTER_DRAIN = false;
    bf16_t* O; int ldc; const float* ssq; float inv_n, eps;
    __device__ __forceinline__ void operator()(const f32x4 (&acc)[2][2][4][2], const Unit& u, int wr, int wc, int fr, int fq) const {
        const int col0 = u.pn * BM + wc * 32 + 8 * fq;
#pragma unroll
        for (int ai = 0; ai < 2; ++ai)
#pragma unroll
            for (int m = 0; m < 4; ++m) {
                const int r = u.pm * BM + ai * HALF + wr * 64 + m * 16 + fr;
                const f32x4* sp = (const f32x4*)(ssq + (size_t)r * 32); float s = 0.f;
#pragma unroll
                for (int i = 0; i < 8; ++i) { const f32x4 t = sp[i]; s += (t[0] + t[1]) + (t[2] + t[3]); }
                const float sc = 1.0f / sqrtf(s * inv_n + eps);
                bf16_t* rowp = O + (size_t)r * ldc + col0;
#pragma unroll
                for (int bj = 0; bj < 2; ++bj) { const f32x4 v0 = acc[ai][bj][m][0] * sc, v1 = acc[ai][bj][m][1] * sc;
                    u32x4 w; w.x = cvt_pk_bf16(v0[0], v0[1]); w.y = cvt_pk_bf16(v0[2], v0[3]); w.z = cvt_pk_bf16(v1[0], v1[1]); w.w = cvt_pk_bf16(v1[2], v1[3]);
                    *(u32x4*)(rowp + bj * HALF) = w; }
            }
    }
};
}

struct Frame {
    LAS unsigned char* lds;
    volatile LAS unsigned* MISC;
    gu32* ctl;
    int tid, lane, wave;
    int vcu, G;
};

__device__ __forceinline__ void p0_transpose_item(const float* W, int K, int ldw, const float* gk, bf16* WT, LAS float* scr, int item, int lane) {
    const int nblk = ldw / 32, kb = item / nblk, nb = item % nblk, k0 = 64 * kb, n0 = 32 * nb;
#pragma unroll 8
    for (int i = 0; i < 32; ++i) { const int kk = 2 * i + (lane >> 5); float w = W[(size_t)(k0 + kk) * ldw + n0 + (lane & 31)]; if (gk) w *= gk[k0 + kk]; scr[kk * 33 + (lane & 31)] = w; }
    LDS_WAIT(); asm volatile("" ::: "memory");
    const int c = lane & 7;
#pragma unroll
    for (int j = 0; j < 4; ++j) { const int n = (lane >> 3) + 8 * j; const LAS float* s = scr + (8 * c) * 33 + n;
        v4u o; o.x = pk2(s[0 * 33], s[1 * 33]); o.y = pk2(s[2 * 33], s[3 * 33]); o.z = pk2(s[4 * 33], s[5 * 33]); o.w = pk2(s[6 * 33], s[7 * 33]);
        *(GAS v4u*)(WT + (size_t)(n0 + n) * K + k0 + 8 * c) = o; }
    LDS_WAIT(); asm volatile("" ::: "memory");
}
__device__ __forceinline__ void rms_row_to_bf16(int lane, const float* xrow, const float* g, bf16* orow) {
    const GAS f32x4* xr = (const GAS f32x4*)xrow + lane; const GAS f32x4* gr = (const GAS f32x4*)g + lane;
    f32x4 v[8]; float s = 0.f;
#pragma unroll
    for (int j = 0; j < 8; ++j) { v[j] = xr[64 * j]; s += (v[j].x * v[j].x + v[j].y * v[j].y) + (v[j].z * v[j].z + v[j].w * v[j].w); }
    const float rstd = 1.f / sqrtf(wave_sum(s) * (1.f / DM) + EPS);
    GAS unsigned long long* o8 = (GAS unsigned long long*)orow + lane;
#pragma unroll
    for (int j = 0; j < 8; ++j) { const f32x4 gg = gr[64 * j];
        o8[64 * j] = (unsigned long long)pk2(v[j].x * rstd * gg.x, v[j].y * rstd * gg.y) | ((unsigned long long)pk2(v[j].z * rstd * gg.z, v[j].w * rstd * gg.w) << 32); }
}

struct Args {
    const float* in[16]; float* out; unsigned char* ws; int ph_lo, ph_hi, li, pad;
};

__device__ __forceinline__ void p0_prologue(Frame& F, const Args& a) {
    unsigned char* ws = a.ws;
    LAS float* scr = (LAS float*)(F.lds + RING_OFF + F.wave * 16384);
    const int gw = F.vcu * NWAVES + F.wave, NGW = F.G * NWAVES;
    bf16* Win_t = (bf16*)(ws + WS_WIN); bf16* Wout_t = (bf16*)(ws + WS_WOUT); bf16* Wq_t = (bf16*)(ws + WS_WQ); bf16* XN = (bf16*)(ws + WS_XN);
    constexpr int I_IN = (DM / 64) * (NIN / 32), I_SQ = (DM / 64) * (DM / 32);
    constexpr int NITEMS = I_IN + 2 * I_SQ;
    for (int it = gw; it < NITEMS; it += NGW) {
        int r = it;
        if (r < I_IN) { p0_transpose_item(a.in[2], DM, NIN, nullptr, Win_t, scr, r, F.lane); continue; } r -= I_IN;
        if (r < I_SQ) { p0_transpose_item(a.in[9], DM, DM, nullptr, Wout_t, scr, r, F.lane); continue; } r -= I_SQ;
        p0_transpose_item(a.in[11], DM, DM, a.in[10], Wq_t, scr, r, F.lane);
    }
    { GAS v4u* z = (GAS v4u*)(Win_t + (size_t)NIN * DM); const int n16 = (NINP - NIN) * DM * 2 / 16;
      for (int i = (gw * 64 + F.lane); i < n16; i += NGW * 64) z[i] = (v4u){0u, 0u, 0u, 0u}; }
    { const f32x4* sk = (const f32x4*)a.in[12]; unsigned long long* skb = (unsigned long long*)(ws + WS_SKB);
      for (int i = gw * 64 + F.lane; i < 8 * 2 * 128 * 128 / 4; i += NGW * 64) { const f32x4 v = sk[i]; skb[i] = (unsigned long long)pk2(v.x, v.y) | ((unsigned long long)pk2(v.z, v.w) << 32); } }
    for (int m = gw; m < M; m += NGW) rms_row_to_bf16(F.lane, a.in[0] + (size_t)m * DM, a.in[1], XN + (size_t)m * DM);
}

__device__ __forceinline__ void p3_finalize(Frame& F, const Args& a) {
    unsigned char* ws = a.ws;
    const int gw = F.vcu * NWAVES + F.wave, NGW = F.G * NWAVES, lane = F.lane;
    const bf16* OFp = (const bf16*)(ws + WS_OF); const bf16* OBp = (const bf16*)(ws + WS_OB);
    const bf16* PROJ = (const bf16*)(ws + WS_PROJ); bf16* Y = (bf16*)(ws + WS_XN);
    const float* gla_g = a.in[7]; const float* att_g = a.in[8];
    const f32x4 gg = *(const f32x4*)(gla_g + 4 * lane);
    for (int m = gw; m < M; m += NGW) {
#pragma unroll
        for (int hh = 0; hh < 4; ++hh) {
            const unsigned long long wf = *(const unsigned long long*)(OFp + (size_t)m * 1024 + hh * 256 + 4 * lane);
            const unsigned long long wb = *(const unsigned long long*)(OBp + (size_t)m * 1024 + hh * 256 + 4 * lane);
            const f32x4 o = (f32x4){bflo((unsigned)wf) + bflo((unsigned)wb), bfhi((unsigned)wf) + bfhi((unsigned)wb), bflo((unsigned)(wf >> 32)) + bflo((unsigned)(wb >> 32)), bfhi((unsigned)(wf >> 32)) + bfhi((unsigned)(wb >> 32))};
            const float ss = wave_sum((o.x * o.x + o.y * o.y) + (o.z * o.z + o.w * o.w));
            const float rstd = 1.f / sqrtf(ss * (1.f / 256.f) + EPS);
            const unsigned long long gr = *(const unsigned long long*)(PROJ + (size_t)m * NINP + O_GR + hh * 256 + 4 * lane);
            const float r0 = bflo((unsigned)gr), r1 = bfhi((unsigned)gr), r2 = bflo((unsigned)(gr >> 32)), r3 = bfhi((unsigned)(gr >> 32));
            const float y0 = o.x * rstd * gg.x * (r0 / (1.f + __expf(-r0))), y1 = o.y * rstd * gg.y * (r1 / (1.f + __expf(-r1)));
            const float y2 = o.z * rstd * gg.z * (r2 / (1.f + __expf(-r2))), y3 = o.w * rstd * gg.w * (r3 / (1.f + __expf(-r3)));
            *(unsigned long long*)(Y + (size_t)m * DM + hh * 256 + 4 * lane) = (unsigned long long)pk2(y0, y1) | ((unsigned long long)pk2(y2, y3) << 32);
        }
        float av[16]; float ss = 0.f;
#pragma unroll
        for (int p = 0; p < 2; ++p) { const int col = p * 512 + 8 * lane, hd = col >> 6; float mm[3], ll[3]; v4u ow[3];
#pragma unroll
            for (int pt = 0; pt < 3; ++pt) { const size_t rec = ((size_t)pt * M + m) * 16 + hd; const f32x2 ml2 = *(const f32x2*)((const float*)(ws + WS_ATTML) + rec * 2); mm[pt] = ml2.x; ll[pt] = ml2.y;
                ow[pt] = *(const v4u*)((const bf16*)(ws + WS_ATTP) + rec * 64 + (col & 63)); }
            const float mt = fmaxf(fmaxf(mm[0], mm[1]), mm[2]); const float w0 = __expf(mm[0] - mt), w1 = __expf(mm[1] - mt), w2 = __expf(mm[2] - mt);
            const float inv = 1.f / (w0 * ll[0] + w1 * ll[1] + w2 * ll[2]);
            av[p * 8 + 0] = (w0 * bflo(ow[0].x) + w1 * bflo(ow[1].x) + w2 * bflo(ow[2].x)) * inv; av[p * 8 + 1] = (w0 * bfhi(ow[0].x) + w1 * bfhi(ow[1].x) + w2 * bfhi(ow[2].x)) * inv;
            av[p * 8 + 2] = (w0 * bflo(ow[0].y) + w1 * bflo(ow[1].y) + w2 * bflo(ow[2].y)) * inv; av[p * 8 + 3] = (w0 * bfhi(ow[0].y) + w1 * bfhi(ow[1].y) + w2 * bfhi(ow[2].y)) * inv;
            av[p * 8 + 4] = (w0 * bflo(ow[0].z) + w1 * bflo(ow[1].z) + w2 * bflo(ow[2].z)) * inv; av[p * 8 + 5] = (w0 * bfhi(ow[0].z) + w1 * bfhi(ow[1].z) + w2 * bfhi(ow[2].z)) * inv;
            av[p * 8 + 6] = (w0 * bflo(ow[0].w) + w1 * bflo(ow[1].w) + w2 * bflo(ow[2].w)) * inv; av[p * 8 + 7] = (w0 * bfhi(ow[0].w) + w1 * bfhi(ow[1].w) + w2 * bfhi(ow[2].w)) * inv; }
#pragma unroll
        for (int i = 0; i < 16; ++i) ss += av[i] * av[i];
        const float rstd = 1.f / sqrtf(wave_sum(ss) * (1.f / 1024.f) + EPS);
#pragma unroll
        for (int p = 0; p < 2; ++p) { const f32x4 g0 = *(const f32x4*)(att_g + p * 512 + 8 * lane), g1 = *(const f32x4*)(att_g + p * 512 + 8 * lane + 4);
            v4u w; w.x = pk2(av[p * 8 + 0] * rstd * g0.x, av[p * 8 + 1] * rstd * g0.y); w.y = pk2(av[p * 8 + 2] * rstd * g0.z, av[p * 8 + 3] * rstd * g0.w);
            w.z = pk2(av[p * 8 + 4] * rstd * g1.x, av[p * 8 + 5] * rstd * g1.y); w.w = pk2(av[p * 8 + 6] * rstd * g1.z, av[p * 8 + 7] * rstd * g1.w);
            *(v4u*)(Y + (size_t)m * DM + 1024 + p * 512 + 8 * lane) = w; }
    }
}


__device__ __forceinline__ void naive_gla_phase(Frame& F, const Args& a) {
    unsigned char* ws = a.ws; const bf16* PROJ = (const bf16*)(ws + WS_PROJ);
    const int half = F.tid >> 8, tid = F.tid & 255, e = tid & 15, dg = tid >> 4, d0 = dg * 8;
    LAS float* sm = (LAS float*)(F.lds + RING_OFF + half * 32768);
    LAS float* qs = sm; LAS float* ks = sm + 2048; LAS float* as_ = sm + 4096; LAS float* gds = sm + 6144; LAS float* vs = sm + 6400; LAS float* psum = sm + 6656;
    for (int ui = F.vcu; ui < 256; ui += F.G) {
        const int unit = ui * 2 + half;
        const int e0 = (unit & 15) * 16, h = (unit >> 4) & 3, b = (unit >> 6) & 3, dir = unit >> 8;
        const float* up = dir ? a.in[5] : a.in[3]; const float* bias = dir ? a.in[6] : a.in[4]; float* Out = (float*)(ws + (dir ? WS_OB : WS_OF));
        float S[8];
#pragma unroll
        for (int j = 0; j < 8; ++j) S[j] = 0.f;
        for (int t0 = 0; t0 < SEQ; t0 += 16) {
            for (int idx = tid; idx < 16 * 128; idx += 256) { const int i = idx >> 7, d = idx & 127; const int t = dir ? (SEQ - 1 - (t0 + i)) : (t0 + i); const size_t row = (size_t)b * SEQ + t;
                qs[i * 128 + d] = bf2f(PROJ[row * NINP + O_GQ + h * 128 + d]) * 0.08838834764831845f; ks[i * 128 + d] = bf2f(PROJ[row * NINP + O_GK + h * 128 + d]); }
            { const int i = tid >> 4, r = tid & 15; const int t = dir ? (SEQ - 1 - (t0 + i)) : (t0 + i); const size_t row = (size_t)b * SEQ + t;
              gds[i * 16 + r] = bf2f(PROJ[row * NINP + O_GDF + dir * 16 + r]); vs[i * 16 + r] = bf2f(PROJ[row * NINP + O_GV + h * 256 + e0 + r]); }
            __syncthreads();
            for (int idx = tid; idx < 16 * 128; idx += 256) { const int i = idx >> 7, d = idx & 127; float z = bias[h * 128 + d];
#pragma unroll
                for (int r = 0; r < 16; ++r) z += gds[i * 16 + r] * up[r * 512 + h * 128 + d];
                const float ls = fminf(z, 0.f) - log1pf(expf(-fabsf(z))); as_[i * 128 + d] = expf(ls * (1.f / 16.f)); }
            __syncthreads();
            for (int i = 0; i < 16; ++i) { const float v = vs[i * 16 + e]; float p = 0.f;
#pragma unroll
                for (int j = 0; j < 8; ++j) { S[j] = as_[i * 128 + d0 + j] * S[j] + ks[i * 128 + d0 + j] * v; p += qs[i * 128 + d0 + j] * S[j]; }
                p += __shfl_xor(p, 16); p += __shfl_xor(p, 32);
                if ((tid & 63) < 16) psum[(i * 4 + (tid >> 6)) * 16 + e] = p; }
            __syncthreads();
            { const int i = tid >> 4, ee = tid & 15; const int t = dir ? (SEQ - 1 - (t0 + i)) : (t0 + i); const size_t row = (size_t)b * SEQ + t;
              Out[row * 1024 + h * 256 + e0 + ee] = (psum[(i * 4 + 0) * 16 + ee] + psum[(i * 4 + 1) * 16 + ee]) + (psum[(i * 4 + 2) * 16 + ee] + psum[(i * 4 + 3) * 16 + ee]); }
        }
        __syncthreads();
    }
}

__device__ __forceinline__ void naive_attn_phase(Frame& F, const Args& a) {
    unsigned char* ws = a.ws; const bf16* PROJ = (const bf16*)(ws + WS_PROJ); bf16* ATT = (bf16*)(ws + WS_ATT);
    for (int gid2 = F.vcu * 512 + F.tid; gid2 < M * 32; gid2 += F.G * 512) {
        const int hf = gid2 & 1, gid = gid2 >> 1;
        const int h = gid & 15, row = gid >> 4, b = row >> 12, t = row & (SEQ - 1);
        float q[32], o[32];
        const bf16* qp = PROJ + (size_t)row * NINP + O_AQ + h * 64 + hf * 32;
#pragma unroll
        for (int i = 0; i < 32; ++i) { q[i] = bf2f(qp[i]) * 0.125f; o[i] = 0.f; }
        const float slope = exp2f(-0.5f * (float)(h + 1));
        float m = -1e30f, l = 0.f;
        for (int p = 0; p < 3; ++p) { const int dil = (p == 0) ? 1 : (p == 1 ? 4 : 16);
            for (int j = -64; j <= 64; ++j) { const int tk = t + j * dil; if (tk < 0 || tk >= SEQ) continue;
                const bf16* kp = PROJ + ((size_t)b * SEQ + tk) * NINP + O_AK + h * 64 + hf * 32; const bf16* vp = kp + (O_AV - O_AK);
                float s = 0.f;
#pragma unroll
                for (int i = 0; i < 32; ++i) s += q[i] * bf2f(kp[i]);
                s += __shfl_xor(s, 1);
                s -= slope * (float)((j < 0 ? -j : j) * dil);
                const float mn = fmaxf(m, s), sc = __expf(m - mn), pe = __expf(s - mn); l = l * sc + pe; m = mn;
#pragma unroll
                for (int i = 0; i < 32; ++i) o[i] = o[i] * sc + pe * bf2f(vp[i]); } }
        const float il = 1.f / l; bf16* op = ATT + (size_t)row * 1024 + h * 64 + hf * 32;
#pragma unroll
        for (int i = 0; i < 32; ++i) op[i] = (bf16)f2bf(o[i] * il);
    }
}

__device__ __forceinline__ void wave_argmax(float& v, int& idx) {
#pragma unroll
    for (int o = 1; o < 64; o <<= 1) { const float ov = __shfl_xor(v, o); const int oi = __shfl_xor(idx, o); if (ov > v || (ov == v && oi < idx)) { v = ov; idx = oi; } }
}
__device__ __forceinline__ void naive_topk_phase(Frame& F, const Args& a) {
    unsigned char* ws = a.ws; const bf16* QP = (const bf16*)(ws + WS_XN); const float* subk = a.in[12]; int* EIDX = (int*)(ws + WS_EIDX); float* GATE = (float*)(ws + WS_GATE);
    LAS float* qsh = (LAS float*)(F.lds + RING_OFF + F.wave * 4096);
    LAS int* sid = (LAS int*)(qsh + 256);
    LAS float* sgt = (LAS float*)(qsh + 384);
    const int lane = F.lane;
    for (int row = F.vcu * NWAVES + F.wave; row < M; row += F.G * NWAVES) {
        for (int h = 0; h < 8; ++h) {
            const bf16* qp = QP + (size_t)row * DM + h * 256;
#pragma unroll
            for (int i = 0; i < 4; ++i) qsh[lane + 64 * i] = bf2f(qp[lane + 64 * i]);
            LDS_WAIT(); asm volatile("" ::: "memory");
            float tv[2]; int ti[2];
#pragma unroll
            for (int c = 0; c < 2; ++c) {
                const float* k0 = subk + (((size_t)h * 2 + c) * 128 + lane) * 128; const float* k1 = k0 + 64 * 128;
                float av = 0.f, bsc = 0.f;
#pragma unroll 4
                for (int d = 0; d < 128; d += 4) { const f32x4 x0 = *(const f32x4*)(k0 + d), x1 = *(const f32x4*)(k1 + d); const float q0 = qsh[c * 128 + d], q1 = qsh[c * 128 + d + 1], q2 = qsh[c * 128 + d + 2], q3 = qsh[c * 128 + d + 3];
                    av += q0 * x0.x + q1 * x0.y + q2 * x0.z + q3 * x0.w; bsc += q0 * x1.x + q1 * x1.y + q2 * x1.z + q3 * x1.w; }
                float keepv = -3e38f; int keepi = 0;
                for (int r = 0; r < 16; ++r) { float v; int idx; if (av >= bsc) { v = av; idx = lane; } else { v = bsc; idx = lane + 64; }
                    wave_argmax(v, idx);
                    if (idx == lane) av = -3e38f; if (idx == lane + 64) bsc = -3e38f;
                    if (lane == r) { keepv = v; keepi = idx; } }
                tv[c] = keepv; ti[c] = keepi;
            }
            float cv[4];
#pragma unroll
            for (int u = 0; u < 4; ++u) { const int id = lane * 4 + u; cv[u] = __shfl(tv[0], id >> 4) + __shfl(tv[1], id & 15); }
            float topv = -3e38f; int topid = 0;
            for (int r = 0; r < 16; ++r) { float v = cv[0]; int idx = lane * 4;
#pragma unroll
                for (int u = 1; u < 4; ++u) if (cv[u] > v) { v = cv[u]; idx = lane * 4 + u; }
                wave_argmax(v, idx);
                if ((idx >> 2) == lane) {
#pragma unroll
                    for (int u = 0; u < 4; ++u) if ((idx & 3) == u) cv[u] = -3e38f; }
                if (lane == r) { topv = v; topid = idx; } }
            const int i1 = __shfl(ti[0], topid >> 4), i2 = __shfl(ti[1], topid & 15);
            const float vm = (lane < 16) ? topv : -3e38f; const float mx = wave_max(vm);
            const float ex = (lane < 16) ? __expf(topv - mx) : 0.f; const float sm = wave_sum(ex);
            if (lane < 16) { sid[h * 16 + lane] = i1 * 128 + i2; sgt[h * 16 + lane] = ex / sm; }
            LDS_WAIT(); asm volatile("" ::: "memory");
        }
        const int m0 = sid[lane], m1 = sid[lane + 64]; const float g0 = sgt[lane], g1 = sgt[lane + 64];
        int r0 = 0, r1 = 0;
        for (int j = 0; j < 128; ++j) { const int o = sid[j]; r0 += (o < m0 || (o == m0 && j < lane)) ? 1 : 0; r1 += (o < m1 || (o == m1 && j < lane + 64)) ? 1 : 0; }
        EIDX[(size_t)row * 128 + r0] = m0; GATE[(size_t)row * 128 + r0] = g0;
        EIDX[(size_t)row * 128 + r1] = m1; GATE[(size_t)row * 128 + r1] = g1;
        LDS_WAIT(); asm volatile("" ::: "memory");
    }
}

typedef float f32x16 __attribute__((ext_vector_type(16)));
__device__ __forceinline__ void ce_desc(float& a, float& b) { const float hi = fmaxf(a, b), lo = fminf(a, b); a = hi; b = lo; }
__device__ __forceinline__ void sort16_desc(float* v) {
#pragma unroll
    for (int k = 2; k <= 16; k <<= 1)
#pragma unroll
        for (int j = k >> 1; j > 0; j >>= 1)
#pragma unroll
            for (int i = 0; i < 16; ++i) { const int l = i ^ j; if (l > i) { if ((i & k) == 0 || k == 16) ce_desc(v[i], v[l]); else ce_desc(v[l], v[i]); } }
}
__device__ __forceinline__ void merge16_desc(float* v) {
#pragma unroll
    for (int j = 8; j > 0; j >>= 1)
#pragma unroll
        for (int i = 0; i < 16; ++i) { const int l = i ^ j; if (l > i) ce_desc(v[i], v[l]); }
}
__device__ __forceinline__ void top16_of_two(float* a, const float* b) {
#pragma unroll
    for (int i = 0; i < 16; ++i) a[i] = fmaxf(a[i], b[15 - i]);
    merge16_desc(a);
}
__device__ __forceinline__ void top16_of_64(float* v) {
    sort16_desc(v); sort16_desc(v + 16); sort16_desc(v + 32); sort16_desc(v + 48);
    top16_of_two(v, v + 16); top16_of_two(v + 32, v + 48); top16_of_two(v, v + 32);
}
__device__ __forceinline__ void topk_phase(Frame& F, const Args& a) {
    unsigned char* ws = a.ws; const bf16* QP = (const bf16*)(ws + WS_XN); const bf16* SKB = (const bf16*)(ws + WS_SKB); int* EIDX = (int*)(ws + WS_EIDX); float* GATE = (float*)(ws + WS_GATE);
    const int lane = F.lane, h = F.wave, r32 = lane & 31, hh = lane >> 5;
    LAS int* tok_id = (LAS int*)(F.lds);
    LAS float* tok_gt = (LAS float*)(F.lds + 32768);
    LAS int* ktab = (LAS int*)(F.lds + 65536 + F.wave * 8192);
    for (int unit = F.vcu; unit < M / 64; unit += F.G) {
        const int tok0 = unit * 64;
#pragma unroll 1
        for (int tt = 0; tt < 2; ++tt) {
            const size_t row = (size_t)(tok0 + tt * 32 + r32);
            float L[2][16];
#pragma unroll
            for (int c = 0; c < 2; ++c) {
                f32x16 acc[4];
#pragma unroll
                for (int kt = 0; kt < 4; ++kt) acc[kt] = (f32x16){0.f, 0.f, 0.f, 0.f, 0.f, 0.f, 0.f, 0.f, 0.f, 0.f, 0.f, 0.f, 0.f, 0.f, 0.f, 0.f};
                const bf16* qb = QP + row * DM + h * 256 + c * 128 + 8 * hh;
                const bf16* kb = SKB + ((size_t)(h * 2 + c) * 128 + r32) * 128 + 8 * hh;
#if !defined(TOPK_DBG)
#pragma unroll 2
                for (int st = 0; st < 8; ++st) {
                    const bf16x8 bq = *(const bf16x8*)(qb + 16 * st);
#pragma unroll
                    for (int kt = 0; kt < 4; ++kt) { const bf16x8 ak = *(const bf16x8*)(kb + (size_t)kt * 32 * 128 + 16 * st);
                        acc[kt] = __builtin_amdgcn_mfma_f32_32x32x16_bf16(ak, bq, acc[kt], 0, 0, 0); }
                }
#else
                (void)qb; (void)kb;
#pragma unroll
                for (int kt = 0; kt < 4; ++kt)
#pragma unroll
                    for (int r = 0; r < 16; ++r) { const int key = 32 * kt + (r & 3) + 8 * (r >> 2) + 4 * hh; float d = 0.f;
                        const bf16* qq = QP + row * DM + h * 256 + c * 128; const float* kk = a.in[12] + ((size_t)(h * 2 + c) * 128 + key) * 128;
                        for (int dd = 0; dd < 128; ++dd) d += bf2f(qq[dd]) * kk[dd];
                        acc[kt][r] = d; }
#endif
                float v[64];
#pragma unroll
                for (int kt = 0; kt < 4; ++kt)
#pragma unroll
                    for (int r = 0; r < 16; ++r) { const int key = 32 * kt + (r & 3) + 8 * (r >> 2);
                        const float sc = acc[kt][r];
                        v[kt * 16 + r] = __builtin_bit_cast(float, (__builtin_bit_cast(unsigned, sc) & ~127u) | (unsigned)(key + 4 * hh)); }
                top16_of_64(v);
                float p[16];
#pragma unroll
                for (int i = 0; i < 16; ++i) p[i] = __shfl_xor(v[i], 32);
                top16_of_two(v, p);
#pragma unroll
                for (int i = 0; i < 16; ++i) { L[c][i] = v[i]; ktab[(c * 16 + i) * 64 + lane] = (int)(__builtin_bit_cast(unsigned, v[i]) & 127u); }
            }
            float cnd[64];
            { int n = 0;
#pragma unroll
              for (int i = 0; i < 16; ++i)
#pragma unroll
                  for (int j = 0; j < 16; ++j) if ((i + 1) * (j + 1) <= 16) { cnd[n] = __builtin_bit_cast(float, (__builtin_bit_cast(unsigned, L[0][i] + L[1][j]) & ~255u) | (unsigned)((i << 4) | j)); ++n; }
#pragma unroll
              for (int q = 50; q < 64; ++q) cnd[q] = -3.0e38f; }
            top16_of_64(cnd);
            float mx = __builtin_bit_cast(float, __builtin_bit_cast(unsigned, cnd[0]) & ~255u), sum = 0.f; float ex[16];
#pragma unroll
            for (int i = 0; i < 16; ++i) { ex[i] = __expf(__builtin_bit_cast(float, __builtin_bit_cast(unsigned, cnd[i]) & ~255u) - mx); sum += ex[i]; }
            const float inv = 1.f / sum;
            LDS_WAIT(); asm volatile("" ::: "memory");
            if (hh == 0) {
#pragma unroll
                for (int i = 0; i < 16; ++i) { const unsigned bits = __builtin_bit_cast(unsigned, cnd[i]); const int ia = (bits >> 4) & 15, jb = bits & 15;
                    const int e = ktab[ia * 64 + lane] * 128 + ktab[(16 + jb) * 64 + lane];
                    tok_id[(tt * 32 + r32) * 128 + h * 16 + i] = e; tok_gt[(tt * 32 + r32) * 128 + h * 16 + i] = ex[i] * inv; }
            }
            LDS_WAIT(); asm volatile("" ::: "memory");
        }
        __syncthreads();
        for (int t8 = 0; t8 < 8; ++t8) { const int tk = F.wave * 8 + t8; const size_t ob = (size_t)(tok0 + tk) * 128;
            EIDX[ob + lane] = tok_id[tk * 128 + lane]; EIDX[ob + 64 + lane] = tok_id[tk * 128 + 64 + lane]; GATE[ob + lane] = tok_gt[tk * 128 + lane]; GATE[ob + 64 + lane] = tok_gt[tk * 128 + 64 + lane]; }
        __syncthreads();
    }
}


__device__ __forceinline__ void gla_prep_phase(Frame& F, const Args& a) {
    unsigned char* ws = a.ws; const bf16* PROJ;
    const int w = F.wave;
    LAS unsigned char* L = F.lds;
    LAS unsigned char* Qraw = L; LAS unsigned char* Kraw = L + 16384; LAS unsigned char* Vraw = L + 32768; LAS float* GDf = (LAS float*)(L + 65536); LAS float* GSUM = (LAS float*)(L + 73728);
    LAS unsigned char* IMGQ = L + 77824; LAS unsigned char* IMGK = L + 95232; LAS unsigned char* IMGE = L + 112640; LAS unsigned char* AMI = L + 32768;
    for (int it = F.vcu; it < 1024; it += F.G) {
        const int b = it >> 8, h = (it >> 6) & 3, n = it & 63; const size_t row0 = (size_t)b * SEQ + n * 64;
        ws = opaque(ws); PROJ = (const bf16*)(ws + WS_PROJ);
        int tid = opaque_v(F.tid), lane = tid & 63, r32 = lane & 31, hh = lane >> 5;
#pragma unroll
        for (int i = 0; i < 2; ++i) { const int idx = tid + 512 * i, r = idx >> 4, c = idx & 15;
            *(LAS v4u*)(Qraw + r * 256 + c * 16) = *(const v4u*)(PROJ + (row0 + r) * NINP + O_GQ + h * 128 + c * 8);
            *(LAS v4u*)(Kraw + r * 256 + c * 16) = *(const v4u*)(PROJ + (row0 + r) * NINP + O_GK + h * 128 + c * 8); }
#pragma unroll
        for (int i = 0; i < 4; ++i) { const int idx = tid + 512 * i, r = idx >> 5, c = idx & 31;
            *(LAS v4u*)(Vraw + r * 512 + c * 16) = *(const v4u*)(PROJ + (row0 + r) * NINP + O_GV + h * 256 + c * 8); }
        if (tid < 256) { const int r = tid >> 2, c = tid & 3; const v4u g = *(const v4u*)(PROJ + (row0 + r) * NINP + O_GDF + c * 8); LAS float* dst = GDf + r * 32 + c * 8;
            dst[0] = bflo(g.x); dst[1] = bfhi(g.x); dst[2] = bflo(g.y); dst[3] = bfhi(g.y); dst[4] = bflo(g.z); dst[5] = bfhi(g.z); dst[6] = bflo(g.w); dst[7] = bfhi(g.w); }
        __syncthreads();
#pragma unroll
        for (int ks = 0; ks < 4; ++ks) { unsigned pk[4];
#pragma unroll
            for (int p = 0; p < 4; ++p) { const int s0 = 16 * ks + 8 * hh + 2 * p; const unsigned lo = *(const LAS unsigned short*)(Vraw + s0 * 512 + (32 * w + r32) * 2), hi = *(const LAS unsigned short*)(Vraw + (s0 + 1) * 512 + (32 * w + r32) * 2); pk[p] = lo | (hi << 16); }
            *(v4u*)((unsigned char*)a.out + OUT_GT_VT + (size_t)it * 32768 + (w * 4 + ks) * 1024 + lane * 16) = (v4u){pk[0], pk[1], pk[2], pk[3]}; }
        for (int dir = 0; dir < 2; ++dir) {
            const size_t idir = (size_t)(((b * 4 + h) * 2 + dir) * 64 + n); ws = opaque(ws); tid = opaque_v(tid); lane = tid & 63; r32 = lane & 31; hh = lane >> 5;
            {
                const int d = tid & 127, tq = tid >> 7; const float* upp = (dir ? a.in[5] : a.in[3]) + h * 128 + d; const float bias = (dir ? a.in[6] : a.in[4])[h * 128 + d];
                float up[16];
#pragma unroll
                for (int r = 0; r < 16; ++r) up[r] = upp[r * 512];
                float c[16];
#pragma unroll
                for (int i = 0; i < 16; ++i) { const LAS float* g = GDf + (16 * tq + i) * 32 + dir * 16; float z = bias;
#pragma unroll
                    for (int r = 0; r < 16; ++r) z += g[r] * up[r];
                    c[i] = (fminf(z, 0.f) - __logf(1.f + __expf(-fabsf(z)))) * (1.f / 16.f); }
                if (dir == 0) {
#pragma unroll
                    for (int i = 1; i < 16; ++i) c[i] += c[i - 1];
                } else {
#pragma unroll
                    for (int i = 14; i >= 0; --i) c[i] += c[i + 1];
                }
                GSUM[(dir * 4 + tq) * 128 + d] = dir == 0 ? c[15] : c[0];
                __syncthreads();
                const float t0 = GSUM[(dir * 4 + 0) * 128 + d], t1 = GSUM[(dir * 4 + 1) * 128 + d], t2 = GSUM[(dir * 4 + 2) * 128 + d], t3 = GSUM[(dir * 4 + 3) * 128 + d];
                const float Bt = (t0 + t1) + (t2 + t3);
                float off;
                if (dir == 0) off = (tq > 0 ? t0 : 0.f) + (tq > 1 ? t1 : 0.f) + (tq > 2 ? t2 : 0.f);
                else off = (tq < 1 ? t1 : 0.f) + (tq < 2 ? t2 : 0.f) + (tq < 3 ? t3 : 0.f);
                unsigned kep[8];
#pragma unroll
                for (int i = 0; i < 16; i += 2) { float ke2[2];
#pragma unroll
                    for (int q = 0; q < 2; ++q) { const int t = 16 * tq + i + q; const float bi = c[i + q] + off;
                        const float qv = bf2f(*(const LAS unsigned short*)(Qraw + t * 256 + d * 2)), kv = bf2f(*(const LAS unsigned short*)(Kraw + t * 256 + d * 2));
                        *(LAS unsigned short*)(IMGQ + t * 272 + d * 2) = (unsigned short)pk2(qv * 0.08838834764831845f * __expf(bi), 0.f);
                        *(LAS unsigned short*)(IMGK + t * 272 + d * 2) = (unsigned short)pk2(kv * __expf(-bi), 0.f);
                        ke2[q] = kv * __expf(Bt - bi); }
                    kep[i >> 1] = pk2(ke2[0], ke2[1]); }
                *(LAS v4u*)(IMGE + d * 144 + (16 * tq) * 2) = (v4u){kep[0], kep[1], kep[2], kep[3]};
                *(LAS v4u*)(IMGE + d * 144 + (16 * tq + 8) * 2) = (v4u){kep[4], kep[5], kep[6], kep[7]};
                if (tq == 0) ((float*)((unsigned char*)a.out + OUT_GT_DEC))[idir * 128 + d] = __expf(Bt);
            }
            __syncthreads();
            if (w < 4) {
                const int si = w >> 1, ti = w & 1; f32x16 acc = (f32x16){0.f, 0.f, 0.f, 0.f, 0.f, 0.f, 0.f, 0.f, 0.f, 0.f, 0.f, 0.f, 0.f, 0.f, 0.f, 0.f};
#pragma unroll
                for (int ks = 0; ks < 8; ++ks) { const bf16x8 ak = *(const LAS bf16x8*)(IMGK + (32 * si + r32) * 272 + (16 * ks + 8 * hh) * 2), bq = *(const LAS bf16x8*)(IMGQ + (32 * ti + r32) * 272 + (16 * ks + 8 * hh) * 2);
                    acc = __builtin_amdgcn_mfma_f32_32x32x16_bf16(ak, bq, acc, 0, 0, 0); }
                const int t = 32 * ti + r32;
#pragma unroll
                for (int qd = 0; qd < 4; ++qd) { float v4[4];
#pragma unroll
                    for (int i = 0; i < 4; ++i) { const int sidx = 32 * si + 8 * qd + 4 * hh + i; const float x = acc[4 * qd + i]; const bool keep = dir == 0 ? (sidx <= t) : (sidx >= t); v4[i] = keep ? x : 0.f; }
                    *(LAS unsigned long long*)(AMI + t * 144 + (32 * si + 8 * qd + 4 * hh) * 2) = (unsigned long long)pk2(v4[0], v4[1]) | ((unsigned long long)pk2(v4[2], v4[3]) << 32); }
            } else {
                const int w4 = w - 4;
#pragma unroll
                for (int q = 0; q < 4; ++q) { const int bq = w4 * 4 + q, tt = bq >> 3, ks = bq & 7, j = ks >> 1, u = ks & 1; const int t = 32 * tt + r32;
                    const unsigned long long p0 = *(const LAS unsigned long long*)(IMGQ + t * 272 + (32 * j + 16 * u + 4 * hh) * 2), p1 = *(const LAS unsigned long long*)(IMGQ + t * 272 + (32 * j + 16 * u + 8 + 4 * hh) * 2);
                    *(v4u*)(ws + WS_GT_QD + idir * 16384 + bq * 1024 + lane * 16) = (v4u){(unsigned)p0, (unsigned)(p0 >> 32), (unsigned)p1, (unsigned)(p1 >> 32)}; }
#pragma unroll
                for (int q = 0; q < 4; ++q) { const int bk = w4 * 4 + q, j = bk >> 2, ks = bk & 3; const int d = 32 * j + r32;
                    *(v4u*)(ws + WS_GT_KE + idir * 16384 + bk * 1024 + lane * 16) = *(const LAS v4u*)(IMGE + d * 144 + (16 * ks + 8 * hh) * 2); }
            }
            __syncthreads();
            { const int tt = w >> 2, ks = w & 3; const int t = 32 * tt + r32;
              *(v4u*)((unsigned char*)a.out + OUT_GT_AM + idir * 8192 + w * 1024 + lane * 16) = *(const LAS v4u*)(AMI + t * 144 + (16 * ks + 8 * hh) * 2); }
            __syncthreads();
        }
    }
}

__device__ __forceinline__ void gla_seq_phase(Frame& F, const Args& a) {
    unsigned char* ws = a.ws;
    const int w = F.wave;
    constexpr int GBUF = 57856;
    for (int unit = F.vcu; unit < 64; unit += F.G) {
        const int dir = unit & 1, eh = (unit >> 1) & 1, bh = unit >> 2, b = bh >> 2, h = bh & 3;
        if (w >= 4) {
            const int lt = opaque_v(F.tid) - 256;
            v4u A[15], B[15];
#define GLA_LOAD(R, NS) do { const int n_ = dir ? 63 - (NS) : (NS); const size_t idir_ = (size_t)((bh * 2 + dir) * 64 + n_), iv_ = (size_t)(bh * 64 + n_); const unsigned char* o_ = opaque((const unsigned char*)a.out); const unsigned char* w_ = opaque(ws); \
            const v4u* gq_ = (const v4u*)(w_ + WS_GT_QD + idir_ * 16384); const v4u* gk_ = (const v4u*)(w_ + WS_GT_KE + idir_ * 16384); const v4u* ga_ = (const v4u*)(o_ + OUT_GT_AM + idir_ * 8192); \
            const v4u* gv_ = (const v4u*)(o_ + OUT_GT_VT + iv_ * 32768 + eh * 16384); const v4u* gd_ = (const v4u*)(o_ + OUT_GT_DEC + idir_ * 512); \
            _Pragma("unroll") for (int i = 0; i < 4; ++i) { R[i] = gq_[lt + 256 * i]; R[4 + i] = gk_[lt + 256 * i]; R[10 + i] = gv_[lt + 256 * i]; } R[8] = ga_[lt]; R[9] = ga_[lt + 256]; R[14] = gd_[lt & 31]; } while (0)
#define GLA_WRITE(R, BUF) do { LAS v4u* d_ = (LAS v4u*)(F.lds + (BUF) * GBUF); \
            _Pragma("unroll") for (int i = 0; i < 4; ++i) { d_[lt + 256 * i] = R[i]; d_[1024 + lt + 256 * i] = R[4 + i]; d_[2560 + lt + 256 * i] = R[10 + i]; } d_[2048 + lt] = R[8]; d_[2048 + lt + 256] = R[9]; if (lt < 32) d_[3584 + lt] = R[14]; } while (0)
            GLA_LOAD(A, 0); GLA_LOAD(B, 1);
            GLA_WRITE(A, 0);
            __syncthreads();
#pragma unroll 1
            for (int ns = 0; ns < 64; ns += 2) {
                if (ns + 2 < 64) GLA_LOAD(A, ns + 2);
                GLA_WRITE(B, 1);
                __syncthreads();
                if (ns + 3 < 64) GLA_LOAD(B, ns + 3);
                if (ns + 2 < 64) GLA_WRITE(A, 0);
                __syncthreads();
            }
#undef GLA_LOAD
#undef GLA_WRITE
        } else {
            f32x16 S[4];
#pragma unroll
            for (int j = 0; j < 4; ++j) S[j] = (f32x16){0.f, 0.f, 0.f, 0.f, 0.f, 0.f, 0.f, 0.f, 0.f, 0.f, 0.f, 0.f, 0.f, 0.f, 0.f, 0.f};
            __syncthreads();
#pragma unroll 1
            for (int ns = 0; ns < 64; ++ns) {
                const int n = dir ? 63 - ns : ns;
                const int lane = opaque_v(F.lane), r32 = lane & 31, hh = lane >> 5;
                LAS unsigned char* QDl = F.lds + (ns & 1) * GBUF; LAS unsigned char* KEl = QDl + 16384; LAS unsigned char* AMl = QDl + 32768; LAS unsigned char* VTl = QDl + 40960; LAS float* DECl = (LAS float*)(QDl + 57344);
                bf16* Out = (bf16*)(opaque(ws) + (dir ? WS_OB : WS_OF));
                bf16x8 vf[4];
#pragma unroll
                for (int ks = 0; ks < 4; ++ks) vf[ks] = *(const LAS bf16x8*)(VTl + (w * 4 + ks) * 1024 + lane * 16);
                f32x16 o[2];
#pragma unroll
                for (int tt = 0; tt < 2; ++tt) o[tt] = (f32x16){0.f, 0.f, 0.f, 0.f, 0.f, 0.f, 0.f, 0.f, 0.f, 0.f, 0.f, 0.f, 0.f, 0.f, 0.f, 0.f};
#pragma unroll
                for (int ks8 = 0; ks8 < 8; ++ks8) { const int j = ks8 >> 1, u = ks8 & 1; v4u sb;
                    sb.x = pg8::cvt_pk_bf16(S[j][8 * u + 0], S[j][8 * u + 1]); sb.y = pg8::cvt_pk_bf16(S[j][8 * u + 2], S[j][8 * u + 3]); sb.z = pg8::cvt_pk_bf16(S[j][8 * u + 4], S[j][8 * u + 5]); sb.w = pg8::cvt_pk_bf16(S[j][8 * u + 6], S[j][8 * u + 7]);
                    const bf16x8 bs = __builtin_bit_cast(bf16x8, sb);
#pragma unroll
                    for (int tt = 0; tt < 2; ++tt) { const bf16x8 aq = *(const LAS bf16x8*)(QDl + (tt * 8 + ks8) * 1024 + lane * 16); o[tt] = __builtin_amdgcn_mfma_f32_32x32x16_bf16(aq, bs, o[tt], 0, 0, 0); } }
#pragma unroll
                for (int ks = 0; ks < 4; ++ks)
#pragma unroll
                    for (int tt = 0; tt < 2; ++tt) { const bf16x8 am = *(const LAS bf16x8*)(AMl + (tt * 4 + ks) * 1024 + lane * 16); o[tt] = __builtin_amdgcn_mfma_f32_32x32x16_bf16(am, vf[ks], o[tt], 0, 0, 0); }
#pragma unroll
                for (int tt = 0; tt < 2; ++tt)
#pragma unroll
                    for (int r = 0; r < 16; ++r) { const int t = 32 * tt + (r & 3) + 8 * (r >> 2) + 4 * hh; const float x = o[tt][r];
                        Out[((size_t)b * SEQ + 64 * n + t) * 1024 + h * 256 + 32 * (eh * 4 + w) + r32] = (bf16)pk2(x, 0.f); }
#pragma unroll
                for (int j = 0; j < 4; ++j) {
#pragma unroll
                    for (int q = 0; q < 4; ++q) { const f32x4 dv = *(const LAS f32x4*)(DECl + 32 * j + 8 * q + 4 * hh); S[j][4 * q + 0] *= dv.x; S[j][4 * q + 1] *= dv.y; S[j][4 * q + 2] *= dv.z; S[j][4 * q + 3] *= dv.w; }
#pragma unroll
                    for (int ks = 0; ks < 4; ++ks) { const bf16x8 ak = *(const LAS bf16x8*)(KEl + (j * 4 + ks) * 1024 + lane * 16); S[j] = __builtin_amdgcn_mfma_f32_32x32x16_bf16(ak, vf[ks], S[j], 0, 0, 0); } }
                __syncthreads();
            }
        }
    }
}

typedef short v4i16_t __attribute__((ext_vector_type(4)));
__device__ __forceinline__ void attn_phase(Frame& F, const Args& a, int qslot) {
    unsigned char* ws = a.ws; const bf16* PROJ;
    const int w = F.wave;
    LAS unsigned char* Kl = F.lds; LAS unsigned char* Vl = F.lds + 39168; volatile LAS int* uword = (volatile LAS int*)(F.lds + 78336);
    constexpr int NUNITS = 64 * 3 * 32;
#define ATT_DECODE(U) const int bh = (U) / 96, rem = (U) - bh * 96, p = rem >> 5, idx = rem & 31; const int lgd = 2 * p, d = 1 << lgd; \
        const int r = idx >> (5 - lgd), J = idx & ((32 >> lgd) - 1), Lc = SEQ >> lgd; const int b = bh >> 4, h = bh & 15; const int m0 = 128 * J - 64;
    v4u kx[4], vx[4]; v4u qw[2];
#define ATT_LOAD(U) do { ATT_DECODE(U) ws = opaque(ws); PROJ = (const bf16*)(ws + WS_PROJ); const int tid_ = opaque_v(F.tid); \
        _Pragma("unroll") for (int i = 0; i < 4; ++i) { const int kr = (tid_ >> 3) + 64 * i, ch = tid_ & 7; const int mp = m0 + kr; kx[i] = (v4u){0u, 0u, 0u, 0u}; vx[i] = kx[i]; \
            if (mp >= 0 && mp < Lc) { const bf16* src = PROJ + ((size_t)b * SEQ + r + d * mp) * NINP + O_AK + h * 64 + ch * 8; kx[i] = *(const v4u*)src; vx[i] = *(const v4u*)(src + (O_AV - O_AK)); } } \
        const int tokq_ = r + d * (128 * J + 16 * w + (tid_ & 15)); \
        _Pragma("unroll") for (int sft = 0; sft < 2; ++sft) qw[sft] = *(const v4u*)(PROJ + ((size_t)b * SEQ + tokq_) * NINP + O_AQ + h * 64 + 32 * sft + 8 * ((tid_ & 63) >> 4)); } while (0)
    float tab[40];
    { const int l0 = opaque_v(F.lane);
#pragma unroll
      for (int c = 0; c < 40; ++c) { const int kb = c >> 3, uu = (c >> 2) & 1, rho = c & 3; const int jo = 32 * kb + 8 * (l0 >> 4) + 4 * uu + rho - 64 - (l0 & 15); const int aj = jo < 0 ? -jo : jo; tab[c] = aj <= 64 ? (float)aj : 3.0e38f; } }
    if (F.tid == 0) uword[0] = (int)__hip_atomic_fetch_add((unsigned*)(F.ctl + CW_ATTQ + 64 * qslot), 1u, __ATOMIC_RELAXED, __HIP_MEMORY_SCOPE_AGENT);
    __syncthreads();
    int u = __builtin_amdgcn_readfirstlane(uword[0]); int par = 1;
    if (u < NUNITS) ATT_LOAD(u);
    while (u < NUNITS) {
        const int tid = opaque_v(F.tid), lane = tid & 63, q16 = lane & 15, g = lane >> 4;
        if (tid == 0) uword[par] = (int)__hip_atomic_fetch_add((unsigned*)(F.ctl + CW_ATTQ + 64 * qslot), 1u, __ATOMIC_RELAXED, __HIP_MEMORY_SCOPE_AGENT);
#pragma unroll
        for (int i = 0; i < 4; ++i) { const int kr = (tid >> 3) + 64 * i, ch = tid & 7; *(LAS v4u*)(Kl + kr * 144 + ch * 16) = kx[i]; *(LAS v4u*)(Vl + kr * 144 + ch * 16) = vx[i]; }
        if (tid < 128) { const int kr = 256 + (tid >> 3), ch = tid & 7; *(LAS v4u*)(Kl + kr * 144 + ch * 16) = (v4u){0u, 0u, 0u, 0u}; *(LAS v4u*)(Vl + kr * 144 + ch * 16) = (v4u){0u, 0u, 0u, 0u}; }
        bf16x8 qf[2];
#pragma unroll
        for (int sft = 0; sft < 2; ++sft) { v4u qs; constexpr float QS = 0.125f * 1.4426950408889634f; qs.x = pk2(bflo(qw[sft].x) * QS, bfhi(qw[sft].x) * QS); qs.y = pk2(bflo(qw[sft].y) * QS, bfhi(qw[sft].y) * QS); qs.z = pk2(bflo(qw[sft].z) * QS, bfhi(qw[sft].z) * QS); qs.w = pk2(bflo(qw[sft].w) * QS, bfhi(qw[sft].w) * QS);
            qf[sft] = __builtin_bit_cast(bf16x8, qs); }
        ATT_DECODE(u)
        const int tokq = r + d * (128 * J + 16 * w + q16);
        __syncthreads();
        const int un = __builtin_amdgcn_readfirstlane(uword[par]); par ^= 1;
        if (un < NUNITS) ATT_LOAD(un);
        const float nslope = -exp2f(-0.5f * (float)(h + 1)) * (float)d * 1.4426950408889634f;
        const bool inrange = (m0 + 16 * w >= 0) && (m0 + 16 * w + 159 < Lc);
        float sv[5][2][4]; float mx = -3.0e38f;
#pragma unroll
        for (int kb = 0; kb < 5; ++kb)
#pragma unroll
            for (int uu = 0; uu < 2; ++uu) { f32x4 acc = (f32x4){0.f, 0.f, 0.f, 0.f};
                const int krow = 16 * w + 32 * kb + 8 * (q16 >> 2) + 4 * uu + (q16 & 3);
#pragma unroll
                for (int sft = 0; sft < 2; ++sft) { const bf16x8 ak = *(const LAS bf16x8*)(Kl + krow * 144 + (32 * sft + 8 * g) * 2); acc = __builtin_amdgcn_mfma_f32_16x16x32_bf16(ak, qf[sft], acc, 0, 0, 0); }
#pragma unroll
                for (int rho = 0; rho < 4; ++rho) { const float x = acc[rho]; sv[kb][uu][rho] = __builtin_fmaf(nslope, tab[kb * 8 + uu * 4 + rho], x); } }
        if (!inrange) {
#pragma unroll
            for (int kb = 0; kb < 5; ++kb)
#pragma unroll
                for (int uu = 0; uu < 2; ++uu)
#pragma unroll
                    for (int rho = 0; rho < 4; ++rho) { const int mp = m0 + 16 * w + 32 * kb + 8 * g + 4 * uu + rho; if (mp < 0 || mp >= Lc) sv[kb][uu][rho] = -3.0e38f; } }
#pragma unroll
        for (int kb = 0; kb < 5; ++kb)
#pragma unroll
            for (int uu = 0; uu < 2; ++uu)
#pragma unroll
                for (int rho = 0; rho < 4; ++rho) mx = fmaxf(mx, sv[kb][uu][rho]);
        mx = fmaxf(mx, __shfl_xor(mx, 16)); mx = fmaxf(mx, __shfl_xor(mx, 32));
        float lsum = 0.f; bf16x8 pf[5];
#pragma unroll
        for (int kb = 0; kb < 5; ++kb) { float e[8];
#pragma unroll
            for (int uu = 0; uu < 2; ++uu)
#pragma unroll
                for (int rho = 0; rho < 4; ++rho) { const float pe = __builtin_amdgcn_exp2f(sv[kb][uu][rho] - mx); e[uu * 4 + rho] = pe; lsum += pe; }
            v4u pw; pw.x = pk2(e[0], e[1]); pw.y = pk2(e[2], e[3]); pw.z = pk2(e[4], e[5]); pw.w = pk2(e[6], e[7]); pf[kb] = __builtin_bit_cast(bf16x8, pw); }
        lsum += __shfl_xor(lsum, 16); lsum += __shfl_xor(lsum, 32);
        f32x4 oT[4];
#pragma unroll
        for (int nn = 0; nn < 4; ++nn) oT[nn] = (f32x4){0.f, 0.f, 0.f, 0.f};
#pragma unroll
        for (int kb = 0; kb < 5; ++kb)
#pragma unroll
            for (int nn = 0; nn < 4; ++nn) { const LAS unsigned char* va = Vl + (16 * w + 32 * kb + 8 * g + (q16 >> 2)) * 144 + (16 * nn + 4 * (q16 & 3)) * 2;
                const v4i16_t lo = __builtin_amdgcn_ds_read_tr16_b64_v4i16((LAS v4i16_t*)va), hi = __builtin_amdgcn_ds_read_tr16_b64_v4i16((LAS v4i16_t*)(va + 4 * 144));
                const bf16x8 vf = (bf16x8){lo[0], lo[1], lo[2], lo[3], hi[0], hi[1], hi[2], hi[3]};
                oT[nn] = __builtin_amdgcn_mfma_f32_16x16x32_bf16(vf, pf[kb], oT[nn], 0, 0, 0); }
        { const size_t rec = ((size_t)p * M + (size_t)b * SEQ + tokq) * 16 + h; bf16* op = (bf16*)(opaque(ws) + WS_ATTP) + rec * 64 + 4 * g;
#pragma unroll
          for (int nn = 0; nn < 4; ++nn) *(unsigned long long*)(op + 16 * nn) = (unsigned long long)pk2(oT[nn][0], oT[nn][1]) | ((unsigned long long)pk2(oT[nn][2], oT[nn][3]) << 32);
          if (g == 0) { float* ml = (float*)(opaque(ws) + WS_ATTML) + rec * 2; ml[0] = mx * 0.6931471805599453f; ml[1] = lsum; } }
        __syncthreads();
        u = un;
    }
#undef ATT_DECODE
#undef ATT_LOAD
}

typedef __bf16 bf16x2_t __attribute__((ext_vector_type(2)));
typedef int i32x4 __attribute__((ext_vector_type(4)));
__device__ __forceinline__ void peer_convert_tables(Frame& F, const Args& a, int qslot) {
    unsigned char* ws = a.ws; const int lane = F.lane; volatile LAS int* uword = (volatile LAS int*)(F.lds + 78336 + 64);
    for (;;) {
        __syncthreads();
        if (F.tid == 0) uword[0] = (int)__hip_atomic_fetch_add((unsigned*)(F.ctl + CW_CONVQ + 64 * qslot), 1u, __ATOMIC_RELAXED, __HIP_MEMORY_SCOPE_AGENT);
        __syncthreads();
        const int blk = __builtin_amdgcn_readfirstlane(uword[0]);
        if (blk >= 2 * PEER_E / 64) break;
#pragma unroll 1
        for (int i = 0; i < 8; ++i) { const int r = blk * 64 + F.wave * 8 + i;
            const int e = r & (PEER_E - 1); const bool isv = r >= PEER_E;
            const float* src = (isv ? a.in[14] : a.in[13]) + (size_t)e * DM;
            unsigned char* dst = (unsigned char*)a.out + (isv ? OUT_V8 : OUT_U8) + (size_t)e * DM; float* sc = (float*)(ws + (isv ? WS_SV : WS_SU));
            f32x4 v[8]; float am = 0.f;
#pragma unroll
            for (int j = 0; j < 8; ++j) { v[j] = *(const f32x4*)(src + 256 * j + 4 * lane); am = fmaxf(am, fmaxf(fmaxf(fabsf(v[j].x), fabsf(v[j].y)), fmaxf(fabsf(v[j].z), fabsf(v[j].w)))); }
            am = wave_max(am); am = fmaxf(am, 1e-30f);
            const float inv = 440.f / am;
#pragma unroll
            for (int j = 0; j < 8; ++j) { int p = __builtin_amdgcn_cvt_pk_fp8_f32(v[j].x * inv, v[j].y * inv, 0, false); p = __builtin_amdgcn_cvt_pk_fp8_f32(v[j].z * inv, v[j].w * inv, p, true);
                *(int*)(dst + 256 * j + 4 * lane) = p; }
            if (lane == 0) sc[e] = am * (1.f / 440.f); }
    }
}

__device__ __forceinline__ float dpp_row_sum(float x) {
#define PEER_DPP(ctrl) x += __builtin_bit_cast(float, __builtin_amdgcn_update_dpp(0, __builtin_bit_cast(int, x), ctrl, 0xF, 0xF, false))
    PEER_DPP(0xB1); PEER_DPP(0x4E); PEER_DPP(0x141); PEER_DPP(0x140);
#undef PEER_DPP
    return x;
}
template <bool VPH, int PBS> __device__ __forceinline__ void peer_uv_phase(Frame& F, const Args& a) {
    unsigned char* ws = a.ws; float* H = (float*)(ws + WS_H); const float* g2 = a.in[10];
    const int sl = blockIdx.x & 7, rk = blockIdx.x >> 3, nrk = F.G >> 3, tpw = M / nrk / NWAVES, nq = tpw / 4;
    const unsigned char* TAB; const int* EIDX; const float* SSQ; const float* PW; float* PD; float* SSQ2;
    LAS int* idt = (LAS int*)(F.lds + F.wave * 8192);
    LAS float* wt = (LAS float*)(F.lds + F.wave * 8192 + 4096);
    const int t0 = (rk * NWAVES + F.wave) * tpw;
#define PEER_STAGE(QI) do { const size_t tb_ = (size_t)(t0 + 4 * (QI) + a4) * 128; const int bf_ = ((QI) & 1) * 512; _Pragma("unroll") for (int k = 0; k < 8; ++k) { \
        idt[bf_ + (16 * k + q) * 4 + a4] = EIDX[tb_ + 16 * k + q]; if (VPH) wt[bf_ + (16 * k + q) * 4 + a4] = PW[tb_ + 16 * k + q]; } } while (0)
#define PEER_ISSUE(R, QI, WB) do { const int bf_ = ((QI) & 1) * 512 + (WB) * (4 * PBS) + a4; _Pragma("unroll") for (int j = 0; j < PBS; ++j) { const int e_ = idt[bf_ + 4 * j]; R[j] = ldu<i32x4>(TAB, (unsigned)e_ * 2048u + (unsigned)(16 * q)); } } while (0)
    unsigned xq[8]; float acc[16];
#define PEER_QUAD_BEGIN(QI) do { const size_t t_ = (size_t)(t0 + 4 * (QI) + a4); \
        if (!VPH) { f32x4 hq[4]; _Pragma("unroll") for (int k = 0; k < 4; ++k) hq[k] = *(const f32x4*)(H + t_ * DM + 256 * sl + 16 * q + 4 * k);  const float pss_ = dpp_row_sum(SSQ[t_ * 32 + q] + SSQ[t_ * 32 + 16 + q]); const float rstd_ = 1.f / sqrtf(pss_ * (1.f / DM) + EPS); f32x4 gv[4]; \
            _Pragma("unroll") for (int k = 0; k < 4; ++k) gv[k] = *(const f32x4*)(g2 + 256 * sl + 16 * q + 4 * k); \
            _Pragma("unroll") for (int k = 0; k < 4; ++k) { xq[2 * k] = pk2(hq[k].x * rstd_ * gv[k].x, hq[k].y * rstd_ * gv[k].y); xq[2 * k + 1] = pk2(hq[k].z * rstd_ * gv[k].z, hq[k].w * rstd_ * gv[k].w); } } \
        else { _Pragma("unroll") for (int k = 0; k < 16; ++k) acc[k] = 0.f; } } while (0)
#define PEER_COMPUTE(R, QI, WB) do { if (!VPH) { float pdb_ = 0.f; _Pragma("unroll") for (int j = 0; j < PBS; ++j) { float d_ = 0.f; _Pragma("unroll") for (int k = 0; k < 4; ++k) { const int dw_ = R[j][k]; \
                d_ = __builtin_amdgcn_fdot2_f32_bf16(__builtin_amdgcn_cvt_scalef32_pk_bf16_fp8(dw_, 1.0f, false), __builtin_bit_cast(bf16x2_t, xq[2 * k]), d_, false); \
                d_ = __builtin_amdgcn_fdot2_f32_bf16(__builtin_amdgcn_cvt_scalef32_pk_bf16_fp8(dw_, 1.0f, true), __builtin_bit_cast(bf16x2_t, xq[2 * k + 1]), d_, false); } \
                d_ = dpp_row_sum(d_); pdb_ = (q == j) ? d_ : pdb_; } \
            if (q < PBS) PD[((size_t)(t0 + 4 * (QI) + a4) * 8 + sl) * 128 + PBS * (WB) + q] = pdb_; } \
        else { const int bf_ = ((QI) & 1) * 512 + (WB) * (4 * PBS) + a4; _Pragma("unroll") for (int j = 0; j < PBS; ++j) { const float w_ = wt[bf_ + 4 * j]; int r0_ = R[j][0], r1_ = R[j][1], r2_ = R[j][2], r3_ = R[j][3]; asm volatile("" : "+v"(r0_), "+v"(r1_), "+v"(r2_), "+v"(r3_));     \
                _Pragma("unroll") for (int k = 0; k < 4; ++k) { const int dw_ = k == 0 ? r0_ : k == 1 ? r1_ : k == 2 ? r2_ : r3_; \
                const f32x2 lo_ = __builtin_amdgcn_cvt_pk_f32_fp8(dw_, false), hi_ = __builtin_amdgcn_cvt_pk_f32_fp8(dw_, true); \
                acc[4 * k + 0] += w_ * lo_.x; acc[4 * k + 1] += w_ * lo_.y; acc[4 * k + 2] += w_ * hi_.x; acc[4 * k + 3] += w_ * hi_.y; } } } } while (0)
#define PEER_QUAD_END(QI) do { if (VPH) { const size_t t_ = (size_t)(t0 + 4 * (QI) + a4); float ss_ = 0.f; f32x4 hq[4]; _Pragma("unroll") for (int k = 0; k < 4; ++k) hq[k] = *(const f32x4*)(H + t_ * DM + 256 * sl + 16 * q + 4 * k); \
            _Pragma("unroll") for (int k = 0; k < 4; ++k) { \
            const f32x4 y_ = hq[k] + (f32x4){acc[4 * k], acc[4 * k + 1], acc[4 * k + 2], acc[4 * k + 3]}; *(f32x4*)(H + t_ * DM + 256 * sl + 16 * q + 4 * k) = y_; ss_ += (y_.x * y_.x + y_.y * y_.y) + (y_.z * y_.z + y_.w * y_.w); } \
            ss_ = dpp_row_sum(ss_); if (q == 0) SSQ2[t_ * 8 + sl] = ss_; } } while (0)
#pragma unroll 1
    for (int qi = 0; qi < nq; ++qi) {
        i32x4 rA[PBS], rB[PBS];
        const int lane = opaque_v(F.lane), a4 = lane >> 4, q = lane & 15; ws = opaque(ws); H = (float*)(ws + WS_H);
        TAB = opaque((const unsigned char*)a.out) + (VPH ? OUT_V8 : OUT_U8) + 256 * sl; EIDX = (const int*)(ws + WS_EIDX); SSQ = (const float*)(ws + WS_SSQ); PW = (const float*)(ws + WS_PW); PD = (float*)(ws + WS_PD); SSQ2 = (float*)(ws + WS_SSQ2);
        PEER_STAGE(qi); LDS_WAIT(); asm volatile("" ::: "memory");
        PEER_ISSUE(rA, qi, 0);
        PEER_ISSUE(rB, qi, 1);
        PEER_QUAD_BEGIN(qi);
#pragma unroll
        for (int wb = 0; wb < 128 / PBS; wb += 2) {
            PEER_COMPUTE(rA, qi, wb); if (wb + 2 < 128 / PBS) { PEER_ISSUE(rA, qi, wb + 2); }
            PEER_COMPUTE(rB, qi, wb + 1); if (wb + 3 < 128 / PBS) { PEER_ISSUE(rB, qi, wb + 3); }
        }
        PEER_QUAD_END(qi);
    }
#undef PEER_STAGE
#undef PEER_ISSUE
#undef PEER_QUAD_BEGIN
#undef PEER_COMPUTE
#undef PEER_QUAD_END
}
__device__ __forceinline__ void peer_w_phase(Frame& F, const Args& a) {
    unsigned char* ws = a.ws; const float* PD = (const float*)(ws + WS_PD); const int* EIDX = (const int*)(ws + WS_EIDX); const float* GATE = (const float*)(ws + WS_GATE);
    const float* SU = (const float*)(ws + WS_SU); const float* SV = (const float*)(ws + WS_SV); float* PW = (float*)(ws + WS_PW);
    for (int i = F.vcu * 512 + F.tid; i < M * 128; i += F.G * 512) { const int t = i >> 7, p = i & 127; float d = 0.f;
#pragma unroll
        for (int sl = 0; sl < 8; ++sl) d += PD[((size_t)t * 8 + sl) * 128 + p];
        const int e = EIDX[i]; d *= SU[e];
        PW[i] = GATE[i] * 0.5f * d * (1.f + erff(d * 0.70710678118654752f)) * SV[e]; }
}
__device__ __forceinline__ void peer_n_phase(Frame& F, const Args& a) {
    unsigned char* ws = a.ws; const float* Y = (const float*)(ws + WS_H); float* O = a.out; const float* gf = a.in[15]; const float* SSQ2 = (const float*)(ws + WS_SSQ2); const int lane = F.lane;
    for (int m = F.vcu * NWAVES + F.wave; m < M; m += F.G * NWAVES) {
        const f32x4 s0 = *(const f32x4*)(SSQ2 + (size_t)m * 8), s1 = *(const f32x4*)(SSQ2 + (size_t)m * 8 + 4);
        const float rf = 1.f / sqrtf((((s0.x + s0.y) + (s0.z + s0.w)) + ((s1.x + s1.y) + (s1.z + s1.w))) * (1.f / DM) + EPS);
#pragma unroll
        for (int j = 0; j < 8; ++j) { const f32x4 g = *(const f32x4*)(gf + 256 * j + 4 * lane); const f32x4 y = *(const f32x4*)(Y + (size_t)m * DM + 256 * j + 4 * lane); *(f32x4*)(O + (size_t)m * DM + 256 * j + 4 * lane) = y * rf * g; }
    }
}

__global__ void __launch_bounds__(NWAVES * 64, 2) mk_fwd(Args args) {
    extern __shared__ __attribute__((aligned(16))) unsigned char lds[];
    Frame F;
    F.lds = (LAS unsigned char*)lds;
    F.MISC = (volatile LAS unsigned*)(F.lds + MISC_OFF);
    F.tid = threadIdx.x; F.lane = F.tid & 63; F.wave = __builtin_amdgcn_readfirstlane(F.tid >> 6);
    F.G = gridDim.x; { const int bx = blockIdx.x; F.vcu = (F.G % 8 == 0) ? (bx % 8) * (F.G / 8) + bx / 8 : bx; }
    unsigned char* ws = args.ws;
    F.ctl = (gu32*)(ws + WS_CTL);
    for (int u = F.tid; u < (LDS_BYTES - LDSCTL_OFF) / 4; u += NWAVES * 64) ((LAS unsigned*)(F.lds + LDSCTL_OFF))[u] = 0u;
    __syncthreads();
    XcdBarrier bar = xcd_barrier_post((unsigned*)(F.ctl + CW_BAR) + args.li * XCD_BAR_WORDS, F.MISC + 8);
    const int lo = args.ph_lo, hi = args.ph_hi;
#define IN(k) (lo <= (k) && (k) < hi)
#define BOTH(k) (IN(k) && IN((k) + 1))
#define GRID_BAR() xcd_barrier(bar)

    if (IN(0)) { for (int rep = 0; rep < NREP(0); ++rep) p0_prologue(F, args); if (BOTH(0)) GRID_BAR(); }

    if (IN(1)) {
        pg8::Gemm g{(const bf16*)(ws + WS_XN), (const bf16*)(ws + WS_WIN), M, NINP, DM}; pg8::StaticOrder S; S.init(M, NINP, F.G, (int)blockIdx.x);
        pg8::EpiBf16<0> E{(bf16*)(ws + WS_PROJ), NINP, nullptr, 0, 0, 1.f};
        for (int rep = 0; rep < NREP(1); ++rep) pg8::gemm_phase<pg8::EpiBf16<0>, pg8::StaticOrder, PG8_ALIGN, PG8_SP2>(F.lds + RING_OFF, g, S, E);
        if (BOTH(1)) GRID_BAR();
    }
    if (IN(2)) {
        for (int rep = 0; rep < NREP(21); ++rep) gla_prep_phase(F, args);
        GRID_BAR();
        for (int rep = 0; rep < NREP(2); ++rep) gla_seq_phase(F, args);
        for (int rep = 0; rep < NREP(20); ++rep) attn_phase(F, args, rep);
        for (int rep = 0; rep < NREP(40); ++rep) peer_convert_tables(F, args, rep);
        if (BOTH(2)) GRID_BAR(); }
    if (IN(3)) { for (int rep = 0; rep < NREP(3); ++rep) p3_finalize(F, args); if (BOTH(3)) GRID_BAR(); }
    if (IN(4)) {
        pg8::Gemm g{(const bf16*)(ws + WS_XN), (const bf16*)(ws + WS_WOUT), M, DM, DM}; pg8::StaticOrder S; S.init(M, DM, F.G, (int)blockIdx.x);
        pg8::EpiRes E{args.in[0], (float*)(ws + WS_H), (bf16*)(ws + WS_HB), (float*)(ws + WS_SSQ), DM};
        for (int rep = 0; rep < NREP(4); ++rep) pg8::gemm_phase<pg8::EpiRes, pg8::StaticOrder, PG8_ALIGN, PG8_SP2>(F.lds + RING_OFF, g, S, E);
        if (BOTH(4)) GRID_BAR();
    }
    if (IN(5)) {
        pg8::Gemm g{(const bf16*)(ws + WS_HB), (const bf16*)(ws + WS_WQ), M, DM, DM}; pg8::StaticOrder S; S.init(M, DM, F.G, (int)blockIdx.x);
        pg8::EpiRowScale E{(bf16*)(ws + WS_XN), DM, (const float*)(ws + WS_SSQ), 1.f / DM, EPS};
        for (int rep = 0; rep < NREP(5); ++rep) pg8::gemm_phase<pg8::EpiRowScale, pg8::StaticOrder, PG8_ALIGN, PG8_SP2>(F.lds + RING_OFF, g, S, E);
        if (BOTH(5)) GRID_BAR();
    }
    if (IN(6)) { for (int rep = 0; rep < NREP(6); ++rep) topk_phase(F, args); if (BOTH(6)) GRID_BAR(); }
    if (IN(7)) {
        for (int rep = 0; rep < NREP(7); ++rep) peer_uv_phase<false, 16>(F, args);
        GRID_BAR();
        peer_w_phase(F, args);
        GRID_BAR();
        if (REP_PHASE != 8) peer_uv_phase<true, 16>(F, args);
        GRID_BAR();
        peer_n_phase(F, args);
    }
#undef IN
#undef BOTH
}


extern "C" void kernel_launch(void* const* d_in, const int* in_sizes, int n_in, void* d_out, int out_size, void* d_ws, size_t ws_size, hipStream_t stream) {
    static int grid = 0;
    if (grid == 0) {
        if (n_in != 16 || in_sizes[0] != M * DM || out_size != M * DM || ws_size < WS_END) { fprintf(stderr, "kernel_launch: unexpected shapes: n_in %d in0 %d out %d ws %zu\n", n_in, n_in > 0 ? in_sizes[0] : -1, out_size, ws_size); grid = -1; return; }
        int dev = 0, cus = 0;
        if (hipGetDevice(&dev) != hipSuccess || hipDeviceGetAttribute(&cus, hipDeviceAttributeMultiprocessorCount, dev) != hipSuccess) { grid = -1; return; }
        if (hipFuncSetAttribute((const void*)mk_fwd, hipFuncAttributeMaxDynamicSharedMemorySize, LDS_BYTES) != hipSuccess) { fprintf(stderr, "kernel_launch: hipFuncSetAttribute failed\n"); grid = -1; return; }
        (void)hipGetLastError();
        grid = cus;
    }
    if (grid < 0) return;
    (void)hipMemsetAsync((char*)d_ws + WS_CTL, 0, CTL_ZERO_BYTES, stream);
    Args a{};
    for (int i = 0; i < 16; ++i) a.in[i] = (const float*)d_in[i];
    a.out = (float*)d_out; a.ws = (unsigned char*)d_ws;
    a.ph_lo = 0; a.ph_hi = 8; a.li = 0;
    hipLaunchKernelGGL(mk_fwd, dim3(grid), dim3(NWAVES * 64), LDS_BYTES, stream, a);
}
```

```cpp
#define REP_PHASE -1

#include <hip/hip_runtime.h>
#include <cstdio>
#include <cstdint>
#include <cmath>
#ifndef REP_PHASE
#define REP_PHASE -1
#endif
#define NREP(k) ((REP_PHASE == (k)) ? 2 : 1)
namespace pg8 {
#define PG8_LAS __attribute__((address_space(3)))
typedef unsigned short bf16_t;
typedef short bf16x8 __attribute__((ext_vector_type(8)));
typedef float f32x4 __attribute__((ext_vector_type(4)));
typedef unsigned u32x4 __attribute__((ext_vector_type(4)));
constexpr int BM = 256, BK = 64, HALF = 128, HTB = HALF * BK * 2  , STAGE_BYTES = 8 * HTB, NXCD = 8, WGM = 8;

__host__ __device__ __forceinline__ int lds_byte(int r, int c) { const int st = (r >> 4) * 2 + (c >> 5), rr = r & 15, cc = c & 31, ob = rr * 64 + cc * 2; return st * 1024 + (ob ^ (((ob >> 9) & 1) << 5)); }
__host__ __device__ __forceinline__ void stage_rc(int b, int& R, int& C) { const int st = b / 1024, sb = b % 1024, swz = sb ^ (((sb >> 9) & 1) << 5); R = (st >> 1) * 16 + swz / 64; C = (st & 1) * 32 + (swz % 64) / 2; }
__host__ __device__ __forceinline__ int perm32(int rho) { const int n = rho >> 4, i = rho & 15; return 8 * (i >> 2) + 4 * n + (i & 3); }

struct Unit { int pm, pn; };
struct Gemm { const bf16_t* A; const bf16_t* Bt; int M, N, K; };

struct StaticOrder {
    int nM, nN, nwg, G, c;
    __host__ __device__ void init(int M, int N, int G_, int c_) { nM = M / BM; nN = N / BM; nwg = nM * nN; G = G_; c = c_; }
    __host__ __device__ bool next(int i, Unit& u) const {
        const long L = (long)i * G + c; if (L >= nwg) return false;
        int wgid = (int)L; { const int q = nwg / NXCD, r = nwg % NXCD, xcd = wgid % NXCD, off = wgid / NXCD; wgid = (xcd < r ? xcd * (q + 1) : r * (q + 1) + (xcd - r) * q) + off; }
        const int nig = WGM * nN, gid = wgid / nig, fm = gid * WGM, gsz = (nM - fm) < WGM ? (nM - fm) : WGM;
        u.pm = fm + ((wgid % nig) % gsz); u.pn = (wgid % nig) / gsz; return true;
    }
    __device__ __forceinline__ void a_ready(const Unit&) const {}
    __device__ __forceinline__ void done(const Unit&) const {}
};

__device__ __forceinline__ unsigned cvt_pk_bf16(float lo, float hi) { unsigned r; asm volatile("v_cvt_pk_bf16_f32 %0, %1, %2" : "=v"(r) : "v"(lo), "v"(hi)); return r; }
typedef float f32x2 __attribute__((ext_vector_type(2)));
__device__ __forceinline__ f32x2 gelu_pk(f32x2 v) {
    const f32x2 av = __builtin_elementwise_abs(v), d = av * 0.2316418882f + 1.0f;
    f32x2 t; t.x = __builtin_amdgcn_rcpf(d.x); t.y = __builtin_amdgcn_rcpf(d.y);
    f32x2 q = t * 0.5307027145f + (-0.7265760135f); q = q * t + 0.7107068705f; q = q * t + (-0.142248368f); q = q * t + 0.127414796f; q = q * t;
    const f32x2 s = (v * v) * (-0.72134752044f);
    f32x2 e; e.x = __builtin_amdgcn_exp2f(s.x); e.y = __builtin_amdgcn_exp2f(s.y);
    const f32x2 m = v * (q * e), r = v - m;
    f32x2 o; o.x = v.x < 0.f ? m.x : r.x; o.y = v.y < 0.f ? m.y : r.y; return o;
}

template <int ACT  > struct EpiBf16 {
    static constexpr bool PERM = true, AFTER_DRAIN = false; static_assert(ACT == 0 || ACT == 1, "EpiBf16: ACT is 0 (none) or 1 (gelu_pk)");
    bf16_t* O; int ldc; const float* bias; int split_cols; size_t split_stride; float scale0;
    __device__ __forceinline__ void operator()(const f32x4 (&acc)[2][2][4][2], const Unit& u, int wr, int wc, int fr, int fq) const {
        const int row0 = u.pm * BM + wr * 64 + fr; int colt = u.pn * BM; bf16_t* base = O;
        float sc = 1.f; if (split_cols) { const int t = colt / split_cols; base += (size_t)t * split_stride; colt -= t * split_cols; if (t == 0) sc = scale0; }
        const int col0 = colt + wc * 32 + 8 * fq, bcol0 = u.pn * BM + wc * 32 + 8 * fq;
        f32x4 bv[2][2];
#pragma unroll
        for (int bj = 0; bj < 2; ++bj)
#pragma unroll
            for (int n = 0; n < 2; ++n) bv[bj][n] = bias ? *(const f32x4*)(bias + bcol0 + bj * HALF + 4 * n) : (f32x4){0.f, 0.f, 0.f, 0.f};
#pragma unroll
        for (int ai = 0; ai < 2; ++ai)
#pragma unroll
            for (int m = 0; m < 4; ++m) { bf16_t* rowp = base + (size_t)(row0 + ai * HALF + m * 16) * ldc + col0;
#pragma unroll
                for (int bj = 0; bj < 2; ++bj) { f32x4 v0 = acc[ai][bj][m][0] + bv[bj][0], v1 = acc[ai][bj][m][1] + bv[bj][1];
                    if (ACT == 1) { f32x2 a = gelu_pk((f32x2){v0[0], v0[1]}), b = gelu_pk((f32x2){v0[2], v0[3]}), c = gelu_pk((f32x2){v1[0], v1[1]}), d = gelu_pk((f32x2){v1[2], v1[3]});
                        v0 = (f32x4){a.x, a.y, b.x, b.y}; v1 = (f32x4){c.x, c.y, d.x, d.y}; }
                    v0 = v0 * sc; v1 = v1 * sc; u32x4 w; w.x = cvt_pk_bf16(v0[0], v0[1]); w.y = cvt_pk_bf16(v0[2], v0[3]); w.z = cvt_pk_bf16(v1[0], v1[1]); w.w = cvt_pk_bf16(v1[2], v1[3]);
                    *(u32x4*)(rowp + bj * HALF) = w; } }
    }
};
template <class Epi, class Sched, bool ALIGN_EPI = false, bool SP2 = false>
__device__ __forceinline__ void gemm_phase(PG8_LAS unsigned char* lds, const Gemm g, const Sched& S, const Epi& E) {
    const int tid = threadIdx.x, wid = __builtin_amdgcn_readfirstlane(tid >> 6), lane = tid & 63, wr = wid >> 2, wc = wid & 3, fr = lane & 15, fq = lane >> 4;
    const int K = g.K, nt = K / BK;
    unsigned voffA[2], voffB[2];
#pragma unroll
    for (int i = 0; i < 2; ++i) { int R, C; stage_rc(tid * 16 + i * 8192, R, C); const int Rb = Epi::PERM ? ((R & ~31) + perm32(R & 31)) : R;
        voffA[i] = (unsigned)(R * K + C) * 2u; voffB[i] = (unsigned)(Rb * K + C) * 2u; }
    const size_t kstep = (size_t)(BK * 2);
    const size_t hstep = (size_t)HALF * K * 2;
    const size_t tstep = 2 * hstep;
    const unsigned ldsw = (unsigned)wid * 1024u;
    const int aoff = lds_byte(wr * 64 + fr, fq * 8), boff = lds_byte(wc * 32 + fr, fq * 8);
#define PG8_SA(b, h) (((b) * 2 + (h)) * HTB)
#define PG8_SB(b, h) ((4 + (b) * 2 + (h)) * HTB)
#define PG8_STAGE(bufoff, gbase, voff) do { _Pragma("unroll") for (int _i = 0; _i < 2; ++_i) \
        __builtin_amdgcn_global_load_lds((const unsigned*)((const char*)(gbase) + (voff)[_i]), (PG8_LAS unsigned*)(lds + (bufoff) + ldsw + _i * 8192), 16, 0, 0); } while (0)
#define PG8_LDA(dst, b, h) do { _Pragma("unroll") for (int m = 0; m < 4; ++m) _Pragma("unroll") for (int k = 0; k < 2; ++k) dst[m][k] = *(const PG8_LAS bf16x8*)(lds + PG8_SA(b, h) + aoff + m * 2048 + k * 1024); } while (0)
#define PG8_LDB(dst, b, h) do { _Pragma("unroll") for (int n = 0; n < 2; ++n) _Pragma("unroll") for (int k = 0; k < 2; ++k) dst[n][k] = *(const PG8_LAS bf16x8*)(lds + PG8_SB(b, h) + boff + n * 2048 + k * 1024); } while (0)
#define PG8_MMA(ai, bj, At, Bt) do { __builtin_amdgcn_s_setprio(1); _Pragma("unroll") for (int m = 0; m < 4; ++m) _Pragma("unroll") for (int n = 0; n < 2; ++n) _Pragma("unroll") for (int k = 0; k < 2; ++k) \
        acc[ai][bj][m][n] = __builtin_amdgcn_mfma_f32_16x16x32_bf16(Bt[n][k], At[m][k], acc[ai][bj][m][n], 0, 0, 0); __builtin_amdgcn_s_setprio(0); } while (0)
#define PG8_WAIT_V(n) asm volatile("s_waitcnt vmcnt(" #n ")" ::: "memory")
#define PG8_WAIT_L(n) asm volatile("s_waitcnt lgkmcnt(" #n ")" ::: "memory")
#define PG8_BAR __builtin_amdgcn_s_barrier()
#define PG8_SCHED __builtin_amdgcn_sched_barrier(0)
    Unit cur, nxt; int ui = 0;
    if (!S.next(0, cur)) return;
    f32x4 acc[2][2][4][2];
#pragma unroll
    for (int a = 0; a < 2; ++a)
#pragma unroll
        for (int b = 0; b < 2; ++b)
#pragma unroll
            for (int m = 0; m < 4; ++m)
#pragma unroll
                for (int n = 0; n < 2; ++n) acc[a][b][m][n] = (f32x4){0.f, 0.f, 0.f, 0.f};
    bf16x8 At[4][2], B0[2][2], B1[2][2];
    const char* cA = (const char*)g.A + (size_t)cur.pm * tstep; const char* cB = (const char*)g.Bt + (size_t)cur.pn * tstep;
    S.a_ready(cur);
    if constexpr (SP2) {
        PG8_STAGE(PG8_SB(0, 0), cB, voffB); PG8_STAGE(PG8_SB(0, 1), cB + hstep, voffB); PG8_STAGE(PG8_SA(0, 0), cA, voffA); PG8_STAGE(PG8_SA(0, 1), cA + hstep, voffA);
        if (wr == 1) PG8_BAR;
        PG8_WAIT_V(2); PG8_BAR;
        PG8_STAGE(PG8_SB(1, 0), cB + kstep, voffB); PG8_STAGE(PG8_SA(1, 0), cA + kstep, voffA); PG8_STAGE(PG8_SB(1, 1), cB + hstep + kstep, voffB);
        PG8_WAIT_V(6); PG8_BAR;
    } else {
        PG8_STAGE(PG8_SB(0, 0), cB, voffB); PG8_STAGE(PG8_SA(0, 0), cA, voffA); PG8_STAGE(PG8_SB(0, 1), cB + hstep, voffB); PG8_STAGE(PG8_SA(0, 1), cA + hstep, voffA);
        if (wr == 1) PG8_BAR;
        PG8_WAIT_V(4); PG8_BAR;
        PG8_STAGE(PG8_SB(1, 0), cB + kstep, voffB); PG8_STAGE(PG8_SA(1, 0), cA + kstep, voffA); PG8_STAGE(PG8_SB(1, 1), cB + hstep + kstep, voffB);
        PG8_WAIT_V(6); PG8_BAR;
    }
    for (;;) {
        const bool has_next = S.next(ui + 1, nxt);
        const char* nA = has_next ? (const char*)g.A + (size_t)nxt.pm * tstep : cA; const char* nB = has_next ? (const char*)g.Bt + (size_t)nxt.pn * tstep : cB;
        for (int t = 0; t < nt; t += 2) {
            const bool last = (t == nt - 2);
            const char* a1 = cA + (size_t)(t + 1) * kstep;
            const char* a2 = last ? nA : cA + (size_t)(t + 2) * kstep; const char* b2 = last ? nB : cB + (size_t)(t + 2) * kstep;
            const char* a3 = a2 + kstep; const char* b3 = b2 + kstep;
            if (last && has_next) S.a_ready(nxt);
            if constexpr (SP2) {
            PG8_LDB(B0, 0, 0); PG8_LDB(B1, 0, 1); PG8_SCHED; PG8_LDA(At, 0, 0); PG8_STAGE(PG8_SA(1, 1), a1 + hstep, voffA);
            PG8_WAIT_V(8); PG8_WAIT_L(0); PG8_BAR; PG8_MMA(0, 0, At, B0); PG8_MMA(0, 1, At, B1); PG8_BAR; PG8_SCHED;
            PG8_LDA(At, 0, 1); PG8_STAGE(PG8_SB(0, 0), b2, voffB); PG8_STAGE(PG8_SB(0, 1), b2 + hstep, voffB); PG8_STAGE(PG8_SA(0, 0), a2, voffA);
            PG8_WAIT_V(8); PG8_WAIT_L(0); PG8_BAR; PG8_MMA(1, 0, At, B0); PG8_MMA(1, 1, At, B1); PG8_BAR; PG8_SCHED;
            PG8_LDB(B0, 1, 0); PG8_LDB(B1, 1, 1); PG8_SCHED; PG8_LDA(At, 1, 0); PG8_STAGE(PG8_SA(0, 1), a2 + hstep, voffA);
            PG8_WAIT_V(8); PG8_WAIT_L(0); PG8_BAR; PG8_MMA(0, 0, At, B0); PG8_MMA(0, 1, At, B1); PG8_BAR; PG8_SCHED;
            PG8_LDA(At, 1, 1); PG8_STAGE(PG8_SB(1, 0), b3, voffB); PG8_STAGE(PG8_SB(1, 1), b3 + hstep, voffB); PG8_STAGE(PG8_SA(1, 0), a3, voffA);
            PG8_WAIT_V(8); PG8_WAIT_L(0); PG8_BAR; PG8_MMA(1, 0, At, B0); PG8_MMA(1, 1, At, B1); PG8_BAR; PG8_SCHED;
            } else {
            PG8_LDB(B0, 0, 0); PG8_SCHED; PG8_LDA(At, 0, 0); PG8_STAGE(PG8_SA(1, 1), a1 + hstep, voffA);
            PG8_WAIT_L(8); PG8_BAR; PG8_WAIT_L(0); PG8_MMA(0, 0, At, B0); PG8_BAR; PG8_SCHED;
            PG8_LDB(B1, 0, 1); PG8_STAGE(PG8_SB(0, 0), b2, voffB);
            PG8_BAR; PG8_WAIT_L(0); PG8_MMA(0, 1, At, B1); PG8_BAR;
            PG8_LDA(At, 0, 1); PG8_STAGE(PG8_SA(0, 0), a2, voffA);
            PG8_BAR; PG8_WAIT_L(0); PG8_MMA(1, 0, At, B0); PG8_BAR; PG8_SCHED;
            PG8_STAGE(PG8_SB(0, 1), b2 + hstep, voffB);
            PG8_WAIT_V(6); PG8_BAR; PG8_MMA(1, 1, At, B1); PG8_BAR;
            PG8_LDB(B0, 1, 0); PG8_SCHED; PG8_LDA(At, 1, 0); PG8_STAGE(PG8_SA(0, 1), a2 + hstep, voffA);
            PG8_WAIT_L(8); PG8_BAR; PG8_WAIT_L(0); PG8_MMA(0, 0, At, B0); PG8_BAR; PG8_SCHED;
            PG8_LDB(B1, 1, 1); PG8_STAGE(PG8_SB(1, 0), b3, voffB);
            PG8_BAR; PG8_WAIT_L(0); PG8_MMA(0, 1, At, B1); PG8_BAR;
            PG8_LDA(At, 1, 1); PG8_STAGE(PG8_SA(1, 0), a3, voffA);
            PG8_BAR; PG8_WAIT_L(0); PG8_MMA(1, 0, At, B0); PG8_BAR; PG8_SCHED;
            PG8_STAGE(PG8_SB(1, 1), b3 + hstep, voffB);
            PG8_WAIT_V(6); PG8_BAR; PG8_MMA(1, 1, At, B1); PG8_BAR;
            }
        }
        if constexpr (ALIGN_EPI) { if (wr == 0) PG8_BAR; }
        if constexpr (!Epi::AFTER_DRAIN) { E(acc, cur, wr, wc, fr, fq); S.done(cur); }
        if (!has_next) break;
#pragma unroll
        for (int a = 0; a < 2; ++a)
#pragma unroll
            for (int b = 0; b < 2; ++b)
#pragma unroll
                for (int m = 0; m < 4; ++m)
#pragma unroll
                    for (int n = 0; n < 2; ++n) acc[a][b][m][n] = (f32x4){0.f, 0.f, 0.f, 0.f};
        cur = nxt; cA = nA; cB = nB; ++ui;
        if constexpr (ALIGN_EPI) { if (wr == 1) PG8_BAR; }
    }
    PG8_WAIT_V(0);
    if constexpr (!ALIGN_EPI) { if (wr == 0) PG8_BAR; }
    PG8_BAR;
    if constexpr (Epi::AFTER_DRAIN) { E.fused(acc, cur, wr, wc, fr, fq, lds, wid, lane); S.done(cur); }
#undef PG8_SA
#undef PG8_SB
#undef PG8_STAGE
#undef PG8_LDA
#undef PG8_LDB
#undef PG8_MMA
#undef PG8_WAIT_V
#undef PG8_WAIT_L
#undef PG8_BAR
#undef PG8_SCHED
}
}

#ifndef PG8_SP2
#define PG8_SP2 true
#endif
#ifndef PG8_ALIGN
#define PG8_ALIGN true
#endif
#define GAS __attribute__((address_space(1)))
#define LAS __attribute__((address_space(3)))
typedef unsigned short bf16;
typedef unsigned v4u __attribute__((ext_vector_type(4)));
typedef float f32x4 __attribute__((ext_vector_type(4)));
typedef short bf16x8 __attribute__((ext_vector_type(8)));
typedef GAS unsigned gu32;
typedef GAS unsigned long long gu64;
#define RLX_AGENT __ATOMIC_RELAXED, __HIP_MEMORY_SCOPE_AGENT
#define LDS_WAIT() asm volatile("s_waitcnt lgkmcnt(0)" ::: "memory")
#define VM_WAIT() asm volatile("s_waitcnt vmcnt(0)" ::: "memory")
__device__ __forceinline__ unsigned long long rt() { return __builtin_amdgcn_s_memrealtime(); }
__device__ __forceinline__ unsigned f2bf(float f) { unsigned u = __builtin_bit_cast(unsigned, f); return (u + 0x7fffu + ((u >> 16) & 1u)) >> 16; }
typedef float pk2_f32x2 __attribute__((ext_vector_type(2))); typedef __bf16 pk2_bf16x2 __attribute__((ext_vector_type(2)));
__device__ __forceinline__ unsigned pk2(float lo, float hi) { pk2_f32x2 v = {lo, hi}; pk2_bf16x2 b = __builtin_convertvector(v, pk2_bf16x2); return __builtin_bit_cast(unsigned, b); }

#define XB_TMO      128
#define XB_XCNT(j)  (256  + 64 * (j))
#define XB_XSUB(j)  (1280 + 64 * (j))
#define XB_XGEN(j)  (2304 + 64 * (j))
#define XB_TOP      3328
#define XB_TOPGEN   3392
#define XCD_BAR_WORDS 3456
#define XB_SPIN_CAP (1u << 18)

__device__ __forceinline__ unsigned xb_ld(unsigned* p)              { return __hip_atomic_load(p, __ATOMIC_RELAXED, __HIP_MEMORY_SCOPE_AGENT); }
__device__ __forceinline__ unsigned xb_add(unsigned* p, unsigned v) { return __hip_atomic_fetch_add(p, v, __ATOMIC_RELAXED, __HIP_MEMORY_SCOPE_AGENT); }
__device__ __forceinline__ unsigned xb_xcc_id() { return (unsigned)__builtin_amdgcn_s_getreg((3 << 11) | 20) & 0xFu; }
#define XB_SPIN(cond, bar) do { unsigned _sp = 0; while (cond) { __builtin_amdgcn_s_sleep(1); \
    if ((++_sp & 255u) == 0u) { if (xb_ld(&(bar)[XB_TMO])) break; if (_sp > XB_SPIN_CAP) { atomicAdd(&(bar)[XB_TMO], 1u); break; } } } } while (0)

struct XcdBarrier {
    unsigned* bar; unsigned x;
    volatile LAS unsigned* st;
};

__device__ __forceinline__ XcdBarrier xcd_barrier_post(unsigned* bar, volatile LAS unsigned* st) {
    XcdBarrier b; b.bar = bar; b.x = xb_xcc_id(); b.st = st;
    if (threadIdx.x == 0) (void)xb_add(&bar[XB_XCNT(b.x)], 1u);
    return b;
}
__device__ __forceinline__ void xcd_barrier_complete(unsigned* bar, unsigned x, unsigned& nloc, unsigned& nx) {
    const unsigned G = gridDim.x * gridDim.y * gridDim.z;
    unsigned sum, cnt, mine, sp = 0u;
    for (;;) {
        sum = 0u; cnt = 0u; mine = 0u;
#pragma unroll
        for (unsigned j = 0; j < 16; ++j) { const unsigned c = xb_ld(&bar[XB_XCNT(j)]); sum += c; cnt += (c > 0u) ? 1u : 0u; mine = (j == x) ? c : mine; }
        if (sum == G) break;
        __builtin_amdgcn_s_sleep(1);
        if ((++sp & 255u) == 0u) { if (xb_ld(&bar[XB_TMO])) break; if (sp > XB_SPIN_CAP) { atomicAdd(&bar[XB_TMO], 1u); break; } }
    }
    nloc = mine > 0u ? mine : 1u; nx = cnt > 0u ? cnt : 1u;
}

__device__ __forceinline__ void xcd_barrier(const XcdBarrier& b) {
    asm volatile("s_waitcnt vmcnt(0)" ::: "memory");
    __syncthreads();
    if (threadIdx.x == 0) {
        unsigned* bar = b.bar;
        __builtin_amdgcn_s_waitcnt(0);
        unsigned nloc = b.st[0], nx = b.st[1];
        if (nloc == 0u) { xcd_barrier_complete(bar, b.x, nloc, nx); b.st[0] = nloc; b.st[1] = nx; }
        const unsigned old = xb_add(&bar[XB_XSUB(b.x)], 1u);
        const unsigned gen = old / nloc;
        if (old + 1u == (gen + 1u) * nloc) {
            __builtin_amdgcn_fence(__ATOMIC_RELEASE, "agent");
            asm volatile("s_waitcnt vmcnt(0)" ::: "memory");
            const unsigned og = xb_add(&bar[XB_TOP], 1u);
            const unsigned tg = og / nx;
            if (og + 1u == (tg + 1u) * nx) xb_add(&bar[XB_TOPGEN], 1u);
            else XB_SPIN(xb_ld(&bar[XB_TOPGEN]) == tg, bar);
            __builtin_amdgcn_fence(__ATOMIC_ACQUIRE, "agent");
            xb_add(&bar[XB_XGEN(b.x)], 1u);
            asm volatile("s_waitcnt vmcnt(0)" ::: "memory");
        } else {
            XB_SPIN(xb_ld(&bar[XB_XGEN(b.x)]) == gen, bar);
            __builtin_amdgcn_fence(__ATOMIC_ACQUIRE, "agent");
            asm volatile("s_waitcnt vmcnt(0)" ::: "memory");
        }
    }
    __syncthreads();
}


constexpr int NWAVES = 8;
constexpr int DM = 2048, BATCH = 4, SEQ = 4096, M = BATCH * SEQ;
constexpr int NIN = 6176, NINP = 6144;
constexpr int O_GQ = 0, O_GK = 512, O_GV = 1024, O_GR = 2048, O_AQ = 3072, O_AK = 4096, O_AV = 5120;
constexpr float EPS = 1e-6f;
constexpr int PEER_K = 128;

constexpr size_t MiB = 1u << 20;
constexpr size_t WS_CTL = 0, CTL_ZERO_BYTES = 1 * MiB;
constexpr size_t WS_WIN = 1 * MiB;
constexpr size_t WS_WGD = 25 * MiB;
constexpr size_t WS_GDB = 62 * MiB;
constexpr size_t WS_WOUT = 26 * MiB;
constexpr size_t WS_WQ = 34 * MiB;
constexpr size_t WS_SSQ = 42 * MiB;
constexpr size_t WS_EIDX = 44 * MiB;
constexpr size_t WS_GATE = 52 * MiB;
constexpr size_t WS_SKB = 60 * MiB;
constexpr size_t WS_XN = 64 * MiB;
constexpr size_t WS_PROJ = 128 * MiB;
constexpr size_t WS_HB = 256 * MiB;
constexpr size_t WS_OF = 328 * MiB;
constexpr size_t WS_OB = 360 * MiB;
constexpr size_t WS_ATT = 392 * MiB;
constexpr size_t WS_ATTP = 392 * MiB;
constexpr size_t WS_ATTML = 488 * MiB;
constexpr size_t WS_GT_QD = 64 * MiB;
constexpr size_t WS_GT_KE = 96 * MiB;
constexpr size_t OUT_GT_AM = 0;
constexpr size_t OUT_GT_DEC = 16 * MiB;
constexpr size_t OUT_GT_VT = 32 * MiB;
constexpr int CW_ATTQ = 64;
constexpr size_t WS_END = 494 * MiB;
constexpr size_t OUT_U8 = 64 * MiB;
constexpr size_t OUT_V8 = 96 * MiB;
constexpr size_t WS_SU = 61 * MiB;
constexpr size_t WS_SV = 61 * MiB + 65536;
constexpr int CW_CONVQ = 256;
constexpr size_t WS_PW = 128 * MiB;
constexpr size_t WS_SSQ2 = 136 * MiB;
constexpr size_t WS_PD = 64 * MiB;
constexpr int PEER_E = 16384;
constexpr int CW_TMO = 0, CW_CODE = 1, CW_BAR = 4096;

constexpr int RING_OFF = 0, RING_BYTES = 131072;
constexpr int LDS_BYTES = 163840;
constexpr int LDSCTL_OFF = LDS_BYTES - 1024, MISC_OFF = LDSCTL_OFF + 320;

typedef float f32x2 __attribute__((ext_vector_type(2)));
typedef float f32x16 __attribute__((ext_vector_type(16)));
__device__ __forceinline__ float bf2f(unsigned short h) { return __builtin_bit_cast(float, (unsigned)h << 16); }
__device__ __forceinline__ float bflo(unsigned w) { return __builtin_bit_cast(float, w << 16); }
__device__ __forceinline__ float bfhi(unsigned w) { return __builtin_bit_cast(float, w & 0xffff0000u); }
__device__ __forceinline__ float wave_sum(float v) {
#pragma unroll
    for (int o = 1; o < 64; o <<= 1) v += __shfl_xor(v, o);
    return v;
}
__device__ __forceinline__ float wave_max(float v) {
#pragma unroll
    for (int o = 1; o < 64; o <<= 1) v = fmaxf(v, __shfl_xor(v, o));
    return v;
}

template <class T> __device__ __forceinline__ T* opaque(T* p) { asm volatile("" : "+s"(p)); return (T*)(GAS T*)p; }
__device__ __forceinline__ int opaque_v(int x) { asm volatile("" : "+v"(x)); return x; }
template <class T> __device__ __forceinline__ T ldu(const void* ubase, unsigned voff) { return *(const GAS T*)((const GAS char*)ubase + voff); }
template <class T> __device__ __forceinline__ void stu(void* ubase, unsigned voff, T v) { *(GAS T*)((GAS char*)ubase + voff) = v; }
namespace pg8 {
struct EpiRes {
    static constexpr bool PERM = false, AFTER_DRAIN = false;
    const float* x; bf16_t* HB; float* ssq; int ldc;
    __device__ __forceinline__ void operator()(const f32x4 (&acc)[2][2][4][2], const Unit& u, int wr, int wc, int fr, int fq) const {
        const int col0 = u.pn * BM + wc * 32 + 4 * fq;
#pragma unroll
        for (int ai = 0; ai < 2; ++ai)
#pragma unroll
            for (int m = 0; m < 4; ++m) {
                const int r = u.pm * BM + ai * HALF + wr * 64 + m * 16 + fr; const size_t off = (size_t)r * ldc + col0; float s = 0.f;
#pragma unroll
                for (int bj = 0; bj < 2; ++bj)
#pragma unroll
                    for (int n = 0; n < 2; ++n) {
                        const f32x4 xv = *(const f32x4*)(x + off + bj * HALF + n * 16);
                        const f32x4 hv = xv + acc[ai][bj][m][n];
                        s += (hv[0] * hv[0] + hv[1] * hv[1]) + (hv[2] * hv[2] + hv[3] * hv[3]);
                        unsigned long long w = (unsigned long long)cvt_pk_bf16(hv[0], hv[1]) | ((unsigned long long)cvt_pk_bf16(hv[2], hv[3]) << 32);
                        *(unsigned long long*)(HB + off + bj * HALF + n * 16) = w;
                    }
                s += __shfl_xor(s, 16); s += __shfl_xor(s, 32);
                if (fq == 0) ssq[(size_t)r * 32 + u.pn * 4 + wc] = s;
            }
    }
};
struct EpiRowScale {
    static constexpr bool PERM = true, AFTER_DRAIN = false;
    bf16_t* O; int ldc; const float* ssq; float inv_n, eps;
    __device__ __forceinline__ void operator()(const f32x4 (&acc)[2][2][4][2], const Unit& u, int wr, int wc, int fr, int fq) const {
        const int col0 = u.pn * BM + wc * 32 + 8 * fq;
#pragma unroll
        for (int ai = 0; ai < 2; ++ai)
#pragma unroll
            for (int m = 0; m < 4; ++m) {
                const int r = u.pm * BM + ai * HALF + wr * 64 + m * 16 + fr;
                const f32x4* sp = (const f32x4*)(ssq + (size_t)r * 32); float s = 0.f;
#pragma unroll
                for (int i = 0; i < 8; ++i) { const f32x4 t = sp[i]; s += (t[0] + t[1]) + (t[2] + t[3]); }
                const float sc = 1.0f / sqrtf(s * inv_n + eps);
                bf16_t* rowp = O + (size_t)r * ldc + col0;
#pragma unroll
                for (int bj = 0; bj < 2; ++bj) { const f32x4 v0 = acc[ai][bj][m][0] * sc, v1 = acc[ai][bj][m][1] * sc;
                    u32x4 w; w.x = cvt_pk_bf16(v0[0], v0[1]); w.y = cvt_pk_bf16(v0[2], v0[3]); w.z = cvt_pk_bf16(v1[0], v1[1]); w.w = cvt_pk_bf16(v1[2], v1[3]);
                    *(u32x4*)(rowp + bj * HALF) = w; }
            }
    }
};
}

struct Frame {
    LAS unsigned char* lds;
    volatile LAS unsigned* MISC;
    gu32* ctl;
    int tid, lane, wave;
    int vcu, G;
};

__device__ __forceinline__ void p0_transpose_item(const float* W, int K, int ldw, const float* gk, bf16* WT, LAS float* scr, int item, int lane) {
    const int nblk = ldw / 32, kb = item / nblk, nb = item % nblk, k0 = 64 * kb, n0 = 32 * nb;
#pragma unroll 8
    for (int i = 0; i < 32; ++i) { const int kk = 2 * i + (lane >> 5); float w = W[(size_t)(k0 + kk) * ldw + n0 + (lane & 31)]; if (gk) w *= gk[k0 + kk]; scr[kk * 33 + (lane & 31)] = w; }
    LDS_WAIT(); asm volatile("" ::: "memory");
    const int c = lane & 7;
#pragma unroll
    for (int j = 0; j < 4; ++j) { const int n = (lane >> 3) + 8 * j; const LAS float* s = scr + (8 * c) * 33 + n;
        v4u o; o.x = pk2(s[0 * 33], s[1 * 33]); o.y = pk2(s[2 * 33], s[3 * 33]); o.z = pk2(s[4 * 33], s[5 * 33]); o.w = pk2(s[6 * 33], s[7 * 33]);
        *(GAS v4u*)(WT + (size_t)(n0 + n) * K + k0 + 8 * c) = o; }
    LDS_WAIT(); asm volatile("" ::: "memory");
}
__device__ __forceinline__ void rms_row_to_bf16(int lane, const float* xrow, const float* g, bf16* orow) {
    const GAS f32x4* xr = (const GAS f32x4*)xrow + lane; const GAS f32x4* gr = (const GAS f32x4*)g + lane;
    f32x4 v[8]; float s = 0.f;
#pragma unroll
    for (int j = 0; j < 8; ++j) { v[j] = xr[64 * j]; s += (v[j].x * v[j].x + v[j].y * v[j].y) + (v[j].z * v[j].z + v[j].w * v[j].w); }
    const float rstd = 1.f / sqrtf(wave_sum(s) * (1.f / DM) + EPS);
    GAS unsigned long long* o8 = (GAS unsigned long long*)orow + lane;
#pragma unroll
    for (int j = 0; j < 8; ++j) { const f32x4 gg = gr[64 * j];
        o8[64 * j] = (unsigned long long)pk2(v[j].x * rstd * gg.x, v[j].y * rstd * gg.y) | ((unsigned long long)pk2(v[j].z * rstd * gg.z, v[j].w * rstd * gg.w) << 32); }
}

struct Args {
    const float* in[16]; float* out; unsigned char* ws; int ph_lo, ph_hi, li, pad;
};

__device__ __forceinline__ void p0_prologue(Frame& F, const Args& a) {
    unsigned char* ws = a.ws;
    LAS float* scr = (LAS float*)(F.lds + RING_OFF + F.wave * 16384);
    const int gw = F.vcu * NWAVES + F.wave, NGW = F.G * NWAVES;
    bf16* Win_t = (bf16*)(ws + WS_WIN); bf16* Wout_t = (bf16*)(ws + WS_WOUT); bf16* Wq_t = (bf16*)(ws + WS_WQ); bf16* XN = (bf16*)(ws + WS_XN);
    constexpr int I_IN = (DM / 64) * (NIN / 32), I_SQ = (DM / 64) * (DM / 32);
    constexpr int NITEMS = I_IN + 2 * I_SQ;
    for (int it = gw; it < NITEMS; it += NGW) {
        int r = it;
        if (r < I_IN) { const int nb = r % (NIN / 32); bf16* dst = nb < 96 ? Win_t : nb == 96 ? (bf16*)(ws + WS_WGD) - (size_t)96 * 32 * DM : Win_t - (size_t)32 * DM;
            p0_transpose_item(a.in[2], DM, NIN, nullptr, dst, scr, r, F.lane); continue; } r -= I_IN;
        if (r < I_SQ) { p0_transpose_item(a.in[9], DM, DM, nullptr, Wout_t, scr, r, F.lane); continue; } r -= I_SQ;
        p0_transpose_item(a.in[11], DM, DM, a.in[10], Wq_t, scr, r, F.lane);
    }
    { const f32x4* sk = (const f32x4*)a.in[12]; unsigned long long* skb = (unsigned long long*)(ws + WS_SKB);
      for (int i = gw * 64 + F.lane; i < 8 * 2 * 128 * 128 / 4; i += NGW * 64) { const f32x4 v = sk[i]; skb[i] = (unsigned long long)pk2(v.x, v.y) | ((unsigned long long)pk2(v.z, v.w) << 32); } }
    for (int m = gw; m < M; m += NGW) rms_row_to_bf16(F.lane, a.in[0] + (size_t)m * DM, a.in[1], XN + (size_t)m * DM);
}


__device__ __forceinline__ void gd_side_gemm(Frame& F, const Args& a) {
    unsigned char* ws = a.ws; const bf16* XN = (const bf16*)(ws + WS_XN); const bf16* WG = (const bf16*)(ws + WS_WGD); float* GDB = (float*)(ws + WS_GDB);
    const int lane = F.lane, w = F.wave, r32 = lane & 31, hh = lane >> 5; LAS float* part = (LAS float*)F.lds;
    for (int blk = F.vcu; blk < M / 64; blk += F.G) { const int tok0 = blk * 64;
        f32x16 acc[2];
#pragma unroll
        for (int tt = 0; tt < 2; ++tt) acc[tt] = (f32x16){0.f, 0.f, 0.f, 0.f, 0.f, 0.f, 0.f, 0.f, 0.f, 0.f, 0.f, 0.f, 0.f, 0.f, 0.f, 0.f};
#pragma unroll 4
        for (int ks = 0; ks < 16; ++ks) { const int k0 = 256 * w + 16 * ks + 8 * hh; const bf16x8 bw = *(const bf16x8*)(WG + (size_t)r32 * DM + k0);
#pragma unroll
            for (int tt = 0; tt < 2; ++tt) { const bf16x8 ax = *(const bf16x8*)(XN + (size_t)(tok0 + 32 * tt + r32) * DM + k0); acc[tt] = __builtin_amdgcn_mfma_f32_32x32x16_bf16(ax, bw, acc[tt], 0, 0, 0); } }
#pragma unroll
        for (int tt = 0; tt < 2; ++tt)
#pragma unroll
            for (int r = 0; r < 16; ++r) { const float x = acc[tt][r]; part[((w * 2 + tt) * 16 + r) * 64 + lane] = x; }
        __syncthreads();
#pragma unroll
        for (int i = 0; i < 4; ++i) { const int o = F.tid + 512 * i; float sum = 0.f;
#pragma unroll
            for (int ww = 0; ww < 8; ++ww) sum += part[ww * 2048 + o];
            const int tt = o >> 10, r = (o >> 6) & 15, ln = o & 63; const int t = 32 * tt + (r & 3) + 8 * (r >> 2) + 4 * (ln >> 5);
            GDB[(size_t)(tok0 + t) * 32 + (ln & 31)] = sum; }
        __syncthreads();
    }
}

__device__ __forceinline__ void p3_finalize(Frame& F, const Args& a) {
    unsigned char* ws = a.ws;
    const int gw = F.vcu * NWAVES + F.wave, NGW = F.G * NWAVES, lane = F.lane;
    const bf16* OFp = (const bf16*)(ws + WS_OF); const bf16* OBp = (const bf16*)(ws + WS_OB);
    const bf16* PROJ = (const bf16*)(ws + WS_PROJ); bf16* Y = (bf16*)(ws + WS_XN);
    const float* gla_g = a.in[7]; const float* att_g = a.in[8];
    const f32x4 gg = *(const f32x4*)(gla_g + 4 * lane);
    for (int m = gw; m < M; m += NGW) {
#pragma unroll
        for (int hh = 0; hh < 4; ++hh) {
            const unsigned long long wf = *(const unsigned long long*)(OFp + (size_t)m * 1024 + hh * 256 + 4 * lane);
            const unsigned long long wb = *(const unsigned long long*)(OBp + (size_t)m * 1024 + hh * 256 + 4 * lane);
            const f32x4 o = (f32x4){bflo((unsigned)wf) + bflo((unsigned)wb), bfhi((unsigned)wf) + bfhi((unsigned)wb), bflo((unsigned)(wf >> 32)) + bflo((unsigned)(wb >> 32)), bfhi((unsigned)(wf >> 32)) + bfhi((unsigned)(wb >> 32))};
            const float ss = wave_sum((o.x * o.x + o.y * o.y) + (o.z * o.z + o.w * o.w));
            const float rstd = 1.f / sqrtf(ss * (1.f / 256.f) + EPS);
            const unsigned long long gr = *(const unsigned long long*)(PROJ + (size_t)m * NINP + O_GR + hh * 256 + 4 * lane);
            const float r0 = bflo((unsigned)gr), r1 = bfhi((unsigned)gr), r2 = bflo((unsigned)(gr >> 32)), r3 = bfhi((unsigned)(gr >> 32));
            const float y0 = o.x * rstd * gg.x * (r0 / (1.f + __expf(-r0))), y1 = o.y * rstd * gg.y * (r1 / (1.f + __expf(-r1)));
            const float y2 = o.z * rstd * gg.z * (r2 / (1.f + __expf(-r2))), y3 = o.w * rstd * gg.w * (r3 / (1.f + __expf(-r3)));
            *(unsigned long long*)(Y + (size_t)m * DM + hh * 256 + 4 * lane) = (unsigned long long)pk2(y0, y1) | ((unsigned long long)pk2(y2, y3) << 32);
        }
        float av[16]; float ss = 0.f;
#pragma unroll
        for (int p = 0; p < 2; ++p) { const int col = p * 512 + 8 * lane, hd = col >> 6; float mm[3], ll[3]; v4u ow[3];
#pragma unroll
            for (int pt = 0; pt < 3; ++pt) { const size_t rec = ((size_t)pt * M + m) * 16 + hd; const f32x2 ml2 = *(const f32x2*)((const float*)(ws + WS_ATTML) + rec * 2); mm[pt] = ml2.x; ll[pt] = ml2.y;
                ow[pt] = *(const v4u*)((const bf16*)(ws + WS_ATTP) + rec * 64 + (col & 63)); }
            const float mt = fmaxf(fmaxf(mm[0], mm[1]), mm[2]); const float w0 = __expf(mm[0] - mt), w1 = __expf(mm[1] - mt), w2 = __expf(mm[2] - mt);
            const float inv = 1.f / (w0 * ll[0] + w1 * ll[1] + w2 * ll[2]);
            av[p * 8 + 0] = (w0 * bflo(ow[0].x) + w1 * bflo(ow[1].x) + w2 * bflo(ow[2].x)) * inv; av[p * 8 + 1] = (w0 * bfhi(ow[0].x) + w1 * bfhi(ow[1].x) + w2 * bfhi(ow[2].x)) * inv;
            av[p * 8 + 2] = (w0 * bflo(ow[0].y) + w1 * bflo(ow[1].y) + w2 * bflo(ow[2].y)) * inv; av[p * 8 + 3] = (w0 * bfhi(ow[0].y) + w1 * bfhi(ow[1].y) + w2 * bfhi(ow[2].y)) * inv;
            av[p * 8 + 4] = (w0 * bflo(ow[0].z) + w1 * bflo(ow[1].z) + w2 * bflo(ow[2].z)) * inv; av[p * 8 + 5] = (w0 * bfhi(ow[0].z) + w1 * bfhi(ow[1].z) + w2 * bfhi(ow[2].z)) * inv;
            av[p * 8 + 6] = (w0 * bflo(ow[0].w) + w1 * bflo(ow[1].w) + w2 * bflo(ow[2].w)) * inv; av[p * 8 + 7] = (w0 * bfhi(ow[0].w) + w1 * bfhi(ow[1].w) + w2 * bfhi(ow[2].w)) * inv; }
#pragma unroll
        for (int i = 0; i < 16; ++i) ss += av[i] * av[i];
        const float rstd = 1.f / sqrtf(wave_sum(ss) * (1.f / 1024.f) + EPS);
#pragma unroll
        for (int p = 0; p < 2; ++p) { const f32x4 g0 = *(const f32x4*)(att_g + p * 512 + 8 * lane), g1 = *(const f32x4*)(att_g + p * 512 + 8 * lane + 4);
            v4u w; w.x = pk2(av[p * 8 + 0] * rstd * g0.x, av[p * 8 + 1] * rstd * g0.y); w.y = pk2(av[p * 8 + 2] * rstd * g0.z, av[p * 8 + 3] * rstd * g0.w);
            w.z = pk2(av[p * 8 + 4] * rstd * g1.x, av[p * 8 + 5] * rstd * g1.y); w.w = pk2(av[p * 8 + 6] * rstd * g1.z, av[p * 8 + 7] * rstd * g1.w);
            *(v4u*)(Y + (size_t)m * DM + 1024 + p * 512 + 8 * lane) = w; }
    }
}


__device__ __forceinline__ void wave_argmax(float& v, int& idx) {
#pragma unroll
    for (int o = 1; o < 64; o <<= 1) { const float ov = __shfl_xor(v, o); const int oi = __shfl_xor(idx, o); if (ov > v || (ov == v && oi < idx)) { v = ov; idx = oi; } }
}
__device__ __forceinline__ void ce_desc(float& a, float& b) { const float hi = fmaxf(a, b), lo = fminf(a, b); a = hi; b = lo; }
__device__ __forceinline__ void sort16_desc(float* v) {
#pragma unroll
    for (int k = 2; k <= 16; k <<= 1)
#pragma unroll
        for (int j = k >> 1; j > 0; j >>= 1)
#pragma unroll
            for (int i = 0; i < 16; ++i) { const int l = i ^ j; if (l > i) { if ((i & k) == 0 || k == 16) ce_desc(v[i], v[l]); else ce_desc(v[l], v[i]); } }
}
__device__ __forceinline__ void merge16_desc(float* v) {
#pragma unroll
    for (int j = 8; j > 0; j >>= 1)
#pragma unroll
        for (int i = 0; i < 16; ++i) { const int l = i ^ j; if (l > i) ce_desc(v[i], v[l]); }
}
__device__ __forceinline__ void top16_of_two(float* a, const float* b) {
#pragma unroll
    for (int i = 0; i < 16; ++i) a[i] = fmaxf(a[i], b[15 - i]);
    merge16_desc(a);
}
__device__ __forceinline__ void top16_of_64(float* v) {
    sort16_desc(v); sort16_desc(v + 16); sort16_desc(v + 32); sort16_desc(v + 48);
    top16_of_two(v, v + 16); top16_of_two(v + 32, v + 48); top16_of_two(v, v + 32);
}
__device__ __forceinline__ void topk_phase(Frame& F, const Args& a) {
    unsigned char* ws = a.ws; const bf16* QP = (const bf16*)(ws + WS_XN); const bf16* SKB = (const bf16*)(ws + WS_SKB); int* EIDX = (int*)(ws + WS_EIDX); float* GATE = (float*)(ws + WS_GATE);
    const int lane = F.lane, h = F.wave, r32 = lane & 31, hh = lane >> 5;
    LAS int* tok_id = (LAS int*)(F.lds);
    LAS float* tok_gt = (LAS float*)(F.lds + 32768);
    LAS int* ktab = (LAS int*)(F.lds + 65536 + F.wave * 8192);
    for (int unit = F.vcu; unit < M / 64; unit += F.G) {
        const int tok0 = unit * 64;
#pragma unroll 1
        for (int tt = 0; tt < 2; ++tt) {
            const size_t row = (size_t)(tok0 + tt * 32 + r32);
            float L[2][16];
#pragma unroll
            for (int c = 0; c < 2; ++c) {
                f32x16 acc[4];
#pragma unroll
                for (int kt = 0; kt < 4; ++kt) acc[kt] = (f32x16){0.f, 0.f, 0.f, 0.f, 0.f, 0.f, 0.f, 0.f, 0.f, 0.f, 0.f, 0.f, 0.f, 0.f, 0.f, 0.f};
                const bf16* qb = QP + row * DM + h * 256 + c * 128 + 8 * hh;
                const bf16* kb = SKB + ((size_t)(h * 2 + c) * 128 + r32) * 128 + 8 * hh;
#if !defined(TOPK_DBG)
#pragma unroll 2
                for (int st = 0; st < 8; ++st) {
                    const bf16x8 bq = *(const bf16x8*)(qb + 16 * st);
#pragma unroll
                    for (int kt = 0; kt < 4; ++kt) { const bf16x8 ak = *(const bf16x8*)(kb + (size_t)kt * 32 * 128 + 16 * st);
                        acc[kt] = __builtin_amdgcn_mfma_f32_32x32x16_bf16(ak, bq, acc[kt], 0, 0, 0); }
                }
#else
                (void)qb; (void)kb;
#pragma unroll
                for (int kt = 0; kt < 4; ++kt)
#pragma unroll
                    for (int r = 0; r < 16; ++r) { const int key = 32 * kt + (r & 3) + 8 * (r >> 2) + 4 * hh; float d = 0.f;
                        const bf16* qq = QP + row * DM + h * 256 + c * 128; const float* kk = a.in[12] + ((size_t)(h * 2 + c) * 128 + key) * 128;
                        for (int dd = 0; dd < 128; ++dd) d += bf2f(qq[dd]) * kk[dd];
                        acc[kt][r] = d; }
#endif
                float v[64];
#pragma unroll
                for (int kt = 0; kt < 4; ++kt)
#pragma unroll
                    for (int r = 0; r < 16; ++r) { const int key = 32 * kt + (r & 3) + 8 * (r >> 2);
                        const float sc = acc[kt][r];
                        v[kt * 16 + r] = __builtin_bit_cast(float, (__builtin_bit_cast(unsigned, sc) & ~127u) | (unsigned)(key + 4 * hh)); }
                top16_of_64(v);
                float p[16];
#pragma unroll
                for (int i = 0; i < 16; ++i) p[i] = __shfl_xor(v[i], 32);
                top16_of_two(v, p);
#pragma unroll
                for (int i = 0; i < 16; ++i) { L[c][i] = v[i]; ktab[(c * 16 + i) * 64 + lane] = (int)(__builtin_bit_cast(unsigned, v[i]) & 127u); }
            }
            float cnd[64];
            { int n = 0;
#pragma unroll
              for (int i = 0; i < 16; ++i)
#pragma unroll
                  for (int j = 0; j < 16; ++j) if ((i + 1) * (j + 1) <= 16) { cnd[n] = __builtin_bit_cast(float, (__builtin_bit_cast(unsigned, L[0][i] + L[1][j]) & ~255u) | (unsigned)((i << 4) | j)); ++n; }
#pragma unroll
              for (int q = 50; q < 64; ++q) cnd[q] = -3.0e38f; }
            top16_of_64(cnd);
            float mx = __builtin_bit_cast(float, __builtin_bit_cast(unsigned, cnd[0]) & ~255u), sum = 0.f; float ex[16];
#pragma unroll
            for (int i = 0; i < 16; ++i) { ex[i] = __expf(__builtin_bit_cast(float, __builtin_bit_cast(unsigned, cnd[i]) & ~255u) - mx); sum += ex[i]; }
            const float inv = 1.f / sum;
            LDS_WAIT(); asm volatile("" ::: "memory");
            if (hh == 0) {
#pragma unroll
                for (int i = 0; i < 16; ++i) { const unsigned bits = __builtin_bit_cast(unsigned, cnd[i]); const int ia = (bits >> 4) & 15, jb = bits & 15;
                    const int e = ktab[ia * 64 + lane] * 128 + ktab[(16 + jb) * 64 + lane];
                    tok_id[(tt * 32 + r32) * 128 + h * 16 + i] = e; tok_gt[(tt * 32 + r32) * 128 + h * 16 + i] = ex[i] * inv; }
            }
            LDS_WAIT(); asm volatile("" ::: "memory");
        }
        __syncthreads();
        for (int t8 = 0; t8 < 8; ++t8) { const int tk = F.wave * 8 + t8; const size_t ob = (size_t)(tok0 + tk) * 128;
            EIDX[ob + lane] = tok_id[tk * 128 + lane]; EIDX[ob + 64 + lane] = tok_id[tk * 128 + 64 + lane]; GATE[ob + lane] = tok_gt[tk * 128 + lane]; GATE[ob + 64 + lane] = tok_gt[tk * 128 + 64 + lane]; }
        __syncthreads();
    }
}


__device__ __forceinline__ void gla_prep_phase(Frame& F, const Args& a) {
    unsigned char* ws = a.ws; const bf16* PROJ;
    const int w = F.wave;
    LAS unsigned char* L = F.lds;
    LAS unsigned char* Qraw = L; LAS unsigned char* Kraw = L + 16384; LAS unsigned char* Vraw = L + 32768; LAS float* GDf = (LAS float*)(L + 65536); LAS float* GSUM = (LAS float*)(L + 73728);
    LAS unsigned char* IMGQ = L + 77824; LAS unsigned char* IMGK = L + 95232; LAS unsigned char* IMGE = L + 112640; LAS unsigned char* AMI = L + 32768;
    for (int it = F.vcu; it < 1024; it += F.G) {
        const int b = it >> 8, h = (it >> 6) & 3, n = it & 63; const size_t row0 = (size_t)b * SEQ + n * 64;
        ws = opaque(ws); PROJ = (const bf16*)(ws + WS_PROJ);
        int tid = opaque_v(F.tid), lane = tid & 63, r32 = lane & 31, hh = lane >> 5;
#pragma unroll
        for (int i = 0; i < 2; ++i) { const int idx = tid + 512 * i, r = idx >> 4, c = idx & 15;
            *(LAS v4u*)(Qraw + r * 256 + c * 16) = *(const GAS v4u*)(PROJ + (row0 + r) * NINP + O_GQ + h * 128 + c * 8);
            *(LAS v4u*)(Kraw + r * 256 + c * 16) = *(const GAS v4u*)(PROJ + (row0 + r) * NINP + O_GK + h * 128 + c * 8); }
#pragma unroll
        for (int i = 0; i < 4; ++i) { const int idx = tid + 512 * i, r = idx >> 5, c = idx & 31;
            *(LAS v4u*)(Vraw + r * 512 + c * 16) = *(const GAS v4u*)(PROJ + (row0 + r) * NINP + O_GV + h * 256 + c * 8); }
        if (tid < 256) { const int r = tid >> 2, c = tid & 3; const GAS float* gsrc = (const GAS float*)(ws + WS_GDB) + (row0 + r) * 32 + c * 8; const f32x4 g0 = *(const GAS f32x4*)gsrc, g1 = *(const GAS f32x4*)(gsrc + 4);
            *(LAS f32x4*)(GDf + r * 32 + c * 8) = g0; *(LAS f32x4*)(GDf + r * 32 + c * 8 + 4) = g1; }
        __syncthreads();
#pragma unroll
        for (int ks = 0; ks < 4; ++ks) { unsigned pk[4];
#pragma unroll
            for (int p = 0; p < 4; ++p) { const int s0 = 16 * ks + 8 * hh + 2 * p; const unsigned lo = *(const LAS unsigned short*)(Vraw + s0 * 512 + (32 * w + r32) * 2), hi = *(const LAS unsigned short*)(Vraw + (s0 + 1) * 512 + (32 * w + r32) * 2); pk[p] = lo | (hi << 16); }
            *(GAS v4u*)((unsigned char*)a.out + OUT_GT_VT + (size_t)it * 32768 + (w * 4 + ks) * 1024 + lane * 16) = (v4u){pk[0], pk[1], pk[2], pk[3]}; }
        for (int dir = 0; dir < 2; ++dir) {
            const size_t idir = (size_t)(((b * 4 + h) * 2 + dir) * 64 + n); ws = opaque(ws); tid = opaque_v(tid); lane = tid & 63; r32 = lane & 31; hh = lane >> 5;
            {
                const int d = tid & 127, tq = tid >> 7; const float* upp = (dir ? a.in[5] : a.in[3]) + h * 128 + d; const float bias = (dir ? a.in[6] : a.in[4])[h * 128 + d];
                float up[16];
#pragma unroll
                for (int r = 0; r < 16; ++r) up[r] = upp[r * 512];
                float c[16];
#pragma unroll
                for (int i = 0; i < 16; ++i) { const LAS float* g = GDf + (16 * tq + i) * 32 + dir * 16; float z = bias;
#pragma unroll
                    for (int r = 0; r < 16; ++r) z += g[r] * up[r];
                    c[i] = (fminf(z, 0.f) - __logf(1.f + __expf(-fabsf(z)))) * (1.f / 16.f); }
                if (dir == 0) {
#pragma unroll
                    for (int i = 1; i < 16; ++i) c[i] += c[i - 1];
                } else {
#pragma unroll
                    for (int i = 14; i >= 0; --i) c[i] += c[i + 1];
                }
                GSUM[(dir * 4 + tq) * 128 + d] = dir == 0 ? c[15] : c[0];
                __syncthreads();
                const float t0 = GSUM[(dir * 4 + 0) * 128 + d], t1 = GSUM[(dir * 4 + 1) * 128 + d], t2 = GSUM[(dir * 4 + 2) * 128 + d], t3 = GSUM[(dir * 4 + 3) * 128 + d];
                const float Bt = (t0 + t1) + (t2 + t3);
                float off;
                if (dir == 0) off = (tq > 0 ? t0 : 0.f) + (tq > 1 ? t1 : 0.f) + (tq > 2 ? t2 : 0.f);
                else off = (tq < 1 ? t1 : 0.f) + (tq < 2 ? t2 : 0.f) + (tq < 3 ? t3 : 0.f);
                unsigned kep[8];
#pragma unroll
                for (int i = 0; i < 16; i += 2) { float ke2[2];
#pragma unroll
                    for (int q = 0; q < 2; ++q) { const int t = 16 * tq + i + q; const float bi = c[i + q] + off;
                        const float qv = bf2f(*(const LAS unsigned short*)(Qraw + t * 256 + d * 2)), kv = bf2f(*(const LAS unsigned short*)(Kraw + t * 256 + d * 2));
                        *(LAS unsigned short*)(IMGQ + t * 272 + d * 2) = (unsigned short)pk2(qv * 0.08838834764831845f * __expf(bi), 0.f);
                        *(LAS unsigned short*)(IMGK + t * 272 + d * 2) = (unsigned short)pk2(kv * __expf(-bi), 0.f);
                        ke2[q] = kv * __expf(Bt - bi); }
                    kep[i >> 1] = pk2(ke2[0], ke2[1]); }
                *(LAS v4u*)(IMGE + d * 144 + (16 * tq) * 2) = (v4u){kep[0], kep[1], kep[2], kep[3]};
                *(LAS v4u*)(IMGE + d * 144 + (16 * tq + 8) * 2) = (v4u){kep[4], kep[5], kep[6], kep[7]};
                if (tq == 0) ((GAS float*)((unsigned char*)a.out + OUT_GT_DEC))[idir * 128 + d] = __expf(Bt);
            }
            __syncthreads();
            if (w < 4) {
                const int si = w >> 1, ti = w & 1; f32x16 acc = (f32x16){0.f, 0.f, 0.f, 0.f, 0.f, 0.f, 0.f, 0.f, 0.f, 0.f, 0.f, 0.f, 0.f, 0.f, 0.f, 0.f};
#pragma unroll
                for (int ks = 0; ks < 8; ++ks) { const bf16x8 ak = *(const LAS bf16x8*)(IMGK + (32 * si + r32) * 272 + (16 * ks + 8 * hh) * 2), bq = *(const LAS bf16x8*)(IMGQ + (32 * ti + r32) * 272 + (16 * ks + 8 * hh) * 2);
                    acc = __builtin_amdgcn_mfma_f32_32x32x16_bf16(ak, bq, acc, 0, 0, 0); }
                const int t = 32 * ti + r32;
#pragma unroll
                for (int qd = 0; qd < 4; ++qd) { float v4[4];
#pragma unroll
                    for (int i = 0; i < 4; ++i) { const int sidx = 32 * si + 8 * qd + 4 * hh + i; const float x = acc[4 * qd + i]; const bool keep = dir == 0 ? (sidx <= t) : (sidx >= t); v4[i] = keep ? x : 0.f; }
                    *(LAS unsigned long long*)(AMI + t * 144 + (32 * si + 8 * qd + 4 * hh) * 2) = (unsigned long long)pk2(v4[0], v4[1]) | ((unsigned long long)pk2(v4[2], v4[3]) << 32); }
            } else {
                const int w4 = w - 4;
#pragma unroll
                for (int q = 0; q < 4; ++q) { const int bq = w4 * 4 + q, tt = bq >> 3, ks = bq & 7, j = ks >> 1, u = ks & 1; const int t = 32 * tt + r32;
                    const unsigned long long p0 = *(const LAS unsigned long long*)(IMGQ + t * 272 + (32 * j + 16 * u + 4 * hh) * 2), p1 = *(const LAS unsigned long long*)(IMGQ + t * 272 + (32 * j + 16 * u + 8 + 4 * hh) * 2);
                    *(GAS v4u*)(ws + WS_GT_QD + idir * 16384 + bq * 1024 + lane * 16) = (v4u){(unsigned)p0, (unsigned)(p0 >> 32), (unsigned)p1, (unsigned)(p1 >> 32)}; }
#pragma unroll
                for (int q = 0; q < 4; ++q) { const int bk = w4 * 4 + q, j = bk >> 2, ks = bk & 3; const int d = 32 * j + r32;
                    *(GAS v4u*)(ws + WS_GT_KE + idir * 16384 + bk * 1024 + lane * 16) = *(const LAS v4u*)(IMGE + d * 144 + (16 * ks + 8 * hh) * 2); }
            }
            __syncthreads();
            { const int tt = w >> 2, ks = w & 3; const int t = 32 * tt + r32;
              *(GAS v4u*)((unsigned char*)a.out + OUT_GT_AM + idir * 8192 + w * 1024 + lane * 16) = *(const LAS v4u*)(AMI + t * 144 + (16 * ks + 8 * hh) * 2); }
            __syncthreads();
        }
    }
}

__device__ __forceinline__ void gla_seq_phase(Frame& F, const Args& a) {
    unsigned char* ws = a.ws;
    const int w = F.wave;
    constexpr int GBUF = 57856;
    for (int unit = F.vcu; unit < 64; unit += F.G) {
        const int dir = unit & 1, eh = (unit >> 1) & 1, bh = unit >> 2, b = bh >> 2, h = bh & 3;
        if (w >= 4) {
            const int lt = opaque_v(F.tid) - 256;
            v4u A[15], B[15];
#define GLA_LOAD(R, NS) do { const int n_ = dir ? 63 - (NS) : (NS); const size_t idir_ = (size_t)((bh * 2 + dir) * 64 + n_), iv_ = (size_t)(bh * 64 + n_); const unsigned char* o_ = opaque((const unsigned char*)a.out); const unsigned char* w_ = opaque(ws); \
            const GAS v4u* gq_ = (const GAS v4u*)(w_ + WS_GT_QD + idir_ * 16384); const GAS v4u* gk_ = (const GAS v4u*)(w_ + WS_GT_KE + idir_ * 16384); const GAS v4u* ga_ = (const GAS v4u*)(o_ + OUT_GT_AM + idir_ * 8192); \
            const GAS v4u* gv_ = (const GAS v4u*)(o_ + OUT_GT_VT + iv_ * 32768 + eh * 16384); const GAS v4u* gd_ = (const GAS v4u*)(o_ + OUT_GT_DEC + idir_ * 512); \
            _Pragma("unroll") for (int i = 0; i < 4; ++i) { R[i] = gq_[lt + 256 * i]; R[4 + i] = gk_[lt + 256 * i]; R[10 + i] = gv_[lt + 256 * i]; } R[8] = ga_[lt]; R[9] = ga_[lt + 256]; R[14] = gd_[lt & 31]; } while (0)
#define GLA_WRITE(R, BUF) do { LAS v4u* d_ = (LAS v4u*)(F.lds + (BUF) * GBUF); \
            _Pragma("unroll") for (int i = 0; i < 4; ++i) { d_[lt + 256 * i] = R[i]; d_[1024 + lt + 256 * i] = R[4 + i]; d_[2560 + lt + 256 * i] = R[10 + i]; } d_[2048 + lt] = R[8]; d_[2048 + lt + 256] = R[9]; if (lt < 32) d_[3584 + lt] = R[14]; } while (0)
            GLA_LOAD(A, 0); GLA_LOAD(B, 1);
            GLA_WRITE(A, 0);
            __syncthreads();
#pragma unroll 1
            for (int ns = 0; ns < 64; ns += 2) {
                if (ns + 2 < 64) GLA_LOAD(A, ns + 2);
                GLA_WRITE(B, 1);
                __syncthreads();
                if (ns + 3 < 64) GLA_LOAD(B, ns + 3);
                if (ns + 2 < 64) GLA_WRITE(A, 0);
                __syncthreads();
            }
#undef GLA_LOAD
#undef GLA_WRITE
        } else {
            f32x16 S[4];
#pragma unroll
            for (int j = 0; j < 4; ++j) S[j] = (f32x16){0.f, 0.f, 0.f, 0.f, 0.f, 0.f, 0.f, 0.f, 0.f, 0.f, 0.f, 0.f, 0.f, 0.f, 0.f, 0.f};
            __syncthreads();
#pragma unroll 1
            for (int ns = 0; ns < 64; ++ns) {
                const int n = dir ? 63 - ns : ns;
                const int lane = opaque_v(F.lane), r32 = lane & 31, hh = lane >> 5;
                LAS unsigned char* QDl = F.lds + (ns & 1) * GBUF; LAS unsigned char* KEl = QDl + 16384; LAS unsigned char* AMl = QDl + 32768; LAS unsigned char* VTl = QDl + 40960; LAS float* DECl = (LAS float*)(QDl + 57344);
                GAS bf16* Out = (GAS bf16*)(opaque(ws) + (dir ? WS_OB : WS_OF));
                bf16x8 vf[4];
#pragma unroll
                for (int ks = 0; ks < 4; ++ks) vf[ks] = *(const LAS bf16x8*)(VTl + (w * 4 + ks) * 1024 + lane * 16);
                f32x16 o[2];
#pragma unroll
                for (int tt = 0; tt < 2; ++tt) o[tt] = (f32x16){0.f, 0.f, 0.f, 0.f, 0.f, 0.f, 0.f, 0.f, 0.f, 0.f, 0.f, 0.f, 0.f, 0.f, 0.f, 0.f};
#pragma unroll
                for (int ks8 = 0; ks8 < 8; ++ks8) { const int j = ks8 >> 1, u = ks8 & 1; v4u sb;
                    sb.x = pg8::cvt_pk_bf16(S[j][8 * u + 0], S[j][8 * u + 1]); sb.y = pg8::cvt_pk_bf16(S[j][8 * u + 2], S[j][8 * u + 3]); sb.z = pg8::cvt_pk_bf16(S[j][8 * u + 4], S[j][8 * u + 5]); sb.w = pg8::cvt_pk_bf16(S[j][8 * u + 6], S[j][8 * u + 7]);
                    const bf16x8 bs = __builtin_bit_cast(bf16x8, sb);
#pragma unroll
                    for (int tt = 0; tt < 2; ++tt) { const bf16x8 aq = *(const LAS bf16x8*)(QDl + (tt * 8 + ks8) * 1024 + lane * 16); o[tt] = __builtin_amdgcn_mfma_f32_32x32x16_bf16(aq, bs, o[tt], 0, 0, 0); } }
#pragma unroll
                for (int ks = 0; ks < 4; ++ks)
#pragma unroll
                    for (int tt = 0; tt < 2; ++tt) { const bf16x8 am = *(const LAS bf16x8*)(AMl + (tt * 4 + ks) * 1024 + lane * 16); o[tt] = __builtin_amdgcn_mfma_f32_32x32x16_bf16(am, vf[ks], o[tt], 0, 0, 0); }
#pragma unroll
                for (int tt = 0; tt < 2; ++tt)
#pragma unroll
                    for (int r = 0; r < 16; ++r) { const int t = 32 * tt + (r & 3) + 8 * (r >> 2) + 4 * hh; const float x = o[tt][r];
                        Out[((size_t)b * SEQ + 64 * n + t) * 1024 + h * 256 + 32 * (eh * 4 + w) + r32] = (bf16)pk2(x, 0.f); }
#pragma unroll
                for (int j = 0; j < 4; ++j) {
#pragma unroll
                    for (int q = 0; q < 4; ++q) { const f32x4 dv = *(const LAS f32x4*)(DECl + 32 * j + 8 * q + 4 * hh); S[j][4 * q + 0] *= dv.x; S[j][4 * q + 1] *= dv.y; S[j][4 * q + 2] *= dv.z; S[j][4 * q + 3] *= dv.w; }
#pragma unroll
                    for (int ks = 0; ks < 4; ++ks) { const bf16x8 ak = *(const LAS bf16x8*)(KEl + (j * 4 + ks) * 1024 + lane * 16); S[j] = __builtin_amdgcn_mfma_f32_32x32x16_bf16(ak, vf[ks], S[j], 0, 0, 0); } }
                __syncthreads();
            }
        }
    }
}

typedef short v4i16_t __attribute__((ext_vector_type(4)));
__device__ __forceinline__ void attn_phase(Frame& F, const Args& a, int qslot) {
    unsigned char* ws = a.ws; const bf16* PROJ;
    const int w = F.wave;
    LAS unsigned char* Kl = F.lds; LAS unsigned char* Vl = F.lds + 39168; volatile LAS int* uword = (volatile LAS int*)(F.lds + 78336);
    constexpr int NUNITS = 64 * 3 * 32;
#define ATT_DECODE(U) const int bh = (U) / 96, rem = (U) - bh * 96, p = rem >> 5, idx = rem & 31; const int lgd = 2 * p, d = 1 << lgd; \
        const int r = idx >> (5 - lgd), J = idx & ((32 >> lgd) - 1), Lc = SEQ >> lgd; const int b = bh >> 4, h = bh & 15; const int m0 = 128 * J - 64;
    v4u kx[4], vx[4]; v4u qw[2];
#define ATT_LOAD(U) do { ATT_DECODE(U) ws = opaque(ws); PROJ = (const bf16*)(ws + WS_PROJ); const int tid_ = opaque_v(F.tid); \
        _Pragma("unroll") for (int i = 0; i < 4; ++i) { const int kr = (tid_ >> 3) + 64 * i, ch = tid_ & 7; const int mp = m0 + kr; kx[i] = (v4u){0u, 0u, 0u, 0u}; vx[i] = kx[i]; \
            if (mp >= 0 && mp < Lc) { const bf16* src = PROJ + ((size_t)b * SEQ + r + d * mp) * NINP + O_AK + h * 64 + ch * 8; kx[i] = *(const GAS v4u*)src; vx[i] = *(const GAS v4u*)(src + (O_AV - O_AK)); } } \
        const int tokq_ = r + d * (128 * J + 16 * w + (tid_ & 15)); \
        _Pragma("unroll") for (int sft = 0; sft < 2; ++sft) qw[sft] = *(const GAS v4u*)(PROJ + ((size_t)b * SEQ + tokq_) * NINP + O_AQ + h * 64 + 32 * sft + 8 * ((tid_ & 63) >> 4)); } while (0)
    float tab[40];
    { const int l0 = opaque_v(F.lane);
#pragma unroll
      for (int c = 0; c < 40; ++c) { const int kb = c >> 3, uu = (c >> 2) & 1, rho = c & 3; const int jo = 32 * kb + 8 * (l0 >> 4) + 4 * uu + rho - 64 - (l0 & 15); const int aj = jo < 0 ? -jo : jo; tab[c] = aj <= 64 ? (float)aj : 3.0e38f; } }
    if (F.tid == 0) { uword[0] = (int)__hip_atomic_fetch_add((unsigned*)(F.ctl + CW_ATTQ + 64 * qslot), 1u, __ATOMIC_RELAXED, __HIP_MEMORY_SCOPE_AGENT); uword[1] = (int)__hip_atomic_fetch_add((unsigned*)(F.ctl + CW_ATTQ + 64 * qslot), 1u, __ATOMIC_RELAXED, __HIP_MEMORY_SCOPE_AGENT); }
    __syncthreads();
    int u = __builtin_amdgcn_readfirstlane(uword[0]), un = __builtin_amdgcn_readfirstlane(uword[1]); int par = 0;
    if (u < NUNITS) ATT_LOAD(u);
    while (u < NUNITS) {
        const int tid = opaque_v(F.tid), lane = tid & 63, q16 = lane & 15, g = lane >> 4;
        int qnext = 0; if (tid == 0) qnext = (int)__hip_atomic_fetch_add((unsigned*)(F.ctl + CW_ATTQ + 64 * qslot), 1u, __ATOMIC_RELAXED, __HIP_MEMORY_SCOPE_AGENT);
#pragma unroll
        for (int i = 0; i < 4; ++i) { const int kr = (tid >> 3) + 64 * i, ch = tid & 7; *(LAS v4u*)(Kl + kr * 144 + ch * 16) = kx[i]; *(LAS v4u*)(Vl + kr * 144 + ch * 16) = vx[i]; }
        if (tid < 128) { const int kr = 256 + (tid >> 3), ch = tid & 7; *(LAS v4u*)(Kl + kr * 144 + ch * 16) = (v4u){0u, 0u, 0u, 0u}; *(LAS v4u*)(Vl + kr * 144 + ch * 16) = (v4u){0u, 0u, 0u, 0u}; }
        bf16x8 qf[2];
#pragma unroll
        for (int sft = 0; sft < 2; ++sft) { v4u qs; constexpr float QS = 0.125f * 1.4426950408889634f; qs.x = pk2(bflo(qw[sft].x) * QS, bfhi(qw[sft].x) * QS); qs.y = pk2(bflo(qw[sft].y) * QS, bfhi(qw[sft].y) * QS); qs.z = pk2(bflo(qw[sft].z) * QS, bfhi(qw[sft].z) * QS); qs.w = pk2(bflo(qw[sft].w) * QS, bfhi(qw[sft].w) * QS);
            qf[sft] = __builtin_bit_cast(bf16x8, qs); }
        ATT_DECODE(u)
        const int tokq = r + d * (128 * J + 16 * w + q16);
        __syncthreads();
        if (un < NUNITS) ATT_LOAD(un);
        const float nslope = -exp2f(-0.5f * (float)(h + 1)) * (float)d * 1.4426950408889634f;
        const bool inrange = (m0 + 16 * w >= 0) && (m0 + 16 * w + 159 < Lc);
        float sv[5][2][4]; float mx = -3.0e38f;
#pragma unroll
        for (int kb = 0; kb < 5; ++kb)
#pragma unroll
            for (int uu = 0; uu < 2; ++uu) { f32x4 acc = (f32x4){0.f, 0.f, 0.f, 0.f};
                const int krow = 16 * w + 32 * kb + 8 * (q16 >> 2) + 4 * uu + (q16 & 3);
#pragma unroll
                for (int sft = 0; sft < 2; ++sft) { const bf16x8 ak = *(const LAS bf16x8*)(Kl + krow * 144 + (32 * sft + 8 * g) * 2); acc = __builtin_amdgcn_mfma_f32_16x16x32_bf16(ak, qf[sft], acc, 0, 0, 0); }
#pragma unroll
                for (int rho = 0; rho < 4; ++rho) { const float x = acc[rho]; sv[kb][uu][rho] = __builtin_fmaf(nslope, tab[kb * 8 + uu * 4 + rho], x); } }
        if (!inrange) {
#pragma unroll
            for (int kb = 0; kb < 5; ++kb)
#pragma unroll
                for (int uu = 0; uu < 2; ++uu)
#pragma unroll
                    for (int rho = 0; rho < 4; ++rho) { const int mp = m0 + 16 * w + 32 * kb + 8 * g + 4 * uu + rho; if (mp < 0 || mp >= Lc) sv[kb][uu][rho] = -3.0e38f; } }
#pragma unroll
        for (int kb = 0; kb < 5; ++kb)
#pragma unroll
            for (int uu = 0; uu < 2; ++uu)
#pragma unroll
                for (int rho = 0; rho < 4; ++rho) mx = fmaxf(mx, sv[kb][uu][rho]);
        mx = fmaxf(mx, __shfl_xor(mx, 16)); mx = fmaxf(mx, __shfl_xor(mx, 32));
        float lsum = 0.f; bf16x8 pf[5];
#pragma unroll
        for (int kb = 0; kb < 5; ++kb) { float e[8];
#pragma unroll
            for (int uu = 0; uu < 2; ++uu)
#pragma unroll
                for (int rho = 0; rho < 4; ++rho) { const float pe = __builtin_amdgcn_exp2f(sv[kb][uu][rho] - mx); e[uu * 4 + rho] = pe; lsum += pe; }
            v4u pw; pw.x = pk2(e[0], e[1]); pw.y = pk2(e[2], e[3]); pw.z = pk2(e[4], e[5]); pw.w = pk2(e[6], e[7]); pf[kb] = __builtin_bit_cast(bf16x8, pw); }
        lsum += __shfl_xor(lsum, 16); lsum += __shfl_xor(lsum, 32);
        f32x4 oT[4];
#pragma unroll
        for (int nn = 0; nn < 4; ++nn) oT[nn] = (f32x4){0.f, 0.f, 0.f, 0.f};
#pragma unroll
        for (int kb = 0; kb < 5; ++kb)
#pragma unroll
            for (int nn = 0; nn < 4; ++nn) { const LAS unsigned char* va = Vl + (16 * w + 32 * kb + 8 * g + (q16 >> 2)) * 144 + (16 * nn + 4 * (q16 & 3)) * 2;
                const v4i16_t lo = __builtin_amdgcn_ds_read_tr16_b64_v4i16((LAS v4i16_t*)va), hi = __builtin_amdgcn_ds_read_tr16_b64_v4i16((LAS v4i16_t*)(va + 4 * 144));
                const bf16x8 vf = (bf16x8){lo[0], lo[1], lo[2], lo[3], hi[0], hi[1], hi[2], hi[3]};
                oT[nn] = __builtin_amdgcn_mfma_f32_16x16x32_bf16(vf, pf[kb], oT[nn], 0, 0, 0); }
        { const size_t rec = ((size_t)p * M + (size_t)b * SEQ + tokq) * 16 + h; GAS bf16* op = (GAS bf16*)(opaque(ws) + WS_ATTP) + rec * 64 + 4 * g;
#pragma unroll
          for (int nn = 0; nn < 4; ++nn) *(GAS unsigned long long*)(op + 16 * nn) = (unsigned long long)pk2(oT[nn][0], oT[nn][1]) | ((unsigned long long)pk2(oT[nn][2], oT[nn][3]) << 32);
          if (g == 0) { GAS float* ml = (GAS float*)(opaque(ws) + WS_ATTML) + rec * 2; ml[0] = mx * 0.6931471805599453f; ml[1] = lsum; } }
        if (tid == 0) uword[par] = qnext;
        __syncthreads();
        u = un; un = __builtin_amdgcn_readfirstlane(uword[par]); par ^= 1;
    }
#undef ATT_DECODE
#undef ATT_LOAD
}

typedef __bf16 bf16x2_t __attribute__((ext_vector_type(2)));
typedef int i32x4 __attribute__((ext_vector_type(4)));
__device__ __forceinline__ void peer_convert_tables(Frame& F, const Args& a, int qslot) {
    unsigned char* ws = a.ws; const int lane = F.lane; volatile LAS int* uword = (volatile LAS int*)(F.lds + 78336 + 64);
    for (;;) {
        __syncthreads();
        if (F.tid == 0) uword[0] = (int)__hip_atomic_fetch_add((unsigned*)(F.ctl + CW_CONVQ + 64 * qslot), 1u, __ATOMIC_RELAXED, __HIP_MEMORY_SCOPE_AGENT);
        __syncthreads();
        const int blk = __builtin_amdgcn_readfirstlane(uword[0]);
        if (blk >= 2 * PEER_E / 64) break;
#pragma unroll 1
        for (int i = 0; i < 8; ++i) { const int r = blk * 64 + F.wave * 8 + i;
            const int e = r & (PEER_E - 1); const bool isv = r >= PEER_E;
            const float* src = (isv ? a.in[14] : a.in[13]) + (size_t)e * DM;
            unsigned char* dst = (unsigned char*)a.out + (isv ? OUT_V8 : OUT_U8) + (size_t)e * DM; float* sc = (float*)(ws + (isv ? WS_SV : WS_SU));
            f32x4 v[8]; float am = 0.f;
#pragma unroll
            for (int j = 0; j < 8; ++j) { v[j] = *(const f32x4*)(src + 256 * j + 4 * lane); am = fmaxf(am, fmaxf(fmaxf(fabsf(v[j].x), fabsf(v[j].y)), fmaxf(fabsf(v[j].z), fabsf(v[j].w)))); }
            am = wave_max(am); am = fmaxf(am, 1e-30f);
            const float inv = 440.f / am;
#pragma unroll
            for (int j = 0; j < 8; ++j) { int p = __builtin_amdgcn_cvt_pk_fp8_f32(v[j].x * inv, v[j].y * inv, 0, false); p = __builtin_amdgcn_cvt_pk_fp8_f32(v[j].z * inv, v[j].w * inv, p, true);
                *(int*)(dst + 256 * j + 4 * lane) = p; }
            if (lane == 0) sc[e] = am * (1.f / 440.f); }
    }
}

__device__ __forceinline__ float dpp_row_sum(float x) {
#define PEER_DPP(ctrl) x += __builtin_bit_cast(float, __builtin_amdgcn_update_dpp(0, __builtin_bit_cast(int, x), ctrl, 0xF, 0xF, false))
    PEER_DPP(0xB1); PEER_DPP(0x4E); PEER_DPP(0x141); PEER_DPP(0x140);
#undef PEER_DPP
    return x;
}
template <bool VPH, int PBS> __device__ __forceinline__ void peer_uv_phase(Frame& F, const Args& a) {
    unsigned char* ws = a.ws; GAS bf16* H = (GAS bf16*)(ws + WS_HB); const GAS float* g2 = (const GAS float*)a.in[10];
    const int sl = blockIdx.x & 7, rk = blockIdx.x >> 3, nrk = F.G >> 3, tpw = M / nrk / NWAVES, nq = tpw / 4;
    const unsigned char* TAB; const GAS int* EIDX; const GAS float* SSQ; const GAS float* PW; GAS float* PD; GAS float* SSQ2;
    LAS int* idt = (LAS int*)(F.lds + F.wave * 8192);
    LAS float* wt = (LAS float*)(F.lds + F.wave * 8192 + 4096);
    const int t0 = (rk * NWAVES + F.wave) * tpw;
#define PEER_STAGE(QI) do { const size_t tb_ = (size_t)(t0 + 4 * (QI) + a4) * 128; const int bf_ = ((QI) & 1) * 512; _Pragma("unroll") for (int k = 0; k < 8; ++k) { \
        idt[bf_ + (16 * k + q) * 4 + a4] = EIDX[tb_ + 16 * k + q]; if (VPH) wt[bf_ + (16 * k + q) * 4 + a4] = PW[tb_ + 16 * k + q]; } } while (0)
#define PEER_ISSUE(R, QI, WB) do { const int bf_ = ((QI) & 1) * 512 + (WB) * (4 * PBS) + a4; _Pragma("unroll") for (int j = 0; j < PBS; ++j) { const int e_ = idt[bf_ + 4 * j]; R[j] = ldu<i32x4>(TAB, (unsigned)e_ * 2048u + (unsigned)(16 * q)); } } while (0)
    unsigned xq[8]; float acc[16];
#define PEER_QUAD_BEGIN(QI) do { const size_t t_ = (size_t)(t0 + 4 * (QI) + a4); \
        if (!VPH) { f32x4 hq[4]; { const v4u h0_ = *(const GAS v4u*)(H + t_ * DM + 256 * sl + 16 * q), h1_ = *(const GAS v4u*)(H + t_ * DM + 256 * sl + 16 * q + 8); \
            hq[0] = (f32x4){bflo(h0_.x), bfhi(h0_.x), bflo(h0_.y), bfhi(h0_.y)}; hq[1] = (f32x4){bflo(h0_.z), bfhi(h0_.z), bflo(h0_.w), bfhi(h0_.w)}; hq[2] = (f32x4){bflo(h1_.x), bfhi(h1_.x), bflo(h1_.y), bfhi(h1_.y)}; hq[3] = (f32x4){bflo(h1_.z), bfhi(h1_.z), bflo(h1_.w), bfhi(h1_.w)}; }  const float pss_ = dpp_row_sum(SSQ[t_ * 32 + q] + SSQ[t_ * 32 + 16 + q]); const float rstd_ = 1.f / sqrtf(pss_ * (1.f / DM) + EPS); f32x4 gv[4]; \
            _Pragma("unroll") for (int k = 0; k < 4; ++k) gv[k] = *(const GAS f32x4*)(g2 + 256 * sl + 16 * q + 4 * k); \
            _Pragma("unroll") for (int k = 0; k < 4; ++k) { xq[2 * k] = pk2(hq[k].x * rstd_ * gv[k].x, hq[k].y * rstd_ * gv[k].y); xq[2 * k + 1] = pk2(hq[k].z * rstd_ * gv[k].z, hq[k].w * rstd_ * gv[k].w); } } \
        else { _Pragma("unroll") for (int k = 0; k < 16; ++k) acc[k] = 0.f; } } while (0)
#define PEER_COMPUTE(R, QI, WB) do { if (!VPH) { float pdb_ = 0.f; _Pragma("unroll") for (int j = 0; j < PBS; ++j) { float d_ = 0.f; _Pragma("unroll") for (int k = 0; k < 4; ++k) { const int dw_ = R[j][k]; \
                d_ = __builtin_amdgcn_fdot2_f32_bf16(__builtin_amdgcn_cvt_scalef32_pk_bf16_fp8(dw_, 1.0f, false), __builtin_bit_cast(bf16x2_t, xq[2 * k]), d_, false); \
                d_ = __builtin_amdgcn_fdot2_f32_bf16(__builtin_amdgcn_cvt_scalef32_pk_bf16_fp8(dw_, 1.0f, true), __builtin_bit_cast(bf16x2_t, xq[2 * k + 1]), d_, false); } \
                d_ = dpp_row_sum(d_); pdb_ = (q == j) ? d_ : pdb_; } \
            if (q < PBS) PD[((size_t)(t0 + 4 * (QI) + a4) * 8 + sl) * 128 + PBS * (WB) + q] = pdb_; } \
        else { const int bf_ = ((QI) & 1) * 512 + (WB) * (4 * PBS) + a4; _Pragma("unroll") for (int j = 0; j < PBS; ++j) { const float w_ = wt[bf_ + 4 * j]; int r0_ = R[j][0], r1_ = R[j][1], r2_ = R[j][2], r3_ = R[j][3]; asm volatile("" : "+v"(r0_), "+v"(r1_), "+v"(r2_), "+v"(r3_));     \
                _Pragma("unroll") for (int k = 0; k < 4; ++k) { const int dw_ = k == 0 ? r0_ : k == 1 ? r1_ : k == 2 ? r2_ : r3_; \
                const f32x2 lo_ = __builtin_amdgcn_cvt_pk_f32_fp8(dw_, false), hi_ = __builtin_amdgcn_cvt_pk_f32_fp8(dw_, true); \
                acc[4 * k + 0] += w_ * lo_.x; acc[4 * k + 1] += w_ * lo_.y; acc[4 * k + 2] += w_ * hi_.x; acc[4 * k + 3] += w_ * hi_.y; } } } } while (0)
#define PEER_QUAD_END(QI) do { if (VPH) { const size_t t_ = (size_t)(t0 + 4 * (QI) + a4); GAS bf16* hp_ = H + t_ * DM + 256 * sl + 16 * q; const v4u h0_ = *(const GAS v4u*)hp_, h1_ = *(const GAS v4u*)(hp_ + 8); \
            float y_[16]; y_[0] = bflo(h0_.x); y_[1] = bfhi(h0_.x); y_[2] = bflo(h0_.y); y_[3] = bfhi(h0_.y); y_[4] = bflo(h0_.z); y_[5] = bfhi(h0_.z); y_[6] = bflo(h0_.w); y_[7] = bfhi(h0_.w); \
            y_[8] = bflo(h1_.x); y_[9] = bfhi(h1_.x); y_[10] = bflo(h1_.y); y_[11] = bfhi(h1_.y); y_[12] = bflo(h1_.z); y_[13] = bfhi(h1_.z); y_[14] = bflo(h1_.w); y_[15] = bfhi(h1_.w); \
            float ss_ = 0.f; _Pragma("unroll") for (int k = 0; k < 16; ++k) { y_[k] += acc[k]; ss_ += y_[k] * y_[k]; } \
            *(GAS v4u*)hp_ = (v4u){pk2(y_[0], y_[1]), pk2(y_[2], y_[3]), pk2(y_[4], y_[5]), pk2(y_[6], y_[7])}; *(GAS v4u*)(hp_ + 8) = (v4u){pk2(y_[8], y_[9]), pk2(y_[10], y_[11]), pk2(y_[12], y_[13]), pk2(y_[14], y_[15])}; \
            ss_ = dpp_row_sum(ss_); if (q == 0) SSQ2[t_ * 8 + sl] = ss_; } } while (0)
#pragma unroll 1
    for (int qi = 0; qi < nq; ++qi) {
        i32x4 rA[PBS], rB[PBS];
        const int lane = opaque_v(F.lane), a4 = lane >> 4, q = lane & 15; ws = opaque(ws); H = (GAS bf16*)(ws + WS_HB);
        TAB = opaque((const unsigned char*)a.out) + (VPH ? OUT_V8 : OUT_U8) + 256 * sl; EIDX = (const GAS int*)(ws + WS_EIDX); SSQ = (const GAS float*)(ws + WS_SSQ); PW = (const GAS float*)(ws + WS_PW); PD = (GAS float*)(ws + WS_PD); SSQ2 = (GAS float*)(ws + WS_SSQ2);
        PEER_STAGE(qi); LDS_WAIT(); asm volatile("" ::: "memory");
        PEER_ISSUE(rA, qi, 0);
        PEER_ISSUE(rB, qi, 1);
        PEER_QUAD_BEGIN(qi);
#pragma unroll
        for (int wb = 0; wb < 128 / PBS; wb += 2) {
            PEER_COMPUTE(rA, qi, wb); if (wb + 2 < 128 / PBS) { PEER_ISSUE(rA, qi, wb + 2); }
            PEER_COMPUTE(rB, qi, wb + 1); if (wb + 3 < 128 / PBS) { PEER_ISSUE(rB, qi, wb + 3); }
        }
        PEER_QUAD_END(qi);
    }
#undef PEER_STAGE
#undef PEER_ISSUE
#undef PEER_QUAD_BEGIN
#undef PEER_COMPUTE
#undef PEER_QUAD_END
}
__device__ __forceinline__ void peer_w_phase(Frame& F, const Args& a) {
    unsigned char* ws = a.ws; const float* PD = (const float*)(ws + WS_PD); const int* EIDX = (const int*)(ws + WS_EIDX); const float* GATE = (const float*)(ws + WS_GATE);
    const float* SU = (const float*)(ws + WS_SU); const float* SV = (const float*)(ws + WS_SV); float* PW = (float*)(ws + WS_PW);
    for (int i = F.vcu * 512 + F.tid; i < M * 128; i += F.G * 512) { const int t = i >> 7, p = i & 127; float d = 0.f;
#pragma unroll
        for (int sl = 0; sl < 8; ++sl) d += PD[((size_t)t * 8 + sl) * 128 + p];
        const int e = EIDX[i]; d *= SU[e];
        PW[i] = GATE[i] * 0.5f * d * (1.f + erff(d * 0.70710678118654752f)) * SV[e]; }
}
__device__ __forceinline__ void peer_n_phase(Frame& F, const Args& a) {
    unsigned char* ws = a.ws; const bf16* Y = (const bf16*)(ws + WS_HB); float* O = a.out; const float* gf = a.in[15]; const float* SSQ2 = (const float*)(ws + WS_SSQ2); const int lane = F.lane;
    for (int m = F.vcu * NWAVES + F.wave; m < M; m += F.G * NWAVES) {
        const f32x4 s0 = *(const f32x4*)(SSQ2 + (size_t)m * 8), s1 = *(const f32x4*)(SSQ2 + (size_t)m * 8 + 4);
        const float rf = 1.f / sqrtf((((s0.x + s0.y) + (s0.z + s0.w)) + ((s1.x + s1.y) + (s1.z + s1.w))) * (1.f / DM) + EPS);
#pragma unroll
        for (int j = 0; j < 4; ++j) { const v4u yw = *(const v4u*)(Y + (size_t)m * DM + 512 * j + 8 * lane); const f32x4 g0 = *(const f32x4*)(gf + 512 * j + 8 * lane), g1 = *(const f32x4*)(gf + 512 * j + 8 * lane + 4);
            *(f32x4*)(O + (size_t)m * DM + 512 * j + 8 * lane) = (f32x4){bflo(yw.x) * rf * g0.x, bfhi(yw.x) * rf * g0.y, bflo(yw.y) * rf * g0.z, bfhi(yw.y) * rf * g0.w};
            *(f32x4*)(O + (size_t)m * DM + 512 * j + 8 * lane + 4) = (f32x4){bflo(yw.z) * rf * g1.x, bfhi(yw.z) * rf * g1.y, bflo(yw.w) * rf * g1.z, bfhi(yw.w) * rf * g1.w}; }
    }
}

__global__ void __launch_bounds__(NWAVES * 64, 2) mk_fwd(Args args_in) {
    extern __shared__ __attribute__((aligned(16))) unsigned char lds[];
    Args args = args_in;
#pragma unroll
    for (int i = 0; i < 16; ++i) args.in[i] = (const float*)(const GAS float*)args_in.in[i];
    args.out = (float*)(GAS float*)args_in.out; args.ws = (unsigned char*)(GAS unsigned char*)args_in.ws;
    Frame F;
    F.lds = (LAS unsigned char*)lds;
    F.MISC = (volatile LAS unsigned*)(F.lds + MISC_OFF);
    F.tid = threadIdx.x; F.lane = F.tid & 63; F.wave = __builtin_amdgcn_readfirstlane(F.tid >> 6);
    F.G = gridDim.x; { const int bx = blockIdx.x; F.vcu = (F.G % 8 == 0) ? (bx % 8) * (F.G / 8) + bx / 8 : bx; }
    unsigned char* ws = args.ws;
    F.ctl = (gu32*)(ws + WS_CTL);
    for (int u = F.tid; u < (LDS_BYTES - LDSCTL_OFF) / 4; u += NWAVES * 64) ((LAS unsigned*)(F.lds + LDSCTL_OFF))[u] = 0u;
    __syncthreads();
    XcdBarrier bar = xcd_barrier_post((unsigned*)(F.ctl + CW_BAR) + args.li * XCD_BAR_WORDS, F.MISC + 8);
    const int lo = args.ph_lo, hi = args.ph_hi;
#define IN(k) (lo <= (k) && (k) < hi)
#define BOTH(k) (IN(k) && IN((k) + 1))
#define GRID_BAR() xcd_barrier(bar)

    if (IN(0)) { for (int rep = 0; rep < NREP(0); ++rep) p0_prologue(F, args); if (BOTH(0)) GRID_BAR(); }

    if (IN(1)) {
        pg8::Gemm g{(const bf16*)(ws + WS_XN), (const bf16*)(ws + WS_WIN), M, NINP, DM}; pg8::StaticOrder S; S.init(M, NINP, F.G, (int)blockIdx.x);
        pg8::EpiBf16<0> E{(bf16*)(ws + WS_PROJ), NINP, nullptr, 0, 0, 1.f};
        for (int rep = 0; rep < NREP(1); ++rep) pg8::gemm_phase<pg8::EpiBf16<0>, pg8::StaticOrder, PG8_ALIGN, PG8_SP2>(F.lds + RING_OFF, g, S, E);
        for (int rep = 0; rep < NREP(11); ++rep) gd_side_gemm(F, args);
        if (BOTH(1)) GRID_BAR();
    }
    if (IN(2)) {
        for (int rep = 0; rep < NREP(21); ++rep) gla_prep_phase(F, args);
        GRID_BAR();
        for (int rep = 0; rep < NREP(2); ++rep) gla_seq_phase(F, args);
        for (int rep = 0; rep < NREP(20); ++rep) attn_phase(F, args, rep);
        for (int rep = 0; rep < NREP(40); ++rep) peer_convert_tables(F, args, rep);
        if (BOTH(2)) GRID_BAR(); }
    if (IN(3)) { for (int rep = 0; rep < NREP(3); ++rep) p3_finalize(F, args); if (BOTH(3)) GRID_BAR(); }
    if (IN(4)) {
        pg8::Gemm g{(const bf16*)(ws + WS_XN), (const bf16*)(ws + WS_WOUT), M, DM, DM}; pg8::StaticOrder S; S.init(M, DM, F.G, (int)blockIdx.x);
        pg8::EpiRes E{args.in[0], (bf16*)(ws + WS_HB), (float*)(ws + WS_SSQ), DM};
        for (int rep = 0; rep < NREP(4); ++rep) pg8::gemm_phase<pg8::EpiRes, pg8::StaticOrder, PG8_ALIGN, PG8_SP2>(F.lds + RING_OFF, g, S, E);
        if (BOTH(4)) GRID_BAR();
    }
    if (IN(5)) {
        pg8::Gemm g{(const bf16*)(ws + WS_HB), (const bf16*)(ws + WS_WQ), M, DM, DM}; pg8::StaticOrder S; S.init(M, DM, F.G, (int)blockIdx.x);
        pg8::EpiRowScale E{(bf16*)(ws + WS_XN), DM, (const float*)(ws + WS_SSQ), 1.f / DM, EPS};
        for (int rep = 0; rep < NREP(5); ++rep) pg8::gemm_phase<pg8::EpiRowScale, pg8::StaticOrder, PG8_ALIGN, PG8_SP2>(F.lds + RING_OFF, g, S, E);
        if (BOTH(5)) GRID_BAR();
    }
    if (IN(6)) { for (int rep = 0; rep < NREP(6); ++rep) topk_phase(F, args); if (BOTH(6)) GRID_BAR(); }
    if (IN(7)) {
        for (int rep = 0; rep < NREP(7); ++rep) peer_uv_phase<false, 16>(F, args);
        GRID_BAR();
        peer_w_phase(F, args);
        GRID_BAR();
        if (REP_PHASE != 8) peer_uv_phase<true, 16>(F, args);
        GRID_BAR();
        peer_n_phase(F, args);
    }
#undef IN
#undef BOTH
}


extern "C" void kernel_launch(void* const* d_in, const int* in_sizes, int n_in, void* d_out, int out_size, void* d_ws, size_t ws_size, hipStream_t stream) {
    static int grid = 0;
    if (grid == 0) {
        if (n_in != 16 || in_sizes[0] != M * DM || out_size != M * DM || ws_size < WS_END) { fprintf(stderr, "kernel_launch: unexpected shapes: n_in %d in0 %d out %d ws %zu\n", n_in, n_in > 0 ? in_sizes[0] : -1, out_size, ws_size); grid = -1; return; }
        int dev = 0, cus = 0;
        if (hipGetDevice(&dev) != hipSuccess || hipDeviceGetAttribute(&cus, hipDeviceAttributeMultiprocessorCount, dev) != hipSuccess) { grid = -1; return; }
        if (hipFuncSetAttribute((const void*)mk_fwd, hipFuncAttributeMaxDynamicSharedMemorySize, LDS_BYTES) != hipSuccess) { fprintf(stderr, "kernel_launch: hipFuncSetAttribute failed\n"); grid = -1; return; }
        (void)hipGetLastError();
        grid = cus;
    }
    if (grid < 0) return;
    (void)hipMemsetAsync((char*)d_ws + WS_CTL, 0, CTL_ZERO_BYTES, stream);
    Args a{};
    for (int i = 0; i < 16; ++i) a.in[i] = (const float*)d_in[i];
    a.out = (float*)d_out; a.ws = (unsigned char*)d_ws;
    a.ph_lo = 0; a.ph_hi = 8; a.li = 0;
    hipLaunchKernelGGL(mk_fwd, dim3(grid), dim3(NWAVES * 64), LDS_BYTES, stream, a);
}
```

```cpp
#define REP_PHASE -1

#include <hip/hip_runtime.h>
#include <cstdio>
#include <cstdint>
#include <cmath>
#ifndef REP_PHASE
#define REP_PHASE -1
#endif
#define NREP(k) ((REP_PHASE == (k)) ? 2 : 1)
namespace pg8 {
#define PG8_LAS __attribute__((address_space(3)))
typedef unsigned short bf16_t;
typedef short bf16x8 __attribute__((ext_vector_type(8)));
typedef float f32x4 __attribute__((ext_vector_type(4)));
typedef unsigned u32x4 __attribute__((ext_vector_type(4)));
constexpr int BM = 256, BK = 64, HALF = 128, HTB = HALF * BK * 2  , STAGE_BYTES = 8 * HTB, NXCD = 8, WGM = 8;

__host__ __device__ __forceinline__ int lds_byte(int r, int c) { const int st = (r >> 4) * 2 + (c >> 5), rr = r & 15, cc = c & 31, ob = rr * 64 + cc * 2; return st * 1024 + (ob ^ (((ob >> 9) & 1) << 5)); }
__host__ __device__ __forceinline__ void stage_rc(int b, int& R, int& C) { const int st = b / 1024, sb = b % 1024, swz = sb ^ (((sb >> 9) & 1) << 5); R = (st >> 1) * 16 + swz / 64; C = (st & 1) * 32 + (swz % 64) / 2; }
__host__ __device__ __forceinline__ int perm32(int rho) { const int n = rho >> 4, i = rho & 15; return 8 * (i >> 2) + 4 * n + (i & 3); }

struct Unit { int pm, pn; };
struct Gemm { const bf16_t* A; const bf16_t* Bt; int M, N, K; };

struct StaticOrder {
    int nM, nN, nwg, G, c;
    __host__ __device__ void init(int M, int N, int G_, int c_) { nM = M / BM; nN = N / BM; nwg = nM * nN; G = G_; c = c_; }
    __host__ __device__ bool next(int i, Unit& u) const {
        const long L = (long)i * G + c; if (L >= nwg) return false;
        int wgid = (int)L; { const int q = nwg / NXCD, r = nwg % NXCD, xcd = wgid % NXCD, off = wgid / NXCD; wgid = (xcd < r ? xcd * (q + 1) : r * (q + 1) + (xcd - r) * q) + off; }
        const int nig = WGM * nN, gid = wgid / nig, fm = gid * WGM, gsz = (nM - fm) < WGM ? (nM - fm) : WGM;
        u.pm = fm + ((wgid % nig) % gsz); u.pn = (wgid % nig) / gsz; return true;
    }
    __device__ __forceinline__ void a_ready(const Unit&) const {}
    __device__ __forceinline__ void done(const Unit&) const {}
};

__device__ __forceinline__ unsigned cvt_pk_bf16(float lo, float hi) { unsigned r; asm volatile("v_cvt_pk_bf16_f32 %0, %1, %2" : "=v"(r) : "v"(lo), "v"(hi)); return r; }
typedef float f32x2 __attribute__((ext_vector_type(2)));
__device__ __forceinline__ f32x2 gelu_pk(f32x2 v) {
    const f32x2 av = __builtin_elementwise_abs(v), d = av * 0.2316418882f + 1.0f;
    f32x2 t; t.x = __builtin_amdgcn_rcpf(d.x); t.y = __builtin_amdgcn_rcpf(d.y);
    f32x2 q = t * 0.5307027145f + (-0.7265760135f); q = q * t + 0.7107068705f; q = q * t + (-0.142248368f); q = q * t + 0.127414796f; q = q * t;
    const f32x2 s = (v * v) * (-0.72134752044f);
    f32x2 e; e.x = __builtin_amdgcn_exp2f(s.x); e.y = __builtin_amdgcn_exp2f(s.y);
    const f32x2 m = v * (q * e), r = v - m;
    f32x2 o; o.x = v.x < 0.f ? m.x : r.x; o.y = v.y < 0.f ? m.y : r.y; return o;
}

template <int ACT  > struct EpiBf16 {
    static constexpr bool PERM = true, AFTER_DRAIN = false; static_assert(ACT == 0 || ACT == 1, "EpiBf16: ACT is 0 (none) or 1 (gelu_pk)");
    bf16_t* O; int ldc; const float* bias; int split_cols; size_t split_stride; float scale0;
    __device__ __forceinline__ void operator()(const f32x4 (&acc)[2][2][4][2], const Unit& u, int wr, int wc, int fr, int fq) const {
        const int row0 = u.pm * BM + wr * 64 + fr; int colt = u.pn * BM; bf16_t* base = O;
        float sc = 1.f; if (split_cols) { const int t = colt / split_cols; base += (size_t)t * split_stride; colt -= t * split_cols; if (t == 0) sc = scale0; }
        const int col0 = colt + wc * 32 + 8 * fq, bcol0 = u.pn * BM + wc * 32 + 8 * fq;
        f32x4 bv[2][2];
#pragma unroll
        for (int bj = 0; bj < 2; ++bj)
#pragma unroll
            for (int n = 0; n < 2; ++n) bv[bj][n] = bias ? *(const f32x4*)(bias + bcol0 + bj * HALF + 4 * n) : (f32x4){0.f, 0.f, 0.f, 0.f};
#pragma unroll
        for (int ai = 0; ai < 2; ++ai)
#pragma unroll
            for (int m = 0; m < 4; ++m) { bf16_t* rowp = base + (size_t)(row0 + ai * HALF + m * 16) * ldc + col0;
#pragma unroll
                for (int bj = 0; bj < 2; ++bj) { f32x4 v0 = acc[ai][bj][m][0] + bv[bj][0], v1 = acc[ai][bj][m][1] + bv[bj][1];
                    if (ACT == 1) { f32x2 a = gelu_pk((f32x2){v0[0], v0[1]}), b = gelu_pk((f32x2){v0[2], v0[3]}), c = gelu_pk((f32x2){v1[0], v1[1]}), d = gelu_pk((f32x2){v1[2], v1[3]});
                        v0 = (f32x4){a.x, a.y, b.x, b.y}; v1 = (f32x4){c.x, c.y, d.x, d.y}; }
                    v0 = v0 * sc; v1 = v1 * sc; u32x4 w; w.x = cvt_pk_bf16(v0[0], v0[1]); w.y = cvt_pk_bf16(v0[2], v0[3]); w.z = cvt_pk_bf16(v1[0], v1[1]); w.w = cvt_pk_bf16(v1[2], v1[3]);
                    *(u32x4*)(rowp + bj * HALF) = w; } }
    }
};
template <class Epi, class Sched, bool ALIGN_EPI = false, bool SP2 = false>
__device__ __forceinline__ void gemm_phase(PG8_LAS unsigned char* lds, const Gemm g, const Sched& S, const Epi& E) {
    const int tid = threadIdx.x, wid = __builtin_amdgcn_readfirstlane(tid >> 6), lane = tid & 63, wr = wid >> 2, wc = wid & 3, fr = lane & 15, fq = lane >> 4;
    const int K = g.K, nt = K / BK;
    unsigned voffA[2], voffB[2];
#pragma unroll
    for (int i = 0; i < 2; ++i) { int R, C; stage_rc(tid * 16 + i * 8192, R, C); const int Rb = Epi::PERM ? ((R & ~31) + perm32(R & 31)) : R;
        voffA[i] = (unsigned)(R * K + C) * 2u; voffB[i] = (unsigned)(Rb * K + C) * 2u; }
    const size_t kstep = (size_t)(BK * 2);
    const size_t hstep = (size_t)HALF * K * 2;
    const size_t tstep = 2 * hstep;
    const unsigned ldsw = (unsigned)wid * 1024u;
    const int aoff = lds_byte(wr * 64 + fr, fq * 8), boff = lds_byte(wc * 32 + fr, fq * 8);
#define PG8_SA(b, h) (((b) * 2 + (h)) * HTB)
#define PG8_SB(b, h) ((4 + (b) * 2 + (h)) * HTB)
#define PG8_STAGE(bufoff, gbase, voff) do { _Pragma("unroll") for (int _i = 0; _i < 2; ++_i) \
        __builtin_amdgcn_global_load_lds((const unsigned*)((const char*)(gbase) + (voff)[_i]), (PG8_LAS unsigned*)(lds + (bufoff) + ldsw + _i * 8192), 16, 0, 0); } while (0)
#define PG8_LDA(dst, b, h) do { _Pragma("unroll") for (int m = 0; m < 4; ++m) _Pragma("unroll") for (int k = 0; k < 2; ++k) dst[m][k] = *(const PG8_LAS bf16x8*)(lds + PG8_SA(b, h) + aoff + m * 2048 + k * 1024); } while (0)
#define PG8_LDB(dst, b, h) do { _Pragma("unroll") for (int n = 0; n < 2; ++n) _Pragma("unroll") for (int k = 0; k < 2; ++k) dst[n][k] = *(const PG8_LAS bf16x8*)(lds + PG8_SB(b, h) + boff + n * 2048 + k * 1024); } while (0)
#define PG8_MMA(ai, bj, At, Bt) do { __builtin_amdgcn_s_setprio(1); _Pragma("unroll") for (int m = 0; m < 4; ++m) _Pragma("unroll") for (int n = 0; n < 2; ++n) _Pragma("unroll") for (int k = 0; k < 2; ++k) \
        acc[ai][bj][m][n] = __builtin_amdgcn_mfma_f32_16x16x32_bf16(Bt[n][k], At[m][k], acc[ai][bj][m][n], 0, 0, 0); __builtin_amdgcn_s_setprio(0); } while (0)
#define PG8_WAIT_V(n) asm volatile("s_waitcnt vmcnt(" #n ")" ::: "memory")
#define PG8_WAIT_L(n) asm volatile("s_waitcnt lgkmcnt(" #n ")" ::: "memory")
#define PG8_BAR __builtin_amdgcn_s_barrier()
#define PG8_SCHED __builtin_amdgcn_sched_barrier(0)
    Unit cur, nxt; int ui = 0;
    if (!S.next(0, cur)) return;
    f32x4 acc[2][2][4][2];
#pragma unroll
    for (int a = 0; a < 2; ++a)
#pragma unroll
        for (int b = 0; b < 2; ++b)
#pragma unroll
            for (int m = 0; m < 4; ++m)
#pragma unroll
                for (int n = 0; n < 2; ++n) acc[a][b][m][n] = (f32x4){0.f, 0.f, 0.f, 0.f};
    bf16x8 At[4][2], B0[2][2], B1[2][2];
    const char* cA = (const char*)g.A + (size_t)cur.pm * tstep; const char* cB = (const char*)g.Bt + (size_t)cur.pn * tstep;
    S.a_ready(cur);
    if constexpr (SP2) {
        PG8_STAGE(PG8_SB(0, 0), cB, voffB); PG8_STAGE(PG8_SB(0, 1), cB + hstep, voffB); PG8_STAGE(PG8_SA(0, 0), cA, voffA); PG8_STAGE(PG8_SA(0, 1), cA + hstep, voffA);
        if (wr == 1) PG8_BAR;
        PG8_WAIT_V(2); PG8_BAR;
        PG8_STAGE(PG8_SB(1, 0), cB + kstep, voffB); PG8_STAGE(PG8_SA(1, 0), cA + kstep, voffA); PG8_STAGE(PG8_SB(1, 1), cB + hstep + kstep, voffB);
        PG8_WAIT_V(6); PG8_BAR;
    } else {
        PG8_STAGE(PG8_SB(0, 0), cB, voffB); PG8_STAGE(PG8_SA(0, 0), cA, voffA); PG8_STAGE(PG8_SB(0, 1), cB + hstep, voffB); PG8_STAGE(PG8_SA(0, 1), cA + hstep, voffA);
        if (wr == 1) PG8_BAR;
        PG8_WAIT_V(4); PG8_BAR;
        PG8_STAGE(PG8_SB(1, 0), cB + kstep, voffB); PG8_STAGE(PG8_SA(1, 0), cA + kstep, voffA); PG8_STAGE(PG8_SB(1, 1), cB + hstep + kstep, voffB);
        PG8_WAIT_V(6); PG8_BAR;
    }
    for (;;) {
        const bool has_next = S.next(ui + 1, nxt);
        const char* nA = has_next ? (const char*)g.A + (size_t)nxt.pm * tstep : cA; const char* nB = has_next ? (const char*)g.Bt + (size_t)nxt.pn * tstep : cB;
        for (int t = 0; t < nt; t += 2) {
            const bool last = (t == nt - 2);
            const char* a1 = cA + (size_t)(t + 1) * kstep;
            const char* a2 = last ? nA : cA + (size_t)(t + 2) * kstep; const char* b2 = last ? nB : cB + (size_t)(t + 2) * kstep;
            const char* a3 = a2 + kstep; const char* b3 = b2 + kstep;
            if (last && has_next) S.a_ready(nxt);
            if constexpr (SP2) {
            PG8_LDB(B0, 0, 0); PG8_LDB(B1, 0, 1); PG8_SCHED; PG8_LDA(At, 0, 0); PG8_STAGE(PG8_SA(1, 1), a1 + hstep, voffA);
            PG8_WAIT_V(8); PG8_WAIT_L(0); PG8_BAR; PG8_MMA(0, 0, At, B0); PG8_MMA(0, 1, At, B1); PG8_BAR; PG8_SCHED;
            PG8_LDA(At, 0, 1); PG8_STAGE(PG8_SB(0, 0), b2, voffB); PG8_STAGE(PG8_SB(0, 1), b2 + hstep, voffB); PG8_STAGE(PG8_SA(0, 0), a2, voffA);
            PG8_WAIT_V(8); PG8_WAIT_L(0); PG8_BAR; PG8_MMA(1, 0, At, B0); PG8_MMA(1, 1, At, B1); PG8_BAR; PG8_SCHED;
            PG8_LDB(B0, 1, 0); PG8_LDB(B1, 1, 1); PG8_SCHED; PG8_LDA(At, 1, 0); PG8_STAGE(PG8_SA(0, 1), a2 + hstep, voffA);
            PG8_WAIT_V(8); PG8_WAIT_L(0); PG8_BAR; PG8_MMA(0, 0, At, B0); PG8_MMA(0, 1, At, B1); PG8_BAR; PG8_SCHED;
            PG8_LDA(At, 1, 1); PG8_STAGE(PG8_SB(1, 0), b3, voffB); PG8_STAGE(PG8_SB(1, 1), b3 + hstep, voffB); PG8_STAGE(PG8_SA(1, 0), a3, voffA);
            PG8_WAIT_V(8); PG8_WAIT_L(0); PG8_BAR; PG8_MMA(1, 0, At, B0); PG8_MMA(1, 1, At, B1); PG8_BAR; PG8_SCHED;
            } else {
            PG8_LDB(B0, 0, 0); PG8_SCHED; PG8_LDA(At, 0, 0); PG8_STAGE(PG8_SA(1, 1), a1 + hstep, voffA);
            PG8_WAIT_L(8); PG8_BAR; PG8_WAIT_L(0); PG8_MMA(0, 0, At, B0); PG8_BAR; PG8_SCHED;
            PG8_LDB(B1, 0, 1); PG8_STAGE(PG8_SB(0, 0), b2, voffB);
            PG8_BAR; PG8_WAIT_L(0); PG8_MMA(0, 1, At, B1); PG8_BAR;
            PG8_LDA(At, 0, 1); PG8_STAGE(PG8_SA(0, 0), a2, voffA);
            PG8_BAR; PG8_WAIT_L(0); PG8_MMA(1, 0, At, B0); PG8_BAR; PG8_SCHED;
            PG8_STAGE(PG8_SB(0, 1), b2 + hstep, voffB);
            PG8_WAIT_V(6); PG8_BAR; PG8_MMA(1, 1, At, B1); PG8_BAR;
            PG8_LDB(B0, 1, 0); PG8_SCHED; PG8_LDA(At, 1, 0); PG8_STAGE(PG8_SA(0, 1), a2 + hstep, voffA);
            PG8_WAIT_L(8); PG8_BAR; PG8_WAIT_L(0); PG8_MMA(0, 0, At, B0); PG8_BAR; PG8_SCHED;
            PG8_LDB(B1, 1, 1); PG8_STAGE(PG8_SB(1, 0), b3, voffB);
            PG8_BAR; PG8_WAIT_L(0); PG8_MMA(0, 1, At, B1); PG8_BAR;
            PG8_LDA(At, 1, 1); PG8_STAGE(PG8_SA(1, 0), a3, voffA);
            PG8_BAR; PG8_WAIT_L(0); PG8_MMA(1, 0, At, B0); PG8_BAR; PG8_SCHED;
            PG8_STAGE(PG8_SB(1, 1), b3 + hstep, voffB);
            PG8_WAIT_V(6); PG8_BAR; PG8_MMA(1, 1, At, B1); PG8_BAR;
            }
        }
        if constexpr (ALIGN_EPI) { if (wr == 0) PG8_BAR; }
        if constexpr (!Epi::AFTER_DRAIN) { E(acc, cur, wr, wc, fr, fq); S.done(cur); }
        if (!has_next) break;
#pragma unroll
        for (int a = 0; a < 2; ++a)
#pragma unroll
            for (int b = 0; b < 2; ++b)
#pragma unroll
                for (int m = 0; m < 4; ++m)
#pragma unroll
                    for (int n = 0; n < 2; ++n) acc[a][b][m][n] = (f32x4){0.f, 0.f, 0.f, 0.f};
        cur = nxt; cA = nA; cB = nB; ++ui;
        if constexpr (ALIGN_EPI) { if (wr == 1) PG8_BAR; }
    }
    PG8_WAIT_V(0);
    if constexpr (!ALIGN_EPI) { if (wr == 0) PG8_BAR; }
    PG8_BAR;
    if constexpr (Epi::AFTER_DRAIN) { E.fused(acc, cur, wr, wc, fr, fq, lds, wid, lane); S.done(cur); }
#undef PG8_SA
#undef PG8_SB
#undef PG8_STAGE
#undef PG8_LDA
#undef PG8_LDB
#undef PG8_MMA
#undef PG8_WAIT_V
#undef PG8_WAIT_L
#undef PG8_BAR
#undef PG8_SCHED
}
}

#ifndef PG8_SP2
#define PG8_SP2 true
#endif
#ifndef PG8_ALIGN
#define PG8_ALIGN true
#endif
#define GAS __attribute__((address_space(1)))
#define LAS __attribute__((address_space(3)))
typedef unsigned short bf16;
typedef unsigned v4u __attribute__((ext_vector_type(4)));
typedef float f32x4 __attribute__((ext_vector_type(4)));
typedef short bf16x8 __attribute__((ext_vector_type(8)));
typedef GAS unsigned gu32;
typedef GAS unsigned long long gu64;
#define RLX_AGENT __ATOMIC_RELAXED, __HIP_MEMORY_SCOPE_AGENT
#define LDS_WAIT() asm volatile("s_waitcnt lgkmcnt(0)" ::: "memory")
#define VM_WAIT() asm volatile("s_waitcnt vmcnt(0)" ::: "memory")
__device__ __forceinline__ unsigned long long rt() { return __builtin_amdgcn_s_memrealtime(); }
__device__ __forceinline__ unsigned f2bf(float f) { unsigned u = __builtin_bit_cast(unsigned, f); return (u + 0x7fffu + ((u >> 16) & 1u)) >> 16; }
typedef float pk2_f32x2 __attribute__((ext_vector_type(2))); typedef __bf16 pk2_bf16x2 __attribute__((ext_vector_type(2)));
__device__ __forceinline__ unsigned pk2(float lo, float hi) { pk2_f32x2 v = {lo, hi}; pk2_bf16x2 b = __builtin_convertvector(v, pk2_bf16x2); return __builtin_bit_cast(unsigned, b); }

#define XB_TMO      128
#define XB_XCNT(j)  (256  + 64 * (j))
#define XB_XSUB(j)  (1280 + 64 * (j))
#define XB_XGEN(j)  (2304 + 64 * (j))
#define XB_TOP      3328
#define XB_TOPGEN   3392
#define XCD_BAR_WORDS 3456
#define XB_SPIN_CAP (1u << 18)

__device__ __forceinline__ unsigned xb_ld(unsigned* p)              { return __hip_atomic_load(p, __ATOMIC_RELAXED, __HIP_MEMORY_SCOPE_AGENT); }
__device__ __forceinline__ unsigned xb_add(unsigned* p, unsigned v) { return __hip_atomic_fetch_add(p, v, __ATOMIC_RELAXED, __HIP_MEMORY_SCOPE_AGENT); }
__device__ __forceinline__ unsigned xb_xcc_id() { return (unsigned)__builtin_amdgcn_s_getreg((3 << 11) | 20) & 0xFu; }
#define XB_SPIN(cond, bar) do { unsigned _sp = 0; while (cond) { __builtin_amdgcn_s_sleep(1); \
    if ((++_sp & 255u) == 0u) { if (xb_ld(&(bar)[XB_TMO])) break; if (_sp > XB_SPIN_CAP) { atomicAdd(&(bar)[XB_TMO], 1u); break; } } } } while (0)

struct XcdBarrier {
    unsigned* bar; unsigned x;
    volatile LAS unsigned* st;
};

__device__ __forceinline__ XcdBarrier xcd_barrier_post(unsigned* bar, volatile LAS unsigned* st) {
    XcdBarrier b; b.bar = bar; b.x = xb_xcc_id(); b.st = st;
    if (threadIdx.x == 0) (void)xb_add(&bar[XB_XCNT(b.x)], 1u);
    return b;
}
__device__ __forceinline__ void xcd_barrier_complete(unsigned* bar, unsigned x, unsigned& nloc, unsigned& nx) {
    const unsigned G = gridDim.x * gridDim.y * gridDim.z;
    unsigned sum, cnt, mine, sp = 0u;
    for (;;) {
        sum = 0u; cnt = 0u; mine = 0u;
#pragma unroll
        for (unsigned j = 0; j < 16; ++j) { const unsigned c = xb_ld(&bar[XB_XCNT(j)]); sum += c; cnt += (c > 0u) ? 1u : 0u; mine = (j == x) ? c : mine; }
        if (sum == G) break;
        __builtin_amdgcn_s_sleep(1);
        if ((++sp & 255u) == 0u) { if (xb_ld(&bar[XB_TMO])) break; if (sp > XB_SPIN_CAP) { atomicAdd(&bar[XB_TMO], 1u); break; } }
    }
    nloc = mine > 0u ? mine : 1u; nx = cnt > 0u ? cnt : 1u;
}

__device__ __forceinline__ void xcd_barrier(const XcdBarrier& b) {
    asm volatile("s_waitcnt vmcnt(0)" ::: "memory");
    __syncthreads();
    if (threadIdx.x == 0) {
        unsigned* bar = b.bar;
        __builtin_amdgcn_s_waitcnt(0);
        unsigned nloc = b.st[0], nx = b.st[1];
        if (nloc == 0u) { xcd_barrier_complete(bar, b.x, nloc, nx); b.st[0] = nloc; b.st[1] = nx; }
        const unsigned old = xb_add(&bar[XB_XSUB(b.x)], 1u);
        const unsigned gen = old / nloc;
        if (old + 1u == (gen + 1u) * nloc) {
            __builtin_amdgcn_fence(__ATOMIC_RELEASE, "agent");
            asm volatile("s_waitcnt vmcnt(0)" ::: "memory");
            const unsigned og = xb_add(&bar[XB_TOP], 1u);
            const unsigned tg = og / nx;
            if (og + 1u == (tg + 1u) * nx) xb_add(&bar[XB_TOPGEN], 1u);
            else XB_SPIN(xb_ld(&bar[XB_TOPGEN]) == tg, bar);
            __builtin_amdgcn_fence(__ATOMIC_ACQUIRE, "agent");
            xb_add(&bar[XB_XGEN(b.x)], 1u);
            asm volatile("s_waitcnt vmcnt(0)" ::: "memory");
        } else {
            XB_SPIN(xb_ld(&bar[XB_XGEN(b.x)]) == gen, bar);
            __builtin_amdgcn_fence(__ATOMIC_ACQUIRE, "agent");
            asm volatile("s_waitcnt vmcnt(0)" ::: "memory");
        }
    }
    __syncthreads();
}


constexpr int NWAVES = 8;
constexpr int DM = 2048, BATCH = 4, SEQ = 4096, M = BATCH * SEQ;
constexpr int NIN = 6176, NINP = 6144;
constexpr int O_GQ = 0, O_GK = 512, O_GV = 1024, O_GR = 2048, O_AQ = 3072, O_AK = 4096, O_AV = 5120;
constexpr float EPS = 1e-6f;
constexpr int PEER_K = 128;

constexpr size_t MiB = 1u << 20;
constexpr size_t WS_CTL = 0, CTL_ZERO_BYTES = 1 * MiB;
constexpr size_t WS_WIN = 1 * MiB;
constexpr size_t WS_WGD = 25 * MiB;
constexpr size_t WS_GDB = 62 * MiB;
constexpr size_t WS_WOUT = 26 * MiB;
constexpr size_t WS_WQ = 34 * MiB;
constexpr size_t WS_SSQ = 42 * MiB;
constexpr size_t WS_EIDX = 44 * MiB;
constexpr size_t WS_GATE = 52 * MiB;
constexpr size_t WS_SKB = 60 * MiB;
constexpr size_t WS_XN = 64 * MiB;
constexpr size_t WS_PROJ = 128 * MiB;
constexpr size_t WS_HB = 256 * MiB;
constexpr size_t WS_OF = 328 * MiB;
constexpr size_t WS_OB = 360 * MiB;
constexpr size_t WS_ATT = 392 * MiB;
constexpr size_t WS_ATTP = 392 * MiB;
constexpr size_t WS_ATTML = 488 * MiB;
constexpr size_t WS_GT_QD = 64 * MiB;
constexpr size_t WS_GT_KE = 96 * MiB;
constexpr size_t OUT_GT_AM = 0;
constexpr size_t OUT_GT_DEC = 16 * MiB;
constexpr size_t OUT_GT_VT = 32 * MiB;
constexpr int CW_ATTQ = 64;
constexpr size_t WS_END = 494 * MiB;
constexpr size_t OUT_U8 = 64 * MiB;
constexpr size_t OUT_V8 = 96 * MiB;
constexpr size_t WS_SU = 61 * MiB;
constexpr size_t WS_SV = 61 * MiB + 65536;
constexpr int CW_CONVQ = 256;
constexpr size_t WS_PW = 128 * MiB;
constexpr size_t WS_SSQ2 = 136 * MiB;
constexpr size_t WS_PD = 64 * MiB;
constexpr int PEER_E = 16384;
constexpr int CW_TMO = 0, CW_CODE = 1, CW_BAR = 4096;

constexpr int RING_OFF = 0, RING_BYTES = 131072;
constexpr int LDS_BYTES = 163840;
constexpr int LDSCTL_OFF = LDS_BYTES - 1024, MISC_OFF = LDSCTL_OFF + 320;

typedef float f32x2 __attribute__((ext_vector_type(2)));
typedef float f32x16 __attribute__((ext_vector_type(16)));
__device__ __forceinline__ float bf2f(unsigned short h) { return __builtin_bit_cast(float, (unsigned)h << 16); }
__device__ __forceinline__ float bflo(unsigned w) { return __builtin_bit_cast(float, w << 16); }
__device__ __forceinline__ float bfhi(unsigned w) { return __builtin_bit_cast(float, w & 0xffff0000u); }
__device__ __forceinline__ float wave_sum(float v) {
#pragma unroll
    for (int o = 1; o < 64; o <<= 1) v += __shfl_xor(v, o);
    return v;
}
__device__ __forceinline__ float wave_max(float v) {
#pragma unroll
    for (int o = 1; o < 64; o <<= 1) v = fmaxf(v, __shfl_xor(v, o));
    return v;
}

template <class T> __device__ __forceinline__ T* opaque(T* p) { asm volatile("" : "+s"(p)); return (T*)(GAS T*)p; }
__device__ __forceinline__ int opaque_v(int x) { asm volatile("" : "+v"(x)); return x; }
template <class T> __device__ __forceinline__ T ldu(const void* ubase, unsigned voff) { return *(const GAS T*)((const GAS char*)ubase + voff); }
template <class T> __device__ __forceinline__ void stu(void* ubase, unsigned voff, T v) { *(GAS T*)((GAS char*)ubase + voff) = v; }
namespace pg8 {
struct EpiRes {
    static constexpr bool PERM = false, AFTER_DRAIN = false;
    const float* x; bf16_t* HB; float* ssq; int ldc;
    __device__ __forceinline__ void operator()(const f32x4 (&acc)[2][2][4][2], const Unit& u, int wr, int wc, int fr, int fq) const {
        const int col0 = u.pn * BM + wc * 32 + 4 * fq;
#pragma unroll
        for (int ai = 0; ai < 2; ++ai)
#pragma unroll
            for (int m = 0; m < 4; ++m) {
                const int r = u.pm * BM + ai * HALF + wr * 64 + m * 16 + fr; const size_t off = (size_t)r * ldc + col0; float s = 0.f;
#pragma unroll
                for (int bj = 0; bj < 2; ++bj)
#pragma unroll
                    for (int n = 0; n < 2; ++n) {
                        const f32x4 xv = *(const f32x4*)(x + off + bj * HALF + n * 16);
                        const f32x4 hv = xv + acc[ai][bj][m][n];
                        s += (hv[0] * hv[0] + hv[1] * hv[1]) + (hv[2] * hv[2] + hv[3] * hv[3]);
                        unsigned long long w = (unsigned long long)cvt_pk_bf16(hv[0], hv[1]) | ((unsigned long long)cvt_pk_bf16(hv[2], hv[3]) << 32);
                        *(unsigned long long*)(HB + off + bj * HALF + n * 16) = w;
                    }
                s += __shfl_xor(s, 16); s += __shfl_xor(s, 32);
                if (fq == 0) ssq[(size_t)r * 32 + u.pn * 4 + wc] = s;
            }
    }
};
struct EpiRowScale {
    static constexpr bool PERM = true, AFTER_DRAIN = false;
    bf16_t* O; int ldc; const float* ssq; float inv_n, eps;
    __device__ __forceinline__ void operator()(const f32x4 (&acc)[2][2][4][2], const Unit& u, int wr, int wc, int fr, int fq) const {
        const int col0 = u.pn * BM + wc * 32 + 8 * fq;
#pragma unroll
        for (int ai = 0; ai < 2; ++ai)
#pragma unroll
            for (int m = 0; m < 4; ++m) {
                const int r = u.pm * BM + ai * HALF + wr * 64 + m * 16 + fr;
                const f32x4* sp = (const f32x4*)(ssq + (size_t)r * 32); float s = 0.f;
#pragma unroll
                for (int i = 0; i < 8; ++i) { const f32x4 t = sp[i]; s += (t[0] + t[1]) + (t[2] + t[3]); }
                const float sc = 1.0f / sqrtf(s * inv_n + eps);
                bf16_t* rowp = O + (size_t)r * ldc + col0;
#pragma unroll
                for (int bj = 0; bj < 2; ++bj) { const f32x4 v0 = acc[ai][bj][m][0] * sc, v1 = acc[ai][bj][m][1] * sc;
                    u32x4 w; w.x = cvt_pk_bf16(v0[0], v0[1]); w.y = cvt_pk_bf16(v0[2], v0[3]); w.z = cvt_pk_bf16(v1[0], v1[1]); w.w = cvt_pk_bf16(v1[2], v1[3]);
                    *(u32x4*)(rowp + bj * HALF) = w; }
            }
    }
};
}

struct Frame {
    LAS unsigned char* lds;
    volatile LAS unsigned* MISC;
    gu32* ctl;
    int tid, lane, wave;
    int vcu, G;
};

__device__ __forceinline__ void p0_transpose_item(const float* W, int K, int ldw, const float* gk, bf16* WT, LAS float* scr, int item, int lane) {
    const int nblk = ldw / 32, kb = item / nblk, nb = item % nblk, k0 = 64 * kb, n0 = 32 * nb;
#pragma unroll 8
    for (int i = 0; i < 32; ++i) { const int kk = 2 * i + (lane >> 5); float w = W[(size_t)(k0 + kk) * ldw + n0 + (lane & 31)]; if (gk) w *= gk[k0 + kk]; scr[kk * 33 + (lane & 31)] = w; }
    LDS_WAIT(); asm volatile("" ::: "memory");
    const int c = lane & 7;
#pragma unroll
    for (int j = 0; j < 4; ++j) { const int n = (lane >> 3) + 8 * j; const LAS float* s = scr + (8 * c) * 33 + n;
        v4u o; o.x = pk2(s[0 * 33], s[1 * 33]); o.y = pk2(s[2 * 33], s[3 * 33]); o.z = pk2(s[4 * 33], s[5 * 33]); o.w = pk2(s[6 * 33], s[7 * 33]);
        *(GAS v4u*)(WT + (size_t)(n0 + n) * K + k0 + 8 * c) = o; }
    LDS_WAIT(); asm volatile("" ::: "memory");
}
__device__ __forceinline__ void rms_row_to_bf16(int lane, const float* xrow, const float* g, bf16* orow) {
    const GAS f32x4* xr = (const GAS f32x4*)xrow + lane; const GAS f32x4* gr = (const GAS f32x4*)g + lane;
    f32x4 v[8]; float s = 0.f;
#pragma unroll
    for (int j = 0; j < 8; ++j) { v[j] = xr[64 * j]; s += (v[j].x * v[j].x + v[j].y * v[j].y) + (v[j].z * v[j].z + v[j].w * v[j].w); }
    const float rstd = 1.f / sqrtf(wave_sum(s) * (1.f / DM) + EPS);
    GAS unsigned long long* o8 = (GAS unsigned long long*)orow + lane;
#pragma unroll
    for (int j = 0; j < 8; ++j) { const f32x4 gg = gr[64 * j];
        o8[64 * j] = (unsigned long long)pk2(v[j].x * rstd * gg.x, v[j].y * rstd * gg.y) | ((unsigned long long)pk2(v[j].z * rstd * gg.z, v[j].w * rstd * gg.w) << 32); }
}

struct Args {
    const float* in[16]; float* out; unsigned char* ws; int ph_lo, ph_hi, li, pad;
};

__device__ __forceinline__ void p0_prologue(Frame& F, const Args& a) {
    unsigned char* ws = a.ws;
    LAS float* scr = (LAS float*)(F.lds + RING_OFF + F.wave * 16384);
    const int gw = F.vcu * NWAVES + F.wave, NGW = F.G * NWAVES;
    bf16* Win_t = (bf16*)(ws + WS_WIN); bf16* Wout_t = (bf16*)(ws + WS_WOUT); bf16* Wq_t = (bf16*)(ws + WS_WQ); bf16* XN = (bf16*)(ws + WS_XN);
    constexpr int I_IN = (DM / 64) * (NIN / 32), I_SQ = (DM / 64) * (DM / 32);
    constexpr int NITEMS = I_IN + 2 * I_SQ;
    for (int it = gw; it < NITEMS; it += NGW) {
        int r = it;
        if (r < I_IN) { const int nb = r % (NIN / 32); bf16* dst = nb < 96 ? Win_t : nb == 96 ? (bf16*)(ws + WS_WGD) - (size_t)96 * 32 * DM : Win_t - (size_t)32 * DM;
            p0_transpose_item(a.in[2], DM, NIN, nullptr, dst, scr, r, F.lane); continue; } r -= I_IN;
        if (r < I_SQ) { p0_transpose_item(a.in[9], DM, DM, nullptr, Wout_t, scr, r, F.lane); continue; } r -= I_SQ;
        p0_transpose_item(a.in[11], DM, DM, a.in[10], Wq_t, scr, r, F.lane);
    }
    { const f32x4* sk = (const f32x4*)a.in[12]; unsigned long long* skb = (unsigned long long*)(ws + WS_SKB);
      for (int i = gw * 64 + F.lane; i < 8 * 2 * 128 * 128 / 4; i += NGW * 64) { const f32x4 v = sk[i]; skb[i] = (unsigned long long)pk2(v.x, v.y) | ((unsigned long long)pk2(v.z, v.w) << 32); } }
    for (int m = gw; m < M; m += NGW) rms_row_to_bf16(F.lane, a.in[0] + (size_t)m * DM, a.in[1], XN + (size_t)m * DM);
}


__device__ __forceinline__ void gd_side_gemm(Frame& F, const Args& a) {
    unsigned char* ws = a.ws; const bf16* XN = (const bf16*)(ws + WS_XN); const bf16* WG = (const bf16*)(ws + WS_WGD); float* GDB = (float*)(ws + WS_GDB);
    const int lane = F.lane, w = F.wave, r32 = lane & 31, hh = lane >> 5; LAS float* part = (LAS float*)F.lds;
    for (int blk = F.vcu; blk < M / 64; blk += F.G) { const int tok0 = blk * 64;
        f32x16 acc[2];
#pragma unroll
        for (int tt = 0; tt < 2; ++tt) acc[tt] = (f32x16){0.f, 0.f, 0.f, 0.f, 0.f, 0.f, 0.f, 0.f, 0.f, 0.f, 0.f, 0.f, 0.f, 0.f, 0.f, 0.f};
#pragma unroll 4
        for (int ks = 0; ks < 16; ++ks) { const int k0 = 256 * w + 16 * ks + 8 * hh; const bf16x8 bw = *(const bf16x8*)(WG + (size_t)r32 * DM + k0);
#pragma unroll
            for (int tt = 0; tt < 2; ++tt) { const bf16x8 ax = *(const bf16x8*)(XN + (size_t)(tok0 + 32 * tt + r32) * DM + k0); acc[tt] = __builtin_amdgcn_mfma_f32_32x32x16_bf16(ax, bw, acc[tt], 0, 0, 0); } }
#pragma unroll
        for (int tt = 0; tt < 2; ++tt)
#pragma unroll
            for (int r = 0; r < 16; ++r) { const float x = acc[tt][r]; part[((w * 2 + tt) * 16 + r) * 64 + lane] = x; }
        __syncthreads();
#pragma unroll
        for (int i = 0; i < 4; ++i) { const int o = F.tid + 512 * i; float sum = 0.f;
#pragma unroll
            for (int ww = 0; ww < 8; ++ww) sum += part[ww * 2048 + o];
            const int tt = o >> 10, r = (o >> 6) & 15, ln = o & 63; const int t = 32 * tt + (r & 3) + 8 * (r >> 2) + 4 * (ln >> 5);
            GDB[(size_t)(tok0 + t) * 32 + (ln & 31)] = sum; }
        __syncthreads();
    }
}

__device__ __forceinline__ void p3_finalize(Frame& F, const Args& a) {
    unsigned char* ws = a.ws;
    const int gw = F.vcu * NWAVES + F.wave, NGW = F.G * NWAVES, lane = F.lane;
    const bf16* OFp = (const bf16*)(ws + WS_OF); const bf16* OBp = (const bf16*)(ws + WS_OB);
    const bf16* PROJ = (const bf16*)(ws + WS_PROJ); bf16* Y = (bf16*)(ws + WS_XN);
    const float* gla_g = a.in[7]; const float* att_g = a.in[8];
    const f32x4 gg = *(const f32x4*)(gla_g + 4 * lane);
    for (int m = gw; m < M; m += NGW) {
#pragma unroll
        for (int hh = 0; hh < 4; ++hh) {
            const unsigned long long wf = *(const unsigned long long*)(OFp + (size_t)m * 1024 + hh * 256 + 4 * lane);
            const unsigned long long wb = *(const unsigned long long*)(OBp + (size_t)m * 1024 + hh * 256 + 4 * lane);
            const f32x4 o = (f32x4){bflo((unsigned)wf) + bflo((unsigned)wb), bfhi((unsigned)wf) + bfhi((unsigned)wb), bflo((unsigned)(wf >> 32)) + bflo((unsigned)(wb >> 32)), bfhi((unsigned)(wf >> 32)) + bfhi((unsigned)(wb >> 32))};
            const float ss = wave_sum((o.x * o.x + o.y * o.y) + (o.z * o.z + o.w * o.w));
            const float rstd = 1.f / sqrtf(ss * (1.f / 256.f) + EPS);
            const unsigned long long gr = *(const unsigned long long*)(PROJ + (size_t)m * NINP + O_GR + hh * 256 + 4 * lane);
            const float r0 = bflo((unsigned)gr), r1 = bfhi((unsigned)gr), r2 = bflo((unsigned)(gr >> 32)), r3 = bfhi((unsigned)(gr >> 32));
            const float y0 = o.x * rstd * gg.x * (r0 / (1.f + __expf(-r0))), y1 = o.y * rstd * gg.y * (r1 / (1.f + __expf(-r1)));
            const float y2 = o.z * rstd * gg.z * (r2 / (1.f + __expf(-r2))), y3 = o.w * rstd * gg.w * (r3 / (1.f + __expf(-r3)));
            *(unsigned long long*)(Y + (size_t)m * DM + hh * 256 + 4 * lane) = (unsigned long long)pk2(y0, y1) | ((unsigned long long)pk2(y2, y3) << 32);
        }
        float av[16]; float ss = 0.f;
#pragma unroll
        for (int p = 0; p < 2; ++p) { const int col = p * 512 + 8 * lane, hd = col >> 6; float mm[3], ll[3]; v4u ow[3];
#pragma unroll
            for (int pt = 0; pt < 3; ++pt) { const size_t rec = ((size_t)pt * M + m) * 16 + hd; const f32x2 ml2 = *(const f32x2*)((const float*)(ws + WS_ATTML) + rec * 2); mm[pt] = ml2.x; ll[pt] = ml2.y;
                ow[pt] = *(const v4u*)((const bf16*)(ws + WS_ATTP) + rec * 64 + (col & 63)); }
            const float mt = fmaxf(fmaxf(mm[0], mm[1]), mm[2]); const float w0 = __expf(mm[0] - mt), w1 = __expf(mm[1] - mt), w2 = __expf(mm[2] - mt);
            const float inv = 1.f / (w0 * ll[0] + w1 * ll[1] + w2 * ll[2]);
            av[p * 8 + 0] = (w0 * bflo(ow[0].x) + w1 * bflo(ow[1].x) + w2 * bflo(ow[2].x)) * inv; av[p * 8 + 1] = (w0 * bfhi(ow[0].x) + w1 * bfhi(ow[1].x) + w2 * bfhi(ow[2].x)) * inv;
            av[p * 8 + 2] = (w0 * bflo(ow[0].y) + w1 * bflo(ow[1].y) + w2 * bflo(ow[2].y)) * inv; av[p * 8 + 3] = (w0 * bfhi(ow[0].y) + w1 * bfhi(ow[1].y) + w2 * bfhi(ow[2].y)) * inv;
            av[p * 8 + 4] = (w0 * bflo(ow[0].z) + w1 * bflo(ow[1].z) + w2 * bflo(ow[2].z)) * inv; av[p * 8 + 5] = (w0 * bfhi(ow[0].z) + w1 * bfhi(ow[1].z) + w2 * bfhi(ow[2].z)) * inv;
            av[p * 8 + 6] = (w0 * bflo(ow[0].w) + w1 * bflo(ow[1].w) + w2 * bflo(ow[2].w)) * inv; av[p * 8 + 7] = (w0 * bfhi(ow[0].w) + w1 * bfhi(ow[1].w) + w2 * bfhi(ow[2].w)) * inv; }
#pragma unroll
        for (int i = 0; i < 16; ++i) ss += av[i] * av[i];
        const float rstd = 1.f / sqrtf(wave_sum(ss) * (1.f / 1024.f) + EPS);
#pragma unroll
        for (int p = 0; p < 2; ++p) { const f32x4 g0 = *(const f32x4*)(att_g + p * 512 + 8 * lane), g1 = *(const f32x4*)(att_g + p * 512 + 8 * lane + 4);
            v4u w; w.x = pk2(av[p * 8 + 0] * rstd * g0.x, av[p * 8 + 1] * rstd * g0.y); w.y = pk2(av[p * 8 + 2] * rstd * g0.z, av[p * 8 + 3] * rstd * g0.w);
            w.z = pk2(av[p * 8 + 4] * rstd * g1.x, av[p * 8 + 5] * rstd * g1.y); w.w = pk2(av[p * 8 + 6] * rstd * g1.z, av[p * 8 + 7] * rstd * g1.w);
            *(v4u*)(Y + (size_t)m * DM + 1024 + p * 512 + 8 * lane) = w; }
    }
}


__device__ __forceinline__ void wave_argmax(float& v, int& idx) {
#pragma unroll
    for (int o = 1; o < 64; o <<= 1) { const float ov = __shfl_xor(v, o); const int oi = __shfl_xor(idx, o); if (ov > v || (ov == v && oi < idx)) { v = ov; idx = oi; } }
}
__device__ __forceinline__ void ce_desc(float& a, float& b) { const float hi = fmaxf(a, b), lo = fminf(a, b); a = hi; b = lo; }
__device__ __forceinline__ void sort16_desc(float* v) {
#pragma unroll
    for (int k = 2; k <= 16; k <<= 1)
#pragma unroll
        for (int j = k >> 1; j > 0; j >>= 1)
#pragma unroll
            for (int i = 0; i < 16; ++i) { const int l = i ^ j; if (l > i) { if ((i & k) == 0 || k == 16) ce_desc(v[i], v[l]); else ce_desc(v[l], v[i]); } }
}
__device__ __forceinline__ void merge16_desc(float* v) {
#pragma unroll
    for (int j = 8; j > 0; j >>= 1)
#pragma unroll
        for (int i = 0; i < 16; ++i) { const int l = i ^ j; if (l > i) ce_desc(v[i], v[l]); }
}
__device__ __forceinline__ void top16_of_two(float* a, const float* b) {
#pragma unroll
    for (int i = 0; i < 16; ++i) a[i] = fmaxf(a[i], b[15 - i]);
    merge16_desc(a);
}
__device__ __forceinline__ void top16_of_64(float* v) {
    sort16_desc(v); sort16_desc(v + 16); sort16_desc(v + 32); sort16_desc(v + 48);
    top16_of_two(v, v + 16); top16_of_two(v + 32, v + 48); top16_of_two(v, v + 32);
}
__device__ __forceinline__ void topk_phase(Frame& F, const Args& a) {
    unsigned char* ws = a.ws; const bf16* QP = (const bf16*)(ws + WS_XN); const bf16* SKB = (const bf16*)(ws + WS_SKB); int* EIDX = (int*)(ws + WS_EIDX); float* GATE = (float*)(ws + WS_GATE);
    const int lane = F.lane, h = F.wave, r32 = lane & 31, hh = lane >> 5;
    LAS int* tok_id = (LAS int*)(F.lds);
    LAS float* tok_gt = (LAS float*)(F.lds + 32768);
    LAS int* ktab = (LAS int*)(F.lds + 65536 + F.wave * 8192);
    for (int unit = F.vcu; unit < M / 64; unit += F.G) {
        const int tok0 = unit * 64;
#pragma unroll 1
        for (int tt = 0; tt < 2; ++tt) {
            const size_t row = (size_t)(tok0 + tt * 32 + r32);
            float L[2][16];
#pragma unroll
            for (int c = 0; c < 2; ++c) {
                f32x16 acc[4];
#pragma unroll
                for (int kt = 0; kt < 4; ++kt) acc[kt] = (f32x16){0.f, 0.f, 0.f, 0.f, 0.f, 0.f, 0.f, 0.f, 0.f, 0.f, 0.f, 0.f, 0.f, 0.f, 0.f, 0.f};
                const bf16* qb = QP + row * DM + h * 256 + c * 128 + 8 * hh;
                const bf16* kb = SKB + ((size_t)(h * 2 + c) * 128 + r32) * 128 + 8 * hh;
#if !defined(TOPK_DBG)
#pragma unroll 2
                for (int st = 0; st < 8; ++st) {
                    const bf16x8 bq = *(const bf16x8*)(qb + 16 * st);
#pragma unroll
                    for (int kt = 0; kt < 4; ++kt) { const bf16x8 ak = *(const bf16x8*)(kb + (size_t)kt * 32 * 128 + 16 * st);
                        acc[kt] = __builtin_amdgcn_mfma_f32_32x32x16_bf16(ak, bq, acc[kt], 0, 0, 0); }
                }
#else
                (void)qb; (void)kb;
#pragma unroll
                for (int kt = 0; kt < 4; ++kt)
#pragma unroll
                    for (int r = 0; r < 16; ++r) { const int key = 32 * kt + (r & 3) + 8 * (r >> 2) + 4 * hh; float d = 0.f;
                        const bf16* qq = QP + row * DM + h * 256 + c * 128; const float* kk = a.in[12] + ((size_t)(h * 2 + c) * 128 + key) * 128;
                        for (int dd = 0; dd < 128; ++dd) d += bf2f(qq[dd]) * kk[dd];
                        acc[kt][r] = d; }
#endif
                float v[64];
#pragma unroll
                for (int kt = 0; kt < 4; ++kt)
#pragma unroll
                    for (int r = 0; r < 16; ++r) { const int key = 32 * kt + (r & 3) + 8 * (r >> 2);
                        const float sc = acc[kt][r];
                        v[kt * 16 + r] = __builtin_bit_cast(float, (__builtin_bit_cast(unsigned, sc) & ~127u) | (unsigned)(key + 4 * hh)); }
                top16_of_64(v);
                float p[16];
#pragma unroll
                for (int i = 0; i < 16; ++i) p[i] = __shfl_xor(v[i], 32);
                top16_of_two(v, p);
#pragma unroll
                for (int i = 0; i < 16; ++i) { L[c][i] = v[i]; ktab[(c * 16 + i) * 64 + lane] = (int)(__builtin_bit_cast(unsigned, v[i]) & 127u); }
            }
            float cnd[64];
            { int n = 0;
#pragma unroll
              for (int i = 0; i < 16; ++i)
#pragma unroll
                  for (int j = 0; j < 16; ++j) if ((i + 1) * (j + 1) <= 16) { cnd[n] = __builtin_bit_cast(float, (__builtin_bit_cast(unsigned, L[0][i] + L[1][j]) & ~255u) | (unsigned)((i << 4) | j)); ++n; }
#pragma unroll
              for (int q = 50; q < 64; ++q) cnd[q] = -3.0e38f; }
            top16_of_64(cnd);
            float mx = __builtin_bit_cast(float, __builtin_bit_cast(unsigned, cnd[0]) & ~255u), sum = 0.f; float ex[16];
#pragma unroll
            for (int i = 0; i < 16; ++i) { ex[i] = __expf(__builtin_bit_cast(float, __builtin_bit_cast(unsigned, cnd[i]) & ~255u) - mx); sum += ex[i]; }
            const float inv = 1.f / sum;
            LDS_WAIT(); asm volatile("" ::: "memory");
            if (hh == 0) {
#pragma unroll
                for (int i = 0; i < 16; ++i) { const unsigned bits = __builtin_bit_cast(unsigned, cnd[i]); const int ia = (bits >> 4) & 15, jb = bits & 15;
                    const int e = ktab[ia * 64 + lane] * 128 + ktab[(16 + jb) * 64 + lane];
                    tok_id[(tt * 32 + r32) * 128 + h * 16 + i] = e; tok_gt[(tt * 32 + r32) * 128 + h * 16 + i] = ex[i] * inv; }
            }
            LDS_WAIT(); asm volatile("" ::: "memory");
        }
        __syncthreads();
        for (int t8 = 0; t8 < 8; ++t8) { const int tk = F.wave * 8 + t8; const size_t ob = (size_t)(tok0 + tk) * 128;
            EIDX[ob + lane] = tok_id[tk * 128 + lane]; EIDX[ob + 64 + lane] = tok_id[tk * 128 + 64 + lane]; GATE[ob + lane] = tok_gt[tk * 128 + lane]; GATE[ob + 64 + lane] = tok_gt[tk * 128 + 64 + lane]; }
        __syncthreads();
    }
}


__device__ __forceinline__ void gla_prep_phase(Frame& F, const Args& a) {
    unsigned char* ws = a.ws; const bf16* PROJ;
    const int w = F.wave;
    LAS unsigned char* L = F.lds;
    LAS unsigned char* Qraw = L; LAS unsigned char* Kraw = L + 16384; LAS unsigned char* Vraw = L + 32768; LAS float* GDf = (LAS float*)(L + 65536); LAS float* GSUM = (LAS float*)(L + 73728);
    LAS unsigned char* IMGQ = L + 77824; LAS unsigned char* IMGK = L + 95232; LAS unsigned char* IMGE = L + 112640; LAS unsigned char* AMI = L + 32768;
    for (int it = F.vcu; it < 1024; it += F.G) {
        const int b = it >> 8, h = (it >> 6) & 3, n = it & 63; const size_t row0 = (size_t)b * SEQ + n * 64;
        ws = opaque(ws); PROJ = (const bf16*)(ws + WS_PROJ);
        int tid = opaque_v(F.tid), lane = tid & 63, r32 = lane & 31, hh = lane >> 5;
#pragma unroll
        for (int i = 0; i < 2; ++i) { const int idx = tid + 512 * i, r = idx >> 4, c = idx & 15;
            *(LAS v4u*)(Qraw + r * 256 + c * 16) = *(const GAS v4u*)(PROJ + (row0 + r) * NINP + O_GQ + h * 128 + c * 8);
            *(LAS v4u*)(Kraw + r * 256 + c * 16) = *(const GAS v4u*)(PROJ + (row0 + r) * NINP + O_GK + h * 128 + c * 8); }
#pragma unroll
        for (int i = 0; i < 4; ++i) { const int idx = tid + 512 * i, r = idx >> 5, c = idx & 31;
            *(LAS v4u*)(Vraw + r * 512 + c * 16) = *(const GAS v4u*)(PROJ + (row0 + r) * NINP + O_GV + h * 256 + c * 8); }
        if (tid < 256) { const int r = tid >> 2, c = tid & 3; const GAS float* gsrc = (const GAS float*)(ws + WS_GDB) + (row0 + r) * 32 + c * 8; const f32x4 g0 = *(const GAS f32x4*)gsrc, g1 = *(const GAS f32x4*)(gsrc + 4);
            *(LAS f32x4*)(GDf + r * 32 + c * 8) = g0; *(LAS f32x4*)(GDf + r * 32 + c * 8 + 4) = g1; }
        __syncthreads();
#pragma unroll
        for (int ks = 0; ks < 4; ++ks) { unsigned pk[4];
#pragma unroll
            for (int p = 0; p < 4; ++p) { const int s0 = 16 * ks + 8 * hh + 2 * p; const unsigned lo = *(const LAS unsigned short*)(Vraw + s0 * 512 + (32 * w + r32) * 2), hi = *(const LAS unsigned short*)(Vraw + (s0 + 1) * 512 + (32 * w + r32) * 2); pk[p] = lo | (hi << 16); }
            *(GAS v4u*)((unsigned char*)a.out + OUT_GT_VT + (size_t)it * 32768 + (w * 4 + ks) * 1024 + lane * 16) = (v4u){pk[0], pk[1], pk[2], pk[3]}; }
        for (int dir = 0; dir < 2; ++dir) {
            const size_t idir = (size_t)(((b * 4 + h) * 2 + dir) * 64 + n); ws = opaque(ws); tid = opaque_v(tid); lane = tid & 63; r32 = lane & 31; hh = lane >> 5;
            {
                const int d = tid & 127, tq = tid >> 7; const float* upp = (dir ? a.in[5] : a.in[3]) + h * 128 + d; const float bias = (dir ? a.in[6] : a.in[4])[h * 128 + d];
                float up[16];
#pragma unroll
                for (int r = 0; r < 16; ++r) up[r] = upp[r * 512];
                float c[16];
#pragma unroll
                for (int i = 0; i < 16; ++i) { const LAS float* g = GDf + (16 * tq + i) * 32 + dir * 16; float z = bias;
#pragma unroll
                    for (int r = 0; r < 16; ++r) z += g[r] * up[r];
                    c[i] = (fminf(z, 0.f) - __logf(1.f + __expf(-fabsf(z)))) * (1.f / 16.f); }
                if (dir == 0) {
#pragma unroll
                    for (int i = 1; i < 16; ++i) c[i] += c[i - 1];
                } else {
#pragma unroll
                    for (int i = 14; i >= 0; --i) c[i] += c[i + 1];
                }
                GSUM[(dir * 4 + tq) * 128 + d] = dir == 0 ? c[15] : c[0];
                __syncthreads();
                const float t0 = GSUM[(dir * 4 + 0) * 128 + d], t1 = GSUM[(dir * 4 + 1) * 128 + d], t2 = GSUM[(dir * 4 + 2) * 128 + d], t3 = GSUM[(dir * 4 + 3) * 128 + d];
                const float Bt = (t0 + t1) + (t2 + t3);
                float off;
                if (dir == 0) off = (tq > 0 ? t0 : 0.f) + (tq > 1 ? t1 : 0.f) + (tq > 2 ? t2 : 0.f);
                else off = (tq < 1 ? t1 : 0.f) + (tq < 2 ? t2 : 0.f) + (tq < 3 ? t3 : 0.f);
                unsigned kep[8];
#pragma unroll
                for (int i = 0; i < 16; i += 2) { float ke2[2];
#pragma unroll
                    for (int q = 0; q < 2; ++q) { const int t = 16 * tq + i + q; const float bi = c[i + q] + off;
                        const float qv = bf2f(*(const LAS unsigned short*)(Qraw + t * 256 + d * 2)), kv = bf2f(*(const LAS unsigned short*)(Kraw + t * 256 + d * 2));
                        *(LAS unsigned short*)(IMGQ + t * 272 + d * 2) = (unsigned short)pk2(qv * 0.08838834764831845f * __expf(bi), 0.f);
                        *(LAS unsigned short*)(IMGK + t * 272 + d * 2) = (unsigned short)pk2(kv * __expf(-bi), 0.f);
                        ke2[q] = kv * __expf(Bt - bi); }
                    kep[i >> 1] = pk2(ke2[0], ke2[1]); }
                *(LAS v4u*)(IMGE + d * 144 + (16 * tq) * 2) = (v4u){kep[0], kep[1], kep[2], kep[3]};
                *(LAS v4u*)(IMGE + d * 144 + (16 * tq + 8) * 2) = (v4u){kep[4], kep[5], kep[6], kep[7]};
                if (tq == 0) ((GAS float*)((unsigned char*)a.out + OUT_GT_DEC))[idir * 128 + d] = __expf(Bt);
            }
            __syncthreads();
            if (w < 4) {
                const int si = w >> 1, ti = w & 1; f32x16 acc = (f32x16){0.f, 0.f, 0.f, 0.f, 0.f, 0.f, 0.f, 0.f, 0.f, 0.f, 0.f, 0.f, 0.f, 0.f, 0.f, 0.f};
#pragma unroll
                for (int ks = 0; ks < 8; ++ks) { const bf16x8 ak = *(const LAS bf16x8*)(IMGK + (32 * si + r32) * 272 + (16 * ks + 8 * hh) * 2), bq = *(const LAS bf16x8*)(IMGQ + (32 * ti + r32) * 272 + (16 * ks + 8 * hh) * 2);
                    acc = __builtin_amdgcn_mfma_f32_32x32x16_bf16(ak, bq, acc, 0, 0, 0); }
                const int t = 32 * ti + r32;
#pragma unroll
                for (int qd = 0; qd < 4; ++qd) { float v4[4];
#pragma unroll
                    for (int i = 0; i < 4; ++i) { const int sidx = 32 * si + 8 * qd + 4 * hh + i; const float x = acc[4 * qd + i]; const bool keep = dir == 0 ? (sidx <= t) : (sidx >= t); v4[i] = keep ? x : 0.f; }
                    *(LAS unsigned long long*)(AMI + t * 144 + (32 * si + 8 * qd + 4 * hh) * 2) = (unsigned long long)pk2(v4[0], v4[1]) | ((unsigned long long)pk2(v4[2], v4[3]) << 32); }
            } else {
                const int w4 = w - 4;
#pragma unroll
                for (int q = 0; q < 4; ++q) { const int bq = w4 * 4 + q, tt = bq >> 3, ks = bq & 7, j = ks >> 1, u = ks & 1; const int t = 32 * tt + r32;
                    const unsigned long long p0 = *(const LAS unsigned long long*)(IMGQ + t * 272 + (32 * j + 16 * u + 4 * hh) * 2), p1 = *(const LAS unsigned long long*)(IMGQ + t * 272 + (32 * j + 16 * u + 8 + 4 * hh) * 2);
                    *(GAS v4u*)(ws + WS_GT_QD + idir * 16384 + bq * 1024 + lane * 16) = (v4u){(unsigned)p0, (unsigned)(p0 >> 32), (unsigned)p1, (unsigned)(p1 >> 32)}; }
#pragma unroll
                for (int q = 0; q < 4; ++q) { const int bk = w4 * 4 + q, j = bk >> 2, ks = bk & 3; const int d = 32 * j + r32;
                    *(GAS v4u*)(ws + WS_GT_KE + idir * 16384 + bk * 1024 + lane * 16) = *(const LAS v4u*)(IMGE + d * 144 + (16 * ks + 8 * hh) * 2); }
            }
            __syncthreads();
            { const int tt = w >> 2, ks = w & 3; const int t = 32 * tt + r32;
              *(GAS v4u*)((unsigned char*)a.out + OUT_GT_AM + idir * 8192 + w * 1024 + lane * 16) = *(const LAS v4u*)(AMI + t * 144 + (16 * ks + 8 * hh) * 2); }
            __syncthreads();
        }
    }
}

__device__ __forceinline__ void gla_seq_phase(Frame& F, const Args& a) {
    unsigned char* ws = a.ws;
    const int w = F.wave;
    constexpr int GBUF = 57856;
    for (int unit = F.vcu; unit < 64; unit += F.G) {
        const int dir = unit & 1, eh = (unit >> 1) & 1, bh = unit >> 2, b = bh >> 2, h = bh & 3;
        if (w >= 4) {
            const int lt = opaque_v(F.tid) - 256;
            v4u A[15], B[15];
#define GLA_LOAD(R, NS) do { const int n_ = dir ? 63 - (NS) : (NS); const size_t idir_ = (size_t)((bh * 2 + dir) * 64 + n_), iv_ = (size_t)(bh * 64 + n_); const unsigned char* o_ = opaque((const unsigned char*)a.out); const unsigned char* w_ = opaque(ws); \
            const GAS v4u* gq_ = (const GAS v4u*)(w_ + WS_GT_QD + idir_ * 16384); const GAS v4u* gk_ = (const GAS v4u*)(w_ + WS_GT_KE + idir_ * 16384); const GAS v4u* ga_ = (const GAS v4u*)(o_ + OUT_GT_AM + idir_ * 8192); \
            const GAS v4u* gv_ = (const GAS v4u*)(o_ + OUT_GT_VT + iv_ * 32768 + eh * 16384); const GAS v4u* gd_ = (const GAS v4u*)(o_ + OUT_GT_DEC + idir_ * 512); \
            _Pragma("unroll") for (int i = 0; i < 4; ++i) { R[i] = gq_[lt + 256 * i]; R[4 + i] = gk_[lt + 256 * i]; R[10 + i] = gv_[lt + 256 * i]; } R[8] = ga_[lt]; R[9] = ga_[lt + 256]; R[14] = gd_[lt & 31]; } while (0)
#define GLA_WRITE(R, BUF) do { LAS v4u* d_ = (LAS v4u*)(F.lds + (BUF) * GBUF); \
            _Pragma("unroll") for (int i = 0; i < 4; ++i) { d_[lt + 256 * i] = R[i]; d_[1024 + lt + 256 * i] = R[4 + i]; d_[2560 + lt + 256 * i] = R[10 + i]; } d_[2048 + lt] = R[8]; d_[2048 + lt + 256] = R[9]; if (lt < 32) d_[3584 + lt] = R[14]; } while (0)
            GLA_LOAD(A, 0); GLA_LOAD(B, 1);
            GLA_WRITE(A, 0);
            __syncthreads();
#pragma unroll 1
            for (int ns = 0; ns < 64; ns += 2) {
                if (ns + 2 < 64) GLA_LOAD(A, ns + 2);
                GLA_WRITE(B, 1);
                __syncthreads();
                if (ns + 3 < 64) GLA_LOAD(B, ns + 3);
                if (ns + 2 < 64) GLA_WRITE(A, 0);
                __syncthreads();
            }
#undef GLA_LOAD
#undef GLA_WRITE
        } else {
            f32x16 S[4];
#pragma unroll
            for (int j = 0; j < 4; ++j) S[j] = (f32x16){0.f, 0.f, 0.f, 0.f, 0.f, 0.f, 0.f, 0.f, 0.f, 0.f, 0.f, 0.f, 0.f, 0.f, 0.f, 0.f};
            __syncthreads();
#pragma unroll 1
            for (int ns = 0; ns < 64; ++ns) {
                const int n = dir ? 63 - ns : ns;
                const int lane = opaque_v(F.lane), r32 = lane & 31, hh = lane >> 5;
                LAS unsigned char* QDl = F.lds + (ns & 1) * GBUF; LAS unsigned char* KEl = QDl + 16384; LAS unsigned char* AMl = QDl + 32768; LAS unsigned char* VTl = QDl + 40960; LAS float* DECl = (LAS float*)(QDl + 57344);
                GAS bf16* Out = (GAS bf16*)(opaque(ws) + (dir ? WS_OB : WS_OF));
                bf16x8 vf[4];
#pragma unroll
                for (int ks = 0; ks < 4; ++ks) vf[ks] = *(const LAS bf16x8*)(VTl + (w * 4 + ks) * 1024 + lane * 16);
                f32x16 o[2];
#pragma unroll
                for (int tt = 0; tt < 2; ++tt) o[tt] = (f32x16){0.f, 0.f, 0.f, 0.f, 0.f, 0.f, 0.f, 0.f, 0.f, 0.f, 0.f, 0.f, 0.f, 0.f, 0.f, 0.f};
#pragma unroll
                for (int ks8 = 0; ks8 < 8; ++ks8) { const int j = ks8 >> 1, u = ks8 & 1; v4u sb;
                    sb.x = pg8::cvt_pk_bf16(S[j][8 * u + 0], S[j][8 * u + 1]); sb.y = pg8::cvt_pk_bf16(S[j][8 * u + 2], S[j][8 * u + 3]); sb.z = pg8::cvt_pk_bf16(S[j][8 * u + 4], S[j][8 * u + 5]); sb.w = pg8::cvt_pk_bf16(S[j][8 * u + 6], S[j][8 * u + 7]);
                    const bf16x8 bs = __builtin_bit_cast(bf16x8, sb);
#pragma unroll
                    for (int tt = 0; tt < 2; ++tt) { const bf16x8 aq = *(const LAS bf16x8*)(QDl + (tt * 8 + ks8) * 1024 + lane * 16); o[tt] = __builtin_amdgcn_mfma_f32_32x32x16_bf16(aq, bs, o[tt], 0, 0, 0); } }
#pragma unroll
                for (int ks = 0; ks < 4; ++ks)
#pragma unroll
                    for (int tt = 0; tt < 2; ++tt) { const bf16x8 am = *(const LAS bf16x8*)(AMl + (tt * 4 + ks) * 1024 + lane * 16); o[tt] = __builtin_amdgcn_mfma_f32_32x32x16_bf16(am, vf[ks], o[tt], 0, 0, 0); }
#pragma unroll
                for (int tt = 0; tt < 2; ++tt)
#pragma unroll
                    for (int r = 0; r < 16; ++r) { const int t = 32 * tt + (r & 3) + 8 * (r >> 2) + 4 * hh; const float x = o[tt][r];
                        Out[((size_t)b * SEQ + 64 * n + t) * 1024 + h * 256 + 32 * (eh * 4 + w) + r32] = (bf16)pk2(x, 0.f); }
#pragma unroll
                for (int j = 0; j < 4; ++j) {
#pragma unroll
                    for (int q = 0; q < 4; ++q) { const f32x4 dv = *(const LAS f32x4*)(DECl + 32 * j + 8 * q + 4 * hh); S[j][4 * q + 0] *= dv.x; S[j][4 * q + 1] *= dv.y; S[j][4 * q + 2] *= dv.z; S[j][4 * q + 3] *= dv.w; }
#pragma unroll
                    for (int ks = 0; ks < 4; ++ks) { const bf16x8 ak = *(const LAS bf16x8*)(KEl + (j * 4 + ks) * 1024 + lane * 16); S[j] = __builtin_amdgcn_mfma_f32_32x32x16_bf16(ak, vf[ks], S[j], 0, 0, 0); } }
                __syncthreads();
            }
        }
    }
}

typedef short v4i16_t __attribute__((ext_vector_type(4)));
__device__ __forceinline__ void attn_phase(Frame& F, const Args& a, int qslot) {
    unsigned char* ws = a.ws; const bf16* PROJ;
    const int w = F.wave;
    volatile LAS int* uword = (volatile LAS int*)(F.lds + 2 * 78336);
    constexpr int NUNITS = 64 * 3 * 32;
#define ATT_DECODE(U) const int bh = (U) / 96, rem = (U) - bh * 96, p = rem >> 5, idx = rem & 31; const int lgd = 2 * p, d = 1 << lgd; \
        const int r = idx >> (5 - lgd), J = idx & ((32 >> lgd) - 1), Lc = SEQ >> lgd; const int b = bh >> 4, h = bh & 15; const int m0 = 128 * J - 64;
    v4u kx[4], vx[4]; v4u qw[2];
#define ATT_LOAD(U) do { ATT_DECODE(U) ws = opaque(ws); PROJ = (const bf16*)(ws + WS_PROJ); const int tid_ = opaque_v(F.tid); \
        _Pragma("unroll") for (int i = 0; i < 4; ++i) { const int kr = (tid_ >> 3) + 64 * i, ch = tid_ & 7; const int mp = m0 + kr; kx[i] = (v4u){0u, 0u, 0u, 0u}; vx[i] = kx[i]; \
            if (mp >= 0 && mp < Lc) { const bf16* src = PROJ + ((size_t)b * SEQ + r + d * mp) * NINP + O_AK + h * 64 + ch * 8; kx[i] = *(const GAS v4u*)src; vx[i] = *(const GAS v4u*)(src + (O_AV - O_AK)); } } \
        const int tokq_ = r + d * (128 * J + 16 * w + (tid_ & 15)); \
        _Pragma("unroll") for (int sft = 0; sft < 2; ++sft) qw[sft] = *(const GAS v4u*)(PROJ + ((size_t)b * SEQ + tokq_) * NINP + O_AQ + h * 64 + 32 * sft + 8 * ((tid_ & 63) >> 4)); } while (0)
    float tab[40];
    { const int l0 = opaque_v(F.lane);
#pragma unroll
      for (int c = 0; c < 40; ++c) { const int kb = c >> 3, uu = (c >> 2) & 1, rho = c & 3; const int jo = 32 * kb + 8 * (l0 >> 4) + 4 * uu + rho - 64 - (l0 & 15); const int aj = jo < 0 ? -jo : jo; tab[c] = aj <= 64 ? (float)aj : 3.0e38f; } }
    if (F.tid == 0) { uword[0] = (int)__hip_atomic_fetch_add((unsigned*)(F.ctl + CW_ATTQ + 64 * qslot), 1u, __ATOMIC_RELAXED, __HIP_MEMORY_SCOPE_AGENT); uword[1] = (int)__hip_atomic_fetch_add((unsigned*)(F.ctl + CW_ATTQ + 64 * qslot), 1u, __ATOMIC_RELAXED, __HIP_MEMORY_SCOPE_AGENT); }
    __syncthreads();
    int u = __builtin_amdgcn_readfirstlane(uword[0]), un = __builtin_amdgcn_readfirstlane(uword[1]); int par = 0;
#define ATT_WRITE(BUF) do { const int tid_ = opaque_v(F.tid); LAS unsigned char* Kw = F.lds + (BUF) * 78336; LAS unsigned char* Vw = Kw + 39168; \
        _Pragma("unroll") for (int i = 0; i < 4; ++i) { const int kr = (tid_ >> 3) + 64 * i, ch = tid_ & 7; *(LAS v4u*)(Kw + kr * 144 + ch * 16) = kx[i]; *(LAS v4u*)(Vw + kr * 144 + ch * 16) = vx[i]; } \
        if (tid_ < 128) { const int kr = 256 + (tid_ >> 3), ch = tid_ & 7; *(LAS v4u*)(Kw + kr * 144 + ch * 16) = (v4u){0u, 0u, 0u, 0u}; *(LAS v4u*)(Vw + kr * 144 + ch * 16) = (v4u){0u, 0u, 0u, 0u}; } } while (0)
    v4u qwc[2];
    if (u < NUNITS) { ATT_LOAD(u); ATT_WRITE(0); qwc[0] = qw[0]; qwc[1] = qw[1]; }
    __syncthreads();
    int bufi = 0;
    while (u < NUNITS) {
        const int tid = opaque_v(F.tid), lane = tid & 63, q16 = lane & 15, g = lane >> 4;
        int qnext = 0; if (tid == 0) qnext = (int)__hip_atomic_fetch_add((unsigned*)(F.ctl + CW_ATTQ + 64 * qslot), 1u, __ATOMIC_RELAXED, __HIP_MEMORY_SCOPE_AGENT);
        LAS unsigned char* Kl = F.lds + bufi * 78336; LAS unsigned char* Vl = Kl + 39168;
        bf16x8 qf[2];
#pragma unroll
        for (int sft = 0; sft < 2; ++sft) { v4u qs; constexpr float QS = 0.125f * 1.4426950408889634f; qs.x = pk2(bflo(qwc[sft].x) * QS, bfhi(qwc[sft].x) * QS); qs.y = pk2(bflo(qwc[sft].y) * QS, bfhi(qwc[sft].y) * QS); qs.z = pk2(bflo(qwc[sft].z) * QS, bfhi(qwc[sft].z) * QS); qs.w = pk2(bflo(qwc[sft].w) * QS, bfhi(qwc[sft].w) * QS);
            qf[sft] = __builtin_bit_cast(bf16x8, qs); }
        ATT_DECODE(u)
        const int tokq = r + d * (128 * J + 16 * w + q16);
        if (un < NUNITS) ATT_LOAD(un);
        const float nslope = -exp2f(-0.5f * (float)(h + 1)) * (float)d * 1.4426950408889634f;
        const bool inrange = (m0 + 16 * w >= 0) && (m0 + 16 * w + 159 < Lc);
        float sv[5][2][4]; float mx = -3.0e38f;
#pragma unroll
        for (int kb = 0; kb < 5; ++kb)
#pragma unroll
            for (int uu = 0; uu < 2; ++uu) { f32x4 acc = (f32x4){0.f, 0.f, 0.f, 0.f};
                const int krow = 16 * w + 32 * kb + 8 * (q16 >> 2) + 4 * uu + (q16 & 3);
#pragma unroll
                for (int sft = 0; sft < 2; ++sft) { const bf16x8 ak = *(const LAS bf16x8*)(Kl + krow * 144 + (32 * sft + 8 * g) * 2); acc = __builtin_amdgcn_mfma_f32_16x16x32_bf16(ak, qf[sft], acc, 0, 0, 0); }
#pragma unroll
                for (int rho = 0; rho < 4; ++rho) { const float x = acc[rho]; sv[kb][uu][rho] = __builtin_fmaf(nslope, tab[kb * 8 + uu * 4 + rho], x); } }
        if (!inrange) {
#pragma unroll
            for (int kb = 0; kb < 5; ++kb)
#pragma unroll
                for (int uu = 0; uu < 2; ++uu)
#pragma unroll
                    for (int rho = 0; rho < 4; ++rho) { const int mp = m0 + 16 * w + 32 * kb + 8 * g + 4 * uu + rho; if (mp < 0 || mp >= Lc) sv[kb][uu][rho] = -3.0e38f; } }
#pragma unroll
        for (int kb = 0; kb < 5; ++kb)
#pragma unroll
            for (int uu = 0; uu < 2; ++uu)
#pragma unroll
                for (int rho = 0; rho < 4; ++rho) mx = fmaxf(mx, sv[kb][uu][rho]);
        mx = fmaxf(mx, __shfl_xor(mx, 16)); mx = fmaxf(mx, __shfl_xor(mx, 32));
        float lsum = 0.f; bf16x8 pf[5];
#pragma unroll
        for (int kb = 0; kb < 5; ++kb) { float e[8];
#pragma unroll
            for (int uu = 0; uu < 2; ++uu)
#pragma unroll
                for (int rho = 0; rho < 4; ++rho) { const float pe = __builtin_amdgcn_exp2f(sv[kb][uu][rho] - mx); e[uu * 4 + rho] = pe; lsum += pe; }
            v4u pw; pw.x = pk2(e[0], e[1]); pw.y = pk2(e[2], e[3]); pw.z = pk2(e[4], e[5]); pw.w = pk2(e[6], e[7]); pf[kb] = __builtin_bit_cast(bf16x8, pw); }
        lsum += __shfl_xor(lsum, 16); lsum += __shfl_xor(lsum, 32);
        f32x4 oT[4];
#pragma unroll
        for (int nn = 0; nn < 4; ++nn) oT[nn] = (f32x4){0.f, 0.f, 0.f, 0.f};
#pragma unroll
        for (int kb = 0; kb < 5; ++kb)
#pragma unroll
            for (int nn = 0; nn < 4; ++nn) { const LAS unsigned char* va = Vl + (16 * w + 32 * kb + 8 * g + (q16 >> 2)) * 144 + (16 * nn + 4 * (q16 & 3)) * 2;
                const v4i16_t lo = __builtin_amdgcn_ds_read_tr16_b64_v4i16((LAS v4i16_t*)va), hi = __builtin_amdgcn_ds_read_tr16_b64_v4i16((LAS v4i16_t*)(va + 4 * 144));
                const bf16x8 vf = (bf16x8){lo[0], lo[1], lo[2], lo[3], hi[0], hi[1], hi[2], hi[3]};
                oT[nn] = __builtin_amdgcn_mfma_f32_16x16x32_bf16(vf, pf[kb], oT[nn], 0, 0, 0); }
        { const size_t rec = ((size_t)p * M + (size_t)b * SEQ + tokq) * 16 + h; GAS bf16* op = (GAS bf16*)(opaque(ws) + WS_ATTP) + rec * 64 + 4 * g;
#pragma unroll
          for (int nn = 0; nn < 4; ++nn) *(GAS unsigned long long*)(op + 16 * nn) = (unsigned long long)pk2(oT[nn][0], oT[nn][1]) | ((unsigned long long)pk2(oT[nn][2], oT[nn][3]) << 32);
          if (g == 0) { GAS float* ml = (GAS float*)(opaque(ws) + WS_ATTML) + rec * 2; ml[0] = mx * 0.6931471805599453f; ml[1] = lsum; } }
        if (un < NUNITS) { ATT_WRITE(bufi ^ 1); qwc[0] = qw[0]; qwc[1] = qw[1]; }
        if (tid == 0) uword[par] = qnext;
        __syncthreads();
        u = un; un = __builtin_amdgcn_readfirstlane(uword[par]); par ^= 1; bufi ^= 1;
    }
#undef ATT_WRITE
#undef ATT_DECODE
#undef ATT_LOAD
}

typedef __bf16 bf16x2_t __attribute__((ext_vector_type(2)));
typedef int i32x4 __attribute__((ext_vector_type(4)));
__device__ __forceinline__ void peer_convert_tables(Frame& F, const Args& a, int qslot) {
    unsigned char* ws = a.ws; const int lane = F.lane; volatile LAS int* uword = (volatile LAS int*)(F.lds + 2 * 78336 + 64);
    for (;;) {
        __syncthreads();
        if (F.tid == 0) uword[0] = (int)__hip_atomic_fetch_add((unsigned*)(F.ctl + CW_CONVQ + 64 * qslot), 1u, __ATOMIC_RELAXED, __HIP_MEMORY_SCOPE_AGENT);
        __syncthreads();
        const int blk = __builtin_amdgcn_readfirstlane(uword[0]);
        if (blk >= 2 * PEER_E / 64) break;
#pragma unroll 1
        for (int i = 0; i < 8; ++i) { const int r = blk * 64 + F.wave * 8 + i;
            const int e = r & (PEER_E - 1); const bool isv = r >= PEER_E;
            const float* src = (isv ? a.in[14] : a.in[13]) + (size_t)e * DM;
            unsigned char* dst = (unsigned char*)a.out + (isv ? OUT_V8 : OUT_U8) + (size_t)e * DM; float* sc = (float*)(ws + (isv ? WS_SV : WS_SU));
            f32x4 v[8]; float am = 0.f;
#pragma unroll
            for (int j = 0; j < 8; ++j) { v[j] = *(const f32x4*)(src + 256 * j + 4 * lane); am = fmaxf(am, fmaxf(fmaxf(fabsf(v[j].x), fabsf(v[j].y)), fmaxf(fabsf(v[j].z), fabsf(v[j].w)))); }
            am = wave_max(am); am = fmaxf(am, 1e-30f);
            const float inv = 440.f / am;
#pragma unroll
            for (int j = 0; j < 8; ++j) { int p = __builtin_amdgcn_cvt_pk_fp8_f32(v[j].x * inv, v[j].y * inv, 0, false); p = __builtin_amdgcn_cvt_pk_fp8_f32(v[j].z * inv, v[j].w * inv, p, true);
                *(int*)(dst + 256 * j + 4 * lane) = p; }
            if (lane == 0) sc[e] = am * (1.f / 440.f); }
    }
}

__device__ __forceinline__ float dpp_row_sum(float x) {
#define PEER_DPP(ctrl) x += __builtin_bit_cast(float, __builtin_amdgcn_update_dpp(0, __builtin_bit_cast(int, x), ctrl, 0xF, 0xF, false))
    PEER_DPP(0xB1); PEER_DPP(0x4E); PEER_DPP(0x141); PEER_DPP(0x140);
#undef PEER_DPP
    return x;
}
template <bool VPH, int PBS> __device__ __forceinline__ void peer_uv_phase(Frame& F, const Args& a) {
    unsigned char* ws = a.ws; GAS bf16* H = (GAS bf16*)(ws + WS_HB); const GAS float* g2 = (const GAS float*)a.in[10];
    const int sl = blockIdx.x & 7, rk = blockIdx.x >> 3, nrk = F.G >> 3, tpw = M / nrk / NWAVES, nq = tpw / 4;
    const unsigned char* TAB; const GAS int* EIDX; const GAS float* SSQ; const GAS float* PW; GAS float* PD; GAS float* SSQ2;
    LAS int* idt = (LAS int*)(F.lds + F.wave * 8192);
    LAS float* wt = (LAS float*)(F.lds + F.wave * 8192 + 4096);
    const int t0 = (rk * NWAVES + F.wave) * tpw;
#define PEER_STAGE(QI) do { const size_t tb_ = (size_t)(t0 + 4 * (QI) + a4) * 128; const int bf_ = ((QI) & 1) * 512; _Pragma("unroll") for (int k = 0; k < 8; ++k) { \
        idt[bf_ + (16 * k + q) * 4 + a4] = EIDX[tb_ + 16 * k + q]; if (VPH) wt[bf_ + (16 * k + q) * 4 + a4] = PW[tb_ + 16 * k + q]; } } while (0)
#define PEER_ISSUE(R, QI, WB) do { const int bf_ = ((QI) & 1) * 512 + (WB) * (4 * PBS) + a4; _Pragma("unroll") for (int j = 0; j < PBS; ++j) { const int e_ = idt[bf_ + 4 * j]; R[j] = ldu<i32x4>(TAB, (unsigned)e_ * 2048u + (unsigned)(16 * q)); } } while (0)
    unsigned xq[8]; float acc[16];
#define PEER_QUAD_BEGIN(QI) do { const size_t t_ = (size_t)(t0 + 4 * (QI) + a4); \
        if (!VPH) { f32x4 hq[4]; { const v4u h0_ = *(const GAS v4u*)(H + t_ * DM + 256 * sl + 16 * q), h1_ = *(const GAS v4u*)(H + t_ * DM + 256 * sl + 16 * q + 8); \
            hq[0] = (f32x4){bflo(h0_.x), bfhi(h0_.x), bflo(h0_.y), bfhi(h0_.y)}; hq[1] = (f32x4){bflo(h0_.z), bfhi(h0_.z), bflo(h0_.w), bfhi(h0_.w)}; hq[2] = (f32x4){bflo(h1_.x), bfhi(h1_.x), bflo(h1_.y), bfhi(h1_.y)}; hq[3] = (f32x4){bflo(h1_.z), bfhi(h1_.z), bflo(h1_.w), bfhi(h1_.w)}; }  const float pss_ = dpp_row_sum(SSQ[t_ * 32 + q] + SSQ[t_ * 32 + 16 + q]); const float rstd_ = 1.f / sqrtf(pss_ * (1.f / DM) + EPS); f32x4 gv[4]; \
            _Pragma("unroll") for (int k = 0; k < 4; ++k) gv[k] = *(const GAS f32x4*)(g2 + 256 * sl + 16 * q + 4 * k); \
            _Pragma("unroll") for (int k = 0; k < 4; ++k) { xq[2 * k] = pk2(hq[k].x * rstd_ * gv[k].x, hq[k].y * rstd_ * gv[k].y); xq[2 * k + 1] = pk2(hq[k].z * rstd_ * gv[k].z, hq[k].w * rstd_ * gv[k].w); } } \
        else { _Pragma("unroll") for (int k = 0; k < 16; ++k) acc[k] = 0.f; } } while (0)
#define PEER_COMPUTE(R, QI, WB) do { if (!VPH) { float pdb_ = 0.f; _Pragma("unroll") for (int j = 0; j < PBS; ++j) { float d_ = 0.f; _Pragma("unroll") for (int k = 0; k < 4; ++k) { const int dw_ = R[j][k]; \
                d_ = __builtin_amdgcn_fdot2_f32_bf16(__builtin_amdgcn_cvt_scalef32_pk_bf16_fp8(dw_, 1.0f, false), __builtin_bit_cast(bf16x2_t, xq[2 * k]), d_, false); \
                d_ = __builtin_amdgcn_fdot2_f32_bf16(__builtin_amdgcn_cvt_scalef32_pk_bf16_fp8(dw_, 1.0f, true), __builtin_bit_cast(bf16x2_t, xq[2 * k + 1]), d_, false); } \
                d_ = dpp_row_sum(d_); pdb_ = (q == j) ? d_ : pdb_; } \
            if (q < PBS) PD[((size_t)(t0 + 4 * (QI) + a4) * 8 + sl) * 128 + PBS * (WB) + q] = pdb_; } \
        else { const int bf_ = ((QI) & 1) * 512 + (WB) * (4 * PBS) + a4; _Pragma("unroll") for (int j = 0; j < PBS; ++j) { const float w_ = wt[bf_ + 4 * j]; int r0_ = R[j][0], r1_ = R[j][1], r2_ = R[j][2], r3_ = R[j][3]; asm volatile("" : "+v"(r0_), "+v"(r1_), "+v"(r2_), "+v"(r3_));     \
                _Pragma("unroll") for (int k = 0; k < 4; ++k) { const int dw_ = k == 0 ? r0_ : k == 1 ? r1_ : k == 2 ? r2_ : r3_; \
                const f32x2 lo_ = __builtin_amdgcn_cvt_pk_f32_fp8(dw_, false), hi_ = __builtin_amdgcn_cvt_pk_f32_fp8(dw_, true); \
                acc[4 * k + 0] += w_ * lo_.x; acc[4 * k + 1] += w_ * lo_.y; acc[4 * k + 2] += w_ * hi_.x; acc[4 * k + 3] += w_ * hi_.y; } } } } while (0)
#define PEER_QUAD_END(QI) do { if (VPH) { const size_t t_ = (size_t)(t0 + 4 * (QI) + a4); GAS bf16* hp_ = H + t_ * DM + 256 * sl + 16 * q; const v4u h0_ = *(const GAS v4u*)hp_, h1_ = *(const GAS v4u*)(hp_ + 8); \
            float y_[16]; y_[0] = bflo(h0_.x); y_[1] = bfhi(h0_.x); y_[2] = bflo(h0_.y); y_[3] = bfhi(h0_.y); y_[4] = bflo(h0_.z); y_[5] = bfhi(h0_.z); y_[6] = bflo(h0_.w); y_[7] = bfhi(h0_.w); \
            y_[8] = bflo(h1_.x); y_[9] = bfhi(h1_.x); y_[10] = bflo(h1_.y); y_[11] = bfhi(h1_.y); y_[12] = bflo(h1_.z); y_[13] = bfhi(h1_.z); y_[14] = bflo(h1_.w); y_[15] = bfhi(h1_.w); \
            float ss_ = 0.f; _Pragma("unroll") for (int k = 0; k < 16; ++k) { y_[k] += acc[k]; ss_ += y_[k] * y_[k]; } \
            *(GAS v4u*)hp_ = (v4u){pk2(y_[0], y_[1]), pk2(y_[2], y_[3]), pk2(y_[4], y_[5]), pk2(y_[6], y_[7])}; *(GAS v4u*)(hp_ + 8) = (v4u){pk2(y_[8], y_[9]), pk2(y_[10], y_[11]), pk2(y_[12], y_[13]), pk2(y_[14], y_[15])}; \
            ss_ = dpp_row_sum(ss_); if (q == 0) SSQ2[t_ * 8 + sl] = ss_; } } while (0)
#pragma unroll 1
    for (int qi = 0; qi < nq; ++qi) {
        i32x4 rA[PBS], rB[PBS];
        const int lane = opaque_v(F.lane), a4 = lane >> 4, q = lane & 15; ws = opaque(ws); H = (GAS bf16*)(ws + WS_HB);
        TAB = opaque((const unsigned char*)a.out) + (VPH ? OUT_V8 : OUT_U8) + 256 * sl; EIDX = (const GAS int*)(ws + WS_EIDX); SSQ = (const GAS float*)(ws + WS_SSQ); PW = (const GAS float*)(ws + WS_PW); PD = (GAS float*)(ws + WS_PD); SSQ2 = (GAS float*)(ws + WS_SSQ2);
        PEER_STAGE(qi); LDS_WAIT(); asm volatile("" ::: "memory");
        PEER_ISSUE(rA, qi, 0);
        PEER_ISSUE(rB, qi, 1);
        PEER_QUAD_BEGIN(qi);
#pragma unroll
        for (int wb = 0; wb < 128 / PBS; wb += 2) {
            PEER_COMPUTE(rA, qi, wb); if (wb + 2 < 128 / PBS) { PEER_ISSUE(rA, qi, wb + 2); }
            PEER_COMPUTE(rB, qi, wb + 1); if (wb + 3 < 128 / PBS) { PEER_ISSUE(rB, qi, wb + 3); }
        }
        PEER_QUAD_END(qi);
    }
#undef PEER_STAGE
#undef PEER_ISSUE
#undef PEER_QUAD_BEGIN
#undef PEER_COMPUTE
#undef PEER_QUAD_END
}
__device__ __forceinline__ void peer_w_phase(Frame& F, const Args& a) {
    unsigned char* ws = a.ws; const float* PD = (const float*)(ws + WS_PD); const int* EIDX = (const int*)(ws + WS_EIDX); const float* GATE = (const float*)(ws + WS_GATE);
    const float* SU = (const float*)(ws + WS_SU); const float* SV = (const float*)(ws + WS_SV); float* PW = (float*)(ws + WS_PW);
    for (int i = F.vcu * 512 + F.tid; i < M * 128; i += F.G * 512) { const int t = i >> 7, p = i & 127; float d = 0.f;
#pragma unroll
        for (int sl = 0; sl < 8; ++sl) d += PD[((size_t)t * 8 + sl) * 128 + p];
        const int e = EIDX[i]; d *= SU[e];
        PW[i] = GATE[i] * 0.5f * d * (1.f + erff(d * 0.70710678118654752f)) * SV[e]; }
}
__device__ __forceinline__ void peer_n_phase(Frame& F, const Args& a) {
    unsigned char* ws = a.ws; const bf16* Y = (const bf16*)(ws + WS_HB); float* O = a.out; const float* gf = a.in[15]; const float* SSQ2 = (const float*)(ws + WS_SSQ2); const int lane = F.lane;
    for (int m = F.vcu * NWAVES + F.wave; m < M; m += F.G * NWAVES) {
        const f32x4 s0 = *(const f32x4*)(SSQ2 + (size_t)m * 8), s1 = *(const f32x4*)(SSQ2 + (size_t)m * 8 + 4);
        const float rf = 1.f / sqrtf((((s0.x + s0.y) + (s0.z + s0.w)) + ((s1.x + s1.y) + (s1.z + s1.w))) * (1.f / DM) + EPS);
#pragma unroll
        for (int j = 0; j < 4; ++j) { const v4u yw = *(const v4u*)(Y + (size_t)m * DM + 512 * j + 8 * lane); const f32x4 g0 = *(const f32x4*)(gf + 512 * j + 8 * lane), g1 = *(const f32x4*)(gf + 512 * j + 8 * lane + 4);
            *(f32x4*)(O + (size_t)m * DM + 512 * j + 8 * lane) = (f32x4){bflo(yw.x) * rf * g0.x, bfhi(yw.x) * rf * g0.y, bflo(yw.y) * rf * g0.z, bfhi(yw.y) * rf * g0.w};
            *(f32x4*)(O + (size_t)m * DM + 512 * j + 8 * lane + 4) = (f32x4){bflo(yw.z) * rf * g1.x, bfhi(yw.z) * rf * g1.y, bflo(yw.w) * rf * g1.z, bfhi(yw.w) * rf * g1.w}; }
    }
}

__global__ void __launch_bounds__(NWAVES * 64, 2) mk_fwd(Args args_in) {
    extern __shared__ __attribute__((aligned(16))) unsigned char lds[];
    Args args = args_in;
#pragma unroll
    for (int i = 0; i < 16; ++i) args.in[i] = (const float*)(const GAS float*)args_in.in[i];
    args.out = (float*)(GAS float*)args_in.out; args.ws = (unsigned char*)(GAS unsigned char*)args_in.ws;
    Frame F;
    F.lds = (LAS unsigned char*)lds;
    F.MISC = (volatile LAS unsigned*)(F.lds + MISC_OFF);
    F.tid = threadIdx.x; F.lane = F.tid & 63; F.wave = __builtin_amdgcn_readfirstlane(F.tid >> 6);
    F.G = gridDim.x; { const int bx = blockIdx.x; F.vcu = (F.G % 8 == 0) ? (bx % 8) * (F.G / 8) + bx / 8 : bx; }
    unsigned char* ws = args.ws;
    F.ctl = (gu32*)(ws + WS_CTL);
    for (int u = F.tid; u < (LDS_BYTES - LDSCTL_OFF) / 4; u += NWAVES * 64) ((LAS unsigned*)(F.lds + LDSCTL_OFF))[u] = 0u;
    __syncthreads();
    XcdBarrier bar = xcd_barrier_post((unsigned*)(F.ctl + CW_BAR) + args.li * XCD_BAR_WORDS, F.MISC + 8);
    const int lo = args.ph_lo, hi = args.ph_hi;
#define IN(k) (lo <= (k) && (k) < hi)
#define BOTH(k) (IN(k) && IN((k) + 1))
#define GRID_BAR() xcd_barrier(bar)

    if (IN(0)) { for (int rep = 0; rep < NREP(0); ++rep) p0_prologue(F, args); if (BOTH(0)) GRID_BAR(); }

    if (IN(1)) {
        pg8::Gemm g{(const bf16*)(ws + WS_XN), (const bf16*)(ws + WS_WIN), M, NINP, DM}; pg8::StaticOrder S; S.init(M, NINP, F.G, (int)blockIdx.x);
        pg8::EpiBf16<0> E{(bf16*)(ws + WS_PROJ), NINP, nullptr, 0, 0, 1.f};
        for (int rep = 0; rep < NREP(1); ++rep) pg8::gemm_phase<pg8::EpiBf16<0>, pg8::StaticOrder, PG8_ALIGN, PG8_SP2>(F.lds + RING_OFF, g, S, E);
        for (int rep = 0; rep < NREP(11); ++rep) gd_side_gemm(F, args);
        if (BOTH(1)) GRID_BAR();
    }
    if (IN(2)) {
        for (int rep = 0; rep < NREP(21); ++rep) gla_prep_phase(F, args);
        GRID_BAR();
        for (int rep = 0; rep < NREP(2); ++rep) gla_seq_phase(F, args);
        for (int rep = 0; rep < NREP(20); ++rep) attn_phase(F, args, rep);
        for (int rep = 0; rep < NREP(40); ++rep) peer_convert_tables(F, args, rep);
        if (BOTH(2)) GRID_BAR(); }
    if (IN(3)) { for (int rep = 0; rep < NREP(3); ++rep) p3_finalize(F, args); if (BOTH(3)) GRID_BAR(); }
    if (IN(4)) {
        pg8::Gemm g{(const bf16*)(ws + WS_XN), (const bf16*)(ws + WS_WOUT), M, DM, DM}; pg8::StaticOrder S; S.init(M, DM, F.G, (int)blockIdx.x);
        pg8::EpiRes E{args.in[0], (bf16*)(ws + WS_HB), (float*)(ws + WS_SSQ), DM};
        for (int rep = 0; rep < NREP(4); ++rep) pg8::gemm_phase<pg8::EpiRes, pg8::StaticOrder, PG8_ALIGN, PG8_SP2>(F.lds + RING_OFF, g, S, E);
        if (BOTH(4)) GRID_BAR();
    }
    if (IN(5)) {
        pg8::Gemm g{(const bf16*)(ws + WS_HB), (const bf16*)(ws + WS_WQ), M, DM, DM}; pg8::StaticOrder S; S.init(M, DM, F.G, (int)blockIdx.x);
        pg8::EpiRowScale E{(bf16*)(ws + WS_XN), DM, (const float*)(ws + WS_SSQ), 1.f / DM, EPS};
        for (int rep = 0; rep < NREP(5); ++rep) pg8::gemm_phase<pg8::EpiRowScale, pg8::StaticOrder, PG8_ALIGN, PG8_SP2>(F.lds + RING_OFF, g, S, E);
        if (BOTH(5)) GRID_BAR();
    }
    if (IN(6)) { for (int rep = 0; rep < NREP(6); ++rep) topk_phase(F, args); if (BOTH(6)) GRID_BAR(); }
    if (IN(7)) {
        for (int rep = 0; rep < NREP(7); ++rep) peer_uv_phase<false, 16>(F, args);
        GRID_BAR();
        peer_w_phase(F, args);
        GRID_BAR();
        if (REP_PHASE != 8) peer_uv_phase<true, 16>(F, args);
        GRID_BAR();
        peer_n_phase(F, args);
    }
#undef IN
#undef BOTH
}


extern "C" void kernel_launch(void* const* d_in, const int* in_sizes, int n_in, void* d_out, int out_size, void* d_ws, size_t ws_size, hipStream_t stream) {
    static int grid = 0;
    if (grid == 0) {
        if (n_in != 16 || in_sizes[0] != M * DM || out_size != M * DM || ws_size < WS_END) { fprintf(stderr, "kernel_launch: unexpected shapes: n_in %d in0 %d out %d ws %zu\n", n_in, n_in > 0 ? in_sizes[0] : -1, out_size, ws_size); grid = -1; return; }
        int dev = 0, cus = 0;
        if (hipGetDevice(&dev) != hipSuccess || hipDeviceGetAttribute(&cus, hipDeviceAttributeMultiprocessorCount, dev) != hipSuccess) { grid = -1; return; }
        if (hipFuncSetAttribute((const void*)mk_fwd, hipFuncAttributeMaxDynamicSharedMemorySize, LDS_BYTES) != hipSuccess) { fprintf(stderr, "kernel_launch: hipFuncSetAttribute failed\n"); grid = -1; return; }
        (void)hipGetLastError();
        grid = cus;
    }
    if (grid < 0) return;
    (void)hipMemsetAsync((char*)d_ws + WS_CTL, 0, CTL_ZERO_BYTES, stream);
    Args a{};
    for (int i = 0; i < 16; ++i) a.in[i] = (const float*)d_in[i];
    a.out = (float*)d_out; a.ws = (unsigned char*)d_ws;
    a.ph_lo = 0; a.ph_hi = 8; a.li = 0;
    hipLaunchKernelGGL(mk_fwd, dim3(grid), dim3(NWAVES * 64), LDS_BYTES, stream, a);
}
```

```cpp
#define REP_PHASE -1

#include <hip/hip_runtime.h>
#include <cstdio>
#include <cstdint>
#include <cmath>
#ifndef REP_PHASE
#define REP_PHASE -1
#endif
#define NREP(k) ((REP_PHASE == (k)) ? 2 : 1)
namespace pg8 {
#define PG8_LAS __attribute__((address_space(3)))
typedef unsigned short bf16_t;
typedef short bf16x8 __attribute__((ext_vector_type(8)));
typedef float f32x4 __attribute__((ext_vector_type(4)));
typedef unsigned u32x4 __attribute__((ext_vector_type(4)));
constexpr int BM = 256, BK = 64, HALF = 128, HTB = HALF * BK * 2  , STAGE_BYTES = 8 * HTB, NXCD = 8, WGM = 8;

__host__ __device__ __forceinline__ int lds_byte(int r, int c) { const int st = (r >> 4) * 2 + (c >> 5), rr = r & 15, cc = c & 31, ob = rr * 64 + cc * 2; return st * 1024 + (ob ^ (((ob >> 9) & 1) << 5)); }
__host__ __device__ __forceinline__ void stage_rc(int b, int& R, int& C) { const int st = b / 1024, sb = b % 1024, swz = sb ^ (((sb >> 9) & 1) << 5); R = (st >> 1) * 16 + swz / 64; C = (st & 1) * 32 + (swz % 64) / 2; }
__host__ __device__ __forceinline__ int perm32(int rho) { const int n = rho >> 4, i = rho & 15; return 8 * (i >> 2) + 4 * n + (i & 3); }

struct Unit { int pm, pn; };
struct Gemm { const bf16_t* A; const bf16_t* Bt; int M, N, K; };

struct StaticOrder {
    int nM, nN, nwg, G, c;
    __host__ __device__ void init(int M, int N, int G_, int c_) { nM = M / BM; nN = N / BM; nwg = nM * nN; G = G_; c = c_; }
    __host__ __device__ bool next(int i, Unit& u) const {
        const long L = (long)i * G + c; if (L >= nwg) return false;
        int wgid = (int)L; { const int q = nwg / NXCD, r = nwg % NXCD, xcd = wgid % NXCD, off = wgid / NXCD; wgid = (xcd < r ? xcd * (q + 1) : r * (q + 1) + (xcd - r) * q) + off; }
        const int nig = WGM * nN, gid = wgid / nig, fm = gid * WGM, gsz = (nM - fm) < WGM ? (nM - fm) : WGM;
        u.pm = fm + ((wgid % nig) % gsz); u.pn = (wgid % nig) / gsz; return true;
    }
    __device__ __forceinline__ void a_ready(const Unit&) const {}
    __device__ __forceinline__ void done(const Unit&) const {}
};

__device__ __forceinline__ unsigned cvt_pk_bf16(float lo, float hi) { unsigned r; asm volatile("v_cvt_pk_bf16_f32 %0, %1, %2" : "=v"(r) : "v"(lo), "v"(hi)); return r; }
typedef float f32x2 __attribute__((ext_vector_type(2)));
__device__ __forceinline__ f32x2 gelu_pk(f32x2 v) {
    const f32x2 av = __builtin_elementwise_abs(v), d = av * 0.2316418882f + 1.0f;
    f32x2 t; t.x = __builtin_amdgcn_rcpf(d.x); t.y = __builtin_amdgcn_rcpf(d.y);
    f32x2 q = t * 0.5307027145f + (-0.7265760135f); q = q * t + 0.7107068705f; q = q * t + (-0.142248368f); q = q * t + 0.127414796f; q = q * t;
    const f32x2 s = (v * v) * (-0.72134752044f);
    f32x2 e; e.x = __builtin_amdgcn_exp2f(s.x); e.y = __builtin_amdgcn_exp2f(s.y);
    const f32x2 m = v * (q * e), r = v - m;
    f32x2 o; o.x = v.x < 0.f ? m.x : r.x; o.y = v.y < 0.f ? m.y : r.y; return o;
}

template <int ACT  > struct EpiBf16 {
    static constexpr bool PERM = true, AFTER_DRAIN = false; static_assert(ACT == 0 || ACT == 1, "EpiBf16: ACT is 0 (none) or 1 (gelu_pk)");
    bf16_t* O; int ldc; const float* bias; int split_cols; size_t split_stride; float scale0;
    __device__ __forceinline__ void operator()(const f32x4 (&acc)[2][2][4][2], const Unit& u, int wr, int wc, int fr, int fq) const {
        const int row0 = u.pm * BM + wr * 64 + fr; int colt = u.pn * BM; bf16_t* base = O;
        float sc = 1.f; if (split_cols) { const int t = colt / split_cols; base += (size_t)t * split_stride; colt -= t * split_cols; if (t == 0) sc = scale0; }
        const int col0 = colt + wc * 32 + 8 * fq, bcol0 = u.pn * BM + wc * 32 + 8 * fq;
        f32x4 bv[2][2];
#pragma unroll
        for (int bj = 0; bj < 2; ++bj)
#pragma unroll
            for (int n = 0; n < 2; ++n) bv[bj][n] = bias ? *(const f32x4*)(bias + bcol0 + bj * HALF + 4 * n) : (f32x4){0.f, 0.f, 0.f, 0.f};
#pragma unroll
        for (int ai = 0; ai < 2; ++ai)
#pragma unroll
            for (int m = 0; m < 4; ++m) { bf16_t* rowp = base + (size_t)(row0 + ai * HALF + m * 16) * ldc + col0;
#pragma unroll
                for (int bj = 0; bj < 2; ++bj) { f32x4 v0 = acc[ai][bj][m][0] + bv[bj][0], v1 = acc[ai][bj][m][1] + bv[bj][1];
                    if (ACT == 1) { f32x2 a = gelu_pk((f32x2){v0[0], v0[1]}), b = gelu_pk((f32x2){v0[2], v0[3]}), c = gelu_pk((f32x2){v1[0], v1[1]}), d = gelu_pk((f32x2){v1[2], v1[3]});
                        v0 = (f32x4){a.x, a.y, b.x, b.y}; v1 = (f32x4){c.x, c.y, d.x, d.y}; }
                    v0 = v0 * sc; v1 = v1 * sc; u32x4 w; w.x = cvt_pk_bf16(v0[0], v0[1]); w.y = cvt_pk_bf16(v0[2], v0[3]); w.z = cvt_pk_bf16(v1[0], v1[1]); w.w = cvt_pk_bf16(v1[2], v1[3]);
                    *(u32x4*)(rowp + bj * HALF) = w; } }
    }
};
template <class Epi, class Sched, bool ALIGN_EPI = false, bool SP2 = false>
__device__ __forceinline__ void gemm_phase(PG8_LAS unsigned char* lds, const Gemm g, const Sched& S, const Epi& E) {
    const int tid = threadIdx.x, wid = __builtin_amdgcn_readfirstlane(tid >> 6), lane = tid & 63, wr = wid >> 2, wc = wid & 3, fr = lane & 15, fq = lane >> 4;
    const int K = g.K, nt = K / BK;
    unsigned voffA[2], voffB[2];
#pragma unroll
    for (int i = 0; i < 2; ++i) { int R, C; stage_rc(tid * 16 + i * 8192, R, C); const int Rb = Epi::PERM ? ((R & ~31) + perm32(R & 31)) : R;
        voffA[i] = (unsigned)(R * K + C) * 2u; voffB[i] = (unsigned)(Rb * K + C) * 2u; }
    const size_t kstep = (size_t)(BK * 2);
    const size_t hstep = (size_t)HALF * K * 2;
    const size_t tstep = 2 * hstep;
    const unsigned ldsw = (unsigned)wid * 1024u;
    const int aoff = lds_byte(wr * 64 + fr, fq * 8), boff = lds_byte(wc * 32 + fr, fq * 8);
#define PG8_SA(b, h) (((b) * 2 + (h)) * HTB)
#define PG8_SB(b, h) ((4 + (b) * 2 + (h)) * HTB)
#define PG8_STAGE(bufoff, gbase, voff) do { _Pragma("unroll") for (int _i = 0; _i < 2; ++_i) \
        __builtin_amdgcn_global_load_lds((const unsigned*)((const char*)(gbase) + (voff)[_i]), (PG8_LAS unsigned*)(lds + (bufoff) + ldsw + _i * 8192), 16, 0, 0); } while (0)
#define PG8_LDA(dst, b, h) do { _Pragma("unroll") for (int m = 0; m < 4; ++m) _Pragma("unroll") for (int k = 0; k < 2; ++k) dst[m][k] = *(const PG8_LAS bf16x8*)(lds + PG8_SA(b, h) + aoff + m * 2048 + k * 1024); } while (0)
#define PG8_LDB(dst, b, h) do { _Pragma("unroll") for (int n = 0; n < 2; ++n) _Pragma("unroll") for (int k = 0; k < 2; ++k) dst[n][k] = *(const PG8_LAS bf16x8*)(lds + PG8_SB(b, h) + boff + n * 2048 + k * 1024); } while (0)
#define PG8_MMA(ai, bj, At, Bt) do { __builtin_amdgcn_s_setprio(1); _Pragma("unroll") for (int m = 0; m < 4; ++m) _Pragma("unroll") for (int n = 0; n < 2; ++n) _Pragma("unroll") for (int k = 0; k < 2; ++k) \
        acc[ai][bj][m][n] = __builtin_amdgcn_mfma_f32_16x16x32_bf16(Bt[n][k], At[m][k], acc[ai][bj][m][n], 0, 0, 0); __builtin_amdgcn_s_setprio(0); } while (0)
#define PG8_WAIT_V(n) asm volatile("s_waitcnt vmcnt(" #n ")" ::: "memory")
#define PG8_WAIT_L(n) asm volatile("s_waitcnt lgkmcnt(" #n ")" ::: "memory")
#define PG8_BAR __builtin_amdgcn_s_barrier()
#define PG8_SCHED __builtin_amdgcn_sched_barrier(0)
    Unit cur, nxt; int ui = 0;
    if (!S.next(0, cur)) return;
    f32x4 acc[2][2][4][2];
#pragma unroll
    for (int a = 0; a < 2; ++a)
#pragma unroll
        for (int b = 0; b < 2; ++b)
#pragma unroll
            for (int m = 0; m < 4; ++m)
#pragma unroll
                for (int n = 0; n < 2; ++n) acc[a][b][m][n] = (f32x4){0.f, 0.f, 0.f, 0.f};
    bf16x8 At[4][2], B0[2][2], B1[2][2];
    const char* cA = (const char*)g.A + (size_t)cur.pm * tstep; const char* cB = (const char*)g.Bt + (size_t)cur.pn * tstep;
    S.a_ready(cur);
    if constexpr (SP2) {
        PG8_STAGE(PG8_SB(0, 0), cB, voffB); PG8_STAGE(PG8_SB(0, 1), cB + hstep, voffB); PG8_STAGE(PG8_SA(0, 0), cA, voffA); PG8_STAGE(PG8_SA(0, 1), cA + hstep, voffA);
        if (wr == 1) PG8_BAR;
        PG8_WAIT_V(2); PG8_BAR;
        PG8_STAGE(PG8_SB(1, 0), cB + kstep, voffB); PG8_STAGE(PG8_SA(1, 0), cA + kstep, voffA); PG8_STAGE(PG8_SB(1, 1), cB + hstep + kstep, voffB);
        PG8_WAIT_V(6); PG8_BAR;
    } else {
        PG8_STAGE(PG8_SB(0, 0), cB, voffB); PG8_STAGE(PG8_SA(0, 0), cA, voffA); PG8_STAGE(PG8_SB(0, 1), cB + hstep, voffB); PG8_STAGE(PG8_SA(0, 1), cA + hstep, voffA);
        if (wr == 1) PG8_BAR;
        PG8_WAIT_V(4); PG8_BAR;
        PG8_STAGE(PG8_SB(1, 0), cB + kstep, voffB); PG8_STAGE(PG8_SA(1, 0), cA + kstep, voffA); PG8_STAGE(PG8_SB(1, 1), cB + hstep + kstep, voffB);
        PG8_WAIT_V(6); PG8_BAR;
    }
    for (;;) {
        const bool has_next = S.next(ui + 1, nxt);
        const char* nA = has_next ? (const char*)g.A + (size_t)nxt.pm * tstep : cA; const char* nB = has_next ? (const char*)g.Bt + (size_t)nxt.pn * tstep : cB;
        for (int t = 0; t < nt; t += 2) {
            const bool last = (t == nt - 2);
            const char* a1 = cA + (size_t)(t + 1) * kstep;
            const char* a2 = last ? nA : cA + (size_t)(t + 2) * kstep; const char* b2 = last ? nB : cB + (size_t)(t + 2) * kstep;
            const char* a3 = a2 + kstep; const char* b3 = b2 + kstep;
            if (last && has_next) S.a_ready(nxt);
            if constexpr (SP2) {
            PG8_LDB(B0, 0, 0); PG8_LDB(B1, 0, 1); PG8_SCHED; PG8_LDA(At, 0, 0); PG8_STAGE(PG8_SA(1, 1), a1 + hstep, voffA);
            PG8_WAIT_V(8); PG8_WAIT_L(0); PG8_BAR; PG8_MMA(0, 0, At, B0); PG8_MMA(0, 1, At, B1); PG8_BAR; PG8_SCHED;
            PG8_LDA(At, 0, 1); PG8_STAGE(PG8_SB(0, 0), b2, voffB); PG8_STAGE(PG8_SB(0, 1), b2 + hstep, voffB); PG8_STAGE(PG8_SA(0, 0), a2, voffA);
            PG8_WAIT_V(8); PG8_WAIT_L(0); PG8_BAR; PG8_MMA(1, 0, At, B0); PG8_MMA(1, 1, At, B1); PG8_BAR; PG8_SCHED;
            PG8_LDB(B0, 1, 0); PG8_LDB(B1, 1, 1); PG8_SCHED; PG8_LDA(At, 1, 0); PG8_STAGE(PG8_SA(0, 1), a2 + hstep, voffA);
            PG8_WAIT_V(8); PG8_WAIT_L(0); PG8_BAR; PG8_MMA(0, 0, At, B0); PG8_MMA(0, 1, At, B1); PG8_BAR; PG8_SCHED;
            PG8_LDA(At, 1, 1); PG8_STAGE(PG8_SB(1, 0), b3, voffB); PG8_STAGE(PG8_SB(1, 1), b3 + hstep, voffB); PG8_STAGE(PG8_SA(1, 0), a3, voffA);
            PG8_WAIT_V(8); PG8_WAIT_L(0); PG8_BAR; PG8_MMA(1, 0, At, B0); PG8_MMA(1, 1, At, B1); PG8_BAR; PG8_SCHED;
            } else {
            PG8_LDB(B0, 0, 0); PG8_SCHED; PG8_LDA(At, 0, 0); PG8_STAGE(PG8_SA(1, 1), a1 + hstep, voffA);
            PG8_WAIT_L(8); PG8_BAR; PG8_WAIT_L(0); PG8_MMA(0, 0, At, B0); PG8_BAR; PG8_SCHED;
            PG8_LDB(B1, 0, 1); PG8_STAGE(PG8_SB(0, 0), b2, voffB);
            PG8_BAR; PG8_WAIT_L(0); PG8_MMA(0, 1, At, B1); PG8_BAR;
            PG8_LDA(At, 0, 1); PG8_STAGE(PG8_SA(0, 0), a2, voffA);
            PG8_BAR; PG8_WAIT_L(0); PG8_MMA(1, 0, At, B0); PG8_BAR; PG8_SCHED;
            PG8_STAGE(PG8_SB(0, 1), b2 + hstep, voffB);
            PG8_WAIT_V(6); PG8_BAR; PG8_MMA(1, 1, At, B1); PG8_BAR;
            PG8_LDB(B0, 1, 0); PG8_SCHED; PG8_LDA(At, 1, 0); PG8_STAGE(PG8_SA(0, 1), a2 + hstep, voffA);
            PG8_WAIT_L(8); PG8_BAR; PG8_WAIT_L(0); PG8_MMA(0, 0, At, B0); PG8_BAR; PG8_SCHED;
            PG8_LDB(B1, 1, 1); PG8_STAGE(PG8_SB(1, 0), b3, voffB);
            PG8_BAR; PG8_WAIT_L(0); PG8_MMA(0, 1, At, B1); PG8_BAR;
            PG8_LDA(At, 1, 1); PG8_STAGE(PG8_SA(1, 0), a3, voffA);
            PG8_BAR; PG8_WAIT_L(0); PG8_MMA(1, 0, At, B0); PG8_BAR; PG8_SCHED;
            PG8_STAGE(PG8_SB(1, 1), b3 + hstep, voffB);
            PG8_WAIT_V(6); PG8_BAR; PG8_MMA(1, 1, At, B1); PG8_BAR;
            }
        }
        if constexpr (ALIGN_EPI) { if (wr == 0) PG8_BAR; }
        if constexpr (!Epi::AFTER_DRAIN) { E(acc, cur, wr, wc, fr, fq); S.done(cur); }
        if (!has_next) break;
#pragma unroll
        for (int a = 0; a < 2; ++a)
#pragma unroll
            for (int b = 0; b < 2; ++b)
#pragma unroll
                for (int m = 0; m < 4; ++m)
#pragma unroll
                    for (int n = 0; n < 2; ++n) acc[a][b][m][n] = (f32x4){0.f, 0.f, 0.f, 0.f};
        cur = nxt; cA = nA; cB = nB; ++ui;
        if constexpr (ALIGN_EPI) { if (wr == 1) PG8_BAR; }
    }
    PG8_WAIT_V(0);
    if constexpr (!ALIGN_EPI) { if (wr == 0) PG8_BAR; }
    PG8_BAR;
    if constexpr (Epi::AFTER_DRAIN) { E.fused(acc, cur, wr, wc, fr, fq, lds, wid, lane); S.done(cur); }
#undef PG8_SA
#undef PG8_SB
#undef PG8_STAGE
#undef PG8_LDA
#undef PG8_LDB
#undef PG8_MMA
#undef PG8_WAIT_V
#undef PG8_WAIT_L
#undef PG8_BAR
#undef PG8_SCHED
}
}

#ifndef PG8_SP2
#define PG8_SP2 true
#endif
#ifndef PG8_ALIGN
#define PG8_ALIGN true
#endif
#define GAS __attribute__((address_space(1)))
#define LAS __attribute__((address_space(3)))
typedef unsigned short bf16;
typedef unsigned v4u __attribute__((ext_vector_type(4)));
typedef float f32x4 __attribute__((ext_vector_type(4)));
typedef short bf16x8 __attribute__((ext_vector_type(8)));
typedef GAS unsigned gu32;
typedef GAS unsigned long long gu64;
#define RLX_AGENT __ATOMIC_RELAXED, __HIP_MEMORY_SCOPE_AGENT
#define LDS_WAIT() asm volatile("s_waitcnt lgkmcnt(0)" ::: "memory")
#define VM_WAIT() asm volatile("s_waitcnt vmcnt(0)" ::: "memory")
__device__ __forceinline__ unsigned long long rt() { return __builtin_amdgcn_s_memrealtime(); }
__device__ __forceinline__ unsigned f2bf(float f) { unsigned u = __builtin_bit_cast(unsigned, f); return (u + 0x7fffu + ((u >> 16) & 1u)) >> 16; }
typedef float pk2_f32x2 __attribute__((ext_vector_type(2))); typedef __bf16 pk2_bf16x2 __attribute__((ext_vector_type(2)));
__device__ __forceinline__ unsigned pk2(float lo, float hi) { pk2_f32x2 v = {lo, hi}; pk2_bf16x2 b = __builtin_convertvector(v, pk2_bf16x2); return __builtin_bit_cast(unsigned, b); }

#define XB_TMO      128
#define XB_XCNT(j)  (256  + 64 * (j))
#define XB_XSUB(j)  (1280 + 64 * (j))
#define XB_XGEN(j)  (2304 + 64 * (j))
#define XB_TOP      3328
#define XB_TOPGEN   3392
#define XCD_BAR_WORDS 3456
#define XB_SPIN_CAP (1u << 18)

__device__ __forceinline__ unsigned xb_ld(unsigned* p)              { return __hip_atomic_load(p, __ATOMIC_RELAXED, __HIP_MEMORY_SCOPE_AGENT); }
__device__ __forceinline__ unsigned xb_add(unsigned* p, unsigned v) { return __hip_atomic_fetch_add(p, v, __ATOMIC_RELAXED, __HIP_MEMORY_SCOPE_AGENT); }
__device__ __forceinline__ unsigned xb_xcc_id() { return (unsigned)__builtin_amdgcn_s_getreg((3 << 11) | 20) & 0xFu; }
#define XB_SPIN(cond, bar) do { unsigned _sp = 0; while (cond) { __builtin_amdgcn_s_sleep(1); \
    if ((++_sp & 255u) == 0u) { if (xb_ld(&(bar)[XB_TMO])) break; if (_sp > XB_SPIN_CAP) { atomicAdd(&(bar)[XB_TMO], 1u); break; } } } } while (0)

struct XcdBarrier {
    unsigned* bar; unsigned x;
    volatile LAS unsigned* st;
};

__device__ __forceinline__ XcdBarrier xcd_barrier_post(unsigned* bar, volatile LAS unsigned* st) {
    XcdBarrier b; b.bar = bar; b.x = xb_xcc_id(); b.st = st;
    if (threadIdx.x == 0) (void)xb_add(&bar[XB_XCNT(b.x)], 1u);
    return b;
}
__device__ __forceinline__ void xcd_barrier_complete(unsigned* bar, unsigned x, unsigned& nloc, unsigned& nx) {
    const unsigned G = gridDim.x * gridDim.y * gridDim.z;
    unsigned sum, cnt, mine, sp = 0u;
    for (;;) {
        sum = 0u; cnt = 0u; mine = 0u;
#pragma unroll
        for (unsigned j = 0; j < 16; ++j) { const unsigned c = xb_ld(&bar[XB_XCNT(j)]); sum += c; cnt += (c > 0u) ? 1u : 0u; mine = (j == x) ? c : mine; }
        if (sum == G) break;
        __builtin_amdgcn_s_sleep(1);
        if ((++sp & 255u) == 0u) { if (xb_ld(&bar[XB_TMO])) break; if (sp > XB_SPIN_CAP) { atomicAdd(&bar[XB_TMO], 1u); break; } }
    }
    nloc = mine > 0u ? mine : 1u; nx = cnt > 0u ? cnt : 1u;
}

__device__ __forceinline__ void xcd_barrier(const XcdBarrier& b) {
    asm volatile("s_waitcnt vmcnt(0)" ::: "memory");
    __syncthreads();
    if (threadIdx.x == 0) {
        unsigned* bar = b.bar;
        __builtin_amdgcn_s_waitcnt(0);
        unsigned nloc = b.st[0], nx = b.st[1];
        if (nloc == 0u) { xcd_barrier_complete(bar, b.x, nloc, nx); b.st[0] = nloc; b.st[1] = nx; }
        const unsigned old = xb_add(&bar[XB_XSUB(b.x)], 1u);
        const unsigned gen = old / nloc;
        if (old + 1u == (gen + 1u) * nloc) {
            __builtin_amdgcn_fence(__ATOMIC_RELEASE, "agent");
            asm volatile("s_waitcnt vmcnt(0)" ::: "memory");
            const unsigned og = xb_add(&bar[XB_TOP], 1u);
            const unsigned tg = og / nx;
            if (og + 1u == (tg + 1u) * nx) xb_add(&bar[XB_TOPGEN], 1u);
            else XB_SPIN(xb_ld(&bar[XB_TOPGEN]) == tg, bar);
            __builtin_amdgcn_fence(__ATOMIC_ACQUIRE, "agent");
            xb_add(&bar[XB_XGEN(b.x)], 1u);
            asm volatile("s_waitcnt vmcnt(0)" ::: "memory");
        } else {
            XB_SPIN(xb_ld(&bar[XB_XGEN(b.x)]) == gen, bar);
            __builtin_amdgcn_fence(__ATOMIC_ACQUIRE, "agent");
            asm volatile("s_waitcnt vmcnt(0)" ::: "memory");
        }
    }
    __syncthreads();
}


constexpr int NWAVES = 8;
constexpr int DM = 2048, BATCH = 4, SEQ = 4096, M = BATCH * SEQ;
constexpr int NIN = 6176, NINP = 6144;
constexpr int O_GQ = 0, O_GK = 512, O_GV = 1024, O_GR = 2048, O_AQ = 3072, O_AK = 4096, O_AV = 5120;
constexpr float EPS = 1e-6f;
constexpr int PEER_K = 128;

constexpr size_t MiB = 1u << 20;
constexpr size_t WS_CTL = 0, CTL_ZERO_BYTES = 1 * MiB;
constexpr size_t WS_WIN = 1 * MiB;
constexpr size_t WS_WGD = 25 * MiB;
constexpr size_t WS_GDB = 62 * MiB;
constexpr size_t WS_WOUT = 26 * MiB;
constexpr size_t WS_WQ = 34 * MiB;
constexpr size_t WS_SSQ = 42 * MiB;
constexpr size_t WS_EIDX = 44 * MiB;
constexpr size_t WS_GATE = 52 * MiB;
constexpr size_t WS_SKB = 60 * MiB;
constexpr size_t WS_XN = 64 * MiB;
constexpr size_t WS_PROJ = 128 * MiB;
constexpr size_t WS_HB = 256 * MiB;
constexpr size_t WS_OF = 328 * MiB;
constexpr size_t WS_OB = 360 * MiB;
constexpr size_t WS_ATT = 392 * MiB;
constexpr size_t WS_ATTP = 392 * MiB;
constexpr size_t WS_ATTML = 488 * MiB;
constexpr size_t WS_GT_QD = 64 * MiB;
constexpr size_t WS_GT_KE = 96 * MiB;
constexpr size_t OUT_GT_AM = 0;
constexpr size_t OUT_GT_DEC = 16 * MiB;
constexpr size_t OUT_GT_VT = 32 * MiB;
constexpr int CW_ATTQ = 64;
constexpr size_t WS_END = 494 * MiB;
constexpr size_t OUT_U8 = 64 * MiB;
constexpr size_t OUT_V8 = 96 * MiB;
constexpr size_t WS_SU = 61 * MiB;
constexpr size_t WS_SV = 61 * MiB + 65536;
constexpr int CW_CONVQ = 256;
constexpr size_t WS_PW = 128 * MiB;
constexpr size_t WS_SSQ2 = 136 * MiB;
constexpr size_t WS_PD = 64 * MiB;
constexpr int PEER_E = 16384;
constexpr int CW_TMO = 0, CW_CODE = 1, CW_BAR = 4096;

constexpr int RING_OFF = 0, RING_BYTES = 131072;
constexpr int LDS_BYTES = 163840;
constexpr int LDSCTL_OFF = LDS_BYTES - 1024, MISC_OFF = LDSCTL_OFF + 320;

typedef float f32x2 __attribute__((ext_vector_type(2)));
typedef float f32x16 __attribute__((ext_vector_type(16)));
typedef int i32x4 __attribute__((ext_vector_type(4)));
__device__ __forceinline__ float bf2f(unsigned short h) { return __builtin_bit_cast(float, (unsigned)h << 16); }
__device__ __forceinline__ float bflo(unsigned w) { return __builtin_bit_cast(float, w << 16); }
__device__ __forceinline__ float bfhi(unsigned w) { return __builtin_bit_cast(float, w & 0xffff0000u); }
__device__ __forceinline__ float wave_sum(float v) {
#pragma unroll
    for (int o = 1; o < 64; o <<= 1) v += __shfl_xor(v, o);
    return v;
}
__device__ __forceinline__ float wave_max(float v) {
#pragma unroll
    for (int o = 1; o < 64; o <<= 1) v = fmaxf(v, __shfl_xor(v, o));
    return v;
}

template <class T> __device__ __forceinline__ T* opaque(T* p) { asm volatile("" : "+s"(p)); return (T*)(GAS T*)p; }
__device__ __forceinline__ int opaque_v(int x) { asm volatile("" : "+v"(x)); return x; }
template <class T> __device__ __forceinline__ T ldu(const void* ubase, unsigned voff) { return *(const GAS T*)((const GAS char*)ubase + voff); }
template <class T> __device__ __forceinline__ void stu(void* ubase, unsigned voff, T v) { *(GAS T*)((GAS char*)ubase + voff) = v; }
namespace pg8 {
struct EpiRes {
    static constexpr bool PERM = false, AFTER_DRAIN = false;
    const float* x; bf16_t* HB; float* ssq; int ldc;
    __device__ __forceinline__ void operator()(const f32x4 (&acc)[2][2][4][2], const Unit& u, int wr, int wc, int fr, int fq) const {
        const int col0 = u.pn * BM + wc * 32 + 4 * fq;
#pragma unroll
        for (int ai = 0; ai < 2; ++ai)
#pragma unroll
            for (int m = 0; m < 4; ++m) {
                const int r = u.pm * BM + ai * HALF + wr * 64 + m * 16 + fr; const size_t off = (size_t)r * ldc + col0; float s = 0.f;
#pragma unroll
                for (int bj = 0; bj < 2; ++bj)
#pragma unroll
                    for (int n = 0; n < 2; ++n) {
                        const f32x4 xv = *(const f32x4*)(x + off + bj * HALF + n * 16);
                        const f32x4 hv = xv + acc[ai][bj][m][n];
                        s += (hv[0] * hv[0] + hv[1] * hv[1]) + (hv[2] * hv[2] + hv[3] * hv[3]);
                        unsigned long long w = (unsigned long long)cvt_pk_bf16(hv[0], hv[1]) | ((unsigned long long)cvt_pk_bf16(hv[2], hv[3]) << 32);
                        *(unsigned long long*)(HB + off + bj * HALF + n * 16) = w;
                    }
                s += __shfl_xor(s, 16); s += __shfl_xor(s, 32);
                if (fq == 0) ssq[(size_t)r * 32 + u.pn * 4 + wc] = s;
            }
    }
};
struct EpiRowScale {
    static constexpr bool PERM = true, AFTER_DRAIN = false;
    bf16_t* O; int ldc; const float* ssq; float inv_n, eps;
    __device__ __forceinline__ void operator()(const f32x4 (&acc)[2][2][4][2], const Unit& u, int wr, int wc, int fr, int fq) const {
        const int col0 = u.pn * BM + wc * 32 + 8 * fq;
#pragma unroll
        for (int ai = 0; ai < 2; ++ai)
#pragma unroll
            for (int m = 0; m < 4; ++m) {
                const int r = u.pm * BM + ai * HALF + wr * 64 + m * 16 + fr;
                const f32x4* sp = (const f32x4*)(ssq + (size_t)r * 32); float s = 0.f;
#pragma unroll
                for (int i = 0; i < 8; ++i) { const f32x4 t = sp[i]; s += (t[0] + t[1]) + (t[2] + t[3]); }
                const float sc = 1.0f / sqrtf(s * inv_n + eps);
                bf16_t* rowp = O + (size_t)r * ldc + col0;
#pragma unroll
                for (int bj = 0; bj < 2; ++bj) { const f32x4 v0 = acc[ai][bj][m][0] * sc, v1 = acc[ai][bj][m][1] * sc;
                    u32x4 w; w.x = cvt_pk_bf16(v0[0], v0[1]); w.y = cvt_pk_bf16(v0[2], v0[3]); w.z = cvt_pk_bf16(v1[0], v1[1]); w.w = cvt_pk_bf16(v1[2], v1[3]);
                    *(u32x4*)(rowp + bj * HALF) = w; }
            }
    }
};
}

struct Frame {
    LAS unsigned char* lds;
    volatile LAS unsigned* MISC;
    gu32* ctl;
    int tid, lane, wave;
    int vcu, G;
};

__device__ __forceinline__ void p0_transpose_item(const float* W, int K, int ldw, const float* gk, bf16* WT, LAS float* scr, int item, int lane) {
    const int nblk = ldw / 32, kb = item / nblk, nb = item % nblk, k0 = 64 * kb, n0 = 32 * nb;
#pragma unroll 8
    for (int i = 0; i < 32; ++i) { const int kk = 2 * i + (lane >> 5); float w = W[(size_t)(k0 + kk) * ldw + n0 + (lane & 31)]; if (gk) w *= gk[k0 + kk]; scr[kk * 33 + (lane & 31)] = w; }
    LDS_WAIT(); asm volatile("" ::: "memory");
    const int c = lane & 7;
#pragma unroll
    for (int j = 0; j < 4; ++j) { const int n = (lane >> 3) + 8 * j; const LAS float* s = scr + (8 * c) * 33 + n;
        v4u o; o.x = pk2(s[0 * 33], s[1 * 33]); o.y = pk2(s[2 * 33], s[3 * 33]); o.z = pk2(s[4 * 33], s[5 * 33]); o.w = pk2(s[6 * 33], s[7 * 33]);
        *(GAS v4u*)(WT + (size_t)(n0 + n) * K + k0 + 8 * c) = o; }
    LDS_WAIT(); asm volatile("" ::: "memory");
}
__device__ __forceinline__ void rms_row_to_bf16(int lane, const float* xrow, const float* g, bf16* orow) {
    const GAS f32x4* xr = (const GAS f32x4*)xrow + lane; const GAS f32x4* gr = (const GAS f32x4*)g + lane;
    f32x4 v[8]; float s = 0.f;
#pragma unroll
    for (int j = 0; j < 8; ++j) { v[j] = xr[64 * j]; s += (v[j].x * v[j].x + v[j].y * v[j].y) + (v[j].z * v[j].z + v[j].w * v[j].w); }
    const float rstd = 1.f / sqrtf(wave_sum(s) * (1.f / DM) + EPS);
    GAS unsigned long long* o8 = (GAS unsigned long long*)orow + lane;
#pragma unroll
    for (int j = 0; j < 8; ++j) { const f32x4 gg = gr[64 * j];
        o8[64 * j] = (unsigned long long)pk2(v[j].x * rstd * gg.x, v[j].y * rstd * gg.y) | ((unsigned long long)pk2(v[j].z * rstd * gg.z, v[j].w * rstd * gg.w) << 32); }
}

struct Args {
    const float* in[16]; float* out; unsigned char* ws; int ph_lo, ph_hi, li, pad;
};

__device__ __forceinline__ void p0_prologue(Frame& F, const Args& a) {
    unsigned char* ws = a.ws;
    LAS float* scr = (LAS float*)(F.lds + RING_OFF + F.wave * 16384);
    const int gw = F.vcu * NWAVES + F.wave, NGW = F.G * NWAVES;
    bf16* Win_t = (bf16*)(ws + WS_WIN); bf16* Wout_t = (bf16*)(ws + WS_WOUT); bf16* Wq_t = (bf16*)(ws + WS_WQ); bf16* XN = (bf16*)(ws + WS_XN);
    constexpr int I_IN = (DM / 64) * (NIN / 32), I_SQ = (DM / 64) * (DM / 32);
    constexpr int NITEMS = I_IN + 2 * I_SQ;
    for (int it = gw; it < NITEMS; it += NGW) {
        int r = it;
        if (r < I_IN) { const int nb = r % (NIN / 32); bf16* dst = nb < 96 ? Win_t : nb == 96 ? (bf16*)(ws + WS_WGD) - (size_t)96 * 32 * DM : Win_t - (size_t)32 * DM;
            p0_transpose_item(a.in[2], DM, NIN, nullptr, dst, scr, r, F.lane); continue; } r -= I_IN;
        if (r < I_SQ) { p0_transpose_item(a.in[9], DM, DM, nullptr, Wout_t, scr, r, F.lane); continue; } r -= I_SQ;
        p0_transpose_item(a.in[11], DM, DM, a.in[10], Wq_t, scr, r, F.lane);
    }
    { const f32x4* sk = (const f32x4*)a.in[12]; unsigned long long* skb = (unsigned long long*)(ws + WS_SKB);
      for (int i = gw * 64 + F.lane; i < 8 * 2 * 128 * 128 / 4; i += NGW * 64) { const f32x4 v = sk[i]; skb[i] = (unsigned long long)pk2(v.x, v.y) | ((unsigned long long)pk2(v.z, v.w) << 32); } }
    { const GAS f32x4* gr = (const GAS f32x4*)a.in[1] + F.lane; f32x4 gg[8];
#pragma unroll
      for (int j = 0; j < 8; ++j) gg[j] = gr[64 * j];
      f32x4 v[8], vn[8];
      if (gw < M) {
#pragma unroll
          for (int j = 0; j < 8; ++j) v[j] = ((const GAS f32x4*)(a.in[0] + (size_t)gw * DM) + F.lane)[64 * j]; }
      for (int m = gw; m < M; m += NGW) { const int mn = m + NGW < M ? m + NGW : m;
#pragma unroll
          for (int j = 0; j < 8; ++j) vn[j] = ((const GAS f32x4*)(a.in[0] + (size_t)mn * DM) + F.lane)[64 * j];
          float ss = 0.f;
#pragma unroll
          for (int j = 0; j < 8; ++j) ss += (v[j].x * v[j].x + v[j].y * v[j].y) + (v[j].z * v[j].z + v[j].w * v[j].w);
          const float rstd = 1.f / sqrtf(wave_sum(ss) * (1.f / DM) + EPS);
          GAS unsigned long long* o8 = (GAS unsigned long long*)(XN + (size_t)m * DM) + F.lane;
#pragma unroll
          for (int j = 0; j < 8; ++j) o8[64 * j] = (unsigned long long)pk2(v[j].x * rstd * gg[j].x, v[j].y * rstd * gg[j].y) | ((unsigned long long)pk2(v[j].z * rstd * gg[j].z, v[j].w * rstd * gg[j].w) << 32);
#pragma unroll
          for (int j = 0; j < 8; ++j) v[j] = vn[j]; } }
}


__device__ __forceinline__ void gd_side_gemm(Frame& F, const Args& a) {
    unsigned char* ws = a.ws; const bf16* XN = (const bf16*)(ws + WS_XN); const bf16* WG = (const bf16*)(ws + WS_WGD); float* GDB = (float*)(ws + WS_GDB);
    const int lane = F.lane, w = F.wave, r32 = lane & 31, hh = lane >> 5; LAS float* part = (LAS float*)F.lds;
    for (int blk = F.vcu; blk < M / 64; blk += F.G) { const int tok0 = blk * 64;
        f32x16 acc[2];
#pragma unroll
        for (int tt = 0; tt < 2; ++tt) acc[tt] = (f32x16){0.f, 0.f, 0.f, 0.f, 0.f, 0.f, 0.f, 0.f, 0.f, 0.f, 0.f, 0.f, 0.f, 0.f, 0.f, 0.f};
#pragma unroll 4
        for (int ks = 0; ks < 16; ++ks) { const int k0 = 256 * w + 16 * ks + 8 * hh; const bf16x8 bw = *(const bf16x8*)(WG + (size_t)r32 * DM + k0);
#pragma unroll
            for (int tt = 0; tt < 2; ++tt) { const bf16x8 ax = *(const bf16x8*)(XN + (size_t)(tok0 + 32 * tt + r32) * DM + k0); acc[tt] = __builtin_amdgcn_mfma_f32_32x32x16_bf16(ax, bw, acc[tt], 0, 0, 0); } }
#pragma unroll
        for (int tt = 0; tt < 2; ++tt)
#pragma unroll
            for (int r = 0; r < 16; ++r) { const float x = acc[tt][r]; part[((w * 2 + tt) * 16 + r) * 64 + lane] = x; }
        __syncthreads();
#pragma unroll
        for (int i = 0; i < 4; ++i) { const int o = F.tid + 512 * i; float sum = 0.f;
#pragma unroll
            for (int ww = 0; ww < 8; ++ww) sum += part[ww * 2048 + o];
            const int tt = o >> 10, r = (o >> 6) & 15, ln = o & 63; const int t = 32 * tt + (r & 3) + 8 * (r >> 2) + 4 * (ln >> 5);
            GDB[(size_t)(tok0 + t) * 32 + (ln & 31)] = sum; }
        __syncthreads();
    }
}

__device__ __forceinline__ void p3_finalize(Frame& F, const Args& a) {
    unsigned char* ws = a.ws;
    const int gw = F.vcu * NWAVES + F.wave, NGW = F.G * NWAVES, lane = F.lane;
    const bf16* OFp = (const bf16*)(ws + WS_OF); const bf16* OBp = (const bf16*)(ws + WS_OB);
    const bf16* PROJ = (const bf16*)(ws + WS_PROJ); bf16* Y = (bf16*)(ws + WS_XN);
    const float* gla_g = a.in[7]; const float* att_g = a.in[8];
    const f32x4 gg = *(const f32x4*)(gla_g + 4 * lane);
    for (int m = gw; m < M; m += NGW) {
#pragma unroll
        for (int hh = 0; hh < 4; ++hh) {
            const unsigned long long wf = *(const unsigned long long*)(OFp + (size_t)m * 1024 + hh * 256 + 4 * lane);
            const unsigned long long wb = *(const unsigned long long*)(OBp + (size_t)m * 1024 + hh * 256 + 4 * lane);
            const f32x4 o = (f32x4){bflo((unsigned)wf) + bflo((unsigned)wb), bfhi((unsigned)wf) + bfhi((unsigned)wb), bflo((unsigned)(wf >> 32)) + bflo((unsigned)(wb >> 32)), bfhi((unsigned)(wf >> 32)) + bfhi((unsigned)(wb >> 32))};
            const float ss = wave_sum((o.x * o.x + o.y * o.y) + (o.z * o.z + o.w * o.w));
            const float rstd = 1.f / sqrtf(ss * (1.f / 256.f) + EPS);
            const unsigned long long gr = *(const unsigned long long*)(PROJ + (size_t)m * NINP + O_GR + hh * 256 + 4 * lane);
            const float r0 = bflo((unsigned)gr), r1 = bfhi((unsigned)gr), r2 = bflo((unsigned)(gr >> 32)), r3 = bfhi((unsigned)(gr >> 32));
            const float y0 = o.x * rstd * gg.x * (r0 / (1.f + __expf(-r0))), y1 = o.y * rstd * gg.y * (r1 / (1.f + __expf(-r1)));
            const float y2 = o.z * rstd * gg.z * (r2 / (1.f + __expf(-r2))), y3 = o.w * rstd * gg.w * (r3 / (1.f + __expf(-r3)));
            *(unsigned long long*)(Y + (size_t)m * DM + hh * 256 + 4 * lane) = (unsigned long long)pk2(y0, y1) | ((unsigned long long)pk2(y2, y3) << 32);
        }
        float av[16]; float ss = 0.f;
#pragma unroll
        for (int p = 0; p < 2; ++p) { const int col = p * 512 + 8 * lane, hd = col >> 6; float mm[3], ll[3]; v4u ow[3];
#pragma unroll
            for (int pt = 0; pt < 3; ++pt) { const size_t rec = ((size_t)pt * M + m) * 16 + hd; const f32x2 ml2 = *(const f32x2*)((const float*)(ws + WS_ATTML) + rec * 2); mm[pt] = ml2.x; ll[pt] = ml2.y;
                ow[pt] = *(const v4u*)((const bf16*)(ws + WS_ATTP) + rec * 64 + (col & 63)); }
            const float mt = fmaxf(fmaxf(mm[0], mm[1]), mm[2]); const float w0 = __expf(mm[0] - mt), w1 = __expf(mm[1] - mt), w2 = __expf(mm[2] - mt);
            const float inv = 1.f / (w0 * ll[0] + w1 * ll[1] + w2 * ll[2]);
            av[p * 8 + 0] = (w0 * bflo(ow[0].x) + w1 * bflo(ow[1].x) + w2 * bflo(ow[2].x)) * inv; av[p * 8 + 1] = (w0 * bfhi(ow[0].x) + w1 * bfhi(ow[1].x) + w2 * bfhi(ow[2].x)) * inv;
            av[p * 8 + 2] = (w0 * bflo(ow[0].y) + w1 * bflo(ow[1].y) + w2 * bflo(ow[2].y)) * inv; av[p * 8 + 3] = (w0 * bfhi(ow[0].y) + w1 * bfhi(ow[1].y) + w2 * bfhi(ow[2].y)) * inv;
            av[p * 8 + 4] = (w0 * bflo(ow[0].z) + w1 * bflo(ow[1].z) + w2 * bflo(ow[2].z)) * inv; av[p * 8 + 5] = (w0 * bfhi(ow[0].z) + w1 * bfhi(ow[1].z) + w2 * bfhi(ow[2].z)) * inv;
            av[p * 8 + 6] = (w0 * bflo(ow[0].w) + w1 * bflo(ow[1].w) + w2 * bflo(ow[2].w)) * inv; av[p * 8 + 7] = (w0 * bfhi(ow[0].w) + w1 * bfhi(ow[1].w) + w2 * bfhi(ow[2].w)) * inv; }
#pragma unroll
        for (int i = 0; i < 16; ++i) ss += av[i] * av[i];
        const float rstd = 1.f / sqrtf(wave_sum(ss) * (1.f / 1024.f) + EPS);
#pragma unroll
        for (int p = 0; p < 2; ++p) { const f32x4 g0 = *(const f32x4*)(att_g + p * 512 + 8 * lane), g1 = *(const f32x4*)(att_g + p * 512 + 8 * lane + 4);
            v4u w; w.x = pk2(av[p * 8 + 0] * rstd * g0.x, av[p * 8 + 1] * rstd * g0.y); w.y = pk2(av[p * 8 + 2] * rstd * g0.z, av[p * 8 + 3] * rstd * g0.w);
            w.z = pk2(av[p * 8 + 4] * rstd * g1.x, av[p * 8 + 5] * rstd * g1.y); w.w = pk2(av[p * 8 + 6] * rstd * g1.z, av[p * 8 + 7] * rstd * g1.w);
            *(v4u*)(Y + (size_t)m * DM + 1024 + p * 512 + 8 * lane) = w; }
    }
}


__device__ __forceinline__ void wave_argmax(float& v, int& idx) {
#pragma unroll
    for (int o = 1; o < 64; o <<= 1) { const float ov = __shfl_xor(v, o); const int oi = __shfl_xor(idx, o); if (ov > v || (ov == v && oi < idx)) { v = ov; idx = oi; } }
}
__device__ __forceinline__ void ce_desc(float& a, float& b) { const float hi = fmaxf(a, b), lo = fminf(a, b); a = hi; b = lo; }
__device__ __forceinline__ void sort16_desc(float* v) {
#pragma unroll
    for (int k = 2; k <= 16; k <<= 1)
#pragma unroll
        for (int j = k >> 1; j > 0; j >>= 1)
#pragma unroll
            for (int i = 0; i < 16; ++i) { const int l = i ^ j; if (l > i) { if ((i & k) == 0 || k == 16) ce_desc(v[i], v[l]); else ce_desc(v[l], v[i]); } }
}
__device__ __forceinline__ void merge16_desc(float* v) {
#pragma unroll
    for (int j = 8; j > 0; j >>= 1)
#pragma unroll
        for (int i = 0; i < 16; ++i) { const int l = i ^ j; if (l > i) ce_desc(v[i], v[l]); }
}
__device__ __forceinline__ void top16_of_two(float* a, const float* b) {
#pragma unroll
    for (int i = 0; i < 16; ++i) a[i] = fmaxf(a[i], b[15 - i]);
    merge16_desc(a);
}
__device__ __forceinline__ void top16_of_64(float* v) {
    sort16_desc(v); sort16_desc(v + 16); sort16_desc(v + 32); sort16_desc(v + 48);
    top16_of_two(v, v + 16); top16_of_two(v + 32, v + 48); top16_of_two(v, v + 32);
}
__device__ __forceinline__ void topk_phase(Frame& F, const Args& a) {
    unsigned char* ws = a.ws; const GAS bf16* QP = (const GAS bf16*)(ws + WS_XN); const GAS bf16* SKB = (const GAS bf16*)(ws + WS_SKB); GAS int* EIDX = (GAS int*)(ws + WS_EIDX); GAS float* GATE = (GAS float*)(ws + WS_GATE);
    const int lane = F.lane, r32 = lane & 31, hh = lane >> 5;
    LAS unsigned char* skl = F.lds;
    LAS int* ktab = (LAS int*)(F.lds + 65536 + F.wave * 8192);
    for (int unit = F.vcu; unit < 8 * (M / 512); unit += F.G) {
        const int h = unit & 7, tok0 = (unit >> 3) * 512 + F.wave * 64;
        __syncthreads();
#pragma unroll
        for (int i = 0; i < 8; ++i) { const int idx = F.tid + 512 * i, key = idx >> 4, ch = idx & 15;
            *(LAS v4u*)(skl + key * 256 + ((ch ^ (key & 15)) * 16)) = *(const GAS v4u*)(SKB + ((size_t)h * 256 + key) * 128 + ch * 8); }
        __syncthreads();
#pragma unroll 1
        for (int tt = 0; tt < 2; ++tt) {
            const size_t row = (size_t)(tok0 + tt * 32 + r32);
            float L[2][16];
#pragma unroll
            for (int c = 0; c < 2; ++c) {
                f32x16 acc[4];
#pragma unroll
                for (int kt = 0; kt < 4; ++kt) acc[kt] = (f32x16){0.f, 0.f, 0.f, 0.f, 0.f, 0.f, 0.f, 0.f, 0.f, 0.f, 0.f, 0.f, 0.f, 0.f, 0.f, 0.f};
                const GAS bf16* qb = QP + row * DM + h * 256 + c * 128 + 8 * hh;
#pragma unroll 2
                for (int st = 0; st < 8; ++st) {
                    const bf16x8 bq = *(const GAS bf16x8*)(qb + 16 * st);
#pragma unroll
                    for (int kt = 0; kt < 4; ++kt) { const int key = c * 128 + 32 * kt + r32; const bf16x8 ak = *(const LAS bf16x8*)(skl + key * 256 + (((2 * st + hh) ^ (key & 15)) * 16));
                        acc[kt] = __builtin_amdgcn_mfma_f32_32x32x16_bf16(ak, bq, acc[kt], 0, 0, 0); }
                }
                float v[64];
#pragma unroll
                for (int kt = 0; kt < 4; ++kt)
#pragma unroll
                    for (int r = 0; r < 16; ++r) { const int key = 32 * kt + (r & 3) + 8 * (r >> 2);
                        const float sc = acc[kt][r];
                        v[kt * 16 + r] = __builtin_bit_cast(float, (__builtin_bit_cast(unsigned, sc) & ~127u) | (unsigned)(key + 4 * hh)); }
                top16_of_64(v);
                float p[16];
#pragma unroll
                for (int i = 0; i < 16; ++i) p[i] = __shfl_xor(v[i], 32);
                top16_of_two(v, p);
#pragma unroll
                for (int i = 0; i < 16; ++i) { L[c][i] = v[i]; ktab[(c * 16 + i) * 64 + lane] = (int)(__builtin_bit_cast(unsigned, v[i]) & 127u); }
            }
            float cnd[64];
            { int n = 0;
#pragma unroll
              for (int i = 0; i < 16; ++i)
#pragma unroll
                  for (int j = 0; j < 16; ++j) if ((i + 1) * (j + 1) <= 16) { cnd[n] = __builtin_bit_cast(float, (__builtin_bit_cast(unsigned, L[0][i] + L[1][j]) & ~255u) | (unsigned)((i << 4) | j)); ++n; }
#pragma unroll
              for (int q = 50; q < 64; ++q) cnd[q] = -3.0e38f; }
            top16_of_64(cnd);
            float mx = __builtin_bit_cast(float, __builtin_bit_cast(unsigned, cnd[0]) & ~255u), sum = 0.f; float ex[16];
#pragma unroll
            for (int i = 0; i < 16; ++i) { ex[i] = __expf(__builtin_bit_cast(float, __builtin_bit_cast(unsigned, cnd[i]) & ~255u) - mx); sum += ex[i]; }
            const float inv = 1.f / sum;
            LDS_WAIT(); asm volatile("" ::: "memory");
            if (hh == 0) {
                int ev[16];
#pragma unroll
                for (int i = 0; i < 16; ++i) { const unsigned bits = __builtin_bit_cast(unsigned, cnd[i]); const int ia = (bits >> 4) & 15, jb = bits & 15; ev[i] = ktab[ia * 64 + lane] * 128 + ktab[(16 + jb) * 64 + lane]; }
                GAS int* ep = EIDX + row * 128 + h * 16; GAS float* gp = GATE + row * 128 + h * 16;
#pragma unroll
                for (int i = 0; i < 4; ++i) { *(GAS i32x4*)(ep + 4 * i) = (i32x4){ev[4 * i], ev[4 * i + 1], ev[4 * i + 2], ev[4 * i + 3]}; *(GAS f32x4*)(gp + 4 * i) = (f32x4){ex[4 * i] * inv, ex[4 * i + 1] * inv, ex[4 * i + 2] * inv, ex[4 * i + 3] * inv}; }
            }
            LDS_WAIT(); asm volatile("" ::: "memory");
        }
    }
}

__device__ __forceinline__ void gla_prep_phase(Frame& F, const Args& a) {
    unsigned char* ws = a.ws; const bf16* PROJ;
    const int w = F.wave;
    LAS unsigned char* L = F.lds;
    LAS unsigned char* Qraw = L; LAS unsigned char* Kraw = L + 16384; LAS unsigned char* Vraw = L + 32768; LAS float* GDf = (LAS float*)(L + 65536); LAS float* GSUM = (LAS float*)(L + 73728);
    LAS unsigned char* IMGQ = L + 77824; LAS unsigned char* IMGK = L + 95232; LAS unsigned char* IMGE = L + 112640; LAS unsigned char* AMI = L + 32768;
    for (int it = F.vcu; it < 1024; it += F.G) {
        const int b = it >> 8, h = (it >> 6) & 3, n = it & 63; const size_t row0 = (size_t)b * SEQ + n * 64;
        ws = opaque(ws); PROJ = (const bf16*)(ws + WS_PROJ);
        int tid = opaque_v(F.tid), lane = tid & 63, r32 = lane & 31, hh = lane >> 5;
#pragma unroll
        for (int i = 0; i < 2; ++i) { const int idx = tid + 512 * i, r = idx >> 4, c = idx & 15;
            *(LAS v4u*)(Qraw + r * 256 + c * 16) = *(const GAS v4u*)(PROJ + (row0 + r) * NINP + O_GQ + h * 128 + c * 8);
            *(LAS v4u*)(Kraw + r * 256 + c * 16) = *(const GAS v4u*)(PROJ + (row0 + r) * NINP + O_GK + h * 128 + c * 8); }
#pragma unroll
        for (int i = 0; i < 4; ++i) { const int idx = tid + 512 * i, r = idx >> 5, c = idx & 31;
            *(LAS v4u*)(Vraw + r * 512 + c * 16) = *(const GAS v4u*)(PROJ + (row0 + r) * NINP + O_GV + h * 256 + c * 8); }
        if (tid < 256) { const int r = tid >> 2, c = tid & 3; const GAS float* gsrc = (const GAS float*)(ws + WS_GDB) + (row0 + r) * 32 + c * 8; const f32x4 g0 = *(const GAS f32x4*)gsrc, g1 = *(const GAS f32x4*)(gsrc + 4);
            *(LAS f32x4*)(GDf + r * 32 + c * 8) = g0; *(LAS f32x4*)(GDf + r * 32 + c * 8 + 4) = g1; }
        __syncthreads();
#pragma unroll
        for (int ks = 0; ks < 4; ++ks) { unsigned pk[4];
#pragma unroll
            for (int p = 0; p < 4; ++p) { const int s0 = 16 * ks + 8 * hh + 2 * p; const unsigned lo = *(const LAS unsigned short*)(Vraw + s0 * 512 + (32 * w + r32) * 2), hi = *(const LAS unsigned short*)(Vraw + (s0 + 1) * 512 + (32 * w + r32) * 2); pk[p] = lo | (hi << 16); }
            *(GAS v4u*)((unsigned char*)a.out + OUT_GT_VT + (size_t)it * 32768 + (w * 4 + ks) * 1024 + lane * 16) = (v4u){pk[0], pk[1], pk[2], pk[3]}; }
        for (int dir = 0; dir < 2; ++dir) {
            const size_t idir = (size_t)(((b * 4 + h) * 2 + dir) * 64 + n); ws = opaque(ws); tid = opaque_v(tid); lane = tid & 63; r32 = lane & 31; hh = lane >> 5;
            {
                const int d = tid & 127, tq = tid >> 7; const float* upp = (dir ? a.in[5] : a.in[3]) + h * 128 + d; const float bias = (dir ? a.in[6] : a.in[4])[h * 128 + d];
                float up[16];
#pragma unroll
                for (int r = 0; r < 16; ++r) up[r] = upp[r * 512];
                float c[16];
#pragma unroll
                for (int i = 0; i < 16; ++i) { const LAS float* g = GDf + (16 * tq + i) * 32 + dir * 16; float z = bias;
#pragma unroll
                    for (int r = 0; r < 16; ++r) z += g[r] * up[r];
                    c[i] = (fminf(z, 0.f) - __logf(1.f + __expf(-fabsf(z)))) * (1.f / 16.f); }
                if (dir == 0) {
#pragma unroll
                    for (int i = 1; i < 16; ++i) c[i] += c[i - 1];
                } else {
#pragma unroll
                    for (int i = 14; i >= 0; --i) c[i] += c[i + 1];
                }
                GSUM[(dir * 4 + tq) * 128 + d] = dir == 0 ? c[15] : c[0];
                __syncthreads();
                const float t0 = GSUM[(dir * 4 + 0) * 128 + d], t1 = GSUM[(dir * 4 + 1) * 128 + d], t2 = GSUM[(dir * 4 + 2) * 128 + d], t3 = GSUM[(dir * 4 + 3) * 128 + d];
                const float Bt = (t0 + t1) + (t2 + t3);
                float off;
                if (dir == 0) off = (tq > 0 ? t0 : 0.f) + (tq > 1 ? t1 : 0.f) + (tq > 2 ? t2 : 0.f);
                else off = (tq < 1 ? t1 : 0.f) + (tq < 2 ? t2 : 0.f) + (tq < 3 ? t3 : 0.f);
                unsigned kep[8];
#pragma unroll
                for (int i = 0; i < 16; i += 2) { float ke2[2];
#pragma unroll
                    for (int q = 0; q < 2; ++q) { const int t = 16 * tq + i + q; const float bi = c[i + q] + off;
                        const float qv = bf2f(*(const LAS unsigned short*)(Qraw + t * 256 + d * 2)), kv = bf2f(*(const LAS unsigned short*)(Kraw + t * 256 + d * 2));
                        *(LAS unsigned short*)(IMGQ + t * 272 + d * 2) = (unsigned short)pk2(qv * 0.08838834764831845f * __expf(bi), 0.f);
                        *(LAS unsigned short*)(IMGK + t * 272 + d * 2) = (unsigned short)pk2(kv * __expf(-bi), 0.f);
                        ke2[q] = kv * __expf(Bt - bi); }
                    kep[i >> 1] = pk2(ke2[0], ke2[1]); }
                *(LAS v4u*)(IMGE + d * 144 + (16 * tq) * 2) = (v4u){kep[0], kep[1], kep[2], kep[3]};
                *(LAS v4u*)(IMGE + d * 144 + (16 * tq + 8) * 2) = (v4u){kep[4], kep[5], kep[6], kep[7]};
                if (tq == 0) ((GAS float*)((unsigned char*)a.out + OUT_GT_DEC))[idir * 128 + d] = __expf(Bt);
            }
            __syncthreads();
            if (w < 4) {
                const int si = w >> 1, ti = w & 1; f32x16 acc = (f32x16){0.f, 0.f, 0.f, 0.f, 0.f, 0.f, 0.f, 0.f, 0.f, 0.f, 0.f, 0.f, 0.f, 0.f, 0.f, 0.f};
#pragma unroll
                for (int ks = 0; ks < 8; ++ks) { const bf16x8 ak = *(const LAS bf16x8*)(IMGK + (32 * si + r32) * 272 + (16 * ks + 8 * hh) * 2), bq = *(const LAS bf16x8*)(IMGQ + (32 * ti + r32) * 272 + (16 * ks + 8 * hh) * 2);
                    acc = __builtin_amdgcn_mfma_f32_32x32x16_bf16(ak, bq, acc, 0, 0, 0); }
                const int t = 32 * ti + r32;
#pragma unroll
                for (int qd = 0; qd < 4; ++qd) { float v4[4];
#pragma unroll
                    for (int i = 0; i < 4; ++i) { const int sidx = 32 * si + 8 * qd + 4 * hh + i; const float x = acc[4 * qd + i]; const bool keep = dir == 0 ? (sidx <= t) : (sidx >= t); v4[i] = keep ? x : 0.f; }
                    *(LAS unsigned long long*)(AMI + t * 144 + (32 * si + 8 * qd + 4 * hh) * 2) = (unsigned long long)pk2(v4[0], v4[1]) | ((unsigned long long)pk2(v4[2], v4[3]) << 32); }
            } else {
                const int w4 = w - 4;
#pragma unroll
                for (int q = 0; q < 4; ++q) { const int bq = w4 * 4 + q, tt = bq >> 3, ks = bq & 7, j = ks >> 1, u = ks & 1; const int t = 32 * tt + r32;
                    const unsigned long long p0 = *(const LAS unsigned long long*)(IMGQ + t * 272 + (32 * j + 16 * u + 4 * hh) * 2), p1 = *(const LAS unsigned long long*)(IMGQ + t * 272 + (32 * j + 16 * u + 8 + 4 * hh) * 2);
                    *(GAS v4u*)(ws + WS_GT_QD + idir * 16384 + bq * 1024 + lane * 16) = (v4u){(unsigned)p0, (unsigned)(p0 >> 32), (unsigned)p1, (unsigned)(p1 >> 32)}; }
#pragma unroll
                for (int q = 0; q < 4; ++q) { const int bk = w4 * 4 + q, j = bk >> 2, ks = bk & 3; const int d = 32 * j + r32;
                    *(GAS v4u*)(ws + WS_GT_KE + idir * 16384 + bk * 1024 + lane * 16) = *(const LAS v4u*)(IMGE + d * 144 + (16 * ks + 8 * hh) * 2); }
            }
            __syncthreads();
            { const int tt = w >> 2, ks = w & 3; const int t = 32 * tt + r32;
              *(GAS v4u*)((unsigned char*)a.out + OUT_GT_AM + idir * 8192 + w * 1024 + lane * 16) = *(const LAS v4u*)(AMI + t * 144 + (16 * ks + 8 * hh) * 2); }
            __syncthreads();
        }
    }
}

__device__ __forceinline__ void gla_seq_phase(Frame& F, const Args& a) {
    unsigned char* ws = a.ws;
    const int w = F.wave;
    constexpr int GBUF = 57856;
    for (int unit = F.vcu; unit < 64; unit += F.G) {
        const int dir = unit & 1, eh = (unit >> 1) & 1, bh = unit >> 2, b = bh >> 2, h = bh & 3;
        if (w >= 4) {
            const int lt = opaque_v(F.tid) - 256;
            v4u A[15], B[15];
#define GLA_LOAD(R, NS) do { const int n_ = dir ? 63 - (NS) : (NS); const size_t idir_ = (size_t)((bh * 2 + dir) * 64 + n_), iv_ = (size_t)(bh * 64 + n_); const unsigned char* o_ = opaque((const unsigned char*)a.out); const unsigned char* w_ = opaque(ws); \
            const GAS v4u* gq_ = (const GAS v4u*)(w_ + WS_GT_QD + idir_ * 16384); const GAS v4u* gk_ = (const GAS v4u*)(w_ + WS_GT_KE + idir_ * 16384); const GAS v4u* ga_ = (const GAS v4u*)(o_ + OUT_GT_AM + idir_ * 8192); \
            const GAS v4u* gv_ = (const GAS v4u*)(o_ + OUT_GT_VT + iv_ * 32768 + eh * 16384); const GAS v4u* gd_ = (const GAS v4u*)(o_ + OUT_GT_DEC + idir_ * 512); \
            _Pragma("unroll") for (int i = 0; i < 4; ++i) { R[i] = gq_[lt + 256 * i]; R[4 + i] = gk_[lt + 256 * i]; R[10 + i] = gv_[lt + 256 * i]; } R[8] = ga_[lt]; R[9] = ga_[lt + 256]; R[14] = gd_[lt & 31]; } while (0)
#define GLA_WRITE(R, BUF) do { LAS v4u* d_ = (LAS v4u*)(F.lds + (BUF) * GBUF); \
            _Pragma("unroll") for (int i = 0; i < 4; ++i) { d_[lt + 256 * i] = R[i]; d_[1024 + lt + 256 * i] = R[4 + i]; d_[2560 + lt + 256 * i] = R[10 + i]; } d_[2048 + lt] = R[8]; d_[2048 + lt + 256] = R[9]; if (lt < 32) d_[3584 + lt] = R[14]; } while (0)
            GLA_LOAD(A, 0); GLA_LOAD(B, 1);
            GLA_WRITE(A, 0);
            __syncthreads();
#pragma unroll 1
            for (int ns = 0; ns < 64; ns += 2) {
                if (ns + 2 < 64) GLA_LOAD(A, ns + 2);
                GLA_WRITE(B, 1);
                __syncthreads();
                if (ns + 3 < 64) GLA_LOAD(B, ns + 3);
                if (ns + 2 < 64) GLA_WRITE(A, 0);
                __syncthreads();
            }
#undef GLA_LOAD
#undef GLA_WRITE
        } else {
            f32x16 S[4];
#pragma unroll
            for (int j = 0; j < 4; ++j) S[j] = (f32x16){0.f, 0.f, 0.f, 0.f, 0.f, 0.f, 0.f, 0.f, 0.f, 0.f, 0.f, 0.f, 0.f, 0.f, 0.f, 0.f};
            __syncthreads();
#pragma unroll 1
            for (int ns = 0; ns < 64; ++ns) {
                const int n = dir ? 63 - ns : ns;
                const int lane = opaque_v(F.lane), r32 = lane & 31, hh = lane >> 5;
                LAS unsigned char* QDl = F.lds + (ns & 1) * GBUF; LAS unsigned char* KEl = QDl + 16384; LAS unsigned char* AMl = QDl + 32768; LAS unsigned char* VTl = QDl + 40960; LAS float* DECl = (LAS float*)(QDl + 57344);
                GAS bf16* Out = (GAS bf16*)(opaque(ws) + (dir ? WS_OB : WS_OF));
                bf16x8 vf[4];
#pragma unroll
                for (int ks = 0; ks < 4; ++ks) vf[ks] = *(const LAS bf16x8*)(VTl + (w * 4 + ks) * 1024 + lane * 16);
                f32x16 o[2];
#pragma unroll
                for (int tt = 0; tt < 2; ++tt) o[tt] = (f32x16){0.f, 0.f, 0.f, 0.f, 0.f, 0.f, 0.f, 0.f, 0.f, 0.f, 0.f, 0.f, 0.f, 0.f, 0.f, 0.f};
#pragma unroll
                for (int ks8 = 0; ks8 < 8; ++ks8) { const int j = ks8 >> 1, u = ks8 & 1; v4u sb;
                    sb.x = pg8::cvt_pk_bf16(S[j][8 * u + 0], S[j][8 * u + 1]); sb.y = pg8::cvt_pk_bf16(S[j][8 * u + 2], S[j][8 * u + 3]); sb.z = pg8::cvt_pk_bf16(S[j][8 * u + 4], S[j][8 * u + 5]); sb.w = pg8::cvt_pk_bf16(S[j][8 * u + 6], S[j][8 * u + 7]);
                    const bf16x8 bs = __builtin_bit_cast(bf16x8, sb);
#pragma unroll
                    for (int tt = 0; tt < 2; ++tt) { const bf16x8 aq = *(const LAS bf16x8*)(QDl + (tt * 8 + ks8) * 1024 + lane * 16); o[tt] = __builtin_amdgcn_mfma_f32_32x32x16_bf16(aq, bs, o[tt], 0, 0, 0); } }
#pragma unroll
                for (int ks = 0; ks < 4; ++ks)
#pragma unroll
                    for (int tt = 0; tt < 2; ++tt) { const bf16x8 am = *(const LAS bf16x8*)(AMl + (tt * 4 + ks) * 1024 + lane * 16); o[tt] = __builtin_amdgcn_mfma_f32_32x32x16_bf16(am, vf[ks], o[tt], 0, 0, 0); }
#pragma unroll
                for (int tt = 0; tt < 2; ++tt)
#pragma unroll
                    for (int r = 0; r < 16; ++r) { const int t = 32 * tt + (r & 3) + 8 * (r >> 2) + 4 * hh; const float x = o[tt][r];
                        Out[((size_t)b * SEQ + 64 * n + t) * 1024 + h * 256 + 32 * (eh * 4 + w) + r32] = (bf16)pk2(x, 0.f); }
#pragma unroll
                for (int j = 0; j < 4; ++j) {
#pragma unroll
                    for (int q = 0; q < 4; ++q) { const f32x4 dv = *(const LAS f32x4*)(DECl + 32 * j + 8 * q + 4 * hh); S[j][4 * q + 0] *= dv.x; S[j][4 * q + 1] *= dv.y; S[j][4 * q + 2] *= dv.z; S[j][4 * q + 3] *= dv.w; }
#pragma unroll
                    for (int ks = 0; ks < 4; ++ks) { const bf16x8 ak = *(const LAS bf16x8*)(KEl + (j * 4 + ks) * 1024 + lane * 16); S[j] = __builtin_amdgcn_mfma_f32_32x32x16_bf16(ak, vf[ks], S[j], 0, 0, 0); } }
                __syncthreads();
            }
        }
    }
}

typedef short v4i16_t __attribute__((ext_vector_type(4)));
__device__ __forceinline__ void attn_phase(Frame& F, const Args& a, int qslot) {
    unsigned char* ws = a.ws; const bf16* PROJ;
    const int w = F.wave;
    volatile LAS int* uword = (volatile LAS int*)(F.lds + 2 * 78336);
    constexpr int NUNITS = 64 * 3 * 32;
#define ATT_DECODE(U) const int bh = (U) / 96, rem = (U) - bh * 96, p = rem >> 5, idx = rem & 31; const int lgd = 2 * p, d = 1 << lgd; \
        const int r = idx >> (5 - lgd), J = idx & ((32 >> lgd) - 1), Lc = SEQ >> lgd; const int b = bh >> 4, h = bh & 15; const int m0 = 128 * J - 64;
    v4u kx[4], vx[4]; v4u qw[2];
#define ATT_LOAD(U) do { ATT_DECODE(U) ws = opaque(ws); PROJ = (const bf16*)(ws + WS_PROJ); const int tid_ = opaque_v(F.tid); \
        _Pragma("unroll") for (int i = 0; i < 4; ++i) { const int kr = (tid_ >> 3) + 64 * i, ch = tid_ & 7; const int mp = m0 + kr; kx[i] = (v4u){0u, 0u, 0u, 0u}; vx[i] = kx[i]; \
            if (mp >= 0 && mp < Lc) { const bf16* src = PROJ + ((size_t)b * SEQ + r + d * mp) * NINP + O_AK + h * 64 + ch * 8; kx[i] = *(const GAS v4u*)src; vx[i] = *(const GAS v4u*)(src + (O_AV - O_AK)); } } \
        const int tokq_ = r + d * (128 * J + 16 * w + (tid_ & 15)); \
        _Pragma("unroll") for (int sft = 0; sft < 2; ++sft) qw[sft] = *(const GAS v4u*)(PROJ + ((size_t)b * SEQ + tokq_) * NINP + O_AQ + h * 64 + 32 * sft + 8 * ((tid_ & 63) >> 4)); } while (0)
    float tab[40];
    { const int l0 = opaque_v(F.lane);
#pragma unroll
      for (int c = 0; c < 40; ++c) { const int kb = c >> 3, uu = (c >> 2) & 1, rho = c & 3; const int jo = 32 * kb + 8 * (l0 >> 4) + 4 * uu + rho - 64 - (l0 & 15); const int aj = jo < 0 ? -jo : jo; tab[c] = aj <= 64 ? (float)aj : 3.0e38f; } }
    if (F.tid == 0) { uword[0] = (int)__hip_atomic_fetch_add((unsigned*)(F.ctl + CW_ATTQ + 64 * qslot), 1u, __ATOMIC_RELAXED, __HIP_MEMORY_SCOPE_AGENT); uword[1] = (int)__hip_atomic_fetch_add((unsigned*)(F.ctl + CW_ATTQ + 64 * qslot), 1u, __ATOMIC_RELAXED, __HIP_MEMORY_SCOPE_AGENT); }
    __syncthreads();
    int u = __builtin_amdgcn_readfirstlane(uword[0]), un = __builtin_amdgcn_readfirstlane(uword[1]); int par = 0;
#define ATT_WRITE(BUF) do { const int tid_ = opaque_v(F.tid); LAS unsigned char* Kw = F.lds + (BUF) * 78336; LAS unsigned char* Vw = Kw + 39168; \
        _Pragma("unroll") for (int i = 0; i < 4; ++i) { const int kr = (tid_ >> 3) + 64 * i, ch = tid_ & 7; *(LAS v4u*)(Kw + kr * 144 + ch * 16) = kx[i]; *(LAS v4u*)(Vw + kr * 144 + ch * 16) = vx[i]; } \
        if (tid_ < 128) { const int kr = 256 + (tid_ >> 3), ch = tid_ & 7; *(LAS v4u*)(Kw + kr * 144 + ch * 16) = (v4u){0u, 0u, 0u, 0u}; *(LAS v4u*)(Vw + kr * 144 + ch * 16) = (v4u){0u, 0u, 0u, 0u}; } } while (0)
    v4u qwc[2];
    if (u < NUNITS) { ATT_LOAD(u); ATT_WRITE(0); qwc[0] = qw[0]; qwc[1] = qw[1]; }
    __syncthreads();
    int bufi = 0;
    while (u < NUNITS) {
        const int tid = opaque_v(F.tid), lane = tid & 63, q16 = lane & 15, g = lane >> 4;
        int qnext = 0; if (tid == 0) qnext = (int)__hip_atomic_fetch_add((unsigned*)(F.ctl + CW_ATTQ + 64 * qslot), 1u, __ATOMIC_RELAXED, __HIP_MEMORY_SCOPE_AGENT);
        LAS unsigned char* Kl = F.lds + bufi * 78336; LAS unsigned char* Vl = Kl + 39168;
        bf16x8 qf[2];
#pragma unroll
        for (int sft = 0; sft < 2; ++sft) { v4u qs; constexpr float QS = 0.125f * 1.4426950408889634f; qs.x = pk2(bflo(qwc[sft].x) * QS, bfhi(qwc[sft].x) * QS); qs.y = pk2(bflo(qwc[sft].y) * QS, bfhi(qwc[sft].y) * QS); qs.z = pk2(bflo(qwc[sft].z) * QS, bfhi(qwc[sft].z) * QS); qs.w = pk2(bflo(qwc[sft].w) * QS, bfhi(qwc[sft].w) * QS);
            qf[sft] = __builtin_bit_cast(bf16x8, qs); }
        ATT_DECODE(u)
        const int tokq = r + d * (128 * J + 16 * w + q16);
        if (un < NUNITS) ATT_LOAD(un);
        const float nslope = -exp2f(-0.5f * (float)(h + 1)) * (float)d * 1.4426950408889634f;
        const bool inrange = (m0 + 16 * w >= 0) && (m0 + 16 * w + 159 < Lc);
        float sv[5][2][4]; float mx = -3.0e38f;
#pragma unroll
        for (int kb = 0; kb < 5; ++kb)
#pragma unroll
            for (int uu = 0; uu < 2; ++uu) { f32x4 acc = (f32x4){0.f, 0.f, 0.f, 0.f};
                const int krow = 16 * w + 32 * kb + 8 * (q16 >> 2) + 4 * uu + (q16 & 3);
#pragma unroll
                for (int sft = 0; sft < 2; ++sft) { const bf16x8 ak = *(const LAS bf16x8*)(Kl + krow * 144 + (32 * sft + 8 * g) * 2); acc = __builtin_amdgcn_mfma_f32_16x16x32_bf16(ak, qf[sft], acc, 0, 0, 0); }
#pragma unroll
                for (int rho = 0; rho < 4; ++rho) { const float x = acc[rho]; sv[kb][uu][rho] = __builtin_fmaf(nslope, tab[kb * 8 + uu * 4 + rho], x); } }
        if (!inrange) {
#pragma unroll
            for (int kb = 0; kb < 5; ++kb)
#pragma unroll
                for (int uu = 0; uu < 2; ++uu)
#pragma unroll
                    for (int rho = 0; rho < 4; ++rho) { const int mp = m0 + 16 * w + 32 * kb + 8 * g + 4 * uu + rho; if (mp < 0 || mp >= Lc) sv[kb][uu][rho] = -3.0e38f; } }
#pragma unroll
        for (int kb = 0; kb < 5; ++kb)
#pragma unroll
            for (int uu = 0; uu < 2; ++uu)
#pragma unroll
                for (int rho = 0; rho < 4; ++rho) mx = fmaxf(mx, sv[kb][uu][rho]);
        mx = fmaxf(mx, __shfl_xor(mx, 16)); mx = fmaxf(mx, __shfl_xor(mx, 32));
        float lsum = 0.f; bf16x8 pf[5];
#pragma unroll
        for (int kb = 0; kb < 5; ++kb) { float e[8];
#pragma unroll
            for (int uu = 0; uu < 2; ++uu)
#pragma unroll
                for (int rho = 0; rho < 4; ++rho) { const float pe = __builtin_amdgcn_exp2f(sv[kb][uu][rho] - mx); e[uu * 4 + rho] = pe; lsum += pe; }
            v4u pw; pw.x = pk2(e[0], e[1]); pw.y = pk2(e[2], e[3]); pw.z = pk2(e[4], e[5]); pw.w = pk2(e[6], e[7]); pf[kb] = __builtin_bit_cast(bf16x8, pw); }
        lsum += __shfl_xor(lsum, 16); lsum += __shfl_xor(lsum, 32);
        f32x4 oT[4];
#pragma unroll
        for (int nn = 0; nn < 4; ++nn) oT[nn] = (f32x4){0.f, 0.f, 0.f, 0.f};
#pragma unroll
        for (int kb = 0; kb < 5; ++kb)
#pragma unroll
            for (int nn = 0; nn < 4; ++nn) { const LAS unsigned char* va = Vl + (16 * w + 32 * kb + 8 * g + (q16 >> 2)) * 144 + (16 * nn + 4 * (q16 & 3)) * 2;
                const v4i16_t lo = __builtin_amdgcn_ds_read_tr16_b64_v4i16((LAS v4i16_t*)va), hi = __builtin_amdgcn_ds_read_tr16_b64_v4i16((LAS v4i16_t*)(va + 4 * 144));
                const bf16x8 vf = (bf16x8){lo[0], lo[1], lo[2], lo[3], hi[0], hi[1], hi[2], hi[3]};
                oT[nn] = __builtin_amdgcn_mfma_f32_16x16x32_bf16(vf, pf[kb], oT[nn], 0, 0, 0); }
        { const size_t rec = ((size_t)p * M + (size_t)b * SEQ + tokq) * 16 + h; GAS bf16* op = (GAS bf16*)(opaque(ws) + WS_ATTP) + rec * 64 + 4 * g;
#pragma unroll
          for (int nn = 0; nn < 4; ++nn) *(GAS unsigned long long*)(op + 16 * nn) = (unsigned long long)pk2(oT[nn][0], oT[nn][1]) | ((unsigned long long)pk2(oT[nn][2], oT[nn][3]) << 32);
          if (g == 0) { GAS float* ml = (GAS float*)(opaque(ws) + WS_ATTML) + rec * 2; ml[0] = mx * 0.6931471805599453f; ml[1] = lsum; } }
        if (un < NUNITS) { ATT_WRITE(bufi ^ 1); qwc[0] = qw[0]; qwc[1] = qw[1]; }
        if (tid == 0) uword[par] = qnext;
        __syncthreads();
        u = un; un = __builtin_amdgcn_readfirstlane(uword[par]); par ^= 1; bufi ^= 1;
    }
#undef ATT_WRITE
#undef ATT_DECODE
#undef ATT_LOAD
}

typedef __bf16 bf16x2_t __attribute__((ext_vector_type(2)));
__device__ __forceinline__ void peer_convert_tables(Frame& F, const Args& a, int qslot) {
    unsigned char* ws = a.ws; const int lane = F.lane; volatile LAS int* uword = (volatile LAS int*)(F.lds + 2 * 78336 + 64);
    for (;;) {
        __syncthreads();
        if (F.tid == 0) uword[0] = (int)__hip_atomic_fetch_add((unsigned*)(F.ctl + CW_CONVQ + 64 * qslot), 1u, __ATOMIC_RELAXED, __HIP_MEMORY_SCOPE_AGENT);
        __syncthreads();
        const int blk = __builtin_amdgcn_readfirstlane(uword[0]);
        if (blk >= 2 * PEER_E / 64) break;
#pragma unroll 1
        for (int i = 0; i < 8; ++i) { const int r = blk * 64 + F.wave * 8 + i;
            const int e = r & (PEER_E - 1); const bool isv = r >= PEER_E;
            const float* src = (isv ? a.in[14] : a.in[13]) + (size_t)e * DM;
            unsigned char* dst = (unsigned char*)a.out + (isv ? OUT_V8 : OUT_U8) + (size_t)e * DM; float* sc = (float*)(ws + (isv ? WS_SV : WS_SU));
            f32x4 v[8]; float am = 0.f;
#pragma unroll
            for (int j = 0; j < 8; ++j) { v[j] = *(const f32x4*)(src + 256 * j + 4 * lane); am = fmaxf(am, fmaxf(fmaxf(fabsf(v[j].x), fabsf(v[j].y)), fmaxf(fabsf(v[j].z), fabsf(v[j].w)))); }
            am = wave_max(am); am = fmaxf(am, 1e-30f);
            const float inv = 440.f / am;
#pragma unroll
            for (int j = 0; j < 8; ++j) { int p = __builtin_amdgcn_cvt_pk_fp8_f32(v[j].x * inv, v[j].y * inv, 0, false); p = __builtin_amdgcn_cvt_pk_fp8_f32(v[j].z * inv, v[j].w * inv, p, true);
                *(int*)(dst + 256 * j + 4 * lane) = p; }
            if (lane == 0) sc[e] = am * (1.f / 440.f); }
    }
}

__device__ __forceinline__ float dpp_row_sum(float x) {
#define PEER_DPP(ctrl) x += __builtin_bit_cast(float, __builtin_amdgcn_update_dpp(0, __builtin_bit_cast(int, x), ctrl, 0xF, 0xF, false))
    PEER_DPP(0xB1); PEER_DPP(0x4E); PEER_DPP(0x141); PEER_DPP(0x140);
#undef PEER_DPP
    return x;
}
template <bool VPH, int PBS, bool LA> __device__ __forceinline__ void peer_uv_phase(Frame& F, const Args& a) {
    unsigned char* ws = a.ws; GAS bf16* H = (GAS bf16*)(ws + WS_HB); const GAS float* g2 = (const GAS float*)a.in[10];
    const int sl = blockIdx.x & 7, rk = blockIdx.x >> 3, nrk = F.G >> 3, tpw = M / nrk / NWAVES, nq = tpw / 4;
    const unsigned char* TAB; const GAS int* EIDX; const GAS float* SSQ; const GAS float* PW; GAS float* PD; GAS float* SSQ2;
    LAS int* idt = (LAS int*)(F.lds + F.wave * 8192);
    LAS float* wt = (LAS float*)(F.lds + F.wave * 8192 + 4096);
    const int t0 = (rk * NWAVES + F.wave) * tpw;
#define PEER_STAGE_LOAD(QI) do { const size_t tb_ = (size_t)(t0 + 4 * (QI) + a4) * 128; _Pragma("unroll") for (int k = 0; k < 8; ++k) sid[k] = EIDX[tb_ + 16 * k + q]; } while (0)
#define PEER_STAGE_WRITE(QI) do { const int bf_ = ((QI) & 1) * 512; _Pragma("unroll") for (int k = 0; k < 8; ++k) idt[bf_ + (16 * k + q) * 4 + a4] = sid[k]; } while (0)
#define PEER_STAGE_W(QI) do { if (VPH) { const size_t tb_ = (size_t)(t0 + 4 * (QI) + a4) * 128; const int bf_ = ((QI) & 1) * 512; _Pragma("unroll") for (int k = 0; k < 8; ++k) wt[bf_ + (16 * k + q) * 4 + a4] = PW[tb_ + 16 * k + q]; LDS_WAIT(); asm volatile("" ::: "memory"); } } while (0)
#define PEER_ISSUE(R, QI, WB) do { const int bf_ = ((QI) & 1) * 512 + (WB) * (4 * PBS) + a4; _Pragma("unroll") for (int j = 0; j < PBS; ++j) { const int e_ = idt[bf_ + 4 * j]; R[j] = ldu<i32x4>(TAB, (unsigned)e_ * 2048u + (unsigned)(16 * q)); } } while (0)
    unsigned xq[8]; float acc[16];
#define PEER_QUAD_BEGIN(QI) do { const size_t t_ = (size_t)(t0 + 4 * (QI) + a4); \
        if (!VPH) { f32x4 hq[4]; { const v4u h0_ = *(const GAS v4u*)(H + t_ * DM + 256 * sl + 16 * q), h1_ = *(const GAS v4u*)(H + t_ * DM + 256 * sl + 16 * q + 8); \
            hq[0] = (f32x4){bflo(h0_.x), bfhi(h0_.x), bflo(h0_.y), bfhi(h0_.y)}; hq[1] = (f32x4){bflo(h0_.z), bfhi(h0_.z), bflo(h0_.w), bfhi(h0_.w)}; hq[2] = (f32x4){bflo(h1_.x), bfhi(h1_.x), bflo(h1_.y), bfhi(h1_.y)}; hq[3] = (f32x4){bflo(h1_.z), bfhi(h1_.z), bflo(h1_.w), bfhi(h1_.w)}; }  const float pss_ = dpp_row_sum(SSQ[t_ * 32 + q] + SSQ[t_ * 32 + 16 + q]); const float rstd_ = 1.f / sqrtf(pss_ * (1.f / DM) + EPS); f32x4 gv[4]; \
            _Pragma("unroll") for (int k = 0; k < 4; ++k) gv[k] = *(const GAS f32x4*)(g2 + 256 * sl + 16 * q + 4 * k); \
            _Pragma("unroll") for (int k = 0; k < 4; ++k) { xq[2 * k] = pk2(hq[k].x * rstd_ * gv[k].x, hq[k].y * rstd_ * gv[k].y); xq[2 * k + 1] = pk2(hq[k].z * rstd_ * gv[k].z, hq[k].w * rstd_ * gv[k].w); } } \
        else { _Pragma("unroll") for (int k = 0; k < 16; ++k) acc[k] = 0.f; } } while (0)
#define PEER_COMPUTE(R, QI, WB) do { if (!VPH) { float pdb_ = 0.f; _Pragma("unroll") for (int j = 0; j < PBS; ++j) { float d_ = 0.f; _Pragma("unroll") for (int k = 0; k < 4; ++k) { const int dw_ = R[j][k]; \
                d_ = __builtin_amdgcn_fdot2_f32_bf16(__builtin_amdgcn_cvt_scalef32_pk_bf16_fp8(dw_, 1.0f, false), __builtin_bit_cast(bf16x2_t, xq[2 * k]), d_, false); \
                d_ = __builtin_amdgcn_fdot2_f32_bf16(__builtin_amdgcn_cvt_scalef32_pk_bf16_fp8(dw_, 1.0f, true), __builtin_bit_cast(bf16x2_t, xq[2 * k + 1]), d_, false); } \
                d_ = dpp_row_sum(d_); pdb_ = (q == j) ? d_ : pdb_; } \
            if (q < PBS) PD[((size_t)(t0 + 4 * (QI) + a4) * 8 + sl) * 128 + PBS * (WB) + q] = pdb_; } \
        else { const int bf_ = ((QI) & 1) * 512 + (WB) * (4 * PBS) + a4; _Pragma("unroll") for (int j = 0; j < PBS; ++j) { const float w_ = wt[bf_ + 4 * j]; int r0_ = R[j][0], r1_ = R[j][1], r2_ = R[j][2], r3_ = R[j][3]; asm volatile("" : "+v"(r0_), "+v"(r1_), "+v"(r2_), "+v"(r3_));     \
                _Pragma("unroll") for (int k = 0; k < 4; ++k) { const int dw_ = k == 0 ? r0_ : k == 1 ? r1_ : k == 2 ? r2_ : r3_; \
                const f32x2 lo_ = __builtin_amdgcn_cvt_pk_f32_fp8(dw_, false), hi_ = __builtin_amdgcn_cvt_pk_f32_fp8(dw_, true); \
                acc[4 * k + 0] += w_ * lo_.x; acc[4 * k + 1] += w_ * lo_.y; acc[4 * k + 2] += w_ * hi_.x; acc[4 * k + 3] += w_ * hi_.y; } } } } while (0)
#define PEER_QUAD_END(QI) do { if (VPH) { const size_t t_ = (size_t)(t0 + 4 * (QI) + a4); GAS bf16* hp_ = H + t_ * DM + 256 * sl + 16 * q; const v4u h0_ = *(const GAS v4u*)hp_, h1_ = *(const GAS v4u*)(hp_ + 8); \
            float y_[16]; y_[0] = bflo(h0_.x); y_[1] = bfhi(h0_.x); y_[2] = bflo(h0_.y); y_[3] = bfhi(h0_.y); y_[4] = bflo(h0_.z); y_[5] = bfhi(h0_.z); y_[6] = bflo(h0_.w); y_[7] = bfhi(h0_.w); \
            y_[8] = bflo(h1_.x); y_[9] = bfhi(h1_.x); y_[10] = bflo(h1_.y); y_[11] = bfhi(h1_.y); y_[12] = bflo(h1_.z); y_[13] = bfhi(h1_.z); y_[14] = bflo(h1_.w); y_[15] = bfhi(h1_.w); \
            float ss_ = 0.f; _Pragma("unroll") for (int k = 0; k < 16; ++k) { y_[k] += acc[k]; ss_ += y_[k] * y_[k]; } \
            *(GAS v4u*)hp_ = (v4u){pk2(y_[0], y_[1]), pk2(y_[2], y_[3]), pk2(y_[4], y_[5]), pk2(y_[6], y_[7])}; *(GAS v4u*)(hp_ + 8) = (v4u){pk2(y_[8], y_[9]), pk2(y_[10], y_[11]), pk2(y_[12], y_[13]), pk2(y_[14], y_[15])}; \
            ss_ = dpp_row_sum(ss_); if (q == 0) SSQ2[t_ * 8 + sl] = ss_; } } while (0)
#pragma unroll 1
    for (int qi = 0; qi < nq; ++qi) {
        i32x4 rA[PBS], rB[PBS];
        const int lane = opaque_v(F.lane), a4 = lane >> 4, q = lane & 15; ws = opaque(ws); H = (GAS bf16*)(ws + WS_HB);
        TAB = opaque((const unsigned char*)a.out) + (VPH ? OUT_V8 : OUT_U8) + 256 * sl; EIDX = (const GAS int*)(ws + WS_EIDX); SSQ = (const GAS float*)(ws + WS_SSQ); PW = (const GAS float*)(ws + WS_PW); PD = (GAS float*)(ws + WS_PD); SSQ2 = (GAS float*)(ws + WS_SSQ2);
        int sid[8];
        if (!LA || qi == 0) { PEER_STAGE_LOAD(qi); PEER_STAGE_WRITE(qi); LDS_WAIT(); asm volatile("" ::: "memory"); }
        PEER_ISSUE(rA, qi, 0);
        PEER_ISSUE(rB, qi, 1);
        if (LA && qi + 1 < nq) PEER_STAGE_LOAD(qi + 1);
        PEER_STAGE_W(qi);
        PEER_QUAD_BEGIN(qi);
#pragma unroll
        for (int wb = 0; wb < 128 / PBS; wb += 2) {
            PEER_COMPUTE(rA, qi, wb); if (wb + 2 < 128 / PBS) { PEER_ISSUE(rA, qi, wb + 2); }
            PEER_COMPUTE(rB, qi, wb + 1); if (wb + 3 < 128 / PBS) { PEER_ISSUE(rB, qi, wb + 3); }
        }
        PEER_QUAD_END(qi);
        if (LA && qi + 1 < nq) { PEER_STAGE_WRITE(qi + 1); LDS_WAIT(); asm volatile("" ::: "memory"); }
    }
#undef PEER_STAGE_LOAD
#undef PEER_STAGE_WRITE
#undef PEER_STAGE_W
#undef PEER_ISSUE
#undef PEER_QUAD_BEGIN
#undef PEER_COMPUTE
#undef PEER_QUAD_END
}
__device__ __forceinline__ void peer_w_phase(Frame& F, const Args& a) {
    unsigned char* ws = a.ws; const float* PD = (const float*)(ws + WS_PD); const int* EIDX = (const int*)(ws + WS_EIDX); const float* GATE = (const float*)(ws + WS_GATE);
    const float* SU = (const float*)(ws + WS_SU); const float* SV = (const float*)(ws + WS_SV); float* PW = (float*)(ws + WS_PW);
    for (int i = F.vcu * 512 + F.tid; i < M * 128; i += F.G * 512) { const int t = i >> 7, p = i & 127; float d = 0.f;
#pragma unroll
        for (int sl = 0; sl < 8; ++sl) d += PD[((size_t)t * 8 + sl) * 128 + p];
        const int e = EIDX[i]; d *= SU[e];
        PW[i] = GATE[i] * 0.5f * d * (1.f + erff(d * 0.70710678118654752f)) * SV[e]; }
}
__device__ __forceinline__ void peer_n_phase(Frame& F, const Args& a) {
    unsigned char* ws = a.ws; const GAS bf16* Y = (const GAS bf16*)(ws + WS_HB); GAS float* O = (GAS float*)a.out; const GAS float* gf = (const GAS float*)a.in[15]; const GAS float* SSQ2 = (const GAS float*)(ws + WS_SSQ2); const int lane = F.lane;
    f32x4 g0[4], g1[4];
#pragma unroll
    for (int j = 0; j < 4; ++j) { g0[j] = *(const GAS f32x4*)(gf + 512 * j + 8 * lane); g1[j] = *(const GAS f32x4*)(gf + 512 * j + 8 * lane + 4); }
    const int gw = F.vcu * NWAVES + F.wave, NGW = F.G * NWAVES;
    v4u yw[4], yn[4]; f32x4 s0, s1, n0, n1;
    if (gw < M) {
#pragma unroll
        for (int j = 0; j < 4; ++j) yw[j] = *(const GAS v4u*)(Y + (size_t)gw * DM + 512 * j + 8 * lane);
        s0 = *(const GAS f32x4*)(SSQ2 + (size_t)gw * 8); s1 = *(const GAS f32x4*)(SSQ2 + (size_t)gw * 8 + 4); }
    for (int m = gw; m < M; m += NGW) { const int mn = m + NGW < M ? m + NGW : m;
#pragma unroll
        for (int j = 0; j < 4; ++j) yn[j] = *(const GAS v4u*)(Y + (size_t)mn * DM + 512 * j + 8 * lane);
        n0 = *(const GAS f32x4*)(SSQ2 + (size_t)mn * 8); n1 = *(const GAS f32x4*)(SSQ2 + (size_t)mn * 8 + 4);
        const float rf = 1.f / sqrtf((((s0.x + s0.y) + (s0.z + s0.w)) + ((s1.x + s1.y) + (s1.z + s1.w))) * (1.f / DM) + EPS);
#pragma unroll
        for (int j = 0; j < 4; ++j) {
            *(GAS f32x4*)(O + (size_t)m * DM + 512 * j + 8 * lane) = (f32x4){bflo(yw[j].x) * rf * g0[j].x, bfhi(yw[j].x) * rf * g0[j].y, bflo(yw[j].y) * rf * g0[j].z, bfhi(yw[j].y) * rf * g0[j].w};
            *(GAS f32x4*)(O + (size_t)m * DM + 512 * j + 8 * lane + 4) = (f32x4){bflo(yw[j].z) * rf * g1[j].x, bfhi(yw[j].z) * rf * g1[j].y, bflo(yw[j].w) * rf * g1[j].z, bfhi(yw[j].w) * rf * g1[j].w}; }
#pragma unroll
        for (int j = 0; j < 4; ++j) yw[j] = yn[j];
        s0 = n0; s1 = n1; }
}

__global__ void __launch_bounds__(NWAVES * 64, 2) mk_fwd(Args args_in) {
    extern __shared__ __attribute__((aligned(16))) unsigned char lds[];
    Args args = args_in;
#pragma unroll
    for (int i = 0; i < 16; ++i) args.in[i] = (const float*)(const GAS float*)args_in.in[i];
    args.out = (float*)(GAS float*)args_in.out; args.ws = (unsigned char*)(GAS unsigned char*)args_in.ws;
    Frame F;
    F.lds = (LAS unsigned char*)lds;
    F.MISC = (volatile LAS unsigned*)(F.lds + MISC_OFF);
    F.tid = threadIdx.x; F.lane = F.tid & 63; F.wave = __builtin_amdgcn_readfirstlane(F.tid >> 6);
    F.G = gridDim.x; { const int bx = blockIdx.x; F.vcu = (F.G % 8 == 0) ? (bx % 8) * (F.G / 8) + bx / 8 : bx; }
    unsigned char* ws = args.ws;
    F.ctl = (gu32*)(ws + WS_CTL);
    for (int u = F.tid; u < (LDS_BYTES - LDSCTL_OFF) / 4; u += NWAVES * 64) ((LAS unsigned*)(F.lds + LDSCTL_OFF))[u] = 0u;
    __syncthreads();
    XcdBarrier bar = xcd_barrier_post((unsigned*)(F.ctl + CW_BAR) + args.li * XCD_BAR_WORDS, F.MISC + 8);
    const int lo = args.ph_lo, hi = args.ph_hi;
#define IN(k) (lo <= (k) && (k) < hi)
#define BOTH(k) (IN(k) && IN((k) + 1))
#define GRID_BAR() xcd_barrier(bar)

    if (IN(0)) { for (int rep = 0; rep < NREP(0); ++rep) p0_prologue(F, args); if (BOTH(0)) GRID_BAR(); }

    if (IN(1)) {
        pg8::Gemm g{(const bf16*)(ws + WS_XN), (const bf16*)(ws + WS_WIN), M, NINP, DM}; pg8::StaticOrder S; S.init(M, NINP, F.G, (int)blockIdx.x);
        pg8::EpiBf16<0> E{(bf16*)(ws + WS_PROJ), NINP, nullptr, 0, 0, 1.f};
        for (int rep = 0; rep < NREP(1); ++rep) pg8::gemm_phase<pg8::EpiBf16<0>, pg8::StaticOrder, PG8_ALIGN, PG8_SP2>(F.lds + RING_OFF, g, S, E);
        for (int rep = 0; rep < NREP(11); ++rep) gd_side_gemm(F, args);
        if (BOTH(1)) GRID_BAR();
    }
    if (IN(2)) {
        for (int rep = 0; rep < NREP(21); ++rep) gla_prep_phase(F, args);
        GRID_BAR();
        for (int rep = 0; rep < NREP(2); ++rep) gla_seq_phase(F, args);
        for (int rep = 0; rep < NREP(20); ++rep) attn_phase(F, args, rep);
        for (int rep = 0; rep < NREP(40); ++rep) peer_convert_tables(F, args, rep);
        if (BOTH(2)) GRID_BAR(); }
    if (IN(3)) { for (int rep = 0; rep < NREP(3); ++rep) p3_finalize(F, args); if (BOTH(3)) GRID_BAR(); }
    if (IN(4)) {
        pg8::Gemm g{(const bf16*)(ws + WS_XN), (const bf16*)(ws + WS_WOUT), M, DM, DM}; pg8::StaticOrder S; S.init(M, DM, F.G, (int)blockIdx.x);
        pg8::EpiRes E{args.in[0], (bf16*)(ws + WS_HB), (float*)(ws + WS_SSQ), DM};
        for (int rep = 0; rep < NREP(4); ++rep) pg8::gemm_phase<pg8::EpiRes, pg8::StaticOrder, PG8_ALIGN, PG8_SP2>(F.lds + RING_OFF, g, S, E);
        if (BOTH(4)) GRID_BAR();
    }
    if (IN(5)) {
        pg8::Gemm g{(const bf16*)(ws + WS_HB), (const bf16*)(ws + WS_WQ), M, DM, DM}; pg8::StaticOrder S; S.init(M, DM, F.G, (int)blockIdx.x);
        pg8::EpiRowScale E{(bf16*)(ws + WS_XN), DM, (const float*)(ws + WS_SSQ), 1.f / DM, EPS};
        for (int rep = 0; rep < NREP(5); ++rep) pg8::gemm_phase<pg8::EpiRowScale, pg8::StaticOrder, PG8_ALIGN, PG8_SP2>(F.lds + RING_OFF, g, S, E);
        if (BOTH(5)) GRID_BAR();
    }
    if (IN(6)) { for (int rep = 0; rep < NREP(6); ++rep) topk_phase(F, args); if (BOTH(6)) GRID_BAR(); }
    if (IN(7)) {
        for (int rep = 0; rep < NREP(7); ++rep) peer_uv_phase<false, 16, true>(F, args);
        GRID_BAR();
        peer_w_phase(F, args);
        GRID_BAR();
        if (REP_PHASE != 8) peer_uv_phase<true, 16, false>(F, args);
        GRID_BAR();
        peer_n_phase(F, args);
    }
#undef IN
#undef BOTH
}


extern "C" void kernel_launch(void* const* d_in, const int* in_sizes, int n_in, void* d_out, int out_size, void* d_ws, size_t ws_size, hipStream_t stream) {
    static int grid = 0;
    if (grid == 0) {
        if (n_in != 16 || in_sizes[0] != M * DM || out_size != M * DM || ws_size < WS_END) { fprintf(stderr, "kernel_launch: unexpected shapes: n_in %d in0 %d out %d ws %zu\n", n_in, n_in > 0 ? in_sizes[0] : -1, out_size, ws_size); grid = -1; return; }
        int dev = 0, cus = 0;
        if (hipGetDevice(&dev) != hipSuccess || hipDeviceGetAttribute(&cus, hipDeviceAttributeMultiprocessorCount, dev) != hipSuccess) { grid = -1; return; }
        if (hipFuncSetAttribute((const void*)mk_fwd, hipFuncAttributeMaxDynamicSharedMemorySize, LDS_BYTES) != hipSuccess) { fprintf(stderr, "kernel_launch: hipFuncSetAttribute failed\n"); grid = -1; return; }
        (void)hipGetLastError();
        grid = cus;
    }
    if (grid < 0) return;
    (void)hipMemsetAsync((char*)d_ws + WS_CTL, 0, CTL_ZERO_BYTES, stream);
    Args a{};
    for (int i = 0; i < 16; ++i) a.in[i] = (const float*)d_in[i];
    a.out = (float*)d_out; a.ws = (unsigned char*)d_ws;
    a.ph_lo = 0; a.ph_hi = 8; a.li = 0;
    hipLaunchKernelGGL(mk_fwd, dim3(grid), dim3(NWAVES * 64), LDS_BYTES, stream, a);
}
```

```cpp
#define REP_PHASE -1

#include <hip/hip_runtime.h>
#include <cstdio>
#include <cstdint>
#include <cmath>
#ifndef REP_PHASE
#define REP_PHASE -1
#endif
#define NREP(k) ((REP_PHASE == (k)) ? 2 : 1)
namespace pg8 {
#define PG8_LAS __attribute__((address_space(3)))
typedef unsigned short bf16_t;
typedef short bf16x8 __attribute__((ext_vector_type(8)));
typedef float f32x4 __attribute__((ext_vector_type(4)));
typedef unsigned u32x4 __attribute__((ext_vector_type(4)));
constexpr int BM = 256, BK = 64, HALF = 128, HTB = HALF * BK * 2  , STAGE_BYTES = 8 * HTB, NXCD = 8, WGM = 8;

__host__ __device__ __forceinline__ int lds_byte(int r, int c) { const int st = (r >> 4) * 2 + (c >> 5), rr = r & 15, cc = c & 31, ob = rr * 64 + cc * 2; return st * 1024 + (ob ^ (((ob >> 9) & 1) << 5)); }
__host__ __device__ __forceinline__ void stage_rc(int b, int& R, int& C) { const int st = b / 1024, sb = b % 1024, swz = sb ^ (((sb >> 9) & 1) << 5); R = (st >> 1) * 16 + swz / 64; C = (st & 1) * 32 + (swz % 64) / 2; }
__host__ __device__ __forceinline__ int perm32(int rho) { const int n = rho >> 4, i = rho & 15; return 8 * (i >> 2) + 4 * n + (i & 3); }

struct Unit { int pm, pn; };
struct Gemm { const bf16_t* A; const bf16_t* Bt; int M, N, K; };

struct StaticOrder {
    int nM, nN, nwg, G, c;
    __host__ __device__ void init(int M, int N, int G_, int c_) { nM = M / BM; nN = N / BM; nwg = nM * nN; G = G_; c = c_; }
    __host__ __device__ bool next(int i, Unit& u) const {
        const long L = (long)i * G + c; if (L >= nwg) return false;
        int wgid = (int)L; { const int q = nwg / NXCD, r = nwg % NXCD, xcd = wgid % NXCD, off = wgid / NXCD; wgid = (xcd < r ? xcd * (q + 1) : r * (q + 1) + (xcd - r) * q) + off; }
        const int nig = WGM * nN, gid = wgid / nig, fm = gid * WGM, gsz = (nM - fm) < WGM ? (nM - fm) : WGM;
        u.pm = fm + ((wgid % nig) % gsz); u.pn = (wgid % nig) / gsz; return true;
    }
    __device__ __forceinline__ void a_ready(const Unit&) const {}
    __device__ __forceinline__ void done(const Unit&) const {}
};

__device__ __forceinline__ unsigned cvt_pk_bf16(float lo, float hi) { unsigned r; asm volatile("v_cvt_pk_bf16_f32 %0, %1, %2" : "=v"(r) : "v"(lo), "v"(hi)); return r; }
typedef float f32x2 __attribute__((ext_vector_type(2)));
__device__ __forceinline__ f32x2 gelu_pk(f32x2 v) {
    const f32x2 av = __builtin_elementwise_abs(v), d = av * 0.2316418882f + 1.0f;
    f32x2 t; t.x = __builtin_amdgcn_rcpf(d.x); t.y = __builtin_amdgcn_rcpf(d.y);
    f32x2 q = t * 0.5307027145f + (-0.7265760135f); q = q * t + 0.7107068705f; q = q * t + (-0.142248368f); q = q * t + 0.127414796f; q = q * t;
    const f32x2 s = (v * v) * (-0.72134752044f);
    f32x2 e; e.x = __builtin_amdgcn_exp2f(s.x); e.y = __builtin_amdgcn_exp2f(s.y);
    const f32x2 m = v * (q * e), r = v - m;
    f32x2 o; o.x = v.x < 0.f ? m.x : r.x; o.y = v.y < 0.f ? m.y : r.y; return o;
}

template <int ACT  > struct EpiBf16 {
    static constexpr bool PERM = true, AFTER_DRAIN = false; static_assert(ACT == 0 || ACT == 1, "EpiBf16: ACT is 0 (none) or 1 (gelu_pk)");
    bf16_t* O; int ldc; const float* bias; int split_cols; size_t split_stride; float scale0;
    __device__ __forceinline__ void operator()(const f32x4 (&acc)[2][2][4][2], const Unit& u, int wr, int wc, int fr, int fq) const {
        const int row0 = u.pm * BM + wr * 64 + fr; int colt = u.pn * BM; bf16_t* base = O;
        float sc = 1.f; if (split_cols) { const int t = colt / split_cols; base += (size_t)t * split_stride; colt -= t * split_cols; if (t == 0) sc = scale0; }
        const int col0 = colt + wc * 32 + 8 * fq, bcol0 = u.pn * BM + wc * 32 + 8 * fq;
        f32x4 bv[2][2];
#pragma unroll
        for (int bj = 0; bj < 2; ++bj)
#pragma unroll
            for (int n = 0; n < 2; ++n) bv[bj][n] = bias ? *(const f32x4*)(bias + bcol0 + bj * HALF + 4 * n) : (f32x4){0.f, 0.f, 0.f, 0.f};
#pragma unroll
        for (int ai = 0; ai < 2; ++ai)
#pragma unroll
            for (int m = 0; m < 4; ++m) { bf16_t* rowp = base + (size_t)(row0 + ai * HALF + m * 16) * ldc + col0;
#pragma unroll
                for (int bj = 0; bj < 2; ++bj) { f32x4 v0 = acc[ai][bj][m][0] + bv[bj][0], v1 = acc[ai][bj][m][1] + bv[bj][1];
                    if (ACT == 1) { f32x2 a = gelu_pk((f32x2){v0[0], v0[1]}), b = gelu_pk((f32x2){v0[2], v0[3]}), c = gelu_pk((f32x2){v1[0], v1[1]}), d = gelu_pk((f32x2){v1[2], v1[3]});
                        v0 = (f32x4){a.x, a.y, b.x, b.y}; v1 = (f32x4){c.x, c.y, d.x, d.y}; }
                    v0 = v0 * sc; v1 = v1 * sc; u32x4 w; w.x = cvt_pk_bf16(v0[0], v0[1]); w.y = cvt_pk_bf16(v0[2], v0[3]); w.z = cvt_pk_bf16(v1[0], v1[1]); w.w = cvt_pk_bf16(v1[2], v1[3]);
                    *(u32x4*)(rowp + bj * HALF) = w; } }
    }
};
template <class Epi, class Sched, bool ALIGN_EPI = false, bool SP2 = false>
__device__ __forceinline__ void gemm_phase(PG8_LAS unsigned char* lds, const Gemm g, const Sched& S, const Epi& E) {
    const int tid = threadIdx.x, wid = __builtin_amdgcn_readfirstlane(tid >> 6), lane = tid & 63, wr = wid >> 2, wc = wid & 3, fr = lane & 15, fq = lane >> 4;
    const int K = g.K, nt = K / BK;
    unsigned voffA[2], voffB[2];
#pragma unroll
    for (int i = 0; i < 2; ++i) { int R, C; stage_rc(tid * 16 + i * 8192, R, C); const int Rb = Epi::PERM ? ((R & ~31) + perm32(R & 31)) : R;
        voffA[i] = (unsigned)(R * K + C) * 2u; voffB[i] = (unsigned)(Rb * K + C) * 2u; }
    const size_t kstep = (size_t)(BK * 2);
    const size_t hstep = (size_t)HALF * K * 2;
    const size_t tstep = 2 * hstep;
    const unsigned ldsw = (unsigned)wid * 1024u;
    const int aoff = lds_byte(wr * 64 + fr, fq * 8), boff = lds_byte(wc * 32 + fr, fq * 8);
#define PG8_SA(b, h) (((b) * 2 + (h)) * HTB)
#define PG8_SB(b, h) ((4 + (b) * 2 + (h)) * HTB)
#define PG8_STAGE(bufoff, gbase, voff) do { _Pragma("unroll") for (int _i = 0; _i < 2; ++_i) \
        __builtin_amdgcn_global_load_lds((const unsigned*)((const char*)(gbase) + (voff)[_i]), (PG8_LAS unsigned*)(lds + (bufoff) + ldsw + _i * 8192), 16, 0, 0); } while (0)
#define PG8_LDA(dst, b, h) do { _Pragma("unroll") for (int m = 0; m < 4; ++m) _Pragma("unroll") for (int k = 0; k < 2; ++k) dst[m][k] = *(const PG8_LAS bf16x8*)(lds + PG8_SA(b, h) + aoff + m * 2048 + k * 1024); } while (0)
#define PG8_LDB(dst, b, h) do { _Pragma("unroll") for (int n = 0; n < 2; ++n) _Pragma("unroll") for (int k = 0; k < 2; ++k) dst[n][k] = *(const PG8_LAS bf16x8*)(lds + PG8_SB(b, h) + boff + n * 2048 + k * 1024); } while (0)
#define PG8_MMA(ai, bj, At, Bt) do { __builtin_amdgcn_s_setprio(1); _Pragma("unroll") for (int m = 0; m < 4; ++m) _Pragma("unroll") for (int n = 0; n < 2; ++n) _Pragma("unroll") for (int k = 0; k < 2; ++k) \
        acc[ai][bj][m][n] = __builtin_amdgcn_mfma_f32_16x16x32_bf16(Bt[n][k], At[m][k], acc[ai][bj][m][n], 0, 0, 0); __builtin_amdgcn_s_setprio(0); } while (0)
#define PG8_WAIT_V(n) asm volatile("s_waitcnt vmcnt(" #n ")" ::: "memory")
#define PG8_WAIT_L(n) asm volatile("s_waitcnt lgkmcnt(" #n ")" ::: "memory")
#define PG8_BAR __builtin_amdgcn_s_barrier()
#define PG8_SCHED __builtin_amdgcn_sched_barrier(0)
    Unit cur, nxt; int ui = 0;
    if (!S.next(0, cur)) return;
    f32x4 acc[2][2][4][2];
#pragma unroll
    for (int a = 0; a < 2; ++a)
#pragma unroll
        for (int b = 0; b < 2; ++b)
#pragma unroll
            for (int m = 0; m < 4; ++m)
#pragma unroll
                for (int n = 0; n < 2; ++n) acc[a][b][m][n] = (f32x4){0.f, 0.f, 0.f, 0.f};
    bf16x8 At[4][2], B0[2][2], B1[2][2];
    const char* cA = (const char*)g.A + (size_t)cur.pm * tstep; const char* cB = (const char*)g.Bt + (size_t)cur.pn * tstep;
    S.a_ready(cur);
    if constexpr (SP2) {
        PG8_STAGE(PG8_SB(0, 0), cB, voffB); PG8_STAGE(PG8_SB(0, 1), cB + hstep, voffB); PG8_STAGE(PG8_SA(0, 0), cA, voffA); PG8_STAGE(PG8_SA(0, 1), cA + hstep, voffA);
        if (wr == 1) PG8_BAR;
        PG8_WAIT_V(2); PG8_BAR;
        PG8_STAGE(PG8_SB(1, 0), cB + kstep, voffB); PG8_STAGE(PG8_SA(1, 0), cA + kstep, voffA); PG8_STAGE(PG8_SB(1, 1), cB + hstep + kstep, voffB);
        PG8_WAIT_V(6); PG8_BAR;
    } else {
        PG8_STAGE(PG8_SB(0, 0), cB, voffB); PG8_STAGE(PG8_SA(0, 0), cA, voffA); PG8_STAGE(PG8_SB(0, 1), cB + hstep, voffB); PG8_STAGE(PG8_SA(0, 1), cA + hstep, voffA);
        if (wr == 1) PG8_BAR;
        PG8_WAIT_V(4); PG8_BAR;
        PG8_STAGE(PG8_SB(1, 0), cB + kstep, voffB); PG8_STAGE(PG8_SA(1, 0), cA + kstep, voffA); PG8_STAGE(PG8_SB(1, 1), cB + hstep + kstep, voffB);
        PG8_WAIT_V(6); PG8_BAR;
    }
    for (;;) {
        const bool has_next = S.next(ui + 1, nxt);
        const char* nA = has_next ? (const char*)g.A + (size_t)nxt.pm * tstep : cA; const char* nB = has_next ? (const char*)g.Bt + (size_t)nxt.pn * tstep : cB;
        for (int t = 0; t < nt; t += 2) {
            const bool last = (t == nt - 2);
            const char* a1 = cA + (size_t)(t + 1) * kstep;
            const char* a2 = last ? nA : cA + (size_t)(t + 2) * kstep; const char* b2 = last ? nB : cB + (size_t)(t + 2) * kstep;
            const char* a3 = a2 + kstep; const char* b3 = b2 + kstep;
            if (last && has_next) S.a_ready(nxt);
            if constexpr (SP2) {
            PG8_LDB(B0, 0, 0); PG8_LDB(B1, 0, 1); PG8_SCHED; PG8_LDA(At, 0, 0); PG8_STAGE(PG8_SA(1, 1), a1 + hstep, voffA);
            PG8_WAIT_V(8); PG8_WAIT_L(0); PG8_BAR; PG8_MMA(0, 0, At, B0); PG8_MMA(0, 1, At, B1); PG8_BAR; PG8_SCHED;
            PG8_LDA(At, 0, 1); PG8_STAGE(PG8_SB(0, 0), b2, voffB); PG8_STAGE(PG8_SB(0, 1), b2 + hstep, voffB); PG8_STAGE(PG8_SA(0, 0), a2, voffA);
            PG8_WAIT_V(8); PG8_WAIT_L(0); PG8_BAR; PG8_MMA(1, 0, At, B0); PG8_MMA(1, 1, At, B1); PG8_BAR; PG8_SCHED;
            PG8_LDB(B0, 1, 0); PG8_LDB(B1, 1, 1); PG8_SCHED; PG8_LDA(At, 1, 0); PG8_STAGE(PG8_SA(0, 1), a2 + hstep, voffA);
            PG8_WAIT_V(8); PG8_WAIT_L(0); PG8_BAR; PG8_MMA(0, 0, At, B0); PG8_MMA(0, 1, At, B1); PG8_BAR; PG8_SCHED;
            PG8_LDA(At, 1, 1); PG8_STAGE(PG8_SB(1, 0), b3, voffB); PG8_STAGE(PG8_SB(1, 1), b3 + hstep, voffB); PG8_STAGE(PG8_SA(1, 0), a3, voffA);
            PG8_WAIT_V(8); PG8_WAIT_L(0); PG8_BAR; PG8_MMA(1, 0, At, B0); PG8_MMA(1, 1, At, B1); PG8_BAR; PG8_SCHED;
            } else {
            PG8_LDB(B0, 0, 0); PG8_SCHED; PG8_LDA(At, 0, 0); PG8_STAGE(PG8_SA(1, 1), a1 + hstep, voffA);
            PG8_WAIT_L(8); PG8_BAR; PG8_WAIT_L(0); PG8_MMA(0, 0, At, B0); PG8_BAR; PG8_SCHED;
            PG8_LDB(B1, 0, 1); PG8_STAGE(PG8_SB(0, 0), b2, voffB);
            PG8_BAR; PG8_WAIT_L(0); PG8_MMA(0, 1, At, B1); PG8_BAR;
            PG8_LDA(At, 0, 1); PG8_STAGE(PG8_SA(0, 0), a2, voffA);
            PG8_BAR; PG8_WAIT_L(0); PG8_MMA(1, 0, At, B0); PG8_BAR; PG8_SCHED;
            PG8_STAGE(PG8_SB(0, 1), b2 + hstep, voffB);
            PG8_WAIT_V(6); PG8_BAR; PG8_MMA(1, 1, At, B1); PG8_BAR;
            PG8_LDB(B0, 1, 0); PG8_SCHED; PG8_LDA(At, 1, 0); PG8_STAGE(PG8_SA(0, 1), a2 + hstep, voffA);
            PG8_WAIT_L(8); PG8_BAR; PG8_WAIT_L(0); PG8_MMA(0, 0, At, B0); PG8_BAR; PG8_SCHED;
            PG8_LDB(B1, 1, 1); PG8_STAGE(PG8_SB(1, 0), b3, voffB);
            PG8_BAR; PG8_WAIT_L(0); PG8_MMA(0, 1, At, B1); PG8_BAR;
            PG8_LDA(At, 1, 1); PG8_STAGE(PG8_SA(1, 0), a3, voffA);
            PG8_BAR; PG8_WAIT_L(0); PG8_MMA(1, 0, At, B0); PG8_BAR; PG8_SCHED;
            PG8_STAGE(PG8_SB(1, 1), b3 + hstep, voffB);
            PG8_WAIT_V(6); PG8_BAR; PG8_MMA(1, 1, At, B1); PG8_BAR;
            }
        }
        if constexpr (ALIGN_EPI) { if (wr == 0) PG8_BAR; }
        if constexpr (!Epi::AFTER_DRAIN) { E(acc, cur, wr, wc, fr, fq); S.done(cur); }
        if (!has_next) break;
#pragma unroll
        for (int a = 0; a < 2; ++a)
#pragma unroll
            for (int b = 0; b < 2; ++b)
#pragma unroll
                for (int m = 0; m < 4; ++m)
#pragma unroll
                    for (int n = 0; n < 2; ++n) acc[a][b][m][n] = (f32x4){0.f, 0.f, 0.f, 0.f};
        cur = nxt; cA = nA; cB = nB; ++ui;
        if constexpr (ALIGN_EPI) { if (wr == 1) PG8_BAR; }
    }
    PG8_WAIT_V(0);
    if constexpr (!ALIGN_EPI) { if (wr == 0) PG8_BAR; }
    PG8_BAR;
    if constexpr (Epi::AFTER_DRAIN) { E.fused(acc, cur, wr, wc, fr, fq, lds, wid, lane); S.done(cur); }
#undef PG8_SA
#undef PG8_SB
#undef PG8_STAGE
#undef PG8_LDA
#undef PG8_LDB
#undef PG8_MMA
#undef PG8_WAIT_V
#undef PG8_WAIT_L
#undef PG8_BAR
#undef PG8_SCHED
}
}

#ifndef PG8_SP2
#define PG8_SP2 true
#endif
#ifndef PG8_ALIGN
#define PG8_ALIGN true
#endif
#define GAS __attribute__((address_space(1)))
#define LAS __attribute__((address_space(3)))
typedef unsigned short bf16;
typedef unsigned v4u __attribute__((ext_vector_type(4)));
typedef float f32x4 __attribute__((ext_vector_type(4)));
typedef short bf16x8 __attribute__((ext_vector_type(8)));
typedef GAS unsigned gu32;
typedef GAS unsigned long long gu64;
#define RLX_AGENT __ATOMIC_RELAXED, __HIP_MEMORY_SCOPE_AGENT
#define LDS_WAIT() asm volatile("s_waitcnt lgkmcnt(0)" ::: "memory")
#define VM_WAIT() asm volatile("s_waitcnt vmcnt(0)" ::: "memory")
__device__ __forceinline__ unsigned long long rt() { return __builtin_amdgcn_s_memrealtime(); }
__device__ __forceinline__ unsigned f2bf(float f) { unsigned u = __builtin_bit_cast(unsigned, f); return (u + 0x7fffu + ((u >> 16) & 1u)) >> 16; }
typedef float pk2_f32x2 __attribute__((ext_vector_type(2))); typedef __bf16 pk2_bf16x2 __attribute__((ext_vector_type(2)));
__device__ __forceinline__ unsigned pk2(float lo, float hi) { pk2_f32x2 v = {lo, hi}; pk2_bf16x2 b = __builtin_convertvector(v, pk2_bf16x2); return __builtin_bit_cast(unsigned, b); }

#define XB_TMO      128
#define XB_XCNT(j)  (256  + 64 * (j))
#define XB_XSUB(j)  (1280 + 64 * (j))
#define XB_XGEN(j)  (2304 + 64 * (j))
#define XB_TOP      3328
#define XB_TOPGEN   3392
#define XCD_BAR_WORDS 3456
#define XB_SPIN_CAP (1u << 18)

__device__ __forceinline__ unsigned xb_ld(unsigned* p)              { return __hip_atomic_load(p, __ATOMIC_RELAXED, __HIP_MEMORY_SCOPE_AGENT); }
__device__ __forceinline__ unsigned xb_add(unsigned* p, unsigned v) { return __hip_atomic_fetch_add(p, v, __ATOMIC_RELAXED, __HIP_MEMORY_SCOPE_AGENT); }
__device__ __forceinline__ unsigned xb_xcc_id() { return (unsigned)__builtin_amdgcn_s_getreg((3 << 11) | 20) & 0xFu; }
#define XB_SPIN(cond, bar) do { unsigned _sp = 0; while (cond) { __builtin_amdgcn_s_sleep(1); \
    if ((++_sp & 255u) == 0u) { if (xb_ld(&(bar)[XB_TMO])) break; if (_sp > XB_SPIN_CAP) { atomicAdd(&(bar)[XB_TMO], 1u); break; } } } } while (0)

struct XcdBarrier {
    unsigned* bar; unsigned x;
    volatile LAS unsigned* st;
};

__device__ __forceinline__ XcdBarrier xcd_barrier_post(unsigned* bar, volatile LAS unsigned* st) {
    XcdBarrier b; b.bar = bar; b.x = xb_xcc_id(); b.st = st;
    if (threadIdx.x == 0) (void)xb_add(&bar[XB_XCNT(b.x)], 1u);
    return b;
}
__device__ __forceinline__ void xcd_barrier_complete(unsigned* bar, unsigned x, unsigned& nloc, unsigned& nx) {
    const unsigned G = gridDim.x * gridDim.y * gridDim.z;
    unsigned sum, cnt, mine, sp = 0u;
    for (;;) {
        sum = 0u; cnt = 0u; mine = 0u;
#pragma unroll
        for (unsigned j = 0; j < 16; ++j) { const unsigned c = xb_ld(&bar[XB_XCNT(j)]); sum += c; cnt += (c > 0u) ? 1u : 0u; mine = (j == x) ? c : mine; }
        if (sum == G) break;
        __builtin_amdgcn_s_sleep(1);
        if ((++sp & 255u) == 0u) { if (xb_ld(&bar[XB_TMO])) break; if (sp > XB_SPIN_CAP) { atomicAdd(&bar[XB_TMO], 1u); break; } }
    }
    nloc = mine > 0u ? mine : 1u; nx = cnt > 0u ? cnt : 1u;
}

__device__ __forceinline__ void xcd_barrier(const XcdBarrier& b) {
    asm volatile("s_waitcnt vmcnt(0)" ::: "memory");
    __syncthreads();
    if (threadIdx.x == 0) {
        unsigned* bar = b.bar;
        __builtin_amdgcn_s_waitcnt(0);
        unsigned nloc = b.st[0], nx = b.st[1];
        if (nloc == 0u) { xcd_barrier_complete(bar, b.x, nloc, nx); b.st[0] = nloc; b.st[1] = nx; }
        const unsigned old = xb_add(&bar[XB_XSUB(b.x)], 1u);
        const unsigned gen = old / nloc;
        if (old + 1u == (gen + 1u) * nloc) {
            __builtin_amdgcn_fence(__ATOMIC_RELEASE, "agent");
            asm volatile("s_waitcnt vmcnt(0)" ::: "memory");
            const unsigned og = xb_add(&bar[XB_TOP], 1u);
            const unsigned tg = og / nx;
            if (og + 1u == (tg + 1u) * nx) xb_add(&bar[XB_TOPGEN], 1u);
            else XB_SPIN(xb_ld(&bar[XB_TOPGEN]) == tg, bar);
            __builtin_amdgcn_fence(__ATOMIC_ACQUIRE, "agent");
            xb_add(&bar[XB_XGEN(b.x)], 1u);
            asm volatile("s_waitcnt vmcnt(0)" ::: "memory");
        } else {
            XB_SPIN(xb_ld(&bar[XB_XGEN(b.x)]) == gen, bar);
            __builtin_amdgcn_fence(__ATOMIC_ACQUIRE, "agent");
            asm volatile("s_waitcnt vmcnt(0)" ::: "memory");
        }
    }
    __syncthreads();
}


constexpr int NWAVES = 8;
constexpr int DM = 2048, BATCH = 4, SEQ = 4096, M = BATCH * SEQ;
constexpr int NIN = 6176, NINP = 6144;
constexpr int O_GQ = 0, O_GK = 512, O_GV = 1024, O_GR = 2048, O_AQ = 3072, O_AK = 4096, O_AV = 5120;
constexpr float EPS = 1e-6f;
constexpr int PEER_K = 128;

constexpr size_t MiB = 1u << 20;
constexpr size_t WS_CTL = 0, CTL_ZERO_BYTES = 1 * MiB;
constexpr size_t WS_WIN = 1 * MiB;
constexpr size_t WS_WGD = 25 * MiB;
constexpr size_t WS_GDB = 62 * MiB;
constexpr size_t WS_WOUT = 26 * MiB;
constexpr size_t WS_WQ = 34 * MiB;
constexpr size_t WS_SSQ = 42 * MiB;
constexpr size_t WS_EIDX = 44 * MiB;
constexpr size_t WS_GATE = 52 * MiB;
constexpr size_t WS_SKB = 60 * MiB;
constexpr size_t WS_XN = 64 * MiB;
constexpr size_t WS_PROJ = 128 * MiB;
constexpr size_t WS_HB = 256 * MiB;
constexpr size_t WS_OF = 328 * MiB;
constexpr size_t WS_OB = 360 * MiB;
constexpr size_t WS_ATT = 392 * MiB;
constexpr size_t WS_ATTP = 392 * MiB;
constexpr size_t WS_ATTML = 488 * MiB;
constexpr size_t WS_GT_QD = 64 * MiB;
constexpr size_t WS_GT_KE = 96 * MiB;
constexpr size_t OUT_GT_AM = 0;
constexpr size_t OUT_GT_DEC = 16 * MiB;
constexpr size_t OUT_GT_VT = 32 * MiB;
constexpr int CW_ATTQ = 64;
constexpr size_t WS_END = 494 * MiB;
constexpr size_t OUT_U8 = 64 * MiB;
constexpr size_t OUT_V8 = 96 * MiB;
constexpr size_t WS_SU = 61 * MiB;
constexpr size_t WS_SV = 61 * MiB + 65536;
constexpr int CW_CONVQ = 256;
constexpr size_t WS_PW = 128 * MiB;
constexpr size_t WS_SSQ2 = 136 * MiB;
constexpr size_t WS_PD = 64 * MiB;
constexpr int PEER_E = 16384;
constexpr int CW_TMO = 0, CW_CODE = 1, CW_BAR = 4096;

constexpr int RING_OFF = 0, RING_BYTES = 131072;
constexpr int LDS_BYTES = 163840;
constexpr int LDSCTL_OFF = LDS_BYTES - 1024, MISC_OFF = LDSCTL_OFF + 320;

typedef float f32x2 __attribute__((ext_vector_type(2)));
typedef float f32x16 __attribute__((ext_vector_type(16)));
typedef int i32x4 __attribute__((ext_vector_type(4)));
__device__ __forceinline__ float bf2f(unsigned short h) { return __builtin_bit_cast(float, (unsigned)h << 16); }
__device__ __forceinline__ float bflo(unsigned w) { return __builtin_bit_cast(float, w << 16); }
__device__ __forceinline__ float bfhi(unsigned w) { return __builtin_bit_cast(float, w & 0xffff0000u); }
__device__ __forceinline__ float wave_sum(float v) {
#pragma unroll
    for (int o = 1; o < 64; o <<= 1) v += __shfl_xor(v, o);
    return v;
}
__device__ __forceinline__ float wave_max(float v) {
#pragma unroll
    for (int o = 1; o < 64; o <<= 1) v = fmaxf(v, __shfl_xor(v, o));
    return v;
}

template <class T> __device__ __forceinline__ T* opaque(T* p) { asm volatile("" : "+s"(p)); return (T*)(GAS T*)p; }
__device__ __forceinline__ int opaque_v(int x) { asm volatile("" : "+v"(x)); return x; }
template <class T> __device__ __forceinline__ T ldu(const void* ubase, unsigned voff) { return *(const GAS T*)((const GAS char*)ubase + voff); }
template <class T> __device__ __forceinline__ void stu(void* ubase, unsigned voff, T v) { *(GAS T*)((GAS char*)ubase + voff) = v; }
namespace pg8 {
struct EpiRes {
    static constexpr bool PERM = true, AFTER_DRAIN = false;
    const float* x; bf16_t* HB; float* ssq; int ldc;
    __device__ __forceinline__ void operator()(const f32x4 (&acc)[2][2][4][2], const Unit& u, int wr, int wc, int fr, int fq) const {
        const int col0 = u.pn * BM + wc * 32 + 8 * fq;
#pragma unroll
        for (int ai = 0; ai < 2; ++ai)
#pragma unroll
            for (int m = 0; m < 4; ++m) {
                const int r = u.pm * BM + ai * HALF + wr * 64 + m * 16 + fr; const size_t off = (size_t)r * ldc + col0; float s = 0.f;
#pragma unroll
                for (int bj = 0; bj < 2; ++bj) {
                    const f32x4 h0 = *(const f32x4*)(x + off + bj * HALF) + acc[ai][bj][m][0], h1 = *(const f32x4*)(x + off + bj * HALF + 4) + acc[ai][bj][m][1];
                    s += ((h0[0] * h0[0] + h0[1] * h0[1]) + (h0[2] * h0[2] + h0[3] * h0[3])) + ((h1[0] * h1[0] + h1[1] * h1[1]) + (h1[2] * h1[2] + h1[3] * h1[3]));
                    u32x4 w; w.x = cvt_pk_bf16(h0[0], h0[1]); w.y = cvt_pk_bf16(h0[2], h0[3]); w.z = cvt_pk_bf16(h1[0], h1[1]); w.w = cvt_pk_bf16(h1[2], h1[3]);
                    *(u32x4*)(HB + off + bj * HALF) = w;
                }
                s += __shfl_xor(s, 16); s += __shfl_xor(s, 32);
                if (fq == 0) ssq[(size_t)r * 32 + u.pn * 4 + wc] = s;
            }
    }
};
struct EpiRowScale {
    static constexpr bool PERM = true, AFTER_DRAIN = false;
    bf16_t* O; int ldc; const float* ssq; float inv_n, eps;
    __device__ __forceinline__ void operator()(const f32x4 (&acc)[2][2][4][2], const Unit& u, int wr, int wc, int fr, int fq) const {
        const int col0 = u.pn * BM + wc * 32 + 8 * fq;
#pragma unroll
        for (int ai = 0; ai < 2; ++ai)
#pragma unroll
            for (int m = 0; m < 4; ++m) {
                const int r = u.pm * BM + ai * HALF + wr * 64 + m * 16 + fr;
                const f32x4* sp = (const f32x4*)(ssq + (size_t)r * 32); float s = 0.f;
#pragma unroll
                for (int i = 0; i < 8; ++i) { const f32x4 t = sp[i]; s += (t[0] + t[1]) + (t[2] + t[3]); }
                const float sc = 1.0f / sqrtf(s * inv_n + eps);
                bf16_t* rowp = O + (size_t)r * ldc + col0;
#pragma unroll
                for (int bj = 0; bj < 2; ++bj) { const f32x4 v0 = acc[ai][bj][m][0] * sc, v1 = acc[ai][bj][m][1] * sc;
                    u32x4 w; w.x = cvt_pk_bf16(v0[0], v0[1]); w.y = cvt_pk_bf16(v0[2], v0[3]); w.z = cvt_pk_bf16(v1[0], v1[1]); w.w = cvt_pk_bf16(v1[2], v1[3]);
                    *(u32x4*)(rowp + bj * HALF) = w; }
            }
    }
};
}

struct Frame {
    LAS unsigned char* lds;
    volatile LAS unsigned* MISC;
    gu32* ctl;
    int tid, lane, wave;
    int vcu, G;
};

__device__ __forceinline__ void p0_transpose_item(const float* W, int K, int ldw, const float* gk, bf16* WT, LAS float* scr, int item, int lane) {
    const int nblk = ldw / 32, kb = item / nblk, nb = item % nblk, k0 = 64 * kb, n0 = 32 * nb;
#pragma unroll 8
    for (int i = 0; i < 32; ++i) { const int kk = 2 * i + (lane >> 5); float w = W[(size_t)(k0 + kk) * ldw + n0 + (lane & 31)]; if (gk) w *= gk[k0 + kk]; scr[kk * 33 + (lane & 31)] = w; }
    LDS_WAIT(); asm volatile("" ::: "memory");
    const int c = lane & 7;
#pragma unroll
    for (int j = 0; j < 4; ++j) { const int n = (lane >> 3) + 8 * j; const LAS float* s = scr + (8 * c) * 33 + n;
        v4u o; o.x = pk2(s[0 * 33], s[1 * 33]); o.y = pk2(s[2 * 33], s[3 * 33]); o.z = pk2(s[4 * 33], s[5 * 33]); o.w = pk2(s[6 * 33], s[7 * 33]);
        *(GAS v4u*)(WT + (size_t)(n0 + n) * K + k0 + 8 * c) = o; }
    LDS_WAIT(); asm volatile("" ::: "memory");
}
__device__ __forceinline__ void rms_row_to_bf16(int lane, const float* xrow, const float* g, bf16* orow) {
    const GAS f32x4* xr = (const GAS f32x4*)xrow + lane; const GAS f32x4* gr = (const GAS f32x4*)g + lane;
    f32x4 v[8]; float s = 0.f;
#pragma unroll
    for (int j = 0; j < 8; ++j) { v[j] = xr[64 * j]; s += (v[j].x * v[j].x + v[j].y * v[j].y) + (v[j].z * v[j].z + v[j].w * v[j].w); }
    const float rstd = 1.f / sqrtf(wave_sum(s) * (1.f / DM) + EPS);
    GAS unsigned long long* o8 = (GAS unsigned long long*)orow + lane;
#pragma unroll
    for (int j = 0; j < 8; ++j) { const f32x4 gg = gr[64 * j];
        o8[64 * j] = (unsigned long long)pk2(v[j].x * rstd * gg.x, v[j].y * rstd * gg.y) | ((unsigned long long)pk2(v[j].z * rstd * gg.z, v[j].w * rstd * gg.w) << 32); }
}

struct Args {
    const float* in[16]; float* out; unsigned char* ws; int ph_lo, ph_hi, li, pad;
};

__device__ __forceinline__ void p0_prologue(Frame& F, const Args& a) {
    unsigned char* ws = a.ws;
    LAS float* scr = (LAS float*)(F.lds + RING_OFF + F.wave * 16384);
    const int gw = F.vcu * NWAVES + F.wave, NGW = F.G * NWAVES;
    bf16* Win_t = (bf16*)(ws + WS_WIN); bf16* Wout_t = (bf16*)(ws + WS_WOUT); bf16* Wq_t = (bf16*)(ws + WS_WQ); bf16* XN = (bf16*)(ws + WS_XN);
    constexpr int I_IN = (DM / 64) * (NIN / 32), I_SQ = (DM / 64) * (DM / 32);
    constexpr int NITEMS = I_IN + 2 * I_SQ;
    for (int it = gw; it < NITEMS; it += NGW) {
        int r = it;
        if (r < I_IN) { const int nb = r % (NIN / 32); bf16* dst = nb < 96 ? Win_t : nb == 96 ? (bf16*)(ws + WS_WGD) - (size_t)96 * 32 * DM : Win_t - (size_t)32 * DM;
            p0_transpose_item(a.in[2], DM, NIN, nullptr, dst, scr, r, F.lane); continue; } r -= I_IN;
        if (r < I_SQ) { p0_transpose_item(a.in[9], DM, DM, nullptr, Wout_t, scr, r, F.lane); continue; } r -= I_SQ;
        p0_transpose_item(a.in[11], DM, DM, a.in[10], Wq_t, scr, r, F.lane);
    }
    { const f32x4* sk = (const f32x4*)a.in[12]; unsigned long long* skb = (unsigned long long*)(ws + WS_SKB);
      for (int i = gw * 64 + F.lane; i < 8 * 2 * 128 * 128 / 4; i += NGW * 64) { const f32x4 v = sk[i]; skb[i] = (unsigned long long)pk2(v.x, v.y) | ((unsigned long long)pk2(v.z, v.w) << 32); } }
    { const GAS f32x4* gr = (const GAS f32x4*)a.in[1] + F.lane; f32x4 gg[8];
#pragma unroll
      for (int j = 0; j < 8; ++j) gg[j] = gr[64 * j];
      f32x4 v[8], vn[8];
      if (gw < M) {
#pragma unroll
          for (int j = 0; j < 8; ++j) v[j] = ((const GAS f32x4*)(a.in[0] + (size_t)gw * DM) + F.lane)[64 * j]; }
      for (int m = gw; m < M; m += NGW) { const int mn = m + NGW < M ? m + NGW : m;
#pragma unroll
          for (int j = 0; j < 8; ++j) vn[j] = ((const GAS f32x4*)(a.in[0] + (size_t)mn * DM) + F.lane)[64 * j];
          float ss = 0.f;
#pragma unroll
          for (int j = 0; j < 8; ++j) ss += (v[j].x * v[j].x + v[j].y * v[j].y) + (v[j].z * v[j].z + v[j].w * v[j].w);
          const float rstd = 1.f / sqrtf(wave_sum(ss) * (1.f / DM) + EPS);
          GAS unsigned long long* o8 = (GAS unsigned long long*)(XN + (size_t)m * DM) + F.lane;
#pragma unroll
          for (int j = 0; j < 8; ++j) o8[64 * j] = (unsigned long long)pk2(v[j].x * rstd * gg[j].x, v[j].y * rstd * gg[j].y) | ((unsigned long long)pk2(v[j].z * rstd * gg[j].z, v[j].w * rstd * gg[j].w) << 32);
#pragma unroll
          for (int j = 0; j < 8; ++j) v[j] = vn[j]; } }
}


__device__ __forceinline__ void gd_side_gemm(Frame& F, const Args& a) {
    unsigned char* ws = a.ws; const bf16* XN = (const bf16*)(ws + WS_XN); const bf16* WG = (const bf16*)(ws + WS_WGD); float* GDB = (float*)(ws + WS_GDB);
    const int lane = F.lane, w = F.wave, r32 = lane & 31, hh = lane >> 5; LAS float* part = (LAS float*)F.lds;
    for (int blk = F.vcu; blk < M / 64; blk += F.G) { const int tok0 = blk * 64;
        f32x16 acc[2];
#pragma unroll
        for (int tt = 0; tt < 2; ++tt) acc[tt] = (f32x16){0.f, 0.f, 0.f, 0.f, 0.f, 0.f, 0.f, 0.f, 0.f, 0.f, 0.f, 0.f, 0.f, 0.f, 0.f, 0.f};
#pragma unroll 4
        for (int ks = 0; ks < 16; ++ks) { const int k0 = 256 * w + 16 * ks + 8 * hh; const bf16x8 bw = *(const bf16x8*)(WG + (size_t)r32 * DM + k0);
#pragma unroll
            for (int tt = 0; tt < 2; ++tt) { const bf16x8 ax = *(const bf16x8*)(XN + (size_t)(tok0 + 32 * tt + r32) * DM + k0); acc[tt] = __builtin_amdgcn_mfma_f32_32x32x16_bf16(ax, bw, acc[tt], 0, 0, 0); } }
#pragma unroll
        for (int tt = 0; tt < 2; ++tt)
#pragma unroll
            for (int r = 0; r < 16; ++r) { const float x = acc[tt][r]; part[((w * 2 + tt) * 16 + r) * 64 + lane] = x; }
        __syncthreads();
#pragma unroll
        for (int i = 0; i < 4; ++i) { const int o = F.tid + 512 * i; float sum = 0.f;
#pragma unroll
            for (int ww = 0; ww < 8; ++ww) sum += part[ww * 2048 + o];
            const int tt = o >> 10, r = (o >> 6) & 15, ln = o & 63; const int t = 32 * tt + (r & 3) + 8 * (r >> 2) + 4 * (ln >> 5);
            GDB[(size_t)(tok0 + t) * 32 + (ln & 31)] = sum; }
        __syncthreads();
    }
}

__device__ __forceinline__ void p3_finalize(Frame& F, const Args& a) {
    unsigned char* ws = a.ws;
    const int gw = F.vcu * NWAVES + F.wave, NGW = F.G * NWAVES, lane = F.lane;
    const GAS bf16* OFp = (const GAS bf16*)(ws + WS_OF); const GAS bf16* OBp = (const GAS bf16*)(ws + WS_OB);
    const GAS bf16* PROJ = (const GAS bf16*)(ws + WS_PROJ); GAS bf16* Y = (GAS bf16*)(ws + WS_XN);
    const GAS float* ATTML = (const GAS float*)(ws + WS_ATTML); const GAS bf16* ATTP = (const GAS bf16*)(ws + WS_ATTP);
    const GAS float* gla_g = (const GAS float*)a.in[7]; const GAS float* att_g = (const GAS float*)a.in[8];
    const f32x4 gg = *(const GAS f32x4*)(gla_g + 4 * lane);
    f32x4 ag[2][2];
#pragma unroll
    for (int p = 0; p < 2; ++p) { ag[p][0] = *(const GAS f32x4*)(att_g + p * 512 + 8 * lane); ag[p][1] = *(const GAS f32x4*)(att_g + p * 512 + 8 * lane + 4); }
    unsigned long long wf[4], wb[4], gr[4], nwf[4], nwb[4], ngr[4]; f32x2 ml[2][3], nml[2][3]; v4u ow[2][3], now[2][3];
#define P3_LOAD(MM, WF, WB, GR, ML, OW) do { _Pragma("unroll") for (int hh = 0; hh < 4; ++hh) { WF[hh] = *(const GAS unsigned long long*)(OFp + (size_t)(MM) * 1024 + hh * 256 + 4 * lane); \
            WB[hh] = *(const GAS unsigned long long*)(OBp + (size_t)(MM) * 1024 + hh * 256 + 4 * lane); GR[hh] = *(const GAS unsigned long long*)(PROJ + (size_t)(MM) * NINP + O_GR + hh * 256 + 4 * lane); } \
        _Pragma("unroll") for (int p = 0; p < 2; ++p) { const int col = p * 512 + 8 * lane, hd = col >> 6; _Pragma("unroll") for (int pt = 0; pt < 3; ++pt) { const size_t rec = ((size_t)pt * M + (MM)) * 16 + hd; \
            ML[p][pt] = *(const GAS f32x2*)(ATTML + rec * 2); OW[p][pt] = *(const GAS v4u*)(ATTP + rec * 64 + (col & 63)); } } } while (0)
    if (gw < M) P3_LOAD(gw, wf, wb, gr, ml, ow);
    for (int m = gw; m < M; m += NGW) {
        const int mn = m + NGW < M ? m + NGW : m;
        P3_LOAD(mn, nwf, nwb, ngr, nml, now);
#pragma unroll
        for (int hh = 0; hh < 4; ++hh) {
            const f32x4 o = (f32x4){bflo((unsigned)wf[hh]) + bflo((unsigned)wb[hh]), bfhi((unsigned)wf[hh]) + bfhi((unsigned)wb[hh]), bflo((unsigned)(wf[hh] >> 32)) + bflo((unsigned)(wb[hh] >> 32)), bfhi((unsigned)(wf[hh] >> 32)) + bfhi((unsigned)(wb[hh] >> 32))};
            const float ss = wave_sum((o.x * o.x + o.y * o.y) + (o.z * o.z + o.w * o.w));
            const float rstd = 1.f / sqrtf(ss * (1.f / 256.f) + EPS);
            const float r0 = bflo((unsigned)gr[hh]), r1 = bfhi((unsigned)gr[hh]), r2 = bflo((unsigned)(gr[hh] >> 32)), r3 = bfhi((unsigned)(gr[hh] >> 32));
            const float y0 = o.x * rstd * gg.x * (r0 / (1.f + __expf(-r0))), y1 = o.y * rstd * gg.y * (r1 / (1.f + __expf(-r1)));
            const float y2 = o.z * rstd * gg.z * (r2 / (1.f + __expf(-r2))), y3 = o.w * rstd * gg.w * (r3 / (1.f + __expf(-r3)));
            *(GAS unsigned long long*)(Y + (size_t)m * DM + hh * 256 + 4 * lane) = (unsigned long long)pk2(y0, y1) | ((unsigned long long)pk2(y2, y3) << 32);
        }
        float av[16]; float ss = 0.f;
#pragma unroll
        for (int p = 0; p < 2; ++p) {
            const float mt = fmaxf(fmaxf(ml[p][0].x, ml[p][1].x), ml[p][2].x); const float w0 = __expf(ml[p][0].x - mt), w1 = __expf(ml[p][1].x - mt), w2 = __expf(ml[p][2].x - mt);
            const float inv = 1.f / (w0 * ml[p][0].y + w1 * ml[p][1].y + w2 * ml[p][2].y);
            av[p * 8 + 0] = (w0 * bflo(ow[p][0].x) + w1 * bflo(ow[p][1].x) + w2 * bflo(ow[p][2].x)) * inv; av[p * 8 + 1] = (w0 * bfhi(ow[p][0].x) + w1 * bfhi(ow[p][1].x) + w2 * bfhi(ow[p][2].x)) * inv;
            av[p * 8 + 2] = (w0 * bflo(ow[p][0].y) + w1 * bflo(ow[p][1].y) + w2 * bflo(ow[p][2].y)) * inv; av[p * 8 + 3] = (w0 * bfhi(ow[p][0].y) + w1 * bfhi(ow[p][1].y) + w2 * bfhi(ow[p][2].y)) * inv;
            av[p * 8 + 4] = (w0 * bflo(ow[p][0].z) + w1 * bflo(ow[p][1].z) + w2 * bflo(ow[p][2].z)) * inv; av[p * 8 + 5] = (w0 * bfhi(ow[p][0].z) + w1 * bfhi(ow[p][1].z) + w2 * bfhi(ow[p][2].z)) * inv;
            av[p * 8 + 6] = (w0 * bflo(ow[p][0].w) + w1 * bflo(ow[p][1].w) + w2 * bflo(ow[p][2].w)) * inv; av[p * 8 + 7] = (w0 * bfhi(ow[p][0].w) + w1 * bfhi(ow[p][1].w) + w2 * bfhi(ow[p][2].w)) * inv; }
#pragma unroll
        for (int i = 0; i < 16; ++i) ss += av[i] * av[i];
        const float rstd = 1.f / sqrtf(wave_sum(ss) * (1.f / 1024.f) + EPS);
#pragma unroll
        for (int p = 0; p < 2; ++p) { const f32x4 g0 = ag[p][0], g1 = ag[p][1];
            v4u w; w.x = pk2(av[p * 8 + 0] * rstd * g0.x, av[p * 8 + 1] * rstd * g0.y); w.y = pk2(av[p * 8 + 2] * rstd * g0.z, av[p * 8 + 3] * rstd * g0.w);
            w.z = pk2(av[p * 8 + 4] * rstd * g1.x, av[p * 8 + 5] * rstd * g1.y); w.w = pk2(av[p * 8 + 6] * rstd * g1.z, av[p * 8 + 7] * rstd * g1.w);
            *(GAS v4u*)(Y + (size_t)m * DM + 1024 + p * 512 + 8 * lane) = w; }
#pragma unroll
        for (int hh = 0; hh < 4; ++hh) { wf[hh] = nwf[hh]; wb[hh] = nwb[hh]; gr[hh] = ngr[hh]; }
#pragma unroll
        for (int p = 0; p < 2; ++p)
#pragma unroll
            for (int pt = 0; pt < 3; ++pt) { ml[p][pt] = nml[p][pt]; ow[p][pt] = now[p][pt]; }
    }
#undef P3_LOAD
}


__device__ __forceinline__ void wave_argmax(float& v, int& idx) {
#pragma unroll
    for (int o = 1; o < 64; o <<= 1) { const float ov = __shfl_xor(v, o); const int oi = __shfl_xor(idx, o); if (ov > v || (ov == v && oi < idx)) { v = ov; idx = oi; } }
}
__device__ __forceinline__ void ce_desc(float& a, float& b) { const float hi = fmaxf(a, b), lo = fminf(a, b); a = hi; b = lo; }
__device__ __forceinline__ void sort16_desc(float* v) {
#pragma unroll
    for (int k = 2; k <= 16; k <<= 1)
#pragma unroll
        for (int j = k >> 1; j > 0; j >>= 1)
#pragma unroll
            for (int i = 0; i < 16; ++i) { const int l = i ^ j; if (l > i) { if ((i & k) == 0 || k == 16) ce_desc(v[i], v[l]); else ce_desc(v[l], v[i]); } }
}
__device__ __forceinline__ void merge16_desc(float* v) {
#pragma unroll
    for (int j = 8; j > 0; j >>= 1)
#pragma unroll
        for (int i = 0; i < 16; ++i) { const int l = i ^ j; if (l > i) ce_desc(v[i], v[l]); }
}
__device__ __forceinline__ void top16_of_two(float* a, const float* b) {
#pragma unroll
    for (int i = 0; i < 16; ++i) a[i] = fmaxf(a[i], b[15 - i]);
    merge16_desc(a);
}
__device__ __forceinline__ void top16_of_64(float* v) {
    sort16_desc(v); sort16_desc(v + 16); sort16_desc(v + 32); sort16_desc(v + 48);
    top16_of_two(v, v + 16); top16_of_two(v + 32, v + 48); top16_of_two(v, v + 32);
}
__device__ __forceinline__ void topk_phase(Frame& F, const Args& a) {
    unsigned char* ws = a.ws; const GAS bf16* QP = (const GAS bf16*)(ws + WS_XN); const GAS bf16* SKB = (const GAS bf16*)(ws + WS_SKB); GAS int* EIDX = (GAS int*)(ws + WS_EIDX); GAS float* GATE = (GAS float*)(ws + WS_GATE);
    const int lane = F.lane, r32 = lane & 31, hh = lane >> 5;
    LAS unsigned char* skl = F.lds;
    LAS int* ktab = (LAS int*)(F.lds + 65536 + F.wave * 8192);
    for (int unit = F.vcu; unit < 8 * (M / 512); unit += F.G) {
        const int h = unit & 7, tok0 = (unit >> 3) * 512 + F.wave * 64;
        __syncthreads();
#pragma unroll
        for (int i = 0; i < 8; ++i) { const int idx = F.tid + 512 * i, key = idx >> 4, ch = idx & 15;
            *(LAS v4u*)(skl + key * 256 + ((ch ^ (key & 15)) * 16)) = *(const GAS v4u*)(SKB + ((size_t)h * 256 + key) * 128 + ch * 8); }
        __syncthreads();
#pragma unroll 1
        for (int tt = 0; tt < 2; ++tt) {
            const size_t row = (size_t)(tok0 + tt * 32 + r32);
            float L[2][16];
#pragma unroll
            for (int c = 0; c < 2; ++c) {
                f32x16 acc[4];
#pragma unroll
                for (int kt = 0; kt < 4; ++kt) acc[kt] = (f32x16){0.f, 0.f, 0.f, 0.f, 0.f, 0.f, 0.f, 0.f, 0.f, 0.f, 0.f, 0.f, 0.f, 0.f, 0.f, 0.f};
                const GAS bf16* qb = QP + row * DM + h * 256 + c * 128 + 8 * hh;
#pragma unroll 2
                for (int st = 0; st < 8; ++st) {
                    const bf16x8 bq = *(const GAS bf16x8*)(qb + 16 * st);
#pragma unroll
                    for (int kt = 0; kt < 4; ++kt) { const int key = c * 128 + 32 * kt + r32; const bf16x8 ak = *(const LAS bf16x8*)(skl + key * 256 + (((2 * st + hh) ^ (key & 15)) * 16));
                        acc[kt] = __builtin_amdgcn_mfma_f32_32x32x16_bf16(ak, bq, acc[kt], 0, 0, 0); }
                }
                float v[64];
#pragma unroll
                for (int kt = 0; kt < 4; ++kt)
#pragma unroll
                    for (int r = 0; r < 16; ++r) { const int key = 32 * kt + (r & 3) + 8 * (r >> 2);
                        const float sc = acc[kt][r];
                        v[kt * 16 + r] = __builtin_bit_cast(float, (__builtin_bit_cast(unsigned, sc) & ~127u) | (unsigned)(key + 4 * hh)); }
                top16_of_64(v);
                float p[16];
#pragma unroll
                for (int i = 0; i < 16; ++i) p[i] = __shfl_xor(v[i], 32);
                top16_of_two(v, p);
#pragma unroll
                for (int i = 0; i < 16; ++i) { L[c][i] = v[i]; ktab[(c * 16 + i) * 64 + lane] = (int)(__builtin_bit_cast(unsigned, v[i]) & 127u); }
            }
            float cnd[64];
            { int n = 0;
#pragma unroll
              for (int i = 0; i < 16; ++i)
#pragma unroll
                  for (int j = 0; j < 16; ++j) if ((i + 1) * (j + 1) <= 16) { cnd[n] = __builtin_bit_cast(float, (__builtin_bit_cast(unsigned, L[0][i] + L[1][j]) & ~255u) | (unsigned)((i << 4) | j)); ++n; }
#pragma unroll
              for (int q = 50; q < 64; ++q) cnd[q] = -3.0e38f; }
            top16_of_64(cnd);
            float rstd; { const GAS f32x4* sp = (const GAS f32x4*)((const GAS float*)(ws + WS_SSQ) + row * 32); float ssq = 0.f;
#pragma unroll
              for (int i = 0; i < 8; ++i) { const f32x4 t4 = sp[i]; ssq += (t4.x + t4.y) + (t4.z + t4.w); }
              rstd = 1.0f / sqrtf(ssq * (1.f / DM) + EPS); }
            float mx = __builtin_bit_cast(float, __builtin_bit_cast(unsigned, cnd[0]) & ~255u), sum = 0.f; float ex[16];
#pragma unroll
            for (int i = 0; i < 16; ++i) { ex[i] = __expf((__builtin_bit_cast(float, __builtin_bit_cast(unsigned, cnd[i]) & ~255u) - mx) * rstd); sum += ex[i]; }
            const float inv = 1.f / sum;
            LDS_WAIT(); asm volatile("" ::: "memory");
            if (hh == 0) {
                int ev[16];
#pragma unroll
                for (int i = 0; i < 16; ++i) { const unsigned bits = __builtin_bit_cast(unsigned, cnd[i]); const int ia = (bits >> 4) & 15, jb = bits & 15; ev[i] = ktab[ia * 64 + lane] * 128 + ktab[(16 + jb) * 64 + lane]; }
                GAS int* ep = EIDX + row * 128 + h * 16; GAS float* gp = GATE + row * 128 + h * 16;
#pragma unroll
                for (int i = 0; i < 4; ++i) { *(GAS i32x4*)(ep + 4 * i) = (i32x4){ev[4 * i], ev[4 * i + 1], ev[4 * i + 2], ev[4 * i + 3]}; *(GAS f32x4*)(gp + 4 * i) = (f32x4){ex[4 * i] * inv, ex[4 * i + 1] * inv, ex[4 * i + 2] * inv, ex[4 * i + 3] * inv}; }
            }
            LDS_WAIT(); asm volatile("" ::: "memory");
        }
    }
}

__device__ __forceinline__ void gla_prep_phase(Frame& F, const Args& a) {
    unsigned char* ws = a.ws; const bf16* PROJ;
    const int w = F.wave;
    LAS unsigned char* L = F.lds;
    LAS unsigned char* Qraw = L; LAS unsigned char* Kraw = L + 16384; LAS unsigned char* Vraw = L + 32768; LAS float* GDf = (LAS float*)(L + 65536); LAS float* GSUM = (LAS float*)(L + 73728);
    LAS unsigned char* IMGQ = L + 77824; LAS unsigned char* IMGK = L + 95232; LAS unsigned char* IMGE = L + 112640; LAS unsigned char* AMI = L + 32768;
    for (int it = F.vcu; it < 1024; it += F.G) {
        const int b = it >> 8, h = (it >> 6) & 3, n = it & 63; const size_t row0 = (size_t)b * SEQ + n * 64;
        ws = opaque(ws); PROJ = (const bf16*)(ws + WS_PROJ);
        int tid = opaque_v(F.tid), lane = tid & 63, r32 = lane & 31, hh = lane >> 5;
#pragma unroll
        for (int i = 0; i < 2; ++i) { const int idx = tid + 512 * i, r = idx >> 4, c = idx & 15;
            *(LAS v4u*)(Qraw + r * 256 + c * 16) = *(const GAS v4u*)(PROJ + (row0 + r) * NINP + O_GQ + h * 128 + c * 8);
            *(LAS v4u*)(Kraw + r * 256 + c * 16) = *(const GAS v4u*)(PROJ + (row0 + r) * NINP + O_GK + h * 128 + c * 8); }
#pragma unroll
        for (int i = 0; i < 4; ++i) { const int idx = tid + 512 * i, r = idx >> 5, c = idx & 31;
            *(LAS v4u*)(Vraw + r * 512 + c * 16) = *(const GAS v4u*)(PROJ + (row0 + r) * NINP + O_GV + h * 256 + c * 8); }
        if (tid < 256) { const int r = tid >> 2, c = tid & 3; const GAS float* gsrc = (const GAS float*)(ws + WS_GDB) + (row0 + r) * 32 + c * 8; const f32x4 g0 = *(const GAS f32x4*)gsrc, g1 = *(const GAS f32x4*)(gsrc + 4);
            *(LAS f32x4*)(GDf + r * 32 + c * 8) = g0; *(LAS f32x4*)(GDf + r * 32 + c * 8 + 4) = g1; }
        __syncthreads();
#pragma unroll
        for (int ks = 0; ks < 4; ++ks) { unsigned pk[4];
#pragma unroll
            for (int p = 0; p < 4; ++p) { const int s0 = 16 * ks + 8 * hh + 2 * p; const unsigned lo = *(const LAS unsigned short*)(Vraw + s0 * 512 + (32 * w + r32) * 2), hi = *(const LAS unsigned short*)(Vraw + (s0 + 1) * 512 + (32 * w + r32) * 2); pk[p] = lo | (hi << 16); }
            *(GAS v4u*)((unsigned char*)a.out + OUT_GT_VT + (size_t)it * 32768 + (w * 4 + ks) * 1024 + lane * 16) = (v4u){pk[0], pk[1], pk[2], pk[3]}; }
        for (int dir = 0; dir < 2; ++dir) {
            const size_t idir = (size_t)(((b * 4 + h) * 2 + dir) * 64 + n); ws = opaque(ws); tid = opaque_v(tid); lane = tid & 63; r32 = lane & 31; hh = lane >> 5;
            {
                const int d = tid & 127, tq = tid >> 7; const float* upp = (dir ? a.in[5] : a.in[3]) + h * 128 + d; const float bias = (dir ? a.in[6] : a.in[4])[h * 128 + d];
                float up[16];
#pragma unroll
                for (int r = 0; r < 16; ++r) up[r] = upp[r * 512];
                float c[16];
#pragma unroll
                for (int i = 0; i < 16; ++i) { const LAS float* g = GDf + (16 * tq + i) * 32 + dir * 16; float z = bias;
#pragma unroll
                    for (int r = 0; r < 16; ++r) z += g[r] * up[r];
                    c[i] = (fminf(z, 0.f) - __logf(1.f + __expf(-fabsf(z)))) * (1.f / 16.f); }
                if (dir == 0) {
#pragma unroll
                    for (int i = 1; i < 16; ++i) c[i] += c[i - 1];
                } else {
#pragma unroll
                    for (int i = 14; i >= 0; --i) c[i] += c[i + 1];
                }
                GSUM[(dir * 4 + tq) * 128 + d] = dir == 0 ? c[15] : c[0];
                __syncthreads();
                const float t0 = GSUM[(dir * 4 + 0) * 128 + d], t1 = GSUM[(dir * 4 + 1) * 128 + d], t2 = GSUM[(dir * 4 + 2) * 128 + d], t3 = GSUM[(dir * 4 + 3) * 128 + d];
                const float Bt = (t0 + t1) + (t2 + t3);
                float off;
                if (dir == 0) off = (tq > 0 ? t0 : 0.f) + (tq > 1 ? t1 : 0.f) + (tq > 2 ? t2 : 0.f);
                else off = (tq < 1 ? t1 : 0.f) + (tq < 2 ? t2 : 0.f) + (tq < 3 ? t3 : 0.f);
                unsigned kep[8];
#pragma unroll
                for (int i = 0; i < 16; i += 2) { float ke2[2];
#pragma unroll
                    for (int q = 0; q < 2; ++q) { const int t = 16 * tq + i + q; const float bi = c[i + q] + off;
                        const float qv = bf2f(*(const LAS unsigned short*)(Qraw + t * 256 + d * 2)), kv = bf2f(*(const LAS unsigned short*)(Kraw + t * 256 + d * 2));
                        *(LAS unsigned short*)(IMGQ + t * 272 + d * 2) = (unsigned short)pk2(qv * 0.08838834764831845f * __expf(bi), 0.f);
                        *(LAS unsigned short*)(IMGK + t * 272 + d * 2) = (unsigned short)pk2(kv * __expf(-bi), 0.f);
                        ke2[q] = kv * __expf(Bt - bi); }
                    kep[i >> 1] = pk2(ke2[0], ke2[1]); }
                *(LAS v4u*)(IMGE + d * 144 + (16 * tq) * 2) = (v4u){kep[0], kep[1], kep[2], kep[3]};
                *(LAS v4u*)(IMGE + d * 144 + (16 * tq + 8) * 2) = (v4u){kep[4], kep[5], kep[6], kep[7]};
                if (tq == 0) ((GAS float*)((unsigned char*)a.out + OUT_GT_DEC))[idir * 128 + d] = __expf(Bt);
            }
            __syncthreads();
            if (w < 4) {
                const int si = w >> 1, ti = w & 1; f32x16 acc = (f32x16){0.f, 0.f, 0.f, 0.f, 0.f, 0.f, 0.f, 0.f, 0.f, 0.f, 0.f, 0.f, 0.f, 0.f, 0.f, 0.f};
#pragma unroll
                for (int ks = 0; ks < 8; ++ks) { const bf16x8 ak = *(const LAS bf16x8*)(IMGK + (32 * si + r32) * 272 + (16 * ks + 8 * hh) * 2), bq = *(const LAS bf16x8*)(IMGQ + (32 * ti + r32) * 272 + (16 * ks + 8 * hh) * 2);
                    acc = __builtin_amdgcn_mfma_f32_32x32x16_bf16(ak, bq, acc, 0, 0, 0); }
                const int t = 32 * ti + r32;
#pragma unroll
                for (int qd = 0; qd < 4; ++qd) { float v4[4];
#pragma unroll
                    for (int i = 0; i < 4; ++i) { const int sidx = 32 * si + 8 * qd + 4 * hh + i; const float x = acc[4 * qd + i]; const bool keep = dir == 0 ? (sidx <= t) : (sidx >= t); v4[i] = keep ? x : 0.f; }
                    *(LAS unsigned long long*)(AMI + t * 144 + (32 * si + 8 * qd + 4 * hh) * 2) = (unsigned long long)pk2(v4[0], v4[1]) | ((unsigned long long)pk2(v4[2], v4[3]) << 32); }
            } else {
                const int w4 = w - 4;
#pragma unroll
                for (int q = 0; q < 4; ++q) { const int bq = w4 * 4 + q, tt = bq >> 3, ks = bq & 7, j = ks >> 1, u = ks & 1; const int t = 32 * tt + r32;
                    const unsigned long long p0 = *(const LAS unsigned long long*)(IMGQ + t * 272 + (32 * j + 16 * u + 4 * hh) * 2), p1 = *(const LAS unsigned long long*)(IMGQ + t * 272 + (32 * j + 16 * u + 8 + 4 * hh) * 2);
                    *(GAS v4u*)(ws + WS_GT_QD + idir * 16384 + bq * 1024 + lane * 16) = (v4u){(unsigned)p0, (unsigned)(p0 >> 32), (unsigned)p1, (unsigned)(p1 >> 32)}; }
#pragma unroll
                for (int q = 0; q < 4; ++q) { const int bk = w4 * 4 + q, j = bk >> 2, ks = bk & 3; const int d = 32 * j + r32;
                    *(GAS v4u*)(ws + WS_GT_KE + idir * 16384 + bk * 1024 + lane * 16) = *(const LAS v4u*)(IMGE + d * 144 + (16 * ks + 8 * hh) * 2); }
            }
            __syncthreads();
            { const int tt = w >> 2, ks = w & 3; const int t = 32 * tt + r32;
              *(GAS v4u*)((unsigned char*)a.out + OUT_GT_AM + idir * 8192 + w * 1024 + lane * 16) = *(const LAS v4u*)(AMI + t * 144 + (16 * ks + 8 * hh) * 2); }
            __syncthreads();
        }
    }
}

__device__ __forceinline__ void gla_seq_phase(Frame& F, const Args& a) {
    unsigned char* ws = a.ws;
    const int w = F.wave;
    constexpr int GBUF = 57856;
    for (int unit = F.vcu; unit < 64; unit += F.G) {
        const int dir = unit & 1, eh = (unit >> 1) & 1, bh = unit >> 2, b = bh >> 2, h = bh & 3;
        if (w >= 4) {
            const int lt = opaque_v(F.tid) - 256;
            v4u A[15], B[15];
#define GLA_LOAD(R, NS) do { const int n_ = dir ? 63 - (NS) : (NS); const size_t idir_ = (size_t)((bh * 2 + dir) * 64 + n_), iv_ = (size_t)(bh * 64 + n_); const unsigned char* o_ = opaque((const unsigned char*)a.out); const unsigned char* w_ = opaque(ws); \
            const GAS v4u* gq_ = (const GAS v4u*)(w_ + WS_GT_QD + idir_ * 16384); const GAS v4u* gk_ = (const GAS v4u*)(w_ + WS_GT_KE + idir_ * 16384); const GAS v4u* ga_ = (const GAS v4u*)(o_ + OUT_GT_AM + idir_ * 8192); \
            const GAS v4u* gv_ = (const GAS v4u*)(o_ + OUT_GT_VT + iv_ * 32768 + eh * 16384); const GAS v4u* gd_ = (const GAS v4u*)(o_ + OUT_GT_DEC + idir_ * 512); \
            _Pragma("unroll") for (int i = 0; i < 4; ++i) { R[i] = gq_[lt + 256 * i]; R[4 + i] = gk_[lt + 256 * i]; R[10 + i] = gv_[lt + 256 * i]; } R[8] = ga_[lt]; R[9] = ga_[lt + 256]; R[14] = gd_[lt & 31]; } while (0)
#define GLA_WRITE(R, BUF) do { LAS v4u* d_ = (LAS v4u*)(F.lds + (BUF) * GBUF); \
            _Pragma("unroll") for (int i = 0; i < 4; ++i) { d_[lt + 256 * i] = R[i]; d_[1024 + lt + 256 * i] = R[4 + i]; d_[2560 + lt + 256 * i] = R[10 + i]; } d_[2048 + lt] = R[8]; d_[2048 + lt + 256] = R[9]; if (lt < 32) d_[3584 + lt] = R[14]; } while (0)
            GLA_LOAD(A, 0); GLA_LOAD(B, 1);
            GLA_WRITE(A, 0);
            __syncthreads();
#pragma unroll 1
            for (int ns = 0; ns < 64; ns += 2) {
                if (ns + 2 < 64) GLA_LOAD(A, ns + 2);
                GLA_WRITE(B, 1);
                __syncthreads();
                if (ns + 3 < 64) GLA_LOAD(B, ns + 3);
                if (ns + 2 < 64) GLA_WRITE(A, 0);
                __syncthreads();
            }
#undef GLA_LOAD
#undef GLA_WRITE
        } else {
            f32x16 S[4];
#pragma unroll
            for (int j = 0; j < 4; ++j) S[j] = (f32x16){0.f, 0.f, 0.f, 0.f, 0.f, 0.f, 0.f, 0.f, 0.f, 0.f, 0.f, 0.f, 0.f, 0.f, 0.f, 0.f};
            __syncthreads();
#pragma unroll 1
            for (int ns = 0; ns < 64; ++ns) {
                const int n = dir ? 63 - ns : ns;
                const int lane = opaque_v(F.lane), r32 = lane & 31, hh = lane >> 5;
                LAS unsigned char* QDl = F.lds + (ns & 1) * GBUF; LAS unsigned char* KEl = QDl + 16384; LAS unsigned char* AMl = QDl + 32768; LAS unsigned char* VTl = QDl + 40960; LAS float* DECl = (LAS float*)(QDl + 57344);
                GAS bf16* Out = (GAS bf16*)(opaque(ws) + (dir ? WS_OB : WS_OF));
                bf16x8 vf[4];
#pragma unroll
                for (int ks = 0; ks < 4; ++ks) vf[ks] = *(const LAS bf16x8*)(VTl + (w * 4 + ks) * 1024 + lane * 16);
                f32x16 o[2];
#pragma unroll
                for (int tt = 0; tt < 2; ++tt) o[tt] = (f32x16){0.f, 0.f, 0.f, 0.f, 0.f, 0.f, 0.f, 0.f, 0.f, 0.f, 0.f, 0.f, 0.f, 0.f, 0.f, 0.f};
#pragma unroll
                for (int ks8 = 0; ks8 < 8; ++ks8) { const int j = ks8 >> 1, u = ks8 & 1; v4u sb;
                    sb.x = pg8::cvt_pk_bf16(S[j][8 * u + 0], S[j][8 * u + 1]); sb.y = pg8::cvt_pk_bf16(S[j][8 * u + 2], S[j][8 * u + 3]); sb.z = pg8::cvt_pk_bf16(S[j][8 * u + 4], S[j][8 * u + 5]); sb.w = pg8::cvt_pk_bf16(S[j][8 * u + 6], S[j][8 * u + 7]);
                    const bf16x8 bs = __builtin_bit_cast(bf16x8, sb);
#pragma unroll
                    for (int tt = 0; tt < 2; ++tt) { const bf16x8 aq = *(const LAS bf16x8*)(QDl + (tt * 8 + ks8) * 1024 + lane * 16); o[tt] = __builtin_amdgcn_mfma_f32_32x32x16_bf16(aq, bs, o[tt], 0, 0, 0); } }
#pragma unroll
                for (int ks = 0; ks < 4; ++ks)
#pragma unroll
                    for (int tt = 0; tt < 2; ++tt) { const bf16x8 am = *(const LAS bf16x8*)(AMl + (tt * 4 + ks) * 1024 + lane * 16); o[tt] = __builtin_amdgcn_mfma_f32_32x32x16_bf16(am, vf[ks], o[tt], 0, 0, 0); }
#pragma unroll
                for (int tt = 0; tt < 2; ++tt)
#pragma unroll
                    for (int r = 0; r < 16; ++r) { const int t = 32 * tt + (r & 3) + 8 * (r >> 2) + 4 * hh; const float x = o[tt][r];
                        Out[((size_t)b * SEQ + 64 * n + t) * 1024 + h * 256 + 32 * (eh * 4 + w) + r32] = (bf16)pk2(x, 0.f); }
#pragma unroll
                for (int j = 0; j < 4; ++j) {
#pragma unroll
                    for (int q = 0; q < 4; ++q) { const f32x4 dv = *(const LAS f32x4*)(DECl + 32 * j + 8 * q + 4 * hh); S[j][4 * q + 0] *= dv.x; S[j][4 * q + 1] *= dv.y; S[j][4 * q + 2] *= dv.z; S[j][4 * q + 3] *= dv.w; }
#pragma unroll
                    for (int ks = 0; ks < 4; ++ks) { const bf16x8 ak = *(const LAS bf16x8*)(KEl + (j * 4 + ks) * 1024 + lane * 16); S[j] = __builtin_amdgcn_mfma_f32_32x32x16_bf16(ak, vf[ks], S[j], 0, 0, 0); } }
                __syncthreads();
            }
        }
    }
}

typedef short v4i16_t __attribute__((ext_vector_type(4)));
__device__ __forceinline__ void attn_phase(Frame& F, const Args& a, int qslot) {
    unsigned char* ws = a.ws; const bf16* PROJ;
    const int w = F.wave;
    volatile LAS int* uword = (volatile LAS int*)(F.lds + 2 * 78336);
    constexpr int NUNITS = 64 * 3 * 32;
#define ATT_DECODE(U) const int bh = (U) / 96, rem = (U) - bh * 96, p = rem >> 5, idx = rem & 31; const int lgd = 2 * p, d = 1 << lgd; \
        const int r = idx >> (5 - lgd), J = idx & ((32 >> lgd) - 1), Lc = SEQ >> lgd; const int b = bh >> 4, h = bh & 15; const int m0 = 128 * J - 64;
    v4u kx[4], vx[4]; v4u qw[2];
#define ATT_LOAD(U) do { ATT_DECODE(U) ws = opaque(ws); PROJ = (const bf16*)(ws + WS_PROJ); const int tid_ = opaque_v(F.tid); \
        _Pragma("unroll") for (int i = 0; i < 4; ++i) { const int kr = (tid_ >> 3) + 64 * i, ch = tid_ & 7; const int mp = m0 + kr; kx[i] = (v4u){0u, 0u, 0u, 0u}; vx[i] = kx[i]; \
            if (mp >= 0 && mp < Lc) { const bf16* src = PROJ + ((size_t)b * SEQ + r + d * mp) * NINP + O_AK + h * 64 + ch * 8; kx[i] = *(const GAS v4u*)src; vx[i] = *(const GAS v4u*)(src + (O_AV - O_AK)); } } \
        const int tokq_ = r + d * (128 * J + 16 * w + (tid_ & 15)); \
        _Pragma("unroll") for (int sft = 0; sft < 2; ++sft) qw[sft] = *(const GAS v4u*)(PROJ + ((size_t)b * SEQ + tokq_) * NINP + O_AQ + h * 64 + 32 * sft + 8 * ((tid_ & 63) >> 4)); } while (0)
    float tab[40];
    { const int l0 = opaque_v(F.lane);
#pragma unroll
      for (int c = 0; c < 40; ++c) { const int kb = c >> 3, uu = (c >> 2) & 1, rho = c & 3; const int jo = 32 * kb + 8 * (l0 >> 4) + 4 * uu + rho - 64 - (l0 & 15); const int aj = jo < 0 ? -jo : jo; tab[c] = aj <= 64 ? (float)aj : 3.0e38f; } }
    if (F.tid == 0) { uword[0] = (int)__hip_atomic_fetch_add((unsigned*)(F.ctl + CW_ATTQ + 64 * qslot), 1u, __ATOMIC_RELAXED, __HIP_MEMORY_SCOPE_AGENT); uword[1] = (int)__hip_atomic_fetch_add((unsigned*)(F.ctl + CW_ATTQ + 64 * qslot), 1u, __ATOMIC_RELAXED, __HIP_MEMORY_SCOPE_AGENT); }
    __syncthreads();
    int u = __builtin_amdgcn_readfirstlane(uword[0]), un = __builtin_amdgcn_readfirstlane(uword[1]); int par = 0;
#define ATT_WRITE(BUF) do { const int tid_ = opaque_v(F.tid); LAS unsigned char* Kw = F.lds + (BUF) * 78336; LAS unsigned char* Vw = Kw + 39168; \
        _Pragma("unroll") for (int i = 0; i < 4; ++i) { const int kr = (tid_ >> 3) + 64 * i, ch = tid_ & 7; *(LAS v4u*)(Kw + kr * 144 + ch * 16) = kx[i]; *(LAS v4u*)(Vw + kr * 144 + ch * 16) = vx[i]; } \
        if (tid_ < 128) { const int kr = 256 + (tid_ >> 3), ch = tid_ & 7; *(LAS v4u*)(Kw + kr * 144 + ch * 16) = (v4u){0u, 0u, 0u, 0u}; *(LAS v4u*)(Vw + kr * 144 + ch * 16) = (v4u){0u, 0u, 0u, 0u}; } } while (0)
    v4u qwc[2];
    if (u < NUNITS) { ATT_LOAD(u); ATT_WRITE(0); qwc[0] = qw[0]; qwc[1] = qw[1]; }
    __syncthreads();
    int bufi = 0;
    while (u < NUNITS) {
        const int tid = opaque_v(F.tid), lane = tid & 63, q16 = lane & 15, g = lane >> 4;
        int qnext = 0; if (tid == 0) qnext = (int)__hip_atomic_fetch_add((unsigned*)(F.ctl + CW_ATTQ + 64 * qslot), 1u, __ATOMIC_RELAXED, __HIP_MEMORY_SCOPE_AGENT);
        LAS unsigned char* Kl = F.lds + bufi * 78336; LAS unsigned char* Vl = Kl + 39168;
        bf16x8 qf[2];
#pragma unroll
        for (int sft = 0; sft < 2; ++sft) { v4u qs; constexpr float QS = 0.125f * 1.4426950408889634f; qs.x = pk2(bflo(qwc[sft].x) * QS, bfhi(qwc[sft].x) * QS); qs.y = pk2(bflo(qwc[sft].y) * QS, bfhi(qwc[sft].y) * QS); qs.z = pk2(bflo(qwc[sft].z) * QS, bfhi(qwc[sft].z) * QS); qs.w = pk2(bflo(qwc[sft].w) * QS, bfhi(qwc[sft].w) * QS);
            qf[sft] = __builtin_bit_cast(bf16x8, qs); }
        ATT_DECODE(u)
        const int tokq = r + d * (128 * J + 16 * w + q16);
        if (un < NUNITS) ATT_LOAD(un);
        const float nslope = -exp2f(-0.5f * (float)(h + 1)) * (float)d * 1.4426950408889634f;
        const bool inrange = (m0 + 16 * w >= 0) && (m0 + 16 * w + 159 < Lc);
        float sv[5][2][4]; float mx = -3.0e38f;
#pragma unroll
        for (int kb = 0; kb < 5; ++kb)
#pragma unroll
            for (int uu = 0; uu < 2; ++uu) { f32x4 acc = (f32x4){0.f, 0.f, 0.f, 0.f};
                const int krow = 16 * w + 32 * kb + 8 * (q16 >> 2) + 4 * uu + (q16 & 3);
#pragma unroll
                for (int sft = 0; sft < 2; ++sft) { const bf16x8 ak = *(const LAS bf16x8*)(Kl + krow * 144 + (32 * sft + 8 * g) * 2); acc = __builtin_amdgcn_mfma_f32_16x16x32_bf16(ak, qf[sft], acc, 0, 0, 0); }
#pragma unroll
                for (int rho = 0; rho < 4; ++rho) { const float x = acc[rho]; sv[kb][uu][rho] = __builtin_fmaf(nslope, tab[kb * 8 + uu * 4 + rho], x); } }
        if (!inrange) {
#pragma unroll
            for (int kb = 0; kb < 5; ++kb)
#pragma unroll
                for (int uu = 0; uu < 2; ++uu)
#pragma unroll
                    for (int rho = 0; rho < 4; ++rho) { const int mp = m0 + 16 * w + 32 * kb + 8 * g + 4 * uu + rho; if (mp < 0 || mp >= Lc) sv[kb][uu][rho] = -3.0e38f; } }
#pragma unroll
        for (int kb = 0; kb < 5; ++kb)
#pragma unroll
            for (int uu = 0; uu < 2; ++uu)
#pragma unroll
                for (int rho = 0; rho < 4; ++rho) mx = fmaxf(mx, sv[kb][uu][rho]);
        mx = fmaxf(mx, __shfl_xor(mx, 16)); mx = fmaxf(mx, __shfl_xor(mx, 32));
        float lsum = 0.f; bf16x8 pf[5];
#pragma unroll
        for (int kb = 0; kb < 5; ++kb) { float e[8];
#pragma unroll
            for (int uu = 0; uu < 2; ++uu)
#pragma unroll
                for (int rho = 0; rho < 4; ++rho) { const float pe = __builtin_amdgcn_exp2f(sv[kb][uu][rho] - mx); e[uu * 4 + rho] = pe; lsum += pe; }
            v4u pw; pw.x = pk2(e[0], e[1]); pw.y = pk2(e[2], e[3]); pw.z = pk2(e[4], e[5]); pw.w = pk2(e[6], e[7]); pf[kb] = __builtin_bit_cast(bf16x8, pw); }
        lsum += __shfl_xor(lsum, 16); lsum += __shfl_xor(lsum, 32);
        f32x4 oT[4];
#pragma unroll
        for (int nn = 0; nn < 4; ++nn) oT[nn] = (f32x4){0.f, 0.f, 0.f, 0.f};
#pragma unroll
        for (int kb = 0; kb < 5; ++kb)
#pragma unroll
            for (int nn = 0; nn < 4; ++nn) { const LAS unsigned char* va = Vl + (16 * w + 32 * kb + 8 * g + (q16 >> 2)) * 144 + (16 * nn + 4 * (q16 & 3)) * 2;
                const v4i16_t lo = __builtin_amdgcn_ds_read_tr16_b64_v4i16((LAS v4i16_t*)va), hi = __builtin_amdgcn_ds_read_tr16_b64_v4i16((LAS v4i16_t*)(va + 4 * 144));
                const bf16x8 vf = (bf16x8){lo[0], lo[1], lo[2], lo[3], hi[0], hi[1], hi[2], hi[3]};
                oT[nn] = __builtin_amdgcn_mfma_f32_16x16x32_bf16(vf, pf[kb], oT[nn], 0, 0, 0); }
        { const size_t rec = ((size_t)p * M + (size_t)b * SEQ + tokq) * 16 + h; GAS bf16* op = (GAS bf16*)(opaque(ws) + WS_ATTP) + rec * 64 + 4 * g;
#pragma unroll
          for (int nn = 0; nn < 4; ++nn) *(GAS unsigned long long*)(op + 16 * nn) = (unsigned long long)pk2(oT[nn][0], oT[nn][1]) | ((unsigned long long)pk2(oT[nn][2], oT[nn][3]) << 32);
          if (g == 0) { GAS float* ml = (GAS float*)(opaque(ws) + WS_ATTML) + rec * 2; ml[0] = mx * 0.6931471805599453f; ml[1] = lsum; } }
        if (un < NUNITS) { ATT_WRITE(bufi ^ 1); qwc[0] = qw[0]; qwc[1] = qw[1]; }
        if (tid == 0) uword[par] = qnext;
        __syncthreads();
        u = un; un = __builtin_amdgcn_readfirstlane(uword[par]); par ^= 1; bufi ^= 1;
    }
#undef ATT_WRITE
#undef ATT_DECODE
#undef ATT_LOAD
}

typedef __bf16 bf16x2_t __attribute__((ext_vector_type(2)));
__device__ __forceinline__ void peer_convert_tables(Frame& F, const Args& a, int qslot) {
    unsigned char* ws = a.ws; const int lane = F.lane; volatile LAS int* uword = (volatile LAS int*)(F.lds + 2 * 78336 + 64);
    for (;;) {
        __syncthreads();
        if (F.tid == 0) uword[0] = (int)__hip_atomic_fetch_add((unsigned*)(F.ctl + CW_CONVQ + 64 * qslot), 1u, __ATOMIC_RELAXED, __HIP_MEMORY_SCOPE_AGENT);
        __syncthreads();
        const int blk = __builtin_amdgcn_readfirstlane(uword[0]);
        if (blk >= 2 * PEER_E / 64) break;
#pragma unroll 1
        for (int i = 0; i < 8; ++i) { const int r = blk * 64 + F.wave * 8 + i;
            const int e = r & (PEER_E - 1); const bool isv = r >= PEER_E;
            const float* src = (isv ? a.in[14] : a.in[13]) + (size_t)e * DM;
            unsigned char* dst = (unsigned char*)a.out + (isv ? OUT_V8 : OUT_U8) + (size_t)e * DM; float* sc = (float*)(ws + (isv ? WS_SV : WS_SU));
            f32x4 v[8]; float am = 0.f;
#pragma unroll
            for (int j = 0; j < 8; ++j) { v[j] = *(const f32x4*)(src + 256 * j + 4 * lane); am = fmaxf(am, fmaxf(fmaxf(fabsf(v[j].x), fabsf(v[j].y)), fmaxf(fabsf(v[j].z), fabsf(v[j].w)))); }
            am = wave_max(am); am = fmaxf(am, 1e-30f);
            const float inv = 440.f / am;
#pragma unroll
            for (int j = 0; j < 8; ++j) { int p = __builtin_amdgcn_cvt_pk_fp8_f32(v[j].x * inv, v[j].y * inv, 0, false); p = __builtin_amdgcn_cvt_pk_fp8_f32(v[j].z * inv, v[j].w * inv, p, true);
                *(int*)(dst + 256 * j + 4 * lane) = p; }
            if (lane == 0) sc[e] = am * (1.f / 440.f); }
    }
}

__device__ __forceinline__ float dpp_row_sum(float x) {
#define PEER_DPP(ctrl) x += __builtin_bit_cast(float, __builtin_amdgcn_update_dpp(0, __builtin_bit_cast(int, x), ctrl, 0xF, 0xF, false))
    PEER_DPP(0xB1); PEER_DPP(0x4E); PEER_DPP(0x141); PEER_DPP(0x140);
#undef PEER_DPP
    return x;
}
template <bool VPH, int PBS, bool LA> __device__ __forceinline__ void peer_uv_phase(Frame& F, const Args& a) {
    unsigned char* ws = a.ws; GAS bf16* H = (GAS bf16*)(ws + WS_HB); const GAS float* g2 = (const GAS float*)a.in[10];
    const int sl = blockIdx.x & 7, rk = blockIdx.x >> 3, nrk = F.G >> 3, tpw = M / nrk / NWAVES, nq = tpw / 4;
    const unsigned char* TAB; const GAS int* EIDX; const GAS float* SSQ; const GAS float* PW; GAS float* PD; GAS float* SSQ2;
    LAS int* idt = (LAS int*)(F.lds + F.wave * 8704);
    LAS float* wt = (LAS float*)(F.lds + F.wave * 8704 + 4352);
    const int t0 = (rk * NWAVES + F.wave) * tpw;
#define PEER_STAGE_LOAD(QI) do { const size_t tb_ = (size_t)(t0 + 4 * (QI) + a4) * 128; _Pragma("unroll") for (int k = 0; k < 8; ++k) sid[k] = EIDX[tb_ + 16 * k + q]; } while (0)
#define PEER_STAGE_WRITE(QI) do { const int bf_ = ((QI) & 1) * 528; _Pragma("unroll") for (int k = 0; k < 8; ++k) idt[bf_ + a4 * 132 + 16 * k + q] = sid[k]; } while (0)
#define PEER_STAGE_W(QI) do { if (VPH) { const size_t tb_ = (size_t)(t0 + 4 * (QI) + a4) * 128; const int bf_ = ((QI) & 1) * 528; _Pragma("unroll") for (int k = 0; k < 8; ++k) wt[bf_ + a4 * 132 + 16 * k + q] = PW[tb_ + 16 * k + q]; LDS_WAIT(); asm volatile("" ::: "memory"); } } while (0)
#define PEER_ISSUE(R, QI, WB) do { const int bf_ = ((QI) & 1) * 528 + a4 * 132 + (WB) * PBS; int ev_[PBS]; _Pragma("unroll") for (int j = 0; j < PBS; j += 4) { const i32x4 e4_ = *(const LAS i32x4*)(idt + bf_ + j); ev_[j] = e4_.x; ev_[j + 1] = e4_.y; ev_[j + 2] = e4_.z; ev_[j + 3] = e4_.w; } \
        _Pragma("unroll") for (int j = 0; j < PBS; ++j) { const int e_ = ev_[j]; R[j] = ldu<i32x4>(TAB, (unsigned)e_ * 2048u + (unsigned)(16 * q)); } } while (0)
    unsigned xq[8]; float acc[16];
#define PEER_QUAD_BEGIN(QI) do { const size_t t_ = (size_t)(t0 + 4 * (QI) + a4); \
        if (!VPH) { f32x4 hq[4]; { const v4u h0_ = *(const GAS v4u*)(H + t_ * DM + 256 * sl + 16 * q), h1_ = *(const GAS v4u*)(H + t_ * DM + 256 * sl + 16 * q + 8); \
            hq[0] = (f32x4){bflo(h0_.x), bfhi(h0_.x), bflo(h0_.y), bfhi(h0_.y)}; hq[1] = (f32x4){bflo(h0_.z), bfhi(h0_.z), bflo(h0_.w), bfhi(h0_.w)}; hq[2] = (f32x4){bflo(h1_.x), bfhi(h1_.x), bflo(h1_.y), bfhi(h1_.y)}; hq[3] = (f32x4){bflo(h1_.z), bfhi(h1_.z), bflo(h1_.w), bfhi(h1_.w)}; }  const float pss_ = dpp_row_sum(SSQ[t_ * 32 + q] + SSQ[t_ * 32 + 16 + q]); const float rstd_ = 1.f / sqrtf(pss_ * (1.f / DM) + EPS); f32x4 gv[4]; \
            _Pragma("unroll") for (int k = 0; k < 4; ++k) gv[k] = *(const GAS f32x4*)(g2 + 256 * sl + 16 * q + 4 * k); \
            _Pragma("unroll") for (int k = 0; k < 4; ++k) { xq[2 * k] = pk2(hq[k].x * rstd_ * gv[k].x, hq[k].y * rstd_ * gv[k].y); xq[2 * k + 1] = pk2(hq[k].z * rstd_ * gv[k].z, hq[k].w * rstd_ * gv[k].w); } } \
        else { _Pragma("unroll") for (int k = 0; k < 16; ++k) acc[k] = 0.f; } } while (0)
#define PEER_COMPUTE(R, QI, WB) do { if (!VPH) { float pdb_ = 0.f; _Pragma("unroll") for (int j = 0; j < PBS; ++j) { float d_ = 0.f; _Pragma("unroll") for (int k = 0; k < 4; ++k) { const int dw_ = R[j][k]; \
                d_ = __builtin_amdgcn_fdot2_f32_bf16(__builtin_amdgcn_cvt_scalef32_pk_bf16_fp8(dw_, 1.0f, false), __builtin_bit_cast(bf16x2_t, xq[2 * k]), d_, false); \
                d_ = __builtin_amdgcn_fdot2_f32_bf16(__builtin_amdgcn_cvt_scalef32_pk_bf16_fp8(dw_, 1.0f, true), __builtin_bit_cast(bf16x2_t, xq[2 * k + 1]), d_, false); } \
                d_ = dpp_row_sum(d_); pdb_ = (q == j) ? d_ : pdb_; } \
            if (q < PBS) PD[((size_t)(t0 + 4 * (QI) + a4) * 8 + sl) * 128 + PBS * (WB) + q] = pdb_; } \
        else { const int bf_ = ((QI) & 1) * 528 + a4 * 132 + (WB) * PBS; float wv_[PBS]; _Pragma("unroll") for (int j = 0; j < PBS; j += 4) { const f32x4 w4_ = *(const LAS f32x4*)(wt + bf_ + j); wv_[j] = w4_.x; wv_[j + 1] = w4_.y; wv_[j + 2] = w4_.z; wv_[j + 3] = w4_.w; } \
            _Pragma("unroll") for (int j = 0; j < PBS; ++j) { const float w_ = wv_[j]; int r0_ = R[j][0], r1_ = R[j][1], r2_ = R[j][2], r3_ = R[j][3]; asm volatile("" : "+v"(r0_), "+v"(r1_), "+v"(r2_), "+v"(r3_));     \
                _Pragma("unroll") for (int k = 0; k < 4; ++k) { const int dw_ = k == 0 ? r0_ : k == 1 ? r1_ : k == 2 ? r2_ : r3_; \
                const f32x2 lo_ = __builtin_amdgcn_cvt_pk_f32_fp8(dw_, false), hi_ = __builtin_amdgcn_cvt_pk_f32_fp8(dw_, true); \
                acc[4 * k + 0] += w_ * lo_.x; acc[4 * k + 1] += w_ * lo_.y; acc[4 * k + 2] += w_ * hi_.x; acc[4 * k + 3] += w_ * hi_.y; } } } } while (0)
#define PEER_QUAD_END(QI) do { if (VPH) { const size_t t_ = (size_t)(t0 + 4 * (QI) + a4); GAS bf16* hp_ = H + t_ * DM + 256 * sl + 16 * q; const v4u h0_ = *(const GAS v4u*)hp_, h1_ = *(const GAS v4u*)(hp_ + 8); \
            float y_[16]; y_[0] = bflo(h0_.x); y_[1] = bfhi(h0_.x); y_[2] = bflo(h0_.y); y_[3] = bfhi(h0_.y); y_[4] = bflo(h0_.z); y_[5] = bfhi(h0_.z); y_[6] = bflo(h0_.w); y_[7] = bfhi(h0_.w); \
            y_[8] = bflo(h1_.x); y_[9] = bfhi(h1_.x); y_[10] = bflo(h1_.y); y_[11] = bfhi(h1_.y); y_[12] = bflo(h1_.z); y_[13] = bfhi(h1_.z); y_[14] = bflo(h1_.w); y_[15] = bfhi(h1_.w); \
            float ss_ = 0.f; _Pragma("unroll") for (int k = 0; k < 16; ++k) { y_[k] += acc[k]; ss_ += y_[k] * y_[k]; } \
            *(GAS v4u*)hp_ = (v4u){pk2(y_[0], y_[1]), pk2(y_[2], y_[3]), pk2(y_[4], y_[5]), pk2(y_[6], y_[7])}; *(GAS v4u*)(hp_ + 8) = (v4u){pk2(y_[8], y_[9]), pk2(y_[10], y_[11]), pk2(y_[12], y_[13]), pk2(y_[14], y_[15])}; \
            ss_ = dpp_row_sum(ss_); if (q == 0) SSQ2[t_ * 8 + sl] = ss_; } } while (0)
#pragma unroll 1
    for (int qi = 0; qi < nq; ++qi) {
        i32x4 rA[PBS], rB[PBS];
        const int lane = opaque_v(F.lane), a4 = lane >> 4, q = lane & 15; ws = opaque(ws); H = (GAS bf16*)(ws + WS_HB);
        TAB = opaque((const unsigned char*)a.out) + (VPH ? OUT_V8 : OUT_U8) + 256 * sl; EIDX = (const GAS int*)(ws + WS_EIDX); SSQ = (const GAS float*)(ws + WS_SSQ); PW = (const GAS float*)(ws + WS_PW); PD = (GAS float*)(ws + WS_PD); SSQ2 = (GAS float*)(ws + WS_SSQ2);
        int sid[8];
        if (!LA || qi == 0) { PEER_STAGE_LOAD(qi); PEER_STAGE_WRITE(qi); LDS_WAIT(); asm volatile("" ::: "memory"); }
        PEER_ISSUE(rA, qi, 0);
        PEER_ISSUE(rB, qi, 1);
        if (LA && qi + 1 < nq) PEER_STAGE_LOAD(qi + 1);
        PEER_STAGE_W(qi);
        PEER_QUAD_BEGIN(qi);
#pragma unroll
        for (int wb = 0; wb < 128 / PBS; wb += 2) {
            PEER_COMPUTE(rA, qi, wb); if (wb + 2 < 128 / PBS) { PEER_ISSUE(rA, qi, wb + 2); }
            PEER_COMPUTE(rB, qi, wb + 1); if (wb + 3 < 128 / PBS) { PEER_ISSUE(rB, qi, wb + 3); }
        }
        PEER_QUAD_END(qi);
        if (LA && qi + 1 < nq) { PEER_STAGE_WRITE(qi + 1); LDS_WAIT(); asm volatile("" ::: "memory"); }
    }
#undef PEER_STAGE_LOAD
#undef PEER_STAGE_WRITE
#undef PEER_STAGE_W
#undef PEER_ISSUE
#undef PEER_QUAD_BEGIN
#undef PEER_COMPUTE
#undef PEER_QUAD_END
}
__device__ __forceinline__ void peer_w_phase(Frame& F, const Args& a) {
    unsigned char* ws = a.ws; const float* PD = (const float*)(ws + WS_PD); const int* EIDX = (const int*)(ws + WS_EIDX); const float* GATE = (const float*)(ws + WS_GATE);
    const float* SU = (const float*)(ws + WS_SU); const float* SV = (const float*)(ws + WS_SV); float* PW = (float*)(ws + WS_PW);
    for (int i = F.vcu * 512 + F.tid; i < M * 128; i += F.G * 512) { const int t = i >> 7, p = i & 127; float d = 0.f;
#pragma unroll
        for (int sl = 0; sl < 8; ++sl) d += PD[((size_t)t * 8 + sl) * 128 + p];
        const int e = EIDX[i]; d *= SU[e];
        PW[i] = GATE[i] * 0.5f * d * (1.f + erff(d * 0.70710678118654752f)) * SV[e]; }
}
__device__ __forceinline__ void peer_n_phase(Frame& F, const Args& a) {
    unsigned char* ws = a.ws; const GAS bf16* Y = (const GAS bf16*)(ws + WS_HB); GAS float* O = (GAS float*)a.out; const GAS float* gf = (const GAS float*)a.in[15]; const GAS float* SSQ2 = (const GAS float*)(ws + WS_SSQ2); const int lane = F.lane;
    f32x4 g0[4], g1[4];
#pragma unroll
    for (int j = 0; j < 4; ++j) { g0[j] = *(const GAS f32x4*)(gf + 512 * j + 8 * lane); g1[j] = *(const GAS f32x4*)(gf + 512 * j + 8 * lane + 4); }
    const int gw = F.vcu * NWAVES + F.wave, NGW = F.G * NWAVES;
    v4u yw[4], yn[4]; f32x4 s0, s1, n0, n1;
    if (gw < M) {
#pragma unroll
        for (int j = 0; j < 4; ++j) yw[j] = *(const GAS v4u*)(Y + (size_t)gw * DM + 512 * j + 8 * lane);
        s0 = *(const GAS f32x4*)(SSQ2 + (size_t)gw * 8); s1 = *(const GAS f32x4*)(SSQ2 + (size_t)gw * 8 + 4); }
    for (int m = gw; m < M; m += NGW) { const int mn = m + NGW < M ? m + NGW : m;
#pragma unroll
        for (int j = 0; j < 4; ++j) yn[j] = *(const GAS v4u*)(Y + (size_t)mn * DM + 512 * j + 8 * lane);
        n0 = *(const GAS f32x4*)(SSQ2 + (size_t)mn * 8); n1 = *(const GAS f32x4*)(SSQ2 + (size_t)mn * 8 + 4);
        const float rf = 1.f / sqrtf((((s0.x + s0.y) + (s0.z + s0.w)) + ((s1.x + s1.y) + (s1.z + s1.w))) * (1.f / DM) + EPS);
#pragma unroll
        for (int j = 0; j < 4; ++j) {
            *(GAS f32x4*)(O + (size_t)m * DM + 512 * j + 8 * lane) = (f32x4){bflo(yw[j].x) * rf * g0[j].x, bfhi(yw[j].x) * rf * g0[j].y, bflo(yw[j].y) * rf * g0[j].z, bfhi(yw[j].y) * rf * g0[j].w};
            *(GAS f32x4*)(O + (size_t)m * DM + 512 * j + 8 * lane + 4) = (f32x4){bflo(yw[j].z) * rf * g1[j].x, bfhi(yw[j].z) * rf * g1[j].y, bflo(yw[j].w) * rf * g1[j].z, bfhi(yw[j].w) * rf * g1[j].w}; }
#pragma unroll
        for (int j = 0; j < 4; ++j) yw[j] = yn[j];
        s0 = n0; s1 = n1; }
}

__global__ void __launch_bounds__(NWAVES * 64, 2) mk_fwd(Args args_in) {
    extern __shared__ __attribute__((aligned(16))) unsigned char lds[];
    Args args = args_in;
#pragma unroll
    for (int i = 0; i < 16; ++i) args.in[i] = (const float*)(const GAS float*)args_in.in[i];
    args.out = (float*)(GAS float*)args_in.out; args.ws = (unsigned char*)(GAS unsigned char*)args_in.ws;
    Frame F;
    F.lds = (LAS unsigned char*)lds;
    F.MISC = (volatile LAS unsigned*)(F.lds + MISC_OFF);
    F.tid = threadIdx.x; F.lane = F.tid & 63; F.wave = __builtin_amdgcn_readfirstlane(F.tid >> 6);
    F.G = gridDim.x; { const int bx = blockIdx.x; F.vcu = (F.G % 8 == 0) ? (bx % 8) * (F.G / 8) + bx / 8 : bx; }
    unsigned char* ws = args.ws;
    F.ctl = (gu32*)(ws + WS_CTL);
    for (int u = F.tid; u < (LDS_BYTES - LDSCTL_OFF) / 4; u += NWAVES * 64) ((LAS unsigned*)(F.lds + LDSCTL_OFF))[u] = 0u;
    __syncthreads();
    XcdBarrier bar = xcd_barrier_post((unsigned*)(F.ctl + CW_BAR) + args.li * XCD_BAR_WORDS, F.MISC + 8);
    const int lo = args.ph_lo, hi = args.ph_hi;
#define IN(k) (lo <= (k) && (k) < hi)
#define BOTH(k) (IN(k) && IN((k) + 1))
#define GRID_BAR() xcd_barrier(bar)

    if (IN(0)) { for (int rep = 0; rep < NREP(0); ++rep) p0_prologue(F, args); if (BOTH(0)) GRID_BAR(); }

    if (IN(1)) {
        pg8::Gemm g{(const bf16*)(ws + WS_XN), (const bf16*)(ws + WS_WIN), M, NINP, DM}; pg8::StaticOrder S; S.init(M, NINP, F.G, (int)blockIdx.x);
        pg8::EpiBf16<0> E{(bf16*)(ws + WS_PROJ), NINP, nullptr, 0, 0, 1.f};
        for (int rep = 0; rep < NREP(1); ++rep) pg8::gemm_phase<pg8::EpiBf16<0>, pg8::StaticOrder, PG8_ALIGN, PG8_SP2>(F.lds + RING_OFF, g, S, E);
        for (int rep = 0; rep < NREP(11); ++rep) gd_side_gemm(F, args);
        if (BOTH(1)) GRID_BAR();
    }
    if (IN(2)) {
        for (int rep = 0; rep < NREP(21); ++rep) gla_prep_phase(F, args);
        GRID_BAR();
        for (int rep = 0; rep < NREP(2); ++rep) gla_seq_phase(F, args);
        for (int rep = 0; rep < NREP(20); ++rep) attn_phase(F, args, rep);
        for (int rep = 0; rep < NREP(40); ++rep) peer_convert_tables(F, args, rep);
        if (BOTH(2)) GRID_BAR(); }
    if (IN(3)) { for (int rep = 0; rep < NREP(3); ++rep) p3_finalize(F, args); if (BOTH(3)) GRID_BAR(); }
    if (IN(4)) {
        pg8::Gemm g{(const bf16*)(ws + WS_XN), (const bf16*)(ws + WS_WOUT), M, DM, DM}; pg8::StaticOrder S; S.init(M, DM, F.G, (int)blockIdx.x);
        pg8::EpiRes E{args.in[0], (bf16*)(ws + WS_HB), (float*)(ws + WS_SSQ), DM};
        for (int rep = 0; rep < NREP(4); ++rep) pg8::gemm_phase<pg8::EpiRes, pg8::StaticOrder, PG8_ALIGN, PG8_SP2>(F.lds + RING_OFF, g, S, E);
        if (BOTH(4)) GRID_BAR();
    }
    if (IN(5)) {
        pg8::Gemm g{(const bf16*)(ws + WS_HB), (const bf16*)(ws + WS_WQ), M, DM, DM}; pg8::StaticOrder S; S.init(M, DM, F.G, (int)blockIdx.x);
        pg8::EpiBf16<0> E{(bf16*)(ws + WS_XN), DM, nullptr, 0, 0, 1.f};
        for (int rep = 0; rep < NREP(5); ++rep) pg8::gemm_phase<pg8::EpiBf16<0>, pg8::StaticOrder, PG8_ALIGN, PG8_SP2>(F.lds + RING_OFF, g, S, E);
        if (BOTH(5)) GRID_BAR();
    }
    if (IN(6)) { for (int rep = 0; rep < NREP(6); ++rep) topk_phase(F, args); if (BOTH(6)) GRID_BAR(); }
    if (IN(7)) {
        for (int rep = 0; rep < NREP(7); ++rep) peer_uv_phase<false, 16, true>(F, args);
        GRID_BAR();
        peer_w_phase(F, args);
        GRID_BAR();
        if (REP_PHASE != 8) peer_uv_phase<true, 16, false>(F, args);
        GRID_BAR();
        peer_n_phase(F, args);
    }
#undef IN
#undef BOTH
}


extern "C" void kernel_launch(void* const* d_in, const int* in_sizes, int n_in, void* d_out, int out_size, void* d_ws, size_t ws_size, hipStream_t stream) {
    static int grid = 0;
    if (grid == 0) {
        if (n_in != 16 || in_sizes[0] != M * DM || out_size != M * DM || ws_size < WS_END) { fprintf(stderr, "kernel_launch: unexpected shapes: n_in %d in0 %d out %d ws %zu\n", n_in, n_in > 0 ? in_sizes[0] : -1, out_size, ws_size); grid = -1; return; }
        int dev = 0, cus = 0;
        if (hipGetDevice(&dev) != hipSuccess || hipDeviceGetAttribute(&cus, hipDeviceAttributeMultiprocessorCount, dev) != hipSuccess) { grid = -1; return; }
        if (hipFuncSetAttribute((const void*)mk_fwd, hipFuncAttributeMaxDynamicSharedMemorySize, LDS_BYTES) != hipSuccess) { fprintf(stderr, "kernel_launch: hipFuncSetAttribute failed\n"); grid = -1; return; }
        (void)hipGetLastError();
        grid = cus;
    }
    if (grid < 0) return;
    (void)hipMemsetAsync((char*)d_ws + WS_CTL, 0, CTL_ZERO_BYTES, stream);
    Args a{};
    for (int i = 0; i < 16; ++i) a.in[i] = (const float*)d_in[i];
    a.out = (float*)d_out; a.ws = (unsigned char*)d_ws;
    a.ph_lo = 0; a.ph_hi = 8; a.li = 0;
    hipLaunchKernelGGL(mk_fwd, dim3(grid), dim3(NWAVES * 64), LDS_BYTES, stream, a);
}
```

```cpp
#define REP_PHASE -1

#include <hip/hip_runtime.h>
#include <cstdio>
#include <cstdint>
#include <cmath>
#ifndef REP_PHASE
#define REP_PHASE -1
#endif
#define NREP(k) ((REP_PHASE == (k)) ? 2 : 1)
namespace pg8 {
#define PG8_LAS __attribute__((address_space(3)))
typedef unsigned short bf16_t;
typedef short bf16x8 __attribute__((ext_vector_type(8)));
typedef float f32x4 __attribute__((ext_vector_type(4)));
typedef unsigned u32x4 __attribute__((ext_vector_type(4)));
constexpr int BM = 256, BK = 64, HALF = 128, HTB = HALF * BK * 2  , STAGE_BYTES = 8 * HTB, NXCD = 8, WGM = 8;

__host__ __device__ __forceinline__ int lds_byte(int r, int c) { const int st = (r >> 4) * 2 + (c >> 5), rr = r & 15, cc = c & 31, ob = rr * 64 + cc * 2; return st * 1024 + (ob ^ (((ob >> 9) & 1) << 5)); }
__host__ __device__ __forceinline__ void stage_rc(int b, int& R, int& C) { const int st = b / 1024, sb = b % 1024, swz = sb ^ (((sb >> 9) & 1) << 5); R = (st >> 1) * 16 + swz / 64; C = (st & 1) * 32 + (swz % 64) / 2; }
__host__ __device__ __forceinline__ int perm32(int rho) { const int n = rho >> 4, i = rho & 15; return 8 * (i >> 2) + 4 * n + (i & 3); }

struct Unit { int pm, pn; };
struct Gemm { const bf16_t* A; const bf16_t* Bt; int M, N, K; };

struct StaticOrder {
    int nM, nN, nwg, G, c;
    __host__ __device__ void init(int M, int N, int G_, int c_) { nM = M / BM; nN = N / BM; nwg = nM * nN; G = G_; c = c_; }
    __host__ __device__ bool next(int i, Unit& u) const {
        const long L = (long)i * G + c; if (L >= nwg) return false;
        int wgid = (int)L; { const int q = nwg / NXCD, r = nwg % NXCD, xcd = wgid % NXCD, off = wgid / NXCD; wgid = (xcd < r ? xcd * (q + 1) : r * (q + 1) + (xcd - r) * q) + off; }
        const int nig = WGM * nN, gid = wgid / nig, fm = gid * WGM, gsz = (nM - fm) < WGM ? (nM - fm) : WGM;
        u.pm = fm + ((wgid % nig) % gsz); u.pn = (wgid % nig) / gsz; return true;
    }
    __device__ __forceinline__ void a_ready(const Unit&) const {}
    __device__ __forceinline__ void done(const Unit&) const {}
};

__device__ __forceinline__ unsigned cvt_pk_bf16(float lo, float hi) { unsigned r; asm volatile("v_cvt_pk_bf16_f32 %0, %1, %2" : "=v"(r) : "v"(lo), "v"(hi)); return r; }
typedef float f32x2 __attribute__((ext_vector_type(2)));
__device__ __forceinline__ f32x2 gelu_pk(f32x2 v) {
    const f32x2 av = __builtin_elementwise_abs(v), d = av * 0.2316418882f + 1.0f;
    f32x2 t; t.x = __builtin_amdgcn_rcpf(d.x); t.y = __builtin_amdgcn_rcpf(d.y);
    f32x2 q = t * 0.5307027145f + (-0.7265760135f); q = q * t + 0.7107068705f; q = q * t + (-0.142248368f); q = q * t + 0.127414796f; q = q * t;
    const f32x2 s = (v * v) * (-0.72134752044f);
    f32x2 e; e.x = __builtin_amdgcn_exp2f(s.x); e.y = __builtin_amdgcn_exp2f(s.y);
    const f32x2 m = v * (q * e), r = v - m;
    f32x2 o; o.x = v.x < 0.f ? m.x : r.x; o.y = v.y < 0.f ? m.y : r.y; return o;
}

template <int ACT  > struct EpiBf16 {
    static constexpr bool PERM = true, AFTER_DRAIN = false; static_assert(ACT == 0 || ACT == 1, "EpiBf16: ACT is 0 (none) or 1 (gelu_pk)");
    bf16_t* O; int ldc; const float* bias; int split_cols; size_t split_stride; float scale0;
    __device__ __forceinline__ void operator()(const f32x4 (&acc)[2][2][4][2], const Unit& u, int wr, int wc, int fr, int fq) const {
        const int row0 = u.pm * BM + wr * 64 + fr; int colt = u.pn * BM; bf16_t* base = O;
        float sc = 1.f; if (split_cols) { const int t = colt / split_cols; base += (size_t)t * split_stride; colt -= t * split_cols; if (t == 0) sc = scale0; }
        const int col0 = colt + wc * 32 + 8 * fq, bcol0 = u.pn * BM + wc * 32 + 8 * fq;
        f32x4 bv[2][2];
#pragma unroll
        for (int bj = 0; bj < 2; ++bj)
#pragma unroll
            for (int n = 0; n < 2; ++n) bv[bj][n] = bias ? *(const f32x4*)(bias + bcol0 + bj * HALF + 4 * n) : (f32x4){0.f, 0.f, 0.f, 0.f};
#pragma unroll
        for (int ai = 0; ai < 2; ++ai)
#pragma unroll
            for (int m = 0; m < 4; ++m) { bf16_t* rowp = base + (size_t)(row0 + ai * HALF + m * 16) * ldc + col0;
#pragma unroll
                for (int bj = 0; bj < 2; ++bj) { f32x4 v0 = acc[ai][bj][m][0] + bv[bj][0], v1 = acc[ai][bj][m][1] + bv[bj][1];
                    if (ACT == 1) { f32x2 a = gelu_pk((f32x2){v0[0], v0[1]}), b = gelu_pk((f32x2){v0[2], v0[3]}), c = gelu_pk((f32x2){v1[0], v1[1]}), d = gelu_pk((f32x2){v1[2], v1[3]});
                        v0 = (f32x4){a.x, a.y, b.x, b.y}; v1 = (f32x4){c.x, c.y, d.x, d.y}; }
                    v0 = v0 * sc; v1 = v1 * sc; u32x4 w; w.x = cvt_pk_bf16(v0[0], v0[1]); w.y = cvt_pk_bf16(v0[2], v0[3]); w.z = cvt_pk_bf16(v1[0], v1[1]); w.w = cvt_pk_bf16(v1[2], v1[3]);
                    *(u32x4*)(rowp + bj * HALF) = w; } }
    }
};
template <class Epi, class Sched, bool ALIGN_EPI = false, bool SP2 = false>
__device__ __forceinline__ void gemm_phase(PG8_LAS unsigned char* lds, const Gemm g, const Sched& S, const Epi& E) {
    const int tid = threadIdx.x, wid = __builtin_amdgcn_readfirstlane(tid >> 6), lane = tid & 63, wr = wid >> 2, wc = wid & 3, fr = lane & 15, fq = lane >> 4;
    const int K = g.K, nt = K / BK;
    unsigned voffA[2], voffB[2];
#pragma unroll
    for (int i = 0; i < 2; ++i) { int R, C; stage_rc(tid * 16 + i * 8192, R, C); const int Rb = Epi::PERM ? ((R & ~31) + perm32(R & 31)) : R;
        voffA[i] = (unsigned)(R * K + C) * 2u; voffB[i] = (unsigned)(Rb * K + C) * 2u; }
    const size_t kstep = (size_t)(BK * 2);
    const size_t hstep = (size_t)HALF * K * 2;
    const size_t tstep = 2 * hstep;
    const unsigned ldsw = (unsigned)wid * 1024u;
    const int aoff = lds_byte(wr * 64 + fr, fq * 8), boff = lds_byte(wc * 32 + fr, fq * 8);
#define PG8_SA(b, h) (((b) * 2 + (h)) * HTB)
#define PG8_SB(b, h) ((4 + (b) * 2 + (h)) * HTB)
#define PG8_STAGE(bufoff, gbase, voff) do { _Pragma("unroll") for (int _i = 0; _i < 2; ++_i) \
        __builtin_amdgcn_global_load_lds((const unsigned*)((const char*)(gbase) + (voff)[_i]), (PG8_LAS unsigned*)(lds + (bufoff) + ldsw + _i * 8192), 16, 0, 0); } while (0)
#define PG8_LDA(dst, b, h) do { _Pragma("unroll") for (int m = 0; m < 4; ++m) _Pragma("unroll") for (int k = 0; k < 2; ++k) dst[m][k] = *(const PG8_LAS bf16x8*)(lds + PG8_SA(b, h) + aoff + m * 2048 + k * 1024); } while (0)
#define PG8_LDB(dst, b, h) do { _Pragma("unroll") for (int n = 0; n < 2; ++n) _Pragma("unroll") for (int k = 0; k < 2; ++k) dst[n][k] = *(const PG8_LAS bf16x8*)(lds + PG8_SB(b, h) + boff + n * 2048 + k * 1024); } while (0)
#define PG8_MMA(ai, bj, At, Bt) do { __builtin_amdgcn_s_setprio(1); _Pragma("unroll") for (int m = 0; m < 4; ++m) _Pragma("unroll") for (int n = 0; n < 2; ++n) _Pragma("unroll") for (int k = 0; k < 2; ++k) \
        acc[ai][bj][m][n] = __builtin_amdgcn_mfma_f32_16x16x32_bf16(Bt[n][k], At[m][k], acc[ai][bj][m][n], 0, 0, 0); __builtin_amdgcn_s_setprio(0); } while (0)
#define PG8_WAIT_V(n) asm volatile("s_waitcnt vmcnt(" #n ")" ::: "memory")
#define PG8_WAIT_L(n) asm volatile("s_waitcnt lgkmcnt(" #n ")" ::: "memory")
#define PG8_BAR __builtin_amdgcn_s_barrier()
#define PG8_SCHED __builtin_amdgcn_sched_barrier(0)
    Unit cur, nxt; int ui = 0;
    if (!S.next(0, cur)) return;
    f32x4 acc[2][2][4][2];
#pragma unroll
    for (int a = 0; a < 2; ++a)
#pragma unroll
        for (int b = 0; b < 2; ++b)
#pragma unroll
            for (int m = 0; m < 4; ++m)
#pragma unroll
                for (int n = 0; n < 2; ++n) acc[a][b][m][n] = (f32x4){0.f, 0.f, 0.f, 0.f};
    bf16x8 At[4][2], B0[2][2], B1[2][2];
    const char* cA = (const char*)g.A + (size_t)cur.pm * tstep; const char* cB = (const char*)g.Bt + (size_t)cur.pn * tstep;
    S.a_ready(cur);
    if constexpr (SP2) {
        PG8_STAGE(PG8_SB(0, 0), cB, voffB); PG8_STAGE(PG8_SB(0, 1), cB + hstep, voffB); PG8_STAGE(PG8_SA(0, 0), cA, voffA); PG8_STAGE(PG8_SA(0, 1), cA + hstep, voffA);
        if (wr == 1) PG8_BAR;
        PG8_WAIT_V(2); PG8_BAR;
        PG8_STAGE(PG8_SB(1, 0), cB + kstep, voffB); PG8_STAGE(PG8_SA(1, 0), cA + kstep, voffA); PG8_STAGE(PG8_SB(1, 1), cB + hstep + kstep, voffB);
        PG8_WAIT_V(6); PG8_BAR;
    } else {
        PG8_STAGE(PG8_SB(0, 0), cB, voffB); PG8_STAGE(PG8_SA(0, 0), cA, voffA); PG8_STAGE(PG8_SB(0, 1), cB + hstep, voffB); PG8_STAGE(PG8_SA(0, 1), cA + hstep, voffA);
        if (wr == 1) PG8_BAR;
        PG8_WAIT_V(4); PG8_BAR;
        PG8_STAGE(PG8_SB(1, 0), cB + kstep, voffB); PG8_STAGE(PG8_SA(1, 0), cA + kstep, voffA); PG8_STAGE(PG8_SB(1, 1), cB + hstep + kstep, voffB);
        PG8_WAIT_V(6); PG8_BAR;
    }
    for (;;) {
        const bool has_next = S.next(ui + 1, nxt);
        const char* nA = has_next ? (const char*)g.A + (size_t)nxt.pm * tstep : cA; const char* nB = has_next ? (const char*)g.Bt + (size_t)nxt.pn * tstep : cB;
        for (int t = 0; t < nt; t += 2) {
            const bool last = (t == nt - 2);
            const char* a1 = cA + (size_t)(t + 1) * kstep;
            const char* a2 = last ? nA : cA + (size_t)(t + 2) * kstep; const char* b2 = last ? nB : cB + (size_t)(t + 2) * kstep;
            const char* a3 = a2 + kstep; const char* b3 = b2 + kstep;
            if (last && has_next) S.a_ready(nxt);
            if constexpr (SP2) {
            PG8_LDB(B0, 0, 0); PG8_LDB(B1, 0, 1); PG8_SCHED; PG8_LDA(At, 0, 0); PG8_STAGE(PG8_SA(1, 1), a1 + hstep, voffA);
            PG8_WAIT_V(8); PG8_WAIT_L(0); PG8_BAR; PG8_MMA(0, 0, At, B0); PG8_MMA(0, 1, At, B1); PG8_BAR; PG8_SCHED;
            PG8_LDA(At, 0, 1); PG8_STAGE(PG8_SB(0, 0), b2, voffB); PG8_STAGE(PG8_SB(0, 1), b2 + hstep, voffB); PG8_STAGE(PG8_SA(0, 0), a2, voffA);
            PG8_WAIT_V(8); PG8_WAIT_L(0); PG8_BAR; PG8_MMA(1, 0, At, B0); PG8_MMA(1, 1, At, B1); PG8_BAR; PG8_SCHED;
            PG8_LDB(B0, 1, 0); PG8_LDB(B1, 1, 1); PG8_SCHED; PG8_LDA(At, 1, 0); PG8_STAGE(PG8_SA(0, 1), a2 + hstep, voffA);
            PG8_WAIT_V(8); PG8_WAIT_L(0); PG8_BAR; PG8_MMA(0, 0, At, B0); PG8_MMA(0, 1, At, B1); PG8_BAR; PG8_SCHED;
            PG8_LDA(At, 1, 1); PG8_STAGE(PG8_SB(1, 0), b3, voffB); PG8_STAGE(PG8_SB(1, 1), b3 + hstep, voffB); PG8_STAGE(PG8_SA(1, 0), a3, voffA);
            PG8_WAIT_V(8); PG8_WAIT_L(0); PG8_BAR; PG8_MMA(1, 0, At, B0); PG8_MMA(1, 1, At, B1); PG8_BAR; PG8_SCHED;
            } else {
            PG8_LDB(B0, 0, 0); PG8_SCHED; PG8_LDA(At, 0, 0); PG8_STAGE(PG8_SA(1, 1), a1 + hstep, voffA);
            PG8_WAIT_L(8); PG8_BAR; PG8_WAIT_L(0); PG8_MMA(0, 0, At, B0); PG8_BAR; PG8_SCHED;
            PG8_LDB(B1, 0, 1); PG8_STAGE(PG8_SB(0, 0), b2, voffB);
            PG8_BAR; PG8_WAIT_L(0); PG8_MMA(0, 1, At, B1); PG8_BAR;
            PG8_LDA(At, 0, 1); PG8_STAGE(PG8_SA(0, 0), a2, voffA);
            PG8_BAR; PG8_WAIT_L(0); PG8_MMA(1, 0, At, B0); PG8_BAR; PG8_SCHED;
            PG8_STAGE(PG8_SB(0, 1), b2 + hstep, voffB);
            PG8_WAIT_V(6); PG8_BAR; PG8_MMA(1, 1, At, B1); PG8_BAR;
            PG8_LDB(B0, 1, 0); PG8_SCHED; PG8_LDA(At, 1, 0); PG8_STAGE(PG8_SA(0, 1), a2 + hstep, voffA);
            PG8_WAIT_L(8); PG8_BAR; PG8_WAIT_L(0); PG8_MMA(0, 0, At, B0); PG8_BAR; PG8_SCHED;
            PG8_LDB(B1, 1, 1); PG8_STAGE(PG8_SB(1, 0), b3, voffB);
            PG8_BAR; PG8_WAIT_L(0); PG8_MMA(0, 1, At, B1); PG8_BAR;
            PG8_LDA(At, 1, 1); PG8_STAGE(PG8_SA(1, 0), a3, voffA);
            PG8_BAR; PG8_WAIT_L(0); PG8_MMA(1, 0, At, B0); PG8_BAR; PG8_SCHED;
            PG8_STAGE(PG8_SB(1, 1), b3 + hstep, voffB);
            PG8_WAIT_V(6); PG8_BAR; PG8_MMA(1, 1, At, B1); PG8_BAR;
            }
        }
        if constexpr (ALIGN_EPI) { if (wr == 0) PG8_BAR; }
        if constexpr (!Epi::AFTER_DRAIN) { E(acc, cur, wr, wc, fr, fq); S.done(cur); }
        if (!has_next) break;
#pragma unroll
        for (int a = 0; a < 2; ++a)
#pragma unroll
            for (int b = 0; b < 2; ++b)
#pragma unroll
                for (int m = 0; m < 4; ++m)
#pragma unroll
                    for (int n = 0; n < 2; ++n) acc[a][b][m][n] = (f32x4){0.f, 0.f, 0.f, 0.f};
        cur = nxt; cA = nA; cB = nB; ++ui;
        if constexpr (ALIGN_EPI) { if (wr == 1) PG8_BAR; }
    }
    PG8_WAIT_V(0);
    if constexpr (!ALIGN_EPI) { if (wr == 0) PG8_BAR; }
    PG8_BAR;
    if constexpr (Epi::AFTER_DRAIN) { E.fused(acc, cur, wr, wc, fr, fq, lds, wid, lane); S.done(cur); }
#undef PG8_SA
#undef PG8_SB
#undef PG8_STAGE
#undef PG8_LDA
#undef PG8_LDB
#undef PG8_MMA
#undef PG8_WAIT_V
#undef PG8_WAIT_L
#undef PG8_BAR
#undef PG8_SCHED
}
}

#ifndef PG8_SP2
#define PG8_SP2 true
#endif
#ifndef PG8_ALIGN
#define PG8_ALIGN true
#endif
#define GAS __attribute__((address_space(1)))
#define LAS __attribute__((address_space(3)))
typedef unsigned short bf16;
typedef unsigned v4u __attribute__((ext_vector_type(4)));
typedef float f32x4 __attribute__((ext_vector_type(4)));
typedef short bf16x8 __attribute__((ext_vector_type(8)));
typedef GAS unsigned gu32;
typedef GAS unsigned long long gu64;
#define RLX_AGENT __ATOMIC_RELAXED, __HIP_MEMORY_SCOPE_AGENT
#define LDS_WAIT() asm volatile("s_waitcnt lgkmcnt(0)" ::: "memory")
#define VM_WAIT() asm volatile("s_waitcnt vmcnt(0)" ::: "memory")
__device__ __forceinline__ unsigned long long rt() { return __builtin_amdgcn_s_memrealtime(); }
__device__ __forceinline__ unsigned f2bf(float f) { unsigned u = __builtin_bit_cast(unsigned, f); return (u + 0x7fffu + ((u >> 16) & 1u)) >> 16; }
typedef float pk2_f32x2 __attribute__((ext_vector_type(2))); typedef __bf16 pk2_bf16x2 __attribute__((ext_vector_type(2)));
__device__ __forceinline__ unsigned pk2(float lo, float hi) { pk2_f32x2 v = {lo, hi}; pk2_bf16x2 b = __builtin_convertvector(v, pk2_bf16x2); return __builtin_bit_cast(unsigned, b); }

#define XB_TMO      128
#define XB_XCNT(j)  (256  + 64 * (j))
#define XB_XSUB(j)  (1280 + 64 * (j))
#define XB_XGEN(j)  (2304 + 64 * (j))
#define XB_TOP      3328
#define XB_TOPGEN   3392
#define XCD_BAR_WORDS 3456
#define XB_SPIN_CAP (1u << 18)

__device__ __forceinline__ unsigned xb_ld(unsigned* p)              { return __hip_atomic_load(p, __ATOMIC_RELAXED, __HIP_MEMORY_SCOPE_AGENT); }
__device__ __forceinline__ unsigned xb_add(unsigned* p, unsigned v) { return __hip_atomic_fetch_add(p, v, __ATOMIC_RELAXED, __HIP_MEMORY_SCOPE_AGENT); }
__device__ __forceinline__ unsigned xb_xcc_id() { return (unsigned)__builtin_amdgcn_s_getreg((3 << 11) | 20) & 0xFu; }
#define XB_SPIN(cond, bar) do { unsigned _sp = 0; while (cond) { __builtin_amdgcn_s_sleep(1); \
    if ((++_sp & 255u) == 0u) { if (xb_ld(&(bar)[XB_TMO])) break; if (_sp > XB_SPIN_CAP) { atomicAdd(&(bar)[XB_TMO], 1u); break; } } } } while (0)

struct XcdBarrier {
    unsigned* bar; unsigned x;
    volatile LAS unsigned* st;
};

__device__ __forceinline__ XcdBarrier xcd_barrier_post(unsigned* bar, volatile LAS unsigned* st) {
    XcdBarrier b; b.bar = bar; b.x = xb_xcc_id(); b.st = st;
    if (threadIdx.x == 0) (void)xb_add(&bar[XB_XCNT(b.x)], 1u);
    return b;
}
__device__ __forceinline__ void xcd_barrier_complete(unsigned* bar, unsigned x, unsigned& nloc, unsigned& nx) {
    const unsigned G = gridDim.x * gridDim.y * gridDim.z;
    unsigned sum, cnt, mine, sp = 0u;
    for (;;) {
        sum = 0u; cnt = 0u; mine = 0u;
#pragma unroll
        for (unsigned j = 0; j < 16; ++j) { const unsigned c = xb_ld(&bar[XB_XCNT(j)]); sum += c; cnt += (c > 0u) ? 1u : 0u; mine = (j == x) ? c : mine; }
        if (sum == G) break;
        __builtin_amdgcn_s_sleep(1);
        if ((++sp & 255u) == 0u) { if (xb_ld(&bar[XB_TMO])) break; if (sp > XB_SPIN_CAP) { atomicAdd(&bar[XB_TMO], 1u); break; } }
    }
    nloc = mine > 0u ? mine : 1u; nx = cnt > 0u ? cnt : 1u;
}

__device__ __forceinline__ void xcd_barrier(const XcdBarrier& b) {
    asm volatile("s_waitcnt vmcnt(0)" ::: "memory");
    __syncthreads();
    if (threadIdx.x == 0) {
        unsigned* bar = b.bar;
        __builtin_amdgcn_s_waitcnt(0);
        unsigned nloc = b.st[0], nx = b.st[1];
        if (nloc == 0u) { xcd_barrier_complete(bar, b.x, nloc, nx); b.st[0] = nloc; b.st[1] = nx; }
        const unsigned old = xb_add(&bar[XB_XSUB(b.x)], 1u);
        const unsigned gen = old / nloc;
        if (old + 1u == (gen + 1u) * nloc) {
            __builtin_amdgcn_fence(__ATOMIC_RELEASE, "agent");
            asm volatile("s_waitcnt vmcnt(0)" ::: "memory");
            const unsigned og = xb_add(&bar[XB_TOP], 1u);
            const unsigned tg = og / nx;
            if (og + 1u == (tg + 1u) * nx) xb_add(&bar[XB_TOPGEN], 1u);
            else XB_SPIN(xb_ld(&bar[XB_TOPGEN]) == tg, bar);
            __builtin_amdgcn_fence(__ATOMIC_ACQUIRE, "agent");
            xb_add(&bar[XB_XGEN(b.x)], 1u);
            asm volatile("s_waitcnt vmcnt(0)" ::: "memory");
        } else {
            XB_SPIN(xb_ld(&bar[XB_XGEN(b.x)]) == gen, bar);
            __builtin_amdgcn_fence(__ATOMIC_ACQUIRE, "agent");
            asm volatile("s_waitcnt vmcnt(0)" ::: "memory");
        }
    }
    __syncthreads();
}


constexpr int NWAVES = 8;
#ifndef PG8_ALIGN23
#define PG8_ALIGN23 true
#endif
constexpr int DM = 2048, BATCH = 4, SEQ = 4096, M = BATCH * SEQ;
constexpr int NIN = 6176, NINP = 6144;
constexpr int O_GQ = 0, O_GK = 512, O_GV = 1024, O_GR = 2048, O_AQ = 3072, O_AK = 4096, O_AV = 5120;
constexpr float EPS = 1e-6f;
constexpr int PEER_K = 128;

constexpr size_t MiB = 1u << 20;
constexpr size_t WS_CTL = 0, CTL_ZERO_BYTES = 1 * MiB;
constexpr size_t WS_WIN = 1 * MiB;
constexpr size_t WS_WGD = 25 * MiB;
constexpr size_t WS_GDB = 62 * MiB;
constexpr size_t WS_WOUT = 26 * MiB;
constexpr size_t WS_WQ = 34 * MiB;
constexpr size_t WS_SSQ = 42 * MiB;
constexpr size_t WS_EIDX = 44 * MiB;
constexpr size_t WS_GATE = 52 * MiB;
constexpr size_t WS_SKB = 60 * MiB;
constexpr size_t WS_XN = 64 * MiB;
constexpr size_t WS_PROJ = 128 * MiB;
constexpr size_t WS_HB = 256 * MiB;
constexpr size_t WS_OF = 328 * MiB;
constexpr size_t WS_OB = 360 * MiB;
constexpr size_t WS_ATT = 392 * MiB;
constexpr size_t WS_ATTP = 392 * MiB;
constexpr size_t WS_ATTML = 488 * MiB;
constexpr size_t WS_GT_QD = 64 * MiB;
constexpr size_t WS_GT_KE = 96 * MiB;
constexpr size_t OUT_GT_AM = 0;
constexpr size_t OUT_GT_DEC = 16 * MiB;
constexpr size_t OUT_GT_VT = 32 * MiB;
constexpr int CW_ATTQ = 64;
constexpr size_t WS_END = 494 * MiB;
constexpr size_t OUT_U8 = 64 * MiB;
constexpr size_t OUT_V8 = 96 * MiB;
constexpr size_t WS_SU = 61 * MiB;
constexpr size_t WS_SV = 61 * MiB + 65536;
constexpr int CW_CONVQ = 256;
constexpr size_t WS_PW = 128 * MiB;
constexpr size_t WS_SSQ2 = 136 * MiB;
constexpr size_t WS_PD = 64 * MiB;
constexpr int PEER_E = 16384;
constexpr int CW_TMO = 0, CW_CODE = 1, CW_BAR = 4096;

constexpr int RING_OFF = 0, RING_BYTES = 131072;
constexpr int LDS_BYTES = 163840;
constexpr int LDSCTL_OFF = LDS_BYTES - 1024, MISC_OFF = LDSCTL_OFF + 320;

typedef float f32x2 __attribute__((ext_vector_type(2)));
typedef float f32x16 __attribute__((ext_vector_type(16)));
typedef int i32x4 __attribute__((ext_vector_type(4)));
__device__ __forceinline__ float bf2f(unsigned short h) { return __builtin_bit_cast(float, (unsigned)h << 16); }
__device__ __forceinline__ float bflo(unsigned w) { return __builtin_bit_cast(float, w << 16); }
__device__ __forceinline__ float bfhi(unsigned w) { return __builtin_bit_cast(float, w & 0xffff0000u); }
__device__ __forceinline__ float wave_sum(float v) {
#pragma unroll
    for (int o = 1; o < 64; o <<= 1) v += __shfl_xor(v, o);
    return v;
}
__device__ __forceinline__ float wave_max(float v) {
#pragma unroll
    for (int o = 1; o < 64; o <<= 1) v = fmaxf(v, __shfl_xor(v, o));
    return v;
}

template <class T> __device__ __forceinline__ T* opaque(T* p) { asm volatile("" : "+s"(p)); return (T*)(GAS T*)p; }
__device__ __forceinline__ int lane_id() { int x; asm volatile("v_mbcnt_lo_u32_b32 %0, -1, 0\n\tv_mbcnt_hi_u32_b32 %0, -1, %0" : "=v"(x)); return x; }
__device__ __forceinline__ int opaque_v(int x) { asm volatile("" : "+v"(x)); return x; }
template <class T> __device__ __forceinline__ T ldu(const void* ubase, unsigned voff) { return *(const GAS T*)((const GAS char*)ubase + voff); }
template <class T> __device__ __forceinline__ void stu(void* ubase, unsigned voff, T v) { *(GAS T*)((GAS char*)ubase + voff) = v; }
namespace pg8 {
struct EpiRes {
    static constexpr bool PERM = true, AFTER_DRAIN = false;
    const float* x; bf16_t* HB; float* ssq; int ldc;
    __device__ __forceinline__ void operator()(const f32x4 (&acc)[2][2][4][2], const Unit& u, int wr, int wc, int fr, int fq) const {
        const int col0 = u.pn * BM + wc * 32 + 8 * fq;
#pragma unroll
        for (int ai = 0; ai < 2; ++ai)
#pragma unroll
            for (int m = 0; m < 4; ++m) {
                const int r = u.pm * BM + ai * HALF + wr * 64 + m * 16 + fr; const size_t off = (size_t)r * ldc + col0; float s = 0.f;
#pragma unroll
                for (int bj = 0; bj < 2; ++bj) {
                    const f32x4 h0 = *(const f32x4*)(x + off + bj * HALF) + acc[ai][bj][m][0], h1 = *(const f32x4*)(x + off + bj * HALF + 4) + acc[ai][bj][m][1];
                    s += ((h0[0] * h0[0] + h0[1] * h0[1]) + (h0[2] * h0[2] + h0[3] * h0[3])) + ((h1[0] * h1[0] + h1[1] * h1[1]) + (h1[2] * h1[2] + h1[3] * h1[3]));
                    u32x4 w; w.x = cvt_pk_bf16(h0[0], h0[1]); w.y = cvt_pk_bf16(h0[2], h0[3]); w.z = cvt_pk_bf16(h1[0], h1[1]); w.w = cvt_pk_bf16(h1[2], h1[3]);
                    *(u32x4*)(HB + off + bj * HALF) = w;
                }
                s += __shfl_xor(s, 16); s += __shfl_xor(s, 32);
                if (fq == 0) ssq[(size_t)r * 32 + u.pn * 4 + wc] = s;
            }
    }
};
struct EpiRowScale {
    static constexpr bool PERM = true, AFTER_DRAIN = false;
    bf16_t* O; int ldc; const float* ssq; float inv_n, eps;
    __device__ __forceinline__ void operator()(const f32x4 (&acc)[2][2][4][2], const Unit& u, int wr, int wc, int fr, int fq) const {
        const int col0 = u.pn * BM + wc * 32 + 8 * fq;
#pragma unroll
        for (int ai = 0; ai < 2; ++ai)
#pragma unroll
            for (int m = 0; m < 4; ++m) {
                const int r = u.pm * BM + ai * HALF + wr * 64 + m * 16 + fr;
                const f32x4* sp = (const f32x4*)(ssq + (size_t)r * 32); float s = 0.f;
#pragma unroll
                for (int i = 0; i < 8; ++i) { const f32x4 t = sp[i]; s += (t[0] + t[1]) + (t[2] + t[3]); }
                const float sc = 1.0f / sqrtf(s * inv_n + eps);
                bf16_t* rowp = O + (size_t)r * ldc + col0;
#pragma unroll
                for (int bj = 0; bj < 2; ++bj) { const f32x4 v0 = acc[ai][bj][m][0] * sc, v1 = acc[ai][bj][m][1] * sc;
                    u32x4 w; w.x = cvt_pk_bf16(v0[0], v0[1]); w.y = cvt_pk_bf16(v0[2], v0[3]); w.z = cvt_pk_bf16(v1[0], v1[1]); w.w = cvt_pk_bf16(v1[2], v1[3]);
                    *(u32x4*)(rowp + bj * HALF) = w; }
            }
    }
};
}

struct Frame {
    LAS unsigned char* lds;
    volatile LAS unsigned* MISC;
    gu32* ctl;
    int tid, lane, wave;
    int vcu, G;
};

__device__ __forceinline__ void p0_transpose_item(const float* W, int K, int ldw, const float* gk, bf16* WT, LAS float* scr, int item, int lane) {
    const int nblk = ldw / 32, kb = item / nblk, nb = item % nblk, k0 = 64 * kb, n0 = 32 * nb;
#pragma unroll 8
    for (int i = 0; i < 32; ++i) { const int kk = 2 * i + (lane >> 5); float w = W[(size_t)(k0 + kk) * ldw + n0 + (lane & 31)]; if (gk) w *= gk[k0 + kk]; scr[kk * 33 + (lane & 31)] = w; }
    LDS_WAIT(); asm volatile("" ::: "memory");
    const int c = lane & 7;
#pragma unroll
    for (int j = 0; j < 4; ++j) { const int n = (lane >> 3) + 8 * j; const LAS float* s = scr + (8 * c) * 33 + n;
        v4u o; o.x = pk2(s[0 * 33], s[1 * 33]); o.y = pk2(s[2 * 33], s[3 * 33]); o.z = pk2(s[4 * 33], s[5 * 33]); o.w = pk2(s[6 * 33], s[7 * 33]);
        *(GAS v4u*)(WT + (size_t)(n0 + n) * K + k0 + 8 * c) = o; }
    LDS_WAIT(); asm volatile("" ::: "memory");
}
__device__ __forceinline__ void rms_row_to_bf16(int lane, const float* xrow, const float* g, bf16* orow) {
    const GAS f32x4* xr = (const GAS f32x4*)xrow + lane; const GAS f32x4* gr = (const GAS f32x4*)g + lane;
    f32x4 v[8]; float s = 0.f;
#pragma unroll
    for (int j = 0; j < 8; ++j) { v[j] = xr[64 * j]; s += (v[j].x * v[j].x + v[j].y * v[j].y) + (v[j].z * v[j].z + v[j].w * v[j].w); }
    const float rstd = 1.f / sqrtf(wave_sum(s) * (1.f / DM) + EPS);
    GAS unsigned long long* o8 = (GAS unsigned long long*)orow + lane;
#pragma unroll
    for (int j = 0; j < 8; ++j) { const f32x4 gg = gr[64 * j];
        o8[64 * j] = (unsigned long long)pk2(v[j].x * rstd * gg.x, v[j].y * rstd * gg.y) | ((unsigned long long)pk2(v[j].z * rstd * gg.z, v[j].w * rstd * gg.w) << 32); }
}

struct Args {
    const float* in[16]; float* out; unsigned char* ws; int ph_lo, ph_hi, li, pad;
};

__device__ __forceinline__ void p0_prologue(Frame& F, const Args& a) {
    unsigned char* ws = a.ws;
    LAS float* scr = (LAS float*)(F.lds + RING_OFF + F.wave * 16384);
    const int gw = F.vcu * NWAVES + F.wave, NGW = F.G * NWAVES;
    bf16* Win_t = (bf16*)(ws + WS_WIN); bf16* Wout_t = (bf16*)(ws + WS_WOUT); bf16* Wq_t = (bf16*)(ws + WS_WQ); bf16* XN = (bf16*)(ws + WS_XN);
    constexpr int I_IN = (DM / 64) * (NIN / 32), I_SQ = (DM / 64) * (DM / 32);
    constexpr int NITEMS = I_IN + 2 * I_SQ;
    for (int it = gw; it < NITEMS; it += NGW) {
        int r = it;
        if (r < I_IN) { const int nb = r % (NIN / 32); bf16* dst = nb < 96 ? Win_t : nb == 96 ? (bf16*)(ws + WS_WGD) - (size_t)96 * 32 * DM : Win_t - (size_t)32 * DM;
            p0_transpose_item(a.in[2], DM, NIN, nullptr, dst, scr, r, lane_id()); continue; } r -= I_IN;
        if (r < I_SQ) { p0_transpose_item(a.in[9], DM, DM, nullptr, Wout_t, scr, r, lane_id()); continue; } r -= I_SQ;
        p0_transpose_item(a.in[11], DM, DM, a.in[10], Wq_t, scr, r, lane_id());
    }
    { const f32x4* sk = (const f32x4*)a.in[12]; unsigned long long* skb = (unsigned long long*)(ws + WS_SKB);
      for (int i = gw * 64 + lane_id(); i < 8 * 2 * 128 * 128 / 4; i += NGW * 64) { const f32x4 v = sk[i]; skb[i] = (unsigned long long)pk2(v.x, v.y) | ((unsigned long long)pk2(v.z, v.w) << 32); } }
    { const GAS f32x4* gr = (const GAS f32x4*)a.in[1] + lane_id(); f32x4 gg[8];
#pragma unroll
      for (int j = 0; j < 8; ++j) gg[j] = gr[64 * j];
      f32x4 v[8], vn[8];
      if (gw < M) {
#pragma unroll
          for (int j = 0; j < 8; ++j) v[j] = ((const GAS f32x4*)(a.in[0] + (size_t)gw * DM) + lane_id())[64 * j]; }
      for (int m = gw; m < M; m += NGW) { const int mn = m + NGW < M ? m + NGW : m;
#pragma unroll
          for (int j = 0; j < 8; ++j) vn[j] = ((const GAS f32x4*)(a.in[0] + (size_t)mn * DM) + lane_id())[64 * j];
          float ss = 0.f;
#pragma unroll
          for (int j = 0; j < 8; ++j) ss += (v[j].x * v[j].x + v[j].y * v[j].y) + (v[j].z * v[j].z + v[j].w * v[j].w);
          const float rstd = 1.f / sqrtf(wave_sum(ss) * (1.f / DM) + EPS);
          GAS unsigned long long* o8 = (GAS unsigned long long*)(XN + (size_t)m * DM) + lane_id();
#pragma unroll
          for (int j = 0; j < 8; ++j) o8[64 * j] = (unsigned long long)pk2(v[j].x * rstd * gg[j].x, v[j].y * rstd * gg[j].y) | ((unsigned long long)pk2(v[j].z * rstd * gg[j].z, v[j].w * rstd * gg[j].w) << 32);
#pragma unroll
          for (int j = 0; j < 8; ++j) v[j] = vn[j]; } }
}


__device__ __forceinline__ void gd_side_gemm(Frame& F, const Args& a) {
    unsigned char* ws = a.ws; const bf16* XN = (const bf16*)(ws + WS_XN); const bf16* WG = (const bf16*)(ws + WS_WGD); float* GDB = (float*)(ws + WS_GDB);
    const int lane = lane_id(), w = F.wave, r32 = lane & 31, hh = lane >> 5; LAS float* part = (LAS float*)F.lds;
    for (int blk = F.vcu; blk < M / 64; blk += F.G) { const int tok0 = blk * 64;
        f32x16 acc[2];
#pragma unroll
        for (int tt = 0; tt < 2; ++tt) acc[tt] = (f32x16){0.f, 0.f, 0.f, 0.f, 0.f, 0.f, 0.f, 0.f, 0.f, 0.f, 0.f, 0.f, 0.f, 0.f, 0.f, 0.f};
#pragma unroll 4
        for (int ks = 0; ks < 16; ++ks) { const int k0 = 256 * w + 16 * ks + 8 * hh; const bf16x8 bw = *(const bf16x8*)(WG + (size_t)r32 * DM + k0);
#pragma unroll
            for (int tt = 0; tt < 2; ++tt) { const bf16x8 ax = *(const bf16x8*)(XN + (size_t)(tok0 + 32 * tt + r32) * DM + k0); acc[tt] = __builtin_amdgcn_mfma_f32_32x32x16_bf16(ax, bw, acc[tt], 0, 0, 0); } }
#pragma unroll
        for (int tt = 0; tt < 2; ++tt)
#pragma unroll
            for (int r = 0; r < 16; ++r) { const float x = acc[tt][r]; part[((w * 2 + tt) * 16 + r) * 64 + lane] = x; }
        __syncthreads();
#pragma unroll
        for (int i = 0; i < 4; ++i) { const int o = (F.wave * 64 + lane_id()) + 512 * i; float sum = 0.f;
#pragma unroll
            for (int ww = 0; ww < 8; ++ww) sum += part[ww * 2048 + o];
            const int tt = o >> 10, r = (o >> 6) & 15, ln = o & 63; const int t = 32 * tt + (r & 3) + 8 * (r >> 2) + 4 * (ln >> 5);
            GDB[(size_t)(tok0 + t) * 32 + (ln & 31)] = sum; }
        __syncthreads();
    }
}

__device__ __forceinline__ void p3_finalize(Frame& F, const Args& a) {
    unsigned char* ws = a.ws;
    const int gw = F.vcu * NWAVES + F.wave, NGW = F.G * NWAVES, lane = lane_id();
    const GAS bf16* OFp = (const GAS bf16*)(ws + WS_OF); const GAS bf16* OBp = (const GAS bf16*)(ws + WS_OB);
    const GAS bf16* PROJ = (const GAS bf16*)(ws + WS_PROJ); GAS bf16* Y = (GAS bf16*)(ws + WS_XN);
    const GAS float* ATTML = (const GAS float*)(ws + WS_ATTML); const GAS bf16* ATTP = (const GAS bf16*)(ws + WS_ATTP);
    const GAS float* gla_g = (const GAS float*)a.in[7]; const GAS float* att_g = (const GAS float*)a.in[8];
    const f32x4 gg = *(const GAS f32x4*)(gla_g + 4 * lane);
    f32x4 ag[2][2];
#pragma unroll
    for (int p = 0; p < 2; ++p) { ag[p][0] = *(const GAS f32x4*)(att_g + p * 512 + 8 * lane); ag[p][1] = *(const GAS f32x4*)(att_g + p * 512 + 8 * lane + 4); }
    unsigned long long wf[4], wb[4], gr[4], nwf[4], nwb[4], ngr[4]; f32x2 ml[2][3], nml[2][3]; v4u ow[2][3], now[2][3];
#define P3_LOAD(MM, WF, WB, GR, ML, OW) do { _Pragma("unroll") for (int hh = 0; hh < 4; ++hh) { WF[hh] = *(const GAS unsigned long long*)(OFp + (size_t)(MM) * 1024 + hh * 256 + 4 * lane); \
            WB[hh] = *(const GAS unsigned long long*)(OBp + (size_t)(MM) * 1024 + hh * 256 + 4 * lane); GR[hh] = *(const GAS unsigned long long*)(PROJ + (size_t)(MM) * NINP + O_GR + hh * 256 + 4 * lane); } \
        _Pragma("unroll") for (int p = 0; p < 2; ++p) { const int col = p * 512 + 8 * lane, hd = col >> 6; _Pragma("unroll") for (int pt = 0; pt < 3; ++pt) { const size_t rec = ((size_t)pt * M + (MM)) * 16 + hd; \
            ML[p][pt] = *(const GAS f32x2*)(ATTML + rec * 2); OW[p][pt] = *(const GAS v4u*)(ATTP + rec * 64 + (col & 63)); } } } while (0)
    if (gw < M) P3_LOAD(gw, wf, wb, gr, ml, ow);
    for (int m = gw; m < M; m += NGW) {
        const int mn = m + NGW < M ? m + NGW : m;
        P3_LOAD(mn, nwf, nwb, ngr, nml, now);
#pragma unroll
        for (int hh = 0; hh < 4; ++hh) {
            const f32x4 o = (f32x4){bflo((unsigned)wf[hh]) + bflo((unsigned)wb[hh]), bfhi((unsigned)wf[hh]) + bfhi((unsigned)wb[hh]), bflo((unsigned)(wf[hh] >> 32)) + bflo((unsigned)(wb[hh] >> 32)), bfhi((unsigned)(wf[hh] >> 32)) + bfhi((unsigned)(wb[hh] >> 32))};
            const float ss = wave_sum((o.x * o.x + o.y * o.y) + (o.z * o.z + o.w * o.w));
            const float rstd = 1.f / sqrtf(ss * (1.f / 256.f) + EPS);
            const float r0 = bflo((unsigned)gr[hh]), r1 = bfhi((unsigned)gr[hh]), r2 = bflo((unsigned)(gr[hh] >> 32)), r3 = bfhi((unsigned)(gr[hh] >> 32));
            const float y0 = o.x * rstd * gg.x * (r0 / (1.f + __expf(-r0))), y1 = o.y * rstd * gg.y * (r1 / (1.f + __expf(-r1)));
            const float y2 = o.z * rstd * gg.z * (r2 / (1.f + __expf(-r2))), y3 = o.w * rstd * gg.w * (r3 / (1.f + __expf(-r3)));
            *(GAS unsigned long long*)(Y + (size_t)m * DM + hh * 256 + 4 * lane) = (unsigned long long)pk2(y0, y1) | ((unsigned long long)pk2(y2, y3) << 32);
        }
        float av[16]; float ss = 0.f;
#pragma unroll
        for (int p = 0; p < 2; ++p) {
            const float mt = fmaxf(fmaxf(ml[p][0].x, ml[p][1].x), ml[p][2].x); const float w0 = __expf(ml[p][0].x - mt), w1 = __expf(ml[p][1].x - mt), w2 = __expf(ml[p][2].x - mt);
            const float inv = 1.f / (w0 * ml[p][0].y + w1 * ml[p][1].y + w2 * ml[p][2].y);
            av[p * 8 + 0] = (w0 * bflo(ow[p][0].x) + w1 * bflo(ow[p][1].x) + w2 * bflo(ow[p][2].x)) * inv; av[p * 8 + 1] = (w0 * bfhi(ow[p][0].x) + w1 * bfhi(ow[p][1].x) + w2 * bfhi(ow[p][2].x)) * inv;
            av[p * 8 + 2] = (w0 * bflo(ow[p][0].y) + w1 * bflo(ow[p][1].y) + w2 * bflo(ow[p][2].y)) * inv; av[p * 8 + 3] = (w0 * bfhi(ow[p][0].y) + w1 * bfhi(ow[p][1].y) + w2 * bfhi(ow[p][2].y)) * inv;
            av[p * 8 + 4] = (w0 * bflo(ow[p][0].z) + w1 * bflo(ow[p][1].z) + w2 * bflo(ow[p][2].z)) * inv; av[p * 8 + 5] = (w0 * bfhi(ow[p][0].z) + w1 * bfhi(ow[p][1].z) + w2 * bfhi(ow[p][2].z)) * inv;
            av[p * 8 + 6] = (w0 * bflo(ow[p][0].w) + w1 * bflo(ow[p][1].w) + w2 * bflo(ow[p][2].w)) * inv; av[p * 8 + 7] = (w0 * bfhi(ow[p][0].w) + w1 * bfhi(ow[p][1].w) + w2 * bfhi(ow[p][2].w)) * inv; }
#pragma unroll
        for (int i = 0; i < 16; ++i) ss += av[i] * av[i];
        const float rstd = 1.f / sqrtf(wave_sum(ss) * (1.f / 1024.f) + EPS);
#pragma unroll
        for (int p = 0; p < 2; ++p) { const f32x4 g0 = ag[p][0], g1 = ag[p][1];
            v4u w; w.x = pk2(av[p * 8 + 0] * rstd * g0.x, av[p * 8 + 1] * rstd * g0.y); w.y = pk2(av[p * 8 + 2] * rstd * g0.z, av[p * 8 + 3] * rstd * g0.w);
            w.z = pk2(av[p * 8 + 4] * rstd * g1.x, av[p * 8 + 5] * rstd * g1.y); w.w = pk2(av[p * 8 + 6] * rstd * g1.z, av[p * 8 + 7] * rstd * g1.w);
            *(GAS v4u*)(Y + (size_t)m * DM + 1024 + p * 512 + 8 * lane) = w; }
#pragma unroll
        for (int hh = 0; hh < 4; ++hh) { wf[hh] = nwf[hh]; wb[hh] = nwb[hh]; gr[hh] = ngr[hh]; }
#pragma unroll
        for (int p = 0; p < 2; ++p)
#pragma unroll
            for (int pt = 0; pt < 3; ++pt) { ml[p][pt] = nml[p][pt]; ow[p][pt] = now[p][pt]; }
    }
#undef P3_LOAD
}


__device__ __forceinline__ void wave_argmax(float& v, int& idx) {
#pragma unroll
    for (int o = 1; o < 64; o <<= 1) { const float ov = __shfl_xor(v, o); const int oi = __shfl_xor(idx, o); if (ov > v || (ov == v && oi < idx)) { v = ov; idx = oi; } }
}
__device__ __forceinline__ void ce_desc(float& a, float& b) { const float hi = fmaxf(a, b), lo = fminf(a, b); a = hi; b = lo; }
__device__ __forceinline__ void sort16_desc(float* v) {
#pragma unroll
    for (int k = 2; k <= 16; k <<= 1)
#pragma unroll
        for (int j = k >> 1; j > 0; j >>= 1)
#pragma unroll
            for (int i = 0; i < 16; ++i) { const int l = i ^ j; if (l > i) { if ((i & k) == 0 || k == 16) ce_desc(v[i], v[l]); else ce_desc(v[l], v[i]); } }
}
__device__ __forceinline__ void merge16_desc(float* v) {
#pragma unroll
    for (int j = 8; j > 0; j >>= 1)
#pragma unroll
        for (int i = 0; i < 16; ++i) { const int l = i ^ j; if (l > i) ce_desc(v[i], v[l]); }
}
__device__ __forceinline__ void top16_of_two(float* a, const float* b) {
#pragma unroll
    for (int i = 0; i < 16; ++i) a[i] = fmaxf(a[i], b[15 - i]);
    merge16_desc(a);
}
__device__ __forceinline__ void top16_of_64(float* v) {
    sort16_desc(v); sort16_desc(v + 16); sort16_desc(v + 32); sort16_desc(v + 48);
    top16_of_two(v, v + 16); top16_of_two(v + 32, v + 48); top16_of_two(v, v + 32);
}
__device__ __forceinline__ void topk_phase(Frame& F, const Args& a) {
    unsigned char* ws = a.ws; const GAS bf16* QP = (const GAS bf16*)(ws + WS_XN); const GAS bf16* SKB = (const GAS bf16*)(ws + WS_SKB); GAS int* EIDX = (GAS int*)(ws + WS_EIDX); GAS float* GATE = (GAS float*)(ws + WS_GATE);
    const int lane = lane_id(), r32 = lane & 31, hh = lane >> 5;
    LAS unsigned char* skl = F.lds;
    LAS int* ktab = (LAS int*)(F.lds + 65536 + F.wave * 8192);
    for (int unit = F.vcu; unit < 8 * (M / 512); unit += F.G) {
        const int h = unit & 7, tok0 = (unit >> 3) * 512 + F.wave * 64;
        __syncthreads();
#pragma unroll
        for (int i = 0; i < 8; ++i) { const int idx = (F.wave * 64 + lane_id()) + 512 * i, key = idx >> 4, ch = idx & 15;
            *(LAS v4u*)(skl + key * 256 + ((ch ^ (key & 15)) * 16)) = *(const GAS v4u*)(SKB + ((size_t)h * 256 + key) * 128 + ch * 8); }
        __syncthreads();
#pragma unroll 1
        for (int tt = 0; tt < 2; ++tt) {
            const size_t row = (size_t)(tok0 + tt * 32 + r32);
            float L[2][16];
#pragma unroll
            for (int c = 0; c < 2; ++c) {
                f32x16 acc[4];
#pragma unroll
                for (int kt = 0; kt < 4; ++kt) acc[kt] = (f32x16){0.f, 0.f, 0.f, 0.f, 0.f, 0.f, 0.f, 0.f, 0.f, 0.f, 0.f, 0.f, 0.f, 0.f, 0.f, 0.f};
                const GAS bf16* qb = QP + row * DM + h * 256 + c * 128 + 8 * hh;
#pragma unroll 2
                for (int st = 0; st < 8; ++st) {
                    const bf16x8 bq = *(const GAS bf16x8*)(qb + 16 * st);
#pragma unroll
                    for (int kt = 0; kt < 4; ++kt) { const int key = c * 128 + 32 * kt + r32; const bf16x8 ak = *(const LAS bf16x8*)(skl + key * 256 + (((2 * st + hh) ^ (key & 15)) * 16));
                        acc[kt] = __builtin_amdgcn_mfma_f32_32x32x16_bf16(ak, bq, acc[kt], 0, 0, 0); }
                }
                float v[64];
#pragma unroll
                for (int kt = 0; kt < 4; ++kt)
#pragma unroll
                    for (int r = 0; r < 16; ++r) { const int key = 32 * kt + (r & 3) + 8 * (r >> 2);
                        const float sc = acc[kt][r];
                        v[kt * 16 + r] = __builtin_bit_cast(float, (__builtin_bit_cast(unsigned, sc) & ~127u) | (unsigned)(key + 4 * hh)); }
                top16_of_64(v);
                float p[16];
#pragma unroll
                for (int i = 0; i < 16; ++i) p[i] = __shfl_xor(v[i], 32);
                top16_of_two(v, p);
#pragma unroll
                for (int i = 0; i < 16; ++i) { L[c][i] = v[i]; ktab[(c * 16 + i) * 64 + lane] = (int)(__builtin_bit_cast(unsigned, v[i]) & 127u); }
            }
            float cnd[64];
            { int n = 0;
#pragma unroll
              for (int i = 0; i < 16; ++i)
#pragma unroll
                  for (int j = 0; j < 16; ++j) if ((i + 1) * (j + 1) <= 16) { cnd[n] = __builtin_bit_cast(float, (__builtin_bit_cast(unsigned, L[0][i] + L[1][j]) & ~255u) | (unsigned)((i << 4) | j)); ++n; }
#pragma unroll
              for (int q = 50; q < 64; ++q) cnd[q] = -3.0e38f; }
            top16_of_64(cnd);
            float rstd; { const GAS f32x4* sp = (const GAS f32x4*)((const GAS float*)(ws + WS_SSQ) + row * 32); float ssq = 0.f;
#pragma unroll
              for (int i = 0; i < 8; ++i) { const f32x4 t4 = sp[i]; ssq += (t4.x + t4.y) + (t4.z + t4.w); }
              rstd = 1.0f / sqrtf(ssq * (1.f / DM) + EPS); }
            float mx = __builtin_bit_cast(float, __builtin_bit_cast(unsigned, cnd[0]) & ~255u), sum = 0.f; float ex[16];
#pragma unroll
            for (int i = 0; i < 16; ++i) { ex[i] = __expf((__builtin_bit_cast(float, __builtin_bit_cast(unsigned, cnd[i]) & ~255u) - mx) * rstd); sum += ex[i]; }
            const float inv = 1.f / sum;
            LDS_WAIT(); asm volatile("" ::: "memory");
            if (hh == 0) {
                int ev[16];
#pragma unroll
                for (int i = 0; i < 16; ++i) { const unsigned bits = __builtin_bit_cast(unsigned, cnd[i]); const int ia = (bits >> 4) & 15, jb = bits & 15; ev[i] = ktab[ia * 64 + lane] * 128 + ktab[(16 + jb) * 64 + lane]; }
                GAS int* ep = EIDX + row * 128 + h * 16; GAS float* gp = GATE + row * 128 + h * 16;
#pragma unroll
                for (int i = 0; i < 4; ++i) { *(GAS i32x4*)(ep + 4 * i) = (i32x4){ev[4 * i], ev[4 * i + 1], ev[4 * i + 2], ev[4 * i + 3]}; *(GAS f32x4*)(gp + 4 * i) = (f32x4){ex[4 * i] * inv, ex[4 * i + 1] * inv, ex[4 * i + 2] * inv, ex[4 * i + 3] * inv}; }
            }
            LDS_WAIT(); asm volatile("" ::: "memory");
        }
    }
}

__device__ __forceinline__ void gla_prep_phase(Frame& F, const Args& a) {
    unsigned char* ws = a.ws; const bf16* PROJ;
    const int w = F.wave;
    LAS unsigned char* L = F.lds;
    LAS unsigned char* Qraw = L; LAS unsigned char* Kraw = L + 16384; LAS unsigned char* Vraw = L + 32768; LAS float* GDf = (LAS float*)(L + 65536); LAS float* GSUM = (LAS float*)(L + 73728);
    LAS unsigned char* IMGQ = L + 77824; LAS unsigned char* IMGK = L + 95232; LAS unsigned char* IMGE = L + 112640; LAS unsigned char* AMI = L + 32768;
    for (int it = F.vcu; it < 1024; it += F.G) {
        const int b = it >> 8, h = (it >> 6) & 3, n = it & 63; const size_t row0 = (size_t)b * SEQ + n * 64;
        ws = opaque(ws); PROJ = (const bf16*)(ws + WS_PROJ);
        int tid = opaque_v((F.wave * 64 + lane_id())), lane = tid & 63, r32 = lane & 31, hh = lane >> 5;
#pragma unroll
        for (int i = 0; i < 2; ++i) { const int idx = tid + 512 * i, r = idx >> 4, c = idx & 15;
            *(LAS v4u*)(Qraw + r * 256 + c * 16) = *(const GAS v4u*)(PROJ + (row0 + r) * NINP + O_GQ + h * 128 + c * 8);
            *(LAS v4u*)(Kraw + r * 256 + c * 16) = *(const GAS v4u*)(PROJ + (row0 + r) * NINP + O_GK + h * 128 + c * 8); }
#pragma unroll
        for (int i = 0; i < 4; ++i) { const int idx = tid + 512 * i, r = idx >> 5, c = idx & 31;
            *(LAS v4u*)(Vraw + r * 512 + c * 16) = *(const GAS v4u*)(PROJ + (row0 + r) * NINP + O_GV + h * 256 + c * 8); }
        if (tid < 256) { const int r = tid >> 2, c = tid & 3; const GAS float* gsrc = (const GAS float*)(ws + WS_GDB) + (row0 + r) * 32 + c * 8; const f32x4 g0 = *(const GAS f32x4*)gsrc, g1 = *(const GAS f32x4*)(gsrc + 4);
            *(LAS f32x4*)(GDf + r * 32 + c * 8) = g0; *(LAS f32x4*)(GDf + r * 32 + c * 8 + 4) = g1; }
        __syncthreads();
#pragma unroll
        for (int ks = 0; ks < 4; ++ks) { unsigned pk[4];
#pragma unroll
            for (int p = 0; p < 4; ++p) { const int s0 = 16 * ks + 8 * hh + 2 * p; const unsigned lo = *(const LAS unsigned short*)(Vraw + s0 * 512 + (32 * w + r32) * 2), hi = *(const LAS unsigned short*)(Vraw + (s0 + 1) * 512 + (32 * w + r32) * 2); pk[p] = lo | (hi << 16); }
            *(GAS v4u*)((unsigned char*)a.out + OUT_GT_VT + (size_t)it * 32768 + (w * 4 + ks) * 1024 + lane * 16) = (v4u){pk[0], pk[1], pk[2], pk[3]}; }
        for (int dir = 0; dir < 2; ++dir) {
            const size_t idir = (size_t)(((b * 4 + h) * 2 + dir) * 64 + n); ws = opaque(ws); tid = opaque_v(tid); lane = tid & 63; r32 = lane & 31; hh = lane >> 5;
            {
                const int d = tid & 127, tq = tid >> 7; const float* upp = (dir ? a.in[5] : a.in[3]) + h * 128 + d; const float bias = (dir ? a.in[6] : a.in[4])[h * 128 + d];
                float up[16];
#pragma unroll
                for (int r = 0; r < 16; ++r) up[r] = upp[r * 512];
                float c[16];
#pragma unroll
                for (int i = 0; i < 16; ++i) { const LAS float* g = GDf + (16 * tq + i) * 32 + dir * 16; float z = bias;
#pragma unroll
                    for (int r = 0; r < 16; ++r) z += g[r] * up[r];
                    c[i] = (fminf(z, 0.f) - __logf(1.f + __expf(-fabsf(z)))) * (1.f / 16.f); }
                if (dir == 0) {
#pragma unroll
                    for (int i = 1; i < 16; ++i) c[i] += c[i - 1];
                } else {
#pragma unroll
                    for (int i = 14; i >= 0; --i) c[i] += c[i + 1];
                }
                GSUM[(dir * 4 + tq) * 128 + d] = dir == 0 ? c[15] : c[0];
                __syncthreads();
                const float t0 = GSUM[(dir * 4 + 0) * 128 + d], t1 = GSUM[(dir * 4 + 1) * 128 + d], t2 = GSUM[(dir * 4 + 2) * 128 + d], t3 = GSUM[(dir * 4 + 3) * 128 + d];
                const float Bt = (t0 + t1) + (t2 + t3);
                float off;
                if (dir == 0) off = (tq > 0 ? t0 : 0.f) + (tq > 1 ? t1 : 0.f) + (tq > 2 ? t2 : 0.f);
                else off = (tq < 1 ? t1 : 0.f) + (tq < 2 ? t2 : 0.f) + (tq < 3 ? t3 : 0.f);
                unsigned kep[8];
#pragma unroll
                for (int i = 0; i < 16; i += 2) { float ke2[2];
#pragma unroll
                    for (int q = 0; q < 2; ++q) { const int t = 16 * tq + i + q; const float bi = c[i + q] + off;
                        const float qv = bf2f(*(const LAS unsigned short*)(Qraw + t * 256 + d * 2)), kv = bf2f(*(const LAS unsigned short*)(Kraw + t * 256 + d * 2));
                        *(LAS unsigned short*)(IMGQ + t * 272 + d * 2) = (unsigned short)pk2(qv * 0.08838834764831845f * __expf(bi), 0.f);
                        *(LAS unsigned short*)(IMGK + t * 272 + d * 2) = (unsigned short)pk2(kv * __expf(-bi), 0.f);
                        ke2[q] = kv * __expf(Bt - bi); }
                    kep[i >> 1] = pk2(ke2[0], ke2[1]); }
                *(LAS v4u*)(IMGE + d * 144 + (16 * tq) * 2) = (v4u){kep[0], kep[1], kep[2], kep[3]};
                *(LAS v4u*)(IMGE + d * 144 + (16 * tq + 8) * 2) = (v4u){kep[4], kep[5], kep[6], kep[7]};
                if (tq == 0) ((GAS float*)((unsigned char*)a.out + OUT_GT_DEC))[idir * 128 + d] = __expf(Bt);
            }
            __syncthreads();
            if (w < 4) {
                const int si = w >> 1, ti = w & 1; f32x16 acc = (f32x16){0.f, 0.f, 0.f, 0.f, 0.f, 0.f, 0.f, 0.f, 0.f, 0.f, 0.f, 0.f, 0.f, 0.f, 0.f, 0.f};
#pragma unroll
                for (int ks = 0; ks < 8; ++ks) { const bf16x8 ak = *(const LAS bf16x8*)(IMGK + (32 * si + r32) * 272 + (16 * ks + 8 * hh) * 2), bq = *(const LAS bf16x8*)(IMGQ + (32 * ti + r32) * 272 + (16 * ks + 8 * hh) * 2);
                    acc = __builtin_amdgcn_mfma_f32_32x32x16_bf16(ak, bq, acc, 0, 0, 0); }
                const int t = 32 * ti + r32;
#pragma unroll
                for (int qd = 0; qd < 4; ++qd) { float v4[4];
#pragma unroll
                    for (int i = 0; i < 4; ++i) { const int sidx = 32 * si + 8 * qd + 4 * hh + i; const float x = acc[4 * qd + i]; const bool keep = dir == 0 ? (sidx <= t) : (sidx >= t); v4[i] = keep ? x : 0.f; }
                    *(LAS unsigned long long*)(AMI + t * 144 + (32 * si + 8 * qd + 4 * hh) * 2) = (unsigned long long)pk2(v4[0], v4[1]) | ((unsigned long long)pk2(v4[2], v4[3]) << 32); }
            } else {
                const int w4 = w - 4;
#pragma unroll
                for (int q = 0; q < 4; ++q) { const int bq = w4 * 4 + q, tt = bq >> 3, ks = bq & 7, j = ks >> 1, u = ks & 1; const int t = 32 * tt + r32;
                    const unsigned long long p0 = *(const LAS unsigned long long*)(IMGQ + t * 272 + (32 * j + 16 * u + 4 * hh) * 2), p1 = *(const LAS unsigned long long*)(IMGQ + t * 272 + (32 * j + 16 * u + 8 + 4 * hh) * 2);
                    *(GAS v4u*)(ws + WS_GT_QD + idir * 16384 + bq * 1024 + lane * 16) = (v4u){(unsigned)p0, (unsigned)(p0 >> 32), (unsigned)p1, (unsigned)(p1 >> 32)}; }
#pragma unroll
                for (int q = 0; q < 4; ++q) { const int bk = w4 * 4 + q, j = bk >> 2, ks = bk & 3; const int d = 32 * j + r32;
                    *(GAS v4u*)(ws + WS_GT_KE + idir * 16384 + bk * 1024 + lane * 16) = *(const LAS v4u*)(IMGE + d * 144 + (16 * ks + 8 * hh) * 2); }
            }
            __syncthreads();
            { const int tt = w >> 2, ks = w & 3; const int t = 32 * tt + r32;
              *(GAS v4u*)((unsigned char*)a.out + OUT_GT_AM + idir * 8192 + w * 1024 + lane * 16) = *(const LAS v4u*)(AMI + t * 144 + (16 * ks + 8 * hh) * 2); }
            __syncthreads();
        }
    }
}

__device__ __forceinline__ void gla_seq_phase(Frame& F, const Args& a) {
    unsigned char* ws = a.ws;
    const int w = F.wave;
    constexpr int GBUF = 57856;
    for (int unit = F.vcu; unit < 64; unit += F.G) {
        const int dir = unit & 1, eh = (unit >> 1) & 1, bh = unit >> 2, b = bh >> 2, h = bh & 3;
        if (w >= 4) {
            const int lt = opaque_v((F.wave * 64 + lane_id())) - 256;
            v4u A[15], B[15];
#define GLA_LOAD(R, NS) do { const int n_ = dir ? 63 - (NS) : (NS); const size_t idir_ = (size_t)((bh * 2 + dir) * 64 + n_), iv_ = (size_t)(bh * 64 + n_); const unsigned char* o_ = opaque((const unsigned char*)a.out); const unsigned char* w_ = opaque(ws); \
            const GAS v4u* gq_ = (const GAS v4u*)(w_ + WS_GT_QD + idir_ * 16384); const GAS v4u* gk_ = (const GAS v4u*)(w_ + WS_GT_KE + idir_ * 16384); const GAS v4u* ga_ = (const GAS v4u*)(o_ + OUT_GT_AM + idir_ * 8192); \
            const GAS v4u* gv_ = (const GAS v4u*)(o_ + OUT_GT_VT + iv_ * 32768 + eh * 16384); const GAS v4u* gd_ = (const GAS v4u*)(o_ + OUT_GT_DEC + idir_ * 512); \
            _Pragma("unroll") for (int i = 0; i < 4; ++i) { R[i] = gq_[lt + 256 * i]; R[4 + i] = gk_[lt + 256 * i]; R[10 + i] = gv_[lt + 256 * i]; } R[8] = ga_[lt]; R[9] = ga_[lt + 256]; R[14] = gd_[lt & 31]; } while (0)
#define GLA_WRITE(R, BUF) do { LAS v4u* d_ = (LAS v4u*)(F.lds + (BUF) * GBUF); \
            _Pragma("unroll") for (int i = 0; i < 4; ++i) { d_[lt + 256 * i] = R[i]; d_[1024 + lt + 256 * i] = R[4 + i]; d_[2560 + lt + 256 * i] = R[10 + i]; } d_[2048 + lt] = R[8]; d_[2048 + lt + 256] = R[9]; if (lt < 32) d_[3584 + lt] = R[14]; } while (0)
            GLA_LOAD(A, 0); GLA_LOAD(B, 1);
            GLA_WRITE(A, 0);
            __syncthreads();
#pragma unroll 1
            for (int ns = 0; ns < 64; ns += 2) {
                if (ns + 2 < 64) GLA_LOAD(A, ns + 2);
                GLA_WRITE(B, 1);
                __syncthreads();
                if (ns + 3 < 64) GLA_LOAD(B, ns + 3);
                if (ns + 2 < 64) GLA_WRITE(A, 0);
                __syncthreads();
            }
#undef GLA_LOAD
#undef GLA_WRITE
        } else {
            f32x16 S[4];
#pragma unroll
            for (int j = 0; j < 4; ++j) S[j] = (f32x16){0.f, 0.f, 0.f, 0.f, 0.f, 0.f, 0.f, 0.f, 0.f, 0.f, 0.f, 0.f, 0.f, 0.f, 0.f, 0.f};
            __syncthreads();
#pragma unroll 1
            for (int ns = 0; ns < 64; ++ns) {
                const int n = dir ? 63 - ns : ns;
                const int lane = opaque_v(lane_id()), r32 = lane & 31, hh = lane >> 5;
                LAS unsigned char* QDl = F.lds + (ns & 1) * GBUF; LAS unsigned char* KEl = QDl + 16384; LAS unsigned char* AMl = QDl + 32768; LAS unsigned char* VTl = QDl + 40960; LAS float* DECl = (LAS float*)(QDl + 57344);
                GAS bf16* Out = (GAS bf16*)(opaque(ws) + (dir ? WS_OB : WS_OF));
                bf16x8 vf[4];
#pragma unroll
                for (int ks = 0; ks < 4; ++ks) vf[ks] = *(const LAS bf16x8*)(VTl + (w * 4 + ks) * 1024 + lane * 16);
                f32x16 o[2];
#pragma unroll
                for (int tt = 0; tt < 2; ++tt) o[tt] = (f32x16){0.f, 0.f, 0.f, 0.f, 0.f, 0.f, 0.f, 0.f, 0.f, 0.f, 0.f, 0.f, 0.f, 0.f, 0.f, 0.f};
#pragma unroll
                for (int ks8 = 0; ks8 < 8; ++ks8) { const int j = ks8 >> 1, u = ks8 & 1; v4u sb;
                    sb.x = pg8::cvt_pk_bf16(S[j][8 * u + 0], S[j][8 * u + 1]); sb.y = pg8::cvt_pk_bf16(S[j][8 * u + 2], S[j][8 * u + 3]); sb.z = pg8::cvt_pk_bf16(S[j][8 * u + 4], S[j][8 * u + 5]); sb.w = pg8::cvt_pk_bf16(S[j][8 * u + 6], S[j][8 * u + 7]);
                    const bf16x8 bs = __builtin_bit_cast(bf16x8, sb);
#pragma unroll
                    for (int tt = 0; tt < 2; ++tt) { const bf16x8 aq = *(const LAS bf16x8*)(QDl + (tt * 8 + ks8) * 1024 + lane * 16); o[tt] = __builtin_amdgcn_mfma_f32_32x32x16_bf16(aq, bs, o[tt], 0, 0, 0); } }
#pragma unroll
                for (int ks = 0; ks < 4; ++ks)
#pragma unroll
                    for (int tt = 0; tt < 2; ++tt) { const bf16x8 am = *(const LAS bf16x8*)(AMl + (tt * 4 + ks) * 1024 + lane * 16); o[tt] = __builtin_amdgcn_mfma_f32_32x32x16_bf16(am, vf[ks], o[tt], 0, 0, 0); }
#pragma unroll
                for (int tt = 0; tt < 2; ++tt)
#pragma unroll
                    for (int r = 0; r < 16; ++r) { const int t = 32 * tt + (r & 3) + 8 * (r >> 2) + 4 * hh; const float x = o[tt][r];
                        Out[((size_t)b * SEQ + 64 * n + t) * 1024 + h * 256 + 32 * (eh * 4 + w) + r32] = (bf16)pk2(x, 0.f); }
#pragma unroll
                for (int j = 0; j < 4; ++j) {
#pragma unroll
                    for (int q = 0; q < 4; ++q) { const f32x4 dv = *(const LAS f32x4*)(DECl + 32 * j + 8 * q + 4 * hh); S[j][4 * q + 0] *= dv.x; S[j][4 * q + 1] *= dv.y; S[j][4 * q + 2] *= dv.z; S[j][4 * q + 3] *= dv.w; }
#pragma unroll
                    for (int ks = 0; ks < 4; ++ks) { const bf16x8 ak = *(const LAS bf16x8*)(KEl + (j * 4 + ks) * 1024 + lane * 16); S[j] = __builtin_amdgcn_mfma_f32_32x32x16_bf16(ak, vf[ks], S[j], 0, 0, 0); } }
                __syncthreads();
            }
        }
    }
}

typedef short v4i16_t __attribute__((ext_vector_type(4)));
__device__ __forceinline__ void attn_phase(Frame& F, const Args& a, int qslot) {
    unsigned char* ws = a.ws; const bf16* PROJ;
    const int w = F.wave;
    volatile LAS int* uword = (volatile LAS int*)(F.lds + 2 * 78336);
    constexpr int NUNITS = 64 * 3 * 32;
#define ATT_DECODE(U) const int bh = (U) / 96, rem = (U) - bh * 96, p = rem >> 5, idx = rem & 31; const int lgd = 2 * p, d = 1 << lgd; \
        const int r = idx >> (5 - lgd), J = idx & ((32 >> lgd) - 1), Lc = SEQ >> lgd; const int b = bh >> 4, h = bh & 15; const int m0 = 128 * J - 64;
    v4u kx[4], vx[4]; v4u qw[2];
#define ATT_LOAD(U) do { ATT_DECODE(U) ws = opaque(ws); PROJ = (const bf16*)(ws + WS_PROJ); const int tid_ = opaque_v((F.wave * 64 + lane_id())); \
        _Pragma("unroll") for (int i = 0; i < 4; ++i) { const int kr = (tid_ >> 3) + 64 * i, ch = tid_ & 7; const int mp = m0 + kr; kx[i] = (v4u){0u, 0u, 0u, 0u}; vx[i] = kx[i]; \
            if (mp >= 0 && mp < Lc) { const bf16* src = PROJ + ((size_t)b * SEQ + r + d * mp) * NINP + O_AK + h * 64 + ch * 8; kx[i] = *(const GAS v4u*)src; vx[i] = *(const GAS v4u*)(src + (O_AV - O_AK)); } } \
        const int tokq_ = r + d * (128 * J + 16 * w + (tid_ & 15)); \
        _Pragma("unroll") for (int sft = 0; sft < 2; ++sft) qw[sft] = *(const GAS v4u*)(PROJ + ((size_t)b * SEQ + tokq_) * NINP + O_AQ + h * 64 + 32 * sft + 8 * ((tid_ & 63) >> 4)); } while (0)
    float tab[40];
    { const int l0 = opaque_v(lane_id());
#pragma unroll
      for (int c = 0; c < 40; ++c) { const int kb = c >> 3, uu = (c >> 2) & 1, rho = c & 3; const int jo = 32 * kb + 8 * (l0 >> 4) + 4 * uu + rho - 64 - (l0 & 15); const int aj = jo < 0 ? -jo : jo; tab[c] = aj <= 64 ? (float)aj : 3.0e38f; } }
    if ((F.wave * 64 + lane_id()) == 0) { uword[0] = (int)__hip_atomic_fetch_add((unsigned*)(F.ctl + CW_ATTQ + 64 * qslot), 1u, __ATOMIC_RELAXED, __HIP_MEMORY_SCOPE_AGENT); uword[1] = (int)__hip_atomic_fetch_add((unsigned*)(F.ctl + CW_ATTQ + 64 * qslot), 1u, __ATOMIC_RELAXED, __HIP_MEMORY_SCOPE_AGENT); }
    __syncthreads();
    int u = __builtin_amdgcn_readfirstlane(uword[0]), un = __builtin_amdgcn_readfirstlane(uword[1]); int par = 0;
#define ATT_WRITE(BUF) do { const int tid_ = opaque_v((F.wave * 64 + lane_id())); LAS unsigned char* Kw = F.lds + (BUF) * 78336; LAS unsigned char* Vw = Kw + 39168; \
        _Pragma("unroll") for (int i = 0; i < 4; ++i) { const int kr = (tid_ >> 3) + 64 * i, ch = tid_ & 7; *(LAS v4u*)(Kw + kr * 144 + ch * 16) = kx[i]; *(LAS v4u*)(Vw + kr * 144 + ch * 16) = vx[i]; } \
        if (tid_ < 128) { const int kr = 256 + (tid_ >> 3), ch = tid_ & 7; *(LAS v4u*)(Kw + kr * 144 + ch * 16) = (v4u){0u, 0u, 0u, 0u}; *(LAS v4u*)(Vw + kr * 144 + ch * 16) = (v4u){0u, 0u, 0u, 0u}; } } while (0)
    v4u qwc[2];
    if (u < NUNITS) { ATT_LOAD(u); ATT_WRITE(0); qwc[0] = qw[0]; qwc[1] = qw[1]; }
    __syncthreads();
    int bufi = 0;
    while (u < NUNITS) {
        const int tid = opaque_v((F.wave * 64 + lane_id())), lane = tid & 63, q16 = lane & 15, g = lane >> 4;
        int qnext = 0; if (tid == 0) qnext = (int)__hip_atomic_fetch_add((unsigned*)(F.ctl + CW_ATTQ + 64 * qslot), 1u, __ATOMIC_RELAXED, __HIP_MEMORY_SCOPE_AGENT);
        LAS unsigned char* Kl = F.lds + bufi * 78336; LAS unsigned char* Vl = Kl + 39168;
        bf16x8 qf[2];
#pragma unroll
        for (int sft = 0; sft < 2; ++sft) { v4u qs; constexpr float QS = 0.125f * 1.4426950408889634f; qs.x = pk2(bflo(qwc[sft].x) * QS, bfhi(qwc[sft].x) * QS); qs.y = pk2(bflo(qwc[sft].y) * QS, bfhi(qwc[sft].y) * QS); qs.z = pk2(bflo(qwc[sft].z) * QS, bfhi(qwc[sft].z) * QS); qs.w = pk2(bflo(qwc[sft].w) * QS, bfhi(qwc[sft].w) * QS);
            qf[sft] = __builtin_bit_cast(bf16x8, qs); }
        ATT_DECODE(u)
        const int tokq = r + d * (128 * J + 16 * w + q16);
        if (un < NUNITS) ATT_LOAD(un);
        const float nslope = -exp2f(-0.5f * (float)(h + 1)) * (float)d * 1.4426950408889634f;
        const bool inrange = (m0 + 16 * w >= 0) && (m0 + 16 * w + 159 < Lc);
        float sv[5][2][4]; float mx = -3.0e38f;
#pragma unroll
        for (int kb = 0; kb < 5; ++kb)
#pragma unroll
            for (int uu = 0; uu < 2; ++uu) { f32x4 acc = (f32x4){0.f, 0.f, 0.f, 0.f};
                const int krow = 16 * w + 32 * kb + 8 * (q16 >> 2) + 4 * uu + (q16 & 3);
#pragma unroll
                for (int sft = 0; sft < 2; ++sft) { const bf16x8 ak = *(const LAS bf16x8*)(Kl + krow * 144 + (32 * sft + 8 * g) * 2); acc = __builtin_amdgcn_mfma_f32_16x16x32_bf16(ak, qf[sft], acc, 0, 0, 0); }
#pragma unroll
                for (int rho = 0; rho < 4; ++rho) { const float x = acc[rho]; sv[kb][uu][rho] = __builtin_fmaf(nslope, tab[kb * 8 + uu * 4 + rho], x); } }
        if (!inrange) {
#pragma unroll
            for (int kb = 0; kb < 5; ++kb)
#pragma unroll
                for (int uu = 0; uu < 2; ++uu)
#pragma unroll
                    for (int rho = 0; rho < 4; ++rho) { const int mp = m0 + 16 * w + 32 * kb + 8 * g + 4 * uu + rho; if (mp < 0 || mp >= Lc) sv[kb][uu][rho] = -3.0e38f; } }
#pragma unroll
        for (int kb = 0; kb < 5; ++kb)
#pragma unroll
            for (int uu = 0; uu < 2; ++uu)
#pragma unroll
                for (int rho = 0; rho < 4; ++rho) mx = fmaxf(mx, sv[kb][uu][rho]);
        mx = fmaxf(mx, __shfl_xor(mx, 16)); mx = fmaxf(mx, __shfl_xor(mx, 32));
        float lsum = 0.f; bf16x8 pf[5];
#pragma unroll
        for (int kb = 0; kb < 5; ++kb) { float e[8];
#pragma unroll
            for (int uu = 0; uu < 2; ++uu)
#pragma unroll
                for (int rho = 0; rho < 4; ++rho) { const float pe = __builtin_amdgcn_exp2f(sv[kb][uu][rho] - mx); e[uu * 4 + rho] = pe; lsum += pe; }
            v4u pw; pw.x = pk2(e[0], e[1]); pw.y = pk2(e[2], e[3]); pw.z = pk2(e[4], e[5]); pw.w = pk2(e[6], e[7]); pf[kb] = __builtin_bit_cast(bf16x8, pw); }
        lsum += __shfl_xor(lsum, 16); lsum += __shfl_xor(lsum, 32);
        f32x4 oT[4];
#pragma unroll
        for (int nn = 0; nn < 4; ++nn) oT[nn] = (f32x4){0.f, 0.f, 0.f, 0.f};
#pragma unroll
        for (int kb = 0; kb < 5; ++kb)
#pragma unroll
            for (int nn = 0; nn < 4; ++nn) { const LAS unsigned char* va = Vl + (16 * w + 32 * kb + 8 * g + (q16 >> 2)) * 144 + (16 * nn + 4 * (q16 & 3)) * 2;
                const v4i16_t lo = __builtin_amdgcn_ds_read_tr16_b64_v4i16((LAS v4i16_t*)va), hi = __builtin_amdgcn_ds_read_tr16_b64_v4i16((LAS v4i16_t*)(va + 4 * 144));
                const bf16x8 vf = (bf16x8){lo[0], lo[1], lo[2], lo[3], hi[0], hi[1], hi[2], hi[3]};
                oT[nn] = __builtin_amdgcn_mfma_f32_16x16x32_bf16(vf, pf[kb], oT[nn], 0, 0, 0); }
        { const size_t rec = ((size_t)p * M + (size_t)b * SEQ + tokq) * 16 + h; GAS bf16* op = (GAS bf16*)(opaque(ws) + WS_ATTP) + rec * 64 + 4 * g;
#pragma unroll
          for (int nn = 0; nn < 4; ++nn) *(GAS unsigned long long*)(op + 16 * nn) = (unsigned long long)pk2(oT[nn][0], oT[nn][1]) | ((unsigned long long)pk2(oT[nn][2], oT[nn][3]) << 32);
          if (g == 0) { GAS float* ml = (GAS float*)(opaque(ws) + WS_ATTML) + rec * 2; ml[0] = mx * 0.6931471805599453f; ml[1] = lsum; } }
        if (un < NUNITS) { ATT_WRITE(bufi ^ 1); qwc[0] = qw[0]; qwc[1] = qw[1]; }
        if (tid == 0) uword[par] = qnext;
        __syncthreads();
        u = un; un = __builtin_amdgcn_readfirstlane(uword[par]); par ^= 1; bufi ^= 1;
    }
#undef ATT_WRITE
#undef ATT_DECODE
#undef ATT_LOAD
}

typedef __bf16 bf16x2_t __attribute__((ext_vector_type(2)));
__device__ __forceinline__ void peer_convert_tables(Frame& F, const Args& a, int qslot) {
    unsigned char* ws = a.ws; const int lane = lane_id(); volatile LAS int* uword = (volatile LAS int*)(F.lds + 2 * 78336 + 64);
    for (;;) {
        __syncthreads();
        if ((F.wave * 64 + lane_id()) == 0) uword[0] = (int)__hip_atomic_fetch_add((unsigned*)(F.ctl + CW_CONVQ + 64 * qslot), 1u, __ATOMIC_RELAXED, __HIP_MEMORY_SCOPE_AGENT);
        __syncthreads();
        const int blk = __builtin_amdgcn_readfirstlane(uword[0]);
        if (blk >= 2 * PEER_E / 64) break;
#pragma unroll 1
        for (int i = 0; i < 8; ++i) { const int r = blk * 64 + F.wave * 8 + i;
            const int e = r & (PEER_E - 1); const bool isv = r >= PEER_E;
            const float* src = (isv ? a.in[14] : a.in[13]) + (size_t)e * DM;
            unsigned char* dst = (unsigned char*)a.out + (isv ? OUT_V8 : OUT_U8) + (size_t)e * DM; float* sc = (float*)(ws + (isv ? WS_SV : WS_SU));
            f32x4 v[8]; float am = 0.f;
#pragma unroll
            for (int j = 0; j < 8; ++j) { v[j] = *(const f32x4*)(src + 256 * j + 4 * lane); am = fmaxf(am, fmaxf(fmaxf(fabsf(v[j].x), fabsf(v[j].y)), fmaxf(fabsf(v[j].z), fabsf(v[j].w)))); }
            am = wave_max(am); am = fmaxf(am, 1e-30f);
            const float inv = 440.f / am;
#pragma unroll
            for (int j = 0; j < 8; ++j) { int p = __builtin_amdgcn_cvt_pk_fp8_f32(v[j].x * inv, v[j].y * inv, 0, false); p = __builtin_amdgcn_cvt_pk_fp8_f32(v[j].z * inv, v[j].w * inv, p, true);
                *(int*)(dst + 256 * j + 4 * lane) = p; }
            if (lane == 0) sc[e] = am * (1.f / 440.f); }
    }
}

__device__ __forceinline__ float dpp_row_sum(float x) {
#define PEER_DPP(ctrl) x += __builtin_bit_cast(float, __builtin_amdgcn_update_dpp(0, __builtin_bit_cast(int, x), ctrl, 0xF, 0xF, false))
    PEER_DPP(0xB1); PEER_DPP(0x4E); PEER_DPP(0x141); PEER_DPP(0x140);
#undef PEER_DPP
    return x;
}
template <bool VPH, int PBS, bool LA> __device__ __forceinline__ void peer_uv_phase(Frame& F, const Args& a) {
    unsigned char* ws = a.ws; GAS bf16* H = (GAS bf16*)(ws + WS_HB); const GAS float* g2 = (const GAS float*)a.in[10];
    const int sl = blockIdx.x & 7, rk = blockIdx.x >> 3, nrk = F.G >> 3, tpw = M / nrk / NWAVES, nq = tpw / 4;
    const unsigned char* TAB; const GAS int* EIDX; const GAS float* SSQ; const GAS float* PW; GAS float* PD; GAS float* SSQ2;
    LAS int* idt = (LAS int*)(F.lds + F.wave * 8704);
    LAS float* wt = (LAS float*)(F.lds + F.wave * 8704 + 4352);
    const int t0 = (rk * NWAVES + F.wave) * tpw;
#define PEER_STAGE_LOAD(QI) do { const size_t tb_ = (size_t)(t0 + 4 * (QI) + a4) * 128; _Pragma("unroll") for (int k = 0; k < 8; ++k) sid[k] = EIDX[tb_ + 16 * k + q]; } while (0)
#define PEER_STAGE_WRITE(QI) do { const int bf_ = ((QI) & 1) * 528; _Pragma("unroll") for (int k = 0; k < 8; ++k) idt[bf_ + a4 * 132 + 16 * k + q] = sid[k]; } while (0)
#define PEER_STAGE_W(QI) do { if (VPH) { const size_t tb_ = (size_t)(t0 + 4 * (QI) + a4) * 128; const int bf_ = ((QI) & 1) * 528; _Pragma("unroll") for (int k = 0; k < 8; ++k) wt[bf_ + a4 * 132 + 16 * k + q] = PW[tb_ + 16 * k + q]; LDS_WAIT(); asm volatile("" ::: "memory"); } } while (0)
#define PEER_ISSUE(R, QI, WB) do { const int bf_ = ((QI) & 1) * 528 + a4 * 132 + (WB) * PBS; i32x4 e4_; _Pragma("unroll") for (int j = 0; j < PBS; ++j) { if ((j & 3) == 0) e4_ = *(const LAS i32x4*)(idt + bf_ + j); const int e_ = (j & 3) == 0 ? e4_.x : (j & 3) == 1 ? e4_.y : (j & 3) == 2 ? e4_.z : e4_.w; R[j] = ldu<i32x4>(TAB, (unsigned)e_ * 2048u + (unsigned)(16 * q)); } } while (0)
    unsigned xq[8]; float acc[16];
#define PEER_QUAD_BEGIN(QI) do { const size_t t_ = (size_t)(t0 + 4 * (QI) + a4); \
        if (!VPH) { f32x4 hq[4]; { const v4u h0_ = *(const GAS v4u*)(H + t_ * DM + 256 * sl + 16 * q), h1_ = *(const GAS v4u*)(H + t_ * DM + 256 * sl + 16 * q + 8); \
            hq[0] = (f32x4){bflo(h0_.x), bfhi(h0_.x), bflo(h0_.y), bfhi(h0_.y)}; hq[1] = (f32x4){bflo(h0_.z), bfhi(h0_.z), bflo(h0_.w), bfhi(h0_.w)}; hq[2] = (f32x4){bflo(h1_.x), bfhi(h1_.x), bflo(h1_.y), bfhi(h1_.y)}; hq[3] = (f32x4){bflo(h1_.z), bfhi(h1_.z), bflo(h1_.w), bfhi(h1_.w)}; }  const float pss_ = dpp_row_sum(SSQ[t_ * 32 + q] + SSQ[t_ * 32 + 16 + q]); const float rstd_ = 1.f / sqrtf(pss_ * (1.f / DM) + EPS); f32x4 gv[4]; \
            _Pragma("unroll") for (int k = 0; k < 4; ++k) gv[k] = *(const GAS f32x4*)(g2 + 256 * sl + 16 * q + 4 * k); \
            _Pragma("unroll") for (int k = 0; k < 4; ++k) { xq[2 * k] = pk2(hq[k].x * rstd_ * gv[k].x, hq[k].y * rstd_ * gv[k].y); xq[2 * k + 1] = pk2(hq[k].z * rstd_ * gv[k].z, hq[k].w * rstd_ * gv[k].w); } } \
        else { _Pragma("unroll") for (int k = 0; k < 16; ++k) acc[k] = 0.f; } } while (0)
#define PEER_COMPUTE(R, QI, WB) do { if (!VPH) { float pdb_ = 0.f; _Pragma("unroll") for (int j = 0; j < PBS; ++j) { float d_ = 0.f; _Pragma("unroll") for (int k = 0; k < 4; ++k) { const int dw_ = R[j][k]; \
                d_ = __builtin_amdgcn_fdot2_f32_bf16(__builtin_amdgcn_cvt_scalef32_pk_bf16_fp8(dw_, 1.0f, false), __builtin_bit_cast(bf16x2_t, xq[2 * k]), d_, false); \
                d_ = __builtin_amdgcn_fdot2_f32_bf16(__builtin_amdgcn_cvt_scalef32_pk_bf16_fp8(dw_, 1.0f, true), __builtin_bit_cast(bf16x2_t, xq[2 * k + 1]), d_, false); } \
                d_ = dpp_row_sum(d_); pdb_ = (q == j) ? d_ : pdb_; } \
            if (q < PBS) PD[((size_t)(t0 + 4 * (QI) + a4) * 8 + sl) * 128 + PBS * (WB) + q] = pdb_; } \
        else { const int bf_ = ((QI) & 1) * 528 + a4 * 132 + (WB) * PBS; f32x4 w4_; _Pragma("unroll") for (int j = 0; j < PBS; ++j) { if ((j & 3) == 0) w4_ = *(const LAS f32x4*)(wt + bf_ + j); const float w_ = (j & 3) == 0 ? w4_.x : (j & 3) == 1 ? w4_.y : (j & 3) == 2 ? w4_.z : w4_.w; int r0_ = R[j][0], r1_ = R[j][1], r2_ = R[j][2], r3_ = R[j][3]; asm volatile("" : "+v"(r0_), "+v"(r1_), "+v"(r2_), "+v"(r3_));     \
                _Pragma("unroll") for (int k = 0; k < 4; ++k) { const int dw_ = k == 0 ? r0_ : k == 1 ? r1_ : k == 2 ? r2_ : r3_; \
                const f32x2 lo_ = __builtin_amdgcn_cvt_pk_f32_fp8(dw_, false), hi_ = __builtin_amdgcn_cvt_pk_f32_fp8(dw_, true); \
                acc[4 * k + 0] += w_ * lo_.x; acc[4 * k + 1] += w_ * lo_.y; acc[4 * k + 2] += w_ * hi_.x; acc[4 * k + 3] += w_ * hi_.y; } } } } while (0)
#define PEER_QUAD_END(QI) do { if (VPH) { const size_t t_ = (size_t)(t0 + 4 * (QI) + a4); GAS bf16* hp_ = H + t_ * DM + 256 * sl + 16 * q; const v4u h0_ = *(const GAS v4u*)hp_, h1_ = *(const GAS v4u*)(hp_ + 8); \
            float y_[16]; y_[0] = bflo(h0_.x); y_[1] = bfhi(h0_.x); y_[2] = bflo(h0_.y); y_[3] = bfhi(h0_.y); y_[4] = bflo(h0_.z); y_[5] = bfhi(h0_.z); y_[6] = bflo(h0_.w); y_[7] = bfhi(h0_.w); \
            y_[8] = bflo(h1_.x); y_[9] = bfhi(h1_.x); y_[10] = bflo(h1_.y); y_[11] = bfhi(h1_.y); y_[12] = bflo(h1_.z); y_[13] = bfhi(h1_.z); y_[14] = bflo(h1_.w); y_[15] = bfhi(h1_.w); \
            float ss_ = 0.f; _Pragma("unroll") for (int k = 0; k < 16; ++k) { y_[k] += acc[k]; ss_ += y_[k] * y_[k]; } \
            *(GAS v4u*)hp_ = (v4u){pk2(y_[0], y_[1]), pk2(y_[2], y_[3]), pk2(y_[4], y_[5]), pk2(y_[6], y_[7])}; *(GAS v4u*)(hp_ + 8) = (v4u){pk2(y_[8], y_[9]), pk2(y_[10], y_[11]), pk2(y_[12], y_[13]), pk2(y_[14], y_[15])}; \
            ss_ = dpp_row_sum(ss_); if (q == 0) SSQ2[t_ * 8 + sl] = ss_; } } while (0)
#pragma unroll 1
    for (int qi = 0; qi < nq; ++qi) {
        i32x4 rA[PBS], rB[PBS];
        const int lane = opaque_v(lane_id()), a4 = lane >> 4, q = lane & 15; ws = opaque(ws); H = (GAS bf16*)(ws + WS_HB);
        TAB = opaque((const unsigned char*)a.out) + (VPH ? OUT_V8 : OUT_U8) + 256 * sl; EIDX = (const GAS int*)(ws + WS_EIDX); SSQ = (const GAS float*)(ws + WS_SSQ); PW = (const GAS float*)(ws + WS_PW); PD = (GAS float*)(ws + WS_PD); SSQ2 = (GAS float*)(ws + WS_SSQ2);
        int sid[8];
        if (!LA || qi == 0) { PEER_STAGE_LOAD(qi); PEER_STAGE_WRITE(qi); LDS_WAIT(); asm volatile("" ::: "memory"); }
        PEER_ISSUE(rA, qi, 0);
        PEER_ISSUE(rB, qi, 1);
        if (LA && qi + 1 < nq) PEER_STAGE_LOAD(qi + 1);
        PEER_STAGE_W(qi);
        PEER_QUAD_BEGIN(qi);
#pragma unroll
        for (int wb = 0; wb < 128 / PBS; wb += 2) {
            PEER_COMPUTE(rA, qi, wb); if (wb + 2 < 128 / PBS) { PEER_ISSUE(rA, qi, wb + 2); }
            PEER_COMPUTE(rB, qi, wb + 1); if (wb + 3 < 128 / PBS) { PEER_ISSUE(rB, qi, wb + 3); }
        }
        PEER_QUAD_END(qi);
        if (LA && qi + 1 < nq) { PEER_STAGE_WRITE(qi + 1); LDS_WAIT(); asm volatile("" ::: "memory"); }
    }
#undef PEER_STAGE_LOAD
#undef PEER_STAGE_WRITE
#undef PEER_STAGE_W
#undef PEER_ISSUE
#undef PEER_QUAD_BEGIN
#undef PEER_COMPUTE
#undef PEER_QUAD_END
}
__device__ __forceinline__ void peer_w_phase(Frame& F, const Args& a) {
    unsigned char* ws = a.ws; const float* PD = (const float*)(ws + WS_PD); const int* EIDX = (const int*)(ws + WS_EIDX); const float* GATE = (const float*)(ws + WS_GATE);
    const float* SU = (const float*)(ws + WS_SU); const float* SV = (const float*)(ws + WS_SV); float* PW = (float*)(ws + WS_PW);
    for (int i = F.vcu * 512 + (F.wave * 64 + lane_id()); i < M * 128; i += F.G * 512) { const int t = i >> 7, p = i & 127; float d = 0.f;
#pragma unroll
        for (int sl = 0; sl < 8; ++sl) d += PD[((size_t)t * 8 + sl) * 128 + p];
        const int e = EIDX[i]; d *= SU[e];
        PW[i] = GATE[i] * 0.5f * d * (1.f + erff(d * 0.70710678118654752f)) * SV[e]; }
}
__device__ __forceinline__ void peer_n_phase(Frame& F, const Args& a) {
    unsigned char* ws = a.ws; const GAS bf16* Y = (const GAS bf16*)(ws + WS_HB); GAS float* O = (GAS float*)a.out; const GAS float* gf = (const GAS float*)a.in[15]; const GAS float* SSQ2 = (const GAS float*)(ws + WS_SSQ2); const int lane = lane_id();
    f32x4 g0[4], g1[4];
#pragma unroll
    for (int j = 0; j < 4; ++j) { g0[j] = *(const GAS f32x4*)(gf + 512 * j + 8 * lane); g1[j] = *(const GAS f32x4*)(gf + 512 * j + 8 * lane + 4); }
    const int gw = F.vcu * NWAVES + F.wave, NGW = F.G * NWAVES;
    v4u yw[4], yn[4]; f32x4 s0, s1, n0, n1;
    if (gw < M) {
#pragma unroll
        for (int j = 0; j < 4; ++j) yw[j] = *(const GAS v4u*)(Y + (size_t)gw * DM + 512 * j + 8 * lane);
        s0 = *(const GAS f32x4*)(SSQ2 + (size_t)gw * 8); s1 = *(const GAS f32x4*)(SSQ2 + (size_t)gw * 8 + 4); }
    for (int m = gw; m < M; m += NGW) { const int mn = m + NGW < M ? m + NGW : m;
#pragma unroll
        for (int j = 0; j < 4; ++j) yn[j] = *(const GAS v4u*)(Y + (size_t)mn * DM + 512 * j + 8 * lane);
        n0 = *(const GAS f32x4*)(SSQ2 + (size_t)mn * 8); n1 = *(const GAS f32x4*)(SSQ2 + (size_t)mn * 8 + 4);
        const float rf = 1.f / sqrtf((((s0.x + s0.y) + (s0.z + s0.w)) + ((s1.x + s1.y) + (s1.z + s1.w))) * (1.f / DM) + EPS);
#pragma unroll
        for (int j = 0; j < 4; ++j) {
            *(GAS f32x4*)(O + (size_t)m * DM + 512 * j + 8 * lane) = (f32x4){bflo(yw[j].x) * rf * g0[j].x, bfhi(yw[j].x) * rf * g0[j].y, bflo(yw[j].y) * rf * g0[j].z, bfhi(yw[j].y) * rf * g0[j].w};
            *(GAS f32x4*)(O + (size_t)m * DM + 512 * j + 8 * lane + 4) = (f32x4){bflo(yw[j].z) * rf * g1[j].x, bfhi(yw[j].z) * rf * g1[j].y, bflo(yw[j].w) * rf * g1[j].z, bfhi(yw[j].w) * rf * g1[j].w}; }
#pragma unroll
        for (int j = 0; j < 4; ++j) yw[j] = yn[j];
        s0 = n0; s1 = n1; }
}

__global__ void __launch_bounds__(NWAVES * 64, 2) mk_fwd(Args args_in) {
    extern __shared__ __attribute__((aligned(16))) unsigned char lds[];
    Args args = args_in;
#pragma unroll
    for (int i = 0; i < 16; ++i) args.in[i] = (const float*)(const GAS float*)args_in.in[i];
    args.out = (float*)(GAS float*)args_in.out; args.ws = (unsigned char*)(GAS unsigned char*)args_in.ws;
    Frame F;
    F.lds = (LAS unsigned char*)lds;
    F.MISC = (volatile LAS unsigned*)(F.lds + MISC_OFF);
    F.wave = __builtin_amdgcn_readfirstlane((int)threadIdx.x >> 6);
    F.G = gridDim.x; { const int bx = blockIdx.x; F.vcu = (F.G % 8 == 0) ? (bx % 8) * (F.G / 8) + bx / 8 : bx; }
    unsigned char* ws = args.ws;
    F.ctl = (gu32*)(ws + WS_CTL);
    for (int u = (F.wave * 64 + lane_id()); u < (LDS_BYTES - LDSCTL_OFF) / 4; u += NWAVES * 64) ((LAS unsigned*)(F.lds + LDSCTL_OFF))[u] = 0u;
    __syncthreads();
    XcdBarrier bar = xcd_barrier_post((unsigned*)(F.ctl + CW_BAR) + args.li * XCD_BAR_WORDS, F.MISC + 8);
    const int lo = args.ph_lo, hi = args.ph_hi;
#define IN(k) (lo <= (k) && (k) < hi)
#define BOTH(k) (IN(k) && IN((k) + 1))
#define GRID_BAR() xcd_barrier(bar)

    if (IN(0)) { for (int rep = 0; rep < NREP(0); ++rep) p0_prologue(F, args); if (BOTH(0)) GRID_BAR(); }

    if (IN(1)) {
        pg8::Gemm g{(const bf16*)(ws + WS_XN), (const bf16*)(ws + WS_WIN), M, NINP, DM}; pg8::StaticOrder S; S.init(M, NINP, F.G, (int)blockIdx.x);
        pg8::EpiBf16<0> E{(bf16*)(ws + WS_PROJ), NINP, nullptr, 0, 0, 1.f};
        for (int rep = 0; rep < NREP(1); ++rep) pg8::gemm_phase<pg8::EpiBf16<0>, pg8::StaticOrder, PG8_ALIGN, PG8_SP2>(F.lds + RING_OFF, g, S, E);
        for (int rep = 0; rep < NREP(11); ++rep) gd_side_gemm(F, args);
        if (BOTH(1)) GRID_BAR();
    }
    if (IN(2)) {
        for (int rep = 0; rep < NREP(21); ++rep) gla_prep_phase(F, args);
        GRID_BAR();
        for (int rep = 0; rep < NREP(2); ++rep) gla_seq_phase(F, args);
        for (int rep = 0; rep < NREP(20); ++rep) attn_phase(F, args, rep);
        for (int rep = 0; rep < NREP(40); ++rep) peer_convert_tables(F, args, rep);
        if (BOTH(2)) GRID_BAR(); }
    if (IN(3)) { for (int rep = 0; rep < NREP(3); ++rep) p3_finalize(F, args); if (BOTH(3)) GRID_BAR(); if (REP_PHASE == 99) { GRID_BAR(); GRID_BAR(); GRID_BAR(); GRID_BAR(); } }
    if (IN(4)) {
        pg8::Gemm g{(const bf16*)(ws + WS_XN), (const bf16*)(ws + WS_WOUT), M, DM, DM}; pg8::StaticOrder S; S.init(M, DM, F.G, (int)blockIdx.x);
        pg8::EpiRes E{args.in[0], (bf16*)(ws + WS_HB), (float*)(ws + WS_SSQ), DM};
        for (int rep = 0; rep < NREP(4); ++rep) pg8::gemm_phase<pg8::EpiRes, pg8::StaticOrder, PG8_ALIGN23, PG8_SP2>(F.lds + RING_OFF, g, S, E);
        if (BOTH(4)) GRID_BAR();
    }
    if (IN(5)) {
        pg8::Gemm g{(const bf16*)(ws + WS_HB), (const bf16*)(ws + WS_WQ), M, DM, DM}; pg8::StaticOrder S; S.init(M, DM, F.G, (int)blockIdx.x);
        pg8::EpiBf16<0> E{(bf16*)(ws + WS_XN), DM, nullptr, 0, 0, 1.f};
        for (int rep = 0; rep < NREP(5); ++rep) pg8::gemm_phase<pg8::EpiBf16<0>, pg8::StaticOrder, PG8_ALIGN23, PG8_SP2>(F.lds + RING_OFF, g, S, E);
        if (BOTH(5)) GRID_BAR();
    }
    if (IN(6)) { for (int rep = 0; rep < NREP(6); ++rep) topk_phase(F, args); if (BOTH(6)) GRID_BAR(); }
    if (IN(7)) {
        for (int rep = 0; rep < NREP(7); ++rep) peer_uv_phase<false, 16, true>(F, args);
        GRID_BAR();
        peer_w_phase(F, args);
        GRID_BAR();
        if (REP_PHASE != 8) peer_uv_phase<true, 8, true>(F, args);
        GRID_BAR();
        peer_n_phase(F, args);
    }
#undef IN
#undef BOTH
}


extern "C" void kernel_launch(void* const* d_in, const int* in_sizes, int n_in, void* d_out, int out_size, void* d_ws, size_t ws_size, hipStream_t stream) {
    static int grid = 0;
    if (grid == 0) {
        if (n_in != 16 || in_sizes[0] != M * DM || out_size != M * DM || ws_size < WS_END) { fprintf(stderr, "kernel_launch: unexpected shapes: n_in %d in0 %d out %d ws %zu\n", n_in, n_in > 0 ? in_sizes[0] : -1, out_size, ws_size); grid = -1; return; }
        int dev = 0, cus = 0;
        if (hipGetDevice(&dev) != hipSuccess || hipDeviceGetAttribute(&cus, hipDeviceAttributeMultiprocessorCount, dev) != hipSuccess) { grid = -1; return; }
        if (hipFuncSetAttribute((const void*)mk_fwd, hipFuncAttributeMaxDynamicSharedMemorySize, LDS_BYTES) != hipSuccess) { fprintf(stderr, "kernel_launch: hipFuncSetAttribute failed\n"); grid = -1; return; }
        (void)hipGetLastError();
        grid = cus;
    }
    if (grid < 0) return;
    (void)hipMemsetAsync((char*)d_ws + WS_CTL, 0, CTL_ZERO_BYTES, stream);
    Args a{};
    for (int i = 0; i < 16; ++i) a.in[i] = (const float*)d_in[i];
    a.out = (float*)d_out; a.ws = (unsigned char*)d_ws;
    a.ph_lo = 0; a.ph_hi = 8; a.li = 0;
    hipLaunchKernelGGL(mk_fwd, dim3(grid), dim3(NWAVES * 64), LDS_BYTES, stream, a);
}
```

```cpp
#define REP_PHASE -1

#include <hip/hip_runtime.h>
#include <cstdio>
#include <cstdint>
#include <cmath>
#ifndef REP_PHASE
#define REP_PHASE -1
#endif
#define NREP(k) ((REP_PHASE == (k)) ? 2 : 1)
namespace pg8 {
#define PG8_LAS __attribute__((address_space(3)))
typedef unsigned short bf16_t;
typedef short bf16x8 __attribute__((ext_vector_type(8)));
typedef float f32x4 __attribute__((ext_vector_type(4)));
typedef unsigned u32x4 __attribute__((ext_vector_type(4)));
constexpr int BM = 256, BK = 64, HALF = 128, HTB = HALF * BK * 2  , STAGE_BYTES = 8 * HTB, NXCD = 8, WGM = 8;

__host__ __device__ __forceinline__ int lds_byte(int r, int c) { const int st = (r >> 4) * 2 + (c >> 5), rr = r & 15, cc = c & 31, ob = rr * 64 + cc * 2; return st * 1024 + (ob ^ (((ob >> 9) & 1) << 5)); }
__host__ __device__ __forceinline__ void stage_rc(int b, int& R, int& C) { const int st = b / 1024, sb = b % 1024, swz = sb ^ (((sb >> 9) & 1) << 5); R = (st >> 1) * 16 + swz / 64; C = (st & 1) * 32 + (swz % 64) / 2; }
__host__ __device__ __forceinline__ int perm32(int rho) { const int n = rho >> 4, i = rho & 15; return 8 * (i >> 2) + 4 * n + (i & 3); }

struct Unit { int pm, pn; };
struct Gemm { const bf16_t* A; const bf16_t* Bt; int M, N, K; };

struct StaticOrder {
    int nM, nN, nwg, G, c;
    __host__ __device__ void init(int M, int N, int G_, int c_) { nM = M / BM; nN = N / BM; nwg = nM * nN; G = G_; c = c_; }
    __host__ __device__ bool next(int i, Unit& u) const {
        const long L = (long)i * G + c; if (L >= nwg) return false;
        int wgid = (int)L; { const int q = nwg / NXCD, r = nwg % NXCD, xcd = wgid % NXCD, off = wgid / NXCD; wgid = (xcd < r ? xcd * (q + 1) : r * (q + 1) + (xcd - r) * q) + off; }
        const int nig = WGM * nN, gid = wgid / nig, fm = gid * WGM, gsz = (nM - fm) < WGM ? (nM - fm) : WGM;
        u.pm = fm + ((wgid % nig) % gsz); u.pn = (wgid % nig) / gsz; return true;
    }
    __device__ __forceinline__ void a_ready(const Unit&) const {}
    __device__ __forceinline__ void done(const Unit&) const {}
};

__device__ __forceinline__ unsigned cvt_pk_bf16(float lo, float hi) { unsigned r; asm volatile("v_cvt_pk_bf16_f32 %0, %1, %2" : "=v"(r) : "v"(lo), "v"(hi)); return r; }
typedef float f32x2 __attribute__((ext_vector_type(2)));
__device__ __forceinline__ f32x2 gelu_pk(f32x2 v) {
    const f32x2 av = __builtin_elementwise_abs(v), d = av * 0.2316418882f + 1.0f;
    f32x2 t; t.x = __builtin_amdgcn_rcpf(d.x); t.y = __builtin_amdgcn_rcpf(d.y);
    f32x2 q = t * 0.5307027145f + (-0.7265760135f); q = q * t + 0.7107068705f; q = q * t + (-0.142248368f); q = q * t + 0.127414796f; q = q * t;
    const f32x2 s = (v * v) * (-0.72134752044f);
    f32x2 e; e.x = __builtin_amdgcn_exp2f(s.x); e.y = __builtin_amdgcn_exp2f(s.y);
    const f32x2 m = v * (q * e), r = v - m;
    f32x2 o; o.x = v.x < 0.f ? m.x : r.x; o.y = v.y < 0.f ? m.y : r.y; return o;
}

template <int ACT  > struct EpiBf16 {
    static constexpr bool PERM = true, AFTER_DRAIN = false; static_assert(ACT == 0 || ACT == 1, "EpiBf16: ACT is 0 (none) or 1 (gelu_pk)");
    bf16_t* O; int ldc; const float* bias; int split_cols; size_t split_stride; float scale0;
    __device__ __forceinline__ void operator()(const f32x4 (&acc)[2][2][4][2], const Unit& u, int wr, int wc, int fr, int fq) const {
        const int row0 = u.pm * BM + wr * 64 + fr; int colt = u.pn * BM; bf16_t* base = O;
        float sc = 1.f; if (split_cols) { const int t = colt / split_cols; base += (size_t)t * split_stride; colt -= t * split_cols; if (t == 0) sc = scale0; }
        const int col0 = colt + wc * 32 + 8 * fq, bcol0 = u.pn * BM + wc * 32 + 8 * fq;
        f32x4 bv[2][2];
#pragma unroll
        for (int bj = 0; bj < 2; ++bj)
#pragma unroll
            for (int n = 0; n < 2; ++n) bv[bj][n] = bias ? *(const f32x4*)(bias + bcol0 + bj * HALF + 4 * n) : (f32x4){0.f, 0.f, 0.f, 0.f};
#pragma unroll
        for (int ai = 0; ai < 2; ++ai)
#pragma unroll
            for (int m = 0; m < 4; ++m) { bf16_t* rowp = base + (size_t)(row0 + ai * HALF + m * 16) * ldc + col0;
#pragma unroll
                for (int bj = 0; bj < 2; ++bj) { f32x4 v0 = acc[ai][bj][m][0] + bv[bj][0], v1 = acc[ai][bj][m][1] + bv[bj][1];
                    if (ACT == 1) { f32x2 a = gelu_pk((f32x2){v0[0], v0[1]}), b = gelu_pk((f32x2){v0[2], v0[3]}), c = gelu_pk((f32x2){v1[0], v1[1]}), d = gelu_pk((f32x2){v1[2], v1[3]});
                        v0 = (f32x4){a.x, a.y, b.x, b.y}; v1 = (f32x4){c.x, c.y, d.x, d.y}; }
                    v0 = v0 * sc; v1 = v1 * sc; u32x4 w; w.x = cvt_pk_bf16(v0[0], v0[1]); w.y = cvt_pk_bf16(v0[2], v0[3]); w.z = cvt_pk_bf16(v1[0], v1[1]); w.w = cvt_pk_bf16(v1[2], v1[3]);
                    *(u32x4*)(rowp + bj * HALF) = w; } }
    }
};
template <class Epi, class Sched, bool ALIGN_EPI = false, bool SP2 = false>
__device__ __forceinline__ void gemm_phase(PG8_LAS unsigned char* lds, const Gemm g, const Sched& S, const Epi& E) {
    const int tid = threadIdx.x, wid = __builtin_amdgcn_readfirstlane(tid >> 6), lane = tid & 63, wr = wid >> 2, wc = wid & 3, fr = lane & 15, fq = lane >> 4;
    const int K = g.K, nt = K / BK;
    unsigned voffA[2], voffB[2];
#pragma unroll
    for (int i = 0; i < 2; ++i) { int R, C; stage_rc(tid * 16 + i * 8192, R, C); const int Rb = Epi::PERM ? ((R & ~31) + perm32(R & 31)) : R;
        voffA[i] = (unsigned)(R * K + C) * 2u; voffB[i] = (unsigned)(Rb * K + C) * 2u; }
    const size_t kstep = (size_t)(BK * 2);
    const size_t hstep = (size_t)HALF * K * 2;
    const size_t tstep = 2 * hstep;
    const unsigned ldsw = (unsigned)wid * 1024u;
    const int aoff = lds_byte(wr * 64 + fr, fq * 8), boff = lds_byte(wc * 32 + fr, fq * 8);
#define PG8_SA(b, h) (((b) * 2 + (h)) * HTB)
#define PG8_SB(b, h) ((4 + (b) * 2 + (h)) * HTB)
#define PG8_STAGE(bufoff, gbase, voff) do { _Pragma("unroll") for (int _i = 0; _i < 2; ++_i) \
        __builtin_amdgcn_global_load_lds((const unsigned*)((const char*)(gbase) + (voff)[_i]), (PG8_LAS unsigned*)(lds + (bufoff) + ldsw + _i * 8192), 16, 0, 0); } while (0)
#define PG8_LDA(dst, b, h) do { _Pragma("unroll") for (int m = 0; m < 4; ++m) _Pragma("unroll") for (int k = 0; k < 2; ++k) dst[m][k] = *(const PG8_LAS bf16x8*)(lds + PG8_SA(b, h) + aoff + m * 2048 + k * 1024); } while (0)
#define PG8_LDB(dst, b, h) do { _Pragma("unroll") for (int n = 0; n < 2; ++n) _Pragma("unroll") for (int k = 0; k < 2; ++k) dst[n][k] = *(const PG8_LAS bf16x8*)(lds + PG8_SB(b, h) + boff + n * 2048 + k * 1024); } while (0)
#define PG8_MMA(ai, bj, At, Bt) do { __builtin_amdgcn_s_setprio(1); _Pragma("unroll") for (int m = 0; m < 4; ++m) _Pragma("unroll") for (int n = 0; n < 2; ++n) _Pragma("unroll") for (int k = 0; k < 2; ++k) \
        acc[ai][bj][m][n] = __builtin_amdgcn_mfma_f32_16x16x32_bf16(Bt[n][k], At[m][k], acc[ai][bj][m][n], 0, 0, 0); __builtin_amdgcn_s_setprio(0); } while (0)
#define PG8_WAIT_V(n) asm volatile("s_waitcnt vmcnt(" #n ")" ::: "memory")
#define PG8_WAIT_L(n) asm volatile("s_waitcnt lgkmcnt(" #n ")" ::: "memory")
#define PG8_BAR __builtin_amdgcn_s_barrier()
#define PG8_SCHED __builtin_amdgcn_sched_barrier(0)
    Unit cur, nxt; int ui = 0;
    if (!S.next(0, cur)) return;
    f32x4 acc[2][2][4][2];
#pragma unroll
    for (int a = 0; a < 2; ++a)
#pragma unroll
        for (int b = 0; b < 2; ++b)
#pragma unroll
            for (int m = 0; m < 4; ++m)
#pragma unroll
                for (int n = 0; n < 2; ++n) acc[a][b][m][n] = (f32x4){0.f, 0.f, 0.f, 0.f};
    bf16x8 At[4][2], B0[2][2], B1[2][2];
    const char* cA = (const char*)g.A + (size_t)cur.pm * tstep; const char* cB = (const char*)g.Bt + (size_t)cur.pn * tstep;
    S.a_ready(cur);
    if constexpr (SP2) {
        PG8_STAGE(PG8_SB(0, 0), cB, voffB); PG8_STAGE(PG8_SB(0, 1), cB + hstep, voffB); PG8_STAGE(PG8_SA(0, 0), cA, voffA); PG8_STAGE(PG8_SA(0, 1), cA + hstep, voffA);
        if (wr == 1) PG8_BAR;
        PG8_WAIT_V(2); PG8_BAR;
        PG8_STAGE(PG8_SB(1, 0), cB + kstep, voffB); PG8_STAGE(PG8_SA(1, 0), cA + kstep, voffA); PG8_STAGE(PG8_SB(1, 1), cB + hstep + kstep, voffB);
        PG8_WAIT_V(6); PG8_BAR;
    } else {
        PG8_STAGE(PG8_SB(0, 0), cB, voffB); PG8_STAGE(PG8_SA(0, 0), cA, voffA); PG8_STAGE(PG8_SB(0, 1), cB + hstep, voffB); PG8_STAGE(PG8_SA(0, 1), cA + hstep, voffA);
        if (wr == 1) PG8_BAR;
        PG8_WAIT_V(4); PG8_BAR;
        PG8_STAGE(PG8_SB(1, 0), cB + kstep, voffB); PG8_STAGE(PG8_SA(1, 0), cA + kstep, voffA); PG8_STAGE(PG8_SB(1, 1), cB + hstep + kstep, voffB);
        PG8_WAIT_V(6); PG8_BAR;
    }
    for (;;) {
        const bool has_next = S.next(ui + 1, nxt);
        const char* nA = has_next ? (const char*)g.A + (size_t)nxt.pm * tstep : cA; const char* nB = has_next ? (const char*)g.Bt + (size_t)nxt.pn * tstep : cB;
        for (int t = 0; t < nt; t += 2) {
            const bool last = (t == nt - 2);
            const char* a1 = cA + (size_t)(t + 1) * kstep;
            const char* a2 = last ? nA : cA + (size_t)(t + 2) * kstep; const char* b2 = last ? nB : cB + (size_t)(t + 2) * kstep;
            const char* a3 = a2 + kstep; const char* b3 = b2 + kstep;
            if (last && has_next) S.a_ready(nxt);
            if constexpr (SP2) {
            PG8_LDB(B0, 0, 0); PG8_LDB(B1, 0, 1); PG8_SCHED; PG8_LDA(At, 0, 0); PG8_STAGE(PG8_SA(1, 1), a1 + hstep, voffA);
            PG8_WAIT_V(8); PG8_WAIT_L(0); PG8_BAR; PG8_MMA(0, 0, At, B0); PG8_MMA(0, 1, At, B1); PG8_BAR; PG8_SCHED;
            PG8_LDA(At, 0, 1); PG8_STAGE(PG8_SB(0, 0), b2, voffB); PG8_STAGE(PG8_SB(0, 1), b2 + hstep, voffB); PG8_STAGE(PG8_SA(0, 0), a2, voffA);
            PG8_WAIT_V(8); PG8_WAIT_L(0); PG8_BAR; PG8_MMA(1, 0, At, B0); PG8_MMA(1, 1, At, B1); PG8_BAR; PG8_SCHED;
            PG8_LDB(B0, 1, 0); PG8_LDB(B1, 1, 1); PG8_SCHED; PG8_LDA(At, 1, 0); PG8_STAGE(PG8_SA(0, 1), a2 + hstep, voffA);
            PG8_WAIT_V(8); PG8_WAIT_L(0); PG8_BAR; PG8_MMA(0, 0, At, B0); PG8_MMA(0, 1, At, B1); PG8_BAR; PG8_SCHED;
            PG8_LDA(At, 1, 1); PG8_STAGE(PG8_SB(1, 0), b3, voffB); PG8_STAGE(PG8_SB(1, 1), b3 + hstep, voffB); PG8_STAGE(PG8_SA(1, 0), a3, voffA);
            PG8_WAIT_V(8); PG8_WAIT_L(0); PG8_BAR; PG8_MMA(1, 0, At, B0); PG8_MMA(1, 1, At, B1); PG8_BAR; PG8_SCHED;
            } else {
            PG8_LDB(B0, 0, 0); PG8_SCHED; PG8_LDA(At, 0, 0); PG8_STAGE(PG8_SA(1, 1), a1 + hstep, voffA);
            PG8_WAIT_L(8); PG8_BAR; PG8_WAIT_L(0); PG8_MMA(0, 0, At, B0); PG8_BAR; PG8_SCHED;
            PG8_LDB(B1, 0, 1); PG8_STAGE(PG8_SB(0, 0), b2, voffB);
            PG8_BAR; PG8_WAIT_L(0); PG8_MMA(0, 1, At, B1); PG8_BAR;
            PG8_LDA(At, 0, 1); PG8_STAGE(PG8_SA(0, 0), a2, voffA);
            PG8_BAR; PG8_WAIT_L(0); PG8_MMA(1, 0, At, B0); PG8_BAR; PG8_SCHED;
            PG8_STAGE(PG8_SB(0, 1), b2 + hstep, voffB);
            PG8_WAIT_V(6); PG8_BAR; PG8_MMA(1, 1, At, B1); PG8_BAR;
            PG8_LDB(B0, 1, 0); PG8_SCHED; PG8_LDA(At, 1, 0); PG8_STAGE(PG8_SA(0, 1), a2 + hstep, voffA);
            PG8_WAIT_L(8); PG8_BAR; PG8_WAIT_L(0); PG8_MMA(0, 0, At, B0); PG8_BAR; PG8_SCHED;
            PG8_LDB(B1, 1, 1); PG8_STAGE(PG8_SB(1, 0), b3, voffB);
            PG8_BAR; PG8_WAIT_L(0); PG8_MMA(0, 1, At, B1); PG8_BAR;
            PG8_LDA(At, 1, 1); PG8_STAGE(PG8_SA(1, 0), a3, voffA);
            PG8_BAR; PG8_WAIT_L(0); PG8_MMA(1, 0, At, B0); PG8_BAR; PG8_SCHED;
            PG8_STAGE(PG8_SB(1, 1), b3 + hstep, voffB);
            PG8_WAIT_V(6); PG8_BAR; PG8_MMA(1, 1, At, B1); PG8_BAR;
            }
        }
        if constexpr (ALIGN_EPI) { if (wr == 0) PG8_BAR; }
        if constexpr (!Epi::AFTER_DRAIN) { E(acc, cur, wr, wc, fr, fq); S.done(cur); }
        if (!has_next) break;
#pragma unroll
        for (int a = 0; a < 2; ++a)
#pragma unroll
            for (int b = 0; b < 2; ++b)
#pragma unroll
                for (int m = 0; m < 4; ++m)
#pragma unroll
                    for (int n = 0; n < 2; ++n) acc[a][b][m][n] = (f32x4){0.f, 0.f, 0.f, 0.f};
        cur = nxt; cA = nA; cB = nB; ++ui;
        if constexpr (ALIGN_EPI) { if (wr == 1) PG8_BAR; }
    }
    PG8_WAIT_V(0);
    if constexpr (!ALIGN_EPI) { if (wr == 0) PG8_BAR; }
    PG8_BAR;
    if constexpr (Epi::AFTER_DRAIN) { E.fused(acc, cur, wr, wc, fr, fq, lds, wid, lane); S.done(cur); }
#undef PG8_SA
#undef PG8_SB
#undef PG8_STAGE
#undef PG8_LDA
#undef PG8_LDB
#undef PG8_MMA
#undef PG8_WAIT_V
#undef PG8_WAIT_L
#undef PG8_BAR
#undef PG8_SCHED
}
}

#ifndef PG8_SP2
#define PG8_SP2 true
#endif
#ifndef PG8_ALIGN
#define PG8_ALIGN true
#endif
#define GAS __attribute__((address_space(1)))
#define LAS __attribute__((address_space(3)))
typedef unsigned short bf16;
typedef unsigned v4u __attribute__((ext_vector_type(4)));
typedef float f32x4 __attribute__((ext_vector_type(4)));
typedef short bf16x8 __attribute__((ext_vector_type(8)));
typedef GAS unsigned gu32;
typedef GAS unsigned long long gu64;
#define RLX_AGENT __ATOMIC_RELAXED, __HIP_MEMORY_SCOPE_AGENT
#define LDS_WAIT() asm volatile("s_waitcnt lgkmcnt(0)" ::: "memory")
#define VM_WAIT() asm volatile("s_waitcnt vmcnt(0)" ::: "memory")
__device__ __forceinline__ unsigned long long rt() { return __builtin_amdgcn_s_memrealtime(); }
__device__ __forceinline__ unsigned f2bf(float f) { unsigned u = __builtin_bit_cast(unsigned, f); return (u + 0x7fffu + ((u >> 16) & 1u)) >> 16; }
typedef float pk2_f32x2 __attribute__((ext_vector_type(2))); typedef __bf16 pk2_bf16x2 __attribute__((ext_vector_type(2)));
__device__ __forceinline__ unsigned pk2(float lo, float hi) { pk2_f32x2 v = {lo, hi}; pk2_bf16x2 b = __builtin_convertvector(v, pk2_bf16x2); return __builtin_bit_cast(unsigned, b); }

#define XB_TMO      128
#define XB_XCNT(j)  (256  + 64 * (j))
#define XB_XSUB(j)  (1280 + 64 * (j))
#define XB_XGEN(j)  (2304 + 64 * (j))
#define XB_TOP      3328
#define XB_TOPGEN   3392
#define XCD_BAR_WORDS 3456
#define XB_SPIN_CAP (1u << 18)

__device__ __forceinline__ unsigned xb_ld(unsigned* p)              { return __hip_atomic_load(p, __ATOMIC_RELAXED, __HIP_MEMORY_SCOPE_AGENT); }
__device__ __forceinline__ unsigned xb_add(unsigned* p, unsigned v) { return __hip_atomic_fetch_add(p, v, __ATOMIC_RELAXED, __HIP_MEMORY_SCOPE_AGENT); }
__device__ __forceinline__ unsigned xb_xcc_id() { return (unsigned)__builtin_amdgcn_s_getreg((3 << 11) | 20) & 0xFu; }
#define XB_SPIN(cond, bar) do { unsigned _sp = 0; while (cond) { __builtin_amdgcn_s_sleep(1); \
    if ((++_sp & 255u) == 0u) { if (xb_ld(&(bar)[XB_TMO])) break; if (_sp > XB_SPIN_CAP) { atomicAdd(&(bar)[XB_TMO], 1u); break; } } } } while (0)

struct XcdBarrier {
    unsigned* bar; unsigned x;
    volatile LAS unsigned* st;
};

__device__ __forceinline__ XcdBarrier xcd_barrier_post(unsigned* bar, volatile LAS unsigned* st) {
    XcdBarrier b; b.bar = bar; b.x = xb_xcc_id(); b.st = st;
    if (threadIdx.x == 0) (void)xb_add(&bar[XB_XCNT(b.x)], 1u);
    return b;
}
__device__ __forceinline__ void xcd_barrier_complete(unsigned* bar, unsigned x, unsigned& nloc, unsigned& nx) {
    const unsigned G = gridDim.x * gridDim.y * gridDim.z;
    unsigned sum, cnt, mine, sp = 0u;
    for (;;) {
        sum = 0u; cnt = 0u; mine = 0u;
#pragma unroll
        for (unsigned j = 0; j < 16; ++j) { const unsigned c = xb_ld(&bar[XB_XCNT(j)]); sum += c; cnt += (c > 0u) ? 1u : 0u; mine = (j == x) ? c : mine; }
        if (sum == G) break;
        __builtin_amdgcn_s_sleep(1);
        if ((++sp & 255u) == 0u) { if (xb_ld(&bar[XB_TMO])) break; if (sp > XB_SPIN_CAP) { atomicAdd(&bar[XB_TMO], 1u); break; } }
    }
    nloc = mine > 0u ? mine : 1u; nx = cnt > 0u ? cnt : 1u;
}

__device__ __forceinline__ void xcd_barrier(const XcdBarrier& b) {
    asm volatile("s_waitcnt vmcnt(0)" ::: "memory");
    __syncthreads();
    if (threadIdx.x == 0) {
        unsigned* bar = b.bar;
        __builtin_amdgcn_s_waitcnt(0);
        unsigned nloc = b.st[0], nx = b.st[1];
        if (nloc == 0u) { xcd_barrier_complete(bar, b.x, nloc, nx); b.st[0] = nloc; b.st[1] = nx; }
        const unsigned old = xb_add(&bar[XB_XSUB(b.x)], 1u);
        const unsigned gen = old / nloc;
        if (old + 1u == (gen + 1u) * nloc) {
            __builtin_amdgcn_fence(__ATOMIC_RELEASE, "agent");
            asm volatile("s_waitcnt vmcnt(0)" ::: "memory");
            const unsigned og = xb_add(&bar[XB_TOP], 1u);
            const unsigned tg = og / nx;
            if (og + 1u == (tg + 1u) * nx) xb_add(&bar[XB_TOPGEN], 1u);
            else XB_SPIN(xb_ld(&bar[XB_TOPGEN]) == tg, bar);
            __builtin_amdgcn_fence(__ATOMIC_ACQUIRE, "agent");
            xb_add(&bar[XB_XGEN(b.x)], 1u);
            asm volatile("s_waitcnt vmcnt(0)" ::: "memory");
        } else {
            XB_SPIN(xb_ld(&bar[XB_XGEN(b.x)]) == gen, bar);
            __builtin_amdgcn_fence(__ATOMIC_ACQUIRE, "agent");
            asm volatile("s_waitcnt vmcnt(0)" ::: "memory");
        }
    }
    __syncthreads();
}


constexpr int NWAVES = 8;
constexpr int DM = 2048, BATCH = 4, SEQ = 4096, M = BATCH * SEQ;
constexpr int NIN = 6176, NINP = 6144;
constexpr int O_GQ = 0, O_GK = 512, O_GV = 1024, O_GR = 2048, O_AQ = 3072, O_AK = 4096, O_AV = 5120;
constexpr float EPS = 1e-6f;
constexpr int PEER_K = 128;

constexpr size_t MiB = 1u << 20;
constexpr size_t WS_CTL = 0, CTL_ZERO_BYTES = 1 * MiB;
constexpr size_t WS_WIN = 1 * MiB;
constexpr size_t WS_WGD = 25 * MiB;
constexpr size_t WS_GDB = 62 * MiB;
constexpr size_t WS_WOUT = 26 * MiB;
constexpr size_t WS_WQ = 34 * MiB;
constexpr size_t WS_SSQ = 42 * MiB;
constexpr size_t WS_EIDX = 44 * MiB;
constexpr size_t WS_GATE = 52 * MiB;
constexpr size_t WS_SKB = 60 * MiB;
constexpr size_t WS_XN = 64 * MiB;
constexpr size_t WS_PROJ = 128 * MiB;
constexpr size_t WS_HB = 256 * MiB;
constexpr size_t WS_OF = 328 * MiB;
constexpr size_t WS_OB = 360 * MiB;
constexpr size_t WS_ATTP = 392 * MiB;
constexpr size_t WS_ATTML = 488 * MiB;
constexpr size_t WS_GT_QD = 64 * MiB;
constexpr size_t WS_GT_KE = 96 * MiB;
constexpr size_t OUT_GT_AM = 0;
constexpr size_t OUT_GT_DEC = 16 * MiB;
constexpr size_t OUT_GT_VT = 32 * MiB;
constexpr int CW_ATTQ = 64;
constexpr size_t WS_END = 494 * MiB;
constexpr size_t OUT_U8 = 64 * MiB;
constexpr size_t OUT_V8 = 96 * MiB;
constexpr size_t WS_SU = 61 * MiB;
constexpr size_t WS_SV = 61 * MiB + 65536;
constexpr int CW_CONVQ = 256;
constexpr size_t WS_PW = 128 * MiB;
constexpr size_t WS_SSQ2 = 136 * MiB;
constexpr size_t WS_PD = 64 * MiB;
constexpr int PEER_E = 16384;
constexpr int CW_TMO = 0, CW_CODE = 1, CW_BAR = 4096;

constexpr int RING_OFF = 0, RING_BYTES = 131072;
constexpr int LDS_BYTES = 163840;
constexpr int LDSCTL_OFF = LDS_BYTES - 1024, MISC_OFF = LDSCTL_OFF + 320;

typedef float f32x2 __attribute__((ext_vector_type(2)));
typedef float f32x16 __attribute__((ext_vector_type(16)));
typedef int i32x4 __attribute__((ext_vector_type(4)));
__device__ __forceinline__ float bf2f(unsigned short h) { return __builtin_bit_cast(float, (unsigned)h << 16); }
__device__ __forceinline__ float bflo(unsigned w) { return __builtin_bit_cast(float, w << 16); }
__device__ __forceinline__ float bfhi(unsigned w) { return __builtin_bit_cast(float, w & 0xffff0000u); }
__device__ __forceinline__ float wave_sum(float v) {
#pragma unroll
    for (int o = 1; o < 64; o <<= 1) v += __shfl_xor(v, o);
    return v;
}
__device__ __forceinline__ float wave_max(float v) {
#pragma unroll
    for (int o = 1; o < 64; o <<= 1) v = fmaxf(v, __shfl_xor(v, o));
    return v;
}

template <class T> __device__ __forceinline__ T* opaque(T* p) { asm volatile("" : "+s"(p)); return (T*)(GAS T*)p; }
__device__ __forceinline__ int lane_id() { int x; asm volatile("v_mbcnt_lo_u32_b32 %0, -1, 0\n\tv_mbcnt_hi_u32_b32 %0, -1, %0" : "=v"(x)); return x; }
__device__ __forceinline__ int opaque_v(int x) { asm volatile("" : "+v"(x)); return x; }
template <class T> __device__ __forceinline__ T ldu(const void* ubase, unsigned voff) { return *(const GAS T*)((const GAS char*)ubase + voff); }
template <class T> __device__ __forceinline__ void stu(void* ubase, unsigned voff, T v) { *(GAS T*)((GAS char*)ubase + voff) = v; }
namespace pg8 {
struct EpiRes {
    static constexpr bool PERM = true, AFTER_DRAIN = false;
    const float* x; bf16_t* HB; float* ssq; int ldc;
    __device__ __forceinline__ void operator()(const f32x4 (&acc)[2][2][4][2], const Unit& u, int wr, int wc, int fr, int fq) const {
        const int col0 = u.pn * BM + wc * 32 + 8 * fq;
#pragma unroll
        for (int ai = 0; ai < 2; ++ai)
#pragma unroll
            for (int m = 0; m < 4; ++m) {
                const int r = u.pm * BM + ai * HALF + wr * 64 + m * 16 + fr; const size_t off = (size_t)r * ldc + col0; float s = 0.f;
#pragma unroll
                for (int bj = 0; bj < 2; ++bj) {
                    const f32x4 h0 = *(const f32x4*)(x + off + bj * HALF) + acc[ai][bj][m][0], h1 = *(const f32x4*)(x + off + bj * HALF + 4) + acc[ai][bj][m][1];
                    s += ((h0[0] * h0[0] + h0[1] * h0[1]) + (h0[2] * h0[2] + h0[3] * h0[3])) + ((h1[0] * h1[0] + h1[1] * h1[1]) + (h1[2] * h1[2] + h1[3] * h1[3]));
                    u32x4 w; w.x = cvt_pk_bf16(h0[0], h0[1]); w.y = cvt_pk_bf16(h0[2], h0[3]); w.z = cvt_pk_bf16(h1[0], h1[1]); w.w = cvt_pk_bf16(h1[2], h1[3]);
                    *(u32x4*)(HB + off + bj * HALF) = w;
                }
                s += __shfl_xor(s, 16); s += __shfl_xor(s, 32);
                if (fq == 0) ssq[(size_t)r * 32 + u.pn * 4 + wc] = s;
            }
    }
};
}

struct Frame {
    LAS unsigned char* lds;
    volatile LAS unsigned* MISC;
    gu32* ctl;
    int wave;
    int vcu, G;
};

__device__ __forceinline__ void p0_transpose_item(const float* W, int K, int ldw, const float* gk, bf16* WT, LAS float* scr, int item, int lane) {
    const int nblk = ldw / 32, kb = item / nblk, nb = item % nblk, k0 = 64 * kb, n0 = 32 * nb;
#pragma unroll 8
    for (int i = 0; i < 32; ++i) { const int kk = 2 * i + (lane >> 5); float w = W[(size_t)(k0 + kk) * ldw + n0 + (lane & 31)]; if (gk) w *= gk[k0 + kk]; scr[kk * 33 + (lane & 31)] = w; }
    LDS_WAIT(); asm volatile("" ::: "memory");
    const int c = lane & 7;
#pragma unroll
    for (int j = 0; j < 4; ++j) { const int n = (lane >> 3) + 8 * j; const LAS float* s = scr + (8 * c) * 33 + n;
        v4u o; o.x = pk2(s[0 * 33], s[1 * 33]); o.y = pk2(s[2 * 33], s[3 * 33]); o.z = pk2(s[4 * 33], s[5 * 33]); o.w = pk2(s[6 * 33], s[7 * 33]);
        *(GAS v4u*)(WT + (size_t)(n0 + n) * K + k0 + 8 * c) = o; }
    LDS_WAIT(); asm volatile("" ::: "memory");
}
struct Args {
    const float* in[16]; float* out; unsigned char* ws; int ph_lo, ph_hi, li, pad;
};

__device__ __forceinline__ void p0_prologue(Frame& F, const Args& a) {
    unsigned char* ws = a.ws;
    LAS float* scr = (LAS float*)(F.lds + RING_OFF + F.wave * 16384);
    const int gw = F.vcu * NWAVES + F.wave, NGW = F.G * NWAVES;
    bf16* Win_t = (bf16*)(ws + WS_WIN); bf16* Wout_t = (bf16*)(ws + WS_WOUT); bf16* Wq_t = (bf16*)(ws + WS_WQ); bf16* XN = (bf16*)(ws + WS_XN);
    constexpr int I_IN = (DM / 64) * (NIN / 32), I_SQ = (DM / 64) * (DM / 32);
    constexpr int NITEMS = I_IN + 2 * I_SQ;
    for (int it = gw; it < NITEMS; it += NGW) {
        int r = it;
        if (r < I_IN) { const int nb = r % (NIN / 32); bf16* dst = nb < 96 ? Win_t : nb == 96 ? (bf16*)(ws + WS_WGD) - (size_t)96 * 32 * DM : Win_t - (size_t)32 * DM;
            p0_transpose_item(a.in[2], DM, NIN, nullptr, dst, scr, r, lane_id()); continue; } r -= I_IN;
        if (r < I_SQ) { p0_transpose_item(a.in[9], DM, DM, nullptr, Wout_t, scr, r, lane_id()); continue; } r -= I_SQ;
        p0_transpose_item(a.in[11], DM, DM, a.in[10], Wq_t, scr, r, lane_id());
    }
    { const f32x4* sk = (const f32x4*)a.in[12]; unsigned long long* skb = (unsigned long long*)(ws + WS_SKB);
      for (int i = gw * 64 + lane_id(); i < 8 * 2 * 128 * 128 / 4; i += NGW * 64) { const f32x4 v = sk[i]; skb[i] = (unsigned long long)pk2(v.x, v.y) | ((unsigned long long)pk2(v.z, v.w) << 32); } }
    { const GAS f32x4* gr = (const GAS f32x4*)a.in[1] + lane_id(); f32x4 gg[8];
#pragma unroll
      for (int j = 0; j < 8; ++j) gg[j] = gr[64 * j];
      f32x4 v[8], vn[8];
      if (gw < M) {
#pragma unroll
          for (int j = 0; j < 8; ++j) v[j] = ((const GAS f32x4*)(a.in[0] + (size_t)gw * DM) + lane_id())[64 * j]; }
      for (int m = gw; m < M; m += NGW) { const int mn = m + NGW < M ? m + NGW : m;
#pragma unroll
          for (int j = 0; j < 8; ++j) vn[j] = ((const GAS f32x4*)(a.in[0] + (size_t)mn * DM) + lane_id())[64 * j];
          float ss = 0.f;
#pragma unroll
          for (int j = 0; j < 8; ++j) ss += (v[j].x * v[j].x + v[j].y * v[j].y) + (v[j].z * v[j].z + v[j].w * v[j].w);
          const float rstd = 1.f / sqrtf(wave_sum(ss) * (1.f / DM) + EPS);
          GAS unsigned long long* o8 = (GAS unsigned long long*)(XN + (size_t)m * DM) + lane_id();
#pragma unroll
          for (int j = 0; j < 8; ++j) o8[64 * j] = (unsigned long long)pk2(v[j].x * rstd * gg[j].x, v[j].y * rstd * gg[j].y) | ((unsigned long long)pk2(v[j].z * rstd * gg[j].z, v[j].w * rstd * gg[j].w) << 32);
#pragma unroll
          for (int j = 0; j < 8; ++j) v[j] = vn[j]; } }
}


__device__ __forceinline__ void gd_side_gemm(Frame& F, const Args& a) {
    unsigned char* ws = a.ws; const bf16* XN = (const bf16*)(ws + WS_XN); const bf16* WG = (const bf16*)(ws + WS_WGD); float* GDB = (float*)(ws + WS_GDB);
    const int lane = lane_id(), w = F.wave, r32 = lane & 31, hh = lane >> 5; LAS float* part = (LAS float*)F.lds;
    for (int blk = F.vcu; blk < M / 64; blk += F.G) { const int tok0 = blk * 64;
        f32x16 acc[2];
#pragma unroll
        for (int tt = 0; tt < 2; ++tt) acc[tt] = (f32x16){0.f, 0.f, 0.f, 0.f, 0.f, 0.f, 0.f, 0.f, 0.f, 0.f, 0.f, 0.f, 0.f, 0.f, 0.f, 0.f};
#pragma unroll 4
        for (int ks = 0; ks < 16; ++ks) { const int k0 = 256 * w + 16 * ks + 8 * hh; const bf16x8 bw = *(const bf16x8*)(WG + (size_t)r32 * DM + k0);
#pragma unroll
            for (int tt = 0; tt < 2; ++tt) { const bf16x8 ax = *(const bf16x8*)(XN + (size_t)(tok0 + 32 * tt + r32) * DM + k0); acc[tt] = __builtin_amdgcn_mfma_f32_32x32x16_bf16(ax, bw, acc[tt], 0, 0, 0); } }
#pragma unroll
        for (int tt = 0; tt < 2; ++tt)
#pragma unroll
            for (int r = 0; r < 16; ++r) { const float x = acc[tt][r]; part[((w * 2 + tt) * 16 + r) * 64 + lane] = x; }
        __syncthreads();
#pragma unroll
        for (int i = 0; i < 4; ++i) { const int o = (F.wave * 64 + lane_id()) + 512 * i; float sum = 0.f;
#pragma unroll
            for (int ww = 0; ww < 8; ++ww) sum += part[ww * 2048 + o];
            const int tt = o >> 10, r = (o >> 6) & 15, ln = o & 63; const int t = 32 * tt + (r & 3) + 8 * (r >> 2) + 4 * (ln >> 5);
            GDB[(size_t)(tok0 + t) * 32 + (ln & 31)] = sum; }
        __syncthreads();
    }
}

__device__ __forceinline__ void p3_finalize(Frame& F, const Args& a) {
    unsigned char* ws = a.ws;
    const int gw = F.vcu * NWAVES + F.wave, NGW = F.G * NWAVES, lane = lane_id();
    const GAS bf16* OFp = (const GAS bf16*)(ws + WS_OF); const GAS bf16* OBp = (const GAS bf16*)(ws + WS_OB);
    const GAS bf16* PROJ = (const GAS bf16*)(ws + WS_PROJ); GAS bf16* Y = (GAS bf16*)(ws + WS_XN);
    const GAS float* ATTML = (const GAS float*)(ws + WS_ATTML); const GAS bf16* ATTP = (const GAS bf16*)(ws + WS_ATTP);
    const GAS float* gla_g = (const GAS float*)a.in[7]; const GAS float* att_g = (const GAS float*)a.in[8];
    const f32x4 gg = *(const GAS f32x4*)(gla_g + 4 * lane);
    f32x4 ag[2][2];
#pragma unroll
    for (int p = 0; p < 2; ++p) { ag[p][0] = *(const GAS f32x4*)(att_g + p * 512 + 8 * lane); ag[p][1] = *(const GAS f32x4*)(att_g + p * 512 + 8 * lane + 4); }
    unsigned long long wf[4], wb[4], gr[4], nwf[4], nwb[4], ngr[4]; f32x2 ml[2][3], nml[2][3]; v4u ow[2][3], now[2][3];
#define P3_LOAD(MM, WF, WB, GR, ML, OW) do { _Pragma("unroll") for (int hh = 0; hh < 4; ++hh) { WF[hh] = *(const GAS unsigned long long*)(OFp + (size_t)(MM) * 1024 + hh * 256 + 4 * lane); \
            WB[hh] = *(const GAS unsigned long long*)(OBp + (size_t)(MM) * 1024 + hh * 256 + 4 * lane); GR[hh] = *(const GAS unsigned long long*)(PROJ + (size_t)(MM) * NINP + O_GR + hh * 256 + 4 * lane); } \
        _Pragma("unroll") for (int p = 0; p < 2; ++p) { const int col = p * 512 + 8 * lane, hd = col >> 6; _Pragma("unroll") for (int pt = 0; pt < 3; ++pt) { const size_t rec = ((size_t)pt * M + (MM)) * 16 + hd; \
            ML[p][pt] = *(const GAS f32x2*)(ATTML + rec * 2); OW[p][pt] = *(const GAS v4u*)(ATTP + rec * 64 + (col & 63)); } } } while (0)
    if (gw < M) P3_LOAD(gw, wf, wb, gr, ml, ow);
    for (int m = gw; m < M; m += NGW) {
        const int mn = m + NGW < M ? m + NGW : m;
        P3_LOAD(mn, nwf, nwb, ngr, nml, now);
#pragma unroll
        for (int hh = 0; hh < 4; ++hh) {
            const f32x4 o = (f32x4){bflo((unsigned)wf[hh]) + bflo((unsigned)wb[hh]), bfhi((unsigned)wf[hh]) + bfhi((unsigned)wb[hh]), bflo((unsigned)(wf[hh] >> 32)) + bflo((unsigned)(wb[hh] >> 32)), bfhi((unsigned)(wf[hh] >> 32)) + bfhi((unsigned)(wb[hh] >> 32))};
            const float ss = wave_sum((o.x * o.x + o.y * o.y) + (o.z * o.z + o.w * o.w));
            const float rstd = 1.f / sqrtf(ss * (1.f / 256.f) + EPS);
            const float r0 = bflo((unsigned)gr[hh]), r1 = bfhi((unsigned)gr[hh]), r2 = bflo((unsigned)(gr[hh] >> 32)), r3 = bfhi((unsigned)(gr[hh] >> 32));
            const float y0 = o.x * rstd * gg.x * (r0 / (1.f + __expf(-r0))), y1 = o.y * rstd * gg.y * (r1 / (1.f + __expf(-r1)));
            const float y2 = o.z * rstd * gg.z * (r2 / (1.f + __expf(-r2))), y3 = o.w * rstd * gg.w * (r3 / (1.f + __expf(-r3)));
            *(GAS unsigned long long*)(Y + (size_t)m * DM + hh * 256 + 4 * lane) = (unsigned long long)pk2(y0, y1) | ((unsigned long long)pk2(y2, y3) << 32);
        }
        float av[16]; float ss = 0.f;
#pragma unroll
        for (int p = 0; p < 2; ++p) {
            const float mt = fmaxf(fmaxf(ml[p][0].x, ml[p][1].x), ml[p][2].x); const float w0 = __expf(ml[p][0].x - mt), w1 = __expf(ml[p][1].x - mt), w2 = __expf(ml[p][2].x - mt);
            const float inv = 1.f / (w0 * ml[p][0].y + w1 * ml[p][1].y + w2 * ml[p][2].y);
            av[p * 8 + 0] = (w0 * bflo(ow[p][0].x) + w1 * bflo(ow[p][1].x) + w2 * bflo(ow[p][2].x)) * inv; av[p * 8 + 1] = (w0 * bfhi(ow[p][0].x) + w1 * bfhi(ow[p][1].x) + w2 * bfhi(ow[p][2].x)) * inv;
            av[p * 8 + 2] = (w0 * bflo(ow[p][0].y) + w1 * bflo(ow[p][1].y) + w2 * bflo(ow[p][2].y)) * inv; av[p * 8 + 3] = (w0 * bfhi(ow[p][0].y) + w1 * bfhi(ow[p][1].y) + w2 * bfhi(ow[p][2].y)) * inv;
            av[p * 8 + 4] = (w0 * bflo(ow[p][0].z) + w1 * bflo(ow[p][1].z) + w2 * bflo(ow[p][2].z)) * inv; av[p * 8 + 5] = (w0 * bfhi(ow[p][0].z) + w1 * bfhi(ow[p][1].z) + w2 * bfhi(ow[p][2].z)) * inv;
            av[p * 8 + 6] = (w0 * bflo(ow[p][0].w) + w1 * bflo(ow[p][1].w) + w2 * bflo(ow[p][2].w)) * inv; av[p * 8 + 7] = (w0 * bfhi(ow[p][0].w) + w1 * bfhi(ow[p][1].w) + w2 * bfhi(ow[p][2].w)) * inv; }
#pragma unroll
        for (int i = 0; i < 16; ++i) ss += av[i] * av[i];
        const float rstd = 1.f / sqrtf(wave_sum(ss) * (1.f / 1024.f) + EPS);
#pragma unroll
        for (int p = 0; p < 2; ++p) { const f32x4 g0 = ag[p][0], g1 = ag[p][1];
            v4u w; w.x = pk2(av[p * 8 + 0] * rstd * g0.x, av[p * 8 + 1] * rstd * g0.y); w.y = pk2(av[p * 8 + 2] * rstd * g0.z, av[p * 8 + 3] * rstd * g0.w);
            w.z = pk2(av[p * 8 + 4] * rstd * g1.x, av[p * 8 + 5] * rstd * g1.y); w.w = pk2(av[p * 8 + 6] * rstd * g1.z, av[p * 8 + 7] * rstd * g1.w);
            *(GAS v4u*)(Y + (size_t)m * DM + 1024 + p * 512 + 8 * lane) = w; }
#pragma unroll
        for (int hh = 0; hh < 4; ++hh) { wf[hh] = nwf[hh]; wb[hh] = nwb[hh]; gr[hh] = ngr[hh]; }
#pragma unroll
        for (int p = 0; p < 2; ++p)
#pragma unroll
            for (int pt = 0; pt < 3; ++pt) { ml[p][pt] = nml[p][pt]; ow[p][pt] = now[p][pt]; }
    }
#undef P3_LOAD
}


__device__ __forceinline__ void ce_desc(float& a, float& b) { const float hi = fmaxf(a, b), lo = fminf(a, b); a = hi; b = lo; }
__device__ __forceinline__ void sort16_desc(float* v) {
#pragma unroll
    for (int k = 2; k <= 16; k <<= 1)
#pragma unroll
        for (int j = k >> 1; j > 0; j >>= 1)
#pragma unroll
            for (int i = 0; i < 16; ++i) { const int l = i ^ j; if (l > i) { if ((i & k) == 0 || k == 16) ce_desc(v[i], v[l]); else ce_desc(v[l], v[i]); } }
}
__device__ __forceinline__ void merge16_desc(float* v) {
#pragma unroll
    for (int j = 8; j > 0; j >>= 1)
#pragma unroll
        for (int i = 0; i < 16; ++i) { const int l = i ^ j; if (l > i) ce_desc(v[i], v[l]); }
}
__device__ __forceinline__ void top16_of_two(float* a, const float* b) {
#pragma unroll
    for (int i = 0; i < 16; ++i) a[i] = fmaxf(a[i], b[15 - i]);
    merge16_desc(a);
}
__device__ __forceinline__ void top16_of_64(float* v) {
    sort16_desc(v); sort16_desc(v + 16); sort16_desc(v + 32); sort16_desc(v + 48);
    top16_of_two(v, v + 16); top16_of_two(v + 32, v + 48); top16_of_two(v, v + 32);
}
__device__ __forceinline__ void topk_phase(Frame& F, const Args& a) {
    unsigned char* ws = a.ws; const GAS bf16* QP = (const GAS bf16*)(ws + WS_XN); const GAS bf16* SKB = (const GAS bf16*)(ws + WS_SKB); GAS int* EIDX = (GAS int*)(ws + WS_EIDX); GAS float* GATE = (GAS float*)(ws + WS_GATE);
    const int lane = lane_id(), r32 = lane & 31, hh = lane >> 5;
    LAS unsigned char* skl = F.lds;
    LAS int* ktab = (LAS int*)(F.lds + 65536 + F.wave * 8192);
    for (int unit = F.vcu; unit < 8 * (M / 512); unit += F.G) {
        const int h = unit & 7, tok0 = (unit >> 3) * 512 + F.wave * 64;
        __syncthreads();
#pragma unroll
        for (int i = 0; i < 8; ++i) { const int idx = (F.wave * 64 + lane_id()) + 512 * i, key = idx >> 4, ch = idx & 15;
            *(LAS v4u*)(skl + key * 256 + ((ch ^ (key & 15)) * 16)) = *(const GAS v4u*)(SKB + ((size_t)h * 256 + key) * 128 + ch * 8); }
        __syncthreads();
#pragma unroll 1
        for (int tt = 0; tt < 2; ++tt) {
            const size_t row = (size_t)(tok0 + tt * 32 + r32);
            float L[2][16];
#pragma unroll
            for (int c = 0; c < 2; ++c) {
                f32x16 acc[4];
#pragma unroll
                for (int kt = 0; kt < 4; ++kt) acc[kt] = (f32x16){0.f, 0.f, 0.f, 0.f, 0.f, 0.f, 0.f, 0.f, 0.f, 0.f, 0.f, 0.f, 0.f, 0.f, 0.f, 0.f};
                const GAS bf16* qb = QP + row * DM + h * 256 + c * 128 + 8 * hh;
#pragma unroll 2
                for (int st = 0; st < 8; ++st) {
                    const bf16x8 bq = *(const GAS bf16x8*)(qb + 16 * st);
#pragma unroll
                    for (int kt = 0; kt < 4; ++kt) { const int key = c * 128 + 32 * kt + r32; const bf16x8 ak = *(const LAS bf16x8*)(skl + key * 256 + (((2 * st + hh) ^ (key & 15)) * 16));
                        acc[kt] = __builtin_amdgcn_mfma_f32_32x32x16_bf16(ak, bq, acc[kt], 0, 0, 0); }
                }
                float v[64];
#pragma unroll
                for (int kt = 0; kt < 4; ++kt)
#pragma unroll
                    for (int r = 0; r < 16; ++r) { const int key = 32 * kt + (r & 3) + 8 * (r >> 2);
                        const float sc = acc[kt][r];
                        v[kt * 16 + r] = __builtin_bit_cast(float, (__builtin_bit_cast(unsigned, sc) & ~127u) | (unsigned)(key + 4 * hh)); }
                top16_of_64(v);
                float p[16];
#pragma unroll
                for (int i = 0; i < 16; ++i) p[i] = __shfl_xor(v[i], 32);
                top16_of_two(v, p);
#pragma unroll
                for (int i = 0; i < 16; ++i) { L[c][i] = v[i]; ktab[(c * 16 + i) * 64 + lane] = (int)(__builtin_bit_cast(unsigned, v[i]) & 127u); }
            }
            float cnd[64];
            { int n = 0;
#pragma unroll
              for (int i = 0; i < 16; ++i)
#pragma unroll
                  for (int j = 0; j < 16; ++j) if ((i + 1) * (j + 1) <= 16) { cnd[n] = __builtin_bit_cast(float, (__builtin_bit_cast(unsigned, L[0][i] + L[1][j]) & ~255u) | (unsigned)((i << 4) | j)); ++n; }
#pragma unroll
              for (int q = 50; q < 64; ++q) cnd[q] = -3.0e38f; }
            top16_of_64(cnd);
            float rstd; { const GAS f32x4* sp = (const GAS f32x4*)((const GAS float*)(ws + WS_SSQ) + row * 32); float ssq = 0.f;
#pragma unroll
              for (int i = 0; i < 8; ++i) { const f32x4 t4 = sp[i]; ssq += (t4.x + t4.y) + (t4.z + t4.w); }
              rstd = 1.0f / sqrtf(ssq * (1.f / DM) + EPS); }
            float mx = __builtin_bit_cast(float, __builtin_bit_cast(unsigned, cnd[0]) & ~255u), sum = 0.f; float ex[16];
#pragma unroll
            for (int i = 0; i < 16; ++i) { ex[i] = __expf((__builtin_bit_cast(float, __builtin_bit_cast(unsigned, cnd[i]) & ~255u) - mx) * rstd); sum += ex[i]; }
            const float inv = 1.f / sum;
            LDS_WAIT(); asm volatile("" ::: "memory");
            if (hh == 0) {
                int ev[16];
#pragma unroll
                for (int i = 0; i < 16; ++i) { const unsigned bits = __builtin_bit_cast(unsigned, cnd[i]); const int ia = (bits >> 4) & 15, jb = bits & 15; ev[i] = ktab[ia * 64 + lane] * 128 + ktab[(16 + jb) * 64 + lane]; }
                GAS int* ep = EIDX + row * 128 + h * 16; GAS float* gp = GATE + row * 128 + h * 16;
#pragma unroll
                for (int i = 0; i < 4; ++i) { *(GAS i32x4*)(ep + 4 * i) = (i32x4){ev[4 * i], ev[4 * i + 1], ev[4 * i + 2], ev[4 * i + 3]}; *(GAS f32x4*)(gp + 4 * i) = (f32x4){ex[4 * i] * inv, ex[4 * i + 1] * inv, ex[4 * i + 2] * inv, ex[4 * i + 3] * inv}; }
            }
            LDS_WAIT(); asm volatile("" ::: "memory");
        }
    }
}

__device__ __forceinline__ void gla_prep_phase(Frame& F, const Args& a) {
    unsigned char* ws = a.ws; const bf16* PROJ;
    const int w = F.wave;
    LAS unsigned char* L = F.lds;
    LAS unsigned char* Qraw = L; LAS unsigned char* Kraw = L + 16384; LAS unsigned char* Vraw = L + 32768; LAS float* GDf = (LAS float*)(L + 65536); LAS float* GSUM = (LAS float*)(L + 73728);
    LAS unsigned char* IMGQ = L + 77824; LAS unsigned char* IMGK = L + 95232; LAS unsigned char* IMGE = L + 112640; LAS unsigned char* AMI = L + 32768;
    for (int it = F.vcu; it < 1024; it += F.G) {
        const int b = it >> 8, h = (it >> 6) & 3, n = it & 63; const size_t row0 = (size_t)b * SEQ + n * 64;
        ws = opaque(ws); PROJ = (const bf16*)(ws + WS_PROJ);
        int tid = opaque_v((F.wave * 64 + lane_id())), lane = tid & 63, r32 = lane & 31, hh = lane >> 5;
#pragma unroll
        for (int i = 0; i < 2; ++i) { const int idx = tid + 512 * i, r = idx >> 4, c = idx & 15;
            *(LAS v4u*)(Qraw + r * 256 + c * 16) = *(const GAS v4u*)(PROJ + (row0 + r) * NINP + O_GQ + h * 128 + c * 8);
            *(LAS v4u*)(Kraw + r * 256 + c * 16) = *(const GAS v4u*)(PROJ + (row0 + r) * NINP + O_GK + h * 128 + c * 8); }
#pragma unroll
        for (int i = 0; i < 4; ++i) { const int idx = tid + 512 * i, r = idx >> 5, c = idx & 31;
            *(LAS v4u*)(Vraw + r * 512 + c * 16) = *(const GAS v4u*)(PROJ + (row0 + r) * NINP + O_GV + h * 256 + c * 8); }
        if (tid < 256) { const int r = tid >> 2, c = tid & 3; const GAS float* gsrc = (const GAS float*)(ws + WS_GDB) + (row0 + r) * 32 + c * 8; const f32x4 g0 = *(const GAS f32x4*)gsrc, g1 = *(const GAS f32x4*)(gsrc + 4);
            *(LAS f32x4*)(GDf + r * 32 + c * 8) = g0; *(LAS f32x4*)(GDf + r * 32 + c * 8 + 4) = g1; }
        __syncthreads();
#pragma unroll
        for (int ks = 0; ks < 4; ++ks) { unsigned pk[4];
#pragma unroll
            for (int p = 0; p < 4; ++p) { const int s0 = 16 * ks + 8 * hh + 2 * p; const unsigned lo = *(const LAS unsigned short*)(Vraw + s0 * 512 + (32 * w + r32) * 2), hi = *(const LAS unsigned short*)(Vraw + (s0 + 1) * 512 + (32 * w + r32) * 2); pk[p] = lo | (hi << 16); }
            *(GAS v4u*)((unsigned char*)a.out + OUT_GT_VT + (size_t)it * 32768 + (w * 4 + ks) * 1024 + lane * 16) = (v4u){pk[0], pk[1], pk[2], pk[3]}; }
        for (int dir = 0; dir < 2; ++dir) {
            const size_t idir = (size_t)(((b * 4 + h) * 2 + dir) * 64 + n); ws = opaque(ws); tid = opaque_v(tid); lane = tid & 63; r32 = lane & 31; hh = lane >> 5;
            {
                const int d = tid & 127, tq = tid >> 7; const float* upp = (dir ? a.in[5] : a.in[3]) + h * 128 + d; const float bias = (dir ? a.in[6] : a.in[4])[h * 128 + d];
                float up[16];
#pragma unroll
                for (int r = 0; r < 16; ++r) up[r] = upp[r * 512];
                float c[16];
#pragma unroll
                for (int i = 0; i < 16; ++i) { const LAS float* g = GDf + (16 * tq + i) * 32 + dir * 16; float z = bias;
#pragma unroll
                    for (int r = 0; r < 16; ++r) z += g[r] * up[r];
                    c[i] = (fminf(z, 0.f) - __logf(1.f + __expf(-fabsf(z)))) * (1.f / 16.f); }
                if (dir == 0) {
#pragma unroll
                    for (int i = 1; i < 16; ++i) c[i] += c[i - 1];
                } else {
#pragma unroll
                    for (int i = 14; i >= 0; --i) c[i] += c[i + 1];
                }
                GSUM[(dir * 4 + tq) * 128 + d] = dir == 0 ? c[15] : c[0];
                __syncthreads();
                const float t0 = GSUM[(dir * 4 + 0) * 128 + d], t1 = GSUM[(dir * 4 + 1) * 128 + d], t2 = GSUM[(dir * 4 + 2) * 128 + d], t3 = GSUM[(dir * 4 + 3) * 128 + d];
                const float Bt = (t0 + t1) + (t2 + t3);
                float off;
                if (dir == 0) off = (tq > 0 ? t0 : 0.f) + (tq > 1 ? t1 : 0.f) + (tq > 2 ? t2 : 0.f);
                else off = (tq < 1 ? t1 : 0.f) + (tq < 2 ? t2 : 0.f) + (tq < 3 ? t3 : 0.f);
                unsigned kep[8];
#pragma unroll
                for (int i = 0; i < 16; i += 2) { float ke2[2];
#pragma unroll
                    for (int q = 0; q < 2; ++q) { const int t = 16 * tq + i + q; const float bi = c[i + q] + off;
                        const float qv = bf2f(*(const LAS unsigned short*)(Qraw + t * 256 + d * 2)), kv = bf2f(*(const LAS unsigned short*)(Kraw + t * 256 + d * 2));
                        *(LAS unsigned short*)(IMGQ + t * 272 + d * 2) = (unsigned short)pk2(qv * 0.08838834764831845f * __expf(bi), 0.f);
                        *(LAS unsigned short*)(IMGK + t * 272 + d * 2) = (unsigned short)pk2(kv * __expf(-bi), 0.f);
                        ke2[q] = kv * __expf(Bt - bi); }
                    kep[i >> 1] = pk2(ke2[0], ke2[1]); }
                *(LAS v4u*)(IMGE + d * 144 + (16 * tq) * 2) = (v4u){kep[0], kep[1], kep[2], kep[3]};
                *(LAS v4u*)(IMGE + d * 144 + (16 * tq + 8) * 2) = (v4u){kep[4], kep[5], kep[6], kep[7]};
                if (tq == 0) ((GAS float*)((unsigned char*)a.out + OUT_GT_DEC))[idir * 128 + d] = __expf(Bt);
            }
            __syncthreads();
            if (w < 4) {
                const int si = w >> 1, ti = w & 1; f32x16 acc = (f32x16){0.f, 0.f, 0.f, 0.f, 0.f, 0.f, 0.f, 0.f, 0.f, 0.f, 0.f, 0.f, 0.f, 0.f, 0.f, 0.f};
#pragma unroll
                for (int ks = 0; ks < 8; ++ks) { const bf16x8 ak = *(const LAS bf16x8*)(IMGK + (32 * si + r32) * 272 + (16 * ks + 8 * hh) * 2), bq = *(const LAS bf16x8*)(IMGQ + (32 * ti + r32) * 272 + (16 * ks + 8 * hh) * 2);
                    acc = __builtin_amdgcn_mfma_f32_32x32x16_bf16(ak, bq, acc, 0, 0, 0); }
                const int t = 32 * ti + r32;
#pragma unroll
                for (int qd = 0; qd < 4; ++qd) { float v4[4];
#pragma unroll
                    for (int i = 0; i < 4; ++i) { const int sidx = 32 * si + 8 * qd + 4 * hh + i; const float x = acc[4 * qd + i]; const bool keep = dir == 0 ? (sidx <= t) : (sidx >= t); v4[i] = keep ? x : 0.f; }
                    *(LAS unsigned long long*)(AMI + t * 144 + (32 * si + 8 * qd + 4 * hh) * 2) = (unsigned long long)pk2(v4[0], v4[1]) | ((unsigned long long)pk2(v4[2], v4[3]) << 32); }
            } else {
                const int w4 = w - 4;
#pragma unroll
                for (int q = 0; q < 4; ++q) { const int bq = w4 * 4 + q, tt = bq >> 3, ks = bq & 7, j = ks >> 1, u = ks & 1; const int t = 32 * tt + r32;
                    const unsigned long long p0 = *(const LAS unsigned long long*)(IMGQ + t * 272 + (32 * j + 16 * u + 4 * hh) * 2), p1 = *(const LAS unsigned long long*)(IMGQ + t * 272 + (32 * j + 16 * u + 8 + 4 * hh) * 2);
                    *(GAS v4u*)(ws + WS_GT_QD + idir * 16384 + bq * 1024 + lane * 16) = (v4u){(unsigned)p0, (unsigned)(p0 >> 32), (unsigned)p1, (unsigned)(p1 >> 32)}; }
#pragma unroll
                for (int q = 0; q < 4; ++q) { const int bk = w4 * 4 + q, j = bk >> 2, ks = bk & 3; const int d = 32 * j + r32;
                    *(GAS v4u*)(ws + WS_GT_KE + idir * 16384 + bk * 1024 + lane * 16) = *(const LAS v4u*)(IMGE + d * 144 + (16 * ks + 8 * hh) * 2); }
            }
            __syncthreads();
            { const int tt = w >> 2, ks = w & 3; const int t = 32 * tt + r32;
              *(GAS v4u*)((unsigned char*)a.out + OUT_GT_AM + idir * 8192 + w * 1024 + lane * 16) = *(const LAS v4u*)(AMI + t * 144 + (16 * ks + 8 * hh) * 2); }
            __syncthreads();
        }
    }
}

__device__ __forceinline__ void gla_seq_phase(Frame& F, const Args& a) {
    unsigned char* ws = a.ws;
    const int w = F.wave;
    constexpr int GBUF = 57856;
    for (int unit = F.vcu; unit < 64; unit += F.G) {
        const int dir = unit & 1, eh = (unit >> 1) & 1, bh = unit >> 2, b = bh >> 2, h = bh & 3;
        if (w >= 4) {
            const int lt = opaque_v((F.wave * 64 + lane_id())) - 256;
            v4u A[15], B[15];
#define GLA_LOAD(R, NS) do { const int n_ = dir ? 63 - (NS) : (NS); const size_t idir_ = (size_t)((bh * 2 + dir) * 64 + n_), iv_ = (size_t)(bh * 64 + n_); const unsigned char* o_ = opaque((const unsigned char*)a.out); const unsigned char* w_ = opaque(ws); \
            const GAS v4u* gq_ = (const GAS v4u*)(w_ + WS_GT_QD + idir_ * 16384); const GAS v4u* gk_ = (const GAS v4u*)(w_ + WS_GT_KE + idir_ * 16384); const GAS v4u* ga_ = (const GAS v4u*)(o_ + OUT_GT_AM + idir_ * 8192); \
            const GAS v4u* gv_ = (const GAS v4u*)(o_ + OUT_GT_VT + iv_ * 32768 + eh * 16384); const GAS v4u* gd_ = (const GAS v4u*)(o_ + OUT_GT_DEC + idir_ * 512); \
            _Pragma("unroll") for (int i = 0; i < 4; ++i) { R[i] = gq_[lt + 256 * i]; R[4 + i] = gk_[lt + 256 * i]; R[10 + i] = gv_[lt + 256 * i]; } R[8] = ga_[lt]; R[9] = ga_[lt + 256]; R[14] = gd_[lt & 31]; } while (0)
#define GLA_WRITE(R, BUF) do { LAS v4u* d_ = (LAS v4u*)(F.lds + (BUF) * GBUF); \
            _Pragma("unroll") for (int i = 0; i < 4; ++i) { d_[lt + 256 * i] = R[i]; d_[1024 + lt + 256 * i] = R[4 + i]; d_[2560 + lt + 256 * i] = R[10 + i]; } d_[2048 + lt] = R[8]; d_[2048 + lt + 256] = R[9]; if (lt < 32) d_[3584 + lt] = R[14]; } while (0)
            GLA_LOAD(A, 0); GLA_LOAD(B, 1);
            GLA_WRITE(A, 0);
            __syncthreads();
#pragma unroll 1
            for (int ns = 0; ns < 64; ns += 2) {
                if (ns + 2 < 64) GLA_LOAD(A, ns + 2);
                GLA_WRITE(B, 1);
                __syncthreads();
                if (ns + 3 < 64) GLA_LOAD(B, ns + 3);
                if (ns + 2 < 64) GLA_WRITE(A, 0);
                __syncthreads();
            }
#undef GLA_LOAD
#undef GLA_WRITE
        } else {
            f32x16 S[4];
#pragma unroll
            for (int j = 0; j < 4; ++j) S[j] = (f32x16){0.f, 0.f, 0.f, 0.f, 0.f, 0.f, 0.f, 0.f, 0.f, 0.f, 0.f, 0.f, 0.f, 0.f, 0.f, 0.f};
            __syncthreads();
#pragma unroll 1
            for (int ns = 0; ns < 64; ++ns) {
                const int n = dir ? 63 - ns : ns;
                const int lane = opaque_v(lane_id()), r32 = lane & 31, hh = lane >> 5;
                LAS unsigned char* QDl = F.lds + (ns & 1) * GBUF; LAS unsigned char* KEl = QDl + 16384; LAS unsigned char* AMl = QDl + 32768; LAS unsigned char* VTl = QDl + 40960; LAS float* DECl = (LAS float*)(QDl + 57344);
                GAS bf16* Out = (GAS bf16*)(opaque(ws) + (dir ? WS_OB : WS_OF));
                bf16x8 vf[4];
#pragma unroll
                for (int ks = 0; ks < 4; ++ks) vf[ks] = *(const LAS bf16x8*)(VTl + (w * 4 + ks) * 1024 + lane * 16);
                f32x16 o[2];
#pragma unroll
                for (int tt = 0; tt < 2; ++tt) o[tt] = (f32x16){0.f, 0.f, 0.f, 0.f, 0.f, 0.f, 0.f, 0.f, 0.f, 0.f, 0.f, 0.f, 0.f, 0.f, 0.f, 0.f};
#pragma unroll
                for (int ks8 = 0; ks8 < 8; ++ks8) { const int j = ks8 >> 1, u = ks8 & 1; v4u sb;
                    sb.x = pg8::cvt_pk_bf16(S[j][8 * u + 0], S[j][8 * u + 1]); sb.y = pg8::cvt_pk_bf16(S[j][8 * u + 2], S[j][8 * u + 3]); sb.z = pg8::cvt_pk_bf16(S[j][8 * u + 4], S[j][8 * u + 5]); sb.w = pg8::cvt_pk_bf16(S[j][8 * u + 6], S[j][8 * u + 7]);
                    const bf16x8 bs = __builtin_bit_cast(bf16x8, sb);
#pragma unroll
                    for (int tt = 0; tt < 2; ++tt) { const bf16x8 aq = *(const LAS bf16x8*)(QDl + (tt * 8 + ks8) * 1024 + lane * 16); o[tt] = __builtin_amdgcn_mfma_f32_32x32x16_bf16(aq, bs, o[tt], 0, 0, 0); } }
#pragma unroll
                for (int ks = 0; ks < 4; ++ks)
#pragma unroll
                    for (int tt = 0; tt < 2; ++tt) { const bf16x8 am = *(const LAS bf16x8*)(AMl + (tt * 4 + ks) * 1024 + lane * 16); o[tt] = __builtin_amdgcn_mfma_f32_32x32x16_bf16(am, vf[ks], o[tt], 0, 0, 0); }
#pragma unroll
                for (int tt = 0; tt < 2; ++tt)
#pragma unroll
                    for (int r = 0; r < 16; ++r) { const int t = 32 * tt + (r & 3) + 8 * (r >> 2) + 4 * hh; const float x = o[tt][r];
                        Out[((size_t)b * SEQ + 64 * n + t) * 1024 + h * 256 + 32 * (eh * 4 + w) + r32] = (bf16)pk2(x, 0.f); }
#pragma unroll
                for (int j = 0; j < 4; ++j) {
#pragma unroll
                    for (int q = 0; q < 4; ++q) { const f32x4 dv = *(const LAS f32x4*)(DECl + 32 * j + 8 * q + 4 * hh); S[j][4 * q + 0] *= dv.x; S[j][4 * q + 1] *= dv.y; S[j][4 * q + 2] *= dv.z; S[j][4 * q + 3] *= dv.w; }
#pragma unroll
                    for (int ks = 0; ks < 4; ++ks) { const bf16x8 ak = *(const LAS bf16x8*)(KEl + (j * 4 + ks) * 1024 + lane * 16); S[j] = __builtin_amdgcn_mfma_f32_32x32x16_bf16(ak, vf[ks], S[j], 0, 0, 0); } }
                __syncthreads();
            }
        }
    }
}

typedef short v4i16_t __attribute__((ext_vector_type(4)));
__device__ __forceinline__ void attn_phase(Frame& F, const Args& a, int qslot) {
    unsigned char* ws = a.ws; const bf16* PROJ;
    const int w = F.wave;
    volatile LAS int* uword = (volatile LAS int*)(F.lds + 2 * 78336);
    constexpr int NUNITS = 64 * 3 * 32;
#define ATT_DECODE(U) const int bh = (U) / 96, rem = (U) - bh * 96, p = rem >> 5, idx = rem & 31; const int lgd = 2 * p, d = 1 << lgd; \
        const int r = idx >> (5 - lgd), J = idx & ((32 >> lgd) - 1), Lc = SEQ >> lgd; const int b = bh >> 4, h = bh & 15; const int m0 = 128 * J - 64;
    v4u kx[4], vx[4]; v4u qw[2];
#define ATT_LOAD(U) do { ATT_DECODE(U) ws = opaque(ws); PROJ = (const bf16*)(ws + WS_PROJ); const int tid_ = opaque_v((F.wave * 64 + lane_id())); \
        _Pragma("unroll") for (int i = 0; i < 4; ++i) { const int kr = (tid_ >> 3) + 64 * i, ch = tid_ & 7; const int mp = m0 + kr; kx[i] = (v4u){0u, 0u, 0u, 0u}; vx[i] = kx[i]; \
            if (mp >= 0 && mp < Lc) { const bf16* src = PROJ + ((size_t)b * SEQ + r + d * mp) * NINP + O_AK + h * 64 + ch * 8; kx[i] = *(const GAS v4u*)src; vx[i] = *(const GAS v4u*)(src + (O_AV - O_AK)); } } \
        const int tokq_ = r + d * (128 * J + 16 * w + (tid_ & 15)); \
        _Pragma("unroll") for (int sft = 0; sft < 2; ++sft) qw[sft] = *(const GAS v4u*)(PROJ + ((size_t)b * SEQ + tokq_) * NINP + O_AQ + h * 64 + 32 * sft + 8 * ((tid_ & 63) >> 4)); } while (0)
    float tab[40];
    { const int l0 = opaque_v(lane_id());
#pragma unroll
      for (int c = 0; c < 40; ++c) { const int kb = c >> 3, uu = (c >> 2) & 1, rho = c & 3; const int jo = 32 * kb + 8 * (l0 >> 4) + 4 * uu + rho - 64 - (l0 & 15); const int aj = jo < 0 ? -jo : jo; tab[c] = aj <= 64 ? (float)aj : 3.0e38f; } }
    if ((F.wave * 64 + lane_id()) == 0) { uword[0] = (int)__hip_atomic_fetch_add((unsigned*)(F.ctl + CW_ATTQ + 64 * qslot), 1u, __ATOMIC_RELAXED, __HIP_MEMORY_SCOPE_AGENT); uword[1] = (int)__hip_atomic_fetch_add((unsigned*)(F.ctl + CW_ATTQ + 64 * qslot), 1u, __ATOMIC_RELAXED, __HIP_MEMORY_SCOPE_AGENT); }
    __syncthreads();
    int u = __builtin_amdgcn_readfirstlane(uword[0]), un = __builtin_amdgcn_readfirstlane(uword[1]); int par = 0;
#define ATT_WRITE(BUF) do { const int tid_ = opaque_v((F.wave * 64 + lane_id())); LAS unsigned char* Kw = F.lds + (BUF) * 78336; LAS unsigned char* Vw = Kw + 39168; \
        _Pragma("unroll") for (int i = 0; i < 4; ++i) { const int kr = (tid_ >> 3) + 64 * i, ch = tid_ & 7; *(LAS v4u*)(Kw + kr * 144 + ch * 16) = kx[i]; *(LAS v4u*)(Vw + kr * 144 + ch * 16) = vx[i]; } \
        if (tid_ < 128) { const int kr = 256 + (tid_ >> 3), ch = tid_ & 7; *(LAS v4u*)(Kw + kr * 144 + ch * 16) = (v4u){0u, 0u, 0u, 0u}; *(LAS v4u*)(Vw + kr * 144 + ch * 16) = (v4u){0u, 0u, 0u, 0u}; } } while (0)
    v4u qwc[2];
    if (u < NUNITS) { ATT_LOAD(u); ATT_WRITE(0); qwc[0] = qw[0]; qwc[1] = qw[1]; }
    __syncthreads();
    int bufi = 0;
    while (u < NUNITS) {
        const int tid = opaque_v((F.wave * 64 + lane_id())), lane = tid & 63, q16 = lane & 15, g = lane >> 4;
        int qnext = 0; if (tid == 0) qnext = (int)__hip_atomic_fetch_add((unsigned*)(F.ctl + CW_ATTQ + 64 * qslot), 1u, __ATOMIC_RELAXED, __HIP_MEMORY_SCOPE_AGENT);
        LAS unsigned char* Kl = F.lds + bufi * 78336; LAS unsigned char* Vl = Kl + 39168;
        bf16x8 qf[2];
#pragma unroll
        for (int sft = 0; sft < 2; ++sft) { v4u qs; constexpr float QS = 0.125f * 1.4426950408889634f; qs.x = pk2(bflo(qwc[sft].x) * QS, bfhi(qwc[sft].x) * QS); qs.y = pk2(bflo(qwc[sft].y) * QS, bfhi(qwc[sft].y) * QS); qs.z = pk2(bflo(qwc[sft].z) * QS, bfhi(qwc[sft].z) * QS); qs.w = pk2(bflo(qwc[sft].w) * QS, bfhi(qwc[sft].w) * QS);
            qf[sft] = __builtin_bit_cast(bf16x8, qs); }
        ATT_DECODE(u)
        const int tokq = r + d * (128 * J + 16 * w + q16);
        if (un < NUNITS) ATT_LOAD(un);
        const float nslope = -exp2f(-0.5f * (float)(h + 1)) * (float)d * 1.4426950408889634f;
        const bool inrange = (m0 + 16 * w >= 0) && (m0 + 16 * w + 159 < Lc);
        float sv[5][2][4]; float mx = -3.0e38f;
#pragma unroll
        for (int kb = 0; kb < 5; ++kb)
#pragma unroll
            for (int uu = 0; uu < 2; ++uu) { f32x4 acc = (f32x4){0.f, 0.f, 0.f, 0.f};
                const int krow = 16 * w + 32 * kb + 8 * (q16 >> 2) + 4 * uu + (q16 & 3);
#pragma unroll
                for (int sft = 0; sft < 2; ++sft) { const bf16x8 ak = *(const LAS bf16x8*)(Kl + krow * 144 + (32 * sft + 8 * g) * 2); acc = __builtin_amdgcn_mfma_f32_16x16x32_bf16(ak, qf[sft], acc, 0, 0, 0); }
#pragma unroll
                for (int rho = 0; rho < 4; ++rho) { const float x = acc[rho]; sv[kb][uu][rho] = __builtin_fmaf(nslope, tab[kb * 8 + uu * 4 + rho], x); } }
        if (!inrange) {
#pragma unroll
            for (int kb = 0; kb < 5; ++kb)
#pragma unroll
                for (int uu = 0; uu < 2; ++uu)
#pragma unroll
                    for (int rho = 0; rho < 4; ++rho) { const int mp = m0 + 16 * w + 32 * kb + 8 * g + 4 * uu + rho; if (mp < 0 || mp >= Lc) sv[kb][uu][rho] = -3.0e38f; } }
#pragma unroll
        for (int kb = 0; kb < 5; ++kb)
#pragma unroll
            for (int uu = 0; uu < 2; ++uu)
#pragma unroll
                for (int rho = 0; rho < 4; ++rho) mx = fmaxf(mx, sv[kb][uu][rho]);
        mx = fmaxf(mx, __shfl_xor(mx, 16)); mx = fmaxf(mx, __shfl_xor(mx, 32));
        float lsum = 0.f; bf16x8 pf[5];
#pragma unroll
        for (int kb = 0; kb < 5; ++kb) { float e[8];
#pragma unroll
            for (int uu = 0; uu < 2; ++uu)
#pragma unroll
                for (int rho = 0; rho < 4; ++rho) { const float pe = __builtin_amdgcn_exp2f(sv[kb][uu][rho] - mx); e[uu * 4 + rho] = pe; lsum += pe; }
            v4u pw; pw.x = pk2(e[0], e[1]); pw.y = pk2(e[2], e[3]); pw.z = pk2(e[4], e[5]); pw.w = pk2(e[6], e[7]); pf[kb] = __builtin_bit_cast(bf16x8, pw); }
        lsum += __shfl_xor(lsum, 16); lsum += __shfl_xor(lsum, 32);
        f32x4 oT[4];
#pragma unroll
        for (int nn = 0; nn < 4; ++nn) oT[nn] = (f32x4){0.f, 0.f, 0.f, 0.f};
#pragma unroll
        for (int kb = 0; kb < 5; ++kb)
#pragma unroll
            for (int nn = 0; nn < 4; ++nn) { const LAS unsigned char* va = Vl + (16 * w + 32 * kb + 8 * g + (q16 >> 2)) * 144 + (16 * nn + 4 * (q16 & 3)) * 2;
                const v4i16_t lo = __builtin_amdgcn_ds_read_tr16_b64_v4i16((LAS v4i16_t*)va), hi = __builtin_amdgcn_ds_read_tr16_b64_v4i16((LAS v4i16_t*)(va + 4 * 144));
                const bf16x8 vf = (bf16x8){lo[0], lo[1], lo[2], lo[3], hi[0], hi[1], hi[2], hi[3]};
                oT[nn] = __builtin_amdgcn_mfma_f32_16x16x32_bf16(vf, pf[kb], oT[nn], 0, 0, 0); }
        { const size_t rec = ((size_t)p * M + (size_t)b * SEQ + tokq) * 16 + h; GAS bf16* op = (GAS bf16*)(opaque(ws) + WS_ATTP) + rec * 64 + 4 * g;
#pragma unroll
          for (int nn = 0; nn < 4; ++nn) *(GAS unsigned long long*)(op + 16 * nn) = (unsigned long long)pk2(oT[nn][0], oT[nn][1]) | ((unsigned long long)pk2(oT[nn][2], oT[nn][3]) << 32);
          if (g == 0) { GAS float* ml = (GAS float*)(opaque(ws) + WS_ATTML) + rec * 2; ml[0] = mx * 0.6931471805599453f; ml[1] = lsum; } }
        if (un < NUNITS) { ATT_WRITE(bufi ^ 1); qwc[0] = qw[0]; qwc[1] = qw[1]; }
        if (tid == 0) uword[par] = qnext;
        __syncthreads();
        u = un; un = __builtin_amdgcn_readfirstlane(uword[par]); par ^= 1; bufi ^= 1;
    }
#undef ATT_WRITE
#undef ATT_DECODE
#undef ATT_LOAD
}

typedef __bf16 bf16x2_t __attribute__((ext_vector_type(2)));
__device__ __forceinline__ void peer_convert_tables(Frame& F, const Args& a, int qslot) {
    unsigned char* ws = a.ws; const int lane = lane_id(); volatile LAS int* uword = (volatile LAS int*)(F.lds + 2 * 78336 + 64);
    for (;;) {
        __syncthreads();
        if ((F.wave * 64 + lane_id()) == 0) uword[0] = (int)__hip_atomic_fetch_add((unsigned*)(F.ctl + CW_CONVQ + 64 * qslot), 1u, __ATOMIC_RELAXED, __HIP_MEMORY_SCOPE_AGENT);
        __syncthreads();
        const int blk = __builtin_amdgcn_readfirstlane(uword[0]);
        if (blk >= 2 * PEER_E / 64) break;
#pragma unroll 1
        for (int i = 0; i < 8; ++i) { const int r = blk * 64 + F.wave * 8 + i;
            const int e = r & (PEER_E - 1); const bool isv = r >= PEER_E;
            const float* src = (isv ? a.in[14] : a.in[13]) + (size_t)e * DM;
            unsigned char* dst = (unsigned char*)a.out + (isv ? OUT_V8 : OUT_U8) + (size_t)e * DM; float* sc = (float*)(ws + (isv ? WS_SV : WS_SU));
            f32x4 v[8]; float am = 0.f;
#pragma unroll
            for (int j = 0; j < 8; ++j) { v[j] = *(const f32x4*)(src + 256 * j + 4 * lane); am = fmaxf(am, fmaxf(fmaxf(fabsf(v[j].x), fabsf(v[j].y)), fmaxf(fabsf(v[j].z), fabsf(v[j].w)))); }
            am = wave_max(am); am = fmaxf(am, 1e-30f);
            const float inv = 440.f / am;
#pragma unroll
            for (int j = 0; j < 8; ++j) { int p = __builtin_amdgcn_cvt_pk_fp8_f32(v[j].x * inv, v[j].y * inv, 0, false); p = __builtin_amdgcn_cvt_pk_fp8_f32(v[j].z * inv, v[j].w * inv, p, true);
                *(int*)(dst + 256 * j + 4 * lane) = p; }
            if (lane == 0) sc[e] = am * (1.f / 440.f); }
    }
}

__device__ __forceinline__ float dpp_row_sum(float x) {
#define PEER_DPP(ctrl) x += __builtin_bit_cast(float, __builtin_amdgcn_update_dpp(0, __builtin_bit_cast(int, x), ctrl, 0xF, 0xF, false))
    PEER_DPP(0xB1); PEER_DPP(0x4E); PEER_DPP(0x141); PEER_DPP(0x140);
#undef PEER_DPP
    return x;
}
template <bool VPH, int PBS, bool LA> __device__ __forceinline__ void peer_uv_phase(Frame& F, const Args& a) {
    unsigned char* ws = a.ws; GAS bf16* H = (GAS bf16*)(ws + WS_HB); const GAS float* g2 = (const GAS float*)a.in[10];
    const int sl = blockIdx.x & 7, rk = blockIdx.x >> 3, nrk = F.G >> 3, tpw = M / nrk / NWAVES, nq = tpw / 4;
    const unsigned char* TAB; const GAS int* EIDX; const GAS float* SSQ; const GAS float* PW; GAS float* PD; GAS float* SSQ2;
    LAS int* idt = (LAS int*)(F.lds + F.wave * 8704);
    LAS float* wt = (LAS float*)(F.lds + F.wave * 8704 + 4352);
    const int t0 = (rk * NWAVES + F.wave) * tpw;
#define PEER_STAGE_LOAD(QI) do { const size_t tb_ = (size_t)(t0 + 4 * (QI) + a4) * 128; _Pragma("unroll") for (int k = 0; k < 8; ++k) sid[k] = EIDX[tb_ + 16 * k + q]; } while (0)
#define PEER_STAGE_WRITE(QI) do { const int bf_ = ((QI) & 1) * 528; _Pragma("unroll") for (int k = 0; k < 8; ++k) idt[bf_ + a4 * 132 + 16 * k + q] = sid[k]; } while (0)
#define PEER_STAGE_W(QI) do { if (VPH) { const size_t tb_ = (size_t)(t0 + 4 * (QI) + a4) * 128; const int bf_ = ((QI) & 1) * 528; _Pragma("unroll") for (int k = 0; k < 8; ++k) wt[bf_ + a4 * 132 + 16 * k + q] = PW[tb_ + 16 * k + q]; LDS_WAIT(); asm volatile("" ::: "memory"); } } while (0)
#define PEER_ISSUE(R, QI, WB) do { const int bf_ = ((QI) & 1) * 528 + a4 * 132 + (WB) * PBS; i32x4 e4_; _Pragma("unroll") for (int j = 0; j < PBS; ++j) { if ((j & 3) == 0) e4_ = *(const LAS i32x4*)(idt + bf_ + j); const int e_ = (j & 3) == 0 ? e4_.x : (j & 3) == 1 ? e4_.y : (j & 3) == 2 ? e4_.z : e4_.w; R[j] = ldu<i32x4>(TAB, (unsigned)e_ * 2048u + (unsigned)(16 * q)); } } while (0)
    unsigned xq[8]; float acc[16];
#define PEER_QUAD_BEGIN(QI) do { const size_t t_ = (size_t)(t0 + 4 * (QI) + a4); \
        if (!VPH) { f32x4 hq[4]; { const v4u h0_ = *(const GAS v4u*)(H + t_ * DM + 256 * sl + 16 * q), h1_ = *(const GAS v4u*)(H + t_ * DM + 256 * sl + 16 * q + 8); \
            hq[0] = (f32x4){bflo(h0_.x), bfhi(h0_.x), bflo(h0_.y), bfhi(h0_.y)}; hq[1] = (f32x4){bflo(h0_.z), bfhi(h0_.z), bflo(h0_.w), bfhi(h0_.w)}; hq[2] = (f32x4){bflo(h1_.x), bfhi(h1_.x), bflo(h1_.y), bfhi(h1_.y)}; hq[3] = (f32x4){bflo(h1_.z), bfhi(h1_.z), bflo(h1_.w), bfhi(h1_.w)}; }  const float pss_ = dpp_row_sum(SSQ[t_ * 32 + q] + SSQ[t_ * 32 + 16 + q]); const float rstd_ = 1.f / sqrtf(pss_ * (1.f / DM) + EPS); f32x4 gv[4]; \
            _Pragma("unroll") for (int k = 0; k < 4; ++k) gv[k] = *(const GAS f32x4*)(g2 + 256 * sl + 16 * q + 4 * k); \
            _Pragma("unroll") for (int k = 0; k < 4; ++k) { xq[2 * k] = pk2(hq[k].x * rstd_ * gv[k].x, hq[k].y * rstd_ * gv[k].y); xq[2 * k + 1] = pk2(hq[k].z * rstd_ * gv[k].z, hq[k].w * rstd_ * gv[k].w); } } \
        else { _Pragma("unroll") for (int k = 0; k < 16; ++k) acc[k] = 0.f; } } while (0)
#define PEER_COMPUTE(R, QI, WB) do { if (!VPH) { float pdb_ = 0.f; _Pragma("unroll") for (int j = 0; j < PBS; ++j) { float d_ = 0.f; _Pragma("unroll") for (int k = 0; k < 4; ++k) { const int dw_ = R[j][k]; \
                d_ = __builtin_amdgcn_fdot2_f32_bf16(__builtin_amdgcn_cvt_scalef32_pk_bf16_fp8(dw_, 1.0f, false), __builtin_bit_cast(bf16x2_t, xq[2 * k]), d_, false); \
                d_ = __builtin_amdgcn_fdot2_f32_bf16(__builtin_amdgcn_cvt_scalef32_pk_bf16_fp8(dw_, 1.0f, true), __builtin_bit_cast(bf16x2_t, xq[2 * k + 1]), d_, false); } \
                d_ = dpp_row_sum(d_); pdb_ = (q == j) ? d_ : pdb_; } \
            if (q < PBS) PD[((size_t)(t0 + 4 * (QI) + a4) * 8 + sl) * 128 + PBS * (WB) + q] = pdb_; } \
        else { const int bf_ = ((QI) & 1) * 528 + a4 * 132 + (WB) * PBS; f32x4 w4_; _Pragma("unroll") for (int j = 0; j < PBS; ++j) { if ((j & 3) == 0) w4_ = *(const LAS f32x4*)(wt + bf_ + j); const float w_ = (j & 3) == 0 ? w4_.x : (j & 3) == 1 ? w4_.y : (j & 3) == 2 ? w4_.z : w4_.w; int r0_ = R[j][0], r1_ = R[j][1], r2_ = R[j][2], r3_ = R[j][3]; asm volatile("" : "+v"(r0_), "+v"(r1_), "+v"(r2_), "+v"(r3_));     \
                _Pragma("unroll") for (int k = 0; k < 4; ++k) { const int dw_ = k == 0 ? r0_ : k == 1 ? r1_ : k == 2 ? r2_ : r3_; \
                const f32x2 lo_ = __builtin_amdgcn_cvt_pk_f32_fp8(dw_, false), hi_ = __builtin_amdgcn_cvt_pk_f32_fp8(dw_, true); \
                acc[4 * k + 0] += w_ * lo_.x; acc[4 * k + 1] += w_ * lo_.y; acc[4 * k + 2] += w_ * hi_.x; acc[4 * k + 3] += w_ * hi_.y; } } } } while (0)
#define PEER_QUAD_END(QI) do { if (VPH) { const size_t t_ = (size_t)(t0 + 4 * (QI) + a4); GAS bf16* hp_ = H + t_ * DM + 256 * sl + 16 * q; const v4u h0_ = *(const GAS v4u*)hp_, h1_ = *(const GAS v4u*)(hp_ + 8); \
            float y_[16]; y_[0] = bflo(h0_.x); y_[1] = bfhi(h0_.x); y_[2] = bflo(h0_.y); y_[3] = bfhi(h0_.y); y_[4] = bflo(h0_.z); y_[5] = bfhi(h0_.z); y_[6] = bflo(h0_.w); y_[7] = bfhi(h0_.w); \
            y_[8] = bflo(h1_.x); y_[9] = bfhi(h1_.x); y_[10] = bflo(h1_.y); y_[11] = bfhi(h1_.y); y_[12] = bflo(h1_.z); y_[13] = bfhi(h1_.z); y_[14] = bflo(h1_.w); y_[15] = bfhi(h1_.w); \
            float ss_ = 0.f; _Pragma("unroll") for (int k = 0; k < 16; ++k) { y_[k] += acc[k]; ss_ += y_[k] * y_[k]; } \
            *(GAS v4u*)hp_ = (v4u){pk2(y_[0], y_[1]), pk2(y_[2], y_[3]), pk2(y_[4], y_[5]), pk2(y_[6], y_[7])}; *(GAS v4u*)(hp_ + 8) = (v4u){pk2(y_[8], y_[9]), pk2(y_[10], y_[11]), pk2(y_[12], y_[13]), pk2(y_[14], y_[15])}; \
            ss_ = dpp_row_sum(ss_); if (q == 0) SSQ2[t_ * 8 + sl] = ss_; } } while (0)
#pragma unroll 1
    for (int qi = 0; qi < nq; ++qi) {
        i32x4 rA[PBS], rB[PBS];
        const int lane = opaque_v(lane_id()), a4 = lane >> 4, q = lane & 15; ws = opaque(ws); H = (GAS bf16*)(ws + WS_HB);
        TAB = opaque((const unsigned char*)a.out) + (VPH ? OUT_V8 : OUT_U8) + 256 * sl; EIDX = (const GAS int*)(ws + WS_EIDX); SSQ = (const GAS float*)(ws + WS_SSQ); PW = (const GAS float*)(ws + WS_PW); PD = (GAS float*)(ws + WS_PD); SSQ2 = (GAS float*)(ws + WS_SSQ2);
        int sid[8];
        if (!LA || qi == 0) { PEER_STAGE_LOAD(qi); PEER_STAGE_WRITE(qi); LDS_WAIT(); asm volatile("" ::: "memory"); }
        PEER_ISSUE(rA, qi, 0);
        PEER_ISSUE(rB, qi, 1);
        if (LA && qi + 1 < nq) PEER_STAGE_LOAD(qi + 1);
        PEER_STAGE_W(qi);
        PEER_QUAD_BEGIN(qi);
#pragma unroll
        for (int wb = 0; wb < 128 / PBS; wb += 2) {
            PEER_COMPUTE(rA, qi, wb); if (wb + 2 < 128 / PBS) { PEER_ISSUE(rA, qi, wb + 2); }
            PEER_COMPUTE(rB, qi, wb + 1); if (wb + 3 < 128 / PBS) { PEER_ISSUE(rB, qi, wb + 3); }
        }
        PEER_QUAD_END(qi);
        if (LA && qi + 1 < nq) { PEER_STAGE_WRITE(qi + 1); LDS_WAIT(); asm volatile("" ::: "memory"); }
    }
#undef PEER_STAGE_LOAD
#undef PEER_STAGE_WRITE
#undef PEER_STAGE_W
#undef PEER_ISSUE
#undef PEER_QUAD_BEGIN
#undef PEER_COMPUTE
#undef PEER_QUAD_END
}
__device__ __forceinline__ void peer_w_phase(Frame& F, const Args& a) {
    unsigned char* ws = a.ws; const float* PD = (const float*)(ws + WS_PD); const int* EIDX = (const int*)(ws + WS_EIDX); const float* GATE = (const float*)(ws + WS_GATE);
    const float* SU = (const float*)(ws + WS_SU); const float* SV = (const float*)(ws + WS_SV); float* PW = (float*)(ws + WS_PW);
    for (int i = F.vcu * 512 + (F.wave * 64 + lane_id()); i < M * 128; i += F.G * 512) { const int t = i >> 7, p = i & 127; float d = 0.f;
#pragma unroll
        for (int sl = 0; sl < 8; ++sl) d += PD[((size_t)t * 8 + sl) * 128 + p];
        const int e = EIDX[i]; d *= SU[e];
        PW[i] = GATE[i] * 0.5f * d * (1.f + erff(d * 0.70710678118654752f)) * SV[e]; }
}
__device__ __forceinline__ void peer_n_phase(Frame& F, const Args& a) {
    unsigned char* ws = a.ws; const GAS bf16* Y = (const GAS bf16*)(ws + WS_HB); GAS float* O = (GAS float*)a.out; const GAS float* gf = (const GAS float*)a.in[15]; const GAS float* SSQ2 = (const GAS float*)(ws + WS_SSQ2); const int lane = lane_id();
    f32x4 g0[4], g1[4];
#pragma unroll
    for (int j = 0; j < 4; ++j) { g0[j] = *(const GAS f32x4*)(gf + 512 * j + 8 * lane); g1[j] = *(const GAS f32x4*)(gf + 512 * j + 8 * lane + 4); }
    const int gw = F.vcu * NWAVES + F.wave, NGW = F.G * NWAVES;
    v4u yw[4], yn[4]; f32x4 s0, s1, n0, n1;
    if (gw < M) {
#pragma unroll
        for (int j = 0; j < 4; ++j) yw[j] = *(const GAS v4u*)(Y + (size_t)gw * DM + 512 * j + 8 * lane);
        s0 = *(const GAS f32x4*)(SSQ2 + (size_t)gw * 8); s1 = *(const GAS f32x4*)(SSQ2 + (size_t)gw * 8 + 4); }
    for (int m = gw; m < M; m += NGW) { const int mn = m + NGW < M ? m + NGW : m;
#pragma unroll
        for (int j = 0; j < 4; ++j) yn[j] = *(const GAS v4u*)(Y + (size_t)mn * DM + 512 * j + 8 * lane);
        n0 = *(const GAS f32x4*)(SSQ2 + (size_t)mn * 8); n1 = *(const GAS f32x4*)(SSQ2 + (size_t)mn * 8 + 4);
        const float rf = 1.f / sqrtf((((s0.x + s0.y) + (s0.z + s0.w)) + ((s1.x + s1.y) + (s1.z + s1.w))) * (1.f / DM) + EPS);
#pragma unroll
        for (int j = 0; j < 4; ++j) {
            *(GAS f32x4*)(O + (size_t)m * DM + 512 * j + 8 * lane) = (f32x4){bflo(yw[j].x) * rf * g0[j].x, bfhi(yw[j].x) * rf * g0[j].y, bflo(yw[j].y) * rf * g0[j].z, bfhi(yw[j].y) * rf * g0[j].w};
            *(GAS f32x4*)(O + (size_t)m * DM + 512 * j + 8 * lane + 4) = (f32x4){bflo(yw[j].z) * rf * g1[j].x, bfhi(yw[j].z) * rf * g1[j].y, bflo(yw[j].w) * rf * g1[j].z, bfhi(yw[j].w) * rf * g1[j].w}; }
#pragma unroll
        for (int j = 0; j < 4; ++j) yw[j] = yn[j];
        s0 = n0; s1 = n1; }
}

__global__ void __launch_bounds__(NWAVES * 64, 2) mk_fwd(Args args_in) {
    extern __shared__ __attribute__((aligned(16))) unsigned char lds[];
    Args args = args_in;
#pragma unroll
    for (int i = 0; i < 16; ++i) args.in[i] = (const float*)(const GAS float*)args_in.in[i];
    args.out = (float*)(GAS float*)args_in.out; args.ws = (unsigned char*)(GAS unsigned char*)args_in.ws;
    Frame F;
    F.lds = (LAS unsigned char*)lds;
    F.MISC = (volatile LAS unsigned*)(F.lds + MISC_OFF);
    F.wave = __builtin_amdgcn_readfirstlane((int)threadIdx.x >> 6);
    F.G = gridDim.x; { const int bx = blockIdx.x; F.vcu = (F.G % 8 == 0) ? (bx % 8) * (F.G / 8) + bx / 8 : bx; }
    unsigned char* ws = args.ws;
    F.ctl = (gu32*)(ws + WS_CTL);
    for (int u = (F.wave * 64 + lane_id()); u < (LDS_BYTES - LDSCTL_OFF) / 4; u += NWAVES * 64) ((LAS unsigned*)(F.lds + LDSCTL_OFF))[u] = 0u;
    __syncthreads();
    XcdBarrier bar = xcd_barrier_post((unsigned*)(F.ctl + CW_BAR) + args.li * XCD_BAR_WORDS, F.MISC + 8);
    const int lo = args.ph_lo, hi = args.ph_hi;
#define IN(k) (lo <= (k) && (k) < hi)
#define BOTH(k) (IN(k) && IN((k) + 1))
#define GRID_BAR() xcd_barrier(bar)

    if (IN(0)) { for (int rep = 0; rep < NREP(0); ++rep) p0_prologue(F, args); if (BOTH(0)) GRID_BAR(); }

    if (IN(1)) {
        pg8::Gemm g{(const bf16*)(ws + WS_XN), (const bf16*)(ws + WS_WIN), M, NINP, DM}; pg8::StaticOrder S; S.init(M, NINP, F.G, (int)blockIdx.x);
        pg8::EpiBf16<0> E{(bf16*)(ws + WS_PROJ), NINP, nullptr, 0, 0, 1.f};
        for (int rep = 0; rep < NREP(1); ++rep) pg8::gemm_phase<pg8::EpiBf16<0>, pg8::StaticOrder, PG8_ALIGN, PG8_SP2>(F.lds + RING_OFF, g, S, E);
        for (int rep = 0; rep < NREP(11); ++rep) gd_side_gemm(F, args);
        if (BOTH(1)) GRID_BAR();
    }
    if (IN(2)) {
        for (int rep = 0; rep < NREP(21); ++rep) gla_prep_phase(F, args);
        GRID_BAR();
        for (int rep = 0; rep < NREP(2); ++rep) gla_seq_phase(F, args);
        for (int rep = 0; rep < NREP(20); ++rep) attn_phase(F, args, rep);
        for (int rep = 0; rep < NREP(40); ++rep) peer_convert_tables(F, args, rep);
        if (BOTH(2)) GRID_BAR(); }
    if (IN(3)) { for (int rep = 0; rep < NREP(3); ++rep) p3_finalize(F, args); if (BOTH(3)) GRID_BAR(); if (REP_PHASE == 99) { GRID_BAR(); GRID_BAR(); GRID_BAR(); GRID_BAR(); } }
    if (IN(4)) {
        pg8::Gemm g{(const bf16*)(ws + WS_XN), (const bf16*)(ws + WS_WOUT), M, DM, DM}; pg8::StaticOrder S; S.init(M, DM, F.G, (int)blockIdx.x);
        pg8::EpiRes E{args.in[0], (bf16*)(ws + WS_HB), (float*)(ws + WS_SSQ), DM};
        for (int rep = 0; rep < NREP(4); ++rep) pg8::gemm_phase<pg8::EpiRes, pg8::StaticOrder, PG8_ALIGN, PG8_SP2>(F.lds + RING_OFF, g, S, E);
        if (BOTH(4)) GRID_BAR();
    }
    if (IN(5)) {
        pg8::Gemm g{(const bf16*)(ws + WS_HB), (const bf16*)(ws + WS_WQ), M, DM, DM}; pg8::StaticOrder S; S.init(M, DM, F.G, (int)blockIdx.x);
        pg8::EpiBf16<0> E{(bf16*)(ws + WS_XN), DM, nullptr, 0, 0, 1.f};
        for (int rep = 0; rep < NREP(5); ++rep) pg8::gemm_phase<pg8::EpiBf16<0>, pg8::StaticOrder, PG8_ALIGN, PG8_SP2>(F.lds + RING_OFF, g, S, E);
        if (BOTH(5)) GRID_BAR();
    }
    if (IN(6)) { for (int rep = 0; rep < NREP(6); ++rep) topk_phase(F, args); if (BOTH(6)) GRID_BAR(); }
    if (IN(7)) {
        for (int rep = 0; rep < NREP(7); ++rep) peer_uv_phase<false, 16, true>(F, args);
        GRID_BAR();
        peer_w_phase(F, args);
        GRID_BAR();
        if (REP_PHASE != 8) peer_uv_phase<true, 8, true>(F, args);
        GRID_BAR();
        peer_n_phase(F, args);
    }
#undef IN
#undef BOTH
}


extern "C" void kernel_launch(void* const* d_in, const int* in_sizes, int n_in, void* d_out, int out_size, void* d_ws, size_t ws_size, hipStream_t stream) {
    static int grid = 0;
    if (grid == 0) {
        if (n_in != 16 || in_sizes[0] != M * DM || out_size != M * DM || ws_size < WS_END) { fprintf(stderr, "kernel_launch: unexpected shapes: n_in %d in0 %d out %d ws %zu\n", n_in, n_in > 0 ? in_sizes[0] : -1, out_size, ws_size); grid = -1; return; }
        int dev = 0, cus = 0;
        if (hipGetDevice(&dev) != hipSuccess || hipDeviceGetAttribute(&cus, hipDeviceAttributeMultiprocessorCount, dev) != hipSuccess) { grid = -1; return; }
        if (hipFuncSetAttribute((const void*)mk_fwd, hipFuncAttributeMaxDynamicSharedMemorySize, LDS_BYTES) != hipSuccess) { fprintf(stderr, "kernel_launch: hipFuncSetAttribute failed\n"); grid = -1; return; }
        (void)hipGetLastError();
        grid = cus;
    }
    if (grid < 0) return;
    (void)hipMemsetAsync((char*)d_ws + WS_CTL, 0, CTL_ZERO_BYTES, stream);
    Args a{};
    for (int i = 0; i < 16; ++i) a.in[i] = (const float*)d_in[i];
    a.out = (float*)d_out; a.ws = (unsigned char*)d_ws;
    a.ph_lo = 0; a.ph_hi = 8; a.li = 0;
    hipLaunchKernelGGL(mk_fwd, dim3(grid), dim3(NWAVES * 64), LDS_BYTES, stream, a);
}
```

```cpp
#define REP_PHASE -1

#include <hip/hip_runtime.h>
#include <cstdio>
#include <cstdint>
#include <cmath>
#ifndef REP_PHASE
#define REP_PHASE -1
#endif
#define NREP(k) ((REP_PHASE == (k)) ? 2 : 1)
namespace pg8 {
#define PG8_LAS __attribute__((address_space(3)))
typedef unsigned short bf16_t;
typedef short bf16x8 __attribute__((ext_vector_type(8)));
typedef float f32x4 __attribute__((ext_vector_type(4)));
typedef unsigned u32x4 __attribute__((ext_vector_type(4)));
constexpr int BM = 256, BK = 64, HALF = 128, HTB = HALF * BK * 2  , STAGE_BYTES = 8 * HTB, NXCD = 8, WGM = 8;

__host__ __device__ __forceinline__ int lds_byte(int r, int c) { const int st = (r >> 4) * 2 + (c >> 5), rr = r & 15, cc = c & 31, ob = rr * 64 + cc * 2; return st * 1024 + (ob ^ (((ob >> 9) & 1) << 5)); }
__host__ __device__ __forceinline__ void stage_rc(int b, int& R, int& C) { const int st = b / 1024, sb = b % 1024, swz = sb ^ (((sb >> 9) & 1) << 5); R = (st >> 1) * 16 + swz / 64; C = (st & 1) * 32 + (swz % 64) / 2; }
__host__ __device__ __forceinline__ int perm32(int rho) { const int n = rho >> 4, i = rho & 15; return 8 * (i >> 2) + 4 * n + (i & 3); }

struct Unit { int pm, pn; };
struct Gemm { const bf16_t* A; const bf16_t* Bt; int M, N, K; };

struct StaticOrder {
    int nM, nN, nwg, G, c;
    __host__ __device__ void init(int M, int N, int G_, int c_) { nM = M / BM; nN = N / BM; nwg = nM * nN; G = G_; c = c_; }
    __host__ __device__ bool next(int i, Unit& u) const {
        const long L = (long)i * G + c; if (L >= nwg) return false;
        int wgid = (int)L; { const int q = nwg / NXCD, r = nwg % NXCD, xcd = wgid % NXCD, off = wgid / NXCD; wgid = (xcd < r ? xcd * (q + 1) : r * (q + 1) + (xcd - r) * q) + off; }
        const int nig = WGM * nN, gid = wgid / nig, fm = gid * WGM, gsz = (nM - fm) < WGM ? (nM - fm) : WGM;
        u.pm = fm + ((wgid % nig) % gsz); u.pn = (wgid % nig) / gsz; return true;
    }
    __device__ __forceinline__ void a_ready(const Unit&) const {}
    __device__ __forceinline__ void done(const Unit&) const {}
};

__device__ __forceinline__ unsigned cvt_pk_bf16(float lo, float hi) { unsigned r; asm volatile("v_cvt_pk_bf16_f32 %0, %1, %2" : "=v"(r) : "v"(lo), "v"(hi)); return r; }
typedef float f32x2 __attribute__((ext_vector_type(2)));
__device__ __forceinline__ f32x2 gelu_pk(f32x2 v) {
    const f32x2 av = __builtin_elementwise_abs(v), d = av * 0.2316418882f + 1.0f;
    f32x2 t; t.x = __builtin_amdgcn_rcpf(d.x); t.y = __builtin_amdgcn_rcpf(d.y);
    f32x2 q = t * 0.5307027145f + (-0.7265760135f); q = q * t + 0.7107068705f; q = q * t + (-0.142248368f); q = q * t + 0.127414796f; q = q * t;
    const f32x2 s = (v * v) * (-0.72134752044f);
    f32x2 e; e.x = __builtin_amdgcn_exp2f(s.x); e.y = __builtin_amdgcn_exp2f(s.y);
    const f32x2 m = v * (q * e), r = v - m;
    f32x2 o; o.x = v.x < 0.f ? m.x : r.x; o.y = v.y < 0.f ? m.y : r.y; return o;
}

template <int ACT  > struct EpiBf16 {
    static constexpr bool PERM = true, AFTER_DRAIN = false; static_assert(ACT == 0 || ACT == 1, "EpiBf16: ACT is 0 (none) or 1 (gelu_pk)");
    bf16_t* O; int ldc; const float* bias; int split_cols; size_t split_stride; float scale0;
    __device__ __forceinline__ void operator()(const f32x4 (&acc)[2][2][4][2], const Unit& u, int wr, int wc, int fr, int fq) const {
        const int row0 = u.pm * BM + wr * 64 + fr; int colt = u.pn * BM; bf16_t* base = O;
        float sc = 1.f; if (split_cols) { const int t = colt / split_cols; base += (size_t)t * split_stride; colt -= t * split_cols; if (t == 0) sc = scale0; }
        const int col0 = colt + wc * 32 + 8 * fq, bcol0 = u.pn * BM + wc * 32 + 8 * fq;
        f32x4 bv[2][2];
#pragma unroll
        for (int bj = 0; bj < 2; ++bj)
#pragma unroll
            for (int n = 0; n < 2; ++n) bv[bj][n] = bias ? *(const f32x4*)(bias + bcol0 + bj * HALF + 4 * n) : (f32x4){0.f, 0.f, 0.f, 0.f};
#pragma unroll
        for (int ai = 0; ai < 2; ++ai)
#pragma unroll
            for (int m = 0; m < 4; ++m) { bf16_t* rowp = base + (size_t)(row0 + ai * HALF + m * 16) * ldc + col0;
#pragma unroll
                for (int bj = 0; bj < 2; ++bj) { f32x4 v0 = acc[ai][bj][m][0] + bv[bj][0], v1 = acc[ai][bj][m][1] + bv[bj][1];
                    if (ACT == 1) { f32x2 a = gelu_pk((f32x2){v0[0], v0[1]}), b = gelu_pk((f32x2){v0[2], v0[3]}), c = gelu_pk((f32x2){v1[0], v1[1]}), d = gelu_pk((f32x2){v1[2], v1[3]});
                        v0 = (f32x4){a.x, a.y, b.x, b.y}; v1 = (f32x4){c.x, c.y, d.x, d.y}; }
                    v0 = v0 * sc; v1 = v1 * sc; u32x4 w; w.x = cvt_pk_bf16(v0[0], v0[1]); w.y = cvt_pk_bf16(v0[2], v0[3]); w.z = cvt_pk_bf16(v1[0], v1[1]); w.w = cvt_pk_bf16(v1[2], v1[3]);
                    *(u32x4*)(rowp + bj * HALF) = w; } }
    }
};
template <class Epi, class Sched, bool ALIGN_EPI = false, bool SP2 = false>
__device__ __forceinline__ void gemm_phase(PG8_LAS unsigned char* lds, const Gemm g, const Sched& S, const Epi& E) {
    const int tid = threadIdx.x, wid = __builtin_amdgcn_readfirstlane(tid >> 6), lane = tid & 63, wr = wid >> 2, wc = wid & 3, fr = lane & 15, fq = lane >> 4;
    const int K = g.K, nt = K / BK;
    unsigned voffA[2], voffB[2];
#pragma unroll
    for (int i = 0; i < 2; ++i) { int R, C; stage_rc(tid * 16 + i * 8192, R, C); const int Rb = Epi::PERM ? ((R & ~31) + perm32(R & 31)) : R;
        voffA[i] = (unsigned)(R * K + C) * 2u; voffB[i] = (unsigned)(Rb * K + C) * 2u; }
    const size_t kstep = (size_t)(BK * 2);
    const size_t hstep = (size_t)HALF * K * 2;
    const size_t tstep = 2 * hstep;
    const unsigned ldsw = (unsigned)wid * 1024u;
    const int aoff = lds_byte(wr * 64 + fr, fq * 8), boff = lds_byte(wc * 32 + fr, fq * 8);
#define PG8_SA(b, h) (((b) * 2 + (h)) * HTB)
#define PG8_SB(b, h) ((4 + (b) * 2 + (h)) * HTB)
#define PG8_STAGE(bufoff, gbase, voff) do { _Pragma("unroll") for (int _i = 0; _i < 2; ++_i) \
        __builtin_amdgcn_global_load_lds((const unsigned*)((const char*)(gbase) + (voff)[_i]), (PG8_LAS unsigned*)(lds + (bufoff) + ldsw + _i * 8192), 16, 0, 0); } while (0)
#define PG8_LDA(dst, b, h) do { _Pragma("unroll") for (int m = 0; m < 4; ++m) _Pragma("unroll") for (int k = 0; k < 2; ++k) dst[m][k] = *(const PG8_LAS bf16x8*)(lds + PG8_SA(b, h) + aoff + m * 2048 + k * 1024); } while (0)
#define PG8_LDB(dst, b, h) do { _Pragma("unroll") for (int n = 0; n < 2; ++n) _Pragma("unroll") for (int k = 0; k < 2; ++k) dst[n][k] = *(const PG8_LAS bf16x8*)(lds + PG8_SB(b, h) + boff + n * 2048 + k * 1024); } while (0)
#define PG8_MMA(ai, bj, At, Bt) do { __builtin_amdgcn_s_setprio(1); _Pragma("unroll") for (int m = 0; m < 4; ++m) _Pragma("unroll") for (int n = 0; n < 2; ++n) _Pragma("unroll") for (int k = 0; k < 2; ++k) \
        acc[ai][bj][m][n] = __builtin_amdgcn_mfma_f32_16x16x32_bf16(Bt[n][k], At[m][k], acc[ai][bj][m][n], 0, 0, 0); __builtin_amdgcn_s_setprio(0); } while (0)
#define PG8_WAIT_V(n) asm volatile("s_waitcnt vmcnt(" #n ")" ::: "memory")
#define PG8_WAIT_L(n) asm volatile("s_waitcnt lgkmcnt(" #n ")" ::: "memory")
#define PG8_BAR __builtin_amdgcn_s_barrier()
#define PG8_SCHED __builtin_amdgcn_sched_barrier(0)
    Unit cur, nxt; int ui = 0;
    if (!S.next(0, cur)) return;
    f32x4 acc[2][2][4][2];
#pragma unroll
    for (int a = 0; a < 2; ++a)
#pragma unroll
        for (int b = 0; b < 2; ++b)
#pragma unroll
            for (int m = 0; m < 4; ++m)
#pragma unroll
                for (int n = 0; n < 2; ++n) acc[a][b][m][n] = (f32x4){0.f, 0.f, 0.f, 0.f};
    bf16x8 At[4][2], B0[2][2], B1[2][2];
    const char* cA = (const char*)g.A + (size_t)cur.pm * tstep; const char* cB = (const char*)g.Bt + (size_t)cur.pn * tstep;
    S.a_ready(cur);
    if constexpr (SP2) {
        PG8_STAGE(PG8_SB(0, 0), cB, voffB); PG8_STAGE(PG8_SB(0, 1), cB + hstep, voffB); PG8_STAGE(PG8_SA(0, 0), cA, voffA); PG8_STAGE(PG8_SA(0, 1), cA + hstep, voffA);
        if (wr == 1) PG8_BAR;
        PG8_WAIT_V(2); PG8_BAR;
        PG8_STAGE(PG8_SB(1, 0), cB + kstep, voffB); PG8_STAGE(PG8_SA(1, 0), cA + kstep, voffA); PG8_STAGE(PG8_SB(1, 1), cB + hstep + kstep, voffB);
        PG8_WAIT_V(6); PG8_BAR;
    } else {
        PG8_STAGE(PG8_SB(0, 0), cB, voffB); PG8_STAGE(PG8_SA(0, 0), cA, voffA); PG8_STAGE(PG8_SB(0, 1), cB + hstep, voffB); PG8_STAGE(PG8_SA(0, 1), cA + hstep, voffA);
        if (wr == 1) PG8_BAR;
        PG8_WAIT_V(4); PG8_BAR;
        PG8_STAGE(PG8_SB(1, 0), cB + kstep, voffB); PG8_STAGE(PG8_SA(1, 0), cA + kstep, voffA); PG8_STAGE(PG8_SB(1, 1), cB + hstep + kstep, voffB);
        PG8_WAIT_V(6); PG8_BAR;
    }
    for (;;) {
        const bool has_next = S.next(ui + 1, nxt);
        const char* nA = has_next ? (const char*)g.A + (size_t)nxt.pm * tstep : cA; const char* nB = has_next ? (const char*)g.Bt + (size_t)nxt.pn * tstep : cB;
        for (int t = 0; t < nt; t += 2) {
            const bool last = (t == nt - 2);
            const char* a1 = cA + (size_t)(t + 1) * kstep;
            const char* a2 = last ? nA : cA + (size_t)(t + 2) * kstep; const char* b2 = last ? nB : cB + (size_t)(t + 2) * kstep;
            const char* a3 = a2 + kstep; const char* b3 = b2 + kstep;
            if (last && has_next) S.a_ready(nxt);
            if constexpr (SP2) {
            PG8_LDB(B0, 0, 0); PG8_LDB(B1, 0, 1); PG8_SCHED; PG8_LDA(At, 0, 0); PG8_STAGE(PG8_SA(1, 1), a1 + hstep, voffA);
            PG8_WAIT_V(8); PG8_WAIT_L(0); PG8_BAR; PG8_MMA(0, 0, At, B0); PG8_MMA(0, 1, At, B1); PG8_BAR; PG8_SCHED;
            PG8_LDA(At, 0, 1); PG8_STAGE(PG8_SB(0, 0), b2, voffB); PG8_STAGE(PG8_SB(0, 1), b2 + hstep, voffB); PG8_STAGE(PG8_SA(0, 0), a2, voffA);
            PG8_WAIT_V(8); PG8_WAIT_L(0); PG8_BAR; PG8_MMA(1, 0, At, B0); PG8_MMA(1, 1, At, B1); PG8_BAR; PG8_SCHED;
            PG8_LDB(B0, 1, 0); PG8_LDB(B1, 1, 1); PG8_SCHED; PG8_LDA(At, 1, 0); PG8_STAGE(PG8_SA(0, 1), a2 + hstep, voffA);
            PG8_WAIT_V(8); PG8_WAIT_L(0); PG8_BAR; PG8_MMA(0, 0, At, B0); PG8_MMA(0, 1, At, B1); PG8_BAR; PG8_SCHED;
            PG8_LDA(At, 1, 1); PG8_STAGE(PG8_SB(1, 0), b3, voffB); PG8_STAGE(PG8_SB(1, 1), b3 + hstep, voffB); PG8_STAGE(PG8_SA(1, 0), a3, voffA);
            PG8_WAIT_V(8); PG8_WAIT_L(0); PG8_BAR; PG8_MMA(1, 0, At, B0); PG8_MMA(1, 1, At, B1); PG8_BAR; PG8_SCHED;
            } else {
            PG8_LDB(B0, 0, 0); PG8_SCHED; PG8_LDA(At, 0, 0); PG8_STAGE(PG8_SA(1, 1), a1 + hstep, voffA);
            PG8_WAIT_L(8); PG8_BAR; PG8_WAIT_L(0); PG8_MMA(0, 0, At, B0); PG8_BAR; PG8_SCHED;
            PG8_LDB(B1, 0, 1); PG8_STAGE(PG8_SB(0, 0), b2, voffB);
            PG8_BAR; PG8_WAIT_L(0); PG8_MMA(0, 1, At, B1); PG8_BAR;
            PG8_LDA(At, 0, 1); PG8_STAGE(PG8_SA(0, 0), a2, voffA);
            PG8_BAR; PG8_WAIT_L(0); PG8_MMA(1, 0, At, B0); PG8_BAR; PG8_SCHED;
            PG8_STAGE(PG8_SB(0, 1), b2 + hstep, voffB);
            PG8_WAIT_V(6); PG8_BAR; PG8_MMA(1, 1, At, B1); PG8_BAR;
            PG8_LDB(B0, 1, 0); PG8_SCHED; PG8_LDA(At, 1, 0); PG8_STAGE(PG8_SA(0, 1), a2 + hstep, voffA);
            PG8_WAIT_L(8); PG8_BAR; PG8_WAIT_L(0); PG8_MMA(0, 0, At, B0); PG8_BAR; PG8_SCHED;
            PG8_LDB(B1, 1, 1); PG8_STAGE(PG8_SB(1, 0), b3, voffB);
            PG8_BAR; PG8_WAIT_L(0); PG8_MMA(0, 1, At, B1); PG8_BAR;
            PG8_LDA(At, 1, 1); PG8_STAGE(PG8_SA(1, 0), a3, voffA);
            PG8_BAR; PG8_WAIT_L(0); PG8_MMA(1, 0, At, B0); PG8_BAR; PG8_SCHED;
            PG8_STAGE(PG8_SB(1, 1), b3 + hstep, voffB);
            PG8_WAIT_V(6); PG8_BAR; PG8_MMA(1, 1, At, B1); PG8_BAR;
            }
        }
        if constexpr (ALIGN_EPI) { if (wr == 0) PG8_BAR; }
        if constexpr (!Epi::AFTER_DRAIN) { E(acc, cur, wr, wc, fr, fq); S.done(cur); }
        if (!has_next) break;
#pragma unroll
        for (int a = 0; a < 2; ++a)
#pragma unroll
            for (int b = 0; b < 2; ++b)
#pragma unroll
                for (int m = 0; m < 4; ++m)
#pragma unroll
                    for (int n = 0; n < 2; ++n) acc[a][b][m][n] = (f32x4){0.f, 0.f, 0.f, 0.f};
        cur = nxt; cA = nA; cB = nB; ++ui;
        if constexpr (ALIGN_EPI) { if (wr == 1) PG8_BAR; }
    }
    PG8_WAIT_V(0);
    if constexpr (!ALIGN_EPI) { if (wr == 0) PG8_BAR; }
    PG8_BAR;
    if constexpr (Epi::AFTER_DRAIN) { E.fused(acc, cur, wr, wc, fr, fq, lds, wid, lane); S.done(cur); }
#undef PG8_SA
#undef PG8_SB
#undef PG8_STAGE
#undef PG8_LDA
#undef PG8_LDB
#undef PG8_MMA
#undef PG8_WAIT_V
#undef PG8_WAIT_L
#undef PG8_BAR
#undef PG8_SCHED
}
}

#ifndef PG8_SP2
#define PG8_SP2 true
#endif
#ifndef PG8_ALIGN
#define PG8_ALIGN true
#endif
#define GAS __attribute__((address_space(1)))
#define LAS __attribute__((address_space(3)))
typedef unsigned short bf16;
typedef unsigned v4u __attribute__((ext_vector_type(4)));
typedef float f32x4 __attribute__((ext_vector_type(4)));
typedef short bf16x8 __attribute__((ext_vector_type(8)));
typedef GAS unsigned gu32;
typedef GAS unsigned long long gu64;
#define RLX_AGENT __ATOMIC_RELAXED, __HIP_MEMORY_SCOPE_AGENT
#define LDS_WAIT() asm volatile("s_waitcnt lgkmcnt(0)" ::: "memory")
#define VM_WAIT() asm volatile("s_waitcnt vmcnt(0)" ::: "memory")
__device__ __forceinline__ unsigned long long rt() { return __builtin_amdgcn_s_memrealtime(); }
__device__ __forceinline__ unsigned f2bf(float f) { unsigned u = __builtin_bit_cast(unsigned, f); return (u + 0x7fffu + ((u >> 16) & 1u)) >> 16; }
typedef float pk2_f32x2 __attribute__((ext_vector_type(2))); typedef __bf16 pk2_bf16x2 __attribute__((ext_vector_type(2)));
__device__ __forceinline__ unsigned pk2(float lo, float hi) { pk2_f32x2 v = {lo, hi}; pk2_bf16x2 b = __builtin_convertvector(v, pk2_bf16x2); return __builtin_bit_cast(unsigned, b); }

#define XB_TMO      128
#define XB_XCNT(j)  (256  + 64 * (j))
#define XB_XSUB(j)  (1280 + 64 * (j))
#define XB_XGEN(j)  (2304 + 64 * (j))
#define XB_TOP      3328
#define XB_TOPGEN   3392
#define XCD_BAR_WORDS 3456
#define XB_SPIN_CAP (1u << 18)

__device__ __forceinline__ unsigned xb_ld(unsigned* p)              { return __hip_atomic_load(p, __ATOMIC_RELAXED, __HIP_MEMORY_SCOPE_AGENT); }
__device__ __forceinline__ unsigned xb_add(unsigned* p, unsigned v) { return __hip_atomic_fetch_add(p, v, __ATOMIC_RELAXED, __HIP_MEMORY_SCOPE_AGENT); }
__device__ __forceinline__ unsigned xb_xcc_id() { return (unsigned)__builtin_amdgcn_s_getreg((3 << 11) | 20) & 0xFu; }
#define XB_SPIN(cond, bar) do { unsigned _sp = 0; while (cond) { __builtin_amdgcn_s_sleep(1); \
    if ((++_sp & 255u) == 0u) { if (xb_ld(&(bar)[XB_TMO])) break; if (_sp > XB_SPIN_CAP) { atomicAdd(&(bar)[XB_TMO], 1u); break; } } } } while (0)

struct XcdBarrier {
    unsigned* bar; unsigned x;
    volatile LAS unsigned* st;
};

__device__ __forceinline__ XcdBarrier xcd_barrier_post(unsigned* bar, volatile LAS unsigned* st) {
    XcdBarrier b; b.bar = bar; b.x = xb_xcc_id(); b.st = st;
    if (threadIdx.x == 0) (void)xb_add(&bar[XB_XCNT(b.x)], 1u);
    return b;
}
__device__ __forceinline__ void xcd_barrier_complete(unsigned* bar, unsigned x, unsigned& nloc, unsigned& nx) {
    const unsigned G = gridDim.x * gridDim.y * gridDim.z;
    unsigned sum, cnt, mine, sp = 0u;
    for (;;) {
        sum = 0u; cnt = 0u; mine = 0u;
#pragma unroll
        for (unsigned j = 0; j < 16; ++j) { const unsigned c = xb_ld(&bar[XB_XCNT(j)]); sum += c; cnt += (c > 0u) ? 1u : 0u; mine = (j == x) ? c : mine; }
        if (sum == G) break;
        __builtin_amdgcn_s_sleep(1);
        if ((++sp & 255u) == 0u) { if (xb_ld(&bar[XB_TMO])) break; if (sp > XB_SPIN_CAP) { atomicAdd(&bar[XB_TMO], 1u); break; } }
    }
    nloc = mine > 0u ? mine : 1u; nx = cnt > 0u ? cnt : 1u;
}

__device__ __forceinline__ void xcd_barrier(const XcdBarrier& b) {
    asm volatile("s_waitcnt vmcnt(0)" ::: "memory");
    __syncthreads();
    if (threadIdx.x == 0) {
        unsigned* bar = b.bar;
        __builtin_amdgcn_s_waitcnt(0);
        unsigned nloc = b.st[0], nx = b.st[1];
        if (nloc == 0u) { xcd_barrier_complete(bar, b.x, nloc, nx); b.st[0] = nloc; b.st[1] = nx; }
        const unsigned old = xb_add(&bar[XB_XSUB(b.x)], 1u);
        const unsigned gen = old / nloc;
        if (old + 1u == (gen + 1u) * nloc) {
            __builtin_amdgcn_fence(__ATOMIC_RELEASE, "agent");
            asm volatile("s_waitcnt vmcnt(0)" ::: "memory");
            const unsigned og = xb_add(&bar[XB_TOP], 1u);
            const unsigned tg = og / nx;
            if (og + 1u == (tg + 1u) * nx) xb_add(&bar[XB_TOPGEN], 1u);
            else XB_SPIN(xb_ld(&bar[XB_TOPGEN]) == tg, bar);
            __builtin_amdgcn_fence(__ATOMIC_ACQUIRE, "agent");
            xb_add(&bar[XB_XGEN(b.x)], 1u);
            asm volatile("s_waitcnt vmcnt(0)" ::: "memory");
        } else {
            XB_SPIN(xb_ld(&bar[XB_XGEN(b.x)]) == gen, bar);
            __builtin_amdgcn_fence(__ATOMIC_ACQUIRE, "agent");
            asm volatile("s_waitcnt vmcnt(0)" ::: "memory");
        }
    }
    __syncthreads();
}


constexpr int NWAVES = 8;
constexpr int DM = 2048, BATCH = 4, SEQ = 4096, M = BATCH * SEQ;
constexpr int NIN = 6176, NINP = 6144;
constexpr int O_GQ = 0, O_GK = 512, O_GV = 1024, O_GR = 2048, O_AQ = 3072, O_AK = 4096, O_AV = 5120;
constexpr float EPS = 1e-6f;
constexpr int PEER_K = 128;

constexpr size_t MiB = 1u << 20;
constexpr size_t WS_CTL = 0, CTL_ZERO_BYTES = 1 * MiB;
constexpr size_t WS_WIN = 1 * MiB;
constexpr size_t WS_WGD = 25 * MiB;
constexpr size_t WS_GDB = 62 * MiB;
constexpr size_t WS_WOUT = 26 * MiB;
constexpr size_t WS_WQ = 34 * MiB;
constexpr size_t WS_SSQ = 42 * MiB;
constexpr size_t WS_EIDX = 44 * MiB;
constexpr size_t WS_GATE = 52 * MiB;
constexpr size_t WS_SKB = 60 * MiB;
constexpr size_t WS_XN = 64 * MiB;
constexpr size_t WS_PROJ = 128 * MiB;
constexpr size_t WS_HB = 256 * MiB;
constexpr size_t WS_OF = 328 * MiB;
constexpr size_t WS_OB = 360 * MiB;
constexpr size_t WS_ATTP = 392 * MiB;
constexpr size_t WS_ATTML = 488 * MiB;
constexpr size_t WS_GT_QD = 64 * MiB;
constexpr size_t WS_GT_KE = 96 * MiB;
constexpr size_t OUT_GT_AM = 0;
constexpr size_t OUT_GT_DEC = 16 * MiB;
constexpr size_t OUT_GT_VT = 32 * MiB;
constexpr int CW_ATTQ = 64;
constexpr size_t WS_END = 494 * MiB;
constexpr size_t OUT_U8 = 64 * MiB;
constexpr size_t OUT_V8 = 96 * MiB;
constexpr size_t WS_SU = 61 * MiB;
constexpr size_t WS_SV = 61 * MiB + 65536;
constexpr int CW_CONVQ = 256;
constexpr size_t WS_PW = 128 * MiB;
constexpr size_t WS_SSQ2 = 136 * MiB;
constexpr size_t WS_PD = 64 * MiB;
constexpr int PEER_E = 16384;
constexpr int CW_TMO = 0, CW_CODE = 1, CW_BAR = 4096;

constexpr int RING_OFF = 0, RING_BYTES = 131072;
constexpr int LDS_BYTES = 163840;
constexpr int LDSCTL_OFF = LDS_BYTES - 1024, MISC_OFF = LDSCTL_OFF + 320;

typedef float f32x2 __attribute__((ext_vector_type(2)));
typedef float f32x16 __attribute__((ext_vector_type(16)));
typedef int i32x4 __attribute__((ext_vector_type(4)));
__device__ __forceinline__ float bf2f(unsigned short h) { return __builtin_bit_cast(float, (unsigned)h << 16); }
__device__ __forceinline__ float bflo(unsigned w) { return __builtin_bit_cast(float, w << 16); }
__device__ __forceinline__ float bfhi(unsigned w) { return __builtin_bit_cast(float, w & 0xffff0000u); }
__device__ __forceinline__ float wave_sum(float v) {
#pragma unroll
    for (int o = 1; o < 64; o <<= 1) v += __shfl_xor(v, o);
    return v;
}
__device__ __forceinline__ float wave_max(float v) {
#pragma unroll
    for (int o = 1; o < 64; o <<= 1) v = fmaxf(v, __shfl_xor(v, o));
    return v;
}

template <class T> __device__ __forceinline__ T* opaque(T* p) { asm volatile("" : "+s"(p)); return (T*)(GAS T*)p; }
__device__ __forceinline__ int lane_id() { int x; asm volatile("v_mbcnt_lo_u32_b32 %0, -1, 0\n\tv_mbcnt_hi_u32_b32 %0, -1, %0" : "=v"(x)); return x; }
__device__ __forceinline__ int opaque_v(int x) { asm volatile("" : "+v"(x)); return x; }
template <class T> __device__ __forceinline__ T ldu(const void* ubase, unsigned voff) { return *(const GAS T*)((const GAS char*)ubase + voff); }
template <class T> __device__ __forceinline__ void stu(void* ubase, unsigned voff, T v) { *(GAS T*)((GAS char*)ubase + voff) = v; }
namespace pg8 {
struct EpiRes {
    static constexpr bool PERM = true, AFTER_DRAIN = false;
    const float* x; bf16_t* HB; float* ssq; int ldc;
    __device__ __forceinline__ void operator()(const f32x4 (&acc)[2][2][4][2], const Unit& u, int wr, int wc, int fr, int fq) const {
        const int col0 = u.pn * BM + wc * 32 + 8 * fq;
        const int rbase = u.pm * BM + wr * 64 + fr;
        f32x4 xc[2][2], xn[2][2];
#define EPIRES_LOAD(D, IDX) do { const size_t o_ = (size_t)(rbase + ((IDX) >> 2) * HALF + ((IDX) & 3) * 16) * ldc + col0; _Pragma("unroll") for (int bj = 0; bj < 2; ++bj) { D[bj][0] = *(const f32x4*)(x + o_ + bj * HALF); D[bj][1] = *(const f32x4*)(x + o_ + bj * HALF + 4); } } while (0)
        EPIRES_LOAD(xc, 0);
#pragma unroll
        for (int idx = 0; idx < 8; ++idx) { const int ai = idx >> 2, m = idx & 3;
            if (idx + 1 < 8) EPIRES_LOAD(xn, idx + 1);
            const int r = rbase + ai * HALF + m * 16; const size_t off = (size_t)r * ldc + col0; float s = 0.f;
#pragma unroll
            for (int bj = 0; bj < 2; ++bj) {
                const f32x4 h0 = xc[bj][0] + acc[ai][bj][m][0], h1 = xc[bj][1] + acc[ai][bj][m][1];
                s += ((h0[0] * h0[0] + h0[1] * h0[1]) + (h0[2] * h0[2] + h0[3] * h0[3])) + ((h1[0] * h1[0] + h1[1] * h1[1]) + (h1[2] * h1[2] + h1[3] * h1[3]));
                u32x4 w; w.x = cvt_pk_bf16(h0[0], h0[1]); w.y = cvt_pk_bf16(h0[2], h0[3]); w.z = cvt_pk_bf16(h1[0], h1[1]); w.w = cvt_pk_bf16(h1[2], h1[3]);
                *(u32x4*)(HB + off + bj * HALF) = w;
            }
            s += __shfl_xor(s, 16); s += __shfl_xor(s, 32);
            if (fq == 0) ssq[(size_t)r * 32 + u.pn * 4 + wc] = s;
#pragma unroll
            for (int bj = 0; bj < 2; ++bj) { xc[bj][0] = xn[bj][0]; xc[bj][1] = xn[bj][1]; }
        }
#undef EPIRES_LOAD
    }
};
}

struct Frame {
    LAS unsigned char* lds;
    volatile LAS unsigned* MISC;
    gu32* ctl;
    int wave;
    int vcu, G;
};

__device__ __forceinline__ void p0_transpose_item(const float* W, int K, int ldw, const float* gk, bf16* WT, LAS float* scr, int item, int lane) {
    const int nblk = ldw / 32, kb = item / nblk, nb = item % nblk, k0 = 64 * kb, n0 = 32 * nb;
#pragma unroll 8
    for (int i = 0; i < 32; ++i) { const int kk = 2 * i + (lane >> 5); float w = W[(size_t)(k0 + kk) * ldw + n0 + (lane & 31)]; if (gk) w *= gk[k0 + kk]; scr[kk * 33 + (lane & 31)] = w; }
    LDS_WAIT(); asm volatile("" ::: "memory");
    const int c = lane & 7;
#pragma unroll
    for (int j = 0; j < 4; ++j) { const int n = (lane >> 3) + 8 * j; const LAS float* s = scr + (8 * c) * 33 + n;
        v4u o; o.x = pk2(s[0 * 33], s[1 * 33]); o.y = pk2(s[2 * 33], s[3 * 33]); o.z = pk2(s[4 * 33], s[5 * 33]); o.w = pk2(s[6 * 33], s[7 * 33]);
        *(GAS v4u*)(WT + (size_t)(n0 + n) * K + k0 + 8 * c) = o; }
    LDS_WAIT(); asm volatile("" ::: "memory");
}
struct Args {
    const float* in[16]; float* out; unsigned char* ws; int ph_lo, ph_hi, li, pad;
};

__device__ __forceinline__ void p0_prologue(Frame& F, const Args& a) {
    unsigned char* ws = a.ws;
    LAS float* scr = (LAS float*)(F.lds + RING_OFF + F.wave * 16384);
    const int gw = F.vcu * NWAVES + F.wave, NGW = F.G * NWAVES;
    bf16* Win_t = (bf16*)(ws + WS_WIN); bf16* Wout_t = (bf16*)(ws + WS_WOUT); bf16* Wq_t = (bf16*)(ws + WS_WQ); bf16* XN = (bf16*)(ws + WS_XN);
    constexpr int I_IN = (DM / 64) * (NIN / 32), I_SQ = (DM / 64) * (DM / 32);
    constexpr int NITEMS = I_IN + 2 * I_SQ;
    for (int it = gw; it < NITEMS; it += NGW) {
        int r = it;
        if (r < I_IN) { const int nb = r % (NIN / 32); bf16* dst = nb < 96 ? Win_t : nb == 96 ? (bf16*)(ws + WS_WGD) - (size_t)96 * 32 * DM : Win_t - (size_t)32 * DM;
            p0_transpose_item(a.in[2], DM, NIN, nullptr, dst, scr, r, lane_id()); continue; } r -= I_IN;
        if (r < I_SQ) { p0_transpose_item(a.in[9], DM, DM, nullptr, Wout_t, scr, r, lane_id()); continue; } r -= I_SQ;
        p0_transpose_item(a.in[11], DM, DM, a.in[10], Wq_t, scr, r, lane_id());
    }
    { const f32x4* sk = (const f32x4*)a.in[12]; unsigned long long* skb = (unsigned long long*)(ws + WS_SKB);
      for (int i = gw * 64 + lane_id(); i < 8 * 2 * 128 * 128 / 4; i += NGW * 64) { const f32x4 v = sk[i]; skb[i] = (unsigned long long)pk2(v.x, v.y) | ((unsigned long long)pk2(v.z, v.w) << 32); } }
    { const GAS f32x4* gr = (const GAS f32x4*)a.in[1] + lane_id(); f32x4 gg[8];
#pragma unroll
      for (int j = 0; j < 8; ++j) gg[j] = gr[64 * j];
      f32x4 v[8], vn[8];
      if (gw < M) {
#pragma unroll
          for (int j = 0; j < 8; ++j) v[j] = ((const GAS f32x4*)(a.in[0] + (size_t)gw * DM) + lane_id())[64 * j]; }
      for (int m = gw; m < M; m += NGW) { const int mn = m + NGW < M ? m + NGW : m;
#pragma unroll
          for (int j = 0; j < 8; ++j) vn[j] = ((const GAS f32x4*)(a.in[0] + (size_t)mn * DM) + lane_id())[64 * j];
          float ss = 0.f;
#pragma unroll
          for (int j = 0; j < 8; ++j) ss += (v[j].x * v[j].x + v[j].y * v[j].y) + (v[j].z * v[j].z + v[j].w * v[j].w);
          const float rstd = 1.f / sqrtf(wave_sum(ss) * (1.f / DM) + EPS);
          GAS unsigned long long* o8 = (GAS unsigned long long*)(XN + (size_t)m * DM) + lane_id();
#pragma unroll
          for (int j = 0; j < 8; ++j) o8[64 * j] = (unsigned long long)pk2(v[j].x * rstd * gg[j].x, v[j].y * rstd * gg[j].y) | ((unsigned long long)pk2(v[j].z * rstd * gg[j].z, v[j].w * rstd * gg[j].w) << 32);
#pragma unroll
          for (int j = 0; j < 8; ++j) v[j] = vn[j]; } }
}


__device__ __forceinline__ void gd_side_gemm(Frame& F, const Args& a) {
    unsigned char* ws = a.ws; const bf16* XN = (const bf16*)(ws + WS_XN); const bf16* WG = (const bf16*)(ws + WS_WGD); float* GDB = (float*)(ws + WS_GDB);
    const int lane = lane_id(), w = F.wave, r32 = lane & 31, hh = lane >> 5; LAS float* part = (LAS float*)F.lds;
    for (int blk = F.vcu; blk < M / 64; blk += F.G) { const int tok0 = blk * 64;
        f32x16 acc[2];
#pragma unroll
        for (int tt = 0; tt < 2; ++tt) acc[tt] = (f32x16){0.f, 0.f, 0.f, 0.f, 0.f, 0.f, 0.f, 0.f, 0.f, 0.f, 0.f, 0.f, 0.f, 0.f, 0.f, 0.f};
#pragma unroll 4
        for (int ks = 0; ks < 16; ++ks) { const int k0 = 256 * w + 16 * ks + 8 * hh; const bf16x8 bw = *(const bf16x8*)(WG + (size_t)r32 * DM + k0);
#pragma unroll
            for (int tt = 0; tt < 2; ++tt) { const bf16x8 ax = *(const bf16x8*)(XN + (size_t)(tok0 + 32 * tt + r32) * DM + k0); acc[tt] = __builtin_amdgcn_mfma_f32_32x32x16_bf16(ax, bw, acc[tt], 0, 0, 0); } }
#pragma unroll
        for (int tt = 0; tt < 2; ++tt)
#pragma unroll
            for (int r = 0; r < 16; ++r) { const float x = acc[tt][r]; part[((w * 2 + tt) * 16 + r) * 64 + lane] = x; }
        __syncthreads();
#pragma unroll
        for (int i = 0; i < 4; ++i) { const int o = (F.wave * 64 + lane_id()) + 512 * i; float sum = 0.f;
#pragma unroll
            for (int ww = 0; ww < 8; ++ww) sum += part[ww * 2048 + o];
            const int tt = o >> 10, r = (o >> 6) & 15, ln = o & 63; const int t = 32 * tt + (r & 3) + 8 * (r >> 2) + 4 * (ln >> 5);
            GDB[(size_t)(tok0 + t) * 32 + (ln & 31)] = sum; }
        __syncthreads();
    }
}

__device__ __forceinline__ void p3_finalize(Frame& F, const Args& a) {
    unsigned char* ws = a.ws;
    const int gw = F.vcu * NWAVES + F.wave, NGW = F.G * NWAVES, lane = lane_id();
    const GAS bf16* OFp = (const GAS bf16*)(ws + WS_OF); const GAS bf16* OBp = (const GAS bf16*)(ws + WS_OB);
    const GAS bf16* PROJ = (const GAS bf16*)(ws + WS_PROJ); GAS bf16* Y = (GAS bf16*)(ws + WS_XN);
    const GAS float* ATTML = (const GAS float*)(ws + WS_ATTML); const GAS bf16* ATTP = (const GAS bf16*)(ws + WS_ATTP);
    const GAS float* gla_g = (const GAS float*)a.in[7]; const GAS float* att_g = (const GAS float*)a.in[8];
    const f32x4 gg = *(const GAS f32x4*)(gla_g + 4 * lane);
    f32x4 ag[2][2];
#pragma unroll
    for (int p = 0; p < 2; ++p) { ag[p][0] = *(const GAS f32x4*)(att_g + p * 512 + 8 * lane); ag[p][1] = *(const GAS f32x4*)(att_g + p * 512 + 8 * lane + 4); }
    unsigned long long wf[4], wb[4], gr[4], nwf[4], nwb[4], ngr[4]; f32x2 ml[2][3], nml[2][3]; v4u ow[2][3], now[2][3];
#define P3_LOAD(MM, WF, WB, GR, ML, OW) do { _Pragma("unroll") for (int hh = 0; hh < 4; ++hh) { WF[hh] = *(const GAS unsigned long long*)(OFp + (size_t)(MM) * 1024 + hh * 256 + 4 * lane); \
            WB[hh] = *(const GAS unsigned long long*)(OBp + (size_t)(MM) * 1024 + hh * 256 + 4 * lane); GR[hh] = *(const GAS unsigned long long*)(PROJ + (size_t)(MM) * NINP + O_GR + hh * 256 + 4 * lane); } \
        _Pragma("unroll") for (int p = 0; p < 2; ++p) { const int col = p * 512 + 8 * lane, hd = col >> 6; _Pragma("unroll") for (int pt = 0; pt < 3; ++pt) { const size_t rec = ((size_t)pt * M + (MM)) * 16 + hd; \
            ML[p][pt] = *(const GAS f32x2*)(ATTML + rec * 2); OW[p][pt] = *(const GAS v4u*)(ATTP + rec * 64 + (col & 63)); } } } while (0)
    if (gw < M) P3_LOAD(gw, wf, wb, gr, ml, ow);
    for (int m = gw; m < M; m += NGW) {
        const int mn = m + NGW < M ? m + NGW : m;
        P3_LOAD(mn, nwf, nwb, ngr, nml, now);
#pragma unroll
        for (int hh = 0; hh < 4; ++hh) {
            const f32x4 o = (f32x4){bflo((unsigned)wf[hh]) + bflo((unsigned)wb[hh]), bfhi((unsigned)wf[hh]) + bfhi((unsigned)wb[hh]), bflo((unsigned)(wf[hh] >> 32)) + bflo((unsigned)(wb[hh] >> 32)), bfhi((unsigned)(wf[hh] >> 32)) + bfhi((unsigned)(wb[hh] >> 32))};
            const float ss = wave_sum((o.x * o.x + o.y * o.y) + (o.z * o.z + o.w * o.w));
            const float rstd = 1.f / sqrtf(ss * (1.f / 256.f) + EPS);
            const float r0 = bflo((unsigned)gr[hh]), r1 = bfhi((unsigned)gr[hh]), r2 = bflo((unsigned)(gr[hh] >> 32)), r3 = bfhi((unsigned)(gr[hh] >> 32));
            const float y0 = o.x * rstd * gg.x * (r0 / (1.f + __expf(-r0))), y1 = o.y * rstd * gg.y * (r1 / (1.f + __expf(-r1)));
            const float y2 = o.z * rstd * gg.z * (r2 / (1.f + __expf(-r2))), y3 = o.w * rstd * gg.w * (r3 / (1.f + __expf(-r3)));
            *(GAS unsigned long long*)(Y + (size_t)m * DM + hh * 256 + 4 * lane) = (unsigned long long)pk2(y0, y1) | ((unsigned long long)pk2(y2, y3) << 32);
        }
        float av[16]; float ss = 0.f;
#pragma unroll
        for (int p = 0; p < 2; ++p) {
            const float mt = fmaxf(fmaxf(ml[p][0].x, ml[p][1].x), ml[p][2].x); const float w0 = __expf(ml[p][0].x - mt), w1 = __expf(ml[p][1].x - mt), w2 = __expf(ml[p][2].x - mt);
            const float inv = 1.f / (w0 * ml[p][0].y + w1 * ml[p][1].y + w2 * ml[p][2].y);
            av[p * 8 + 0] = (w0 * bflo(ow[p][0].x) + w1 * bflo(ow[p][1].x) + w2 * bflo(ow[p][2].x)) * inv; av[p * 8 + 1] = (w0 * bfhi(ow[p][0].x) + w1 * bfhi(ow[p][1].x) + w2 * bfhi(ow[p][2].x)) * inv;
            av[p * 8 + 2] = (w0 * bflo(ow[p][0].y) + w1 * bflo(ow[p][1].y) + w2 * bflo(ow[p][2].y)) * inv; av[p * 8 + 3] = (w0 * bfhi(ow[p][0].y) + w1 * bfhi(ow[p][1].y) + w2 * bfhi(ow[p][2].y)) * inv;
            av[p * 8 + 4] = (w0 * bflo(ow[p][0].z) + w1 * bflo(ow[p][1].z) + w2 * bflo(ow[p][2].z)) * inv; av[p * 8 + 5] = (w0 * bfhi(ow[p][0].z) + w1 * bfhi(ow[p][1].z) + w2 * bfhi(ow[p][2].z)) * inv;
            av[p * 8 + 6] = (w0 * bflo(ow[p][0].w) + w1 * bflo(ow[p][1].w) + w2 * bflo(ow[p][2].w)) * inv; av[p * 8 + 7] = (w0 * bfhi(ow[p][0].w) + w1 * bfhi(ow[p][1].w) + w2 * bfhi(ow[p][2].w)) * inv; }
#pragma unroll
        for (int i = 0; i < 16; ++i) ss += av[i] * av[i];
        const float rstd = 1.f / sqrtf(wave_sum(ss) * (1.f / 1024.f) + EPS);
#pragma unroll
        for (int p = 0; p < 2; ++p) { const f32x4 g0 = ag[p][0], g1 = ag[p][1];
            v4u w; w.x = pk2(av[p * 8 + 0] * rstd * g0.x, av[p * 8 + 1] * rstd * g0.y); w.y = pk2(av[p * 8 + 2] * rstd * g0.z, av[p * 8 + 3] * rstd * g0.w);
            w.z = pk2(av[p * 8 + 4] * rstd * g1.x, av[p * 8 + 5] * rstd * g1.y); w.w = pk2(av[p * 8 + 6] * rstd * g1.z, av[p * 8 + 7] * rstd * g1.w);
            *(GAS v4u*)(Y + (size_t)m * DM + 1024 + p * 512 + 8 * lane) = w; }
#pragma unroll
        for (int hh = 0; hh < 4; ++hh) { wf[hh] = nwf[hh]; wb[hh] = nwb[hh]; gr[hh] = ngr[hh]; }
#pragma unroll
        for (int p = 0; p < 2; ++p)
#pragma unroll
            for (int pt = 0; pt < 3; ++pt) { ml[p][pt] = nml[p][pt]; ow[p][pt] = now[p][pt]; }
    }
#undef P3_LOAD
}


__device__ __forceinline__ void ce_desc(float& a, float& b) { const float hi = fmaxf(a, b), lo = fminf(a, b); a = hi; b = lo; }
__device__ __forceinline__ void sort16_desc(float* v) {
#pragma unroll
    for (int k = 2; k <= 16; k <<= 1)
#pragma unroll
        for (int j = k >> 1; j > 0; j >>= 1)
#pragma unroll
            for (int i = 0; i < 16; ++i) { const int l = i ^ j; if (l > i) { if ((i & k) == 0 || k == 16) ce_desc(v[i], v[l]); else ce_desc(v[l], v[i]); } }
}
__device__ __forceinline__ void merge16_desc(float* v) {
#pragma unroll
    for (int j = 8; j > 0; j >>= 1)
#pragma unroll
        for (int i = 0; i < 16; ++i) { const int l = i ^ j; if (l > i) ce_desc(v[i], v[l]); }
}
__device__ __forceinline__ void top16_of_two(float* a, const float* b) {
#pragma unroll
    for (int i = 0; i < 16; ++i) a[i] = fmaxf(a[i], b[15 - i]);
    merge16_desc(a);
}
__device__ __forceinline__ void top16_of_64(float* v) {
    sort16_desc(v); sort16_desc(v + 16); sort16_desc(v + 32); sort16_desc(v + 48);
    top16_of_two(v, v + 16); top16_of_two(v + 32, v + 48); top16_of_two(v, v + 32);
}
__device__ __forceinline__ void topk_phase(Frame& F, const Args& a) {
    unsigned char* ws = a.ws; const GAS bf16* QP = (const GAS bf16*)(ws + WS_XN); const GAS bf16* SKB = (const GAS bf16*)(ws + WS_SKB); GAS int* EIDX = (GAS int*)(ws + WS_EIDX); GAS float* GATE = (GAS float*)(ws + WS_GATE);
    const int lane = lane_id(), r32 = lane & 31, hh = lane >> 5;
    LAS unsigned char* skl = F.lds;
    LAS int* ktab = (LAS int*)(F.lds + 65536 + F.wave * 8192);
    for (int unit = F.vcu; unit < 8 * (M / 512); unit += F.G) {
        const int h = unit & 7, tok0 = (unit >> 3) * 512 + F.wave * 64;
        __syncthreads();
#pragma unroll
        for (int i = 0; i < 8; ++i) { const int idx = (F.wave * 64 + lane_id()) + 512 * i, key = idx >> 4, ch = idx & 15;
            *(LAS v4u*)(skl + key * 256 + ((ch ^ (key & 15)) * 16)) = *(const GAS v4u*)(SKB + ((size_t)h * 256 + key) * 128 + ch * 8); }
        __syncthreads();
#pragma unroll 1
        for (int tt = 0; tt < 2; ++tt) {
            const size_t row = (size_t)(tok0 + tt * 32 + r32);
            float L[2][16];
#pragma unroll
            for (int c = 0; c < 2; ++c) {
                f32x16 acc[4];
#pragma unroll
                for (int kt = 0; kt < 4; ++kt) acc[kt] = (f32x16){0.f, 0.f, 0.f, 0.f, 0.f, 0.f, 0.f, 0.f, 0.f, 0.f, 0.f, 0.f, 0.f, 0.f, 0.f, 0.f};
                const GAS bf16* qb = QP + row * DM + h * 256 + c * 128 + 8 * hh;
#pragma unroll 2
                for (int st = 0; st < 8; ++st) {
                    const bf16x8 bq = *(const GAS bf16x8*)(qb + 16 * st);
#pragma unroll
                    for (int kt = 0; kt < 4; ++kt) { const int key = c * 128 + 32 * kt + r32; const bf16x8 ak = *(const LAS bf16x8*)(skl + key * 256 + (((2 * st + hh) ^ (key & 15)) * 16));
                        acc[kt] = __builtin_amdgcn_mfma_f32_32x32x16_bf16(ak, bq, acc[kt], 0, 0, 0); }
                }
                float v[64];
#pragma unroll
                for (int kt = 0; kt < 4; ++kt)
#pragma unroll
                    for (int r = 0; r < 16; ++r) { const int key = 32 * kt + (r & 3) + 8 * (r >> 2);
                        const float sc = acc[kt][r];
                        v[kt * 16 + r] = __builtin_bit_cast(float, (__builtin_bit_cast(unsigned, sc) & ~127u) | (unsigned)(key + 4 * hh)); }
                top16_of_64(v);
                float p[16];
#pragma unroll
                for (int i = 0; i < 16; ++i) p[i] = __shfl_xor(v[i], 32);
                top16_of_two(v, p);
#pragma unroll
                for (int i = 0; i < 16; ++i) { L[c][i] = v[i]; ktab[(c * 16 + i) * 64 + lane] = (int)(__builtin_bit_cast(unsigned, v[i]) & 127u); }
            }
            float cnd[64];
            { int n = 0;
#pragma unroll
              for (int i = 0; i < 16; ++i)
#pragma unroll
                  for (int j = 0; j < 16; ++j) if ((i + 1) * (j + 1) <= 16) { cnd[n] = __builtin_bit_cast(float, (__builtin_bit_cast(unsigned, L[0][i] + L[1][j]) & ~255u) | (unsigned)((i << 4) | j)); ++n; }
#pragma unroll
              for (int q = 50; q < 64; ++q) cnd[q] = -3.0e38f; }
            top16_of_64(cnd);
            float rstd; { const GAS f32x4* sp = (const GAS f32x4*)((const GAS float*)(ws + WS_SSQ) + row * 32); float ssq = 0.f;
#pragma unroll
              for (int i = 0; i < 8; ++i) { const f32x4 t4 = sp[i]; ssq += (t4.x + t4.y) + (t4.z + t4.w); }
              rstd = 1.0f / sqrtf(ssq * (1.f / DM) + EPS); }
            float mx = __builtin_bit_cast(float, __builtin_bit_cast(unsigned, cnd[0]) & ~255u), sum = 0.f; float ex[16];
#pragma unroll
            for (int i = 0; i < 16; ++i) { ex[i] = __expf((__builtin_bit_cast(float, __builtin_bit_cast(unsigned, cnd[i]) & ~255u) - mx) * rstd); sum += ex[i]; }
            const float inv = 1.f / sum;
            LDS_WAIT(); asm volatile("" ::: "memory");
            if (hh == 0) {
                int ev[16];
#pragma unroll
                for (int i = 0; i < 16; ++i) { const unsigned bits = __builtin_bit_cast(unsigned, cnd[i]); const int ia = (bits >> 4) & 15, jb = bits & 15; ev[i] = ktab[ia * 64 + lane] * 128 + ktab[(16 + jb) * 64 + lane]; }
                GAS int* ep = EIDX + row * 128 + h * 16; GAS float* gp = GATE + row * 128 + h * 16;
#pragma unroll
                for (int i = 0; i < 4; ++i) { *(GAS i32x4*)(ep + 4 * i) = (i32x4){ev[4 * i], ev[4 * i + 1], ev[4 * i + 2], ev[4 * i + 3]}; *(GAS f32x4*)(gp + 4 * i) = (f32x4){ex[4 * i] * inv, ex[4 * i + 1] * inv, ex[4 * i + 2] * inv, ex[4 * i + 3] * inv}; }
            }
            LDS_WAIT(); asm volatile("" ::: "memory");
        }
    }
}

__device__ __forceinline__ void gla_prep_phase(Frame& F, const Args& a) {
    unsigned char* ws = a.ws; const bf16* PROJ;
    const int w = F.wave;
    LAS unsigned char* L = F.lds;
    LAS unsigned char* Qraw = L; LAS unsigned char* Kraw = L + 16384; LAS unsigned char* Vraw = L + 32768; LAS float* GDf = (LAS float*)(L + 65536); LAS float* GSUM = (LAS float*)(L + 73728);
    LAS unsigned char* IMGQ = L + 77824; LAS unsigned char* IMGK = L + 95232; LAS unsigned char* IMGE = L + 112640; LAS unsigned char* AMI = L + 32768;
    for (int it = F.vcu; it < 1024; it += F.G) {
        const int b = it >> 8, h = (it >> 6) & 3, n = it & 63; const size_t row0 = (size_t)b * SEQ + n * 64;
        ws = opaque(ws); PROJ = (const bf16*)(ws + WS_PROJ);
        int tid = opaque_v((F.wave * 64 + lane_id())), lane = tid & 63, r32 = lane & 31, hh = lane >> 5;
#pragma unroll
        for (int i = 0; i < 2; ++i) { const int idx = tid + 512 * i, r = idx >> 4, c = idx & 15;
            *(LAS v4u*)(Qraw + r * 256 + c * 16) = *(const GAS v4u*)(PROJ + (row0 + r) * NINP + O_GQ + h * 128 + c * 8);
            *(LAS v4u*)(Kraw + r * 256 + c * 16) = *(const GAS v4u*)(PROJ + (row0 + r) * NINP + O_GK + h * 128 + c * 8); }
#pragma unroll
        for (int i = 0; i < 4; ++i) { const int idx = tid + 512 * i, r = idx >> 5, c = idx & 31;
            *(LAS v4u*)(Vraw + r * 512 + c * 16) = *(const GAS v4u*)(PROJ + (row0 + r) * NINP + O_GV + h * 256 + c * 8); }
        if (tid < 256) { const int r = tid >> 2, c = tid & 3; const GAS float* gsrc = (const GAS float*)(ws + WS_GDB) + (row0 + r) * 32 + c * 8; const f32x4 g0 = *(const GAS f32x4*)gsrc, g1 = *(const GAS f32x4*)(gsrc + 4);
            *(LAS f32x4*)(GDf + r * 32 + c * 8) = g0; *(LAS f32x4*)(GDf + r * 32 + c * 8 + 4) = g1; }
        __syncthreads();
#pragma unroll
        for (int ks = 0; ks < 4; ++ks) { unsigned pk[4];
#pragma unroll
            for (int p = 0; p < 4; ++p) { const int s0 = 16 * ks + 8 * hh + 2 * p; const unsigned lo = *(const LAS unsigned short*)(Vraw + s0 * 512 + (32 * w + r32) * 2), hi = *(const LAS unsigned short*)(Vraw + (s0 + 1) * 512 + (32 * w + r32) * 2); pk[p] = lo | (hi << 16); }
            *(GAS v4u*)((unsigned char*)a.out + OUT_GT_VT + (size_t)it * 32768 + (w * 4 + ks) * 1024 + lane * 16) = (v4u){pk[0], pk[1], pk[2], pk[3]}; }
        for (int dir = 0; dir < 2; ++dir) {
            const size_t idir = (size_t)(((b * 4 + h) * 2 + dir) * 64 + n); ws = opaque(ws); tid = opaque_v(tid); lane = tid & 63; r32 = lane & 31; hh = lane >> 5;
            {
                const int d = tid & 127, tq = tid >> 7; const float* upp = (dir ? a.in[5] : a.in[3]) + h * 128 + d; const float bias = (dir ? a.in[6] : a.in[4])[h * 128 + d];
                float up[16];
#pragma unroll
                for (int r = 0; r < 16; ++r) up[r] = upp[r * 512];
                float c[16];
#pragma unroll
                for (int i = 0; i < 16; ++i) { const LAS float* g = GDf + (16 * tq + i) * 32 + dir * 16; float z = bias;
#pragma unroll
                    for (int r = 0; r < 16; ++r) z += g[r] * up[r];
                    c[i] = (fminf(z, 0.f) - __logf(1.f + __expf(-fabsf(z)))) * (1.f / 16.f); }
                if (dir == 0) {
#pragma unroll
                    for (int i = 1; i < 16; ++i) c[i] += c[i - 1];
                } else {
#pragma unroll
                    for (int i = 14; i >= 0; --i) c[i] += c[i + 1];
                }
                GSUM[(dir * 4 + tq) * 128 + d] = dir == 0 ? c[15] : c[0];
                __syncthreads();
                const float t0 = GSUM[(dir * 4 + 0) * 128 + d], t1 = GSUM[(dir * 4 + 1) * 128 + d], t2 = GSUM[(dir * 4 + 2) * 128 + d], t3 = GSUM[(dir * 4 + 3) * 128 + d];
                const float Bt = (t0 + t1) + (t2 + t3);
                float off;
                if (dir == 0) off = (tq > 0 ? t0 : 0.f) + (tq > 1 ? t1 : 0.f) + (tq > 2 ? t2 : 0.f);
                else off = (tq < 1 ? t1 : 0.f) + (tq < 2 ? t2 : 0.f) + (tq < 3 ? t3 : 0.f);
                unsigned kep[8];
#pragma unroll
                for (int i = 0; i < 16; i += 2) { float ke2[2];
#pragma unroll
                    for (int q = 0; q < 2; ++q) { const int t = 16 * tq + i + q; const float bi = c[i + q] + off;
                        const float qv = bf2f(*(const LAS unsigned short*)(Qraw + t * 256 + d * 2)), kv = bf2f(*(const LAS unsigned short*)(Kraw + t * 256 + d * 2));
                        *(LAS unsigned short*)(IMGQ + t * 272 + d * 2) = (unsigned short)pk2(qv * 0.08838834764831845f * __expf(bi), 0.f);
                        *(LAS unsigned short*)(IMGK + t * 272 + d * 2) = (unsigned short)pk2(kv * __expf(-bi), 0.f);
                        ke2[q] = kv * __expf(Bt - bi); }
                    kep[i >> 1] = pk2(ke2[0], ke2[1]); }
                *(LAS v4u*)(IMGE + d * 144 + (16 * tq) * 2) = (v4u){kep[0], kep[1], kep[2], kep[3]};
                *(LAS v4u*)(IMGE + d * 144 + (16 * tq + 8) * 2) = (v4u){kep[4], kep[5], kep[6], kep[7]};
                if (tq == 0) ((GAS float*)((unsigned char*)a.out + OUT_GT_DEC))[idir * 128 + d] = __expf(Bt);
            }
            __syncthreads();
            if (w < 4) {
                const int si = w >> 1, ti = w & 1; f32x16 acc = (f32x16){0.f, 0.f, 0.f, 0.f, 0.f, 0.f, 0.f, 0.f, 0.f, 0.f, 0.f, 0.f, 0.f, 0.f, 0.f, 0.f};
#pragma unroll
                for (int ks = 0; ks < 8; ++ks) { const bf16x8 ak = *(const LAS bf16x8*)(IMGK + (32 * si + r32) * 272 + (16 * ks + 8 * hh) * 2), bq = *(const LAS bf16x8*)(IMGQ + (32 * ti + r32) * 272 + (16 * ks + 8 * hh) * 2);
                    acc = __builtin_amdgcn_mfma_f32_32x32x16_bf16(ak, bq, acc, 0, 0, 0); }
                const int t = 32 * ti + r32;
#pragma unroll
                for (int qd = 0; qd < 4; ++qd) { float v4[4];
#pragma unroll
                    for (int i = 0; i < 4; ++i) { const int sidx = 32 * si + 8 * qd + 4 * hh + i; const float x = acc[4 * qd + i]; const bool keep = dir == 0 ? (sidx <= t) : (sidx >= t); v4[i] = keep ? x : 0.f; }
                    *(LAS unsigned long long*)(AMI + t * 144 + (32 * si + 8 * qd + 4 * hh) * 2) = (unsigned long long)pk2(v4[0], v4[1]) | ((unsigned long long)pk2(v4[2], v4[3]) << 32); }
            } else {
                const int w4 = w - 4;
#pragma unroll
                for (int q = 0; q < 4; ++q) { const int bq = w4 * 4 + q, tt = bq >> 3, ks = bq & 7, j = ks >> 1, u = ks & 1; const int t = 32 * tt + r32;
                    const unsigned long long p0 = *(const LAS unsigned long long*)(IMGQ + t * 272 + (32 * j + 16 * u + 4 * hh) * 2), p1 = *(const LAS unsigned long long*)(IMGQ + t * 272 + (32 * j + 16 * u + 8 + 4 * hh) * 2);
                    *(GAS v4u*)(ws + WS_GT_QD + idir * 16384 + bq * 1024 + lane * 16) = (v4u){(unsigned)p0, (unsigned)(p0 >> 32), (unsigned)p1, (unsigned)(p1 >> 32)}; }
#pragma unroll
                for (int q = 0; q < 4; ++q) { const int bk = w4 * 4 + q, j = bk >> 2, ks = bk & 3; const int d = 32 * j + r32;
                    *(GAS v4u*)(ws + WS_GT_KE + idir * 16384 + bk * 1024 + lane * 16) = *(const LAS v4u*)(IMGE + d * 144 + (16 * ks + 8 * hh) * 2); }
            }
            __syncthreads();
            { const int tt = w >> 2, ks = w & 3; const int t = 32 * tt + r32;
              *(GAS v4u*)((unsigned char*)a.out + OUT_GT_AM + idir * 8192 + w * 1024 + lane * 16) = *(const LAS v4u*)(AMI + t * 144 + (16 * ks + 8 * hh) * 2); }
            __syncthreads();
        }
    }
}

__device__ __forceinline__ void gla_seq_phase(Frame& F, const Args& a) {
    unsigned char* ws = a.ws;
    const int w = F.wave;
    constexpr int GBUF = 57856;
    for (int unit = F.vcu; unit < 64; unit += F.G) {
        const int dir = unit & 1, eh = (unit >> 1) & 1, bh = unit >> 2, b = bh >> 2, h = bh & 3;
        if (w >= 4) {
            const int lt = opaque_v((F.wave * 64 + lane_id())) - 256;
            v4u A[15], B[15];
#define GLA_LOAD(R, NS) do { const int n_ = dir ? 63 - (NS) : (NS); const size_t idir_ = (size_t)((bh * 2 + dir) * 64 + n_), iv_ = (size_t)(bh * 64 + n_); const unsigned char* o_ = opaque((const unsigned char*)a.out); const unsigned char* w_ = opaque(ws); \
            const GAS v4u* gq_ = (const GAS v4u*)(w_ + WS_GT_QD + idir_ * 16384); const GAS v4u* gk_ = (const GAS v4u*)(w_ + WS_GT_KE + idir_ * 16384); const GAS v4u* ga_ = (const GAS v4u*)(o_ + OUT_GT_AM + idir_ * 8192); \
            const GAS v4u* gv_ = (const GAS v4u*)(o_ + OUT_GT_VT + iv_ * 32768 + eh * 16384); const GAS v4u* gd_ = (const GAS v4u*)(o_ + OUT_GT_DEC + idir_ * 512); \
            _Pragma("unroll") for (int i = 0; i < 4; ++i) { R[i] = gq_[lt + 256 * i]; R[4 + i] = gk_[lt + 256 * i]; R[10 + i] = gv_[lt + 256 * i]; } R[8] = ga_[lt]; R[9] = ga_[lt + 256]; R[14] = gd_[lt & 31]; } while (0)
#define GLA_WRITE(R, BUF) do { LAS v4u* d_ = (LAS v4u*)(F.lds + (BUF) * GBUF); \
            _Pragma("unroll") for (int i = 0; i < 4; ++i) { d_[lt + 256 * i] = R[i]; d_[1024 + lt + 256 * i] = R[4 + i]; d_[2560 + lt + 256 * i] = R[10 + i]; } d_[2048 + lt] = R[8]; d_[2048 + lt + 256] = R[9]; if (lt < 32) d_[3584 + lt] = R[14]; } while (0)
            GLA_LOAD(A, 0); GLA_LOAD(B, 1);
            GLA_WRITE(A, 0);
            __syncthreads();
#pragma unroll 1
            for (int ns = 0; ns < 64; ns += 2) {
                if (ns + 2 < 64) GLA_LOAD(A, ns + 2);
                GLA_WRITE(B, 1);
                __syncthreads();
                if (ns + 3 < 64) GLA_LOAD(B, ns + 3);
                if (ns + 2 < 64) GLA_WRITE(A, 0);
                __syncthreads();
            }
#undef GLA_LOAD
#undef GLA_WRITE
        } else {
            f32x16 S[4];
#pragma unroll
            for (int j = 0; j < 4; ++j) S[j] = (f32x16){0.f, 0.f, 0.f, 0.f, 0.f, 0.f, 0.f, 0.f, 0.f, 0.f, 0.f, 0.f, 0.f, 0.f, 0.f, 0.f};
            __syncthreads();
#pragma unroll 1
            for (int ns = 0; ns < 64; ++ns) {
                const int n = dir ? 63 - ns : ns;
                const int lane = opaque_v(lane_id()), r32 = lane & 31, hh = lane >> 5;
                LAS unsigned char* QDl = F.lds + (ns & 1) * GBUF; LAS unsigned char* KEl = QDl + 16384; LAS unsigned char* AMl = QDl + 32768; LAS unsigned char* VTl = QDl + 40960; LAS float* DECl = (LAS float*)(QDl + 57344);
                GAS bf16* Out = (GAS bf16*)(opaque(ws) + (dir ? WS_OB : WS_OF));
                bf16x8 vf[4];
#pragma unroll
                for (int ks = 0; ks < 4; ++ks) vf[ks] = *(const LAS bf16x8*)(VTl + (w * 4 + ks) * 1024 + lane * 16);
                f32x16 o[2];
#pragma unroll
                for (int tt = 0; tt < 2; ++tt) o[tt] = (f32x16){0.f, 0.f, 0.f, 0.f, 0.f, 0.f, 0.f, 0.f, 0.f, 0.f, 0.f, 0.f, 0.f, 0.f, 0.f, 0.f};
#pragma unroll
                for (int ks8 = 0; ks8 < 8; ++ks8) { const int j = ks8 >> 1, u = ks8 & 1; v4u sb;
                    sb.x = pg8::cvt_pk_bf16(S[j][8 * u + 0], S[j][8 * u + 1]); sb.y = pg8::cvt_pk_bf16(S[j][8 * u + 2], S[j][8 * u + 3]); sb.z = pg8::cvt_pk_bf16(S[j][8 * u + 4], S[j][8 * u + 5]); sb.w = pg8::cvt_pk_bf16(S[j][8 * u + 6], S[j][8 * u + 7]);
                    const bf16x8 bs = __builtin_bit_cast(bf16x8, sb);
#pragma unroll
                    for (int tt = 0; tt < 2; ++tt) { const bf16x8 aq = *(const LAS bf16x8*)(QDl + (tt * 8 + ks8) * 1024 + lane * 16); o[tt] = __builtin_amdgcn_mfma_f32_32x32x16_bf16(aq, bs, o[tt], 0, 0, 0); } }
#pragma unroll
                for (int ks = 0; ks < 4; ++ks)
#pragma unroll
                    for (int tt = 0; tt < 2; ++tt) { const bf16x8 am = *(const LAS bf16x8*)(AMl + (tt * 4 + ks) * 1024 + lane * 16); o[tt] = __builtin_amdgcn_mfma_f32_32x32x16_bf16(am, vf[ks], o[tt], 0, 0, 0); }
#pragma unroll
                for (int tt = 0; tt < 2; ++tt)
#pragma unroll
                    for (int r = 0; r < 16; ++r) { const int t = 32 * tt + (r & 3) + 8 * (r >> 2) + 4 * hh; const float x = o[tt][r];
                        Out[((size_t)b * SEQ + 64 * n + t) * 1024 + h * 256 + 32 * (eh * 4 + w) + r32] = (bf16)pk2(x, 0.f); }
#pragma unroll
                for (int j = 0; j < 4; ++j) {
#pragma unroll
                    for (int q = 0; q < 4; ++q) { const f32x4 dv = *(const LAS f32x4*)(DECl + 32 * j + 8 * q + 4 * hh); S[j][4 * q + 0] *= dv.x; S[j][4 * q + 1] *= dv.y; S[j][4 * q + 2] *= dv.z; S[j][4 * q + 3] *= dv.w; }
#pragma unroll
                    for (int ks = 0; ks < 4; ++ks) { const bf16x8 ak = *(const LAS bf16x8*)(KEl + (j * 4 + ks) * 1024 + lane * 16); S[j] = __builtin_amdgcn_mfma_f32_32x32x16_bf16(ak, vf[ks], S[j], 0, 0, 0); } }
                __syncthreads();
            }
        }
    }
}

typedef short v4i16_t __attribute__((ext_vector_type(4)));
__device__ __forceinline__ void attn_phase(Frame& F, const Args& a, int qslot) {
    unsigned char* ws = a.ws; const bf16* PROJ;
    const int w = F.wave;
    volatile LAS int* uword = (volatile LAS int*)(F.lds + 2 * 78336);
    constexpr int NUNITS = 64 * 3 * 32;
#define ATT_DECODE(U) const int bh = (U) / 96, rem = (U) - bh * 96, p = rem >> 5, idx = rem & 31; const int lgd = 2 * p, d = 1 << lgd; \
        const int r = idx >> (5 - lgd), J = idx & ((32 >> lgd) - 1), Lc = SEQ >> lgd; const int b = bh >> 4, h = bh & 15; const int m0 = 128 * J - 64;
    v4u kx[4], vx[4]; v4u qw[2];
#define ATT_LOAD(U) do { ATT_DECODE(U) ws = opaque(ws); PROJ = (const bf16*)(ws + WS_PROJ); const int tid_ = opaque_v((F.wave * 64 + lane_id())); \
        _Pragma("unroll") for (int i = 0; i < 4; ++i) { const int kr = (tid_ >> 3) + 64 * i, ch = tid_ & 7; const int mp = m0 + kr; kx[i] = (v4u){0u, 0u, 0u, 0u}; vx[i] = kx[i]; \
            if (mp >= 0 && mp < Lc) { const bf16* src = PROJ + ((size_t)b * SEQ + r + d * mp) * NINP + O_AK + h * 64 + ch * 8; kx[i] = *(const GAS v4u*)src; vx[i] = *(const GAS v4u*)(src + (O_AV - O_AK)); } } \
        const int tokq_ = r + d * (128 * J + 16 * w + (tid_ & 15)); \
        _Pragma("unroll") for (int sft = 0; sft < 2; ++sft) qw[sft] = *(const GAS v4u*)(PROJ + ((size_t)b * SEQ + tokq_) * NINP + O_AQ + h * 64 + 32 * sft + 8 * ((tid_ & 63) >> 4)); } while (0)
    float tab[40];
    { const int l0 = opaque_v(lane_id());
#pragma unroll
      for (int c = 0; c < 40; ++c) { const int kb = c >> 3, uu = (c >> 2) & 1, rho = c & 3; const int jo = 32 * kb + 8 * (l0 >> 4) + 4 * uu + rho - 64 - (l0 & 15); const int aj = jo < 0 ? -jo : jo; tab[c] = aj <= 64 ? (float)aj : 3.0e38f; } }
    if ((F.wave * 64 + lane_id()) == 0) { uword[0] = (int)__hip_atomic_fetch_add((unsigned*)(F.ctl + CW_ATTQ + 64 * qslot), 1u, __ATOMIC_RELAXED, __HIP_MEMORY_SCOPE_AGENT); uword[1] = (int)__hip_atomic_fetch_add((unsigned*)(F.ctl + CW_ATTQ + 64 * qslot), 1u, __ATOMIC_RELAXED, __HIP_MEMORY_SCOPE_AGENT); }
    __syncthreads();
    int u = __builtin_amdgcn_readfirstlane(uword[0]), un = __builtin_amdgcn_readfirstlane(uword[1]); int par = 0;
#define ATT_WRITE(BUF) do { const int tid_ = opaque_v((F.wave * 64 + lane_id())); LAS unsigned char* Kw = F.lds + (BUF) * 78336; LAS unsigned char* Vw = Kw + 39168; \
        _Pragma("unroll") for (int i = 0; i < 4; ++i) { const int kr = (tid_ >> 3) + 64 * i, ch = tid_ & 7; *(LAS v4u*)(Kw + kr * 144 + ch * 16) = kx[i]; *(LAS v4u*)(Vw + kr * 144 + ch * 16) = vx[i]; } \
        if (tid_ < 128) { const int kr = 256 + (tid_ >> 3), ch = tid_ & 7; *(LAS v4u*)(Kw + kr * 144 + ch * 16) = (v4u){0u, 0u, 0u, 0u}; *(LAS v4u*)(Vw + kr * 144 + ch * 16) = (v4u){0u, 0u, 0u, 0u}; } } while (0)
    v4u qwc[2];
    if (u < NUNITS) { ATT_LOAD(u); ATT_WRITE(0); qwc[0] = qw[0]; qwc[1] = qw[1]; }
    __syncthreads();
    int bufi = 0;
    while (u < NUNITS) {
        const int tid = opaque_v((F.wave * 64 + lane_id())), lane = tid & 63, q16 = lane & 15, g = lane >> 4;
        int qnext = 0; if (tid == 0) qnext = (int)__hip_atomic_fetch_add((unsigned*)(F.ctl + CW_ATTQ + 64 * qslot), 1u, __ATOMIC_RELAXED, __HIP_MEMORY_SCOPE_AGENT);
        LAS unsigned char* Kl = F.lds + bufi * 78336; LAS unsigned char* Vl = Kl + 39168;
        bf16x8 qf[2];
#pragma unroll
        for (int sft = 0; sft < 2; ++sft) { v4u qs; constexpr float QS = 0.125f * 1.4426950408889634f; qs.x = pk2(bflo(qwc[sft].x) * QS, bfhi(qwc[sft].x) * QS); qs.y = pk2(bflo(qwc[sft].y) * QS, bfhi(qwc[sft].y) * QS); qs.z = pk2(bflo(qwc[sft].z) * QS, bfhi(qwc[sft].z) * QS); qs.w = pk2(bflo(qwc[sft].w) * QS, bfhi(qwc[sft].w) * QS);
            qf[sft] = __builtin_bit_cast(bf16x8, qs); }
        ATT_DECODE(u)
        const int tokq = r + d * (128 * J + 16 * w + q16);
        if (un < NUNITS) ATT_LOAD(un);
        const float nslope = -exp2f(-0.5f * (float)(h + 1)) * (float)d * 1.4426950408889634f;
        const bool inrange = (m0 + 16 * w >= 0) && (m0 + 16 * w + 159 < Lc);
        float sv[5][2][4]; float mx = -3.0e38f;
#pragma unroll
        for (int kb = 0; kb < 5; ++kb)
#pragma unroll
            for (int uu = 0; uu < 2; ++uu) { f32x4 acc = (f32x4){0.f, 0.f, 0.f, 0.f};
                const int krow = 16 * w + 32 * kb + 8 * (q16 >> 2) + 4 * uu + (q16 & 3);
#pragma unroll
                for (int sft = 0; sft < 2; ++sft) { const bf16x8 ak = *(const LAS bf16x8*)(Kl + krow * 144 + (32 * sft + 8 * g) * 2); acc = __builtin_amdgcn_mfma_f32_16x16x32_bf16(ak, qf[sft], acc, 0, 0, 0); }
#pragma unroll
                for (int rho = 0; rho < 4; ++rho) { const float x = acc[rho]; sv[kb][uu][rho] = __builtin_fmaf(nslope, tab[kb * 8 + uu * 4 + rho], x); } }
        if (!inrange) {
#pragma unroll
            for (int kb = 0; kb < 5; ++kb)
#pragma unroll
                for (int uu = 0; uu < 2; ++uu)
#pragma unroll
                    for (int rho = 0; rho < 4; ++rho) { const int mp = m0 + 16 * w + 32 * kb + 8 * g + 4 * uu + rho; if (mp < 0 || mp >= Lc) sv[kb][uu][rho] = -3.0e38f; } }
#pragma unroll
        for (int kb = 0; kb < 5; ++kb)
#pragma unroll
            for (int uu = 0; uu < 2; ++uu)
#pragma unroll
                for (int rho = 0; rho < 4; ++rho) mx = fmaxf(mx, sv[kb][uu][rho]);
        mx = fmaxf(mx, __shfl_xor(mx, 16)); mx = fmaxf(mx, __shfl_xor(mx, 32));
        float lsum = 0.f; bf16x8 pf[5];
#pragma unroll
        for (int kb = 0; kb < 5; ++kb) { float e[8];
#pragma unroll
            for (int uu = 0; uu < 2; ++uu)
#pragma unroll
                for (int rho = 0; rho < 4; ++rho) { const float pe = __builtin_amdgcn_exp2f(sv[kb][uu][rho] - mx); e[uu * 4 + rho] = pe; lsum += pe; }
            v4u pw; pw.x = pk2(e[0], e[1]); pw.y = pk2(e[2], e[3]); pw.z = pk2(e[4], e[5]); pw.w = pk2(e[6], e[7]); pf[kb] = __builtin_bit_cast(bf16x8, pw); }
        lsum += __shfl_xor(lsum, 16); lsum += __shfl_xor(lsum, 32);
        f32x4 oT[4];
#pragma unroll
        for (int nn = 0; nn < 4; ++nn) oT[nn] = (f32x4){0.f, 0.f, 0.f, 0.f};
#pragma unroll
        for (int kb = 0; kb < 5; ++kb)
#pragma unroll
            for (int nn = 0; nn < 4; ++nn) { const LAS unsigned char* va = Vl + (16 * w + 32 * kb + 8 * g + (q16 >> 2)) * 144 + (16 * nn + 4 * (q16 & 3)) * 2;
                const v4i16_t lo = __builtin_amdgcn_ds_read_tr16_b64_v4i16((LAS v4i16_t*)va), hi = __builtin_amdgcn_ds_read_tr16_b64_v4i16((LAS v4i16_t*)(va + 4 * 144));
                const bf16x8 vf = (bf16x8){lo[0], lo[1], lo[2], lo[3], hi[0], hi[1], hi[2], hi[3]};
                oT[nn] = __builtin_amdgcn_mfma_f32_16x16x32_bf16(vf, pf[kb], oT[nn], 0, 0, 0); }
        { const size_t rec = ((size_t)p * M + (size_t)b * SEQ + tokq) * 16 + h; GAS bf16* op = (GAS bf16*)(opaque(ws) + WS_ATTP) + rec * 64 + 4 * g;
#pragma unroll
          for (int nn = 0; nn < 4; ++nn) *(GAS unsigned long long*)(op + 16 * nn) = (unsigned long long)pk2(oT[nn][0], oT[nn][1]) | ((unsigned long long)pk2(oT[nn][2], oT[nn][3]) << 32);
          if (g == 0) { GAS float* ml = (GAS float*)(opaque(ws) + WS_ATTML) + rec * 2; ml[0] = mx * 0.6931471805599453f; ml[1] = lsum; } }
        if (un < NUNITS) { ATT_WRITE(bufi ^ 1); qwc[0] = qw[0]; qwc[1] = qw[1]; }
        if (tid == 0) uword[par] = qnext;
        __syncthreads();
        u = un; un = __builtin_amdgcn_readfirstlane(uword[par]); par ^= 1; bufi ^= 1;
    }
#undef ATT_WRITE
#undef ATT_DECODE
#undef ATT_LOAD
}

typedef __bf16 bf16x2_t __attribute__((ext_vector_type(2)));
__device__ __forceinline__ void peer_convert_tables(Frame& F, const Args& a, int qslot) {
    unsigned char* ws = a.ws; const int lane = lane_id(); volatile LAS int* uword = (volatile LAS int*)(F.lds + 2 * 78336 + 64);
    for (;;) {
        __syncthreads();
        if ((F.wave * 64 + lane_id()) == 0) uword[0] = (int)__hip_atomic_fetch_add((unsigned*)(F.ctl + CW_CONVQ + 64 * qslot), 1u, __ATOMIC_RELAXED, __HIP_MEMORY_SCOPE_AGENT);
        __syncthreads();
        const int blk = __builtin_amdgcn_readfirstlane(uword[0]);
        if (blk >= 2 * PEER_E / 64) break;
#pragma unroll 1
        for (int i = 0; i < 8; ++i) { const int r = blk * 64 + F.wave * 8 + i;
            const int e = r & (PEER_E - 1); const bool isv = r >= PEER_E;
            const float* src = (isv ? a.in[14] : a.in[13]) + (size_t)e * DM;
            unsigned char* dst = (unsigned char*)a.out + (isv ? OUT_V8 : OUT_U8) + (size_t)e * DM; float* sc = (float*)(ws + (isv ? WS_SV : WS_SU));
            f32x4 v[8]; float am = 0.f;
#pragma unroll
            for (int j = 0; j < 8; ++j) { v[j] = *(const f32x4*)(src + 256 * j + 4 * lane); am = fmaxf(am, fmaxf(fmaxf(fabsf(v[j].x), fabsf(v[j].y)), fmaxf(fabsf(v[j].z), fabsf(v[j].w)))); }
            am = wave_max(am); am = fmaxf(am, 1e-30f);
            const float inv = 440.f / am;
#pragma unroll
            for (int j = 0; j < 8; ++j) { int p = __builtin_amdgcn_cvt_pk_fp8_f32(v[j].x * inv, v[j].y * inv, 0, false); p = __builtin_amdgcn_cvt_pk_fp8_f32(v[j].z * inv, v[j].w * inv, p, true);
                *(int*)(dst + 256 * j + 4 * lane) = p; }
            if (lane == 0) sc[e] = am * (1.f / 440.f); }
    }
}

__device__ __forceinline__ float dpp_row_sum(float x) {
#define PEER_DPP(ctrl) x += __builtin_bit_cast(float, __builtin_amdgcn_update_dpp(0, __builtin_bit_cast(int, x), ctrl, 0xF, 0xF, false))
    PEER_DPP(0xB1); PEER_DPP(0x4E); PEER_DPP(0x141); PEER_DPP(0x140);
#undef PEER_DPP
    return x;
}
template <bool VPH, int PBS, bool LA> __device__ __forceinline__ void peer_uv_phase(Frame& F, const Args& a) {
    unsigned char* ws = a.ws; GAS bf16* H = (GAS bf16*)(ws + WS_HB); const GAS float* g2 = (const GAS float*)a.in[10];
    const int sl = blockIdx.x & 7, rk = blockIdx.x >> 3, nrk = F.G >> 3, tpw = M / nrk / NWAVES, nq = tpw / 4;
    const unsigned char* TAB; const GAS int* EIDX; const GAS float* SSQ; const GAS float* PW; GAS float* PD; GAS float* SSQ2;
    LAS int* idt = (LAS int*)(F.lds + F.wave * 8704);
    LAS float* wt = (LAS float*)(F.lds + F.wave * 8704 + 4352);
    const int t0 = (rk * NWAVES + F.wave) * tpw;
#define PEER_STAGE_LOAD(QI) do { const size_t tb_ = (size_t)(t0 + 4 * (QI) + a4) * 128; _Pragma("unroll") for (int k = 0; k < 8; ++k) sid[k] = EIDX[tb_ + 16 * k + q]; } while (0)
#define PEER_STAGE_WRITE(QI) do { const int bf_ = ((QI) & 1) * 528; _Pragma("unroll") for (int k = 0; k < 8; ++k) idt[bf_ + a4 * 132 + 16 * k + q] = sid[k]; } while (0)
#define PEER_STAGE_W(QI) do { if (VPH) { const size_t tb_ = (size_t)(t0 + 4 * (QI) + a4) * 128; const int bf_ = ((QI) & 1) * 528; _Pragma("unroll") for (int k = 0; k < 8; ++k) wt[bf_ + a4 * 132 + 16 * k + q] = PW[tb_ + 16 * k + q]; LDS_WAIT(); asm volatile("" ::: "memory"); } } while (0)
#define PEER_ISSUE(R, QI, WB) do { const int bf_ = ((QI) & 1) * 528 + a4 * 132 + (WB) * PBS; i32x4 e4_; _Pragma("unroll") for (int j = 0; j < PBS; ++j) { if ((j & 3) == 0) e4_ = *(const LAS i32x4*)(idt + bf_ + j); const int e_ = (j & 3) == 0 ? e4_.x : (j & 3) == 1 ? e4_.y : (j & 3) == 2 ? e4_.z : e4_.w; R[j] = ldu<i32x4>(TAB, (unsigned)e_ * 2048u + (unsigned)(16 * q)); } } while (0)
    unsigned xq[8]; float acc[16];
#define PEER_QUAD_BEGIN(QI) do { const size_t t_ = (size_t)(t0 + 4 * (QI) + a4); \
        if (!VPH) { f32x4 hq[4]; { const v4u h0_ = *(const GAS v4u*)(H + t_ * DM + 256 * sl + 16 * q), h1_ = *(const GAS v4u*)(H + t_ * DM + 256 * sl + 16 * q + 8); \
            hq[0] = (f32x4){bflo(h0_.x), bfhi(h0_.x), bflo(h0_.y), bfhi(h0_.y)}; hq[1] = (f32x4){bflo(h0_.z), bfhi(h0_.z), bflo(h0_.w), bfhi(h0_.w)}; hq[2] = (f32x4){bflo(h1_.x), bfhi(h1_.x), bflo(h1_.y), bfhi(h1_.y)}; hq[3] = (f32x4){bflo(h1_.z), bfhi(h1_.z), bflo(h1_.w), bfhi(h1_.w)}; }  const float pss_ = dpp_row_sum(SSQ[t_ * 32 + q] + SSQ[t_ * 32 + 16 + q]); const float rstd_ = 1.f / sqrtf(pss_ * (1.f / DM) + EPS); f32x4 gv[4]; \
            _Pragma("unroll") for (int k = 0; k < 4; ++k) gv[k] = *(const GAS f32x4*)(g2 + 256 * sl + 16 * q + 4 * k); \
            _Pragma("unroll") for (int k = 0; k < 4; ++k) { xq[2 * k] = pk2(hq[k].x * rstd_ * gv[k].x, hq[k].y * rstd_ * gv[k].y); xq[2 * k + 1] = pk2(hq[k].z * rstd_ * gv[k].z, hq[k].w * rstd_ * gv[k].w); } } \
        else { _Pragma("unroll") for (int k = 0; k < 16; ++k) acc[k] = 0.f; } } while (0)
#define PEER_COMPUTE(R, QI, WB) do { if (!VPH) { float pdb_ = 0.f; _Pragma("unroll") for (int j = 0; j < PBS; ++j) { float d_ = 0.f; _Pragma("unroll") for (int k = 0; k < 4; ++k) { const int dw_ = R[j][k]; \
                d_ = __builtin_amdgcn_fdot2_f32_bf16(__builtin_amdgcn_cvt_scalef32_pk_bf16_fp8(dw_, 1.0f, false), __builtin_bit_cast(bf16x2_t, xq[2 * k]), d_, false); \
                d_ = __builtin_amdgcn_fdot2_f32_bf16(__builtin_amdgcn_cvt_scalef32_pk_bf16_fp8(dw_, 1.0f, true), __builtin_bit_cast(bf16x2_t, xq[2 * k + 1]), d_, false); } \
                d_ = dpp_row_sum(d_); pdb_ = (q == j) ? d_ : pdb_; } \
            if (q < PBS) PD[((size_t)(t0 + 4 * (QI) + a4) * 8 + sl) * 128 + PBS * (WB) + q] = pdb_; } \
        else { const int bf_ = ((QI) & 1) * 528 + a4 * 132 + (WB) * PBS; f32x4 w4_; _Pragma("unroll") for (int j = 0; j < PBS; ++j) { if ((j & 3) == 0) w4_ = *(const LAS f32x4*)(wt + bf_ + j); const float w_ = (j & 3) == 0 ? w4_.x : (j & 3) == 1 ? w4_.y : (j & 3) == 2 ? w4_.z : w4_.w; int r0_ = R[j][0], r1_ = R[j][1], r2_ = R[j][2], r3_ = R[j][3]; asm volatile("" : "+v"(r0_), "+v"(r1_), "+v"(r2_), "+v"(r3_));     \
                _Pragma("unroll") for (int k = 0; k < 4; ++k) { const int dw_ = k == 0 ? r0_ : k == 1 ? r1_ : k == 2 ? r2_ : r3_; \
                const f32x2 lo_ = __builtin_amdgcn_cvt_pk_f32_fp8(dw_, false), hi_ = __builtin_amdgcn_cvt_pk_f32_fp8(dw_, true); \
                acc[4 * k + 0] += w_ * lo_.x; acc[4 * k + 1] += w_ * lo_.y; acc[4 * k + 2] += w_ * hi_.x; acc[4 * k + 3] += w_ * hi_.y; } } } } while (0)
#define PEER_QUAD_END(QI) do { if (VPH) { const size_t t_ = (size_t)(t0 + 4 * (QI) + a4); GAS bf16* hp_ = H + t_ * DM + 256 * sl + 16 * q; const v4u h0_ = *(const GAS v4u*)hp_, h1_ = *(const GAS v4u*)(hp_ + 8); \
            float y_[16]; y_[0] = bflo(h0_.x); y_[1] = bfhi(h0_.x); y_[2] = bflo(h0_.y); y_[3] = bfhi(h0_.y); y_[4] = bflo(h0_.z); y_[5] = bfhi(h0_.z); y_[6] = bflo(h0_.w); y_[7] = bfhi(h0_.w); \
            y_[8] = bflo(h1_.x); y_[9] = bfhi(h1_.x); y_[10] = bflo(h1_.y); y_[11] = bfhi(h1_.y); y_[12] = bflo(h1_.z); y_[13] = bfhi(h1_.z); y_[14] = bflo(h1_.w); y_[15] = bfhi(h1_.w); \
            float ss_ = 0.f; _Pragma("unroll") for (int k = 0; k < 16; ++k) { y_[k] += acc[k]; ss_ += y_[k] * y_[k]; } \
            *(GAS v4u*)hp_ = (v4u){pk2(y_[0], y_[1]), pk2(y_[2], y_[3]), pk2(y_[4], y_[5]), pk2(y_[6], y_[7])}; *(GAS v4u*)(hp_ + 8) = (v4u){pk2(y_[8], y_[9]), pk2(y_[10], y_[11]), pk2(y_[12], y_[13]), pk2(y_[14], y_[15])}; \
            ss_ = dpp_row_sum(ss_); if (q == 0) SSQ2[t_ * 8 + sl] = ss_; } } while (0)
#pragma unroll 1
    for (int qi = 0; qi < nq; ++qi) {
        i32x4 rA[PBS], rB[PBS];
        const int lane = opaque_v(lane_id()), a4 = lane >> 4, q = lane & 15; ws = opaque(ws); H = (GAS bf16*)(ws + WS_HB);
        TAB = opaque((const unsigned char*)a.out) + (VPH ? OUT_V8 : OUT_U8) + 256 * sl; EIDX = (const GAS int*)(ws + WS_EIDX); SSQ = (const GAS float*)(ws + WS_SSQ); PW = (const GAS float*)(ws + WS_PW); PD = (GAS float*)(ws + WS_PD); SSQ2 = (GAS float*)(ws + WS_SSQ2);
        int sid[8];
        if (!LA || qi == 0) { PEER_STAGE_LOAD(qi); PEER_STAGE_WRITE(qi); LDS_WAIT(); asm volatile("" ::: "memory"); }
        PEER_ISSUE(rA, qi, 0);
        PEER_ISSUE(rB, qi, 1);
        if (LA && qi + 1 < nq) PEER_STAGE_LOAD(qi + 1);
        PEER_STAGE_W(qi);
        PEER_QUAD_BEGIN(qi);
#pragma unroll
        for (int wb = 0; wb < 128 / PBS; wb += 2) {
            PEER_COMPUTE(rA, qi, wb); if (wb + 2 < 128 / PBS) { PEER_ISSUE(rA, qi, wb + 2); }
            PEER_COMPUTE(rB, qi, wb + 1); if (wb + 3 < 128 / PBS) { PEER_ISSUE(rB, qi, wb + 3); }
        }
        PEER_QUAD_END(qi);
        if (LA && qi + 1 < nq) { PEER_STAGE_WRITE(qi + 1); LDS_WAIT(); asm volatile("" ::: "memory"); }
    }
#undef PEER_STAGE_LOAD
#undef PEER_STAGE_WRITE
#undef PEER_STAGE_W
#undef PEER_ISSUE
#undef PEER_QUAD_BEGIN
#undef PEER_COMPUTE
#undef PEER_QUAD_END
}
__device__ __forceinline__ void peer_w_phase(Frame& F, const Args& a) {
    unsigned char* ws = a.ws; const float* PD = (const float*)(ws + WS_PD); const int* EIDX = (const int*)(ws + WS_EIDX); const float* GATE = (const float*)(ws + WS_GATE);
    const float* SU = (const float*)(ws + WS_SU); const float* SV = (const float*)(ws + WS_SV); float* PW = (float*)(ws + WS_PW);
    for (int i = F.vcu * 512 + (F.wave * 64 + lane_id()); i < M * 128; i += F.G * 512) { const int t = i >> 7, p = i & 127; float d = 0.f;
#pragma unroll
        for (int sl = 0; sl < 8; ++sl) d += PD[((size_t)t * 8 + sl) * 128 + p];
        const int e = EIDX[i]; d *= SU[e];
        PW[i] = GATE[i] * 0.5f * d * (1.f + erff(d * 0.70710678118654752f)) * SV[e]; }
}
__device__ __forceinline__ void peer_n_phase(Frame& F, const Args& a) {
    unsigned char* ws = a.ws; const GAS bf16* Y = (const GAS bf16*)(ws + WS_HB); GAS float* O = (GAS float*)a.out; const GAS float* gf = (const GAS float*)a.in[15]; const GAS float* SSQ2 = (const GAS float*)(ws + WS_SSQ2); const int lane = lane_id();
    f32x4 g0[4], g1[4];
#pragma unroll
    for (int j = 0; j < 4; ++j) { g0[j] = *(const GAS f32x4*)(gf + 512 * j + 8 * lane); g1[j] = *(const GAS f32x4*)(gf + 512 * j + 8 * lane + 4); }
    const int gw = F.vcu * NWAVES + F.wave, NGW = F.G * NWAVES;
    v4u yw[4], yn[4]; f32x4 s0, s1, n0, n1;
    if (gw < M) {
#pragma unroll
        for (int j = 0; j < 4; ++j) yw[j] = *(const GAS v4u*)(Y + (size_t)gw * DM + 512 * j + 8 * lane);
        s0 = *(const GAS f32x4*)(SSQ2 + (size_t)gw * 8); s1 = *(const GAS f32x4*)(SSQ2 + (size_t)gw * 8 + 4); }
    for (int m = gw; m < M; m += NGW) { const int mn = m + NGW < M ? m + NGW : m;
#pragma unroll
        for (int j = 0; j < 4; ++j) yn[j] = *(const GAS v4u*)(Y + (size_t)mn * DM + 512 * j + 8 * lane);
        n0 = *(const GAS f32x4*)(SSQ2 + (size_t)mn * 8); n1 = *(const GAS f32x4*)(SSQ2 + (size_t)mn * 8 + 4);
        const float rf = 1.f / sqrtf((((s0.x + s0.y) + (s0.z + s0.w)) + ((s1.x + s1.y) + (s1.z + s1.w))) * (1.f / DM) + EPS);
#pragma unroll
        for (int j = 0; j < 4; ++j) {
            *(GAS f32x4*)(O + (size_t)m * DM + 512 * j + 8 * lane) = (f32x4){bflo(yw[j].x) * rf * g0[j].x, bfhi(yw[j].x) * rf * g0[j].y, bflo(yw[j].y) * rf * g0[j].z, bfhi(yw[j].y) * rf * g0[j].w};
            *(GAS f32x4*)(O + (size_t)m * DM + 512 * j + 8 * lane + 4) = (f32x4){bflo(yw[j].z) * rf * g1[j].x, bfhi(yw[j].z) * rf * g1[j].y, bflo(yw[j].w) * rf * g1[j].z, bfhi(yw[j].w) * rf * g1[j].w}; }
#pragma unroll
        for (int j = 0; j < 4; ++j) yw[j] = yn[j];
        s0 = n0; s1 = n1; }
}

__global__ void __launch_bounds__(NWAVES * 64, 2) mk_fwd(Args args_in) {
    extern __shared__ __attribute__((aligned(16))) unsigned char lds[];
    Args args = args_in;
#pragma unroll
    for (int i = 0; i < 16; ++i) args.in[i] = (const float*)(const GAS float*)args_in.in[i];
    args.out = (float*)(GAS float*)args_in.out; args.ws = (unsigned char*)(GAS unsigned char*)args_in.ws;
    Frame F;
    F.lds = (LAS unsigned char*)lds;
    F.MISC = (volatile LAS unsigned*)(F.lds + MISC_OFF);
    F.wave = __builtin_amdgcn_readfirstlane((int)threadIdx.x >> 6);
    F.G = gridDim.x; { const int bx = blockIdx.x; F.vcu = (F.G % 8 == 0) ? (bx % 8) * (F.G / 8) + bx / 8 : bx; }
    unsigned char* ws = args.ws;
    F.ctl = (gu32*)(ws + WS_CTL);
    for (int u = (F.wave * 64 + lane_id()); u < (LDS_BYTES - LDSCTL_OFF) / 4; u += NWAVES * 64) ((LAS unsigned*)(F.lds + LDSCTL_OFF))[u] = 0u;
    __syncthreads();
    XcdBarrier bar = xcd_barrier_post((unsigned*)(F.ctl + CW_BAR) + args.li * XCD_BAR_WORDS, F.MISC + 8);
    const int lo = args.ph_lo, hi = args.ph_hi;
#define IN(k) (lo <= (k) && (k) < hi)
#define BOTH(k) (IN(k) && IN((k) + 1))
#define GRID_BAR() xcd_barrier(bar)

    if (IN(0)) { for (int rep = 0; rep < NREP(0); ++rep) p0_prologue(F, args); if (BOTH(0)) GRID_BAR(); }

    if (IN(1)) {
        pg8::Gemm g{(const bf16*)(ws + WS_XN), (const bf16*)(ws + WS_WIN), M, NINP, DM}; pg8::StaticOrder S; S.init(M, NINP, F.G, (int)blockIdx.x);
        pg8::EpiBf16<0> E{(bf16*)(ws + WS_PROJ), NINP, nullptr, 0, 0, 1.f};
        for (int rep = 0; rep < NREP(1); ++rep) pg8::gemm_phase<pg8::EpiBf16<0>, pg8::StaticOrder, PG8_ALIGN, PG8_SP2>(F.lds + RING_OFF, g, S, E);
        for (int rep = 0; rep < NREP(11); ++rep) gd_side_gemm(F, args);
        if (BOTH(1)) GRID_BAR();
    }
    if (IN(2)) {
        for (int rep = 0; rep < NREP(21); ++rep) gla_prep_phase(F, args);
        GRID_BAR();
        for (int rep = 0; rep < NREP(2); ++rep) gla_seq_phase(F, args);
        for (int rep = 0; rep < NREP(20); ++rep) attn_phase(F, args, rep);
        for (int rep = 0; rep < NREP(40); ++rep) peer_convert_tables(F, args, rep);
        if (BOTH(2)) GRID_BAR(); }
    if (IN(3)) { for (int rep = 0; rep < NREP(3); ++rep) p3_finalize(F, args); if (BOTH(3)) GRID_BAR(); if (REP_PHASE == 99) { GRID_BAR(); GRID_BAR(); GRID_BAR(); GRID_BAR(); } }
    if (IN(4)) {
        pg8::Gemm g{(const bf16*)(ws + WS_XN), (const bf16*)(ws + WS_WOUT), M, DM, DM}; pg8::StaticOrder S; S.init(M, DM, F.G, (int)blockIdx.x);
        pg8::EpiRes E{args.in[0], (bf16*)(ws + WS_HB), (float*)(ws + WS_SSQ), DM};
        for (int rep = 0; rep < NREP(4); ++rep) pg8::gemm_phase<pg8::EpiRes, pg8::StaticOrder, PG8_ALIGN, PG8_SP2>(F.lds + RING_OFF, g, S, E);
        if (BOTH(4)) GRID_BAR();
    }
    if (IN(5)) {
        pg8::Gemm g{(const bf16*)(ws + WS_HB), (const bf16*)(ws + WS_WQ), M, DM, DM}; pg8::StaticOrder S; S.init(M, DM, F.G, (int)blockIdx.x);
        pg8::EpiBf16<0> E{(bf16*)(ws + WS_XN), DM, nullptr, 0, 0, 1.f};
        for (int rep = 0; rep < NREP(5); ++rep) pg8::gemm_phase<pg8::EpiBf16<0>, pg8::StaticOrder, PG8_ALIGN, PG8_SP2>(F.lds + RING_OFF, g, S, E);
        if (BOTH(5)) GRID_BAR();
    }
    if (IN(6)) { for (int rep = 0; rep < NREP(6); ++rep) topk_phase(F, args); if (BOTH(6)) GRID_BAR(); }
    if (IN(7)) {
        for (int rep = 0; rep < NREP(7); ++rep) peer_uv_phase<false, 16, true>(F, args);
        GRID_BAR();
        peer_w_phase(F, args);
        GRID_BAR();
        if (REP_PHASE != 8) peer_uv_phase<true, 8, true>(F, args);
        GRID_BAR();
        peer_n_phase(F, args);
    }
#undef IN
#undef BOTH
}


extern "C" void kernel_launch(void* const* d_in, const int* in_sizes, int n_in, void* d_out, int out_size, void* d_ws, size_t ws_size, hipStream_t stream) {
    static int grid = 0;
    if (grid == 0) {
        if (n_in != 16 || in_sizes[0] != M * DM || out_size != M * DM || ws_size < WS_END) { fprintf(stderr, "kernel_launch: unexpected shapes: n_in %d in0 %d out %d ws %zu\n", n_in, n_in > 0 ? in_sizes[0] : -1, out_size, ws_size); grid = -1; return; }
        int dev = 0, cus = 0;
        if (hipGetDevice(&dev) != hipSuccess || hipDeviceGetAttribute(&cus, hipDeviceAttributeMultiprocessorCount, dev) != hipSuccess) { grid = -1; return; }
        if (hipFuncSetAttribute((const void*)mk_fwd, hipFuncAttributeMaxDynamicSharedMemorySize, LDS_BYTES) != hipSuccess) { fprintf(stderr, "kernel_launch: hipFuncSetAttribute failed\n"); grid = -1; return; }
        (void)hipGetLastError();
        grid = cus;
    }
    if (grid < 0) return;
    (void)hipMemsetAsync((char*)d_ws + WS_CTL, 0, CTL_ZERO_BYTES, stream);
    Args a{};
    for (int i = 0; i < 16; ++i) a.in[i] = (const float*)d_in[i];
    a.out = (float*)d_out; a.ws = (unsigned char*)d_ws;
    a.ph_lo = 0; a.ph_hi = 8; a.li = 0;
    hipLaunchKernelGGL(mk_fwd, dim3(grid), dim3(NWAVES * 64), LDS_BYTES, stream, a);
}
```

```cpp
#define REP_PHASE -1

#include <hip/hip_runtime.h>
#include <cstdio>
#include <cstdint>
#include <cmath>
#ifndef REP_PHASE
#define REP_PHASE -1
#endif
#define NREP(k) ((REP_PHASE == (k)) ? 2 : 1)
namespace pg8 {
#define PG8_LAS __attribute__((address_space(3)))
typedef unsigned short bf16_t;
typedef short bf16x8 __attribute__((ext_vector_type(8)));
typedef float f32x4 __attribute__((ext_vector_type(4)));
typedef unsigned u32x4 __attribute__((ext_vector_type(4)));
constexpr int BM = 256, BK = 64, HALF = 128, HTB = HALF * BK * 2  , STAGE_BYTES = 8 * HTB, NXCD = 8, WGM = 8;

__host__ __device__ __forceinline__ int lds_byte(int r, int c) { const int st = (r >> 4) * 2 + (c >> 5), rr = r & 15, cc = c & 31, ob = rr * 64 + cc * 2; return st * 1024 + (ob ^ (((ob >> 9) & 1) << 5)); }
__host__ __device__ __forceinline__ void stage_rc(int b, int& R, int& C) { const int st = b / 1024, sb = b % 1024, swz = sb ^ (((sb >> 9) & 1) << 5); R = (st >> 1) * 16 + swz / 64; C = (st & 1) * 32 + (swz % 64) / 2; }
__host__ __device__ __forceinline__ int perm32(int rho) { const int n = rho >> 4, i = rho & 15; return 8 * (i >> 2) + 4 * n + (i & 3); }

struct Unit { int pm, pn; };
struct Gemm { const bf16_t* A; const bf16_t* Bt; int M, N, K; };

struct StaticOrder {
    int nM, nN, nwg, G, c;
    __host__ __device__ void init(int M, int N, int G_, int c_) { nM = M / BM; nN = N / BM; nwg = nM * nN; G = G_; c = c_; }
    __host__ __device__ bool next(int i, Unit& u) const {
        const long L = (long)i * G + c; if (L >= nwg) return false;
        int wgid = (int)L; { const int q = nwg / NXCD, r = nwg % NXCD, xcd = wgid % NXCD, off = wgid / NXCD; wgid = (xcd < r ? xcd * (q + 1) : r * (q + 1) + (xcd - r) * q) + off; }
        const int nig = WGM * nN, gid = wgid / nig, fm = gid * WGM, gsz = (nM - fm) < WGM ? (nM - fm) : WGM;
        u.pm = fm + ((wgid % nig) % gsz); u.pn = (wgid % nig) / gsz; return true;
    }
    __device__ __forceinline__ void a_ready(const Unit&) const {}
    __device__ __forceinline__ void done(const Unit&) const {}
};

__device__ __forceinline__ unsigned cvt_pk_bf16(float lo, float hi) { unsigned r; asm volatile("v_cvt_pk_bf16_f32 %0, %1, %2" : "=v"(r) : "v"(lo), "v"(hi)); return r; }
typedef float f32x2 __attribute__((ext_vector_type(2)));
__device__ __forceinline__ f32x2 gelu_pk(f32x2 v) {
    const f32x2 av = __builtin_elementwise_abs(v), d = av * 0.2316418882f + 1.0f;
    f32x2 t; t.x = __builtin_amdgcn_rcpf(d.x); t.y = __builtin_amdgcn_rcpf(d.y);
    f32x2 q = t * 0.5307027145f + (-0.7265760135f); q = q * t + 0.7107068705f; q = q * t + (-0.142248368f); q = q * t + 0.127414796f; q = q * t;
    const f32x2 s = (v * v) * (-0.72134752044f);
    f32x2 e; e.x = __builtin_amdgcn_exp2f(s.x); e.y = __builtin_amdgcn_exp2f(s.y);
    const f32x2 m = v * (q * e), r = v - m;
    f32x2 o; o.x = v.x < 0.f ? m.x : r.x; o.y = v.y < 0.f ? m.y : r.y; return o;
}

template <int ACT  > struct EpiBf16 {
    static constexpr bool PERM = true, AFTER_DRAIN = false; static_assert(ACT == 0 || ACT == 1, "EpiBf16: ACT is 0 (none) or 1 (gelu_pk)");
    bf16_t* O; int ldc; const float* bias; int split_cols; size_t split_stride; float scale0;
    __device__ __forceinline__ void operator()(const f32x4 (&acc)[2][2][4][2], const Unit& u, int wr, int wc, int fr, int fq) const {
        const int row0 = u.pm * BM + wr * 64 + fr; int colt = u.pn * BM; bf16_t* base = O;
        float sc = 1.f; if (split_cols) { const int t = colt / split_cols; base += (size_t)t * split_stride; colt -= t * split_cols; if (t == 0) sc = scale0; }
        const int col0 = colt + wc * 32 + 8 * fq, bcol0 = u.pn * BM + wc * 32 + 8 * fq;
        f32x4 bv[2][2];
#pragma unroll
        for (int bj = 0; bj < 2; ++bj)
#pragma unroll
            for (int n = 0; n < 2; ++n) bv[bj][n] = bias ? *(const f32x4*)(bias + bcol0 + bj * HALF + 4 * n) : (f32x4){0.f, 0.f, 0.f, 0.f};
#pragma unroll
        for (int ai = 0; ai < 2; ++ai)
#pragma unroll
            for (int m = 0; m < 4; ++m) { bf16_t* rowp = base + (size_t)(row0 + ai * HALF + m * 16) * ldc + col0;
#pragma unroll
                for (int bj = 0; bj < 2; ++bj) { f32x4 v0 = acc[ai][bj][m][0] + bv[bj][0], v1 = acc[ai][bj][m][1] + bv[bj][1];
                    if (ACT == 1) { f32x2 a = gelu_pk((f32x2){v0[0], v0[1]}), b = gelu_pk((f32x2){v0[2], v0[3]}), c = gelu_pk((f32x2){v1[0], v1[1]}), d = gelu_pk((f32x2){v1[2], v1[3]});
                        v0 = (f32x4){a.x, a.y, b.x, b.y}; v1 = (f32x4){c.x, c.y, d.x, d.y}; }
                    v0 = v0 * sc; v1 = v1 * sc; u32x4 w; w.x = cvt_pk_bf16(v0[0], v0[1]); w.y = cvt_pk_bf16(v0[2], v0[3]); w.z = cvt_pk_bf16(v1[0], v1[1]); w.w = cvt_pk_bf16(v1[2], v1[3]);
                    *(u32x4*)(rowp + bj * HALF) = w; } }
    }
};
template <class Epi, class Sched, bool ALIGN_EPI = false, bool SP2 = false>
__device__ __forceinline__ void gemm_phase(PG8_LAS unsigned char* lds, const Gemm g, const Sched& S, const Epi& E) {
    const int tid = threadIdx.x, wid = __builtin_amdgcn_readfirstlane(tid >> 6), lane = tid & 63, wr = wid >> 2, wc = wid & 3, fr = lane & 15, fq = lane >> 4;
    const int K = g.K, nt = K / BK;
    unsigned voffA[2], voffB[2];
#pragma unroll
    for (int i = 0; i < 2; ++i) { int R, C; stage_rc(tid * 16 + i * 8192, R, C); const int Rb = Epi::PERM ? ((R & ~31) + perm32(R & 31)) : R;
        voffA[i] = (unsigned)(R * K + C) * 2u; voffB[i] = (unsigned)(Rb * K + C) * 2u; }
    const size_t kstep = (size_t)(BK * 2);
    const size_t hstep = (size_t)HALF * K * 2;
    const size_t tstep = 2 * hstep;
    const unsigned ldsw = (unsigned)wid * 1024u;
    const int aoff = lds_byte(wr * 64 + fr, fq * 8), boff = lds_byte(wc * 32 + fr, fq * 8);
#define PG8_SA(b, h) (((b) * 2 + (h)) * HTB)
#define PG8_SB(b, h) ((4 + (b) * 2 + (h)) * HTB)
#define PG8_STAGE(bufoff, gbase, voff) do { _Pragma("unroll") for (int _i = 0; _i < 2; ++_i) \
        __builtin_amdgcn_global_load_lds((const unsigned*)((const char*)(gbase) + (voff)[_i]), (PG8_LAS unsigned*)(lds + (bufoff) + ldsw + _i * 8192), 16, 0, 0); } while (0)
#define PG8_LDA(dst, b, h) do { _Pragma("unroll") for (int m = 0; m < 4; ++m) _Pragma("unroll") for (int k = 0; k < 2; ++k) dst[m][k] = *(const PG8_LAS bf16x8*)(lds + PG8_SA(b, h) + aoff + m * 2048 + k * 1024); } while (0)
#define PG8_LDB(dst, b, h) do { _Pragma("unroll") for (int n = 0; n < 2; ++n) _Pragma("unroll") for (int k = 0; k < 2; ++k) dst[n][k] = *(const PG8_LAS bf16x8*)(lds + PG8_SB(b, h) + boff + n * 2048 + k * 1024); } while (0)
#define PG8_MMA(ai, bj, At, Bt) do { __builtin_amdgcn_s_setprio(1); _Pragma("unroll") for (int m = 0; m < 4; ++m) _Pragma("unroll") for (int n = 0; n < 2; ++n) _Pragma("unroll") for (int k = 0; k < 2; ++k) \
        acc[ai][bj][m][n] = __builtin_amdgcn_mfma_f32_16x16x32_bf16(Bt[n][k], At[m][k], acc[ai][bj][m][n], 0, 0, 0); __builtin_amdgcn_s_setprio(0); } while (0)
#define PG8_WAIT_V(n) asm volatile("s_waitcnt vmcnt(" #n ")" ::: "memory")
#define PG8_WAIT_L(n) asm volatile("s_waitcnt lgkmcnt(" #n ")" ::: "memory")
#define PG8_BAR __builtin_amdgcn_s_barrier()
#define PG8_SCHED __builtin_amdgcn_sched_barrier(0)
    Unit cur, nxt; int ui = 0;
    if (!S.next(0, cur)) return;
    f32x4 acc[2][2][4][2];
#pragma unroll
    for (int a = 0; a < 2; ++a)
#pragma unroll
        for (int b = 0; b < 2; ++b)
#pragma unroll
            for (int m = 0; m < 4; ++m)
#pragma unroll
                for (int n = 0; n < 2; ++n) acc[a][b][m][n] = (f32x4){0.f, 0.f, 0.f, 0.f};
    bf16x8 At[4][2], B0[2][2], B1[2][2];
    const char* cA = (const char*)g.A + (size_t)cur.pm * tstep; const char* cB = (const char*)g.Bt + (size_t)cur.pn * tstep;
    S.a_ready(cur);
    if constexpr (SP2) {
        PG8_STAGE(PG8_SB(0, 0), cB, voffB); PG8_STAGE(PG8_SB(0, 1), cB + hstep, voffB); PG8_STAGE(PG8_SA(0, 0), cA, voffA); PG8_STAGE(PG8_SA(0, 1), cA + hstep, voffA);
        if (wr == 1) PG8_BAR;
        PG8_WAIT_V(2); PG8_BAR;
        PG8_STAGE(PG8_SB(1, 0), cB + kstep, voffB); PG8_STAGE(PG8_SA(1, 0), cA + kstep, voffA); PG8_STAGE(PG8_SB(1, 1), cB + hstep + kstep, voffB);
        PG8_WAIT_V(6); PG8_BAR;
    } else {
        PG8_STAGE(PG8_SB(0, 0), cB, voffB); PG8_STAGE(PG8_SA(0, 0), cA, voffA); PG8_STAGE(PG8_SB(0, 1), cB + hstep, voffB); PG8_STAGE(PG8_SA(0, 1), cA + hstep, voffA);
        if (wr == 1) PG8_BAR;
        PG8_WAIT_V(4); PG8_BAR;
        PG8_STAGE(PG8_SB(1, 0), cB + kstep, voffB); PG8_STAGE(PG8_SA(1, 0), cA + kstep, voffA); PG8_STAGE(PG8_SB(1, 1), cB + hstep + kstep, voffB);
        PG8_WAIT_V(6); PG8_BAR;
    }
    for (;;) {
        const bool has_next = S.next(ui + 1, nxt);
        const char* nA = has_next ? (const char*)g.A + (size_t)nxt.pm * tstep : cA; const char* nB = has_next ? (const char*)g.Bt + (size_t)nxt.pn * tstep : cB;
        for (int t = 0; t < nt; t += 2) {
            const bool last = (t == nt - 2);
            const char* a1 = cA + (size_t)(t + 1) * kstep;
            const char* a2 = last ? nA : cA + (size_t)(t + 2) * kstep; const char* b2 = last ? nB : cB + (size_t)(t + 2) * kstep;
            const char* a3 = a2 + kstep; const char* b3 = b2 + kstep;
            if (last && has_next) S.a_ready(nxt);
            if constexpr (SP2) {
            PG8_LDB(B0, 0, 0); PG8_LDB(B1, 0, 1); PG8_SCHED; PG8_LDA(At, 0, 0); PG8_STAGE(PG8_SA(1, 1), a1 + hstep, voffA);
            PG8_WAIT_V(8); PG8_WAIT_L(0); PG8_BAR; PG8_MMA(0, 0, At, B0); PG8_MMA(0, 1, At, B1); PG8_BAR; PG8_SCHED;
            PG8_LDA(At, 0, 1); PG8_STAGE(PG8_SB(0, 0), b2, voffB); PG8_STAGE(PG8_SB(0, 1), b2 + hstep, voffB); PG8_STAGE(PG8_SA(0, 0), a2, voffA);
            PG8_WAIT_V(8); PG8_WAIT_L(0); PG8_BAR; PG8_MMA(1, 0, At, B0); PG8_MMA(1, 1, At, B1); PG8_BAR; PG8_SCHED;
            PG8_LDB(B0, 1, 0); PG8_LDB(B1, 1, 1); PG8_SCHED; PG8_LDA(At, 1, 0); PG8_STAGE(PG8_SA(0, 1), a2 + hstep, voffA);
            PG8_WAIT_V(8); PG8_WAIT_L(0); PG8_BAR; PG8_MMA(0, 0, At, B0); PG8_MMA(0, 1, At, B1); PG8_BAR; PG8_SCHED;
            PG8_LDA(At, 1, 1); PG8_STAGE(PG8_SB(1, 0), b3, voffB); PG8_STAGE(PG8_SB(1, 1), b3 + hstep, voffB); PG8_STAGE(PG8_SA(1, 0), a3, voffA);
            PG8_WAIT_V(8); PG8_WAIT_L(0); PG8_BAR; PG8_MMA(1, 0, At, B0); PG8_MMA(1, 1, At, B1); PG8_BAR; PG8_SCHED;
            } else {
            PG8_LDB(B0, 0, 0); PG8_SCHED; PG8_LDA(At, 0, 0); PG8_STAGE(PG8_SA(1, 1), a1 + hstep, voffA);
            PG8_WAIT_L(8); PG8_BAR; PG8_WAIT_L(0); PG8_MMA(0, 0, At, B0); PG8_BAR; PG8_SCHED;
            PG8_LDB(B1, 0, 1); PG8_STAGE(PG8_SB(0, 0), b2, voffB);
            PG8_BAR; PG8_WAIT_L(0); PG8_MMA(0, 1, At, B1); PG8_BAR;
            PG8_LDA(At, 0, 1); PG8_STAGE(PG8_SA(0, 0), a2, voffA);
            PG8_BAR; PG8_WAIT_L(0); PG8_MMA(1, 0, At, B0); PG8_BAR; PG8_SCHED;
            PG8_STAGE(PG8_SB(0, 1), b2 + hstep, voffB);
            PG8_WAIT_V(6); PG8_BAR; PG8_MMA(1, 1, At, B1); PG8_BAR;
            PG8_LDB(B0, 1, 0); PG8_SCHED; PG8_LDA(At, 1, 0); PG8_STAGE(PG8_SA(0, 1), a2 + hstep, voffA);
            PG8_WAIT_L(8); PG8_BAR; PG8_WAIT_L(0); PG8_MMA(0, 0, At, B0); PG8_BAR; PG8_SCHED;
            PG8_LDB(B1, 1, 1); PG8_STAGE(PG8_SB(1, 0), b3, voffB);
            PG8_BAR; PG8_WAIT_L(0); PG8_MMA(0, 1, At, B1); PG8_BAR;
            PG8_LDA(At, 1, 1); PG8_STAGE(PG8_SA(1, 0), a3, voffA);
            PG8_BAR; PG8_WAIT_L(0); PG8_MMA(1, 0, At, B0); PG8_BAR; PG8_SCHED;
            PG8_STAGE(PG8_SB(1, 1), b3 + hstep, voffB);
            PG8_WAIT_V(6); PG8_BAR; PG8_MMA(1, 1, At, B1); PG8_BAR;
            }
        }
        if constexpr (ALIGN_EPI) { if (wr == 0) PG8_BAR; }
        if constexpr (!Epi::AFTER_DRAIN) { E(acc, cur, wr, wc, fr, fq); S.done(cur); }
        if (!has_next) break;
#pragma unroll
        for (int a = 0; a < 2; ++a)
#pragma unroll
            for (int b = 0; b < 2; ++b)
#pragma unroll
                for (int m = 0; m < 4; ++m)
#pragma unroll
                    for (int n = 0; n < 2; ++n) acc[a][b][m][n] = (f32x4){0.f, 0.f, 0.f, 0.f};
        cur = nxt; cA = nA; cB = nB; ++ui;
        if constexpr (ALIGN_EPI) { if (wr == 1) PG8_BAR; }
    }
    PG8_WAIT_V(0);
    if constexpr (!ALIGN_EPI) { if (wr == 0) PG8_BAR; }
    PG8_BAR;
    if constexpr (Epi::AFTER_DRAIN) { E.fused(acc, cur, wr, wc, fr, fq, lds, wid, lane); S.done(cur); }
#undef PG8_SA
#undef PG8_SB
#undef PG8_STAGE
#undef PG8_LDA
#undef PG8_LDB
#undef PG8_MMA
#undef PG8_WAIT_V
#undef PG8_WAIT_L
#undef PG8_BAR
#undef PG8_SCHED
}
}

#ifndef PG8_SP2
#define PG8_SP2 true
#endif
#ifndef PG8_ALIGN
#define PG8_ALIGN true
#endif
#define GAS __attribute__((address_space(1)))
#define LAS __attribute__((address_space(3)))
typedef unsigned short bf16;
typedef unsigned v4u __attribute__((ext_vector_type(4)));
typedef float f32x4 __attribute__((ext_vector_type(4)));
typedef short bf16x8 __attribute__((ext_vector_type(8)));
typedef GAS unsigned gu32;
typedef GAS unsigned long long gu64;
#define RLX_AGENT __ATOMIC_RELAXED, __HIP_MEMORY_SCOPE_AGENT
#define LDS_WAIT() asm volatile("s_waitcnt lgkmcnt(0)" ::: "memory")
#define VM_WAIT() asm volatile("s_waitcnt vmcnt(0)" ::: "memory")
__device__ __forceinline__ unsigned long long rt() { return __builtin_amdgcn_s_memrealtime(); }
__device__ __forceinline__ unsigned f2bf(float f) { unsigned u = __builtin_bit_cast(unsigned, f); return (u + 0x7fffu + ((u >> 16) & 1u)) >> 16; }
typedef float pk2_f32x2 __attribute__((ext_vector_type(2))); typedef __bf16 pk2_bf16x2 __attribute__((ext_vector_type(2)));
__device__ __forceinline__ unsigned pk2(float lo, float hi) { pk2_f32x2 v = {lo, hi}; pk2_bf16x2 b = __builtin_convertvector(v, pk2_bf16x2); return __builtin_bit_cast(unsigned, b); }

#define XB_TMO      128
#define XB_XCNT(j)  (256  + 64 * (j))
#define XB_XSUB(j)  (1280 + 64 * (j))
#define XB_XGEN(j)  (2304 + 64 * (j))
#define XB_TOP      3328
#define XB_TOPGEN   3392
#define XCD_BAR_WORDS 3456
#define XB_SPIN_CAP (1u << 18)

__device__ __forceinline__ unsigned xb_ld(unsigned* p)              { return __hip_atomic_load(p, __ATOMIC_RELAXED, __HIP_MEMORY_SCOPE_AGENT); }
__device__ __forceinline__ unsigned xb_add(unsigned* p, unsigned v) { return __hip_atomic_fetch_add(p, v, __ATOMIC_RELAXED, __HIP_MEMORY_SCOPE_AGENT); }
__device__ __forceinline__ unsigned xb_xcc_id() { return (unsigned)__builtin_amdgcn_s_getreg((3 << 11) | 20) & 0xFu; }
#define XB_SPIN(cond, bar) do { unsigned _sp = 0; while (cond) { __builtin_amdgcn_s_sleep(1); \
    if ((++_sp & 255u) == 0u) { if (xb_ld(&(bar)[XB_TMO])) break; if (_sp > XB_SPIN_CAP) { atomicAdd(&(bar)[XB_TMO], 1u); break; } } } } while (0)

struct XcdBarrier {
    unsigned* bar; unsigned x;
    volatile LAS unsigned* st;
};

__device__ __forceinline__ XcdBarrier xcd_barrier_post(unsigned* bar, volatile LAS unsigned* st) {
    XcdBarrier b; b.bar = bar; b.x = xb_xcc_id(); b.st = st;
    if (threadIdx.x == 0) (void)xb_add(&bar[XB_XCNT(b.x)], 1u);
    return b;
}
__device__ __forceinline__ void xcd_barrier_complete(unsigned* bar, unsigned x, unsigned& nloc, unsigned& nx) {
    const unsigned G = gridDim.x * gridDim.y * gridDim.z;
    unsigned sum, cnt, mine, sp = 0u;
    for (;;) {
        sum = 0u; cnt = 0u; mine = 0u;
#pragma unroll
        for (unsigned j = 0; j < 16; ++j) { const unsigned c = xb_ld(&bar[XB_XCNT(j)]); sum += c; cnt += (c > 0u) ? 1u : 0u; mine = (j == x) ? c : mine; }
        if (sum == G) break;
        __builtin_amdgcn_s_sleep(1);
        if ((++sp & 255u) == 0u) { if (xb_ld(&bar[XB_TMO])) break; if (sp > XB_SPIN_CAP) { atomicAdd(&bar[XB_TMO], 1u); break; } }
    }
    nloc = mine > 0u ? mine : 1u; nx = cnt > 0u ? cnt : 1u;
}

__device__ __forceinline__ void xcd_barrier(const XcdBarrier& b) {
    asm volatile("s_waitcnt vmcnt(0)" ::: "memory");
    __syncthreads();
    if (threadIdx.x == 0) {
        unsigned* bar = b.bar;
        __builtin_amdgcn_s_waitcnt(0);
        unsigned nloc = b.st[0], nx = b.st[1];
        if (nloc == 0u) { xcd_barrier_complete(bar, b.x, nloc, nx); b.st[0] = nloc; b.st[1] = nx; }
        const unsigned old = xb_add(&bar[XB_XSUB(b.x)], 1u);
        const unsigned gen = old / nloc;
        if (old + 1u == (gen + 1u) * nloc) {
            __builtin_amdgcn_fence(__ATOMIC_RELEASE, "agent");
            asm volatile("s_waitcnt vmcnt(0)" ::: "memory");
            const unsigned og = xb_add(&bar[XB_TOP], 1u);
            const unsigned tg = og / nx;
            if (og + 1u == (tg + 1u) * nx) xb_add(&bar[XB_TOPGEN], 1u);
            else XB_SPIN(xb_ld(&bar[XB_TOPGEN]) == tg, bar);
            __builtin_amdgcn_fence(__ATOMIC_ACQUIRE, "agent");
            xb_add(&bar[XB_XGEN(b.x)], 1u);
            asm volatile("s_waitcnt vmcnt(0)" ::: "memory");
        } else {
            XB_SPIN(xb_ld(&bar[XB_XGEN(b.x)]) == gen, bar);
            __builtin_amdgcn_fence(__ATOMIC_ACQUIRE, "agent");
            asm volatile("s_waitcnt vmcnt(0)" ::: "memory");
        }
    }
    __syncthreads();
}


constexpr int NWAVES = 8;
constexpr int DM = 2048, BATCH = 4, SEQ = 4096, M = BATCH * SEQ;
constexpr int NIN = 6176, NINP = 6144;
constexpr int O_GQ = 0, O_GK = 512, O_GV = 1024, O_GR = 2048, O_AQ = 3072, O_AK = 4096, O_AV = 5120;
constexpr float EPS = 1e-6f;
constexpr int PEER_K = 128;

constexpr size_t MiB = 1u << 20;
constexpr size_t WS_CTL = 0, CTL_ZERO_BYTES = 1 * MiB;
constexpr size_t WS_WIN = 1 * MiB;
constexpr size_t WS_WGD = 25 * MiB;
constexpr size_t WS_GDB = 62 * MiB;
constexpr size_t WS_WOUT = 26 * MiB;
constexpr size_t WS_WQ = 34 * MiB;
constexpr size_t WS_SSQ = 42 * MiB;
constexpr size_t WS_EIDX = 44 * MiB;
constexpr size_t WS_GATE = 52 * MiB;
constexpr size_t WS_SKB = 60 * MiB;
constexpr size_t WS_XN = 64 * MiB;
constexpr size_t WS_PROJ = 128 * MiB;
constexpr size_t WS_HB = 256 * MiB;
constexpr size_t WS_OF = 328 * MiB;
constexpr size_t WS_OB = 360 * MiB;
constexpr size_t WS_ATTP = 392 * MiB;
constexpr size_t WS_ATTML = 488 * MiB;
constexpr size_t WS_GT_QD = 64 * MiB;
constexpr size_t WS_GT_KE = 96 * MiB;
constexpr size_t OUT_GT_AM = 0;
constexpr size_t OUT_GT_DEC = 16 * MiB;
constexpr size_t OUT_GT_VT = 32 * MiB;
constexpr int CW_ATTQX = 512;
constexpr size_t WS_EIDX16 = 494 * MiB;
constexpr size_t WS_END = 498 * MiB;
constexpr size_t OUT_U8 = 64 * MiB;
constexpr size_t OUT_V8 = 96 * MiB;
constexpr size_t WS_SU = 61 * MiB;
constexpr size_t WS_SV = 61 * MiB + 65536;
constexpr int CONV_FIRST_RANK = 24;
constexpr int CW_CONVQ = 256;
constexpr size_t WS_PW = 128 * MiB;
constexpr size_t WS_SSQ2 = 136 * MiB;
constexpr size_t WS_PD = 64 * MiB;
constexpr int PEER_E = 16384;
constexpr int CW_TMO = 0, CW_CODE = 1, CW_BAR = 4096;

constexpr int RING_OFF = 0, RING_BYTES = 131072;
constexpr int LDS_BYTES = 163840;
constexpr int LDSCTL_OFF = LDS_BYTES - 1024, MISC_OFF = LDSCTL_OFF + 320;

typedef float f32x2 __attribute__((ext_vector_type(2)));
typedef float f32x16 __attribute__((ext_vector_type(16)));
typedef int i32x4 __attribute__((ext_vector_type(4)));
typedef int i32x2 __attribute__((ext_vector_type(2)));
__device__ __forceinline__ float bf2f(unsigned short h) { return __builtin_bit_cast(float, (unsigned)h << 16); }
__device__ __forceinline__ float bflo(unsigned w) { return __builtin_bit_cast(float, w << 16); }
__device__ __forceinline__ float bfhi(unsigned w) { return __builtin_bit_cast(float, w & 0xffff0000u); }
#define WRED_DPP(x, ctrl) __builtin_bit_cast(float, __builtin_amdgcn_update_dpp(0, __builtin_bit_cast(int, (x)), ctrl, 0xF, 0xF, false))
#define WRED_LANE(x, l) __builtin_bit_cast(float, __builtin_amdgcn_readlane(__builtin_bit_cast(int, (x)), (l)))
__device__ __forceinline__ float wave_sum(float v) {
    v += WRED_DPP(v, 0xB1); v += WRED_DPP(v, 0x4E); v += WRED_DPP(v, 0x141); v += WRED_DPP(v, 0x140);
    return (WRED_LANE(v, 0) + WRED_LANE(v, 16)) + (WRED_LANE(v, 32) + WRED_LANE(v, 48));
}
__device__ __forceinline__ float wave_max(float v) {
    v = fmaxf(v, WRED_DPP(v, 0xB1)); v = fmaxf(v, WRED_DPP(v, 0x4E)); v = fmaxf(v, WRED_DPP(v, 0x141)); v = fmaxf(v, WRED_DPP(v, 0x140));
    return fmaxf(fmaxf(WRED_LANE(v, 0), WRED_LANE(v, 16)), fmaxf(WRED_LANE(v, 32), WRED_LANE(v, 48)));
}

#define SWAP_PAIR(OP, x, r0, r1) do { unsigned a_ = __builtin_bit_cast(unsigned, (x)), b_ = a_; asm volatile("" : "+v"(b_)); auto s_ = OP(a_, b_, false, false); const unsigned u0_ = s_[0], u1_ = s_[1];   r0 = __builtin_bit_cast(float, u0_); r1 = __builtin_bit_cast(float, u1_); } while (0)
__device__ __forceinline__ float xrow_max(float v) {
    float p, q; SWAP_PAIR(__builtin_amdgcn_permlane16_swap, v, p, q); v = fmaxf(p, q); SWAP_PAIR(__builtin_amdgcn_permlane32_swap, v, p, q); return fmaxf(p, q);
}
__device__ __forceinline__ float xrow_sum(float v) {
    float p, q; SWAP_PAIR(__builtin_amdgcn_permlane16_swap, v, p, q); v = p + q; SWAP_PAIR(__builtin_amdgcn_permlane32_swap, v, p, q); return p + q;
}
template <class T> __device__ __forceinline__ T* opaque(T* p) { asm volatile("" : "+s"(p)); return (T*)(GAS T*)p; }
__device__ __forceinline__ int lane_id() { int x; asm volatile("v_mbcnt_lo_u32_b32 %0, -1, 0\n\tv_mbcnt_hi_u32_b32 %0, -1, %0" : "=v"(x)); return x; }
__device__ __forceinline__ int opaque_v(int x) { asm volatile("" : "+v"(x)); return x; }
template <class T> __device__ __forceinline__ T ldu(const void* ubase, unsigned voff) { return *(const GAS T*)((const GAS char*)ubase + voff); }
template <class T> __device__ __forceinline__ void stu(void* ubase, unsigned voff, T v) { *(GAS T*)((GAS char*)ubase + voff) = v; }
namespace pg8 {
struct EpiRes {
    static constexpr bool PERM = true, AFTER_DRAIN = false;
    const float* x; bf16_t* HB; float* ssq; int ldc;
    __device__ __forceinline__ void operator()(const f32x4 (&acc)[2][2][4][2], const Unit& u, int wr, int wc, int fr, int fq) const {
        const int col0 = u.pn * BM + wc * 32 + 8 * fq;
        const int rbase = u.pm * BM + wr * 64 + fr;
        f32x4 xc[2][2], xn[2][2];
#define EPIRES_LOAD(D, IDX) do { const size_t o_ = (size_t)(rbase + ((IDX) >> 2) * HALF + ((IDX) & 3) * 16) * ldc + col0; _Pragma("unroll") for (int bj = 0; bj < 2; ++bj) { D[bj][0] = *(const f32x4*)(x + o_ + bj * HALF); D[bj][1] = *(const f32x4*)(x + o_ + bj * HALF + 4); } } while (0)
        EPIRES_LOAD(xc, 0);
#pragma unroll
        for (int idx = 0; idx < 8; ++idx) { const int ai = idx >> 2, m = idx & 3;
            if (idx + 1 < 8) EPIRES_LOAD(xn, idx + 1);
            const int r = rbase + ai * HALF + m * 16; const size_t off = (size_t)r * ldc + col0; float s = 0.f;
#pragma unroll
            for (int bj = 0; bj < 2; ++bj) {
                const f32x4 h0 = xc[bj][0] + acc[ai][bj][m][0], h1 = xc[bj][1] + acc[ai][bj][m][1];
                s += ((h0[0] * h0[0] + h0[1] * h0[1]) + (h0[2] * h0[2] + h0[3] * h0[3])) + ((h1[0] * h1[0] + h1[1] * h1[1]) + (h1[2] * h1[2] + h1[3] * h1[3]));
                u32x4 w; w.x = cvt_pk_bf16(h0[0], h0[1]); w.y = cvt_pk_bf16(h0[2], h0[3]); w.z = cvt_pk_bf16(h1[0], h1[1]); w.w = cvt_pk_bf16(h1[2], h1[3]);
                *(u32x4*)(HB + off + bj * HALF) = w;
            }
            s += __shfl_xor(s, 16); s += __shfl_xor(s, 32);
            if (fq == 0) ssq[(size_t)r * 32 + u.pn * 4 + wc] = s;
#pragma unroll
            for (int bj = 0; bj < 2; ++bj) { xc[bj][0] = xn[bj][0]; xc[bj][1] = xn[bj][1]; }
        }
#undef EPIRES_LOAD
    }
};
}

struct Frame {
    LAS unsigned char* lds;
    volatile LAS unsigned* MISC;
    gu32* ctl;
    int wave;
    int vcu, G;
};

__device__ __forceinline__ void p0_transpose_item(const float* W, int K, int ldw, const float* gk, bf16* WT, LAS float* scr, int item, int lane) {
    const int nblk = ldw / 32, kb = item / nblk, nb = item % nblk, k0 = 64 * kb, n0 = 32 * nb;
    float wv[32];
    { const GAS float* Wg = (const GAS float*)W + (size_t)(k0 + (lane >> 5)) * ldw + n0 + (lane & 31);
#pragma unroll
      for (int i = 0; i < 32; ++i) wv[i] = Wg[(size_t)(2 * i) * ldw]; }
    if (gk) {
#pragma unroll
      for (int i = 0; i < 32; ++i) wv[i] *= ((const GAS float*)gk)[k0 + 2 * i + (lane >> 5)]; }
#pragma unroll
    for (int i = 0; i < 32; ++i) scr[(2 * i + (lane >> 5)) * 33 + (lane & 31)] = wv[i];
    LDS_WAIT(); asm volatile("" ::: "memory");
    const int c = lane & 7;
#pragma unroll
    for (int j = 0; j < 4; ++j) { const int n = (lane >> 3) + 8 * j; const LAS float* s = scr + (8 * c) * 33 + n;
        v4u o; o.x = pk2(s[0 * 33], s[1 * 33]); o.y = pk2(s[2 * 33], s[3 * 33]); o.z = pk2(s[4 * 33], s[5 * 33]); o.w = pk2(s[6 * 33], s[7 * 33]);
        *(GAS v4u*)(WT + (size_t)(n0 + n) * K + k0 + 8 * c) = o; }
    LDS_WAIT(); asm volatile("" ::: "memory");
}
struct Args {
    const float* in[16]; float* out; unsigned char* ws; int ph_lo, ph_hi, li, pad;
};

__device__ __forceinline__ void p0_prologue(Frame& F, const Args& a) {
    unsigned char* ws = a.ws;
    LAS float* scr = (LAS float*)(F.lds + RING_OFF + F.wave * 16384);
    const int gw = F.vcu * NWAVES + F.wave, NGW = F.G * NWAVES;
    bf16* Win_t = (bf16*)(ws + WS_WIN); bf16* Wout_t = (bf16*)(ws + WS_WOUT); bf16* Wq_t = (bf16*)(ws + WS_WQ); bf16* XN = (bf16*)(ws + WS_XN);
    constexpr int I_IN = (DM / 64) * (NIN / 32), I_SQ = (DM / 64) * (DM / 32);
    constexpr int NITEMS = I_IN + 2 * I_SQ;
    for (int it = gw; it < NITEMS; it += NGW) {
        int r = it;
        if (r < I_IN) { const int nb = r % (NIN / 32); bf16* dst = nb < 96 ? Win_t : nb == 96 ? (bf16*)(ws + WS_WGD) - (size_t)96 * 32 * DM : Win_t - (size_t)32 * DM;
            p0_transpose_item(a.in[2], DM, NIN, nullptr, dst, scr, r, lane_id()); continue; } r -= I_IN;
        if (r < I_SQ) { p0_transpose_item(a.in[9], DM, DM, nullptr, Wout_t, scr, r, lane_id()); continue; } r -= I_SQ;
        p0_transpose_item(a.in[11], DM, DM, a.in[10], Wq_t, scr, r, lane_id());
    }
    { const f32x4* sk = (const f32x4*)a.in[12]; unsigned long long* skb = (unsigned long long*)(ws + WS_SKB);
      for (int i = gw * 64 + lane_id(); i < 8 * 2 * 128 * 128 / 4; i += NGW * 64) { const f32x4 v = sk[i]; skb[i] = (unsigned long long)pk2(v.x, v.y) | ((unsigned long long)pk2(v.z, v.w) << 32); } }
    { const GAS f32x4* gr = (const GAS f32x4*)a.in[1] + lane_id(); f32x4 gg[8];
#pragma unroll
      for (int j = 0; j < 8; ++j) gg[j] = gr[64 * j];
      f32x4 v[8], vn[8], vn2[8];
#define P0_LOAD(MM, V) do { _Pragma("unroll") for (int j = 0; j < 8; ++j) V[j] = ((const GAS f32x4*)(a.in[0] + (size_t)(MM) * DM) + lane_id())[64 * j]; } while (0)
      if (gw < M) { P0_LOAD(gw, v); const int m1 = gw + NGW < M ? gw + NGW : gw; P0_LOAD(m1, vn); }
      for (int m = gw; m < M; m += NGW) { const int mn = m + 2 * NGW < M ? m + 2 * NGW : m;
          P0_LOAD(mn, vn2);
          float ss = 0.f;
#pragma unroll
          for (int j = 0; j < 8; ++j) ss += (v[j].x * v[j].x + v[j].y * v[j].y) + (v[j].z * v[j].z + v[j].w * v[j].w);
          const float rstd = 1.f / sqrtf(wave_sum(ss) * (1.f / DM) + EPS);
          GAS unsigned long long* o8 = (GAS unsigned long long*)(XN + (size_t)m * DM) + lane_id();
#pragma unroll
          for (int j = 0; j < 8; ++j) o8[64 * j] = (unsigned long long)pk2(v[j].x * rstd * gg[j].x, v[j].y * rstd * gg[j].y) | ((unsigned long long)pk2(v[j].z * rstd * gg[j].z, v[j].w * rstd * gg[j].w) << 32);
#pragma unroll
          for (int j = 0; j < 8; ++j) { v[j] = vn[j]; vn[j] = vn2[j]; } } }
#undef P0_LOAD
}


__device__ __forceinline__ void gd_side_gemm(Frame& F, const Args& a) {
    unsigned char* ws = a.ws; const bf16* XN = (const bf16*)(ws + WS_XN); const bf16* WG = (const bf16*)(ws + WS_WGD); float* GDB = (float*)(ws + WS_GDB);
    const int lane = lane_id(), w = F.wave, r32 = lane & 31, hh = lane >> 5; LAS float* part = (LAS float*)F.lds;
    for (int blk = F.vcu; blk < M / 64; blk += F.G) { const int tok0 = blk * 64;
        f32x16 acc[2];
#pragma unroll
        for (int tt = 0; tt < 2; ++tt) acc[tt] = (f32x16){0.f, 0.f, 0.f, 0.f, 0.f, 0.f, 0.f, 0.f, 0.f, 0.f, 0.f, 0.f, 0.f, 0.f, 0.f, 0.f};
#pragma unroll 4
        for (int ks = 0; ks < 16; ++ks) { const int k0 = 256 * w + 16 * ks + 8 * hh; const bf16x8 bw = *(const bf16x8*)(WG + (size_t)r32 * DM + k0);
#pragma unroll
            for (int tt = 0; tt < 2; ++tt) { const bf16x8 ax = *(const bf16x8*)(XN + (size_t)(tok0 + 32 * tt + r32) * DM + k0); acc[tt] = __builtin_amdgcn_mfma_f32_32x32x16_bf16(ax, bw, acc[tt], 0, 0, 0); } }
#pragma unroll
        for (int tt = 0; tt < 2; ++tt)
#pragma unroll
            for (int r = 0; r < 16; ++r) { const float x = acc[tt][r]; part[((w * 2 + tt) * 16 + r) * 64 + lane] = x; }
        __syncthreads();
#pragma unroll
        for (int i = 0; i < 4; ++i) { const int o = (F.wave * 64 + lane_id()) + 512 * i; float sum = 0.f;
#pragma unroll
            for (int ww = 0; ww < 8; ++ww) sum += part[ww * 2048 + o];
            const int tt = o >> 10, r = (o >> 6) & 15, ln = o & 63; const int t = 32 * tt + (r & 3) + 8 * (r >> 2) + 4 * (ln >> 5);
            GDB[(size_t)(tok0 + t) * 32 + (ln & 31)] = sum; }
        __syncthreads();
    }
}

__device__ __forceinline__ void p3_finalize(Frame& F, const Args& a) {
    unsigned char* ws = a.ws;
    const int gw = F.vcu * NWAVES + F.wave, NGW = F.G * NWAVES, lane = lane_id();
    const GAS bf16* OFp = (const GAS bf16*)(ws + WS_OF); const GAS bf16* OBp = (const GAS bf16*)(ws + WS_OB);
    const GAS bf16* PROJ = (const GAS bf16*)(ws + WS_PROJ); GAS bf16* Y = (GAS bf16*)(ws + WS_XN);
    const GAS float* ATTML = (const GAS float*)(ws + WS_ATTML); const GAS bf16* ATTP = (const GAS bf16*)(ws + WS_ATTP);
    const GAS float* gla_g = (const GAS float*)a.in[7]; const GAS float* att_g = (const GAS float*)a.in[8];
    const f32x4 gg = *(const GAS f32x4*)(gla_g + 4 * lane);
    f32x4 ag[2][2];
#pragma unroll
    for (int p = 0; p < 2; ++p) { ag[p][0] = *(const GAS f32x4*)(att_g + p * 512 + 8 * lane); ag[p][1] = *(const GAS f32x4*)(att_g + p * 512 + 8 * lane + 4); }
    unsigned long long wf[4], wb[4], gr[4], nwf[4], nwb[4], ngr[4]; f32x2 ml[2][3], nml[2][3]; v4u ow[2][3], now[2][3];
#define P3_LOAD(MM, WF, WB, GR, ML, OW) do { _Pragma("unroll") for (int hh = 0; hh < 4; ++hh) { WF[hh] = *(const GAS unsigned long long*)(OFp + (size_t)(MM) * 1024 + hh * 256 + 4 * lane); \
            WB[hh] = *(const GAS unsigned long long*)(OBp + (size_t)(MM) * 1024 + hh * 256 + 4 * lane); GR[hh] = *(const GAS unsigned long long*)(PROJ + (size_t)(MM) * NINP + O_GR + hh * 256 + 4 * lane); } \
        _Pragma("unroll") for (int p = 0; p < 2; ++p) { const int col = p * 512 + 8 * lane, hd = col >> 6; _Pragma("unroll") for (int pt = 0; pt < 3; ++pt) { const size_t rec = ((size_t)pt * M + (MM)) * 16 + hd; \
            ML[p][pt] = *(const GAS f32x2*)(ATTML + rec * 2); OW[p][pt] = *(const GAS v4u*)(ATTP + rec * 64 + (col & 63)); } } } while (0)
    if (gw < M) P3_LOAD(gw, wf, wb, gr, ml, ow);
    for (int m = gw; m < M; m += NGW) {
        const int mn = m + NGW < M ? m + NGW : m;
        P3_LOAD(mn, nwf, nwb, ngr, nml, now);
#pragma unroll
        for (int hh = 0; hh < 4; ++hh) {
            const f32x4 o = (f32x4){bflo((unsigned)wf[hh]) + bflo((unsigned)wb[hh]), bfhi((unsigned)wf[hh]) + bfhi((unsigned)wb[hh]), bflo((unsigned)(wf[hh] >> 32)) + bflo((unsigned)(wb[hh] >> 32)), bfhi((unsigned)(wf[hh] >> 32)) + bfhi((unsigned)(wb[hh] >> 32))};
            const float ss = wave_sum((o.x * o.x + o.y * o.y) + (o.z * o.z + o.w * o.w));
            const float rstd = 1.f / sqrtf(ss * (1.f / 256.f) + EPS);
            const float r0 = bflo((unsigned)gr[hh]), r1 = bfhi((unsigned)gr[hh]), r2 = bflo((unsigned)(gr[hh] >> 32)), r3 = bfhi((unsigned)(gr[hh] >> 32));
            const float y0 = o.x * rstd * gg.x * (r0 / (1.f + __expf(-r0))), y1 = o.y * rstd * gg.y * (r1 / (1.f + __expf(-r1)));
            const float y2 = o.z * rstd * gg.z * (r2 / (1.f + __expf(-r2))), y3 = o.w * rstd * gg.w * (r3 / (1.f + __expf(-r3)));
            *(GAS unsigned long long*)(Y + (size_t)m * DM + hh * 256 + 4 * lane) = (unsigned long long)pk2(y0, y1) | ((unsigned long long)pk2(y2, y3) << 32);
        }
        float av[16]; float ss = 0.f;
#pragma unroll
        for (int p = 0; p < 2; ++p) {
            const float mt = fmaxf(fmaxf(ml[p][0].x, ml[p][1].x), ml[p][2].x); const float w0 = __expf(ml[p][0].x - mt), w1 = __expf(ml[p][1].x - mt), w2 = __expf(ml[p][2].x - mt);
            const float inv = 1.f / (w0 * ml[p][0].y + w1 * ml[p][1].y + w2 * ml[p][2].y);
            av[p * 8 + 0] = (w0 * bflo(ow[p][0].x) + w1 * bflo(ow[p][1].x) + w2 * bflo(ow[p][2].x)) * inv; av[p * 8 + 1] = (w0 * bfhi(ow[p][0].x) + w1 * bfhi(ow[p][1].x) + w2 * bfhi(ow[p][2].x)) * inv;
            av[p * 8 + 2] = (w0 * bflo(ow[p][0].y) + w1 * bflo(ow[p][1].y) + w2 * bflo(ow[p][2].y)) * inv; av[p * 8 + 3] = (w0 * bfhi(ow[p][0].y) + w1 * bfhi(ow[p][1].y) + w2 * bfhi(ow[p][2].y)) * inv;
            av[p * 8 + 4] = (w0 * bflo(ow[p][0].z) + w1 * bflo(ow[p][1].z) + w2 * bflo(ow[p][2].z)) * inv; av[p * 8 + 5] = (w0 * bfhi(ow[p][0].z) + w1 * bfhi(ow[p][1].z) + w2 * bfhi(ow[p][2].z)) * inv;
            av[p * 8 + 6] = (w0 * bflo(ow[p][0].w) + w1 * bflo(ow[p][1].w) + w2 * bflo(ow[p][2].w)) * inv; av[p * 8 + 7] = (w0 * bfhi(ow[p][0].w) + w1 * bfhi(ow[p][1].w) + w2 * bfhi(ow[p][2].w)) * inv; }
#pragma unroll
        for (int i = 0; i < 16; ++i) ss += av[i] * av[i];
        const float rstd = 1.f / sqrtf(wave_sum(ss) * (1.f / 1024.f) + EPS);
#pragma unroll
        for (int p = 0; p < 2; ++p) { const f32x4 g0 = ag[p][0], g1 = ag[p][1];
            v4u w; w.x = pk2(av[p * 8 + 0] * rstd * g0.x, av[p * 8 + 1] * rstd * g0.y); w.y = pk2(av[p * 8 + 2] * rstd * g0.z, av[p * 8 + 3] * rstd * g0.w);
            w.z = pk2(av[p * 8 + 4] * rstd * g1.x, av[p * 8 + 5] * rstd * g1.y); w.w = pk2(av[p * 8 + 6] * rstd * g1.z, av[p * 8 + 7] * rstd * g1.w);
            *(GAS v4u*)(Y + (size_t)m * DM + 1024 + p * 512 + 8 * lane) = w; }
#pragma unroll
        for (int hh = 0; hh < 4; ++hh) { wf[hh] = nwf[hh]; wb[hh] = nwb[hh]; gr[hh] = ngr[hh]; }
#pragma unroll
        for (int p = 0; p < 2; ++p)
#pragma unroll
            for (int pt = 0; pt < 3; ++pt) { ml[p][pt] = nml[p][pt]; ow[p][pt] = now[p][pt]; }
    }
#undef P3_LOAD
}


__device__ __forceinline__ void ce_desc(float& a, float& b) { const float hi = fmaxf(a, b), lo = fminf(a, b); a = hi; b = lo; }
__device__ __forceinline__ void sort16_desc(float* v) {
    ce_desc(v[0], v[1]); ce_desc(v[2], v[3]); ce_desc(v[0], v[2]); ce_desc(v[1], v[3]); ce_desc(v[1], v[2]); ce_desc(v[4], v[5]); ce_desc(v[6], v[7]); ce_desc(v[4], v[6]);
    ce_desc(v[5], v[7]); ce_desc(v[5], v[6]); ce_desc(v[0], v[4]); ce_desc(v[2], v[6]); ce_desc(v[2], v[4]); ce_desc(v[1], v[5]); ce_desc(v[3], v[7]); ce_desc(v[3], v[5]);
    ce_desc(v[1], v[2]); ce_desc(v[3], v[4]); ce_desc(v[5], v[6]); ce_desc(v[8], v[9]); ce_desc(v[10], v[11]); ce_desc(v[8], v[10]); ce_desc(v[9], v[11]); ce_desc(v[9], v[10]);
    ce_desc(v[12], v[13]); ce_desc(v[14], v[15]); ce_desc(v[12], v[14]); ce_desc(v[13], v[15]); ce_desc(v[13], v[14]); ce_desc(v[8], v[12]); ce_desc(v[10], v[14]); ce_desc(v[10], v[12]);
    ce_desc(v[9], v[13]); ce_desc(v[11], v[15]); ce_desc(v[11], v[13]); ce_desc(v[9], v[10]); ce_desc(v[11], v[12]); ce_desc(v[13], v[14]); ce_desc(v[0], v[8]); ce_desc(v[4], v[12]);
    ce_desc(v[4], v[8]); ce_desc(v[2], v[10]); ce_desc(v[6], v[14]); ce_desc(v[6], v[10]); ce_desc(v[2], v[4]); ce_desc(v[6], v[8]); ce_desc(v[10], v[12]); ce_desc(v[1], v[9]);
    ce_desc(v[5], v[13]); ce_desc(v[5], v[9]); ce_desc(v[3], v[11]); ce_desc(v[7], v[15]); ce_desc(v[7], v[11]); ce_desc(v[3], v[5]); ce_desc(v[7], v[9]); ce_desc(v[11], v[13]);
    ce_desc(v[1], v[2]); ce_desc(v[3], v[4]); ce_desc(v[5], v[6]); ce_desc(v[7], v[8]); ce_desc(v[9], v[10]); ce_desc(v[11], v[12]); ce_desc(v[13], v[14]);
}
__device__ __forceinline__ void merge16_desc(float* v) {
#pragma unroll
    for (int j = 8; j > 0; j >>= 1)
#pragma unroll
        for (int i = 0; i < 16; ++i) { const int l = i ^ j; if (l > i) ce_desc(v[i], v[l]); }
}
__device__ __forceinline__ void top16_of_two(float* a, const float* b) {
#pragma unroll
    for (int i = 0; i < 16; ++i) a[i] = fmaxf(a[i], b[15 - i]);
    merge16_desc(a);
}
__device__ __forceinline__ void top16_of_64(float* v) {
    sort16_desc(v); sort16_desc(v + 16); sort16_desc(v + 32); sort16_desc(v + 48);
    top16_of_two(v, v + 16); top16_of_two(v + 32, v + 48); top16_of_two(v, v + 32);
}
__device__ __forceinline__ void merge8_desc(float* v) {
#pragma unroll
    for (int j = 4; j > 0; j >>= 1)
#pragma unroll
        for (int i = 0; i < 8; ++i) { const int l = i ^ j; if (l > i) ce_desc(v[i], v[l]); }
}
__device__ __forceinline__ void top16_staircase(const float* A, const float* B, float* t1) {
    float Bp[16]; const float cb = 1.f - (A[15] + B[15]);
#pragma unroll
    for (int j = 0; j < 16; ++j) Bp[j] = B[j] + cb;
#define PK_CND(i, j) __builtin_bit_cast(float, (__builtin_bit_cast(unsigned, A[(i)] + Bp[(j)]) & ~255u) | (unsigned)(255 - (((i) << 4) | (j))))
#pragma unroll
    for (int j = 0; j < 16; ++j) t1[j] = PK_CND(0, j);
#pragma unroll
    for (int i = 4; i < 16; ++i) t1[i] = fmaxf(t1[i], PK_CND(4 + (15 - i), 0));
    merge16_desc(t1);
    float t2[16];
#pragma unroll
    for (int k = 0; k < 8; ++k) t2[k] = PK_CND(1, k);
    t2[8] = 0.f; t2[9] = 0.f; t2[10] = 0.f;
#pragma unroll
    for (int m = 0; m < 5; ++m) t2[11 + m] = PK_CND(2, 4 - m);
    merge16_desc(t2);
    float t3[9];
#pragma unroll
    for (int k = 0; k < 4; ++k) { t3[k] = PK_CND(3, k); t3[4 + k] = PK_CND(4 + (3 - k), 1); }
    merge8_desc(t3);
    t3[8] = PK_CND(4, 2);
#pragma unroll
    for (int k = 7; k >= 0; --k) ce_desc(t3[k], t3[k + 1]);
#pragma unroll
    for (int i = 7; i < 16; ++i) t2[i] = fmaxf(t2[i], t3[15 - i]);
    merge16_desc(t2);
#pragma unroll
    for (int i = 0; i < 16; ++i) t1[i] = fmaxf(t1[i], t2[15 - i]);
    merge16_desc(t1);
#undef PK_CND
}
__device__ __forceinline__ void topk_phase(Frame& F, const Args& a) {
    unsigned char* ws = a.ws; const GAS bf16* QP = (const GAS bf16*)(ws + WS_XN); const GAS bf16* SKB = (const GAS bf16*)(ws + WS_SKB); GAS int* EIDX = (GAS int*)(ws + WS_EIDX); GAS int* EIDX16 = (GAS int*)(ws + WS_EIDX16); GAS float* GATE = (GAS float*)(ws + WS_GATE);
    const int lane = lane_id(), r32 = lane & 31, hh = lane >> 5;
    LAS unsigned char* skl = F.lds;
    LAS int* ktab = (LAS int*)(F.lds + 65536 + F.wave * 8192);
    for (int unit = F.vcu; unit < 8 * (M / 512); unit += F.G) {
        const int h = unit & 7, tok0 = (unit >> 3) * 512 + F.wave * 64;
        __syncthreads();
#pragma unroll
        for (int i = 0; i < 8; ++i) { const int idx = (F.wave * 64 + lane_id()) + 512 * i, key = idx >> 4, ch = idx & 15;
            *(LAS v4u*)(skl + key * 256 + ((ch ^ (key & 15)) * 16)) = *(const GAS v4u*)(SKB + ((size_t)h * 256 + key) * 128 + ch * 8); }
        __syncthreads();
#pragma unroll 1
        for (int tt = 0; tt < 2; ++tt) {
            const size_t row = (size_t)(tok0 + tt * 32 + r32);
            float L[2][16];
#pragma unroll
            for (int c = 0; c < 2; ++c) {
                f32x16 acc[4];
#pragma unroll
                for (int kt = 0; kt < 4; ++kt) acc[kt] = (f32x16){0.f, 0.f, 0.f, 0.f, 0.f, 0.f, 0.f, 0.f, 0.f, 0.f, 0.f, 0.f, 0.f, 0.f, 0.f, 0.f};
                const GAS bf16* qb = QP + row * DM + h * 256 + c * 128 + 8 * hh;
#pragma unroll 2
                for (int st = 0; st < 8; ++st) {
                    const bf16x8 bq = *(const GAS bf16x8*)(qb + 16 * st);
#pragma unroll
                    for (int kt = 0; kt < 4; ++kt) { const int key = c * 128 + 32 * kt + r32; const bf16x8 ak = *(const LAS bf16x8*)(skl + key * 256 + (((2 * st + hh) ^ (key & 15)) * 16));
                        acc[kt] = __builtin_amdgcn_mfma_f32_32x32x16_bf16(ak, bq, acc[kt], 0, 0, 0); }
                }
                float v[64];
#pragma unroll
                for (int kt = 0; kt < 4; ++kt)
#pragma unroll
                    for (int r = 0; r < 16; ++r) { const int key = 32 * kt + (r & 3) + 8 * (r >> 2);
                        const float sc = acc[kt][r];
                        v[kt * 16 + r] = __builtin_bit_cast(float, (__builtin_bit_cast(unsigned, sc) & ~127u) | (unsigned)(key + 4 * hh)); }
                top16_of_64(v);
                float p[16];
#pragma unroll
                for (int i = 0; i < 16; ++i) { float lo_, hi_; SWAP_PAIR(__builtin_amdgcn_permlane32_swap, v[i], lo_, hi_); v[i] = lo_; p[i] = hi_; }
                top16_of_two(v, p);
#pragma unroll
                for (int i = 0; i < 16; ++i) { L[c][i] = v[i]; ktab[(c * 16 + i) * 64 + lane] = (int)(__builtin_bit_cast(unsigned, v[i]) & 127u); }
            }
            float cnd[16]; top16_staircase(L[0], L[1], cnd);
            float rstd; { const GAS f32x4* sp = (const GAS f32x4*)((const GAS float*)(ws + WS_SSQ) + row * 32); float ssq = 0.f;
#pragma unroll
              for (int i = 0; i < 8; ++i) { const f32x4 t4 = sp[i]; ssq += (t4.x + t4.y) + (t4.z + t4.w); }
              rstd = 1.0f / sqrtf(ssq * (1.f / DM) + EPS); }
            float mx = __builtin_bit_cast(float, __builtin_bit_cast(unsigned, cnd[0]) & ~255u), sum = 0.f; float ex[16];
#pragma unroll
            for (int i = 0; i < 16; ++i) { ex[i] = __expf((__builtin_bit_cast(float, __builtin_bit_cast(unsigned, cnd[i]) & ~255u) - mx) * rstd); sum += ex[i]; }
            const float inv = 1.f / sum;
            LDS_WAIT(); asm volatile("" ::: "memory");
            if (hh == 0) {
                int ev[16];
#pragma unroll
                for (int i = 0; i < 16; ++i) { const unsigned bits = 255u - (__builtin_bit_cast(unsigned, cnd[i]) & 255u); const int ia = (bits >> 4) & 15, jb = bits & 15; ev[i] = ktab[ia * 64 + lane] * 128 + ktab[(16 + jb) * 64 + lane]; }
                GAS int* ep = EIDX + row * 128 + h * 16; GAS float* gp = GATE + row * 128 + h * 16;
#pragma unroll
                for (int i = 0; i < 2; ++i) *(GAS i32x4*)(EIDX16 + row * 64 + h * 8 + 4 * i) = (i32x4){ev[8 * i] | (ev[8 * i + 1] << 16), ev[8 * i + 2] | (ev[8 * i + 3] << 16), ev[8 * i + 4] | (ev[8 * i + 5] << 16), ev[8 * i + 6] | (ev[8 * i + 7] << 16)};
#pragma unroll
                for (int i = 0; i < 4; ++i) { *(GAS i32x4*)(ep + 4 * i) = (i32x4){ev[4 * i], ev[4 * i + 1], ev[4 * i + 2], ev[4 * i + 3]}; *(GAS f32x4*)(gp + 4 * i) = (f32x4){ex[4 * i] * inv, ex[4 * i + 1] * inv, ex[4 * i + 2] * inv, ex[4 * i + 3] * inv}; }
            }
            LDS_WAIT(); asm volatile("" ::: "memory");
        }
    }
}

__device__ __forceinline__ void gla_prep_phase(Frame& F, const Args& a) {
    unsigned char* ws = a.ws; const bf16* PROJ;
    const int w = F.wave;
    LAS unsigned char* L = F.lds;
    LAS unsigned char* Qraw = L; LAS unsigned char* Kraw = L + 16384; LAS unsigned char* Vraw = L + 32768; LAS float* GDf = (LAS float*)(L + 65536); LAS float* GSUM = (LAS float*)(L + 73728);
    LAS unsigned char* IMGQ = L + 77824; LAS unsigned char* IMGK = L + 95232; LAS unsigned char* IMGE = L + 112640; LAS unsigned char* AMI = L + 32768;
    v4u rq[2], rk[2], rv[4]; f32x4 rg0, rg1;
#define PREP_LOAD(IT) do { const int b_ = (IT) >> 8, h_ = ((IT) >> 6) & 3, n_ = (IT) & 63; const size_t row0_ = (size_t)b_ * SEQ + n_ * 64; ws = opaque(ws); PROJ = (const bf16*)(ws + WS_PROJ); const int tid_ = opaque_v((F.wave * 64 + lane_id())); \
        _Pragma("unroll") for (int i = 0; i < 2; ++i) { const int idx = tid_ + 512 * i, r = idx >> 4, c = idx & 15; \
            rq[i] = *(const GAS v4u*)(PROJ + (row0_ + r) * NINP + O_GQ + h_ * 128 + c * 8); rk[i] = *(const GAS v4u*)(PROJ + (row0_ + r) * NINP + O_GK + h_ * 128 + c * 8); } \
        _Pragma("unroll") for (int i = 0; i < 4; ++i) { const int idx = tid_ + 512 * i, r = idx >> 5, c = idx & 31; rv[i] = *(const GAS v4u*)(PROJ + (row0_ + r) * NINP + O_GV + h_ * 256 + c * 8); } \
        if (tid_ < 256) { const int r = tid_ >> 2, c = tid_ & 3; const GAS float* gsrc = (const GAS float*)(ws + WS_GDB) + (row0_ + r) * 32 + c * 8; rg0 = *(const GAS f32x4*)gsrc; rg1 = *(const GAS f32x4*)(gsrc + 4); } } while (0)
#define PREP_STORE() do { const int tid_ = opaque_v((F.wave * 64 + lane_id())); \
        _Pragma("unroll") for (int i = 0; i < 2; ++i) { const int idx = tid_ + 512 * i, r = idx >> 4, c = idx & 15; *(LAS v4u*)(Qraw + r * 256 + c * 16) = rq[i]; *(LAS v4u*)(Kraw + r * 256 + c * 16) = rk[i]; } \
        _Pragma("unroll") for (int i = 0; i < 4; ++i) { const int idx = tid_ + 512 * i, r = idx >> 5, c = idx & 31; *(LAS v4u*)(Vraw + r * 512 + c * 16) = rv[i]; } \
        if (tid_ < 256) { const int r = tid_ >> 2, c = tid_ & 3; *(LAS f32x4*)(GDf + r * 32 + c * 8) = rg0; *(LAS f32x4*)(GDf + r * 32 + c * 8 + 4) = rg1; } } while (0)
    if (F.vcu < 1024) PREP_LOAD(F.vcu);
    float up0[16], up1[16], bias0 = 0.f, bias1 = 0.f; int hcur = -1;
    for (int it = F.vcu; it < 1024; it += F.G) {
        const int b = it >> 8, h = (it >> 6) & 3, n = it & 63;
        int tid = opaque_v((F.wave * 64 + lane_id())), lane = tid & 63, r32 = lane & 31, hh = lane >> 5;
        if (h != hcur) { hcur = h; const int d = tid & 127; const GAS float* u0 = (const GAS float*)a.in[3] + h * 128 + d; const GAS float* u1 = (const GAS float*)a.in[5] + h * 128 + d;
#pragma unroll
            for (int r = 0; r < 16; ++r) { up0[r] = u0[r * 512]; up1[r] = u1[r * 512]; }
            bias0 = ((const GAS float*)a.in[4])[h * 128 + d]; bias1 = ((const GAS float*)a.in[6])[h * 128 + d]; }
        PREP_STORE();
        __syncthreads();
        if (it + F.G < 1024) PREP_LOAD(it + F.G);
#pragma unroll
        for (int ks = 0; ks < 4; ++ks) { unsigned pk[4];
#pragma unroll
            for (int p = 0; p < 4; ++p) { const int s0 = 16 * ks + 8 * hh + 2 * p; const unsigned lo = *(const LAS unsigned short*)(Vraw + s0 * 512 + (32 * w + r32) * 2), hi = *(const LAS unsigned short*)(Vraw + (s0 + 1) * 512 + (32 * w + r32) * 2); pk[p] = lo | (hi << 16); }
            *(GAS v4u*)((unsigned char*)a.out + OUT_GT_VT + (size_t)it * 32768 + (w * 4 + ks) * 1024 + lane * 16) = (v4u){pk[0], pk[1], pk[2], pk[3]}; }
        for (int dir = 0; dir < 2; ++dir) {
            const size_t idir = (size_t)(((b * 4 + h) * 2 + dir) * 64 + n); ws = opaque(ws); tid = opaque_v(tid); lane = tid & 63; r32 = lane & 31; hh = lane >> 5;
            {
                const int d = tid & 127, tq = tid >> 7; const float bias = dir ? bias1 : bias0;
                float up[16];
#pragma unroll
                for (int r = 0; r < 16; ++r) up[r] = dir ? up1[r] : up0[r];
                float c[16];
#pragma unroll
                for (int i = 0; i < 16; ++i) { const LAS float* g = GDf + (16 * tq + i) * 32 + dir * 16; float z = bias;
#pragma unroll
                    for (int r = 0; r < 16; ++r) z += g[r] * up[r];
                    c[i] = (fminf(z, 0.f) - __logf(1.f + __expf(-fabsf(z)))) * (1.f / 16.f); }
                if (dir == 0) {
#pragma unroll
                    for (int i = 1; i < 16; ++i) c[i] += c[i - 1];
                } else {
#pragma unroll
                    for (int i = 14; i >= 0; --i) c[i] += c[i + 1];
                }
                GSUM[(dir * 4 + tq) * 128 + d] = dir == 0 ? c[15] : c[0];
                __syncthreads();
                const float t0 = GSUM[(dir * 4 + 0) * 128 + d], t1 = GSUM[(dir * 4 + 1) * 128 + d], t2 = GSUM[(dir * 4 + 2) * 128 + d], t3 = GSUM[(dir * 4 + 3) * 128 + d];
                const float Bt = (t0 + t1) + (t2 + t3);
                float off;
                if (dir == 0) off = (tq > 0 ? t0 : 0.f) + (tq > 1 ? t1 : 0.f) + (tq > 2 ? t2 : 0.f);
                else off = (tq < 1 ? t1 : 0.f) + (tq < 2 ? t2 : 0.f) + (tq < 3 ? t3 : 0.f);
                unsigned kep[8];
#pragma unroll
                for (int i = 0; i < 16; i += 2) { float ke2[2];
#pragma unroll
                    for (int q = 0; q < 2; ++q) { const int t = 16 * tq + i + q; const float bi = c[i + q] + off;
                        const float qv = bf2f(*(const LAS unsigned short*)(Qraw + t * 256 + d * 2)), kv = bf2f(*(const LAS unsigned short*)(Kraw + t * 256 + d * 2));
                        *(LAS unsigned short*)(IMGQ + t * 272 + d * 2) = (unsigned short)pk2(qv * 0.08838834764831845f * __expf(bi), 0.f);
                        *(LAS unsigned short*)(IMGK + t * 272 + d * 2) = (unsigned short)pk2(kv * __expf(-bi), 0.f);
                        ke2[q] = kv * __expf(Bt - bi); }
                    kep[i >> 1] = pk2(ke2[0], ke2[1]); }
                *(LAS v4u*)(IMGE + d * 144 + (16 * tq) * 2) = (v4u){kep[0], kep[1], kep[2], kep[3]};
                *(LAS v4u*)(IMGE + d * 144 + (16 * tq + 8) * 2) = (v4u){kep[4], kep[5], kep[6], kep[7]};
                if (tq == 0) ((GAS float*)((unsigned char*)a.out + OUT_GT_DEC))[idir * 128 + d] = __expf(Bt);
            }
            __syncthreads();
            if (w < 4) {
                const int si = w >> 1, ti = w & 1; f32x16 acc = (f32x16){0.f, 0.f, 0.f, 0.f, 0.f, 0.f, 0.f, 0.f, 0.f, 0.f, 0.f, 0.f, 0.f, 0.f, 0.f, 0.f};
#pragma unroll
                for (int ks = 0; ks < 8; ++ks) { const bf16x8 ak = *(const LAS bf16x8*)(IMGK + (32 * si + r32) * 272 + (16 * ks + 8 * hh) * 2), bq = *(const LAS bf16x8*)(IMGQ + (32 * ti + r32) * 272 + (16 * ks + 8 * hh) * 2);
                    acc = __builtin_amdgcn_mfma_f32_32x32x16_bf16(ak, bq, acc, 0, 0, 0); }
                const int t = 32 * ti + r32;
#pragma unroll
                for (int qd = 0; qd < 4; ++qd) { float v4[4];
#pragma unroll
                    for (int i = 0; i < 4; ++i) { const int sidx = 32 * si + 8 * qd + 4 * hh + i; const float x = acc[4 * qd + i]; const bool keep = dir == 0 ? (sidx <= t) : (sidx >= t); v4[i] = keep ? x : 0.f; }
                    *(LAS unsigned long long*)(AMI + t * 144 + (32 * si + 8 * qd + 4 * hh) * 2) = (unsigned long long)pk2(v4[0], v4[1]) | ((unsigned long long)pk2(v4[2], v4[3]) << 32); }
            } else {
                const int w4 = w - 4;
#pragma unroll
                for (int q = 0; q < 4; ++q) { const int bq = w4 * 4 + q, tt = bq >> 3, ks = bq & 7, j = ks >> 1, u = ks & 1; const int t = 32 * tt + r32;
                    const unsigned long long p0 = *(const LAS unsigned long long*)(IMGQ + t * 272 + (32 * j + 16 * u + 4 * hh) * 2), p1 = *(const LAS unsigned long long*)(IMGQ + t * 272 + (32 * j + 16 * u + 8 + 4 * hh) * 2);
                    *(GAS v4u*)(ws + WS_GT_QD + idir * 16384 + bq * 1024 + lane * 16) = (v4u){(unsigned)p0, (unsigned)(p0 >> 32), (unsigned)p1, (unsigned)(p1 >> 32)}; }
#pragma unroll
                for (int q = 0; q < 4; ++q) { const int bk = w4 * 4 + q, j = bk >> 2, ks = bk & 3; const int d = 32 * j + r32;
                    *(GAS v4u*)(ws + WS_GT_KE + idir * 16384 + bk * 1024 + lane * 16) = *(const LAS v4u*)(IMGE + d * 144 + (16 * ks + 8 * hh) * 2); }
            }
            __syncthreads();
            { const int tt = w >> 2, ks = w & 3; const int t = 32 * tt + r32;
              *(GAS v4u*)((unsigned char*)a.out + OUT_GT_AM + idir * 8192 + w * 1024 + lane * 16) = *(const LAS v4u*)(AMI + t * 144 + (16 * ks + 8 * hh) * 2); }
            __syncthreads();
        }
    }
#undef PREP_LOAD
#undef PREP_STORE
}

__device__ __forceinline__ void gla_seq_phase(Frame& F, const Args& a) {
    unsigned char* ws = a.ws;
    const int w = F.wave;
    constexpr int GBUF = 57856;
    const int bx_ = (int)blockIdx.x;
    const int su_ = (F.G % 8 == 0 && F.G >= 64) ? (((bx_ >> 3) < 8) ? (bx_ & 7) * 8 + (bx_ >> 3) : 64) : bx_;
    for (int unit = su_; unit < 64; unit += F.G) {
        const int dir = unit & 1, eh = (unit >> 1) & 1, bh = unit >> 2, b = bh >> 2, h = bh & 3;
        if (w >= 4) {
            const int lt = opaque_v((F.wave * 64 + lane_id())) - 256;
            v4u A[15], B[15];
#define GLA_LOAD(R, NS) do { const int n_ = dir ? 63 - (NS) : (NS); const size_t idir_ = (size_t)((bh * 2 + dir) * 64 + n_), iv_ = (size_t)(bh * 64 + n_); const unsigned char* o_ = opaque((const unsigned char*)a.out); const unsigned char* w_ = opaque(ws); \
            const GAS v4u* gq_ = (const GAS v4u*)(w_ + WS_GT_QD + idir_ * 16384); const GAS v4u* gk_ = (const GAS v4u*)(w_ + WS_GT_KE + idir_ * 16384); const GAS v4u* ga_ = (const GAS v4u*)(o_ + OUT_GT_AM + idir_ * 8192); \
            const GAS v4u* gv_ = (const GAS v4u*)(o_ + OUT_GT_VT + iv_ * 32768 + eh * 16384); const GAS v4u* gd_ = (const GAS v4u*)(o_ + OUT_GT_DEC + idir_ * 512); \
            _Pragma("unroll") for (int i = 0; i < 4; ++i) { R[i] = gq_[lt + 256 * i]; R[4 + i] = gk_[lt + 256 * i]; R[10 + i] = gv_[lt + 256 * i]; } R[8] = ga_[lt]; R[9] = ga_[lt + 256]; R[14] = gd_[lt & 31]; } while (0)
#define GLA_WRITE(R, BUF) do { LAS v4u* d_ = (LAS v4u*)(F.lds + (BUF) * GBUF); \
            _Pragma("unroll") for (int i = 0; i < 4; ++i) { d_[lt + 256 * i] = R[i]; d_[1024 + lt + 256 * i] = R[4 + i]; d_[2560 + lt + 256 * i] = R[10 + i]; } d_[2048 + lt] = R[8]; d_[2048 + lt + 256] = R[9]; if (lt < 32) d_[3584 + lt] = R[14]; } while (0)
            GLA_LOAD(A, 0); GLA_LOAD(B, 1);
            GLA_WRITE(A, 0);
            __syncthreads();
#pragma unroll 1
            for (int ns = 0; ns < 64; ns += 2) {
                if (ns + 2 < 64) GLA_LOAD(A, ns + 2);
                GLA_WRITE(B, 1);
                __syncthreads();
                if (ns + 3 < 64) GLA_LOAD(B, ns + 3);
                if (ns + 2 < 64) GLA_WRITE(A, 0);
                __syncthreads();
            }
#undef GLA_LOAD
#undef GLA_WRITE
        } else {
            f32x16 S[4];
#pragma unroll
            for (int j = 0; j < 4; ++j) S[j] = (f32x16){0.f, 0.f, 0.f, 0.f, 0.f, 0.f, 0.f, 0.f, 0.f, 0.f, 0.f, 0.f, 0.f, 0.f, 0.f, 0.f};
            __syncthreads();
#pragma unroll 1
            for (int ns = 0; ns < 64; ++ns) {
                const int n = dir ? 63 - ns : ns;
                const int lane = opaque_v(lane_id()), r32 = lane & 31, hh = lane >> 5;
                LAS unsigned char* QDl = F.lds + (ns & 1) * GBUF; LAS unsigned char* KEl = QDl + 16384; LAS unsigned char* AMl = QDl + 32768; LAS unsigned char* VTl = QDl + 40960; LAS float* DECl = (LAS float*)(QDl + 57344);
                GAS bf16* Out = (GAS bf16*)(opaque(ws) + (dir ? WS_OB : WS_OF));
                bf16x8 vf[4];
#pragma unroll
                for (int ks = 0; ks < 4; ++ks) vf[ks] = *(const LAS bf16x8*)(VTl + (w * 4 + ks) * 1024 + lane * 16);
                f32x16 o[2];
#pragma unroll
                for (int tt = 0; tt < 2; ++tt) o[tt] = (f32x16){0.f, 0.f, 0.f, 0.f, 0.f, 0.f, 0.f, 0.f, 0.f, 0.f, 0.f, 0.f, 0.f, 0.f, 0.f, 0.f};
#pragma unroll
                for (int ks8 = 0; ks8 < 8; ++ks8) { const int j = ks8 >> 1, u = ks8 & 1; v4u sb;
                    sb.x = pg8::cvt_pk_bf16(S[j][8 * u + 0], S[j][8 * u + 1]); sb.y = pg8::cvt_pk_bf16(S[j][8 * u + 2], S[j][8 * u + 3]); sb.z = pg8::cvt_pk_bf16(S[j][8 * u + 4], S[j][8 * u + 5]); sb.w = pg8::cvt_pk_bf16(S[j][8 * u + 6], S[j][8 * u + 7]);
                    const bf16x8 bs = __builtin_bit_cast(bf16x8, sb);
#pragma unroll
                    for (int tt = 0; tt < 2; ++tt) { const bf16x8 aq = *(const LAS bf16x8*)(QDl + (tt * 8 + ks8) * 1024 + lane * 16); o[tt] = __builtin_amdgcn_mfma_f32_32x32x16_bf16(aq, bs, o[tt], 0, 0, 0); } }
#pragma unroll
                for (int ks = 0; ks < 4; ++ks)
#pragma unroll
                    for (int tt = 0; tt < 2; ++tt) { const bf16x8 am = *(const LAS bf16x8*)(AMl + (tt * 4 + ks) * 1024 + lane * 16); o[tt] = __builtin_amdgcn_mfma_f32_32x32x16_bf16(am, vf[ks], o[tt], 0, 0, 0); }
#pragma unroll
                for (int tt = 0; tt < 2; ++tt)
#pragma unroll
                    for (int r = 0; r < 16; ++r) { const int t = 32 * tt + (r & 3) + 8 * (r >> 2) + 4 * hh; const float x = o[tt][r];
                        Out[((size_t)b * SEQ + 64 * n + t) * 1024 + h * 256 + 32 * (eh * 4 + w) + r32] = (bf16)pk2(x, 0.f); }
#pragma unroll
                for (int j = 0; j < 4; ++j) {
#pragma unroll
                    for (int q = 0; q < 4; ++q) { const f32x4 dv = *(const LAS f32x4*)(DECl + 32 * j + 8 * q + 4 * hh); S[j][4 * q + 0] *= dv.x; S[j][4 * q + 1] *= dv.y; S[j][4 * q + 2] *= dv.z; S[j][4 * q + 3] *= dv.w; }
#pragma unroll
                    for (int ks = 0; ks < 4; ++ks) { const bf16x8 ak = *(const LAS bf16x8*)(KEl + (j * 4 + ks) * 1024 + lane * 16); S[j] = __builtin_amdgcn_mfma_f32_32x32x16_bf16(ak, vf[ks], S[j], 0, 0, 0); } }
                __syncthreads();
            }
        }
    }
}

typedef short v4i16_t __attribute__((ext_vector_type(4)));
__device__ __forceinline__ void attn_phase(Frame& F, const Args& a, int qslot) {
    unsigned char* ws = a.ws; const bf16* PROJ;
    const int w = F.wave;
    volatile LAS int* uword = (volatile LAS int*)(F.lds + 2 * 78336);
    constexpr int NUNITS = 64 * 3 * 32;
#define ATT_DECODE(U) const int bh = (U) / 96, rem = (U) - bh * 96, p = rem >> 5, idx = rem & 31; const int lgd = 2 * p, d = 1 << lgd; \
        const int r = idx >> (5 - lgd), J = idx & ((32 >> lgd) - 1), Lc = SEQ >> lgd; const int b = bh >> 4, h = bh & 15; const int m0 = 128 * J - 64;
    v4u kx[4], vx[4]; v4u qw[2];
#define ATT_LOAD(U) do { ATT_DECODE(U) ws = opaque(ws); PROJ = (const bf16*)(ws + WS_PROJ); const int tid_ = opaque_v((F.wave * 64 + lane_id())); \
        _Pragma("unroll") for (int i = 0; i < 4; ++i) { const int kr = (tid_ >> 3) + 64 * i, ch = tid_ & 7; const int mp = m0 + kr; kx[i] = (v4u){0u, 0u, 0u, 0u}; vx[i] = kx[i]; \
            if (mp >= 0 && mp < Lc) { const bf16* src = PROJ + ((size_t)b * SEQ + r + d * mp) * NINP + O_AK + h * 64 + ch * 8; kx[i] = *(const GAS v4u*)src; vx[i] = *(const GAS v4u*)(src + (O_AV - O_AK)); } } \
        const int tokq_ = r + d * (128 * J + 16 * w + (tid_ & 15)); \
        _Pragma("unroll") for (int sft = 0; sft < 2; ++sft) qw[sft] = *(const GAS v4u*)(PROJ + ((size_t)b * SEQ + tokq_) * NINP + O_AQ + h * 64 + 32 * sft + 8 * ((tid_ & 63) >> 4)); } while (0)
    float tab[40];
    { const int l0 = opaque_v(lane_id());
#pragma unroll
      for (int c = 0; c < 40; ++c) { const int kb = c >> 3, uu = (c >> 2) & 1, rho = c & 3; const int jo = 32 * kb + 8 * (l0 >> 4) + 4 * uu + rho - 64 - (l0 & 15); const int aj = jo < 0 ? -jo : jo; tab[c] = aj <= 64 ? (float)aj : 3.0e38f; } }
#define ATT_FETCH(DST) do { int v_ = NUNITS; int qx_ = uword[2], qt_ = uword[3]; while (qt_ < 8) { const int t_ = (int)__hip_atomic_fetch_add((unsigned*)(F.ctl + CW_ATTQX + 128 * qslot + 16 * qx_), 1u, __ATOMIC_RELAXED, __HIP_MEMORY_SCOPE_AGENT); \
        if (t_ < 768) { v_ = qx_ * 768 + t_; break; } qx_ = (qx_ + 1) & 7; ++qt_; } uword[2] = qx_; uword[3] = qt_; DST = v_; } while (0)
    if ((F.wave * 64 + lane_id()) == 0) { uword[2] = (int)blockIdx.x & 7; uword[3] = 0; int f0, f1; ATT_FETCH(f0); ATT_FETCH(f1); uword[0] = f0; uword[1] = f1; }
    __syncthreads();
    int u = __builtin_amdgcn_readfirstlane(uword[0]), un = __builtin_amdgcn_readfirstlane(uword[1]); int par = 0;
#define ATT_WRITE(BUF) do { const int tid_ = opaque_v((F.wave * 64 + lane_id())); LAS unsigned char* Kw = F.lds + (BUF) * 78336; LAS unsigned char* Vw = Kw + 39168; \
        _Pragma("unroll") for (int i = 0; i < 4; ++i) { const int kr = (tid_ >> 3) + 64 * i, ch = tid_ & 7; *(LAS v4u*)(Kw + kr * 144 + ch * 16) = kx[i]; *(LAS v4u*)(Vw + kr * 144 + ch * 16) = vx[i]; } \
        if (tid_ < 128) { const int kr = 256 + (tid_ >> 3), ch = tid_ & 7; *(LAS v4u*)(Kw + kr * 144 + ch * 16) = (v4u){0u, 0u, 0u, 0u}; *(LAS v4u*)(Vw + kr * 144 + ch * 16) = (v4u){0u, 0u, 0u, 0u}; } } while (0)
    v4u qwc[2];
    if (u < NUNITS) { ATT_LOAD(u); ATT_WRITE(0); qwc[0] = qw[0]; qwc[1] = qw[1]; }
    __syncthreads();
    int bufi = 0;
    while (u < NUNITS) {
        const int tid = opaque_v((F.wave * 64 + lane_id())), lane = tid & 63, q16 = lane & 15, g = lane >> 4;
        int qnext = 0; if (tid == 0) ATT_FETCH(qnext);
        LAS unsigned char* Kl = F.lds + bufi * 78336; LAS unsigned char* Vl = Kl + 39168;
        bf16x8 qf[2];
#pragma unroll
        for (int sft = 0; sft < 2; ++sft) { v4u qs; constexpr float QS = 0.125f * 1.4426950408889634f; qs.x = pk2(bflo(qwc[sft].x) * QS, bfhi(qwc[sft].x) * QS); qs.y = pk2(bflo(qwc[sft].y) * QS, bfhi(qwc[sft].y) * QS); qs.z = pk2(bflo(qwc[sft].z) * QS, bfhi(qwc[sft].z) * QS); qs.w = pk2(bflo(qwc[sft].w) * QS, bfhi(qwc[sft].w) * QS);
            qf[sft] = __builtin_bit_cast(bf16x8, qs); }
        ATT_DECODE(u)
        const int tokq = r + d * (128 * J + 16 * w + q16);
        if (un < NUNITS) ATT_LOAD(un);
        const float nslope = -exp2f(-0.5f * (float)(h + 1)) * (float)d * 1.4426950408889634f;
        const bool inrange = (m0 + 16 * w >= 0) && (m0 + 16 * w + 159 < Lc);
        float sv[5][2][4]; float mx = -3.0e38f;
#pragma unroll
        for (int kb = 0; kb < 5; ++kb)
#pragma unroll
            for (int uu = 0; uu < 2; ++uu) { f32x4 acc = (f32x4){0.f, 0.f, 0.f, 0.f};
                const int krow = 16 * w + 32 * kb + 8 * (q16 >> 2) + 4 * uu + (q16 & 3);
#pragma unroll
                for (int sft = 0; sft < 2; ++sft) { const bf16x8 ak = *(const LAS bf16x8*)(Kl + krow * 144 + (32 * sft + 8 * g) * 2); acc = __builtin_amdgcn_mfma_f32_16x16x32_bf16(ak, qf[sft], acc, 0, 0, 0); }
#pragma unroll
                for (int rho = 0; rho < 4; ++rho) { const float x = acc[rho]; sv[kb][uu][rho] = __builtin_fmaf(nslope, tab[kb * 8 + uu * 4 + rho], x); } }
        if (!inrange) {
#pragma unroll
            for (int kb = 0; kb < 5; ++kb)
#pragma unroll
                for (int uu = 0; uu < 2; ++uu)
#pragma unroll
                    for (int rho = 0; rho < 4; ++rho) { const int mp = m0 + 16 * w + 32 * kb + 8 * g + 4 * uu + rho; if (mp < 0 || mp >= Lc) sv[kb][uu][rho] = -3.0e38f; } }
#pragma unroll
        for (int kb = 0; kb < 5; ++kb)
#pragma unroll
            for (int uu = 0; uu < 2; ++uu)
#pragma unroll
                for (int rho = 0; rho < 4; ++rho) mx = fmaxf(mx, sv[kb][uu][rho]);
        mx = xrow_max(mx);
        float lsum = 0.f; bf16x8 pf[5];
#pragma unroll
        for (int kb = 0; kb < 5; ++kb) { float e[8];
#pragma unroll
            for (int uu = 0; uu < 2; ++uu)
#pragma unroll
                for (int rho = 0; rho < 4; ++rho) { const float pe = __builtin_amdgcn_exp2f(sv[kb][uu][rho] - mx); e[uu * 4 + rho] = pe; lsum += pe; }
            v4u pw; pw.x = pk2(e[0], e[1]); pw.y = pk2(e[2], e[3]); pw.z = pk2(e[4], e[5]); pw.w = pk2(e[6], e[7]); pf[kb] = __builtin_bit_cast(bf16x8, pw); }
        lsum = xrow_sum(lsum);
        f32x4 oT[4];
#pragma unroll
        for (int nn = 0; nn < 4; ++nn) oT[nn] = (f32x4){0.f, 0.f, 0.f, 0.f};
#pragma unroll
        for (int kb = 0; kb < 5; ++kb)
#pragma unroll
            for (int nn = 0; nn < 4; ++nn) { const LAS unsigned char* va = Vl + (16 * w + 32 * kb + 8 * g + (q16 >> 2)) * 144 + (16 * nn + 4 * (q16 & 3)) * 2;
                const v4i16_t lo = __builtin_amdgcn_ds_read_tr16_b64_v4i16((LAS v4i16_t*)va), hi = __builtin_amdgcn_ds_read_tr16_b64_v4i16((LAS v4i16_t*)(va + 4 * 144));
                const bf16x8 vf = (bf16x8){lo[0], lo[1], lo[2], lo[3], hi[0], hi[1], hi[2], hi[3]};
                oT[nn] = __builtin_amdgcn_mfma_f32_16x16x32_bf16(vf, pf[kb], oT[nn], 0, 0, 0); }
        { const size_t rec = ((size_t)p * M + (size_t)b * SEQ + tokq) * 16 + h; GAS bf16* op = (GAS bf16*)(opaque(ws) + WS_ATTP) + rec * 64 + 4 * g;
#pragma unroll
          for (int nn = 0; nn < 4; ++nn) *(GAS unsigned long long*)(op + 16 * nn) = (unsigned long long)pk2(oT[nn][0], oT[nn][1]) | ((unsigned long long)pk2(oT[nn][2], oT[nn][3]) << 32);
          if (g == 0) { GAS float* ml = (GAS float*)(opaque(ws) + WS_ATTML) + rec * 2; ml[0] = mx * 0.6931471805599453f; ml[1] = lsum; } }
        if (un < NUNITS) { ATT_WRITE(bufi ^ 1); qwc[0] = qw[0]; qwc[1] = qw[1]; }
        if (tid == 0) uword[par] = qnext;
        __syncthreads();
        u = un; un = __builtin_amdgcn_readfirstlane(uword[par]); par ^= 1; bufi ^= 1;
    }
#undef ATT_WRITE
#undef ATT_DECODE
#undef ATT_LOAD
#undef ATT_FETCH
}

typedef __bf16 bf16x2_t __attribute__((ext_vector_type(2)));
__device__ __forceinline__ void peer_convert_tables(Frame& F, const Args& a, int qslot) {
    unsigned char* ws = a.ws; const int lane = lane_id(); volatile LAS int* uword = (volatile LAS int*)(F.lds + 2 * 78336 + 64);
    for (;;) {
        __syncthreads();
        if ((F.wave * 64 + lane_id()) == 0) uword[0] = (int)__hip_atomic_fetch_add((unsigned*)(F.ctl + CW_CONVQ + 64 * qslot), 1u, __ATOMIC_RELAXED, __HIP_MEMORY_SCOPE_AGENT);
        __syncthreads();
        const int blk = __builtin_amdgcn_readfirstlane(uword[0]);
        if (blk >= 2 * PEER_E / 128) break;
        const int rbase = blk * 128 + F.wave * 16; const bool isv = rbase >= PEER_E; const int e0 = rbase & (PEER_E - 1);
        const GAS float* src = (const GAS float*)(isv ? a.in[14] : a.in[13]) + (size_t)e0 * DM + 4 * lane;
        GAS unsigned char* dst = (GAS unsigned char*)a.out + (isv ? OUT_V8 : OUT_U8) + (size_t)e0 * 256 + 4 * lane;     GAS float* sc = (GAS float*)(ws + (isv ? WS_SV : WS_SU)) + e0;
        f32x4 v[8], vn[8];
#pragma unroll
        for (int j = 0; j < 8; ++j) v[j] = *(const GAS f32x4*)(src + 256 * j);
#pragma unroll 1
        for (int i = 0; i < 16; ++i) { const int in_ = i + 1 < 16 ? i + 1 : i;
#pragma unroll
            for (int j = 0; j < 8; ++j) vn[j] = *(const GAS f32x4*)(src + (size_t)in_ * DM + 256 * j);
            float am = 0.f;
#pragma unroll
            for (int j = 0; j < 8; ++j) am = fmaxf(am, fmaxf(fmaxf(fabsf(v[j].x), fabsf(v[j].y)), fmaxf(fabsf(v[j].z), fabsf(v[j].w))));
            am = wave_max(am); am = fmaxf(am, 1e-30f);
            const float inv = 440.f / am;
#pragma unroll
            for (int j = 0; j < 8; ++j) { int p = __builtin_amdgcn_cvt_pk_fp8_f32(v[j].x * inv, v[j].y * inv, 0, false); p = __builtin_amdgcn_cvt_pk_fp8_f32(v[j].z * inv, v[j].w * inv, p, true);
                *(GAS int*)(dst + (size_t)i * 256 + (size_t)j * (PEER_E * 256)) = p; }
            if (lane == 0) sc[i] = am * (1.f / 440.f);
#pragma unroll
            for (int j = 0; j < 8; ++j) v[j] = vn[j]; }
    }
}

__device__ __forceinline__ float dpp_row_sum(float x) {
#define PEER_DPP(ctrl) x += __builtin_bit_cast(float, __builtin_amdgcn_update_dpp(0, __builtin_bit_cast(int, x), ctrl, 0xF, 0xF, false))
    PEER_DPP(0xB1); PEER_DPP(0x4E); PEER_DPP(0x141); PEER_DPP(0x140);
#undef PEER_DPP
    return x;
}
template <bool VPH, int PBS, bool LA> __device__ __forceinline__ void peer_uv_phase(Frame& F, const Args& a) {
    unsigned char* ws = a.ws; GAS bf16* H = (GAS bf16*)(ws + WS_HB); const GAS float* g2 = (const GAS float*)a.in[10];
    const int sl = blockIdx.x & 7, rk = blockIdx.x >> 3, nrk = F.G >> 3, tpw = M / nrk / NWAVES, nq = tpw / 4;
    const unsigned char* TAB; const GAS int* EIDX; const GAS float* SSQ; const GAS float* PW; GAS float* PD; GAS float* SSQ2;
    LAS int* idt = (LAS int*)(F.lds + F.wave * 8704);
    LAS float* wt = (LAS float*)(F.lds + F.wave * 8704 + 4352);
    const int t0 = (rk * NWAVES + F.wave) * tpw;
#define PEER_STAGE_LOAD(QI) do { const size_t tb_ = (size_t)(t0 + 4 * (QI) + a4) * 64; _Pragma("unroll") for (int k = 0; k < 4; ++k) sid[k] = EIDX[tb_ + 16 * k + q]; } while (0)
#define PEER_STAGE_WRITE(QI) do { const int bf_ = ((QI) & 1) * 528; _Pragma("unroll") for (int k = 0; k < 4; ++k) *(LAS i32x2*)(idt + bf_ + a4 * 132 + 32 * k + 2 * q) = (i32x2){sid[k] & 0xffff, (int)((unsigned)sid[k] >> 16)}; } while (0)
#define PEER_STAGE_W(QI) do { if (VPH) { const size_t tb_ = (size_t)(t0 + 4 * (QI) + a4) * 128; const int bf_ = ((QI) & 1) * 528; _Pragma("unroll") for (int k = 0; k < 8; ++k) wt[bf_ + a4 * 132 + 16 * k + q] = PW[tb_ + 16 * k + q]; LDS_WAIT(); asm volatile("" ::: "memory"); } } while (0)
#define PEER_ISSUE(R, QI, WB) do { const int bf_ = ((QI) & 1) * 528 + a4 * 132 + (WB) * PBS; i32x4 e4_; _Pragma("unroll") for (int j = 0; j < PBS; ++j) { if ((j & 3) == 0) e4_ = *(const LAS i32x4*)(idt + bf_ + j); const int e_ = (j & 3) == 0 ? e4_.x : (j & 3) == 1 ? e4_.y : (j & 3) == 2 ? e4_.z : e4_.w; R[j] = ldu<i32x4>(TAB, (unsigned)e_ * 256u + (unsigned)(16 * q)); } } while (0)
    unsigned xq[8]; float acc[16];
#define PEER_QUAD_BEGIN(QI) do { const size_t t_ = (size_t)(t0 + 4 * (QI) + a4); \
        if (!VPH) { f32x4 hq[4]; { const v4u h0_ = *(const GAS v4u*)(H + t_ * DM + 256 * sl + 16 * q), h1_ = *(const GAS v4u*)(H + t_ * DM + 256 * sl + 16 * q + 8); \
            hq[0] = (f32x4){bflo(h0_.x), bfhi(h0_.x), bflo(h0_.y), bfhi(h0_.y)}; hq[1] = (f32x4){bflo(h0_.z), bfhi(h0_.z), bflo(h0_.w), bfhi(h0_.w)}; hq[2] = (f32x4){bflo(h1_.x), bfhi(h1_.x), bflo(h1_.y), bfhi(h1_.y)}; hq[3] = (f32x4){bflo(h1_.z), bfhi(h1_.z), bflo(h1_.w), bfhi(h1_.w)}; }  const float pss_ = dpp_row_sum(SSQ[t_ * 32 + q] + SSQ[t_ * 32 + 16 + q]); const float rstd_ = 1.f / sqrtf(pss_ * (1.f / DM) + EPS); f32x4 gv[4]; \
            _Pragma("unroll") for (int k = 0; k < 4; ++k) gv[k] = *(const GAS f32x4*)(g2 + 256 * sl + 16 * q + 4 * k); \
            _Pragma("unroll") for (int k = 0; k < 4; ++k) { xq[2 * k] = pk2(hq[k].x * rstd_ * gv[k].x, hq[k].y * rstd_ * gv[k].y); xq[2 * k + 1] = pk2(hq[k].z * rstd_ * gv[k].z, hq[k].w * rstd_ * gv[k].w); } } \
        else { _Pragma("unroll") for (int k = 0; k < 16; ++k) acc[k] = 0.f; } } while (0)
#define PEER_COMPUTE(R, QI, WB) do { if (!VPH) { float pdb_ = 0.f; _Pragma("unroll") for (int j = 0; j < PBS; ++j) { float d_ = 0.f; _Pragma("unroll") for (int k = 0; k < 4; ++k) { const int dw_ = R[j][k]; \
                d_ = __builtin_amdgcn_fdot2_f32_bf16(__builtin_amdgcn_cvt_scalef32_pk_bf16_fp8(dw_, 1.0f, false), __builtin_bit_cast(bf16x2_t, xq[2 * k]), d_, false); \
                d_ = __builtin_amdgcn_fdot2_f32_bf16(__builtin_amdgcn_cvt_scalef32_pk_bf16_fp8(dw_, 1.0f, true), __builtin_bit_cast(bf16x2_t, xq[2 * k + 1]), d_, false); } \
                d_ = dpp_row_sum(d_); pdb_ = (q == j) ? d_ : pdb_; } \
            if (q < PBS) PD[((size_t)(t0 + 4 * (QI) + a4) * 8 + sl) * 128 + PBS * (WB) + q] = pdb_; } \
        else { const int bf_ = ((QI) & 1) * 528 + a4 * 132 + (WB) * PBS; f32x4 w4_; _Pragma("unroll") for (int j = 0; j < PBS; ++j) { if ((j & 3) == 0) w4_ = *(const LAS f32x4*)(wt + bf_ + j); const float w_ = (j & 3) == 0 ? w4_.x : (j & 3) == 1 ? w4_.y : (j & 3) == 2 ? w4_.z : w4_.w; int r0_ = R[j][0], r1_ = R[j][1], r2_ = R[j][2], r3_ = R[j][3]; asm volatile("" : "+v"(r0_), "+v"(r1_), "+v"(r2_), "+v"(r3_));     \
                _Pragma("unroll") for (int k = 0; k < 4; ++k) { const int dw_ = k == 0 ? r0_ : k == 1 ? r1_ : k == 2 ? r2_ : r3_; \
                const f32x2 lo_ = __builtin_amdgcn_cvt_pk_f32_fp8(dw_, false), hi_ = __builtin_amdgcn_cvt_pk_f32_fp8(dw_, true); \
                acc[4 * k + 0] += w_ * lo_.x; acc[4 * k + 1] += w_ * lo_.y; acc[4 * k + 2] += w_ * hi_.x; acc[4 * k + 3] += w_ * hi_.y; } } } } while (0)
#define PEER_QUAD_END(QI) do { if (VPH) { const size_t t_ = (size_t)(t0 + 4 * (QI) + a4); GAS bf16* hp_ = H + t_ * DM + 256 * sl + 16 * q; const v4u h0_ = *(const GAS v4u*)hp_, h1_ = *(const GAS v4u*)(hp_ + 8); \
            float y_[16]; y_[0] = bflo(h0_.x); y_[1] = bfhi(h0_.x); y_[2] = bflo(h0_.y); y_[3] = bfhi(h0_.y); y_[4] = bflo(h0_.z); y_[5] = bfhi(h0_.z); y_[6] = bflo(h0_.w); y_[7] = bfhi(h0_.w); \
            y_[8] = bflo(h1_.x); y_[9] = bfhi(h1_.x); y_[10] = bflo(h1_.y); y_[11] = bfhi(h1_.y); y_[12] = bflo(h1_.z); y_[13] = bfhi(h1_.z); y_[14] = bflo(h1_.w); y_[15] = bfhi(h1_.w); \
            float ss_ = 0.f; _Pragma("unroll") for (int k = 0; k < 16; ++k) { y_[k] += acc[k]; ss_ += y_[k] * y_[k]; } \
            *(GAS v4u*)hp_ = (v4u){pk2(y_[0], y_[1]), pk2(y_[2], y_[3]), pk2(y_[4], y_[5]), pk2(y_[6], y_[7])}; *(GAS v4u*)(hp_ + 8) = (v4u){pk2(y_[8], y_[9]), pk2(y_[10], y_[11]), pk2(y_[12], y_[13]), pk2(y_[14], y_[15])}; \
            ss_ = dpp_row_sum(ss_); if (q == 0) SSQ2[t_ * 8 + sl] = ss_; } } while (0)
#pragma unroll 1
    for (int qi = 0; qi < nq; ++qi) {
        i32x4 rA[PBS], rB[PBS];
        const int lane = opaque_v(lane_id()), a4 = lane >> 4, q = lane & 15; ws = opaque(ws); H = (GAS bf16*)(ws + WS_HB);
        TAB = opaque((const unsigned char*)a.out) + (VPH ? OUT_V8 : OUT_U8) + (size_t)sl * (PEER_E * 256); EIDX = (const GAS int*)(ws + WS_EIDX16); SSQ = (const GAS float*)(ws + WS_SSQ); PW = (const GAS float*)(ws + WS_PW); PD = (GAS float*)(ws + WS_PD); SSQ2 = (GAS float*)(ws + WS_SSQ2);
        int sid[4];
        if (!LA || qi == 0) { PEER_STAGE_LOAD(qi); PEER_STAGE_WRITE(qi); LDS_WAIT(); asm volatile("" ::: "memory"); }
        PEER_ISSUE(rA, qi, 0);
        PEER_ISSUE(rB, qi, 1);
        if (LA && qi + 1 < nq) PEER_STAGE_LOAD(qi + 1);
        PEER_STAGE_W(qi);
        PEER_QUAD_BEGIN(qi);
#pragma unroll
        for (int wb = 0; wb < 128 / PBS; wb += 2) {
            PEER_COMPUTE(rA, qi, wb); if (wb + 2 < 128 / PBS) { PEER_ISSUE(rA, qi, wb + 2); }
            PEER_COMPUTE(rB, qi, wb + 1); if (wb + 3 < 128 / PBS) { PEER_ISSUE(rB, qi, wb + 3); }
        }
        PEER_QUAD_END(qi);
        if (LA && qi + 1 < nq) { PEER_STAGE_WRITE(qi + 1); LDS_WAIT(); asm volatile("" ::: "memory"); }
    }
#undef PEER_STAGE_LOAD
#undef PEER_STAGE_WRITE
#undef PEER_STAGE_W
#undef PEER_ISSUE
#undef PEER_QUAD_BEGIN
#undef PEER_COMPUTE
#undef PEER_QUAD_END
}
__device__ __forceinline__ void peer_w_phase(Frame& F, const Args& a) {
    unsigned char* ws = a.ws; const float* PD = (const float*)(ws + WS_PD); const int* EIDX = (const int*)(ws + WS_EIDX); const float* GATE = (const float*)(ws + WS_GATE);
    const float* SU = (const float*)(ws + WS_SU); const float* SV = (const float*)(ws + WS_SV); float* PW = (float*)(ws + WS_PW);
    for (int i = F.vcu * 512 + (F.wave * 64 + lane_id()); i < M * 128; i += F.G * 512) { const int t = i >> 7, p = i & 127; float d = 0.f;
#pragma unroll
        for (int sl = 0; sl < 8; ++sl) d += PD[((size_t)t * 8 + sl) * 128 + p];
        const int e = EIDX[i]; d *= SU[e];
        PW[i] = GATE[i] * 0.5f * d * (1.f + erff(d * 0.70710678118654752f)) * SV[e]; }
}
__device__ __forceinline__ void peer_n_phase(Frame& F, const Args& a) {
    unsigned char* ws = a.ws; const GAS bf16* Y = (const GAS bf16*)(ws + WS_HB); GAS float* O = (GAS float*)a.out; const GAS float* gf = (const GAS float*)a.in[15]; const GAS float* SSQ2 = (const GAS float*)(ws + WS_SSQ2); const int lane = lane_id();
    f32x4 g0[4], g1[4];
#pragma unroll
    for (int j = 0; j < 4; ++j) { g0[j] = *(const GAS f32x4*)(gf + 512 * j + 8 * lane); g1[j] = *(const GAS f32x4*)(gf + 512 * j + 8 * lane + 4); }
    const int gw = F.vcu * NWAVES + F.wave, NGW = F.G * NWAVES;
    v4u yw[4], yn[4]; f32x4 s0, s1, n0, n1;
    if (gw < M) {
#pragma unroll
        for (int j = 0; j < 4; ++j) yw[j] = *(const GAS v4u*)(Y + (size_t)gw * DM + 512 * j + 8 * lane);
        s0 = *(const GAS f32x4*)(SSQ2 + (size_t)gw * 8); s1 = *(const GAS f32x4*)(SSQ2 + (size_t)gw * 8 + 4); }
    for (int m = gw; m < M; m += NGW) { const int mn = m + NGW < M ? m + NGW : m;
#pragma unroll
        for (int j = 0; j < 4; ++j) yn[j] = *(const GAS v4u*)(Y + (size_t)mn * DM + 512 * j + 8 * lane);
        n0 = *(const GAS f32x4*)(SSQ2 + (size_t)mn * 8); n1 = *(const GAS f32x4*)(SSQ2 + (size_t)mn * 8 + 4);
        const float rf = 1.f / sqrtf((((s0.x + s0.y) + (s0.z + s0.w)) + ((s1.x + s1.y) + (s1.z + s1.w))) * (1.f / DM) + EPS);
#pragma unroll
        for (int j = 0; j < 4; ++j) {
            *(GAS f32x4*)(O + (size_t)m * DM + 512 * j + 8 * lane) = (f32x4){bflo(yw[j].x) * rf * g0[j].x, bfhi(yw[j].x) * rf * g0[j].y, bflo(yw[j].y) * rf * g0[j].z, bfhi(yw[j].y) * rf * g0[j].w};
            *(GAS f32x4*)(O + (size_t)m * DM + 512 * j + 8 * lane + 4) = (f32x4){bflo(yw[j].z) * rf * g1[j].x, bfhi(yw[j].z) * rf * g1[j].y, bflo(yw[j].w) * rf * g1[j].z, bfhi(yw[j].w) * rf * g1[j].w}; }
#pragma unroll
        for (int j = 0; j < 4; ++j) yw[j] = yn[j];
        s0 = n0; s1 = n1; }
}

__global__ void __launch_bounds__(NWAVES * 64, 2) mk_fwd(Args args_in) {
    extern __shared__ __attribute__((aligned(16))) unsigned char lds[];
    Args args = args_in;
#pragma unroll
    for (int i = 0; i < 16; ++i) args.in[i] = (const float*)(const GAS float*)args_in.in[i];
    args.out = (float*)(GAS float*)args_in.out; args.ws = (unsigned char*)(GAS unsigned char*)args_in.ws;
    Frame F;
    F.lds = (LAS unsigned char*)lds;
    F.MISC = (volatile LAS unsigned*)(F.lds + MISC_OFF);
    F.wave = __builtin_amdgcn_readfirstlane((int)threadIdx.x >> 6);
    F.G = gridDim.x; { const int bx = blockIdx.x; F.vcu = (F.G % 8 == 0) ? (bx % 8) * (F.G / 8) + bx / 8 : bx; }
    unsigned char* ws = args.ws;
    F.ctl = (gu32*)(ws + WS_CTL);
    for (int u = (F.wave * 64 + lane_id()); u < (LDS_BYTES - LDSCTL_OFF) / 4; u += NWAVES * 64) ((LAS unsigned*)(F.lds + LDSCTL_OFF))[u] = 0u;
    __syncthreads();
    XcdBarrier bar = xcd_barrier_post((unsigned*)(F.ctl + CW_BAR) + args.li * XCD_BAR_WORDS, F.MISC + 8);
    const int lo = args.ph_lo, hi = args.ph_hi;
#define IN(k) (lo <= (k) && (k) < hi)
#define BOTH(k) (IN(k) && IN((k) + 1))
#define GRID_BAR() xcd_barrier(bar)

    if (IN(0)) { for (int rep = 0; rep < NREP(0); ++rep) p0_prologue(F, args); if (BOTH(0)) GRID_BAR(); }

    if (IN(1)) {
        pg8::Gemm g{(const bf16*)(ws + WS_XN), (const bf16*)(ws + WS_WIN), M, NINP, DM}; pg8::StaticOrder S; S.init(M, NINP, F.G, (int)blockIdx.x);
        pg8::EpiBf16<0> E{(bf16*)(ws + WS_PROJ), NINP, nullptr, 0, 0, 1.f};
        for (int rep = 0; rep < NREP(1); ++rep) pg8::gemm_phase<pg8::EpiBf16<0>, pg8::StaticOrder, PG8_ALIGN, PG8_SP2>(F.lds + RING_OFF, g, S, E);
        for (int rep = 0; rep < NREP(11); ++rep) gd_side_gemm(F, args);
        if (BOTH(1)) GRID_BAR();
    }
    if (IN(2)) {
        for (int rep = 0; rep < NREP(21); ++rep) gla_prep_phase(F, args);
        GRID_BAR();
        for (int rep = 0; rep < NREP(2); ++rep) gla_seq_phase(F, args);
        const bool conv_first = ((int)blockIdx.x >> 3) >= CONV_FIRST_RANK;
        for (int pass = 0; pass < 2; ++pass) {
            if (pass == 1 || conv_first) peer_convert_tables(F, args, 0);
            if (pass == 0) attn_phase(F, args, 0); }
        if (BOTH(2)) GRID_BAR(); }
    if (IN(3)) { for (int rep = 0; rep < NREP(3); ++rep) p3_finalize(F, args); if (BOTH(3)) GRID_BAR(); if (REP_PHASE == 99) { GRID_BAR(); GRID_BAR(); GRID_BAR(); GRID_BAR(); } }
    if (IN(4)) {
        pg8::Gemm g{(const bf16*)(ws + WS_XN), (const bf16*)(ws + WS_WOUT), M, DM, DM}; pg8::StaticOrder S; S.init(M, DM, F.G, (int)blockIdx.x);
        pg8::EpiRes E{args.in[0], (bf16*)(ws + WS_HB), (float*)(ws + WS_SSQ), DM};
        for (int rep = 0; rep < NREP(4); ++rep) pg8::gemm_phase<pg8::EpiRes, pg8::StaticOrder, PG8_ALIGN, PG8_SP2>(F.lds + RING_OFF, g, S, E);
        if (BOTH(4)) GRID_BAR();
    }
    if (IN(5)) {
        pg8::Gemm g{(const bf16*)(ws + WS_HB), (const bf16*)(ws + WS_WQ), M, DM, DM}; pg8::StaticOrder S; S.init(M, DM, F.G, (int)blockIdx.x);
        pg8::EpiBf16<0> E{(bf16*)(ws + WS_XN), DM, nullptr, 0, 0, 1.f};
        for (int rep = 0; rep < NREP(5); ++rep) pg8::gemm_phase<pg8::EpiBf16<0>, pg8::StaticOrder, PG8_ALIGN, PG8_SP2>(F.lds + RING_OFF, g, S, E);
        if (BOTH(5)) GRID_BAR();
    }
    if (IN(6)) { for (int rep = 0; rep < NREP(6); ++rep) topk_phase(F, args); if (BOTH(6)) GRID_BAR(); }
    if (IN(7)) {
        for (int rep = 0; rep < NREP(7); ++rep) peer_uv_phase<false, 16, true>(F, args);
        GRID_BAR();
        peer_w_phase(F, args);
        GRID_BAR();
        if (REP_PHASE != 8) peer_uv_phase<true, 8, true>(F, args);
        GRID_BAR();
        peer_n_phase(F, args);
    }
#undef IN
#undef BOTH
}


extern "C" void kernel_launch(void* const* d_in, const int* in_sizes, int n_in, void* d_out, int out_size, void* d_ws, size_t ws_size, hipStream_t stream) {
    static int grid = 0;
    if (grid == 0) {
        if (n_in != 16 || in_sizes[0] != M * DM || out_size != M * DM || ws_size < WS_END) { fprintf(stderr, "kernel_launch: unexpected shapes: n_in %d in0 %d out %d ws %zu\n", n_in, n_in > 0 ? in_sizes[0] : -1, out_size, ws_size); grid = -1; return; }
        int dev = 0, cus = 0;
        if (hipGetDevice(&dev) != hipSuccess || hipDeviceGetAttribute(&cus, hipDeviceAttributeMultiprocessorCount, dev) != hipSuccess) { grid = -1; return; }
        if (hipFuncSetAttribute((const void*)mk_fwd, hipFuncAttributeMaxDynamicSharedMemorySize, LDS_BYTES) != hipSuccess) { fprintf(stderr, "kernel_launch: hipFuncSetAttribute failed\n"); grid = -1; return; }
        (void)hipGetLastError();
        grid = cus;
    }
    if (grid < 0) return;
    (void)hipMemsetAsync((char*)d_ws + WS_CTL, 0, CTL_ZERO_BYTES, stream);
    Args a{};
    for (int i = 0; i < 16; ++i) a.in[i] = (const float*)d_in[i];
    a.out = (float*)d_out; a.ws = (unsigned char*)d_ws;
    a.ph_lo = 0; a.ph_hi = 8; a.li = 0;
    hipLaunchKernelGGL(mk_fwd, dim3(grid), dim3(NWAVES * 64), LDS_BYTES, stream, a);
}
```

```cpp
#define REP_PHASE -1
#define PG8_ALIGN false
#include <hip/hip_runtime.h>
#include <cstdio>
#include <cstdint>
#include <cmath>
#ifndef REP_PHASE
#define REP_PHASE -1
#endif
#define NREP(k) ((REP_PHASE == (k)) ? 2 : 1)
namespace pg8 {
#define PG8_LAS __attribute__((address_space(3)))
typedef unsigned short bf16_t;
typedef short bf16x8 __attribute__((ext_vector_type(8)));
typedef float f32x4 __attribute__((ext_vector_type(4)));
typedef unsigned u32x4 __attribute__((ext_vector_type(4)));
constexpr int BM = 256, BK = 64, HALF = 128, HTB = HALF * BK * 2  , STAGE_BYTES = 8 * HTB, NXCD = 8, WGM = 8;

__host__ __device__ __forceinline__ int lds_byte(int r, int c) { const int st = (r >> 4) * 2 + (c >> 5), rr = r & 15, cc = c & 31, ob = rr * 64 + cc * 2; return st * 1024 + (ob ^ (((ob >> 9) & 1) << 5)); }
__host__ __device__ __forceinline__ void stage_rc(int b, int& R, int& C) { const int st = b / 1024, sb = b % 1024, swz = sb ^ (((sb >> 9) & 1) << 5); R = (st >> 1) * 16 + swz / 64; C = (st & 1) * 32 + (swz % 64) / 2; }
__host__ __device__ __forceinline__ int perm32(int rho) { const int n = rho >> 4, i = rho & 15; return 8 * (i >> 2) + 4 * n + (i & 3); }

struct Unit { int pm, pn; };
struct Gemm { const bf16_t* A; const bf16_t* Bt; int M, N, K; };

struct StaticOrder {
    int nM, nN, nwg, G, c;
    __host__ __device__ void init(int M, int N, int G_, int c_) { nM = M / BM; nN = N / BM; nwg = nM * nN; G = G_; c = c_; }
    __host__ __device__ bool next(int i, Unit& u) const {
        const long L = (long)i * G + c; if (L >= nwg) return false;
        int wgid = (int)L; { const int q = nwg / NXCD, r = nwg % NXCD, xcd = wgid % NXCD, off = wgid / NXCD; wgid = (xcd < r ? xcd * (q + 1) : r * (q + 1) + (xcd - r) * q) + off; }
        const int nig = WGM * nN, gid = wgid / nig, fm = gid * WGM, gsz = (nM - fm) < WGM ? (nM - fm) : WGM;
        u.pm = fm + ((wgid % nig) % gsz); u.pn = (wgid % nig) / gsz; return true;
    }
    __device__ __forceinline__ void a_ready(const Unit&) const {}
    __device__ __forceinline__ void done(const Unit&) const {}
};

__device__ __forceinline__ unsigned cvt_pk_bf16(float lo, float hi) { unsigned r; asm volatile("v_cvt_pk_bf16_f32 %0, %1, %2" : "=v"(r) : "v"(lo), "v"(hi)); return r; }
typedef float f32x2 __attribute__((ext_vector_type(2)));
__device__ __forceinline__ f32x2 gelu_pk(f32x2 v) {
    const f32x2 av = __builtin_elementwise_abs(v), d = av * 0.2316418882f + 1.0f;
    f32x2 t; t.x = __builtin_amdgcn_rcpf(d.x); t.y = __builtin_amdgcn_rcpf(d.y);
    f32x2 q = t * 0.5307027145f + (-0.7265760135f); q = q * t + 0.7107068705f; q = q * t + (-0.142248368f); q = q * t + 0.127414796f; q = q * t;
    const f32x2 s = (v * v) * (-0.72134752044f);
    f32x2 e; e.x = __builtin_amdgcn_exp2f(s.x); e.y = __builtin_amdgcn_exp2f(s.y);
    const f32x2 m = v * (q * e), r = v - m;
    f32x2 o; o.x = v.x < 0.f ? m.x : r.x; o.y = v.y < 0.f ? m.y : r.y; return o;
}

template <int ACT  > struct EpiBf16 {
    static constexpr bool PERM = true, AFTER_DRAIN = false; static_assert(ACT == 0 || ACT == 1, "EpiBf16: ACT is 0 (none) or 1 (gelu_pk)");
    bf16_t* O; int ldc; const float* bias; int split_cols; size_t split_stride; float scale0;
    __device__ __forceinline__ void operator()(const f32x4 (&acc)[2][2][4][2], const Unit& u, int wr, int wc, int fr, int fq) const {
        const int row0 = u.pm * BM + wr * 64 + fr; int colt = u.pn * BM; bf16_t* base = O;
        float sc = 1.f; if (split_cols) { const int t = colt / split_cols; base += (size_t)t * split_stride; colt -= t * split_cols; if (t == 0) sc = scale0; }
        const int col0 = colt + wc * 32 + 8 * fq, bcol0 = u.pn * BM + wc * 32 + 8 * fq;
        f32x4 bv[2][2];
#pragma unroll
        for (int bj = 0; bj < 2; ++bj)
#pragma unroll
            for (int n = 0; n < 2; ++n) bv[bj][n] = bias ? *(const f32x4*)(bias + bcol0 + bj * HALF + 4 * n) : (f32x4){0.f, 0.f, 0.f, 0.f};
#pragma unroll
        for (int ai = 0; ai < 2; ++ai)
#pragma unroll
            for (int m = 0; m < 4; ++m) { bf16_t* rowp = base + (size_t)(row0 + ai * HALF + m * 16) * ldc + col0;
#pragma unroll
                for (int bj = 0; bj < 2; ++bj) { f32x4 v0 = acc[ai][bj][m][0] + bv[bj][0], v1 = acc[ai][bj][m][1] + bv[bj][1];
                    if (ACT == 1) { f32x2 a = gelu_pk((f32x2){v0[0], v0[1]}), b = gelu_pk((f32x2){v0[2], v0[3]}), c = gelu_pk((f32x2){v1[0], v1[1]}), d = gelu_pk((f32x2){v1[2], v1[3]});
                        v0 = (f32x4){a.x, a.y, b.x, b.y}; v1 = (f32x4){c.x, c.y, d.x, d.y}; }
                    v0 = v0 * sc; v1 = v1 * sc; u32x4 w; w.x = cvt_pk_bf16(v0[0], v0[1]); w.y = cvt_pk_bf16(v0[2], v0[3]); w.z = cvt_pk_bf16(v1[0], v1[1]); w.w = cvt_pk_bf16(v1[2], v1[3]);
                    *(u32x4*)(rowp + bj * HALF) = w; } }
    }
};
template <class Epi, class Sched, bool ALIGN_EPI = false, bool SP2 = false>
__device__ __forceinline__ void gemm_phase(PG8_LAS unsigned char* lds, const Gemm g, const Sched& S, const Epi& E) {
    const int tid = threadIdx.x, wid = __builtin_amdgcn_readfirstlane(tid >> 6), lane = tid & 63, wr = wid >> 2, wc = wid & 3, fr = lane & 15, fq = lane >> 4;
    const int K = g.K, nt = K / BK;
    unsigned voffA[2], voffB[2];
#pragma unroll
    for (int i = 0; i < 2; ++i) { int R, C; stage_rc(tid * 16 + i * 8192, R, C); const int Rb = Epi::PERM ? ((R & ~31) + perm32(R & 31)) : R;
        voffA[i] = (unsigned)(R * K + C) * 2u; voffB[i] = (unsigned)(Rb * K + C) * 2u; }
    const size_t kstep = (size_t)(BK * 2);
    const size_t hstep = (size_t)HALF * K * 2;
    const size_t tstep = 2 * hstep;
    const unsigned ldsw = (unsigned)wid * 1024u;
    const int aoff = lds_byte(wr * 64 + fr, fq * 8), boff = lds_byte(wc * 32 + fr, fq * 8);
#define PG8_SA(b, h) (((b) * 2 + (h)) * HTB)
#define PG8_SB(b, h) ((4 + (b) * 2 + (h)) * HTB)
#define PG8_STAGE(bufoff, gbase, voff) do { _Pragma("unroll") for (int _i = 0; _i < 2; ++_i) \
        __builtin_amdgcn_global_load_lds((const unsigned*)((const char*)(gbase) + (voff)[_i]), (PG8_LAS unsigned*)(lds + (bufoff) + ldsw + _i * 8192), 16, 0, 0); } while (0)
#define PG8_LDA(dst, b, h) do { _Pragma("unroll") for (int m = 0; m < 4; ++m) _Pragma("unroll") for (int k = 0; k < 2; ++k) dst[m][k] = *(const PG8_LAS bf16x8*)(lds + PG8_SA(b, h) + aoff + m * 2048 + k * 1024); } while (0)
#define PG8_LDB(dst, b, h) do { _Pragma("unroll") for (int n = 0; n < 2; ++n) _Pragma("unroll") for (int k = 0; k < 2; ++k) dst[n][k] = *(const PG8_LAS bf16x8*)(lds + PG8_SB(b, h) + boff + n * 2048 + k * 1024); } while (0)
#define PG8_MMA(ai, bj, At, Bt) do { __builtin_amdgcn_s_setprio(1); _Pragma("unroll") for (int m = 0; m < 4; ++m) _Pragma("unroll") for (int n = 0; n < 2; ++n) _Pragma("unroll") for (int k = 0; k < 2; ++k) \
        acc[ai][bj][m][n] = __builtin_amdgcn_mfma_f32_16x16x32_bf16(Bt[n][k], At[m][k], acc[ai][bj][m][n], 0, 0, 0); __builtin_amdgcn_s_setprio(0); } while (0)
#define PG8_WAIT_V(n) asm volatile("s_waitcnt vmcnt(" #n ")" ::: "memory")
#define PG8_WAIT_L(n) asm volatile("s_waitcnt lgkmcnt(" #n ")" ::: "memory")
#define PG8_BAR __builtin_amdgcn_s_barrier()
#define PG8_SCHED __builtin_amdgcn_sched_barrier(0)
    Unit cur, nxt; int ui = 0;
    if (!S.next(0, cur)) return;
    f32x4 acc[2][2][4][2];
#pragma unroll
    for (int a = 0; a < 2; ++a)
#pragma unroll
        for (int b = 0; b < 2; ++b)
#pragma unroll
            for (int m = 0; m < 4; ++m)
#pragma unroll
                for (int n = 0; n < 2; ++n) acc[a][b][m][n] = (f32x4){0.f, 0.f, 0.f, 0.f};
    bf16x8 At[4][2], B0[2][2], B1[2][2];
    const char* cA = (const char*)g.A + (size_t)cur.pm * tstep; const char* cB = (const char*)g.Bt + (size_t)cur.pn * tstep;
    S.a_ready(cur);
    if constexpr (SP2) {
        PG8_STAGE(PG8_SB(0, 0), cB, voffB); PG8_STAGE(PG8_SB(0, 1), cB + hstep, voffB); PG8_STAGE(PG8_SA(0, 0), cA, voffA); PG8_STAGE(PG8_SA(0, 1), cA + hstep, voffA);
        if (wr == 1) PG8_BAR;
        PG8_WAIT_V(2); PG8_BAR;
        PG8_STAGE(PG8_SB(1, 0), cB + kstep, voffB); PG8_STAGE(PG8_SA(1, 0), cA + kstep, voffA); PG8_STAGE(PG8_SB(1, 1), cB + hstep + kstep, voffB);
        PG8_WAIT_V(6); PG8_BAR;
    } else {
        PG8_STAGE(PG8_SB(0, 0), cB, voffB); PG8_STAGE(PG8_SA(0, 0), cA, voffA); PG8_STAGE(PG8_SB(0, 1), cB + hstep, voffB); PG8_STAGE(PG8_SA(0, 1), cA + hstep, voffA);
        if (wr == 1) PG8_BAR;
        PG8_WAIT_V(4); PG8_BAR;
        PG8_STAGE(PG8_SB(1, 0), cB + kstep, voffB); PG8_STAGE(PG8_SA(1, 0), cA + kstep, voffA); PG8_STAGE(PG8_SB(1, 1), cB + hstep + kstep, voffB);
        PG8_WAIT_V(6); PG8_BAR;
    }
    for (;;) {
        const bool has_next = S.next(ui + 1, nxt);
        const char* nA = has_next ? (const char*)g.A + (size_t)nxt.pm * tstep : cA; const char* nB = has_next ? (const char*)g.Bt + (size_t)nxt.pn * tstep : cB;
        for (int t = 0; t < nt; t += 2) {
            const bool last = (t == nt - 2);
            const char* a1 = cA + (size_t)(t + 1) * kstep;
            const char* a2 = last ? nA : cA + (size_t)(t + 2) * kstep; const char* b2 = last ? nB : cB + (size_t)(t + 2) * kstep;
            const char* a3 = a2 + kstep; const char* b3 = b2 + kstep;
            if (last && has_next) S.a_ready(nxt);
            if constexpr (SP2) {
            PG8_LDB(B0, 0, 0); PG8_LDB(B1, 0, 1); PG8_SCHED; PG8_LDA(At, 0, 0); PG8_STAGE(PG8_SA(1, 1), a1 + hstep, voffA);
            PG8_WAIT_V(8); PG8_WAIT_L(0); PG8_BAR; PG8_MMA(0, 0, At, B0); PG8_MMA(0, 1, At, B1); PG8_BAR; PG8_SCHED;
            PG8_LDA(At, 0, 1); PG8_STAGE(PG8_SB(0, 0), b2, voffB); PG8_STAGE(PG8_SB(0, 1), b2 + hstep, voffB); PG8_STAGE(PG8_SA(0, 0), a2, voffA);
            PG8_WAIT_V(8); PG8_WAIT_L(0); PG8_BAR; PG8_MMA(1, 0, At, B0); PG8_MMA(1, 1, At, B1); PG8_BAR; PG8_SCHED;
            PG8_LDB(B0, 1, 0); PG8_LDB(B1, 1, 1); PG8_SCHED; PG8_LDA(At, 1, 0); PG8_STAGE(PG8_SA(0, 1), a2 + hstep, voffA);
            PG8_WAIT_V(8); PG8_WAIT_L(0); PG8_BAR; PG8_MMA(0, 0, At, B0); PG8_MMA(0, 1, At, B1); PG8_BAR; PG8_SCHED;
            PG8_LDA(At, 1, 1); PG8_STAGE(PG8_SB(1, 0), b3, voffB); PG8_STAGE(PG8_SB(1, 1), b3 + hstep, voffB); PG8_STAGE(PG8_SA(1, 0), a3, voffA);
            PG8_WAIT_V(8); PG8_WAIT_L(0); PG8_BAR; PG8_MMA(1, 0, At, B0); PG8_MMA(1, 1, At, B1); PG8_BAR; PG8_SCHED;
            } else {
            PG8_LDB(B0, 0, 0); PG8_SCHED; PG8_LDA(At, 0, 0); PG8_STAGE(PG8_SA(1, 1), a1 + hstep, voffA);
            PG8_WAIT_L(8); PG8_BAR; PG8_WAIT_L(0); PG8_MMA(0, 0, At, B0); PG8_BAR; PG8_SCHED;
            PG8_LDB(B1, 0, 1); PG8_STAGE(PG8_SB(0, 0), b2, voffB);
            PG8_BAR; PG8_WAIT_L(0); PG8_MMA(0, 1, At, B1); PG8_BAR;
            PG8_LDA(At, 0, 1); PG8_STAGE(PG8_SA(0, 0), a2, voffA);
            PG8_BAR; PG8_WAIT_L(0); PG8_MMA(1, 0, At, B0); PG8_BAR; PG8_SCHED;
            PG8_STAGE(PG8_SB(0, 1), b2 + hstep, voffB);
            PG8_WAIT_V(6); PG8_BAR; PG8_MMA(1, 1, At, B1); PG8_BAR;
            PG8_LDB(B0, 1, 0); PG8_SCHED; PG8_LDA(At, 1, 0); PG8_STAGE(PG8_SA(0, 1), a2 + hstep, voffA);
            PG8_WAIT_L(8); PG8_BAR; PG8_WAIT_L(0); PG8_MMA(0, 0, At, B0); PG8_BAR; PG8_SCHED;
            PG8_LDB(B1, 1, 1); PG8_STAGE(PG8_SB(1, 0), b3, voffB);
            PG8_BAR; PG8_WAIT_L(0); PG8_MMA(0, 1, At, B1); PG8_BAR;
            PG8_LDA(At, 1, 1); PG8_STAGE(PG8_SA(1, 0), a3, voffA);
            PG8_BAR; PG8_WAIT_L(0); PG8_MMA(1, 0, At, B0); PG8_BAR; PG8_SCHED;
            PG8_STAGE(PG8_SB(1, 1), b3 + hstep, voffB);
            PG8_WAIT_V(6); PG8_BAR; PG8_MMA(1, 1, At, B1); PG8_BAR;
            }
        }
        if constexpr (ALIGN_EPI) { if (wr == 0) PG8_BAR; }
        if constexpr (!Epi::AFTER_DRAIN) { E(acc, cur, wr, wc, fr, fq); S.done(cur); }
        if (!has_next) break;
#pragma unroll
        for (int a = 0; a < 2; ++a)
#pragma unroll
            for (int b = 0; b < 2; ++b)
#pragma unroll
                for (int m = 0; m < 4; ++m)
#pragma unroll
                    for (int n = 0; n < 2; ++n) acc[a][b][m][n] = (f32x4){0.f, 0.f, 0.f, 0.f};
        cur = nxt; cA = nA; cB = nB; ++ui;
        if constexpr (ALIGN_EPI) { if (wr == 1) PG8_BAR; }
    }
    PG8_WAIT_V(0);
    if constexpr (!ALIGN_EPI) { if (wr == 0) PG8_BAR; }
    PG8_BAR;
    if constexpr (Epi::AFTER_DRAIN) { E.fused(acc, cur, wr, wc, fr, fq, lds, wid, lane); S.done(cur); }
#undef PG8_SA
#undef PG8_SB
#undef PG8_STAGE
#undef PG8_LDA
#undef PG8_LDB
#undef PG8_MMA
#undef PG8_WAIT_V
#undef PG8_WAIT_L
#undef PG8_BAR
#undef PG8_SCHED
}
}

#ifndef PG8_SP2
#define PG8_SP2 true
#endif
#ifndef PG8_ALIGN
#define PG8_ALIGN true
#endif
#define GAS __attribute__((address_space(1)))
#define LAS __attribute__((address_space(3)))
typedef unsigned short bf16;
typedef unsigned v4u __attribute__((ext_vector_type(4)));
typedef float f32x4 __attribute__((ext_vector_type(4)));
typedef short bf16x8 __attribute__((ext_vector_type(8)));
typedef GAS unsigned gu32;
typedef GAS unsigned long long gu64;
#define RLX_AGENT __ATOMIC_RELAXED, __HIP_MEMORY_SCOPE_AGENT
#define LDS_WAIT() asm volatile("s_waitcnt lgkmcnt(0)" ::: "memory")
#define VM_WAIT() asm volatile("s_waitcnt vmcnt(0)" ::: "memory")
__device__ __forceinline__ unsigned long long rt() { return __builtin_amdgcn_s_memrealtime(); }
__device__ __forceinline__ unsigned f2bf(float f) { unsigned u = __builtin_bit_cast(unsigned, f); return (u + 0x7fffu + ((u >> 16) & 1u)) >> 16; }
typedef float pk2_f32x2 __attribute__((ext_vector_type(2))); typedef __bf16 pk2_bf16x2 __attribute__((ext_vector_type(2)));
__device__ __forceinline__ unsigned pk2(float lo, float hi) { pk2_f32x2 v = {lo, hi}; pk2_bf16x2 b = __builtin_convertvector(v, pk2_bf16x2); return __builtin_bit_cast(unsigned, b); }

#define XB_TMO      128
#define XB_XCNT(j)  (256  + 64 * (j))
#define XB_XSUB(j)  (1280 + 64 * (j))
#define XB_XGEN(j)  (2304 + 64 * (j))
#define XB_TOP      3328
#define XB_TOPGEN   3392
#define XCD_BAR_WORDS 3456
#define XB_SPIN_CAP (1u << 18)

__device__ __forceinline__ unsigned xb_ld(unsigned* p)              { return __hip_atomic_load(p, __ATOMIC_RELAXED, __HIP_MEMORY_SCOPE_AGENT); }
__device__ __forceinline__ unsigned xb_add(unsigned* p, unsigned v) { return __hip_atomic_fetch_add(p, v, __ATOMIC_RELAXED, __HIP_MEMORY_SCOPE_AGENT); }
__device__ __forceinline__ unsigned xb_xcc_id() { return (unsigned)__builtin_amdgcn_s_getreg((3 << 11) | 20) & 0xFu; }
#define XB_SPIN(cond, bar) do { unsigned _sp = 0; while (cond) { __builtin_amdgcn_s_sleep(1); \
    if ((++_sp & 255u) == 0u) { if (xb_ld(&(bar)[XB_TMO])) break; if (_sp > XB_SPIN_CAP) { atomicAdd(&(bar)[XB_TMO], 1u); break; } } } } while (0)

struct XcdBarrier {
    unsigned* bar; unsigned x;
    volatile LAS unsigned* st;
};

__device__ __forceinline__ XcdBarrier xcd_barrier_post(unsigned* bar, volatile LAS unsigned* st) {
    XcdBarrier b; b.bar = bar; b.x = xb_xcc_id(); b.st = st;
    if (threadIdx.x == 0) (void)xb_add(&bar[XB_XCNT(b.x)], 1u);
    return b;
}
__device__ __forceinline__ void xcd_barrier_complete(unsigned* bar, unsigned x, unsigned& nloc, unsigned& nx) {
    const unsigned G = gridDim.x * gridDim.y * gridDim.z;
    unsigned sum, cnt, mine, sp = 0u;
    for (;;) {
        sum = 0u; cnt = 0u; mine = 0u;
#pragma unroll
        for (unsigned j = 0; j < 16; ++j) { const unsigned c = xb_ld(&bar[XB_XCNT(j)]); sum += c; cnt += (c > 0u) ? 1u : 0u; mine = (j == x) ? c : mine; }
        if (sum == G) break;
        __builtin_amdgcn_s_sleep(1);
        if ((++sp & 255u) == 0u) { if (xb_ld(&bar[XB_TMO])) break; if (sp > XB_SPIN_CAP) { atomicAdd(&bar[XB_TMO], 1u); break; } }
    }
    nloc = mine > 0u ? mine : 1u; nx = cnt > 0u ? cnt : 1u;
}

__device__ __forceinline__ void xcd_barrier(const XcdBarrier& b) {
    asm volatile("s_waitcnt vmcnt(0)" ::: "memory");
    __syncthreads();
    if (threadIdx.x == 0) {
        unsigned* bar = b.bar;
        __builtin_amdgcn_s_waitcnt(0);
        unsigned nloc = b.st[0], nx = b.st[1];
        if (nloc == 0u) { xcd_barrier_complete(bar, b.x, nloc, nx); b.st[0] = nloc; b.st[1] = nx; }
        const unsigned old = xb_add(&bar[XB_XSUB(b.x)], 1u);
        const unsigned gen = old / nloc;
        if (old + 1u == (gen + 1u) * nloc) {
            __builtin_amdgcn_fence(__ATOMIC_RELEASE, "agent");
            asm volatile("s_waitcnt vmcnt(0)" ::: "memory");
            const unsigned og = xb_add(&bar[XB_TOP], 1u);
            const unsigned tg = og / nx;
            if (og + 1u == (tg + 1u) * nx) xb_add(&bar[XB_TOPGEN], 1u);
            else XB_SPIN(xb_ld(&bar[XB_TOPGEN]) == tg, bar);
            __builtin_amdgcn_fence(__ATOMIC_ACQUIRE, "agent");
            xb_add(&bar[XB_XGEN(b.x)], 1u);
            asm volatile("s_waitcnt vmcnt(0)" ::: "memory");
        } else {
            XB_SPIN(xb_ld(&bar[XB_XGEN(b.x)]) == gen, bar);
            __builtin_amdgcn_fence(__ATOMIC_ACQUIRE, "agent");
            asm volatile("s_waitcnt vmcnt(0)" ::: "memory");
        }
    }
    __syncthreads();
}


constexpr int NWAVES = 8;
constexpr int DM = 2048, BATCH = 4, SEQ = 4096, M = BATCH * SEQ;
constexpr int NIN = 6176, NINP = 6144;
constexpr int O_GQ = 0, O_GK = 512, O_GV = 1024, O_GR = 2048, O_AQ = 3072, O_AK = 4096, O_AV = 5120;
constexpr float EPS = 1e-6f;
constexpr int PEER_K = 128;

constexpr size_t MiB = 1u << 20;
constexpr size_t WS_CTL = 0, CTL_ZERO_BYTES = 1 * MiB;
constexpr size_t WS_WIN = 1 * MiB;
constexpr size_t WS_WGD = 25 * MiB;
constexpr size_t WS_GDB = 62 * MiB;
constexpr size_t WS_WOUT = 26 * MiB;
constexpr size_t WS_WQ = 34 * MiB;
constexpr size_t WS_SSQ = 42 * MiB;
constexpr size_t WS_EIDX = 44 * MiB;
constexpr size_t WS_GATE = 52 * MiB;
constexpr size_t WS_SKB = 60 * MiB;
constexpr size_t WS_XN = 64 * MiB;
constexpr size_t WS_PROJ = 128 * MiB;
constexpr size_t WS_HB = 256 * MiB;
constexpr size_t WS_OF = 328 * MiB;
constexpr size_t WS_OB = 360 * MiB;
constexpr size_t WS_ATTP = 392 * MiB;
constexpr size_t WS_ATTML = 488 * MiB;
constexpr size_t WS_GT_QD = 64 * MiB;
constexpr size_t WS_GT_KE = 96 * MiB;
constexpr size_t OUT_GT_AM = 0;
constexpr size_t OUT_GT_DEC = 16 * MiB;
constexpr size_t OUT_GT_VT = 32 * MiB;
constexpr int CW_ATTQX = 512;
constexpr size_t WS_EIDX16 = 494 * MiB;
constexpr size_t WS_END = 498 * MiB;
constexpr size_t OUT_U8 = 64 * MiB;
constexpr size_t OUT_V8 = 96 * MiB;
constexpr size_t WS_SU = 61 * MiB;
constexpr size_t WS_SV = 61 * MiB + 65536;
constexpr int CONV_FIRST_RANK = 24;
constexpr int CW_CONVQ = 256;
constexpr size_t WS_PW = 128 * MiB;
constexpr size_t WS_SSQ2 = 136 * MiB;
constexpr size_t WS_PD = 64 * MiB;
constexpr int PEER_E = 16384;
constexpr int CW_TMO = 0, CW_CODE = 1, CW_BAR = 4096;

constexpr int RING_OFF = 0, RING_BYTES = 131072;
constexpr int LDS_BYTES = 163840;
constexpr int LDSCTL_OFF = LDS_BYTES - 1024, MISC_OFF = LDSCTL_OFF + 320;

typedef float f32x2 __attribute__((ext_vector_type(2)));
typedef float f32x16 __attribute__((ext_vector_type(16)));
typedef int i32x4 __attribute__((ext_vector_type(4)));
typedef int i32x2 __attribute__((ext_vector_type(2)));
__device__ __forceinline__ float bf2f(unsigned short h) { return __builtin_bit_cast(float, (unsigned)h << 16); }
__device__ __forceinline__ float bflo(unsigned w) { return __builtin_bit_cast(float, w << 16); }
__device__ __forceinline__ float bfhi(unsigned w) { return __builtin_bit_cast(float, w & 0xffff0000u); }
#define WRED_DPP(x, ctrl) __builtin_bit_cast(float, __builtin_amdgcn_update_dpp(0, __builtin_bit_cast(int, (x)), ctrl, 0xF, 0xF, false))
#define WRED_LANE(x, l) __builtin_bit_cast(float, __builtin_amdgcn_readlane(__builtin_bit_cast(int, (x)), (l)))
__device__ __forceinline__ float wave_sum(float v) {
    v += WRED_DPP(v, 0xB1); v += WRED_DPP(v, 0x4E); v += WRED_DPP(v, 0x141); v += WRED_DPP(v, 0x140);
    return (WRED_LANE(v, 0) + WRED_LANE(v, 16)) + (WRED_LANE(v, 32) + WRED_LANE(v, 48));
}
__device__ __forceinline__ float wave_max(float v) {
    v = fmaxf(v, WRED_DPP(v, 0xB1)); v = fmaxf(v, WRED_DPP(v, 0x4E)); v = fmaxf(v, WRED_DPP(v, 0x141)); v = fmaxf(v, WRED_DPP(v, 0x140));
    return fmaxf(fmaxf(WRED_LANE(v, 0), WRED_LANE(v, 16)), fmaxf(WRED_LANE(v, 32), WRED_LANE(v, 48)));
}

#define SWAP_PAIR(OP, x, r0, r1) do { unsigned a_ = __builtin_bit_cast(unsigned, (x)), b_ = a_; asm volatile("" : "+v"(b_)); auto s_ = OP(a_, b_, false, false); const unsigned u0_ = s_[0], u1_ = s_[1];   r0 = __builtin_bit_cast(float, u0_); r1 = __builtin_bit_cast(float, u1_); } while (0)
__device__ __forceinline__ float xrow_max(float v) {
    float p, q; SWAP_PAIR(__builtin_amdgcn_permlane16_swap, v, p, q); v = fmaxf(p, q); SWAP_PAIR(__builtin_amdgcn_permlane32_swap, v, p, q); return fmaxf(p, q);
}
__device__ __forceinline__ float xrow_sum(float v) {
    float p, q; SWAP_PAIR(__builtin_amdgcn_permlane16_swap, v, p, q); v = p + q; SWAP_PAIR(__builtin_amdgcn_permlane32_swap, v, p, q); return p + q;
}
template <class T> __device__ __forceinline__ T* opaque(T* p) { asm volatile("" : "+s"(p)); return (T*)(GAS T*)p; }
__device__ __forceinline__ int lane_id() { int x; asm volatile("v_mbcnt_lo_u32_b32 %0, -1, 0\n\tv_mbcnt_hi_u32_b32 %0, -1, %0" : "=v"(x)); return x; }
__device__ __forceinline__ int opaque_v(int x) { asm volatile("" : "+v"(x)); return x; }
template <class T> __device__ __forceinline__ T ldu(const void* ubase, unsigned voff) { return *(const GAS T*)((const GAS char*)ubase + voff); }
template <class T> __device__ __forceinline__ void stu(void* ubase, unsigned voff, T v) { *(GAS T*)((GAS char*)ubase + voff) = v; }
namespace pg8 {
struct EpiRes {
    static constexpr bool PERM = true, AFTER_DRAIN = false;
    const float* x; bf16_t* HB; float* ssq; int ldc;
    __device__ __forceinline__ void operator()(const f32x4 (&acc)[2][2][4][2], const Unit& u, int wr, int wc, int fr, int fq) const {
        const int col0 = u.pn * BM + wc * 32 + 8 * fq;
        const int rbase = u.pm * BM + wr * 64 + fr;
        f32x4 xc[2][2], xn[2][2];
#define EPIRES_LOAD(D, IDX) do { const size_t o_ = (size_t)(rbase + ((IDX) >> 2) * HALF + ((IDX) & 3) * 16) * ldc + col0; _Pragma("unroll") for (int bj = 0; bj < 2; ++bj) { D[bj][0] = *(const f32x4*)(x + o_ + bj * HALF); D[bj][1] = *(const f32x4*)(x + o_ + bj * HALF + 4); } } while (0)
        EPIRES_LOAD(xc, 0);
#pragma unroll
        for (int idx = 0; idx < 8; ++idx) { const int ai = idx >> 2, m = idx & 3;
            if (idx + 1 < 8) EPIRES_LOAD(xn, idx + 1);
            const int r = rbase + ai * HALF + m * 16; const size_t off = (size_t)r * ldc + col0; float s = 0.f;
#pragma unroll
            for (int bj = 0; bj < 2; ++bj) {
                const f32x4 h0 = xc[bj][0] + acc[ai][bj][m][0], h1 = xc[bj][1] + acc[ai][bj][m][1];
                s += ((h0[0] * h0[0] + h0[1] * h0[1]) + (h0[2] * h0[2] + h0[3] * h0[3])) + ((h1[0] * h1[0] + h1[1] * h1[1]) + (h1[2] * h1[2] + h1[3] * h1[3]));
                u32x4 w; w.x = cvt_pk_bf16(h0[0], h0[1]); w.y = cvt_pk_bf16(h0[2], h0[3]); w.z = cvt_pk_bf16(h1[0], h1[1]); w.w = cvt_pk_bf16(h1[2], h1[3]);
                *(u32x4*)(HB + off + bj * HALF) = w;
            }
            s += __shfl_xor(s, 16); s += __shfl_xor(s, 32);
            if (fq == 0) ssq[(size_t)r * 32 + u.pn * 4 + wc] = s;
#pragma unroll
            for (int bj = 0; bj < 2; ++bj) { xc[bj][0] = xn[bj][0]; xc[bj][1] = xn[bj][1]; }
        }
#undef EPIRES_LOAD
    }
};
constexpr int EPI_STAGE_OFF = 131072;
struct EpiBf16S {
    static constexpr bool PERM = true, AFTER_DRAIN = false;
    bf16_t* O; int ldc; LAS unsigned char* stage;
    __device__ __forceinline__ void operator()(const f32x4 (&acc)[2][2][4][2], const Unit& u, int wr, int wc, int fr, int fq) const {
        LAS unsigned char* st = stage + (wr * 4 + wc) * 3584;
        const int lane = fr + 16 * fq, srow = lane >> 2, sch = lane & 3;
        LAS unsigned char* wp = st + fr * 80 + fq * 16; const LAS unsigned char* rp = st + srow * 80 + sch * 16;
        bf16_t* gp = O + (size_t)(u.pm * BM + wr * 64 + srow) * ldc + u.pn * BM + wc * 32 + sch * 8;
#pragma unroll
        for (int ai = 0; ai < 2; ++ai)
#pragma unroll
            for (int m = 0; m < 4; ++m)
#pragma unroll
                for (int bj = 0; bj < 2; ++bj) { const f32x4 v0 = acc[ai][bj][m][0], v1 = acc[ai][bj][m][1];
                    u32x4 w; w.x = cvt_pk_bf16(v0[0], v0[1]); w.y = cvt_pk_bf16(v0[2], v0[3]); w.z = cvt_pk_bf16(v1[0], v1[1]); w.w = cvt_pk_bf16(v1[2], v1[3]);
                    *(LAS u32x4*)wp = w;
                    const u32x4 o = *(const LAS u32x4*)rp;
                    *(u32x4*)(gp + (size_t)(ai * HALF + m * 16) * ldc + bj * HALF) = o; }
    }
};
struct EpiResS {
    static constexpr bool PERM = true, AFTER_DRAIN = false;
    const float* x; bf16_t* HB; float* ssq; int ldc; LAS unsigned char* stage;
    __device__ __forceinline__ void operator()(const f32x4 (&acc)[2][2][4][2], const Unit& u, int wr, int wc, int fr, int fq) const {
        LAS unsigned char* xs = stage + (wr * 4 + wc) * 3584; LAS unsigned char* os = xs + 2304;
        const int lane = fr + 16 * fq, srow = lane >> 2, sch = lane & 3, lrow = lane >> 3, lch = lane & 7;
        const int R0 = u.pm * BM + wr * 64, C0 = u.pn * BM + wc * 32;
        const float* xg = x + (size_t)(R0 + lrow) * ldc + C0 + lch * 4;
        bf16_t* gp = HB + (size_t)(R0 + srow) * ldc + C0 + sch * 8;
        f32x4 xc[4], xn[4];
#define EPIRES_LOAD(D, IDX) do { const size_t o_ = (size_t)(((IDX) >> 2) * HALF + ((IDX) & 3) * 16) * ldc; _Pragma("unroll") for (int bj = 0; bj < 2; ++bj) { D[2 * bj] = *(const f32x4*)(xg + o_ + bj * HALF); D[2 * bj + 1] = *(const f32x4*)(xg + o_ + (size_t)8 * ldc + bj * HALF); } } while (0)
        EPIRES_LOAD(xc, 0);
#pragma unroll
        for (int idx = 0; idx < 8; ++idx) { const int ai = idx >> 2, m = idx & 3;
            if (idx + 1 < 8) EPIRES_LOAD(xn, idx + 1);
            float s = 0.f;
#pragma unroll
            for (int bj = 0; bj < 2; ++bj) {
                *(LAS f32x4*)(xs + lrow * 144 + lch * 16) = xc[2 * bj]; *(LAS f32x4*)(xs + (8 + lrow) * 144 + lch * 16) = xc[2 * bj + 1];
                const f32x4 r0 = *(const LAS f32x4*)(xs + fr * 144 + fq * 32), r1 = *(const LAS f32x4*)(xs + fr * 144 + fq * 32 + 16);
                const f32x4 h0 = r0 + acc[ai][bj][m][0], h1 = r1 + acc[ai][bj][m][1];
                s += ((h0[0] * h0[0] + h0[1] * h0[1]) + (h0[2] * h0[2] + h0[3] * h0[3])) + ((h1[0] * h1[0] + h1[1] * h1[1]) + (h1[2] * h1[2] + h1[3] * h1[3]));
                u32x4 w; w.x = cvt_pk_bf16(h0[0], h0[1]); w.y = cvt_pk_bf16(h0[2], h0[3]); w.z = cvt_pk_bf16(h1[0], h1[1]); w.w = cvt_pk_bf16(h1[2], h1[3]);
                *(LAS u32x4*)(os + fr * 80 + fq * 16) = w;
                const u32x4 o = *(const LAS u32x4*)(os + srow * 80 + sch * 16);
                *(u32x4*)(gp + (size_t)(ai * HALF + m * 16) * ldc + bj * HALF) = o;
            }
            s = xrow_sum(s);
            if (fq == 0) ssq[(size_t)(R0 + ai * HALF + m * 16 + fr) * 32 + u.pn * 4 + wc] = s;
#pragma unroll
            for (int j = 0; j < 4; ++j) xc[j] = xn[j];
        }
#undef EPIRES_LOAD
    }
};
}

struct Frame {
    LAS unsigned char* lds;
    volatile LAS unsigned* MISC;
    gu32* ctl;
    int wave;
    int vcu, G;
};

__device__ __forceinline__ void p0_transpose_item(const float* W, int K, int ldw, const float* gk, bf16* WT, LAS float* scr, int item, int lane) {
    const int nblk = ldw / 32, kb = item / nblk, nb = item % nblk, k0 = 64 * kb, n0 = 32 * nb;
    float wv[32];
    { const GAS float* Wg = (const GAS float*)W + (size_t)(k0 + (lane >> 5)) * ldw + n0 + (lane & 31);
#pragma unroll
      for (int i = 0; i < 32; ++i) wv[i] = Wg[(size_t)(2 * i) * ldw]; }
    if (gk) {
#pragma unroll
      for (int i = 0; i < 32; ++i) wv[i] *= ((const GAS float*)gk)[k0 + 2 * i + (lane >> 5)]; }
#pragma unroll
    for (int i = 0; i < 32; ++i) scr[(2 * i + (lane >> 5)) * 33 + (lane & 31)] = wv[i];
    LDS_WAIT(); asm volatile("" ::: "memory");
    const int c = lane & 7;
#pragma unroll
    for (int j = 0; j < 4; ++j) { const int n = (lane >> 3) + 8 * j; const LAS float* s = scr + (8 * c) * 33 + n;
        v4u o; o.x = pk2(s[0 * 33], s[1 * 33]); o.y = pk2(s[2 * 33], s[3 * 33]); o.z = pk2(s[4 * 33], s[5 * 33]); o.w = pk2(s[6 * 33], s[7 * 33]);
        *(GAS v4u*)(WT + (size_t)(n0 + n) * K + k0 + 8 * c) = o; }
    LDS_WAIT(); asm volatile("" ::: "memory");
}
struct Args {
    const float* in[16]; float* out; unsigned char* ws; int ph_lo, ph_hi, li, pad;
};

__device__ __forceinline__ void p0_prologue(Frame& F, const Args& a) {
    unsigned char* ws = a.ws;
    LAS float* scr = (LAS float*)(F.lds + RING_OFF + F.wave * 16384);
    const int gw = F.vcu * NWAVES + F.wave, NGW = F.G * NWAVES;
    bf16* Win_t = (bf16*)(ws + WS_WIN); bf16* Wout_t = (bf16*)(ws + WS_WOUT); bf16* Wq_t = (bf16*)(ws + WS_WQ); bf16* XN = (bf16*)(ws + WS_XN);
    constexpr int I_IN = (DM / 64) * (NIN / 32), I_SQ = (DM / 64) * (DM / 32);
    constexpr int NITEMS = I_IN + 2 * I_SQ;
    for (int it = gw; it < NITEMS; it += NGW) {
        int r = it;
        if (r < I_IN) { const int nb = r % (NIN / 32); bf16* dst = nb < 96 ? Win_t : nb == 96 ? (bf16*)(ws + WS_WGD) - (size_t)96 * 32 * DM : Win_t - (size_t)32 * DM;
            p0_transpose_item(a.in[2], DM, NIN, nullptr, dst, scr, r, lane_id()); continue; } r -= I_IN;
        if (r < I_SQ) { p0_transpose_item(a.in[9], DM, DM, nullptr, Wout_t, scr, r, lane_id()); continue; } r -= I_SQ;
        p0_transpose_item(a.in[11], DM, DM, a.in[10], Wq_t, scr, r, lane_id());
    }
    { const f32x4* sk = (const f32x4*)a.in[12]; unsigned long long* skb = (unsigned long long*)(ws + WS_SKB);
      for (int i = gw * 64 + lane_id(); i < 8 * 2 * 128 * 128 / 4; i += NGW * 64) { const f32x4 v = sk[i]; skb[i] = (unsigned long long)pk2(v.x, v.y) | ((unsigned long long)pk2(v.z, v.w) << 32); } }
    { const GAS f32x4* gr = (const GAS f32x4*)a.in[1] + lane_id(); f32x4 gg[8];
#pragma unroll
      for (int j = 0; j < 8; ++j) gg[j] = gr[64 * j];
      f32x4 v[8], vn[8], vn2[8];
#define P0_LOAD(MM, V) do { _Pragma("unroll") for (int j = 0; j < 8; ++j) V[j] = ((const GAS f32x4*)(a.in[0] + (size_t)(MM) * DM) + lane_id())[64 * j]; } while (0)
      if (gw < M) { P0_LOAD(gw, v); const int m1 = gw + NGW < M ? gw + NGW : gw; P0_LOAD(m1, vn); }
      for (int m = gw; m < M; m += NGW) { const int mn = m + 2 * NGW < M ? m + 2 * NGW : m;
          P0_LOAD(mn, vn2);
          float ss = 0.f;
#pragma unroll
          for (int j = 0; j < 8; ++j) ss += (v[j].x * v[j].x + v[j].y * v[j].y) + (v[j].z * v[j].z + v[j].w * v[j].w);
          const float rstd = 1.f / sqrtf(wave_sum(ss) * (1.f / DM) + EPS);
          GAS unsigned long long* o8 = (GAS unsigned long long*)(XN + (size_t)m * DM) + lane_id();
#pragma unroll
          for (int j = 0; j < 8; ++j) o8[64 * j] = (unsigned long long)pk2(v[j].x * rstd * gg[j].x, v[j].y * rstd * gg[j].y) | ((unsigned long long)pk2(v[j].z * rstd * gg[j].z, v[j].w * rstd * gg[j].w) << 32);
#pragma unroll
          for (int j = 0; j < 8; ++j) { v[j] = vn[j]; vn[j] = vn2[j]; } } }
#undef P0_LOAD
}


__device__ __forceinline__ void gd_side_gemm(Frame& F, const Args& a) {
    unsigned char* ws = a.ws; const bf16* XN = (const bf16*)(ws + WS_XN); const bf16* WG = (const bf16*)(ws + WS_WGD); float* GDB = (float*)(ws + WS_GDB);
    const int lane = lane_id(), w = F.wave, r32 = lane & 31, hh = lane >> 5; LAS float* part = (LAS float*)F.lds;
    for (int blk = F.vcu; blk < M / 64; blk += F.G) { const int tok0 = blk * 64;
        f32x16 acc[2];
#pragma unroll
        for (int tt = 0; tt < 2; ++tt) acc[tt] = (f32x16){0.f, 0.f, 0.f, 0.f, 0.f, 0.f, 0.f, 0.f, 0.f, 0.f, 0.f, 0.f, 0.f, 0.f, 0.f, 0.f};
#pragma unroll 4
        for (int ks = 0; ks < 16; ++ks) { const int k0 = 256 * w + 16 * ks + 8 * hh; const bf16x8 bw = *(const bf16x8*)(WG + (size_t)r32 * DM + k0);
#pragma unroll
            for (int tt = 0; tt < 2; ++tt) { const bf16x8 ax = *(const bf16x8*)(XN + (size_t)(tok0 + 32 * tt + r32) * DM + k0); acc[tt] = __builtin_amdgcn_mfma_f32_32x32x16_bf16(ax, bw, acc[tt], 0, 0, 0); } }
#pragma unroll
        for (int tt = 0; tt < 2; ++tt)
#pragma unroll
            for (int r = 0; r < 16; ++r) { const float x = acc[tt][r]; part[((w * 2 + tt) * 16 + r) * 64 + lane] = x; }
        __syncthreads();
#pragma unroll
        for (int i = 0; i < 4; ++i) { const int o = (F.wave * 64 + lane_id()) + 512 * i; float sum = 0.f;
#pragma unroll
            for (int ww = 0; ww < 8; ++ww) sum += part[ww * 2048 + o];
            const int tt = o >> 10, r = (o >> 6) & 15, ln = o & 63; const int t = 32 * tt + (r & 3) + 8 * (r >> 2) + 4 * (ln >> 5);
            GDB[(size_t)(tok0 + t) * 32 + (ln & 31)] = sum; }
        __syncthreads();
    }
}

__device__ __forceinline__ void p3_finalize(Frame& F, const Args& a) {
    unsigned char* ws = a.ws;
    const int gw = F.vcu * NWAVES + F.wave, NGW = F.G * NWAVES, lane = lane_id();
    const GAS bf16* OFp = (const GAS bf16*)(ws + WS_OF); const GAS bf16* OBp = (const GAS bf16*)(ws + WS_OB);
    const GAS bf16* PROJ = (const GAS bf16*)(ws + WS_PROJ); GAS bf16* Y = (GAS bf16*)(ws + WS_XN);
    const GAS float* ATTML = (const GAS float*)(ws + WS_ATTML); const GAS bf16* ATTP = (const GAS bf16*)(ws + WS_ATTP);
    const GAS float* gla_g = (const GAS float*)a.in[7]; const GAS float* att_g = (const GAS float*)a.in[8];
    const f32x4 gg = *(const GAS f32x4*)(gla_g + 4 * lane);
    f32x4 ag[2][2];
#pragma unroll
    for (int p = 0; p < 2; ++p) { ag[p][0] = *(const GAS f32x4*)(att_g + p * 512 + 8 * lane); ag[p][1] = *(const GAS f32x4*)(att_g + p * 512 + 8 * lane + 4); }
    unsigned long long wf[4], wb[4], gr[4], nwf[4], nwb[4], ngr[4]; f32x2 ml[2][3], nml[2][3]; v4u ow[2][3], now[2][3];
#define P3_LOAD(MM, WF, WB, GR, ML, OW) do { _Pragma("unroll") for (int hh = 0; hh < 4; ++hh) { WF[hh] = *(const GAS unsigned long long*)(OFp + (size_t)(MM) * 1024 + hh * 256 + 4 * lane); \
            WB[hh] = *(const GAS unsigned long long*)(OBp + (size_t)(MM) * 1024 + hh * 256 + 4 * lane); GR[hh] = *(const GAS unsigned long long*)(PROJ + (size_t)(MM) * NINP + O_GR + hh * 256 + 4 * lane); } \
        _Pragma("unroll") for (int p = 0; p < 2; ++p) { const int col = p * 512 + 8 * lane, hd = col >> 6; _Pragma("unroll") for (int pt = 0; pt < 3; ++pt) { const size_t rec = ((size_t)pt * M + (MM)) * 16 + hd; \
            ML[p][pt] = *(const GAS f32x2*)(ATTML + rec * 2); OW[p][pt] = *(const GAS v4u*)(ATTP + rec * 64 + (col & 63)); } } } while (0)
    if (gw < M) P3_LOAD(gw, wf, wb, gr, ml, ow);
    for (int m = gw; m < M; m += NGW) {
        const int mn = m + NGW < M ? m + NGW : m;
        P3_LOAD(mn, nwf, nwb, ngr, nml, now);
#pragma unroll
        for (int hh = 0; hh < 4; ++hh) {
            const f32x4 o = (f32x4){bflo((unsigned)wf[hh]) + bflo((unsigned)wb[hh]), bfhi((unsigned)wf[hh]) + bfhi((unsigned)wb[hh]), bflo((unsigned)(wf[hh] >> 32)) + bflo((unsigned)(wb[hh] >> 32)), bfhi((unsigned)(wf[hh] >> 32)) + bfhi((unsigned)(wb[hh] >> 32))};
            const float ss = wave_sum((o.x * o.x + o.y * o.y) + (o.z * o.z + o.w * o.w));
            const float rstd = 1.f / sqrtf(ss * (1.f / 256.f) + EPS);
            const float r0 = bflo((unsigned)gr[hh]), r1 = bfhi((unsigned)gr[hh]), r2 = bflo((unsigned)(gr[hh] >> 32)), r3 = bfhi((unsigned)(gr[hh] >> 32));
            const float y0 = o.x * rstd * gg.x * (r0 / (1.f + __expf(-r0))), y1 = o.y * rstd * gg.y * (r1 / (1.f + __expf(-r1)));
            const float y2 = o.z * rstd * gg.z * (r2 / (1.f + __expf(-r2))), y3 = o.w * rstd * gg.w * (r3 / (1.f + __expf(-r3)));
            *(GAS unsigned long long*)(Y + (size_t)m * DM + hh * 256 + 4 * lane) = (unsigned long long)pk2(y0, y1) | ((unsigned long long)pk2(y2, y3) << 32);
        }
        float av[16]; float ss = 0.f;
#pragma unroll
        for (int p = 0; p < 2; ++p) {
            const float mt = fmaxf(fmaxf(ml[p][0].x, ml[p][1].x), ml[p][2].x); const float w0 = __expf(ml[p][0].x - mt), w1 = __expf(ml[p][1].x - mt), w2 = __expf(ml[p][2].x - mt);
            const float inv = 1.f / (w0 * ml[p][0].y + w1 * ml[p][1].y + w2 * ml[p][2].y);
            av[p * 8 + 0] = (w0 * bflo(ow[p][0].x) + w1 * bflo(ow[p][1].x) + w2 * bflo(ow[p][2].x)) * inv; av[p * 8 + 1] = (w0 * bfhi(ow[p][0].x) + w1 * bfhi(ow[p][1].x) + w2 * bfhi(ow[p][2].x)) * inv;
            av[p * 8 + 2] = (w0 * bflo(ow[p][0].y) + w1 * bflo(ow[p][1].y) + w2 * bflo(ow[p][2].y)) * inv; av[p * 8 + 3] = (w0 * bfhi(ow[p][0].y) + w1 * bfhi(ow[p][1].y) + w2 * bfhi(ow[p][2].y)) * inv;
            av[p * 8 + 4] = (w0 * bflo(ow[p][0].z) + w1 * bflo(ow[p][1].z) + w2 * bflo(ow[p][2].z)) * inv; av[p * 8 + 5] = (w0 * bfhi(ow[p][0].z) + w1 * bfhi(ow[p][1].z) + w2 * bfhi(ow[p][2].z)) * inv;
            av[p * 8 + 6] = (w0 * bflo(ow[p][0].w) + w1 * bflo(ow[p][1].w) + w2 * bflo(ow[p][2].w)) * inv; av[p * 8 + 7] = (w0 * bfhi(ow[p][0].w) + w1 * bfhi(ow[p][1].w) + w2 * bfhi(ow[p][2].w)) * inv; }
#pragma unroll
        for (int i = 0; i < 16; ++i) ss += av[i] * av[i];
        const float rstd = 1.f / sqrtf(wave_sum(ss) * (1.f / 1024.f) + EPS);
#pragma unroll
        for (int p = 0; p < 2; ++p) { const f32x4 g0 = ag[p][0], g1 = ag[p][1];
            v4u w; w.x = pk2(av[p * 8 + 0] * rstd * g0.x, av[p * 8 + 1] * rstd * g0.y); w.y = pk2(av[p * 8 + 2] * rstd * g0.z, av[p * 8 + 3] * rstd * g0.w);
            w.z = pk2(av[p * 8 + 4] * rstd * g1.x, av[p * 8 + 5] * rstd * g1.y); w.w = pk2(av[p * 8 + 6] * rstd * g1.z, av[p * 8 + 7] * rstd * g1.w);
            *(GAS v4u*)(Y + (size_t)m * DM + 1024 + p * 512 + 8 * lane) = w; }
#pragma unroll
        for (int hh = 0; hh < 4; ++hh) { wf[hh] = nwf[hh]; wb[hh] = nwb[hh]; gr[hh] = ngr[hh]; }
#pragma unroll
        for (int p = 0; p < 2; ++p)
#pragma unroll
            for (int pt = 0; pt < 3; ++pt) { ml[p][pt] = nml[p][pt]; ow[p][pt] = now[p][pt]; }
    }
#undef P3_LOAD
}


__device__ __forceinline__ void ce_desc(float& a, float& b) { const float hi = fmaxf(a, b), lo = fminf(a, b); a = hi; b = lo; }
__device__ __forceinline__ void sort16_desc(float* v) {
    ce_desc(v[0], v[1]); ce_desc(v[2], v[3]); ce_desc(v[0], v[2]); ce_desc(v[1], v[3]); ce_desc(v[1], v[2]); ce_desc(v[4], v[5]); ce_desc(v[6], v[7]); ce_desc(v[4], v[6]);
    ce_desc(v[5], v[7]); ce_desc(v[5], v[6]); ce_desc(v[0], v[4]); ce_desc(v[2], v[6]); ce_desc(v[2], v[4]); ce_desc(v[1], v[5]); ce_desc(v[3], v[7]); ce_desc(v[3], v[5]);
    ce_desc(v[1], v[2]); ce_desc(v[3], v[4]); ce_desc(v[5], v[6]); ce_desc(v[8], v[9]); ce_desc(v[10], v[11]); ce_desc(v[8], v[10]); ce_desc(v[9], v[11]); ce_desc(v[9], v[10]);
    ce_desc(v[12], v[13]); ce_desc(v[14], v[15]); ce_desc(v[12], v[14]); ce_desc(v[13], v[15]); ce_desc(v[13], v[14]); ce_desc(v[8], v[12]); ce_desc(v[10], v[14]); ce_desc(v[10], v[12]);
    ce_desc(v[9], v[13]); ce_desc(v[11], v[15]); ce_desc(v[11], v[13]); ce_desc(v[9], v[10]); ce_desc(v[11], v[12]); ce_desc(v[13], v[14]); ce_desc(v[0], v[8]); ce_desc(v[4], v[12]);
    ce_desc(v[4], v[8]); ce_desc(v[2], v[10]); ce_desc(v[6], v[14]); ce_desc(v[6], v[10]); ce_desc(v[2], v[4]); ce_desc(v[6], v[8]); ce_desc(v[10], v[12]); ce_desc(v[1], v[9]);
    ce_desc(v[5], v[13]); ce_desc(v[5], v[9]); ce_desc(v[3], v[11]); ce_desc(v[7], v[15]); ce_desc(v[7], v[11]); ce_desc(v[3], v[5]); ce_desc(v[7], v[9]); ce_desc(v[11], v[13]);
    ce_desc(v[1], v[2]); ce_desc(v[3], v[4]); ce_desc(v[5], v[6]); ce_desc(v[7], v[8]); ce_desc(v[9], v[10]); ce_desc(v[11], v[12]); ce_desc(v[13], v[14]);
}
__device__ __forceinline__ void merge16_desc(float* v) {
#pragma unroll
    for (int j = 8; j > 0; j >>= 1)
#pragma unroll
        for (int i = 0; i < 16; ++i) { const int l = i ^ j; if (l > i) ce_desc(v[i], v[l]); }
}
__device__ __forceinline__ void top16_of_two(float* a, const float* b) {
#pragma unroll
    for (int i = 0; i < 16; ++i) a[i] = fmaxf(a[i], b[15 - i]);
    merge16_desc(a);
}
__device__ __forceinline__ void top16_of_64(float* v) {
    sort16_desc(v); sort16_desc(v + 16); sort16_desc(v + 32); sort16_desc(v + 48);
    top16_of_two(v, v + 16); top16_of_two(v + 32, v + 48); top16_of_two(v, v + 32);
}
__device__ __forceinline__ void merge8_desc(float* v) {
#pragma unroll
    for (int j = 4; j > 0; j >>= 1)
#pragma unroll
        for (int i = 0; i < 8; ++i) { const int l = i ^ j; if (l > i) ce_desc(v[i], v[l]); }
}
__device__ __forceinline__ void top16_staircase(const float* A, const float* B, float* t1) {
    float Bp[16]; const float cb = 1.f - (A[15] + B[15]);
#pragma unroll
    for (int j = 0; j < 16; ++j) Bp[j] = B[j] + cb;
#define PK_CND(i, j) __builtin_bit_cast(float, (__builtin_bit_cast(unsigned, A[(i)] + Bp[(j)]) & ~255u) | (unsigned)(255 - (((i) << 4) | (j))))
#pragma unroll
    for (int j = 0; j < 16; ++j) t1[j] = PK_CND(0, j);
#pragma unroll
    for (int i = 4; i < 16; ++i) t1[i] = fmaxf(t1[i], PK_CND(4 + (15 - i), 0));
    merge16_desc(t1);
    float t2[16];
#pragma unroll
    for (int k = 0; k < 8; ++k) t2[k] = PK_CND(1, k);
    t2[8] = 0.f; t2[9] = 0.f; t2[10] = 0.f;
#pragma unroll
    for (int m = 0; m < 5; ++m) t2[11 + m] = PK_CND(2, 4 - m);
    merge16_desc(t2);
    float t3[9];
#pragma unroll
    for (int k = 0; k < 4; ++k) { t3[k] = PK_CND(3, k); t3[4 + k] = PK_CND(4 + (3 - k), 1); }
    merge8_desc(t3);
    t3[8] = PK_CND(4, 2);
#pragma unroll
    for (int k = 7; k >= 0; --k) ce_desc(t3[k], t3[k + 1]);
#pragma unroll
    for (int i = 7; i < 16; ++i) t2[i] = fmaxf(t2[i], t3[15 - i]);
    merge16_desc(t2);
#pragma unroll
    for (int i = 0; i < 16; ++i) t1[i] = fmaxf(t1[i], t2[15 - i]);
    merge16_desc(t1);
#undef PK_CND
}
__device__ __forceinline__ void topk_phase(Frame& F, const Args& a) {
    unsigned char* ws = a.ws; const GAS bf16* QP = (const GAS bf16*)(ws + WS_XN); const GAS bf16* SKB = (const GAS bf16*)(ws + WS_SKB); GAS int* EIDX = (GAS int*)(ws + WS_EIDX); GAS int* EIDX16 = (GAS int*)(ws + WS_EIDX16); GAS float* GATE = (GAS float*)(ws + WS_GATE);
    const int lane = lane_id(), r32 = lane & 31, hh = lane >> 5;
    LAS unsigned char* skl = F.lds;
    LAS int* ktab = (LAS int*)(F.lds + 65536 + F.wave * 8192);
    for (int unit = F.vcu; unit < 8 * (M / 512); unit += F.G) {
        const int h = unit & 7, tok0 = (unit >> 3) * 512 + F.wave * 64;
        __syncthreads();
#pragma unroll
        for (int i = 0; i < 8; ++i) { const int idx = (F.wave * 64 + lane_id()) + 512 * i, key = idx >> 4, ch = idx & 15;
            *(LAS v4u*)(skl + key * 256 + ((ch ^ (key & 15)) * 16)) = *(const GAS v4u*)(SKB + ((size_t)h * 256 + key) * 128 + ch * 8); }
        __syncthreads();
#pragma unroll 1
        for (int tt = 0; tt < 2; ++tt) {
            const size_t row = (size_t)(tok0 + tt * 32 + r32);
            float L[2][16];
#pragma unroll
            for (int c = 0; c < 2; ++c) {
                f32x16 acc[4];
#pragma unroll
                for (int kt = 0; kt < 4; ++kt) acc[kt] = (f32x16){0.f, 0.f, 0.f, 0.f, 0.f, 0.f, 0.f, 0.f, 0.f, 0.f, 0.f, 0.f, 0.f, 0.f, 0.f, 0.f};
                const GAS bf16* qb = QP + row * DM + h * 256 + c * 128 + 8 * hh;
#pragma unroll 2
                for (int st = 0; st < 8; ++st) {
                    const bf16x8 bq = *(const GAS bf16x8*)(qb + 16 * st);
#pragma unroll
                    for (int kt = 0; kt < 4; ++kt) { const int key = c * 128 + 32 * kt + r32; const bf16x8 ak = *(const LAS bf16x8*)(skl + key * 256 + (((2 * st + hh) ^ (key & 15)) * 16));
                        acc[kt] = __builtin_amdgcn_mfma_f32_32x32x16_bf16(ak, bq, acc[kt], 0, 0, 0); }
                }
                float v[64];
#pragma unroll
                for (int kt = 0; kt < 4; ++kt)
#pragma unroll
                    for (int r = 0; r < 16; ++r) { const int key = 32 * kt + (r & 3) + 8 * (r >> 2);
                        const float sc = acc[kt][r];
                        v[kt * 16 + r] = __builtin_bit_cast(float, (__builtin_bit_cast(unsigned, sc) & ~127u) | (unsigned)(key + 4 * hh)); }
                top16_of_64(v);
                float p[16];
#pragma unroll
                for (int i = 0; i < 16; ++i) { float lo_, hi_; SWAP_PAIR(__builtin_amdgcn_permlane32_swap, v[i], lo_, hi_); v[i] = lo_; p[i] = hi_; }
                top16_of_two(v, p);
#pragma unroll
                for (int i = 0; i < 16; ++i) { L[c][i] = v[i]; ktab[(c * 16 + i) * 64 + lane] = (int)(__builtin_bit_cast(unsigned, v[i]) & 127u); }
            }
            float cnd[16]; top16_staircase(L[0], L[1], cnd);
            float rstd; { const GAS f32x4* sp = (const GAS f32x4*)((const GAS float*)(ws + WS_SSQ) + row * 32); float ssq = 0.f;
#pragma unroll
              for (int i = 0; i < 8; ++i) { const f32x4 t4 = sp[i]; ssq += (t4.x + t4.y) + (t4.z + t4.w); }
              rstd = 1.0f / sqrtf(ssq * (1.f / DM) + EPS); }
            float mx = __builtin_bit_cast(float, __builtin_bit_cast(unsigned, cnd[0]) & ~255u), sum = 0.f; float ex[16];
#pragma unroll
            for (int i = 0; i < 16; ++i) { ex[i] = __expf((__builtin_bit_cast(float, __builtin_bit_cast(unsigned, cnd[i]) & ~255u) - mx) * rstd); sum += ex[i]; }
            const float inv = 1.f / sum;
            LDS_WAIT(); asm volatile("" ::: "memory");
            if (hh == 0) {
                int ev[16];
#pragma unroll
                for (int i = 0; i < 16; ++i) { const unsigned bits = 255u - (__builtin_bit_cast(unsigned, cnd[i]) & 255u); const int ia = (bits >> 4) & 15, jb = bits & 15; ev[i] = ktab[ia * 64 + lane] * 128 + ktab[(16 + jb) * 64 + lane]; }
                GAS int* ep = EIDX + row * 128 + h * 16; GAS float* gp = GATE + row * 128 + h * 16;
#pragma unroll
                for (int i = 0; i < 2; ++i) *(GAS i32x4*)(EIDX16 + row * 64 + h * 8 + 4 * i) = (i32x4){ev[8 * i] | (ev[8 * i + 1] << 16), ev[8 * i + 2] | (ev[8 * i + 3] << 16), ev[8 * i + 4] | (ev[8 * i + 5] << 16), ev[8 * i + 6] | (ev[8 * i + 7] << 16)};
#pragma unroll
                for (int i = 0; i < 4; ++i) { *(GAS i32x4*)(ep + 4 * i) = (i32x4){ev[4 * i], ev[4 * i + 1], ev[4 * i + 2], ev[4 * i + 3]}; *(GAS f32x4*)(gp + 4 * i) = (f32x4){ex[4 * i] * inv, ex[4 * i + 1] * inv, ex[4 * i + 2] * inv, ex[4 * i + 3] * inv}; }
            }
            LDS_WAIT(); asm volatile("" ::: "memory");
        }
    }
}

__device__ __forceinline__ void gla_prep_phase(Frame& F, const Args& a) {
    unsigned char* ws = a.ws; const bf16* PROJ;
    const int w = F.wave;
    LAS unsigned char* L = F.lds;
    LAS unsigned char* Qraw = L; LAS unsigned char* Kraw = L + 16384; LAS unsigned char* Vraw = L + 32768; LAS float* GDf = (LAS float*)(L + 65536); LAS float* GSUM = (LAS float*)(L + 73728);
    LAS unsigned char* IMGQ = L + 77824; LAS unsigned char* IMGK = L + 95232; LAS unsigned char* IMGE = L + 112640; LAS unsigned char* AMI = L + 32768;
    v4u rq[2], rk[2], rv[4]; f32x4 rg0, rg1;
#define PREP_LOAD(IT) do { const int b_ = (IT) >> 8, h_ = ((IT) >> 6) & 3, n_ = (IT) & 63; const size_t row0_ = (size_t)b_ * SEQ + n_ * 64; ws = opaque(ws); PROJ = (const bf16*)(ws + WS_PROJ); const int tid_ = opaque_v((F.wave * 64 + lane_id())); \
        _Pragma("unroll") for (int i = 0; i < 2; ++i) { const int idx = tid_ + 512 * i, r = idx >> 4, c = idx & 15; \
            rq[i] = *(const GAS v4u*)(PROJ + (row0_ + r) * NINP + O_GQ + h_ * 128 + c * 8); rk[i] = *(const GAS v4u*)(PROJ + (row0_ + r) * NINP + O_GK + h_ * 128 + c * 8); } \
        _Pragma("unroll") for (int i = 0; i < 4; ++i) { const int idx = tid_ + 512 * i, r = idx >> 5, c = idx & 31; rv[i] = *(const GAS v4u*)(PROJ + (row0_ + r) * NINP + O_GV + h_ * 256 + c * 8); } \
        if (tid_ < 256) { const int r = tid_ >> 2, c = tid_ & 3; const GAS float* gsrc = (const GAS float*)(ws + WS_GDB) + (row0_ + r) * 32 + c * 8; rg0 = *(const GAS f32x4*)gsrc; rg1 = *(const GAS f32x4*)(gsrc + 4); } } while (0)
#define PREP_STORE() do { const int tid_ = opaque_v((F.wave * 64 + lane_id())); \
        _Pragma("unroll") for (int i = 0; i < 2; ++i) { const int idx = tid_ + 512 * i, r = idx >> 4, c = idx & 15; *(LAS v4u*)(Qraw + r * 256 + c * 16) = rq[i]; *(LAS v4u*)(Kraw + r * 256 + c * 16) = rk[i]; } \
        _Pragma("unroll") for (int i = 0; i < 4; ++i) { const int idx = tid_ + 512 * i, r = idx >> 5, c = idx & 31; *(LAS v4u*)(Vraw + r * 512 + c * 16) = rv[i]; } \
        if (tid_ < 256) { const int r = tid_ >> 2, c = tid_ & 3; *(LAS f32x4*)(GDf + r * 32 + c * 8) = rg0; *(LAS f32x4*)(GDf + r * 32 + c * 8 + 4) = rg1; } } while (0)
    if (F.vcu < 1024) PREP_LOAD(F.vcu);
    float up0[16], up1[16], bias0 = 0.f, bias1 = 0.f; int hcur = -1;
    for (int it = F.vcu; it < 1024; it += F.G) {
        const int b = it >> 8, h = (it >> 6) & 3, n = it & 63;
        int tid = opaque_v((F.wave * 64 + lane_id())), lane = tid & 63, r32 = lane & 31, hh = lane >> 5;
        if (h != hcur) { hcur = h; const int d = tid & 127; const GAS float* u0 = (const GAS float*)a.in[3] + h * 128 + d; const GAS float* u1 = (const GAS float*)a.in[5] + h * 128 + d;
#pragma unroll
            for (int r = 0; r < 16; ++r) { up0[r] = u0[r * 512]; up1[r] = u1[r * 512]; }
            bias0 = ((const GAS float*)a.in[4])[h * 128 + d]; bias1 = ((const GAS float*)a.in[6])[h * 128 + d]; }
        PREP_STORE();
        __syncthreads();
        if (it + F.G < 1024) PREP_LOAD(it + F.G);
#pragma unroll
        for (int ks = 0; ks < 4; ++ks) { unsigned pk[4];
#pragma unroll
            for (int p = 0; p < 4; ++p) { const int s0 = 16 * ks + 8 * hh + 2 * p; const unsigned lo = *(const LAS unsigned short*)(Vraw + s0 * 512 + (32 * w + r32) * 2), hi = *(const LAS unsigned short*)(Vraw + (s0 + 1) * 512 + (32 * w + r32) * 2); pk[p] = lo | (hi << 16); }
            *(GAS v4u*)((unsigned char*)a.out + OUT_GT_VT + (size_t)it * 32768 + (w * 4 + ks) * 1024 + lane * 16) = (v4u){pk[0], pk[1], pk[2], pk[3]}; }
        for (int dir = 0; dir < 2; ++dir) {
            const size_t idir = (size_t)(((b * 4 + h) * 2 + dir) * 64 + n); ws = opaque(ws); tid = opaque_v(tid); lane = tid & 63; r32 = lane & 31; hh = lane >> 5;
            {
                const int d = tid & 127, tq = tid >> 7; const float bias = dir ? bias1 : bias0;
                float up[16];
#pragma unroll
                for (int r = 0; r < 16; ++r) up[r] = dir ? up1[r] : up0[r];
                float c[16];
#pragma unroll
                for (int i = 0; i < 16; ++i) { const LAS float* g = GDf + (16 * tq + i) * 32 + dir * 16; float z = bias;
#pragma unroll
                    for (int r = 0; r < 16; ++r) z += g[r] * up[r];
                    c[i] = (fminf(z, 0.f) - __logf(1.f + __expf(-fabsf(z)))) * (1.f / 16.f); }
                if (dir == 0) {
#pragma unroll
                    for (int i = 1; i < 16; ++i) c[i] += c[i - 1];
                } else {
#pragma unroll
                    for (int i = 14; i >= 0; --i) c[i] += c[i + 1];
                }
                GSUM[(dir * 4 + tq) * 128 + d] = dir == 0 ? c[15] : c[0];
                __syncthreads();
                const float t0 = GSUM[(dir * 4 + 0) * 128 + d], t1 = GSUM[(dir * 4 + 1) * 128 + d], t2 = GSUM[(dir * 4 + 2) * 128 + d], t3 = GSUM[(dir * 4 + 3) * 128 + d];
                const float Bt = (t0 + t1) + (t2 + t3);
                float off;
                if (dir == 0) off = (tq > 0 ? t0 : 0.f) + (tq > 1 ? t1 : 0.f) + (tq > 2 ? t2 : 0.f);
                else off = (tq < 1 ? t1 : 0.f) + (tq < 2 ? t2 : 0.f) + (tq < 3 ? t3 : 0.f);
                unsigned kep[8];
#pragma unroll
                for (int i = 0; i < 16; i += 2) { float ke2[2];
#pragma unroll
                    for (int q = 0; q < 2; ++q) { const int t = 16 * tq + i + q; const float bi = c[i + q] + off;
                        const float qv = bf2f(*(const LAS unsigned short*)(Qraw + t * 256 + d * 2)), kv = bf2f(*(const LAS unsigned short*)(Kraw + t * 256 + d * 2));
                        *(LAS unsigned short*)(IMGQ + t * 272 + d * 2) = (unsigned short)pk2(qv * 0.08838834764831845f * __expf(bi), 0.f);
                        *(LAS unsigned short*)(IMGK + t * 272 + d * 2) = (unsigned short)pk2(kv * __expf(-bi), 0.f);
                        ke2[q] = kv * __expf(Bt - bi); }
                    kep[i >> 1] = pk2(ke2[0], ke2[1]); }
                *(LAS v4u*)(IMGE + d * 144 + (16 * tq) * 2) = (v4u){kep[0], kep[1], kep[2], kep[3]};
                *(LAS v4u*)(IMGE + d * 144 + (16 * tq + 8) * 2) = (v4u){kep[4], kep[5], kep[6], kep[7]};
                if (tq == 0) ((GAS float*)((unsigned char*)a.out + OUT_GT_DEC))[idir * 128 + d] = __expf(Bt);
            }
            __syncthreads();
            if (w < 4) {
                const int si = w >> 1, ti = w & 1; f32x16 acc = (f32x16){0.f, 0.f, 0.f, 0.f, 0.f, 0.f, 0.f, 0.f, 0.f, 0.f, 0.f, 0.f, 0.f, 0.f, 0.f, 0.f};
#pragma unroll
                for (int ks = 0; ks < 8; ++ks) { const bf16x8 ak = *(const LAS bf16x8*)(IMGK + (32 * si + r32) * 272 + (16 * ks + 8 * hh) * 2), bq = *(const LAS bf16x8*)(IMGQ + (32 * ti + r32) * 272 + (16 * ks + 8 * hh) * 2);
                    acc = __builtin_amdgcn_mfma_f32_32x32x16_bf16(ak, bq, acc, 0, 0, 0); }
                const int t = 32 * ti + r32;
#pragma unroll
                for (int qd = 0; qd < 4; ++qd) { float v4[4];
#pragma unroll
                    for (int i = 0; i < 4; ++i) { const int sidx = 32 * si + 8 * qd + 4 * hh + i; const float x = acc[4 * qd + i]; const bool keep = dir == 0 ? (sidx <= t) : (sidx >= t); v4[i] = keep ? x : 0.f; }
                    *(LAS unsigned long long*)(AMI + t * 144 + (32 * si + 8 * qd + 4 * hh) * 2) = (unsigned long long)pk2(v4[0], v4[1]) | ((unsigned long long)pk2(v4[2], v4[3]) << 32); }
            } else {
                const int w4 = w - 4;
#pragma unroll
                for (int q = 0; q < 4; ++q) { const int bq = w4 * 4 + q, tt = bq >> 3, ks = bq & 7, j = ks >> 1, u = ks & 1; const int t = 32 * tt + r32;
                    const unsigned long long p0 = *(const LAS unsigned long long*)(IMGQ + t * 272 + (32 * j + 16 * u + 4 * hh) * 2), p1 = *(const LAS unsigned long long*)(IMGQ + t * 272 + (32 * j + 16 * u + 8 + 4 * hh) * 2);
                    *(GAS v4u*)(ws + WS_GT_QD + idir * 16384 + bq * 1024 + lane * 16) = (v4u){(unsigned)p0, (unsigned)(p0 >> 32), (unsigned)p1, (unsigned)(p1 >> 32)}; }
#pragma unroll
                for (int q = 0; q < 4; ++q) { const int bk = w4 * 4 + q, j = bk >> 2, ks = bk & 3; const int d = 32 * j + r32;
                    *(GAS v4u*)(ws + WS_GT_KE + idir * 16384 + bk * 1024 + lane * 16) = *(const LAS v4u*)(IMGE + d * 144 + (16 * ks + 8 * hh) * 2); }
            }
            __syncthreads();
            { const int tt = w >> 2, ks = w & 3; const int t = 32 * tt + r32;
              *(GAS v4u*)((unsigned char*)a.out + OUT_GT_AM + idir * 8192 + w * 1024 + lane * 16) = *(const LAS v4u*)(AMI + t * 144 + (16 * ks + 8 * hh) * 2); }
            __syncthreads();
        }
    }
#undef PREP_LOAD
#undef PREP_STORE
}

__device__ __forceinline__ void gla_seq_phase(Frame& F, const Args& a) {
    unsigned char* ws = a.ws;
    const int w = F.wave;
    constexpr int GBUF = 57856;
    const int bx_ = (int)blockIdx.x;
    const int su_ = (F.G % 8 == 0 && F.G >= 64) ? (((bx_ >> 3) < 8) ? (bx_ & 7) * 8 + (bx_ >> 3) : 64) : bx_;
    for (int unit = su_; unit < 64; unit += F.G) {
        const int dir = unit & 1, eh = (unit >> 1) & 1, bh = unit >> 2, b = bh >> 2, h = bh & 3;
        if (w >= 4) {
            const int lt = opaque_v((F.wave * 64 + lane_id())) - 256;
            v4u A[15], B[15];
#define GLA_LOAD(R, NS) do { const int n_ = dir ? 63 - (NS) : (NS); const size_t idir_ = (size_t)((bh * 2 + dir) * 64 + n_), iv_ = (size_t)(bh * 64 + n_); const unsigned char* o_ = opaque((const unsigned char*)a.out); const unsigned char* w_ = opaque(ws); \
            const GAS v4u* gq_ = (const GAS v4u*)(w_ + WS_GT_QD + idir_ * 16384); const GAS v4u* gk_ = (const GAS v4u*)(w_ + WS_GT_KE + idir_ * 16384); const GAS v4u* ga_ = (const GAS v4u*)(o_ + OUT_GT_AM + idir_ * 8192); \
            const GAS v4u* gv_ = (const GAS v4u*)(o_ + OUT_GT_VT + iv_ * 32768 + eh * 16384); const GAS v4u* gd_ = (const GAS v4u*)(o_ + OUT_GT_DEC + idir_ * 512); \
            _Pragma("unroll") for (int i = 0; i < 4; ++i) { R[i] = gq_[lt + 256 * i]; R[4 + i] = gk_[lt + 256 * i]; R[10 + i] = gv_[lt + 256 * i]; } R[8] = ga_[lt]; R[9] = ga_[lt + 256]; R[14] = gd_[lt & 31]; } while (0)
#define GLA_WRITE(R, BUF) do { LAS v4u* d_ = (LAS v4u*)(F.lds + (BUF) * GBUF); \
            _Pragma("unroll") for (int i = 0; i < 4; ++i) { d_[lt + 256 * i] = R[i]; d_[1024 + lt + 256 * i] = R[4 + i]; d_[2560 + lt + 256 * i] = R[10 + i]; } d_[2048 + lt] = R[8]; d_[2048 + lt + 256] = R[9]; if (lt < 32) d_[3584 + lt] = R[14]; } while (0)
            GLA_LOAD(A, 0); GLA_LOAD(B, 1);
            GLA_WRITE(A, 0);
            __syncthreads();
#pragma unroll 1
            for (int ns = 0; ns < 64; ns += 2) {
                if (ns + 2 < 64) GLA_LOAD(A, ns + 2);
                GLA_WRITE(B, 1);
                __syncthreads();
                if (ns + 3 < 64) GLA_LOAD(B, ns + 3);
                if (ns + 2 < 64) GLA_WRITE(A, 0);
                __syncthreads();
            }
#undef GLA_LOAD
#undef GLA_WRITE
        } else {
            f32x16 S[4];
#pragma unroll
            for (int j = 0; j < 4; ++j) S[j] = (f32x16){0.f, 0.f, 0.f, 0.f, 0.f, 0.f, 0.f, 0.f, 0.f, 0.f, 0.f, 0.f, 0.f, 0.f, 0.f, 0.f};
            __syncthreads();
#pragma unroll 1
            for (int ns = 0; ns < 64; ++ns) {
                const int n = dir ? 63 - ns : ns;
                const int lane = opaque_v(lane_id()), r32 = lane & 31, hh = lane >> 5;
                LAS unsigned char* QDl = F.lds + (ns & 1) * GBUF; LAS unsigned char* KEl = QDl + 16384; LAS unsigned char* AMl = QDl + 32768; LAS unsigned char* VTl = QDl + 40960; LAS float* DECl = (LAS float*)(QDl + 57344);
                GAS bf16* Out = (GAS bf16*)(opaque(ws) + (dir ? WS_OB : WS_OF));
                bf16x8 vf[4];
#pragma unroll
                for (int ks = 0; ks < 4; ++ks) vf[ks] = *(const LAS bf16x8*)(VTl + (w * 4 + ks) * 1024 + lane * 16);
                f32x16 o[2];
#pragma unroll
                for (int tt = 0; tt < 2; ++tt) o[tt] = (f32x16){0.f, 0.f, 0.f, 0.f, 0.f, 0.f, 0.f, 0.f, 0.f, 0.f, 0.f, 0.f, 0.f, 0.f, 0.f, 0.f};
#pragma unroll
                for (int ks8 = 0; ks8 < 8; ++ks8) { const int j = ks8 >> 1, u = ks8 & 1; v4u sb;
                    sb.x = pg8::cvt_pk_bf16(S[j][8 * u + 0], S[j][8 * u + 1]); sb.y = pg8::cvt_pk_bf16(S[j][8 * u + 2], S[j][8 * u + 3]); sb.z = pg8::cvt_pk_bf16(S[j][8 * u + 4], S[j][8 * u + 5]); sb.w = pg8::cvt_pk_bf16(S[j][8 * u + 6], S[j][8 * u + 7]);
                    const bf16x8 bs = __builtin_bit_cast(bf16x8, sb);
#pragma unroll
                    for (int tt = 0; tt < 2; ++tt) { const bf16x8 aq = *(const LAS bf16x8*)(QDl + (tt * 8 + ks8) * 1024 + lane * 16); o[tt] = __builtin_amdgcn_mfma_f32_32x32x16_bf16(aq, bs, o[tt], 0, 0, 0); } }
#pragma unroll
                for (int ks = 0; ks < 4; ++ks)
#pragma unroll
                    for (int tt = 0; tt < 2; ++tt) { const bf16x8 am = *(const LAS bf16x8*)(AMl + (tt * 4 + ks) * 1024 + lane * 16); o[tt] = __builtin_amdgcn_mfma_f32_32x32x16_bf16(am, vf[ks], o[tt], 0, 0, 0); }
#pragma unroll
                for (int tt = 0; tt < 2; ++tt)
#pragma unroll
                    for (int r = 0; r < 16; ++r) { const int t = 32 * tt + (r & 3) + 8 * (r >> 2) + 4 * hh; const float x = o[tt][r];
                        Out[((size_t)b * SEQ + 64 * n + t) * 1024 + h * 256 + 32 * (eh * 4 + w) + r32] = (bf16)pk2(x, 0.f); }
#pragma unroll
                for (int j = 0; j < 4; ++j) {
#pragma unroll
                    for (int q = 0; q < 4; ++q) { const f32x4 dv = *(const LAS f32x4*)(DECl + 32 * j + 8 * q + 4 * hh); S[j][4 * q + 0] *= dv.x; S[j][4 * q + 1] *= dv.y; S[j][4 * q + 2] *= dv.z; S[j][4 * q + 3] *= dv.w; }
#pragma unroll
                    for (int ks = 0; ks < 4; ++ks) { const bf16x8 ak = *(const LAS bf16x8*)(KEl + (j * 4 + ks) * 1024 + lane * 16); S[j] = __builtin_amdgcn_mfma_f32_32x32x16_bf16(ak, vf[ks], S[j], 0, 0, 0); } }
                __syncthreads();
            }
        }
    }
}

typedef short v4i16_t __attribute__((ext_vector_type(4)));
__device__ __forceinline__ void attn_phase(Frame& F, const Args& a, int qslot) {
    unsigned char* ws = a.ws; const bf16* PROJ;
    const int w = F.wave;
    volatile LAS int* uword = (volatile LAS int*)(F.lds + 2 * 78336);
    constexpr int NUNITS = 64 * 3 * 32;
#define ATT_DECODE(U) const int bh = (U) / 96, rem = (U) - bh * 96, p = rem >> 5, idx = rem & 31; const int lgd = 2 * p, d = 1 << lgd; \
        const int r = idx >> (5 - lgd), J = idx & ((32 >> lgd) - 1), Lc = SEQ >> lgd; const int b = bh >> 4, h = bh & 15; const int m0 = 128 * J - 64;
    v4u kx[4], vx[4]; v4u qw[2];
#define ATT_LOAD(U) do { ATT_DECODE(U) ws = opaque(ws); PROJ = (const bf16*)(ws + WS_PROJ); const int tid_ = opaque_v((F.wave * 64 + lane_id())); \
        _Pragma("unroll") for (int i = 0; i < 4; ++i) { const int kr = (tid_ >> 3) + 64 * i, ch = tid_ & 7; const int mp = m0 + kr; kx[i] = (v4u){0u, 0u, 0u, 0u}; vx[i] = kx[i]; \
            if (mp >= 0 && mp < Lc) { const bf16* src = PROJ + ((size_t)b * SEQ + r + d * mp) * NINP + O_AK + h * 64 + ch * 8; kx[i] = *(const GAS v4u*)src; vx[i] = *(const GAS v4u*)(src + (O_AV - O_AK)); } } \
        const int tokq_ = r + d * (128 * J + 16 * w + (tid_ & 15)); \
        _Pragma("unroll") for (int sft = 0; sft < 2; ++sft) qw[sft] = *(const GAS v4u*)(PROJ + ((size_t)b * SEQ + tokq_) * NINP + O_AQ + h * 64 + 32 * sft + 8 * ((tid_ & 63) >> 4)); } while (0)
    float tab[40];
    { const int l0 = opaque_v(lane_id());
#pragma unroll
      for (int c = 0; c < 40; ++c) { const int kb = c >> 3, uu = (c >> 2) & 1, rho = c & 3; const int jo = 32 * kb + 8 * (l0 >> 4) + 4 * uu + rho - 64 - (l0 & 15); const int aj = jo < 0 ? -jo : jo; tab[c] = aj <= 64 ? (float)aj : 3.0e38f; } }
#define ATT_FETCH(DST) do { int v_ = NUNITS; int qx_ = uword[2], qt_ = uword[3]; while (qt_ < 8) { const int t_ = (int)__hip_atomic_fetch_add((unsigned*)(F.ctl + CW_ATTQX + 128 * qslot + 16 * qx_), 1u, __ATOMIC_RELAXED, __HIP_MEMORY_SCOPE_AGENT); \
        if (t_ < 768) { v_ = qx_ * 768 + t_; break; } qx_ = (qx_ + 1) & 7; ++qt_; } uword[2] = qx_; uword[3] = qt_; DST = v_; } while (0)
    if ((F.wave * 64 + lane_id()) == 0) { uword[2] = (int)blockIdx.x & 7; uword[3] = 0; int f0, f1; ATT_FETCH(f0); ATT_FETCH(f1); uword[0] = f0; uword[1] = f1; }
    __syncthreads();
    int u = __builtin_amdgcn_readfirstlane(uword[0]), un = __builtin_amdgcn_readfirstlane(uword[1]); int par = 0;
#define ATT_WRITE(BUF) do { const int tid_ = opaque_v((F.wave * 64 + lane_id())); LAS unsigned char* Kw = F.lds + (BUF) * 78336; LAS unsigned char* Vw = Kw + 39168; \
        _Pragma("unroll") for (int i = 0; i < 4; ++i) { const int kr = (tid_ >> 3) + 64 * i, ch = tid_ & 7; *(LAS v4u*)(Kw + kr * 144 + ch * 16) = kx[i]; *(LAS v4u*)(Vw + kr * 144 + ch * 16) = vx[i]; } \
        if (tid_ < 128) { const int kr = 256 + (tid_ >> 3), ch = tid_ & 7; *(LAS v4u*)(Kw + kr * 144 + ch * 16) = (v4u){0u, 0u, 0u, 0u}; *(LAS v4u*)(Vw + kr * 144 + ch * 16) = (v4u){0u, 0u, 0u, 0u}; } } while (0)
    v4u qwc[2];
    if (u < NUNITS) { ATT_LOAD(u); ATT_WRITE(0); qwc[0] = qw[0]; qwc[1] = qw[1]; }
    __syncthreads();
    int bufi = 0;
    while (u < NUNITS) {
        const int tid = opaque_v((F.wave * 64 + lane_id())), lane = tid & 63, q16 = lane & 15, g = lane >> 4;
        int qnext = 0; if (tid == 0) ATT_FETCH(qnext);
        LAS unsigned char* Kl = F.lds + bufi * 78336; LAS unsigned char* Vl = Kl + 39168;
        bf16x8 qf[2];
#pragma unroll
        for (int sft = 0; sft < 2; ++sft) { v4u qs; constexpr float QS = 0.125f * 1.4426950408889634f; qs.x = pk2(bflo(qwc[sft].x) * QS, bfhi(qwc[sft].x) * QS); qs.y = pk2(bflo(qwc[sft].y) * QS, bfhi(qwc[sft].y) * QS); qs.z = pk2(bflo(qwc[sft].z) * QS, bfhi(qwc[sft].z) * QS); qs.w = pk2(bflo(qwc[sft].w) * QS, bfhi(qwc[sft].w) * QS);
            qf[sft] = __builtin_bit_cast(bf16x8, qs); }
        ATT_DECODE(u)
        const int tokq = r + d * (128 * J + 16 * w + q16);
        if (un < NUNITS) ATT_LOAD(un);
        const float nslope = -exp2f(-0.5f * (float)(h + 1)) * (float)d * 1.4426950408889634f;
        const bool inrange = (m0 + 16 * w >= 0) && (m0 + 16 * w + 159 < Lc);
        float sv[5][2][4]; float mx = -3.0e38f;
#pragma unroll
        for (int kb = 0; kb < 5; ++kb)
#pragma unroll
            for (int uu = 0; uu < 2; ++uu) { f32x4 acc = (f32x4){0.f, 0.f, 0.f, 0.f};
                const int krow = 16 * w + 32 * kb + 8 * (q16 >> 2) + 4 * uu + (q16 & 3);
#pragma unroll
                for (int sft = 0; sft < 2; ++sft) { const bf16x8 ak = *(const LAS bf16x8*)(Kl + krow * 144 + (32 * sft + 8 * g) * 2); acc = __builtin_amdgcn_mfma_f32_16x16x32_bf16(ak, qf[sft], acc, 0, 0, 0); }
#pragma unroll
                for (int rho = 0; rho < 4; ++rho) { const float x = acc[rho]; sv[kb][uu][rho] = __builtin_fmaf(nslope, tab[kb * 8 + uu * 4 + rho], x); } }
        if (!inrange) {
#pragma unroll
            for (int kb = 0; kb < 5; ++kb)
#pragma unroll
                for (int uu = 0; uu < 2; ++uu)
#pragma unroll
                    for (int rho = 0; rho < 4; ++rho) { const int mp = m0 + 16 * w + 32 * kb + 8 * g + 4 * uu + rho; if (mp < 0 || mp >= Lc) sv[kb][uu][rho] = -3.0e38f; } }
#pragma unroll
        for (int kb = 0; kb < 5; ++kb)
#pragma unroll
            for (int uu = 0; uu < 2; ++uu)
#pragma unroll
                for (int rho = 0; rho < 4; ++rho) mx = fmaxf(mx, sv[kb][uu][rho]);
        mx = xrow_max(mx);
        float lsum = 0.f; bf16x8 pf[5];
#pragma unroll
        for (int kb = 0; kb < 5; ++kb) { float e[8];
#pragma unroll
            for (int uu = 0; uu < 2; ++uu)
#pragma unroll
                for (int rho = 0; rho < 4; ++rho) { const float pe = __builtin_amdgcn_exp2f(sv[kb][uu][rho] - mx); e[uu * 4 + rho] = pe; lsum += pe; }
            v4u pw; pw.x = pk2(e[0], e[1]); pw.y = pk2(e[2], e[3]); pw.z = pk2(e[4], e[5]); pw.w = pk2(e[6], e[7]); pf[kb] = __builtin_bit_cast(bf16x8, pw); }
        lsum = xrow_sum(lsum);
        f32x4 oT[4];
#pragma unroll
        for (int nn = 0; nn < 4; ++nn) oT[nn] = (f32x4){0.f, 0.f, 0.f, 0.f};
#pragma unroll
        for (int kb = 0; kb < 5; ++kb)
#pragma unroll
            for (int nn = 0; nn < 4; ++nn) { const LAS unsigned char* va = Vl + (16 * w + 32 * kb + 8 * g + (q16 >> 2)) * 144 + (16 * nn + 4 * (q16 & 3)) * 2;
                const v4i16_t lo = __builtin_amdgcn_ds_read_tr16_b64_v4i16((LAS v4i16_t*)va), hi = __builtin_amdgcn_ds_read_tr16_b64_v4i16((LAS v4i16_t*)(va + 4 * 144));
                const bf16x8 vf = (bf16x8){lo[0], lo[1], lo[2], lo[3], hi[0], hi[1], hi[2], hi[3]};
                oT[nn] = __builtin_amdgcn_mfma_f32_16x16x32_bf16(vf, pf[kb], oT[nn], 0, 0, 0); }
        { const size_t rec = ((size_t)p * M + (size_t)b * SEQ + tokq) * 16 + h; GAS bf16* op = (GAS bf16*)(opaque(ws) + WS_ATTP) + rec * 64 + 4 * g;
#pragma unroll
          for (int nn = 0; nn < 4; ++nn) *(GAS unsigned long long*)(op + 16 * nn) = (unsigned long long)pk2(oT[nn][0], oT[nn][1]) | ((unsigned long long)pk2(oT[nn][2], oT[nn][3]) << 32);
          if (g == 0) { GAS float* ml = (GAS float*)(opaque(ws) + WS_ATTML) + rec * 2; ml[0] = mx * 0.6931471805599453f; ml[1] = lsum; } }
        if (un < NUNITS) { ATT_WRITE(bufi ^ 1); qwc[0] = qw[0]; qwc[1] = qw[1]; }
        if (tid == 0) uword[par] = qnext;
        __syncthreads();
        u = un; un = __builtin_amdgcn_readfirstlane(uword[par]); par ^= 1; bufi ^= 1;
    }
#undef ATT_WRITE
#undef ATT_DECODE
#undef ATT_LOAD
#undef ATT_FETCH
}

typedef __bf16 bf16x2_t __attribute__((ext_vector_type(2)));
__device__ __forceinline__ void peer_convert_tables(Frame& F, const Args& a, int qslot) {
    unsigned char* ws = a.ws; const int lane = lane_id(); volatile LAS int* uword = (volatile LAS int*)(F.lds + 2 * 78336 + 64);
    for (;;) {
        __syncthreads();
        if ((F.wave * 64 + lane_id()) == 0) uword[0] = (int)__hip_atomic_fetch_add((unsigned*)(F.ctl + CW_CONVQ + 64 * qslot), 1u, __ATOMIC_RELAXED, __HIP_MEMORY_SCOPE_AGENT);
        __syncthreads();
        const int blk = __builtin_amdgcn_readfirstlane(uword[0]);
        if (blk >= 2 * PEER_E / 128) break;
        const int rbase = blk * 128 + F.wave * 16; const bool isv = rbase >= PEER_E; const int e0 = rbase & (PEER_E - 1);
        const GAS float* src = (const GAS float*)(isv ? a.in[14] : a.in[13]) + (size_t)e0 * DM + 4 * lane;
        GAS unsigned char* dst = (GAS unsigned char*)a.out + (isv ? OUT_V8 : OUT_U8) + (size_t)e0 * 256 + 4 * lane;     GAS float* sc = (GAS float*)(ws + (isv ? WS_SV : WS_SU)) + e0;
        f32x4 v[8], vn[8];
#pragma unroll
        for (int j = 0; j < 8; ++j) v[j] = *(const GAS f32x4*)(src + 256 * j);
#pragma unroll 1
        for (int i = 0; i < 16; ++i) { const int in_ = i + 1 < 16 ? i + 1 : i;
#pragma unroll
            for (int j = 0; j < 8; ++j) vn[j] = *(const GAS f32x4*)(src + (size_t)in_ * DM + 256 * j);
            float am = 0.f;
#pragma unroll
            for (int j = 0; j < 8; ++j) am = fmaxf(am, fmaxf(fmaxf(fabsf(v[j].x), fabsf(v[j].y)), fmaxf(fabsf(v[j].z), fabsf(v[j].w))));
            am = wave_max(am); am = fmaxf(am, 1e-30f);
            const float inv = 440.f / am;
#pragma unroll
            for (int j = 0; j < 8; ++j) { int p = __builtin_amdgcn_cvt_pk_fp8_f32(v[j].x * inv, v[j].y * inv, 0, false); p = __builtin_amdgcn_cvt_pk_fp8_f32(v[j].z * inv, v[j].w * inv, p, true);
                *(GAS int*)(dst + (size_t)i * 256 + (size_t)j * (PEER_E * 256)) = p; }
            if (lane == 0) sc[i] = am * (1.f / 440.f);
#pragma unroll
            for (int j = 0; j < 8; ++j) v[j] = vn[j]; }
    }
}

__device__ __forceinline__ float dpp_row_sum(float x) {
#define PEER_DPP(ctrl) x += __builtin_bit_cast(float, __builtin_amdgcn_update_dpp(0, __builtin_bit_cast(int, x), ctrl, 0xF, 0xF, false))
    PEER_DPP(0xB1); PEER_DPP(0x4E); PEER_DPP(0x141); PEER_DPP(0x140);
#undef PEER_DPP
    return x;
}
template <bool VPH, int PBS, bool LA> __device__ __forceinline__ void peer_uv_phase(Frame& F, const Args& a) {
    unsigned char* ws = a.ws; GAS bf16* H = (GAS bf16*)(ws + WS_HB); const GAS float* g2 = (const GAS float*)a.in[10];
    const int sl = blockIdx.x & 7, rk = blockIdx.x >> 3, nrk = F.G >> 3, tpw = M / nrk / NWAVES, nq = tpw / 4;
    const unsigned char* TAB; const GAS int* EIDX; const GAS float* SSQ; const GAS float* PW; GAS float* PD; GAS float* SSQ2;
    LAS int* idt = (LAS int*)(F.lds + F.wave * 8704);
    LAS float* wt = (LAS float*)(F.lds + F.wave * 8704 + 4352);
    const int t0 = (rk * NWAVES + F.wave) * tpw;
#define PEER_STAGE_LOAD(QI) do { const size_t tb_ = (size_t)(t0 + 4 * (QI) + a4) * 64; _Pragma("unroll") for (int k = 0; k < 4; ++k) sid[k] = EIDX[tb_ + 16 * k + q]; } while (0)
#define PEER_STAGE_WRITE(QI) do { const int bf_ = ((QI) & 1) * 528; _Pragma("unroll") for (int k = 0; k < 4; ++k) *(LAS i32x2*)(idt + bf_ + a4 * 132 + 32 * k + 2 * q) = (i32x2){sid[k] & 0xffff, (int)((unsigned)sid[k] >> 16)}; } while (0)
#define PEER_STAGE_W(QI) do { if (VPH) { const size_t tb_ = (size_t)(t0 + 4 * (QI) + a4) * 128; const int bf_ = ((QI) & 1) * 528; _Pragma("unroll") for (int k = 0; k < 8; ++k) wt[bf_ + a4 * 132 + 16 * k + q] = PW[tb_ + 16 * k + q]; LDS_WAIT(); asm volatile("" ::: "memory"); } } while (0)
#define PEER_ISSUE(R, QI, WB) do { const int bf_ = ((QI) & 1) * 528 + a4 * 132 + (WB) * PBS; i32x4 e4_; _Pragma("unroll") for (int j = 0; j < PBS; ++j) { if ((j & 3) == 0) e4_ = *(const LAS i32x4*)(idt + bf_ + j); const int e_ = (j & 3) == 0 ? e4_.x : (j & 3) == 1 ? e4_.y : (j & 3) == 2 ? e4_.z : e4_.w; R[j] = ldu<i32x4>(TAB, (unsigned)e_ * 256u + (unsigned)(16 * q)); } } while (0)
    unsigned xq[8]; float acc[16];
#define PEER_QUAD_BEGIN(QI) do { const size_t t_ = (size_t)(t0 + 4 * (QI) + a4); \
        if (!VPH) { f32x4 hq[4]; { const v4u h0_ = *(const GAS v4u*)(H + t_ * DM + 256 * sl + 16 * q), h1_ = *(const GAS v4u*)(H + t_ * DM + 256 * sl + 16 * q + 8); \
            hq[0] = (f32x4){bflo(h0_.x), bfhi(h0_.x), bflo(h0_.y), bfhi(h0_.y)}; hq[1] = (f32x4){bflo(h0_.z), bfhi(h0_.z), bflo(h0_.w), bfhi(h0_.w)}; hq[2] = (f32x4){bflo(h1_.x), bfhi(h1_.x), bflo(h1_.y), bfhi(h1_.y)}; hq[3] = (f32x4){bflo(h1_.z), bfhi(h1_.z), bflo(h1_.w), bfhi(h1_.w)}; }  const float pss_ = dpp_row_sum(SSQ[t_ * 32 + q] + SSQ[t_ * 32 + 16 + q]); const float rstd_ = 1.f / sqrtf(pss_ * (1.f / DM) + EPS); f32x4 gv[4]; \
            _Pragma("unroll") for (int k = 0; k < 4; ++k) gv[k] = *(const GAS f32x4*)(g2 + 256 * sl + 16 * q + 4 * k); \
            _Pragma("unroll") for (int k = 0; k < 4; ++k) { xq[2 * k] = pk2(hq[k].x * rstd_ * gv[k].x, hq[k].y * rstd_ * gv[k].y); xq[2 * k + 1] = pk2(hq[k].z * rstd_ * gv[k].z, hq[k].w * rstd_ * gv[k].w); } } \
        else { _Pragma("unroll") for (int k = 0; k < 16; ++k) acc[k] = 0.f; } } while (0)
#define PEER_COMPUTE(R, QI, WB) do { if (!VPH) { float pdb_ = 0.f; _Pragma("unroll") for (int j = 0; j < PBS; ++j) { float d_ = 0.f; _Pragma("unroll") for (int k = 0; k < 4; ++k) { const int dw_ = R[j][k]; \
                d_ = __builtin_amdgcn_fdot2_f32_bf16(__builtin_amdgcn_cvt_scalef32_pk_bf16_fp8(dw_, 1.0f, false), __builtin_bit_cast(bf16x2_t, xq[2 * k]), d_, false); \
                d_ = __builtin_amdgcn_fdot2_f32_bf16(__builtin_amdgcn_cvt_scalef32_pk_bf16_fp8(dw_, 1.0f, true), __builtin_bit_cast(bf16x2_t, xq[2 * k + 1]), d_, false); } \
                d_ = dpp_row_sum(d_); pdb_ = (q == j) ? d_ : pdb_; } \
            if (q < PBS) PD[((size_t)(t0 + 4 * (QI) + a4) * 8 + sl) * 128 + PBS * (WB) + q] = pdb_; } \
        else { const int bf_ = ((QI) & 1) * 528 + a4 * 132 + (WB) * PBS; f32x4 w4_; _Pragma("unroll") for (int j = 0; j < PBS; ++j) { if ((j & 3) == 0) w4_ = *(const LAS f32x4*)(wt + bf_ + j); const float w_ = (j & 3) == 0 ? w4_.x : (j & 3) == 1 ? w4_.y : (j & 3) == 2 ? w4_.z : w4_.w; int r0_ = R[j][0], r1_ = R[j][1], r2_ = R[j][2], r3_ = R[j][3]; asm volatile("" : "+v"(r0_), "+v"(r1_), "+v"(r2_), "+v"(r3_));     \
                _Pragma("unroll") for (int k = 0; k < 4; ++k) { const int dw_ = k == 0 ? r0_ : k == 1 ? r1_ : k == 2 ? r2_ : r3_; \
                const f32x2 lo_ = __builtin_amdgcn_cvt_pk_f32_fp8(dw_, false), hi_ = __builtin_amdgcn_cvt_pk_f32_fp8(dw_, true); \
                acc[4 * k + 0] += w_ * lo_.x; acc[4 * k + 1] += w_ * lo_.y; acc[4 * k + 2] += w_ * hi_.x; acc[4 * k + 3] += w_ * hi_.y; } } } } while (0)
#define PEER_QUAD_END(QI) do { if (VPH) { const size_t t_ = (size_t)(t0 + 4 * (QI) + a4); GAS bf16* hp_ = H + t_ * DM + 256 * sl + 16 * q; const v4u h0_ = *(const GAS v4u*)hp_, h1_ = *(const GAS v4u*)(hp_ + 8); \
            float y_[16]; y_[0] = bflo(h0_.x); y_[1] = bfhi(h0_.x); y_[2] = bflo(h0_.y); y_[3] = bfhi(h0_.y); y_[4] = bflo(h0_.z); y_[5] = bfhi(h0_.z); y_[6] = bflo(h0_.w); y_[7] = bfhi(h0_.w); \
            y_[8] = bflo(h1_.x); y_[9] = bfhi(h1_.x); y_[10] = bflo(h1_.y); y_[11] = bfhi(h1_.y); y_[12] = bflo(h1_.z); y_[13] = bfhi(h1_.z); y_[14] = bflo(h1_.w); y_[15] = bfhi(h1_.w); \
            float ss_ = 0.f; _Pragma("unroll") for (int k = 0; k < 16; ++k) { y_[k] += acc[k]; ss_ += y_[k] * y_[k]; } \
            *(GAS v4u*)hp_ = (v4u){pk2(y_[0], y_[1]), pk2(y_[2], y_[3]), pk2(y_[4], y_[5]), pk2(y_[6], y_[7])}; *(GAS v4u*)(hp_ + 8) = (v4u){pk2(y_[8], y_[9]), pk2(y_[10], y_[11]), pk2(y_[12], y_[13]), pk2(y_[14], y_[15])}; \
            ss_ = dpp_row_sum(ss_); if (q == 0) SSQ2[t_ * 8 + sl] = ss_; } } while (0)
#pragma unroll 1
    for (int qi = 0; qi < nq; ++qi) {
        i32x4 rA[PBS], rB[PBS];
        const int lane = opaque_v(lane_id()), a4 = lane >> 4, q = lane & 15; ws = opaque(ws); H = (GAS bf16*)(ws + WS_HB);
        TAB = opaque((const unsigned char*)a.out) + (VPH ? OUT_V8 : OUT_U8) + (size_t)sl * (PEER_E * 256); EIDX = (const GAS int*)(ws + WS_EIDX16); SSQ = (const GAS float*)(ws + WS_SSQ); PW = (const GAS float*)(ws + WS_PW); PD = (GAS float*)(ws + WS_PD); SSQ2 = (GAS float*)(ws + WS_SSQ2);
        int sid[4];
        if (!LA || qi == 0) { PEER_STAGE_LOAD(qi); PEER_STAGE_WRITE(qi); LDS_WAIT(); asm volatile("" ::: "memory"); }
        PEER_ISSUE(rA, qi, 0);
        PEER_ISSUE(rB, qi, 1);
        if (LA && qi + 1 < nq) PEER_STAGE_LOAD(qi + 1);
        PEER_STAGE_W(qi);
        PEER_QUAD_BEGIN(qi);
#pragma unroll
        for (int wb = 0; wb < 128 / PBS; wb += 2) {
            PEER_COMPUTE(rA, qi, wb); if (wb + 2 < 128 / PBS) { PEER_ISSUE(rA, qi, wb + 2); }
            PEER_COMPUTE(rB, qi, wb + 1); if (wb + 3 < 128 / PBS) { PEER_ISSUE(rB, qi, wb + 3); }
        }
        PEER_QUAD_END(qi);
        if (LA && qi + 1 < nq) { PEER_STAGE_WRITE(qi + 1); LDS_WAIT(); asm volatile("" ::: "memory"); }
    }
#undef PEER_STAGE_LOAD
#undef PEER_STAGE_WRITE
#undef PEER_STAGE_W
#undef PEER_ISSUE
#undef PEER_QUAD_BEGIN
#undef PEER_COMPUTE
#undef PEER_QUAD_END
}
__device__ __forceinline__ void peer_w_phase(Frame& F, const Args& a) {
    unsigned char* ws = a.ws; const float* PD = (const float*)(ws + WS_PD); const int* EIDX = (const int*)(ws + WS_EIDX); const float* GATE = (const float*)(ws + WS_GATE);
    const float* SU = (const float*)(ws + WS_SU); const float* SV = (const float*)(ws + WS_SV); float* PW = (float*)(ws + WS_PW);
    for (int i = F.vcu * 512 + (F.wave * 64 + lane_id()); i < M * 128; i += F.G * 512) { const int t = i >> 7, p = i & 127; float d = 0.f;
#pragma unroll
        for (int sl = 0; sl < 8; ++sl) d += PD[((size_t)t * 8 + sl) * 128 + p];
        const int e = EIDX[i]; d *= SU[e];
        PW[i] = GATE[i] * 0.5f * d * (1.f + erff(d * 0.70710678118654752f)) * SV[e]; }
}
__device__ __forceinline__ void peer_n_phase(Frame& F, const Args& a) {
    unsigned char* ws = a.ws; const GAS bf16* Y = (const GAS bf16*)(ws + WS_HB); GAS float* O = (GAS float*)a.out; const GAS float* gf = (const GAS float*)a.in[15]; const GAS float* SSQ2 = (const GAS float*)(ws + WS_SSQ2); const int lane = lane_id();
    f32x4 g0[4], g1[4];
#pragma unroll
    for (int j = 0; j < 4; ++j) { g0[j] = *(const GAS f32x4*)(gf + 512 * j + 8 * lane); g1[j] = *(const GAS f32x4*)(gf + 512 * j + 8 * lane + 4); }
    const int gw = F.vcu * NWAVES + F.wave, NGW = F.G * NWAVES;
    v4u yw[4], yn[4]; f32x4 s0, s1, n0, n1;
    if (gw < M) {
#pragma unroll
        for (int j = 0; j < 4; ++j) yw[j] = *(const GAS v4u*)(Y + (size_t)gw * DM + 512 * j + 8 * lane);
        s0 = *(const GAS f32x4*)(SSQ2 + (size_t)gw * 8); s1 = *(const GAS f32x4*)(SSQ2 + (size_t)gw * 8 + 4); }
    for (int m = gw; m < M; m += NGW) { const int mn = m + NGW < M ? m + NGW : m;
#pragma unroll
        for (int j = 0; j < 4; ++j) yn[j] = *(const GAS v4u*)(Y + (size_t)mn * DM + 512 * j + 8 * lane);
        n0 = *(const GAS f32x4*)(SSQ2 + (size_t)mn * 8); n1 = *(const GAS f32x4*)(SSQ2 + (size_t)mn * 8 + 4);
        const float rf = 1.f / sqrtf((((s0.x + s0.y) + (s0.z + s0.w)) + ((s1.x + s1.y) + (s1.z + s1.w))) * (1.f / DM) + EPS);
#pragma unroll
        for (int j = 0; j < 4; ++j) {
            *(GAS f32x4*)(O + (size_t)m * DM + 512 * j + 8 * lane) = (f32x4){bflo(yw[j].x) * rf * g0[j].x, bfhi(yw[j].x) * rf * g0[j].y, bflo(yw[j].y) * rf * g0[j].z, bfhi(yw[j].y) * rf * g0[j].w};
            *(GAS f32x4*)(O + (size_t)m * DM + 512 * j + 8 * lane + 4) = (f32x4){bflo(yw[j].z) * rf * g1[j].x, bfhi(yw[j].z) * rf * g1[j].y, bflo(yw[j].w) * rf * g1[j].z, bfhi(yw[j].w) * rf * g1[j].w}; }
#pragma unroll
        for (int j = 0; j < 4; ++j) yw[j] = yn[j];
        s0 = n0; s1 = n1; }
}

__global__ void __launch_bounds__(NWAVES * 64, 2) mk_fwd(Args args_in) {
    extern __shared__ __attribute__((aligned(16))) unsigned char lds[];
    Args args = args_in;
#pragma unroll
    for (int i = 0; i < 16; ++i) args.in[i] = (const float*)(const GAS float*)args_in.in[i];
    args.out = (float*)(GAS float*)args_in.out; args.ws = (unsigned char*)(GAS unsigned char*)args_in.ws;
    Frame F;
    F.lds = (LAS unsigned char*)lds;
    F.MISC = (volatile LAS unsigned*)(F.lds + MISC_OFF);
    F.wave = __builtin_amdgcn_readfirstlane((int)threadIdx.x >> 6);
    F.G = gridDim.x; { const int bx = blockIdx.x; F.vcu = (F.G % 8 == 0) ? (bx % 8) * (F.G / 8) + bx / 8 : bx; }
    unsigned char* ws = args.ws;
    F.ctl = (gu32*)(ws + WS_CTL);
    for (int u = (F.wave * 64 + lane_id()); u < (LDS_BYTES - LDSCTL_OFF) / 4; u += NWAVES * 64) ((LAS unsigned*)(F.lds + LDSCTL_OFF))[u] = 0u;
    __syncthreads();
    XcdBarrier bar = xcd_barrier_post((unsigned*)(F.ctl + CW_BAR) + args.li * XCD_BAR_WORDS, F.MISC + 8);
    const int lo = args.ph_lo, hi = args.ph_hi;
#define IN(k) (lo <= (k) && (k) < hi)
#define BOTH(k) (IN(k) && IN((k) + 1))
#define GRID_BAR() xcd_barrier(bar)

    if (IN(0)) { for (int rep = 0; rep < NREP(0); ++rep) p0_prologue(F, args); if (BOTH(0)) GRID_BAR(); }

    if (IN(1)) {
        pg8::Gemm g{(const bf16*)(ws + WS_XN), (const bf16*)(ws + WS_WIN), M, NINP, DM}; pg8::StaticOrder S; S.init(M, NINP, F.G, (int)blockIdx.x);
        pg8::EpiBf16S E{(pg8::bf16_t*)(ws + WS_PROJ), NINP, F.lds + pg8::EPI_STAGE_OFF};
        for (int rep = 0; rep < NREP(1); ++rep) pg8::gemm_phase<pg8::EpiBf16S, pg8::StaticOrder, PG8_ALIGN, PG8_SP2>(F.lds + RING_OFF, g, S, E);
        for (int rep = 0; rep < NREP(11); ++rep) gd_side_gemm(F, args);
        if (BOTH(1)) GRID_BAR();
    }
    if (IN(2)) {
        for (int rep = 0; rep < NREP(21); ++rep) gla_prep_phase(F, args);
        GRID_BAR();
        for (int rep = 0; rep < NREP(2); ++rep) gla_seq_phase(F, args);
        const bool conv_first = ((int)blockIdx.x >> 3) >= CONV_FIRST_RANK;
        for (int pass = 0; pass < 2; ++pass) {
            if (pass == 1 || conv_first) peer_convert_tables(F, args, 0);
            if (pass == 0) attn_phase(F, args, 0); }
        if (BOTH(2)) GRID_BAR(); }
    if (IN(3)) { for (int rep = 0; rep < NREP(3); ++rep) p3_finalize(F, args); if (BOTH(3)) GRID_BAR(); if (REP_PHASE == 99) { GRID_BAR(); GRID_BAR(); GRID_BAR(); GRID_BAR(); } }
    if (IN(4)) {
        pg8::Gemm g{(const bf16*)(ws + WS_XN), (const bf16*)(ws + WS_WOUT), M, DM, DM}; pg8::StaticOrder S; S.init(M, DM, F.G, (int)blockIdx.x);
        pg8::EpiResS E{args.in[0], (pg8::bf16_t*)(ws + WS_HB), (float*)(ws + WS_SSQ), DM, F.lds + pg8::EPI_STAGE_OFF};
        for (int rep = 0; rep < NREP(4); ++rep) pg8::gemm_phase<pg8::EpiResS, pg8::StaticOrder, PG8_ALIGN, PG8_SP2>(F.lds + RING_OFF, g, S, E);
        if (BOTH(4)) GRID_BAR();
    }
    if (IN(5)) {
        pg8::Gemm g{(const bf16*)(ws + WS_HB), (const bf16*)(ws + WS_WQ), M, DM, DM}; pg8::StaticOrder S; S.init(M, DM, F.G, (int)blockIdx.x);
        pg8::EpiBf16S E{(pg8::bf16_t*)(ws + WS_XN), DM, F.lds + pg8::EPI_STAGE_OFF};
        for (int rep = 0; rep < NREP(5); ++rep) pg8::gemm_phase<pg8::EpiBf16S, pg8::StaticOrder, PG8_ALIGN, PG8_SP2>(F.lds + RING_OFF, g, S, E);
        if (BOTH(5)) GRID_BAR();
    }
    if (IN(6)) { for (int rep = 0; rep < NREP(6); ++rep) topk_phase(F, args); if (BOTH(6)) GRID_BAR(); }
    if (IN(7)) {
        for (int rep = 0; rep < NREP(7); ++rep) peer_uv_phase<false, 16, true>(F, args);
        GRID_BAR();
        peer_w_phase(F, args);
        GRID_BAR();
        if (REP_PHASE != 8) peer_uv_phase<true, 8, true>(F, args);
        GRID_BAR();
        peer_n_phase(F, args);
    }
#undef IN
#undef BOTH
}


extern "C" void kernel_launch(void* const* d_in, const int* in_sizes, int n_in, void* d_out, int out_size, void* d_ws, size_t ws_size, hipStream_t stream) {
    static int grid = 0;
    if (grid == 0) {
        if (n_in != 16 || in_sizes[0] != M * DM || out_size != M * DM || ws_size < WS_END) { fprintf(stderr, "kernel_launch: unexpected shapes: n_in %d in0 %d out %d ws %zu\n", n_in, n_in > 0 ? in_sizes[0] : -1, out_size, ws_size); grid = -1; return; }
        int dev = 0, cus = 0;
        if (hipGetDevice(&dev) != hipSuccess || hipDeviceGetAttribute(&cus, hipDeviceAttributeMultiprocessorCount, dev) != hipSuccess) { grid = -1; return; }
        if (hipFuncSetAttribute((const void*)mk_fwd, hipFuncAttributeMaxDynamicSharedMemorySize, LDS_BYTES) != hipSuccess) { fprintf(stderr, "kernel_launch: hipFuncSetAttribute failed\n"); grid = -1; return; }
        (void)hipGetLastError();
        grid = cus;
    }
    if (grid < 0) return;
    (void)hipMemsetAsync((char*)d_ws + WS_CTL, 0, CTL_ZERO_BYTES, stream);
    Args a{};
    for (int i = 0; i < 16; ++i) a.in[i] = (const float*)d_in[i];
    a.out = (float*)d_out; a.ws = (unsigned char*)d_ws;
    a.ph_lo = 0; a.ph_hi = 8; a.li = 0;
    hipLaunchKernelGGL(mk_fwd, dim3(grid), dim3(NWAVES * 64), LDS_BYTES, stream, a);
}
```

```cpp
#define REP_PHASE -1
#define PG8_ALIGN false
#include <hip/hip_runtime.h>
#include <cstdio>
#include <cstdint>
#include <cmath>
#ifndef REP_PHASE
#define REP_PHASE -1
#endif
#define NREP(k) ((REP_PHASE == (k)) ? 2 : 1)
namespace pg8 {
#define PG8_LAS __attribute__((address_space(3)))
typedef unsigned short bf16_t;
typedef short bf16x8 __attribute__((ext_vector_type(8)));
typedef float f32x4 __attribute__((ext_vector_type(4)));
typedef unsigned u32x4 __attribute__((ext_vector_type(4)));
constexpr int BM = 256, BK = 64, HALF = 128, HTB = HALF * BK * 2  , STAGE_BYTES = 8 * HTB, NXCD = 8, WGM = 8;

__host__ __device__ __forceinline__ int lds_byte(int r, int c) { const int st = (r >> 4) * 2 + (c >> 5), rr = r & 15, cc = c & 31, ob = rr * 64 + cc * 2; return st * 1024 + (ob ^ (((ob >> 9) & 1) << 5)); }
__host__ __device__ __forceinline__ void stage_rc(int b, int& R, int& C) { const int st = b / 1024, sb = b % 1024, swz = sb ^ (((sb >> 9) & 1) << 5); R = (st >> 1) * 16 + swz / 64; C = (st & 1) * 32 + (swz % 64) / 2; }
__host__ __device__ __forceinline__ int perm32(int rho) { const int n = rho >> 4, i = rho & 15; return 8 * (i >> 2) + 4 * n + (i & 3); }

struct Unit { int pm, pn; };
struct Gemm { const bf16_t* A; const bf16_t* Bt; int M, N, K; };

struct StaticOrder {
    int nM, nN, nwg, G, c;
    __host__ __device__ void init(int M, int N, int G_, int c_) { nM = M / BM; nN = N / BM; nwg = nM * nN; G = G_; c = c_; }
    __host__ __device__ bool next(int i, Unit& u) const {
        const long L = (long)i * G + c; if (L >= nwg) return false;
        int wgid = (int)L; { const int q = nwg / NXCD, r = nwg % NXCD, xcd = wgid % NXCD, off = wgid / NXCD; wgid = (xcd < r ? xcd * (q + 1) : r * (q + 1) + (xcd - r) * q) + off; }
        const int nig = WGM * nN, gid = wgid / nig, fm = gid * WGM, gsz = (nM - fm) < WGM ? (nM - fm) : WGM;
        u.pm = fm + ((wgid % nig) % gsz); u.pn = (wgid % nig) / gsz; return true;
    }
    __device__ __forceinline__ void a_ready(const Unit&) const {}
    __device__ __forceinline__ void done(const Unit&) const {}
};

__device__ __forceinline__ unsigned cvt_pk_bf16(float lo, float hi) { unsigned r; asm volatile("v_cvt_pk_bf16_f32 %0, %1, %2" : "=v"(r) : "v"(lo), "v"(hi)); return r; }
typedef float f32x2 __attribute__((ext_vector_type(2)));
__device__ __forceinline__ f32x2 gelu_pk(f32x2 v) {
    const f32x2 av = __builtin_elementwise_abs(v), d = av * 0.2316418882f + 1.0f;
    f32x2 t; t.x = __builtin_amdgcn_rcpf(d.x); t.y = __builtin_amdgcn_rcpf(d.y);
    f32x2 q = t * 0.5307027145f + (-0.7265760135f); q = q * t + 0.7107068705f; q = q * t + (-0.142248368f); q = q * t + 0.127414796f; q = q * t;
    const f32x2 s = (v * v) * (-0.72134752044f);
    f32x2 e; e.x = __builtin_amdgcn_exp2f(s.x); e.y = __builtin_amdgcn_exp2f(s.y);
    const f32x2 m = v * (q * e), r = v - m;
    f32x2 o; o.x = v.x < 0.f ? m.x : r.x; o.y = v.y < 0.f ? m.y : r.y; return o;
}

template <int ACT  > struct EpiBf16 {
    static constexpr bool PERM = true, AFTER_DRAIN = false; static_assert(ACT == 0 || ACT == 1, "EpiBf16: ACT is 0 (none) or 1 (gelu_pk)");
    bf16_t* O; int ldc; const float* bias; int split_cols; size_t split_stride; float scale0;
    __device__ __forceinline__ void operator()(const f32x4 (&acc)[2][2][4][2], const Unit& u, int wr, int wc, int fr, int fq) const {
        const int row0 = u.pm * BM + wr * 64 + fr; int colt = u.pn * BM; bf16_t* base = O;
        float sc = 1.f; if (split_cols) { const int t = colt / split_cols; base += (size_t)t * split_stride; colt -= t * split_cols; if (t == 0) sc = scale0; }
        const int col0 = colt + wc * 32 + 8 * fq, bcol0 = u.pn * BM + wc * 32 + 8 * fq;
        f32x4 bv[2][2];
#pragma unroll
        for (int bj = 0; bj < 2; ++bj)
#pragma unroll
            for (int n = 0; n < 2; ++n) bv[bj][n] = bias ? *(const f32x4*)(bias + bcol0 + bj * HALF + 4 * n) : (f32x4){0.f, 0.f, 0.f, 0.f};
#pragma unroll
        for (int ai = 0; ai < 2; ++ai)
#pragma unroll
            for (int m = 0; m < 4; ++m) { bf16_t* rowp = base + (size_t)(row0 + ai * HALF + m * 16) * ldc + col0;
#pragma unroll
                for (int bj = 0; bj < 2; ++bj) { f32x4 v0 = acc[ai][bj][m][0] + bv[bj][0], v1 = acc[ai][bj][m][1] + bv[bj][1];
                    if (ACT == 1) { f32x2 a = gelu_pk((f32x2){v0[0], v0[1]}), b = gelu_pk((f32x2){v0[2], v0[3]}), c = gelu_pk((f32x2){v1[0], v1[1]}), d = gelu_pk((f32x2){v1[2], v1[3]});
                        v0 = (f32x4){a.x, a.y, b.x, b.y}; v1 = (f32x4){c.x, c.y, d.x, d.y}; }
                    v0 = v0 * sc; v1 = v1 * sc; u32x4 w; w.x = cvt_pk_bf16(v0[0], v0[1]); w.y = cvt_pk_bf16(v0[2], v0[3]); w.z = cvt_pk_bf16(v1[0], v1[1]); w.w = cvt_pk_bf16(v1[2], v1[3]);
                    *(u32x4*)(rowp + bj * HALF) = w; } }
    }
};
template <class Epi, class Sched, bool ALIGN_EPI = false, bool SP2 = false>
__device__ __forceinline__ void gemm_phase(PG8_LAS unsigned char* lds, const Gemm g, const Sched& S, const Epi& E) {
    const int tid = threadIdx.x, wid = __builtin_amdgcn_readfirstlane(tid >> 6), lane = tid & 63, wr = wid >> 2, wc = wid & 3, fr = lane & 15, fq = lane >> 4;
    const int K = g.K, nt = K / BK;
    unsigned voffA[2], voffB[2];
#pragma unroll
    for (int i = 0; i < 2; ++i) { int R, C; stage_rc(tid * 16 + i * 8192, R, C); const int Rb = Epi::PERM ? ((R & ~31) + perm32(R & 31)) : R;
        voffA[i] = (unsigned)(R * K + C) * 2u; voffB[i] = (unsigned)(Rb * K + C) * 2u; }
    const size_t kstep = (size_t)(BK * 2);
    const size_t hstep = (size_t)HALF * K * 2;
    const size_t tstep = 2 * hstep;
    const unsigned ldsw = (unsigned)wid * 1024u;
    const int aoff = lds_byte(wr * 64 + fr, fq * 8), boff = lds_byte(wc * 32 + fr, fq * 8);
#define PG8_SA(b, h) (((b) * 2 + (h)) * HTB)
#define PG8_SB(b, h) ((4 + (b) * 2 + (h)) * HTB)
#define PG8_STAGE(bufoff, gbase, voff) do { _Pragma("unroll") for (int _i = 0; _i < 2; ++_i) \
        __builtin_amdgcn_global_load_lds((const unsigned*)((const char*)(gbase) + (voff)[_i]), (PG8_LAS unsigned*)(lds + (bufoff) + ldsw + _i * 8192), 16, 0, 0); } while (0)
#define PG8_LDA(dst, b, h) do { _Pragma("unroll") for (int m = 0; m < 4; ++m) _Pragma("unroll") for (int k = 0; k < 2; ++k) dst[m][k] = *(const PG8_LAS bf16x8*)(lds + PG8_SA(b, h) + aoff + m * 2048 + k * 1024); } while (0)
#define PG8_LDB(dst, b, h) do { _Pragma("unroll") for (int n = 0; n < 2; ++n) _Pragma("unroll") for (int k = 0; k < 2; ++k) dst[n][k] = *(const PG8_LAS bf16x8*)(lds + PG8_SB(b, h) + boff + n * 2048 + k * 1024); } while (0)
#define PG8_MMA(ai, bj, At, Bt) do { __builtin_amdgcn_s_setprio(1); _Pragma("unroll") for (int m = 0; m < 4; ++m) _Pragma("unroll") for (int n = 0; n < 2; ++n) _Pragma("unroll") for (int k = 0; k < 2; ++k) \
        acc[ai][bj][m][n] = __builtin_amdgcn_mfma_f32_16x16x32_bf16(Bt[n][k], At[m][k], acc[ai][bj][m][n], 0, 0, 0); __builtin_amdgcn_s_setprio(0); } while (0)
#define PG8_WAIT_V(n) asm volatile("s_waitcnt vmcnt(" #n ")" ::: "memory")
#define PG8_WAIT_L(n) asm volatile("s_waitcnt lgkmcnt(" #n ")" ::: "memory")
#define PG8_BAR __builtin_amdgcn_s_barrier()
#define PG8_SCHED __builtin_amdgcn_sched_barrier(0)
    Unit cur, nxt; int ui = 0;
    if (!S.next(0, cur)) return;
    f32x4 acc[2][2][4][2];
#pragma unroll
    for (int a = 0; a < 2; ++a)
#pragma unroll
        for (int b = 0; b < 2; ++b)
#pragma unroll
            for (int m = 0; m < 4; ++m)
#pragma unroll
                for (int n = 0; n < 2; ++n) acc[a][b][m][n] = (f32x4){0.f, 0.f, 0.f, 0.f};
    bf16x8 At[4][2], B0[2][2], B1[2][2];
    const char* cA = (const char*)g.A + (size_t)cur.pm * tstep; const char* cB = (const char*)g.Bt + (size_t)cur.pn * tstep;
    S.a_ready(cur);
    if constexpr (SP2) {
        PG8_STAGE(PG8_SB(0, 0), cB, voffB); PG8_STAGE(PG8_SB(0, 1), cB + hstep, voffB); PG8_STAGE(PG8_SA(0, 0), cA, voffA); PG8_STAGE(PG8_SA(0, 1), cA + hstep, voffA);
        if (wr == 1) PG8_BAR;
        PG8_WAIT_V(2); PG8_BAR;
        PG8_STAGE(PG8_SB(1, 0), cB + kstep, voffB); PG8_STAGE(PG8_SA(1, 0), cA + kstep, voffA); PG8_STAGE(PG8_SB(1, 1), cB + hstep + kstep, voffB);
        PG8_WAIT_V(6); PG8_BAR;
    } else {
        PG8_STAGE(PG8_SB(0, 0), cB, voffB); PG8_STAGE(PG8_SA(0, 0), cA, voffA); PG8_STAGE(PG8_SB(0, 1), cB + hstep, voffB); PG8_STAGE(PG8_SA(0, 1), cA + hstep, voffA);
        if (wr == 1) PG8_BAR;
        PG8_WAIT_V(4); PG8_BAR;
        PG8_STAGE(PG8_SB(1, 0), cB + kstep, voffB); PG8_STAGE(PG8_SA(1, 0), cA + kstep, voffA); PG8_STAGE(PG8_SB(1, 1), cB + hstep + kstep, voffB);
        PG8_WAIT_V(6); PG8_BAR;
    }
    for (;;) {
        const bool has_next = S.next(ui + 1, nxt);
        const char* nA = has_next ? (const char*)g.A + (size_t)nxt.pm * tstep : cA; const char* nB = has_next ? (const char*)g.Bt + (size_t)nxt.pn * tstep : cB;
        for (int t = 0; t < nt; t += 2) {
            const bool last = (t == nt - 2);
            const char* a1 = cA + (size_t)(t + 1) * kstep;
            const char* a2 = last ? nA : cA + (size_t)(t + 2) * kstep; const char* b2 = last ? nB : cB + (size_t)(t + 2) * kstep;
            const char* a3 = a2 + kstep; const char* b3 = b2 + kstep;
            if (last && has_next) S.a_ready(nxt);
            if constexpr (SP2) {
            PG8_LDB(B0, 0, 0); PG8_LDB(B1, 0, 1); PG8_SCHED; PG8_LDA(At, 0, 0); PG8_STAGE(PG8_SA(1, 1), a1 + hstep, voffA);
            PG8_WAIT_V(8); PG8_WAIT_L(0); PG8_BAR; PG8_MMA(0, 0, At, B0); PG8_MMA(0, 1, At, B1); PG8_BAR; PG8_SCHED;
            PG8_LDA(At, 0, 1); PG8_STAGE(PG8_SB(0, 0), b2, voffB); PG8_STAGE(PG8_SB(0, 1), b2 + hstep, voffB); PG8_STAGE(PG8_SA(0, 0), a2, voffA);
            PG8_WAIT_V(8); PG8_WAIT_L(0); PG8_BAR; PG8_MMA(1, 0, At, B0); PG8_MMA(1, 1, At, B1); PG8_BAR; PG8_SCHED;
            PG8_LDB(B0, 1, 0); PG8_LDB(B1, 1, 1); PG8_SCHED; PG8_LDA(At, 1, 0); PG8_STAGE(PG8_SA(0, 1), a2 + hstep, voffA);
            PG8_WAIT_V(8); PG8_WAIT_L(0); PG8_BAR; PG8_MMA(0, 0, At, B0); PG8_MMA(0, 1, At, B1); PG8_BAR; PG8_SCHED;
            PG8_LDA(At, 1, 1); PG8_STAGE(PG8_SB(1, 0), b3, voffB); PG8_STAGE(PG8_SB(1, 1), b3 + hstep, voffB); PG8_STAGE(PG8_SA(1, 0), a3, voffA);
            PG8_WAIT_V(8); PG8_WAIT_L(0); PG8_BAR; PG8_MMA(1, 0, At, B0); PG8_MMA(1, 1, At, B1); PG8_BAR; PG8_SCHED;
            } else {
            PG8_LDB(B0, 0, 0); PG8_SCHED; PG8_LDA(At, 0, 0); PG8_STAGE(PG8_SA(1, 1), a1 + hstep, voffA);
            PG8_WAIT_L(8); PG8_BAR; PG8_WAIT_L(0); PG8_MMA(0, 0, At, B0); PG8_BAR; PG8_SCHED;
            PG8_LDB(B1, 0, 1); PG8_STAGE(PG8_SB(0, 0), b2, voffB);
            PG8_BAR; PG8_WAIT_L(0); PG8_MMA(0, 1, At, B1); PG8_BAR;
            PG8_LDA(At, 0, 1); PG8_STAGE(PG8_SA(0, 0), a2, voffA);
            PG8_BAR; PG8_WAIT_L(0); PG8_MMA(1, 0, At, B0); PG8_BAR; PG8_SCHED;
            PG8_STAGE(PG8_SB(0, 1), b2 + hstep, voffB);
            PG8_WAIT_V(6); PG8_BAR; PG8_MMA(1, 1, At, B1); PG8_BAR;
            PG8_LDB(B0, 1, 0); PG8_SCHED; PG8_LDA(At, 1, 0); PG8_STAGE(PG8_SA(0, 1), a2 + hstep, voffA);
            PG8_WAIT_L(8); PG8_BAR; PG8_WAIT_L(0); PG8_MMA(0, 0, At, B0); PG8_BAR; PG8_SCHED;
            PG8_LDB(B1, 1, 1); PG8_STAGE(PG8_SB(1, 0), b3, voffB);
            PG8_BAR; PG8_WAIT_L(0); PG8_MMA(0, 1, At, B1); PG8_BAR;
            PG8_LDA(At, 1, 1); PG8_STAGE(PG8_SA(1, 0), a3, voffA);
            PG8_BAR; PG8_WAIT_L(0); PG8_MMA(1, 0, At, B0); PG8_BAR; PG8_SCHED;
            PG8_STAGE(PG8_SB(1, 1), b3 + hstep, voffB);
            PG8_WAIT_V(6); PG8_BAR; PG8_MMA(1, 1, At, B1); PG8_BAR;
            }
        }
        if constexpr (ALIGN_EPI) { if (wr == 0) PG8_BAR; }
        if constexpr (!Epi::AFTER_DRAIN) { E(acc, cur, wr, wc, fr, fq); S.done(cur); }
        if (!has_next) break;
#pragma unroll
        for (int a = 0; a < 2; ++a)
#pragma unroll
            for (int b = 0; b < 2; ++b)
#pragma unroll
                for (int m = 0; m < 4; ++m)
#pragma unroll
                    for (int n = 0; n < 2; ++n) acc[a][b][m][n] = (f32x4){0.f, 0.f, 0.f, 0.f};
        cur = nxt; cA = nA; cB = nB; ++ui;
        if constexpr (ALIGN_EPI) { if (wr == 1) PG8_BAR; }
    }
    PG8_WAIT_V(0);
    if constexpr (!ALIGN_EPI) { if (wr == 0) PG8_BAR; }
    PG8_BAR;
    if constexpr (Epi::AFTER_DRAIN) { E.fused(acc, cur, wr, wc, fr, fq, lds, wid, lane); S.done(cur); }
#undef PG8_SA
#undef PG8_SB
#undef PG8_STAGE
#undef PG8_LDA
#undef PG8_LDB
#undef PG8_MMA
#undef PG8_WAIT_V
#undef PG8_WAIT_L
#undef PG8_BAR
#undef PG8_SCHED
}
}

#ifndef PG8_SP2
#define PG8_SP2 true
#endif
#ifndef PG8_ALIGN
#define PG8_ALIGN true
#endif
#define GAS __attribute__((address_space(1)))
#define LAS __attribute__((address_space(3)))
typedef unsigned short bf16;
typedef unsigned v4u __attribute__((ext_vector_type(4)));
typedef float f32x4 __attribute__((ext_vector_type(4)));
typedef short bf16x8 __attribute__((ext_vector_type(8)));
typedef GAS unsigned gu32;
typedef GAS unsigned long long gu64;
#define RLX_AGENT __ATOMIC_RELAXED, __HIP_MEMORY_SCOPE_AGENT
#define LDS_WAIT() asm volatile("s_waitcnt lgkmcnt(0)" ::: "memory")
#define VM_WAIT() asm volatile("s_waitcnt vmcnt(0)" ::: "memory")
__device__ __forceinline__ unsigned long long rt() { return __builtin_amdgcn_s_memrealtime(); }
__device__ __forceinline__ unsigned f2bf(float f) { unsigned u = __builtin_bit_cast(unsigned, f); return (u + 0x7fffu + ((u >> 16) & 1u)) >> 16; }
typedef float pk2_f32x2 __attribute__((ext_vector_type(2))); typedef __bf16 pk2_bf16x2 __attribute__((ext_vector_type(2)));
__device__ __forceinline__ unsigned pk2(float lo, float hi) { pk2_f32x2 v = {lo, hi}; pk2_bf16x2 b = __builtin_convertvector(v, pk2_bf16x2); return __builtin_bit_cast(unsigned, b); }

#define XB_TMO      128
#define XB_XCNT(j)  (256  + 64 * (j))
#define XB_XSUB(j)  (1280 + 64 * (j))
#define XB_XGEN(j)  (2304 + 64 * (j))
#define XB_TOP      3328
#define XB_TOPGEN   3392
#define XCD_BAR_WORDS 3456
#define XB_SPIN_CAP (1u << 18)

__device__ __forceinline__ unsigned xb_ld(unsigned* p)              { return __hip_atomic_load(p, __ATOMIC_RELAXED, __HIP_MEMORY_SCOPE_AGENT); }
__device__ __forceinline__ unsigned xb_add(unsigned* p, unsigned v) { return __hip_atomic_fetch_add(p, v, __ATOMIC_RELAXED, __HIP_MEMORY_SCOPE_AGENT); }
__device__ __forceinline__ unsigned xb_xcc_id() { return (unsigned)__builtin_amdgcn_s_getreg((3 << 11) | 20) & 0xFu; }
#define XB_SPIN(cond, bar) do { unsigned _sp = 0; while (cond) { __builtin_amdgcn_s_sleep(1); \
    if ((++_sp & 255u) == 0u) { if (xb_ld(&(bar)[XB_TMO])) break; if (_sp > XB_SPIN_CAP) { atomicAdd(&(bar)[XB_TMO], 1u); break; } } } } while (0)

struct XcdBarrier {
    unsigned* bar; unsigned x;
    volatile LAS unsigned* st;
};

__device__ __forceinline__ XcdBarrier xcd_barrier_post(unsigned* bar, volatile LAS unsigned* st) {
    XcdBarrier b; b.bar = bar; b.x = xb_xcc_id(); b.st = st;
    if (threadIdx.x == 0) (void)xb_add(&bar[XB_XCNT(b.x)], 1u);
    return b;
}
__device__ __forceinline__ void xcd_barrier_complete(unsigned* bar, unsigned x, unsigned& nloc, unsigned& nx) {
    const unsigned G = gridDim.x * gridDim.y * gridDim.z;
    unsigned sum, cnt, mine, sp = 0u;
    for (;;) {
        sum = 0u; cnt = 0u; mine = 0u;
#pragma unroll
        for (unsigned j = 0; j < 16; ++j) { const unsigned c = xb_ld(&bar[XB_XCNT(j)]); sum += c; cnt += (c > 0u) ? 1u : 0u; mine = (j == x) ? c : mine; }
        if (sum == G) break;
        __builtin_amdgcn_s_sleep(1);
        if ((++sp & 255u) == 0u) { if (xb_ld(&bar[XB_TMO])) break; if (sp > XB_SPIN_CAP) { atomicAdd(&bar[XB_TMO], 1u); break; } }
    }
    nloc = mine > 0u ? mine : 1u; nx = cnt > 0u ? cnt : 1u;
}

__device__ __forceinline__ void xcd_barrier(const XcdBarrier& b) {
    asm volatile("s_waitcnt vmcnt(0)" ::: "memory");
    __syncthreads();
    if (threadIdx.x == 0) {
        unsigned* bar = b.bar;
        __builtin_amdgcn_s_waitcnt(0);
        unsigned nloc = b.st[0], nx = b.st[1];
        if (nloc == 0u) { xcd_barrier_complete(bar, b.x, nloc, nx); b.st[0] = nloc; b.st[1] = nx; }
        const unsigned old = xb_add(&bar[XB_XSUB(b.x)], 1u);
        const unsigned gen = old / nloc;
        if (old + 1u == (gen + 1u) * nloc) {
            __builtin_amdgcn_fence(__ATOMIC_RELEASE, "agent");
            asm volatile("s_waitcnt vmcnt(0)" ::: "memory");
            const unsigned og = xb_add(&bar[XB_TOP], 1u);
            const unsigned tg = og / nx;
            if (og + 1u == (tg + 1u) * nx) xb_add(&bar[XB_TOPGEN], 1u);
            else XB_SPIN(xb_ld(&bar[XB_TOPGEN]) == tg, bar);
            __builtin_amdgcn_fence(__ATOMIC_ACQUIRE, "agent");
            xb_add(&bar[XB_XGEN(b.x)], 1u);
            asm volatile("s_waitcnt vmcnt(0)" ::: "memory");
        } else {
            XB_SPIN(xb_ld(&bar[XB_XGEN(b.x)]) == gen, bar);
            __builtin_amdgcn_fence(__ATOMIC_ACQUIRE, "agent");
            asm volatile("s_waitcnt vmcnt(0)" ::: "memory");
        }
    }
    __syncthreads();
}


constexpr int NWAVES = 8;
constexpr int DM = 2048, BATCH = 4, SEQ = 4096, M = BATCH * SEQ;
constexpr int NIN = 6176, NINP = 6144;
constexpr int O_GQ = 0, O_GK = 512, O_GV = 1024, O_GR = 2048, O_AQ = 3072, O_AK = 4096, O_AV = 5120;
constexpr float EPS = 1e-6f;
constexpr int PEER_K = 128;

constexpr size_t MiB = 1u << 20;
constexpr size_t WS_CTL = 0, CTL_ZERO_BYTES = 1 * MiB;
constexpr size_t WS_WIN = 1 * MiB;
constexpr size_t WS_WGD = 25 * MiB;
constexpr size_t WS_GDB = 62 * MiB;
constexpr size_t WS_WOUT = 26 * MiB;
constexpr size_t WS_WQ = 34 * MiB;
constexpr size_t WS_SSQ = 42 * MiB;
constexpr size_t WS_EIDX = 44 * MiB;
constexpr size_t WS_GATE = 52 * MiB;
constexpr size_t WS_SKB = 60 * MiB;
constexpr size_t WS_XN = 64 * MiB;
constexpr size_t WS_PROJ = 128 * MiB;
constexpr size_t WS_HB = 256 * MiB;
constexpr size_t WS_OF = 328 * MiB;
constexpr size_t WS_OB = 360 * MiB;
constexpr size_t WS_ATTP = 392 * MiB;
constexpr size_t WS_ATTML = 488 * MiB;
constexpr size_t WS_GT_QD = 64 * MiB;
constexpr size_t WS_GT_KE = 96 * MiB;
constexpr size_t OUT_GT_AM = 0;
constexpr size_t OUT_GT_DEC = 16 * MiB;
constexpr size_t OUT_GT_VT = 32 * MiB;
constexpr int CW_ATTQX = 512;
constexpr size_t WS_EIDX16 = 494 * MiB;
constexpr size_t WS_END = 498 * MiB;
constexpr size_t OUT_U8 = 64 * MiB;
constexpr size_t OUT_V8 = 96 * MiB;
constexpr size_t WS_SU = 61 * MiB;
constexpr size_t WS_SV = 61 * MiB + 65536;
constexpr int CONV_FIRST_RANK = 24;
constexpr int CW_CONVQ = 256;
constexpr size_t WS_PW = 128 * MiB;
constexpr size_t WS_SSQ2 = 136 * MiB;
constexpr size_t WS_PD = 64 * MiB;
constexpr int PEER_E = 16384;
constexpr int CW_TMO = 0, CW_CODE = 1, CW_BAR = 4096;

constexpr int RING_OFF = 0, RING_BYTES = 131072;
constexpr int LDS_BYTES = 163840;
constexpr int LDSCTL_OFF = LDS_BYTES - 1024, MISC_OFF = LDSCTL_OFF + 320;

typedef float f32x2 __attribute__((ext_vector_type(2)));
typedef float f32x16 __attribute__((ext_vector_type(16)));
typedef int i32x4 __attribute__((ext_vector_type(4)));
typedef int i32x2 __attribute__((ext_vector_type(2)));
__device__ __forceinline__ float bf2f(unsigned short h) { return __builtin_bit_cast(float, (unsigned)h << 16); }
__device__ __forceinline__ float bflo(unsigned w) { return __builtin_bit_cast(float, w << 16); }
__device__ __forceinline__ float bfhi(unsigned w) { return __builtin_bit_cast(float, w & 0xffff0000u); }
#define WRED_DPP(x, ctrl) __builtin_bit_cast(float, __builtin_amdgcn_update_dpp(0, __builtin_bit_cast(int, (x)), ctrl, 0xF, 0xF, false))
#define WRED_LANE(x, l) __builtin_bit_cast(float, __builtin_amdgcn_readlane(__builtin_bit_cast(int, (x)), (l)))
__device__ __forceinline__ float wave_sum(float v) {
    v += WRED_DPP(v, 0xB1); v += WRED_DPP(v, 0x4E); v += WRED_DPP(v, 0x141); v += WRED_DPP(v, 0x140);
    return (WRED_LANE(v, 0) + WRED_LANE(v, 16)) + (WRED_LANE(v, 32) + WRED_LANE(v, 48));
}
__device__ __forceinline__ float wave_max(float v) {
    v = fmaxf(v, WRED_DPP(v, 0xB1)); v = fmaxf(v, WRED_DPP(v, 0x4E)); v = fmaxf(v, WRED_DPP(v, 0x141)); v = fmaxf(v, WRED_DPP(v, 0x140));
    return fmaxf(fmaxf(WRED_LANE(v, 0), WRED_LANE(v, 16)), fmaxf(WRED_LANE(v, 32), WRED_LANE(v, 48)));
}

#define SWAP_PAIR(OP, x, r0, r1) do { unsigned a_ = __builtin_bit_cast(unsigned, (x)), b_ = a_; asm volatile("" : "+v"(b_)); auto s_ = OP(a_, b_, false, false); const unsigned u0_ = s_[0], u1_ = s_[1];   r0 = __builtin_bit_cast(float, u0_); r1 = __builtin_bit_cast(float, u1_); } while (0)
__device__ __forceinline__ float xrow_max(float v) {
    float p, q; SWAP_PAIR(__builtin_amdgcn_permlane16_swap, v, p, q); v = fmaxf(p, q); SWAP_PAIR(__builtin_amdgcn_permlane32_swap, v, p, q); return fmaxf(p, q);
}
__device__ __forceinline__ float xrow_sum(float v) {
    float p, q; SWAP_PAIR(__builtin_amdgcn_permlane16_swap, v, p, q); v = p + q; SWAP_PAIR(__builtin_amdgcn_permlane32_swap, v, p, q); return p + q;
}
template <class T> __device__ __forceinline__ T* opaque(T* p) { asm volatile("" : "+s"(p)); return (T*)(GAS T*)p; }
__device__ __forceinline__ int lane_id() { int x; asm volatile("v_mbcnt_lo_u32_b32 %0, -1, 0\n\tv_mbcnt_hi_u32_b32 %0, -1, %0" : "=v"(x)); return x; }
__device__ __forceinline__ int opaque_v(int x) { asm volatile("" : "+v"(x)); return x; }
template <class T> __device__ __forceinline__ T ldu(const void* ubase, unsigned voff) { return *(const GAS T*)((const GAS char*)ubase + voff); }
template <class T> __device__ __forceinline__ void stu(void* ubase, unsigned voff, T v) { *(GAS T*)((GAS char*)ubase + voff) = v; }
namespace pg8 {
struct EpiRes {
    static constexpr bool PERM = true, AFTER_DRAIN = false;
    const float* x; bf16_t* HB; float* ssq; int ldc;
    __device__ __forceinline__ void operator()(const f32x4 (&acc)[2][2][4][2], const Unit& u, int wr, int wc, int fr, int fq) const {
        const int col0 = u.pn * BM + wc * 32 + 8 * fq;
        const int rbase = u.pm * BM + wr * 64 + fr;
        f32x4 xc[2][2], xn[2][2];
#define EPIRES_LOAD(D, IDX) do { const size_t o_ = (size_t)(rbase + ((IDX) >> 2) * HALF + ((IDX) & 3) * 16) * ldc + col0; _Pragma("unroll") for (int bj = 0; bj < 2; ++bj) { D[bj][0] = *(const f32x4*)(x + o_ + bj * HALF); D[bj][1] = *(const f32x4*)(x + o_ + bj * HALF + 4); } } while (0)
        EPIRES_LOAD(xc, 0);
#pragma unroll
        for (int idx = 0; idx < 8; ++idx) { const int ai = idx >> 2, m = idx & 3;
            if (idx + 1 < 8) EPIRES_LOAD(xn, idx + 1);
            const int r = rbase + ai * HALF + m * 16; const size_t off = (size_t)r * ldc + col0; float s = 0.f;
#pragma unroll
            for (int bj = 0; bj < 2; ++bj) {
                const f32x4 h0 = xc[bj][0] + acc[ai][bj][m][0], h1 = xc[bj][1] + acc[ai][bj][m][1];
                s += ((h0[0] * h0[0] + h0[1] * h0[1]) + (h0[2] * h0[2] + h0[3] * h0[3])) + ((h1[0] * h1[0] + h1[1] * h1[1]) + (h1[2] * h1[2] + h1[3] * h1[3]));
                u32x4 w; w.x = cvt_pk_bf16(h0[0], h0[1]); w.y = cvt_pk_bf16(h0[2], h0[3]); w.z = cvt_pk_bf16(h1[0], h1[1]); w.w = cvt_pk_bf16(h1[2], h1[3]);
                *(u32x4*)(HB + off + bj * HALF) = w;
            }
            s += __shfl_xor(s, 16); s += __shfl_xor(s, 32);
            if (fq == 0) ssq[(size_t)r * 32 + u.pn * 4 + wc] = s;
#pragma unroll
            for (int bj = 0; bj < 2; ++bj) { xc[bj][0] = xn[bj][0]; xc[bj][1] = xn[bj][1]; }
        }
#undef EPIRES_LOAD
    }
};
constexpr int EPI_STAGE_OFF = 131072;
struct EpiBf16S {
    static constexpr bool PERM = true, AFTER_DRAIN = false;
    bf16_t* O; int ldc; LAS unsigned char* stage;
    __device__ __forceinline__ void operator()(const f32x4 (&acc)[2][2][4][2], const Unit& u, int wr, int wc, int fr, int fq) const {
        LAS unsigned char* st = stage + (wr * 4 + wc) * 3584;
        const int lane = fr + 16 * fq, srow = lane >> 2, sch = lane & 3;
        LAS unsigned char* wp = st + fr * 80 + fq * 16; const LAS unsigned char* rp = st + srow * 80 + sch * 16;
        bf16_t* gp = O + (size_t)(u.pm * BM + wr * 64 + srow) * ldc + u.pn * BM + wc * 32 + sch * 8;
#pragma unroll
        for (int ai = 0; ai < 2; ++ai)
#pragma unroll
            for (int m = 0; m < 4; ++m)
#pragma unroll
                for (int bj = 0; bj < 2; ++bj) { const f32x4 v0 = acc[ai][bj][m][0], v1 = acc[ai][bj][m][1];
                    u32x4 w; w.x = cvt_pk_bf16(v0[0], v0[1]); w.y = cvt_pk_bf16(v0[2], v0[3]); w.z = cvt_pk_bf16(v1[0], v1[1]); w.w = cvt_pk_bf16(v1[2], v1[3]);
                    *(LAS u32x4*)wp = w;
                    const u32x4 o = *(const LAS u32x4*)rp;
                    *(u32x4*)(gp + (size_t)(ai * HALF + m * 16) * ldc + bj * HALF) = o; }
    }
};
struct EpiResS {
    static constexpr bool PERM = true, AFTER_DRAIN = false;
    const float* x; bf16_t* HB; float* ssq; int ldc; LAS unsigned char* stage;
    __device__ __forceinline__ void operator()(const f32x4 (&acc)[2][2][4][2], const Unit& u, int wr, int wc, int fr, int fq) const {
        LAS unsigned char* xs = stage + (wr * 4 + wc) * 3584; LAS unsigned char* os = xs + 2304;
        const int lane = fr + 16 * fq, srow = lane >> 2, sch = lane & 3, lrow = lane >> 3, lch = lane & 7;
        const int R0 = u.pm * BM + wr * 64, C0 = u.pn * BM + wc * 32;
        const float* xg = x + (size_t)(R0 + lrow) * ldc + C0 + lch * 4;
        bf16_t* gp = HB + (size_t)(R0 + srow) * ldc + C0 + sch * 8;
        f32x4 xc[4], xn[4];
#define EPIRES_LOAD(D, IDX) do { const size_t o_ = (size_t)(((IDX) >> 2) * HALF + ((IDX) & 3) * 16) * ldc; _Pragma("unroll") for (int bj = 0; bj < 2; ++bj) { D[2 * bj] = *(const f32x4*)(xg + o_ + bj * HALF); D[2 * bj + 1] = *(const f32x4*)(xg + o_ + (size_t)8 * ldc + bj * HALF); } } while (0)
        EPIRES_LOAD(xc, 0);
#pragma unroll
        for (int idx = 0; idx < 8; ++idx) { const int ai = idx >> 2, m = idx & 3;
            if (idx + 1 < 8) EPIRES_LOAD(xn, idx + 1);
            float s = 0.f;
#pragma unroll
            for (int bj = 0; bj < 2; ++bj) {
                *(LAS f32x4*)(xs + lrow * 144 + lch * 16) = xc[2 * bj]; *(LAS f32x4*)(xs + (8 + lrow) * 144 + lch * 16) = xc[2 * bj + 1];
                const f32x4 r0 = *(const LAS f32x4*)(xs + fr * 144 + fq * 32), r1 = *(const LAS f32x4*)(xs + fr * 144 + fq * 32 + 16);
                const f32x4 h0 = r0 + acc[ai][bj][m][0], h1 = r1 + acc[ai][bj][m][1];
                s += ((h0[0] * h0[0] + h0[1] * h0[1]) + (h0[2] * h0[2] + h0[3] * h0[3])) + ((h1[0] * h1[0] + h1[1] * h1[1]) + (h1[2] * h1[2] + h1[3] * h1[3]));
                u32x4 w; w.x = cvt_pk_bf16(h0[0], h0[1]); w.y = cvt_pk_bf16(h0[2], h0[3]); w.z = cvt_pk_bf16(h1[0], h1[1]); w.w = cvt_pk_bf16(h1[2], h1[3]);
                *(LAS u32x4*)(os + fr * 80 + fq * 16) = w;
                const u32x4 o = *(const LAS u32x4*)(os + srow * 80 + sch * 16);
                *(u32x4*)(gp + (size_t)(ai * HALF + m * 16) * ldc + bj * HALF) = o;
            }
            s = xrow_sum(s);
            if (fq == 0) ssq[(size_t)(R0 + ai * HALF + m * 16 + fr) * 32 + u.pn * 4 + wc] = s;
#pragma unroll
            for (int j = 0; j < 4; ++j) xc[j] = xn[j];
        }
#undef EPIRES_LOAD
    }
};
}

struct Frame {
    LAS unsigned char* lds;
    volatile LAS unsigned* MISC;
    gu32* ctl;
    int wave;
    int vcu, G;
};

__device__ __forceinline__ void p0_transpose_item(const float* W, int K, int ldw, const float* gk, bf16* WT, LAS float* scr, int item, int lane) {
    const int nblk = ldw / 32, kb = item / nblk, nb = item % nblk, k0 = 64 * kb, n0 = 32 * nb;
    float wv[32];
    { const GAS float* Wg = (const GAS float*)W + (size_t)(k0 + (lane >> 5)) * ldw + n0 + (lane & 31);
#pragma unroll
      for (int i = 0; i < 32; ++i) wv[i] = Wg[(size_t)(2 * i) * ldw]; }
    if (gk) {
#pragma unroll
      for (int i = 0; i < 32; ++i) wv[i] *= ((const GAS float*)gk)[k0 + 2 * i + (lane >> 5)]; }
#pragma unroll
    for (int i = 0; i < 32; ++i) scr[(2 * i + (lane >> 5)) * 33 + (lane & 31)] = wv[i];
    LDS_WAIT(); asm volatile("" ::: "memory");
    const int c = lane & 7;
#pragma unroll
    for (int j = 0; j < 4; ++j) { const int n = (lane >> 3) + 8 * j; const LAS float* s = scr + (8 * c) * 33 + n;
        v4u o; o.x = pk2(s[0 * 33], s[1 * 33]); o.y = pk2(s[2 * 33], s[3 * 33]); o.z = pk2(s[4 * 33], s[5 * 33]); o.w = pk2(s[6 * 33], s[7 * 33]);
        *(GAS v4u*)(WT + (size_t)(n0 + n) * K + k0 + 8 * c) = o; }
    LDS_WAIT(); asm volatile("" ::: "memory");
}
struct Args {
    const float* in[16]; float* out; unsigned char* ws; int ph_lo, ph_hi, li, pad;
};

__device__ __forceinline__ void p0_prologue(Frame& F, const Args& a) {
    unsigned char* ws = a.ws;
    LAS float* scr = (LAS float*)(F.lds + RING_OFF + F.wave * 16384);
    const int gw = F.vcu * NWAVES + F.wave, NGW = F.G * NWAVES;
    bf16* Win_t = (bf16*)(ws + WS_WIN); bf16* Wout_t = (bf16*)(ws + WS_WOUT); bf16* Wq_t = (bf16*)(ws + WS_WQ); bf16* XN = (bf16*)(ws + WS_XN);
    constexpr int I_IN = (DM / 64) * (NIN / 32), I_SQ = (DM / 64) * (DM / 32);
    constexpr int NITEMS = I_IN + 2 * I_SQ;
    for (int it = gw; it < NITEMS; it += NGW) {
        int r = it;
        if (r < I_IN) { const int nb = r % (NIN / 32); bf16* dst = nb < 96 ? Win_t : nb == 96 ? (bf16*)(ws + WS_WGD) - (size_t)96 * 32 * DM : Win_t - (size_t)32 * DM;
            p0_transpose_item(a.in[2], DM, NIN, nullptr, dst, scr, r, lane_id()); continue; } r -= I_IN;
        if (r < I_SQ) { p0_transpose_item(a.in[9], DM, DM, nullptr, Wout_t, scr, r, lane_id()); continue; } r -= I_SQ;
        p0_transpose_item(a.in[11], DM, DM, a.in[10], Wq_t, scr, r, lane_id());
    }
    { const f32x4* sk = (const f32x4*)a.in[12]; unsigned long long* skb = (unsigned long long*)(ws + WS_SKB);
      for (int i = gw * 64 + lane_id(); i < 8 * 2 * 128 * 128 / 4; i += NGW * 64) { const f32x4 v = sk[i]; skb[i] = (unsigned long long)pk2(v.x, v.y) | ((unsigned long long)pk2(v.z, v.w) << 32); } }
    { const GAS f32x4* gr = (const GAS f32x4*)a.in[1] + lane_id(); f32x4 gg[8];
#pragma unroll
      for (int j = 0; j < 8; ++j) gg[j] = gr[64 * j];
      f32x4 v[8], vn[8], vn2[8];
#define P0_LOAD(MM, V) do { _Pragma("unroll") for (int j = 0; j < 8; ++j) V[j] = ((const GAS f32x4*)(a.in[0] + (size_t)(MM) * DM) + lane_id())[64 * j]; } while (0)
      if (gw < M) { P0_LOAD(gw, v); const int m1 = gw + NGW < M ? gw + NGW : gw; P0_LOAD(m1, vn); }
      for (int m = gw; m < M; m += NGW) { const int mn = m + 2 * NGW < M ? m + 2 * NGW : m;
          P0_LOAD(mn, vn2);
          float ss = 0.f;
#pragma unroll
          for (int j = 0; j < 8; ++j) ss += (v[j].x * v[j].x + v[j].y * v[j].y) + (v[j].z * v[j].z + v[j].w * v[j].w);
          const float rstd = 1.f / sqrtf(wave_sum(ss) * (1.f / DM) + EPS);
          GAS unsigned long long* o8 = (GAS unsigned long long*)(XN + (size_t)m * DM) + lane_id();
#pragma unroll
          for (int j = 0; j < 8; ++j) o8[64 * j] = (unsigned long long)pk2(v[j].x * rstd * gg[j].x, v[j].y * rstd * gg[j].y) | ((unsigned long long)pk2(v[j].z * rstd * gg[j].z, v[j].w * rstd * gg[j].w) << 32);
#pragma unroll
          for (int j = 0; j < 8; ++j) { v[j] = vn[j]; vn[j] = vn2[j]; } } }
#undef P0_LOAD
}


__device__ __forceinline__ void gd_side_gemm(Frame& F, const Args& a) {
    unsigned char* ws = a.ws; const bf16* XN = (const bf16*)(ws + WS_XN); const bf16* WG = (const bf16*)(ws + WS_WGD); float* GDB = (float*)(ws + WS_GDB);
    const int lane = lane_id(), w = F.wave, r32 = lane & 31, hh = lane >> 5; LAS float* part = (LAS float*)F.lds;
    LAS unsigned char* abuf = F.lds + w * 16896;
    for (int blk = F.vcu; blk < M / 64; blk += F.G) { const int tok0 = blk * 64;
        f32x16 acc[2];
#pragma unroll
        for (int tt = 0; tt < 2; ++tt) acc[tt] = (f32x16){0.f, 0.f, 0.f, 0.f, 0.f, 0.f, 0.f, 0.f, 0.f, 0.f, 0.f, 0.f, 0.f, 0.f, 0.f, 0.f};
        bf16x8 bwv[16];
#pragma unroll
        for (int ks = 0; ks < 16; ++ks) bwv[ks] = *(const GAS bf16x8*)(WG + (size_t)r32 * DM + 256 * w + 16 * ks + 8 * hh);
#pragma unroll
        for (int tt = 0; tt < 2; ++tt) {
            v4u ra[16];
#pragma unroll
            for (int i = 0; i < 16; ++i) ra[i] = *(const GAS v4u*)(XN + (size_t)(tok0 + 32 * tt + 2 * i + (lane >> 5)) * DM + 256 * w + (lane & 31) * 8);
#pragma unroll
            for (int i = 0; i < 16; ++i) *(LAS v4u*)(abuf + (2 * i + (lane >> 5)) * 528 + (lane & 31) * 16) = ra[i];
#pragma unroll
            for (int ks = 0; ks < 16; ++ks) { const bf16x8 ax = *(const LAS bf16x8*)(abuf + r32 * 528 + (16 * ks + 8 * hh) * 2); acc[tt] = __builtin_amdgcn_mfma_f32_32x32x16_bf16(ax, bwv[ks], acc[tt], 0, 0, 0); }
        }
        __syncthreads();
#pragma unroll
        for (int tt = 0; tt < 2; ++tt)
#pragma unroll
            for (int r = 0; r < 16; ++r) { const float x = acc[tt][r]; part[((w * 2 + tt) * 16 + r) * 64 + lane] = x; }
        __syncthreads();
#pragma unroll
        for (int i = 0; i < 4; ++i) { const int o = (F.wave * 64 + lane_id()) + 512 * i; float sum = 0.f;
#pragma unroll
            for (int ww = 0; ww < 8; ++ww) sum += part[ww * 2048 + o];
            const int tt = o >> 10, r = (o >> 6) & 15, ln = o & 63; const int t = 32 * tt + (r & 3) + 8 * (r >> 2) + 4 * (ln >> 5);
            GDB[(size_t)(tok0 + t) * 32 + (ln & 31)] = sum; }
        __syncthreads();
    }
}

__device__ __forceinline__ void p3_finalize(Frame& F, const Args& a) {
    unsigned char* ws = a.ws;
    const int gw = F.vcu * NWAVES + F.wave, NGW = F.G * NWAVES, lane = lane_id();
    const GAS bf16* OFp = (const GAS bf16*)(ws + WS_OF); const GAS bf16* OBp = (const GAS bf16*)(ws + WS_OB);
    const GAS bf16* PROJ = (const GAS bf16*)(ws + WS_PROJ); GAS bf16* Y = (GAS bf16*)(ws + WS_XN);
    const GAS float* ATTML = (const GAS float*)(ws + WS_ATTML); const GAS bf16* ATTP = (const GAS bf16*)(ws + WS_ATTP);
    const GAS float* gla_g = (const GAS float*)a.in[7]; const GAS float* att_g = (const GAS float*)a.in[8];
    const f32x4 gg = *(const GAS f32x4*)(gla_g + 4 * lane);
    f32x4 ag[2][2];
#pragma unroll
    for (int p = 0; p < 2; ++p) { ag[p][0] = *(const GAS f32x4*)(att_g + p * 512 + 8 * lane); ag[p][1] = *(const GAS f32x4*)(att_g + p * 512 + 8 * lane + 4); }
    unsigned long long wf[4], wb[4], gr[4], nwf[4], nwb[4], ngr[4]; f32x2 ml[2][3], nml[2][3]; v4u ow[2][3], now[2][3];
#define P3_LOAD(MM, WF, WB, GR, ML, OW) do { _Pragma("unroll") for (int hh = 0; hh < 4; ++hh) { WF[hh] = *(const GAS unsigned long long*)(OFp + (size_t)(MM) * 1024 + hh * 256 + 4 * lane); \
            WB[hh] = *(const GAS unsigned long long*)(OBp + (size_t)(MM) * 1024 + hh * 256 + 4 * lane); GR[hh] = *(const GAS unsigned long long*)(PROJ + (size_t)(MM) * NINP + O_GR + hh * 256 + 4 * lane); } \
        _Pragma("unroll") for (int p = 0; p < 2; ++p) { const int col = p * 512 + 8 * lane, hd = col >> 6; _Pragma("unroll") for (int pt = 0; pt < 3; ++pt) { const size_t rec = ((size_t)pt * M + (MM)) * 16 + hd; \
            ML[p][pt] = *(const GAS f32x2*)(ATTML + rec * 2); OW[p][pt] = *(const GAS v4u*)(ATTP + rec * 64 + (col & 63)); } } } while (0)
    if (gw < M) P3_LOAD(gw, wf, wb, gr, ml, ow);
    for (int m = gw; m < M; m += NGW) {
        const int mn = m + NGW < M ? m + NGW : m;
        P3_LOAD(mn, nwf, nwb, ngr, nml, now);
#pragma unroll
        for (int hh = 0; hh < 4; ++hh) {
            const f32x4 o = (f32x4){bflo((unsigned)wf[hh]) + bflo((unsigned)wb[hh]), bfhi((unsigned)wf[hh]) + bfhi((unsigned)wb[hh]), bflo((unsigned)(wf[hh] >> 32)) + bflo((unsigned)(wb[hh] >> 32)), bfhi((unsigned)(wf[hh] >> 32)) + bfhi((unsigned)(wb[hh] >> 32))};
            const float ss = wave_sum((o.x * o.x + o.y * o.y) + (o.z * o.z + o.w * o.w));
            const float rstd = 1.f / sqrtf(ss * (1.f / 256.f) + EPS);
            const float r0 = bflo((unsigned)gr[hh]), r1 = bfhi((unsigned)gr[hh]), r2 = bflo((unsigned)(gr[hh] >> 32)), r3 = bfhi((unsigned)(gr[hh] >> 32));
            const float y0 = o.x * rstd * gg.x * (r0 / (1.f + __expf(-r0))), y1 = o.y * rstd * gg.y * (r1 / (1.f + __expf(-r1)));
            const float y2 = o.z * rstd * gg.z * (r2 / (1.f + __expf(-r2))), y3 = o.w * rstd * gg.w * (r3 / (1.f + __expf(-r3)));
            *(GAS unsigned long long*)(Y + (size_t)m * DM + hh * 256 + 4 * lane) = (unsigned long long)pk2(y0, y1) | ((unsigned long long)pk2(y2, y3) << 32);
        }
        float av[16]; float ss = 0.f;
#pragma unroll
        for (int p = 0; p < 2; ++p) {
            const float mt = fmaxf(fmaxf(ml[p][0].x, ml[p][1].x), ml[p][2].x); const float w0 = __expf(ml[p][0].x - mt), w1 = __expf(ml[p][1].x - mt), w2 = __expf(ml[p][2].x - mt);
            const float inv = 1.f / (w0 * ml[p][0].y + w1 * ml[p][1].y + w2 * ml[p][2].y);
            av[p * 8 + 0] = (w0 * bflo(ow[p][0].x) + w1 * bflo(ow[p][1].x) + w2 * bflo(ow[p][2].x)) * inv; av[p * 8 + 1] = (w0 * bfhi(ow[p][0].x) + w1 * bfhi(ow[p][1].x) + w2 * bfhi(ow[p][2].x)) * inv;
            av[p * 8 + 2] = (w0 * bflo(ow[p][0].y) + w1 * bflo(ow[p][1].y) + w2 * bflo(ow[p][2].y)) * inv; av[p * 8 + 3] = (w0 * bfhi(ow[p][0].y) + w1 * bfhi(ow[p][1].y) + w2 * bfhi(ow[p][2].y)) * inv;
            av[p * 8 + 4] = (w0 * bflo(ow[p][0].z) + w1 * bflo(ow[p][1].z) + w2 * bflo(ow[p][2].z)) * inv; av[p * 8 + 5] = (w0 * bfhi(ow[p][0].z) + w1 * bfhi(ow[p][1].z) + w2 * bfhi(ow[p][2].z)) * inv;
            av[p * 8 + 6] = (w0 * bflo(ow[p][0].w) + w1 * bflo(ow[p][1].w) + w2 * bflo(ow[p][2].w)) * inv; av[p * 8 + 7] = (w0 * bfhi(ow[p][0].w) + w1 * bfhi(ow[p][1].w) + w2 * bfhi(ow[p][2].w)) * inv; }
#pragma unroll
        for (int i = 0; i < 16; ++i) ss += av[i] * av[i];
        const float rstd = 1.f / sqrtf(wave_sum(ss) * (1.f / 1024.f) + EPS);
#pragma unroll
        for (int p = 0; p < 2; ++p) { const f32x4 g0 = ag[p][0], g1 = ag[p][1];
            v4u w; w.x = pk2(av[p * 8 + 0] * rstd * g0.x, av[p * 8 + 1] * rstd * g0.y); w.y = pk2(av[p * 8 + 2] * rstd * g0.z, av[p * 8 + 3] * rstd * g0.w);
            w.z = pk2(av[p * 8 + 4] * rstd * g1.x, av[p * 8 + 5] * rstd * g1.y); w.w = pk2(av[p * 8 + 6] * rstd * g1.z, av[p * 8 + 7] * rstd * g1.w);
            *(GAS v4u*)(Y + (size_t)m * DM + 1024 + p * 512 + 8 * lane) = w; }
#pragma unroll
        for (int hh = 0; hh < 4; ++hh) { wf[hh] = nwf[hh]; wb[hh] = nwb[hh]; gr[hh] = ngr[hh]; }
#pragma unroll
        for (int p = 0; p < 2; ++p)
#pragma unroll
            for (int pt = 0; pt < 3; ++pt) { ml[p][pt] = nml[p][pt]; ow[p][pt] = now[p][pt]; }
    }
#undef P3_LOAD
}


__device__ __forceinline__ void ce_desc(float& a, float& b) { const float hi = fmaxf(a, b), lo = fminf(a, b); a = hi; b = lo; }
__device__ __forceinline__ void sort16_desc(float* v) {
    ce_desc(v[0], v[1]); ce_desc(v[2], v[3]); ce_desc(v[0], v[2]); ce_desc(v[1], v[3]); ce_desc(v[1], v[2]); ce_desc(v[4], v[5]); ce_desc(v[6], v[7]); ce_desc(v[4], v[6]);
    ce_desc(v[5], v[7]); ce_desc(v[5], v[6]); ce_desc(v[0], v[4]); ce_desc(v[2], v[6]); ce_desc(v[2], v[4]); ce_desc(v[1], v[5]); ce_desc(v[3], v[7]); ce_desc(v[3], v[5]);
    ce_desc(v[1], v[2]); ce_desc(v[3], v[4]); ce_desc(v[5], v[6]); ce_desc(v[8], v[9]); ce_desc(v[10], v[11]); ce_desc(v[8], v[10]); ce_desc(v[9], v[11]); ce_desc(v[9], v[10]);
    ce_desc(v[12], v[13]); ce_desc(v[14], v[15]); ce_desc(v[12], v[14]); ce_desc(v[13], v[15]); ce_desc(v[13], v[14]); ce_desc(v[8], v[12]); ce_desc(v[10], v[14]); ce_desc(v[10], v[12]);
    ce_desc(v[9], v[13]); ce_desc(v[11], v[15]); ce_desc(v[11], v[13]); ce_desc(v[9], v[10]); ce_desc(v[11], v[12]); ce_desc(v[13], v[14]); ce_desc(v[0], v[8]); ce_desc(v[4], v[12]);
    ce_desc(v[4], v[8]); ce_desc(v[2], v[10]); ce_desc(v[6], v[14]); ce_desc(v[6], v[10]); ce_desc(v[2], v[4]); ce_desc(v[6], v[8]); ce_desc(v[10], v[12]); ce_desc(v[1], v[9]);
    ce_desc(v[5], v[13]); ce_desc(v[5], v[9]); ce_desc(v[3], v[11]); ce_desc(v[7], v[15]); ce_desc(v[7], v[11]); ce_desc(v[3], v[5]); ce_desc(v[7], v[9]); ce_desc(v[11], v[13]);
    ce_desc(v[1], v[2]); ce_desc(v[3], v[4]); ce_desc(v[5], v[6]); ce_desc(v[7], v[8]); ce_desc(v[9], v[10]); ce_desc(v[11], v[12]); ce_desc(v[13], v[14]);
}
__device__ __forceinline__ void merge16_desc(float* v) {
#pragma unroll
    for (int j = 8; j > 0; j >>= 1)
#pragma unroll
        for (int i = 0; i < 16; ++i) { const int l = i ^ j; if (l > i) ce_desc(v[i], v[l]); }
}
__device__ __forceinline__ void top16_of_two(float* a, const float* b) {
#pragma unroll
    for (int i = 0; i < 16; ++i) a[i] = fmaxf(a[i], b[15 - i]);
    merge16_desc(a);
}
__device__ __forceinline__ void top16_of_64(float* v) {
    sort16_desc(v); sort16_desc(v + 16); sort16_desc(v + 32); sort16_desc(v + 48);
    top16_of_two(v, v + 16); top16_of_two(v + 32, v + 48); top16_of_two(v, v + 32);
}
__device__ __forceinline__ void merge8_desc(float* v) {
#pragma unroll
    for (int j = 4; j > 0; j >>= 1)
#pragma unroll
        for (int i = 0; i < 8; ++i) { const int l = i ^ j; if (l > i) ce_desc(v[i], v[l]); }
}
__device__ __forceinline__ void top16_staircase(const float* A, const float* B, float* t1) {
    float Bp[16]; const float cb = 1.f - (A[15] + B[15]);
#pragma unroll
    for (int j = 0; j < 16; ++j) Bp[j] = B[j] + cb;
#define PK_CND(i, j) __builtin_bit_cast(float, (__builtin_bit_cast(unsigned, A[(i)] + Bp[(j)]) & ~255u) | (unsigned)(255 - (((i) << 4) | (j))))
#pragma unroll
    for (int j = 0; j < 16; ++j) t1[j] = PK_CND(0, j);
#pragma unroll
    for (int i = 4; i < 16; ++i) t1[i] = fmaxf(t1[i], PK_CND(4 + (15 - i), 0));
    merge16_desc(t1);
    float t2[16];
#pragma unroll
    for (int k = 0; k < 8; ++k) t2[k] = PK_CND(1, k);
    t2[8] = 0.f; t2[9] = 0.f; t2[10] = 0.f;
#pragma unroll
    for (int m = 0; m < 5; ++m) t2[11 + m] = PK_CND(2, 4 - m);
    merge16_desc(t2);
    float t3[9];
#pragma unroll
    for (int k = 0; k < 4; ++k) { t3[k] = PK_CND(3, k); t3[4 + k] = PK_CND(4 + (3 - k), 1); }
    merge8_desc(t3);
    t3[8] = PK_CND(4, 2);
#pragma unroll
    for (int k = 7; k >= 0; --k) ce_desc(t3[k], t3[k + 1]);
#pragma unroll
    for (int i = 7; i < 16; ++i) t2[i] = fmaxf(t2[i], t3[15 - i]);
    merge16_desc(t2);
#pragma unroll
    for (int i = 0; i < 16; ++i) t1[i] = fmaxf(t1[i], t2[15 - i]);
    merge16_desc(t1);
#undef PK_CND
}
__device__ __forceinline__ void topk_phase(Frame& F, const Args& a) {
    unsigned char* ws = a.ws; const GAS bf16* QP = (const GAS bf16*)(ws + WS_XN); const GAS bf16* SKB = (const GAS bf16*)(ws + WS_SKB); GAS int* EIDX = (GAS int*)(ws + WS_EIDX); GAS int* EIDX16 = (GAS int*)(ws + WS_EIDX16); GAS float* GATE = (GAS float*)(ws + WS_GATE);
    const int lane = lane_id(), r32 = lane & 31, hh = lane >> 5;
    LAS unsigned char* skl = F.lds;
    LAS int* ktab = (LAS int*)(F.lds + 65536 + F.wave * 8192);
    for (int unit = F.vcu; unit < 8 * (M / 512); unit += F.G) {
        const int h = unit & 7, tok0 = (unit >> 3) * 512 + F.wave * 64;
        __syncthreads();
#pragma unroll
        for (int i = 0; i < 8; ++i) { const int idx = (F.wave * 64 + lane_id()) + 512 * i, key = idx >> 4, ch = idx & 15;
            *(LAS v4u*)(skl + key * 256 + ((ch ^ (key & 15)) * 16)) = *(const GAS v4u*)(SKB + ((size_t)h * 256 + key) * 128 + ch * 8); }
        __syncthreads();
#pragma unroll 1
        for (int tt = 0; tt < 2; ++tt) {
            const size_t row = (size_t)(tok0 + tt * 32 + r32);
            float L[2][16];
#pragma unroll
            for (int c = 0; c < 2; ++c) {
                f32x16 acc[4];
#pragma unroll
                for (int kt = 0; kt < 4; ++kt) acc[kt] = (f32x16){0.f, 0.f, 0.f, 0.f, 0.f, 0.f, 0.f, 0.f, 0.f, 0.f, 0.f, 0.f, 0.f, 0.f, 0.f, 0.f};
                const GAS bf16* qb = QP + row * DM + h * 256 + c * 128 + 8 * hh;
#pragma unroll 2
                for (int st = 0; st < 8; ++st) {
                    const bf16x8 bq = *(const GAS bf16x8*)(qb + 16 * st);
#pragma unroll
                    for (int kt = 0; kt < 4; ++kt) { const int key = c * 128 + 32 * kt + r32; const bf16x8 ak = *(const LAS bf16x8*)(skl + key * 256 + (((2 * st + hh) ^ (key & 15)) * 16));
                        acc[kt] = __builtin_amdgcn_mfma_f32_32x32x16_bf16(ak, bq, acc[kt], 0, 0, 0); }
                }
                float v[64];
#pragma unroll
                for (int kt = 0; kt < 4; ++kt)
#pragma unroll
                    for (int r = 0; r < 16; ++r) { const int key = 32 * kt + (r & 3) + 8 * (r >> 2);
                        const float sc = acc[kt][r];
                        v[kt * 16 + r] = __builtin_bit_cast(float, (__builtin_bit_cast(unsigned, sc) & ~127u) | (unsigned)(key + 4 * hh)); }
                top16_of_64(v);
                float p[16];
#pragma unroll
                for (int i = 0; i < 16; ++i) { float lo_, hi_; SWAP_PAIR(__builtin_amdgcn_permlane32_swap, v[i], lo_, hi_); v[i] = lo_; p[i] = hi_; }
                top16_of_two(v, p);
#pragma unroll
                for (int i = 0; i < 16; ++i) { L[c][i] = v[i]; ktab[(c * 16 + i) * 64 + lane] = (int)(__builtin_bit_cast(unsigned, v[i]) & 127u); }
            }
            float cnd[16]; top16_staircase(L[0], L[1], cnd);
            float rstd; { const GAS f32x4* sp = (const GAS f32x4*)((const GAS float*)(ws + WS_SSQ) + row * 32); float ssq = 0.f;
#pragma unroll
              for (int i = 0; i < 8; ++i) { const f32x4 t4 = sp[i]; ssq += (t4.x + t4.y) + (t4.z + t4.w); }
              rstd = 1.0f / sqrtf(ssq * (1.f / DM) + EPS); }
            float mx = __builtin_bit_cast(float, __builtin_bit_cast(unsigned, cnd[0]) & ~255u), sum = 0.f; float ex[16];
#pragma unroll
            for (int i = 0; i < 16; ++i) { ex[i] = __expf((__builtin_bit_cast(float, __builtin_bit_cast(unsigned, cnd[i]) & ~255u) - mx) * rstd); sum += ex[i]; }
            const float inv = 1.f / sum;
            LDS_WAIT(); asm volatile("" ::: "memory");
            if (hh == 0) {
                int ev[16];
#pragma unroll
                for (int i = 0; i < 16; ++i) { const unsigned bits = 255u - (__builtin_bit_cast(unsigned, cnd[i]) & 255u); const int ia = (bits >> 4) & 15, jb = bits & 15; ev[i] = ktab[ia * 64 + lane] * 128 + ktab[(16 + jb) * 64 + lane]; }
                GAS int* ep = EIDX + row * 128 + h * 16; GAS float* gp = GATE + row * 128 + h * 16;
#pragma unroll
                for (int i = 0; i < 2; ++i) *(GAS i32x4*)(EIDX16 + row * 64 + h * 8 + 4 * i) = (i32x4){ev[8 * i] | (ev[8 * i + 1] << 16), ev[8 * i + 2] | (ev[8 * i + 3] << 16), ev[8 * i + 4] | (ev[8 * i + 5] << 16), ev[8 * i + 6] | (ev[8 * i + 7] << 16)};
#pragma unroll
                for (int i = 0; i < 4; ++i) { *(GAS i32x4*)(ep + 4 * i) = (i32x4){ev[4 * i], ev[4 * i + 1], ev[4 * i + 2], ev[4 * i + 3]}; *(GAS f32x4*)(gp + 4 * i) = (f32x4){ex[4 * i] * inv, ex[4 * i + 1] * inv, ex[4 * i + 2] * inv, ex[4 * i + 3] * inv}; }
            }
            LDS_WAIT(); asm volatile("" ::: "memory");
        }
    }
}

__device__ __forceinline__ void gla_prep_phase(Frame& F, const Args& a) {
    unsigned char* ws = a.ws; const bf16* PROJ;
    const int w = F.wave;
    LAS unsigned char* L = F.lds;
    LAS unsigned char* Qraw = L; LAS unsigned char* Kraw = L + 16384; LAS unsigned char* Vraw = L + 32768; LAS float* GDf = (LAS float*)(L + 65536); LAS float* GSUM = (LAS float*)(L + 73728);
    LAS unsigned char* IMGQ = L + 77824; LAS unsigned char* IMGK = L + 95232; LAS unsigned char* IMGE = L + 112640; LAS unsigned char* AMI = L + 32768;
    v4u rq[2], rk[2], rv[4]; f32x4 rg0, rg1;
#define PREP_LOAD(IT) do { const int b_ = (IT) >> 8, h_ = ((IT) >> 6) & 3, n_ = (IT) & 63; const size_t row0_ = (size_t)b_ * SEQ + n_ * 64; ws = opaque(ws); PROJ = (const bf16*)(ws + WS_PROJ); const int tid_ = opaque_v((F.wave * 64 + lane_id())); \
        _Pragma("unroll") for (int i = 0; i < 2; ++i) { const int idx = tid_ + 512 * i, r = idx >> 4, c = idx & 15; \
            rq[i] = *(const GAS v4u*)(PROJ + (row0_ + r) * NINP + O_GQ + h_ * 128 + c * 8); rk[i] = *(const GAS v4u*)(PROJ + (row0_ + r) * NINP + O_GK + h_ * 128 + c * 8); } \
        _Pragma("unroll") for (int i = 0; i < 4; ++i) { const int idx = tid_ + 512 * i, r = idx >> 5, c = idx & 31; rv[i] = *(const GAS v4u*)(PROJ + (row0_ + r) * NINP + O_GV + h_ * 256 + c * 8); } \
        if (tid_ < 256) { const int r = tid_ >> 2, c = tid_ & 3; const GAS float* gsrc = (const GAS float*)(ws + WS_GDB) + (row0_ + r) * 32 + c * 8; rg0 = *(const GAS f32x4*)gsrc; rg1 = *(const GAS f32x4*)(gsrc + 4); } } while (0)
#define PREP_STORE() do { const int tid_ = opaque_v((F.wave * 64 + lane_id())); \
        _Pragma("unroll") for (int i = 0; i < 2; ++i) { const int idx = tid_ + 512 * i, r = idx >> 4, c = idx & 15; *(LAS v4u*)(Qraw + r * 256 + c * 16) = rq[i]; *(LAS v4u*)(Kraw + r * 256 + c * 16) = rk[i]; } \
        _Pragma("unroll") for (int i = 0; i < 4; ++i) { const int idx = tid_ + 512 * i, r = idx >> 5, c = idx & 31; *(LAS v4u*)(Vraw + r * 512 + c * 16) = rv[i]; } \
        if (tid_ < 256) { const int r = tid_ >> 2, c = tid_ & 3; *(LAS f32x4*)(GDf + r * 32 + c * 8) = rg0; *(LAS f32x4*)(GDf + r * 32 + c * 8 + 4) = rg1; } } while (0)
    if (F.vcu < 1024) PREP_LOAD(F.vcu);
    float up0[16], up1[16], bias0 = 0.f, bias1 = 0.f; int hcur = -1;
    for (int it = F.vcu; it < 1024; it += F.G) {
        const int b = it >> 8, h = (it >> 6) & 3, n = it & 63;
        int tid = opaque_v((F.wave * 64 + lane_id())), lane = tid & 63, r32 = lane & 31, hh = lane >> 5;
        if (h != hcur) { hcur = h; const int d = tid & 127; const GAS float* u0 = (const GAS float*)a.in[3] + h * 128 + d; const GAS float* u1 = (const GAS float*)a.in[5] + h * 128 + d;
#pragma unroll
            for (int r = 0; r < 16; ++r) { up0[r] = u0[r * 512]; up1[r] = u1[r * 512]; }
            bias0 = ((const GAS float*)a.in[4])[h * 128 + d]; bias1 = ((const GAS float*)a.in[6])[h * 128 + d]; }
        PREP_STORE();
        __syncthreads();
        if (it + F.G < 1024) PREP_LOAD(it + F.G);
#pragma unroll
        for (int ks = 0; ks < 4; ++ks) { unsigned pk[4];
#pragma unroll
            for (int p = 0; p < 4; ++p) { const int s0 = 16 * ks + 8 * hh + 2 * p; const unsigned lo = *(const LAS unsigned short*)(Vraw + s0 * 512 + (32 * w + r32) * 2), hi = *(const LAS unsigned short*)(Vraw + (s0 + 1) * 512 + (32 * w + r32) * 2); pk[p] = lo | (hi << 16); }
            *(GAS v4u*)((unsigned char*)a.out + OUT_GT_VT + (size_t)it * 32768 + (w * 4 + ks) * 1024 + lane * 16) = (v4u){pk[0], pk[1], pk[2], pk[3]}; }
        for (int dir = 0; dir < 2; ++dir) {
            const size_t idir = (size_t)(((b * 4 + h) * 2 + dir) * 64 + n); ws = opaque(ws); tid = opaque_v(tid); lane = tid & 63; r32 = lane & 31; hh = lane >> 5;
            {
                const int d = tid & 127, tq = tid >> 7; const float bias = dir ? bias1 : bias0;
                float up[16];
#pragma unroll
                for (int r = 0; r < 16; ++r) up[r] = dir ? up1[r] : up0[r];
                float c[16];
#pragma unroll
                for (int i = 0; i < 16; ++i) { const LAS float* g = GDf + (16 * tq + i) * 32 + dir * 16; float z = bias;
#pragma unroll
                    for (int r = 0; r < 16; ++r) z += g[r] * up[r];
                    c[i] = (fminf(z, 0.f) - __logf(1.f + __expf(-fabsf(z)))) * (1.f / 16.f); }
                if (dir == 0) {
#pragma unroll
                    for (int i = 1; i < 16; ++i) c[i] += c[i - 1];
                } else {
#pragma unroll
                    for (int i = 14; i >= 0; --i) c[i] += c[i + 1];
                }
                GSUM[(dir * 4 + tq) * 128 + d] = dir == 0 ? c[15] : c[0];
                __syncthreads();
                const float t0 = GSUM[(dir * 4 + 0) * 128 + d], t1 = GSUM[(dir * 4 + 1) * 128 + d], t2 = GSUM[(dir * 4 + 2) * 128 + d], t3 = GSUM[(dir * 4 + 3) * 128 + d];
                const float Bt = (t0 + t1) + (t2 + t3);
                float off;
                if (dir == 0) off = (tq > 0 ? t0 : 0.f) + (tq > 1 ? t1 : 0.f) + (tq > 2 ? t2 : 0.f);
                else off = (tq < 1 ? t1 : 0.f) + (tq < 2 ? t2 : 0.f) + (tq < 3 ? t3 : 0.f);
                unsigned kep[8];
#pragma unroll
                for (int i = 0; i < 16; i += 2) { float ke2[2];
#pragma unroll
                    for (int q = 0; q < 2; ++q) { const int t = 16 * tq + i + q; const float bi = c[i + q] + off;
                        const float qv = bf2f(*(const LAS unsigned short*)(Qraw + t * 256 + d * 2)), kv = bf2f(*(const LAS unsigned short*)(Kraw + t * 256 + d * 2));
                        *(LAS unsigned short*)(IMGQ + t * 272 + d * 2) = (unsigned short)pk2(qv * 0.08838834764831845f * __expf(bi), 0.f);
                        *(LAS unsigned short*)(IMGK + t * 272 + d * 2) = (unsigned short)pk2(kv * __expf(-bi), 0.f);
                        ke2[q] = kv * __expf(Bt - bi); }
                    kep[i >> 1] = pk2(ke2[0], ke2[1]); }
                *(LAS v4u*)(IMGE + d * 144 + (16 * tq) * 2) = (v4u){kep[0], kep[1], kep[2], kep[3]};
                *(LAS v4u*)(IMGE + d * 144 + (16 * tq + 8) * 2) = (v4u){kep[4], kep[5], kep[6], kep[7]};
                if (tq == 0) ((GAS float*)((unsigned char*)a.out + OUT_GT_DEC))[idir * 128 + d] = __expf(Bt);
            }
            __syncthreads();
            if (w < 4) {
                const int si = w >> 1, ti = w & 1; f32x16 acc = (f32x16){0.f, 0.f, 0.f, 0.f, 0.f, 0.f, 0.f, 0.f, 0.f, 0.f, 0.f, 0.f, 0.f, 0.f, 0.f, 0.f};
#pragma unroll
                for (int ks = 0; ks < 8; ++ks) { const bf16x8 ak = *(const LAS bf16x8*)(IMGK + (32 * si + r32) * 272 + (16 * ks + 8 * hh) * 2), bq = *(const LAS bf16x8*)(IMGQ + (32 * ti + r32) * 272 + (16 * ks + 8 * hh) * 2);
                    acc = __builtin_amdgcn_mfma_f32_32x32x16_bf16(ak, bq, acc, 0, 0, 0); }
                const int t = 32 * ti + r32;
#pragma unroll
                for (int qd = 0; qd < 4; ++qd) { float v4[4];
#pragma unroll
                    for (int i = 0; i < 4; ++i) { const int sidx = 32 * si + 8 * qd + 4 * hh + i; const float x = acc[4 * qd + i]; const bool keep = dir == 0 ? (sidx <= t) : (sidx >= t); v4[i] = keep ? x : 0.f; }
                    *(LAS unsigned long long*)(AMI + t * 144 + (32 * si + 8 * qd + 4 * hh) * 2) = (unsigned long long)pk2(v4[0], v4[1]) | ((unsigned long long)pk2(v4[2], v4[3]) << 32); }
            } else {
                const int w4 = w - 4;
#pragma unroll
                for (int q = 0; q < 4; ++q) { const int bq = w4 * 4 + q, tt = bq >> 3, ks = bq & 7, j = ks >> 1, u = ks & 1; const int t = 32 * tt + r32;
                    const unsigned long long p0 = *(const LAS unsigned long long*)(IMGQ + t * 272 + (32 * j + 16 * u + 4 * hh) * 2), p1 = *(const LAS unsigned long long*)(IMGQ + t * 272 + (32 * j + 16 * u + 8 + 4 * hh) * 2);
                    *(GAS v4u*)(ws + WS_GT_QD + idir * 16384 + bq * 1024 + lane * 16) = (v4u){(unsigned)p0, (unsigned)(p0 >> 32), (unsigned)p1, (unsigned)(p1 >> 32)}; }
#pragma unroll
                for (int q = 0; q < 4; ++q) { const int bk = w4 * 4 + q, j = bk >> 2, ks = bk & 3; const int d = 32 * j + r32;
                    *(GAS v4u*)(ws + WS_GT_KE + idir * 16384 + bk * 1024 + lane * 16) = *(const LAS v4u*)(IMGE + d * 144 + (16 * ks + 8 * hh) * 2); }
            }
            __syncthreads();
            { const int tt = w >> 2, ks = w & 3; const int t = 32 * tt + r32;
              *(GAS v4u*)((unsigned char*)a.out + OUT_GT_AM + idir * 8192 + w * 1024 + lane * 16) = *(const LAS v4u*)(AMI + t * 144 + (16 * ks + 8 * hh) * 2); }
            __syncthreads();
        }
    }
#undef PREP_LOAD
#undef PREP_STORE
}

__device__ __forceinline__ void gla_seq_phase(Frame& F, const Args& a) {
    unsigned char* ws = a.ws;
    const int w = F.wave;
    constexpr int GBUF = 57856;
    const int bx_ = (int)blockIdx.x;
    const int su_ = (F.G % 8 == 0 && F.G >= 64) ? (((bx_ >> 3) < 8) ? (bx_ & 7) * 8 + (bx_ >> 3) : 64) : bx_;
    for (int unit = su_; unit < 64; unit += F.G) {
        const int dir = unit & 1, eh = (unit >> 1) & 1, bh = unit >> 2, b = bh >> 2, h = bh & 3;
        if (w >= 4) {
            const int lt = opaque_v((F.wave * 64 + lane_id())) - 256;
            v4u A[15], B[15];
#define GLA_LOAD(R, NS) do { const int n_ = dir ? 63 - (NS) : (NS); const size_t idir_ = (size_t)((bh * 2 + dir) * 64 + n_), iv_ = (size_t)(bh * 64 + n_); const unsigned char* o_ = opaque((const unsigned char*)a.out); const unsigned char* w_ = opaque(ws); \
            const GAS v4u* gq_ = (const GAS v4u*)(w_ + WS_GT_QD + idir_ * 16384); const GAS v4u* gk_ = (const GAS v4u*)(w_ + WS_GT_KE + idir_ * 16384); const GAS v4u* ga_ = (const GAS v4u*)(o_ + OUT_GT_AM + idir_ * 8192); \
            const GAS v4u* gv_ = (const GAS v4u*)(o_ + OUT_GT_VT + iv_ * 32768 + eh * 16384); const GAS v4u* gd_ = (const GAS v4u*)(o_ + OUT_GT_DEC + idir_ * 512); \
            _Pragma("unroll") for (int i = 0; i < 4; ++i) { R[i] = gq_[lt + 256 * i]; R[4 + i] = gk_[lt + 256 * i]; R[10 + i] = gv_[lt + 256 * i]; } R[8] = ga_[lt]; R[9] = ga_[lt + 256]; R[14] = gd_[lt & 31]; } while (0)
#define GLA_WRITE(R, BUF) do { LAS v4u* d_ = (LAS v4u*)(F.lds + (BUF) * GBUF); \
            _Pragma("unroll") for (int i = 0; i < 4; ++i) { d_[lt + 256 * i] = R[i]; d_[1024 + lt + 256 * i] = R[4 + i]; d_[2560 + lt + 256 * i] = R[10 + i]; } d_[2048 + lt] = R[8]; d_[2048 + lt + 256] = R[9]; if (lt < 32) d_[3584 + lt] = R[14]; } while (0)
            GLA_LOAD(A, 0); GLA_LOAD(B, 1);
            GLA_WRITE(A, 0);
            __syncthreads();
#pragma unroll 1
            for (int ns = 0; ns < 64; ns += 2) {
                if (ns + 2 < 64) GLA_LOAD(A, ns + 2);
                GLA_WRITE(B, 1);
                __syncthreads();
                if (ns + 3 < 64) GLA_LOAD(B, ns + 3);
                if (ns + 2 < 64) GLA_WRITE(A, 0);
                __syncthreads();
            }
#undef GLA_LOAD
#undef GLA_WRITE
        } else {
            f32x16 S[4];
#pragma unroll
            for (int j = 0; j < 4; ++j) S[j] = (f32x16){0.f, 0.f, 0.f, 0.f, 0.f, 0.f, 0.f, 0.f, 0.f, 0.f, 0.f, 0.f, 0.f, 0.f, 0.f, 0.f};
            __syncthreads();
#pragma unroll 1
            for (int ns = 0; ns < 64; ++ns) {
                const int n = dir ? 63 - ns : ns;
                const int lane = opaque_v(lane_id()), r32 = lane & 31, hh = lane >> 5;
                LAS unsigned char* QDl = F.lds + (ns & 1) * GBUF; LAS unsigned char* KEl = QDl + 16384; LAS unsigned char* AMl = QDl + 32768; LAS unsigned char* VTl = QDl + 40960; LAS float* DECl = (LAS float*)(QDl + 57344);
                GAS bf16* Out = (GAS bf16*)(opaque(ws) + (dir ? WS_OB : WS_OF));
                bf16x8 vf[4];
#pragma unroll
                for (int ks = 0; ks < 4; ++ks) vf[ks] = *(const LAS bf16x8*)(VTl + (w * 4 + ks) * 1024 + lane * 16);
                f32x16 o[2];
#pragma unroll
                for (int tt = 0; tt < 2; ++tt) o[tt] = (f32x16){0.f, 0.f, 0.f, 0.f, 0.f, 0.f, 0.f, 0.f, 0.f, 0.f, 0.f, 0.f, 0.f, 0.f, 0.f, 0.f};
#pragma unroll
                for (int ks8 = 0; ks8 < 8; ++ks8) { const int j = ks8 >> 1, u = ks8 & 1; v4u sb;
                    sb.x = pg8::cvt_pk_bf16(S[j][8 * u + 0], S[j][8 * u + 1]); sb.y = pg8::cvt_pk_bf16(S[j][8 * u + 2], S[j][8 * u + 3]); sb.z = pg8::cvt_pk_bf16(S[j][8 * u + 4], S[j][8 * u + 5]); sb.w = pg8::cvt_pk_bf16(S[j][8 * u + 6], S[j][8 * u + 7]);
                    const bf16x8 bs = __builtin_bit_cast(bf16x8, sb);
#pragma unroll
                    for (int tt = 0; tt < 2; ++tt) { const bf16x8 aq = *(const LAS bf16x8*)(QDl + (tt * 8 + ks8) * 1024 + lane * 16); o[tt] = __builtin_amdgcn_mfma_f32_32x32x16_bf16(aq, bs, o[tt], 0, 0, 0); } }
#pragma unroll
                for (int ks = 0; ks < 4; ++ks)
#pragma unroll
                    for (int tt = 0; tt < 2; ++tt) { const bf16x8 am = *(const LAS bf16x8*)(AMl + (tt * 4 + ks) * 1024 + lane * 16); o[tt] = __builtin_amdgcn_mfma_f32_32x32x16_bf16(am, vf[ks], o[tt], 0, 0, 0); }
#pragma unroll
                for (int tt = 0; tt < 2; ++tt)
#pragma unroll
                    for (int r = 0; r < 16; ++r) { const int t = 32 * tt + (r & 3) + 8 * (r >> 2) + 4 * hh; const float x = o[tt][r];
                        Out[((size_t)b * SEQ + 64 * n + t) * 1024 + h * 256 + 32 * (eh * 4 + w) + r32] = (bf16)pk2(x, 0.f); }
#pragma unroll
                for (int j = 0; j < 4; ++j) {
#pragma unroll
                    for (int q = 0; q < 4; ++q) { const f32x4 dv = *(const LAS f32x4*)(DECl + 32 * j + 8 * q + 4 * hh); S[j][4 * q + 0] *= dv.x; S[j][4 * q + 1] *= dv.y; S[j][4 * q + 2] *= dv.z; S[j][4 * q + 3] *= dv.w; }
#pragma unroll
                    for (int ks = 0; ks < 4; ++ks) { const bf16x8 ak = *(const LAS bf16x8*)(KEl + (j * 4 + ks) * 1024 + lane * 16); S[j] = __builtin_amdgcn_mfma_f32_32x32x16_bf16(ak, vf[ks], S[j], 0, 0, 0); } }
                __syncthreads();
            }
        }
    }
}

typedef short v4i16_t __attribute__((ext_vector_type(4)));
__device__ __forceinline__ void attn_phase(Frame& F, const Args& a, int qslot) {
    unsigned char* ws = a.ws; const bf16* PROJ;
    const int w = F.wave;
    volatile LAS int* uword = (volatile LAS int*)(F.lds + 2 * 78336);
    constexpr int NUNITS = 64 * 3 * 32;
#define ATT_DECODE(U) const int bh = (U) / 96, rem = (U) - bh * 96, p = rem >> 5, idx = rem & 31; const int lgd = 2 * p, d = 1 << lgd; \
        const int r = idx >> (5 - lgd), J = idx & ((32 >> lgd) - 1), Lc = SEQ >> lgd; const int b = bh >> 4, h = bh & 15; const int m0 = 128 * J - 64;
    v4u kx[4], vx[4]; v4u qw[2];
#define ATT_LOAD(U) do { ATT_DECODE(U) ws = opaque(ws); PROJ = (const bf16*)(ws + WS_PROJ); const int tid_ = opaque_v((F.wave * 64 + lane_id())); \
        _Pragma("unroll") for (int i = 0; i < 4; ++i) { const int kr = (tid_ >> 3) + 64 * i, ch = tid_ & 7; const int mp = m0 + kr; kx[i] = (v4u){0u, 0u, 0u, 0u}; vx[i] = kx[i]; \
            if (mp >= 0 && mp < Lc) { const bf16* src = PROJ + ((size_t)b * SEQ + r + d * mp) * NINP + O_AK + h * 64 + ch * 8; kx[i] = *(const GAS v4u*)src; vx[i] = *(const GAS v4u*)(src + (O_AV - O_AK)); } } \
        const int tokq_ = r + d * (128 * J + 16 * w + (tid_ & 15)); \
        _Pragma("unroll") for (int sft = 0; sft < 2; ++sft) qw[sft] = *(const GAS v4u*)(PROJ + ((size_t)b * SEQ + tokq_) * NINP + O_AQ + h * 64 + 32 * sft + 8 * ((tid_ & 63) >> 4)); } while (0)
    float tab[40];
    { const int l0 = opaque_v(lane_id());
#pragma unroll
      for (int c = 0; c < 40; ++c) { const int kb = c >> 3, uu = (c >> 2) & 1, rho = c & 3; const int jo = 32 * kb + 8 * (l0 >> 4) + 4 * uu + rho - 64 - (l0 & 15); const int aj = jo < 0 ? -jo : jo; tab[c] = aj <= 64 ? (float)aj : 3.0e38f; } }
#define ATT_FETCH(DST) do { int v_ = NUNITS; int qx_ = uword[2], qt_ = uword[3]; while (qt_ < 8) { const int t_ = (int)__hip_atomic_fetch_add((unsigned*)(F.ctl + CW_ATTQX + 128 * qslot + 16 * qx_), 1u, __ATOMIC_RELAXED, __HIP_MEMORY_SCOPE_AGENT); \
        if (t_ < 768) { v_ = qx_ * 768 + t_; break; } qx_ = (qx_ + 1) & 7; ++qt_; } uword[2] = qx_; uword[3] = qt_; DST = v_; } while (0)
    if ((F.wave * 64 + lane_id()) == 0) { uword[2] = (int)blockIdx.x & 7; uword[3] = 0; int f0, f1; ATT_FETCH(f0); ATT_FETCH(f1); uword[0] = f0; uword[1] = f1; }
    __syncthreads();
    int u = __builtin_amdgcn_readfirstlane(uword[0]), un = __builtin_amdgcn_readfirstlane(uword[1]); int par = 0;
#define ATT_WRITE(BUF) do { const int tid_ = opaque_v((F.wave * 64 + lane_id())); LAS unsigned char* Kw = F.lds + (BUF) * 78336; LAS unsigned char* Vw = Kw + 39168; \
        _Pragma("unroll") for (int i = 0; i < 4; ++i) { const int kr = (tid_ >> 3) + 64 * i, ch = tid_ & 7; *(LAS v4u*)(Kw + kr * 144 + ch * 16) = kx[i]; *(LAS v4u*)(Vw + kr * 144 + ch * 16) = vx[i]; } \
        if (tid_ < 128) { const int kr = 256 + (tid_ >> 3), ch = tid_ & 7; *(LAS v4u*)(Kw + kr * 144 + ch * 16) = (v4u){0u, 0u, 0u, 0u}; *(LAS v4u*)(Vw + kr * 144 + ch * 16) = (v4u){0u, 0u, 0u, 0u}; } } while (0)
    v4u qwc[2];
    if (u < NUNITS) { ATT_LOAD(u); ATT_WRITE(0); qwc[0] = qw[0]; qwc[1] = qw[1]; }
    __syncthreads();
    int bufi = 0;
    while (u < NUNITS) {
        const int tid = opaque_v((F.wave * 64 + lane_id())), lane = tid & 63, q16 = lane & 15, g = lane >> 4;
        int qnext = 0; if (tid == 0) ATT_FETCH(qnext);
        LAS unsigned char* Kl = F.lds + bufi * 78336; LAS unsigned char* Vl = Kl + 39168;
        bf16x8 qf[2];
#pragma unroll
        for (int sft = 0; sft < 2; ++sft) { v4u qs; constexpr float QS = 0.125f * 1.4426950408889634f; qs.x = pk2(bflo(qwc[sft].x) * QS, bfhi(qwc[sft].x) * QS); qs.y = pk2(bflo(qwc[sft].y) * QS, bfhi(qwc[sft].y) * QS); qs.z = pk2(bflo(qwc[sft].z) * QS, bfhi(qwc[sft].z) * QS); qs.w = pk2(bflo(qwc[sft].w) * QS, bfhi(qwc[sft].w) * QS);
            qf[sft] = __builtin_bit_cast(bf16x8, qs); }
        ATT_DECODE(u)
        const int tokq = r + d * (128 * J + 16 * w + q16);
        if (un < NUNITS) ATT_LOAD(un);
        const float nslope = -exp2f(-0.5f * (float)(h + 1)) * (float)d * 1.4426950408889634f;
        const bool inrange = (m0 + 16 * w >= 0) && (m0 + 16 * w + 159 < Lc);
        float sv[5][2][4]; float mx = -3.0e38f;
#pragma unroll
        for (int kb = 0; kb < 5; ++kb)
#pragma unroll
            for (int uu = 0; uu < 2; ++uu) { f32x4 acc = (f32x4){0.f, 0.f, 0.f, 0.f};
                const int krow = 16 * w + 32 * kb + 8 * (q16 >> 2) + 4 * uu + (q16 & 3);
#pragma unroll
                for (int sft = 0; sft < 2; ++sft) { const bf16x8 ak = *(const LAS bf16x8*)(Kl + krow * 144 + (32 * sft + 8 * g) * 2); acc = __builtin_amdgcn_mfma_f32_16x16x32_bf16(ak, qf[sft], acc, 0, 0, 0); }
#pragma unroll
                for (int rho = 0; rho < 4; ++rho) { const float x = acc[rho]; sv[kb][uu][rho] = __builtin_fmaf(nslope, tab[kb * 8 + uu * 4 + rho], x); } }
        if (!inrange) {
#pragma unroll
            for (int kb = 0; kb < 5; ++kb)
#pragma unroll
                for (int uu = 0; uu < 2; ++uu)
#pragma unroll
                    for (int rho = 0; rho < 4; ++rho) { const int mp = m0 + 16 * w + 32 * kb + 8 * g + 4 * uu + rho; if (mp < 0 || mp >= Lc) sv[kb][uu][rho] = -3.0e38f; } }
#pragma unroll
        for (int kb = 0; kb < 5; ++kb)
#pragma unroll
            for (int uu = 0; uu < 2; ++uu)
#pragma unroll
                for (int rho = 0; rho < 4; ++rho) mx = fmaxf(mx, sv[kb][uu][rho]);
        mx = xrow_max(mx);
        float lsum = 0.f; bf16x8 pf[5];
#pragma unroll
        for (int kb = 0; kb < 5; ++kb) { float e[8];
#pragma unroll
            for (int uu = 0; uu < 2; ++uu)
#pragma unroll
                for (int rho = 0; rho < 4; ++rho) { const float pe = __builtin_amdgcn_exp2f(sv[kb][uu][rho] - mx); e[uu * 4 + rho] = pe; lsum += pe; }
            v4u pw; pw.x = pk2(e[0], e[1]); pw.y = pk2(e[2], e[3]); pw.z = pk2(e[4], e[5]); pw.w = pk2(e[6], e[7]); pf[kb] = __builtin_bit_cast(bf16x8, pw); }
        lsum = xrow_sum(lsum);
        f32x4 oT[4];
#pragma unroll
        for (int nn = 0; nn < 4; ++nn) oT[nn] = (f32x4){0.f, 0.f, 0.f, 0.f};
#pragma unroll
        for (int kb = 0; kb < 5; ++kb)
#pragma unroll
            for (int nn = 0; nn < 4; ++nn) { const LAS unsigned char* va = Vl + (16 * w + 32 * kb + 8 * g + (q16 >> 2)) * 144 + (16 * nn + 4 * (q16 & 3)) * 2;
                const v4i16_t lo = __builtin_amdgcn_ds_read_tr16_b64_v4i16((LAS v4i16_t*)va), hi = __builtin_amdgcn_ds_read_tr16_b64_v4i16((LAS v4i16_t*)(va + 4 * 144));
                const bf16x8 vf = (bf16x8){lo[0], lo[1], lo[2], lo[3], hi[0], hi[1], hi[2], hi[3]};
                oT[nn] = __builtin_amdgcn_mfma_f32_16x16x32_bf16(vf, pf[kb], oT[nn], 0, 0, 0); }
        { const size_t rec = ((size_t)p * M + (size_t)b * SEQ + tokq) * 16 + h; GAS bf16* op = (GAS bf16*)(opaque(ws) + WS_ATTP) + rec * 64 + 4 * g;
#pragma unroll
          for (int nn = 0; nn < 4; ++nn) *(GAS unsigned long long*)(op + 16 * nn) = (unsigned long long)pk2(oT[nn][0], oT[nn][1]) | ((unsigned long long)pk2(oT[nn][2], oT[nn][3]) << 32);
          if (g == 0) { GAS float* ml = (GAS float*)(opaque(ws) + WS_ATTML) + rec * 2; ml[0] = mx * 0.6931471805599453f; ml[1] = lsum; } }
        if (un < NUNITS) { ATT_WRITE(bufi ^ 1); qwc[0] = qw[0]; qwc[1] = qw[1]; }
        if (tid == 0) uword[par] = qnext;
        __syncthreads();
        u = un; un = __builtin_amdgcn_readfirstlane(uword[par]); par ^= 1; bufi ^= 1;
    }
#undef ATT_WRITE
#undef ATT_DECODE
#undef ATT_LOAD
#undef ATT_FETCH
}

typedef __bf16 bf16x2_t __attribute__((ext_vector_type(2)));
__device__ __forceinline__ void peer_convert_tables(Frame& F, const Args& a, int qslot) {
    unsigned char* ws = a.ws; const int lane = lane_id(); volatile LAS int* uword = (volatile LAS int*)(F.lds + 2 * 78336 + 64);
    for (;;) {
        __syncthreads();
        if ((F.wave * 64 + lane_id()) == 0) uword[0] = (int)__hip_atomic_fetch_add((unsigned*)(F.ctl + CW_CONVQ + 64 * qslot), 1u, __ATOMIC_RELAXED, __HIP_MEMORY_SCOPE_AGENT);
        __syncthreads();
        const int blk = __builtin_amdgcn_readfirstlane(uword[0]);
        if (blk >= 2 * PEER_E / 128) break;
        const int rbase = blk * 128 + F.wave * 16; const bool isv = rbase >= PEER_E; const int e0 = rbase & (PEER_E - 1);
        const GAS float* src = (const GAS float*)(isv ? a.in[14] : a.in[13]) + (size_t)e0 * DM + 4 * lane;
        GAS unsigned char* dst = (GAS unsigned char*)a.out + (isv ? OUT_V8 : OUT_U8) + (size_t)e0 * 256 + 4 * lane;     GAS float* sc = (GAS float*)(ws + (isv ? WS_SV : WS_SU)) + e0;
        f32x4 v[8], vn[8];
#pragma unroll
        for (int j = 0; j < 8; ++j) v[j] = *(const GAS f32x4*)(src + 256 * j);
#pragma unroll 1
        for (int i = 0; i < 16; ++i) { const int in_ = i + 1 < 16 ? i + 1 : i;
#pragma unroll
            for (int j = 0; j < 8; ++j) vn[j] = *(const GAS f32x4*)(src + (size_t)in_ * DM + 256 * j);
            float am = 0.f;
#pragma unroll
            for (int j = 0; j < 8; ++j) am = fmaxf(am, fmaxf(fmaxf(fabsf(v[j].x), fabsf(v[j].y)), fmaxf(fabsf(v[j].z), fabsf(v[j].w))));
            am = wave_max(am); am = fmaxf(am, 1e-30f);
            const float inv = 440.f / am;
#pragma unroll
            for (int j = 0; j < 8; ++j) { int p = __builtin_amdgcn_cvt_pk_fp8_f32(v[j].x * inv, v[j].y * inv, 0, false); p = __builtin_amdgcn_cvt_pk_fp8_f32(v[j].z * inv, v[j].w * inv, p, true);
                *(GAS int*)(dst + (size_t)i * 256 + (size_t)j * (PEER_E * 256)) = p; }
            if (lane == 0) sc[i] = am * (1.f / 440.f);
#pragma unroll
            for (int j = 0; j < 8; ++j) v[j] = vn[j]; }
    }
}

__device__ __forceinline__ float dpp_row_sum(float x) {
#define PEER_DPP(ctrl) x += __builtin_bit_cast(float, __builtin_amdgcn_update_dpp(0, __builtin_bit_cast(int, x), ctrl, 0xF, 0xF, false))
    PEER_DPP(0xB1); PEER_DPP(0x4E); PEER_DPP(0x141); PEER_DPP(0x140);
#undef PEER_DPP
    return x;
}
template <bool VPH, int PBS, bool LA> __device__ __forceinline__ void peer_uv_phase(Frame& F, const Args& a) {
    unsigned char* ws = a.ws; GAS bf16* H = (GAS bf16*)(ws + WS_HB); const GAS float* g2 = (const GAS float*)a.in[10];
    const int sl = blockIdx.x & 7, rk = blockIdx.x >> 3, nrk = F.G >> 3, tpw = M / nrk / NWAVES, nq = tpw / 4;
    const unsigned char* TAB; const GAS int* EIDX; const GAS float* SSQ; const GAS float* PW; GAS float* PD; GAS float* SSQ2;
    LAS int* idt = (LAS int*)(F.lds + F.wave * 8704);
    LAS float* wt = (LAS float*)(F.lds + F.wave * 8704 + 4352);
    const int t0 = (rk * NWAVES + F.wave) * tpw;
#define PEER_STAGE_LOAD(QI) do { const size_t tb_ = (size_t)(t0 + 4 * (QI) + a4) * 64; _Pragma("unroll") for (int k = 0; k < 4; ++k) sid[k] = EIDX[tb_ + 16 * k + q]; } while (0)
#define PEER_STAGE_WRITE(QI) do { const int bf_ = ((QI) & 1) * 528; _Pragma("unroll") for (int k = 0; k < 4; ++k) *(LAS i32x2*)(idt + bf_ + a4 * 132 + 32 * k + 2 * q) = (i32x2){sid[k] & 0xffff, (int)((unsigned)sid[k] >> 16)}; } while (0)
#define PEER_STAGE_W(QI) do { if (VPH) { const size_t tb_ = (size_t)(t0 + 4 * (QI) + a4) * 128; const int bf_ = ((QI) & 1) * 528; _Pragma("unroll") for (int k = 0; k < 8; ++k) wt[bf_ + a4 * 132 + 16 * k + q] = PW[tb_ + 16 * k + q]; LDS_WAIT(); asm volatile("" ::: "memory"); } } while (0)
#define PEER_ISSUE(R, QI, WB) do { const int bf_ = ((QI) & 1) * 528 + a4 * 132 + (WB) * PBS; i32x4 e4_; _Pragma("unroll") for (int j = 0; j < PBS; ++j) { if ((j & 3) == 0) e4_ = *(const LAS i32x4*)(idt + bf_ + j); const int e_ = (j & 3) == 0 ? e4_.x : (j & 3) == 1 ? e4_.y : (j & 3) == 2 ? e4_.z : e4_.w; R[j] = ldu<i32x4>(TAB, (unsigned)e_ * 256u + (unsigned)(16 * q)); } } while (0)
    unsigned xq[8]; float acc[16];
#define PEER_QUAD_BEGIN(QI) do { const size_t t_ = (size_t)(t0 + 4 * (QI) + a4); \
        if (!VPH) { f32x4 hq[4]; { const v4u h0_ = *(const GAS v4u*)(H + t_ * DM + 256 * sl + 16 * q), h1_ = *(const GAS v4u*)(H + t_ * DM + 256 * sl + 16 * q + 8); \
            hq[0] = (f32x4){bflo(h0_.x), bfhi(h0_.x), bflo(h0_.y), bfhi(h0_.y)}; hq[1] = (f32x4){bflo(h0_.z), bfhi(h0_.z), bflo(h0_.w), bfhi(h0_.w)}; hq[2] = (f32x4){bflo(h1_.x), bfhi(h1_.x), bflo(h1_.y), bfhi(h1_.y)}; hq[3] = (f32x4){bflo(h1_.z), bfhi(h1_.z), bflo(h1_.w), bfhi(h1_.w)}; }  const float pss_ = dpp_row_sum(SSQ[t_ * 32 + q] + SSQ[t_ * 32 + 16 + q]); const float rstd_ = 1.f / sqrtf(pss_ * (1.f / DM) + EPS); f32x4 gv[4]; \
            _Pragma("unroll") for (int k = 0; k < 4; ++k) gv[k] = *(const GAS f32x4*)(g2 + 256 * sl + 16 * q + 4 * k); \
            _Pragma("unroll") for (int k = 0; k < 4; ++k) { xq[2 * k] = pk2(hq[k].x * rstd_ * gv[k].x, hq[k].y * rstd_ * gv[k].y); xq[2 * k + 1] = pk2(hq[k].z * rstd_ * gv[k].z, hq[k].w * rstd_ * gv[k].w); } } \
        else { _Pragma("unroll") for (int k = 0; k < 16; ++k) acc[k] = 0.f; } } while (0)
#define PEER_COMPUTE(R, QI, WB) do { if (!VPH) { float pdb_ = 0.f; _Pragma("unroll") for (int j = 0; j < PBS; ++j) { float d_ = 0.f; _Pragma("unroll") for (int k = 0; k < 4; ++k) { const int dw_ = R[j][k]; \
                d_ = __builtin_amdgcn_fdot2_f32_bf16(__builtin_amdgcn_cvt_scalef32_pk_bf16_fp8(dw_, 1.0f, false), __builtin_bit_cast(bf16x2_t, xq[2 * k]), d_, false); \
                d_ = __builtin_amdgcn_fdot2_f32_bf16(__builtin_amdgcn_cvt_scalef32_pk_bf16_fp8(dw_, 1.0f, true), __builtin_bit_cast(bf16x2_t, xq[2 * k + 1]), d_, false); } \
                d_ = dpp_row_sum(d_); pdb_ = (q == j) ? d_ : pdb_; } \
            if (q < PBS) PD[((size_t)(t0 + 4 * (QI) + a4) * 8 + sl) * 128 + PBS * (WB) + q] = pdb_; } \
        else { const int bf_ = ((QI) & 1) * 528 + a4 * 132 + (WB) * PBS; f32x4 w4_; _Pragma("unroll") for (int j = 0; j < PBS; ++j) { if ((j & 3) == 0) w4_ = *(const LAS f32x4*)(wt + bf_ + j); const float w_ = (j & 3) == 0 ? w4_.x : (j & 3) == 1 ? w4_.y : (j & 3) == 2 ? w4_.z : w4_.w; int r0_ = R[j][0], r1_ = R[j][1], r2_ = R[j][2], r3_ = R[j][3]; asm volatile("" : "+v"(r0_), "+v"(r1_), "+v"(r2_), "+v"(r3_));     \
                _Pragma("unroll") for (int k = 0; k < 4; ++k) { const int dw_ = k == 0 ? r0_ : k == 1 ? r1_ : k == 2 ? r2_ : r3_; \
                const f32x2 lo_ = __builtin_amdgcn_cvt_pk_f32_fp8(dw_, false), hi_ = __builtin_amdgcn_cvt_pk_f32_fp8(dw_, true); \
                acc[4 * k + 0] += w_ * lo_.x; acc[4 * k + 1] += w_ * lo_.y; acc[4 * k + 2] += w_ * hi_.x; acc[4 * k + 3] += w_ * hi_.y; } } } } while (0)
#define PEER_QUAD_END(QI) do { if (VPH) { const size_t t_ = (size_t)(t0 + 4 * (QI) + a4); GAS bf16* hp_ = H + t_ * DM + 256 * sl + 16 * q; const v4u h0_ = *(const GAS v4u*)hp_, h1_ = *(const GAS v4u*)(hp_ + 8); \
            float y_[16]; y_[0] = bflo(h0_.x); y_[1] = bfhi(h0_.x); y_[2] = bflo(h0_.y); y_[3] = bfhi(h0_.y); y_[4] = bflo(h0_.z); y_[5] = bfhi(h0_.z); y_[6] = bflo(h0_.w); y_[7] = bfhi(h0_.w); \
            y_[8] = bflo(h1_.x); y_[9] = bfhi(h1_.x); y_[10] = bflo(h1_.y); y_[11] = bfhi(h1_.y); y_[12] = bflo(h1_.z); y_[13] = bfhi(h1_.z); y_[14] = bflo(h1_.w); y_[15] = bfhi(h1_.w); \
            float ss_ = 0.f; _Pragma("unroll") for (int k = 0; k < 16; ++k) { y_[k] += acc[k]; ss_ += y_[k] * y_[k]; } \
            *(GAS v4u*)hp_ = (v4u){pk2(y_[0], y_[1]), pk2(y_[2], y_[3]), pk2(y_[4], y_[5]), pk2(y_[6], y_[7])}; *(GAS v4u*)(hp_ + 8) = (v4u){pk2(y_[8], y_[9]), pk2(y_[10], y_[11]), pk2(y_[12], y_[13]), pk2(y_[14], y_[15])}; \
            ss_ = dpp_row_sum(ss_); if (q == 0) SSQ2[t_ * 8 + sl] = ss_; } } while (0)
#pragma unroll 1
    for (int qi = 0; qi < nq; ++qi) {
        i32x4 rA[PBS], rB[PBS];
        const int lane = opaque_v(lane_id()), a4 = lane >> 4, q = lane & 15; ws = opaque(ws); H = (GAS bf16*)(ws + WS_HB);
        TAB = opaque((const unsigned char*)a.out) + (VPH ? OUT_V8 : OUT_U8) + (size_t)sl * (PEER_E * 256); EIDX = (const GAS int*)(ws + WS_EIDX16); SSQ = (const GAS float*)(ws + WS_SSQ); PW = (const GAS float*)(ws + WS_PW); PD = (GAS float*)(ws + WS_PD); SSQ2 = (GAS float*)(ws + WS_SSQ2);
        int sid[4];
        if (!LA || qi == 0) { PEER_STAGE_LOAD(qi); PEER_STAGE_WRITE(qi); LDS_WAIT(); asm volatile("" ::: "memory"); }
        PEER_ISSUE(rA, qi, 0);
        PEER_ISSUE(rB, qi, 1);
        if (LA && qi + 1 < nq) PEER_STAGE_LOAD(qi + 1);
        PEER_STAGE_W(qi);
        PEER_QUAD_BEGIN(qi);
#pragma unroll
        for (int wb = 0; wb < 128 / PBS; wb += 2) {
            PEER_COMPUTE(rA, qi, wb); if (wb + 2 < 128 / PBS) { PEER_ISSUE(rA, qi, wb + 2); }
            PEER_COMPUTE(rB, qi, wb + 1); if (wb + 3 < 128 / PBS) { PEER_ISSUE(rB, qi, wb + 3); }
        }
        PEER_QUAD_END(qi);
        if (LA && qi + 1 < nq) { PEER_STAGE_WRITE(qi + 1); LDS_WAIT(); asm volatile("" ::: "memory"); }
    }
#undef PEER_STAGE_LOAD
#undef PEER_STAGE_WRITE
#undef PEER_STAGE_W
#undef PEER_ISSUE
#undef PEER_QUAD_BEGIN
#undef PEER_COMPUTE
#undef PEER_QUAD_END
}
__device__ __forceinline__ void peer_w_phase(Frame& F, const Args& a) {
    unsigned char* ws = a.ws; const float* PD = (const float*)(ws + WS_PD); const int* EIDX = (const int*)(ws + WS_EIDX); const float* GATE = (const float*)(ws + WS_GATE);
    const float* SU = (const float*)(ws + WS_SU); const float* SV = (const float*)(ws + WS_SV); float* PW = (float*)(ws + WS_PW);
    for (int i = F.vcu * 512 + (F.wave * 64 + lane_id()); i < M * 128; i += F.G * 512) { const int t = i >> 7, p = i & 127; float d = 0.f;
#pragma unroll
        for (int sl = 0; sl < 8; ++sl) d += PD[((size_t)t * 8 + sl) * 128 + p];
        const int e = EIDX[i]; d *= SU[e];
        PW[i] = GATE[i] * 0.5f * d * (1.f + erff(d * 0.70710678118654752f)) * SV[e]; }
}
__device__ __forceinline__ void peer_n_phase(Frame& F, const Args& a) {
    unsigned char* ws = a.ws; const GAS bf16* Y = (const GAS bf16*)(ws + WS_HB); GAS float* O = (GAS float*)a.out; const GAS float* gf = (const GAS float*)a.in[15]; const GAS float* SSQ2 = (const GAS float*)(ws + WS_SSQ2); const int lane = lane_id();
    f32x4 g0[4], g1[4];
#pragma unroll
    for (int j = 0; j < 4; ++j) { g0[j] = *(const GAS f32x4*)(gf + 512 * j + 8 * lane); g1[j] = *(const GAS f32x4*)(gf + 512 * j + 8 * lane + 4); }
    const int gw = F.vcu * NWAVES + F.wave, NGW = F.G * NWAVES;
    v4u yw[4], yn[4]; f32x4 s0, s1, n0, n1;
    if (gw < M) {
#pragma unroll
        for (int j = 0; j < 4; ++j) yw[j] = *(const GAS v4u*)(Y + (size_t)gw * DM + 512 * j + 8 * lane);
        s0 = *(const GAS f32x4*)(SSQ2 + (size_t)gw * 8); s1 = *(const GAS f32x4*)(SSQ2 + (size_t)gw * 8 + 4); }
    for (int m = gw; m < M; m += NGW) { const int mn = m + NGW < M ? m + NGW : m;
#pragma unroll
        for (int j = 0; j < 4; ++j) yn[j] = *(const GAS v4u*)(Y + (size_t)mn * DM + 512 * j + 8 * lane);
        n0 = *(const GAS f32x4*)(SSQ2 + (size_t)mn * 8); n1 = *(const GAS f32x4*)(SSQ2 + (size_t)mn * 8 + 4);
        const float rf = 1.f / sqrtf((((s0.x + s0.y) + (s0.z + s0.w)) + ((s1.x + s1.y) + (s1.z + s1.w))) * (1.f / DM) + EPS);
#pragma unroll
        for (int j = 0; j < 4; ++j) {
            *(GAS f32x4*)(O + (size_t)m * DM + 512 * j + 8 * lane) = (f32x4){bflo(yw[j].x) * rf * g0[j].x, bfhi(yw[j].x) * rf * g0[j].y, bflo(yw[j].y) * rf * g0[j].z, bfhi(yw[j].y) * rf * g0[j].w};
            *(GAS f32x4*)(O + (size_t)m * DM + 512 * j + 8 * lane + 4) = (f32x4){bflo(yw[j].z) * rf * g1[j].x, bfhi(yw[j].z) * rf * g1[j].y, bflo(yw[j].w) * rf * g1[j].z, bfhi(yw[j].w) * rf * g1[j].w}; }
#pragma unroll
        for (int j = 0; j < 4; ++j) yw[j] = yn[j];
        s0 = n0; s1 = n1; }
}

__global__ void __launch_bounds__(NWAVES * 64, 2) mk_fwd(Args args_in) {
    extern __shared__ __attribute__((aligned(16))) unsigned char lds[];
    Args args = args_in;
#pragma unroll
    for (int i = 0; i < 16; ++i) args.in[i] = (const float*)(const GAS float*)args_in.in[i];
    args.out = (float*)(GAS float*)args_in.out; args.ws = (unsigned char*)(GAS unsigned char*)args_in.ws;
    Frame F;
    F.lds = (LAS unsigned char*)lds;
    F.MISC = (volatile LAS unsigned*)(F.lds + MISC_OFF);
    F.wave = __builtin_amdgcn_readfirstlane((int)threadIdx.x >> 6);
    F.G = gridDim.x; { const int bx = blockIdx.x; F.vcu = (F.G % 8 == 0) ? (bx % 8) * (F.G / 8) + bx / 8 : bx; }
    unsigned char* ws = args.ws;
    F.ctl = (gu32*)(ws + WS_CTL);
    for (int u = (F.wave * 64 + lane_id()); u < (LDS_BYTES - LDSCTL_OFF) / 4; u += NWAVES * 64) ((LAS unsigned*)(F.lds + LDSCTL_OFF))[u] = 0u;
    __syncthreads();
    XcdBarrier bar = xcd_barrier_post((unsigned*)(F.ctl + CW_BAR) + args.li * XCD_BAR_WORDS, F.MISC + 8);
    const int lo = args.ph_lo, hi = args.ph_hi;
#define IN(k) (lo <= (k) && (k) < hi)
#define BOTH(k) (IN(k) && IN((k) + 1))
#define GRID_BAR() xcd_barrier(bar)

    if (IN(0)) { for (int rep = 0; rep < NREP(0); ++rep) p0_prologue(F, args); if (BOTH(0)) GRID_BAR(); }

    if (IN(1)) {
        pg8::Gemm g{(const bf16*)(ws + WS_XN), (const bf16*)(ws + WS_WIN), M, NINP, DM}; pg8::StaticOrder S; S.init(M, NINP, F.G, (int)blockIdx.x);
        pg8::EpiBf16S E{(pg8::bf16_t*)(ws + WS_PROJ), NINP, F.lds + pg8::EPI_STAGE_OFF};
        for (int rep = 0; rep < NREP(1); ++rep) pg8::gemm_phase<pg8::EpiBf16S, pg8::StaticOrder, PG8_ALIGN, PG8_SP2>(F.lds + RING_OFF, g, S, E);
        for (int rep = 0; rep < NREP(11); ++rep) gd_side_gemm(F, args);
        if (BOTH(1)) GRID_BAR();
    }
    if (IN(2)) {
        for (int rep = 0; rep < NREP(21); ++rep) gla_prep_phase(F, args);
        GRID_BAR();
        for (int rep = 0; rep < NREP(2); ++rep) gla_seq_phase(F, args);
        const bool conv_first = ((int)blockIdx.x >> 3) >= CONV_FIRST_RANK;
        for (int pass = 0; pass < 2; ++pass) {
            if (pass == 1 || conv_first) peer_convert_tables(F, args, 0);
            if (pass == 0) attn_phase(F, args, 0); }
        if (BOTH(2)) GRID_BAR(); }
    if (IN(3)) { for (int rep = 0; rep < NREP(3); ++rep) p3_finalize(F, args); if (BOTH(3)) GRID_BAR(); if (REP_PHASE == 99) { GRID_BAR(); GRID_BAR(); GRID_BAR(); GRID_BAR(); } }
    if (IN(4)) {
        pg8::Gemm g{(const bf16*)(ws + WS_XN), (const bf16*)(ws + WS_WOUT), M, DM, DM}; pg8::StaticOrder S; S.init(M, DM, F.G, (int)blockIdx.x);
        pg8::EpiResS E{args.in[0], (pg8::bf16_t*)(ws + WS_HB), (float*)(ws + WS_SSQ), DM, F.lds + pg8::EPI_STAGE_OFF};
        for (int rep = 0; rep < NREP(4); ++rep) pg8::gemm_phase<pg8::EpiResS, pg8::StaticOrder, PG8_ALIGN, PG8_SP2>(F.lds + RING_OFF, g, S, E);
        if (BOTH(4)) GRID_BAR();
    }
    if (IN(5)) {
        pg8::Gemm g{(const bf16*)(ws + WS_HB), (const bf16*)(ws + WS_WQ), M, DM, DM}; pg8::StaticOrder S; S.init(M, DM, F.G, (int)blockIdx.x);
        pg8::EpiBf16S E{(pg8::bf16_t*)(ws + WS_XN), DM, F.lds + pg8::EPI_STAGE_OFF};
        for (int rep = 0; rep < NREP(5); ++rep) pg8::gemm_phase<pg8::EpiBf16S, pg8::StaticOrder, PG8_ALIGN, PG8_SP2>(F.lds + RING_OFF, g, S, E);
        if (BOTH(5)) GRID_BAR();
    }
    if (IN(6)) { for (int rep = 0; rep < NREP(6); ++rep) topk_phase(F, args); if (BOTH(6)) GRID_BAR(); }
    if (IN(7)) {
        for (int rep = 0; rep < NREP(7); ++rep) peer_uv_phase<false, 16, true>(F, args);
        GRID_BAR();
        peer_w_phase(F, args);
        GRID_BAR();
        if (REP_PHASE != 8) peer_uv_phase<true, 8, true>(F, args);
        GRID_BAR();
        peer_n_phase(F, args);
    }
#undef IN
#undef BOTH
}


extern "C" void kernel_launch(void* const* d_in, const int* in_sizes, int n_in, void* d_out, int out_size, void* d_ws, size_t ws_size, hipStream_t stream) {
    static int grid = 0;
    if (grid == 0) {
        if (n_in != 16 || in_sizes[0] != M * DM || out_size != M * DM || ws_size < WS_END) { fprintf(stderr, "kernel_launch: unexpected shapes: n_in %d in0 %d out %d ws %zu\n", n_in, n_in > 0 ? in_sizes[0] : -1, out_size, ws_size); grid = -1; return; }
        int dev = 0, cus = 0;
        if (hipGetDevice(&dev) != hipSuccess || hipDeviceGetAttribute(&cus, hipDeviceAttributeMultiprocessorCount, dev) != hipSuccess) { grid = -1; return; }
        if (hipFuncSetAttribute((const void*)mk_fwd, hipFuncAttributeMaxDynamicSharedMemorySize, LDS_BYTES) != hipSuccess) { fprintf(stderr, "kernel_launch: hipFuncSetAttribute failed\n"); grid = -1; return; }
        (void)hipGetLastError();
        grid = cus;
    }
    if (grid < 0) return;
    (void)hipMemsetAsync((char*)d_ws + WS_CTL, 0, CTL_ZERO_BYTES, stream);
    Args a{};
    for (int i = 0; i < 16; ++i) a.in[i] = (const float*)d_in[i];
    a.out = (float*)d_out; a.ws = (unsigned char*)d_ws;
    a.ph_lo = 0; a.ph_hi = 8; a.li = 0;
    hipLaunchKernelGGL(mk_fwd, dim3(grid), dim3(NWAVES * 64), LDS_BYTES, stream, a);
}
```

```cpp
#define REP_PHASE -1
#define PG8_ALIGN false
#include <hip/hip_runtime.h>
#include <cstdio>
#include <cstdint>
#include <cmath>
#ifndef REP_PHASE
#define REP_PHASE -1
#endif
#define NREP(k) ((REP_PHASE == (k)) ? 2 : 1)
namespace pg8 {
#define PG8_LAS __attribute__((address_space(3)))
typedef unsigned short bf16_t;
typedef short bf16x8 __attribute__((ext_vector_type(8)));
typedef float f32x4 __attribute__((ext_vector_type(4)));
typedef unsigned u32x4 __attribute__((ext_vector_type(4)));
constexpr int BM = 256, BK = 64, HALF = 128, HTB = HALF * BK * 2  , STAGE_BYTES = 8 * HTB, NXCD = 8, WGM = 8;

__host__ __device__ __forceinline__ int lds_byte(int r, int c) { const int st = (r >> 4) * 2 + (c >> 5), rr = r & 15, cc = c & 31, ob = rr * 64 + cc * 2; return st * 1024 + (ob ^ (((ob >> 9) & 1) << 5)); }
__host__ __device__ __forceinline__ void stage_rc(int b, int& R, int& C) { const int st = b / 1024, sb = b % 1024, swz = sb ^ (((sb >> 9) & 1) << 5); R = (st >> 1) * 16 + swz / 64; C = (st & 1) * 32 + (swz % 64) / 2; }
__host__ __device__ __forceinline__ int perm32(int rho) { const int n = rho >> 4, i = rho & 15; return 8 * (i >> 2) + 4 * n + (i & 3); }

struct Unit { int pm, pn; };
struct Gemm { const bf16_t* A; const bf16_t* Bt; int M, N, K; };

struct StaticOrder {
    int nM, nN, nwg, G, c;
    __host__ __device__ void init(int M, int N, int G_, int c_) { nM = M / BM; nN = N / BM; nwg = nM * nN; G = G_; c = c_; }
    __host__ __device__ bool next(int i, Unit& u) const {
        const long L = (long)i * G + c; if (L >= nwg) return false;
        int wgid = (int)L; { const int q = nwg / NXCD, r = nwg % NXCD, xcd = wgid % NXCD, off = wgid / NXCD; wgid = (xcd < r ? xcd * (q + 1) : r * (q + 1) + (xcd - r) * q) + off; }
        const int nig = WGM * nN, gid = wgid / nig, fm = gid * WGM, gsz = (nM - fm) < WGM ? (nM - fm) : WGM;
        u.pm = fm + ((wgid % nig) % gsz); u.pn = (wgid % nig) / gsz; return true;
    }
    __device__ __forceinline__ void a_ready(const Unit&) const {}
    __device__ __forceinline__ void done(const Unit&) const {}
};

__device__ __forceinline__ unsigned cvt_pk_bf16(float lo, float hi) { unsigned r; asm volatile("v_cvt_pk_bf16_f32 %0, %1, %2" : "=v"(r) : "v"(lo), "v"(hi)); return r; }
typedef float f32x2 __attribute__((ext_vector_type(2)));
__device__ __forceinline__ f32x2 gelu_pk(f32x2 v) {
    const f32x2 av = __builtin_elementwise_abs(v), d = av * 0.2316418882f + 1.0f;
    f32x2 t; t.x = __builtin_amdgcn_rcpf(d.x); t.y = __builtin_amdgcn_rcpf(d.y);
    f32x2 q = t * 0.5307027145f + (-0.7265760135f); q = q * t + 0.7107068705f; q = q * t + (-0.142248368f); q = q * t + 0.127414796f; q = q * t;
    const f32x2 s = (v * v) * (-0.72134752044f);
    f32x2 e; e.x = __builtin_amdgcn_exp2f(s.x); e.y = __builtin_amdgcn_exp2f(s.y);
    const f32x2 m = v * (q * e), r = v - m;
    f32x2 o; o.x = v.x < 0.f ? m.x : r.x; o.y = v.y < 0.f ? m.y : r.y; return o;
}

template <int ACT  > struct EpiBf16 {
    static constexpr bool PERM = true, AFTER_DRAIN = false; static_assert(ACT == 0 || ACT == 1, "EpiBf16: ACT is 0 (none) or 1 (gelu_pk)");
    bf16_t* O; int ldc; const float* bias; int split_cols; size_t split_stride; float scale0;
    __device__ __forceinline__ void operator()(const f32x4 (&acc)[2][2][4][2], const Unit& u, int wr, int wc, int fr, int fq) const {
        const int row0 = u.pm * BM + wr * 64 + fr; int colt = u.pn * BM; bf16_t* base = O;
        float sc = 1.f; if (split_cols) { const int t = colt / split_cols; base += (size_t)t * split_stride; colt -= t * split_cols; if (t == 0) sc = scale0; }
        const int col0 = colt + wc * 32 + 8 * fq, bcol0 = u.pn * BM + wc * 32 + 8 * fq;
        f32x4 bv[2][2];
#pragma unroll
        for (int bj = 0; bj < 2; ++bj)
#pragma unroll
            for (int n = 0; n < 2; ++n) bv[bj][n] = bias ? *(const f32x4*)(bias + bcol0 + bj * HALF + 4 * n) : (f32x4){0.f, 0.f, 0.f, 0.f};
#pragma unroll
        for (int ai = 0; ai < 2; ++ai)
#pragma unroll
            for (int m = 0; m < 4; ++m) { bf16_t* rowp = base + (size_t)(row0 + ai * HALF + m * 16) * ldc + col0;
#pragma unroll
                for (int bj = 0; bj < 2; ++bj) { f32x4 v0 = acc[ai][bj][m][0] + bv[bj][0], v1 = acc[ai][bj][m][1] + bv[bj][1];
                    if (ACT == 1) { f32x2 a = gelu_pk((f32x2){v0[0], v0[1]}), b = gelu_pk((f32x2){v0[2], v0[3]}), c = gelu_pk((f32x2){v1[0], v1[1]}), d = gelu_pk((f32x2){v1[2], v1[3]});
                        v0 = (f32x4){a.x, a.y, b.x, b.y}; v1 = (f32x4){c.x, c.y, d.x, d.y}; }
                    v0 = v0 * sc; v1 = v1 * sc; u32x4 w; w.x = cvt_pk_bf16(v0[0], v0[1]); w.y = cvt_pk_bf16(v0[2], v0[3]); w.z = cvt_pk_bf16(v1[0], v1[1]); w.w = cvt_pk_bf16(v1[2], v1[3]);
                    *(u32x4*)(rowp + bj * HALF) = w; } }
    }
};
template <class Epi, class Sched, bool ALIGN_EPI = false, bool SP2 = false>
__device__ __forceinline__ void gemm_phase(PG8_LAS unsigned char* lds, const Gemm g, const Sched& S, const Epi& E) {
    const int tid = threadIdx.x, wid = __builtin_amdgcn_readfirstlane(tid >> 6), lane = tid & 63, wr = wid >> 2, wc = wid & 3, fr = lane & 15, fq = lane >> 4;
    const int K = g.K, nt = K / BK;
    unsigned voffA[2], voffB[2];
#pragma unroll
    for (int i = 0; i < 2; ++i) { int R, C; stage_rc(tid * 16 + i * 8192, R, C); const int Rb = Epi::PERM ? ((R & ~31) + perm32(R & 31)) : R;
        voffA[i] = (unsigned)(R * K + C) * 2u; voffB[i] = (unsigned)(Rb * K + C) * 2u; }
    const size_t kstep = (size_t)(BK * 2);
    const size_t hstep = (size_t)HALF * K * 2;
    const size_t tstep = 2 * hstep;
    const unsigned ldsw = (unsigned)wid * 1024u;
    const int aoff = lds_byte(wr * 64 + fr, fq * 8), boff = lds_byte(wc * 32 + fr, fq * 8);
#define PG8_SA(b, h) (((b) * 2 + (h)) * HTB)
#define PG8_SB(b, h) ((4 + (b) * 2 + (h)) * HTB)
#define PG8_STAGE(bufoff, gbase, voff) do { _Pragma("unroll") for (int _i = 0; _i < 2; ++_i) \
        __builtin_amdgcn_global_load_lds((const unsigned*)((const char*)(gbase) + (voff)[_i]), (PG8_LAS unsigned*)(lds + (bufoff) + ldsw + _i * 8192), 16, 0, 0); } while (0)
#define PG8_LDA(dst, b, h) do { _Pragma("unroll") for (int m = 0; m < 4; ++m) _Pragma("unroll") for (int k = 0; k < 2; ++k) dst[m][k] = *(const PG8_LAS bf16x8*)(lds + PG8_SA(b, h) + aoff + m * 2048 + k * 1024); } while (0)
#define PG8_LDB(dst, b, h) do { _Pragma("unroll") for (int n = 0; n < 2; ++n) _Pragma("unroll") for (int k = 0; k < 2; ++k) dst[n][k] = *(const PG8_LAS bf16x8*)(lds + PG8_SB(b, h) + boff + n * 2048 + k * 1024); } while (0)
#define PG8_MMA(ai, bj, At, Bt) do { __builtin_amdgcn_s_setprio(1); _Pragma("unroll") for (int m = 0; m < 4; ++m) _Pragma("unroll") for (int n = 0; n < 2; ++n) _Pragma("unroll") for (int k = 0; k < 2; ++k) \
        acc[ai][bj][m][n] = __builtin_amdgcn_mfma_f32_16x16x32_bf16(Bt[n][k], At[m][k], acc[ai][bj][m][n], 0, 0, 0); __builtin_amdgcn_s_setprio(0); } while (0)
#define PG8_WAIT_V(n) asm volatile("s_waitcnt vmcnt(" #n ")" ::: "memory")
#define PG8_WAIT_L(n) asm volatile("s_waitcnt lgkmcnt(" #n ")" ::: "memory")
#define PG8_BAR __builtin_amdgcn_s_barrier()
#define PG8_SCHED __builtin_amdgcn_sched_barrier(0)
    Unit cur, nxt; int ui = 0;
    if (!S.next(0, cur)) return;
    f32x4 acc[2][2][4][2];
#pragma unroll
    for (int a = 0; a < 2; ++a)
#pragma unroll
        for (int b = 0; b < 2; ++b)
#pragma unroll
            for (int m = 0; m < 4; ++m)
#pragma unroll
                for (int n = 0; n < 2; ++n) acc[a][b][m][n] = (f32x4){0.f, 0.f, 0.f, 0.f};
    bf16x8 At[4][2], B0[2][2], B1[2][2];
    const char* cA = (const char*)g.A + (size_t)cur.pm * tstep; const char* cB = (const char*)g.Bt + (size_t)cur.pn * tstep;
    S.a_ready(cur);
    if constexpr (SP2) {
        PG8_STAGE(PG8_SB(0, 0), cB, voffB); PG8_STAGE(PG8_SB(0, 1), cB + hstep, voffB); PG8_STAGE(PG8_SA(0, 0), cA, voffA); PG8_STAGE(PG8_SA(0, 1), cA + hstep, voffA);
        if (wr == 1) PG8_BAR;
        PG8_WAIT_V(2); PG8_BAR;
        PG8_STAGE(PG8_SB(1, 0), cB + kstep, voffB); PG8_STAGE(PG8_SA(1, 0), cA + kstep, voffA); PG8_STAGE(PG8_SB(1, 1), cB + hstep + kstep, voffB);
        PG8_WAIT_V(6); PG8_BAR;
    } else {
        PG8_STAGE(PG8_SB(0, 0), cB, voffB); PG8_STAGE(PG8_SA(0, 0), cA, voffA); PG8_STAGE(PG8_SB(0, 1), cB + hstep, voffB); PG8_STAGE(PG8_SA(0, 1), cA + hstep, voffA);
        if (wr == 1) PG8_BAR;
        PG8_WAIT_V(4); PG8_BAR;
        PG8_STAGE(PG8_SB(1, 0), cB + kstep, voffB); PG8_STAGE(PG8_SA(1, 0), cA + kstep, voffA); PG8_STAGE(PG8_SB(1, 1), cB + hstep + kstep, voffB);
        PG8_WAIT_V(6); PG8_BAR;
    }
    for (;;) {
        const bool has_next = S.next(ui + 1, nxt);
        const char* nA = has_next ? (const char*)g.A + (size_t)nxt.pm * tstep : cA; const char* nB = has_next ? (const char*)g.Bt + (size_t)nxt.pn * tstep : cB;
        for (int t = 0; t < nt; t += 2) {
            const bool last = (t == nt - 2);
            const char* a1 = cA + (size_t)(t + 1) * kstep;
            const char* a2 = last ? nA : cA + (size_t)(t + 2) * kstep; const char* b2 = last ? nB : cB + (size_t)(t + 2) * kstep;
            const char* a3 = a2 + kstep; const char* b3 = b2 + kstep;
            if (last && has_next) S.a_ready(nxt);
            if constexpr (SP2) {
            PG8_LDB(B0, 0, 0); PG8_LDB(B1, 0, 1); PG8_SCHED; PG8_LDA(At, 0, 0); PG8_STAGE(PG8_SA(1, 1), a1 + hstep, voffA);
            PG8_WAIT_V(8); PG8_WAIT_L(0); PG8_BAR; PG8_MMA(0, 0, At, B0); PG8_MMA(0, 1, At, B1); PG8_BAR; PG8_SCHED;
            PG8_LDA(At, 0, 1); PG8_STAGE(PG8_SB(0, 0), b2, voffB); PG8_STAGE(PG8_SB(0, 1), b2 + hstep, voffB); PG8_STAGE(PG8_SA(0, 0), a2, voffA);
            PG8_WAIT_V(8); PG8_WAIT_L(0); PG8_BAR; PG8_MMA(1, 0, At, B0); PG8_MMA(1, 1, At, B1); PG8_BAR; PG8_SCHED;
            PG8_LDB(B0, 1, 0); PG8_LDB(B1, 1, 1); PG8_SCHED; PG8_LDA(At, 1, 0); PG8_STAGE(PG8_SA(0, 1), a2 + hstep, voffA);
            PG8_WAIT_V(8); PG8_WAIT_L(0); PG8_BAR; PG8_MMA(0, 0, At, B0); PG8_MMA(0, 1, At, B1); PG8_BAR; PG8_SCHED;
            PG8_LDA(At, 1, 1); PG8_STAGE(PG8_SB(1, 0), b3, voffB); PG8_STAGE(PG8_SB(1, 1), b3 + hstep, voffB); PG8_STAGE(PG8_SA(1, 0), a3, voffA);
            PG8_WAIT_V(8); PG8_WAIT_L(0); PG8_BAR; PG8_MMA(1, 0, At, B0); PG8_MMA(1, 1, At, B1); PG8_BAR; PG8_SCHED;
            } else {
            PG8_LDB(B0, 0, 0); PG8_SCHED; PG8_LDA(At, 0, 0); PG8_STAGE(PG8_SA(1, 1), a1 + hstep, voffA);
            PG8_WAIT_L(8); PG8_BAR; PG8_WAIT_L(0); PG8_MMA(0, 0, At, B0); PG8_BAR; PG8_SCHED;
            PG8_LDB(B1, 0, 1); PG8_STAGE(PG8_SB(0, 0), b2, voffB);
            PG8_BAR; PG8_WAIT_L(0); PG8_MMA(0, 1, At, B1); PG8_BAR;
            PG8_LDA(At, 0, 1); PG8_STAGE(PG8_SA(0, 0), a2, voffA);
            PG8_BAR; PG8_WAIT_L(0); PG8_MMA(1, 0, At, B0); PG8_BAR; PG8_SCHED;
            PG8_STAGE(PG8_SB(0, 1), b2 + hstep, voffB);
            PG8_WAIT_V(6); PG8_BAR; PG8_MMA(1, 1, At, B1); PG8_BAR;
            PG8_LDB(B0, 1, 0); PG8_SCHED; PG8_LDA(At, 1, 0); PG8_STAGE(PG8_SA(0, 1), a2 + hstep, voffA);
            PG8_WAIT_L(8); PG8_BAR; PG8_WAIT_L(0); PG8_MMA(0, 0, At, B0); PG8_BAR; PG8_SCHED;
            PG8_LDB(B1, 1, 1); PG8_STAGE(PG8_SB(1, 0), b3, voffB);
            PG8_BAR; PG8_WAIT_L(0); PG8_MMA(0, 1, At, B1); PG8_BAR;
            PG8_LDA(At, 1, 1); PG8_STAGE(PG8_SA(1, 0), a3, voffA);
            PG8_BAR; PG8_WAIT_L(0); PG8_MMA(1, 0, At, B0); PG8_BAR; PG8_SCHED;
            PG8_STAGE(PG8_SB(1, 1), b3 + hstep, voffB);
            PG8_WAIT_V(6); PG8_BAR; PG8_MMA(1, 1, At, B1); PG8_BAR;
            }
        }
        if constexpr (ALIGN_EPI) { if (wr == 0) PG8_BAR; }
        if constexpr (!Epi::AFTER_DRAIN) { E(acc, cur, wr, wc, fr, fq); S.done(cur); }
        if (!has_next) break;
#pragma unroll
        for (int a = 0; a < 2; ++a)
#pragma unroll
            for (int b = 0; b < 2; ++b)
#pragma unroll
                for (int m = 0; m < 4; ++m)
#pragma unroll
                    for (int n = 0; n < 2; ++n) acc[a][b][m][n] = (f32x4){0.f, 0.f, 0.f, 0.f};
        cur = nxt; cA = nA; cB = nB; ++ui;
        if constexpr (ALIGN_EPI) { if (wr == 1) PG8_BAR; }
    }
    PG8_WAIT_V(0);
    if constexpr (!ALIGN_EPI) { if (wr == 0) PG8_BAR; }
    PG8_BAR;
    if constexpr (Epi::AFTER_DRAIN) { E.fused(acc, cur, wr, wc, fr, fq, lds, wid, lane); S.done(cur); }
#undef PG8_SA
#undef PG8_SB
#undef PG8_STAGE
#undef PG8_LDA
#undef PG8_LDB
#undef PG8_MMA
#undef PG8_WAIT_V
#undef PG8_WAIT_L
#undef PG8_BAR
#undef PG8_SCHED
}
}

#ifndef PG8_SP2
#define PG8_SP2 true
#endif
#ifndef PG8_ALIGN
#define PG8_ALIGN true
#endif
#define GAS __attribute__((address_space(1)))
#define LAS __attribute__((address_space(3)))
typedef unsigned short bf16;
typedef unsigned v4u __attribute__((ext_vector_type(4)));
typedef float f32x4 __attribute__((ext_vector_type(4)));
typedef short bf16x8 __attribute__((ext_vector_type(8)));
typedef GAS unsigned gu32;
typedef GAS unsigned long long gu64;
#define RLX_AGENT __ATOMIC_RELAXED, __HIP_MEMORY_SCOPE_AGENT
#define LDS_WAIT() asm volatile("s_waitcnt lgkmcnt(0)" ::: "memory")
#define VM_WAIT() asm volatile("s_waitcnt vmcnt(0)" ::: "memory")
__device__ __forceinline__ unsigned long long rt() { return __builtin_amdgcn_s_memrealtime(); }
__device__ __forceinline__ unsigned f2bf(float f) { unsigned u = __builtin_bit_cast(unsigned, f); return (u + 0x7fffu + ((u >> 16) & 1u)) >> 16; }
typedef float pk2_f32x2 __attribute__((ext_vector_type(2))); typedef __bf16 pk2_bf16x2 __attribute__((ext_vector_type(2)));
__device__ __forceinline__ unsigned pk2(float lo, float hi) { pk2_f32x2 v = {lo, hi}; pk2_bf16x2 b = __builtin_convertvector(v, pk2_bf16x2); return __builtin_bit_cast(unsigned, b); }

#define XB_TMO      128
#define XB_XCNT(j)  (256  + 64 * (j))
#define XB_XSUB(j)  (1280 + 64 * (j))
#define XB_XGEN(j)  (2304 + 64 * (j))
#define XB_TOP      3328
#define XB_TOPGEN   3392
#define XCD_BAR_WORDS 3456
#define XB_SPIN_CAP (1u << 18)

__device__ __forceinline__ unsigned xb_ld(unsigned* p)              { return __hip_atomic_load(p, __ATOMIC_RELAXED, __HIP_MEMORY_SCOPE_AGENT); }
__device__ __forceinline__ unsigned xb_add(unsigned* p, unsigned v) { return __hip_atomic_fetch_add(p, v, __ATOMIC_RELAXED, __HIP_MEMORY_SCOPE_AGENT); }
__device__ __forceinline__ unsigned xb_xcc_id() { return (unsigned)__builtin_amdgcn_s_getreg((3 << 11) | 20) & 0xFu; }
#define XB_SPIN(cond, bar) do { unsigned _sp = 0; while (cond) { __builtin_amdgcn_s_sleep(1); \
    if ((++_sp & 255u) == 0u) { if (xb_ld(&(bar)[XB_TMO])) break; if (_sp > XB_SPIN_CAP) { atomicAdd(&(bar)[XB_TMO], 1u); break; } } } } while (0)

struct XcdBarrier {
    unsigned* bar; unsigned x;
    volatile LAS unsigned* st;
};

__device__ __forceinline__ XcdBarrier xcd_barrier_post(unsigned* bar, volatile LAS unsigned* st) {
    XcdBarrier b; b.bar = bar; b.x = xb_xcc_id(); b.st = st;
    if (threadIdx.x == 0) (void)xb_add(&bar[XB_XCNT(b.x)], 1u);
    return b;
}
__device__ __forceinline__ void xcd_barrier_complete(unsigned* bar, unsigned x, unsigned& nloc, unsigned& nx) {
    const unsigned G = gridDim.x * gridDim.y * gridDim.z;
    unsigned sum, cnt, mine, sp = 0u;
    for (;;) {
        sum = 0u; cnt = 0u; mine = 0u;
#pragma unroll
        for (unsigned j = 0; j < 16; ++j) { const unsigned c = xb_ld(&bar[XB_XCNT(j)]); sum += c; cnt += (c > 0u) ? 1u : 0u; mine = (j == x) ? c : mine; }
        if (sum == G) break;
        __builtin_amdgcn_s_sleep(1);
        if ((++sp & 255u) == 0u) { if (xb_ld(&bar[XB_TMO])) break; if (sp > XB_SPIN_CAP) { atomicAdd(&bar[XB_TMO], 1u); break; } }
    }
    nloc = mine > 0u ? mine : 1u; nx = cnt > 0u ? cnt : 1u;
}

__device__ __forceinline__ void xcd_barrier(const XcdBarrier& b) {
    asm volatile("s_waitcnt vmcnt(0)" ::: "memory");
    __syncthreads();
    if (threadIdx.x == 0) {
        unsigned* bar = b.bar;
        __builtin_amdgcn_s_waitcnt(0);
        unsigned nloc = b.st[0], nx = b.st[1];
        if (nloc == 0u) { xcd_barrier_complete(bar, b.x, nloc, nx); b.st[0] = nloc; b.st[1] = nx; }
        const unsigned old = xb_add(&bar[XB_XSUB(b.x)], 1u);
        const unsigned gen = old / nloc;
        if (old + 1u == (gen + 1u) * nloc) {
            __builtin_amdgcn_fence(__ATOMIC_RELEASE, "agent");
            asm volatile("s_waitcnt vmcnt(0)" ::: "memory");
            const unsigned og = xb_add(&bar[XB_TOP], 1u);
            const unsigned tg = og / nx;
            if (og + 1u == (tg + 1u) * nx) xb_add(&bar[XB_TOPGEN], 1u);
            else XB_SPIN(xb_ld(&bar[XB_TOPGEN]) == tg, bar);
            __builtin_amdgcn_fence(__ATOMIC_ACQUIRE, "agent");
            xb_add(&bar[XB_XGEN(b.x)], 1u);
            asm volatile("s_waitcnt vmcnt(0)" ::: "memory");
        } else {
            XB_SPIN(xb_ld(&bar[XB_XGEN(b.x)]) == gen, bar);
            __builtin_amdgcn_fence(__ATOMIC_ACQUIRE, "agent");
            asm volatile("s_waitcnt vmcnt(0)" ::: "memory");
        }
    }
    __syncthreads();
}


constexpr int NWAVES = 8;
constexpr int DM = 2048, BATCH = 4, SEQ = 4096, M = BATCH * SEQ;
constexpr int NIN = 6176, NINP = 6144;
constexpr int O_GQ = 0, O_GK = 512, O_GV = 1024, O_GR = 2048, O_AQ = 3072, O_AK = 4096, O_AV = 5120;
constexpr float EPS = 1e-6f;
constexpr int PEER_K = 128;

constexpr size_t MiB = 1u << 20;
constexpr size_t WS_CTL = 0, CTL_ZERO_BYTES = 1 * MiB;
constexpr size_t WS_WIN = 1 * MiB;
constexpr size_t WS_WGD = 25 * MiB;
constexpr size_t WS_GDB = 62 * MiB;
constexpr size_t WS_WOUT = 26 * MiB;
constexpr size_t WS_WQ = 34 * MiB;
constexpr size_t WS_SSQ = 42 * MiB;
constexpr size_t WS_EIDX = 44 * MiB;
constexpr size_t WS_GATE = 52 * MiB;
constexpr size_t WS_SKB = 60 * MiB;
constexpr size_t WS_XN = 64 * MiB;
constexpr size_t WS_PROJ = 128 * MiB;
constexpr size_t WS_HB = 256 * MiB;
constexpr size_t WS_OF = 328 * MiB;
constexpr size_t WS_OB = 360 * MiB;
constexpr size_t WS_ATTP = 392 * MiB;
constexpr size_t WS_ATTML = 488 * MiB;
constexpr size_t WS_GT_QD = 64 * MiB;
constexpr size_t WS_GT_KE = 96 * MiB;
constexpr size_t OUT_GT_AM = 0;
constexpr size_t OUT_GT_DEC = 16 * MiB;
constexpr size_t OUT_GT_VT = 32 * MiB;
constexpr int CW_ATTQX = 512;
constexpr size_t WS_EIDX16 = 494 * MiB;
constexpr size_t WS_END = 498 * MiB;
constexpr size_t OUT_U8 = 64 * MiB;
constexpr size_t OUT_V8 = 96 * MiB;
constexpr size_t WS_SU = 61 * MiB;
constexpr size_t WS_SV = 61 * MiB + 65536;
constexpr int CONV_FIRST_RANK = 24;
constexpr int CW_CONVQ = 256;
constexpr size_t WS_PW = 128 * MiB;
constexpr size_t WS_SSQ2 = 136 * MiB;
constexpr size_t WS_PD = 64 * MiB;
constexpr int PEER_E = 16384;
constexpr int CW_TMO = 0, CW_CODE = 1, CW_BAR = 4096;

constexpr int RING_OFF = 0, RING_BYTES = 131072;
constexpr int LDS_BYTES = 163840;
constexpr int LDSCTL_OFF = LDS_BYTES - 1024, MISC_OFF = LDSCTL_OFF + 320;

typedef float f32x2 __attribute__((ext_vector_type(2)));
typedef float f32x16 __attribute__((ext_vector_type(16)));
typedef int i32x4 __attribute__((ext_vector_type(4)));
typedef int i32x2 __attribute__((ext_vector_type(2)));
__device__ __forceinline__ float bf2f(unsigned short h) { return __builtin_bit_cast(float, (unsigned)h << 16); }
__device__ __forceinline__ float bflo(unsigned w) { return __builtin_bit_cast(float, w << 16); }
__device__ __forceinline__ float bfhi(unsigned w) { return __builtin_bit_cast(float, w & 0xffff0000u); }
#define WRED_DPP(x, ctrl) __builtin_bit_cast(float, __builtin_amdgcn_update_dpp(0, __builtin_bit_cast(int, (x)), ctrl, 0xF, 0xF, false))
#define WRED_LANE(x, l) __builtin_bit_cast(float, __builtin_amdgcn_readlane(__builtin_bit_cast(int, (x)), (l)))
__device__ __forceinline__ float wave_sum(float v) {
    v += WRED_DPP(v, 0xB1); v += WRED_DPP(v, 0x4E); v += WRED_DPP(v, 0x141); v += WRED_DPP(v, 0x140);
    return (WRED_LANE(v, 0) + WRED_LANE(v, 16)) + (WRED_LANE(v, 32) + WRED_LANE(v, 48));
}
__device__ __forceinline__ float wave_max(float v) {
    v = fmaxf(v, WRED_DPP(v, 0xB1)); v = fmaxf(v, WRED_DPP(v, 0x4E)); v = fmaxf(v, WRED_DPP(v, 0x141)); v = fmaxf(v, WRED_DPP(v, 0x140));
    return fmaxf(fmaxf(WRED_LANE(v, 0), WRED_LANE(v, 16)), fmaxf(WRED_LANE(v, 32), WRED_LANE(v, 48)));
}

#define SWAP_PAIR(OP, x, r0, r1) do { unsigned a_ = __builtin_bit_cast(unsigned, (x)), b_ = a_; asm volatile("" : "+v"(b_)); auto s_ = OP(a_, b_, false, false); const unsigned u0_ = s_[0], u1_ = s_[1];   r0 = __builtin_bit_cast(float, u0_); r1 = __builtin_bit_cast(float, u1_); } while (0)
__device__ __forceinline__ float xrow_max(float v) {
    float p, q; SWAP_PAIR(__builtin_amdgcn_permlane16_swap, v, p, q); v = fmaxf(p, q); SWAP_PAIR(__builtin_amdgcn_permlane32_swap, v, p, q); return fmaxf(p, q);
}
__device__ __forceinline__ float xrow_sum(float v) {
    float p, q; SWAP_PAIR(__builtin_amdgcn_permlane16_swap, v, p, q); v = p + q; SWAP_PAIR(__builtin_amdgcn_permlane32_swap, v, p, q); return p + q;
}
template <class T> __device__ __forceinline__ T* opaque(T* p) { asm volatile("" : "+s"(p)); return (T*)(GAS T*)p; }
__device__ __forceinline__ int lane_id() { int x; asm volatile("v_mbcnt_lo_u32_b32 %0, -1, 0\n\tv_mbcnt_hi_u32_b32 %0, -1, %0" : "=v"(x)); return x; }
__device__ __forceinline__ int opaque_v(int x) { asm volatile("" : "+v"(x)); return x; }
template <class T> __device__ __forceinline__ T ldu(const void* ubase, unsigned voff) { return *(const GAS T*)((const GAS char*)ubase + voff); }
template <class T> __device__ __forceinline__ void stu(void* ubase, unsigned voff, T v) { *(GAS T*)((GAS char*)ubase + voff) = v; }
namespace pg8 {
struct EpiRes {
    static constexpr bool PERM = true, AFTER_DRAIN = false;
    const float* x; bf16_t* HB; float* ssq; int ldc;
    __device__ __forceinline__ void operator()(const f32x4 (&acc)[2][2][4][2], const Unit& u, int wr, int wc, int fr, int fq) const {
        const int col0 = u.pn * BM + wc * 32 + 8 * fq;
        const int rbase = u.pm * BM + wr * 64 + fr;
        f32x4 xc[2][2], xn[2][2];
#define EPIRES_LOAD(D, IDX) do { const size_t o_ = (size_t)(rbase + ((IDX) >> 2) * HALF + ((IDX) & 3) * 16) * ldc + col0; _Pragma("unroll") for (int bj = 0; bj < 2; ++bj) { D[bj][0] = *(const f32x4*)(x + o_ + bj * HALF); D[bj][1] = *(const f32x4*)(x + o_ + bj * HALF + 4); } } while (0)
        EPIRES_LOAD(xc, 0);
#pragma unroll
        for (int idx = 0; idx < 8; ++idx) { const int ai = idx >> 2, m = idx & 3;
            if (idx + 1 < 8) EPIRES_LOAD(xn, idx + 1);
            const int r = rbase + ai * HALF + m * 16; const size_t off = (size_t)r * ldc + col0; float s = 0.f;
#pragma unroll
            for (int bj = 0; bj < 2; ++bj) {
                const f32x4 h0 = xc[bj][0] + acc[ai][bj][m][0], h1 = xc[bj][1] + acc[ai][bj][m][1];
                s += ((h0[0] * h0[0] + h0[1] * h0[1]) + (h0[2] * h0[2] + h0[3] * h0[3])) + ((h1[0] * h1[0] + h1[1] * h1[1]) + (h1[2] * h1[2] + h1[3] * h1[3]));
                u32x4 w; w.x = cvt_pk_bf16(h0[0], h0[1]); w.y = cvt_pk_bf16(h0[2], h0[3]); w.z = cvt_pk_bf16(h1[0], h1[1]); w.w = cvt_pk_bf16(h1[2], h1[3]);
                *(u32x4*)(HB + off + bj * HALF) = w;
            }
            s += __shfl_xor(s, 16); s += __shfl_xor(s, 32);
            if (fq == 0) ssq[(size_t)r * 32 + u.pn * 4 + wc] = s;
#pragma unroll
            for (int bj = 0; bj < 2; ++bj) { xc[bj][0] = xn[bj][0]; xc[bj][1] = xn[bj][1]; }
        }
#undef EPIRES_LOAD
    }
};
constexpr int EPI_STAGE_OFF = 131072;
struct EpiBf16S {
    static constexpr bool PERM = true, AFTER_DRAIN = false;
    bf16_t* O; int ldc; LAS unsigned char* stage;
    __device__ __forceinline__ void operator()(const f32x4 (&acc)[2][2][4][2], const Unit& u, int wr, int wc, int fr, int fq) const {
        LAS unsigned char* st = stage + (wr * 4 + wc) * 3584;
        const int lane = fr + 16 * fq, srow = lane >> 2, sch = lane & 3;
        LAS unsigned char* wp = st + fr * 80 + fq * 16; const LAS unsigned char* rp = st + srow * 80 + sch * 16;
        bf16_t* gp = O + (size_t)(u.pm * BM + wr * 64 + srow) * ldc + u.pn * BM + wc * 32 + sch * 8;
#pragma unroll
        for (int ai = 0; ai < 2; ++ai)
#pragma unroll
            for (int m = 0; m < 4; ++m)
#pragma unroll
                for (int bj = 0; bj < 2; ++bj) { const f32x4 v0 = acc[ai][bj][m][0], v1 = acc[ai][bj][m][1];
                    u32x4 w; w.x = cvt_pk_bf16(v0[0], v0[1]); w.y = cvt_pk_bf16(v0[2], v0[3]); w.z = cvt_pk_bf16(v1[0], v1[1]); w.w = cvt_pk_bf16(v1[2], v1[3]);
                    *(LAS u32x4*)wp = w;
                    const u32x4 o = *(const LAS u32x4*)rp;
                    *(u32x4*)(gp + (size_t)(ai * HALF + m * 16) * ldc + bj * HALF) = o; }
    }
};
struct EpiResS {
    static constexpr bool PERM = true, AFTER_DRAIN = false;
    const float* x; bf16_t* HB; float* ssq; int ldc; LAS unsigned char* stage;
    __device__ __forceinline__ void operator()(const f32x4 (&acc)[2][2][4][2], const Unit& u, int wr, int wc, int fr, int fq) const {
        LAS unsigned char* xs = stage + (wr * 4 + wc) * 3584; LAS unsigned char* os = xs + 2304;
        const int lane = fr + 16 * fq, srow = lane >> 2, sch = lane & 3, lrow = lane >> 3, lch = lane & 7;
        const int R0 = u.pm * BM + wr * 64, C0 = u.pn * BM + wc * 32;
        const float* xg = x + (size_t)(R0 + lrow) * ldc + C0 + lch * 4;
        bf16_t* gp = HB + (size_t)(R0 + srow) * ldc + C0 + sch * 8;
        f32x4 xc[4], xn[4];
#define EPIRES_LOAD(D, IDX) do { const size_t o_ = (size_t)(((IDX) >> 2) * HALF + ((IDX) & 3) * 16) * ldc; _Pragma("unroll") for (int bj = 0; bj < 2; ++bj) { D[2 * bj] = *(const f32x4*)(xg + o_ + bj * HALF); D[2 * bj + 1] = *(const f32x4*)(xg + o_ + (size_t)8 * ldc + bj * HALF); } } while (0)
        EPIRES_LOAD(xc, 0);
#pragma unroll
        for (int idx = 0; idx < 8; ++idx) { const int ai = idx >> 2, m = idx & 3;
            if (idx + 1 < 8) EPIRES_LOAD(xn, idx + 1);
            float s = 0.f;
#pragma unroll
            for (int bj = 0; bj < 2; ++bj) {
                *(LAS f32x4*)(xs + lrow * 144 + lch * 16) = xc[2 * bj]; *(LAS f32x4*)(xs + (8 + lrow) * 144 + lch * 16) = xc[2 * bj + 1];
                const f32x4 r0 = *(const LAS f32x4*)(xs + fr * 144 + fq * 32), r1 = *(const LAS f32x4*)(xs + fr * 144 + fq * 32 + 16);
                const f32x4 h0 = r0 + acc[ai][bj][m][0], h1 = r1 + acc[ai][bj][m][1];
                s += ((h0[0] * h0[0] + h0[1] * h0[1]) + (h0[2] * h0[2] + h0[3] * h0[3])) + ((h1[0] * h1[0] + h1[1] * h1[1]) + (h1[2] * h1[2] + h1[3] * h1[3]));
                u32x4 w; w.x = cvt_pk_bf16(h0[0], h0[1]); w.y = cvt_pk_bf16(h0[2], h0[3]); w.z = cvt_pk_bf16(h1[0], h1[1]); w.w = cvt_pk_bf16(h1[2], h1[3]);
                *(LAS u32x4*)(os + fr * 80 + fq * 16) = w;
                const u32x4 o = *(const LAS u32x4*)(os + srow * 80 + sch * 16);
                *(u32x4*)(gp + (size_t)(ai * HALF + m * 16) * ldc + bj * HALF) = o;
            }
            s = xrow_sum(s);
            if (fq == 0) ssq[(size_t)(R0 + ai * HALF + m * 16 + fr) * 32 + u.pn * 4 + wc] = s;
#pragma unroll
            for (int j = 0; j < 4; ++j) xc[j] = xn[j];
        }
#undef EPIRES_LOAD
    }
};
}

struct Frame {
    LAS unsigned char* lds;
    volatile LAS unsigned* MISC;
    gu32* ctl;
    int wave;
    int vcu, G;
};

__device__ __forceinline__ void p0_transpose_item(const float* W, int K, int ldw, const float* gk, bf16* WT, LAS float* scr, int item, int lane) {
    const int nblk = ldw / 32, kb = item / nblk, nb = item % nblk, k0 = 64 * kb, n0 = 32 * nb;
    float wv[32];
    { const GAS float* Wg = (const GAS float*)W + (size_t)(k0 + (lane >> 5)) * ldw + n0 + (lane & 31);
#pragma unroll
      for (int i = 0; i < 32; ++i) wv[i] = Wg[(size_t)(2 * i) * ldw]; }
    if (gk) {
#pragma unroll
      for (int i = 0; i < 32; ++i) wv[i] *= ((const GAS float*)gk)[k0 + 2 * i + (lane >> 5)]; }
#pragma unroll
    for (int i = 0; i < 32; ++i) scr[(2 * i + (lane >> 5)) * 33 + (lane & 31)] = wv[i];
    LDS_WAIT(); asm volatile("" ::: "memory");
    const int c = lane & 7;
#pragma unroll
    for (int j = 0; j < 4; ++j) { const int n = (lane >> 3) + 8 * j; const LAS float* s = scr + (8 * c) * 33 + n;
        v4u o; o.x = pk2(s[0 * 33], s[1 * 33]); o.y = pk2(s[2 * 33], s[3 * 33]); o.z = pk2(s[4 * 33], s[5 * 33]); o.w = pk2(s[6 * 33], s[7 * 33]);
        *(GAS v4u*)(WT + (size_t)(n0 + n) * K + k0 + 8 * c) = o; }
    LDS_WAIT(); asm volatile("" ::: "memory");
}
struct Args {
    const float* in[16]; float* out; unsigned char* ws; int ph_lo, ph_hi, li, pad;
};

__device__ __forceinline__ void p0_prologue(Frame& F, const Args& a) {
    unsigned char* ws = a.ws;
    LAS float* scr = (LAS float*)(F.lds + RING_OFF + F.wave * 16384);
    const int gw = F.vcu * NWAVES + F.wave, NGW = F.G * NWAVES;
    bf16* Win_t = (bf16*)(ws + WS_WIN); bf16* Wout_t = (bf16*)(ws + WS_WOUT); bf16* Wq_t = (bf16*)(ws + WS_WQ); bf16* XN = (bf16*)(ws + WS_XN);
    constexpr int I_IN = (DM / 64) * (NIN / 32), I_SQ = (DM / 64) * (DM / 32);
    constexpr int NITEMS = I_IN + 2 * I_SQ;
    for (int it = gw; it < NITEMS; it += NGW) {
        int r = it;
        if (r < I_IN) { const int nb = r % (NIN / 32); bf16* dst = nb < 96 ? Win_t : nb == 96 ? (bf16*)(ws + WS_WGD) - (size_t)96 * 32 * DM : Win_t - (size_t)32 * DM;
            p0_transpose_item(a.in[2], DM, NIN, nullptr, dst, scr, r, lane_id()); continue; } r -= I_IN;
        if (r < I_SQ) { p0_transpose_item(a.in[9], DM, DM, nullptr, Wout_t, scr, r, lane_id()); continue; } r -= I_SQ;
        p0_transpose_item(a.in[11], DM, DM, a.in[10], Wq_t, scr, r, lane_id());
    }
    { const f32x4* sk = (const f32x4*)a.in[12]; unsigned long long* skb = (unsigned long long*)(ws + WS_SKB);
      for (int i = gw * 64 + lane_id(); i < 8 * 2 * 128 * 128 / 4; i += NGW * 64) { const f32x4 v = sk[i]; skb[i] = (unsigned long long)pk2(v.x, v.y) | ((unsigned long long)pk2(v.z, v.w) << 32); } }
    { const GAS f32x4* gr = (const GAS f32x4*)a.in[1] + lane_id(); f32x4 gg[8];
#pragma unroll
      for (int j = 0; j < 8; ++j) gg[j] = gr[64 * j];
      f32x4 v[8], vn[8], vn2[8];
#define P0_LOAD(MM, V) do { _Pragma("unroll") for (int j = 0; j < 8; ++j) V[j] = ((const GAS f32x4*)(a.in[0] + (size_t)(MM) * DM) + lane_id())[64 * j]; } while (0)
      if (gw < M) { P0_LOAD(gw, v); const int m1 = gw + NGW < M ? gw + NGW : gw; P0_LOAD(m1, vn); }
      for (int m = gw; m < M; m += NGW) { const int mn = m + 2 * NGW < M ? m + 2 * NGW : m;
          P0_LOAD(mn, vn2);
          float ss = 0.f;
#pragma unroll
          for (int j = 0; j < 8; ++j) ss += (v[j].x * v[j].x + v[j].y * v[j].y) + (v[j].z * v[j].z + v[j].w * v[j].w);
          const float rstd = 1.f / sqrtf(wave_sum(ss) * (1.f / DM) + EPS);
          GAS unsigned long long* o8 = (GAS unsigned long long*)(XN + (size_t)m * DM) + lane_id();
#pragma unroll
          for (int j = 0; j < 8; ++j) o8[64 * j] = (unsigned long long)pk2(v[j].x * rstd * gg[j].x, v[j].y * rstd * gg[j].y) | ((unsigned long long)pk2(v[j].z * rstd * gg[j].z, v[j].w * rstd * gg[j].w) << 32);
#pragma unroll
          for (int j = 0; j < 8; ++j) { v[j] = vn[j]; vn[j] = vn2[j]; } } }
#undef P0_LOAD
}


__device__ __forceinline__ void gd_side_gemm(Frame& F, const Args& a) {
    unsigned char* ws = a.ws; const bf16* XN = (const bf16*)(ws + WS_XN); const bf16* WG = (const bf16*)(ws + WS_WGD); float* GDB = (float*)(ws + WS_GDB);
    const int lane = lane_id(), w = F.wave, r32 = lane & 31, hh = lane >> 5; LAS float* part = (LAS float*)F.lds;
    LAS unsigned char* abuf = F.lds + w * 16896;
    for (int blk = F.vcu; blk < M / 64; blk += F.G) { const int tok0 = blk * 64;
        f32x16 acc[2];
#pragma unroll
        for (int tt = 0; tt < 2; ++tt) acc[tt] = (f32x16){0.f, 0.f, 0.f, 0.f, 0.f, 0.f, 0.f, 0.f, 0.f, 0.f, 0.f, 0.f, 0.f, 0.f, 0.f, 0.f};
        bf16x8 bwv[16];
#pragma unroll
        for (int ks = 0; ks < 16; ++ks) bwv[ks] = *(const GAS bf16x8*)(WG + (size_t)r32 * DM + 256 * w + 16 * ks + 8 * hh);
#pragma unroll
        for (int tt = 0; tt < 2; ++tt) {
            v4u ra[16];
#pragma unroll
            for (int i = 0; i < 16; ++i) ra[i] = *(const GAS v4u*)(XN + (size_t)(tok0 + 32 * tt + 2 * i + (lane >> 5)) * DM + 256 * w + (lane & 31) * 8);
#pragma unroll
            for (int i = 0; i < 16; ++i) *(LAS v4u*)(abuf + (2 * i + (lane >> 5)) * 528 + (lane & 31) * 16) = ra[i];
#pragma unroll
            for (int ks = 0; ks < 16; ++ks) { const bf16x8 ax = *(const LAS bf16x8*)(abuf + r32 * 528 + (16 * ks + 8 * hh) * 2); acc[tt] = __builtin_amdgcn_mfma_f32_32x32x16_bf16(ax, bwv[ks], acc[tt], 0, 0, 0); }
        }
        __syncthreads();
#pragma unroll
        for (int tt = 0; tt < 2; ++tt)
#pragma unroll
            for (int r = 0; r < 16; ++r) { const float x = acc[tt][r]; part[((w * 2 + tt) * 16 + r) * 64 + lane] = x; }
        __syncthreads();
#pragma unroll
        for (int i = 0; i < 4; ++i) { const int o = (F.wave * 64 + lane_id()) + 512 * i; float sum = 0.f;
#pragma unroll
            for (int ww = 0; ww < 8; ++ww) sum += part[ww * 2048 + o];
            const int tt = o >> 10, r = (o >> 6) & 15, ln = o & 63; const int t = 32 * tt + (r & 3) + 8 * (r >> 2) + 4 * (ln >> 5);
            GDB[(size_t)(tok0 + t) * 32 + (ln & 31)] = sum; }
        __syncthreads();
    }
}

__device__ __forceinline__ void p3_finalize(Frame& F, const Args& a) {
    unsigned char* ws = a.ws;
    const int gw = F.vcu * NWAVES + F.wave, NGW = F.G * NWAVES, lane = lane_id();
    const GAS bf16* OFp = (const GAS bf16*)(ws + WS_OF); const GAS bf16* OBp = (const GAS bf16*)(ws + WS_OB);
    const GAS bf16* PROJ = (const GAS bf16*)(ws + WS_PROJ); GAS bf16* Y = (GAS bf16*)(ws + WS_XN);
    const GAS float* ATTML = (const GAS float*)(ws + WS_ATTML); const GAS bf16* ATTP = (const GAS bf16*)(ws + WS_ATTP);
    const GAS float* gla_g = (const GAS float*)a.in[7]; const GAS float* att_g = (const GAS float*)a.in[8];
    const f32x4 gg = *(const GAS f32x4*)(gla_g + 4 * lane);
    f32x4 ag[2][2];
#pragma unroll
    for (int p = 0; p < 2; ++p) { ag[p][0] = *(const GAS f32x4*)(att_g + p * 512 + 8 * lane); ag[p][1] = *(const GAS f32x4*)(att_g + p * 512 + 8 * lane + 4); }
    unsigned long long wf[4], wb[4], gr[4], nwf[4], nwb[4], ngr[4]; f32x2 ml[2][3], nml[2][3]; v4u ow[2][3], now[2][3];
#define P3_LOAD(MM, WF, WB, GR, ML, OW) do { _Pragma("unroll") for (int hh = 0; hh < 4; ++hh) { WF[hh] = *(const GAS unsigned long long*)(OFp + (size_t)(MM) * 1024 + hh * 256 + 4 * lane); \
            WB[hh] = *(const GAS unsigned long long*)(OBp + (size_t)(MM) * 1024 + hh * 256 + 4 * lane); GR[hh] = *(const GAS unsigned long long*)(PROJ + (size_t)(MM) * NINP + O_GR + hh * 256 + 4 * lane); } \
        _Pragma("unroll") for (int p = 0; p < 2; ++p) { const int col = p * 512 + 8 * lane, hd = col >> 6; _Pragma("unroll") for (int pt = 0; pt < 3; ++pt) { const size_t rec = ((size_t)pt * M + (MM)) * 16 + hd; \
            ML[p][pt] = *(const GAS f32x2*)(ATTML + rec * 2); OW[p][pt] = *(const GAS v4u*)(ATTP + rec * 64 + (col & 63)); } } } while (0)
    if (gw < M) P3_LOAD(gw, wf, wb, gr, ml, ow);
    for (int m = gw; m < M; m += NGW) {
        const int mn = m + NGW < M ? m + NGW : m;
        P3_LOAD(mn, nwf, nwb, ngr, nml, now);
#pragma unroll
        for (int hh = 0; hh < 4; ++hh) {
            const f32x4 o = (f32x4){bflo((unsigned)wf[hh]) + bflo((unsigned)wb[hh]), bfhi((unsigned)wf[hh]) + bfhi((unsigned)wb[hh]), bflo((unsigned)(wf[hh] >> 32)) + bflo((unsigned)(wb[hh] >> 32)), bfhi((unsigned)(wf[hh] >> 32)) + bfhi((unsigned)(wb[hh] >> 32))};
            const float ss = wave_sum((o.x * o.x + o.y * o.y) + (o.z * o.z + o.w * o.w));
            const float rstd = 1.f / sqrtf(ss * (1.f / 256.f) + EPS);
            const float r0 = bflo((unsigned)gr[hh]), r1 = bfhi((unsigned)gr[hh]), r2 = bflo((unsigned)(gr[hh] >> 32)), r3 = bfhi((unsigned)(gr[hh] >> 32));
            const float y0 = o.x * rstd * gg.x * (r0 / (1.f + __expf(-r0))), y1 = o.y * rstd * gg.y * (r1 / (1.f + __expf(-r1)));
            const float y2 = o.z * rstd * gg.z * (r2 / (1.f + __expf(-r2))), y3 = o.w * rstd * gg.w * (r3 / (1.f + __expf(-r3)));
            *(GAS unsigned long long*)(Y + (size_t)m * DM + hh * 256 + 4 * lane) = (unsigned long long)pk2(y0, y1) | ((unsigned long long)pk2(y2, y3) << 32);
        }
        float av[16]; float ss = 0.f;
#pragma unroll
        for (int p = 0; p < 2; ++p) {
            const float mt = fmaxf(fmaxf(ml[p][0].x, ml[p][1].x), ml[p][2].x); const float w0 = __expf(ml[p][0].x - mt), w1 = __expf(ml[p][1].x - mt), w2 = __expf(ml[p][2].x - mt);
            const float inv = 1.f / (w0 * ml[p][0].y + w1 * ml[p][1].y + w2 * ml[p][2].y);
            av[p * 8 + 0] = (w0 * bflo(ow[p][0].x) + w1 * bflo(ow[p][1].x) + w2 * bflo(ow[p][2].x)) * inv; av[p * 8 + 1] = (w0 * bfhi(ow[p][0].x) + w1 * bfhi(ow[p][1].x) + w2 * bfhi(ow[p][2].x)) * inv;
            av[p * 8 + 2] = (w0 * bflo(ow[p][0].y) + w1 * bflo(ow[p][1].y) + w2 * bflo(ow[p][2].y)) * inv; av[p * 8 + 3] = (w0 * bfhi(ow[p][0].y) + w1 * bfhi(ow[p][1].y) + w2 * bfhi(ow[p][2].y)) * inv;
            av[p * 8 + 4] = (w0 * bflo(ow[p][0].z) + w1 * bflo(ow[p][1].z) + w2 * bflo(ow[p][2].z)) * inv; av[p * 8 + 5] = (w0 * bfhi(ow[p][0].z) + w1 * bfhi(ow[p][1].z) + w2 * bfhi(ow[p][2].z)) * inv;
            av[p * 8 + 6] = (w0 * bflo(ow[p][0].w) + w1 * bflo(ow[p][1].w) + w2 * bflo(ow[p][2].w)) * inv; av[p * 8 + 7] = (w0 * bfhi(ow[p][0].w) + w1 * bfhi(ow[p][1].w) + w2 * bfhi(ow[p][2].w)) * inv; }
#pragma unroll
        for (int i = 0; i < 16; ++i) ss += av[i] * av[i];
        const float rstd = 1.f / sqrtf(wave_sum(ss) * (1.f / 1024.f) + EPS);
#pragma unroll
        for (int p = 0; p < 2; ++p) { const f32x4 g0 = ag[p][0], g1 = ag[p][1];
            v4u w; w.x = pk2(av[p * 8 + 0] * rstd * g0.x, av[p * 8 + 1] * rstd * g0.y); w.y = pk2(av[p * 8 + 2] * rstd * g0.z, av[p * 8 + 3] * rstd * g0.w);
            w.z = pk2(av[p * 8 + 4] * rstd * g1.x, av[p * 8 + 5] * rstd * g1.y); w.w = pk2(av[p * 8 + 6] * rstd * g1.z, av[p * 8 + 7] * rstd * g1.w);
            *(GAS v4u*)(Y + (size_t)m * DM + 1024 + p * 512 + 8 * lane) = w; }
#pragma unroll
        for (int hh = 0; hh < 4; ++hh) { wf[hh] = nwf[hh]; wb[hh] = nwb[hh]; gr[hh] = ngr[hh]; }
#pragma unroll
        for (int p = 0; p < 2; ++p)
#pragma unroll
            for (int pt = 0; pt < 3; ++pt) { ml[p][pt] = nml[p][pt]; ow[p][pt] = now[p][pt]; }
    }
#undef P3_LOAD
}


__device__ __forceinline__ void ce_desc(float& a, float& b) { const float hi = fmaxf(a, b), lo = fminf(a, b); a = hi; b = lo; }
__device__ __forceinline__ void sort16_desc(float* v) {
    ce_desc(v[0], v[1]); ce_desc(v[2], v[3]); ce_desc(v[0], v[2]); ce_desc(v[1], v[3]); ce_desc(v[1], v[2]); ce_desc(v[4], v[5]); ce_desc(v[6], v[7]); ce_desc(v[4], v[6]);
    ce_desc(v[5], v[7]); ce_desc(v[5], v[6]); ce_desc(v[0], v[4]); ce_desc(v[2], v[6]); ce_desc(v[2], v[4]); ce_desc(v[1], v[5]); ce_desc(v[3], v[7]); ce_desc(v[3], v[5]);
    ce_desc(v[1], v[2]); ce_desc(v[3], v[4]); ce_desc(v[5], v[6]); ce_desc(v[8], v[9]); ce_desc(v[10], v[11]); ce_desc(v[8], v[10]); ce_desc(v[9], v[11]); ce_desc(v[9], v[10]);
    ce_desc(v[12], v[13]); ce_desc(v[14], v[15]); ce_desc(v[12], v[14]); ce_desc(v[13], v[15]); ce_desc(v[13], v[14]); ce_desc(v[8], v[12]); ce_desc(v[10], v[14]); ce_desc(v[10], v[12]);
    ce_desc(v[9], v[13]); ce_desc(v[11], v[15]); ce_desc(v[11], v[13]); ce_desc(v[9], v[10]); ce_desc(v[11], v[12]); ce_desc(v[13], v[14]); ce_desc(v[0], v[8]); ce_desc(v[4], v[12]);
    ce_desc(v[4], v[8]); ce_desc(v[2], v[10]); ce_desc(v[6], v[14]); ce_desc(v[6], v[10]); ce_desc(v[2], v[4]); ce_desc(v[6], v[8]); ce_desc(v[10], v[12]); ce_desc(v[1], v[9]);
    ce_desc(v[5], v[13]); ce_desc(v[5], v[9]); ce_desc(v[3], v[11]); ce_desc(v[7], v[15]); ce_desc(v[7], v[11]); ce_desc(v[3], v[5]); ce_desc(v[7], v[9]); ce_desc(v[11], v[13]);
    ce_desc(v[1], v[2]); ce_desc(v[3], v[4]); ce_desc(v[5], v[6]); ce_desc(v[7], v[8]); ce_desc(v[9], v[10]); ce_desc(v[11], v[12]); ce_desc(v[13], v[14]);
}
__device__ __forceinline__ void merge16_desc(float* v) {
#pragma unroll
    for (int j = 8; j > 0; j >>= 1)
#pragma unroll
        for (int i = 0; i < 16; ++i) { const int l = i ^ j; if (l > i) ce_desc(v[i], v[l]); }
}
__device__ __forceinline__ void top16_of_two(float* a, const float* b) {
#pragma unroll
    for (int i = 0; i < 16; ++i) a[i] = fmaxf(a[i], b[15 - i]);
    merge16_desc(a);
}
__device__ __forceinline__ void top16_of_64(float* v) {
    sort16_desc(v); sort16_desc(v + 16); sort16_desc(v + 32); sort16_desc(v + 48);
    top16_of_two(v, v + 16); top16_of_two(v + 32, v + 48); top16_of_two(v, v + 32);
}
__device__ __forceinline__ void merge8_desc(float* v) {
#pragma unroll
    for (int j = 4; j > 0; j >>= 1)
#pragma unroll
        for (int i = 0; i < 8; ++i) { const int l = i ^ j; if (l > i) ce_desc(v[i], v[l]); }
}
__device__ __forceinline__ void top16_staircase(const float* A, const float* B, float* t1) {
    float Bp[16]; const float cb = 1.f - (A[15] + B[15]);
#pragma unroll
    for (int j = 0; j < 16; ++j) Bp[j] = B[j] + cb;
#define PK_CND(i, j) __builtin_bit_cast(float, (__builtin_bit_cast(unsigned, A[(i)] + Bp[(j)]) & ~255u) | (unsigned)(255 - (((i) << 4) | (j))))
#pragma unroll
    for (int j = 0; j < 16; ++j) t1[j] = PK_CND(0, j);
#pragma unroll
    for (int i = 4; i < 16; ++i) t1[i] = fmaxf(t1[i], PK_CND(4 + (15 - i), 0));
    merge16_desc(t1);
    float t2[16];
#pragma unroll
    for (int k = 0; k < 8; ++k) t2[k] = PK_CND(1, k);
    t2[8] = 0.f; t2[9] = 0.f; t2[10] = 0.f;
#pragma unroll
    for (int m = 0; m < 5; ++m) t2[11 + m] = PK_CND(2, 4 - m);
    merge16_desc(t2);
    float t3[9];
#pragma unroll
    for (int k = 0; k < 4; ++k) { t3[k] = PK_CND(3, k); t3[4 + k] = PK_CND(4 + (3 - k), 1); }
    merge8_desc(t3);
    t3[8] = PK_CND(4, 2);
#pragma unroll
    for (int k = 7; k >= 0; --k) ce_desc(t3[k], t3[k + 1]);
#pragma unroll
    for (int i = 7; i < 16; ++i) t2[i] = fmaxf(t2[i], t3[15 - i]);
    merge16_desc(t2);
#pragma unroll
    for (int i = 0; i < 16; ++i) t1[i] = fmaxf(t1[i], t2[15 - i]);
    merge16_desc(t1);
#undef PK_CND
}
__device__ __forceinline__ void topk_phase(Frame& F, const Args& a) {
    unsigned char* ws = a.ws; const GAS bf16* QP = (const GAS bf16*)(ws + WS_XN); const GAS bf16* SKB = (const GAS bf16*)(ws + WS_SKB); GAS int* EIDX = (GAS int*)(ws + WS_EIDX); GAS int* EIDX16 = (GAS int*)(ws + WS_EIDX16); GAS float* GATE = (GAS float*)(ws + WS_GATE);
    const int lane = lane_id(), r32 = lane & 31, hh = lane >> 5;
    LAS unsigned char* skl = F.lds;
    LAS int* ktab = (LAS int*)(F.lds + 65536 + F.wave * 8192);
    for (int unit = F.vcu; unit < 8 * (M / 512); unit += F.G) {
        const int h = unit & 7, tok0 = (unit >> 3) * 512 + F.wave * 64;
        __syncthreads();
#pragma unroll
        for (int i = 0; i < 8; ++i) { const int idx = (F.wave * 64 + lane_id()) + 512 * i, key = idx >> 4, ch = idx & 15;
            *(LAS v4u*)(skl + key * 256 + ((ch ^ (key & 15)) * 16)) = *(const GAS v4u*)(SKB + ((size_t)h * 256 + key) * 128 + ch * 8); }
        __syncthreads();
#pragma unroll 1
        for (int tt = 0; tt < 2; ++tt) {
            const size_t row = (size_t)(tok0 + tt * 32 + r32);
            float L[2][16];
#pragma unroll
            for (int c = 0; c < 2; ++c) {
                f32x16 acc[4];
#pragma unroll
                for (int kt = 0; kt < 4; ++kt) acc[kt] = (f32x16){0.f, 0.f, 0.f, 0.f, 0.f, 0.f, 0.f, 0.f, 0.f, 0.f, 0.f, 0.f, 0.f, 0.f, 0.f, 0.f};
                const GAS bf16* qb = QP + row * DM + h * 256 + c * 128 + 8 * hh;
#pragma unroll 2
                for (int st = 0; st < 8; ++st) {
                    const bf16x8 bq = *(const GAS bf16x8*)(qb + 16 * st);
#pragma unroll
                    for (int kt = 0; kt < 4; ++kt) { const int key = c * 128 + 32 * kt + r32; const bf16x8 ak = *(const LAS bf16x8*)(skl + key * 256 + (((2 * st + hh) ^ (key & 15)) * 16));
                        acc[kt] = __builtin_amdgcn_mfma_f32_32x32x16_bf16(ak, bq, acc[kt], 0, 0, 0); }
                }
                float v[64];
#pragma unroll
                for (int kt = 0; kt < 4; ++kt)
#pragma unroll
                    for (int r = 0; r < 16; ++r) { const int key = 32 * kt + (r & 3) + 8 * (r >> 2);
                        const float sc = acc[kt][r];
                        v[kt * 16 + r] = __builtin_bit_cast(float, (__builtin_bit_cast(unsigned, sc) & ~127u) | (unsigned)(key + 4 * hh)); }
                top16_of_64(v);
                float p[16];
#pragma unroll
                for (int i = 0; i < 16; ++i) { float lo_, hi_; SWAP_PAIR(__builtin_amdgcn_permlane32_swap, v[i], lo_, hi_); v[i] = lo_; p[i] = hi_; }
                top16_of_two(v, p);
#pragma unroll
                for (int i = 0; i < 16; ++i) { L[c][i] = v[i]; ktab[(c * 16 + i) * 64 + lane] = (int)(__builtin_bit_cast(unsigned, v[i]) & 127u); }
            }
            float cnd[16]; top16_staircase(L[0], L[1], cnd);
            float rstd; { const GAS f32x4* sp = (const GAS f32x4*)((const GAS float*)(ws + WS_SSQ) + row * 32); float ssq = 0.f;
#pragma unroll
              for (int i = 0; i < 8; ++i) { const f32x4 t4 = sp[i]; ssq += (t4.x + t4.y) + (t4.z + t4.w); }
              rstd = 1.0f / sqrtf(ssq * (1.f / DM) + EPS); }
            float mx = __builtin_bit_cast(float, __builtin_bit_cast(unsigned, cnd[0]) & ~255u), sum = 0.f; float ex[16];
#pragma unroll
            for (int i = 0; i < 16; ++i) { ex[i] = __expf((__builtin_bit_cast(float, __builtin_bit_cast(unsigned, cnd[i]) & ~255u) - mx) * rstd); sum += ex[i]; }
            const float inv = 1.f / sum;
            LDS_WAIT(); asm volatile("" ::: "memory");
            if (hh == 0) {
                int ev[16];
#pragma unroll
                for (int i = 0; i < 16; ++i) { const unsigned bits = 255u - (__builtin_bit_cast(unsigned, cnd[i]) & 255u); const int ia = (bits >> 4) & 15, jb = bits & 15; ev[i] = ktab[ia * 64 + lane] * 128 + ktab[(16 + jb) * 64 + lane]; }
                GAS int* ep = EIDX + row * 128 + h * 16; GAS float* gp = GATE + row * 128 + h * 16;
#pragma unroll
                for (int i = 0; i < 2; ++i) *(GAS i32x4*)(EIDX16 + row * 64 + h * 8 + 4 * i) = (i32x4){ev[8 * i] | (ev[8 * i + 1] << 16), ev[8 * i + 2] | (ev[8 * i + 3] << 16), ev[8 * i + 4] | (ev[8 * i + 5] << 16), ev[8 * i + 6] | (ev[8 * i + 7] << 16)};
#pragma unroll
                for (int i = 0; i < 4; ++i) { *(GAS i32x4*)(ep + 4 * i) = (i32x4){ev[4 * i], ev[4 * i + 1], ev[4 * i + 2], ev[4 * i + 3]}; *(GAS f32x4*)(gp + 4 * i) = (f32x4){ex[4 * i] * inv, ex[4 * i + 1] * inv, ex[4 * i + 2] * inv, ex[4 * i + 3] * inv}; }
            }
            LDS_WAIT(); asm volatile("" ::: "memory");
        }
    }
}

__device__ __forceinline__ void gla_prep_phase(Frame& F, const Args& a) {
    unsigned char* ws = a.ws; const bf16* PROJ;
    const int w = F.wave;
    LAS unsigned char* L = F.lds;
    LAS unsigned char* Qraw = L; LAS unsigned char* Kraw = L + 16384; LAS unsigned char* Vraw = L + 32768; LAS float* GDf = (LAS float*)(L + 65536); LAS float* GSUM = (LAS float*)(L + 73728);
    LAS unsigned char* IMGQ = L + 77824; LAS unsigned char* IMGK = L + 95232; LAS unsigned char* IMGE = L + 112640; LAS unsigned char* AMI = L + 32768;
    v4u rq[2], rk[2], rv[4]; f32x4 rg0, rg1;
#define PREP_LOAD(IT) do { const int b_ = (IT) >> 8, h_ = ((IT) >> 6) & 3, n_ = (IT) & 63; const size_t row0_ = (size_t)b_ * SEQ + n_ * 64; ws = opaque(ws); PROJ = (const bf16*)(ws + WS_PROJ); const int tid_ = opaque_v((F.wave * 64 + lane_id())); \
        _Pragma("unroll") for (int i = 0; i < 2; ++i) { const int idx = tid_ + 512 * i, r = idx >> 4, c = idx & 15; \
            rq[i] = *(const GAS v4u*)(PROJ + (row0_ + r) * NINP + O_GQ + h_ * 128 + c * 8); rk[i] = *(const GAS v4u*)(PROJ + (row0_ + r) * NINP + O_GK + h_ * 128 + c * 8); } \
        _Pragma("unroll") for (int i = 0; i < 4; ++i) { const int idx = tid_ + 512 * i, r = idx >> 5, c = idx & 31; rv[i] = *(const GAS v4u*)(PROJ + (row0_ + r) * NINP + O_GV + h_ * 256 + c * 8); } \
        if (tid_ < 256) { const int r = tid_ >> 2, c = tid_ & 3; const GAS float* gsrc = (const GAS float*)(ws + WS_GDB) + (row0_ + r) * 32 + c * 8; rg0 = *(const GAS f32x4*)gsrc; rg1 = *(const GAS f32x4*)(gsrc + 4); } } while (0)
#define PREP_STORE() do { const int tid_ = opaque_v((F.wave * 64 + lane_id())); \
        _Pragma("unroll") for (int i = 0; i < 2; ++i) { const int idx = tid_ + 512 * i, r = idx >> 4, c = idx & 15; *(LAS v4u*)(Qraw + r * 256 + c * 16) = rq[i]; *(LAS v4u*)(Kraw + r * 256 + c * 16) = rk[i]; } \
        _Pragma("unroll") for (int i = 0; i < 4; ++i) { const int idx = tid_ + 512 * i, r = idx >> 5, c = idx & 31; *(LAS v4u*)(Vraw + r * 512 + c * 16) = rv[i]; } \
        if (tid_ < 256) { const int r = tid_ >> 2, c = tid_ & 3; *(LAS f32x4*)(GDf + r * 32 + c * 8) = rg0; *(LAS f32x4*)(GDf + r * 32 + c * 8 + 4) = rg1; } } while (0)
    if (F.vcu < 1024) PREP_LOAD(F.vcu);
    float up0[16], up1[16], bias0 = 0.f, bias1 = 0.f; int hcur = -1;
    for (int it = F.vcu; it < 1024; it += F.G) {
        const int b = it >> 8, h = (it >> 6) & 3, n = it & 63;
        int tid = opaque_v((F.wave * 64 + lane_id())), lane = tid & 63, r32 = lane & 31, hh = lane >> 5;
        if (h != hcur) { hcur = h; const int d = tid & 127; const GAS float* u0 = (const GAS float*)a.in[3] + h * 128 + d; const GAS float* u1 = (const GAS float*)a.in[5] + h * 128 + d;
#pragma unroll
            for (int r = 0; r < 16; ++r) { up0[r] = u0[r * 512]; up1[r] = u1[r * 512]; }
            bias0 = ((const GAS float*)a.in[4])[h * 128 + d]; bias1 = ((const GAS float*)a.in[6])[h * 128 + d]; }
        PREP_STORE();
        __syncthreads();
        if (it + F.G < 1024) PREP_LOAD(it + F.G);
#pragma unroll
        for (int ks = 0; ks < 4; ++ks) { unsigned pk[4];
#pragma unroll
            for (int p = 0; p < 4; ++p) { const int s0 = 16 * ks + 8 * hh + 2 * p; const unsigned lo = *(const LAS unsigned short*)(Vraw + s0 * 512 + (32 * w + r32) * 2), hi = *(const LAS unsigned short*)(Vraw + (s0 + 1) * 512 + (32 * w + r32) * 2); pk[p] = lo | (hi << 16); }
            *(GAS v4u*)((unsigned char*)a.out + OUT_GT_VT + (size_t)it * 32768 + (w * 4 + ks) * 1024 + lane * 16) = (v4u){pk[0], pk[1], pk[2], pk[3]}; }
        for (int dir = 0; dir < 2; ++dir) {
            const size_t idir = (size_t)(((b * 4 + h) * 2 + dir) * 64 + n); ws = opaque(ws); tid = opaque_v(tid); lane = tid & 63; r32 = lane & 31; hh = lane >> 5;
            {
                const int d = tid & 127, tq = tid >> 7; const float bias = dir ? bias1 : bias0;
                float up[16];
#pragma unroll
                for (int r = 0; r < 16; ++r) up[r] = dir ? up1[r] : up0[r];
                float c[16];
#pragma unroll
                for (int i = 0; i < 16; ++i) { const LAS float* g = GDf + (16 * tq + i) * 32 + dir * 16; float z = bias;
#pragma unroll
                    for (int r = 0; r < 16; ++r) z += g[r] * up[r];
                    c[i] = (fminf(z, 0.f) - __logf(1.f + __expf(-fabsf(z)))) * (1.f / 16.f); }
                if (dir == 0) {
#pragma unroll
                    for (int i = 1; i < 16; ++i) c[i] += c[i - 1];
                } else {
#pragma unroll
                    for (int i = 14; i >= 0; --i) c[i] += c[i + 1];
                }
                GSUM[(dir * 4 + tq) * 128 + d] = dir == 0 ? c[15] : c[0];
                __syncthreads();
                const float t0 = GSUM[(dir * 4 + 0) * 128 + d], t1 = GSUM[(dir * 4 + 1) * 128 + d], t2 = GSUM[(dir * 4 + 2) * 128 + d], t3 = GSUM[(dir * 4 + 3) * 128 + d];
                const float Bt = (t0 + t1) + (t2 + t3);
                float off;
                if (dir == 0) off = (tq > 0 ? t0 : 0.f) + (tq > 1 ? t1 : 0.f) + (tq > 2 ? t2 : 0.f);
                else off = (tq < 1 ? t1 : 0.f) + (tq < 2 ? t2 : 0.f) + (tq < 3 ? t3 : 0.f);
                unsigned kep[8];
#pragma unroll
                for (int i = 0; i < 16; i += 2) { float ke2[2];
#pragma unroll
                    for (int q = 0; q < 2; ++q) { const int t = 16 * tq + i + q; const float bi = c[i + q] + off;
                        const float qv = bf2f(*(const LAS unsigned short*)(Qraw + t * 256 + d * 2)), kv = bf2f(*(const LAS unsigned short*)(Kraw + t * 256 + d * 2));
                        *(LAS unsigned short*)(IMGQ + t * 272 + d * 2) = (unsigned short)pk2(qv * 0.08838834764831845f * __expf(bi), 0.f);
                        *(LAS unsigned short*)(IMGK + t * 272 + d * 2) = (unsigned short)pk2(kv * __expf(-bi), 0.f);
                        ke2[q] = kv * __expf(Bt - bi); }
                    kep[i >> 1] = pk2(ke2[0], ke2[1]); }
                *(LAS v4u*)(IMGE + d * 144 + (16 * tq) * 2) = (v4u){kep[0], kep[1], kep[2], kep[3]};
                *(LAS v4u*)(IMGE + d * 144 + (16 * tq + 8) * 2) = (v4u){kep[4], kep[5], kep[6], kep[7]};
                if (tq == 0) ((GAS float*)((unsigned char*)a.out + OUT_GT_DEC))[idir * 128 + d] = __expf(Bt);
            }
            __syncthreads();
            if (w < 4) {
                const int si = w >> 1, ti = w & 1; f32x16 acc = (f32x16){0.f, 0.f, 0.f, 0.f, 0.f, 0.f, 0.f, 0.f, 0.f, 0.f, 0.f, 0.f, 0.f, 0.f, 0.f, 0.f};
#pragma unroll
                for (int ks = 0; ks < 8; ++ks) { const bf16x8 ak = *(const LAS bf16x8*)(IMGK + (32 * si + r32) * 272 + (16 * ks + 8 * hh) * 2), bq = *(const LAS bf16x8*)(IMGQ + (32 * ti + r32) * 272 + (16 * ks + 8 * hh) * 2);
                    acc = __builtin_amdgcn_mfma_f32_32x32x16_bf16(ak, bq, acc, 0, 0, 0); }
                const int t = 32 * ti + r32;
#pragma unroll
                for (int qd = 0; qd < 4; ++qd) { float v4[4];
#pragma unroll
                    for (int i = 0; i < 4; ++i) { const int sidx = 32 * si + 8 * qd + 4 * hh + i; const float x = acc[4 * qd + i]; const bool keep = dir == 0 ? (sidx <= t) : (sidx >= t); v4[i] = keep ? x : 0.f; }
                    *(LAS unsigned long long*)(AMI + t * 144 + (32 * si + 8 * qd + 4 * hh) * 2) = (unsigned long long)pk2(v4[0], v4[1]) | ((unsigned long long)pk2(v4[2], v4[3]) << 32); }
            } else {
                const int w4 = w - 4;
#pragma unroll
                for (int q = 0; q < 4; ++q) { const int bq = w4 * 4 + q, tt = bq >> 3, ks = bq & 7, j = ks >> 1, u = ks & 1; const int t = 32 * tt + r32;
                    const unsigned long long p0 = *(const LAS unsigned long long*)(IMGQ + t * 272 + (32 * j + 16 * u + 4 * hh) * 2), p1 = *(const LAS unsigned long long*)(IMGQ + t * 272 + (32 * j + 16 * u + 8 + 4 * hh) * 2);
                    *(GAS v4u*)(ws + WS_GT_QD + idir * 16384 + bq * 1024 + lane * 16) = (v4u){(unsigned)p0, (unsigned)(p0 >> 32), (unsigned)p1, (unsigned)(p1 >> 32)}; }
#pragma unroll
                for (int q = 0; q < 4; ++q) { const int bk = w4 * 4 + q, j = bk >> 2, ks = bk & 3; const int d = 32 * j + r32;
                    *(GAS v4u*)(ws + WS_GT_KE + idir * 16384 + bk * 1024 + lane * 16) = *(const LAS v4u*)(IMGE + d * 144 + (16 * ks + 8 * hh) * 2); }
            }
            __syncthreads();
            { const int tt = w >> 2, ks = w & 3; const int t = 32 * tt + r32;
              *(GAS v4u*)((unsigned char*)a.out + OUT_GT_AM + idir * 8192 + w * 1024 + lane * 16) = *(const LAS v4u*)(AMI + t * 144 + (16 * ks + 8 * hh) * 2); }
            __syncthreads();
        }
    }
#undef PREP_LOAD
#undef PREP_STORE
}

__device__ __forceinline__ void gla_seq_phase(Frame& F, const Args& a) {
    unsigned char* ws = a.ws;
    const int w = F.wave;
    constexpr int GBUF = 57856;
    const int bx_ = (int)blockIdx.x;
    const int su_ = (F.G % 8 == 0 && F.G >= 64) ? (((bx_ >> 3) < 8) ? (bx_ & 7) * 8 + (bx_ >> 3) : 64) : bx_;
    for (int unit = su_; unit < 64; unit += F.G) {
        const int dir = unit & 1, eh = (unit >> 1) & 1, bh = unit >> 2, b = bh >> 2, h = bh & 3;
        if (w >= 4) {
            const int lt = opaque_v((F.wave * 64 + lane_id())) - 256;
            v4u A[15], B[15];
#define GLA_LOAD(R, NS) do { const int n_ = dir ? 63 - (NS) : (NS); const size_t idir_ = (size_t)((bh * 2 + dir) * 64 + n_), iv_ = (size_t)(bh * 64 + n_); const unsigned char* o_ = opaque((const unsigned char*)a.out); const unsigned char* w_ = opaque(ws); \
            const GAS v4u* gq_ = (const GAS v4u*)(w_ + WS_GT_QD + idir_ * 16384); const GAS v4u* gk_ = (const GAS v4u*)(w_ + WS_GT_KE + idir_ * 16384); const GAS v4u* ga_ = (const GAS v4u*)(o_ + OUT_GT_AM + idir_ * 8192); \
            const GAS v4u* gv_ = (const GAS v4u*)(o_ + OUT_GT_VT + iv_ * 32768 + eh * 16384); const GAS v4u* gd_ = (const GAS v4u*)(o_ + OUT_GT_DEC + idir_ * 512); \
            _Pragma("unroll") for (int i = 0; i < 4; ++i) { R[i] = gq_[lt + 256 * i]; R[4 + i] = gk_[lt + 256 * i]; R[10 + i] = gv_[lt + 256 * i]; } R[8] = ga_[lt]; R[9] = ga_[lt + 256]; R[14] = gd_[lt & 31]; } while (0)
#define GLA_WRITE(R, BUF) do { LAS v4u* d_ = (LAS v4u*)(F.lds + (BUF) * GBUF); \
            _Pragma("unroll") for (int i = 0; i < 4; ++i) { d_[lt + 256 * i] = R[i]; d_[1024 + lt + 256 * i] = R[4 + i]; d_[2560 + lt + 256 * i] = R[10 + i]; } d_[2048 + lt] = R[8]; d_[2048 + lt + 256] = R[9]; if (lt < 32) d_[3584 + lt] = R[14]; } while (0)
            GLA_LOAD(A, 0); GLA_LOAD(B, 1);
            GLA_WRITE(A, 0);
            __syncthreads();
#pragma unroll 1
            for (int ns = 0; ns < 64; ns += 2) {
                if (ns + 2 < 64) GLA_LOAD(A, ns + 2);
                GLA_WRITE(B, 1);
                __syncthreads();
                if (ns + 3 < 64) GLA_LOAD(B, ns + 3);
                if (ns + 2 < 64) GLA_WRITE(A, 0);
                __syncthreads();
            }
#undef GLA_LOAD
#undef GLA_WRITE
        } else {
            f32x16 S[4];
#pragma unroll
            for (int j = 0; j < 4; ++j) S[j] = (f32x16){0.f, 0.f, 0.f, 0.f, 0.f, 0.f, 0.f, 0.f, 0.f, 0.f, 0.f, 0.f, 0.f, 0.f, 0.f, 0.f};
            __syncthreads();
#pragma unroll 1
            for (int ns = 0; ns < 64; ++ns) {
                const int n = dir ? 63 - ns : ns;
                const int lane = opaque_v(lane_id()), r32 = lane & 31, hh = lane >> 5;
                LAS unsigned char* QDl = F.lds + (ns & 1) * GBUF; LAS unsigned char* KEl = QDl + 16384; LAS unsigned char* AMl = QDl + 32768; LAS unsigned char* VTl = QDl + 40960; LAS float* DECl = (LAS float*)(QDl + 57344);
                GAS bf16* Out = (GAS bf16*)(opaque(ws) + (dir ? WS_OB : WS_OF));
                bf16x8 vf[4];
#pragma unroll
                for (int ks = 0; ks < 4; ++ks) vf[ks] = *(const LAS bf16x8*)(VTl + (w * 4 + ks) * 1024 + lane * 16);
                f32x16 o[2];
#pragma unroll
                for (int tt = 0; tt < 2; ++tt) o[tt] = (f32x16){0.f, 0.f, 0.f, 0.f, 0.f, 0.f, 0.f, 0.f, 0.f, 0.f, 0.f, 0.f, 0.f, 0.f, 0.f, 0.f};
#pragma unroll
                for (int ks8 = 0; ks8 < 8; ++ks8) { const int j = ks8 >> 1, u = ks8 & 1; v4u sb;
                    sb.x = pg8::cvt_pk_bf16(S[j][8 * u + 0], S[j][8 * u + 1]); sb.y = pg8::cvt_pk_bf16(S[j][8 * u + 2], S[j][8 * u + 3]); sb.z = pg8::cvt_pk_bf16(S[j][8 * u + 4], S[j][8 * u + 5]); sb.w = pg8::cvt_pk_bf16(S[j][8 * u + 6], S[j][8 * u + 7]);
                    const bf16x8 bs = __builtin_bit_cast(bf16x8, sb);
#pragma unroll
                    for (int tt = 0; tt < 2; ++tt) { const bf16x8 aq = *(const LAS bf16x8*)(QDl + (tt * 8 + ks8) * 1024 + lane * 16); o[tt] = __builtin_amdgcn_mfma_f32_32x32x16_bf16(aq, bs, o[tt], 0, 0, 0); } }
#pragma unroll
                for (int ks = 0; ks < 4; ++ks)
#pragma unroll
                    for (int tt = 0; tt < 2; ++tt) { const bf16x8 am = *(const LAS bf16x8*)(AMl + (tt * 4 + ks) * 1024 + lane * 16); o[tt] = __builtin_amdgcn_mfma_f32_32x32x16_bf16(am, vf[ks], o[tt], 0, 0, 0); }
#pragma unroll
                for (int tt = 0; tt < 2; ++tt)
#pragma unroll
                    for (int r = 0; r < 16; ++r) { const int t = 32 * tt + (r & 3) + 8 * (r >> 2) + 4 * hh; const float x = o[tt][r];
                        Out[((size_t)b * SEQ + 64 * n + t) * 1024 + h * 256 + 32 * (eh * 4 + w) + r32] = (bf16)pk2(x, 0.f); }
#pragma unroll
                for (int j = 0; j < 4; ++j) {
#pragma unroll
                    for (int q = 0; q < 4; ++q) { const f32x4 dv = *(const LAS f32x4*)(DECl + 32 * j + 8 * q + 4 * hh); S[j][4 * q + 0] *= dv.x; S[j][4 * q + 1] *= dv.y; S[j][4 * q + 2] *= dv.z; S[j][4 * q + 3] *= dv.w; }
#pragma unroll
                    for (int ks = 0; ks < 4; ++ks) { const bf16x8 ak = *(const LAS bf16x8*)(KEl + (j * 4 + ks) * 1024 + lane * 16); S[j] = __builtin_amdgcn_mfma_f32_32x32x16_bf16(ak, vf[ks], S[j], 0, 0, 0); } }
                __syncthreads();
            }
        }
    }
}

typedef short v4i16_t __attribute__((ext_vector_type(4)));
__device__ __forceinline__ void attn_phase(Frame& F, const Args& a, int qslot) {
    unsigned char* ws = a.ws; const bf16* PROJ;
    const int w = F.wave;
    volatile LAS int* uword = (volatile LAS int*)(F.lds + 2 * 78336);
    constexpr int NUNITS = 64 * 3 * 32;
#define ATT_DECODE(U) const int bh = (U) / 96, rem = (U) - bh * 96, p = rem >> 5, idx = rem & 31; const int lgd = 2 * p, d = 1 << lgd; \
        const int r = idx >> (5 - lgd), J = idx & ((32 >> lgd) - 1), Lc = SEQ >> lgd; const int b = bh >> 4, h = bh & 15; const int m0 = 128 * J - 64;
    v4u kx[4], vx[4]; v4u qw[2];
#define ATT_LOAD(U) do { ATT_DECODE(U) ws = opaque(ws); PROJ = (const bf16*)(ws + WS_PROJ); const int tid_ = opaque_v((F.wave * 64 + lane_id())); \
        _Pragma("unroll") for (int i = 0; i < 4; ++i) { const int kr = (tid_ >> 3) + 64 * i, ch = tid_ & 7; const int mp = m0 + kr; kx[i] = (v4u){0u, 0u, 0u, 0u}; vx[i] = kx[i]; \
            if (mp >= 0 && mp < Lc) { const bf16* src = PROJ + ((size_t)b * SEQ + r + d * mp) * NINP + O_AK + h * 64 + ch * 8; kx[i] = *(const GAS v4u*)src; vx[i] = *(const GAS v4u*)(src + (O_AV - O_AK)); } } \
        const int tokq_ = r + d * (128 * J + 16 * w + (tid_ & 15)); \
        _Pragma("unroll") for (int sft = 0; sft < 2; ++sft) qw[sft] = *(const GAS v4u*)(PROJ + ((size_t)b * SEQ + tokq_) * NINP + O_AQ + h * 64 + 32 * sft + 8 * ((tid_ & 63) >> 4)); } while (0)
    float tab[40];
    { const int l0 = opaque_v(lane_id());
#pragma unroll
      for (int c = 0; c < 40; ++c) { const int kb = c >> 3, uu = (c >> 2) & 1, rho = c & 3; const int jo = 32 * kb + 8 * (l0 >> 4) + 4 * uu + rho - 64 - (l0 & 15); const int aj = jo < 0 ? -jo : jo; tab[c] = aj <= 64 ? (float)aj : 3.0e38f; } }
#define ATT_FETCH(DST) do { int v_ = NUNITS; int qx_ = uword[2], qt_ = uword[3]; while (qt_ < 8) { const int t_ = (int)__hip_atomic_fetch_add((unsigned*)(F.ctl + CW_ATTQX + 128 * qslot + 16 * qx_), 1u, __ATOMIC_RELAXED, __HIP_MEMORY_SCOPE_AGENT); \
        if (t_ < 768) { v_ = qx_ * 768 + t_; break; } qx_ = (qx_ + 1) & 7; ++qt_; } uword[2] = qx_; uword[3] = qt_; DST = v_; } while (0)
    if ((F.wave * 64 + lane_id()) == 0) { uword[2] = (int)blockIdx.x & 7; uword[3] = 0; int f0, f1; ATT_FETCH(f0); ATT_FETCH(f1); uword[0] = f0; uword[1] = f1; }
    __syncthreads();
    int u = __builtin_amdgcn_readfirstlane(uword[0]), un = __builtin_amdgcn_readfirstlane(uword[1]); int par = 0;
#define ATT_WRITE(BUF) do { const int tid_ = opaque_v((F.wave * 64 + lane_id())); LAS unsigned char* Kw = F.lds + (BUF) * 78336; LAS unsigned char* Vw = Kw + 39168; \
        _Pragma("unroll") for (int i = 0; i < 4; ++i) { const int kr = (tid_ >> 3) + 64 * i, ch = tid_ & 7; *(LAS v4u*)(Kw + kr * 144 + ch * 16) = kx[i]; *(LAS v4u*)(Vw + kr * 144 + ch * 16) = vx[i]; } \
        if (tid_ < 128) { const int kr = 256 + (tid_ >> 3), ch = tid_ & 7; *(LAS v4u*)(Kw + kr * 144 + ch * 16) = (v4u){0u, 0u, 0u, 0u}; *(LAS v4u*)(Vw + kr * 144 + ch * 16) = (v4u){0u, 0u, 0u, 0u}; } } while (0)
    v4u qwc[2];
    if (u < NUNITS) { ATT_LOAD(u); ATT_WRITE(0); qwc[0] = qw[0]; qwc[1] = qw[1]; }
    __syncthreads();
    int bufi = 0;
    while (u < NUNITS) {
        const int tid = opaque_v((F.wave * 64 + lane_id())), lane = tid & 63, q16 = lane & 15, g = lane >> 4;
        int qnext = 0; if (tid == 0) ATT_FETCH(qnext);
        LAS unsigned char* Kl = F.lds + bufi * 78336; LAS unsigned char* Vl = Kl + 39168;
        bf16x8 qf[2];
#pragma unroll
        for (int sft = 0; sft < 2; ++sft) { v4u qs; constexpr float QS = 0.125f * 1.4426950408889634f; qs.x = pk2(bflo(qwc[sft].x) * QS, bfhi(qwc[sft].x) * QS); qs.y = pk2(bflo(qwc[sft].y) * QS, bfhi(qwc[sft].y) * QS); qs.z = pk2(bflo(qwc[sft].z) * QS, bfhi(qwc[sft].z) * QS); qs.w = pk2(bflo(qwc[sft].w) * QS, bfhi(qwc[sft].w) * QS);
            qf[sft] = __builtin_bit_cast(bf16x8, qs); }
        ATT_DECODE(u)
        const int tokq = r + d * (128 * J + 16 * w + q16);
        if (un < NUNITS) ATT_LOAD(un);
        const float nslope = -exp2f(-0.5f * (float)(h + 1)) * (float)d * 1.4426950408889634f;
        const bool inrange = (m0 + 16 * w >= 0) && (m0 + 16 * w + 159 < Lc);
        float sv[5][2][4]; float mx = -3.0e38f;
#pragma unroll
        for (int kb = 0; kb < 5; ++kb)
#pragma unroll
            for (int uu = 0; uu < 2; ++uu) { f32x4 acc = (f32x4){0.f, 0.f, 0.f, 0.f};
                const int krow = 16 * w + 32 * kb + 8 * (q16 >> 2) + 4 * uu + (q16 & 3);
#pragma unroll
                for (int sft = 0; sft < 2; ++sft) { const bf16x8 ak = *(const LAS bf16x8*)(Kl + krow * 144 + (32 * sft + 8 * g) * 2); acc = __builtin_amdgcn_mfma_f32_16x16x32_bf16(ak, qf[sft], acc, 0, 0, 0); }
#pragma unroll
                for (int rho = 0; rho < 4; ++rho) { const float x = acc[rho]; sv[kb][uu][rho] = __builtin_fmaf(nslope, tab[kb * 8 + uu * 4 + rho], x); } }
        if (!inrange) {
#pragma unroll
            for (int kb = 0; kb < 5; ++kb)
#pragma unroll
                for (int uu = 0; uu < 2; ++uu)
#pragma unroll
                    for (int rho = 0; rho < 4; ++rho) { const int mp = m0 + 16 * w + 32 * kb + 8 * g + 4 * uu + rho; if (mp < 0 || mp >= Lc) sv[kb][uu][rho] = -3.0e38f; } }
#pragma unroll
        for (int kb = 0; kb < 5; ++kb)
#pragma unroll
            for (int uu = 0; uu < 2; ++uu)
#pragma unroll
                for (int rho = 0; rho < 4; ++rho) mx = fmaxf(mx, sv[kb][uu][rho]);
        mx = xrow_max(mx);
        float lsum = 0.f; bf16x8 pf[5];
#pragma unroll
        for (int kb = 0; kb < 5; ++kb) { float e[8];
#pragma unroll
            for (int uu = 0; uu < 2; ++uu)
#pragma unroll
                for (int rho = 0; rho < 4; ++rho) { const float pe = __builtin_amdgcn_exp2f(sv[kb][uu][rho] - mx); e[uu * 4 + rho] = pe; lsum += pe; }
            v4u pw; pw.x = pk2(e[0], e[1]); pw.y = pk2(e[2], e[3]); pw.z = pk2(e[4], e[5]); pw.w = pk2(e[6], e[7]); pf[kb] = __builtin_bit_cast(bf16x8, pw); }
        lsum = xrow_sum(lsum);
        f32x4 oT[4];
#pragma unroll
        for (int nn = 0; nn < 4; ++nn) oT[nn] = (f32x4){0.f, 0.f, 0.f, 0.f};
#pragma unroll
        for (int kb = 0; kb < 5; ++kb)
#pragma unroll
            for (int nn = 0; nn < 4; ++nn) { const LAS unsigned char* va = Vl + (16 * w + 32 * kb + 8 * g + (q16 >> 2)) * 144 + (16 * nn + 4 * (q16 & 3)) * 2;
                const v4i16_t lo = __builtin_amdgcn_ds_read_tr16_b64_v4i16((LAS v4i16_t*)va), hi = __builtin_amdgcn_ds_read_tr16_b64_v4i16((LAS v4i16_t*)(va + 4 * 144));
                const bf16x8 vf = (bf16x8){lo[0], lo[1], lo[2], lo[3], hi[0], hi[1], hi[2], hi[3]};
                oT[nn] = __builtin_amdgcn_mfma_f32_16x16x32_bf16(vf, pf[kb], oT[nn], 0, 0, 0); }
        { LAS unsigned char* Ko = F.lds + (bufi ^ 1) * 78336;
          LAS unsigned char* sw = Ko + ((q16 & 8) ? 39168 : 0) + (8 * w + (q16 & 7)) * 144 + 8 * g;
#pragma unroll
          for (int nn = 0; nn < 4; ++nn) *(LAS unsigned long long*)(sw + 32 * nn) = (unsigned long long)pk2(oT[nn][0], oT[nn][1]) | ((unsigned long long)pk2(oT[nn][2], oT[nn][3]) << 32);
          const int rr = lane >> 3, ch = lane & 7;
#pragma unroll
          for (int hs = 0; hs < 2; ++hs) { const v4u o = *(const LAS v4u*)(Ko + hs * 39168 + (8 * w + rr) * 144 + ch * 16);
              const size_t rec2 = ((size_t)p * M + (size_t)b * SEQ + (size_t)(r + d * (128 * J + 16 * w + 8 * hs + rr))) * 16 + h;
              *(GAS v4u*)((GAS bf16*)(opaque(ws) + WS_ATTP) + rec2 * 64 + 8 * ch) = o; }
          if (g == 0) { const size_t rec = ((size_t)p * M + (size_t)b * SEQ + tokq) * 16 + h; GAS float* ml = (GAS float*)(opaque(ws) + WS_ATTML) + rec * 2; ml[0] = mx * 0.6931471805599453f; ml[1] = lsum; } }
        if (un < NUNITS) { ATT_WRITE(bufi ^ 1); qwc[0] = qw[0]; qwc[1] = qw[1]; }
        if (tid == 0) uword[par] = qnext;
        __syncthreads();
        u = un; un = __builtin_amdgcn_readfirstlane(uword[par]); par ^= 1; bufi ^= 1;
    }
#undef ATT_WRITE
#undef ATT_DECODE
#undef ATT_LOAD
#undef ATT_FETCH
}

typedef __bf16 bf16x2_t __attribute__((ext_vector_type(2)));
__device__ __forceinline__ void peer_convert_tables(Frame& F, const Args& a, int qslot) {
    unsigned char* ws = a.ws; const int lane = lane_id(); volatile LAS int* uword = (volatile LAS int*)(F.lds + 2 * 78336 + 64);
    for (;;) {
        __syncthreads();
        if ((F.wave * 64 + lane_id()) == 0) uword[0] = (int)__hip_atomic_fetch_add((unsigned*)(F.ctl + CW_CONVQ + 64 * qslot), 1u, __ATOMIC_RELAXED, __HIP_MEMORY_SCOPE_AGENT);
        __syncthreads();
        const int blk = __builtin_amdgcn_readfirstlane(uword[0]);
        if (blk >= 2 * PEER_E / 128) break;
        const int rbase = blk * 128 + F.wave * 16; const bool isv = rbase >= PEER_E; const int e0 = rbase & (PEER_E - 1);
        const GAS float* src = (const GAS float*)(isv ? a.in[14] : a.in[13]) + (size_t)e0 * DM + 4 * lane;
        GAS unsigned char* dst = (GAS unsigned char*)a.out + (isv ? OUT_V8 : OUT_U8) + (size_t)e0 * 256 + 4 * lane;     GAS float* sc = (GAS float*)(ws + (isv ? WS_SV : WS_SU)) + e0;
        f32x4 v[8], vn[8];
#pragma unroll
        for (int j = 0; j < 8; ++j) v[j] = *(const GAS f32x4*)(src + 256 * j);
#pragma unroll 1
        for (int i = 0; i < 16; ++i) { const int in_ = i + 1 < 16 ? i + 1 : i;
#pragma unroll
            for (int j = 0; j < 8; ++j) vn[j] = *(const GAS f32x4*)(src + (size_t)in_ * DM + 256 * j);
            float am = 0.f;
#pragma unroll
            for (int j = 0; j < 8; ++j) am = fmaxf(am, fmaxf(fmaxf(fabsf(v[j].x), fabsf(v[j].y)), fmaxf(fabsf(v[j].z), fabsf(v[j].w))));
            am = wave_max(am); am = fmaxf(am, 1e-30f);
            const float inv = 440.f / am;
#pragma unroll
            for (int j = 0; j < 8; ++j) { int p = __builtin_amdgcn_cvt_pk_fp8_f32(v[j].x * inv, v[j].y * inv, 0, false); p = __builtin_amdgcn_cvt_pk_fp8_f32(v[j].z * inv, v[j].w * inv, p, true);
                *(GAS int*)(dst + (size_t)i * 256 + (size_t)j * (PEER_E * 256)) = p; }
            if (lane == 0) sc[i] = am * (1.f / 440.f);
#pragma unroll
            for (int j = 0; j < 8; ++j) v[j] = vn[j]; }
    }
}

__device__ __forceinline__ float dpp_row_sum(float x) {
#define PEER_DPP(ctrl) x += __builtin_bit_cast(float, __builtin_amdgcn_update_dpp(0, __builtin_bit_cast(int, x), ctrl, 0xF, 0xF, false))
    PEER_DPP(0xB1); PEER_DPP(0x4E); PEER_DPP(0x141); PEER_DPP(0x140);
#undef PEER_DPP
    return x;
}
template <bool VPH, int PBS, bool LA> __device__ __forceinline__ void peer_uv_phase(Frame& F, const Args& a) {
    unsigned char* ws = a.ws; GAS bf16* H = (GAS bf16*)(ws + WS_HB); const GAS float* g2 = (const GAS float*)a.in[10];
    const int sl = blockIdx.x & 7, rk = blockIdx.x >> 3, nrk = F.G >> 3, tpw = M / nrk / NWAVES, nq = tpw / 4;
    const unsigned char* TAB; const GAS int* EIDX; const GAS float* SSQ; const GAS float* PW; GAS float* PD; GAS float* SSQ2;
    LAS int* idt = (LAS int*)(F.lds + F.wave * 8704);
    LAS float* wt = (LAS float*)(F.lds + F.wave * 8704 + 4352);
    const int t0 = (rk * NWAVES + F.wave) * tpw;
#define PEER_STAGE_LOAD(QI) do { const size_t tb_ = (size_t)(t0 + 4 * (QI) + a4) * 64; _Pragma("unroll") for (int k = 0; k < 4; ++k) sid[k] = EIDX[tb_ + 16 * k + q]; } while (0)
#define PEER_STAGE_WRITE(QI) do { const int bf_ = ((QI) & 1) * 528; _Pragma("unroll") for (int k = 0; k < 4; ++k) *(LAS i32x2*)(idt + bf_ + a4 * 132 + 32 * k + 2 * q) = (i32x2){sid[k] & 0xffff, (int)((unsigned)sid[k] >> 16)}; } while (0)
#define PEER_STAGE_W(QI) do { if (VPH) { const size_t tb_ = (size_t)(t0 + 4 * (QI) + a4) * 128; const int bf_ = ((QI) & 1) * 528; _Pragma("unroll") for (int k = 0; k < 8; ++k) wt[bf_ + a4 * 132 + 16 * k + q] = PW[tb_ + 16 * k + q]; LDS_WAIT(); asm volatile("" ::: "memory"); } } while (0)
#define PEER_ISSUE(R, QI, WB) do { const int bf_ = ((QI) & 1) * 528 + a4 * 132 + (WB) * PBS; i32x4 e4_; _Pragma("unroll") for (int j = 0; j < PBS; ++j) { if ((j & 3) == 0) e4_ = *(const LAS i32x4*)(idt + bf_ + j); const int e_ = (j & 3) == 0 ? e4_.x : (j & 3) == 1 ? e4_.y : (j & 3) == 2 ? e4_.z : e4_.w; R[j] = ldu<i32x4>(TAB, (unsigned)e_ * 256u + (unsigned)(16 * q)); } } while (0)
    unsigned xq[8]; float acc[16];
#define PEER_QUAD_BEGIN(QI) do { const size_t t_ = (size_t)(t0 + 4 * (QI) + a4); \
        if (!VPH) { f32x4 hq[4]; { const v4u h0_ = *(const GAS v4u*)(H + t_ * DM + 256 * sl + 16 * q), h1_ = *(const GAS v4u*)(H + t_ * DM + 256 * sl + 16 * q + 8); \
            hq[0] = (f32x4){bflo(h0_.x), bfhi(h0_.x), bflo(h0_.y), bfhi(h0_.y)}; hq[1] = (f32x4){bflo(h0_.z), bfhi(h0_.z), bflo(h0_.w), bfhi(h0_.w)}; hq[2] = (f32x4){bflo(h1_.x), bfhi(h1_.x), bflo(h1_.y), bfhi(h1_.y)}; hq[3] = (f32x4){bflo(h1_.z), bfhi(h1_.z), bflo(h1_.w), bfhi(h1_.w)}; }  const float pss_ = dpp_row_sum(SSQ[t_ * 32 + q] + SSQ[t_ * 32 + 16 + q]); const float rstd_ = 1.f / sqrtf(pss_ * (1.f / DM) + EPS); f32x4 gv[4]; \
            _Pragma("unroll") for (int k = 0; k < 4; ++k) gv[k] = *(const GAS f32x4*)(g2 + 256 * sl + 16 * q + 4 * k); \
            _Pragma("unroll") for (int k = 0; k < 4; ++k) { xq[2 * k] = pk2(hq[k].x * rstd_ * gv[k].x, hq[k].y * rstd_ * gv[k].y); xq[2 * k + 1] = pk2(hq[k].z * rstd_ * gv[k].z, hq[k].w * rstd_ * gv[k].w); } } \
        else { _Pragma("unroll") for (int k = 0; k < 16; ++k) acc[k] = 0.f; } } while (0)
#define PEER_COMPUTE(R, QI, WB) do { if (!VPH) { float pdb_ = 0.f; _Pragma("unroll") for (int j = 0; j < PBS; ++j) { float d_ = 0.f; _Pragma("unroll") for (int k = 0; k < 4; ++k) { const int dw_ = R[j][k]; \
                d_ = __builtin_amdgcn_fdot2_f32_bf16(__builtin_amdgcn_cvt_scalef32_pk_bf16_fp8(dw_, 1.0f, false), __builtin_bit_cast(bf16x2_t, xq[2 * k]), d_, false); \
                d_ = __builtin_amdgcn_fdot2_f32_bf16(__builtin_amdgcn_cvt_scalef32_pk_bf16_fp8(dw_, 1.0f, true), __builtin_bit_cast(bf16x2_t, xq[2 * k + 1]), d_, false); } \
                d_ = dpp_row_sum(d_); pdb_ = (q == j) ? d_ : pdb_; } \
            if (q < PBS) PD[((size_t)(t0 + 4 * (QI) + a4) * 8 + sl) * 128 + PBS * (WB) + q] = pdb_; } \
        else { const int bf_ = ((QI) & 1) * 528 + a4 * 132 + (WB) * PBS; f32x4 w4_; _Pragma("unroll") for (int j = 0; j < PBS; ++j) { if ((j & 3) == 0) w4_ = *(const LAS f32x4*)(wt + bf_ + j); const float w_ = (j & 3) == 0 ? w4_.x : (j & 3) == 1 ? w4_.y : (j & 3) == 2 ? w4_.z : w4_.w; int r0_ = R[j][0], r1_ = R[j][1], r2_ = R[j][2], r3_ = R[j][3]; asm volatile("" : "+v"(r0_), "+v"(r1_), "+v"(r2_), "+v"(r3_));     \
                _Pragma("unroll") for (int k = 0; k < 4; ++k) { const int dw_ = k == 0 ? r0_ : k == 1 ? r1_ : k == 2 ? r2_ : r3_; \
                const f32x2 lo_ = __builtin_amdgcn_cvt_pk_f32_fp8(dw_, false), hi_ = __builtin_amdgcn_cvt_pk_f32_fp8(dw_, true); \
                acc[4 * k + 0] += w_ * lo_.x; acc[4 * k + 1] += w_ * lo_.y; acc[4 * k + 2] += w_ * hi_.x; acc[4 * k + 3] += w_ * hi_.y; } } } } while (0)
#define PEER_QUAD_END(QI) do { if (VPH) { const size_t t_ = (size_t)(t0 + 4 * (QI) + a4); GAS bf16* hp_ = H + t_ * DM + 256 * sl + 16 * q; const v4u h0_ = *(const GAS v4u*)hp_, h1_ = *(const GAS v4u*)(hp_ + 8); \
            float y_[16]; y_[0] = bflo(h0_.x); y_[1] = bfhi(h0_.x); y_[2] = bflo(h0_.y); y_[3] = bfhi(h0_.y); y_[4] = bflo(h0_.z); y_[5] = bfhi(h0_.z); y_[6] = bflo(h0_.w); y_[7] = bfhi(h0_.w); \
            y_[8] = bflo(h1_.x); y_[9] = bfhi(h1_.x); y_[10] = bflo(h1_.y); y_[11] = bfhi(h1_.y); y_[12] = bflo(h1_.z); y_[13] = bfhi(h1_.z); y_[14] = bflo(h1_.w); y_[15] = bfhi(h1_.w); \
            float ss_ = 0.f; _Pragma("unroll") for (int k = 0; k < 16; ++k) { y_[k] += acc[k]; ss_ += y_[k] * y_[k]; } \
            *(GAS v4u*)hp_ = (v4u){pk2(y_[0], y_[1]), pk2(y_[2], y_[3]), pk2(y_[4], y_[5]), pk2(y_[6], y_[7])}; *(GAS v4u*)(hp_ + 8) = (v4u){pk2(y_[8], y_[9]), pk2(y_[10], y_[11]), pk2(y_[12], y_[13]), pk2(y_[14], y_[15])}; \
            ss_ = dpp_row_sum(ss_); if (q == 0) SSQ2[t_ * 8 + sl] = ss_; } } while (0)
#pragma unroll 1
    for (int qi = 0; qi < nq; ++qi) {
        i32x4 rA[PBS], rB[PBS];
        const int lane = opaque_v(lane_id()), a4 = lane >> 4, q = lane & 15; ws = opaque(ws); H = (GAS bf16*)(ws + WS_HB);
        TAB = opaque((const unsigned char*)a.out) + (VPH ? OUT_V8 : OUT_U8) + (size_t)sl * (PEER_E * 256); EIDX = (const GAS int*)(ws + WS_EIDX16); SSQ = (const GAS float*)(ws + WS_SSQ); PW = (const GAS float*)(ws + WS_PW); PD = (GAS float*)(ws + WS_PD); SSQ2 = (GAS float*)(ws + WS_SSQ2);
        int sid[4];
        if (!LA || qi == 0) { PEER_STAGE_LOAD(qi); PEER_STAGE_WRITE(qi); LDS_WAIT(); asm volatile("" ::: "memory"); }
        PEER_ISSUE(rA, qi, 0);
        PEER_ISSUE(rB, qi, 1);
        if (LA && qi + 1 < nq) PEER_STAGE_LOAD(qi + 1);
        PEER_STAGE_W(qi);
        PEER_QUAD_BEGIN(qi);
#pragma unroll
        for (int wb = 0; wb < 128 / PBS; wb += 2) {
            PEER_COMPUTE(rA, qi, wb); if (wb + 2 < 128 / PBS) { PEER_ISSUE(rA, qi, wb + 2); }
            PEER_COMPUTE(rB, qi, wb + 1); if (wb + 3 < 128 / PBS) { PEER_ISSUE(rB, qi, wb + 3); }
        }
        PEER_QUAD_END(qi);
        if (LA && qi + 1 < nq) { PEER_STAGE_WRITE(qi + 1); LDS_WAIT(); asm volatile("" ::: "memory"); }
    }
#undef PEER_STAGE_LOAD
#undef PEER_STAGE_WRITE
#undef PEER_STAGE_W
#undef PEER_ISSUE
#undef PEER_QUAD_BEGIN
#undef PEER_COMPUTE
#undef PEER_QUAD_END
}
__device__ __forceinline__ void peer_w_phase(Frame& F, const Args& a) {
    unsigned char* ws = a.ws; const float* PD = (const float*)(ws + WS_PD); const int* EIDX = (const int*)(ws + WS_EIDX); const float* GATE = (const float*)(ws + WS_GATE);
    const float* SU = (const float*)(ws + WS_SU); const float* SV = (const float*)(ws + WS_SV); float* PW = (float*)(ws + WS_PW);
    for (int i = F.vcu * 512 + (F.wave * 64 + lane_id()); i < M * 128; i += F.G * 512) { const int t = i >> 7, p = i & 127; float d = 0.f;
#pragma unroll
        for (int sl = 0; sl < 8; ++sl) d += PD[((size_t)t * 8 + sl) * 128 + p];
        const int e = EIDX[i]; d *= SU[e];
        PW[i] = GATE[i] * 0.5f * d * (1.f + erff(d * 0.70710678118654752f)) * SV[e]; }
}
__device__ __forceinline__ void peer_n_phase(Frame& F, const Args& a) {
    unsigned char* ws = a.ws; const GAS bf16* Y = (const GAS bf16*)(ws + WS_HB); GAS float* O = (GAS float*)a.out; const GAS float* gf = (const GAS float*)a.in[15]; const GAS float* SSQ2 = (const GAS float*)(ws + WS_SSQ2); const int lane = lane_id();
    f32x4 g0[4], g1[4];
#pragma unroll
    for (int j = 0; j < 4; ++j) { g0[j] = *(const GAS f32x4*)(gf + 512 * j + 8 * lane); g1[j] = *(const GAS f32x4*)(gf + 512 * j + 8 * lane + 4); }
    const int gw = F.vcu * NWAVES + F.wave, NGW = F.G * NWAVES;
    v4u yw[4], yn[4]; f32x4 s0, s1, n0, n1;
    if (gw < M) {
#pragma unroll
        for (int j = 0; j < 4; ++j) yw[j] = *(const GAS v4u*)(Y + (size_t)gw * DM + 512 * j + 8 * lane);
        s0 = *(const GAS f32x4*)(SSQ2 + (size_t)gw * 8); s1 = *(const GAS f32x4*)(SSQ2 + (size_t)gw * 8 + 4); }
    for (int m = gw; m < M; m += NGW) { const int mn = m + NGW < M ? m + NGW : m;
#pragma unroll
        for (int j = 0; j < 4; ++j) yn[j] = *(const GAS v4u*)(Y + (size_t)mn * DM + 512 * j + 8 * lane);
        n0 = *(const GAS f32x4*)(SSQ2 + (size_t)mn * 8); n1 = *(const GAS f32x4*)(SSQ2 + (size_t)mn * 8 + 4);
        const float rf = 1.f / sqrtf((((s0.x + s0.y) + (s0.z + s0.w)) + ((s1.x + s1.y) + (s1.z + s1.w))) * (1.f / DM) + EPS);
#pragma unroll
        for (int j = 0; j < 4; ++j) {
            *(GAS f32x4*)(O + (size_t)m * DM + 512 * j + 8 * lane) = (f32x4){bflo(yw[j].x) * rf * g0[j].x, bfhi(yw[j].x) * rf * g0[j].y, bflo(yw[j].y) * rf * g0[j].z, bfhi(yw[j].y) * rf * g0[j].w};
            *(GAS f32x4*)(O + (size_t)m * DM + 512 * j + 8 * lane + 4) = (f32x4){bflo(yw[j].z) * rf * g1[j].x, bfhi(yw[j].z) * rf * g1[j].y, bflo(yw[j].w) * rf * g1[j].z, bfhi(yw[j].w) * rf * g1[j].w}; }
#pragma unroll
        for (int j = 0; j < 4; ++j) yw[j] = yn[j];
        s0 = n0; s1 = n1; }
}

__global__ void __launch_bounds__(NWAVES * 64, 2) mk_fwd(Args args_in) {
    extern __shared__ __attribute__((aligned(16))) unsigned char lds[];
    Args args = args_in;
#pragma unroll
    for (int i = 0; i < 16; ++i) args.in[i] = (const float*)(const GAS float*)args_in.in[i];
    args.out = (float*)(GAS float*)args_in.out; args.ws = (unsigned char*)(GAS unsigned char*)args_in.ws;
    Frame F;
    F.lds = (LAS unsigned char*)lds;
    F.MISC = (volatile LAS unsigned*)(F.lds + MISC_OFF);
    F.wave = __builtin_amdgcn_readfirstlane((int)threadIdx.x >> 6);
    F.G = gridDim.x; { const int bx = blockIdx.x; F.vcu = (F.G % 8 == 0) ? (bx % 8) * (F.G / 8) + bx / 8 : bx; }
    unsigned char* ws = args.ws;
    F.ctl = (gu32*)(ws + WS_CTL);
    for (int u = (F.wave * 64 + lane_id()); u < (LDS_BYTES - LDSCTL_OFF) / 4; u += NWAVES * 64) ((LAS unsigned*)(F.lds + LDSCTL_OFF))[u] = 0u;
    __syncthreads();
    XcdBarrier bar = xcd_barrier_post((unsigned*)(F.ctl + CW_BAR) + args.li * XCD_BAR_WORDS, F.MISC + 8);
    const int lo = args.ph_lo, hi = args.ph_hi;
#define IN(k) (lo <= (k) && (k) < hi)
#define BOTH(k) (IN(k) && IN((k) + 1))
#define GRID_BAR() xcd_barrier(bar)

    if (IN(0)) { for (int rep = 0; rep < NREP(0); ++rep) p0_prologue(F, args); if (BOTH(0)) GRID_BAR(); }

    if (IN(1)) {
        pg8::Gemm g{(const bf16*)(ws + WS_XN), (const bf16*)(ws + WS_WIN), M, NINP, DM}; pg8::StaticOrder S; S.init(M, NINP, F.G, (int)blockIdx.x);
        pg8::EpiBf16S E{(pg8::bf16_t*)(ws + WS_PROJ), NINP, F.lds + pg8::EPI_STAGE_OFF};
        for (int rep = 0; rep < NREP(1); ++rep) pg8::gemm_phase<pg8::EpiBf16S, pg8::StaticOrder, PG8_ALIGN, PG8_SP2>(F.lds + RING_OFF, g, S, E);
        for (int rep = 0; rep < NREP(11); ++rep) gd_side_gemm(F, args);
        if (BOTH(1)) GRID_BAR();
    }
    if (IN(2)) {
        for (int rep = 0; rep < NREP(21); ++rep) gla_prep_phase(F, args);
        GRID_BAR();
        for (int rep = 0; rep < NREP(2); ++rep) gla_seq_phase(F, args);
        const bool conv_first = ((int)blockIdx.x >> 3) >= CONV_FIRST_RANK;
        for (int pass = 0; pass < 2; ++pass) {
            if (pass == 1 || conv_first) peer_convert_tables(F, args, 0);
            if (pass == 0) attn_phase(F, args, 0); }
        if (BOTH(2)) GRID_BAR(); }
    if (IN(3)) { for (int rep = 0; rep < NREP(3); ++rep) p3_finalize(F, args); if (BOTH(3)) GRID_BAR(); if (REP_PHASE == 99) { GRID_BAR(); GRID_BAR(); GRID_BAR(); GRID_BAR(); } }
    if (IN(4)) {
        pg8::Gemm g{(const bf16*)(ws + WS_XN), (const bf16*)(ws + WS_WOUT), M, DM, DM}; pg8::StaticOrder S; S.init(M, DM, F.G, (int)blockIdx.x);
        pg8::EpiResS E{args.in[0], (pg8::bf16_t*)(ws + WS_HB), (float*)(ws + WS_SSQ), DM, F.lds + pg8::EPI_STAGE_OFF};
        for (int rep = 0; rep < NREP(4); ++rep) pg8::gemm_phase<pg8::EpiResS, pg8::StaticOrder, PG8_ALIGN, PG8_SP2>(F.lds + RING_OFF, g, S, E);
        if (BOTH(4)) GRID_BAR();
    }
    if (IN(5)) {
        pg8::Gemm g{(const bf16*)(ws + WS_HB), (const bf16*)(ws + WS_WQ), M, DM, DM}; pg8::StaticOrder S; S.init(M, DM, F.G, (int)blockIdx.x);
        pg8::EpiBf16S E{(pg8::bf16_t*)(ws + WS_XN), DM, F.lds + pg8::EPI_STAGE_OFF};
        for (int rep = 0; rep < NREP(5); ++rep) pg8::gemm_phase<pg8::EpiBf16S, pg8::StaticOrder, PG8_ALIGN, PG8_SP2>(F.lds + RING_OFF, g, S, E);
        if (BOTH(5)) GRID_BAR();
    }
    if (IN(6)) { for (int rep = 0; rep < NREP(6); ++rep) topk_phase(F, args); if (BOTH(6)) GRID_BAR(); }
    if (IN(7)) {
        for (int rep = 0; rep < NREP(7); ++rep) peer_uv_phase<false, 16, true>(F, args);
        GRID_BAR();
        peer_w_phase(F, args);
        GRID_BAR();
        if (REP_PHASE != 8) peer_uv_phase<true, 8, true>(F, args);
        GRID_BAR();
        peer_n_phase(F, args);
    }
#undef IN
#undef BOTH
}


extern "C" void kernel_launch(void* const* d_in, const int* in_sizes, int n_in, void* d_out, int out_size, void* d_ws, size_t ws_size, hipStream_t stream) {
    static int grid = 0;
    if (grid == 0) {
        if (n_in != 16 || in_sizes[0] != M * DM || out_size != M * DM || ws_size < WS_END) { fprintf(stderr, "kernel_launch: unexpected shapes: n_in %d in0 %d out %d ws %zu\n", n_in, n_in > 0 ? in_sizes[0] : -1, out_size, ws_size); grid = -1; return; }
        int dev = 0, cus = 0;
        if (hipGetDevice(&dev) != hipSuccess || hipDeviceGetAttribute(&cus, hipDeviceAttributeMultiprocessorCount, dev) != hipSuccess) { grid = -1; return; }
        if (hipFuncSetAttribute((const void*)mk_fwd, hipFuncAttributeMaxDynamicSharedMemorySize, LDS_BYTES) != hipSuccess) { fprintf(stderr, "kernel_launch: hipFuncSetAttribute failed\n"); grid = -1; return; }
        (void)hipGetLastError();
        grid = cus;
    }
    if (grid < 0) return;
    (void)hipMemsetAsync((char*)d_ws + WS_CTL, 0, CTL_ZERO_BYTES, stream);
    Args a{};
    for (int i = 0; i < 16; ++i) a.in[i] = (const float*)d_in[i];
    a.out = (float*)d_out; a.ws = (unsigned char*)d_ws;
    a.ph_lo = 0; a.ph_hi = 8; a.li = 0;
    hipLaunchKernelGGL(mk_fwd, dim3(grid), dim3(NWAVES * 64), LDS_BYTES, stream, a);
}
```

```cpp
#define REP_PHASE -1
#define PG8_ALIGN false
#include <hip/hip_runtime.h>
#include <cstdio>
#include <cstdint>
#include <cmath>
#ifndef REP_PHASE
#define REP_PHASE -1
#endif
#define NREP(k) ((REP_PHASE == (k)) ? 2 : 1)
namespace pg8 {
#define PG8_LAS __attribute__((address_space(3)))
typedef unsigned short bf16_t;
typedef short bf16x8 __attribute__((ext_vector_type(8)));
typedef float f32x4 __attribute__((ext_vector_type(4)));
typedef unsigned u32x4 __attribute__((ext_vector_type(4)));
constexpr int BM = 256, BK = 64, HALF = 128, HTB = HALF * BK * 2  , STAGE_BYTES = 8 * HTB, NXCD = 8, WGM = 8;

__host__ __device__ __forceinline__ int lds_byte(int r, int c) { const int st = (r >> 4) * 2 + (c >> 5), rr = r & 15, cc = c & 31, ob = rr * 64 + cc * 2; return st * 1024 + (ob ^ (((ob >> 9) & 1) << 5)); }
__host__ __device__ __forceinline__ void stage_rc(int b, int& R, int& C) { const int st = b / 1024, sb = b % 1024, swz = sb ^ (((sb >> 9) & 1) << 5); R = (st >> 1) * 16 + swz / 64; C = (st & 1) * 32 + (swz % 64) / 2; }
__host__ __device__ __forceinline__ int perm32(int rho) { const int n = rho >> 4, i = rho & 15; return 8 * (i >> 2) + 4 * n + (i & 3); }

struct Unit { int pm, pn; };
struct Gemm { const bf16_t* A; const bf16_t* Bt; int M, N, K; };

struct StaticOrder {
    int nM, nN, nwg, G, c;
    __host__ __device__ void init(int M, int N, int G_, int c_) { nM = M / BM; nN = N / BM; nwg = nM * nN; G = G_; c = c_; }
    __host__ __device__ bool next(int i, Unit& u) const {
        const long L = (long)i * G + c; if (L >= nwg) return false;
        int wgid = (int)L; { const int q = nwg / NXCD, r = nwg % NXCD, xcd = wgid % NXCD, off = wgid / NXCD; wgid = (xcd < r ? xcd * (q + 1) : r * (q + 1) + (xcd - r) * q) + off; }
        const int nig = WGM * nN, gid = wgid / nig, fm = gid * WGM, gsz = (nM - fm) < WGM ? (nM - fm) : WGM;
        u.pm = fm + ((wgid % nig) % gsz); u.pn = (wgid % nig) / gsz; return true;
    }
    __device__ __forceinline__ void a_ready(const Unit&) const {}
    __device__ __forceinline__ void done(const Unit&) const {}
};

__device__ __forceinline__ unsigned cvt_pk_bf16(float lo, float hi) { unsigned r; asm volatile("v_cvt_pk_bf16_f32 %0, %1, %2" : "=v"(r) : "v"(lo), "v"(hi)); return r; }
typedef float f32x2 __attribute__((ext_vector_type(2)));
__device__ __forceinline__ f32x2 gelu_pk(f32x2 v) {
    const f32x2 av = __builtin_elementwise_abs(v), d = av * 0.2316418882f + 1.0f;
    f32x2 t; t.x = __builtin_amdgcn_rcpf(d.x); t.y = __builtin_amdgcn_rcpf(d.y);
    f32x2 q = t * 0.5307027145f + (-0.7265760135f); q = q * t + 0.7107068705f; q = q * t + (-0.142248368f); q = q * t + 0.127414796f; q = q * t;
    const f32x2 s = (v * v) * (-0.72134752044f);
    f32x2 e; e.x = __builtin_amdgcn_exp2f(s.x); e.y = __builtin_amdgcn_exp2f(s.y);
    const f32x2 m = v * (q * e), r = v - m;
    f32x2 o; o.x = v.x < 0.f ? m.x : r.x; o.y = v.y < 0.f ? m.y : r.y; return o;
}

template <int ACT  > struct EpiBf16 {
    static constexpr bool PERM = true, AFTER_DRAIN = false; static_assert(ACT == 0 || ACT == 1, "EpiBf16: ACT is 0 (none) or 1 (gelu_pk)");
    bf16_t* O; int ldc; const float* bias; int split_cols; size_t split_stride; float scale0;
    __device__ __forceinline__ void operator()(const f32x4 (&acc)[2][2][4][2], const Unit& u, int wr, int wc, int fr, int fq) const {
        const int row0 = u.pm * BM + wr * 64 + fr; int colt = u.pn * BM; bf16_t* base = O;
        float sc = 1.f; if (split_cols) { const int t = colt / split_cols; base += (size_t)t * split_stride; colt -= t * split_cols; if (t == 0) sc = scale0; }
        const int col0 = colt + wc * 32 + 8 * fq, bcol0 = u.pn * BM + wc * 32 + 8 * fq;
        f32x4 bv[2][2];
#pragma unroll
        for (int bj = 0; bj < 2; ++bj)
#pragma unroll
            for (int n = 0; n < 2; ++n) bv[bj][n] = bias ? *(const f32x4*)(bias + bcol0 + bj * HALF + 4 * n) : (f32x4){0.f, 0.f, 0.f, 0.f};
#pragma unroll
        for (int ai = 0; ai < 2; ++ai)
#pragma unroll
            for (int m = 0; m < 4; ++m) { bf16_t* rowp = base + (size_t)(row0 + ai * HALF + m * 16) * ldc + col0;
#pragma unroll
                for (int bj = 0; bj < 2; ++bj) { f32x4 v0 = acc[ai][bj][m][0] + bv[bj][0], v1 = acc[ai][bj][m][1] + bv[bj][1];
                    if (ACT == 1) { f32x2 a = gelu_pk((f32x2){v0[0], v0[1]}), b = gelu_pk((f32x2){v0[2], v0[3]}), c = gelu_pk((f32x2){v1[0], v1[1]}), d = gelu_pk((f32x2){v1[2], v1[3]});
                        v0 = (f32x4){a.x, a.y, b.x, b.y}; v1 = (f32x4){c.x, c.y, d.x, d.y}; }
                    v0 = v0 * sc; v1 = v1 * sc; u32x4 w; w.x = cvt_pk_bf16(v0[0], v0[1]); w.y = cvt_pk_bf16(v0[2], v0[3]); w.z = cvt_pk_bf16(v1[0], v1[1]); w.w = cvt_pk_bf16(v1[2], v1[3]);
                    *(u32x4*)(rowp + bj * HALF) = w; } }
    }
};
template <class Epi, class Sched, bool ALIGN_EPI = false, bool SP2 = false>
__device__ __forceinline__ void gemm_phase(PG8_LAS unsigned char* lds, const Gemm g, const Sched& S, const Epi& E) {
    const int tid = threadIdx.x, wid = __builtin_amdgcn_readfirstlane(tid >> 6), lane = tid & 63, wr = wid >> 2, wc = wid & 3, fr = lane & 15, fq = lane >> 4;
    const int K = g.K, nt = K / BK;
    unsigned voffA[2], voffB[2];
#pragma unroll
    for (int i = 0; i < 2; ++i) { int R, C; stage_rc(tid * 16 + i * 8192, R, C); const int Rb = Epi::PERM ? ((R & ~31) + perm32(R & 31)) : R;
        voffA[i] = (unsigned)(R * K + C) * 2u; voffB[i] = (unsigned)(Rb * K + C) * 2u; }
    const size_t kstep = (size_t)(BK * 2);
    const size_t hstep = (size_t)HALF * K * 2;
    const size_t tstep = 2 * hstep;
    const unsigned ldsw = (unsigned)wid * 1024u;
    const int aoff = lds_byte(wr * 64 + fr, fq * 8), boff = lds_byte(wc * 32 + fr, fq * 8);
#define PG8_SA(b, h) (((b) * 2 + (h)) * HTB)
#define PG8_SB(b, h) ((4 + (b) * 2 + (h)) * HTB)
#define PG8_STAGE(bufoff, gbase, voff) do { _Pragma("unroll") for (int _i = 0; _i < 2; ++_i) \
        __builtin_amdgcn_global_load_lds((const unsigned*)((const char*)(gbase) + (voff)[_i]), (PG8_LAS unsigned*)(lds + (bufoff) + ldsw + _i * 8192), 16, 0, 0); } while (0)
#define PG8_LDA(dst, b, h) do { _Pragma("unroll") for (int m = 0; m < 4; ++m) _Pragma("unroll") for (int k = 0; k < 2; ++k) dst[m][k] = *(const PG8_LAS bf16x8*)(lds + PG8_SA(b, h) + aoff + m * 2048 + k * 1024); } while (0)
#define PG8_LDB(dst, b, h) do { _Pragma("unroll") for (int n = 0; n < 2; ++n) _Pragma("unroll") for (int k = 0; k < 2; ++k) dst[n][k] = *(const PG8_LAS bf16x8*)(lds + PG8_SB(b, h) + boff + n * 2048 + k * 1024); } while (0)
#define PG8_MMA(ai, bj, At, Bt) do { __builtin_amdgcn_s_setprio(1); _Pragma("unroll") for (int m = 0; m < 4; ++m) _Pragma("unroll") for (int n = 0; n < 2; ++n) _Pragma("unroll") for (int k = 0; k < 2; ++k) \
        acc[ai][bj][m][n] = __builtin_amdgcn_mfma_f32_16x16x32_bf16(Bt[n][k], At[m][k], acc[ai][bj][m][n], 0, 0, 0); __builtin_amdgcn_s_setprio(0); } while (0)
#define PG8_WAIT_V(n) asm volatile("s_waitcnt vmcnt(" #n ")" ::: "memory")
#define PG8_WAIT_L(n) asm volatile("s_waitcnt lgkmcnt(" #n ")" ::: "memory")
#define PG8_BAR __builtin_amdgcn_s_barrier()
#define PG8_SCHED __builtin_amdgcn_sched_barrier(0)
    Unit cur, nxt; int ui = 0;
    if (!S.next(0, cur)) return;
    f32x4 acc[2][2][4][2];
#pragma unroll
    for (int a = 0; a < 2; ++a)
#pragma unroll
        for (int b = 0; b < 2; ++b)
#pragma unroll
            for (int m = 0; m < 4; ++m)
#pragma unroll
                for (int n = 0; n < 2; ++n) acc[a][b][m][n] = (f32x4){0.f, 0.f, 0.f, 0.f};
    bf16x8 At[4][2], B0[2][2], B1[2][2];
    const char* cA = (const char*)g.A + (size_t)cur.pm * tstep; const char* cB = (const char*)g.Bt + (size_t)cur.pn * tstep;
    S.a_ready(cur);
    if constexpr (SP2) {
        PG8_STAGE(PG8_SB(0, 0), cB, voffB); PG8_STAGE(PG8_SB(0, 1), cB + hstep, voffB); PG8_STAGE(PG8_SA(0, 0), cA, voffA); PG8_STAGE(PG8_SA(0, 1), cA + hstep, voffA);
        if (wr == 1) PG8_BAR;
        PG8_WAIT_V(2); PG8_BAR;
        PG8_STAGE(PG8_SB(1, 0), cB + kstep, voffB); PG8_STAGE(PG8_SA(1, 0), cA + kstep, voffA); PG8_STAGE(PG8_SB(1, 1), cB + hstep + kstep, voffB);
        PG8_WAIT_V(6); PG8_BAR;
    } else {
        PG8_STAGE(PG8_SB(0, 0), cB, voffB); PG8_STAGE(PG8_SA(0, 0), cA, voffA); PG8_STAGE(PG8_SB(0, 1), cB + hstep, voffB); PG8_STAGE(PG8_SA(0, 1), cA + hstep, voffA);
        if (wr == 1) PG8_BAR;
        PG8_WAIT_V(4); PG8_BAR;
        PG8_STAGE(PG8_SB(1, 0), cB + kstep, voffB); PG8_STAGE(PG8_SA(1, 0), cA + kstep, voffA); PG8_STAGE(PG8_SB(1, 1), cB + hstep + kstep, voffB);
        PG8_WAIT_V(6); PG8_BAR;
    }
    for (;;) {
        const bool has_next = S.next(ui + 1, nxt);
        const char* nA = has_next ? (const char*)g.A + (size_t)nxt.pm * tstep : cA; const char* nB = has_next ? (const char*)g.Bt + (size_t)nxt.pn * tstep : cB;
        for (int t = 0; t < nt; t += 2) {
            const bool last = (t == nt - 2);
            const char* a1 = cA + (size_t)(t + 1) * kstep;
            const char* a2 = last ? nA : cA + (size_t)(t + 2) * kstep; const char* b2 = last ? nB : cB + (size_t)(t + 2) * kstep;
            const char* a3 = a2 + kstep; const char* b3 = b2 + kstep;
            if (last && has_next) S.a_ready(nxt);
            if constexpr (SP2) {
            PG8_LDB(B0, 0, 0); PG8_LDB(B1, 0, 1); PG8_SCHED; PG8_LDA(At, 0, 0); PG8_STAGE(PG8_SA(1, 1), a1 + hstep, voffA);
            PG8_WAIT_V(8); PG8_WAIT_L(0); PG8_BAR; PG8_MMA(0, 0, At, B0); PG8_MMA(0, 1, At, B1); PG8_BAR; PG8_SCHED;
            PG8_LDA(At, 0, 1); PG8_STAGE(PG8_SB(0, 0), b2, voffB); PG8_STAGE(PG8_SB(0, 1), b2 + hstep, voffB); PG8_STAGE(PG8_SA(0, 0), a2, voffA);
            PG8_WAIT_V(8); PG8_WAIT_L(0); PG8_BAR; PG8_MMA(1, 0, At, B0); PG8_MMA(1, 1, At, B1); PG8_BAR; PG8_SCHED;
            PG8_LDB(B0, 1, 0); PG8_LDB(B1, 1, 1); PG8_SCHED; PG8_LDA(At, 1, 0); PG8_STAGE(PG8_SA(0, 1), a2 + hstep, voffA);
            PG8_WAIT_V(8); PG8_WAIT_L(0); PG8_BAR; PG8_MMA(0, 0, At, B0); PG8_MMA(0, 1, At, B1); PG8_BAR; PG8_SCHED;
            PG8_LDA(At, 1, 1); PG8_STAGE(PG8_SB(1, 0), b3, voffB); PG8_STAGE(PG8_SB(1, 1), b3 + hstep, voffB); PG8_STAGE(PG8_SA(1, 0), a3, voffA);
            PG8_WAIT_V(8); PG8_WAIT_L(0); PG8_BAR; PG8_MMA(1, 0, At, B0); PG8_MMA(1, 1, At, B1); PG8_BAR; PG8_SCHED;
            } else {
            PG8_LDB(B0, 0, 0); PG8_SCHED; PG8_LDA(At, 0, 0); PG8_STAGE(PG8_SA(1, 1), a1 + hstep, voffA);
            PG8_WAIT_L(8); PG8_BAR; PG8_WAIT_L(0); PG8_MMA(0, 0, At, B0); PG8_BAR; PG8_SCHED;
            PG8_LDB(B1, 0, 1); PG8_STAGE(PG8_SB(0, 0), b2, voffB);
            PG8_BAR; PG8_WAIT_L(0); PG8_MMA(0, 1, At, B1); PG8_BAR;
            PG8_LDA(At, 0, 1); PG8_STAGE(PG8_SA(0, 0), a2, voffA);
            PG8_BAR; PG8_WAIT_L(0); PG8_MMA(1, 0, At, B0); PG8_BAR; PG8_SCHED;
            PG8_STAGE(PG8_SB(0, 1), b2 + hstep, voffB);
            PG8_WAIT_V(6); PG8_BAR; PG8_MMA(1, 1, At, B1); PG8_BAR;
            PG8_LDB(B0, 1, 0); PG8_SCHED; PG8_LDA(At, 1, 0); PG8_STAGE(PG8_SA(0, 1), a2 + hstep, voffA);
            PG8_WAIT_L(8); PG8_BAR; PG8_WAIT_L(0); PG8_MMA(0, 0, At, B0); PG8_BAR; PG8_SCHED;
            PG8_LDB(B1, 1, 1); PG8_STAGE(PG8_SB(1, 0), b3, voffB);
            PG8_BAR; PG8_WAIT_L(0); PG8_MMA(0, 1, At, B1); PG8_BAR;
            PG8_LDA(At, 1, 1); PG8_STAGE(PG8_SA(1, 0), a3, voffA);
            PG8_BAR; PG8_WAIT_L(0); PG8_MMA(1, 0, At, B0); PG8_BAR; PG8_SCHED;
            PG8_STAGE(PG8_SB(1, 1), b3 + hstep, voffB);
            PG8_WAIT_V(6); PG8_BAR; PG8_MMA(1, 1, At, B1); PG8_BAR;
            }
        }
        if constexpr (ALIGN_EPI) { if (wr == 0) PG8_BAR; }
        if constexpr (!Epi::AFTER_DRAIN) { E(acc, cur, wr, wc, fr, fq); S.done(cur); }
        if (!has_next) break;
#pragma unroll
        for (int a = 0; a < 2; ++a)
#pragma unroll
            for (int b = 0; b < 2; ++b)
#pragma unroll
                for (int m = 0; m < 4; ++m)
#pragma unroll
                    for (int n = 0; n < 2; ++n) acc[a][b][m][n] = (f32x4){0.f, 0.f, 0.f, 0.f};
        cur = nxt; cA = nA; cB = nB; ++ui;
        if constexpr (ALIGN_EPI) { if (wr == 1) PG8_BAR; }
    }
    PG8_WAIT_V(0);
    if constexpr (!ALIGN_EPI) { if (wr == 0) PG8_BAR; }
    PG8_BAR;
    if constexpr (Epi::AFTER_DRAIN) { E.fused(acc, cur, wr, wc, fr, fq, lds, wid, lane); S.done(cur); }
#undef PG8_SA
#undef PG8_SB
#undef PG8_STAGE
#undef PG8_LDA
#undef PG8_LDB
#undef PG8_MMA
#undef PG8_WAIT_V
#undef PG8_WAIT_L
#undef PG8_BAR
#undef PG8_SCHED
}
}

#ifndef PG8_SP2
#define PG8_SP2 true
#endif
#ifndef PG8_ALIGN
#define PG8_ALIGN true
#endif
#define GAS __attribute__((address_space(1)))
#define LAS __attribute__((address_space(3)))
typedef unsigned short bf16;
typedef unsigned v4u __attribute__((ext_vector_type(4)));
typedef float f32x4 __attribute__((ext_vector_type(4)));
typedef short bf16x8 __attribute__((ext_vector_type(8)));
typedef GAS unsigned gu32;
typedef GAS unsigned long long gu64;
#define RLX_AGENT __ATOMIC_RELAXED, __HIP_MEMORY_SCOPE_AGENT
#define LDS_WAIT() asm volatile("s_waitcnt lgkmcnt(0)" ::: "memory")
#define VM_WAIT() asm volatile("s_waitcnt vmcnt(0)" ::: "memory")
__device__ __forceinline__ unsigned long long rt() { return __builtin_amdgcn_s_memrealtime(); }
__device__ __forceinline__ unsigned f2bf(float f) { unsigned u = __builtin_bit_cast(unsigned, f); return (u + 0x7fffu + ((u >> 16) & 1u)) >> 16; }
typedef float pk2_f32x2 __attribute__((ext_vector_type(2))); typedef __bf16 pk2_bf16x2 __attribute__((ext_vector_type(2)));
__device__ __forceinline__ unsigned pk2(float lo, float hi) { pk2_f32x2 v = {lo, hi}; pk2_bf16x2 b = __builtin_convertvector(v, pk2_bf16x2); return __builtin_bit_cast(unsigned, b); }

#define XB_TMO      128
#define XB_XCNT(j)  (256  + 64 * (j))
#define XB_XSUB(j)  (1280 + 64 * (j))
#define XB_XGEN(j)  (2304 + 64 * (j))
#define XB_TOP      3328
#define XB_TOPGEN   3392
#define XCD_BAR_WORDS 3456
#define XB_SPIN_CAP (1u << 18)

__device__ __forceinline__ unsigned xb_ld(unsigned* p)              { return __hip_atomic_load(p, __ATOMIC_RELAXED, __HIP_MEMORY_SCOPE_AGENT); }
__device__ __forceinline__ unsigned xb_add(unsigned* p, unsigned v) { return __hip_atomic_fetch_add(p, v, __ATOMIC_RELAXED, __HIP_MEMORY_SCOPE_AGENT); }
__device__ __forceinline__ unsigned xb_xcc_id() { return (unsigned)__builtin_amdgcn_s_getreg((3 << 11) | 20) & 0xFu; }
#define XB_SPIN(cond, bar) do { unsigned _sp = 0; while (cond) { __builtin_amdgcn_s_sleep(1); \
    if ((++_sp & 255u) == 0u) { if (xb_ld(&(bar)[XB_TMO])) break; if (_sp > XB_SPIN_CAP) { atomicAdd(&(bar)[XB_TMO], 1u); break; } } } } while (0)

struct XcdBarrier {
    unsigned* bar; unsigned x;
    volatile LAS unsigned* st;
};

__device__ __forceinline__ XcdBarrier xcd_barrier_post(unsigned* bar, volatile LAS unsigned* st) {
    XcdBarrier b; b.bar = bar; b.x = xb_xcc_id(); b.st = st;
    if (threadIdx.x == 0) (void)xb_add(&bar[XB_XCNT(b.x)], 1u);
    return b;
}
__device__ __forceinline__ void xcd_barrier_complete(unsigned* bar, unsigned x, unsigned& nloc, unsigned& nx) {
    const unsigned G = gridDim.x * gridDim.y * gridDim.z;
    unsigned sum, cnt, mine, sp = 0u;
    for (;;) {
        sum = 0u; cnt = 0u; mine = 0u;
#pragma unroll
        for (unsigned j = 0; j < 16; ++j) { const unsigned c = xb_ld(&bar[XB_XCNT(j)]); sum += c; cnt += (c > 0u) ? 1u : 0u; mine = (j == x) ? c : mine; }
        if (sum == G) break;
        __builtin_amdgcn_s_sleep(1);
        if ((++sp & 255u) == 0u) { if (xb_ld(&bar[XB_TMO])) break; if (sp > XB_SPIN_CAP) { atomicAdd(&bar[XB_TMO], 1u); break; } }
    }
    nloc = mine > 0u ? mine : 1u; nx = cnt > 0u ? cnt : 1u;
}

__device__ __forceinline__ void xcd_barrier(const XcdBarrier& b) {
    asm volatile("s_waitcnt vmcnt(0)" ::: "memory");
    __syncthreads();
    if (threadIdx.x == 0) {
        unsigned* bar = b.bar;
        __builtin_amdgcn_s_waitcnt(0);
        unsigned nloc = b.st[0], nx = b.st[1];
        if (nloc == 0u) { xcd_barrier_complete(bar, b.x, nloc, nx); b.st[0] = nloc; b.st[1] = nx; }
        const unsigned old = xb_add(&bar[XB_XSUB(b.x)], 1u);
        const unsigned gen = old / nloc;
        if (old + 1u == (gen + 1u) * nloc) {
            __builtin_amdgcn_fence(__ATOMIC_RELEASE, "agent");
            asm volatile("s_waitcnt vmcnt(0)" ::: "memory");
            const unsigned og = xb_add(&bar[XB_TOP], 1u);
            const unsigned tg = og / nx;
            if (og + 1u == (tg + 1u) * nx) xb_add(&bar[XB_TOPGEN], 1u);
            else XB_SPIN(xb_ld(&bar[XB_TOPGEN]) == tg, bar);
            __builtin_amdgcn_fence(__ATOMIC_ACQUIRE, "agent");
            xb_add(&bar[XB_XGEN(b.x)], 1u);
            asm volatile("s_waitcnt vmcnt(0)" ::: "memory");
        } else {
            XB_SPIN(xb_ld(&bar[XB_XGEN(b.x)]) == gen, bar);
            __builtin_amdgcn_fence(__ATOMIC_ACQUIRE, "agent");
            asm volatile("s_waitcnt vmcnt(0)" ::: "memory");
        }
    }
    __syncthreads();
}


constexpr int NWAVES = 8;
constexpr int DM = 2048, BATCH = 4, SEQ = 4096, M = BATCH * SEQ;
constexpr int NIN = 6176, NINP = 6144;
constexpr int O_GQ = 0, O_GK = 512, O_GV = 1024, O_GR = 2048, O_AQ = 3072, O_AK = 4096, O_AV = 5120;
constexpr float EPS = 1e-6f;
constexpr int PEER_K = 128;

constexpr size_t MiB = 1u << 20;
constexpr size_t WS_CTL = 0, CTL_ZERO_BYTES = 128 * 1024;
constexpr size_t WS_WIN = 1 * MiB;
constexpr size_t WS_WGD = 25 * MiB;
constexpr size_t WS_GDB = 62 * MiB;
constexpr size_t WS_WOUT = 26 * MiB;
constexpr size_t WS_WQ = 34 * MiB;
constexpr size_t WS_SSQ = 42 * MiB;
constexpr size_t WS_EIDX = 44 * MiB;
constexpr size_t WS_GATE = 52 * MiB;
constexpr size_t WS_SKB = 60 * MiB;
constexpr size_t WS_XN = 64 * MiB;
constexpr size_t WS_PROJ = 128 * MiB;
constexpr size_t WS_HB = 256 * MiB;
constexpr size_t WS_OF = 328 * MiB;
constexpr size_t WS_OB = 360 * MiB;
constexpr size_t WS_ATTP = 392 * MiB;
constexpr size_t WS_ATTML = 488 * MiB;
constexpr size_t WS_GT_QD = 64 * MiB;
constexpr size_t WS_GT_KE = 96 * MiB;
constexpr size_t OUT_GT_AM = 0;
constexpr size_t OUT_GT_DEC = 16 * MiB;
constexpr size_t OUT_GT_VT = 32 * MiB;
constexpr int CW_ATTQX = 512;
constexpr size_t WS_EIDX16 = 494 * MiB;
constexpr size_t WS_END = 498 * MiB;
constexpr size_t OUT_U8 = 64 * MiB;
constexpr size_t OUT_V8 = 96 * MiB;
constexpr size_t WS_SU = 61 * MiB;
constexpr size_t WS_SV = 61 * MiB + 65536;
constexpr int CONV_FIRST_RANK = 24;
constexpr int CW_CONVQ = 256;
constexpr size_t WS_PW = 128 * MiB;
constexpr size_t WS_SSQ2 = 136 * MiB;
constexpr size_t WS_PD = 64 * MiB;
constexpr int PEER_E = 16384;
constexpr int CW_TMO = 0, CW_CODE = 1, CW_BAR = 4096;

constexpr int RING_OFF = 0, RING_BYTES = 131072;
constexpr int LDS_BYTES = 163840;
constexpr int LDSCTL_OFF = LDS_BYTES - 1024, MISC_OFF = LDSCTL_OFF + 320;

typedef float f32x2 __attribute__((ext_vector_type(2)));
typedef float f32x16 __attribute__((ext_vector_type(16)));
typedef int i32x4 __attribute__((ext_vector_type(4)));
typedef int i32x2 __attribute__((ext_vector_type(2)));
__device__ __forceinline__ float bf2f(unsigned short h) { return __builtin_bit_cast(float, (unsigned)h << 16); }
__device__ __forceinline__ float bflo(unsigned w) { return __builtin_bit_cast(float, w << 16); }
__device__ __forceinline__ float bfhi(unsigned w) { return __builtin_bit_cast(float, w & 0xffff0000u); }
#define WRED_DPP(x, ctrl) __builtin_bit_cast(float, __builtin_amdgcn_update_dpp(0, __builtin_bit_cast(int, (x)), ctrl, 0xF, 0xF, false))
#define WRED_LANE(x, l) __builtin_bit_cast(float, __builtin_amdgcn_readlane(__builtin_bit_cast(int, (x)), (l)))
__device__ __forceinline__ float wave_sum(float v) {
    v += WRED_DPP(v, 0xB1); v += WRED_DPP(v, 0x4E); v += WRED_DPP(v, 0x141); v += WRED_DPP(v, 0x140);
    return (WRED_LANE(v, 0) + WRED_LANE(v, 16)) + (WRED_LANE(v, 32) + WRED_LANE(v, 48));
}
__device__ __forceinline__ float wave_max(float v) {
    v = fmaxf(v, WRED_DPP(v, 0xB1)); v = fmaxf(v, WRED_DPP(v, 0x4E)); v = fmaxf(v, WRED_DPP(v, 0x141)); v = fmaxf(v, WRED_DPP(v, 0x140));
    return fmaxf(fmaxf(WRED_LANE(v, 0), WRED_LANE(v, 16)), fmaxf(WRED_LANE(v, 32), WRED_LANE(v, 48)));
}

#define SWAP_PAIR(OP, x, r0, r1) do { unsigned a_ = __builtin_bit_cast(unsigned, (x)), b_ = a_; asm volatile("" : "+v"(b_)); auto s_ = OP(a_, b_, false, false); const unsigned u0_ = s_[0], u1_ = s_[1];   r0 = __builtin_bit_cast(float, u0_); r1 = __builtin_bit_cast(float, u1_); } while (0)
__device__ __forceinline__ float xrow_max(float v) {
    float p, q; SWAP_PAIR(__builtin_amdgcn_permlane16_swap, v, p, q); v = fmaxf(p, q); SWAP_PAIR(__builtin_amdgcn_permlane32_swap, v, p, q); return fmaxf(p, q);
}
__device__ __forceinline__ float xrow_sum(float v) {
    float p, q; SWAP_PAIR(__builtin_amdgcn_permlane16_swap, v, p, q); v = p + q; SWAP_PAIR(__builtin_amdgcn_permlane32_swap, v, p, q); return p + q;
}
template <class T> __device__ __forceinline__ T* opaque(T* p) { asm volatile("" : "+s"(p)); return (T*)(GAS T*)p; }
__device__ __forceinline__ int lane_id() { int x; asm volatile("v_mbcnt_lo_u32_b32 %0, -1, 0\n\tv_mbcnt_hi_u32_b32 %0, -1, %0" : "=v"(x)); return x; }
__device__ __forceinline__ int opaque_v(int x) { asm volatile("" : "+v"(x)); return x; }
template <class T> __device__ __forceinline__ T ldu(const void* ubase, unsigned voff) { return *(const GAS T*)((const GAS char*)ubase + voff); }
template <class T> __device__ __forceinline__ void stu(void* ubase, unsigned voff, T v) { *(GAS T*)((GAS char*)ubase + voff) = v; }
namespace pg8 {
struct EpiRes {
    static constexpr bool PERM = true, AFTER_DRAIN = false;
    const float* x; bf16_t* HB; float* ssq; int ldc;
    __device__ __forceinline__ void operator()(const f32x4 (&acc)[2][2][4][2], const Unit& u, int wr, int wc, int fr, int fq) const {
        const int col0 = u.pn * BM + wc * 32 + 8 * fq;
        const int rbase = u.pm * BM + wr * 64 + fr;
        f32x4 xc[2][2], xn[2][2];
#define EPIRES_LOAD(D, IDX) do { const size_t o_ = (size_t)(rbase + ((IDX) >> 2) * HALF + ((IDX) & 3) * 16) * ldc + col0; _Pragma("unroll") for (int bj = 0; bj < 2; ++bj) { D[bj][0] = *(const f32x4*)(x + o_ + bj * HALF); D[bj][1] = *(const f32x4*)(x + o_ + bj * HALF + 4); } } while (0)
        EPIRES_LOAD(xc, 0);
#pragma unroll
        for (int idx = 0; idx < 8; ++idx) { const int ai = idx >> 2, m = idx & 3;
            if (idx + 1 < 8) EPIRES_LOAD(xn, idx + 1);
            const int r = rbase + ai * HALF + m * 16; const size_t off = (size_t)r * ldc + col0; float s = 0.f;
#pragma unroll
            for (int bj = 0; bj < 2; ++bj) {
                const f32x4 h0 = xc[bj][0] + acc[ai][bj][m][0], h1 = xc[bj][1] + acc[ai][bj][m][1];
                s += ((h0[0] * h0[0] + h0[1] * h0[1]) + (h0[2] * h0[2] + h0[3] * h0[3])) + ((h1[0] * h1[0] + h1[1] * h1[1]) + (h1[2] * h1[2] + h1[3] * h1[3]));
                u32x4 w; w.x = cvt_pk_bf16(h0[0], h0[1]); w.y = cvt_pk_bf16(h0[2], h0[3]); w.z = cvt_pk_bf16(h1[0], h1[1]); w.w = cvt_pk_bf16(h1[2], h1[3]);
                *(u32x4*)(HB + off + bj * HALF) = w;
            }
            s += __shfl_xor(s, 16); s += __shfl_xor(s, 32);
            if (fq == 0) ssq[(size_t)r * 32 + u.pn * 4 + wc] = s;
#pragma unroll
            for (int bj = 0; bj < 2; ++bj) { xc[bj][0] = xn[bj][0]; xc[bj][1] = xn[bj][1]; }
        }
#undef EPIRES_LOAD
    }
};
constexpr int EPI_STAGE_OFF = 131072;
struct EpiBf16S {
    static constexpr bool PERM = true, AFTER_DRAIN = false;
    bf16_t* O; int ldc; LAS unsigned char* stage;
    __device__ __forceinline__ void operator()(const f32x4 (&acc)[2][2][4][2], const Unit& u, int wr, int wc, int fr, int fq) const {
        LAS unsigned char* st = stage + (wr * 4 + wc) * 3584;
        const int lane = fr + 16 * fq, srow = lane >> 2, sch = lane & 3;
        LAS unsigned char* wp = st + fr * 80 + fq * 16; const LAS unsigned char* rp = st + srow * 80 + sch * 16;
        bf16_t* gp = O + (size_t)(u.pm * BM + wr * 64 + srow) * ldc + u.pn * BM + wc * 32 + sch * 8;
#pragma unroll
        for (int ai = 0; ai < 2; ++ai)
#pragma unroll
            for (int m = 0; m < 4; ++m)
#pragma unroll
                for (int bj = 0; bj < 2; ++bj) { const f32x4 v0 = acc[ai][bj][m][0], v1 = acc[ai][bj][m][1];
                    u32x4 w; w.x = cvt_pk_bf16(v0[0], v0[1]); w.y = cvt_pk_bf16(v0[2], v0[3]); w.z = cvt_pk_bf16(v1[0], v1[1]); w.w = cvt_pk_bf16(v1[2], v1[3]);
                    *(LAS u32x4*)wp = w;
                    const u32x4 o = *(const LAS u32x4*)rp;
                    *(u32x4*)(gp + (size_t)(ai * HALF + m * 16) * ldc + bj * HALF) = o; }
    }
};
struct EpiResS {
    static constexpr bool PERM = true, AFTER_DRAIN = false;
    const float* x; bf16_t* HB; float* ssq; int ldc; LAS unsigned char* stage;
    __device__ __forceinline__ void operator()(const f32x4 (&acc)[2][2][4][2], const Unit& u, int wr, int wc, int fr, int fq) const {
        LAS unsigned char* xs = stage + (wr * 4 + wc) * 3584; LAS unsigned char* os = xs + 2304;
        const int lane = fr + 16 * fq, srow = lane >> 2, sch = lane & 3, lrow = lane >> 3, lch = lane & 7;
        const int R0 = u.pm * BM + wr * 64, C0 = u.pn * BM + wc * 32;
        const float* xg = x + (size_t)(R0 + lrow) * ldc + C0 + lch * 4;
        bf16_t* gp = HB + (size_t)(R0 + srow) * ldc + C0 + sch * 8;
        f32x4 xc[4], xn[4];
#define EPIRES_LOAD(D, IDX) do { const size_t o_ = (size_t)(((IDX) >> 2) * HALF + ((IDX) & 3) * 16) * ldc; _Pragma("unroll") for (int bj = 0; bj < 2; ++bj) { D[2 * bj] = *(const f32x4*)(xg + o_ + bj * HALF); D[2 * bj + 1] = *(const f32x4*)(xg + o_ + (size_t)8 * ldc + bj * HALF); } } while (0)
        EPIRES_LOAD(xc, 0);
#pragma unroll
        for (int idx = 0; idx < 8; ++idx) { const int ai = idx >> 2, m = idx & 3;
            if (idx + 1 < 8) EPIRES_LOAD(xn, idx + 1);
            float s = 0.f;
#pragma unroll
            for (int bj = 0; bj < 2; ++bj) {
                *(LAS f32x4*)(xs + lrow * 144 + lch * 16) = xc[2 * bj]; *(LAS f32x4*)(xs + (8 + lrow) * 144 + lch * 16) = xc[2 * bj + 1];
                const f32x4 r0 = *(const LAS f32x4*)(xs + fr * 144 + fq * 32), r1 = *(const LAS f32x4*)(xs + fr * 144 + fq * 32 + 16);
                const f32x4 h0 = r0 + acc[ai][bj][m][0], h1 = r1 + acc[ai][bj][m][1];
                s += ((h0[0] * h0[0] + h0[1] * h0[1]) + (h0[2] * h0[2] + h0[3] * h0[3])) + ((h1[0] * h1[0] + h1[1] * h1[1]) + (h1[2] * h1[2] + h1[3] * h1[3]));
                u32x4 w; w.x = cvt_pk_bf16(h0[0], h0[1]); w.y = cvt_pk_bf16(h0[2], h0[3]); w.z = cvt_pk_bf16(h1[0], h1[1]); w.w = cvt_pk_bf16(h1[2], h1[3]);
                *(LAS u32x4*)(os + fr * 80 + fq * 16) = w;
                const u32x4 o = *(const LAS u32x4*)(os + srow * 80 + sch * 16);
                *(u32x4*)(gp + (size_t)(ai * HALF + m * 16) * ldc + bj * HALF) = o;
            }
            s = xrow_sum(s);
            if (fq == 0) ssq[(size_t)(R0 + ai * HALF + m * 16 + fr) * 32 + u.pn * 4 + wc] = s;
#pragma unroll
            for (int j = 0; j < 4; ++j) xc[j] = xn[j];
        }
#undef EPIRES_LOAD
    }
};
}

struct Frame {
    LAS unsigned char* lds;
    volatile LAS unsigned* MISC;
    gu32* ctl;
    int wave;
    int vcu, G;
};

__device__ __forceinline__ void p0_transpose_item(const float* W, int K, int ldw, const float* gk, bf16* WT, LAS float* scr, int item, int lane) {
    const int nblk = ldw / 32, kb = item / nblk, nb = item % nblk, k0 = 64 * kb, n0 = 32 * nb;
    float wv[32];
    { const GAS float* Wg = (const GAS float*)W + (size_t)(k0 + (lane >> 5)) * ldw + n0 + (lane & 31);
#pragma unroll
      for (int i = 0; i < 32; ++i) wv[i] = Wg[(size_t)(2 * i) * ldw]; }
    if (gk) {
#pragma unroll
      for (int i = 0; i < 32; ++i) wv[i] *= ((const GAS float*)gk)[k0 + 2 * i + (lane >> 5)]; }
#pragma unroll
    for (int i = 0; i < 32; ++i) scr[(2 * i + (lane >> 5)) * 33 + (lane & 31)] = wv[i];
    LDS_WAIT(); asm volatile("" ::: "memory");
    const int c = lane & 7;
#pragma unroll
    for (int j = 0; j < 4; ++j) { const int n = (lane >> 3) + 8 * j; const LAS float* s = scr + (8 * c) * 33 + n;
        v4u o; o.x = pk2(s[0 * 33], s[1 * 33]); o.y = pk2(s[2 * 33], s[3 * 33]); o.z = pk2(s[4 * 33], s[5 * 33]); o.w = pk2(s[6 * 33], s[7 * 33]);
        *(GAS v4u*)(WT + (size_t)(n0 + n) * K + k0 + 8 * c) = o; }
    LDS_WAIT(); asm volatile("" ::: "memory");
}
struct Args {
    const float* in[16]; float* out; unsigned char* ws; int ph_lo, ph_hi, li, pad;
};

__device__ __forceinline__ void p0_prologue(Frame& F, const Args& a) {
    unsigned char* ws = a.ws;
    LAS float* scr = (LAS float*)(F.lds + RING_OFF + F.wave * 16384);
    const int gw = F.vcu * NWAVES + F.wave, NGW = F.G * NWAVES;
    bf16* Win_t = (bf16*)(ws + WS_WIN); bf16* Wout_t = (bf16*)(ws + WS_WOUT); bf16* Wq_t = (bf16*)(ws + WS_WQ); bf16* XN = (bf16*)(ws + WS_XN);
    constexpr int I_IN = (DM / 64) * (NIN / 32), I_SQ = (DM / 64) * (DM / 32);
    constexpr int NITEMS = I_IN + 2 * I_SQ;
    for (int it = gw; it < NITEMS; it += NGW) {
        int r = it;
        if (r < I_IN) { const int nb = r % (NIN / 32); bf16* dst = nb < 96 ? Win_t : nb == 96 ? (bf16*)(ws + WS_WGD) - (size_t)96 * 32 * DM : Win_t - (size_t)32 * DM;
            p0_transpose_item(a.in[2], DM, NIN, nullptr, dst, scr, r, lane_id()); continue; } r -= I_IN;
        if (r < I_SQ) { p0_transpose_item(a.in[9], DM, DM, nullptr, Wout_t, scr, r, lane_id()); continue; } r -= I_SQ;
        p0_transpose_item(a.in[11], DM, DM, a.in[10], Wq_t, scr, r, lane_id());
    }
    { const f32x4* sk = (const f32x4*)a.in[12]; unsigned long long* skb = (unsigned long long*)(ws + WS_SKB);
      for (int i = gw * 64 + lane_id(); i < 8 * 2 * 128 * 128 / 4; i += NGW * 64) { const f32x4 v = sk[i]; skb[i] = (unsigned long long)pk2(v.x, v.y) | ((unsigned long long)pk2(v.z, v.w) << 32); } }
    { const GAS f32x4* gr = (const GAS f32x4*)a.in[1] + lane_id(); f32x4 gg[8];
#pragma unroll
      for (int j = 0; j < 8; ++j) gg[j] = gr[64 * j];
      f32x4 v[8], vn[8], vn2[8];
#define P0_LOAD(MM, V) do { _Pragma("unroll") for (int j = 0; j < 8; ++j) V[j] = ((const GAS f32x4*)(a.in[0] + (size_t)(MM) * DM) + lane_id())[64 * j]; } while (0)
      if (gw < M) { P0_LOAD(gw, v); const int m1 = gw + NGW < M ? gw + NGW : gw; P0_LOAD(m1, vn); }
      for (int m = gw; m < M; m += NGW) { const int mn = m + 2 * NGW < M ? m + 2 * NGW : m;
          P0_LOAD(mn, vn2);
          float ss = 0.f;
#pragma unroll
          for (int j = 0; j < 8; ++j) ss += (v[j].x * v[j].x + v[j].y * v[j].y) + (v[j].z * v[j].z + v[j].w * v[j].w);
          const float rstd = 1.f / sqrtf(wave_sum(ss) * (1.f / DM) + EPS);
          GAS unsigned long long* o8 = (GAS unsigned long long*)(XN + (size_t)m * DM) + lane_id();
#pragma unroll
          for (int j = 0; j < 8; ++j) o8[64 * j] = (unsigned long long)pk2(v[j].x * rstd * gg[j].x, v[j].y * rstd * gg[j].y) | ((unsigned long long)pk2(v[j].z * rstd * gg[j].z, v[j].w * rstd * gg[j].w) << 32);
#pragma unroll
          for (int j = 0; j < 8; ++j) { v[j] = vn[j]; vn[j] = vn2[j]; } } }
#undef P0_LOAD
}


__device__ __forceinline__ void gd_side_gemm(Frame& F, const Args& a) {
    unsigned char* ws = a.ws; const bf16* XN = (const bf16*)(ws + WS_XN); const bf16* WG = (const bf16*)(ws + WS_WGD); float* GDB = (float*)(ws + WS_GDB);
    const int lane = lane_id(), w = F.wave, r32 = lane & 31, hh = lane >> 5; LAS float* part = (LAS float*)F.lds;
    LAS unsigned char* abuf = F.lds + w * 16896;
    for (int blk = F.vcu; blk < M / 64; blk += F.G) { const int tok0 = blk * 64;
        f32x16 acc[2];
#pragma unroll
        for (int tt = 0; tt < 2; ++tt) acc[tt] = (f32x16){0.f, 0.f, 0.f, 0.f, 0.f, 0.f, 0.f, 0.f, 0.f, 0.f, 0.f, 0.f, 0.f, 0.f, 0.f, 0.f};
        bf16x8 bwv[16];
#pragma unroll
        for (int ks = 0; ks < 16; ++ks) bwv[ks] = *(const GAS bf16x8*)(WG + (size_t)r32 * DM + 256 * w + 16 * ks + 8 * hh);
#pragma unroll
        for (int tt = 0; tt < 2; ++tt) {
            v4u ra[16];
#pragma unroll
            for (int i = 0; i < 16; ++i) ra[i] = *(const GAS v4u*)(XN + (size_t)(tok0 + 32 * tt + 2 * i + (lane >> 5)) * DM + 256 * w + (lane & 31) * 8);
#pragma unroll
            for (int i = 0; i < 16; ++i) *(LAS v4u*)(abuf + (2 * i + (lane >> 5)) * 528 + (lane & 31) * 16) = ra[i];
#pragma unroll
            for (int ks = 0; ks < 16; ++ks) { const bf16x8 ax = *(const LAS bf16x8*)(abuf + r32 * 528 + (16 * ks + 8 * hh) * 2); acc[tt] = __builtin_amdgcn_mfma_f32_32x32x16_bf16(ax, bwv[ks], acc[tt], 0, 0, 0); }
        }
        __syncthreads();
#pragma unroll
        for (int tt = 0; tt < 2; ++tt)
#pragma unroll
            for (int r = 0; r < 16; ++r) { const float x = acc[tt][r]; part[((w * 2 + tt) * 16 + r) * 64 + lane] = x; }
        __syncthreads();
#pragma unroll
        for (int i = 0; i < 4; ++i) { const int o = (F.wave * 64 + lane_id()) + 512 * i; float sum = 0.f;
#pragma unroll
            for (int ww = 0; ww < 8; ++ww) sum += part[ww * 2048 + o];
            const int tt = o >> 10, r = (o >> 6) & 15, ln = o & 63; const int t = 32 * tt + (r & 3) + 8 * (r >> 2) + 4 * (ln >> 5);
            GDB[(size_t)(tok0 + t) * 32 + (ln & 31)] = sum; }
        __syncthreads();
    }
}

__device__ __forceinline__ void p3_finalize(Frame& F, const Args& a) {
    unsigned char* ws = a.ws;
    const int gw = F.vcu * NWAVES + F.wave, NGW = F.G * NWAVES, lane = lane_id();
    const GAS bf16* OFp = (const GAS bf16*)(ws + WS_OF); const GAS bf16* OBp = (const GAS bf16*)(ws + WS_OB);
    const GAS bf16* PROJ = (const GAS bf16*)(ws + WS_PROJ); GAS bf16* Y = (GAS bf16*)(ws + WS_XN);
    const GAS float* ATTML = (const GAS float*)(ws + WS_ATTML); const GAS bf16* ATTP = (const GAS bf16*)(ws + WS_ATTP);
    const GAS float* gla_g = (const GAS float*)a.in[7]; const GAS float* att_g = (const GAS float*)a.in[8];
    const f32x4 gg = *(const GAS f32x4*)(gla_g + 4 * lane);
    f32x4 ag[2][2];
#pragma unroll
    for (int p = 0; p < 2; ++p) { ag[p][0] = *(const GAS f32x4*)(att_g + p * 512 + 8 * lane); ag[p][1] = *(const GAS f32x4*)(att_g + p * 512 + 8 * lane + 4); }
    unsigned long long wf[4], wb[4], gr[4], nwf[4], nwb[4], ngr[4]; f32x2 ml[2][3], nml[2][3]; v4u ow[2][3], now[2][3];
#define P3_LOAD(MM, WF, WB, GR, ML, OW) do { _Pragma("unroll") for (int hh = 0; hh < 4; ++hh) { WF[hh] = *(const GAS unsigned long long*)(OFp + (size_t)(MM) * 1024 + hh * 256 + 4 * lane); \
            WB[hh] = *(const GAS unsigned long long*)(OBp + (size_t)(MM) * 1024 + hh * 256 + 4 * lane); GR[hh] = *(const GAS unsigned long long*)(PROJ + (size_t)(MM) * NINP + O_GR + hh * 256 + 4 * lane); } \
        _Pragma("unroll") for (int p = 0; p < 2; ++p) { const int col = p * 512 + 8 * lane, hd = col >> 6; _Pragma("unroll") for (int pt = 0; pt < 3; ++pt) { const size_t rec = ((size_t)pt * M + (MM)) * 16 + hd; \
            ML[p][pt] = *(const GAS f32x2*)(ATTML + rec * 2); OW[p][pt] = *(const GAS v4u*)(ATTP + rec * 64 + (col & 63)); } } } while (0)
    if (gw < M) P3_LOAD(gw, wf, wb, gr, ml, ow);
    for (int m = gw; m < M; m += NGW) {
        const int mn = m + NGW < M ? m + NGW : m;
        P3_LOAD(mn, nwf, nwb, ngr, nml, now);
#pragma unroll
        for (int hh = 0; hh < 4; ++hh) {
            const f32x4 o = (f32x4){bflo((unsigned)wf[hh]) + bflo((unsigned)wb[hh]), bfhi((unsigned)wf[hh]) + bfhi((unsigned)wb[hh]), bflo((unsigned)(wf[hh] >> 32)) + bflo((unsigned)(wb[hh] >> 32)), bfhi((unsigned)(wf[hh] >> 32)) + bfhi((unsigned)(wb[hh] >> 32))};
            const float ss = wave_sum((o.x * o.x + o.y * o.y) + (o.z * o.z + o.w * o.w));
            const float rstd = 1.f / sqrtf(ss * (1.f / 256.f) + EPS);
            const float r0 = bflo((unsigned)gr[hh]), r1 = bfhi((unsigned)gr[hh]), r2 = bflo((unsigned)(gr[hh] >> 32)), r3 = bfhi((unsigned)(gr[hh] >> 32));
            const float y0 = o.x * rstd * gg.x * (r0 / (1.f + __expf(-r0))), y1 = o.y * rstd * gg.y * (r1 / (1.f + __expf(-r1)));
            const float y2 = o.z * rstd * gg.z * (r2 / (1.f + __expf(-r2))), y3 = o.w * rstd * gg.w * (r3 / (1.f + __expf(-r3)));
            *(GAS unsigned long long*)(Y + (size_t)m * DM + hh * 256 + 4 * lane) = (unsigned long long)pk2(y0, y1) | ((unsigned long long)pk2(y2, y3) << 32);
        }
        float av[16]; float ss = 0.f;
#pragma unroll
        for (int p = 0; p < 2; ++p) {
            const float mt = fmaxf(fmaxf(ml[p][0].x, ml[p][1].x), ml[p][2].x); const float w0 = __expf(ml[p][0].x - mt), w1 = __expf(ml[p][1].x - mt), w2 = __expf(ml[p][2].x - mt);
            const float inv = 1.f / (w0 * ml[p][0].y + w1 * ml[p][1].y + w2 * ml[p][2].y);
            av[p * 8 + 0] = (w0 * bflo(ow[p][0].x) + w1 * bflo(ow[p][1].x) + w2 * bflo(ow[p][2].x)) * inv; av[p * 8 + 1] = (w0 * bfhi(ow[p][0].x) + w1 * bfhi(ow[p][1].x) + w2 * bfhi(ow[p][2].x)) * inv;
            av[p * 8 + 2] = (w0 * bflo(ow[p][0].y) + w1 * bflo(ow[p][1].y) + w2 * bflo(ow[p][2].y)) * inv; av[p * 8 + 3] = (w0 * bfhi(ow[p][0].y) + w1 * bfhi(ow[p][1].y) + w2 * bfhi(ow[p][2].y)) * inv;
            av[p * 8 + 4] = (w0 * bflo(ow[p][0].z) + w1 * bflo(ow[p][1].z) + w2 * bflo(ow[p][2].z)) * inv; av[p * 8 + 5] = (w0 * bfhi(ow[p][0].z) + w1 * bfhi(ow[p][1].z) + w2 * bfhi(ow[p][2].z)) * inv;
            av[p * 8 + 6] = (w0 * bflo(ow[p][0].w) + w1 * bflo(ow[p][1].w) + w2 * bflo(ow[p][2].w)) * inv; av[p * 8 + 7] = (w0 * bfhi(ow[p][0].w) + w1 * bfhi(ow[p][1].w) + w2 * bfhi(ow[p][2].w)) * inv; }
#pragma unroll
        for (int i = 0; i < 16; ++i) ss += av[i] * av[i];
        const float rstd = 1.f / sqrtf(wave_sum(ss) * (1.f / 1024.f) + EPS);
#pragma unroll
        for (int p = 0; p < 2; ++p) { const f32x4 g0 = ag[p][0], g1 = ag[p][1];
            v4u w; w.x = pk2(av[p * 8 + 0] * rstd * g0.x, av[p * 8 + 1] * rstd * g0.y); w.y = pk2(av[p * 8 + 2] * rstd * g0.z, av[p * 8 + 3] * rstd * g0.w);
            w.z = pk2(av[p * 8 + 4] * rstd * g1.x, av[p * 8 + 5] * rstd * g1.y); w.w = pk2(av[p * 8 + 6] * rstd * g1.z, av[p * 8 + 7] * rstd * g1.w);
            *(GAS v4u*)(Y + (size_t)m * DM + 1024 + p * 512 + 8 * lane) = w; }
#pragma unroll
        for (int hh = 0; hh < 4; ++hh) { wf[hh] = nwf[hh]; wb[hh] = nwb[hh]; gr[hh] = ngr[hh]; }
#pragma unroll
        for (int p = 0; p < 2; ++p)
#pragma unroll
            for (int pt = 0; pt < 3; ++pt) { ml[p][pt] = nml[p][pt]; ow[p][pt] = now[p][pt]; }
    }
#undef P3_LOAD
}


__device__ __forceinline__ void ce_desc(float& a, float& b) { const float hi = fmaxf(a, b), lo = fminf(a, b); a = hi; b = lo; }
__device__ __forceinline__ void sort16_desc(float* v) {
    ce_desc(v[0], v[1]); ce_desc(v[2], v[3]); ce_desc(v[0], v[2]); ce_desc(v[1], v[3]); ce_desc(v[1], v[2]); ce_desc(v[4], v[5]); ce_desc(v[6], v[7]); ce_desc(v[4], v[6]);
    ce_desc(v[5], v[7]); ce_desc(v[5], v[6]); ce_desc(v[0], v[4]); ce_desc(v[2], v[6]); ce_desc(v[2], v[4]); ce_desc(v[1], v[5]); ce_desc(v[3], v[7]); ce_desc(v[3], v[5]);
    ce_desc(v[1], v[2]); ce_desc(v[3], v[4]); ce_desc(v[5], v[6]); ce_desc(v[8], v[9]); ce_desc(v[10], v[11]); ce_desc(v[8], v[10]); ce_desc(v[9], v[11]); ce_desc(v[9], v[10]);
    ce_desc(v[12], v[13]); ce_desc(v[14], v[15]); ce_desc(v[12], v[14]); ce_desc(v[13], v[15]); ce_desc(v[13], v[14]); ce_desc(v[8], v[12]); ce_desc(v[10], v[14]); ce_desc(v[10], v[12]);
    ce_desc(v[9], v[13]); ce_desc(v[11], v[15]); ce_desc(v[11], v[13]); ce_desc(v[9], v[10]); ce_desc(v[11], v[12]); ce_desc(v[13], v[14]); ce_desc(v[0], v[8]); ce_desc(v[4], v[12]);
    ce_desc(v[4], v[8]); ce_desc(v[2], v[10]); ce_desc(v[6], v[14]); ce_desc(v[6], v[10]); ce_desc(v[2], v[4]); ce_desc(v[6], v[8]); ce_desc(v[10], v[12]); ce_desc(v[1], v[9]);
    ce_desc(v[5], v[13]); ce_desc(v[5], v[9]); ce_desc(v[3], v[11]); ce_desc(v[7], v[15]); ce_desc(v[7], v[11]); ce_desc(v[3], v[5]); ce_desc(v[7], v[9]); ce_desc(v[11], v[13]);
    ce_desc(v[1], v[2]); ce_desc(v[3], v[4]); ce_desc(v[5], v[6]); ce_desc(v[7], v[8]); ce_desc(v[9], v[10]); ce_desc(v[11], v[12]); ce_desc(v[13], v[14]);
}
__device__ __forceinline__ void merge16_desc(float* v) {
#pragma unroll
    for (int j = 8; j > 0; j >>= 1)
#pragma unroll
        for (int i = 0; i < 16; ++i) { const int l = i ^ j; if (l > i) ce_desc(v[i], v[l]); }
}
__device__ __forceinline__ void top16_of_two(float* a, const float* b) {
#pragma unroll
    for (int i = 0; i < 16; ++i) a[i] = fmaxf(a[i], b[15 - i]);
    merge16_desc(a);
}
__device__ __forceinline__ void top16_of_64(float* v) {
    sort16_desc(v); sort16_desc(v + 16); sort16_desc(v + 32); sort16_desc(v + 48);
    top16_of_two(v, v + 16); top16_of_two(v + 32, v + 48); top16_of_two(v, v + 32);
}
__device__ __forceinline__ void merge8_desc(float* v) {
#pragma unroll
    for (int j = 4; j > 0; j >>= 1)
#pragma unroll
        for (int i = 0; i < 8; ++i) { const int l = i ^ j; if (l > i) ce_desc(v[i], v[l]); }
}
__device__ __forceinline__ void top16_staircase(const float* A, const float* B, float* t1) {
    float Bp[16]; const float cb = 1.f - (A[15] + B[15]);
#pragma unroll
    for (int j = 0; j < 16; ++j) Bp[j] = B[j] + cb;
#define PK_CND(i, j) __builtin_bit_cast(float, (__builtin_bit_cast(unsigned, A[(i)] + Bp[(j)]) & ~255u) | (unsigned)(255 - (((i) << 4) | (j))))
#pragma unroll
    for (int j = 0; j < 16; ++j) t1[j] = PK_CND(0, j);
#pragma unroll
    for (int i = 4; i < 16; ++i) t1[i] = fmaxf(t1[i], PK_CND(4 + (15 - i), 0));
    merge16_desc(t1);
    float t2[16];
#pragma unroll
    for (int k = 0; k < 8; ++k) t2[k] = PK_CND(1, k);
    t2[8] = 0.f; t2[9] = 0.f; t2[10] = 0.f;
#pragma unroll
    for (int m = 0; m < 5; ++m) t2[11 + m] = PK_CND(2, 4 - m);
    merge16_desc(t2);
    float t3[9];
#pragma unroll
    for (int k = 0; k < 4; ++k) { t3[k] = PK_CND(3, k); t3[4 + k] = PK_CND(4 + (3 - k), 1); }
    merge8_desc(t3);
    t3[8] = PK_CND(4, 2);
#pragma unroll
    for (int k = 7; k >= 0; --k) ce_desc(t3[k], t3[k + 1]);
#pragma unroll
    for (int i = 7; i < 16; ++i) t2[i] = fmaxf(t2[i], t3[15 - i]);
    merge16_desc(t2);
#pragma unroll
    for (int i = 0; i < 16; ++i) t1[i] = fmaxf(t1[i], t2[15 - i]);
    merge16_desc(t1);
#undef PK_CND
}
__device__ __forceinline__ void topk_phase(Frame& F, const Args& a) {
    unsigned char* ws = a.ws; const GAS bf16* QP = (const GAS bf16*)(ws + WS_XN); const GAS bf16* SKB = (const GAS bf16*)(ws + WS_SKB); GAS int* EIDX = (GAS int*)(ws + WS_EIDX); GAS int* EIDX16 = (GAS int*)(ws + WS_EIDX16); GAS float* GATE = (GAS float*)(ws + WS_GATE);
    const int lane = lane_id(), r32 = lane & 31, hh = lane >> 5;
    LAS unsigned char* skl = F.lds;
    LAS int* ktab = (LAS int*)(F.lds + 65536 + F.wave * 8192);
    for (int unit = F.vcu; unit < 8 * (M / 512); unit += F.G) {
        const int h = unit & 7, tok0 = (unit >> 3) * 512 + F.wave * 64;
        __syncthreads();
#pragma unroll
        for (int i = 0; i < 8; ++i) { const int idx = (F.wave * 64 + lane_id()) + 512 * i, key = idx >> 4, ch = idx & 15;
            *(LAS v4u*)(skl + key * 256 + ((ch ^ (key & 15)) * 16)) = *(const GAS v4u*)(SKB + ((size_t)h * 256 + key) * 128 + ch * 8); }
        __syncthreads();
#pragma unroll 1
        for (int tt = 0; tt < 2; ++tt) {
            const size_t row = (size_t)(tok0 + tt * 32 + r32);
            float L[2][16];
#pragma unroll
            for (int c = 0; c < 2; ++c) {
                f32x16 acc[4];
#pragma unroll
                for (int kt = 0; kt < 4; ++kt) acc[kt] = (f32x16){0.f, 0.f, 0.f, 0.f, 0.f, 0.f, 0.f, 0.f, 0.f, 0.f, 0.f, 0.f, 0.f, 0.f, 0.f, 0.f};
                const GAS bf16* qb = QP + row * DM + h * 256 + c * 128 + 8 * hh;
#pragma unroll 2
                for (int st = 0; st < 8; ++st) {
                    const bf16x8 bq = *(const GAS bf16x8*)(qb + 16 * st);
#pragma unroll
                    for (int kt = 0; kt < 4; ++kt) { const int key = c * 128 + 32 * kt + r32; const bf16x8 ak = *(const LAS bf16x8*)(skl + key * 256 + (((2 * st + hh) ^ (key & 15)) * 16));
                        acc[kt] = __builtin_amdgcn_mfma_f32_32x32x16_bf16(ak, bq, acc[kt], 0, 0, 0); }
                }
                float v[64];
#pragma unroll
                for (int kt = 0; kt < 4; ++kt)
#pragma unroll
                    for (int r = 0; r < 16; ++r) { const int key = 32 * kt + (r & 3) + 8 * (r >> 2);
                        const float sc = acc[kt][r];
                        v[kt * 16 + r] = __builtin_bit_cast(float, (__builtin_bit_cast(unsigned, sc) & ~127u) | (unsigned)(key + 4 * hh)); }
                top16_of_64(v);
                float p[16];
#pragma unroll
                for (int i = 0; i < 16; ++i) { float lo_, hi_; SWAP_PAIR(__builtin_amdgcn_permlane32_swap, v[i], lo_, hi_); v[i] = lo_; p[i] = hi_; }
                top16_of_two(v, p);
#pragma unroll
                for (int i = 0; i < 16; ++i) { L[c][i] = v[i]; ktab[(c * 16 + i) * 64 + lane] = (int)(__builtin_bit_cast(unsigned, v[i]) & 127u); }
            }
            float cnd[16]; top16_staircase(L[0], L[1], cnd);
            float rstd; { const GAS f32x4* sp = (const GAS f32x4*)((const GAS float*)(ws + WS_SSQ) + row * 32); float ssq = 0.f;
#pragma unroll
              for (int i = 0; i < 8; ++i) { const f32x4 t4 = sp[i]; ssq += (t4.x + t4.y) + (t4.z + t4.w); }
              rstd = 1.0f / sqrtf(ssq * (1.f / DM) + EPS); }
            float mx = __builtin_bit_cast(float, __builtin_bit_cast(unsigned, cnd[0]) & ~255u), sum = 0.f; float ex[16];
#pragma unroll
            for (int i = 0; i < 16; ++i) { ex[i] = __expf((__builtin_bit_cast(float, __builtin_bit_cast(unsigned, cnd[i]) & ~255u) - mx) * rstd); sum += ex[i]; }
            const float inv = 1.f / sum;
            LDS_WAIT(); asm volatile("" ::: "memory");
            if (hh == 0) {
                int ev[16];
#pragma unroll
                for (int i = 0; i < 16; ++i) { const unsigned bits = 255u - (__builtin_bit_cast(unsigned, cnd[i]) & 255u); const int ia = (bits >> 4) & 15, jb = bits & 15; ev[i] = ktab[ia * 64 + lane] * 128 + ktab[(16 + jb) * 64 + lane]; }
                GAS int* ep = EIDX + row * 128 + h * 16; GAS float* gp = GATE + row * 128 + h * 16;
#pragma unroll
                for (int i = 0; i < 2; ++i) *(GAS i32x4*)(EIDX16 + row * 64 + h * 8 + 4 * i) = (i32x4){ev[8 * i] | (ev[8 * i + 1] << 16), ev[8 * i + 2] | (ev[8 * i + 3] << 16), ev[8 * i + 4] | (ev[8 * i + 5] << 16), ev[8 * i + 6] | (ev[8 * i + 7] << 16)};
#pragma unroll
                for (int i = 0; i < 4; ++i) { *(GAS i32x4*)(ep + 4 * i) = (i32x4){ev[4 * i], ev[4 * i + 1], ev[4 * i + 2], ev[4 * i + 3]}; *(GAS f32x4*)(gp + 4 * i) = (f32x4){ex[4 * i] * inv, ex[4 * i + 1] * inv, ex[4 * i + 2] * inv, ex[4 * i + 3] * inv}; }
            }
            LDS_WAIT(); asm volatile("" ::: "memory");
        }
    }
}

__device__ __forceinline__ void gla_prep_phase(Frame& F, const Args& a) {
    unsigned char* ws = a.ws; const bf16* PROJ;
    const int w = F.wave;
    LAS unsigned char* L = F.lds;
    LAS unsigned char* Qraw = L; LAS unsigned char* Kraw = L + 16384; LAS unsigned char* Vraw = L + 32768; LAS float* GDf = (LAS float*)(L + 65536); LAS float* GSUM = (LAS float*)(L + 73728);
    LAS unsigned char* IMGQ = L + 77824; LAS unsigned char* IMGK = L + 95232; LAS unsigned char* IMGE = L + 112640; LAS unsigned char* AMI = L + 32768;
    v4u rq[2], rk[2], rv[4]; f32x4 rg0, rg1;
#define PREP_LOAD(IT) do { const int b_ = (IT) >> 8, h_ = ((IT) >> 6) & 3, n_ = (IT) & 63; const size_t row0_ = (size_t)b_ * SEQ + n_ * 64; ws = opaque(ws); PROJ = (const bf16*)(ws + WS_PROJ); const int tid_ = opaque_v((F.wave * 64 + lane_id())); \
        _Pragma("unroll") for (int i = 0; i < 2; ++i) { const int idx = tid_ + 512 * i, r = idx >> 4, c = idx & 15; \
            rq[i] = *(const GAS v4u*)(PROJ + (row0_ + r) * NINP + O_GQ + h_ * 128 + c * 8); rk[i] = *(const GAS v4u*)(PROJ + (row0_ + r) * NINP + O_GK + h_ * 128 + c * 8); } \
        _Pragma("unroll") for (int i = 0; i < 4; ++i) { const int idx = tid_ + 512 * i, r = idx >> 5, c = idx & 31; rv[i] = *(const GAS v4u*)(PROJ + (row0_ + r) * NINP + O_GV + h_ * 256 + c * 8); } \
        if (tid_ < 256) { const int r = tid_ >> 2, c = tid_ & 3; const GAS float* gsrc = (const GAS float*)(ws + WS_GDB) + (row0_ + r) * 32 + c * 8; rg0 = *(const GAS f32x4*)gsrc; rg1 = *(const GAS f32x4*)(gsrc + 4); } } while (0)
#define PREP_STORE() do { const int tid_ = opaque_v((F.wave * 64 + lane_id())); \
        _Pragma("unroll") for (int i = 0; i < 2; ++i) { const int idx = tid_ + 512 * i, r = idx >> 4, c = idx & 15; *(LAS v4u*)(Qraw + r * 256 + c * 16) = rq[i]; *(LAS v4u*)(Kraw + r * 256 + c * 16) = rk[i]; } \
        _Pragma("unroll") for (int i = 0; i < 4; ++i) { const int idx = tid_ + 512 * i, r = idx >> 5, c = idx & 31; *(LAS v4u*)(Vraw + r * 512 + c * 16) = rv[i]; } \
        if (tid_ < 256) { const int r = tid_ >> 2, c = tid_ & 3; *(LAS f32x4*)(GDf + r * 32 + c * 8) = rg0; *(LAS f32x4*)(GDf + r * 32 + c * 8 + 4) = rg1; } } while (0)
    if (F.vcu < 1024) PREP_LOAD(F.vcu);
    float up0[16], up1[16], bias0 = 0.f, bias1 = 0.f; int hcur = -1;
    for (int it = F.vcu; it < 1024; it += F.G) {
        const int b = it >> 8, h = (it >> 6) & 3, n = it & 63;
        int tid = opaque_v((F.wave * 64 + lane_id())), lane = tid & 63, r32 = lane & 31, hh = lane >> 5;
        if (h != hcur) { hcur = h; const int d = tid & 127; const GAS float* u0 = (const GAS float*)a.in[3] + h * 128 + d; const GAS float* u1 = (const GAS float*)a.in[5] + h * 128 + d;
#pragma unroll
            for (int r = 0; r < 16; ++r) { up0[r] = u0[r * 512]; up1[r] = u1[r * 512]; }
            bias0 = ((const GAS float*)a.in[4])[h * 128 + d]; bias1 = ((const GAS float*)a.in[6])[h * 128 + d]; }
        PREP_STORE();
        __syncthreads();
        if (it + F.G < 1024) PREP_LOAD(it + F.G);
#pragma unroll
        for (int ks = 0; ks < 4; ++ks) { unsigned pk[4];
#pragma unroll
            for (int p = 0; p < 4; ++p) { const int s0 = 16 * ks + 8 * hh + 2 * p; const unsigned lo = *(const LAS unsigned short*)(Vraw + s0 * 512 + (32 * w + r32) * 2), hi = *(const LAS unsigned short*)(Vraw + (s0 + 1) * 512 + (32 * w + r32) * 2); pk[p] = lo | (hi << 16); }
            *(GAS v4u*)((unsigned char*)a.out + OUT_GT_VT + (size_t)it * 32768 + (w * 4 + ks) * 1024 + lane * 16) = (v4u){pk[0], pk[1], pk[2], pk[3]}; }
        for (int dir = 0; dir < 2; ++dir) {
            const size_t idir = (size_t)(((b * 4 + h) * 2 + dir) * 64 + n); ws = opaque(ws); tid = opaque_v(tid); lane = tid & 63; r32 = lane & 31; hh = lane >> 5;
            {
                const int d = tid & 127, tq = tid >> 7; const float bias = dir ? bias1 : bias0;
                float up[16];
#pragma unroll
                for (int r = 0; r < 16; ++r) up[r] = dir ? up1[r] : up0[r];
                float c[16];
#pragma unroll
                for (int i = 0; i < 16; ++i) { const LAS float* g = GDf + (16 * tq + i) * 32 + dir * 16; float z = bias;
#pragma unroll
                    for (int r = 0; r < 16; ++r) z += g[r] * up[r];
                    c[i] = (fminf(z, 0.f) - __logf(1.f + __expf(-fabsf(z)))) * (1.f / 16.f); }
                if (dir == 0) {
#pragma unroll
                    for (int i = 1; i < 16; ++i) c[i] += c[i - 1];
                } else {
#pragma unroll
                    for (int i = 14; i >= 0; --i) c[i] += c[i + 1];
                }
                GSUM[(dir * 4 + tq) * 128 + d] = dir == 0 ? c[15] : c[0];
                __syncthreads();
                const float t0 = GSUM[(dir * 4 + 0) * 128 + d], t1 = GSUM[(dir * 4 + 1) * 128 + d], t2 = GSUM[(dir * 4 + 2) * 128 + d], t3 = GSUM[(dir * 4 + 3) * 128 + d];
                const float Bt = (t0 + t1) + (t2 + t3);
                float off;
                if (dir == 0) off = (tq > 0 ? t0 : 0.f) + (tq > 1 ? t1 : 0.f) + (tq > 2 ? t2 : 0.f);
                else off = (tq < 1 ? t1 : 0.f) + (tq < 2 ? t2 : 0.f) + (tq < 3 ? t3 : 0.f);
                unsigned kep[8];
#pragma unroll
                for (int i = 0; i < 16; i += 2) { float ke2[2];
#pragma unroll
                    for (int q = 0; q < 2; ++q) { const int t = 16 * tq + i + q; const float bi = c[i + q] + off;
                        const float qv = bf2f(*(const LAS unsigned short*)(Qraw + t * 256 + d * 2)), kv = bf2f(*(const LAS unsigned short*)(Kraw + t * 256 + d * 2));
                        *(LAS unsigned short*)(IMGQ + t * 272 + d * 2) = (unsigned short)pk2(qv * 0.08838834764831845f * __expf(bi), 0.f);
                        *(LAS unsigned short*)(IMGK + t * 272 + d * 2) = (unsigned short)pk2(kv * __expf(-bi), 0.f);
                        ke2[q] = kv * __expf(Bt - bi); }
                    kep[i >> 1] = pk2(ke2[0], ke2[1]); }
                *(LAS v4u*)(IMGE + d * 144 + (16 * tq) * 2) = (v4u){kep[0], kep[1], kep[2], kep[3]};
                *(LAS v4u*)(IMGE + d * 144 + (16 * tq + 8) * 2) = (v4u){kep[4], kep[5], kep[6], kep[7]};
                if (tq == 0) ((GAS float*)((unsigned char*)a.out + OUT_GT_DEC))[idir * 128 + d] = __expf(Bt);
            }
            __syncthreads();
            if (w < 4) {
                const int si = w >> 1, ti = w & 1; f32x16 acc = (f32x16){0.f, 0.f, 0.f, 0.f, 0.f, 0.f, 0.f, 0.f, 0.f, 0.f, 0.f, 0.f, 0.f, 0.f, 0.f, 0.f};
#pragma unroll
                for (int ks = 0; ks < 8; ++ks) { const bf16x8 ak = *(const LAS bf16x8*)(IMGK + (32 * si + r32) * 272 + (16 * ks + 8 * hh) * 2), bq = *(const LAS bf16x8*)(IMGQ + (32 * ti + r32) * 272 + (16 * ks + 8 * hh) * 2);
                    acc = __builtin_amdgcn_mfma_f32_32x32x16_bf16(ak, bq, acc, 0, 0, 0); }
                const int t = 32 * ti + r32;
#pragma unroll
                for (int qd = 0; qd < 4; ++qd) { float v4[4];
#pragma unroll
                    for (int i = 0; i < 4; ++i) { const int sidx = 32 * si + 8 * qd + 4 * hh + i; const float x = acc[4 * qd + i]; const bool keep = dir == 0 ? (sidx <= t) : (sidx >= t); v4[i] = keep ? x : 0.f; }
                    *(LAS unsigned long long*)(AMI + t * 144 + (32 * si + 8 * qd + 4 * hh) * 2) = (unsigned long long)pk2(v4[0], v4[1]) | ((unsigned long long)pk2(v4[2], v4[3]) << 32); }
            } else {
                const int w4 = w - 4;
#pragma unroll
                for (int q = 0; q < 4; ++q) { const int bq = w4 * 4 + q, tt = bq >> 3, ks = bq & 7, j = ks >> 1, u = ks & 1; const int t = 32 * tt + r32;
                    const unsigned long long p0 = *(const LAS unsigned long long*)(IMGQ + t * 272 + (32 * j + 16 * u + 4 * hh) * 2), p1 = *(const LAS unsigned long long*)(IMGQ + t * 272 + (32 * j + 16 * u + 8 + 4 * hh) * 2);
                    *(GAS v4u*)(ws + WS_GT_QD + idir * 16384 + bq * 1024 + lane * 16) = (v4u){(unsigned)p0, (unsigned)(p0 >> 32), (unsigned)p1, (unsigned)(p1 >> 32)}; }
#pragma unroll
                for (int q = 0; q < 4; ++q) { const int bk = w4 * 4 + q, j = bk >> 2, ks = bk & 3; const int d = 32 * j + r32;
                    *(GAS v4u*)(ws + WS_GT_KE + idir * 16384 + bk * 1024 + lane * 16) = *(const LAS v4u*)(IMGE + d * 144 + (16 * ks + 8 * hh) * 2); }
            }
            __syncthreads();
            { const int tt = w >> 2, ks = w & 3; const int t = 32 * tt + r32;
              *(GAS v4u*)((unsigned char*)a.out + OUT_GT_AM + idir * 8192 + w * 1024 + lane * 16) = *(const LAS v4u*)(AMI + t * 144 + (16 * ks + 8 * hh) * 2); }
            __syncthreads();
        }
    }
#undef PREP_LOAD
#undef PREP_STORE
}

__device__ __forceinline__ void gla_seq_phase(Frame& F, const Args& a) {
    unsigned char* ws = a.ws;
    const int w = F.wave;
    constexpr int GBUF = 57856;
    const int bx_ = (int)blockIdx.x;
    const int su_ = (F.G % 8 == 0 && F.G >= 64) ? (((bx_ >> 3) < 8) ? (bx_ & 7) * 8 + (bx_ >> 3) : 64) : bx_;
    for (int unit = su_; unit < 64; unit += F.G) {
        const int dir = unit & 1, eh = (unit >> 1) & 1, bh = unit >> 2, b = bh >> 2, h = bh & 3;
        if (w >= 4) {
            const int lt = opaque_v((F.wave * 64 + lane_id())) - 256;
            v4u A[15], B[15];
#define GLA_LOAD(R, NS) do { const int n_ = dir ? 63 - (NS) : (NS); const size_t idir_ = (size_t)((bh * 2 + dir) * 64 + n_), iv_ = (size_t)(bh * 64 + n_); const unsigned char* o_ = opaque((const unsigned char*)a.out); const unsigned char* w_ = opaque(ws); \
            const GAS v4u* gq_ = (const GAS v4u*)(w_ + WS_GT_QD + idir_ * 16384); const GAS v4u* gk_ = (const GAS v4u*)(w_ + WS_GT_KE + idir_ * 16384); const GAS v4u* ga_ = (const GAS v4u*)(o_ + OUT_GT_AM + idir_ * 8192); \
            const GAS v4u* gv_ = (const GAS v4u*)(o_ + OUT_GT_VT + iv_ * 32768 + eh * 16384); const GAS v4u* gd_ = (const GAS v4u*)(o_ + OUT_GT_DEC + idir_ * 512); \
            _Pragma("unroll") for (int i = 0; i < 4; ++i) { R[i] = gq_[lt + 256 * i]; R[4 + i] = gk_[lt + 256 * i]; R[10 + i] = gv_[lt + 256 * i]; } R[8] = ga_[lt]; R[9] = ga_[lt + 256]; R[14] = gd_[lt & 31]; } while (0)
#define GLA_WRITE(R, BUF) do { LAS v4u* d_ = (LAS v4u*)(F.lds + (BUF) * GBUF); \
            _Pragma("unroll") for (int i = 0; i < 4; ++i) { d_[lt + 256 * i] = R[i]; d_[1024 + lt + 256 * i] = R[4 + i]; d_[2560 + lt + 256 * i] = R[10 + i]; } d_[2048 + lt] = R[8]; d_[2048 + lt + 256] = R[9]; if (lt < 32) d_[3584 + lt] = R[14]; } while (0)
            GLA_LOAD(A, 0); GLA_LOAD(B, 1);
            GLA_WRITE(A, 0);
            __syncthreads();
#pragma unroll 1
            for (int ns = 0; ns < 64; ns += 2) {
                if (ns + 2 < 64) GLA_LOAD(A, ns + 2);
                GLA_WRITE(B, 1);
                __syncthreads();
                if (ns + 3 < 64) GLA_LOAD(B, ns + 3);
                if (ns + 2 < 64) GLA_WRITE(A, 0);
                __syncthreads();
            }
#undef GLA_LOAD
#undef GLA_WRITE
        } else {
            f32x16 S[4];
#pragma unroll
            for (int j = 0; j < 4; ++j) S[j] = (f32x16){0.f, 0.f, 0.f, 0.f, 0.f, 0.f, 0.f, 0.f, 0.f, 0.f, 0.f, 0.f, 0.f, 0.f, 0.f, 0.f};
            __syncthreads();
#pragma unroll 1
            for (int ns = 0; ns < 64; ++ns) {
                const int n = dir ? 63 - ns : ns;
                const int lane = opaque_v(lane_id()), r32 = lane & 31, hh = lane >> 5;
                LAS unsigned char* QDl = F.lds + (ns & 1) * GBUF; LAS unsigned char* KEl = QDl + 16384; LAS unsigned char* AMl = QDl + 32768; LAS unsigned char* VTl = QDl + 40960; LAS float* DECl = (LAS float*)(QDl + 57344);
                GAS bf16* Out = (GAS bf16*)(opaque(ws) + (dir ? WS_OB : WS_OF));
                bf16x8 vf[4];
#pragma unroll
                for (int ks = 0; ks < 4; ++ks) vf[ks] = *(const LAS bf16x8*)(VTl + (w * 4 + ks) * 1024 + lane * 16);
                f32x16 o[2];
#pragma unroll
                for (int tt = 0; tt < 2; ++tt) o[tt] = (f32x16){0.f, 0.f, 0.f, 0.f, 0.f, 0.f, 0.f, 0.f, 0.f, 0.f, 0.f, 0.f, 0.f, 0.f, 0.f, 0.f};
#pragma unroll
                for (int ks8 = 0; ks8 < 8; ++ks8) { const int j = ks8 >> 1, u = ks8 & 1; v4u sb;
                    sb.x = pg8::cvt_pk_bf16(S[j][8 * u + 0], S[j][8 * u + 1]); sb.y = pg8::cvt_pk_bf16(S[j][8 * u + 2], S[j][8 * u + 3]); sb.z = pg8::cvt_pk_bf16(S[j][8 * u + 4], S[j][8 * u + 5]); sb.w = pg8::cvt_pk_bf16(S[j][8 * u + 6], S[j][8 * u + 7]);
                    const bf16x8 bs = __builtin_bit_cast(bf16x8, sb);
#pragma unroll
                    for (int tt = 0; tt < 2; ++tt) { const bf16x8 aq = *(const LAS bf16x8*)(QDl + (tt * 8 + ks8) * 1024 + lane * 16); o[tt] = __builtin_amdgcn_mfma_f32_32x32x16_bf16(aq, bs, o[tt], 0, 0, 0); } }
#pragma unroll
                for (int ks = 0; ks < 4; ++ks)
#pragma unroll
                    for (int tt = 0; tt < 2; ++tt) { const bf16x8 am = *(const LAS bf16x8*)(AMl + (tt * 4 + ks) * 1024 + lane * 16); o[tt] = __builtin_amdgcn_mfma_f32_32x32x16_bf16(am, vf[ks], o[tt], 0, 0, 0); }
#pragma unroll
                for (int tt = 0; tt < 2; ++tt)
#pragma unroll
                    for (int r = 0; r < 16; ++r) { const int t = 32 * tt + (r & 3) + 8 * (r >> 2) + 4 * hh; const float x = o[tt][r];
                        Out[((size_t)b * SEQ + 64 * n + t) * 1024 + h * 256 + 32 * (eh * 4 + w) + r32] = (bf16)pk2(x, 0.f); }
#pragma unroll
                for (int j = 0; j < 4; ++j) {
#pragma unroll
                    for (int q = 0; q < 4; ++q) { const f32x4 dv = *(const LAS f32x4*)(DECl + 32 * j + 8 * q + 4 * hh); S[j][4 * q + 0] *= dv.x; S[j][4 * q + 1] *= dv.y; S[j][4 * q + 2] *= dv.z; S[j][4 * q + 3] *= dv.w; }
#pragma unroll
                    for (int ks = 0; ks < 4; ++ks) { const bf16x8 ak = *(const LAS bf16x8*)(KEl + (j * 4 + ks) * 1024 + lane * 16); S[j] = __builtin_amdgcn_mfma_f32_32x32x16_bf16(ak, vf[ks], S[j], 0, 0, 0); } }
                __syncthreads();
            }
        }
    }
}

typedef short v4i16_t __attribute__((ext_vector_type(4)));
__device__ __forceinline__ void attn_phase(Frame& F, const Args& a, int qslot) {
    unsigned char* ws = a.ws; const bf16* PROJ;
    const int w = F.wave;
    volatile LAS int* uword = (volatile LAS int*)(F.lds + 2 * 78336);
    constexpr int NUNITS = 64 * 3 * 32;
#define ATT_DECODE(U) const int bh = (U) / 96, rem = (U) - bh * 96, p = rem >> 5, idx = rem & 31; const int lgd = 2 * p, d = 1 << lgd; \
        const int r = idx >> (5 - lgd), J = idx & ((32 >> lgd) - 1), Lc = SEQ >> lgd; const int b = bh >> 4, h = bh & 15; const int m0 = 128 * J - 64;
    v4u kx[4], vx[4]; v4u qw[2];
#define ATT_LOAD(U) do { ATT_DECODE(U) ws = opaque(ws); PROJ = (const bf16*)(ws + WS_PROJ); const int tid_ = opaque_v((F.wave * 64 + lane_id())); \
        _Pragma("unroll") for (int i = 0; i < 4; ++i) { const int kr = (tid_ >> 3) + 64 * i, ch = tid_ & 7; const int mp = m0 + kr; kx[i] = (v4u){0u, 0u, 0u, 0u}; vx[i] = kx[i]; \
            if (mp >= 0 && mp < Lc) { const bf16* src = PROJ + ((size_t)b * SEQ + r + d * mp) * NINP + O_AK + h * 64 + ch * 8; kx[i] = *(const GAS v4u*)src; vx[i] = *(const GAS v4u*)(src + (O_AV - O_AK)); } } \
        const int tokq_ = r + d * (128 * J + 16 * w + (tid_ & 15)); \
        _Pragma("unroll") for (int sft = 0; sft < 2; ++sft) qw[sft] = *(const GAS v4u*)(PROJ + ((size_t)b * SEQ + tokq_) * NINP + O_AQ + h * 64 + 32 * sft + 8 * ((tid_ & 63) >> 4)); } while (0)
    float tab[40];
    { const int l0 = opaque_v(lane_id());
#pragma unroll
      for (int c = 0; c < 40; ++c) { const int kb = c >> 3, uu = (c >> 2) & 1, rho = c & 3; const int jo = 32 * kb + 8 * (l0 >> 4) + 4 * uu + rho - 64 - (l0 & 15); const int aj = jo < 0 ? -jo : jo; tab[c] = aj <= 64 ? (float)aj : 3.0e38f; } }
#define ATT_FETCH(DST) do { int v_ = NUNITS; int qx_ = uword[2], qt_ = uword[3]; while (qt_ < 8) { const int t_ = (int)__hip_atomic_fetch_add((unsigned*)(F.ctl + CW_ATTQX + 128 * qslot + 16 * qx_), 1u, __ATOMIC_RELAXED, __HIP_MEMORY_SCOPE_AGENT); \
        if (t_ < 768) { v_ = qx_ * 768 + t_; break; } qx_ = (qx_ + 1) & 7; ++qt_; } uword[2] = qx_; uword[3] = qt_; DST = v_; } while (0)
    if ((F.wave * 64 + lane_id()) == 0) { uword[2] = (int)blockIdx.x & 7; uword[3] = 0; int f0, f1; ATT_FETCH(f0); ATT_FETCH(f1); uword[0] = f0; uword[1] = f1; }
    __syncthreads();
    int u = __builtin_amdgcn_readfirstlane(uword[0]), un = __builtin_amdgcn_readfirstlane(uword[1]); int par = 0;
#define ATT_WRITE(BUF) do { const int tid_ = opaque_v((F.wave * 64 + lane_id())); LAS unsigned char* Kw = F.lds + (BUF) * 78336; LAS unsigned char* Vw = Kw + 39168; \
        _Pragma("unroll") for (int i = 0; i < 4; ++i) { const int kr = (tid_ >> 3) + 64 * i, ch = tid_ & 7; *(LAS v4u*)(Kw + kr * 144 + ch * 16) = kx[i]; *(LAS v4u*)(Vw + kr * 144 + ch * 16) = vx[i]; } \
        if (tid_ < 128) { const int kr = 256 + (tid_ >> 3), ch = tid_ & 7; *(LAS v4u*)(Kw + kr * 144 + ch * 16) = (v4u){0u, 0u, 0u, 0u}; *(LAS v4u*)(Vw + kr * 144 + ch * 16) = (v4u){0u, 0u, 0u, 0u}; } } while (0)
    v4u qwc[2];
    if (u < NUNITS) { ATT_LOAD(u); ATT_WRITE(0); qwc[0] = qw[0]; qwc[1] = qw[1]; }
    __syncthreads();
    int bufi = 0;
    while (u < NUNITS) {
        const int tid = opaque_v((F.wave * 64 + lane_id())), lane = tid & 63, q16 = lane & 15, g = lane >> 4;
        int qnext = 0; if (tid == 0) ATT_FETCH(qnext);
        LAS unsigned char* Kl = F.lds + bufi * 78336; LAS unsigned char* Vl = Kl + 39168;
        bf16x8 qf[2];
#pragma unroll
        for (int sft = 0; sft < 2; ++sft) { v4u qs; constexpr float QS = 0.125f * 1.4426950408889634f; qs.x = pk2(bflo(qwc[sft].x) * QS, bfhi(qwc[sft].x) * QS); qs.y = pk2(bflo(qwc[sft].y) * QS, bfhi(qwc[sft].y) * QS); qs.z = pk2(bflo(qwc[sft].z) * QS, bfhi(qwc[sft].z) * QS); qs.w = pk2(bflo(qwc[sft].w) * QS, bfhi(qwc[sft].w) * QS);
            qf[sft] = __builtin_bit_cast(bf16x8, qs); }
        ATT_DECODE(u)
        const int tokq = r + d * (128 * J + 16 * w + q16);
        if (un < NUNITS) ATT_LOAD(un);
        const float nslope = -exp2f(-0.5f * (float)(h + 1)) * (float)d * 1.4426950408889634f;
        const bool inrange = (m0 + 16 * w >= 0) && (m0 + 16 * w + 159 < Lc);
        float sv[5][2][4]; float mx = -3.0e38f;
#pragma unroll
        for (int kb = 0; kb < 5; ++kb)
#pragma unroll
            for (int uu = 0; uu < 2; ++uu) { f32x4 acc = (f32x4){0.f, 0.f, 0.f, 0.f};
                const int krow = 16 * w + 32 * kb + 8 * (q16 >> 2) + 4 * uu + (q16 & 3);
#pragma unroll
                for (int sft = 0; sft < 2; ++sft) { const bf16x8 ak = *(const LAS bf16x8*)(Kl + krow * 144 + (32 * sft + 8 * g) * 2); acc = __builtin_amdgcn_mfma_f32_16x16x32_bf16(ak, qf[sft], acc, 0, 0, 0); }
#pragma unroll
                for (int rho = 0; rho < 4; ++rho) { const float x = acc[rho]; sv[kb][uu][rho] = __builtin_fmaf(nslope, tab[kb * 8 + uu * 4 + rho], x); } }
        if (!inrange) {
#pragma unroll
            for (int kb = 0; kb < 5; ++kb)
#pragma unroll
                for (int uu = 0; uu < 2; ++uu)
#pragma unroll
                    for (int rho = 0; rho < 4; ++rho) { const int mp = m0 + 16 * w + 32 * kb + 8 * g + 4 * uu + rho; if (mp < 0 || mp >= Lc) sv[kb][uu][rho] = -3.0e38f; } }
#pragma unroll
        for (int kb = 0; kb < 5; ++kb)
#pragma unroll
            for (int uu = 0; uu < 2; ++uu)
#pragma unroll
                for (int rho = 0; rho < 4; ++rho) mx = fmaxf(mx, sv[kb][uu][rho]);
        mx = xrow_max(mx);
        float lsum = 0.f; bf16x8 pf[5];
#pragma unroll
        for (int kb = 0; kb < 5; ++kb) { float e[8];
#pragma unroll
            for (int uu = 0; uu < 2; ++uu)
#pragma unroll
                for (int rho = 0; rho < 4; ++rho) { const float pe = __builtin_amdgcn_exp2f(sv[kb][uu][rho] - mx); e[uu * 4 + rho] = pe; lsum += pe; }
            v4u pw; pw.x = pk2(e[0], e[1]); pw.y = pk2(e[2], e[3]); pw.z = pk2(e[4], e[5]); pw.w = pk2(e[6], e[7]); pf[kb] = __builtin_bit_cast(bf16x8, pw); }
        lsum = xrow_sum(lsum);
        f32x4 oT[4];
#pragma unroll
        for (int nn = 0; nn < 4; ++nn) oT[nn] = (f32x4){0.f, 0.f, 0.f, 0.f};
#pragma unroll
        for (int kb = 0; kb < 5; ++kb)
#pragma unroll
            for (int nn = 0; nn < 4; ++nn) { const LAS unsigned char* va = Vl + (16 * w + 32 * kb + 8 * g + (q16 >> 2)) * 144 + (16 * nn + 4 * (q16 & 3)) * 2;
                const v4i16_t lo = __builtin_amdgcn_ds_read_tr16_b64_v4i16((LAS v4i16_t*)va), hi = __builtin_amdgcn_ds_read_tr16_b64_v4i16((LAS v4i16_t*)(va + 4 * 144));
                const bf16x8 vf = (bf16x8){lo[0], lo[1], lo[2], lo[3], hi[0], hi[1], hi[2], hi[3]};
                oT[nn] = __builtin_amdgcn_mfma_f32_16x16x32_bf16(vf, pf[kb], oT[nn], 0, 0, 0); }
        { LAS unsigned char* Ko = F.lds + (bufi ^ 1) * 78336;
          LAS unsigned char* sw = Ko + ((q16 & 8) ? 39168 : 0) + (8 * w + (q16 & 7)) * 144 + 8 * g;
#pragma unroll
          for (int nn = 0; nn < 4; ++nn) *(LAS unsigned long long*)(sw + 32 * nn) = (unsigned long long)pk2(oT[nn][0], oT[nn][1]) | ((unsigned long long)pk2(oT[nn][2], oT[nn][3]) << 32);
          const int rr = lane >> 3, ch = lane & 7;
#pragma unroll
          for (int hs = 0; hs < 2; ++hs) { const v4u o = *(const LAS v4u*)(Ko + hs * 39168 + (8 * w + rr) * 144 + ch * 16);
              const size_t rec2 = ((size_t)p * M + (size_t)b * SEQ + (size_t)(r + d * (128 * J + 16 * w + 8 * hs + rr))) * 16 + h;
              *(GAS v4u*)((GAS bf16*)(opaque(ws) + WS_ATTP) + rec2 * 64 + 8 * ch) = o; }
          if (g == 0) { const size_t rec = ((size_t)p * M + (size_t)b * SEQ + tokq) * 16 + h; GAS float* ml = (GAS float*)(opaque(ws) + WS_ATTML) + rec * 2; ml[0] = mx * 0.6931471805599453f; ml[1] = lsum; } }
        if (un < NUNITS) { ATT_WRITE(bufi ^ 1); qwc[0] = qw[0]; qwc[1] = qw[1]; }
        if (tid == 0) uword[par] = qnext;
        __syncthreads();
        u = un; un = __builtin_amdgcn_readfirstlane(uword[par]); par ^= 1; bufi ^= 1;
    }
#undef ATT_WRITE
#undef ATT_DECODE
#undef ATT_LOAD
#undef ATT_FETCH
}

typedef __bf16 bf16x2_t __attribute__((ext_vector_type(2)));
__device__ __forceinline__ void peer_convert_tables(Frame& F, const Args& a, int qslot) {
    unsigned char* ws = a.ws; const int lane = lane_id(); volatile LAS int* uword = (volatile LAS int*)(F.lds + 2 * 78336 + 64);
    for (;;) {
        __syncthreads();
        if ((F.wave * 64 + lane_id()) == 0) uword[0] = (int)__hip_atomic_fetch_add((unsigned*)(F.ctl + CW_CONVQ + 64 * qslot), 1u, __ATOMIC_RELAXED, __HIP_MEMORY_SCOPE_AGENT);
        __syncthreads();
        const int blk = __builtin_amdgcn_readfirstlane(uword[0]);
        if (blk >= 2 * PEER_E / 128) break;
        const int rbase = blk * 128 + F.wave * 16; const bool isv = rbase >= PEER_E; const int e0 = rbase & (PEER_E - 1);
        const GAS float* src = (const GAS float*)(isv ? a.in[14] : a.in[13]) + (size_t)e0 * DM + 4 * lane;
        GAS unsigned char* dst = (GAS unsigned char*)a.out + (isv ? OUT_V8 : OUT_U8) + (size_t)e0 * 256 + 4 * lane;     GAS float* sc = (GAS float*)(ws + (isv ? WS_SV : WS_SU)) + e0;
        f32x4 v[8], vn[8];
#pragma unroll
        for (int j = 0; j < 8; ++j) v[j] = *(const GAS f32x4*)(src + 256 * j);
#pragma unroll 1
        for (int i = 0; i < 16; ++i) { const int in_ = i + 1 < 16 ? i + 1 : i;
#pragma unroll
            for (int j = 0; j < 8; ++j) vn[j] = *(const GAS f32x4*)(src + (size_t)in_ * DM + 256 * j);
            float am = 0.f;
#pragma unroll
            for (int j = 0; j < 8; ++j) am = fmaxf(am, fmaxf(fmaxf(fabsf(v[j].x), fabsf(v[j].y)), fmaxf(fabsf(v[j].z), fabsf(v[j].w))));
            am = wave_max(am); am = fmaxf(am, 1e-30f);
            const float inv = 440.f / am;
#pragma unroll
            for (int j = 0; j < 8; ++j) { int p = __builtin_amdgcn_cvt_pk_fp8_f32(v[j].x * inv, v[j].y * inv, 0, false); p = __builtin_amdgcn_cvt_pk_fp8_f32(v[j].z * inv, v[j].w * inv, p, true);
                *(GAS int*)(dst + (size_t)i * 256 + (size_t)j * (PEER_E * 256)) = p; }
            if (lane == 0) sc[i] = am * (1.f / 440.f);
#pragma unroll
            for (int j = 0; j < 8; ++j) v[j] = vn[j]; }
    }
}

__device__ __forceinline__ float dpp_row_sum(float x) {
#define PEER_DPP(ctrl) x += __builtin_bit_cast(float, __builtin_amdgcn_update_dpp(0, __builtin_bit_cast(int, x), ctrl, 0xF, 0xF, false))
    PEER_DPP(0xB1); PEER_DPP(0x4E); PEER_DPP(0x141); PEER_DPP(0x140);
#undef PEER_DPP
    return x;
}
template <bool VPH, int PBS, bool LA> __device__ __forceinline__ void peer_uv_phase(Frame& F, const Args& a) {
    unsigned char* ws = a.ws; GAS bf16* H = (GAS bf16*)(ws + WS_HB); const GAS float* g2 = (const GAS float*)a.in[10];
    const int sl = blockIdx.x & 7, rk = blockIdx.x >> 3, nrk = F.G >> 3, tpw = M / nrk / NWAVES, nq = tpw / 4;
    const unsigned char* TAB; const GAS int* EIDX; const GAS float* SSQ; const GAS float* PW; GAS float* PD; GAS float* SSQ2;
    LAS int* idt = (LAS int*)(F.lds + F.wave * 8704);
    LAS float* wt = (LAS float*)(F.lds + F.wave * 8704 + 4352);
    const int t0 = (rk * NWAVES + F.wave) * tpw;
#define PEER_STAGE_LOAD(QI) do { const size_t tb_ = (size_t)(t0 + 4 * (QI) + a4) * 64; _Pragma("unroll") for (int k = 0; k < 4; ++k) sid[k] = EIDX[tb_ + 16 * k + q]; } while (0)
#define PEER_STAGE_WRITE(QI) do { const int bf_ = ((QI) & 1) * 528; _Pragma("unroll") for (int k = 0; k < 4; ++k) *(LAS i32x2*)(idt + bf_ + a4 * 132 + 32 * k + 2 * q) = (i32x2){sid[k] & 0xffff, (int)((unsigned)sid[k] >> 16)}; } while (0)
#define PEER_STAGE_W(QI) do { if (VPH) { const size_t tb_ = (size_t)(t0 + 4 * (QI) + a4) * 128; const int bf_ = ((QI) & 1) * 528; _Pragma("unroll") for (int k = 0; k < 8; ++k) wt[bf_ + a4 * 132 + 16 * k + q] = PW[tb_ + 16 * k + q]; LDS_WAIT(); asm volatile("" ::: "memory"); } } while (0)
#define PEER_ISSUE(R, QI, WB) do { const int bf_ = ((QI) & 1) * 528 + a4 * 132 + (WB) * PBS; i32x4 e4_; _Pragma("unroll") for (int j = 0; j < PBS; ++j) { if ((j & 3) == 0) e4_ = *(const LAS i32x4*)(idt + bf_ + j); const int e_ = (j & 3) == 0 ? e4_.x : (j & 3) == 1 ? e4_.y : (j & 3) == 2 ? e4_.z : e4_.w; R[j] = ldu<i32x4>(TAB, (unsigned)e_ * 256u + (unsigned)(16 * q)); } } while (0)
    unsigned xq[8]; float acc[16];
#define PEER_QUAD_BEGIN(QI) do { const size_t t_ = (size_t)(t0 + 4 * (QI) + a4); \
        if (!VPH) { f32x4 hq[4]; { const v4u h0_ = *(const GAS v4u*)(H + t_ * DM + 256 * sl + 16 * q), h1_ = *(const GAS v4u*)(H + t_ * DM + 256 * sl + 16 * q + 8); \
            hq[0] = (f32x4){bflo(h0_.x), bfhi(h0_.x), bflo(h0_.y), bfhi(h0_.y)}; hq[1] = (f32x4){bflo(h0_.z), bfhi(h0_.z), bflo(h0_.w), bfhi(h0_.w)}; hq[2] = (f32x4){bflo(h1_.x), bfhi(h1_.x), bflo(h1_.y), bfhi(h1_.y)}; hq[3] = (f32x4){bflo(h1_.z), bfhi(h1_.z), bflo(h1_.w), bfhi(h1_.w)}; }  const float pss_ = dpp_row_sum(SSQ[t_ * 32 + q] + SSQ[t_ * 32 + 16 + q]); const float rstd_ = 1.f / sqrtf(pss_ * (1.f / DM) + EPS); f32x4 gv[4]; \
            _Pragma("unroll") for (int k = 0; k < 4; ++k) gv[k] = *(const GAS f32x4*)(g2 + 256 * sl + 16 * q + 4 * k); \
            _Pragma("unroll") for (int k = 0; k < 4; ++k) { xq[2 * k] = pk2(hq[k].x * rstd_ * gv[k].x, hq[k].y * rstd_ * gv[k].y); xq[2 * k + 1] = pk2(hq[k].z * rstd_ * gv[k].z, hq[k].w * rstd_ * gv[k].w); } } \
        else { _Pragma("unroll") for (int k = 0; k < 16; ++k) acc[k] = 0.f; } } while (0)
#define PEER_COMPUTE(R, QI, WB) do { if (!VPH) { float pdb_ = 0.f; _Pragma("unroll") for (int j = 0; j < PBS; ++j) { float d_ = 0.f; _Pragma("unroll") for (int k = 0; k < 4; ++k) { const int dw_ = R[j][k]; \
                d_ = __builtin_amdgcn_fdot2_f32_bf16(__builtin_amdgcn_cvt_scalef32_pk_bf16_fp8(dw_, 1.0f, false), __builtin_bit_cast(bf16x2_t, xq[2 * k]), d_, false); \
                d_ = __builtin_amdgcn_fdot2_f32_bf16(__builtin_amdgcn_cvt_scalef32_pk_bf16_fp8(dw_, 1.0f, true), __builtin_bit_cast(bf16x2_t, xq[2 * k + 1]), d_, false); } \
                d_ = dpp_row_sum(d_); pdb_ = (q == j) ? d_ : pdb_; } \
            if (q < PBS) PD[((size_t)(t0 + 4 * (QI) + a4) * 8 + sl) * 128 + PBS * (WB) + q] = pdb_; } \
        else { const int bf_ = ((QI) & 1) * 528 + a4 * 132 + (WB) * PBS; f32x4 w4_; _Pragma("unroll") for (int j = 0; j < PBS; ++j) { if ((j & 3) == 0) w4_ = *(const LAS f32x4*)(wt + bf_ + j); const float w_ = (j & 3) == 0 ? w4_.x : (j & 3) == 1 ? w4_.y : (j & 3) == 2 ? w4_.z : w4_.w; int r0_ = R[j][0], r1_ = R[j][1], r2_ = R[j][2], r3_ = R[j][3]; asm volatile("" : "+v"(r0_), "+v"(r1_), "+v"(r2_), "+v"(r3_));     \
                _Pragma("unroll") for (int k = 0; k < 4; ++k) { const int dw_ = k == 0 ? r0_ : k == 1 ? r1_ : k == 2 ? r2_ : r3_; \
                const f32x2 lo_ = __builtin_amdgcn_cvt_pk_f32_fp8(dw_, false), hi_ = __builtin_amdgcn_cvt_pk_f32_fp8(dw_, true); \
                acc[4 * k + 0] += w_ * lo_.x; acc[4 * k + 1] += w_ * lo_.y; acc[4 * k + 2] += w_ * hi_.x; acc[4 * k + 3] += w_ * hi_.y; } } } } while (0)
#define PEER_QUAD_END(QI) do { if (VPH) { const size_t t_ = (size_t)(t0 + 4 * (QI) + a4); GAS bf16* hp_ = H + t_ * DM + 256 * sl + 16 * q; const v4u h0_ = *(const GAS v4u*)hp_, h1_ = *(const GAS v4u*)(hp_ + 8); \
            float y_[16]; y_[0] = bflo(h0_.x); y_[1] = bfhi(h0_.x); y_[2] = bflo(h0_.y); y_[3] = bfhi(h0_.y); y_[4] = bflo(h0_.z); y_[5] = bfhi(h0_.z); y_[6] = bflo(h0_.w); y_[7] = bfhi(h0_.w); \
            y_[8] = bflo(h1_.x); y_[9] = bfhi(h1_.x); y_[10] = bflo(h1_.y); y_[11] = bfhi(h1_.y); y_[12] = bflo(h1_.z); y_[13] = bfhi(h1_.z); y_[14] = bflo(h1_.w); y_[15] = bfhi(h1_.w); \
            float ss_ = 0.f; _Pragma("unroll") for (int k = 0; k < 16; ++k) { y_[k] += acc[k]; ss_ += y_[k] * y_[k]; } \
            *(GAS v4u*)hp_ = (v4u){pk2(y_[0], y_[1]), pk2(y_[2], y_[3]), pk2(y_[4], y_[5]), pk2(y_[6], y_[7])}; *(GAS v4u*)(hp_ + 8) = (v4u){pk2(y_[8], y_[9]), pk2(y_[10], y_[11]), pk2(y_[12], y_[13]), pk2(y_[14], y_[15])}; \
            ss_ = dpp_row_sum(ss_); if (q == 0) SSQ2[t_ * 8 + sl] = ss_; } } while (0)
#pragma unroll 1
    for (int qi = 0; qi < nq; ++qi) {
        i32x4 rA[PBS], rB[PBS];
        const int lane = opaque_v(lane_id()), a4 = lane >> 4, q = lane & 15; ws = opaque(ws); H = (GAS bf16*)(ws + WS_HB);
        TAB = opaque((const unsigned char*)a.out) + (VPH ? OUT_V8 : OUT_U8) + (size_t)sl * (PEER_E * 256); EIDX = (const GAS int*)(ws + WS_EIDX16); SSQ = (const GAS float*)(ws + WS_SSQ); PW = (const GAS float*)(ws + WS_PW); PD = (GAS float*)(ws + WS_PD); SSQ2 = (GAS float*)(ws + WS_SSQ2);
        int sid[4];
        if (!LA || qi == 0) { PEER_STAGE_LOAD(qi); PEER_STAGE_WRITE(qi); LDS_WAIT(); asm volatile("" ::: "memory"); }
        PEER_ISSUE(rA, qi, 0);
        PEER_ISSUE(rB, qi, 1);
        if (LA && qi + 1 < nq) PEER_STAGE_LOAD(qi + 1);
        PEER_STAGE_W(qi);
        PEER_QUAD_BEGIN(qi);
#pragma unroll
        for (int wb = 0; wb < 128 / PBS; wb += 2) {
            PEER_COMPUTE(rA, qi, wb); if (wb + 2 < 128 / PBS) { PEER_ISSUE(rA, qi, wb + 2); }
            PEER_COMPUTE(rB, qi, wb + 1); if (wb + 3 < 128 / PBS) { PEER_ISSUE(rB, qi, wb + 3); }
        }
        PEER_QUAD_END(qi);
        if (LA && qi + 1 < nq) { PEER_STAGE_WRITE(qi + 1); LDS_WAIT(); asm volatile("" ::: "memory"); }
    }
#undef PEER_STAGE_LOAD
#undef PEER_STAGE_WRITE
#undef PEER_STAGE_W
#undef PEER_ISSUE
#undef PEER_QUAD_BEGIN
#undef PEER_COMPUTE
#undef PEER_QUAD_END
}
__device__ __forceinline__ void peer_w_phase(Frame& F, const Args& a) {
    unsigned char* ws = a.ws; const float* PD = (const float*)(ws + WS_PD); const int* EIDX = (const int*)(ws + WS_EIDX); const float* GATE = (const float*)(ws + WS_GATE);
    const float* SU = (const float*)(ws + WS_SU); const float* SV = (const float*)(ws + WS_SV); float* PW = (float*)(ws + WS_PW);
    for (int i = F.vcu * 512 + (F.wave * 64 + lane_id()); i < M * 128; i += F.G * 512) { const int t = i >> 7, p = i & 127; float d = 0.f;
#pragma unroll
        for (int sl = 0; sl < 8; ++sl) d += PD[((size_t)t * 8 + sl) * 128 + p];
        const int e = EIDX[i]; d *= SU[e];
        PW[i] = GATE[i] * 0.5f * d * (1.f + erff(d * 0.70710678118654752f)) * SV[e]; }
}
__device__ __forceinline__ void peer_n_phase(Frame& F, const Args& a) {
    unsigned char* ws = a.ws; const GAS bf16* Y = (const GAS bf16*)(ws + WS_HB); GAS float* O = (GAS float*)a.out; const GAS float* gf = (const GAS float*)a.in[15]; const GAS float* SSQ2 = (const GAS float*)(ws + WS_SSQ2); const int lane = lane_id();
    f32x4 g0[4], g1[4];
#pragma unroll
    for (int j = 0; j < 4; ++j) { g0[j] = *(const GAS f32x4*)(gf + 512 * j + 8 * lane); g1[j] = *(const GAS f32x4*)(gf + 512 * j + 8 * lane + 4); }
    const int gw = F.vcu * NWAVES + F.wave, NGW = F.G * NWAVES;
    v4u yw[4], yn[4]; f32x4 s0, s1, n0, n1;
    if (gw < M) {
#pragma unroll
        for (int j = 0; j < 4; ++j) yw[j] = *(const GAS v4u*)(Y + (size_t)gw * DM + 512 * j + 8 * lane);
        s0 = *(const GAS f32x4*)(SSQ2 + (size_t)gw * 8); s1 = *(const GAS f32x4*)(SSQ2 + (size_t)gw * 8 + 4); }
    for (int m = gw; m < M; m += NGW) { const int mn = m + NGW < M ? m + NGW : m;
#pragma unroll
        for (int j = 0; j < 4; ++j) yn[j] = *(const GAS v4u*)(Y + (size_t)mn * DM + 512 * j + 8 * lane);
        n0 = *(const GAS f32x4*)(SSQ2 + (size_t)mn * 8); n1 = *(const GAS f32x4*)(SSQ2 + (size_t)mn * 8 + 4);
        const float rf = 1.f / sqrtf((((s0.x + s0.y) + (s0.z + s0.w)) + ((s1.x + s1.y) + (s1.z + s1.w))) * (1.f / DM) + EPS);
#pragma unroll
        for (int j = 0; j < 4; ++j) {
            *(GAS f32x4*)(O + (size_t)m * DM + 512 * j + 8 * lane) = (f32x4){bflo(yw[j].x) * rf * g0[j].x, bfhi(yw[j].x) * rf * g0[j].y, bflo(yw[j].y) * rf * g0[j].z, bfhi(yw[j].y) * rf * g0[j].w};
            *(GAS f32x4*)(O + (size_t)m * DM + 512 * j + 8 * lane + 4) = (f32x4){bflo(yw[j].z) * rf * g1[j].x, bfhi(yw[j].z) * rf * g1[j].y, bflo(yw[j].w) * rf * g1[j].z, bfhi(yw[j].w) * rf * g1[j].w}; }
#pragma unroll
        for (int j = 0; j < 4; ++j) yw[j] = yn[j];
        s0 = n0; s1 = n1; }
}

__global__ void __launch_bounds__(NWAVES * 64, 2) mk_fwd(Args args_in) {
    extern __shared__ __attribute__((aligned(16))) unsigned char lds[];
    Args args = args_in;
#pragma unroll
    for (int i = 0; i < 16; ++i) args.in[i] = (const float*)(const GAS float*)args_in.in[i];
    args.out = (float*)(GAS float*)args_in.out; args.ws = (unsigned char*)(GAS unsigned char*)args_in.ws;
    Frame F;
    F.lds = (LAS unsigned char*)lds;
    F.MISC = (volatile LAS unsigned*)(F.lds + MISC_OFF);
    F.wave = __builtin_amdgcn_readfirstlane((int)threadIdx.x >> 6);
    F.G = gridDim.x; { const int bx = blockIdx.x; F.vcu = (F.G % 8 == 0) ? (bx % 8) * (F.G / 8) + bx / 8 : bx; }
    unsigned char* ws = args.ws;
    F.ctl = (gu32*)(ws + WS_CTL);
    for (int u = (F.wave * 64 + lane_id()); u < (LDS_BYTES - LDSCTL_OFF) / 4; u += NWAVES * 64) ((LAS unsigned*)(F.lds + LDSCTL_OFF))[u] = 0u;
    __syncthreads();
    XcdBarrier bar = xcd_barrier_post((unsigned*)(F.ctl + CW_BAR) + args.li * XCD_BAR_WORDS, F.MISC + 8);
    const int lo = args.ph_lo, hi = args.ph_hi;
#define IN(k) (lo <= (k) && (k) < hi)
#define BOTH(k) (IN(k) && IN((k) + 1))
#define GRID_BAR() xcd_barrier(bar)

    if (IN(0)) { for (int rep = 0; rep < NREP(0); ++rep) p0_prologue(F, args); if (BOTH(0)) GRID_BAR(); }

    if (IN(1)) {
        pg8::Gemm g{(const bf16*)(ws + WS_XN), (const bf16*)(ws + WS_WIN), M, NINP, DM}; pg8::StaticOrder S; S.init(M, NINP, F.G, (int)blockIdx.x);
        pg8::EpiBf16S E{(pg8::bf16_t*)(ws + WS_PROJ), NINP, F.lds + pg8::EPI_STAGE_OFF};
        for (int rep = 0; rep < NREP(1); ++rep) pg8::gemm_phase<pg8::EpiBf16S, pg8::StaticOrder, PG8_ALIGN, PG8_SP2>(F.lds + RING_OFF, g, S, E);
        for (int rep = 0; rep < NREP(11); ++rep) gd_side_gemm(F, args);
        if (BOTH(1)) GRID_BAR();
    }
    if (IN(2)) {
        for (int rep = 0; rep < NREP(21); ++rep) gla_prep_phase(F, args);
        GRID_BAR();
        for (int rep = 0; rep < NREP(2); ++rep) gla_seq_phase(F, args);
        const bool conv_first = ((int)blockIdx.x >> 3) >= CONV_FIRST_RANK;
        for (int pass = 0; pass < 2; ++pass) {
            if (pass == 1 || conv_first) peer_convert_tables(F, args, 0);
            if (pass == 0) attn_phase(F, args, 0); }
        if (BOTH(2)) GRID_BAR(); }
    if (IN(3)) { for (int rep = 0; rep < NREP(3); ++rep) p3_finalize(F, args); if (BOTH(3)) GRID_BAR(); if (REP_PHASE == 99) { GRID_BAR(); GRID_BAR(); GRID_BAR(); GRID_BAR(); } }
    if (IN(4)) {
        pg8::Gemm g{(const bf16*)(ws + WS_XN), (const bf16*)(ws + WS_WOUT), M, DM, DM}; pg8::StaticOrder S; S.init(M, DM, F.G, (int)blockIdx.x);
        pg8::EpiResS E{args.in[0], (pg8::bf16_t*)(ws + WS_HB), (float*)(ws + WS_SSQ), DM, F.lds + pg8::EPI_STAGE_OFF};
        for (int rep = 0; rep < NREP(4); ++rep) pg8::gemm_phase<pg8::EpiResS, pg8::StaticOrder, PG8_ALIGN, PG8_SP2>(F.lds + RING_OFF, g, S, E);
        if (BOTH(4)) GRID_BAR();
    }
    if (IN(5)) {
        pg8::Gemm g{(const bf16*)(ws + WS_HB), (const bf16*)(ws + WS_WQ), M, DM, DM}; pg8::StaticOrder S; S.init(M, DM, F.G, (int)blockIdx.x);
        pg8::EpiBf16S E{(pg8::bf16_t*)(ws + WS_XN), DM, F.lds + pg8::EPI_STAGE_OFF};
        for (int rep = 0; rep < NREP(5); ++rep) pg8::gemm_phase<pg8::EpiBf16S, pg8::StaticOrder, PG8_ALIGN, PG8_SP2>(F.lds + RING_OFF, g, S, E);
        if (BOTH(5)) GRID_BAR();
    }
    if (IN(6)) { for (int rep = 0; rep < NREP(6); ++rep) topk_phase(F, args); if (BOTH(6)) GRID_BAR(); }
    if (IN(7)) {
        for (int rep = 0; rep < NREP(7); ++rep) peer_uv_phase<false, 16, true>(F, args);
        GRID_BAR();
        peer_w_phase(F, args);
        GRID_BAR();
        if (REP_PHASE != 8) peer_uv_phase<true, 8, true>(F, args);
        GRID_BAR();
        peer_n_phase(F, args);
    }
#undef IN
#undef BOTH
}


extern "C" void kernel_launch(void* const* d_in, const int* in_sizes, int n_in, void* d_out, int out_size, void* d_ws, size_t ws_size, hipStream_t stream) {
    static int grid = 0;
    if (grid == 0) {
        if (n_in != 16 || in_sizes[0] != M * DM || out_size != M * DM || ws_size < WS_END) { fprintf(stderr, "kernel_launch: unexpected shapes: n_in %d in0 %d out %d ws %zu\n", n_in, n_in > 0 ? in_sizes[0] : -1, out_size, ws_size); grid = -1; return; }
        int dev = 0, cus = 0;
        if (hipGetDevice(&dev) != hipSuccess || hipDeviceGetAttribute(&cus, hipDeviceAttributeMultiprocessorCount, dev) != hipSuccess) { grid = -1; return; }
        if (hipFuncSetAttribute((const void*)mk_fwd, hipFuncAttributeMaxDynamicSharedMemorySize, LDS_BYTES) != hipSuccess) { fprintf(stderr, "kernel_launch: hipFuncSetAttribute failed\n"); grid = -1; return; }
        (void)hipGetLastError();
        grid = cus;
    }
    if (grid < 0) return;
    (void)hipMemsetAsync((char*)d_ws + WS_CTL, 0, CTL_ZERO_BYTES, stream);
    Args a{};
    for (int i = 0; i < 16; ++i) a.in[i] = (const float*)d_in[i];
    a.out = (float*)d_out; a.ws = (unsigned char*)d_ws;
    a.ph_lo = 0; a.ph_hi = 8; a.li = 0;
    hipLaunchKernelGGL(mk_fwd, dim3(grid), dim3(NWAVES * 64), LDS_BYTES, stream, a);
}
```
